# Optimizing an MI355X kernel written in HIP

```python
import math
import jax
import jax.numpy as jnp
from jax import lax
import numpy as np

D_MODEL = 1024
BATCH = 4
SEQ = 4096
DEPTH = 4

GRID_W = 64
CTX_LEN = 256
N_MIXERS = 3
EPS = 1e-6

N_HEADS = 16
N_KV_HEADS = 4
HEAD_DIM = D_MODEL // N_HEADS
Q_PER_KV = N_HEADS // N_KV_HEADS
QKV_DIM = (N_HEADS + 2 * N_KV_HEADS) * HEAD_DIM
ROPE_THETA = 10000.0
Q_BLOCK = 128

POOL_WINDOWS = (2, 4, 8, 16)
POOL_GROUP = D_MODEL // len(POOL_WINDOWS)

SSM_D_INNER = 2 * D_MODEL
SSM_HEAD_DIM = 64
SSM_HEADS = SSM_D_INNER // SSM_HEAD_DIM
SSM_GROUPS = 4
SSM_HPG = SSM_HEADS // SSM_GROUPS
SSM_STATE = 128
SSM_CONV = 4
SSM_CHUNK = 128
SSM_GN = SSM_GROUPS * SSM_STATE
SSM_CONV_DIM = SSM_D_INNER + 2 * SSM_GN
SSM_IN_DIM = SSM_D_INNER + SSM_CONV_DIM + 2 * SSM_HEADS
DT_MIN = 0.001
DT_MAX = 0.1

MOE_GROUPS = 4
MOE_EXPERTS_PER_GROUP = 8
MOE_EXPERTS = MOE_GROUPS * MOE_EXPERTS_PER_GROUP
MOE_TOPK = 2
MOE_HIDDEN = 512
MOE_BLOCK = 256

N_ATTN_LAYERS = (DEPTH + 2) // N_MIXERS
N_POOL_LAYERS = (DEPTH + 1) // N_MIXERS
N_SSM_LAYERS = DEPTH // N_MIXERS

kernel_name = 'hybrid_attn_pool_ssd_hmoe_dit'


def rms_norm(x, g):
    xf = x.astype(jnp.float32)
    y = xf * lax.rsqrt(jnp.mean(xf * xf, axis=-1, keepdims=True) + EPS)
    return (y * g.astype(jnp.float32)).astype(x.dtype)


def modulate(h, shift, scale):
    return h * (1 + scale) + shift


def axial_rope_tables(n_tokens):
    rows = n_tokens // GRID_W
    row = jnp.broadcast_to(jnp.arange(rows)[:, None], (rows, GRID_W)).reshape(-1).astype(jnp.float32)
    col = jnp.broadcast_to(jnp.arange(GRID_W)[None, :], (rows, GRID_W)).reshape(-1).astype(jnp.float32)
    n_freq = HEAD_DIM // 4
    inv_freq = ROPE_THETA ** (-jnp.arange(n_freq, dtype=jnp.float32) / n_freq)
    ang = jnp.concatenate([row[:, None] * inv_freq, col[:, None] * inv_freq], axis=-1)
    return jnp.cos(ang), jnp.sin(ang)


def apply_rope(x, cos, sin):
    shape = (1, x.shape[1]) + (1,) * (x.ndim - 3) + (HEAD_DIM // 2,)
    cs = cos.reshape(shape)
    sn = sin.reshape(shape)
    xf = x.astype(jnp.float32).reshape(x.shape[:-1] + (HEAD_DIM // 2, 2))
    x0 = xf[..., 0]
    x1 = xf[..., 1]
    out = jnp.stack([x0 * cs - x1 * sn, x0 * sn + x1 * cs], axis=-1).reshape(x.shape)
    return out.astype(x.dtype)


def _attend(q, k, v):
    s = jnp.einsum('bqkgd,btkd->bkgqt', q, k, preferred_element_type=jnp.float32) * (HEAD_DIM ** -0.5)
    p = jax.nn.softmax(s, axis=-1).astype(v.dtype)
    return jnp.einsum('bkgqt,btkd->bqkgd', p, v)


def attention_mixer(h_lat, h_ctx, w_qkv, w_o, q_g, k_g, cos, sin, ctx_out):
    b, n, _ = h_lat.shape
    m = h_ctx.shape[1]
    hq = N_HEADS * HEAD_DIM
    hkv = N_KV_HEADS * HEAD_DIM
    qkv = h_lat @ w_qkv
    q_l = rms_norm(qkv[..., :hq].reshape(b, n, N_KV_HEADS, Q_PER_KV, HEAD_DIM), q_g)
    k_l = rms_norm(qkv[..., hq:hq + hkv].reshape(b, n, N_KV_HEADS, HEAD_DIM), k_g)
    v_l = qkv[..., hq + hkv:].reshape(b, n, N_KV_HEADS, HEAD_DIM)
    q_l = apply_rope(q_l, cos, sin)
    k_l = apply_rope(k_l, cos, sin)
    if ctx_out:
        qkv_c = h_ctx @ w_qkv
        q_c = rms_norm(qkv_c[..., :hq].reshape(b, m, N_KV_HEADS, Q_PER_KV, HEAD_DIM), q_g)
        kv_c = qkv_c[..., hq:]
    else:
        kv_c = h_ctx @ w_qkv[:, hq:]
    k_c = rms_norm(kv_c[..., :hkv].reshape(b, m, N_KV_HEADS, HEAD_DIM), k_g)
    v_c = kv_c[..., hkv:].reshape(b, m, N_KV_HEADS, HEAD_DIM)
    k_all = jnp.concatenate([k_c, k_l], axis=1)
    v_all = jnp.concatenate([v_c, v_l], axis=1)
    n_blk = n // Q_BLOCK
    qb = jnp.moveaxis(q_l.reshape(b, n_blk, Q_BLOCK, N_KV_HEADS, Q_PER_KV, HEAD_DIM), 1, 0)
    o_l = lax.map(lambda qblk: _attend(qblk, k_all, v_all), qb)
    o_l = jnp.moveaxis(o_l, 0, 1).reshape(b, n, hq) @ w_o
    o_c = (_attend(q_c, k_c, v_c).reshape(b, m, hq) @ w_o) if ctx_out else None
    return o_l, o_c


def pool_mixer(h, w_pool, scale):
    b, n, d = h.shape
    cs = jnp.concatenate([jnp.zeros((b, 1, d), jnp.float32), jnp.cumsum(h.astype(jnp.float32), axis=1)], axis=1)
    t = jnp.arange(n)
    outs = []
    for gi, win in enumerate(POOL_WINDOWS):
        lo = jnp.maximum(t - win // 2, 0)
        hi = jnp.minimum(t + win // 2, n)
        sl = slice(gi * POOL_GROUP, (gi + 1) * POOL_GROUP)
        cg = cs[..., sl]
        mean = (cg[:, hi] - cg[:, lo]) / (hi - lo).astype(jnp.float32)[None, :, None]
        diff = (mean - h[..., sl].astype(jnp.float32)).astype(h.dtype)
        outs.append(diff @ w_pool[gi])
    return jnp.concatenate(outs, axis=-1) * scale


def depthwise_conv(u, w, bias):
    out = lax.conv_general_dilated(u, w[:, None, :], window_strides=(1,),
                                   padding=[(SSM_CONV // 2, (SSM_CONV - 1) // 2)],
                                   dimension_numbers=('NWC', 'WIO', 'NWC'),
                                   feature_group_count=u.shape[-1])
    return out + bias


def ssd_chunked(x, dt, a, bm, cm, h0, with_y):
    b, n = x.shape[:2]
    nc = n // SSM_CHUNK
    Q = SSM_CHUNK
    xs = (x * dt[..., None]).reshape(b, nc, Q, SSM_GROUPS, SSM_HPG, SSM_HEAD_DIM)
    la = (dt * a).reshape(b, nc, Q, SSM_GROUPS, SSM_HPG)
    la_cs = jnp.cumsum(la, axis=2)
    bc = bm.reshape(b, nc, Q, SSM_GROUPS, SSM_STATE)
    cc = cm.reshape(b, nc, Q, SSM_GROUPS, SSM_STATE)
    decay_end = jnp.exp(la_cs[:, :, -1:] - la_cs)
    states = jnp.einsum('bcsgn,bcsgrp->bcgrpn', bc, xs * decay_end[..., None])
    chunk_decay = jnp.exp(la_cs[:, :, -1])

    def step(h, inp):
        st, dec = inp
        return h * dec[..., None, None] + st, h

    h_fin, h_in = lax.scan(step, h0.reshape(b, SSM_GROUPS, SSM_HPG, SSM_HEAD_DIM, SSM_STATE),
                           (jnp.moveaxis(states, 1, 0), jnp.moveaxis(chunk_decay, 1, 0)))
    h_fin = h_fin.reshape(b, SSM_HEADS, SSM_HEAD_DIM, SSM_STATE)
    if not with_y:
        return None, h_fin
    h_in = jnp.moveaxis(h_in, 0, 1)
    la_t = jnp.moveaxis(la_cs, 2, -1)
    seg = la_t[..., :, None] - la_t[..., None, :]
    scan_order = jnp.tril(jnp.ones((Q, Q), dtype=bool))
    decay = jnp.exp(jnp.where(scan_order, seg, -jnp.inf))
    scores = jnp.einsum('bclgn,bcsgn->bcgls', cc, bc)
    y_diag = jnp.einsum('bcgrls,bcsgrp->bclgrp', decay * scores[:, :, :, None], xs)
    y_off = jnp.einsum('bclgn,bcgrpn->bclgrp', cc, h_in) * jnp.exp(la_cs)[..., None]
    return (y_diag + y_off).reshape(b, n, SSM_HEADS, SSM_HEAD_DIM), h_fin


def _seq_flip(t, rev):
    return jnp.flip(t, axis=1) if rev else t


def ssd_mixer(h_lat, h_ctx, w_in, conv_w, conv_b, dt_bias, a_log, d_skip, norm_g, w_out, ctx_out):
    def project(h, with_gate):
        b, n = h.shape[:2]
        proj = h @ (w_in if with_gate else w_in[:, SSM_D_INNER:])
        z = proj[..., :SSM_D_INNER] if with_gate else None
        rest = proj[..., SSM_D_INNER:] if with_gate else proj
        xbc = jax.nn.silu(depthwise_conv(rest[..., :SSM_CONV_DIM], conv_w, conv_b)).astype(jnp.float32)
        xh = xbc[..., :SSM_D_INNER].reshape(b, n, SSM_HEADS, SSM_HEAD_DIM)
        bm = xbc[..., SSM_D_INNER:SSM_D_INNER + SSM_GN].reshape(b, n, SSM_GROUPS, SSM_STATE)
        cm = xbc[..., SSM_D_INNER + SSM_GN:].reshape(b, n, SSM_GROUPS, SSM_STATE)
        dt = jax.nn.softplus(rest[..., SSM_CONV_DIM:].astype(jnp.float32).reshape(b, n, 2, SSM_HEADS)
                             + dt_bias.astype(jnp.float32))
        return z, xh, bm, cm, dt

    z_l, x_l, b_l, c_l, dt_l = project(h_lat, True)
    z_c, x_c, b_c, c_c, dt_c = project(h_ctx, ctx_out)
    a = -jnp.exp(a_log.astype(jnp.float32))
    dsk = d_skip.astype(jnp.float32)
    h0 = jnp.zeros((h_ctx.shape[0], SSM_HEADS, SSM_HEAD_DIM, SSM_STATE), jnp.float32)
    y_l = jnp.zeros_like(x_l)
    y_c = jnp.zeros_like(x_c) if ctx_out else None
    for direction in range(2):
        rev = direction == 1
        yc_d, h_ctx_fin = ssd_chunked(_seq_flip(x_c, rev), _seq_flip(dt_c[:, :, direction], rev), a[direction],
                                      _seq_flip(b_c, rev), _seq_flip(c_c, rev), h0, ctx_out)
        yl_d, _ = ssd_chunked(_seq_flip(x_l, rev), _seq_flip(dt_l[:, :, direction], rev), a[direction],
                              _seq_flip(b_l, rev), _seq_flip(c_l, rev), h_ctx_fin, True)
        y_l = y_l + _seq_flip(yl_d, rev) + dsk[direction][:, None] * x_l
        if ctx_out:
            y_c = y_c + _seq_flip(yc_d, rev) + dsk[direction][:, None] * x_c

    def gated_out(y, z):
        b, n = y.shape[:2]
        g = y.reshape(b, n, SSM_D_INNER) * jax.nn.silu(z.astype(jnp.float32))
        g = g.reshape(b, n, SSM_GROUPS, SSM_D_INNER // SSM_GROUPS)
        g = g * lax.rsqrt(jnp.mean(g * g, axis=-1, keepdims=True) + EPS)
        g = g.reshape(b, n, SSM_D_INNER) * norm_g.astype(jnp.float32)
        return g.astype(h_lat.dtype) @ w_out

    return gated_out(y_l, z_l), (gated_out(y_c, z_c) if ctx_out else None)


def hierarchical_moe(h, w_rg, w_re, w_gu, w_down):
    T, d = h.shape
    hf = h.astype(jnp.float32)
    pg = jax.nn.softmax(hf @ w_rg.astype(jnp.float32), axis=-1)
    gate_g, grp = lax.top_k(pg, 1)
    le = (hf @ w_re.astype(jnp.float32)).reshape(T, MOE_GROUPS, MOE_EXPERTS_PER_GROUP)
    le = le[jnp.arange(T), grp[:, 0]]
    top_v, top_i = lax.top_k(le, MOE_TOPK)
    w_sel = gate_g * jax.nn.softmax(top_v, axis=-1)
    expert = grp * MOE_EXPERTS_PER_GROUP + top_i
    n_assign = T * MOE_TOPK
    e_flat = expert.reshape(-1)
    w_flat = w_sel.reshape(-1).astype(h.dtype)
    tok_flat = jnp.repeat(jnp.arange(T, dtype=jnp.int32), MOE_TOPK)
    order = jnp.argsort(e_flat)
    e_sorted = e_flat[order]
    counts = jnp.zeros((MOE_EXPERTS,), jnp.int32).at[e_flat].add(1)
    starts = jnp.cumsum(counts) - counts
    padded = (counts + MOE_BLOCK - 1) // MOE_BLOCK * MOE_BLOCK
    pends = jnp.cumsum(padded)
    pstarts = pends - padded
    dest = pstarts[e_sorted] + jnp.arange(n_assign, dtype=jnp.int32) - starts[e_sorted]
    n_blocks = -(-n_assign // MOE_BLOCK) + MOE_EXPERTS
    n_rows = n_blocks * MOE_BLOCK
    row_tok = jnp.full((n_rows,), T, jnp.int32).at[dest].set(tok_flat[order])
    row_w = jnp.zeros((n_rows,), h.dtype).at[dest].set(w_flat[order])
    block_expert = jnp.minimum(
        jnp.searchsorted(pends, jnp.arange(n_blocks, dtype=jnp.int32) * MOE_BLOCK, side='right'),
        MOE_EXPERTS - 1)
    h_pad = jnp.concatenate([h, jnp.zeros((1, d), h.dtype)], axis=0)

    def expert_block(args):
        rows, e = args
        gu = h_pad[rows] @ w_gu[e]
        return (jax.nn.silu(gu[:, :MOE_HIDDEN]) * gu[:, MOE_HIDDEN:]) @ w_down[e]

    y = lax.map(expert_block, (row_tok.reshape(n_blocks, MOE_BLOCK), block_expert))
    y = y.reshape(n_rows, d) * row_w[:, None]
    return jnp.zeros_like(h_pad).at[row_tok].add(y)[:T]


def setup_inputs(seed: int = 0) -> dict:
    key = jax.random.key(seed)
    ks = iter(jax.random.split(key, 40))
    D = D_MODEL

    def nrm(shape, scale):
        return jax.random.normal(next(ks), shape, jnp.float32) * scale

    u = jax.random.uniform(next(ks), (N_SSM_LAYERS, 2, SSM_HEADS), jnp.float32)
    dt0 = jnp.exp(u * (math.log(DT_MAX) - math.log(DT_MIN)) + math.log(DT_MIN))
    dt_bias = dt0 + jnp.log(-jnp.expm1(-dt0))
    a_log = jnp.log(jax.random.uniform(next(ks), (N_SSM_LAYERS, 2, SSM_HEADS), jnp.float32, 1.0, 16.0))
    return {
        'x': nrm((BATCH, SEQ, D), 1.0),
        'c': nrm((BATCH, D), 1.0),
        'ctx': nrm((BATCH, CTX_LEN, D), 1.0),
        'c_ctx': nrm((D,), 1.0),
        'w_ada': nrm((DEPTH, D, 6 * D), 0.5 * D ** -0.5),
        'b_ada': nrm((DEPTH, 6 * D), 0.02),
        'norm_mix_g': 1.0 + nrm((DEPTH, D), 0.05),
        'norm_ffn_g': 1.0 + nrm((DEPTH, D), 0.05),
        'final_norm_g': 1.0 + nrm((D,), 0.05),
        'attn_w_qkv': nrm((N_ATTN_LAYERS, D, QKV_DIM), D ** -0.5),
        'attn_w_o': nrm((N_ATTN_LAYERS, N_HEADS * HEAD_DIM, D), (N_HEADS * HEAD_DIM) ** -0.5),
        'attn_q_norm_g': 1.0 + nrm((N_ATTN_LAYERS, HEAD_DIM), 0.05),
        'attn_k_norm_g': 1.0 + nrm((N_ATTN_LAYERS, HEAD_DIM), 0.05),
        'pool_w': nrm((N_POOL_LAYERS, len(POOL_WINDOWS), POOL_GROUP, POOL_GROUP), POOL_GROUP ** -0.5),
        'pool_scale': 1.0 + nrm((N_POOL_LAYERS, D), 0.05),
        'ssm_w_in': nrm((N_SSM_LAYERS, D, SSM_IN_DIM), D ** -0.5),
        'ssm_conv_w': nrm((N_SSM_LAYERS, SSM_CONV, SSM_CONV_DIM), SSM_CONV ** -0.5),
        'ssm_conv_b': nrm((N_SSM_LAYERS, SSM_CONV_DIM), 0.02),
        'ssm_dt_bias': dt_bias,
        'ssm_a_log': a_log,
        'ssm_d': 1.0 + nrm((N_SSM_LAYERS, 2, SSM_HEADS), 0.05),
        'ssm_norm_g': 1.0 + nrm((N_SSM_LAYERS, SSM_D_INNER), 0.05),
        'ssm_w_out': nrm((N_SSM_LAYERS, SSM_D_INNER, D), SSM_D_INNER ** -0.5),
        'moe_w_router_group': nrm((DEPTH, D, MOE_GROUPS), D ** -0.5),
        'moe_w_router_expert': nrm((DEPTH, D, MOE_EXPERTS), D ** -0.5),
        'moe_w_gate_up': nrm((DEPTH, MOE_EXPERTS, D, 2 * MOE_HIDDEN), D ** -0.5),
        'moe_w_down': nrm((DEPTH, MOE_EXPERTS, MOE_HIDDEN, D), MOE_HIDDEN ** -0.5),
    }


def reference(x, c, ctx, c_ctx, w_ada, b_ada, norm_mix_g, norm_ffn_g, final_norm_g,
              attn_w_qkv, attn_w_o, attn_q_norm_g, attn_k_norm_g, pool_w, pool_scale,
              ssm_w_in, ssm_conv_w, ssm_conv_b, ssm_dt_bias, ssm_a_log, ssm_d, ssm_norm_g, ssm_w_out,
              moe_w_router_group, moe_w_router_expert, moe_w_gate_up, moe_w_down):
    b, n, d = x.shape
    m = ctx.shape[1]
    cos, sin = axial_rope_tables(n)
    cond_lat = jax.nn.silu(c)
    cond_ctx = jax.nn.silu(c_ctx)
    x_lat, x_ctx = x, ctx
    for i in range(DEPTH):
        kind, j = i % N_MIXERS, i // N_MIXERS
        ctx_out = i < DEPTH - 1
        ctx_in = ctx_out or kind != 1
        mod_l = (cond_lat @ w_ada[i] + b_ada[i])[:, None, :]
        sh_m, sc_m, g_m, sh_f, sc_f, g_f = jnp.split(mod_l, 6, axis=-1)
        h_l = modulate(rms_norm(x_lat, norm_mix_g[i]), sh_m, sc_m)
        if ctx_in:
            n_mod = 6 if ctx_out else 3
            mc = jnp.split(cond_ctx @ w_ada[i][:, :n_mod * d] + b_ada[i][:n_mod * d], n_mod)
            h_c = modulate(rms_norm(x_ctx, norm_mix_g[i]), mc[0], mc[1])
        if kind == 0:
            o_l, o_c = attention_mixer(h_l, h_c, attn_w_qkv[j], attn_w_o[j], attn_q_norm_g[j],
                                       attn_k_norm_g[j], cos, sin, ctx_out)
        elif kind == 1:
            o_l = pool_mixer(h_l, pool_w[j], pool_scale[j])
            o_c = pool_mixer(h_c, pool_w[j], pool_scale[j]) if ctx_out else None
        else:
            o_l, o_c = ssd_mixer(h_l, h_c, ssm_w_in[j], ssm_conv_w[j], ssm_conv_b[j], ssm_dt_bias[j],
                                 ssm_a_log[j], ssm_d[j], ssm_norm_g[j], ssm_w_out[j], ctx_out)
        x_lat = x_lat + g_m * o_l
        if ctx_out:
            x_ctx = x_ctx + mc[2] * o_c
        tokens = modulate(rms_norm(x_lat, norm_ffn_g[i]), sh_f, sc_f).reshape(b * n, d)
        if ctx_out:
            h_cf = modulate(rms_norm(x_ctx, norm_ffn_g[i]), mc[3], mc[4])
            tokens = jnp.concatenate([tokens, h_cf.reshape(b * m, d)], axis=0)
        f = hierarchical_moe(tokens, moe_w_router_group[i], moe_w_router_expert[i],
                             moe_w_gate_up[i], moe_w_down[i])
        x_lat = x_lat + g_f * f[:b * n].reshape(b, n, d)
        if ctx_out:
            x_ctx = x_ctx + mc[5] * f[b * n:].reshape(b, m, d)
    return rms_norm(x_lat, final_norm_g)
```

```cpp
#include <hip/hip_runtime.h>
#include <cstdio>
#include <cstdint>

#define LAS __attribute__((address_space(3)))
#define GAS __attribute__((address_space(1)))
typedef unsigned short bf16;
typedef short bf16x8 __attribute__((ext_vector_type(8)));
typedef short s16x4 __attribute__((ext_vector_type(4)));
typedef float f32x2 __attribute__((ext_vector_type(2)));
typedef float f32x4 __attribute__((ext_vector_type(4)));
typedef float f32x16 __attribute__((ext_vector_type(16)));
typedef unsigned u32x2 __attribute__((ext_vector_type(2)));
typedef unsigned u32x4 __attribute__((ext_vector_type(4)));
typedef __bf16 bf16x2_t __attribute__((ext_vector_type(2)));

constexpr int D = 1024, NB = 4, SEQ = 4096, CTXL = 256, TL = NB * SEQ, TC = NB * CTXL, TT = TL + TC;
constexpr int KVROWS = SEQ + CTXL;
constexpr int NCH = TT / 128;
constexpr int MOE_CAP = TT;
constexpr float EPS = 1e-6f;
constexpr int NWAVES = 8, NTHREADS = 512;
#ifndef NLAYERS
#define NLAYERS 4
#endif
#ifndef DEBUG_CHECKS
#define DEBUG_CHECKS 0
#endif
#ifndef PROBE
#define PROBE 0
#endif
#define PROBE_A0 0
#define PROBE_A1 1
#define PROBE_B0 4
#define PROBE_B1 5
#define PROBE_K 4
#define DEBUG_CUTS { {1, 1, 0, 1}, {3, 2, 0, 1}, {4, 3, 0, 1}, {5, 4, 0, 1}, {8, 5, 0, 2} }

enum { I_X = 0, I_C, I_CTX, I_CCTX, I_WADA, I_BADA, I_NMIX, I_NFFN, I_NFIN, I_WQKV, I_WO, I_QG, I_KG, I_POOLW, I_POOLS, I_WIN, I_CONVW, I_CONVB, I_DTB, I_ALOG, I_DSK, I_SNORM, I_WOUT, I_WRG, I_WRE, I_WGU, I_WDN, N_IN };

constexpr size_t MiB = 1u << 20;
constexpr size_t WS_CTL = 0, CTL_ZERO_BYTES = 1 * MiB;
constexpr size_t WS_MODL = 1 * MiB;
constexpr size_t WS_MODC = WS_MODL + 4 * 4 * 6144 * 4;
constexpr size_t WS_ROPE = 1 * MiB + 512 * 1024;
constexpr size_t WS_WR = 2 * MiB;
constexpr size_t WS_WQKV = 3 * MiB;
constexpr size_t WS_WO = 9 * MiB;
constexpr size_t WS_WPOOL = 13 * MiB;
constexpr size_t WS_WIN = 14 * MiB;
constexpr size_t WS_WOUT = 25 * MiB;
constexpr size_t WS_WGU = 29 * MiB;
constexpr size_t WS_WDN = 285 * MiB;
constexpr size_t WS_X = 413 * MiB;
constexpr size_t WS_HB = 481 * MiB;
constexpr size_t WS_TK = 515 * MiB;
constexpr size_t WS_Q = 549 * MiB;
constexpr size_t WS_K = 583 * MiB;
constexpr size_t WS_V = 592 * MiB;
constexpr size_t WS_Y2 = 601 * MiB;
constexpr size_t WS_ACT = 669 * MiB;
constexpr size_t WS_LIST = 711 * MiB;
constexpr size_t WS_W2 = 714 * MiB;
constexpr size_t WS_Z = 715 * MiB;
constexpr size_t WS_XBC = 783 * MiB;
constexpr size_t WS_DT = 885 * MiB;
constexpr size_t WS_XT = 890 * MiB;
constexpr size_t WS_BN = 958 * MiB;
constexpr size_t WS_BT = 975 * MiB;
constexpr size_t WS_CN = 992 * MiB;
constexpr size_t WS_SCA = 1009 * MiB;
constexpr size_t WS_SCB = 1018 * MiB;
constexpr size_t WS_DEC = 1027 * MiB;
constexpr size_t WS_HIN = 1028 * MiB;
constexpr size_t WS_G = 1164 * MiB;
constexpr size_t WS_RSTD = 1232 * MiB;
constexpr size_t WS_END = 1233 * MiB;

constexpr int CW_BAR = 4096;
constexpr int CW_CNT = 200000;
constexpr int CW_DBG = 201000;
constexpr int CW_TS = 202000;

constexpr int LDS_BYTES = 163840;
constexpr int MISC_OFF = LDS_BYTES - 512;

__device__ __forceinline__ unsigned cvtpk(float lo, float hi) { f32x2 v = {lo, hi}; bf16x2_t b = __builtin_convertvector(v, bf16x2_t); return __builtin_bit_cast(unsigned, b); }
__device__ __forceinline__ float bflo(unsigned u) { return __uint_as_float(u << 16); }
__device__ __forceinline__ float bfhi(unsigned u) { return __uint_as_float(u & 0xffff0000u); }
__device__ __forceinline__ float bf2f(bf16 b) { return __uint_as_float((unsigned)b << 16); }
__device__ __forceinline__ float wave_sum(float v) {
#pragma unroll
    for (int o = 1; o < 64; o <<= 1) v += __shfl_xor(v, o);
    return v;
}
__device__ __forceinline__ float silu_f(float v) { return v / (1.0f + __expf(-v)); }
__device__ __forceinline__ int tid_opaque() { int t = threadIdx.x; asm volatile("" : "+v"(t)); return t; }
#define LDS_WAIT() asm volatile("s_waitcnt lgkmcnt(0)" ::: "memory")
#define VM_WAIT() asm volatile("s_waitcnt vmcnt(0)" ::: "memory")

#define XB_TMO      128
#define XB_XCNT(j)  (256  + 64 * (j))
#define XB_XSUB(j)  (1280 + 64 * (j))
#define XB_XGEN(j)  (2304 + 64 * (j))
#define XB_TOP      3328
#define XB_TOPGEN   3392
#define XCD_BAR_WORDS 3456
#define XB_SPIN_CAP (1u << 20)
__device__ __forceinline__ unsigned xb_ld(unsigned* p)              { return __hip_atomic_load(p, __ATOMIC_RELAXED, __HIP_MEMORY_SCOPE_AGENT); }
__device__ __forceinline__ unsigned xb_add(unsigned* p, unsigned v) { return __hip_atomic_fetch_add(p, v, __ATOMIC_RELAXED, __HIP_MEMORY_SCOPE_AGENT); }
__device__ __forceinline__ unsigned xb_xcc_id() { return (unsigned)__builtin_amdgcn_s_getreg((3 << 11) | 20) & 0xFu; }
#define XB_SPIN(cond, bar) do { unsigned _sp = 0; while (cond) { __builtin_amdgcn_s_sleep(1); \
    if ((++_sp & 255u) == 0u) { if (xb_ld(&(bar)[XB_TMO])) break; if (_sp > XB_SPIN_CAP) { atomicAdd(&(bar)[XB_TMO], 1u); break; } } } } while (0)
struct XcdBarrier { unsigned* bar; unsigned x; volatile LAS unsigned* st; };
__device__ __forceinline__ XcdBarrier xcd_barrier_post(unsigned* bar, volatile LAS unsigned* st) {
    XcdBarrier b; b.bar = bar; b.x = xb_xcc_id(); b.st = st;
    if (threadIdx.x == 0) (void)xb_add(&bar[XB_XCNT(b.x)], 1u);
    return b;
}
__device__ __forceinline__ void xcd_barrier_complete(unsigned* bar, unsigned x, unsigned& nloc, unsigned& nx) {
    const unsigned G = gridDim.x * gridDim.y * gridDim.z;
    unsigned sum, cnt, mine, sp = 0u;
    for (;;) {
        sum = 0u; cnt = 0u; mine = 0u;
#pragma unroll
        for (unsigned j = 0; j < 16; ++j) { const unsigned c = xb_ld(&bar[XB_XCNT(j)]); sum += c; cnt += (c > 0u) ? 1u : 0u; mine = (j == x) ? c : mine; }
        if (sum == G) break;
        __builtin_amdgcn_s_sleep(1);
        if ((++sp & 255u) == 0u) { if (xb_ld(&bar[XB_TMO])) break; if (sp > XB_SPIN_CAP) { atomicAdd(&bar[XB_TMO], 1u); break; } }
    }
    nloc = mine > 0u ? mine : 1u; nx = cnt > 0u ? cnt : 1u;
}
__device__ __forceinline__ void xcd_barrier(const XcdBarrier& b) {
    asm volatile("s_waitcnt vmcnt(0)" ::: "memory");
    __syncthreads();
    if (threadIdx.x == 0) {
        unsigned* bar = b.bar;
        __builtin_amdgcn_s_waitcnt(0);
        unsigned nloc = b.st[0], nx = b.st[1];
        if (nloc == 0u) { xcd_barrier_complete(bar, b.x, nloc, nx); b.st[0] = nloc; b.st[1] = nx; }
        const unsigned old = xb_add(&bar[XB_XSUB(b.x)], 1u);
        const unsigned gen = old / nloc;
        if (old + 1u == (gen + 1u) * nloc) {
            __builtin_amdgcn_fence(__ATOMIC_RELEASE, "agent");
            asm volatile("s_waitcnt vmcnt(0)" ::: "memory");
            const unsigned og = xb_add(&bar[XB_TOP], 1u);
            const unsigned tg = og / nx;
            if (og + 1u == (tg + 1u) * nx) xb_add(&bar[XB_TOPGEN], 1u);
            else XB_SPIN(xb_ld(&bar[XB_TOPGEN]) == tg, bar);
            __builtin_amdgcn_fence(__ATOMIC_ACQUIRE, "agent");
            xb_add(&bar[XB_XGEN(b.x)], 1u);
            asm volatile("s_waitcnt vmcnt(0)" ::: "memory");
        } else {
            XB_SPIN(xb_ld(&bar[XB_XGEN(b.x)]) == gen, bar);
            __builtin_amdgcn_fence(__ATOMIC_ACQUIRE, "agent");
            asm volatile("s_waitcnt vmcnt(0)" ::: "memory");
        }
    }
    __syncthreads();
}

enum { K_P0 = 0, K_RMIX, K_QKV, K_ROPE, K_ATT, K_OPROJ, K_M1, K_M2, K_M3, K_RPOOL, K_POOLG, K_INPROJ, K_CONV, K_SCAN, K_YPH, K_GFIX, K_OUTPROJ, K_FINAL, K_DBG };
struct Args { const float* in[N_IN]; float* out; unsigned char* ws; int ph_lo, ph_hi; int flags; int bar_region; };

struct Ctx {
    LAS unsigned char* lds; int tid, lane, wave, vcu, G;
};

__device__ __forceinline__ const float* mod_row(const Args& a, int layer, int r) {
    return r < TL ? (const float*)(a.ws + WS_MODL) + (size_t)(layer * 4 + r / SEQ) * 6144 : (const float*)(a.ws + WS_MODC) + (size_t)layer * 6144;
}
__device__ __forceinline__ const float* resid_row(const Args& a, int layer, int r) {
    if (layer == 0) return r < TL ? a.in[I_X] + (size_t)r * D : a.in[I_CTX] + (size_t)(r - TL) * D;
    return (const float*)(a.ws + WS_X) + (size_t)r * D;
}

__device__ __forceinline__ void load_row_combined(const Args& a, int layer, int r, int lane, f32x4 (&v)[4]) {
    const f32x4* xr = (const f32x4*)resid_row(a, layer, r) + lane;
#pragma unroll
    for (int j = 0; j < 4; ++j) v[j] = xr[64 * j];
    if (layer > 0 && !(a.flags & 1)) {
        const f32x4* gf = (const f32x4*)(mod_row(a, layer - 1, r) + 5 * D) + lane;
        const u32x2* y0 = (const u32x2*)((const bf16*)(a.ws + WS_Y2) + (size_t)(2 * r) * D) + lane;
        const u32x2* y1 = (const u32x2*)((const bf16*)(a.ws + WS_Y2) + (size_t)(2 * r + 1) * D) + lane;
#pragma unroll
        for (int j = 0; j < 4; ++j) {
            const u32x2 p = y0[64 * j], q = y1[64 * j]; const f32x4 g = gf[64 * j];
            v[j].x += g.x * (bflo(p.x) + bflo(q.x)); v[j].y += g.y * (bfhi(p.x) + bfhi(q.x));
            v[j].z += g.z * (bflo(p.y) + bflo(q.y)); v[j].w += g.w * (bfhi(p.y) + bfhi(q.y));
        }
    }
}
__device__ __forceinline__ float row_rstd(const f32x4 (&v)[4]) {
    float s = 0.f;
#pragma unroll
    for (int j = 0; j < 4; ++j) s += (v[j].x * v[j].x + v[j].y * v[j].y) + (v[j].z * v[j].z + v[j].w * v[j].w);
    return rsqrtf(wave_sum(s) * (1.0f / D) + EPS);
}
__device__ __forceinline__ void norm_mod(const f32x4 (&v)[4], float rstd, const float* g, const float* shift, const float* scale, int lane, f32x4 (&h)[4]) {
#pragma unroll
    for (int j = 0; j < 4; ++j) {
        const f32x4 gg = ((const f32x4*)g)[lane + 64 * j], sh = ((const f32x4*)shift)[lane + 64 * j], sc = ((const f32x4*)scale)[lane + 64 * j];
        h[j] = (v[j] * rstd) * gg * (sc + 1.0f) + sh;
    }
}

__device__ __forceinline__ void tr_item(const float* W, int N, int k0, int n0, bf16* WT, size_t drow0, int dK, LAS float* scr, int lane) {
#pragma unroll 8
    for (int i = 0; i < 32; ++i) { const int kk = 2 * i + (lane >> 5); scr[kk * 33 + (lane & 31)] = W[(size_t)(k0 + kk) * N + n0 + (lane & 31)]; }
    LDS_WAIT(); asm volatile("" ::: "memory");
    const int c = lane & 7;
#pragma unroll
    for (int j = 0; j < 4; ++j) { const int n = (lane >> 3) + 8 * j; const LAS float* s = scr + (8 * c) * 33 + n;
        u32x4 o; o.x = cvtpk(s[0 * 33], s[1 * 33]); o.y = cvtpk(s[2 * 33], s[3 * 33]); o.z = cvtpk(s[4 * 33], s[5 * 33]); o.w = cvtpk(s[6 * 33], s[7 * 33]);
        *(u32x4*)(WT + (drow0 + n) * dK + k0 + 8 * c) = o; }
    LDS_WAIT(); asm volatile("" ::: "memory");
}
__device__ __forceinline__ void p0_prologue(const Args& a, const Ctx& c) {
    LAS float* scr = (LAS float*)(c.lds + c.wave * 16384);
    const int gw = c.vcu * NWAVES + c.wave, NGW = c.G * NWAVES;
    constexpr int C0 = 2 * 768, C1 = C0 + 2 * 512, C2_ = C1 + 4 * 32, C3 = C2_ + 2592, C4 = C3 + 1024, C5 = C4 + 128 * 512, C6 = C5 + 128 * 256;
    for (int it = gw; it < C6; it += NGW) {
        int r = it;
        if (r < C0) { const int m = r / 768, q = r % 768, kb = q / 48, nb = q % 48;
            tr_item(a.in[I_WQKV] + (size_t)m * 1024 * 1536, 1536, kb * 64, nb * 32, (bf16*)(a.ws + WS_WQKV) + (size_t)m * 1536 * 1024, nb * 32, 1024, scr, c.lane); continue; }
        r -= C0;
        if (r < 2 * 512) { const int m = r / 512, q = r % 512, kb = q / 32, nb = q % 32;
            tr_item(a.in[I_WO] + (size_t)m * 1024 * 1024, 1024, kb * 64, nb * 32, (bf16*)(a.ws + WS_WO) + (size_t)m * 1024 * 1024, nb * 32, 1024, scr, c.lane); continue; }
        r -= 2 * 512;
        if (r < 4 * 32) { const int m = r / 32, q = r % 32, kb = q / 8, nb = q % 8;
            tr_item(a.in[I_POOLW] + (size_t)m * 256 * 256, 256, kb * 64, nb * 32, (bf16*)(a.ws + WS_WPOOL) + (size_t)m * 256 * 256, nb * 32, 256, scr, c.lane); continue; }
        r -= 4 * 32;
        if (r < 2592) { const int kb = r / 162, nb = r % 162;
            tr_item(a.in[I_WIN], 5184, kb * 64, nb * 32, (bf16*)(a.ws + WS_WIN), nb * 32, 1024, scr, c.lane); continue; }
        r -= 2592;
        if (r < 1024) { const int kb = r / 32, nb = r % 32;
            tr_item(a.in[I_WOUT], 1024, kb * 64, nb * 32, (bf16*)(a.ws + WS_WOUT), nb * 32, 2048, scr, c.lane); continue; }
        r -= 1024;
        if (r < 128 * 512) { const int m = r / 512, q = r % 512, kb = q / 32, nb = q % 32; const int n0 = nb * 32;
            const int j = n0 & 511, drow = 256 * (j >> 7) + (j & 127) + ((n0 >= 512) ? 128 : 0);
            tr_item(a.in[I_WGU] + (size_t)m * 1024 * 1024, 1024, kb * 64, n0, (bf16*)(a.ws + WS_WGU) + (size_t)m * 1024 * 1024, drow, 1024, scr, c.lane); continue; }
        r -= 128 * 512;
        { const int m = r / 256, q = r % 256, kb = q / 32, nb = q % 32;
            tr_item(a.in[I_WDN] + (size_t)m * 512 * 1024, 1024, kb * 64, nb * 32, (bf16*)(a.ws + WS_WDN) + (size_t)m * 1024 * 512, nb * 32, 512, scr, c.lane); }
    }
    __syncthreads();
    LAS float* sv = (LAS float*)c.lds;
    LAS float* part = (LAS float*)(c.lds + 20480);
    for (int u = c.tid; u < 5 * 1024; u += NTHREADS) { const int v = u >> 10, k = u & 1023; const float x = v < 4 ? a.in[I_C][v * 1024 + k] : a.in[I_CCTX][k]; sv[u] = x / (1.0f + expf(-x)); }
    __syncthreads();
    for (int item = blockIdx.x; item < 4 * 96; item += c.G) {
        const int li = item / 96, c0 = (item % 96) * 64, cq = c.tid & 15, ks = c.tid >> 4;
        f32x4 acc[5];
#pragma unroll
        for (int v = 0; v < 5; ++v) acc[v] = (f32x4){0.f, 0.f, 0.f, 0.f};
        const float* w = a.in[I_WADA] + ((size_t)li * 1024 + ks * 32) * 6144 + c0 + 4 * cq;
#pragma unroll 4
        for (int k = 0; k < 32; ++k) { const f32x4 wv = *(const f32x4*)(w + (size_t)k * 6144);
#pragma unroll
            for (int v = 0; v < 5; ++v) acc[v] += wv * sv[v * 1024 + ks * 32 + k]; }
#pragma unroll
        for (int v = 0; v < 5; ++v) *(LAS f32x4*)(part + (ks * 16 + cq) * 20 + v * 4) = acc[v];
        __syncthreads();
        if (c.tid < 320) { const int v = c.tid >> 6, col = c.tid & 63, q = col >> 2, e = col & 3; float s = 0.f;
            for (int k2 = 0; k2 < 32; ++k2) s += part[(k2 * 16 + q) * 20 + v * 4 + e];
            s += a.in[I_BADA][li * 6144 + c0 + col];
            if (v < 4) ((float*)(a.ws + WS_MODL))[(size_t)(li * 4 + v) * 6144 + c0 + col] = s; else ((float*)(a.ws + WS_MODC))[(size_t)li * 6144 + c0 + col] = s; }
        __syncthreads();
    }
    if (blockIdx.x == (unsigned)(c.G - 1)) for (int u = c.tid; u < 1024; u += NTHREADS) { const int pos = u >> 4, f = u & 15;
        const float inv = (float)pow(10000.0, -(double)f / 16.0); const double ang = (double)((float)pos * inv);
        ((f32x2*)(a.ws + WS_ROPE))[u] = (f32x2){(float)cos(ang), (float)sin(ang)}; }
    for (int u = blockIdx.x * NTHREADS + c.tid; u < 4 * 64 * 1024; u += c.G * NTHREADS) { const int li = u >> 16, n = (u >> 10) & 63, k = u & 1023;
        float w = 0.f; if (n < 4) w = a.in[I_WRG][((size_t)li * 1024 + k) * 4 + n]; else if (n < 36) w = a.in[I_WRE][((size_t)li * 1024 + k) * 32 + (n - 4)];
        const unsigned hi = cvtpk(w, 0.f) & 0xffffu; const float rem = w - bflo(hi); const unsigned lo = cvtpk(rem, 0.f) & 0xffffu;
        bf16* wr = (bf16*)(a.ws + WS_WR) + (size_t)li * 2 * 65536; wr[n * 1024 + k] = (bf16)hi; wr[65536 + n * 1024 + k] = (bf16)lo; }
}

__device__ __forceinline__ void ph_rmix(const Args& a, const Ctx& c, int layer) {
    const int gw = c.vcu * NWAVES + c.wave, NGW = c.G * NWAVES;
    const float* g = a.in[I_NMIX] + layer * D;
    for (int r = gw; r < TT; r += NGW) {
        f32x4 v[4], h[4]; load_row_combined(a, layer, r, c.lane, v);
        if (layer > 0) { f32x4* xo = (f32x4*)((float*)(a.ws + WS_X) + (size_t)r * D) + c.lane;
#pragma unroll
            for (int j = 0; j < 4; ++j) xo[64 * j] = v[j]; }
        const float rstd = row_rstd(v); const float* m = mod_row(a, layer, r);
        norm_mod(v, rstd, g, m, m + D, c.lane, h);
        u32x2* ho = (u32x2*)((bf16*)(a.ws + WS_HB) + (size_t)r * D) + c.lane;
#pragma unroll
        for (int j = 0; j < 4; ++j) ho[64 * j] = (u32x2){cvtpk(h[j].x, h[j].y), cvtpk(h[j].z, h[j].w)};
    }
}

__device__ __forceinline__ void ph_final(const Args& a, const Ctx& c, int layer) {
    const int gw = c.vcu * NWAVES + c.wave, NGW = c.G * NWAVES;
    float dscale = 1.f, dmark = 0.f;
#if DEBUG_CHECKS
    { unsigned* dbg = (unsigned*)(a.ws + WS_CTL) + CW_DBG; int code = 0; float mag = 0.f;
      for (int id = 1; id < 32; ++id) { const float e = __uint_as_float(__hip_atomic_load(dbg + id, __ATOMIC_RELAXED, __HIP_MEMORY_SCOPE_AGENT)); if (code == 0 && e > 0.03f) { code = id; mag = e; } }
      dscale = 1.f + (float)code; dmark = code ? 100.f * (1.f + fminf(fmaxf(log2f(mag / 0.03f), 0.f), 30.f)) : 0.f; }
#endif
    for (int r = gw; r < TL; r += NGW) {
        f32x4 v[4]; load_row_combined(a, layer, r, c.lane, v);
        const float rstd = row_rstd(v) * dscale;
        f32x4* o = (f32x4*)(a.out + (size_t)r * D) + c.lane;
#pragma unroll
        for (int j = 0; j < 4; ++j) { f32x4 ov = (v[j] * rstd) * ((const f32x4*)a.in[I_NFIN])[c.lane + 64 * j]; if (j == 0 && r == 0 && c.lane == 0 && dmark > 0.f) ov.x = dmark; o[64 * j] = ov; }
    }
}


namespace pg8 {
constexpr int BM = 256, BK = 64, HALF = 128, HTB = HALF * BK * 2, STAGE_BYTES = 8 * HTB;
__host__ __device__ __forceinline__ int lds_byte(int r, int c) { const int st = (r >> 4) * 2 + (c >> 5), rr = r & 15, cc = c & 31, ob = rr * 64 + cc * 2; return st * 1024 + (ob ^ (((ob >> 9) & 1) << 5)); }
__host__ __device__ __forceinline__ void stage_rc(int b, int& R, int& C) { const int st = b / 1024, sb = b % 1024, swz = sb ^ (((sb >> 9) & 1) << 5); R = (st >> 1) * 16 + swz / 64; C = (st & 1) * 32 + (swz % 64) / 2; }
__host__ __device__ __forceinline__ int perm32(int rho) { const int n = rho >> 4, i = rho & 15; return 8 * (i >> 2) + 4 * n + (i & 3); }
struct Unit { const char* A; const char* B; int pm, pn, x0, x1; };
__device__ __forceinline__ void tile_of(int L, int nM, int nN, int& pm, int& pn) {
    const int nwg = nM * nN; int wgid = L; { const int q = nwg / 8, r = nwg % 8, xcd = wgid % 8, off = wgid / 8; wgid = (xcd < r ? xcd * (q + 1) : r * (q + 1) + (xcd - r) * q) + off; }
    const int nig = 8 * nN, gid = wgid / nig, fm = gid * 8, gsz = (nM - fm) < 8 ? (nM - fm) : 8;
    pm = fm + ((wgid % nig) % gsz); pn = (wgid % nig) / gsz;
}
template <class Epi, class Sched, bool GATHER>
__device__ __forceinline__ void gemm_phase(LAS unsigned char* lds, const int K, const int lda, const Sched& S, const Epi& E) {
    const int tid = tid_opaque(), wid = __builtin_amdgcn_readfirstlane(tid >> 6), lane = tid & 63, wr = wid >> 2, wc = wid & 3, fr = lane & 15, fq = lane >> 4;
    const int nt = K / BK;
    unsigned voffA[2], voffB[2]; int RA[2], CA[2];
#pragma unroll
    for (int i = 0; i < 2; ++i) { int R, C; stage_rc(tid * 16 + i * 8192, R, C); const int Rb = Epi::PERM ? ((R & ~31) + perm32(R & 31)) : R;
        RA[i] = R; CA[i] = C; voffA[i] = (unsigned)(R * lda + C) * 2u; voffB[i] = (unsigned)(Rb * K + C) * 2u; }
    const size_t kstep = (size_t)(BK * 2);
    const size_t hstepA = (size_t)HALF * lda * 2, hstepB = (size_t)HALF * K * 2;
    const unsigned ldsw = (unsigned)wid * 1024u;
    const int aoff = lds_byte(wr * 64 + fr, fq * 8), boff = lds_byte(wc * 32 + fr, fq * 8);
#define PG8_SA(b, h) (((b) * 2 + (h)) * HTB)
#define PG8_SB(b, h) ((4 + (b) * 2 + (h)) * HTB)
#define PG8_GLDS(bufoff, gptr, i_) __builtin_amdgcn_global_load_lds((const unsigned*)(gptr), (LAS unsigned*)(lds + (bufoff) + ldsw + (i_) * 8192), 16, 0, 0)
#define PG8_STAGE_B(bufoff, gbase) do { _Pragma("unroll") for (int _i = 0; _i < 2; ++_i) PG8_GLDS(bufoff, (const char*)(gbase) + voffB[_i], _i); } while (0)
#define PG8_STAGE_A(bufoff, ab, kb, h, NX) do { _Pragma("unroll") for (int _i = 0; _i < 2; ++_i) { \
        if constexpr (GATHER) { const unsigned _vo = (NX) ? voN[h][_i] : voC[h][_i]; PG8_GLDS(bufoff, (ab) + (kb) + _vo, _i); } \
        else { PG8_GLDS(bufoff, (ab) + (kb) + (size_t)(h) * hstepA + voffA[_i], _i); } } } while (0)
#define PG8_LDA(dst, b, h) do { _Pragma("unroll") for (int m = 0; m < 4; ++m) _Pragma("unroll") for (int k = 0; k < 2; ++k) dst[m][k] = *(const LAS bf16x8*)(lds + PG8_SA(b, h) + aoff + m * 2048 + k * 1024); } while (0)
#define PG8_LDB(dst, b, h) do { _Pragma("unroll") for (int n = 0; n < 2; ++n) _Pragma("unroll") for (int k = 0; k < 2; ++k) dst[n][k] = *(const LAS bf16x8*)(lds + PG8_SB(b, h) + boff + n * 2048 + k * 1024); } while (0)
#define PG8_MMA(ai, bj, At, Bt) do { __builtin_amdgcn_s_setprio(1); _Pragma("unroll") for (int m = 0; m < 4; ++m) _Pragma("unroll") for (int n = 0; n < 2; ++n) _Pragma("unroll") for (int k = 0; k < 2; ++k) \
        acc[ai][bj][m][n] = __builtin_amdgcn_mfma_f32_16x16x32_bf16(Bt[n][k], At[m][k], acc[ai][bj][m][n], 0, 0, 0); __builtin_amdgcn_s_setprio(0); } while (0)
#define PG8_WAIT_V(n) asm volatile("s_waitcnt vmcnt(" #n ")" ::: "memory")
#define PG8_WAIT_L(n) asm volatile("s_waitcnt lgkmcnt(" #n ")" ::: "memory")
#define PG8_BAR __builtin_amdgcn_s_barrier()
#define PG8_SCHED __builtin_amdgcn_sched_barrier(0)
    Unit cur, nxt; int ui = 0;
    if (!S.next(0, cur)) return;
    unsigned voC[2][2], voN[2][2];
    if constexpr (GATHER) {
#pragma unroll
        for (int h = 0; h < 2; ++h)
#pragma unroll
            for (int i = 0; i < 2; ++i) { voC[h][i] = (unsigned)(S.gather(cur, h * HALF + RA[i]) * lda + CA[i]) * 2u; voN[h][i] = voC[h][i]; }
    } else { voC[0][0] = voN[0][0] = 0u; }
    f32x4 acc[2][2][4][2];
#pragma unroll
    for (int a = 0; a < 2; ++a)
#pragma unroll
        for (int b = 0; b < 2; ++b)
#pragma unroll
            for (int m = 0; m < 4; ++m)
#pragma unroll
                for (int n = 0; n < 2; ++n) acc[a][b][m][n] = (f32x4){0.f, 0.f, 0.f, 0.f};
    bf16x8 At[4][2], B0[2][2], B1[2][2];
    const char* cA = cur.A; const char* cB = cur.B;
    PG8_STAGE_B(PG8_SB(0, 0), cB); PG8_STAGE_B(PG8_SB(0, 1), cB + hstepB); PG8_STAGE_A(PG8_SA(0, 0), cA, (size_t)0, 0, false); PG8_STAGE_A(PG8_SA(0, 1), cA, (size_t)0, 1, false);
    if (wr == 1) PG8_BAR;
    PG8_WAIT_V(2); PG8_BAR;
    PG8_STAGE_B(PG8_SB(1, 0), cB + kstep); PG8_STAGE_A(PG8_SA(1, 0), cA, kstep, 0, false); PG8_STAGE_B(PG8_SB(1, 1), cB + hstepB + kstep);
    PG8_WAIT_V(6); PG8_BAR;
    for (;;) {
        const bool has_next = S.next(ui + 1, nxt);
        if constexpr (GATHER) { if (has_next) {
#pragma unroll
            for (int h = 0; h < 2; ++h)
#pragma unroll
                for (int i = 0; i < 2; ++i) voN[h][i] = (unsigned)(S.gather(nxt, h * HALF + RA[i]) * lda + CA[i]) * 2u; } }
        const char* nA = has_next ? nxt.A : cA; const char* nB = has_next ? nxt.B : cB;
        for (int t = 0; t < nt; t += 2) {
            const bool last = (t == nt - 2);
            const size_t k1 = (size_t)(t + 1) * kstep;
            const char* a2 = last ? nA : cA; const size_t k2 = last ? (size_t)0 : (size_t)(t + 2) * kstep; const size_t k3 = k2 + kstep;
            const char* b2 = last ? nB : cB + (size_t)(t + 2) * kstep; const char* b3 = b2 + kstep;
            const bool nx = GATHER ? (last && has_next) : false;
            PG8_LDB(B0, 0, 0); PG8_LDB(B1, 0, 1); PG8_SCHED; PG8_LDA(At, 0, 0); PG8_STAGE_A(PG8_SA(1, 1), cA, k1, 1, false);
            PG8_WAIT_V(8); PG8_WAIT_L(0); PG8_BAR; PG8_MMA(0, 0, At, B0); PG8_MMA(0, 1, At, B1); PG8_BAR; PG8_SCHED;
            PG8_LDA(At, 0, 1); PG8_STAGE_B(PG8_SB(0, 0), b2); PG8_STAGE_B(PG8_SB(0, 1), b2 + hstepB); PG8_STAGE_A(PG8_SA(0, 0), a2, k2, 0, nx);
            PG8_WAIT_V(8); PG8_WAIT_L(0); PG8_BAR; PG8_MMA(1, 0, At, B0); PG8_MMA(1, 1, At, B1); PG8_BAR; PG8_SCHED;
            PG8_LDB(B0, 1, 0); PG8_LDB(B1, 1, 1); PG8_SCHED; PG8_LDA(At, 1, 0); PG8_STAGE_A(PG8_SA(0, 1), a2, k2, 1, nx);
            PG8_WAIT_V(8); PG8_WAIT_L(0); PG8_BAR; PG8_MMA(0, 0, At, B0); PG8_MMA(0, 1, At, B1); PG8_BAR; PG8_SCHED;
            PG8_LDA(At, 1, 1); PG8_STAGE_B(PG8_SB(1, 0), b3); PG8_STAGE_B(PG8_SB(1, 1), b3 + hstepB); PG8_STAGE_A(PG8_SA(1, 0), a2, k3, 0, nx);
            PG8_WAIT_V(8); PG8_WAIT_L(0); PG8_BAR; PG8_MMA(1, 0, At, B0); PG8_MMA(1, 1, At, B1); PG8_BAR; PG8_SCHED;
        }
        if (wr == 0) PG8_BAR;
        E(acc, cur, wr, wc, fr, fq);
        if (!has_next) break;
#pragma unroll
        for (int a = 0; a < 2; ++a)
#pragma unroll
            for (int b = 0; b < 2; ++b)
#pragma unroll
                for (int m = 0; m < 4; ++m)
#pragma unroll
                    for (int n = 0; n < 2; ++n) acc[a][b][m][n] = (f32x4){0.f, 0.f, 0.f, 0.f};
        cur = nxt; cA = nA; cB = nB; ++ui;
        if constexpr (GATHER) {
#pragma unroll
            for (int h = 0; h < 2; ++h)
#pragma unroll
                for (int i = 0; i < 2; ++i) voC[h][i] = voN[h][i]; }
        if (wr == 1) PG8_BAR;
    }
    PG8_WAIT_V(0);
    PG8_BAR;
#undef PG8_SA
#undef PG8_SB
#undef PG8_GLDS
#undef PG8_STAGE_A
#undef PG8_STAGE_B
#undef PG8_LDA
#undef PG8_LDB
#undef PG8_MMA
#undef PG8_WAIT_V
#undef PG8_WAIT_L
#undef PG8_BAR
#undef PG8_SCHED
}
}
#include <hip/hip_bf16.h>
#include <cmath>
namespace attn_body {
using bf16=__hip_bfloat16;
using bf16x8=__attribute__((ext_vector_type(8)))short;
using s16x4=__attribute__((ext_vector_type(4)))short;
using f32x16=__attribute__((ext_vector_type(16)))float;
using u32x4=__attribute__((ext_vector_type(4)))unsigned;
constexpr int D=64,QP=1024,KVP=256;
constexpr int NW=8,QBLK=32,QB=QBLK*NW,KVBLK=64;
__device__ __forceinline__ int crow(int r,int hi){return (r&3)+8*(r>>2)+4*hi;}
#define SBAR() __builtin_amdgcn_sched_barrier(0)
constexpr int NSLOT=3, SLOTB=8192;
constexpr int LDS_K=0, LDS_V=NSLOT*SLOTB, LDS_WS=2*NSLOT*SLOTB, LDS_OST=LDS_WS+NW*64*4, LDS_BYTES=LDS_OST+NW*4096;
constexpr float C2=0.125f*1.4426950408889634f;
__device__ __forceinline__ void glds16s(const void*sbase,unsigned voff,unsigned lds_dst){unsigned keep;
  asm volatile("s_mov_b32 %0, m0\n\ts_mov_b32 m0, %3\n\ts_nop 4\n\tglobal_load_lds_dwordx4 %1, %2\n\ts_mov_b32 m0, %0":"=&s"(keep):"v"(voff),"s"(sbase),"s"(lds_dst):"memory");}
__device__ __forceinline__ float max3f(float a,float b,float c){float r;asm("v_max3_f32 %0, %1, %2, %3":"=v"(r):"v"(a),"v"(b),"v"(c));return r;}
__device__ __forceinline__ float max2f(float a,float b){float r;asm("v_max_f32_e32 %0, %1, %2":"=v"(r):"v"(a),"v"(b));return r;}
__device__ __forceinline__ float fadd_s(float a,float b){float r;asm("v_add_f32_e32 %0, %1, %2":"=v"(r):"v"(a),"v"(b));return r;}
__device__ __forceinline__ float fsub_s(float a,float b){float r;asm("v_sub_f32_e32 %0, %1, %2":"=v"(r):"v"(a),"v"(b));return r;}
typedef float f32x2_t __attribute__((ext_vector_type(2))); typedef __bf16 bf16x2_t __attribute__((ext_vector_type(2)));
__device__ __forceinline__ unsigned cvtpk_s(float lo,float hi){f32x2_t v={lo,hi};bf16x2_t b=__builtin_convertvector(v,bf16x2_t);return __builtin_bit_cast(unsigned,b);}
#define WAIT_BAR(N) asm volatile("s_waitcnt vmcnt(" #N ") lgkmcnt(0)\n\ts_barrier":::"memory")

__device__ __forceinline__ void qkt(f32x16&p0,f32x16&p1,const char*Kslot,const bf16x8*qr,const f32x16&negm,int r32,int hi){
  const char*kb=Kslot+hi*1024+r32*16;
  #pragma unroll
  for(int d0=0;d0<4;++d0){
    const bf16x8 b0=*reinterpret_cast<const bf16x8*>(kb+d0*2048);
    const bf16x8 b1=*reinterpret_cast<const bf16x8*>(kb+d0*2048+512);
    if(d0==0){p0=__builtin_amdgcn_mfma_f32_32x32x16_bf16(b0,qr[0],negm,0,0,0);p1=__builtin_amdgcn_mfma_f32_32x32x16_bf16(b1,qr[0],negm,0,0,0);}
    else{p0=__builtin_amdgcn_mfma_f32_32x32x16_bf16(b0,qr[d0],p0,0,0,0);p1=__builtin_amdgcn_mfma_f32_32x32x16_bf16(b1,qr[d0],p1,0,0,0);}}
}
typedef __attribute__((address_space(3))) const char* lds_cptr;
typedef short v4i16_t __attribute__((ext_vector_type(4)));
__device__ __forceinline__ void kload8(bf16x8*kf,lds_cptr kp){
  kf[0]=*(const __attribute__((address_space(3))) bf16x8*)(kp);      kf[1]=*(const __attribute__((address_space(3))) bf16x8*)(kp+512);
  kf[2]=*(const __attribute__((address_space(3))) bf16x8*)(kp+2048); kf[3]=*(const __attribute__((address_space(3))) bf16x8*)(kp+2560);
  kf[4]=*(const __attribute__((address_space(3))) bf16x8*)(kp+4096); kf[5]=*(const __attribute__((address_space(3))) bf16x8*)(kp+4608);
  kf[6]=*(const __attribute__((address_space(3))) bf16x8*)(kp+6144); kf[7]=*(const __attribute__((address_space(3))) bf16x8*)(kp+6656);
}
__device__ __forceinline__ void kload2(bf16x8*kf,lds_cptr kp,int j){ kf[2*j]=*(const __attribute__((address_space(3))) bf16x8*)(kp+j*2048); kf[2*j+1]=*(const __attribute__((address_space(3))) bf16x8*)(kp+j*2048+512); }
__device__ __forceinline__ s16x4 vtr(lds_cptr p){ return __builtin_bit_cast(s16x4,__builtin_amdgcn_ds_read_tr16_b64_v4i16((__attribute__((address_space(3))) v4i16_t*)p)); }
__device__ __forceinline__ float rowmax(const f32x16&p0,const f32x16&p1){
  float a=max3f(p0[0],p0[1],p1[0]),b=max3f(p0[2],p0[3],p1[1]);a=max3f(a,p1[2],p1[3]);
  #pragma unroll
  for(int r=4;r<16;r+=4){a=max3f(a,p0[r],p0[r+1]);b=max3f(b,p0[r+2],p0[r+3]);a=max3f(a,p1[r],p1[r+1]);b=max3f(b,p1[r+2],p1[r+3]);}
  const float m=max2f(a,b);
  auto rr=__builtin_amdgcn_permlane32_swap(__float_as_uint(m),__float_as_uint(m),false,false);
  return max2f(__uint_as_float(rr[0]),__uint_as_float(rr[1]));
}
__device__ __forceinline__ void pv(f32x16*o,int vb,bf16x8 pa0,bf16x8 pa1,bf16x8 pa2,bf16x8 pa3){
  #pragma unroll
  for(int d0=0;d0<2;++d0){s16x4 lo[4],hi[4];
    #pragma unroll
    for(int ks=0;ks<4;++ks){
      asm volatile("ds_read_b64_tr_b16 %0,%1 offset:%c2":"=&v"(lo[ks]):"v"(vb),"i"(d0*4096+ks*1024):"memory");
      asm volatile("ds_read_b64_tr_b16 %0,%1 offset:%c2":"=&v"(hi[ks]):"v"(vb),"i"(d0*4096+ks*1024+512):"memory");}
    asm volatile("s_waitcnt lgkmcnt(0)":::"memory");SBAR();
    #define PK(k) (bf16x8){lo[k][0],lo[k][1],lo[k][2],lo[k][3],hi[k][0],hi[k][1],hi[k][2],hi[k][3]}
    o[d0]=__builtin_amdgcn_mfma_f32_32x32x16_bf16(pa0,PK(0),o[d0],0,0,0);
    o[d0]=__builtin_amdgcn_mfma_f32_32x32x16_bf16(pa1,PK(1),o[d0],0,0,0);
    o[d0]=__builtin_amdgcn_mfma_f32_32x32x16_bf16(pa2,PK(2),o[d0],0,0,0);
    o[d0]=__builtin_amdgcn_mfma_f32_32x32x16_bf16(pa3,PK(3),o[d0],0,0,0);
    #undef PK
  }
}

#ifndef ATTN_STORE16
#define ATTN_STORE16(p,v) (*(u32x4*)(p)=(v))
#endif
template<int THRL> __device__ __forceinline__ void attn_unit(long qrow0,int h,long kvrow0,int NT,const bf16*Q,const bf16*__restrict__ K,const bf16*__restrict__ V,bf16*O,char*shm){
  const int tid=tid_opaque(),lane=tid&63,r32=lane&31,hi=lane>>5; const int wid=__builtin_amdgcn_readfirstlane(tid>>6);
  const bf16*Qw=Q+(qrow0+wid*QBLK)*QP+h*D;
  const bf16*Kh=K+kvrow0*KVP+(h>>2)*D,*Vh=V+kvrow0*KVP+(h>>2)*D;
  const unsigned lds0=(unsigned)(uintptr_t)shm;
  float*wsf=(float*)(shm+LDS_WS)+wid*64;
  const unsigned kvo=(unsigned)(lane*KVP+wid*8)*2u;
  const unsigned vvo=(unsigned)((16*(wid&3)+(lane>>2))*KVP+(wid>>2)*32+(lane&3)*8)*2u;
  const unsigned kdst=lds0+LDS_K+wid*1024, vdst=lds0+LDS_V+wid*1024;
  #define DMA_K(t,slot) glds16s(Kh+(long)(t)*KVBLK*KVP,kvo,(unsigned)__builtin_amdgcn_readfirstlane(kdst+(slot)))
  #define DMA_V(t,slot) glds16s(Vh+(long)(t)*KVBLK*KVP,vvo,(unsigned)__builtin_amdgcn_readfirstlane(vdst+(slot)))
  const int vb0=(int)(lds0+LDS_V)+((lane>>4)&1)*32+(lane&3)*8+(4*hi+((lane&15)>>2))*64;
  const char*Kbase=shm+LDS_K; bf16x8 kf[8];
  const lds_cptr shm3=(lds_cptr)shm; const lds_cptr kp0=shm3+LDS_K+hi*1024+r32*16; const lds_cptr vp0=shm3+LDS_V+((lane>>4)&1)*32+(lane&3)*8+(4*hi+((lane&15)>>2))*64;
  DMA_K(0,0);DMA_V(0,0);DMA_K(1,SLOTB);
  bf16x8 qr[4];
  #pragma unroll
  for(int d0=0;d0<4;++d0)qr[d0]=*reinterpret_cast<const bf16x8*>(&Qw[(long)r32*QP+d0*16+hi*8]);
  float mhat=0.f,l_reg=0.f;f32x16 o[2];o[0]=f32x16{};o[1]=f32x16{};f32x16 negm=f32x16{};asm volatile("":"+v"(negm));
  #define CMASK(P0,P1,t) do{}while(0)
  bool resc=false;
  #define START(P0,P1) do{ const float rm=rowmax(P0,P1); resc=false; \
    { const float dl=rm; mhat=fadd_s(mhat,dl); \
      _Pragma("unroll") for(int r=0;r<16;++r){P0[r]=fsub_s(P0[r],dl);P1[r]=fsub_s(P1[r],dl);} \
      _Pragma("unroll") for(int r=0;r<16;++r)negm[r]=-mhat; asm volatile("":"+v"(negm)); } \
    _Pragma("unroll") for(int r=0;r<16;++r)P0[r]=__builtin_amdgcn_exp2f(P0[r]); }while(0)
  #define RESC() do{ if(resc){ asm volatile("s_waitcnt lgkmcnt(0)":::"memory"); \
      _Pragma("unroll") for(int d_=0;d_<2;++d_) _Pragma("unroll") for(int r=0;r<16;++r)o[d_][r]*=wsf[crow(r,hi)]; } }while(0)
  f32x16 pA0,pA1,pB0,pB1;
  int sl_prev=0,sl_cur=0,sl_next=SLOTB;
  #define ROT() do{sl_prev=sl_cur;sl_cur=sl_next;sl_next=(sl_next==(NSLOT-1)*SLOTB)?0:sl_next+SLOTB;}while(0)
  DMA_K(2,2*SLOTB);
  WAIT_BAR(3);
  qkt(pA0,pA1,Kbase,qr,negm,r32,hi);asm volatile("s_nop 15\n\ts_nop 7":"+v"(pA0),"+v"(pA1));CMASK(pA0,pA1,0);
  START(pA0,pA1);
  _Pragma("unroll") for(int r=0;r<16;++r)pA1[r]=__builtin_amdgcn_exp2f(pA1[r]);
  WAIT_BAR(0);
  DMA_K(3,0);DMA_V(1,SLOTB);
  ROT();
  kload8(kf,kp0+sl_cur);
  WAIT_BAR(2);
  s16x4 vlo[8],vhi[8]; u32x4 pw0,pw1,pw2,pw3;
  #define PKW(P,B) cvtpk_s(P[B],P[B+1])
  #define PAF(k) __builtin_bit_cast(bf16x8,pw##k)
  #define VFR(i) (bf16x8){vlo[i][0],vlo[i][1],vlo[i][2],vlo[i][3],vhi[i][0],vhi[i][1],vhi[i][2],vhi[i][3]}
  #define PIN(x) asm volatile("":"+v"(x))
  #define MX3(a,b,c) __builtin_fmaxf(__builtin_fmaxf((a),(b)),(c))
  #define GAPA(MF,A0,A1,A2,A3,W0,W1,PW) do{ MF; sacc+=A0; sacc+=A1; sacc+=A2; sacc+=A3; PIN(sacc); W0; W1; PIN(PW); SBAR(); }while(0)
  #define EX(v) __builtin_amdgcn_exp2f(v)
  #define GAPB(MF,X,B) do{ MF; X[B]=EX(X[B]); X[B+1]=EX(X[B+1]); X[B+2]=EX(X[B+2]); X[B+3]=EX(X[B+3]); PIN(X); SBAR(); }while(0)
  #define VRD(i) do{ vlo[i]=vtr(vp_+(((i)>>2)*4096+((i)&3)*1024)); vhi[i]=vtr(vp_+(((i)>>2)*4096+((i)&3)*1024+512)); }while(0)
  #define KRD(G,j) do{ if(G){ kload2(kf,kp0+sl_next,j); SBAR(); } }while(0)
  #define STEP(C0,C1,P0,P1,t,GK,GV,GL) do{ SBAR(); \
    const lds_cptr vp_=vp0+sl_prev; \
    VRD(0); SBAR(); float sacc=(P0[0]+P0[1]); \
    GAPA(C0=__builtin_amdgcn_mfma_f32_32x32x16_bf16(kf[0],qr[0],negm,0,0,0), P0[2],P0[3],P0[4],P0[5],     pw0[0]=PKW(P0,0), pw0[1]=PKW(P0,2), pw0); \
    VRD(4); SBAR(); GAPA(C1=__builtin_amdgcn_mfma_f32_32x32x16_bf16(kf[1],qr[0],negm,0,0,0), P0[6],P0[7],P0[8],P0[9],     pw0[2]=PKW(P0,4), pw0[3]=PKW(P0,6), pw0); \
    VRD(1); SBAR(); GAPA(C0=__builtin_amdgcn_mfma_f32_32x32x16_bf16(kf[2],qr[1],C0,0,0,0),   P0[10],P0[11],P0[12],P0[13], pw1[0]=PKW(P0,8), pw1[1]=PKW(P0,10), pw1); \
    VRD(5); SBAR(); GAPA(C1=__builtin_amdgcn_mfma_f32_32x32x16_bf16(kf[3],qr[1],C1,0,0,0),   P0[14],P0[15],P1[0],P1[1],   pw1[2]=PKW(P0,12),pw1[3]=PKW(P0,14), pw1); \
    VRD(2); SBAR(); GAPA(C0=__builtin_amdgcn_mfma_f32_32x32x16_bf16(kf[4],qr[2],C0,0,0,0),   P1[2],P1[3],P1[4],P1[5],     pw2[0]=PKW(P1,0), pw2[1]=PKW(P1,2), pw2); \
    VRD(6); SBAR(); GAPA(C1=__builtin_amdgcn_mfma_f32_32x32x16_bf16(kf[5],qr[2],C1,0,0,0),   P1[6],P1[7],P1[8],P1[9],     pw2[2]=PKW(P1,4), pw2[3]=PKW(P1,6), pw2); \
    VRD(3); SBAR(); GAPA(C0=__builtin_amdgcn_mfma_f32_32x32x16_bf16(kf[6],qr[3],C0,0,0,0),   P1[10],P1[11],P1[12],P1[13], pw3[0]=PKW(P1,8), pw3[1]=PKW(P1,10), pw3); \
    VRD(7); SBAR(); GAPA(C1=__builtin_amdgcn_mfma_f32_32x32x16_bf16(kf[7],qr[3],C1,0,0,0),   P1[14],P1[15],0.f,0.f,       pw3[2]=PKW(P1,12),pw3[3]=PKW(P1,14), pw3); \
    l_reg+=sacc; \
    if(GK){DMA_K((t)+3,sl_cur);} if(GV){DMA_V((t)+1,sl_next);} \
    CMASK(C0,C1,t); \
    { float a=MX3(C0[0],C0[1],C1[0]),b=MX3(C0[2],C0[3],C1[1]); a=MX3(a,C1[2],C1[3]); \
      _Pragma("unroll") for(int r=4;r<16;r+=4){a=MX3(a,C0[r],C0[r+1]);b=MX3(b,C0[r+2],C0[r+3]);a=MX3(a,C1[r],C1[r+1]);b=MX3(b,C1[r+2],C1[r+3]);} \
      float rm=__builtin_fmaxf(a,b); { auto rr=__builtin_amdgcn_permlane32_swap(__float_as_uint(rm),__float_as_uint(rm),false,false); rm=__builtin_fmaxf(__uint_as_float(rr[0]),__uint_as_float(rr[1])); } \
      resc=false; \
      if(__builtin_expect(__any(rm>(float)THRL),0)){ const float dl=__builtin_fmaxf(rm,0.f); mhat+=dl; \
        _Pragma("unroll") for(int r=0;r<16;++r){C0[r]-=dl;C1[r]-=dl;} \
        _Pragma("unroll") for(int r=0;r<16;++r)negm[r]=-mhat; asm volatile("":"+v"(negm)); \
        const float f=__builtin_amdgcn_exp2f(-dl); l_reg*=f; if(hi==0)wsf[r32]=f; resc=true; } } \
    SBAR(); \
    GAPB(o[0]=__builtin_amdgcn_mfma_f32_32x32x16_bf16(PAF(0),VFR(0),o[0],0,0,0), C0,0); \
    GAPB(o[1]=__builtin_amdgcn_mfma_f32_32x32x16_bf16(PAF(0),VFR(4),o[1],0,0,0), C0,4); \
    KRD(GL,0); GAPB(o[0]=__builtin_amdgcn_mfma_f32_32x32x16_bf16(PAF(1),VFR(1),o[0],0,0,0), C0,8); \
    KRD(GL,1); GAPB(o[1]=__builtin_amdgcn_mfma_f32_32x32x16_bf16(PAF(1),VFR(5),o[1],0,0,0), C0,12); \
    KRD(GL,2); GAPB(o[0]=__builtin_amdgcn_mfma_f32_32x32x16_bf16(PAF(2),VFR(2),o[0],0,0,0), C1,0); \
    KRD(GL,3); GAPB(o[1]=__builtin_amdgcn_mfma_f32_32x32x16_bf16(PAF(2),VFR(6),o[1],0,0,0), C1,4); \
    GAPB(o[0]=__builtin_amdgcn_mfma_f32_32x32x16_bf16(PAF(3),VFR(3),o[0],0,0,0), C1,8); \
    GAPB(o[1]=__builtin_amdgcn_mfma_f32_32x32x16_bf16(PAF(3),VFR(7),o[1],0,0,0), C1,12); \
    }while(0)
  int t=1;
  for(;t+5<NT;t+=2){
    STEP(pB0,pB1,pA0,pA1,t,true,true,true);     WAIT_BAR(2); RESC(); ROT();
    STEP(pA0,pA1,pB0,pB1,t+1,true,true,true);   WAIT_BAR(2); RESC(); ROT();
  }
  #define ENDW(tt) do{ if((tt)+3<NT){WAIT_BAR(2);} else if((tt)+2<NT){WAIT_BAR(1);} else {WAIT_BAR(0);} }while(0)
  for(;t+1<NT;t+=2){
    STEP(pB0,pB1,pA0,pA1,t,(t+3<NT),(t+1<NT),(t+1<NT));       ENDW(t);   RESC(); ROT();
    STEP(pA0,pA1,pB0,pB1,t+1,(t+4<NT),(t+2<NT),(t+2<NT));     ENDW(t+1); RESC(); ROT();
  }
  STEP(pB0,pB1,pA0,pA1,NT-1,false,false,false); RESC();
  { float sacc=pB0[0]+pB0[1]; _Pragma("unroll") for(int r=2;r<16;++r)sacc+=pB0[r]; _Pragma("unroll") for(int r=0;r<16;++r)sacc+=pB1[r]; l_reg+=sacc;
    pw0=(u32x4){PKW(pB0,0),PKW(pB0,2),PKW(pB0,4),PKW(pB0,6)};pw1=(u32x4){PKW(pB0,8),PKW(pB0,10),PKW(pB0,12),PKW(pB0,14)};pw2=(u32x4){PKW(pB1,0),PKW(pB1,2),PKW(pB1,4),PKW(pB1,6)};pw3=(u32x4){PKW(pB1,8),PKW(pB1,10),PKW(pB1,12),PKW(pB1,14)};
    SBAR(); pv(o,vb0+sl_cur,PAF(0),PAF(1),PAF(2),PAF(3)); }
  #undef PKW
  #undef PAF
  #undef VFR
  #undef PIN
  #undef MX3
  #undef GAPA
  #undef GAPB
  #undef EX
  #undef VRD
  #undef KRD
  #undef STEP
  #undef ENDW
  {auto rr=__builtin_amdgcn_permlane32_swap(__float_as_uint(l_reg),__float_as_uint(l_reg),false,false);l_reg=__uint_as_float(rr[0])+__uint_as_float(rr[1]);}
  if(hi==0)wsf[32+r32]=l_reg;asm volatile("s_waitcnt lgkmcnt(0)":::"memory");
  float rli[16];
  #pragma unroll
  for(int r=0;r<16;++r)rli[r]=__builtin_amdgcn_rcpf(wsf[32+crow(r,hi)]);
  bf16*Ow=O+(qrow0+wid*QBLK)*QP+h*D;
  { bf16*stg=(bf16*)(shm+LDS_OST)+wid*2048;
    #pragma unroll
    for(int r=0;r<16;++r){const int orow=crow(r,hi);
      #pragma unroll
      for(int d0=0;d0<2;++d0)stg[orow*64+d0*32+r32]=__float2bfloat16(o[d0][r]*rli[r]);}
    asm volatile("s_waitcnt lgkmcnt(0)":::"memory");
    #pragma unroll
    for(int i=0;i<4;++i){const int row=i*8+(lane>>3),ch=lane&7; const u32x4 v=*(const u32x4*)(stg+row*64+ch*8); ATTN_STORE16(Ow+(long)row*QP+ch*8,v);} }
  asm volatile("s_waitcnt lgkmcnt(0)\n\ts_barrier":::"memory");
  #undef DMA_K
  #undef DMA_V
  #undef CMASK
  #undef START
  #undef RESC
  #undef ROT
}
constexpr int ATTN_LDS_BYTES=LDS_BYTES;
#undef SBAR
#undef WAIT_BAR
}

typedef f32x4 AccT[2][2][4][2];
__device__ __forceinline__ long kv_row(int r) { return r < TL ? (long)(r / SEQ) * KVROWS + CTXL + (r % SEQ) : (long)((r - TL) / CTXL) * KVROWS + ((r - TL) % CTXL); }

struct SchedDense {
    const char* A; const char* B; size_t astep, bstep, acol; int nM, nN, G, c;
    __device__ __forceinline__ bool next(int i, pg8::Unit& u) const {
        const int L = i * G + c; if (L >= nM * nN) return false;
        pg8::tile_of(L, nM, nN, u.pm, u.pn); u.A = A + (size_t)u.pm * astep + (size_t)u.pn * acol; u.B = B + (size_t)u.pn * bstep; u.x0 = 0; u.x1 = 0; return true; }
    __device__ __forceinline__ int gather(const pg8::Unit&, int) const { return 0; }
};
struct SchedQKV {
    const char* A; const char* B; int ctxq, G, c;
    __device__ __forceinline__ bool next(int i, pg8::Unit& u) const {
        const int L = i * G + c, n1 = 64 * 6, n2 = ctxq ? 24 : 8; if (L >= n1 + n2) return false;
        if (L < n1) pg8::tile_of(L, 64, 6, u.pm, u.pn);
        else if (ctxq) { pg8::tile_of(L - n1, 4, 6, u.pm, u.pn); u.pm += 64; }
        else { u.pm = 64 + ((L - n1) >> 1); u.pn = 4 + ((L - n1) & 1); }
        u.A = A + (size_t)u.pm * (256 * 1024 * 2); u.B = B + (size_t)u.pn * (256 * 1024 * 2); u.x0 = 0; u.x1 = 0; return true; }
    __device__ __forceinline__ int gather(const pg8::Unit&, int) const { return 0; }
};
struct SchedMoe {
    const char* Abase; size_t astep; const char* Bbase; size_t bstep_e, bstep_n; const LAS int* tab; const int* list; int G, c;
    __device__ __forceinline__ int T(int i) const { return __builtin_amdgcn_readfirstlane(tab[i]); }
    __device__ __forceinline__ bool next(int i, pg8::Unit& u) const {
        const int ntiles = T(32), L = i * G + c; if (L >= ntiles * 4) return false;
        int gt, pn; pg8::tile_of(L, ntiles, 4, gt, pn);
        int e = 0;
        for (int q = 1; q < 32; ++q) e += (T(q) <= gt) ? 1 : 0;
        const int ti = gt - T(e); int valid = T(40 + e) - ti * 256; valid = valid > 256 ? 256 : valid;
        u.pm = gt; u.pn = pn; u.x0 = e * MOE_CAP + ti * 256; u.x1 = valid;
        u.A = Abase + (size_t)gt * astep; u.B = Bbase + (size_t)e * bstep_e + (size_t)pn * bstep_n; return true; }
    __device__ __forceinline__ int gather(const pg8::Unit& u, int lr) const { return lr < u.x1 ? (list[u.x0 + lr] >> 1) : 0; }
};

struct EpiQKV { static constexpr bool PERM = true; bf16* Q; bf16* Kb; bf16* Vb;
    __device__ __forceinline__ void operator()(const AccT& acc, const pg8::Unit& u, int wr, int wc, int fr, int fq) const {
        bf16* base; int pitch; long row0;
        if (u.pn < 4) { base = Q + u.pn * 256; pitch = 1024; row0 = (long)u.pm * 256; }
        else { base = (u.pn == 4) ? Kb : Vb; pitch = 256; row0 = kv_row(u.pm * 256); }
#pragma unroll
        for (int ai = 0; ai < 2; ++ai)
#pragma unroll
            for (int m = 0; m < 4; ++m) { bf16* rowp = base + (row0 + ai * 128 + wr * 64 + m * 16 + fr) * pitch + wc * 32 + 8 * fq;
#pragma unroll
                for (int bj = 0; bj < 2; ++bj) { const f32x4 v0 = acc[ai][bj][m][0], v1 = acc[ai][bj][m][1];
                    *(u32x4*)(rowp + bj * 128) = (u32x4){cvtpk(v0[0], v0[1]), cvtpk(v0[2], v0[3]), cvtpk(v1[0], v1[1]), cvtpk(v1[2], v1[3])}; } }
    }
};
struct EpiResid { static constexpr bool PERM = false; const Args* a; int layer; const float* pscale; const float* srcbase;
    __device__ __forceinline__ void operator()(const AccT& acc, const pg8::Unit& u, int wr, int wc, int fr, int fq) const {
        const int r0 = u.pm * 256;
        const float* src = srcbase ? srcbase + (size_t)r0 * D : resid_row(*a, layer, r0); const float* gate = mod_row(*a, layer, r0) + 2 * D; float* out = (float*)(a->ws + WS_X) + (size_t)r0 * D;
        const int col0 = u.pn * 256 + wc * 32 + 4 * fq;
#pragma unroll
        for (int bj = 0; bj < 2; ++bj)
#pragma unroll
            for (int n = 0; n < 2; ++n) { const int cc = col0 + bj * 128 + n * 16; f32x4 g = *(const f32x4*)(gate + cc); if (pscale) g = g * *(const f32x4*)(pscale + cc);
#pragma unroll
                for (int ai = 0; ai < 2; ++ai)
#pragma unroll
                    for (int m = 0; m < 4; ++m) { const size_t off = (size_t)(ai * 128 + wr * 64 + m * 16 + fr) * D + cc;
                        *(f32x4*)(out + off) = *(const f32x4*)(src + off) + g * acc[ai][bj][m][n]; } }
    }
};
struct EpiGateUp { static constexpr bool PERM = true; bf16* act;
    __device__ __forceinline__ void operator()(const AccT& acc, const pg8::Unit& u, int wr, int wc, int fr, int fq) const {
#pragma unroll
        for (int ai = 0; ai < 2; ++ai)
#pragma unroll
            for (int m = 0; m < 4; ++m) { bf16* p = act + ((size_t)u.pm * 256 + ai * 128 + wr * 64 + m * 16 + fr) * 512 + u.pn * 128 + wc * 32 + 8 * fq;
                const f32x4 g0 = acc[ai][0][m][0], g1 = acc[ai][0][m][1], u0 = acc[ai][1][m][0], u1 = acc[ai][1][m][1];
                *(u32x4*)p = (u32x4){cvtpk(silu_f(g0[0]) * u0[0], silu_f(g0[1]) * u0[1]), cvtpk(silu_f(g0[2]) * u0[2], silu_f(g0[3]) * u0[3]),
                                     cvtpk(silu_f(g1[0]) * u1[0], silu_f(g1[1]) * u1[1]), cvtpk(silu_f(g1[2]) * u1[2], silu_f(g1[3]) * u1[3])}; }
    }
};
struct EpiDown { static constexpr bool PERM = true; const int* list; const float* w2; bf16* y2;
    __device__ __forceinline__ void operator()(const AccT& acc, const pg8::Unit& u, int wr, int wc, int fr, int fq) const {
#pragma unroll
        for (int ai = 0; ai < 2; ++ai)
#pragma unroll
            for (int m = 0; m < 4; ++m) { const int lr = ai * 128 + wr * 64 + m * 16 + fr;
                if (lr < u.x1) { const int dest = list[u.x0 + lr]; const float w = w2[dest]; bf16* p = y2 + (size_t)dest * D + u.pn * 256 + wc * 32 + 8 * fq;
#pragma unroll
                    for (int bj = 0; bj < 2; ++bj) { const f32x4 v0 = acc[ai][bj][m][0] * w, v1 = acc[ai][bj][m][1] * w;
                        *(u32x4*)(p + bj * 128) = (u32x4){cvtpk(v0[0], v0[1]), cvtpk(v0[2], v0[3]), cvtpk(v1[0], v1[1]), cvtpk(v1[2], v1[3])}; } } }
    }
};

constexpr int TAB_OFF = 135168;

__device__ __forceinline__ void ph_rope(const Args& a, const Ctx& c, int layer) {
    const int j = layer == 0 ? 0 : 1; const bool ctxq = layer == 0;
    const float* qg = a.in[I_QG] + j * 64; const float* kg = a.in[I_KG] + j * 64;
    const f32x2* tab = (const f32x2*)(a.ws + WS_ROPE);
    bf16* Qb = (bf16*)(a.ws + WS_Q); bf16* Kb = (bf16*)(a.ws + WS_K);
    const int nitems = TT * 20;
    for (int it = blockIdx.x * NTHREADS + c.tid; it < nitems; it += c.G * NTHREADS) {
        const int r = it / 20, hs = it % 20;
        if (hs < 16 && r >= TL && !ctxq) continue;
        bf16* p; const float* g; float post;
        if (hs < 16) { p = Qb + (size_t)r * 1024 + hs * 64; g = qg; post = 0.125f * 1.4426950408889634f; } else { p = Kb + kv_row(r) * 256 + (hs - 16) * 64; g = kg; post = 1.0f; }
        float x[64]; float ss = 0.f;
#pragma unroll
        for (int i = 0; i < 8; ++i) { const u32x4 w = ((const u32x4*)p)[i];
            x[8 * i + 0] = bflo(w.x); x[8 * i + 1] = bfhi(w.x); x[8 * i + 2] = bflo(w.y); x[8 * i + 3] = bfhi(w.y);
            x[8 * i + 4] = bflo(w.z); x[8 * i + 5] = bfhi(w.z); x[8 * i + 6] = bflo(w.w); x[8 * i + 7] = bfhi(w.w); }
#pragma unroll
        for (int i = 0; i < 64; ++i) ss += x[i] * x[i];
        const float rstd = rsqrtf(ss * (1.0f / 64.0f) + EPS);
#pragma unroll
        for (int i = 0; i < 64; ++i) x[i] = x[i] * rstd * g[i];
        if (r < TL) { const int t = r % SEQ, rp = t >> 6, cp = t & 63;
#pragma unroll
            for (int i = 0; i < 32; ++i) { const f32x2 cs = tab[(i < 16 ? rp : cp) * 16 + (i & 15)]; const float x0 = x[2 * i], x1 = x[2 * i + 1];
                x[2 * i] = x0 * cs.x - x1 * cs.y; x[2 * i + 1] = x0 * cs.y + x1 * cs.x; } }
#pragma unroll
        for (int i = 0; i < 8; ++i) ((u32x4*)p)[i] = (u32x4){cvtpk(x[8 * i] * post, x[8 * i + 1] * post), cvtpk(x[8 * i + 2] * post, x[8 * i + 3] * post),
                                                            cvtpk(x[8 * i + 4] * post, x[8 * i + 5] * post), cvtpk(x[8 * i + 6] * post, x[8 * i + 7] * post)};
    }
}

__device__ __forceinline__ void ph_att(const Args& a, const Ctx& c, int layer, char* lds_generic) {
    const int nun = 1024 + (layer == 0 ? 64 : 0);
    const attn_body::bf16* Qb = (const attn_body::bf16*)(a.ws + WS_Q); const attn_body::bf16* Kb = (const attn_body::bf16*)(a.ws + WS_K); const attn_body::bf16* Vb = (const attn_body::bf16*)(a.ws + WS_V);
    for (int U = c.vcu; U < nun; U += c.G) {
        long qrow0, kv0; int h, NT;
        if (U < 1024) { const int bh = U >> 4, qb = U & 15, b = bh >> 4; h = bh & 15; qrow0 = (long)b * SEQ + qb * 256; kv0 = (long)b * KVROWS; NT = KVROWS / 64; }
        else { const int q = U - 1024, b = q >> 4; h = q & 15; qrow0 = (long)TL + b * CTXL; kv0 = (long)b * KVROWS; NT = CTXL / 64; }
        attn_body::attn_unit<8>(qrow0, h, kv0, NT, Qb, Kb, Vb, (attn_body::bf16*)(a.ws + WS_HB), lds_generic);
    }
}

__device__ __forceinline__ void ph_m1(const Args& a, const Ctx& c, int layer) {
    const int Tm = layer == 3 ? TL : TT, ntiles = Tm / 32;
    const float* g = a.in[I_NFFN] + layer * D;
    constexpr int RP = 2064;
    LAS unsigned char* hiT = c.lds; LAS unsigned char* loT = c.lds + 32 * RP;
    LAS float* part = (LAS float*)c.lds;
    LAS float* logit = (LAS float*)(c.lds + 65536);
    LAS int* lcnt = (LAS int*)(c.lds + 133120); LAS int* lbase = lcnt + 32;
    const bf16* wr = (const bf16*)(a.ws + WS_WR) + (size_t)layer * 2 * 65536;
    unsigned* gcnt = (unsigned*)(a.ws + WS_CTL) + CW_CNT + layer * 32;
    int* list = (int*)(a.ws + WS_LIST); float* w2 = (float*)(a.ws + WS_W2);
    const int r32 = c.lane & 31, hi = c.lane >> 5;
    for (int tile = blockIdx.x; tile < ntiles; tile += c.G) {
        const int r0 = tile * 32;
        if (c.tid < 32) lcnt[c.tid] = 0;
#pragma unroll 1
        for (int i = 0; i < 4; ++i) { const int lr = 4 * c.wave + i, r = r0 + lr;
            f32x4 v[4], h[4]; const f32x4* xr = (const f32x4*)((const float*)(a.ws + WS_X) + (size_t)r * D) + c.lane;
#pragma unroll
            for (int j = 0; j < 4; ++j) v[j] = xr[64 * j];
            const float rstd = row_rstd(v); const float* m = mod_row(a, layer, r);
            norm_mod(v, rstd, g, m + 3 * D, m + 4 * D, c.lane, h);
            u32x2* to = (u32x2*)((bf16*)(a.ws + WS_TK) + (size_t)r * D) + c.lane;
#pragma unroll
            for (int j = 0; j < 4; ++j) { const unsigned h0 = cvtpk(h[j].x, h[j].y), h1 = cvtpk(h[j].z, h[j].w);
                const unsigned l0 = cvtpk(h[j].x - bflo(h0), h[j].y - bfhi(h0)), l1 = cvtpk(h[j].z - bflo(h1), h[j].w - bfhi(h1));
                to[64 * j] = (u32x2){h0, h1};
                *(LAS u32x2*)(hiT + lr * RP + (4 * c.lane + 256 * j) * 2) = (u32x2){h0, h1};
                *(LAS u32x2*)(loT + lr * RP + (4 * c.lane + 256 * j) * 2) = (u32x2){l0, l1}; } }
        __syncthreads();
        f32x16 acc0 = {}, acc1 = {};
#pragma unroll 2
        for (int kk = 0; kk < 8; ++kk) { const int k0 = 128 * c.wave + 16 * kk + 8 * hi;
            const bf16x8 ahi = *(const LAS bf16x8*)(hiT + r32 * RP + k0 * 2), alo = *(const LAS bf16x8*)(loT + r32 * RP + k0 * 2);
            const bf16x8 b0h = *(const bf16x8*)(wr + r32 * 1024 + k0), b1h = *(const bf16x8*)(wr + (32 + r32) * 1024 + k0);
            const bf16x8 b0l = *(const bf16x8*)(wr + 65536 + r32 * 1024 + k0), b1l = *(const bf16x8*)(wr + 65536 + (32 + r32) * 1024 + k0);
            acc0 = __builtin_amdgcn_mfma_f32_32x32x16_bf16(ahi, b0h, acc0, 0, 0, 0); acc1 = __builtin_amdgcn_mfma_f32_32x32x16_bf16(ahi, b1h, acc1, 0, 0, 0);
            acc0 = __builtin_amdgcn_mfma_f32_32x32x16_bf16(alo, b0h, acc0, 0, 0, 0); acc1 = __builtin_amdgcn_mfma_f32_32x32x16_bf16(alo, b1h, acc1, 0, 0, 0);
            acc0 = __builtin_amdgcn_mfma_f32_32x32x16_bf16(ahi, b0l, acc0, 0, 0, 0); acc1 = __builtin_amdgcn_mfma_f32_32x32x16_bf16(ahi, b1l, acc1, 0, 0, 0); }
        __syncthreads();
#pragma unroll
        for (int reg = 0; reg < 16; ++reg) { part[((c.wave * 2 + 0) * 16 + reg) * 64 + c.lane] = acc0[reg]; part[((c.wave * 2 + 1) * 16 + reg) * 64 + c.lane] = acc1[reg]; }
        __syncthreads();
#pragma unroll
        for (int q = 0; q < 4; ++q) { const int idx = c.tid + 512 * q, nt = idx >> 10, reg = (idx >> 6) & 15, ln = idx & 63; float s = 0.f;
#pragma unroll
            for (int w = 0; w < 8; ++w) s += part[((w * 2 + nt) * 16 + reg) * 64 + ln];
            logit[((reg & 3) + 8 * (reg >> 2) + 4 * (ln >> 5)) * 64 + nt * 32 + (ln & 31)] = s; }
        __syncthreads();
        int e0 = 0, e1 = 0, p0 = 0, p1 = 0; float w0 = 0.f, w1 = 0.f;
        if (c.tid < 32) { const LAS float* lg = logit + c.tid * 64;
            int grp = 0; float gm = lg[0];
#pragma unroll
            for (int q = 1; q < 4; ++q) if (lg[q] > gm) { gm = lg[q]; grp = q; }
            float den = 0.f;
#pragma unroll
            for (int q = 0; q < 4; ++q) den += expf(lg[q] - gm);
            const float gate = 1.0f / den;
            const LAS float* le = lg + 4 + grp * 8;
            int i0 = 0; float v0 = le[0];
#pragma unroll
            for (int q = 1; q < 8; ++q) if (le[q] > v0) { v0 = le[q]; i0 = q; }
            int i1 = -1; float v1 = -3.0e38f;
#pragma unroll
            for (int q = 0; q < 8; ++q) if (q != i0 && le[q] > v1) { v1 = le[q]; i1 = q; }
            const float ex = expf(v1 - v0); w0 = gate / (1.0f + ex); w1 = gate * ex / (1.0f + ex);
            e0 = grp * 8 + i0; e1 = grp * 8 + i1;
            p0 = __hip_atomic_fetch_add(lcnt + e0, 1, __ATOMIC_RELAXED, __HIP_MEMORY_SCOPE_WORKGROUP);
            p1 = __hip_atomic_fetch_add(lcnt + e1, 1, __ATOMIC_RELAXED, __HIP_MEMORY_SCOPE_WORKGROUP); }
        __syncthreads();
        if (c.tid < 32) { const int n = lcnt[c.tid]; lbase[c.tid] = n ? (int)__hip_atomic_fetch_add(gcnt + c.tid, (unsigned)n, __ATOMIC_RELAXED, __HIP_MEMORY_SCOPE_AGENT) : 0; }
        __syncthreads();
        if (c.tid < 32) { const int r = r0 + c.tid;
            list[e0 * MOE_CAP + lbase[e0] + p0] = 2 * r; w2[2 * r] = w0;
            list[e1 * MOE_CAP + lbase[e1] + p1] = 2 * r + 1; w2[2 * r + 1] = w1; }
        __syncthreads();
    }
}
__device__ __forceinline__ void moe_tables(const Args& a, const Ctx& c, int layer, LAS int* tab) {
    unsigned* gcnt = (unsigned*)(a.ws + WS_CTL) + CW_CNT + layer * 32;
    if (c.tid < 32) tab[40 + c.tid] = (int)__hip_atomic_load(gcnt + c.tid, __ATOMIC_RELAXED, __HIP_MEMORY_SCOPE_AGENT);
    __syncthreads();
    if (c.tid == 0) { int s = 0; for (int e = 0; e < 32; ++e) { tab[e] = s; s += (tab[40 + e] + 255) >> 8; } tab[32] = s; }
    __syncthreads();
}

__device__ __forceinline__ void ph_rpool(const Args& a, const Ctx& c, int layer) {
    LAS unsigned char* hs = c.lds;
    const float* g = a.in[I_NMIX] + layer * D;
    for (int tile = blockIdx.x; tile < TT / 32; tile += c.G) {
        const int r0 = tile * 32;
        const int s0 = r0 < TL ? (r0 / SEQ) * SEQ : TL + ((r0 - TL) / CTXL) * CTXL, s1 = s0 + (r0 < TL ? SEQ : CTXL);
        for (int lr = c.wave; lr < 47; lr += NWAVES) { const int gr = r0 - 8 + lr; if (gr < s0 || gr >= s1) continue;
            f32x4 v[4], h[4]; load_row_combined(a, layer, gr, c.lane, v);
            if (lr >= 8 && lr < 40) { f32x4* xo = (f32x4*)((float*)(a.ws + WS_Z) + (size_t)gr * D) + c.lane;
#pragma unroll
                for (int j = 0; j < 4; ++j) xo[64 * j] = v[j]; }
            const float rstd = row_rstd(v); const float* m = mod_row(a, layer, gr);
            norm_mod(v, rstd, g, m, m + D, c.lane, h);
#pragma unroll
            for (int j = 0; j < 4; ++j) *(LAS u32x2*)(hs + lr * 2048 + (4 * c.lane + 256 * j) * 2) = (u32x2){cvtpk(h[j].x, h[j].y), cvtpk(h[j].z, h[j].w)}; }
        __syncthreads();
        { const int half = 1 << (c.tid >> 7);
          const LAS unsigned* col = (const LAS unsigned*)hs + c.tid;
          float sx = 0.f, sy = 0.f;
          { const int lo = (r0 - half) > s0 ? (r0 - half) : s0, hi = (r0 + half) < s1 ? (r0 + half) : s1;
            for (int gr = lo; gr < hi; ++gr) { const unsigned u = col[(gr - r0 + 8) * 512]; sx += bflo(u); sy += bfhi(u); } }
          unsigned* ho = (unsigned*)((bf16*)(a.ws + WS_HB) + (size_t)r0 * D) + c.tid;
          for (int t = 0; t < 32; ++t) { const int gr = r0 + t; const int lo = (gr - half) > s0 ? (gr - half) : s0, hi = (gr + half) < s1 ? (gr + half) : s1;
              const float inv = 1.0f / (float)(hi - lo); const unsigned u = col[(t + 8) * 512];
              ho[t * 512] = cvtpk(sx * inv - bflo(u), sy * inv - bfhi(u));
              if (t < 31) { if (gr + half < s1) { const unsigned w = col[(t + 8 + half) * 512]; sx += bflo(w); sy += bfhi(w); }
                            if (gr - half >= s0) { const unsigned w = col[(t + 8 - half) * 512]; sx -= bflo(w); sy -= bfhi(w); } } } }
        __syncthreads();
    }
}

struct EpiInproj { static constexpr bool PERM = true; bf16* Z; bf16* XBC; float* DT; const float* dtb;
    __device__ __forceinline__ void operator()(const AccT& acc, const pg8::Unit& u, int wr, int wc, int fr, int fq) const {
        const size_t r0 = (size_t)u.pm * 256;
        if (u.pn < 20) { bf16* base; int pitch; if (u.pn < 8) { base = Z + u.pn * 256; pitch = 2048; } else { base = XBC + (u.pn - 8) * 256; pitch = 3072; }
#pragma unroll
            for (int ai = 0; ai < 2; ++ai)
#pragma unroll
                for (int m = 0; m < 4; ++m) { bf16* rowp = base + (r0 + ai * 128 + wr * 64 + m * 16 + fr) * pitch + wc * 32 + 8 * fq;
#pragma unroll
                    for (int bj = 0; bj < 2; ++bj) { const f32x4 v0 = acc[ai][bj][m][0], v1 = acc[ai][bj][m][1];
                        *(u32x4*)(rowp + bj * 128) = (u32x4){cvtpk(v0[0], v0[1]), cvtpk(v0[2], v0[3]), cvtpk(v1[0], v1[1]), cvtpk(v1[2], v1[3])}; } }
        } else if (wc < 2) { const int col = wc * 32 + 8 * fq; const f32x4 b0 = *(const f32x4*)(dtb + col), b1 = *(const f32x4*)(dtb + col + 4);
#pragma unroll
            for (int ai = 0; ai < 2; ++ai)
#pragma unroll
                for (int m = 0; m < 4; ++m) { float* p = DT + (r0 + ai * 128 + wr * 64 + m * 16 + fr) * 64 + col; f32x4 v0 = acc[ai][0][m][0] + b0, v1 = acc[ai][0][m][1] + b1;
#pragma unroll
                    for (int e = 0; e < 4; ++e) { v0[e] = fmaxf(v0[e], 0.f) + log1pf(__expf(-fabsf(v0[e]))); v1[e] = fmaxf(v1[e], 0.f) + log1pf(__expf(-fabsf(v1[e]))); }
                    *(f32x4*)p = v0; *(f32x4*)(p + 4) = v1; } }
    }
};

__device__ __forceinline__ void ph_conv(const Args& a, const Ctx& c) {
    LAS unsigned char* tin = c.lds; LAS unsigned char* toT = c.lds + 17408; LAS unsigned char* toN = c.lds + 34816;
    const bf16* xbc = (const bf16*)(a.ws + WS_XBC);
    for (int task = blockIdx.x; task < NCH * 48; task += c.G) {
        const int ci = task / 48, chb = task % 48, r0 = ci * 128, ch0 = chb * 64;
        const bool first = ci < 128 ? (ci % 32 == 0) : (((ci - 128) & 1) == 0), last = ci < 128 ? (ci % 32 == 31) : (((ci - 128) & 1) == 1);
        for (int p = c.tid; p < 131 * 8; p += NTHREADS) { const int lr = p >> 3, pc = p & 7; const bool valid = !((lr < 2 && first) || (lr == 130 && last));
            u32x4 v = (u32x4){0u, 0u, 0u, 0u}; if (valid) v = *(const u32x4*)(xbc + (size_t)(r0 - 2 + lr) * 3072 + ch0 + pc * 8);
            *(LAS u32x4*)(tin + lr * 128 + pc * 16) = v; }
        __syncthreads();
        { const int ch = c.tid & 63, tq = c.tid >> 6; const float* cw = a.in[I_CONVW] + ch0 + ch;
          const float w0 = cw[0], w1 = cw[3072], w2 = cw[2 * 3072], w3 = cw[3 * 3072], bias = a.in[I_CONVB][ch0 + ch];
          float xin[19];
#pragma unroll
          for (int i = 0; i < 19; ++i) xin[i] = bf2f(*(const LAS bf16*)(tin + (16 * tq + i) * 128 + ch * 2));
          float o[16];
#pragma unroll
          for (int i = 0; i < 16; ++i) o[i] = silu_f(bias + w0 * xin[i] + w1 * xin[i + 1] + w2 * xin[i + 2] + w3 * xin[i + 3]);
          if (chb < 40) { *(LAS u32x4*)(toT + ch * 272 + tq * 32) = (u32x4){cvtpk(o[0], o[1]), cvtpk(o[2], o[3]), cvtpk(o[4], o[5]), cvtpk(o[6], o[7])};
                          *(LAS u32x4*)(toT + ch * 272 + tq * 32 + 16) = (u32x4){cvtpk(o[8], o[9]), cvtpk(o[10], o[11]), cvtpk(o[12], o[13]), cvtpk(o[14], o[15])}; }
          if (chb >= 32) {
#pragma unroll
              for (int i = 0; i < 16; ++i) *(LAS bf16*)(toN + (16 * tq + i) * 144 + ch * 2) = (bf16)(cvtpk(o[i], 0.f) & 0xffffu); } }
        __syncthreads();
        if (chb < 40) { bf16* dst = chb < 32 ? (bf16*)(a.ws + WS_XT) + ((size_t)ci * 2048 + ch0) * 128 : (bf16*)(a.ws + WS_BT) + ((size_t)ci * 512 + (ch0 - 2048)) * 128;
#pragma unroll
            for (int q = 0; q < 2; ++q) { const int p = c.tid + 512 * q, chl = p >> 4, pc = p & 15; *(u32x4*)(dst + chl * 128 + pc * 8) = *(const LAS u32x4*)(toT + chl * 272 + pc * 16); } }
        if (chb >= 32) { bf16* dst = chb < 40 ? (bf16*)(a.ws + WS_BN) + (size_t)r0 * 512 + (ch0 - 2048) : (bf16*)(a.ws + WS_CN) + (size_t)r0 * 512 + (ch0 - 2560);
#pragma unroll
            for (int q = 0; q < 2; ++q) { const int p = c.tid + 512 * q, t = p >> 3, pc = p & 7; *(u32x4*)(dst + (size_t)t * 512 + pc * 8) = *(const LAS u32x4*)(toN + t * 144 + pc * 16); } }
        __syncthreads();
    }
    const int gw = c.vcu * NWAVES + c.wave, NGW = c.G * NWAVES;
    const float* dt = (const float*)(a.ws + WS_DT);
    for (int item = gw; item < NCH * 32; item += NGW) { const int ci = item >> 5, h = item & 31, r0 = ci * 128 + 2 * c.lane;
        const float af = -expf(a.in[I_ALOG][h]), ab = -expf(a.in[I_ALOG][32 + h]);
        const float dtf0 = dt[(size_t)r0 * 64 + h], dtf1 = dt[(size_t)(r0 + 1) * 64 + h], dtb0 = dt[(size_t)r0 * 64 + 32 + h], dtb1 = dt[(size_t)(r0 + 1) * 64 + 32 + h];
        const float laf0 = dtf0 * af, laf1 = dtf1 * af, lab0 = dtb0 * ab, lab1 = dtb1 * ab;
        float inf_ = laf0 + laf1, inb = lab0 + lab1; const float pf = inf_, pbk = inb;
#pragma unroll
        for (int o = 1; o < 64; o <<= 1) { const float t1 = __shfl_up(inf_, o), t2 = __shfl_up(inb, o); if (c.lane >= o) { inf_ += t1; inb += t2; } }
        const float totf = __shfl(inf_, 63), totb = __shfl(inb, 63);
        const float exf = inf_ - pf, exb = inb - pbk;
        const float cf0 = exf + laf0, cf1 = inf_, pb0 = exb, pb1 = exb + lab0;
        f32x4* sca = (f32x4*)(a.ws + WS_SCA) + (size_t)r0 * 32 + h; f32x4* scb = (f32x4*)(a.ws + WS_SCB) + (size_t)r0 * 32 + h;
        sca[0] = (f32x4){cf0, pb0, dtf0, dtb0}; sca[32] = (f32x4){cf1, pb1, dtf1, dtb1};
        scb[0] = (f32x4){__expf(cf0), __expf(totb - pb0), dtf0 * __expf(totf - cf0), dtb0 * __expf(pb0)};
        scb[32] = (f32x4){__expf(cf1), __expf(totb - pb1), dtf1 * __expf(totf - cf1), dtb1 * __expf(pb1)};
        if (c.lane == 0) ((f32x2*)(a.ws + WS_DEC))[ci * 32 + h] = (f32x2){__expf(totf), __expf(totb)}; }
}

__device__ __forceinline__ void ph_scan(const Args& a, const Ctx& c) {
    constexpr int P = 272, BUF = 53248;
    LAS unsigned char* stg = c.lds + 2 * BUF + c.wave * 2048;
    const int r32 = c.lane & 31, hi = c.lane >> 5, pt = c.wave >> 2, nt = c.wave & 3;
    for (int task = c.vcu; task < 256; task += c.G) { const int b = task >> 6, dir = (task >> 5) & 1, h = task & 31, g = h >> 3;
        f32x16 acc = {};
        u32x4 xr[2], br[4]; float wreg = 0.f;
#define SCAN_CI(k) (dir == 0 ? ((k) < 2 ? 128 + 2 * b + (k) : 32 * b + ((k) - 2)) : ((k) < 2 ? 128 + 2 * b + 1 - (k) : 32 * b + 31 - ((k) - 2)))
#define SCAN_LOAD(k) do { const int ci_ = SCAN_CI(k); const bf16* xs_ = (const bf16*)(a.ws + WS_XT) + ((size_t)ci_ * 2048 + 64 * h) * 128; const bf16* bs_ = (const bf16*)(a.ws + WS_BT) + ((size_t)ci_ * 512 + 128 * g) * 128; \
        _Pragma("unroll") for (int q = 0; q < 2; ++q) xr[q] = ((const u32x4*)xs_)[c.tid + 512 * q]; _Pragma("unroll") for (int q = 0; q < 4; ++q) br[q] = ((const u32x4*)bs_)[c.tid + 512 * q]; \
        if (c.tid < 128) { const f32x4 s4 = ((const f32x4*)(a.ws + WS_SCB))[((size_t)ci_ * 128 + c.tid) * 32 + h]; wreg = dir == 0 ? s4.z : s4.w; } } while (0)
#define SCAN_WRITE(bi) do { LAS unsigned char* xb_ = c.lds + (bi) * BUF; LAS unsigned char* bb_ = xb_ + 17408; \
        _Pragma("unroll") for (int q = 0; q < 2; ++q) { const int p = c.tid + 512 * q; *(LAS u32x4*)(xb_ + (p >> 4) * P + (p & 15) * 16) = xr[q]; } \
        _Pragma("unroll") for (int q = 0; q < 4; ++q) { const int p = c.tid + 512 * q; *(LAS u32x4*)(bb_ + (p >> 4) * P + (p & 15) * 16) = br[q]; } \
        if (c.tid < 128) ((LAS float*)(xb_ + 52224))[c.tid] = wreg; } while (0)
        SCAN_LOAD(0); SCAN_WRITE(0);
        __syncthreads();
        for (int k = 0; k < 34; ++k) { const int cur = k & 1, ci = SCAN_CI(k);
            if (k + 1 < 34) SCAN_LOAD(k + 1);
            { bf16* hin = (bf16*)(a.ws + WS_HIN) + (((size_t)ci * 2 + dir) * 32 + h) * 8192;
#pragma unroll
              for (int r = 0; r < 16; ++r) *(LAS bf16*)(stg + ((r & 3) + 8 * (r >> 2) + 4 * hi) * 64 + r32 * 2) = (bf16)(cvtpk(acc[r], 0.f) & 0xffffu);
              LDS_WAIT();
#pragma unroll
              for (int i = 0; i < 2; ++i) { const int row = (c.lane >> 2) + 16 * i, pc = c.lane & 3; *(u32x4*)(hin + (size_t)(32 * pt + row) * 128 + 32 * nt + pc * 8) = *(const LAS u32x4*)(stg + row * 64 + pc * 16); } }
            const f32x2 dd = ((const f32x2*)(a.ws + WS_DEC))[ci * 32 + h]; const float dec = dir == 0 ? dd.x : dd.y;
#pragma unroll
            for (int r = 0; r < 16; ++r) acc[r] *= dec;
            { LAS unsigned char* xb = c.lds + cur * BUF; LAS unsigned char* bb = xb + 17408; const LAS float* wv = (const LAS float*)(xb + 52224);
#pragma unroll
              for (int kk = 0; kk < 8; ++kk) { const int s8 = 16 * kk + 8 * hi;
                  const u32x4 xa = *(const LAS u32x4*)(xb + (32 * pt + r32) * P + s8 * 2); const f32x4 wa = *(const LAS f32x4*)(wv + s8), wb = *(const LAS f32x4*)(wv + s8 + 4);
                  const u32x4 xs = (u32x4){cvtpk(bflo(xa.x) * wa.x, bfhi(xa.x) * wa.y), cvtpk(bflo(xa.y) * wa.z, bfhi(xa.y) * wa.w), cvtpk(bflo(xa.z) * wb.x, bfhi(xa.z) * wb.y), cvtpk(bflo(xa.w) * wb.z, bfhi(xa.w) * wb.w)};
                  const bf16x8 bfrag = *(const LAS bf16x8*)(bb + (32 * nt + r32) * P + s8 * 2);
                  acc = __builtin_amdgcn_mfma_f32_32x32x16_bf16(__builtin_bit_cast(bf16x8, xs), bfrag, acc, 0, 0, 0); } }
            if (k + 1 < 34) SCAN_WRITE(cur ^ 1);
            __syncthreads();
        }
#undef SCAN_CI
#undef SCAN_LOAD
#undef SCAN_WRITE
    }
}

__device__ __forceinline__ int crow16(int r, int hi) { return (r & 3) + 8 * (r >> 2) + 4 * hi; }
__device__ __forceinline__ void ph_yph(const Args& a, const Ctx& c) {
    constexpr int P = 272, ZP = 144;
    LAS unsigned char* Cs = c.lds; LAS unsigned char* Bs = c.lds + 34816; LAS unsigned char* xs = c.lds + 69632; LAS unsigned char* hf = c.lds + 87040; LAS unsigned char* hb = c.lds + 104448;
    LAS unsigned char* zs = c.lds + 121856; LAS unsigned char* os = c.lds + 140288; LAS f32x2* scf = (LAS f32x2*)(c.lds + 158720); LAS f32x2* scbk = (LAS f32x2*)(c.lds + 159744); LAS f32x2* scb = (LAS f32x2*)(c.lds + 160768); LAS float* ssql = (LAS float*)(c.lds + 34816);
    const int lb = c.wave & 3, pb = c.wave >> 2;
    for (int task = c.vcu; task < NCH * 4; task += c.G) { const int ci = task >> 2, g = task & 3, r0 = ci * 128;
        int tid_t = c.tid; asm volatile("" : "+v"(tid_t));
        f32x16 X[4]; int l0; { const int tid = tid_t, lane = tid & 63, r32 = lane & 31, hi = lane >> 5; l0 = 32 * lb + r32; (void)hi;
        { const bf16* cn = (const bf16*)(a.ws + WS_CN) + (size_t)r0 * 512 + 128 * g; const bf16* bn = (const bf16*)(a.ws + WS_BN) + (size_t)r0 * 512 + 128 * g;
#pragma unroll
          for (int q = 0; q < 4; ++q) { const int p = tid + 512 * q, row = p >> 4, pc = p & 15;
              *(LAS u32x4*)(Cs + row * P + pc * 16) = *(const u32x4*)(cn + (size_t)row * 512 + pc * 8); *(LAS u32x4*)(Bs + row * P + pc * 16) = *(const u32x4*)(bn + (size_t)row * 512 + pc * 8); } }
        __syncthreads();
#pragma unroll
        for (int sb = 0; sb < 4; ++sb) { X[sb] = (f32x16){};
#pragma unroll
            for (int kk = 0; kk < 8; ++kk) { const int k8 = (16 * kk + 8 * hi) * 2;
                X[sb] = __builtin_amdgcn_mfma_f32_32x32x16_bf16(*(const LAS bf16x8*)(Bs + (32 * sb + r32) * P + k8), *(const LAS bf16x8*)(Cs + (32 * lb + r32) * P + k8), X[sb], 0, 0, 0); } }
        }
        float ssq = 0.f;
#pragma unroll 1
        for (int hh = 0; hh < 8; ++hh) { const int h = 8 * g + hh;
            int tid = c.tid; asm volatile("" : "+v"(tid)); const int lane = tid & 63, r32 = lane & 31, hi = lane >> 5, l = 32 * lb + r32; (void)lane;
            __syncthreads();
            { const u32x4* xt = (const u32x4*)((const bf16*)(a.ws + WS_XT) + ((size_t)ci * 2048 + 64 * h) * 128);
              const u32x4* hfg = (const u32x4*)((const bf16*)(a.ws + WS_HIN) + (((size_t)ci * 2 + 0) * 32 + h) * 8192); const u32x4* hbg = (const u32x4*)((const bf16*)(a.ws + WS_HIN) + (((size_t)ci * 2 + 1) * 32 + h) * 8192);
              const bf16* zg = (const bf16*)(a.ws + WS_Z) + (size_t)r0 * 2048 + 64 * h;
#pragma unroll
              for (int q = 0; q < 2; ++q) { const int p = tid + 512 * q, row = p >> 4, pc = p & 15;
                  *(LAS u32x4*)(xs + row * P + pc * 16) = xt[p]; *(LAS u32x4*)(hf + row * P + pc * 16) = hfg[p]; *(LAS u32x4*)(hb + row * P + pc * 16) = hbg[p];
                  const int zr = p >> 3, zc = p & 7; *(LAS u32x4*)(zs + zr * ZP + zc * 16) = *(const u32x4*)(zg + (size_t)zr * 2048 + zc * 8); }
              if (tid < 128) { const f32x4 s1 = ((const f32x4*)(a.ws + WS_SCA))[((size_t)r0 + tid) * 32 + h]; scf[tid] = (f32x2){s1.x, s1.z}; scbk[tid] = (f32x2){s1.y, s1.w};
                                 const f32x4 s4 = ((const f32x4*)(a.ws + WS_SCB))[((size_t)r0 + tid) * 32 + h]; scb[tid] = (f32x2){s4.x, s4.y}; } }
            __syncthreads();
            const f32x2 mef = scf[l], meb = scbk[l]; const f32x4 me = (f32x4){mef.x, meb.x, mef.y, meb.y}; const f32x2 ee = scb[l]; const float dsum = a.in[I_DSK][h] + a.in[I_DSK][32 + h];
            f32x16 accd = {};
#pragma unroll
            for (int sb = 0; sb < 4; ++sb) { unsigned mp[8];
#pragma unroll
                for (int q = 0; q < 4; ++q) { float mv[4];
#pragma unroll
                    for (int e = 0; e < 4; ++e) { const int s = 32 * sb + 8 * q + 4 * hi + e;
                        const f32x2 pr = (s <= l) ? scf[s] : scbk[s];
                        const float arg = (s <= l) ? (me.x - pr.x) : (pr.x - me.y); const float coef = (s == l) ? (me.z + me.w) : pr.y;
                        float m = X[sb][4 * q + e] * __expf(arg) * coef; if (s == l) m += dsum; mv[e] = m; }
                    mp[2 * q] = cvtpk(mv[0], mv[1]); mp[2 * q + 1] = cvtpk(mv[2], mv[3]);
                    __builtin_amdgcn_sched_barrier(0); }
#pragma unroll
                for (int t = 0; t < 2; ++t) { const int sof = (32 * sb + 16 * t + 4 * hi) * 2;
                    const u32x2 lo = *(const LAS u32x2*)(xs + (32 * pb + r32) * P + sof), h2 = *(const LAS u32x2*)(xs + (32 * pb + r32) * P + sof + 16);
                    const u32x4 af = (u32x4){lo.x, lo.y, h2.x, h2.y}, bfm = (u32x4){mp[4 * t], mp[4 * t + 1], mp[4 * t + 2], mp[4 * t + 3]};
                    accd = __builtin_amdgcn_mfma_f32_32x32x16_bf16(__builtin_bit_cast(bf16x8, af), __builtin_bit_cast(bf16x8, bfm), accd, 0, 0, 0); }
                __builtin_amdgcn_sched_barrier(0); }
#pragma unroll
            for (int dd = 0; dd < 2; ++dd) { f32x16 acco = {}; LAS unsigned char* hx = dd == 0 ? hf : hb;
#pragma unroll
                for (int kk = 0; kk < 8; ++kk) { const int k8 = (16 * kk + 8 * hi) * 2;
                    acco = __builtin_amdgcn_mfma_f32_32x32x16_bf16(*(const LAS bf16x8*)(hx + (32 * pb + r32) * P + k8), *(const LAS bf16x8*)(Cs + (32 * lb + r32) * P + k8), acco, 0, 0, 0); }
                const float ex = dd == 0 ? ee.x : ee.y;
#pragma unroll
                for (int r = 0; r < 16; ++r) accd[r] += ex * acco[r]; }
#pragma unroll
            for (int q = 0; q < 4; ++q) { const int pcol = 32 * pb + 8 * q + 4 * hi; const u32x2 zq = *(const LAS u32x2*)(zs + l * ZP + pcol * 2);
                float gv[4];
#pragma unroll
                for (int e = 0; e < 4; ++e) { const int r = 4 * q + e; const float y = accd[r];
                    const float z = (e == 0) ? bflo(zq.x) : (e == 1) ? bfhi(zq.x) : (e == 2) ? bflo(zq.y) : bfhi(zq.y); gv[e] = y * silu_f(z); ssq += gv[e] * gv[e]; }
                *(LAS u32x2*)(os + l * ZP + pcol * 2) = (u32x2){cvtpk(gv[0], gv[1]), cvtpk(gv[2], gv[3])}; }
            __syncthreads();
            { bf16* gg = (bf16*)(a.ws + WS_G) + (size_t)r0 * 2048 + 64 * h;
#pragma unroll
              for (int q = 0; q < 2; ++q) { const int p = tid + 512 * q, zr = p >> 3, zc = p & 7; *(u32x4*)(gg + (size_t)zr * 2048 + zc * 8) = *(const LAS u32x4*)(os + zr * ZP + zc * 16); } }
        }
        ssq += __shfl_xor(ssq, 32);
        if ((c.lane >> 5) == 0) ssql[pb * 128 + l0] = ssq;
        __syncthreads();
        if (c.tid < 128) ((float*)(a.ws + WS_RSTD))[((size_t)r0 + c.tid) * 4 + g] = rsqrtf((ssql[c.tid] + ssql[128 + c.tid]) * (1.0f / 512.0f) + EPS);
        __syncthreads();
    }
}
__device__ __forceinline__ void ph_gfix(const Args& a, const Ctx& c) {
    const float* ng = a.in[I_SNORM]; const float* rs = (const float*)(a.ws + WS_RSTD);
    const int n16 = TT * 256;
    for (int p = blockIdx.x * NTHREADS + c.tid; p < n16; p += c.G * NTHREADS) { const int r = p >> 8, col = (p & 255) * 8;
        u32x4* gp = (u32x4*)((bf16*)(a.ws + WS_G) + (size_t)r * 2048 + col); const u32x4 v = *gp; const float s = rs[r * 4 + (col >> 9)];
        const f32x4 g0 = *(const f32x4*)(ng + col), g1 = *(const f32x4*)(ng + col + 4);
        *gp = (u32x4){cvtpk(bflo(v.x) * s * g0.x, bfhi(v.x) * s * g0.y), cvtpk(bflo(v.y) * s * g0.z, bfhi(v.y) * s * g0.w), cvtpk(bflo(v.z) * s * g1.x, bfhi(v.z) * s * g1.y), cvtpk(bflo(v.w) * s * g1.z, bfhi(v.w) * s * g1.w)}; }
}

#if DEBUG_CHECKS
__device__ __forceinline__ int dbg_sample_row(int b) { const int SR[16] = {0, 1, 77, 4095, 4096, 5000, 8191, 9000, 12288, 16383, 16384, 16385, 16384 + 255, 16384 + 256, 17000, 17407}; int r = 0;
#pragma unroll
    for (int i = 0; i < 16; ++i) r = (b == i) ? SR[i] : r;
    return r; }
__device__ __forceinline__ float blk_sum(float v, LAS float* red, int tid) {
    v = wave_sum(v); __syncthreads(); if ((tid & 63) == 0) red[tid >> 6] = v; __syncthreads(); float s = 0.f;
#pragma unroll
    for (int i = 0; i < 8; ++i) s += red[i];
    __syncthreads(); return s; }
__device__ __forceinline__ float blk_max(float v, LAS float* red, int tid) {
#pragma unroll
    for (int o = 1; o < 64; o <<= 1) v = fmaxf(v, __shfl_xor(v, o));
    __syncthreads(); if ((tid & 63) == 0) red[tid >> 6] = v; __syncthreads(); float s = red[0];
#pragma unroll
    for (int i = 1; i < 8; ++i) s = fmaxf(s, red[i]);
    __syncthreads(); return s; }
__device__ __forceinline__ void dbg_report(const Args& a, int id, float err, float ssref, float n, int tid) {
    if (tid == 0) { float rel = err / (sqrtf(ssref / n) + 1e-20f); if (!(rel == rel)) rel = 1e30f; atomicMax((unsigned*)(a.ws + WS_CTL) + CW_DBG + id, __float_as_uint(rel)); } }
__device__ __forceinline__ float dbg_mod(const Args& a, int layer, int r, int j) {
    const float* cv = r < TL ? a.in[I_C] + (r / SEQ) * 1024 : a.in[I_CCTX]; float s = 0.f;
    _Pragma("nounroll") for (int k = 0; k < 1024; ++k) { const float x = cv[k]; s += (x / (1.0f + expf(-x))) * a.in[I_WADA][((size_t)layer * 1024 + k) * 6144 + j]; }
    return s + a.in[I_BADA][layer * 6144 + j]; }

__device__ __forceinline__ void chk_rmix(const Args& a, int layer, int id, LAS unsigned char* ldsb) {
    if (blockIdx.x >= 16) return; const int tid = tid_opaque(), r = dbg_sample_row(blockIdx.x);
    LAS float* red = (LAS float*)ldsb;
    const float* x = resid_row(a, layer, r); const bf16* hb = (const bf16*)(a.ws + WS_HB) + (size_t)r * D;
    float ss = 0.f; for (int cc = tid; cc < D; cc += 512) ss += x[cc] * x[cc];
    ss = blk_sum(ss, red, tid); const float rstd = rsqrtf(ss / D + EPS);
    float err = 0.f, sr = 0.f;
    for (int cc = tid; cc < D; cc += 512) { const float sh = dbg_mod(a, layer, r, cc), sc = dbg_mod(a, layer, r, D + cc);
        const float ref = x[cc] * rstd * a.in[I_NMIX][layer * D + cc] * (1.f + sc) + sh; err = fmaxf(err, fabsf(ref - bf2f(hb[cc]))); sr += ref * ref; }
    err = blk_max(err, red, tid); sr = blk_sum(sr, red, tid); dbg_report(a, id, err, sr, D, tid);
}
__device__ __forceinline__ void chk_qkv(const Args& a, int layer, int id, LAS unsigned char* ldsb) {
    if (blockIdx.x >= 16) return; const int tid = tid_opaque(), r = dbg_sample_row(blockIdx.x), j = layer ? 1 : 0;
    LAS float* red = (LAS float*)ldsb; LAS float* y = red + 16; LAS float* hrow = y + 1536;
    const bf16* hb = (const bf16*)(a.ws + WS_HB) + (size_t)r * D;
    _Pragma("nounroll") for (int k = tid; k < D; k += 512) hrow[k] = bf2f(hb[k]);
    __syncthreads();
    for (int n = tid; n < 1536; n += 512) { float s = 0.f; const float* w = a.in[I_WQKV] + (size_t)j * 1024 * 1536 + n; _Pragma("nounroll") for (int k = 0; k < 1024; ++k) s += hrow[k] * w[(size_t)k * 1536]; y[n] = s; }
    __syncthreads();
    float err = 0.f, sr = 0.f;
    for (int n = tid; n < 1536; n += 512) { float ref;
        if (n < 1280) { const int h0 = n & ~63; float ss = 0.f; _Pragma("nounroll") for (int q = 0; q < 64; ++q) ss += y[h0 + q] * y[h0 + q];
            const float rstd = rsqrtf(ss / 64.f + EPS); const float* g = (n < 1024 ? a.in[I_QG] : a.in[I_KG]) + j * 64;
            float v = y[n] * rstd * g[n & 63], vp = y[n ^ 1] * rstd * g[(n ^ 1) & 63];
            if (r < TL) { const int t = r % SEQ, i = (n & 63) >> 1, f = i & 15, pos = i < 16 ? t / 64 : t % 64; const float inv = powf(10000.f, -(float)f / 16.f), ang = (float)pos * inv, cs = cosf(ang), sn = sinf(ang);
                v = (n & 1) ? (vp * sn + v * cs) : (v * cs - vp * sn); }
            if (n < 1024) v *= 0.125f * 1.4426950408889634f;
            ref = v; } else ref = y[n];
        float got;
        if (n < 1024) { if (layer == 3 && r >= TL) continue; got = bf2f(((const bf16*)(a.ws + WS_Q))[(size_t)r * 1024 + n]); }
        else if (n < 1280) got = bf2f(((const bf16*)(a.ws + WS_K))[kv_row(r) * 256 + (n - 1024)]);
        else got = bf2f(((const bf16*)(a.ws + WS_V))[kv_row(r) * 256 + (n - 1280)]);
        err = fmaxf(err, fabsf(ref - got)); sr += ref * ref; }
    err = blk_max(err, red, tid); sr = blk_sum(sr, red, tid); dbg_report(a, id, err, sr, 1536, tid);
}
__device__ __forceinline__ void chk_att(const Args& a, int layer, int id, LAS unsigned char* ldsb) {
    if (blockIdx.x >= 16) return; const int tid = tid_opaque(), r = dbg_sample_row(blockIdx.x);
    if (layer == 3 && r >= TL) return;
    LAS float* red = (LAS float*)ldsb; LAS float* sc = red + 16; LAS float* po = sc + 4352;
    const int nk = r < TL ? KVROWS : CTXL; const long kv0 = (long)(r < TL ? r / SEQ : (r - TL) / CTXL) * KVROWS;
    const bf16* Qb = (const bf16*)(a.ws + WS_Q); const bf16* Kb = (const bf16*)(a.ws + WS_K); const bf16* Vb = (const bf16*)(a.ws + WS_V); const bf16* Ob = (const bf16*)(a.ws + WS_HB);
    float err = 0.f, sr = 0.f;
    for (int h = 0; h < 16; ++h) {
        float mx = -3e38f;
        _Pragma("nounroll") for (int jk = tid; jk < nk; jk += 512) { float s = 0.f; _Pragma("nounroll") for (int d = 0; d < 64; ++d) s += bf2f(Qb[(size_t)r * 1024 + h * 64 + d]) * bf2f(Kb[(kv0 + jk) * 256 + (h >> 2) * 64 + d]); sc[jk] = s; mx = fmaxf(mx, s); }
        mx = blk_max(mx, red, tid);
        float l = 0.f; _Pragma("nounroll") for (int jk = tid; jk < nk; jk += 512) { const float p = exp2f(sc[jk] - mx); sc[jk] = p; l += p; }
        l = blk_sum(l, red, tid);
        { const int d = tid & 63, part = tid >> 6; float o = 0.f; _Pragma("nounroll") for (int jk = part; jk < nk; jk += 8) o += sc[jk] * bf2f(Vb[(kv0 + jk) * 256 + (h >> 2) * 64 + d]); po[part * 64 + d] = o; }
        __syncthreads();
        if (tid < 64) { float o = 0.f; _Pragma("nounroll") for (int p = 0; p < 8; ++p) o += po[p * 64 + tid]; o /= l; err = fmaxf(err, fabsf(o - bf2f(Ob[(size_t)r * 1024 + h * 64 + tid]))); sr += o * o; }
        __syncthreads();
    }
    err = blk_max(err, red, tid); sr = blk_sum(sr, red, tid); dbg_report(a, id, err, sr, 1024, tid);
}
__device__ __forceinline__ void chk_oproj(const Args& a, int layer, int id, LAS unsigned char* ldsb) {
    if (blockIdx.x >= 16 || layer != 0) return; const int tid = tid_opaque(), r = dbg_sample_row(blockIdx.x), j = 0;
    LAS float* red = (LAS float*)ldsb; LAS float* orow = red + 16;
    const bf16* Ob = (const bf16*)(a.ws + WS_HB) + (size_t)r * D;
    _Pragma("nounroll") for (int k = tid; k < D; k += 512) orow[k] = bf2f(Ob[k]);
    __syncthreads();
    float err = 0.f, sr = 0.f;
    for (int n = tid; n < D; n += 512) { float s = 0.f; const float* w = a.in[I_WO] + (size_t)j * 1024 * 1024 + n; _Pragma("nounroll") for (int k = 0; k < 1024; ++k) s += orow[k] * w[(size_t)k * 1024];
        const float dl = dbg_mod(a, layer, r, 2 * D + n) * s, ref = resid_row(a, 0, r)[n] + dl; err = fmaxf(err, fabsf(ref - ((const float*)(a.ws + WS_X))[(size_t)r * D + n])); sr += dl * dl; }
    err = blk_max(err, red, tid); sr = blk_sum(sr, red, tid); dbg_report(a, id, err, sr, D, tid);
}
__device__ __forceinline__ void chk_moe(const Args& a, int layer, int id_tok, int id_y, LAS unsigned char* ldsb) {
    if (blockIdx.x >= 16) return; const int tid = tid_opaque(), r = dbg_sample_row(blockIdx.x);
    if (layer == 3 && r >= TL) return;
    LAS float* red = (LAS float*)ldsb; LAS float* tok = red + 16; LAS float* lg = tok + 1024; LAS float* tkb = lg + 64; LAS float* act = tkb + 1024; LAS float* rt = act + 1024;
    const float* x = (const float*)(a.ws + WS_X) + (size_t)r * D; const bf16* tk = (const bf16*)(a.ws + WS_TK) + (size_t)r * D;
    float ss = 0.f; for (int cc = tid; cc < D; cc += 512) ss += x[cc] * x[cc];
    ss = blk_sum(ss, red, tid); const float rstd = rsqrtf(ss / D + EPS);
    float err = 0.f, sr = 0.f;
    for (int cc = tid; cc < D; cc += 512) { const float sh = dbg_mod(a, layer, r, 3 * D + cc), sc = dbg_mod(a, layer, r, 4 * D + cc);
        const float ref = x[cc] * rstd * a.in[I_NFFN][layer * D + cc] * (1.f + sc) + sh; tok[cc] = ref; tkb[cc] = bf2f(tk[cc]); err = fmaxf(err, fabsf(ref - tkb[cc])); sr += ref * ref; }
    err = blk_max(err, red, tid); sr = blk_sum(sr, red, tid);
    if (tid < 36) { float s = 0.f; _Pragma("nounroll") for (int k = 0; k < 1024; ++k) s += tok[k] * (tid < 4 ? a.in[I_WRG][((size_t)layer * 1024 + k) * 4 + tid] : a.in[I_WRE][((size_t)layer * 1024 + k) * 32 + tid - 4]); lg[tid] = s; }
    __syncthreads();
    if (tid == 0) { int grp = 0; _Pragma("nounroll") for (int q = 1; q < 4; ++q) if (lg[q] > lg[grp]) grp = q; float den = 0.f; _Pragma("nounroll") for (int q = 0; q < 4; ++q) den += expf(lg[q] - lg[grp]);
        const LAS float* le = lg + 4 + grp * 8; int i0 = 0; _Pragma("nounroll") for (int q = 1; q < 8; ++q) if (le[q] > le[i0]) i0 = q; int i1 = -1; _Pragma("nounroll") for (int q = 0; q < 8; ++q) if (q != i0 && (i1 < 0 || le[q] > le[i1])) i1 = q;
        const float ex = expf(le[i1] - le[i0]), w0 = 1.f / den / (1.f + ex), w1 = 1.f / den * ex / (1.f + ex);
        rt[0] = (float)(grp * 8 + i0); rt[1] = (float)(grp * 8 + i1); rt[2] = w0; rt[3] = w1;
        const float* w2 = (const float*)(a.ws + WS_W2); float e2 = fmaxf(fabsf(w2[2 * r] - w0), fabsf(w2[2 * r + 1] - w1)) * 30.f;
        const int* list = (const int*)(a.ws + WS_LIST); const unsigned* gc = (const unsigned*)(a.ws + WS_CTL) + CW_CNT + layer * 32;
        _Pragma("nounroll") for (int k = 0; k < 2; ++k) { const int e = (int)rt[k]; bool found = false; const int n = (int)gc[e]; _Pragma("nounroll") for (int q = 0; q < n && q < MOE_CAP; ++q) if (list[e * MOE_CAP + q] == 2 * r + k) found = true; if (!found) e2 = 1e6f; }
        rt[4] = e2; }
    __syncthreads();
    err = fmaxf(err, rt[4] * sqrtf(sr / D));
    dbg_report(a, id_tok, err, sr, D, tid);
    float err2 = 0.f, sr2 = 0.f;
    _Pragma("nounroll") for (int k = 0; k < 2; ++k) { const int e = (int)rt[k]; const float wk = rt[2 + k];
        const float* wgu = a.in[I_WGU] + ((size_t)layer * 32 + e) * 1024 * 1024; const float* wdn = a.in[I_WDN] + ((size_t)layer * 32 + e) * 512 * 1024;
        { float sg = 0.f, su = 0.f; _Pragma("nounroll") for (int q = 0; q < 1024; ++q) { sg += tkb[q] * wgu[(size_t)q * 1024 + tid]; su += tkb[q] * wgu[(size_t)q * 1024 + 512 + tid]; } act[tid] = (sg / (1.f + expf(-sg))) * su; }
        __syncthreads();
        for (int n = tid; n < D; n += 512) { float s = 0.f; _Pragma("nounroll") for (int q = 0; q < 512; ++q) s += act[q] * wdn[(size_t)q * 1024 + n]; s *= wk;
            err2 = fmaxf(err2, fabsf(s - bf2f(((const bf16*)(a.ws + WS_Y2))[(size_t)(2 * r + k) * D + n]))); sr2 += s * s; }
        __syncthreads(); }
    err2 = blk_max(err2, red, tid); sr2 = blk_sum(sr2, red, tid); dbg_report(a, id_y, err2, sr2, 2 * D, tid);
}

__global__ void __launch_bounds__(NTHREADS) dbg_kernel(Args a, int ty, int layer, int id) {
    extern __shared__ __attribute__((aligned(16))) unsigned char lds_dbg[];
    LAS unsigned char* l = (LAS unsigned char*)lds_dbg;
    if (ty == 1) chk_rmix(a, layer, id, l); else if (ty == 2) chk_qkv(a, layer, id, l); else if (ty == 3) chk_att(a, layer, id, l);
    else if (ty == 4) chk_oproj(a, layer, id, l); else if (ty == 5) chk_moe(a, layer, id, id + 1, l);
}
#endif

template <int KIND, int LAYER> __device__ __forceinline__ void run_phase(const Args& a0, Ctx& c, unsigned char* lds_gen) {
    Args a = a0; { unsigned long long wsv = (unsigned long long)a0.ws; asm volatile("" : "+s"(wsv)); a.ws = (unsigned char*)(GAS unsigned char*)wsv; }
    { unsigned lb = (unsigned)(uintptr_t)(LAS unsigned char*)lds_gen; asm volatile("" : "+s"(lb)); c.lds = (LAS unsigned char*)(uintptr_t)lb; }
    c.tid = tid_opaque(); c.lane = c.tid & 63;
    unsigned char* const ws = a.ws; constexpr int layer = LAYER;
    if constexpr (KIND == K_P0) p0_prologue(a, c);
    else if constexpr (KIND == K_RMIX) ph_rmix(a, c, layer);
    else if constexpr (KIND == K_QKV) { constexpr int j = layer ? 1 : 0;
        SchedQKV S{(const char*)(ws + WS_HB), (const char*)(ws + WS_WQKV) + (size_t)j * 1536 * 1024 * 2, layer == 0 ? 1 : 0, c.G, (int)blockIdx.x};
        EpiQKV E{(bf16*)(ws + WS_Q), (bf16*)(ws + WS_K), (bf16*)(ws + WS_V)};
        pg8::gemm_phase<EpiQKV, SchedQKV, false>(c.lds, 1024, 1024, S, E); }
    else if constexpr (KIND == K_ROPE) ph_rope(a, c, layer);
    else if constexpr (KIND == K_ATT) ph_att(a, c, layer, (char*)c.lds);
    else if constexpr (KIND == K_OPROJ) { constexpr int j = layer ? 1 : 0;
        SchedDense S{(const char*)(ws + WS_HB), (const char*)(ws + WS_WO) + (size_t)j * 1024 * 1024 * 2, (size_t)256 * 1024 * 2, (size_t)256 * 1024 * 2, 0, layer == 3 ? 64 : 68, 4, c.G, (int)blockIdx.x};
        EpiResid E{&a, layer, nullptr, nullptr};
        pg8::gemm_phase<EpiResid, SchedDense, false>(c.lds, 1024, 1024, S, E); }
    else if constexpr (KIND == K_M1) ph_m1(a, c, layer);
    else if constexpr (KIND == K_M2) { LAS int* tab = (LAS int*)(c.lds + TAB_OFF); moe_tables(a, c, layer, tab);
        SchedMoe S{(const char*)(ws + WS_TK), 0, (const char*)(ws + WS_WGU) + (size_t)layer * 32 * 1024 * 1024 * 2, (size_t)1024 * 1024 * 2, (size_t)256 * 1024 * 2, tab, (const int*)(ws + WS_LIST), c.G, (int)blockIdx.x};
        EpiGateUp E{(bf16*)(ws + WS_ACT)};
        pg8::gemm_phase<EpiGateUp, SchedMoe, true>(c.lds, 1024, 1024, S, E); }
    else if constexpr (KIND == K_M3) { LAS int* tab = (LAS int*)(c.lds + TAB_OFF); moe_tables(a, c, layer, tab);
        SchedMoe S{(const char*)(ws + WS_ACT), (size_t)256 * 512 * 2, (const char*)(ws + WS_WDN) + (size_t)layer * 32 * 1024 * 512 * 2, (size_t)1024 * 512 * 2, (size_t)256 * 512 * 2, tab, (const int*)(ws + WS_LIST), c.G, (int)blockIdx.x};
        EpiDown E{(const int*)(ws + WS_LIST), (const float*)(ws + WS_W2), (bf16*)(ws + WS_Y2)};
        pg8::gemm_phase<EpiDown, SchedMoe, false>(c.lds, 512, 512, S, E); }
    else if constexpr (KIND == K_RPOOL) ph_rpool(a, c, layer);
    else if constexpr (KIND == K_POOLG) {
        SchedDense S{(const char*)(ws + WS_HB), (const char*)(ws + WS_WPOOL), (size_t)256 * 1024 * 2, (size_t)256 * 256 * 2, (size_t)256 * 2, 68, 4, c.G, (int)blockIdx.x};
        EpiResid E{&a, layer, a.in[I_POOLS], (const float*)(ws + WS_Z)};
        pg8::gemm_phase<EpiResid, SchedDense, false>(c.lds, 256, 1024, S, E); }
    else if constexpr (KIND == K_INPROJ) {
        SchedDense S{(const char*)(ws + WS_HB), (const char*)(ws + WS_WIN), (size_t)256 * 1024 * 2, (size_t)256 * 1024 * 2, 0, 68, 21, c.G, (int)blockIdx.x};
        EpiInproj E{(bf16*)(ws + WS_Z), (bf16*)(ws + WS_XBC), (float*)(ws + WS_DT), a.in[I_DTB]};
        pg8::gemm_phase<EpiInproj, SchedDense, false>(c.lds, 1024, 1024, S, E); }
    else if constexpr (KIND == K_CONV) ph_conv(a, c);
    else if constexpr (KIND == K_SCAN) ph_scan(a, c);
    else if constexpr (KIND == K_YPH) ph_yph(a, c);
    else if constexpr (KIND == K_GFIX) ph_gfix(a, c);
    else if constexpr (KIND == K_OUTPROJ) {
        SchedDense S{(const char*)(ws + WS_G), (const char*)(ws + WS_WOUT), (size_t)256 * 2048 * 2, (size_t)256 * 2048 * 2, 0, 68, 4, c.G, (int)blockIdx.x};
        EpiResid E{&a, layer, nullptr, nullptr};
        pg8::gemm_phase<EpiResid, SchedDense, false>(c.lds, 2048, 2048, S, E); }
    else if constexpr (KIND == K_FINAL) ph_final(a, c, layer);
}
#define PROGRAM(X) \
    X(0, K_P0, 0) \
    X(1, K_RMIX, 0) X(2, K_QKV, 0) X(3, K_ROPE, 0) X(4, K_ATT, 0) X(5, K_OPROJ, 0) X(6, K_M1, 0) X(7, K_M2, 0) X(8, K_M3, 0) \
    X(9, K_RPOOL, 1) X(10, K_POOLG, 1) X(11, K_M1, 1) X(12, K_M2, 1) X(13, K_M3, 1) \
    X(14, K_RMIX, 2) X(15, K_INPROJ, 2) X(16, K_CONV, 2) X(17, K_SCAN, 2) X(18, K_YPH, 2) X(19, K_GFIX, 2) X(20, K_OUTPROJ, 2) X(21, K_M1, 2) X(22, K_M2, 2) X(23, K_M3, 2) \
    X(24, K_RMIX, 3) X(25, K_QKV, 3) X(26, K_ROPE, 3) X(27, K_ATT, 3) X(28, K_OPROJ, 3) X(29, K_M1, 3) X(30, K_M2, 3) X(31, K_M3, 3) \
    X(32, K_FINAL, 4)
constexpr int NPHASES = 33;
__global__ void __launch_bounds__(NTHREADS, 2) mega(Args a0) {
    extern __shared__ __attribute__((aligned(16))) unsigned char lds_raw[];
    Ctx c; c.lds = (LAS unsigned char*)lds_raw; c.tid = threadIdx.x; c.lane = c.tid & 63; c.wave = __builtin_amdgcn_readfirstlane(c.tid >> 6);
    c.G = gridDim.x; { const int bx = blockIdx.x; c.vcu = (c.G % 8 == 0) ? (bx % 8) * (c.G / 8) + bx / 8 : bx; }
    volatile LAS unsigned* MISC = (volatile LAS unsigned*)(c.lds + MISC_OFF);
    for (int u = c.tid; u < 128; u += NTHREADS) MISC[u] = 0u;
    __syncthreads();
    XcdBarrier bar = xcd_barrier_post((unsigned*)(a0.ws + WS_CTL) + CW_BAR + a0.bar_region * XCD_BAR_WORDS, MISC + 8);
    const int lo = a0.ph_lo, hi = a0.ph_hi;
#if PROBE
#define STAMP(idx) if (blockIdx.x == 0 && threadIdx.x == 0) __hip_atomic_store((unsigned long long*)((unsigned*)(a0.ws + WS_CTL) + CW_TS) + (idx), (unsigned long long)__builtin_amdgcn_s_memrealtime(), __ATOMIC_RELAXED, __HIP_MEMORY_SCOPE_AGENT);
#else
#define STAMP(idx)
#endif
    STAMP(0)
#define RUNPH(idx, KIND, LAYER) if (lo <= (idx) && (idx) < hi) { run_phase<KIND, LAYER>(a0, c, lds_raw); if ((idx) + 1 < hi) xcd_barrier(bar); STAMP((idx) + 1) }
    PROGRAM(RUNPH)
#undef RUNPH
#if PROBE
    if (blockIdx.x == 0 && threadIdx.x == 0 && hi == NPHASES) { const unsigned long long* ts = (const unsigned long long*)((unsigned*)(a0.ws + WS_CTL) + CW_TS);
        const unsigned long long d = (unsigned long long)PROBE_K * ((ts[PROBE_A1] - ts[PROBE_A0]) + (ts[PROBE_B1] - ts[PROBE_B0])), t0 = __builtin_amdgcn_s_memrealtime();
        while (__builtin_amdgcn_s_memrealtime() - t0 < d) __builtin_amdgcn_s_sleep(8); }
#endif
}

extern "C" void kernel_launch(void* const* d_in, const int* in_sizes, int n_in, void* d_out, int out_size, void* d_ws, size_t ws_size, hipStream_t stream) {
    static int grid = 0;
    if (grid == 0) {
        if (n_in != N_IN || out_size != TL * D || ws_size < WS_END) { fprintf(stderr, "kernel_launch: unexpected shapes (n_in %d out %d ws %zu)\n", n_in, out_size, ws_size); grid = -1; return; }
        int dev = 0, cus = 0;
        if (hipGetDevice(&dev) != hipSuccess || hipDeviceGetAttribute(&cus, hipDeviceAttributeMultiprocessorCount, dev) != hipSuccess) { grid = -1; return; }
        if (hipFuncSetAttribute((const void*)mega, hipFuncAttributeMaxDynamicSharedMemorySize, LDS_BYTES) != hipSuccess) { fprintf(stderr, "kernel_launch: hipFuncSetAttribute failed\n"); grid = -1; return; }
        int per_cu = 0;
        if (hipOccupancyMaxActiveBlocksPerMultiprocessor(&per_cu, (const void*)mega, NTHREADS, LDS_BYTES) != hipSuccess || per_cu < 1) fprintf(stderr, "kernel_launch: occupancy query says %d\n", per_cu);
        (void)hipGetLastError();
        grid = cus;
    }
    if (grid < 0) return;
    (void)hipMemsetAsync((char*)d_ws + WS_CTL, 0, CTL_ZERO_BYTES, stream);
    Args a{};
    for (int i = 0; i < N_IN; ++i) a.in[i] = (const float*)d_in[i];
    a.out = (float*)d_out; a.ws = (unsigned char*)d_ws; a.flags = 0;
#if DEBUG_CHECKS
    struct Cut { int after; int ty, layer, nid; };
    const Cut cuts[] = DEBUG_CUTS;
    int lo = 0, region = 0, dbg_id = 1;
    for (unsigned k = 0; k < sizeof(cuts) / sizeof(cuts[0]); ++k) {
        if (cuts[k].after + 1 > lo) { a.ph_lo = lo; a.ph_hi = cuts[k].after + 1; a.bar_region = region++; hipLaunchKernelGGL(mega, dim3(grid), dim3(NTHREADS), LDS_BYTES, stream, a); lo = cuts[k].after + 1; }
        hipLaunchKernelGGL(dbg_kernel, dim3(16), dim3(NTHREADS), 65536, stream, a, cuts[k].ty, cuts[k].layer, dbg_id); dbg_id += cuts[k].nid;
    }
    a.ph_lo = lo; a.ph_hi = NPHASES; a.bar_region = region++;
    hipLaunchKernelGGL(mega, dim3(grid), dim3(NTHREADS), LDS_BYTES, stream, a);
#else
    a.ph_lo = 0; a.ph_hi = NPHASES; a.bar_region = 0;
    hipLaunchKernelGGL(mega, dim3(grid), dim3(NTHREADS), LDS_BYTES, stream, a);
#endif
}
```

```cpp
#include <hip/hip_runtime.h>
#include <cstdio>
#include <cstdint>

#define LAS __attribute__((address_space(3)))
#define GAS __attribute__((address_space(1)))
typedef unsigned short bf16;
typedef short bf16x8 __attribute__((ext_vector_type(8)));
typedef short s16x4 __attribute__((ext_vector_type(4)));
typedef float f32x2 __attribute__((ext_vector_type(2)));
typedef float f32x4 __attribute__((ext_vector_type(4)));
typedef float f32x16 __attribute__((ext_vector_type(16)));
typedef unsigned u32x2 __attribute__((ext_vector_type(2)));
typedef unsigned u32x4 __attribute__((ext_vector_type(4)));
typedef __bf16 bf16x2_t __attribute__((ext_vector_type(2)));

constexpr int D = 1024, NB = 4, SEQ = 4096, CTXL = 256, TL = NB * SEQ, TC = NB * CTXL, TT = TL + TC;
constexpr int KVROWS = SEQ + CTXL;
constexpr int NCH = TT / 128;
constexpr int MOE_CAP = TT;
constexpr float EPS = 1e-6f;
constexpr int NWAVES = 8, NTHREADS = 512;
#ifndef NLAYERS
#define NLAYERS 4
#endif
#ifndef DEBUG_CHECKS
#define DEBUG_CHECKS 0
#endif
#ifndef PROBE
#define PROBE 0
#endif
#define PROBE_A0 0
#define PROBE_A1 1
#define PROBE_B0 4
#define PROBE_B1 5
#define PROBE_K 2
#define PROBE_MASK 0x1222224u
#define EXTRA_BARS 0
#define PROBE_SLOT 0
#if PROBE
#define SECT_DECL unsigned long long sect_t = __builtin_amdgcn_s_memrealtime(); unsigned long long sect_acc[8] = {0, 0, 0, 0, 0, 0, 0, 0};
#define SECT(k) do { const unsigned long long n_ = __builtin_amdgcn_s_memrealtime(); sect_acc[k] += n_ - sect_t; sect_t = n_; } while (0)
#define SECT_END(base) do { if (blockIdx.x == 0 && threadIdx.x == 0) { _Pragma("unroll") for (int k_ = 0; k_ < 8; ++k_) ((unsigned long long*)((unsigned*)(a.ws + WS_CTL) + CW_TS))[(base) + k_] = sect_acc[k_]; } } while (0)
#else
#define SECT_DECL
#define SECT(k) do {} while (0)
#define SECT_END(base) do {} while (0)
#endif
#define DEBUG_CUTS { {1, 1, 0, 1}, {2, 2, 0, 1}, {3, 3, 0, 1}, {4, 4, 0, 1}, {6, 5, 0, 2} }

enum { I_X = 0, I_C, I_CTX, I_CCTX, I_WADA, I_BADA, I_NMIX, I_NFFN, I_NFIN, I_WQKV, I_WO, I_QG, I_KG, I_POOLW, I_POOLS, I_WIN, I_CONVW, I_CONVB, I_DTB, I_ALOG, I_DSK, I_SNORM, I_WOUT, I_WRG, I_WRE, I_WGU, I_WDN, N_IN };

constexpr size_t MiB = 1u << 20;
constexpr size_t WS_CTL = 0, CTL_ZERO_BYTES = 1 * MiB;
constexpr size_t WS_MODL = 1 * MiB;
constexpr size_t WS_MODC = WS_MODL + 4 * 4 * 6144 * 4;
constexpr size_t WS_ROPE = 1 * MiB + 512 * 1024;
constexpr size_t WS_WR = 2 * MiB;
constexpr size_t WS_WQKV = 3 * MiB;
constexpr size_t WS_WO = 9 * MiB;
constexpr size_t WS_WPOOL = 13 * MiB;
constexpr size_t WS_WIN = 14 * MiB;
constexpr size_t WS_WOUT = 25 * MiB;
constexpr size_t WS_WGU = 29 * MiB;
constexpr size_t WS_WDN = 285 * MiB;
constexpr size_t WS_X = 413 * MiB;
constexpr size_t WS_HB = 481 * MiB;
constexpr size_t WS_TK = 515 * MiB;
constexpr size_t WS_Q = 549 * MiB;
constexpr size_t WS_K = 583 * MiB;
constexpr size_t WS_V = 592 * MiB;
constexpr size_t WS_Y2 = 601 * MiB;
constexpr size_t WS_ACT = 669 * MiB;
constexpr size_t WS_LIST = 711 * MiB;
constexpr size_t WS_W2 = 714 * MiB;
constexpr size_t WS_Z = 715 * MiB;
constexpr size_t WS_XBC = 783 * MiB;
constexpr size_t WS_DT = 885 * MiB;
constexpr size_t WS_XT = 890 * MiB;
constexpr size_t WS_BN = 958 * MiB;
constexpr size_t WS_BT = 975 * MiB;
constexpr size_t WS_CN = 992 * MiB;
constexpr size_t WS_SCA = 1009 * MiB;
constexpr size_t WS_SCB = 1018 * MiB;
constexpr size_t WS_DEC = 1027 * MiB;
constexpr size_t WS_HIN = 1028 * MiB;
constexpr size_t WS_G = 1164 * MiB;
constexpr size_t WS_RSTD = 1232 * MiB;
constexpr size_t WS_END = 1233 * MiB;

constexpr int CW_BAR = 4096;
constexpr int CW_CNT = 200000;
constexpr int CW_DBG = 201000;
constexpr int CW_RDY = 204000;
constexpr int CW_TS = 202000;

constexpr int LDS_BYTES = 163840;
constexpr int MISC_OFF = LDS_BYTES - 512;

__device__ __forceinline__ unsigned cvtpk(float lo, float hi) { f32x2 v = {lo, hi}; bf16x2_t b = __builtin_convertvector(v, bf16x2_t); return __builtin_bit_cast(unsigned, b); }
__device__ __forceinline__ float bflo(unsigned u) { return __uint_as_float(u << 16); }
__device__ __forceinline__ float bfhi(unsigned u) { return __uint_as_float(u & 0xffff0000u); }
__device__ __forceinline__ float bf2f(bf16 b) { return __uint_as_float((unsigned)b << 16); }
__device__ __forceinline__ float wave_sum(float v) {
#pragma unroll
    for (int o = 1; o < 64; o <<= 1) v += __shfl_xor(v, o);
    return v;
}
__device__ __forceinline__ float silu_f(float v) { return v * __builtin_amdgcn_rcpf(1.0f + __builtin_amdgcn_exp2f(v * -1.4426950408889634f)); }
__device__ __forceinline__ int tid_opaque() { int t = threadIdx.x; asm volatile("" : "+v"(t)); return t; }
#define LDS_WAIT() asm volatile("s_waitcnt lgkmcnt(0)" ::: "memory")
#define VM_WAIT() asm volatile("s_waitcnt vmcnt(0)" ::: "memory")

#define XB_TMO      128
#define XB_XCNT(j)  (256  + 64 * (j))
#define XB_XSUB(j)  (1280 + 64 * (j))
#define XB_XGEN(j)  (2304 + 64 * (j))
#define XB_TOP      3328
#define XB_TOPGEN   3392
#define XCD_BAR_WORDS 3456
#define XB_SPIN_CAP (1u << 20)
__device__ __forceinline__ unsigned xb_ld(unsigned* p)              { return __hip_atomic_load(p, __ATOMIC_RELAXED, __HIP_MEMORY_SCOPE_AGENT); }
__device__ __forceinline__ unsigned xb_add(unsigned* p, unsigned v) { return __hip_atomic_fetch_add(p, v, __ATOMIC_RELAXED, __HIP_MEMORY_SCOPE_AGENT); }
__device__ __forceinline__ unsigned xb_xcc_id() { return (unsigned)__builtin_amdgcn_s_getreg((3 << 11) | 20) & 0xFu; }
#define XB_SPIN(cond, bar) do { unsigned _sp = 0; while (cond) { __builtin_amdgcn_s_sleep(1); \
    if ((++_sp & 255u) == 0u) { if (xb_ld(&(bar)[XB_TMO])) break; if (_sp > XB_SPIN_CAP) { atomicAdd(&(bar)[XB_TMO], 1u); break; } } } } while (0)
struct XcdBarrier { unsigned* bar; unsigned x; volatile LAS unsigned* st; };
__device__ __forceinline__ XcdBarrier xcd_barrier_post(unsigned* bar, volatile LAS unsigned* st) {
    XcdBarrier b; b.bar = bar; b.x = xb_xcc_id(); b.st = st;
    if (threadIdx.x == 0) (void)xb_add(&bar[XB_XCNT(b.x)], 1u);
    return b;
}
__device__ __forceinline__ void xcd_barrier_complete(unsigned* bar, unsigned x, unsigned& nloc, unsigned& nx) {
    const unsigned G = gridDim.x * gridDim.y * gridDim.z;
    unsigned sum, cnt, mine, sp = 0u;
    for (;;) {
        sum = 0u; cnt = 0u; mine = 0u;
#pragma unroll
        for (unsigned j = 0; j < 16; ++j) { const unsigned c = xb_ld(&bar[XB_XCNT(j)]); sum += c; cnt += (c > 0u) ? 1u : 0u; mine = (j == x) ? c : mine; }
        if (sum == G) break;
        __builtin_amdgcn_s_sleep(1);
        if ((++sp & 255u) == 0u) { if (xb_ld(&bar[XB_TMO])) break; if (sp > XB_SPIN_CAP) { atomicAdd(&bar[XB_TMO], 1u); break; } }
    }
    nloc = mine > 0u ? mine : 1u; nx = cnt > 0u ? cnt : 1u;
}
__device__ __forceinline__ void xcd_barrier(const XcdBarrier& b) {
    asm volatile("s_waitcnt vmcnt(0)" ::: "memory");
    __syncthreads();
    if (threadIdx.x == 0) {
        unsigned* bar = b.bar;
        __builtin_amdgcn_s_waitcnt(0);
        unsigned nloc = b.st[0], nx = b.st[1];
        if (nloc == 0u) { xcd_barrier_complete(bar, b.x, nloc, nx); b.st[0] = nloc; b.st[1] = nx; }
        const unsigned old = xb_add(&bar[XB_XSUB(b.x)], 1u);
        const unsigned gen = old / nloc;
        if (old + 1u == (gen + 1u) * nloc) {
            __builtin_amdgcn_fence(__ATOMIC_RELEASE, "agent");
            asm volatile("s_waitcnt vmcnt(0)" ::: "memory");
            const unsigned og = xb_add(&bar[XB_TOP], 1u);
            const unsigned tg = og / nx;
            if (og + 1u == (tg + 1u) * nx) xb_add(&bar[XB_TOPGEN], 1u);
            else XB_SPIN(xb_ld(&bar[XB_TOPGEN]) == tg, bar);
            __builtin_amdgcn_fence(__ATOMIC_ACQUIRE, "agent");
            xb_add(&bar[XB_XGEN(b.x)], 1u);
            asm volatile("s_waitcnt vmcnt(0)" ::: "memory");
        } else {
            XB_SPIN(xb_ld(&bar[XB_XGEN(b.x)]) == gen, bar);
            __builtin_amdgcn_fence(__ATOMIC_ACQUIRE, "agent");
            asm volatile("s_waitcnt vmcnt(0)" ::: "memory");
        }
    }
    __syncthreads();
}

enum { K_P0 = 0, K_RMIX, K_QKV, K_ROPE, K_ATT, K_OPROJ, K_M1, K_M2, K_M3, K_RPOOL, K_POOLG, K_INPROJ, K_CONV, K_SCAN, K_YPH, K_GFIX, K_OUTPROJ, K_FINAL, K_DBG };
struct Args { const float* in[N_IN]; float* out; unsigned char* ws; int ph_lo, ph_hi; int flags; int bar_region; };

struct Ctx {
    LAS unsigned char* lds; int tid, lane, wave, vcu, G;
};

__device__ __forceinline__ const float* mod_row(const Args& a, int layer, int r) {
    return r < TL ? (const float*)(a.ws + WS_MODL) + (size_t)(layer * 4 + r / SEQ) * 6144 : (const float*)(a.ws + WS_MODC) + (size_t)layer * 6144;
}
__device__ __forceinline__ const float* resid_row(const Args& a, int layer, int r) {
    if (layer == 0) return r < TL ? a.in[I_X] + (size_t)r * D : a.in[I_CTX] + (size_t)(r - TL) * D;
    return (const float*)(a.ws + WS_X) + (size_t)r * D;
}

__device__ __forceinline__ void load_row_combined(const Args& a, int layer, int r, int lane, f32x4 (&v)[4]) {
    const f32x4* xr = (const f32x4*)resid_row(a, layer, r) + lane;
#pragma unroll
    for (int j = 0; j < 4; ++j) v[j] = xr[64 * j];
    if (layer > 0 && !(a.flags & 1)) {
        const f32x4* gf = (const f32x4*)(mod_row(a, layer - 1, r) + 5 * D) + lane;
        const u32x2* y0 = (const u32x2*)((const bf16*)(a.ws + WS_Y2) + (size_t)(2 * r) * D) + lane;
        const u32x2* y1 = (const u32x2*)((const bf16*)(a.ws + WS_Y2) + (size_t)(2 * r + 1) * D) + lane;
#pragma unroll
        for (int j = 0; j < 4; ++j) {
            const u32x2 p = y0[64 * j], q = y1[64 * j]; const f32x4 g = gf[64 * j];
            v[j].x += g.x * (bflo(p.x) + bflo(q.x)); v[j].y += g.y * (bfhi(p.x) + bfhi(q.x));
            v[j].z += g.z * (bflo(p.y) + bflo(q.y)); v[j].w += g.w * (bfhi(p.y) + bfhi(q.y));
        }
    }
}
__device__ __forceinline__ float row_rstd(const f32x4 (&v)[4]) {
    float s = 0.f;
#pragma unroll
    for (int j = 0; j < 4; ++j) s += (v[j].x * v[j].x + v[j].y * v[j].y) + (v[j].z * v[j].z + v[j].w * v[j].w);
    return rsqrtf(wave_sum(s) * (1.0f / D) + EPS);
}
__device__ __forceinline__ void norm_mod(const f32x4 (&v)[4], float rstd, const float* g, const float* shift, const float* scale, int lane, f32x4 (&h)[4]) {
#pragma unroll
    for (int j = 0; j < 4; ++j) {
        const f32x4 gg = ((const f32x4*)g)[lane + 64 * j], sh = ((const f32x4*)shift)[lane + 64 * j], sc = ((const f32x4*)scale)[lane + 64 * j];
        h[j] = (v[j] * rstd) * gg * (sc + 1.0f) + sh;
    }
}

__device__ __forceinline__ void tr_item(const float* W, int N, int k0, int n0, bf16* WT, size_t drow0, int dK, LAS float* scr, int lane, int hi_skip = 0) {
    const int nq = lane & 15, kr = lane >> 4;
#pragma unroll
    for (int i = 0; i < 16; ++i) { const int kk = 4 * i + kr; const f32x4 v = *(const f32x4*)(W + (size_t)(k0 + kk) * N + n0 + 4 * nq);
        LAS float* d = scr + kk * 65 + 4 * nq; d[0] = v.x; d[1] = v.y; d[2] = v.z; d[3] = v.w; }
    LDS_WAIT(); asm volatile("" ::: "memory");
    const int c = lane & 7;
#pragma unroll
    for (int j = 0; j < 8; ++j) { const int n = (lane >> 3) + 8 * j; const LAS float* s = scr + (8 * c) * 65 + n;
        u32x4 o; o.x = cvtpk(s[0 * 65], s[1 * 65]); o.y = cvtpk(s[2 * 65], s[3 * 65]); o.z = cvtpk(s[4 * 65], s[5 * 65]); o.w = cvtpk(s[6 * 65], s[7 * 65]);
        *(u32x4*)(WT + (drow0 + n + (n >= 32 ? hi_skip : 0)) * dK + k0 + 8 * c) = o; }
    LDS_WAIT(); asm volatile("" ::: "memory");
}
__device__ __forceinline__ void p0_prologue(const Args& a, const Ctx& c) {
    LAS float* scr = (LAS float*)(c.lds + c.wave * 16896);
    const int gw = c.vcu * NWAVES + c.wave, NGW = c.G * NWAVES;
    constexpr int I0 = 2 * 384, I1 = 2 * 256, I2 = 4 * 16, I3 = 16 * 81, I4 = 32 * 16, I5 = 128 * 256, I6 = 128 * 128, ITOT = I0 + I1 + I2 + I3 + I4 + I5 + I6;
    for (int it = gw; it < ITOT; it += NGW) {
        int r = it;
        if (r < I5) { const int m = r / 256, q = r % 256, kb = q / 16, nb = q % 16; const int n0 = nb * 64;
            const int j = n0 & 511, drow = 256 * (j >> 7) + (j & 127) + ((n0 >= 512) ? 128 : 0);
            tr_item(a.in[I_WGU] + (size_t)m * 1024 * 1024, 1024, kb * 64, n0, (bf16*)(a.ws + WS_WGU) + (size_t)m * 1024 * 1024, drow, 1024, scr, c.lane); continue; }
        r -= I5;
        if (r < I6) { const int m = r / 128, q = r % 128, kb = q / 16, nb = q % 16;
            tr_item(a.in[I_WDN] + (size_t)m * 512 * 1024, 1024, kb * 64, nb * 64, (bf16*)(a.ws + WS_WDN) + (size_t)m * 1024 * 512, nb * 64, 512, scr, c.lane); continue; }
        r -= I6;
        if (r < I0) { const int m = r / 384, q = r % 384, kb = q / 24, nb = q % 24;
            tr_item(a.in[I_WQKV] + (size_t)m * 1024 * 1536, 1536, kb * 64, nb * 64, (bf16*)(a.ws + WS_WQKV) + (size_t)m * 1536 * 1024, (nb >> 2) * 256 + (nb & 3) * 32, 1024, scr, c.lane, 96); continue; }
        r -= I0;
        if (r < I1) { const int m = r / 256, q = r % 256, kb = q / 16, nb = q % 16;
            tr_item(a.in[I_WO] + (size_t)m * 1024 * 1024, 1024, kb * 64, nb * 64, (bf16*)(a.ws + WS_WO) + (size_t)m * 1024 * 1024, nb * 64, 1024, scr, c.lane); continue; }
        r -= I1;
        if (r < I2) { const int m = r / 16, q = r % 16, kb = q / 4, nb = q % 4;
            tr_item(a.in[I_POOLW] + (size_t)m * 256 * 256, 256, kb * 64, nb * 64, (bf16*)(a.ws + WS_WPOOL) + (size_t)m * 256 * 256, nb * 64, 256, scr, c.lane); continue; }
        r -= I2;
        if (r < I3) { const int kb = r / 81, nb = r % 81;
            tr_item(a.in[I_WIN], 5184, kb * 64, nb * 64, (bf16*)(a.ws + WS_WIN), nb * 64, 1024, scr, c.lane); continue; }
        r -= I3;
        { const int kb = r / 16, nb = r % 16;
            tr_item(a.in[I_WOUT], 1024, kb * 64, nb * 64, (bf16*)(a.ws + WS_WOUT), nb * 64, 2048, scr, c.lane); }
    }
    __syncthreads();
    LAS float* sv = (LAS float*)c.lds;
    LAS float* part = (LAS float*)(c.lds + 20480);
    for (int u = c.tid; u < 5 * 1024; u += NTHREADS) { const int v = u >> 10, k = u & 1023; const float x = v < 4 ? a.in[I_C][v * 1024 + k] : a.in[I_CCTX][k]; sv[u] = x / (1.0f + expf(-x)); }
    __syncthreads();
    for (int item = blockIdx.x; item < 4 * 96; item += c.G) {
        const int li = item / 96, c0 = (item % 96) * 64, cq = c.tid & 15, ks = c.tid >> 4;
        f32x4 acc[5];
#pragma unroll
        for (int v = 0; v < 5; ++v) acc[v] = (f32x4){0.f, 0.f, 0.f, 0.f};
        const float* w = a.in[I_WADA] + ((size_t)li * 1024 + ks * 32) * 6144 + c0 + 4 * cq;
#pragma unroll 4
        for (int k = 0; k < 32; ++k) { const f32x4 wv = *(const f32x4*)(w + (size_t)k * 6144);
#pragma unroll
            for (int v = 0; v < 5; ++v) acc[v] += wv * sv[v * 1024 + ks * 32 + k]; }
#pragma unroll
        for (int v = 0; v < 5; ++v) *(LAS f32x4*)(part + (ks * 16 + cq) * 20 + v * 4) = acc[v];
        __syncthreads();
        if (c.tid < 320) { const int v = c.tid >> 6, col = c.tid & 63, q = col >> 2, e = col & 3; float s = 0.f;
            for (int k2 = 0; k2 < 32; ++k2) s += part[(k2 * 16 + q) * 20 + v * 4 + e];
            s += a.in[I_BADA][li * 6144 + c0 + col];
            if (v < 4) ((float*)(a.ws + WS_MODL))[(size_t)(li * 4 + v) * 6144 + c0 + col] = s; else ((float*)(a.ws + WS_MODC))[(size_t)li * 6144 + c0 + col] = s; }
        __syncthreads();
    }
    if (blockIdx.x == (unsigned)(c.G - 1)) for (int u = c.tid; u < 1024; u += NTHREADS) { const int pos = u >> 4, f = u & 15;
        const float inv = (float)pow(10000.0, -(double)f / 16.0); const double ang = (double)((float)pos * inv);
        ((f32x2*)(a.ws + WS_ROPE))[u] = (f32x2){(float)cos(ang), (float)sin(ang)}; }
    for (int u = blockIdx.x * NTHREADS + c.tid; u < 4 * 64 * 1024; u += c.G * NTHREADS) { const int li = u >> 16, n = (u >> 10) & 63, k = u & 1023;
        float w = 0.f; if (n < 4) w = a.in[I_WRG][((size_t)li * 1024 + k) * 4 + n]; else if (n < 36) w = a.in[I_WRE][((size_t)li * 1024 + k) * 32 + (n - 4)];
        const unsigned hi = cvtpk(w, 0.f) & 0xffffu; const float rem = w - bflo(hi); const unsigned lo = cvtpk(rem, 0.f) & 0xffffu;
        bf16* wr = (bf16*)(a.ws + WS_WR) + (size_t)li * 2 * 65536; wr[n * 1024 + k] = (bf16)hi; wr[65536 + n * 1024 + k] = (bf16)lo; }
}

__device__ __forceinline__ void ph_rmix(const Args& a, const Ctx& c, int layer) {
    const int gw = c.vcu * NWAVES + c.wave, NGW = c.G * NWAVES;
    const float* g = a.in[I_NMIX] + layer * D;
    for (int r = gw; r < TT; r += NGW) {
        f32x4 v[4], h[4]; load_row_combined(a, layer, r, c.lane, v);
        if (layer > 0) { f32x4* xo = (f32x4*)((float*)(a.ws + WS_X) + (size_t)r * D) + c.lane;
#pragma unroll
            for (int j = 0; j < 4; ++j) xo[64 * j] = v[j]; }
        const float rstd = row_rstd(v); const float* m = mod_row(a, layer, r);
        norm_mod(v, rstd, g, m, m + D, c.lane, h);
        u32x2* ho = (u32x2*)((bf16*)(a.ws + WS_HB) + (size_t)r * D) + c.lane;
#pragma unroll
        for (int j = 0; j < 4; ++j) ho[64 * j] = (u32x2){cvtpk(h[j].x, h[j].y), cvtpk(h[j].z, h[j].w)};
    }
}

__device__ __forceinline__ void ph_final(const Args& a, const Ctx& c, int layer) {
    const int gw = c.vcu * NWAVES + c.wave, NGW = c.G * NWAVES;
    float dscale = 1.f, dmark = 0.f;
#if DEBUG_CHECKS
    { unsigned* dbg = (unsigned*)(a.ws + WS_CTL) + CW_DBG; int code = 0; float mag = 0.f;
      for (int id = 1; id < 32; ++id) { const float e = __uint_as_float(__hip_atomic_load(dbg + id, __ATOMIC_RELAXED, __HIP_MEMORY_SCOPE_AGENT)); if (code == 0 && e > 0.03f) { code = id; mag = e; } }
      dscale = 1.f + (float)code; dmark = code ? 100.f * (1.f + fminf(fmaxf(log2f(mag / 0.03f), 0.f), 30.f)) : 0.f; }
#endif
    for (int r = gw; r < TL; r += NGW) {
        f32x4 v[4]; load_row_combined(a, layer, r, c.lane, v);
        const float rstd = row_rstd(v) * dscale;
        f32x4* o = (f32x4*)(a.out + (size_t)r * D) + c.lane;
#pragma unroll
        for (int j = 0; j < 4; ++j) { f32x4 ov = (v[j] * rstd) * ((const f32x4*)a.in[I_NFIN])[c.lane + 64 * j]; if (j == 0 && r == 0 && c.lane == 0 && dmark > 0.f) ov.x = dmark; o[64 * j] = ov; }
    }
}


namespace pg8 {
constexpr int BM = 256, BK = 64, HALF = 128, HTB = HALF * BK * 2, STAGE_BYTES = 8 * HTB;
__host__ __device__ __forceinline__ int lds_byte(int r, int c) { const int st = (r >> 4) * 2 + (c >> 5), rr = r & 15, cc = c & 31, ob = rr * 64 + cc * 2; return st * 1024 + (ob ^ (((ob >> 9) & 1) << 5)); }
__host__ __device__ __forceinline__ void stage_rc(int b, int& R, int& C) { const int st = b / 1024, sb = b % 1024, swz = sb ^ (((sb >> 9) & 1) << 5); R = (st >> 1) * 16 + swz / 64; C = (st & 1) * 32 + (swz % 64) / 2; }
__host__ __device__ __forceinline__ int perm32(int rho) { const int n = rho >> 4, i = rho & 15; return 8 * (i >> 2) + 4 * n + (i & 3); }
struct Unit { const char* A; const char* B; int pm, pn, x0, x1; };
__device__ __forceinline__ void tile_of(int L, int nM, int nN, int& pm, int& pn) {
    const int nwg = nM * nN; int wgid = L; { const int q = nwg / 8, r = nwg % 8, xcd = wgid % 8, off = wgid / 8; wgid = (xcd < r ? xcd * (q + 1) : r * (q + 1) + (xcd - r) * q) + off; }
    const int nig = 8 * nN, gid = wgid / nig, fm = gid * 8, gsz = (nM - fm) < 8 ? (nM - fm) : 8;
    pm = fm + ((wgid % nig) % gsz); pn = (wgid % nig) / gsz;
}
template <class Epi, class Sched, bool GATHER>
__device__ __forceinline__ void gemm_phase(LAS unsigned char* lds, const int K, const int lda, const Sched& S, const Epi& E) {
    const int tid = tid_opaque(), wid = __builtin_amdgcn_readfirstlane(tid >> 6), lane = tid & 63, wr = wid >> 2, wc = wid & 3, fr = lane & 15, fq = lane >> 4;
    const int nt = K / BK;
    unsigned voffA[2], voffB[2]; int RA[2], CA[2];
#pragma unroll
    for (int i = 0; i < 2; ++i) { int R, C; stage_rc(tid * 16 + i * 8192, R, C); const int Rb = Epi::PERM ? ((R & ~31) + perm32(R & 31)) : R;
        RA[i] = R; CA[i] = C; voffA[i] = (unsigned)(R * lda + C) * 2u; voffB[i] = (unsigned)(Rb * K + C) * 2u; }
    const size_t kstep = (size_t)(BK * 2);
    const size_t hstepA = (size_t)HALF * lda * 2, hstepB = (size_t)HALF * K * 2;
    const unsigned ldsw = (unsigned)wid * 1024u;
    const int aoff = lds_byte(wr * 64 + fr, fq * 8), boff = lds_byte(wc * 32 + fr, fq * 8);
#define PG8_SA(b, h) (((b) * 2 + (h)) * HTB)
#define PG8_SB(b, h) ((4 + (b) * 2 + (h)) * HTB)
#define PG8_GLDS(bufoff, gptr, i_) __builtin_amdgcn_global_load_lds((const unsigned*)(gptr), (LAS unsigned*)(lds + (bufoff) + ldsw + (i_) * 8192), 16, 0, 0)
#define PG8_STAGE_B(bufoff, gbase) do { _Pragma("unroll") for (int _i = 0; _i < 2; ++_i) PG8_GLDS(bufoff, (const char*)(gbase) + voffB[_i], _i); } while (0)
#define PG8_STAGE_A(bufoff, ab, kb, h, NX) do { _Pragma("unroll") for (int _i = 0; _i < 2; ++_i) { \
        if constexpr (GATHER) { const unsigned _vo = (NX) ? voN[h][_i] : voC[h][_i]; PG8_GLDS(bufoff, (ab) + (kb) + _vo, _i); } \
        else { PG8_GLDS(bufoff, (ab) + (kb) + (size_t)(h) * hstepA + voffA[_i], _i); } } } while (0)
#define PG8_LDA(dst, b, h) do { _Pragma("unroll") for (int m = 0; m < 4; ++m) _Pragma("unroll") for (int k = 0; k < 2; ++k) dst[m][k] = *(const LAS bf16x8*)(lds + PG8_SA(b, h) + aoff + m * 2048 + k * 1024); } while (0)
#define PG8_LDB(dst, b, h) do { _Pragma("unroll") for (int n = 0; n < 2; ++n) _Pragma("unroll") for (int k = 0; k < 2; ++k) dst[n][k] = *(const LAS bf16x8*)(lds + PG8_SB(b, h) + boff + n * 2048 + k * 1024); } while (0)
#define PG8_MMA(ai, bj, At, Bt) do { __builtin_amdgcn_s_setprio(1); _Pragma("unroll") for (int m = 0; m < 4; ++m) _Pragma("unroll") for (int n = 0; n < 2; ++n) _Pragma("unroll") for (int k = 0; k < 2; ++k) \
        acc[ai][bj][m][n] = __builtin_amdgcn_mfma_f32_16x16x32_bf16(Bt[n][k], At[m][k], acc[ai][bj][m][n], 0, 0, 0); __builtin_amdgcn_s_setprio(0); } while (0)
#define PG8_WAIT_V(n) asm volatile("s_waitcnt vmcnt(" #n ")" ::: "memory")
#define PG8_WAIT_L(n) asm volatile("s_waitcnt lgkmcnt(" #n ")" ::: "memory")
#define PG8_BAR __builtin_amdgcn_s_barrier()
#define PG8_SCHED __builtin_amdgcn_sched_barrier(0)
    Unit cur, nxt, pend; int ui = 0; bool have_pend = false;
    if (!S.next(0, cur)) return;
    pend = cur;
    unsigned voC[2][2], voN[2][2];
    if constexpr (GATHER) {
#pragma unroll
        for (int h = 0; h < 2; ++h)
#pragma unroll
            for (int i = 0; i < 2; ++i) { voC[h][i] = (unsigned)(S.gather(cur, h * HALF + RA[i]) * lda + CA[i]) * 2u; voN[h][i] = voC[h][i]; }
    } else { voC[0][0] = voN[0][0] = 0u; }
    f32x4 acc[2][2][4][2];
#pragma unroll
    for (int a = 0; a < 2; ++a)
#pragma unroll
        for (int b = 0; b < 2; ++b)
#pragma unroll
            for (int m = 0; m < 4; ++m)
#pragma unroll
                for (int n = 0; n < 2; ++n) acc[a][b][m][n] = (f32x4){0.f, 0.f, 0.f, 0.f};
    bf16x8 At[4][2], B0[2][2], B1[2][2];
    const char* cA = cur.A; const char* cB = cur.B;
    S.a_ready(cur, wid);
    PG8_STAGE_B(PG8_SB(0, 0), cB); PG8_STAGE_B(PG8_SB(0, 1), cB + hstepB); PG8_STAGE_A(PG8_SA(0, 0), cA, (size_t)0, 0, false); PG8_STAGE_A(PG8_SA(0, 1), cA, (size_t)0, 1, false);
    if (wr == 1) PG8_BAR;
    PG8_WAIT_V(2); PG8_BAR;
    PG8_STAGE_B(PG8_SB(1, 0), cB + kstep); PG8_STAGE_A(PG8_SA(1, 0), cA, kstep, 0, false); PG8_STAGE_B(PG8_SB(1, 1), cB + hstepB + kstep);
    PG8_WAIT_V(6); PG8_BAR;
    for (;;) {
        const bool has_next = S.next(ui + 1, nxt);
        if constexpr (GATHER) { if (has_next) {
#pragma unroll
            for (int h = 0; h < 2; ++h)
#pragma unroll
                for (int i = 0; i < 2; ++i) voN[h][i] = (unsigned)(S.gather(nxt, h * HALF + RA[i]) * lda + CA[i]) * 2u; } }
        const char* nA = has_next ? nxt.A : cA; const char* nB = has_next ? nxt.B : cB;
        for (int t = 0; t < nt; t += 2) {
            const bool last = (t == nt - 2);
            const size_t k1 = (size_t)(t + 1) * kstep;
            const char* a2 = last ? nA : cA; const size_t k2 = last ? (size_t)0 : (size_t)(t + 2) * kstep; const size_t k3 = k2 + kstep;
            const char* b2 = last ? nB : cB + (size_t)(t + 2) * kstep; const char* b3 = b2 + kstep;
            const bool nx = GATHER ? (last && has_next) : false;
            if (last && has_next) S.a_ready(nxt, wid);
            PG8_LDB(B0, 0, 0); PG8_LDB(B1, 0, 1); PG8_SCHED; PG8_LDA(At, 0, 0); PG8_STAGE_A(PG8_SA(1, 1), cA, k1, 1, false);
            PG8_WAIT_V(8); PG8_WAIT_L(0); PG8_BAR; PG8_MMA(0, 0, At, B0); PG8_MMA(0, 1, At, B1); PG8_BAR; PG8_SCHED;
            PG8_LDA(At, 0, 1); PG8_STAGE_B(PG8_SB(0, 0), b2); PG8_STAGE_B(PG8_SB(0, 1), b2 + hstepB); PG8_STAGE_A(PG8_SA(0, 0), a2, k2, 0, nx);
            PG8_WAIT_V(8); PG8_WAIT_L(0);
            if (have_pend) { S.done(pend, lane); have_pend = false; }
            PG8_BAR; PG8_MMA(1, 0, At, B0); PG8_MMA(1, 1, At, B1); PG8_BAR; PG8_SCHED;
            PG8_LDB(B0, 1, 0); PG8_LDB(B1, 1, 1); PG8_SCHED; PG8_LDA(At, 1, 0); PG8_STAGE_A(PG8_SA(0, 1), a2, k2, 1, nx);
            PG8_WAIT_V(8); PG8_WAIT_L(0); PG8_BAR; PG8_MMA(0, 0, At, B0); PG8_MMA(0, 1, At, B1); PG8_BAR; PG8_SCHED;
            PG8_LDA(At, 1, 1); PG8_STAGE_B(PG8_SB(1, 0), b3); PG8_STAGE_B(PG8_SB(1, 1), b3 + hstepB); PG8_STAGE_A(PG8_SA(1, 0), a2, k3, 0, nx);
            PG8_WAIT_V(8); PG8_WAIT_L(0); PG8_BAR; PG8_MMA(1, 0, At, B0); PG8_MMA(1, 1, At, B1); PG8_BAR; PG8_SCHED;
        }
        if (wr == 0) PG8_BAR;
        E(acc, cur, wr, wc, fr, fq);
        pend = cur; have_pend = true;
        if (!has_next) break;
#pragma unroll
        for (int a = 0; a < 2; ++a)
#pragma unroll
            for (int b = 0; b < 2; ++b)
#pragma unroll
                for (int m = 0; m < 4; ++m)
#pragma unroll
                    for (int n = 0; n < 2; ++n) acc[a][b][m][n] = (f32x4){0.f, 0.f, 0.f, 0.f};
        cur = nxt; cA = nA; cB = nB; ++ui;
        if constexpr (GATHER) {
#pragma unroll
            for (int h = 0; h < 2; ++h)
#pragma unroll
                for (int i = 0; i < 2; ++i) voC[h][i] = voN[h][i]; }
        if (wr == 1) PG8_BAR;
    }
    PG8_WAIT_V(0);
    if (have_pend) S.done(pend, lane);
    PG8_BAR;
#undef PG8_SA
#undef PG8_SB
#undef PG8_GLDS
#undef PG8_STAGE_A
#undef PG8_STAGE_B
#undef PG8_LDA
#undef PG8_LDB
#undef PG8_MMA
#undef PG8_WAIT_V
#undef PG8_WAIT_L
#undef PG8_BAR
#undef PG8_SCHED
}
}
#include <hip/hip_bf16.h>
#include <cmath>
namespace attn_body {
using bf16=__hip_bfloat16;
using bf16x8=__attribute__((ext_vector_type(8)))short;
using s16x4=__attribute__((ext_vector_type(4)))short;
using f32x16=__attribute__((ext_vector_type(16)))float;
using u32x4=__attribute__((ext_vector_type(4)))unsigned;
constexpr int D=64,QP=1024,KVP=256;
constexpr int NW=8,QBLK=32,QB=QBLK*NW,KVBLK=64;
__device__ __forceinline__ int crow(int r,int hi){return (r&3)+8*(r>>2)+4*hi;}
#define SBAR() __builtin_amdgcn_sched_barrier(0)
constexpr int NSLOT=3, SLOTB=8192;
constexpr int LDS_K=0, LDS_V=NSLOT*SLOTB, LDS_WS=2*NSLOT*SLOTB, LDS_OST=LDS_WS+NW*64*4, LDS_BYTES=LDS_OST+NW*4096;
constexpr float C2=0.125f*1.4426950408889634f;
__device__ __forceinline__ void glds16s(const void*sbase,unsigned voff,unsigned lds_dst){unsigned keep;
  asm volatile("s_mov_b32 %0, m0\n\ts_mov_b32 m0, %3\n\ts_nop 4\n\tglobal_load_lds_dwordx4 %1, %2\n\ts_mov_b32 m0, %0":"=&s"(keep):"v"(voff),"s"(sbase),"s"(lds_dst):"memory");}
__device__ __forceinline__ float max3f(float a,float b,float c){float r;asm("v_max3_f32 %0, %1, %2, %3":"=v"(r):"v"(a),"v"(b),"v"(c));return r;}
__device__ __forceinline__ float max2f(float a,float b){float r;asm("v_max_f32_e32 %0, %1, %2":"=v"(r):"v"(a),"v"(b));return r;}
__device__ __forceinline__ float fadd_s(float a,float b){float r;asm("v_add_f32_e32 %0, %1, %2":"=v"(r):"v"(a),"v"(b));return r;}
__device__ __forceinline__ float fsub_s(float a,float b){float r;asm("v_sub_f32_e32 %0, %1, %2":"=v"(r):"v"(a),"v"(b));return r;}
typedef float f32x2_t __attribute__((ext_vector_type(2))); typedef __bf16 bf16x2_t __attribute__((ext_vector_type(2)));
__device__ __forceinline__ unsigned cvtpk_s(float lo,float hi){f32x2_t v={lo,hi};bf16x2_t b=__builtin_convertvector(v,bf16x2_t);return __builtin_bit_cast(unsigned,b);}
#define WAIT_BAR(N) asm volatile("s_waitcnt vmcnt(" #N ") lgkmcnt(0)\n\ts_barrier":::"memory")

__device__ __forceinline__ void qkt(f32x16&p0,f32x16&p1,const char*Kslot,const bf16x8*qr,const f32x16&negm,int r32,int hi){
  const char*kb=Kslot+hi*1024+r32*16;
  #pragma unroll
  for(int d0=0;d0<4;++d0){
    const bf16x8 b0=*reinterpret_cast<const bf16x8*>(kb+d0*2048);
    const bf16x8 b1=*reinterpret_cast<const bf16x8*>(kb+d0*2048+512);
    if(d0==0){p0=__builtin_amdgcn_mfma_f32_32x32x16_bf16(b0,qr[0],negm,0,0,0);p1=__builtin_amdgcn_mfma_f32_32x32x16_bf16(b1,qr[0],negm,0,0,0);}
    else{p0=__builtin_amdgcn_mfma_f32_32x32x16_bf16(b0,qr[d0],p0,0,0,0);p1=__builtin_amdgcn_mfma_f32_32x32x16_bf16(b1,qr[d0],p1,0,0,0);}}
}
typedef __attribute__((address_space(3))) const char* lds_cptr;
typedef short v4i16_t __attribute__((ext_vector_type(4)));
__device__ __forceinline__ void kload8(bf16x8*kf,lds_cptr kp){
  kf[0]=*(const __attribute__((address_space(3))) bf16x8*)(kp);      kf[1]=*(const __attribute__((address_space(3))) bf16x8*)(kp+512);
  kf[2]=*(const __attribute__((address_space(3))) bf16x8*)(kp+2048); kf[3]=*(const __attribute__((address_space(3))) bf16x8*)(kp+2560);
  kf[4]=*(const __attribute__((address_space(3))) bf16x8*)(kp+4096); kf[5]=*(const __attribute__((address_space(3))) bf16x8*)(kp+4608);
  kf[6]=*(const __attribute__((address_space(3))) bf16x8*)(kp+6144); kf[7]=*(const __attribute__((address_space(3))) bf16x8*)(kp+6656);
}
__device__ __forceinline__ void kload2(bf16x8*kf,lds_cptr kp,int j){ kf[2*j]=*(const __attribute__((address_space(3))) bf16x8*)(kp+j*2048); kf[2*j+1]=*(const __attribute__((address_space(3))) bf16x8*)(kp+j*2048+512); }
__device__ __forceinline__ s16x4 vtr(lds_cptr p){ return __builtin_bit_cast(s16x4,__builtin_amdgcn_ds_read_tr16_b64_v4i16((__attribute__((address_space(3))) v4i16_t*)p)); }
__device__ __forceinline__ float rowmax(const f32x16&p0,const f32x16&p1){
  float a=max3f(p0[0],p0[1],p1[0]),b=max3f(p0[2],p0[3],p1[1]);a=max3f(a,p1[2],p1[3]);
  #pragma unroll
  for(int r=4;r<16;r+=4){a=max3f(a,p0[r],p0[r+1]);b=max3f(b,p0[r+2],p0[r+3]);a=max3f(a,p1[r],p1[r+1]);b=max3f(b,p1[r+2],p1[r+3]);}
  const float m=max2f(a,b);
  auto rr=__builtin_amdgcn_permlane32_swap(__float_as_uint(m),__float_as_uint(m),false,false);
  return max2f(__uint_as_float(rr[0]),__uint_as_float(rr[1]));
}
__device__ __forceinline__ void pv(f32x16*o,int vb,bf16x8 pa0,bf16x8 pa1,bf16x8 pa2,bf16x8 pa3){
  #pragma unroll
  for(int d0=0;d0<2;++d0){s16x4 lo[4],hi[4];
    #pragma unroll
    for(int ks=0;ks<4;++ks){
      asm volatile("ds_read_b64_tr_b16 %0,%1 offset:%c2":"=&v"(lo[ks]):"v"(vb),"i"(d0*4096+ks*1024):"memory");
      asm volatile("ds_read_b64_tr_b16 %0,%1 offset:%c2":"=&v"(hi[ks]):"v"(vb),"i"(d0*4096+ks*1024+512):"memory");}
    asm volatile("s_waitcnt lgkmcnt(0)":::"memory");SBAR();
    #define PK(k) (bf16x8){lo[k][0],lo[k][1],lo[k][2],lo[k][3],hi[k][0],hi[k][1],hi[k][2],hi[k][3]}
    o[d0]=__builtin_amdgcn_mfma_f32_32x32x16_bf16(pa0,PK(0),o[d0],0,0,0);
    o[d0]=__builtin_amdgcn_mfma_f32_32x32x16_bf16(pa1,PK(1),o[d0],0,0,0);
    o[d0]=__builtin_amdgcn_mfma_f32_32x32x16_bf16(pa2,PK(2),o[d0],0,0,0);
    o[d0]=__builtin_amdgcn_mfma_f32_32x32x16_bf16(pa3,PK(3),o[d0],0,0,0);
    #undef PK
  }
}

#ifndef ATTN_STORE16
#define ATTN_STORE16(p,v) (*(u32x4*)(p)=(v))
#endif
template<int THRL> __device__ __forceinline__ void attn_unit(long qrow0,int h,long kvrow0,int NT,const bf16*Q,const bf16*__restrict__ K,const bf16*__restrict__ V,bf16*O,char*shm){
  const int tid=tid_opaque(),lane=tid&63,r32=lane&31,hi=lane>>5; const int wid=__builtin_amdgcn_readfirstlane(tid>>6);
  const bf16*Qw=Q+(qrow0+wid*QBLK)*QP+h*D;
  const bf16*Kh=K+kvrow0*KVP+(h>>2)*D,*Vh=V+kvrow0*KVP+(h>>2)*D;
  const unsigned lds0=(unsigned)(uintptr_t)shm;
  float*wsf=(float*)(shm+LDS_WS)+wid*64;
  const unsigned kvo=(unsigned)(lane*KVP+wid*8)*2u;
  const unsigned vvo=(unsigned)((16*(wid&3)+(lane>>2))*KVP+(wid>>2)*32+(lane&3)*8)*2u;
  const unsigned kdst=lds0+LDS_K+wid*1024, vdst=lds0+LDS_V+wid*1024;
  #define DMA_K(t,slot) glds16s(Kh+(long)(t)*KVBLK*KVP,kvo,(unsigned)__builtin_amdgcn_readfirstlane(kdst+(slot)))
  #define DMA_V(t,slot) glds16s(Vh+(long)(t)*KVBLK*KVP,vvo,(unsigned)__builtin_amdgcn_readfirstlane(vdst+(slot)))
  const int vb0=(int)(lds0+LDS_V)+((lane>>4)&1)*32+(lane&3)*8+(4*hi+((lane&15)>>2))*64;
  const char*Kbase=shm+LDS_K; bf16x8 kf[8];
  const lds_cptr shm3=(lds_cptr)shm; const lds_cptr kp0=shm3+LDS_K+hi*1024+r32*16; const lds_cptr vp0=shm3+LDS_V+((lane>>4)&1)*32+(lane&3)*8+(4*hi+((lane&15)>>2))*64;
  DMA_K(0,0);DMA_V(0,0);DMA_K(1,SLOTB);
  bf16x8 qr[4];
  #pragma unroll
  for(int d0=0;d0<4;++d0)qr[d0]=*reinterpret_cast<const bf16x8*>(&Qw[(long)r32*QP+d0*16+hi*8]);
  float mhat=0.f,l_reg=0.f;f32x16 o[2];o[0]=f32x16{};o[1]=f32x16{};f32x16 negm=f32x16{};asm volatile("":"+v"(negm));
  #define CMASK(P0,P1,t) do{}while(0)
  bool resc=false;
  #define START(P0,P1) do{ const float rm=rowmax(P0,P1); resc=false; \
    { const float dl=rm; mhat=fadd_s(mhat,dl); \
      _Pragma("unroll") for(int r=0;r<16;++r){P0[r]=fsub_s(P0[r],dl);P1[r]=fsub_s(P1[r],dl);} \
      _Pragma("unroll") for(int r=0;r<16;++r)negm[r]=-mhat; asm volatile("":"+v"(negm)); } \
    _Pragma("unroll") for(int r=0;r<16;++r)P0[r]=__builtin_amdgcn_exp2f(P0[r]); }while(0)
  #define RESC() do{ if(resc){ asm volatile("s_waitcnt lgkmcnt(0)":::"memory"); \
      _Pragma("unroll") for(int d_=0;d_<2;++d_) _Pragma("unroll") for(int r=0;r<16;++r)o[d_][r]*=wsf[crow(r,hi)]; } }while(0)
  f32x16 pA0,pA1,pB0,pB1;
  int sl_prev=0,sl_cur=0,sl_next=SLOTB;
  #define ROT() do{sl_prev=sl_cur;sl_cur=sl_next;sl_next=(sl_next==(NSLOT-1)*SLOTB)?0:sl_next+SLOTB;}while(0)
  DMA_K(2,2*SLOTB);
  WAIT_BAR(3);
  qkt(pA0,pA1,Kbase,qr,negm,r32,hi);asm volatile("s_nop 15\n\ts_nop 7":"+v"(pA0),"+v"(pA1));CMASK(pA0,pA1,0);
  START(pA0,pA1);
  _Pragma("unroll") for(int r=0;r<16;++r)pA1[r]=__builtin_amdgcn_exp2f(pA1[r]);
  WAIT_BAR(0);
  DMA_K(3,0);DMA_V(1,SLOTB);
  ROT();
  kload8(kf,kp0+sl_cur);
  WAIT_BAR(2);
  s16x4 vlo[8],vhi[8]; u32x4 pw0,pw1,pw2,pw3;
  #define PKW(P,B) cvtpk_s(P[B],P[B+1])
  #define PAF(k) __builtin_bit_cast(bf16x8,pw##k)
  #define VFR(i) (bf16x8){vlo[i][0],vlo[i][1],vlo[i][2],vlo[i][3],vhi[i][0],vhi[i][1],vhi[i][2],vhi[i][3]}
  #define PIN(x) asm volatile("":"+v"(x))
  #define MX3(a,b,c) __builtin_fmaxf(__builtin_fmaxf((a),(b)),(c))
  #define GAPA(MF,A0,A1,A2,A3,W0,W1,PW) do{ MF; sacc+=A0; sacc+=A1; sacc+=A2; sacc+=A3; PIN(sacc); W0; W1; PIN(PW); SBAR(); }while(0)
  #define EX(v) __builtin_amdgcn_exp2f(v)
  #define GAPB(MF,X,B) do{ MF; X[B]=EX(X[B]); X[B+1]=EX(X[B+1]); X[B+2]=EX(X[B+2]); X[B+3]=EX(X[B+3]); PIN(X); SBAR(); }while(0)
  #define VRD(i) do{ vlo[i]=vtr(vp_+(((i)>>2)*4096+((i)&3)*1024)); vhi[i]=vtr(vp_+(((i)>>2)*4096+((i)&3)*1024+512)); }while(0)
  #define KRD(G,j) do{ if(G){ kload2(kf,kp0+sl_next,j); SBAR(); } }while(0)
  #define STEP(C0,C1,P0,P1,t,GK,GV,GL) do{ SBAR(); \
    const lds_cptr vp_=vp0+sl_prev; \
    VRD(0); SBAR(); float sacc=(P0[0]+P0[1]); \
    GAPA(C0=__builtin_amdgcn_mfma_f32_32x32x16_bf16(kf[0],qr[0],negm,0,0,0), P0[2],P0[3],P0[4],P0[5],     pw0[0]=PKW(P0,0), pw0[1]=PKW(P0,2), pw0); \
    VRD(4); SBAR(); GAPA(C1=__builtin_amdgcn_mfma_f32_32x32x16_bf16(kf[1],qr[0],negm,0,0,0), P0[6],P0[7],P0[8],P0[9],     pw0[2]=PKW(P0,4), pw0[3]=PKW(P0,6), pw0); \
    VRD(1); SBAR(); GAPA(C0=__builtin_amdgcn_mfma_f32_32x32x16_bf16(kf[2],qr[1],C0,0,0,0),   P0[10],P0[11],P0[12],P0[13], pw1[0]=PKW(P0,8), pw1[1]=PKW(P0,10), pw1); \
    VRD(5); SBAR(); GAPA(C1=__builtin_amdgcn_mfma_f32_32x32x16_bf16(kf[3],qr[1],C1,0,0,0),   P0[14],P0[15],P1[0],P1[1],   pw1[2]=PKW(P0,12),pw1[3]=PKW(P0,14), pw1); \
    VRD(2); SBAR(); GAPA(C0=__builtin_amdgcn_mfma_f32_32x32x16_bf16(kf[4],qr[2],C0,0,0,0),   P1[2],P1[3],P1[4],P1[5],     pw2[0]=PKW(P1,0), pw2[1]=PKW(P1,2), pw2); \
    VRD(6); SBAR(); GAPA(C1=__builtin_amdgcn_mfma_f32_32x32x16_bf16(kf[5],qr[2],C1,0,0,0),   P1[6],P1[7],P1[8],P1[9],     pw2[2]=PKW(P1,4), pw2[3]=PKW(P1,6), pw2); \
    VRD(3); SBAR(); GAPA(C0=__builtin_amdgcn_mfma_f32_32x32x16_bf16(kf[6],qr[3],C0,0,0,0),   P1[10],P1[11],P1[12],P1[13], pw3[0]=PKW(P1,8), pw3[1]=PKW(P1,10), pw3); \
    VRD(7); SBAR(); GAPA(C1=__builtin_amdgcn_mfma_f32_32x32x16_bf16(kf[7],qr[3],C1,0,0,0),   P1[14],P1[15],0.f,0.f,       pw3[2]=PKW(P1,12),pw3[3]=PKW(P1,14), pw3); \
    l_reg+=sacc; \
    if(GK){DMA_K((t)+3,sl_cur);} if(GV){DMA_V((t)+1,sl_next);} \
    CMASK(C0,C1,t); \
    { float a=MX3(C0[0],C0[1],C1[0]),b=MX3(C0[2],C0[3],C1[1]); a=MX3(a,C1[2],C1[3]); \
      _Pragma("unroll") for(int r=4;r<16;r+=4){a=MX3(a,C0[r],C0[r+1]);b=MX3(b,C0[r+2],C0[r+3]);a=MX3(a,C1[r],C1[r+1]);b=MX3(b,C1[r+2],C1[r+3]);} \
      float rm=__builtin_fmaxf(a,b); { auto rr=__builtin_amdgcn_permlane32_swap(__float_as_uint(rm),__float_as_uint(rm),false,false); rm=__builtin_fmaxf(__uint_as_float(rr[0]),__uint_as_float(rr[1])); } \
      resc=false; \
      if(__builtin_expect(__any(rm>(float)THRL),0)){ const float dl=__builtin_fmaxf(rm,0.f); mhat+=dl; \
        _Pragma("unroll") for(int r=0;r<16;++r){C0[r]-=dl;C1[r]-=dl;} \
        _Pragma("unroll") for(int r=0;r<16;++r)negm[r]=-mhat; asm volatile("":"+v"(negm)); \
        const float f=__builtin_amdgcn_exp2f(-dl); l_reg*=f; if(hi==0)wsf[r32]=f; resc=true; } } \
    SBAR(); \
    GAPB(o[0]=__builtin_amdgcn_mfma_f32_32x32x16_bf16(PAF(0),VFR(0),o[0],0,0,0), C0,0); \
    GAPB(o[1]=__builtin_amdgcn_mfma_f32_32x32x16_bf16(PAF(0),VFR(4),o[1],0,0,0), C0,4); \
    KRD(GL,0); GAPB(o[0]=__builtin_amdgcn_mfma_f32_32x32x16_bf16(PAF(1),VFR(1),o[0],0,0,0), C0,8); \
    KRD(GL,1); GAPB(o[1]=__builtin_amdgcn_mfma_f32_32x32x16_bf16(PAF(1),VFR(5),o[1],0,0,0), C0,12); \
    KRD(GL,2); GAPB(o[0]=__builtin_amdgcn_mfma_f32_32x32x16_bf16(PAF(2),VFR(2),o[0],0,0,0), C1,0); \
    KRD(GL,3); GAPB(o[1]=__builtin_amdgcn_mfma_f32_32x32x16_bf16(PAF(2),VFR(6),o[1],0,0,0), C1,4); \
    GAPB(o[0]=__builtin_amdgcn_mfma_f32_32x32x16_bf16(PAF(3),VFR(3),o[0],0,0,0), C1,8); \
    GAPB(o[1]=__builtin_amdgcn_mfma_f32_32x32x16_bf16(PAF(3),VFR(7),o[1],0,0,0), C1,12); \
    }while(0)
  int t=1;
  for(;t+5<NT;t+=2){
    STEP(pB0,pB1,pA0,pA1,t,true,true,true);     WAIT_BAR(2); RESC(); ROT();
    STEP(pA0,pA1,pB0,pB1,t+1,true,true,true);   WAIT_BAR(2); RESC(); ROT();
  }
  #define ENDW(tt) do{ if((tt)+3<NT){WAIT_BAR(2);} else if((tt)+2<NT){WAIT_BAR(1);} else {WAIT_BAR(0);} }while(0)
  for(;t+1<NT;t+=2){
    STEP(pB0,pB1,pA0,pA1,t,(t+3<NT),(t+1<NT),(t+1<NT));       ENDW(t);   RESC(); ROT();
    STEP(pA0,pA1,pB0,pB1,t+1,(t+4<NT),(t+2<NT),(t+2<NT));     ENDW(t+1); RESC(); ROT();
  }
  STEP(pB0,pB1,pA0,pA1,NT-1,false,false,false); RESC();
  { float sacc=pB0[0]+pB0[1]; _Pragma("unroll") for(int r=2;r<16;++r)sacc+=pB0[r]; _Pragma("unroll") for(int r=0;r<16;++r)sacc+=pB1[r]; l_reg+=sacc;
    pw0=(u32x4){PKW(pB0,0),PKW(pB0,2),PKW(pB0,4),PKW(pB0,6)};pw1=(u32x4){PKW(pB0,8),PKW(pB0,10),PKW(pB0,12),PKW(pB0,14)};pw2=(u32x4){PKW(pB1,0),PKW(pB1,2),PKW(pB1,4),PKW(pB1,6)};pw3=(u32x4){PKW(pB1,8),PKW(pB1,10),PKW(pB1,12),PKW(pB1,14)};
    SBAR(); pv(o,vb0+sl_cur,PAF(0),PAF(1),PAF(2),PAF(3)); }
  #undef PKW
  #undef PAF
  #undef VFR
  #undef PIN
  #undef MX3
  #undef GAPA
  #undef GAPB
  #undef EX
  #undef VRD
  #undef KRD
  #undef STEP
  #undef ENDW
  {auto rr=__builtin_amdgcn_permlane32_swap(__float_as_uint(l_reg),__float_as_uint(l_reg),false,false);l_reg=__uint_as_float(rr[0])+__uint_as_float(rr[1]);}
  if(hi==0)wsf[32+r32]=l_reg;asm volatile("s_waitcnt lgkmcnt(0)":::"memory");
  float rli[16];
  #pragma unroll
  for(int r=0;r<16;++r)rli[r]=__builtin_amdgcn_rcpf(wsf[32+crow(r,hi)]);
  bf16*Ow=O+(qrow0+wid*QBLK)*QP+h*D;
  { bf16*stg=(bf16*)(shm+LDS_OST)+wid*2048;
    #pragma unroll
    for(int r=0;r<16;++r){const int orow=crow(r,hi);
      #pragma unroll
      for(int d0=0;d0<2;++d0)stg[orow*64+d0*32+r32]=__float2bfloat16(o[d0][r]*rli[r]);}
    asm volatile("s_waitcnt lgkmcnt(0)":::"memory");
    #pragma unroll
    for(int i=0;i<4;++i){const int row=i*8+(lane>>3),ch=lane&7; const u32x4 v=*(const u32x4*)(stg+row*64+ch*8); ATTN_STORE16(Ow+(long)row*QP+ch*8,v);} }
  asm volatile("s_waitcnt lgkmcnt(0)\n\ts_barrier":::"memory");
  #undef DMA_K
  #undef DMA_V
  #undef CMASK
  #undef START
  #undef RESC
  #undef ROT
}
constexpr int ATTN_LDS_BYTES=LDS_BYTES;
#undef SBAR
#undef WAIT_BAR
}

typedef f32x4 AccT[2][2][4][2];
__device__ __forceinline__ long kv_row(int r) { return r < TL ? (long)(r / SEQ) * KVROWS + CTXL + (r % SEQ) : (long)((r - TL) / CTXL) * KVROWS + ((r - TL) % CTXL); }

struct SchedDense {
    const char* A; const char* B; size_t astep, bstep, acol; int nM, nN, G, c;
    __device__ __forceinline__ bool next(int i, pg8::Unit& u) const {
        const int L = i * G + c; if (L >= nM * nN) return false;
        pg8::tile_of(L, nM, nN, u.pm, u.pn); u.A = A + (size_t)u.pm * astep + (size_t)u.pn * acol; u.B = B + (size_t)u.pn * bstep; u.x0 = 0; u.x1 = 0; return true; }
    __device__ __forceinline__ int gather(const pg8::Unit&, int) const { return 0; }
    __device__ __forceinline__ void a_ready(const pg8::Unit&, int) const {}
    __device__ __forceinline__ void done(const pg8::Unit&, int) const {}
};
struct SchedQKV {
    const char* A; const char* B; int ctxq, G, c;
    __device__ __forceinline__ bool next(int i, pg8::Unit& u) const {
        const int L = i * G + c, n1 = 64 * 6, n2 = ctxq ? 24 : 8; if (L >= n1 + n2) return false;
        if (L < n1) pg8::tile_of(L, 64, 6, u.pm, u.pn);
        else if (ctxq) { pg8::tile_of(L - n1, 4, 6, u.pm, u.pn); u.pm += 64; }
        else { u.pm = 64 + ((L - n1) >> 1); u.pn = 4 + ((L - n1) & 1); }
        u.A = A + (size_t)u.pm * (256 * 1024 * 2); u.B = B + (size_t)u.pn * (256 * 1024 * 2); u.x0 = 0; u.x1 = 0; return true; }
    __device__ __forceinline__ int gather(const pg8::Unit&, int) const { return 0; }
    __device__ __forceinline__ void a_ready(const pg8::Unit&, int) const {}
    __device__ __forceinline__ void done(const pg8::Unit&, int) const {}
};
struct SchedMoe {
    const char* Abase; size_t astep; const char* Bbase; size_t bstep_e, bstep_n; const LAS int* tab; const int* list; int G, c;
    unsigned* ready; int mode;
    __device__ __forceinline__ int T(int i) const { return __builtin_amdgcn_readfirstlane(tab[i]); }
    __device__ __forceinline__ bool next(int i, pg8::Unit& u) const {
        const int ntiles = T(32), L = i * G + (mode == 2 ? G - 1 - c : c); if (L >= ntiles * 4) return false;
        int gt, pn; pg8::tile_of(L, ntiles, 4, gt, pn);
        int e = 0;
        for (int q = 1; q < 32; ++q) e += (T(q) <= gt) ? 1 : 0;
        const int ti = gt - T(e); int valid = T(40 + e) - ti * 256; valid = valid > 256 ? 256 : valid;
        u.pm = gt; u.pn = pn; u.x0 = e * MOE_CAP + ti * 256; u.x1 = valid;
        u.A = Abase + (size_t)gt * astep; u.B = Bbase + (size_t)e * bstep_e + (size_t)pn * bstep_n; return true; }
    __device__ __forceinline__ int gather(const pg8::Unit& u, int lr) const { return lr < u.x1 ? (list[u.x0 + lr] >> 1) : 0; }
    __device__ __forceinline__ void a_ready(const pg8::Unit& u, int wid) const {
        if (mode != 2) return;
        if (wid == 0) { unsigned sp = 0;
            while ((unsigned)__builtin_amdgcn_readfirstlane(__hip_atomic_load(ready + u.pm, __ATOMIC_RELAXED, __HIP_MEMORY_SCOPE_AGENT)) < 32u) { __builtin_amdgcn_s_sleep(2); if (++sp > (1u << 22)) break; }
            __builtin_amdgcn_fence(__ATOMIC_ACQUIRE, "agent"); asm volatile("s_waitcnt vmcnt(0)" ::: "memory"); }
        __builtin_amdgcn_s_barrier(); asm volatile("" ::: "memory");
    }
    __device__ __forceinline__ void done(const pg8::Unit& u, int lane) const {
        if (mode != 1) return;
        if (lane == 0) __hip_atomic_fetch_add(ready + u.pm, 1u, __ATOMIC_RELAXED, __HIP_MEMORY_SCOPE_AGENT);
    }
};

struct EpiQKV { static constexpr bool PERM = true; bf16* Q; bf16* Kb; bf16* Vb; const float* qg; const float* kg; const f32x2* tab;
    __device__ __forceinline__ void operator()(const AccT& acc, const pg8::Unit& u, int wr, int wc, int fr, int fq) const {
        bf16* base; int pitch; long row0;
        if (u.pn < 4) { base = Q + u.pn * 256; pitch = 1024; row0 = (long)u.pm * 256; }
        else { base = (u.pn == 4) ? Kb : Vb; pitch = 256; row0 = kv_row(u.pm * 256); }
        const bool isv = u.pn == 5, lat = u.pm < 64; const float* g = u.pn < 4 ? qg : kg; const float post = u.pn < 4 ? 0.125f * 1.4426950408889634f : 1.0f;
#pragma unroll
        for (int ai = 0; ai < 2; ++ai)
#pragma unroll
            for (int m = 0; m < 4; ++m) { int fq_ = fq; asm volatile("" : "+v"(fq_));
                const int fq = fq_; const int lr = ai * 128 + wr * 64 + m * 16 + fr; const unsigned roff = (unsigned)(((int)row0 + lr) * pitch + wc * 64 + 8 * fq) * 2u;
                f32x4 g0[2], g1[2];
#pragma unroll
                for (int bj = 0; bj < 2; ++bj) { g0[bj] = *(const f32x4*)(g + 32 * bj + 8 * fq); g1[bj] = *(const f32x4*)(g + 32 * bj + 8 * fq + 4); }
                f32x4 v[2][2];
#pragma unroll
                for (int bj = 0; bj < 2; ++bj) { v[bj][0] = acc[ai][bj][m][0]; v[bj][1] = acc[ai][bj][m][1]; }
                if (!isv) {
                    float ss = 0.f;
#pragma unroll
                    for (int bj = 0; bj < 2; ++bj)
#pragma unroll
                        for (int n = 0; n < 2; ++n) ss += (v[bj][n][0] * v[bj][n][0] + v[bj][n][1] * v[bj][n][1]) + (v[bj][n][2] * v[bj][n][2] + v[bj][n][3] * v[bj][n][3]);
                    ss += __shfl_xor(ss, 16); ss += __shfl_xor(ss, 32);
                    const float rstd = rsqrtf(ss * (1.0f / 64.0f) + EPS);
#pragma unroll
                    for (int bj = 0; bj < 2; ++bj) { v[bj][0] = v[bj][0] * rstd * g0[bj]; v[bj][1] = v[bj][1] * rstd * g1[bj]; }
                    if (lat) { const int t = (u.pm * 256 + lr) & (SEQ - 1);
#pragma unroll
                        for (int bj = 0; bj < 2; ++bj) { const f32x2* tb = (const f32x2*)((const char*)tab + (unsigned)(((bj == 0 ? (t >> 6) : (t & 63)) * 16 + 4 * fq) * 8));
#pragma unroll
                            for (int n = 0; n < 2; ++n)
#pragma unroll
                                for (int e = 0; e < 2; ++e) { const f32x2 cs = tb[2 * n + e]; const float x0 = v[bj][n][2 * e], x1 = v[bj][n][2 * e + 1];
                                    v[bj][n][2 * e] = x0 * cs.x - x1 * cs.y; v[bj][n][2 * e + 1] = x0 * cs.y + x1 * cs.x; } } }
#pragma unroll
                    for (int bj = 0; bj < 2; ++bj) { v[bj][0] = v[bj][0] * post; v[bj][1] = v[bj][1] * post; }
                }
#pragma unroll
                for (int bj = 0; bj < 2; ++bj)
                    *(u32x4*)((char*)base + roff + bj * 64) = (u32x4){cvtpk(v[bj][0][0], v[bj][0][1]), cvtpk(v[bj][0][2], v[bj][0][3]), cvtpk(v[bj][1][0], v[bj][1][1]), cvtpk(v[bj][1][2], v[bj][1][3])}; }
    }
};
struct EpiResid { static constexpr bool PERM = false; const Args* a; int layer; const float* pscale; const float* srcbase;
    __device__ __forceinline__ void operator()(const AccT& acc, const pg8::Unit& u, int wr, int wc, int fr, int fq) const {
        const int r0 = u.pm * 256;
        const float* src = srcbase ? srcbase + (size_t)r0 * D : resid_row(*a, layer, r0); const float* gate = mod_row(*a, layer, r0) + 2 * D; float* out = (float*)(a->ws + WS_X) + (size_t)r0 * D;
        const int col0 = u.pn * 256 + wc * 32 + 4 * fq;
#pragma unroll
        for (int bj = 0; bj < 2; ++bj)
#pragma unroll
            for (int n = 0; n < 2; ++n) { const int cc = col0 + bj * 128 + n * 16; f32x4 g = *(const f32x4*)(gate + cc); if (pscale) g = g * *(const f32x4*)(pscale + cc);
#pragma unroll
                for (int ai = 0; ai < 2; ++ai)
#pragma unroll
                    for (int m = 0; m < 4; ++m) { const size_t off = (size_t)(ai * 128 + wr * 64 + m * 16 + fr) * D + cc;
                        *(f32x4*)(out + off) = *(const f32x4*)(src + off) + g * acc[ai][bj][m][n]; } }
    }
};
struct EpiGateUp { static constexpr bool PERM = true; bf16* act;
    __device__ __forceinline__ void operator()(const AccT& acc, const pg8::Unit& u, int wr, int wc, int fr, int fq) const {
        const __amdgpu_buffer_rsrc_t rs = __builtin_amdgcn_make_buffer_rsrc((void*)act, 0, 43008 * 512 * 2, 0x00020000);
#pragma unroll
        for (int ai = 0; ai < 2; ++ai)
#pragma unroll
            for (int m = 0; m < 4; ++m) { const int off = (int)((((size_t)u.pm * 256 + ai * 128 + wr * 64 + m * 16 + fr) * 512 + u.pn * 128 + wc * 32 + 8 * fq) * 2);
                const f32x4 g0 = acc[ai][0][m][0], g1 = acc[ai][0][m][1], u0 = acc[ai][1][m][0], u1 = acc[ai][1][m][1];
                const u32x4 ov = (u32x4){cvtpk(silu_f(g0[0]) * u0[0], silu_f(g0[1]) * u0[1]), cvtpk(silu_f(g0[2]) * u0[2], silu_f(g0[3]) * u0[3]),
                                     cvtpk(silu_f(g1[0]) * u1[0], silu_f(g1[1]) * u1[1]), cvtpk(silu_f(g1[2]) * u1[2], silu_f(g1[3]) * u1[3])};
                __builtin_amdgcn_raw_buffer_store_b128(ov, rs, off, 0, 16  ); }
    }
};
struct EpiDown { static constexpr bool PERM = true; const int* list; const float* w2; bf16* y2;
    __device__ __forceinline__ void operator()(const AccT& acc, const pg8::Unit& u, int wr, int wc, int fr, int fq) const {
#pragma unroll
        for (int ai = 0; ai < 2; ++ai)
#pragma unroll
            for (int m = 0; m < 4; ++m) { const int lr = ai * 128 + wr * 64 + m * 16 + fr;
                if (lr < u.x1) { const int dest = list[u.x0 + lr]; const float w = w2[dest]; bf16* p = y2 + (size_t)dest * D + u.pn * 256 + wc * 32 + 8 * fq;
#pragma unroll
                    for (int bj = 0; bj < 2; ++bj) { const f32x4 v0 = acc[ai][bj][m][0] * w, v1 = acc[ai][bj][m][1] * w;
                        *(u32x4*)(p + bj * 128) = (u32x4){cvtpk(v0[0], v0[1]), cvtpk(v0[2], v0[3]), cvtpk(v1[0], v1[1]), cvtpk(v1[2], v1[3])}; } } }
    }
};

constexpr int TAB_OFF = 135168;

__device__ __forceinline__ void ph_rope(const Args& a, const Ctx& c, int layer) {
    const int j = layer == 0 ? 0 : 1; const bool ctxq = layer == 0;
    const float* qg = a.in[I_QG] + j * 64; const float* kg = a.in[I_KG] + j * 64;
    const f32x2* tab = (const f32x2*)(a.ws + WS_ROPE);
    bf16* Qb = (bf16*)(a.ws + WS_Q); bf16* Kb = (bf16*)(a.ws + WS_K);
    const int nitems = TT * 20;
    for (int it = blockIdx.x * NTHREADS + c.tid; it < nitems; it += c.G * NTHREADS) {
        const int r = it / 20, hs = it % 20;
        if (hs < 16 && r >= TL && !ctxq) continue;
        bf16* p; const float* g; float post;
        if (hs < 16) { p = Qb + (size_t)r * 1024 + hs * 64; g = qg; post = 0.125f * 1.4426950408889634f; } else { p = Kb + kv_row(r) * 256 + (hs - 16) * 64; g = kg; post = 1.0f; }
        float x[64]; float ss = 0.f;
#pragma unroll
        for (int i = 0; i < 8; ++i) { const u32x4 w = ((const u32x4*)p)[i];
            x[8 * i + 0] = bflo(w.x); x[8 * i + 1] = bfhi(w.x); x[8 * i + 2] = bflo(w.y); x[8 * i + 3] = bfhi(w.y);
            x[8 * i + 4] = bflo(w.z); x[8 * i + 5] = bfhi(w.z); x[8 * i + 6] = bflo(w.w); x[8 * i + 7] = bfhi(w.w); }
#pragma unroll
        for (int i = 0; i < 64; ++i) ss += x[i] * x[i];
        const float rstd = rsqrtf(ss * (1.0f / 64.0f) + EPS);
#pragma unroll
        for (int i = 0; i < 64; ++i) x[i] = x[i] * rstd * g[i];
        if (r < TL) { const int t = r % SEQ, rp = t >> 6, cp = t & 63;
#pragma unroll
            for (int i = 0; i < 32; ++i) { const f32x2 cs = tab[(i < 16 ? rp : cp) * 16 + (i & 15)]; const float x0 = x[2 * i], x1 = x[2 * i + 1];
                x[2 * i] = x0 * cs.x - x1 * cs.y; x[2 * i + 1] = x0 * cs.y + x1 * cs.x; } }
#pragma unroll
        for (int i = 0; i < 8; ++i) ((u32x4*)p)[i] = (u32x4){cvtpk(x[8 * i] * post, x[8 * i + 1] * post), cvtpk(x[8 * i + 2] * post, x[8 * i + 3] * post),
                                                            cvtpk(x[8 * i + 4] * post, x[8 * i + 5] * post), cvtpk(x[8 * i + 6] * post, x[8 * i + 7] * post)};
    }
}

__device__ __forceinline__ void ph_att(const Args& a, const Ctx& c, int layer, char* lds_generic) {
    const int nun = 1024 + (layer == 0 ? 64 : 0);
    const attn_body::bf16* Qb = (const attn_body::bf16*)(a.ws + WS_Q); const attn_body::bf16* Kb = (const attn_body::bf16*)(a.ws + WS_K); const attn_body::bf16* Vb = (const attn_body::bf16*)(a.ws + WS_V);
    for (int U = c.vcu; U < nun; U += c.G) {
        long qrow0, kv0; int h, NT;
        if (U < 1024) { const int bh = U >> 4, qb = U & 15, b = bh >> 4; h = bh & 15; qrow0 = (long)b * SEQ + qb * 256; kv0 = (long)b * KVROWS; NT = KVROWS / 64; }
        else { const int q = U - 1024, b = q >> 4; h = q & 15; qrow0 = (long)TL + b * CTXL; kv0 = (long)b * KVROWS; NT = CTXL / 64; }
        attn_body::attn_unit<8>(qrow0, h, kv0, NT, Qb, Kb, Vb, (attn_body::bf16*)(a.ws + WS_HB), lds_generic);
    }
}

__device__ __forceinline__ void ph_m1(const Args& a, const Ctx& c, int layer) {
    const int Tm = layer == 3 ? TL : TT, ntiles = Tm / 32;
    const float* g = a.in[I_NFFN] + layer * D;
    constexpr int RP = 2064;
    LAS unsigned char* hiT = c.lds; LAS unsigned char* loT = c.lds + 32 * RP;
    LAS float* part = (LAS float*)c.lds;
    LAS float* logit = (LAS float*)(c.lds + 65536);
    LAS int* lcnt = (LAS int*)(c.lds + 133120); LAS int* lbase = lcnt + 32;
    const bf16* wr = (const bf16*)(a.ws + WS_WR) + (size_t)layer * 2 * 65536;
    unsigned* gcnt = (unsigned*)(a.ws + WS_CTL) + CW_CNT + layer * 32;
    int* list = (int*)(a.ws + WS_LIST); float* w2 = (float*)(a.ws + WS_W2);
    const int r32 = c.lane & 31, hi = c.lane >> 5;
    for (int tile = blockIdx.x; tile < ntiles; tile += c.G) {
        const int r0 = tile * 32;
        if (c.tid < 32) lcnt[c.tid] = 0;
#pragma unroll 1
        for (int i = 0; i < 4; ++i) { const int lr = 4 * c.wave + i, r = r0 + lr;
            f32x4 v[4], h[4]; const f32x4* xr = (const f32x4*)((const float*)(a.ws + WS_X) + (size_t)r * D) + c.lane;
#pragma unroll
            for (int j = 0; j < 4; ++j) v[j] = xr[64 * j];
            const float rstd = row_rstd(v); const float* m = mod_row(a, layer, r);
            norm_mod(v, rstd, g, m + 3 * D, m + 4 * D, c.lane, h);
            u32x2* to = (u32x2*)((bf16*)(a.ws + WS_TK) + (size_t)r * D) + c.lane;
#pragma unroll
            for (int j = 0; j < 4; ++j) { const unsigned h0 = cvtpk(h[j].x, h[j].y), h1 = cvtpk(h[j].z, h[j].w);
                const unsigned l0 = cvtpk(h[j].x - bflo(h0), h[j].y - bfhi(h0)), l1 = cvtpk(h[j].z - bflo(h1), h[j].w - bfhi(h1));
                to[64 * j] = (u32x2){h0, h1};
                *(LAS u32x2*)(hiT + lr * RP + (4 * c.lane + 256 * j) * 2) = (u32x2){h0, h1};
                *(LAS u32x2*)(loT + lr * RP + (4 * c.lane + 256 * j) * 2) = (u32x2){l0, l1}; } }
        __syncthreads();
        f32x16 acc0 = {}, acc1 = {};
#pragma unroll 2
        for (int kk = 0; kk < 8; ++kk) { const int k0 = 128 * c.wave + 16 * kk + 8 * hi;
            const bf16x8 ahi = *(const LAS bf16x8*)(hiT + r32 * RP + k0 * 2), alo = *(const LAS bf16x8*)(loT + r32 * RP + k0 * 2);
            const bf16x8 b0h = *(const bf16x8*)(wr + r32 * 1024 + k0), b1h = *(const bf16x8*)(wr + (32 + r32) * 1024 + k0);
            const bf16x8 b0l = *(const bf16x8*)(wr + 65536 + r32 * 1024 + k0), b1l = *(const bf16x8*)(wr + 65536 + (32 + r32) * 1024 + k0);
            acc0 = __builtin_amdgcn_mfma_f32_32x32x16_bf16(ahi, b0h, acc0, 0, 0, 0); acc1 = __builtin_amdgcn_mfma_f32_32x32x16_bf16(ahi, b1h, acc1, 0, 0, 0);
            acc0 = __builtin_amdgcn_mfma_f32_32x32x16_bf16(alo, b0h, acc0, 0, 0, 0); acc1 = __builtin_amdgcn_mfma_f32_32x32x16_bf16(alo, b1h, acc1, 0, 0, 0);
            acc0 = __builtin_amdgcn_mfma_f32_32x32x16_bf16(ahi, b0l, acc0, 0, 0, 0); acc1 = __builtin_amdgcn_mfma_f32_32x32x16_bf16(ahi, b1l, acc1, 0, 0, 0); }
        __syncthreads();
#pragma unroll
        for (int reg = 0; reg < 16; ++reg) { part[((c.wave * 2 + 0) * 16 + reg) * 64 + c.lane] = acc0[reg]; part[((c.wave * 2 + 1) * 16 + reg) * 64 + c.lane] = acc1[reg]; }
        __syncthreads();
#pragma unroll
        for (int q = 0; q < 4; ++q) { const int idx = c.tid + 512 * q, nt = idx >> 10, reg = (idx >> 6) & 15, ln = idx & 63; float s = 0.f;
#pragma unroll
            for (int w = 0; w < 8; ++w) s += part[((w * 2 + nt) * 16 + reg) * 64 + ln];
            logit[((reg & 3) + 8 * (reg >> 2) + 4 * (ln >> 5)) * 64 + nt * 32 + (ln & 31)] = s; }
        __syncthreads();
        int e0 = 0, e1 = 0, p0 = 0, p1 = 0; float w0 = 0.f, w1 = 0.f;
        if (c.tid < 32) { const LAS float* lg = logit + c.tid * 64;
            int grp = 0; float gm = lg[0];
#pragma unroll
            for (int q = 1; q < 4; ++q) if (lg[q] > gm) { gm = lg[q]; grp = q; }
            float den = 0.f;
#pragma unroll
            for (int q = 0; q < 4; ++q) den += expf(lg[q] - gm);
            const float gate = 1.0f / den;
            const LAS float* le = lg + 4 + grp * 8;
            int i0 = 0; float v0 = le[0];
#pragma unroll
            for (int q = 1; q < 8; ++q) if (le[q] > v0) { v0 = le[q]; i0 = q; }
            int i1 = -1; float v1 = -3.0e38f;
#pragma unroll
            for (int q = 0; q < 8; ++q) if (q != i0 && le[q] > v1) { v1 = le[q]; i1 = q; }
            const float ex = expf(v1 - v0); w0 = gate / (1.0f + ex); w1 = gate * ex / (1.0f + ex);
            e0 = grp * 8 + i0; e1 = grp * 8 + i1;
            p0 = __hip_atomic_fetch_add(lcnt + e0, 1, __ATOMIC_RELAXED, __HIP_MEMORY_SCOPE_WORKGROUP);
            p1 = __hip_atomic_fetch_add(lcnt + e1, 1, __ATOMIC_RELAXED, __HIP_MEMORY_SCOPE_WORKGROUP); }
        __syncthreads();
        if (c.tid < 32) { const int n = lcnt[c.tid]; lbase[c.tid] = n ? (int)__hip_atomic_fetch_add(gcnt + c.tid, (unsigned)n, __ATOMIC_RELAXED, __HIP_MEMORY_SCOPE_AGENT) : 0; }
        __syncthreads();
        if (c.tid < 32) { const int r = r0 + c.tid;
            list[e0 * MOE_CAP + lbase[e0] + p0] = 2 * r; w2[2 * r] = w0;
            list[e1 * MOE_CAP + lbase[e1] + p1] = 2 * r + 1; w2[2 * r + 1] = w1; }
        __syncthreads();
    }
}
__device__ __forceinline__ void moe_tables(const Args& a, const Ctx& c, int layer, LAS int* tab) {
    unsigned* gcnt = (unsigned*)(a.ws + WS_CTL) + CW_CNT + layer * 32;
    if (c.tid < 32) tab[40 + c.tid] = (int)__hip_atomic_load(gcnt + c.tid, __ATOMIC_RELAXED, __HIP_MEMORY_SCOPE_AGENT);
    __syncthreads();
    if (c.tid == 0) { int s = 0; for (int e = 0; e < 32; ++e) { tab[e] = s; s += (tab[40 + e] + 255) >> 8; } tab[32] = s; }
    __syncthreads();
}

__device__ __forceinline__ void ph_rpool(const Args& a, const Ctx& c, int layer) {
    LAS unsigned char* hs = c.lds;
    const float* g = a.in[I_NMIX] + layer * D;
    for (int tile = blockIdx.x; tile < TT / 32; tile += c.G) {
        const int r0 = tile * 32;
        const int s0 = r0 < TL ? (r0 / SEQ) * SEQ : TL + ((r0 - TL) / CTXL) * CTXL, s1 = s0 + (r0 < TL ? SEQ : CTXL);
        for (int lr = c.wave; lr < 47; lr += NWAVES) { const int gr = r0 - 8 + lr; if (gr < s0 || gr >= s1) continue;
            f32x4 v[4], h[4]; load_row_combined(a, layer, gr, c.lane, v);
            if (lr >= 8 && lr < 40) { f32x4* xo = (f32x4*)((float*)(a.ws + WS_Z) + (size_t)gr * D) + c.lane;
#pragma unroll
                for (int j = 0; j < 4; ++j) xo[64 * j] = v[j]; }
            const float rstd = row_rstd(v); const float* m = mod_row(a, layer, gr);
            norm_mod(v, rstd, g, m, m + D, c.lane, h);
#pragma unroll
            for (int j = 0; j < 4; ++j) *(LAS u32x2*)(hs + lr * 2048 + (4 * c.lane + 256 * j) * 2) = (u32x2){cvtpk(h[j].x, h[j].y), cvtpk(h[j].z, h[j].w)}; }
        __syncthreads();
        { const int half = 1 << (c.tid >> 7);
          const LAS unsigned* col = (const LAS unsigned*)hs + c.tid;
          float sx = 0.f, sy = 0.f;
          { const int lo = (r0 - half) > s0 ? (r0 - half) : s0, hi = (r0 + half) < s1 ? (r0 + half) : s1;
            for (int gr = lo; gr < hi; ++gr) { const unsigned u = col[(gr - r0 + 8) * 512]; sx += bflo(u); sy += bfhi(u); } }
          unsigned* ho = (unsigned*)((bf16*)(a.ws + WS_HB) + (size_t)r0 * D) + c.tid;
          for (int t = 0; t < 32; ++t) { const int gr = r0 + t; const int lo = (gr - half) > s0 ? (gr - half) : s0, hi = (gr + half) < s1 ? (gr + half) : s1;
              const float inv = __builtin_amdgcn_rcpf((float)(hi - lo)); const unsigned u = col[(t + 8) * 512];
              ho[t * 512] = cvtpk(sx * inv - bflo(u), sy * inv - bfhi(u));
              if (t < 31) { if (gr + half < s1) { const unsigned w = col[(t + 8 + half) * 512]; sx += bflo(w); sy += bfhi(w); }
                            if (gr - half >= s0) { const unsigned w = col[(t + 8 - half) * 512]; sx -= bflo(w); sy -= bfhi(w); } } } }
        __syncthreads();
    }
}

struct EpiInproj { static constexpr bool PERM = true; bf16* Z; bf16* XBC; float* DT; const float* dtb;
    __device__ __forceinline__ void operator()(const AccT& acc, const pg8::Unit& u, int wr, int wc, int fr, int fq) const {
        const size_t r0 = (size_t)u.pm * 256;
        if (u.pn < 20) { bf16* base; int pitch; if (u.pn < 8) { base = Z + u.pn * 256; pitch = 2048; } else { base = XBC + (u.pn - 8) * 256; pitch = 3072; }
#pragma unroll
            for (int ai = 0; ai < 2; ++ai)
#pragma unroll
                for (int m = 0; m < 4; ++m) { bf16* rowp = base + (r0 + ai * 128 + wr * 64 + m * 16 + fr) * pitch + wc * 32 + 8 * fq;
#pragma unroll
                    for (int bj = 0; bj < 2; ++bj) { const f32x4 v0 = acc[ai][bj][m][0], v1 = acc[ai][bj][m][1];
                        *(u32x4*)(rowp + bj * 128) = (u32x4){cvtpk(v0[0], v0[1]), cvtpk(v0[2], v0[3]), cvtpk(v1[0], v1[1]), cvtpk(v1[2], v1[3])}; } }
        } else if (wc < 2) { const int col = wc * 32 + 8 * fq; const f32x4 b0 = *(const f32x4*)(dtb + col), b1 = *(const f32x4*)(dtb + col + 4);
#pragma unroll
            for (int ai = 0; ai < 2; ++ai)
#pragma unroll
                for (int m = 0; m < 4; ++m) { float* p = DT + (r0 + ai * 128 + wr * 64 + m * 16 + fr) * 64 + col; f32x4 v0 = acc[ai][0][m][0] + b0, v1 = acc[ai][0][m][1] + b1;
#pragma unroll
                    for (int e = 0; e < 4; ++e) { v0[e] = fmaxf(v0[e], 0.f) + log1pf(__expf(-fabsf(v0[e]))); v1[e] = fmaxf(v1[e], 0.f) + log1pf(__expf(-fabsf(v1[e]))); }
                    *(f32x4*)p = v0; *(f32x4*)(p + 4) = v1; } }
    }
};

__device__ __forceinline__ void ph_conv(const Args& a, const Ctx& c) {
    LAS unsigned char* tin = c.lds; LAS unsigned char* toT = c.lds + 17408; LAS unsigned char* toN = c.lds + 34816;
    const bf16* xbc = (const bf16*)(a.ws + WS_XBC);
    for (int task = blockIdx.x; task < NCH * 48; task += c.G) {
        const int ci = task / 48, chb = task % 48, r0 = ci * 128, ch0 = chb * 64;
        const bool first = ci < 128 ? (ci % 32 == 0) : (((ci - 128) & 1) == 0), last = ci < 128 ? (ci % 32 == 31) : (((ci - 128) & 1) == 1);
        for (int p = c.tid; p < 131 * 8; p += NTHREADS) { const int lr = p >> 3, pc = p & 7; const bool valid = !((lr < 2 && first) || (lr == 130 && last));
            u32x4 v = (u32x4){0u, 0u, 0u, 0u}; if (valid) v = *(const u32x4*)(xbc + (size_t)(r0 - 2 + lr) * 3072 + ch0 + pc * 8);
            *(LAS u32x4*)(tin + lr * 128 + pc * 16) = v; }
        __syncthreads();
        { const int ch = c.tid & 63, tq = c.tid >> 6; const float* cw = a.in[I_CONVW] + ch0 + ch;
          const float w0 = cw[0], w1 = cw[3072], w2 = cw[2 * 3072], w3 = cw[3 * 3072], bias = a.in[I_CONVB][ch0 + ch];
          float xin[19];
#pragma unroll
          for (int i = 0; i < 19; ++i) xin[i] = bf2f(*(const LAS bf16*)(tin + (16 * tq + i) * 128 + ch * 2));
          float o[16];
#pragma unroll
          for (int i = 0; i < 16; ++i) o[i] = silu_f(bias + w0 * xin[i] + w1 * xin[i + 1] + w2 * xin[i + 2] + w3 * xin[i + 3]);
          if (chb < 40) { *(LAS u32x4*)(toT + ch * 272 + tq * 32) = (u32x4){cvtpk(o[0], o[1]), cvtpk(o[2], o[3]), cvtpk(o[4], o[5]), cvtpk(o[6], o[7])};
                          *(LAS u32x4*)(toT + ch * 272 + tq * 32 + 16) = (u32x4){cvtpk(o[8], o[9]), cvtpk(o[10], o[11]), cvtpk(o[12], o[13]), cvtpk(o[14], o[15])}; }
          if (chb >= 32) {
#pragma unroll
              for (int i = 0; i < 16; ++i) *(LAS bf16*)(toN + (16 * tq + i) * 144 + ch * 2) = (bf16)(cvtpk(o[i], 0.f) & 0xffffu); } }
        __syncthreads();
        if (chb < 40) { bf16* dst = chb < 32 ? (bf16*)(a.ws + WS_XT) + ((size_t)ci * 2048 + ch0) * 128 : (bf16*)(a.ws + WS_BT) + ((size_t)ci * 512 + (ch0 - 2048)) * 128;
#pragma unroll
            for (int q = 0; q < 2; ++q) { const int p = c.tid + 512 * q, chl = p >> 4, pc = p & 15; *(u32x4*)(dst + chl * 128 + pc * 8) = *(const LAS u32x4*)(toT + chl * 272 + pc * 16); } }
        if (chb >= 32) { bf16* dst = chb < 40 ? (bf16*)(a.ws + WS_BN) + (size_t)r0 * 512 + (ch0 - 2048) : (bf16*)(a.ws + WS_CN) + (size_t)r0 * 512 + (ch0 - 2560);
#pragma unroll
            for (int q = 0; q < 2; ++q) { const int p = c.tid + 512 * q, t = p >> 3, pc = p & 7; *(u32x4*)(dst + (size_t)t * 512 + pc * 8) = *(const LAS u32x4*)(toN + t * 144 + pc * 16); } }
        __syncthreads();
    }
    const int gw = c.vcu * NWAVES + c.wave, NGW = c.G * NWAVES;
    const float* dt = (const float*)(a.ws + WS_DT);
    for (int item = gw; item < NCH * 32; item += NGW) { const int ci = item >> 5, h = item & 31, r0 = ci * 128 + 2 * c.lane;
        const float af = -expf(a.in[I_ALOG][h]), ab = -expf(a.in[I_ALOG][32 + h]);
        const float dtf0 = dt[(size_t)r0 * 64 + h], dtf1 = dt[(size_t)(r0 + 1) * 64 + h], dtb0 = dt[(size_t)r0 * 64 + 32 + h], dtb1 = dt[(size_t)(r0 + 1) * 64 + 32 + h];
        const float laf0 = dtf0 * af, laf1 = dtf1 * af, lab0 = dtb0 * ab, lab1 = dtb1 * ab;
        float inf_ = laf0 + laf1, inb = lab0 + lab1; const float pf = inf_, pbk = inb;
#pragma unroll
        for (int o = 1; o < 64; o <<= 1) { const float t1 = __shfl_up(inf_, o), t2 = __shfl_up(inb, o); if (c.lane >= o) { inf_ += t1; inb += t2; } }
        const float totf = __shfl(inf_, 63), totb = __shfl(inb, 63);
        const float exf = inf_ - pf, exb = inb - pbk;
        const float cf0 = exf + laf0, cf1 = inf_, pb0 = exb, pb1 = exb + lab0;
        f32x4* sca = (f32x4*)(a.ws + WS_SCA) + (size_t)r0 * 32 + h; f32x4* scb = (f32x4*)(a.ws + WS_SCB) + (size_t)r0 * 32 + h;
        { const float L2E = 1.4426950408889634f;
          sca[0] = (f32x4){cf0 * L2E, pb0 * L2E, cf0 * L2E - __log2f(dtf0), pb0 * L2E + __log2f(dtb0)}; sca[32] = (f32x4){cf1 * L2E, pb1 * L2E, cf1 * L2E - __log2f(dtf1), pb1 * L2E + __log2f(dtb1)}; }
        scb[0] = (f32x4){__expf(cf0), __expf(totb - pb0), dtf0 * __expf(totf - cf0), dtb0 * __expf(pb0)};
        scb[32] = (f32x4){__expf(cf1), __expf(totb - pb1), dtf1 * __expf(totf - cf1), dtb1 * __expf(pb1)};
        if (c.lane == 0) ((f32x2*)(a.ws + WS_DEC))[ci * 32 + h] = (f32x2){__expf(totf), __expf(totb)}; }
}

__device__ __forceinline__ void ph_scan(const Args& a, const Ctx& c) {
    constexpr int P = 272, BUF = 53248;
    LAS unsigned char* stg = c.lds + 2 * BUF + c.wave * 2048;
    const int r32 = c.lane & 31, hi = c.lane >> 5, pt = c.wave >> 2, nt = c.wave & 3;
    for (int task = c.vcu; task < 256; task += c.G) { const int b = task >> 6, dir = (task >> 5) & 1, h = task & 31, g = h >> 3;
        f32x16 acc = {};
        u32x4 xr[2], br[4]; float wreg = 0.f;
#define SCAN_CI(k) (dir == 0 ? ((k) < 2 ? 128 + 2 * b + (k) : 32 * b + ((k) - 2)) : ((k) < 2 ? 128 + 2 * b + 1 - (k) : 32 * b + 31 - ((k) - 2)))
#define SCAN_LOAD(k) do { const int ci_ = SCAN_CI(k); const bf16* xs_ = (const bf16*)(a.ws + WS_XT) + ((size_t)ci_ * 2048 + 64 * h) * 128; const bf16* bs_ = (const bf16*)(a.ws + WS_BT) + ((size_t)ci_ * 512 + 128 * g) * 128; \
        _Pragma("unroll") for (int q = 0; q < 2; ++q) xr[q] = ((const u32x4*)xs_)[c.tid + 512 * q]; _Pragma("unroll") for (int q = 0; q < 4; ++q) br[q] = ((const u32x4*)bs_)[c.tid + 512 * q]; \
        if (c.tid < 128) { const f32x4 s4 = ((const f32x4*)(a.ws + WS_SCB))[((size_t)ci_ * 128 + c.tid) * 32 + h]; wreg = dir == 0 ? s4.z : s4.w; } } while (0)
#define SCAN_WRITE(bi) do { LAS unsigned char* xb_ = c.lds + (bi) * BUF; LAS unsigned char* bb_ = xb_ + 17408; \
        _Pragma("unroll") for (int q = 0; q < 2; ++q) { const int p = c.tid + 512 * q; *(LAS u32x4*)(xb_ + (p >> 4) * P + (p & 15) * 16) = xr[q]; } \
        _Pragma("unroll") for (int q = 0; q < 4; ++q) { const int p = c.tid + 512 * q; *(LAS u32x4*)(bb_ + (p >> 4) * P + (p & 15) * 16) = br[q]; } \
        if (c.tid < 128) ((LAS float*)(xb_ + 52224))[c.tid] = wreg; } while (0)
        SCAN_LOAD(0); SCAN_WRITE(0);
        __syncthreads();
        for (int k = 0; k < 34; ++k) { const int cur = k & 1, ci = SCAN_CI(k);
            if (k + 1 < 34) SCAN_LOAD(k + 1);
            { bf16* hin = (bf16*)(a.ws + WS_HIN) + (((size_t)ci * 2 + dir) * 32 + h) * 8192;
#pragma unroll
              for (int r = 0; r < 16; ++r) *(LAS bf16*)(stg + ((r & 3) + 8 * (r >> 2) + 4 * hi) * 64 + r32 * 2) = (bf16)(cvtpk(acc[r], 0.f) & 0xffffu);
              LDS_WAIT();
#pragma unroll
              for (int i = 0; i < 2; ++i) { const int row = (c.lane >> 2) + 16 * i, pc = c.lane & 3; *(u32x4*)(hin + (size_t)(32 * pt + row) * 128 + 32 * nt + pc * 8) = *(const LAS u32x4*)(stg + row * 64 + pc * 16); } }
            const f32x2 dd = ((const f32x2*)(a.ws + WS_DEC))[ci * 32 + h]; const float dec = dir == 0 ? dd.x : dd.y;
#pragma unroll
            for (int r = 0; r < 16; ++r) acc[r] *= dec;
            { LAS unsigned char* xb = c.lds + cur * BUF; LAS unsigned char* bb = xb + 17408; const LAS float* wv = (const LAS float*)(xb + 52224);
#pragma unroll
              for (int kk = 0; kk < 8; ++kk) { const int s8 = 16 * kk + 8 * hi;
                  const u32x4 xa = *(const LAS u32x4*)(xb + (32 * pt + r32) * P + s8 * 2); const f32x4 wa = *(const LAS f32x4*)(wv + s8), wb = *(const LAS f32x4*)(wv + s8 + 4);
                  const u32x4 xs = (u32x4){cvtpk(bflo(xa.x) * wa.x, bfhi(xa.x) * wa.y), cvtpk(bflo(xa.y) * wa.z, bfhi(xa.y) * wa.w), cvtpk(bflo(xa.z) * wb.x, bfhi(xa.z) * wb.y), cvtpk(bflo(xa.w) * wb.z, bfhi(xa.w) * wb.w)};
                  const bf16x8 bfrag = *(const LAS bf16x8*)(bb + (32 * nt + r32) * P + s8 * 2);
                  acc = __builtin_amdgcn_mfma_f32_32x32x16_bf16(__builtin_bit_cast(bf16x8, xs), bfrag, acc, 0, 0, 0); } }
            if (k + 1 < 34) SCAN_WRITE(cur ^ 1);
            __syncthreads();
        }
#undef SCAN_CI
#undef SCAN_LOAD
#undef SCAN_WRITE
    }
}

__device__ __forceinline__ int crow16(int r, int hi) { return (r & 3) + 8 * (r >> 2) + 4 * hi; }
__device__ __forceinline__ void ph_yph(const Args& a, const Ctx& c) {
    constexpr int P = 272, ZP = 144;
    LAS unsigned char* Cs = c.lds; LAS unsigned char* Bs = c.lds + 34816; LAS unsigned char* xs = c.lds + 69632; LAS unsigned char* hf = c.lds + 87040; LAS unsigned char* hb = c.lds + 104448;
    LAS unsigned char* zs = c.lds + 121856; LAS unsigned char* os = c.lds + 140288; LAS f32x4* sca = (LAS f32x4*)(c.lds + 158720); LAS f32x2* scb = (LAS f32x2*)(c.lds + 160768);
    LAS float* sbv = (LAS float*)(c.lds + 161792); LAS float* scv = (LAS float*)(c.lds + 162304); LAS float* ssql = (LAS float*)(c.lds + 34816);
    const int lb = c.wave & 3, pb = c.wave >> 2;
    SECT_DECL
    for (int task = c.vcu; task < NCH * 4; task += c.G) { const int ci = task >> 2, g = task & 3, r0 = ci * 128;
        int tid_t = c.tid; asm volatile("" : "+v"(tid_t));
        f32x16 X[4]; int l0;
        u32x4 pxt[2], phf[2], phb[2], pz[2]; f32x4 ps1 = {}; f32x4 ps4 = {};
#define YPH_PREFETCH(hq) do { const int h_ = 8 * g + (hq); const u32x4* xt_ = (const u32x4*)((const bf16*)(a.ws + WS_XT) + ((size_t)ci * 2048 + 64 * h_) * 128); \
            const u32x4* hfg_ = (const u32x4*)((const bf16*)(a.ws + WS_HIN) + (((size_t)ci * 2 + 0) * 32 + h_) * 8192); const u32x4* hbg_ = (const u32x4*)((const bf16*)(a.ws + WS_HIN) + (((size_t)ci * 2 + 1) * 32 + h_) * 8192); \
            const bf16* zg_ = (const bf16*)(a.ws + WS_Z) + (size_t)r0 * 2048 + 64 * h_; \
            _Pragma("unroll") for (int q = 0; q < 2; ++q) { const int p = tidp + 512 * q; pxt[q] = xt_[p]; phf[q] = hfg_[p]; phb[q] = hbg_[p]; pz[q] = *(const u32x4*)(zg_ + (size_t)(p >> 3) * 2048 + (p & 7) * 8); } \
            if (tidp < 128) { ps1 = ((const f32x4*)(a.ws + WS_SCA))[((size_t)r0 + tidp) * 32 + h_]; ps4 = ((const f32x4*)(a.ws + WS_SCB))[((size_t)r0 + tidp) * 32 + h_]; } } while (0)
        { const int tid = tid_t, lane = tid & 63, r32 = lane & 31, hi = lane >> 5; l0 = 32 * lb + r32;
          { const bf16* cn = (const bf16*)(a.ws + WS_CN) + (size_t)r0 * 512 + 128 * g; const bf16* bn = (const bf16*)(a.ws + WS_BN) + (size_t)r0 * 512 + 128 * g;
#pragma unroll
            for (int q = 0; q < 4; ++q) { const int p = tid + 512 * q, row = p >> 4, pc = p & 15;
                *(LAS u32x4*)(Cs + row * P + pc * 16) = *(const u32x4*)(cn + (size_t)row * 512 + pc * 8); *(LAS u32x4*)(Bs + row * P + pc * 16) = *(const u32x4*)(bn + (size_t)row * 512 + pc * 8); } }
          { const int tidp = tid; YPH_PREFETCH(0); }
          __syncthreads();
#pragma unroll
          for (int sb = 0; sb < 4; ++sb) { X[sb] = (f32x16){};
#pragma unroll
              for (int kk = 0; kk < 8; ++kk) { const int k8 = (16 * kk + 8 * hi) * 2;
                  X[sb] = __builtin_amdgcn_mfma_f32_32x32x16_bf16(*(const LAS bf16x8*)(Bs + (32 * sb + r32) * P + k8), *(const LAS bf16x8*)(Cs + (32 * lb + r32) * P + k8), X[sb], 0, 0, 0); } }
        }
        SECT(0);
        float ssq = 0.f;
#pragma unroll 1
        for (int hh = 0; hh < 8; ++hh) { const int h = 8 * g + hh;
            int tid = c.tid; asm volatile("" : "+v"(tid)); const int lane = tid & 63, r32 = lane & 31, hi = lane >> 5, l = 32 * lb + r32; (void)lane;
            __syncthreads();
            SECT(1);
            if (hh > 0) { bf16* gg = (bf16*)(a.ws + WS_G) + (size_t)r0 * 2048 + 64 * (h - 1);
#pragma unroll
                for (int q = 0; q < 2; ++q) { const int p = tid + 512 * q, zr = p >> 3, zc = p & 7; *(u32x4*)(gg + (size_t)zr * 2048 + zc * 8) = *(const LAS u32x4*)(os + zr * ZP + zc * 16); } }
#pragma unroll
            for (int q = 0; q < 2; ++q) { const int p = tid + 512 * q, row = p >> 4, pc = p & 15;
                *(LAS u32x4*)(xs + row * P + pc * 16) = pxt[q]; *(LAS u32x4*)(hf + row * P + pc * 16) = phf[q]; *(LAS u32x4*)(hb + row * P + pc * 16) = phb[q];
                *(LAS u32x4*)(zs + (p >> 3) * ZP + (p & 7) * 16) = pz[q]; }
            if (tid < 128) { sca[tid] = ps1; scb[tid] = (f32x2){ps4.x, ps4.y}; sbv[tid] = ps1.z; scv[tid] = ps1.w; }
            __syncthreads();
            SECT(2);
            if (hh < 7) { const int tidp = tid; YPH_PREFETCH(hh + 1); }
            SECT(3);
            const f32x4 me = sca[l]; const f32x2 ee = scb[l]; const float dsum = a.in[I_DSK][h] + a.in[I_DSK][32 + h];
            const float dtb_l = __builtin_amdgcn_exp2f(me.w - me.y);
            f32x16 accd = {};
#pragma unroll
            for (int sb = 0; sb < 4; ++sb) { unsigned mp[8];
#pragma unroll
                for (int q = 0; q < 4; ++q) { const int s0 = 32 * sb + 8 * q + 4 * hi; float mv[4];
                    if (sb < lb) { const f32x4 bs4 = *(const LAS f32x4*)(sbv + s0);
#pragma unroll
                        for (int e = 0; e < 4; ++e) mv[e] = X[sb][4 * q + e] * __builtin_amdgcn_exp2f(me.x - bs4[e]); }
                    else if (sb > lb) { const f32x4 cs4 = *(const LAS f32x4*)(scv + s0);
#pragma unroll
                        for (int e = 0; e < 4; ++e) mv[e] = X[sb][4 * q + e] * __builtin_amdgcn_exp2f(cs4[e] - me.y); }
                    else { const f32x4 bs4 = *(const LAS f32x4*)(sbv + s0), cs4 = *(const LAS f32x4*)(scv + s0);
#pragma unroll
                        for (int e = 0; e < 4; ++e) { const int s = s0 + e; const float t = (s <= l) ? (me.x - bs4[e]) : (cs4[e] - me.y); const float xv = X[sb][4 * q + e];
                            float m = xv * __builtin_amdgcn_exp2f(t); if (s == l) m += xv * dtb_l + dsum; mv[e] = m; } }
                    mp[2 * q] = cvtpk(mv[0], mv[1]); mp[2 * q + 1] = cvtpk(mv[2], mv[3]); }
#pragma unroll
                for (int t = 0; t < 2; ++t) { const int sof = (32 * sb + 16 * t + 4 * hi) * 2;
                    const u32x2 lo = *(const LAS u32x2*)(xs + (32 * pb + r32) * P + sof), h2 = *(const LAS u32x2*)(xs + (32 * pb + r32) * P + sof + 16);
                    const u32x4 af = (u32x4){lo.x, lo.y, h2.x, h2.y}, bfm = (u32x4){mp[4 * t], mp[4 * t + 1], mp[4 * t + 2], mp[4 * t + 3]};
                    accd = __builtin_amdgcn_mfma_f32_32x32x16_bf16(__builtin_bit_cast(bf16x8, af), __builtin_bit_cast(bf16x8, bfm), accd, 0, 0, 0); }
                }
            SECT(4);
#pragma unroll
            for (int dd = 0; dd < 2; ++dd) { f32x16 acco = {}; LAS unsigned char* hx = dd == 0 ? hf : hb;
#pragma unroll
                for (int kk = 0; kk < 8; ++kk) { const int k8 = (16 * kk + 8 * hi) * 2;
                    acco = __builtin_amdgcn_mfma_f32_32x32x16_bf16(*(const LAS bf16x8*)(hx + (32 * pb + r32) * P + k8), *(const LAS bf16x8*)(Cs + (32 * lb + r32) * P + k8), acco, 0, 0, 0); }
                const float ex = dd == 0 ? ee.x : ee.y;
#pragma unroll
                for (int r = 0; r < 16; ++r) accd[r] += ex * acco[r]; }
            SECT(5);
#pragma unroll
            for (int q = 0; q < 4; ++q) { const int pcol = 32 * pb + 8 * q + 4 * hi; const u32x2 zq = *(const LAS u32x2*)(zs + l * ZP + pcol * 2);
                float gv[4];
#pragma unroll
                for (int e = 0; e < 4; ++e) { const int r = 4 * q + e; const float y = accd[r];
                    const float z = (e == 0) ? bflo(zq.x) : (e == 1) ? bfhi(zq.x) : (e == 2) ? bflo(zq.y) : bfhi(zq.y); gv[e] = y * silu_f(z); ssq += gv[e] * gv[e]; }
                *(LAS u32x2*)(os + l * ZP + pcol * 2) = (u32x2){cvtpk(gv[0], gv[1]), cvtpk(gv[2], gv[3])}; }
            SECT(6);
        }
#undef YPH_PREFETCH
        __syncthreads();
        { bf16* gg = (bf16*)(a.ws + WS_G) + (size_t)r0 * 2048 + 64 * (8 * g + 7);
#pragma unroll
          for (int q = 0; q < 2; ++q) { const int p = c.tid + 512 * q, zr = p >> 3, zc = p & 7; *(u32x4*)(gg + (size_t)zr * 2048 + zc * 8) = *(const LAS u32x4*)(os + zr * ZP + zc * 16); } }
        ssq += __shfl_xor(ssq, 32);
        if ((c.lane >> 5) == 0) ssql[pb * 128 + l0] = ssq;
        __syncthreads();
        if (c.tid < 128) ssql[256 + c.tid] = rsqrtf((ssql[c.tid] + ssql[128 + c.tid]) * (1.0f / 512.0f) + EPS);
        VM_WAIT();
        __syncthreads();
        { bf16* gt = (bf16*)(a.ws + WS_G) + (size_t)r0 * 2048 + 512 * g; const float* ng = a.in[I_SNORM] + 512 * g;
#pragma unroll 1
          for (int qb = 0; qb < 2; ++qb) { u32x4 gv8[8]; int tidq = c.tid + 4096 * qb; asm volatile("" : "+v"(tidq));
#pragma unroll
            for (int q = 0; q < 8; ++q) { const int p = tidq + 512 * q; gv8[q] = *(const u32x4*)(gt + (size_t)(p >> 6) * 2048 + (p & 63) * 8); }
#pragma unroll
            for (int q = 0; q < 8; ++q) { const int p = tidq + 512 * q, row = p >> 6, col = (p & 63) * 8; const u32x4 v = gv8[q]; const float sr = ssql[256 + row];
              const f32x4 g0 = *(const f32x4*)(ng + col), g1 = *(const f32x4*)(ng + col + 4);
              *(u32x4*)(gt + (size_t)row * 2048 + col) = (u32x4){cvtpk(bflo(v.x) * sr * g0.x, bfhi(v.x) * sr * g0.y), cvtpk(bflo(v.y) * sr * g0.z, bfhi(v.y) * sr * g0.w), cvtpk(bflo(v.z) * sr * g1.x, bfhi(v.z) * sr * g1.y), cvtpk(bflo(v.w) * sr * g1.z, bfhi(v.w) * sr * g1.w)}; } } }
        __syncthreads();
        SECT(7);
    }
    SECT_END(40);
}
__device__ __forceinline__ void ph_gfix(const Args& a, const Ctx& c) {
    const float* ng = a.in[I_SNORM]; const float* rs = (const float*)(a.ws + WS_RSTD);
    const int n16 = TT * 256;
    for (int p = blockIdx.x * NTHREADS + c.tid; p < n16; p += c.G * NTHREADS) { const int r = p >> 8, col = (p & 255) * 8;
        u32x4* gp = (u32x4*)((bf16*)(a.ws + WS_G) + (size_t)r * 2048 + col); const u32x4 v = *gp; const float s = rs[r * 4 + (col >> 9)];
        const f32x4 g0 = *(const f32x4*)(ng + col), g1 = *(const f32x4*)(ng + col + 4);
        *gp = (u32x4){cvtpk(bflo(v.x) * s * g0.x, bfhi(v.x) * s * g0.y), cvtpk(bflo(v.y) * s * g0.z, bfhi(v.y) * s * g0.w), cvtpk(bflo(v.z) * s * g1.x, bfhi(v.z) * s * g1.y), cvtpk(bflo(v.w) * s * g1.z, bfhi(v.w) * s * g1.w)}; }
}

#if DEBUG_CHECKS
__device__ __forceinline__ int dbg_sample_row(int b) { const int SR[16] = {0, 1, 77, 4095, 4096, 5000, 8191, 9000, 12288, 16383, 16384, 16385, 16384 + 255, 16384 + 256, 17000, 17407}; int r = 0;
#pragma unroll
    for (int i = 0; i < 16; ++i) r = (b == i) ? SR[i] : r;
    return r; }
__device__ __forceinline__ float blk_sum(float v, LAS float* red, int tid) {
    v = wave_sum(v); __syncthreads(); if ((tid & 63) == 0) red[tid >> 6] = v; __syncthreads(); float s = 0.f;
#pragma unroll
    for (int i = 0; i < 8; ++i) s += red[i];
    __syncthreads(); return s; }
__device__ __forceinline__ float blk_max(float v, LAS float* red, int tid) {
#pragma unroll
    for (int o = 1; o < 64; o <<= 1) v = fmaxf(v, __shfl_xor(v, o));
    __syncthreads(); if ((tid & 63) == 0) red[tid >> 6] = v; __syncthreads(); float s = red[0];
#pragma unroll
    for (int i = 1; i < 8; ++i) s = fmaxf(s, red[i]);
    __syncthreads(); return s; }
__device__ __forceinline__ void dbg_report(const Args& a, int id, float err, float ssref, float n, int tid) {
    if (tid == 0) { float rel = err / (sqrtf(ssref / n) + 1e-20f); if (!(rel == rel)) rel = 1e30f; atomicMax((unsigned*)(a.ws + WS_CTL) + CW_DBG + id, __float_as_uint(rel)); } }
__device__ __forceinline__ float dbg_mod(const Args& a, int layer, int r, int j) {
    const float* cv = r < TL ? a.in[I_C] + (r / SEQ) * 1024 : a.in[I_CCTX]; float s = 0.f;
    _Pragma("nounroll") for (int k = 0; k < 1024; ++k) { const float x = cv[k]; s += (x / (1.0f + expf(-x))) * a.in[I_WADA][((size_t)layer * 1024 + k) * 6144 + j]; }
    return s + a.in[I_BADA][layer * 6144 + j]; }

__device__ __forceinline__ void chk_rmix(const Args& a, int layer, int id, LAS unsigned char* ldsb) {
    if (blockIdx.x >= 16) return; const int tid = tid_opaque(), r = dbg_sample_row(blockIdx.x);
    LAS float* red = (LAS float*)ldsb;
    const float* x = resid_row(a, layer, r); const bf16* hb = (const bf16*)(a.ws + WS_HB) + (size_t)r * D;
    float ss = 0.f; for (int cc = tid; cc < D; cc += 512) ss += x[cc] * x[cc];
    ss = blk_sum(ss, red, tid); const float rstd = rsqrtf(ss / D + EPS);
    float err = 0.f, sr = 0.f;
    for (int cc = tid; cc < D; cc += 512) { const float sh = dbg_mod(a, layer, r, cc), sc = dbg_mod(a, layer, r, D + cc);
        const float ref = x[cc] * rstd * a.in[I_NMIX][layer * D + cc] * (1.f + sc) + sh; err = fmaxf(err, fabsf(ref - bf2f(hb[cc]))); sr += ref * ref; }
    err = blk_max(err, red, tid); sr = blk_sum(sr, red, tid); dbg_report(a, id, err, sr, D, tid);
}
__device__ __forceinline__ void chk_qkv(const Args& a, int layer, int id, LAS unsigned char* ldsb) {
    if (blockIdx.x >= 16) return; const int tid = tid_opaque(), r = dbg_sample_row(blockIdx.x), j = layer ? 1 : 0;
    LAS float* red = (LAS float*)ldsb; LAS float* y = red + 16; LAS float* hrow = y + 1536;
    const bf16* hb = (const bf16*)(a.ws + WS_HB) + (size_t)r * D;
    _Pragma("nounroll") for (int k = tid; k < D; k += 512) hrow[k] = bf2f(hb[k]);
    __syncthreads();
    for (int n = tid; n < 1536; n += 512) { float s = 0.f; const float* w = a.in[I_WQKV] + (size_t)j * 1024 * 1536 + n; _Pragma("nounroll") for (int k = 0; k < 1024; ++k) s += hrow[k] * w[(size_t)k * 1536]; y[n] = s; }
    __syncthreads();
    float err = 0.f, sr = 0.f;
    for (int n = tid; n < 1536; n += 512) { float ref;
        if (n < 1280) { const int h0 = n & ~63; float ss = 0.f; _Pragma("nounroll") for (int q = 0; q < 64; ++q) ss += y[h0 + q] * y[h0 + q];
            const float rstd = rsqrtf(ss / 64.f + EPS); const float* g = (n < 1024 ? a.in[I_QG] : a.in[I_KG]) + j * 64;
            float v = y[n] * rstd * g[n & 63], vp = y[n ^ 1] * rstd * g[(n ^ 1) & 63];
            if (r < TL) { const int t = r % SEQ, i = (n & 63) >> 1, f = i & 15, pos = i < 16 ? t / 64 : t % 64; const float inv = powf(10000.f, -(float)f / 16.f), ang = (float)pos * inv, cs = cosf(ang), sn = sinf(ang);
                v = (n & 1) ? (vp * sn + v * cs) : (v * cs - vp * sn); }
            if (n < 1024) v *= 0.125f * 1.4426950408889634f;
            ref = v; } else ref = y[n];
        float got;
        if (n < 1024) { if (layer == 3 && r >= TL) continue; got = bf2f(((const bf16*)(a.ws + WS_Q))[(size_t)r * 1024 + n]); }
        else if (n < 1280) got = bf2f(((const bf16*)(a.ws + WS_K))[kv_row(r) * 256 + (n - 1024)]);
        else got = bf2f(((const bf16*)(a.ws + WS_V))[kv_row(r) * 256 + (n - 1280)]);
        err = fmaxf(err, fabsf(ref - got)); sr += ref * ref; }
    err = blk_max(err, red, tid); sr = blk_sum(sr, red, tid); dbg_report(a, id, err, sr, 1536, tid);
}
__device__ __forceinline__ void chk_att(const Args& a, int layer, int id, LAS unsigned char* ldsb) {
    if (blockIdx.x >= 16) return; const int tid = tid_opaque(), r = dbg_sample_row(blockIdx.x);
    if (layer == 3 && r >= TL) return;
    LAS float* red = (LAS float*)ldsb; LAS float* sc = red + 16; LAS float* po = sc + 4352;
    const int nk = r < TL ? KVROWS : CTXL; const long kv0 = (long)(r < TL ? r / SEQ : (r - TL) / CTXL) * KVROWS;
    const bf16* Qb = (const bf16*)(a.ws + WS_Q); const bf16* Kb = (const bf16*)(a.ws + WS_K); const bf16* Vb = (const bf16*)(a.ws + WS_V); const bf16* Ob = (const bf16*)(a.ws + WS_HB);
    float err = 0.f, sr = 0.f;
    for (int h = 0; h < 16; ++h) {
        float mx = -3e38f;
        _Pragma("nounroll") for (int jk = tid; jk < nk; jk += 512) { float s = 0.f; _Pragma("nounroll") for (int d = 0; d < 64; ++d) s += bf2f(Qb[(size_t)r * 1024 + h * 64 + d]) * bf2f(Kb[(kv0 + jk) * 256 + (h >> 2) * 64 + d]); sc[jk] = s; mx = fmaxf(mx, s); }
        mx = blk_max(mx, red, tid);
        float l = 0.f; _Pragma("nounroll") for (int jk = tid; jk < nk; jk += 512) { const float p = exp2f(sc[jk] - mx); sc[jk] = p; l += p; }
        l = blk_sum(l, red, tid);
        { const int d = tid & 63, part = tid >> 6; float o = 0.f; _Pragma("nounroll") for (int jk = part; jk < nk; jk += 8) o += sc[jk] * bf2f(Vb[(kv0 + jk) * 256 + (h >> 2) * 64 + d]); po[part * 64 + d] = o; }
        __syncthreads();
        if (tid < 64) { float o = 0.f; _Pragma("nounroll") for (int p = 0; p < 8; ++p) o += po[p * 64 + tid]; o /= l; err = fmaxf(err, fabsf(o - bf2f(Ob[(size_t)r * 1024 + h * 64 + tid]))); sr += o * o; }
        __syncthreads();
    }
    err = blk_max(err, red, tid); sr = blk_sum(sr, red, tid); dbg_report(a, id, err, sr, 1024, tid);
}
__device__ __forceinline__ void chk_oproj(const Args& a, int layer, int id, LAS unsigned char* ldsb) {
    if (blockIdx.x >= 16 || layer != 0) return; const int tid = tid_opaque(), r = dbg_sample_row(blockIdx.x), j = 0;
    LAS float* red = (LAS float*)ldsb; LAS float* orow = red + 16;
    const bf16* Ob = (const bf16*)(a.ws + WS_HB) + (size_t)r * D;
    _Pragma("nounroll") for (int k = tid; k < D; k += 512) orow[k] = bf2f(Ob[k]);
    __syncthreads();
    float err = 0.f, sr = 0.f;
    for (int n = tid; n < D; n += 512) { float s = 0.f; const float* w = a.in[I_WO] + (size_t)j * 1024 * 1024 + n; _Pragma("nounroll") for (int k = 0; k < 1024; ++k) s += orow[k] * w[(size_t)k * 1024];
        const float dl = dbg_mod(a, layer, r, 2 * D + n) * s, ref = resid_row(a, 0, r)[n] + dl; err = fmaxf(err, fabsf(ref - ((const float*)(a.ws + WS_X))[(size_t)r * D + n])); sr += dl * dl; }
    err = blk_max(err, red, tid); sr = blk_sum(sr, red, tid); dbg_report(a, id, err, sr, D, tid);
}
__device__ __forceinline__ void chk_moe(const Args& a, int layer, int id_tok, int id_y, LAS unsigned char* ldsb) {
    if (blockIdx.x >= 16) return; const int tid = tid_opaque(), r = dbg_sample_row(blockIdx.x);
    if (layer == 3 && r >= TL) return;
    LAS float* red = (LAS float*)ldsb; LAS float* tok = red + 16; LAS float* lg = tok + 1024; LAS float* tkb = lg + 64; LAS float* act = tkb + 1024; LAS float* rt = act + 1024;
    const float* x = (const float*)(a.ws + WS_X) + (size_t)r * D; const bf16* tk = (const bf16*)(a.ws + WS_TK) + (size_t)r * D;
    float ss = 0.f; for (int cc = tid; cc < D; cc += 512) ss += x[cc] * x[cc];
    ss = blk_sum(ss, red, tid); const float rstd = rsqrtf(ss / D + EPS);
    float err = 0.f, sr = 0.f;
    for (int cc = tid; cc < D; cc += 512) { const float sh = dbg_mod(a, layer, r, 3 * D + cc), sc = dbg_mod(a, layer, r, 4 * D + cc);
        const float ref = x[cc] * rstd * a.in[I_NFFN][layer * D + cc] * (1.f + sc) + sh; tok[cc] = ref; tkb[cc] = bf2f(tk[cc]); err = fmaxf(err, fabsf(ref - tkb[cc])); sr += ref * ref; }
    err = blk_max(err, red, tid); sr = blk_sum(sr, red, tid);
    if (tid < 36) { float s = 0.f; _Pragma("nounroll") for (int k = 0; k < 1024; ++k) s += tok[k] * (tid < 4 ? a.in[I_WRG][((size_t)layer * 1024 + k) * 4 + tid] : a.in[I_WRE][((size_t)layer * 1024 + k) * 32 + tid - 4]); lg[tid] = s; }
    __syncthreads();
    if (tid == 0) { int grp = 0; _Pragma("nounroll") for (int q = 1; q < 4; ++q) if (lg[q] > lg[grp]) grp = q; float den = 0.f; _Pragma("nounroll") for (int q = 0; q < 4; ++q) den += expf(lg[q] - lg[grp]);
        const LAS float* le = lg + 4 + grp * 8; int i0 = 0; _Pragma("nounroll") for (int q = 1; q < 8; ++q) if (le[q] > le[i0]) i0 = q; int i1 = -1; _Pragma("nounroll") for (int q = 0; q < 8; ++q) if (q != i0 && (i1 < 0 || le[q] > le[i1])) i1 = q;
        const float ex = expf(le[i1] - le[i0]), w0 = 1.f / den / (1.f + ex), w1 = 1.f / den * ex / (1.f + ex);
        rt[0] = (float)(grp * 8 + i0); rt[1] = (float)(grp * 8 + i1); rt[2] = w0; rt[3] = w1;
        const float* w2 = (const float*)(a.ws + WS_W2); float e2 = fmaxf(fabsf(w2[2 * r] - w0), fabsf(w2[2 * r + 1] - w1)) * 30.f;
        const int* list = (const int*)(a.ws + WS_LIST); const unsigned* gc = (const unsigned*)(a.ws + WS_CTL) + CW_CNT + layer * 32;
        _Pragma("nounroll") for (int k = 0; k < 2; ++k) { const int e = (int)rt[k]; bool found = false; const int n = (int)gc[e]; _Pragma("nounroll") for (int q = 0; q < n && q < MOE_CAP; ++q) if (list[e * MOE_CAP + q] == 2 * r + k) found = true; if (!found) e2 = 1e6f; }
        rt[4] = e2; }
    __syncthreads();
    err = fmaxf(err, rt[4] * sqrtf(sr / D));
    dbg_report(a, id_tok, err, sr, D, tid);
    float err2 = 0.f, sr2 = 0.f;
    _Pragma("nounroll") for (int k = 0; k < 2; ++k) { const int e = (int)rt[k]; const float wk = rt[2 + k];
        const float* wgu = a.in[I_WGU] + ((size_t)layer * 32 + e) * 1024 * 1024; const float* wdn = a.in[I_WDN] + ((size_t)layer * 32 + e) * 512 * 1024;
        { float sg = 0.f, su = 0.f; _Pragma("nounroll") for (int q = 0; q < 1024; ++q) { sg += tkb[q] * wgu[(size_t)q * 1024 + tid]; su += tkb[q] * wgu[(size_t)q * 1024 + 512 + tid]; } act[tid] = (sg / (1.f + expf(-sg))) * su; }
        __syncthreads();
        for (int n = tid; n < D; n += 512) { float s = 0.f; _Pragma("nounroll") for (int q = 0; q < 512; ++q) s += act[q] * wdn[(size_t)q * 1024 + n]; s *= wk;
            err2 = fmaxf(err2, fabsf(s - bf2f(((const bf16*)(a.ws + WS_Y2))[(size_t)(2 * r + k) * D + n]))); sr2 += s * s; }
        __syncthreads(); }
    err2 = blk_max(err2, red, tid); sr2 = blk_sum(sr2, red, tid); dbg_report(a, id_y, err2, sr2, 2 * D, tid);
}

__global__ void __launch_bounds__(NTHREADS) dbg_kernel(Args a, int ty, int layer, int id) {
    extern __shared__ __attribute__((aligned(16))) unsigned char lds_dbg[];
    LAS unsigned char* l = (LAS unsigned char*)lds_dbg;
    if (ty == 1) chk_rmix(a, layer, id, l); else if (ty == 2) chk_qkv(a, layer, id, l); else if (ty == 3) chk_att(a, layer, id, l);
    else if (ty == 4) chk_oproj(a, layer, id, l); else if (ty == 5) chk_moe(a, layer, id, id + 1, l);
}
#endif

template <int KIND, int LAYER> __device__ __forceinline__ void run_phase(const Args& a0, Ctx& c, unsigned char* lds_gen) {
    Args a = a0; { unsigned long long wsv = (unsigned long long)a0.ws; asm volatile("" : "+s"(wsv)); a.ws = (unsigned char*)(GAS unsigned char*)wsv; }
    { unsigned lb = (unsigned)(uintptr_t)(LAS unsigned char*)lds_gen; asm volatile("" : "+s"(lb)); c.lds = (LAS unsigned char*)(uintptr_t)lb; }
    c.tid = tid_opaque(); c.lane = c.tid & 63;
    unsigned char* const ws = a.ws; constexpr int layer = LAYER;
    if constexpr (KIND == K_P0) p0_prologue(a, c);
    else if constexpr (KIND == K_RMIX) ph_rmix(a, c, layer);
    else if constexpr (KIND == K_QKV) { constexpr int j = layer ? 1 : 0;
        SchedQKV S{(const char*)(ws + WS_HB), (const char*)(ws + WS_WQKV) + (size_t)j * 1536 * 1024 * 2, layer == 0 ? 1 : 0, c.G, (int)blockIdx.x};
        EpiQKV E{(bf16*)(ws + WS_Q), (bf16*)(ws + WS_K), (bf16*)(ws + WS_V), a.in[I_QG] + j * 64, a.in[I_KG] + j * 64, (const f32x2*)(ws + WS_ROPE)};
        pg8::gemm_phase<EpiQKV, SchedQKV, false>(c.lds, 1024, 1024, S, E); }
    else if constexpr (KIND == K_ROPE) ph_rope(a, c, layer);
    else if constexpr (KIND == K_ATT) ph_att(a, c, layer, (char*)c.lds);
    else if constexpr (KIND == K_OPROJ) { constexpr int j = layer ? 1 : 0;
        SchedDense S{(const char*)(ws + WS_HB), (const char*)(ws + WS_WO) + (size_t)j * 1024 * 1024 * 2, (size_t)256 * 1024 * 2, (size_t)256 * 1024 * 2, 0, layer == 3 ? 64 : 68, 4, c.G, (int)blockIdx.x};
        EpiResid E{&a, layer, nullptr, nullptr};
        pg8::gemm_phase<EpiResid, SchedDense, false>(c.lds, 1024, 1024, S, E); }
    else if constexpr (KIND == K_M1) ph_m1(a, c, layer);
    else if constexpr (KIND == K_M2) {
        LAS int* tab = (LAS int*)(c.lds + TAB_OFF); moe_tables(a, c, layer, tab);
        unsigned* rdy = (unsigned*)(ws + WS_CTL) + CW_RDY + layer * 256;
        { SchedMoe S{(const char*)(ws + WS_TK), 0, (const char*)(ws + WS_WGU) + (size_t)layer * 32 * 1024 * 1024 * 2, (size_t)1024 * 1024 * 2, (size_t)256 * 1024 * 2, tab, (const int*)(ws + WS_LIST), c.G, (int)blockIdx.x, rdy, 1};
          EpiGateUp E{(bf16*)(ws + WS_ACT)};
          pg8::gemm_phase<EpiGateUp, SchedMoe, true>(c.lds, 1024, 1024, S, E); }
        { SchedMoe S{(const char*)(ws + WS_ACT), (size_t)256 * 512 * 2, (const char*)(ws + WS_WDN) + (size_t)layer * 32 * 1024 * 512 * 2, (size_t)1024 * 512 * 2, (size_t)256 * 512 * 2, tab, (const int*)(ws + WS_LIST), c.G, (int)blockIdx.x, rdy, 2};
          EpiDown E{(const int*)(ws + WS_LIST), (const float*)(ws + WS_W2), (bf16*)(ws + WS_Y2)};
          pg8::gemm_phase<EpiDown, SchedMoe, false>(c.lds, 512, 512, S, E); } }
    else if constexpr (KIND == K_RPOOL) ph_rpool(a, c, layer);
    else if constexpr (KIND == K_POOLG) {
        SchedDense S{(const char*)(ws + WS_HB), (const char*)(ws + WS_WPOOL), (size_t)256 * 1024 * 2, (size_t)256 * 256 * 2, (size_t)256 * 2, 68, 4, c.G, (int)blockIdx.x};
        EpiResid E{&a, layer, a.in[I_POOLS], (const float*)(ws + WS_Z)};
        pg8::gemm_phase<EpiResid, SchedDense, false>(c.lds, 256, 1024, S, E); }
    else if constexpr (KIND == K_INPROJ) {
        SchedDense S{(const char*)(ws + WS_HB), (const char*)(ws + WS_WIN), (size_t)256 * 1024 * 2, (size_t)256 * 1024 * 2, 0, 68, 21, c.G, (int)blockIdx.x};
        EpiInproj E{(bf16*)(ws + WS_Z), (bf16*)(ws + WS_XBC), (float*)(ws + WS_DT), a.in[I_DTB]};
        pg8::gemm_phase<EpiInproj, SchedDense, false>(c.lds, 1024, 1024, S, E); }
    else if constexpr (KIND == K_CONV) ph_conv(a, c);
    else if constexpr (KIND == K_SCAN) ph_scan(a, c);
    else if constexpr (KIND == K_YPH) ph_yph(a, c);
    else if constexpr (KIND == K_GFIX) ph_gfix(a, c);
    else if constexpr (KIND == K_OUTPROJ) {
        SchedDense S{(const char*)(ws + WS_G), (const char*)(ws + WS_WOUT), (size_t)256 * 2048 * 2, (size_t)256 * 2048 * 2, 0, 68, 4, c.G, (int)blockIdx.x};
        EpiResid E{&a, layer, nullptr, nullptr};
        pg8::gemm_phase<EpiResid, SchedDense, false>(c.lds, 2048, 2048, S, E); }
    else if constexpr (KIND == K_FINAL) ph_final(a, c, layer);
}
#define PROGRAM(X) \
    X(0, K_P0, 0) \
    X(1, K_RMIX, 0) X(2, K_QKV, 0) X(3, K_ATT, 0) X(4, K_OPROJ, 0) X(5, K_M1, 0) X(6, K_M2, 0) \
    X(7, K_RPOOL, 1) X(8, K_POOLG, 1) X(9, K_M1, 1) X(10, K_M2, 1) \
    X(11, K_RMIX, 2) X(12, K_INPROJ, 2) X(13, K_CONV, 2) X(14, K_SCAN, 2) X(15, K_YPH, 2) X(16, K_OUTPROJ, 2) X(17, K_M1, 2) X(18, K_M2, 2) \
    X(19, K_RMIX, 3) X(20, K_QKV, 3) X(21, K_ATT, 3) X(22, K_OPROJ, 3) X(23, K_M1, 3) X(24, K_M2, 3) \
    X(25, K_FINAL, 4)
constexpr int NPHASES = 26;
__device__ __forceinline__ unsigned long long probe_phases(const unsigned long long* ts, unsigned mask) { unsigned long long r = 0; for (int k = 0; k < 32; ++k) if (mask & (1u << k)) r += ts[k + 1] - ts[k]; return r; }
__device__ __forceinline__ unsigned long long probe_sum(const unsigned long long* s, int mask) { unsigned long long r = 0; for (int k = 0; k < 8; ++k) if (mask & (1 << k)) r += s[k]; return r; }
__global__ void __launch_bounds__(NTHREADS, 2) mega(Args a0) {
    extern __shared__ __attribute__((aligned(16))) unsigned char lds_raw[];
    Ctx c; c.lds = (LAS unsigned char*)lds_raw; c.tid = threadIdx.x; c.lane = c.tid & 63; c.wave = __builtin_amdgcn_readfirstlane(c.tid >> 6);
    c.G = gridDim.x; { const int bx = blockIdx.x; c.vcu = (c.G % 8 == 0) ? (bx % 8) * (c.G / 8) + bx / 8 : bx; }
    volatile LAS unsigned* MISC = (volatile LAS unsigned*)(c.lds + MISC_OFF);
    for (int u = c.tid; u < 128; u += NTHREADS) MISC[u] = 0u;
    __syncthreads();
    XcdBarrier bar = xcd_barrier_post((unsigned*)(a0.ws + WS_CTL) + CW_BAR + a0.bar_region * XCD_BAR_WORDS, MISC + 8);
    const int lo = a0.ph_lo, hi = a0.ph_hi;
#if PROBE
#define STAMP(idx) if (blockIdx.x == 0 && threadIdx.x == 0) __hip_atomic_store((unsigned long long*)((unsigned*)(a0.ws + WS_CTL) + CW_TS) + (idx), (unsigned long long)__builtin_amdgcn_s_memrealtime(), __ATOMIC_RELAXED, __HIP_MEMORY_SCOPE_AGENT);
#else
#define STAMP(idx)
#endif
    STAMP(0)
#if EXTRA_BARS
    for (int eb = 0; eb < EXTRA_BARS; ++eb) xcd_barrier(bar);
#endif
#define RUNPH(idx, KIND, LAYER) if (lo <= (idx) && (idx) < hi) { run_phase<KIND, LAYER>(a0, c, lds_raw); if ((idx) + 1 < hi) xcd_barrier(bar); STAMP((idx) + 1) }
    PROGRAM(RUNPH)
#undef RUNPH
#if PROBE
    if (blockIdx.x == 0 && threadIdx.x == 0 && hi == NPHASES) { const unsigned long long* ts = (const unsigned long long*)((unsigned*)(a0.ws + WS_CTL) + CW_TS);
        const unsigned long long d = (unsigned long long)PROBE_K * (PROBE_SLOT ? probe_sum(ts + 40, PROBE_SLOT) : probe_phases(ts, PROBE_MASK)), t0 = __builtin_amdgcn_s_memrealtime();
        while (__builtin_amdgcn_s_memrealtime() - t0 < d) __builtin_amdgcn_s_sleep(8); }
#endif
}

extern "C" void kernel_launch(void* const* d_in, const int* in_sizes, int n_in, void* d_out, int out_size, void* d_ws, size_t ws_size, hipStream_t stream) {
    static int grid = 0;
    if (grid == 0) {
        if (n_in != N_IN || out_size != TL * D || ws_size < WS_END) { fprintf(stderr, "kernel_launch: unexpected shapes (n_in %d out %d ws %zu)\n", n_in, out_size, ws_size); grid = -1; return; }
        int dev = 0, cus = 0;
        if (hipGetDevice(&dev) != hipSuccess || hipDeviceGetAttribute(&cus, hipDeviceAttributeMultiprocessorCount, dev) != hipSuccess) { grid = -1; return; }
        if (hipFuncSetAttribute((const void*)mega, hipFuncAttributeMaxDynamicSharedMemorySize, LDS_BYTES) != hipSuccess) { fprintf(stderr, "kernel_launch: hipFuncSetAttribute failed\n"); grid = -1; return; }
        int per_cu = 0;
        if (hipOccupancyMaxActiveBlocksPerMultiprocessor(&per_cu, (const void*)mega, NTHREADS, LDS_BYTES) != hipSuccess || per_cu < 1) fprintf(stderr, "kernel_launch: occupancy query says %d\n", per_cu);
        (void)hipGetLastError();
        grid = cus;
    }
    if (grid < 0) return;
    (void)hipMemsetAsync((char*)d_ws + WS_CTL, 0, CTL_ZERO_BYTES, stream);
    Args a{};
    for (int i = 0; i < N_IN; ++i) a.in[i] = (const float*)d_in[i];
    a.out = (float*)d_out; a.ws = (unsigned char*)d_ws; a.flags = 0;
#if DEBUG_CHECKS
    struct Cut { int after; int ty, layer, nid; };
    const Cut cuts[] = DEBUG_CUTS;
    int lo = 0, region = 0, dbg_id = 1;
    for (unsigned k = 0; k < sizeof(cuts) / sizeof(cuts[0]); ++k) {
        if (cuts[k].after + 1 > lo) { a.ph_lo = lo; a.ph_hi = cuts[k].after + 1; a.bar_region = region++; hipLaunchKernelGGL(mega, dim3(grid), dim3(NTHREADS), LDS_BYTES, stream, a); lo = cuts[k].after + 1; }
        hipLaunchKernelGGL(dbg_kernel, dim3(16), dim3(NTHREADS), 65536, stream, a, cuts[k].ty, cuts[k].layer, dbg_id); dbg_id += cuts[k].nid;
    }
    a.ph_lo = lo; a.ph_hi = NPHASES; a.bar_region = region++;
    hipLaunchKernelGGL(mega, dim3(grid), dim3(NTHREADS), LDS_BYTES, stream, a);
#else
    a.ph_lo = 0; a.ph_hi = NPHASES; a.bar_region = 0;
    hipLaunchKernelGGL(mega, dim3(grid), dim3(NTHREADS), LDS_BYTES, stream, a);
#endif
}
```

```cpp
#include <hip/hip_runtime.h>
#include <cstdio>
#include <cstdint>

#define LAS __attribute__((address_space(3)))
#define GAS __attribute__((address_space(1)))
typedef unsigned short bf16;
typedef short bf16x8 __attribute__((ext_vector_type(8)));
typedef short s16x4 __attribute__((ext_vector_type(4)));
typedef float f32x2 __attribute__((ext_vector_type(2)));
typedef float f32x4 __attribute__((ext_vector_type(4)));
typedef float f32x16 __attribute__((ext_vector_type(16)));
typedef unsigned u32x2 __attribute__((ext_vector_type(2)));
typedef unsigned u32x4 __attribute__((ext_vector_type(4)));
typedef __bf16 bf16x2_t __attribute__((ext_vector_type(2)));

constexpr int D = 1024, NB = 4, SEQ = 4096, CTXL = 256, TL = NB * SEQ, TC = NB * CTXL, TT = TL + TC;
constexpr int KVROWS = SEQ + CTXL;
constexpr int NCH = TT / 128;
constexpr int MOE_CAP = TT;
constexpr float EPS = 1e-6f;
constexpr int NWAVES = 8, NTHREADS = 512;
#ifndef NLAYERS
#define NLAYERS 4
#endif
#ifndef MOE_FP8
#define MOE_FP8 1
#endif
#define MOE_WSH 5
#define MOE_ASH 2
#define DBG_TOL 0.03f
#ifndef DEBUG_CHECKS
#define DEBUG_CHECKS 0
#endif
#ifndef PROBE
#define PROBE 0
#endif
#define PROBE_A0 0
#define PROBE_A1 1
#define PROBE_B0 4
#define PROBE_B1 5
#define PROBE_K 2
#define PROBE_MASK 0x1222224u
#define EXTRA_BARS 0
#define PROBE_SLOT_BASE 40
#define PROBE_SLOT 0
#if PROBE
#define SECT_DECL unsigned long long sect_t = __builtin_amdgcn_s_memrealtime(); unsigned long long sect_acc[8] = {0, 0, 0, 0, 0, 0, 0, 0};
#define SECT(k) do { const unsigned long long n_ = __builtin_amdgcn_s_memrealtime(); sect_acc[k] += n_ - sect_t; sect_t = n_; } while (0)
#define SECT_END(base) do { if (blockIdx.x == 0 && threadIdx.x == 0) { _Pragma("unroll") for (int k_ = 0; k_ < 8; ++k_) ((unsigned long long*)((unsigned*)(a.ws + WS_CTL) + CW_TS))[(base) + k_] = sect_acc[k_]; } } while (0)
#else
#define SECT_DECL
#define SECT(k) do {} while (0)
#define SECT_END(base) do {} while (0)
#endif
#define DEBUG_CUTS { {1, 1, 0, 1}, {2, 2, 0, 1}, {3, 3, 0, 1}, {4, 4, 0, 1}, {6, 5, 0, 2} }

enum { I_X = 0, I_C, I_CTX, I_CCTX, I_WADA, I_BADA, I_NMIX, I_NFFN, I_NFIN, I_WQKV, I_WO, I_QG, I_KG, I_POOLW, I_POOLS, I_WIN, I_CONVW, I_CONVB, I_DTB, I_ALOG, I_DSK, I_SNORM, I_WOUT, I_WRG, I_WRE, I_WGU, I_WDN, N_IN };

constexpr size_t MiB = 1u << 20;
constexpr size_t WS_CTL = 0, CTL_ZERO_BYTES = 1 * MiB;
constexpr size_t WS_MODL = 1 * MiB;
constexpr size_t WS_MODC = WS_MODL + 4 * 4 * 6144 * 4;
constexpr size_t WS_ROPE = 1 * MiB + 512 * 1024;
constexpr size_t WS_WR = 2 * MiB;
constexpr size_t WS_WQKV = 3 * MiB;
constexpr size_t WS_WO = 9 * MiB;
constexpr size_t WS_WPOOL = 13 * MiB;
constexpr size_t WS_WIN = 14 * MiB;
constexpr size_t WS_WOUT = 25 * MiB;
constexpr size_t WS_WGU = 29 * MiB;
constexpr size_t WS_WDN = 285 * MiB;
constexpr size_t WS_X = 413 * MiB;
constexpr size_t WS_HB = 481 * MiB;
constexpr size_t WS_TK = 515 * MiB;
constexpr size_t WS_Q = 549 * MiB;
constexpr size_t WS_K = 583 * MiB;
constexpr size_t WS_V = 592 * MiB;
constexpr size_t WS_Y2 = 601 * MiB;
constexpr size_t WS_ACT = 669 * MiB;
constexpr size_t WS_LIST = 711 * MiB;
constexpr size_t WS_W2 = 714 * MiB;
constexpr size_t WS_Z = 715 * MiB;
constexpr size_t WS_XBC = 783 * MiB;
constexpr size_t WS_DT = 885 * MiB;
constexpr size_t WS_XT = 890 * MiB;
constexpr size_t WS_BN = 958 * MiB;
constexpr size_t WS_BT = 975 * MiB;
constexpr size_t WS_CN = 992 * MiB;
constexpr size_t WS_SCA = 1009 * MiB;
constexpr size_t WS_SCB = 1018 * MiB;
constexpr size_t WS_DEC = 1027 * MiB;
constexpr size_t WS_HIN = 1028 * MiB;
constexpr size_t WS_G = 1164 * MiB;
constexpr size_t WS_RSTD = 1232 * MiB;
constexpr size_t WS_END = 1233 * MiB;

constexpr int CW_BAR = 4096;
constexpr int CW_CNT = 200000;
constexpr int CW_DBG = 201000;
constexpr int CW_RDY = 204000;
constexpr int CW_TS = 202000;

constexpr int LDS_BYTES = 163840;
constexpr int MISC_OFF = LDS_BYTES - 512;

__device__ __forceinline__ unsigned cvtpk(float lo, float hi) { f32x2 v = {lo, hi}; bf16x2_t b = __builtin_convertvector(v, bf16x2_t); return __builtin_bit_cast(unsigned, b); }
__device__ __forceinline__ unsigned pk_fp8x4(float a, float b, float c, float d) {
    a = __builtin_amdgcn_fmed3f(a, -448.f, 448.f); b = __builtin_amdgcn_fmed3f(b, -448.f, 448.f); c = __builtin_amdgcn_fmed3f(c, -448.f, 448.f); d = __builtin_amdgcn_fmed3f(d, -448.f, 448.f);
    unsigned w = __builtin_amdgcn_cvt_pk_fp8_f32(a, b, 0u, false); return __builtin_amdgcn_cvt_pk_fp8_f32(c, d, w, true); }
__device__ __forceinline__ float bflo(unsigned u) { return __uint_as_float(u << 16); }
__device__ __forceinline__ float bfhi(unsigned u) { return __uint_as_float(u & 0xffff0000u); }
__device__ __forceinline__ float bf2f(bf16 b) { return __uint_as_float((unsigned)b << 16); }
__device__ __forceinline__ float wave_sum(float v) {
#pragma unroll
    for (int o = 1; o < 64; o <<= 1) v += __shfl_xor(v, o);
    return v;
}
__device__ __forceinline__ float silu_f(float v) { return v * __builtin_amdgcn_rcpf(1.0f + __builtin_amdgcn_exp2f(v * -1.4426950408889634f)); }
__device__ __forceinline__ int tid_opaque() { int t = threadIdx.x; asm volatile("" : "+v"(t)); return t; }
#define LDS_WAIT() asm volatile("s_waitcnt lgkmcnt(0)" ::: "memory")
#define VM_WAIT() asm volatile("s_waitcnt vmcnt(0)" ::: "memory")

#define XB_TMO      128
#define XB_XCNT(j)  (256  + 64 * (j))
#define XB_XSUB(j)  (1280 + 64 * (j))
#define XB_XGEN(j)  (2304 + 64 * (j))
#define XB_TOP      3328
#define XB_TOPGEN   3392
#define XCD_BAR_WORDS 3456
#define XB_SPIN_CAP (1u << 20)
__device__ __forceinline__ unsigned xb_ld(unsigned* p)              { return __hip_atomic_load(p, __ATOMIC_RELAXED, __HIP_MEMORY_SCOPE_AGENT); }
__device__ __forceinline__ unsigned xb_add(unsigned* p, unsigned v) { return __hip_atomic_fetch_add(p, v, __ATOMIC_RELAXED, __HIP_MEMORY_SCOPE_AGENT); }
__device__ __forceinline__ unsigned xb_xcc_id() { return (unsigned)__builtin_amdgcn_s_getreg((3 << 11) | 20) & 0xFu; }
#define XB_SPIN(cond, bar) do { unsigned _sp = 0; while (cond) { __builtin_amdgcn_s_sleep(1); \
    if ((++_sp & 255u) == 0u) { if (xb_ld(&(bar)[XB_TMO])) break; if (_sp > XB_SPIN_CAP) { atomicAdd(&(bar)[XB_TMO], 1u); break; } } } } while (0)
struct XcdBarrier { unsigned* bar; unsigned x; volatile LAS unsigned* st; };
__device__ __forceinline__ XcdBarrier xcd_barrier_post(unsigned* bar, volatile LAS unsigned* st) {
    XcdBarrier b; b.bar = bar; b.x = xb_xcc_id(); b.st = st;
    if (threadIdx.x == 0) (void)xb_add(&bar[XB_XCNT(b.x)], 1u);
    return b;
}
__device__ __forceinline__ void xcd_barrier_complete(unsigned* bar, unsigned x, unsigned& nloc, unsigned& nx) {
    const unsigned G = gridDim.x * gridDim.y * gridDim.z;
    unsigned sum, cnt, mine, sp = 0u;
    for (;;) {
        sum = 0u; cnt = 0u; mine = 0u;
#pragma unroll
        for (unsigned j = 0; j < 16; ++j) { const unsigned c = xb_ld(&bar[XB_XCNT(j)]); sum += c; cnt += (c > 0u) ? 1u : 0u; mine = (j == x) ? c : mine; }
        if (sum == G) break;
        __builtin_amdgcn_s_sleep(1);
        if ((++sp & 255u) == 0u) { if (xb_ld(&bar[XB_TMO])) break; if (sp > XB_SPIN_CAP) { atomicAdd(&bar[XB_TMO], 1u); break; } }
    }
    nloc = mine > 0u ? mine : 1u; nx = cnt > 0u ? cnt : 1u;
}
__device__ __forceinline__ void xcd_barrier(const XcdBarrier& b) {
    asm volatile("s_waitcnt vmcnt(0)" ::: "memory");
    __syncthreads();
    if (threadIdx.x == 0) {
        unsigned* bar = b.bar;
        __builtin_amdgcn_s_waitcnt(0);
        unsigned nloc = b.st[0], nx = b.st[1];
        if (nloc == 0u) { xcd_barrier_complete(bar, b.x, nloc, nx); b.st[0] = nloc; b.st[1] = nx; }
        const unsigned old = xb_add(&bar[XB_XSUB(b.x)], 1u);
        const unsigned gen = old / nloc;
        if (old + 1u == (gen + 1u) * nloc) {
            __builtin_amdgcn_fence(__ATOMIC_RELEASE, "agent");
            asm volatile("s_waitcnt vmcnt(0)" ::: "memory");
            const unsigned og = xb_add(&bar[XB_TOP], 1u);
            const unsigned tg = og / nx;
            if (og + 1u == (tg + 1u) * nx) xb_add(&bar[XB_TOPGEN], 1u);
            else XB_SPIN(xb_ld(&bar[XB_TOPGEN]) == tg, bar);
            __builtin_amdgcn_fence(__ATOMIC_ACQUIRE, "agent");
            xb_add(&bar[XB_XGEN(b.x)], 1u);
            asm volatile("s_waitcnt vmcnt(0)" ::: "memory");
        } else {
            XB_SPIN(xb_ld(&bar[XB_XGEN(b.x)]) == gen, bar);
            __builtin_amdgcn_fence(__ATOMIC_ACQUIRE, "agent");
            asm volatile("s_waitcnt vmcnt(0)" ::: "memory");
        }
    }
    __syncthreads();
}

enum { K_P0 = 0, K_RMIX, K_QKV, K_ROPE, K_ATT, K_OPROJ, K_M1, K_M2, K_M3, K_RPOOL, K_POOLG, K_INPROJ, K_CONV, K_SCAN, K_YPH, K_GFIX, K_OUTPROJ, K_FINAL, K_DBG };
struct Args { const float* in[N_IN]; float* out; unsigned char* ws; int ph_lo, ph_hi; int flags; int bar_region; };

struct Ctx {
    LAS unsigned char* lds; int tid, lane, wave, vcu, G;
};

__device__ __forceinline__ const float* mod_row(const Args& a, int layer, int r) {
    return r < TL ? (const float*)(a.ws + WS_MODL) + (size_t)(layer * 4 + r / SEQ) * 6144 : (const float*)(a.ws + WS_MODC) + (size_t)layer * 6144;
}
__device__ __forceinline__ const float* resid_row(const Args& a, int layer, int r) {
    if (layer == 0) return r < TL ? a.in[I_X] + (size_t)r * D : a.in[I_CTX] + (size_t)(r - TL) * D;
    return (const float*)(a.ws + WS_X) + (size_t)r * D;
}

__device__ __forceinline__ void load_row_combined(const Args& a, int layer, int r, int lane, f32x4 (&v)[4]) {
    const f32x4* xr = (const f32x4*)resid_row(a, layer, r) + lane;
#pragma unroll
    for (int j = 0; j < 4; ++j) v[j] = xr[64 * j];
    if (layer > 0 && !(a.flags & 1)) {
        const f32x4* gf = (const f32x4*)(mod_row(a, layer - 1, r) + 5 * D) + lane;
        const u32x2* y0 = (const u32x2*)((const bf16*)(a.ws + WS_Y2) + (size_t)(2 * r) * D) + lane;
        const u32x2* y1 = (const u32x2*)((const bf16*)(a.ws + WS_Y2) + (size_t)(2 * r + 1) * D) + lane;
#pragma unroll
        for (int j = 0; j < 4; ++j) {
            const u32x2 p = y0[64 * j], q = y1[64 * j]; const f32x4 g = gf[64 * j];
            v[j].x += g.x * (bflo(p.x) + bflo(q.x)); v[j].y += g.y * (bfhi(p.x) + bfhi(q.x));
            v[j].z += g.z * (bflo(p.y) + bflo(q.y)); v[j].w += g.w * (bfhi(p.y) + bfhi(q.y));
        }
    }
}
__device__ __forceinline__ float row_rstd(const f32x4 (&v)[4]) {
    float s = 0.f;
#pragma unroll
    for (int j = 0; j < 4; ++j) s += (v[j].x * v[j].x + v[j].y * v[j].y) + (v[j].z * v[j].z + v[j].w * v[j].w);
    return rsqrtf(wave_sum(s) * (1.0f / D) + EPS);
}
__device__ __forceinline__ void norm_mod(const f32x4 (&v)[4], float rstd, const float* g, const float* shift, const float* scale, int lane, f32x4 (&h)[4]) {
#pragma unroll
    for (int j = 0; j < 4; ++j) {
        const f32x4 gg = ((const f32x4*)g)[lane + 64 * j], sh = ((const f32x4*)shift)[lane + 64 * j], sc = ((const f32x4*)scale)[lane + 64 * j];
        h[j] = (v[j] * rstd) * gg * (sc + 1.0f) + sh;
    }
}

__device__ __forceinline__ void tr_item(const float* W, int N, int k0, int n0, bf16* WT, size_t drow0, int dK, LAS float* scr, int lane, int hi_skip = 0) {
    const int nq = lane & 15, kr = lane >> 4;
#pragma unroll
    for (int i = 0; i < 16; ++i) { const int kk = 4 * i + kr; const f32x4 v = *(const f32x4*)(W + (size_t)(k0 + kk) * N + n0 + 4 * nq);
        LAS float* d = scr + kk * 65 + 4 * nq; d[0] = v.x; d[1] = v.y; d[2] = v.z; d[3] = v.w; }
    LDS_WAIT(); asm volatile("" ::: "memory");
    const int c = lane & 7;
#pragma unroll
    for (int j = 0; j < 8; ++j) { const int n = (lane >> 3) + 8 * j; const LAS float* s = scr + (8 * c) * 65 + n;
        u32x4 o; o.x = cvtpk(s[0 * 65], s[1 * 65]); o.y = cvtpk(s[2 * 65], s[3 * 65]); o.z = cvtpk(s[4 * 65], s[5 * 65]); o.w = cvtpk(s[6 * 65], s[7 * 65]);
        *(u32x4*)(WT + (drow0 + n + (n >= 32 ? hi_skip : 0)) * dK + k0 + 8 * c) = o; }
    LDS_WAIT(); asm volatile("" ::: "memory");
}
__device__ __forceinline__ void tr_item8(const float* W, int N, int k0, int n0, unsigned char* WT, size_t drow0, int dKb, LAS float* scr, int lane, float scale) {
    const int nq = lane & 15, kr = lane >> 4;
#pragma unroll
    for (int i = 0; i < 16; ++i) { const int kk = 4 * i + kr; const f32x4 v = *(const f32x4*)(W + (size_t)(k0 + kk) * N + n0 + 4 * nq);
        LAS float* d = scr + kk * 65 + 4 * nq; d[0] = v.x; d[1] = v.y; d[2] = v.z; d[3] = v.w; }
    LDS_WAIT(); asm volatile("" ::: "memory");
    const int c = lane & 3;
#pragma unroll
    for (int j = 0; j < 4; ++j) { const int n = (lane >> 2) + 16 * j; const LAS float* s = scr + (16 * c) * 65 + n;
        u32x4 o; o.x = pk_fp8x4(s[0 * 65] * scale, s[1 * 65] * scale, s[2 * 65] * scale, s[3 * 65] * scale); o.y = pk_fp8x4(s[4 * 65] * scale, s[5 * 65] * scale, s[6 * 65] * scale, s[7 * 65] * scale);
        o.z = pk_fp8x4(s[8 * 65] * scale, s[9 * 65] * scale, s[10 * 65] * scale, s[11 * 65] * scale); o.w = pk_fp8x4(s[12 * 65] * scale, s[13 * 65] * scale, s[14 * 65] * scale, s[15 * 65] * scale);
        *(u32x4*)(WT + (drow0 + n) * dKb + k0 + 16 * c) = o; }
    LDS_WAIT(); asm volatile("" ::: "memory");
}
__device__ __forceinline__ void p0_prologue(const Args& a, const Ctx& c) {
    LAS float* scr = (LAS float*)(c.lds + c.wave * 16896);
    const int gw = c.vcu * NWAVES + c.wave, NGW = c.G * NWAVES;
    constexpr int I0 = 2 * 384, I1 = 2 * 256, I2 = 4 * 16, I3 = 16 * 81, I4 = 32 * 16, I5 = 128 * 256, I6 = 128 * 128, ITOT = I0 + I1 + I2 + I3 + I4 + I5 + I6;
    for (int it = gw; it < ITOT; it += NGW) {
        int r = it;
        if (r < I5) { const int m = r / 256, q = r % 256, kb = q / 16, nb = q % 16; const int n0 = nb * 64;
            const int j = n0 & 511, drow = 256 * (j >> 7) + (j & 127) + ((n0 >= 512) ? 128 : 0);
#if MOE_FP8
            tr_item8(a.in[I_WGU] + (size_t)m * 1024 * 1024, 1024, kb * 64, n0, (unsigned char*)(a.ws + WS_WGU) + (size_t)m * 1024 * 1024, drow, 1024, scr, c.lane, (float)(1 << MOE_WSH)); continue; }
#else
            tr_item(a.in[I_WGU] + (size_t)m * 1024 * 1024, 1024, kb * 64, n0, (bf16*)(a.ws + WS_WGU) + (size_t)m * 1024 * 1024, drow, 1024, scr, c.lane); continue; }
#endif
        r -= I5;
        if (r < I6) { const int m = r / 128, q = r % 128, kb = q / 16, nb = q % 16;
#if MOE_FP8
            tr_item8(a.in[I_WDN] + (size_t)m * 512 * 1024, 1024, kb * 64, nb * 64, (unsigned char*)(a.ws + WS_WDN) + (size_t)m * 1024 * 512, nb * 64, 512, scr, c.lane, (float)(1 << MOE_WSH)); continue; }
#else
            tr_item(a.in[I_WDN] + (size_t)m * 512 * 1024, 1024, kb * 64, nb * 64, (bf16*)(a.ws + WS_WDN) + (size_t)m * 1024 * 512, nb * 64, 512, scr, c.lane); continue; }
#endif
        r -= I6;
        if (r < I0) { const int m = r / 384, q = r % 384, kb = q / 24, nb = q % 24;
            tr_item(a.in[I_WQKV] + (size_t)m * 1024 * 1536, 1536, kb * 64, nb * 64, (bf16*)(a.ws + WS_WQKV) + (size_t)m * 1536 * 1024, (nb >> 2) * 256 + (nb & 3) * 32, 1024, scr, c.lane, 96); continue; }
        r -= I0;
        if (r < I1) { const int m = r / 256, q = r % 256, kb = q / 16, nb = q % 16;
            tr_item(a.in[I_WO] + (size_t)m * 1024 * 1024, 1024, kb * 64, nb * 64, (bf16*)(a.ws + WS_WO) + (size_t)m * 1024 * 1024, nb * 64, 1024, scr, c.lane); continue; }
        r -= I1;
        if (r < I2) { const int m = r / 16, q = r % 16, kb = q / 4, nb = q % 4;
            tr_item(a.in[I_POOLW] + (size_t)m * 256 * 256, 256, kb * 64, nb * 64, (bf16*)(a.ws + WS_WPOOL) + (size_t)m * 256 * 256, nb * 64, 256, scr, c.lane); continue; }
        r -= I2;
        if (r < I3) { const int kb = r / 81, nb = r % 81;
            tr_item(a.in[I_WIN], 5184, kb * 64, nb * 64, (bf16*)(a.ws + WS_WIN), nb * 64, 1024, scr, c.lane); continue; }
        r -= I3;
        { const int kb = r / 16, nb = r % 16;
            tr_item(a.in[I_WOUT], 1024, kb * 64, nb * 64, (bf16*)(a.ws + WS_WOUT), nb * 64, 2048, scr, c.lane); }
    }
    __syncthreads();
    LAS float* sv = (LAS float*)c.lds;
    LAS float* part = (LAS float*)(c.lds + 20480);
    for (int u = c.tid; u < 5 * 1024; u += NTHREADS) { const int v = u >> 10, k = u & 1023; const float x = v < 4 ? a.in[I_C][v * 1024 + k] : a.in[I_CCTX][k]; sv[u] = x / (1.0f + expf(-x)); }
    __syncthreads();
    for (int item = blockIdx.x; item < 4 * 96; item += c.G) {
        const int li = item / 96, c0 = (item % 96) * 64, cq = c.tid & 15, ks = c.tid >> 4;
        f32x4 acc[5];
#pragma unroll
        for (int v = 0; v < 5; ++v) acc[v] = (f32x4){0.f, 0.f, 0.f, 0.f};
        const float* w = a.in[I_WADA] + ((size_t)li * 1024 + ks * 32) * 6144 + c0 + 4 * cq;
#pragma unroll 4
        for (int k = 0; k < 32; ++k) { const f32x4 wv = *(const f32x4*)(w + (size_t)k * 6144);
#pragma unroll
            for (int v = 0; v < 5; ++v) acc[v] += wv * sv[v * 1024 + ks * 32 + k]; }
#pragma unroll
        for (int v = 0; v < 5; ++v) *(LAS f32x4*)(part + (ks * 16 + cq) * 20 + v * 4) = acc[v];
        __syncthreads();
        if (c.tid < 320) { const int v = c.tid >> 6, col = c.tid & 63, q = col >> 2, e = col & 3; float s = 0.f;
            for (int k2 = 0; k2 < 32; ++k2) s += part[(k2 * 16 + q) * 20 + v * 4 + e];
            s += a.in[I_BADA][li * 6144 + c0 + col];
            if (v < 4) ((float*)(a.ws + WS_MODL))[(size_t)(li * 4 + v) * 6144 + c0 + col] = s; else ((float*)(a.ws + WS_MODC))[(size_t)li * 6144 + c0 + col] = s; }
        __syncthreads();
    }
    if (blockIdx.x == (unsigned)(c.G - 1)) for (int u = c.tid; u < 1024; u += NTHREADS) { const int pos = u >> 4, f = u & 15;
        const float inv = (float)pow(10000.0, -(double)f / 16.0); const double ang = (double)((float)pos * inv);
        ((f32x2*)(a.ws + WS_ROPE))[u] = (f32x2){(float)cos(ang), (float)sin(ang)}; }
    for (int u = blockIdx.x * NTHREADS + c.tid; u < 4 * 64 * 1024; u += c.G * NTHREADS) { const int li = u >> 16, n = (u >> 10) & 63, k = u & 1023;
        float w = 0.f; if (n < 4) w = a.in[I_WRG][((size_t)li * 1024 + k) * 4 + n]; else if (n < 36) w = a.in[I_WRE][((size_t)li * 1024 + k) * 32 + (n - 4)];
        const unsigned hi = cvtpk(w, 0.f) & 0xffffu; const float rem = w - bflo(hi); const unsigned lo = cvtpk(rem, 0.f) & 0xffffu;
        bf16* wr = (bf16*)(a.ws + WS_WR) + (size_t)li * 2 * 65536; wr[n * 1024 + k] = (bf16)hi; wr[65536 + n * 1024 + k] = (bf16)lo; }
}

__device__ __forceinline__ void ph_rmix(const Args& a, const Ctx& c, int layer) {
    const int gw = c.vcu * NWAVES + c.wave, NGW = c.G * NWAVES;
    const float* g = a.in[I_NMIX] + layer * D;
    for (int r = gw; r < TT; r += NGW) {
        f32x4 v[4], h[4]; load_row_combined(a, layer, r, c.lane, v);
        if (layer > 0) { f32x4* xo = (f32x4*)((float*)(a.ws + WS_X) + (size_t)r * D) + c.lane;
#pragma unroll
            for (int j = 0; j < 4; ++j) xo[64 * j] = v[j]; }
        const float rstd = row_rstd(v); const float* m = mod_row(a, layer, r);
        norm_mod(v, rstd, g, m, m + D, c.lane, h);
        u32x2* ho = (u32x2*)((bf16*)(a.ws + WS_HB) + (size_t)r * D) + c.lane;
#pragma unroll
        for (int j = 0; j < 4; ++j) ho[64 * j] = (u32x2){cvtpk(h[j].x, h[j].y), cvtpk(h[j].z, h[j].w)};
    }
}

__device__ __forceinline__ void ph_final(const Args& a, const Ctx& c, int layer) {
    const int gw = c.vcu * NWAVES + c.wave, NGW = c.G * NWAVES;
    float dscale = 1.f, dmark = 0.f;
#if DEBUG_CHECKS
    { unsigned* dbg = (unsigned*)(a.ws + WS_CTL) + CW_DBG; int code = 0; float mag = 0.f;
      for (int id = 1; id < 32; ++id) { const float e = __uint_as_float(__hip_atomic_load(dbg + id, __ATOMIC_RELAXED, __HIP_MEMORY_SCOPE_AGENT)); if (code == 0 && e > DBG_TOL) { code = id; mag = e; } }
      dscale = 1.f + (float)code; dmark = code ? 100.f * (1.f + fminf(fmaxf(log2f(mag / DBG_TOL), 0.f), 30.f)) : 0.f; }
#endif
    for (int r = gw; r < TL; r += NGW) {
        f32x4 v[4]; load_row_combined(a, layer, r, c.lane, v);
        const float rstd = row_rstd(v) * dscale;
        f32x4* o = (f32x4*)(a.out + (size_t)r * D) + c.lane;
#pragma unroll
        for (int j = 0; j < 4; ++j) { f32x4 ov = (v[j] * rstd) * ((const f32x4*)a.in[I_NFIN])[c.lane + 64 * j]; if (j == 0 && r == 0 && c.lane == 0 && dmark > 0.f) ov.x = dmark; o[64 * j] = ov; }
    }
}


namespace pg8 {
constexpr int BM = 256, BK = 64, HALF = 128, HTB = HALF * BK * 2, STAGE_BYTES = 8 * HTB;
__host__ __device__ __forceinline__ int lds_byte(int r, int c) { const int st = (r >> 4) * 2 + (c >> 5), rr = r & 15, cc = c & 31, ob = rr * 64 + cc * 2; return st * 1024 + (ob ^ (((ob >> 9) & 1) << 5)); }
__host__ __device__ __forceinline__ void stage_rc(int b, int& R, int& C) { const int st = b / 1024, sb = b % 1024, swz = sb ^ (((sb >> 9) & 1) << 5); R = (st >> 1) * 16 + swz / 64; C = (st & 1) * 32 + (swz % 64) / 2; }
__host__ __device__ __forceinline__ int perm32(int rho) { const int n = rho >> 4, i = rho & 15; return 8 * (i >> 2) + 4 * n + (i & 3); }
struct Unit { const char* A; const char* B; int pm, pn, x0, x1; };
__device__ __forceinline__ void tile_of(int L, int nM, int nN, int& pm, int& pn) {
    const int nwg = nM * nN; int wgid = L; { const int q = nwg / 8, r = nwg % 8, xcd = wgid % 8, off = wgid / 8; wgid = (xcd < r ? xcd * (q + 1) : r * (q + 1) + (xcd - r) * q) + off; }
    const int nig = 8 * nN, gid = wgid / nig, fm = gid * 8, gsz = (nM - fm) < 8 ? (nM - fm) : 8;
    pm = fm + ((wgid % nig) % gsz); pn = (wgid % nig) / gsz;
}
typedef int v4i_t __attribute__((ext_vector_type(4))); typedef int v8i_t __attribute__((ext_vector_type(8)));
template <class Epi, class Sched, bool GATHER, bool FP8 = false>
__device__ __forceinline__ void gemm_phase(LAS unsigned char* lds, const int Kb, const int ldab, const Sched& S, const Epi& E, const int scw = 127, const int sca = 127) {
    const int tid = tid_opaque(), wid = __builtin_amdgcn_readfirstlane(tid >> 6), lane = tid & 63, wr = wid >> 2, wc = wid & 3, fr = lane & 15, fq = lane >> 4;
    const int nt = Kb / (BK * 2);
    int scw_v = scw, sca_v = sca;
    unsigned voffA[2], voffB[2]; int RA[2], CA[2];
#pragma unroll
    for (int i = 0; i < 2; ++i) { int R, C; stage_rc(tid * 16 + i * 8192, R, C); const int Rb = Epi::PERM ? ((R & ~31) + perm32(R & 31)) : R;
        RA[i] = R; CA[i] = C; voffA[i] = (unsigned)(R * ldab + C * 2); voffB[i] = (unsigned)(Rb * Kb + C * 2); }
    const size_t kstep = (size_t)(BK * 2);
    const size_t hstepA = (size_t)HALF * ldab, hstepB = (size_t)HALF * Kb;
    const unsigned ldsw = (unsigned)wid * 1024u;
    const int aoff = lds_byte(wr * 64 + fr, fq * 8), boff = lds_byte(wc * 32 + fr, fq * 8);
#define PG8_SA(b, h) (((b) * 2 + (h)) * HTB)
#define PG8_SB(b, h) ((4 + (b) * 2 + (h)) * HTB)
#define PG8_GLDS(bufoff, gptr, i_) __builtin_amdgcn_global_load_lds((const unsigned*)(gptr), (LAS unsigned*)(lds + (bufoff) + ldsw + (i_) * 8192), 16, 0, 0)
#define PG8_STAGE_B(bufoff, gbase) do { _Pragma("unroll") for (int _i = 0; _i < 2; ++_i) PG8_GLDS(bufoff, (const char*)(gbase) + voffB[_i], _i); } while (0)
#define PG8_STAGE_A(bufoff, ab, kb, h, NX) do { _Pragma("unroll") for (int _i = 0; _i < 2; ++_i) { \
        if constexpr (GATHER) { const unsigned _vo = (NX) ? voN[h][_i] : voC[h][_i]; PG8_GLDS(bufoff, (ab) + (kb) + _vo, _i); } \
        else { PG8_GLDS(bufoff, (ab) + (kb) + (size_t)(h) * hstepA + voffA[_i], _i); } } } while (0)
#define PG8_LDA(dst, b, h) do { _Pragma("unroll") for (int m = 0; m < 4; ++m) _Pragma("unroll") for (int k = 0; k < 2; ++k) dst[m][k] = *(const LAS bf16x8*)(lds + PG8_SA(b, h) + aoff + m * 2048 + k * 1024); } while (0)
#define PG8_LDB(dst, b, h) do { _Pragma("unroll") for (int n = 0; n < 2; ++n) _Pragma("unroll") for (int k = 0; k < 2; ++k) dst[n][k] = *(const LAS bf16x8*)(lds + PG8_SB(b, h) + boff + n * 2048 + k * 1024); } while (0)
#define PG8_MMA(ai, bj, At, Bt) do { __builtin_amdgcn_s_setprio(1); _Pragma("unroll") for (int m = 0; m < 4; ++m) _Pragma("unroll") for (int n = 0; n < 2; ++n) { \
        if constexpr (FP8) { const v8i_t b8 = __builtin_shufflevector(__builtin_bit_cast(v4i_t, Bt[n][0]), __builtin_bit_cast(v4i_t, Bt[n][1]), 0, 1, 2, 3, 4, 5, 6, 7), a8 = __builtin_shufflevector(__builtin_bit_cast(v4i_t, At[m][0]), __builtin_bit_cast(v4i_t, At[m][1]), 0, 1, 2, 3, 4, 5, 6, 7); \
            asm volatile("v_mfma_scale_f32_16x16x128_f8f6f4 %0, %1, %2, %0, %3, %4 op_sel_hi:[0,0,0]" : "+v"(acc[ai][bj][m][n]) : "v"(b8), "v"(a8), "v"(scw_v), "v"(sca_v)); } \
        else { _Pragma("unroll") for (int k = 0; k < 2; ++k) acc[ai][bj][m][n] = __builtin_amdgcn_mfma_f32_16x16x32_bf16(Bt[n][k], At[m][k], acc[ai][bj][m][n], 0, 0, 0); } } __builtin_amdgcn_s_setprio(0); } while (0)
#define PG8_WAIT_V(n) asm volatile("s_waitcnt vmcnt(" #n ")" ::: "memory")
#define PG8_WAIT_L(n) asm volatile("s_waitcnt lgkmcnt(" #n ")" ::: "memory")
#define PG8_BAR __builtin_amdgcn_s_barrier()
#define PG8_SCHED __builtin_amdgcn_sched_barrier(0)
    Unit cur, nxt, pend; int ui = 0; bool have_pend = false;
    if (!S.next(0, cur)) return;
    pend = cur;
    unsigned voC[2][2], voN[2][2];
    if constexpr (GATHER) {
#pragma unroll
        for (int h = 0; h < 2; ++h)
#pragma unroll
            for (int i = 0; i < 2; ++i) { voC[h][i] = (unsigned)(S.gather(cur, h * HALF + RA[i]) * ldab + CA[i] * 2); voN[h][i] = voC[h][i]; }
    } else { voC[0][0] = voN[0][0] = 0u; }
    f32x4 acc[2][2][4][2];
#pragma unroll
    for (int a = 0; a < 2; ++a)
#pragma unroll
        for (int b = 0; b < 2; ++b)
#pragma unroll
            for (int m = 0; m < 4; ++m)
#pragma unroll
                for (int n = 0; n < 2; ++n) acc[a][b][m][n] = (f32x4){0.f, 0.f, 0.f, 0.f};
    bf16x8 At[4][2], B0[2][2], B1[2][2];
    const char* cA = cur.A; const char* cB = cur.B;
    S.a_ready(cur, wid);
    PG8_STAGE_B(PG8_SB(0, 0), cB); PG8_STAGE_B(PG8_SB(0, 1), cB + hstepB); PG8_STAGE_A(PG8_SA(0, 0), cA, (size_t)0, 0, false); PG8_STAGE_A(PG8_SA(0, 1), cA, (size_t)0, 1, false);
    if (wr == 1) PG8_BAR;
    PG8_WAIT_V(2); PG8_BAR;
    PG8_STAGE_B(PG8_SB(1, 0), cB + kstep); PG8_STAGE_A(PG8_SA(1, 0), cA, kstep, 0, false); PG8_STAGE_B(PG8_SB(1, 1), cB + hstepB + kstep);
    PG8_WAIT_V(6); PG8_BAR;
    for (;;) {
        const bool has_next = S.next(ui + 1, nxt);
        if constexpr (GATHER) { if (has_next) {
#pragma unroll
            for (int h = 0; h < 2; ++h)
#pragma unroll
                for (int i = 0; i < 2; ++i) voN[h][i] = (unsigned)(S.gather(nxt, h * HALF + RA[i]) * ldab + CA[i] * 2); } }
        const char* nA = has_next ? nxt.A : cA; const char* nB = has_next ? nxt.B : cB;
        for (int t = 0; t < nt; t += 2) {
            const bool last = (t == nt - 2);
            const size_t k1 = (size_t)(t + 1) * kstep;
            const char* a2 = last ? nA : cA; const size_t k2 = last ? (size_t)0 : (size_t)(t + 2) * kstep; const size_t k3 = k2 + kstep;
            const char* b2 = last ? nB : cB + (size_t)(t + 2) * kstep; const char* b3 = b2 + kstep;
            const bool nx = GATHER ? (last && has_next) : false;
            if (last && has_next) S.a_ready(nxt, wid);
            PG8_LDB(B0, 0, 0); PG8_LDB(B1, 0, 1); PG8_SCHED; PG8_LDA(At, 0, 0); PG8_STAGE_A(PG8_SA(1, 1), cA, k1, 1, false);
            PG8_WAIT_V(8); PG8_WAIT_L(0); PG8_BAR; PG8_MMA(0, 0, At, B0); PG8_MMA(0, 1, At, B1); PG8_BAR; PG8_SCHED;
            PG8_LDA(At, 0, 1); PG8_STAGE_B(PG8_SB(0, 0), b2); PG8_STAGE_B(PG8_SB(0, 1), b2 + hstepB); PG8_STAGE_A(PG8_SA(0, 0), a2, k2, 0, nx);
            PG8_WAIT_V(8); PG8_WAIT_L(0);
            if (have_pend) { S.done(pend, lane); have_pend = false; }
            PG8_BAR; PG8_MMA(1, 0, At, B0); PG8_MMA(1, 1, At, B1); PG8_BAR; PG8_SCHED;
            PG8_LDB(B0, 1, 0); PG8_LDB(B1, 1, 1); PG8_SCHED; PG8_LDA(At, 1, 0); PG8_STAGE_A(PG8_SA(0, 1), a2, k2, 1, nx);
            PG8_WAIT_V(8); PG8_WAIT_L(0); PG8_BAR; PG8_MMA(0, 0, At, B0); PG8_MMA(0, 1, At, B1); PG8_BAR; PG8_SCHED;
            PG8_LDA(At, 1, 1); PG8_STAGE_B(PG8_SB(1, 0), b3); PG8_STAGE_B(PG8_SB(1, 1), b3 + hstepB); PG8_STAGE_A(PG8_SA(1, 0), a2, k3, 0, nx);
            PG8_WAIT_V(8); PG8_WAIT_L(0); PG8_BAR; PG8_MMA(1, 0, At, B0); PG8_MMA(1, 1, At, B1); PG8_BAR; PG8_SCHED;
        }
        if (wr == 0) PG8_BAR;
        if constexpr (FP8) asm volatile("s_nop 15\n\ts_nop 15" ::: "memory");
        E(acc, cur, wr, wc, fr, fq);
        pend = cur; have_pend = true;
        if (!has_next) break;
#pragma unroll
        for (int a = 0; a < 2; ++a)
#pragma unroll
            for (int b = 0; b < 2; ++b)
#pragma unroll
                for (int m = 0; m < 4; ++m)
#pragma unroll
                    for (int n = 0; n < 2; ++n) acc[a][b][m][n] = (f32x4){0.f, 0.f, 0.f, 0.f};
        cur = nxt; cA = nA; cB = nB; ++ui;
        if constexpr (GATHER) {
#pragma unroll
            for (int h = 0; h < 2; ++h)
#pragma unroll
                for (int i = 0; i < 2; ++i) voC[h][i] = voN[h][i]; }
        if (wr == 1) PG8_BAR;
    }
    PG8_WAIT_V(0);
    if (have_pend) S.done(pend, lane);
    PG8_BAR;
#undef PG8_SA
#undef PG8_SB
#undef PG8_GLDS
#undef PG8_STAGE_A
#undef PG8_STAGE_B
#undef PG8_LDA
#undef PG8_LDB
#undef PG8_MMA
#undef PG8_WAIT_V
#undef PG8_WAIT_L
#undef PG8_BAR
#undef PG8_SCHED
}
}
#include <hip/hip_bf16.h>
#include <cmath>
namespace attn_body {
using bf16=__hip_bfloat16;
using bf16x8=__attribute__((ext_vector_type(8)))short;
using s16x4=__attribute__((ext_vector_type(4)))short;
using f32x16=__attribute__((ext_vector_type(16)))float;
using u32x4=__attribute__((ext_vector_type(4)))unsigned;
constexpr int D=64,QP=1024,KVP=256;
constexpr int NW=8,QBLK=32,QB=QBLK*NW,KVBLK=64;
__device__ __forceinline__ int crow(int r,int hi){return (r&3)+8*(r>>2)+4*hi;}
#define SBAR() __builtin_amdgcn_sched_barrier(0)
constexpr int NSLOT=3, SLOTB=8192;
constexpr int LDS_K=0, LDS_V=NSLOT*SLOTB, LDS_WS=2*NSLOT*SLOTB, LDS_OST=LDS_WS+NW*64*4, LDS_BYTES=LDS_OST+NW*4096;
constexpr float C2=0.125f*1.4426950408889634f;
__device__ __forceinline__ void glds16s(const void*sbase,unsigned voff,unsigned lds_dst){unsigned keep;
  asm volatile("s_mov_b32 %0, m0\n\ts_mov_b32 m0, %3\n\ts_nop 4\n\tglobal_load_lds_dwordx4 %1, %2\n\ts_mov_b32 m0, %0":"=&s"(keep):"v"(voff),"s"(sbase),"s"(lds_dst):"memory");}
__device__ __forceinline__ float max3f(float a,float b,float c){float r;asm("v_max3_f32 %0, %1, %2, %3":"=v"(r):"v"(a),"v"(b),"v"(c));return r;}
__device__ __forceinline__ float max2f(float a,float b){float r;asm("v_max_f32_e32 %0, %1, %2":"=v"(r):"v"(a),"v"(b));return r;}
__device__ __forceinline__ float fadd_s(float a,float b){float r;asm("v_add_f32_e32 %0, %1, %2":"=v"(r):"v"(a),"v"(b));return r;}
__device__ __forceinline__ float fsub_s(float a,float b){float r;asm("v_sub_f32_e32 %0, %1, %2":"=v"(r):"v"(a),"v"(b));return r;}
typedef float f32x2_t __attribute__((ext_vector_type(2))); typedef __bf16 bf16x2_t __attribute__((ext_vector_type(2)));
__device__ __forceinline__ unsigned cvtpk_s(float lo,float hi){f32x2_t v={lo,hi};bf16x2_t b=__builtin_convertvector(v,bf16x2_t);return __builtin_bit_cast(unsigned,b);}
#define WAIT_BAR(N) asm volatile("s_waitcnt vmcnt(" #N ") lgkmcnt(0)\n\ts_barrier":::"memory")

__device__ __forceinline__ void qkt(f32x16&p0,f32x16&p1,const char*Kslot,const bf16x8*qr,const f32x16&negm,int r32,int hi){
  const char*kb=Kslot+hi*1024+r32*16;
  #pragma unroll
  for(int d0=0;d0<4;++d0){
    const bf16x8 b0=*reinterpret_cast<const bf16x8*>(kb+d0*2048);
    const bf16x8 b1=*reinterpret_cast<const bf16x8*>(kb+d0*2048+512);
    if(d0==0){p0=__builtin_amdgcn_mfma_f32_32x32x16_bf16(b0,qr[0],negm,0,0,0);p1=__builtin_amdgcn_mfma_f32_32x32x16_bf16(b1,qr[0],negm,0,0,0);}
    else{p0=__builtin_amdgcn_mfma_f32_32x32x16_bf16(b0,qr[d0],p0,0,0,0);p1=__builtin_amdgcn_mfma_f32_32x32x16_bf16(b1,qr[d0],p1,0,0,0);}}
}
typedef __attribute__((address_space(3))) const char* lds_cptr;
typedef short v4i16_t __attribute__((ext_vector_type(4)));
__device__ __forceinline__ void kload8(bf16x8*kf,lds_cptr kp){
  kf[0]=*(const __attribute__((address_space(3))) bf16x8*)(kp);      kf[1]=*(const __attribute__((address_space(3))) bf16x8*)(kp+512);
  kf[2]=*(const __attribute__((address_space(3))) bf16x8*)(kp+2048); kf[3]=*(const __attribute__((address_space(3))) bf16x8*)(kp+2560);
  kf[4]=*(const __attribute__((address_space(3))) bf16x8*)(kp+4096); kf[5]=*(const __attribute__((address_space(3))) bf16x8*)(kp+4608);
  kf[6]=*(const __attribute__((address_space(3))) bf16x8*)(kp+6144); kf[7]=*(const __attribute__((address_space(3))) bf16x8*)(kp+6656);
}
__device__ __forceinline__ void kload2(bf16x8*kf,lds_cptr kp,int j){ kf[2*j]=*(const __attribute__((address_space(3))) bf16x8*)(kp+j*2048); kf[2*j+1]=*(const __attribute__((address_space(3))) bf16x8*)(kp+j*2048+512); }
__device__ __forceinline__ s16x4 vtr(lds_cptr p){ return __builtin_bit_cast(s16x4,__builtin_amdgcn_ds_read_tr16_b64_v4i16((__attribute__((address_space(3))) v4i16_t*)p)); }
__device__ __forceinline__ float rowmax(const f32x16&p0,const f32x16&p1){
  float a=max3f(p0[0],p0[1],p1[0]),b=max3f(p0[2],p0[3],p1[1]);a=max3f(a,p1[2],p1[3]);
  #pragma unroll
  for(int r=4;r<16;r+=4){a=max3f(a,p0[r],p0[r+1]);b=max3f(b,p0[r+2],p0[r+3]);a=max3f(a,p1[r],p1[r+1]);b=max3f(b,p1[r+2],p1[r+3]);}
  const float m=max2f(a,b);
  auto rr=__builtin_amdgcn_permlane32_swap(__float_as_uint(m),__float_as_uint(m),false,false);
  return max2f(__uint_as_float(rr[0]),__uint_as_float(rr[1]));
}
__device__ __forceinline__ void pv(f32x16*o,int vb,bf16x8 pa0,bf16x8 pa1,bf16x8 pa2,bf16x8 pa3){
  #pragma unroll
  for(int d0=0;d0<2;++d0){s16x4 lo[4],hi[4];
    #pragma unroll
    for(int ks=0;ks<4;++ks){
      asm volatile("ds_read_b64_tr_b16 %0,%1 offset:%c2":"=&v"(lo[ks]):"v"(vb),"i"(d0*4096+ks*1024):"memory");
      asm volatile("ds_read_b64_tr_b16 %0,%1 offset:%c2":"=&v"(hi[ks]):"v"(vb),"i"(d0*4096+ks*1024+512):"memory");}
    asm volatile("s_waitcnt lgkmcnt(0)":::"memory");SBAR();
    #define PK(k) (bf16x8){lo[k][0],lo[k][1],lo[k][2],lo[k][3],hi[k][0],hi[k][1],hi[k][2],hi[k][3]}
    o[d0]=__builtin_amdgcn_mfma_f32_32x32x16_bf16(pa0,PK(0),o[d0],0,0,0);
    o[d0]=__builtin_amdgcn_mfma_f32_32x32x16_bf16(pa1,PK(1),o[d0],0,0,0);
    o[d0]=__builtin_amdgcn_mfma_f32_32x32x16_bf16(pa2,PK(2),o[d0],0,0,0);
    o[d0]=__builtin_amdgcn_mfma_f32_32x32x16_bf16(pa3,PK(3),o[d0],0,0,0);
    #undef PK
  }
}

#ifndef ATTN_STORE16
#define ATTN_STORE16(p,v) (*(u32x4*)(p)=(v))
#endif
template<int THRL> __device__ __forceinline__ void attn_unit(long qrow0,int h,long kvrow0,int NT,const bf16*Q,const bf16*__restrict__ K,const bf16*__restrict__ V,bf16*O,char*shm){
  const int tid=tid_opaque(),lane=tid&63,r32=lane&31,hi=lane>>5; const int wid=__builtin_amdgcn_readfirstlane(tid>>6);
  const bf16*Qw=Q+(qrow0+wid*QBLK)*QP+h*D;
  const bf16*Kh=K+kvrow0*KVP+(h>>2)*D,*Vh=V+kvrow0*KVP+(h>>2)*D;
  const unsigned lds0=(unsigned)(uintptr_t)shm;
  float*wsf=(float*)(shm+LDS_WS)+wid*64;
  const unsigned kvo=(unsigned)(lane*KVP+wid*8)*2u;
  const unsigned vvo=(unsigned)((16*(wid&3)+(lane>>2))*KVP+(wid>>2)*32+(lane&3)*8)*2u;
  const unsigned kdst=lds0+LDS_K+wid*1024, vdst=lds0+LDS_V+wid*1024;
  #define DMA_K(t,slot) glds16s(Kh+(long)(t)*KVBLK*KVP,kvo,(unsigned)__builtin_amdgcn_readfirstlane(kdst+(slot)))
  #define DMA_V(t,slot) glds16s(Vh+(long)(t)*KVBLK*KVP,vvo,(unsigned)__builtin_amdgcn_readfirstlane(vdst+(slot)))
  const int vb0=(int)(lds0+LDS_V)+((lane>>4)&1)*32+(lane&3)*8+(4*hi+((lane&15)>>2))*64;
  const char*Kbase=shm+LDS_K; bf16x8 kf[8];
  const lds_cptr shm3=(lds_cptr)shm; const lds_cptr kp0=shm3+LDS_K+hi*1024+r32*16; const lds_cptr vp0=shm3+LDS_V+((lane>>4)&1)*32+(lane&3)*8+(4*hi+((lane&15)>>2))*64;
  DMA_K(0,0);DMA_V(0,0);DMA_K(1,SLOTB);
  bf16x8 qr[4];
  #pragma unroll
  for(int d0=0;d0<4;++d0)qr[d0]=*reinterpret_cast<const bf16x8*>(&Qw[(long)r32*QP+d0*16+hi*8]);
  float mhat=0.f,l_reg=0.f;f32x16 o[2];o[0]=f32x16{};o[1]=f32x16{};f32x16 negm=f32x16{};asm volatile("":"+v"(negm));
  #define CMASK(P0,P1,t) do{}while(0)
  bool resc=false;
  #define START(P0,P1) do{ const float rm=rowmax(P0,P1); resc=false; \
    { const float dl=rm; mhat=fadd_s(mhat,dl); \
      _Pragma("unroll") for(int r=0;r<16;++r){P0[r]=fsub_s(P0[r],dl);P1[r]=fsub_s(P1[r],dl);} \
      _Pragma("unroll") for(int r=0;r<16;++r)negm[r]=-mhat; asm volatile("":"+v"(negm)); } \
    _Pragma("unroll") for(int r=0;r<16;++r)P0[r]=__builtin_amdgcn_exp2f(P0[r]); }while(0)
  #define RESC() do{ if(resc){ asm volatile("s_waitcnt lgkmcnt(0)":::"memory"); \
      _Pragma("unroll") for(int d_=0;d_<2;++d_) _Pragma("unroll") for(int r=0;r<16;++r)o[d_][r]*=wsf[crow(r,hi)]; } }while(0)
  f32x16 pA0,pA1,pB0,pB1;
  int sl_prev=0,sl_cur=0,sl_next=SLOTB;
  #define ROT() do{sl_prev=sl_cur;sl_cur=sl_next;sl_next=(sl_next==(NSLOT-1)*SLOTB)?0:sl_next+SLOTB;}while(0)
  DMA_K(2,2*SLOTB);
  WAIT_BAR(3);
  qkt(pA0,pA1,Kbase,qr,negm,r32,hi);asm volatile("s_nop 15\n\ts_nop 7":"+v"(pA0),"+v"(pA1));CMASK(pA0,pA1,0);
  START(pA0,pA1);
  _Pragma("unroll") for(int r=0;r<16;++r)pA1[r]=__builtin_amdgcn_exp2f(pA1[r]);
  WAIT_BAR(0);
  DMA_K(3,0);DMA_V(1,SLOTB);
  ROT();
  kload8(kf,kp0+sl_cur);
  WAIT_BAR(2);
  s16x4 vlo[8],vhi[8]; u32x4 pw0,pw1,pw2,pw3;
  #define PKW(P,B) cvtpk_s(P[B],P[B+1])
  #define PAF(k) __builtin_bit_cast(bf16x8,pw##k)
  #define VFR(i) (bf16x8){vlo[i][0],vlo[i][1],vlo[i][2],vlo[i][3],vhi[i][0],vhi[i][1],vhi[i][2],vhi[i][3]}
  #define PIN(x) asm volatile("":"+v"(x))
  #define MX3(a,b,c) __builtin_fmaxf(__builtin_fmaxf((a),(b)),(c))
  #define GAPA(MF,A0,A1,A2,A3,W0,W1,PW) do{ MF; sacc+=A0; sacc+=A1; sacc+=A2; sacc+=A3; PIN(sacc); W0; W1; PIN(PW); SBAR(); }while(0)
  #define EX(v) __builtin_amdgcn_exp2f(v)
  #define GAPB(MF,X,B) do{ MF; X[B]=EX(X[B]); X[B+1]=EX(X[B+1]); X[B+2]=EX(X[B+2]); X[B+3]=EX(X[B+3]); PIN(X); SBAR(); }while(0)
  #define VRD(i) do{ vlo[i]=vtr(vp_+(((i)>>2)*4096+((i)&3)*1024)); vhi[i]=vtr(vp_+(((i)>>2)*4096+((i)&3)*1024+512)); }while(0)
  #define KRD(G,j) do{ if(G){ kload2(kf,kp0+sl_next,j); SBAR(); } }while(0)
  #define STEP(C0,C1,P0,P1,t,GK,GV,GL) do{ SBAR(); \
    const lds_cptr vp_=vp0+sl_prev; \
    VRD(0); SBAR(); float sacc=(P0[0]+P0[1]); \
    GAPA(C0=__builtin_amdgcn_mfma_f32_32x32x16_bf16(kf[0],qr[0],negm,0,0,0), P0[2],P0[3],P0[4],P0[5],     pw0[0]=PKW(P0,0), pw0[1]=PKW(P0,2), pw0); \
    VRD(4); SBAR(); GAPA(C1=__builtin_amdgcn_mfma_f32_32x32x16_bf16(kf[1],qr[0],negm,0,0,0), P0[6],P0[7],P0[8],P0[9],     pw0[2]=PKW(P0,4), pw0[3]=PKW(P0,6), pw0); \
    VRD(1); SBAR(); GAPA(C0=__builtin_amdgcn_mfma_f32_32x32x16_bf16(kf[2],qr[1],C0,0,0,0),   P0[10],P0[11],P0[12],P0[13], pw1[0]=PKW(P0,8), pw1[1]=PKW(P0,10), pw1); \
    VRD(5); SBAR(); GAPA(C1=__builtin_amdgcn_mfma_f32_32x32x16_bf16(kf[3],qr[1],C1,0,0,0),   P0[14],P0[15],P1[0],P1[1],   pw1[2]=PKW(P0,12),pw1[3]=PKW(P0,14), pw1); \
    VRD(2); SBAR(); GAPA(C0=__builtin_amdgcn_mfma_f32_32x32x16_bf16(kf[4],qr[2],C0,0,0,0),   P1[2],P1[3],P1[4],P1[5],     pw2[0]=PKW(P1,0), pw2[1]=PKW(P1,2), pw2); \
    VRD(6); SBAR(); GAPA(C1=__builtin_amdgcn_mfma_f32_32x32x16_bf16(kf[5],qr[2],C1,0,0,0),   P1[6],P1[7],P1[8],P1[9],     pw2[2]=PKW(P1,4), pw2[3]=PKW(P1,6), pw2); \
    VRD(3); SBAR(); GAPA(C0=__builtin_amdgcn_mfma_f32_32x32x16_bf16(kf[6],qr[3],C0,0,0,0),   P1[10],P1[11],P1[12],P1[13], pw3[0]=PKW(P1,8), pw3[1]=PKW(P1,10), pw3); \
    VRD(7); SBAR(); GAPA(C1=__builtin_amdgcn_mfma_f32_32x32x16_bf16(kf[7],qr[3],C1,0,0,0),   P1[14],P1[15],0.f,0.f,       pw3[2]=PKW(P1,12),pw3[3]=PKW(P1,14), pw3); \
    l_reg+=sacc; \
    if(GK){DMA_K((t)+3,sl_cur);} if(GV){DMA_V((t)+1,sl_next);} \
    CMASK(C0,C1,t); \
    { float a=MX3(C0[0],C0[1],C1[0]),b=MX3(C0[2],C0[3],C1[1]); a=MX3(a,C1[2],C1[3]); \
      _Pragma("unroll") for(int r=4;r<16;r+=4){a=MX3(a,C0[r],C0[r+1]);b=MX3(b,C0[r+2],C0[r+3]);a=MX3(a,C1[r],C1[r+1]);b=MX3(b,C1[r+2],C1[r+3]);} \
      float rm=__builtin_fmaxf(a,b); { auto rr=__builtin_amdgcn_permlane32_swap(__float_as_uint(rm),__float_as_uint(rm),false,false); rm=__builtin_fmaxf(__uint_as_float(rr[0]),__uint_as_float(rr[1])); } \
      resc=false; \
      if(__builtin_expect(__any(rm>(float)THRL),0)){ const float dl=__builtin_fmaxf(rm,0.f); mhat+=dl; \
        _Pragma("unroll") for(int r=0;r<16;++r){C0[r]-=dl;C1[r]-=dl;} \
        _Pragma("unroll") for(int r=0;r<16;++r)negm[r]=-mhat; asm volatile("":"+v"(negm)); \
        const float f=__builtin_amdgcn_exp2f(-dl); l_reg*=f; if(hi==0)wsf[r32]=f; resc=true; } } \
    SBAR(); \
    GAPB(o[0]=__builtin_amdgcn_mfma_f32_32x32x16_bf16(PAF(0),VFR(0),o[0],0,0,0), C0,0); \
    GAPB(o[1]=__builtin_amdgcn_mfma_f32_32x32x16_bf16(PAF(0),VFR(4),o[1],0,0,0), C0,4); \
    KRD(GL,0); GAPB(o[0]=__builtin_amdgcn_mfma_f32_32x32x16_bf16(PAF(1),VFR(1),o[0],0,0,0), C0,8); \
    KRD(GL,1); GAPB(o[1]=__builtin_amdgcn_mfma_f32_32x32x16_bf16(PAF(1),VFR(5),o[1],0,0,0), C0,12); \
    KRD(GL,2); GAPB(o[0]=__builtin_amdgcn_mfma_f32_32x32x16_bf16(PAF(2),VFR(2),o[0],0,0,0), C1,0); \
    KRD(GL,3); GAPB(o[1]=__builtin_amdgcn_mfma_f32_32x32x16_bf16(PAF(2),VFR(6),o[1],0,0,0), C1,4); \
    GAPB(o[0]=__builtin_amdgcn_mfma_f32_32x32x16_bf16(PAF(3),VFR(3),o[0],0,0,0), C1,8); \
    GAPB(o[1]=__builtin_amdgcn_mfma_f32_32x32x16_bf16(PAF(3),VFR(7),o[1],0,0,0), C1,12); \
    }while(0)
  int t=1;
  for(;t+5<NT;t+=2){
    STEP(pB0,pB1,pA0,pA1,t,true,true,true);     WAIT_BAR(2); RESC(); ROT();
    STEP(pA0,pA1,pB0,pB1,t+1,true,true,true);   WAIT_BAR(2); RESC(); ROT();
  }
  #define ENDW(tt) do{ if((tt)+3<NT){WAIT_BAR(2);} else if((tt)+2<NT){WAIT_BAR(1);} else {WAIT_BAR(0);} }while(0)
  for(;t+1<NT;t+=2){
    STEP(pB0,pB1,pA0,pA1,t,(t+3<NT),(t+1<NT),(t+1<NT));       ENDW(t);   RESC(); ROT();
    STEP(pA0,pA1,pB0,pB1,t+1,(t+4<NT),(t+2<NT),(t+2<NT));     ENDW(t+1); RESC(); ROT();
  }
  STEP(pB0,pB1,pA0,pA1,NT-1,false,false,false); RESC();
  { float sacc=pB0[0]+pB0[1]; _Pragma("unroll") for(int r=2;r<16;++r)sacc+=pB0[r]; _Pragma("unroll") for(int r=0;r<16;++r)sacc+=pB1[r]; l_reg+=sacc;
    pw0=(u32x4){PKW(pB0,0),PKW(pB0,2),PKW(pB0,4),PKW(pB0,6)};pw1=(u32x4){PKW(pB0,8),PKW(pB0,10),PKW(pB0,12),PKW(pB0,14)};pw2=(u32x4){PKW(pB1,0),PKW(pB1,2),PKW(pB1,4),PKW(pB1,6)};pw3=(u32x4){PKW(pB1,8),PKW(pB1,10),PKW(pB1,12),PKW(pB1,14)};
    SBAR(); pv(o,vb0+sl_cur,PAF(0),PAF(1),PAF(2),PAF(3)); }
  #undef PKW
  #undef PAF
  #undef VFR
  #undef PIN
  #undef MX3
  #undef GAPA
  #undef GAPB
  #undef EX
  #undef VRD
  #undef KRD
  #undef STEP
  #undef ENDW
  {auto rr=__builtin_amdgcn_permlane32_swap(__float_as_uint(l_reg),__float_as_uint(l_reg),false,false);l_reg=__uint_as_float(rr[0])+__uint_as_float(rr[1]);}
  if(hi==0)wsf[32+r32]=l_reg;asm volatile("s_waitcnt lgkmcnt(0)":::"memory");
  float rli[16];
  #pragma unroll
  for(int r=0;r<16;++r)rli[r]=__builtin_amdgcn_rcpf(wsf[32+crow(r,hi)]);
  bf16*Ow=O+(qrow0+wid*QBLK)*QP+h*D;
  { bf16*stg=(bf16*)(shm+LDS_OST)+wid*2048;
    #pragma unroll
    for(int r=0;r<16;++r){const int orow=crow(r,hi);
      #pragma unroll
      for(int d0=0;d0<2;++d0)stg[orow*64+d0*32+r32]=__float2bfloat16(o[d0][r]*rli[r]);}
    asm volatile("s_waitcnt lgkmcnt(0)":::"memory");
    #pragma unroll
    for(int i=0;i<4;++i){const int row=i*8+(lane>>3),ch=lane&7; const u32x4 v=*(const u32x4*)(stg+row*64+ch*8); ATTN_STORE16(Ow+(long)row*QP+ch*8,v);} }
  asm volatile("s_waitcnt lgkmcnt(0)\n\ts_barrier":::"memory");
  #undef DMA_K
  #undef DMA_V
  #undef CMASK
  #undef START
  #undef RESC
  #undef ROT
}
constexpr int ATTN_LDS_BYTES=LDS_BYTES;
#undef SBAR
#undef WAIT_BAR
}

typedef f32x4 AccT[2][2][4][2];
__device__ __forceinline__ long kv_row(int r) { return r < TL ? (long)(r / SEQ) * KVROWS + CTXL + (r % SEQ) : (long)((r - TL) / CTXL) * KVROWS + ((r - TL) % CTXL); }

struct SchedDense {
    const char* A; const char* B; size_t astep, bstep, acol; int nM, nN, G, c;
    __device__ __forceinline__ bool next(int i, pg8::Unit& u) const {
        const int L = i * G + c; if (L >= nM * nN) return false;
        pg8::tile_of(L, nM, nN, u.pm, u.pn); u.A = A + (size_t)u.pm * astep + (size_t)u.pn * acol; u.B = B + (size_t)u.pn * bstep; u.x0 = 0; u.x1 = 0; return true; }
    __device__ __forceinline__ int gather(const pg8::Unit&, int) const { return 0; }
    __device__ __forceinline__ void a_ready(const pg8::Unit&, int) const {}
    __device__ __forceinline__ void done(const pg8::Unit&, int) const {}
};
struct SchedQKV {
    const char* A; const char* B; int ctxq, G, c;
    __device__ __forceinline__ bool next(int i, pg8::Unit& u) const {
        const int L = i * G + c, n1 = 64 * 6, n2 = ctxq ? 24 : 8; if (L >= n1 + n2) return false;
        if (L < n1) pg8::tile_of(L, 64, 6, u.pm, u.pn);
        else if (ctxq) { pg8::tile_of(L - n1, 4, 6, u.pm, u.pn); u.pm += 64; }
        else { u.pm = 64 + ((L - n1) >> 1); u.pn = 4 + ((L - n1) & 1); }
        u.A = A + (size_t)u.pm * (256 * 1024 * 2); u.B = B + (size_t)u.pn * (256 * 1024 * 2); u.x0 = 0; u.x1 = 0; return true; }
    __device__ __forceinline__ int gather(const pg8::Unit&, int) const { return 0; }
    __device__ __forceinline__ void a_ready(const pg8::Unit&, int) const {}
    __device__ __forceinline__ void done(const pg8::Unit&, int) const {}
};
struct SchedMoe {
    const char* Abase; size_t astep; const char* Bbase; size_t bstep_e, bstep_n; const LAS int* tab; const int* list; int G, c;
    unsigned* ready; int mode;
    __device__ __forceinline__ int T(int i) const { return __builtin_amdgcn_readfirstlane(tab[i]); }
    __device__ __forceinline__ bool next(int i, pg8::Unit& u) const {
        const int ntiles = T(32), L = i * G + (mode == 2 ? G - 1 - c : c); if (L >= ntiles * 4) return false;
        int gt, pn; pg8::tile_of(L, ntiles, 4, gt, pn);
        int e = 0;
        for (int q = 1; q < 32; ++q) e += (T(q) <= gt) ? 1 : 0;
        const int ti = gt - T(e); int valid = T(40 + e) - ti * 256; valid = valid > 256 ? 256 : valid;
        u.pm = gt; u.pn = pn; u.x0 = e * MOE_CAP + ti * 256; u.x1 = valid;
        u.A = Abase + (size_t)gt * astep; u.B = Bbase + (size_t)e * bstep_e + (size_t)pn * bstep_n; return true; }
    __device__ __forceinline__ int gather(const pg8::Unit& u, int lr) const { return lr < u.x1 ? (list[u.x0 + lr] >> 1) : 0; }
    __device__ __forceinline__ void a_ready(const pg8::Unit& u, int wid) const {
        if (mode != 2) return;
        if (wid == 0) { unsigned sp = 0;
            while ((unsigned)__builtin_amdgcn_readfirstlane(__hip_atomic_load(ready + u.pm, __ATOMIC_RELAXED, __HIP_MEMORY_SCOPE_AGENT)) < 32u) { __builtin_amdgcn_s_sleep(2); if (++sp > (1u << 22)) break; }
            __builtin_amdgcn_fence(__ATOMIC_ACQUIRE, "agent"); asm volatile("s_waitcnt vmcnt(0)" ::: "memory"); }
        __builtin_amdgcn_s_barrier(); asm volatile("" ::: "memory");
    }
    __device__ __forceinline__ void done(const pg8::Unit& u, int lane) const {
        if (mode != 1) return;
        if (lane == 0) __hip_atomic_fetch_add(ready + u.pm, 1u, __ATOMIC_RELAXED, __HIP_MEMORY_SCOPE_AGENT);
    }
};

struct EpiQKV { static constexpr bool PERM = true; bf16* Q; bf16* Kb; bf16* Vb; const float* qg; const float* kg; const f32x2* tab;
    __device__ __forceinline__ void operator()(const AccT& acc, const pg8::Unit& u, int wr, int wc, int fr, int fq) const {
        bf16* base; int pitch; long row0;
        if (u.pn < 4) { base = Q + u.pn * 256; pitch = 1024; row0 = (long)u.pm * 256; }
        else { base = (u.pn == 4) ? Kb : Vb; pitch = 256; row0 = kv_row(u.pm * 256); }
        const bool isv = u.pn == 5, lat = u.pm < 64; const float* g = u.pn < 4 ? qg : kg; const float post = u.pn < 4 ? 0.125f * 1.4426950408889634f : 1.0f;
#pragma unroll
        for (int ai = 0; ai < 2; ++ai)
#pragma unroll
            for (int m = 0; m < 4; ++m) { int fq_ = fq; asm volatile("" : "+v"(fq_));
                const int fq = fq_; const int lr = ai * 128 + wr * 64 + m * 16 + fr; const unsigned roff = (unsigned)(((int)row0 + lr) * pitch + wc * 64 + 8 * fq) * 2u;
                f32x4 g0[2], g1[2];
#pragma unroll
                for (int bj = 0; bj < 2; ++bj) { g0[bj] = *(const f32x4*)(g + 32 * bj + 8 * fq); g1[bj] = *(const f32x4*)(g + 32 * bj + 8 * fq + 4); }
                f32x4 v[2][2];
#pragma unroll
                for (int bj = 0; bj < 2; ++bj) { v[bj][0] = acc[ai][bj][m][0]; v[bj][1] = acc[ai][bj][m][1]; }
                if (!isv) {
                    float ss = 0.f;
#pragma unroll
                    for (int bj = 0; bj < 2; ++bj)
#pragma unroll
                        for (int n = 0; n < 2; ++n) ss += (v[bj][n][0] * v[bj][n][0] + v[bj][n][1] * v[bj][n][1]) + (v[bj][n][2] * v[bj][n][2] + v[bj][n][3] * v[bj][n][3]);
                    ss += __shfl_xor(ss, 16); ss += __shfl_xor(ss, 32);
                    const float rstd = rsqrtf(ss * (1.0f / 64.0f) + EPS);
#pragma unroll
                    for (int bj = 0; bj < 2; ++bj) { v[bj][0] = v[bj][0] * rstd * g0[bj]; v[bj][1] = v[bj][1] * rstd * g1[bj]; }
                    if (lat) { const int t = (u.pm * 256 + lr) & (SEQ - 1);
#pragma unroll
                        for (int bj = 0; bj < 2; ++bj) { const f32x2* tb = (const f32x2*)((const char*)tab + (unsigned)(((bj == 0 ? (t >> 6) : (t & 63)) * 16 + 4 * fq) * 8));
#pragma unroll
                            for (int n = 0; n < 2; ++n)
#pragma unroll
                                for (int e = 0; e < 2; ++e) { const f32x2 cs = tb[2 * n + e]; const float x0 = v[bj][n][2 * e], x1 = v[bj][n][2 * e + 1];
                                    v[bj][n][2 * e] = x0 * cs.x - x1 * cs.y; v[bj][n][2 * e + 1] = x0 * cs.y + x1 * cs.x; } } }
#pragma unroll
                    for (int bj = 0; bj < 2; ++bj) { v[bj][0] = v[bj][0] * post; v[bj][1] = v[bj][1] * post; }
                }
#pragma unroll
                for (int bj = 0; bj < 2; ++bj)
                    *(u32x4*)((char*)base + roff + bj * 64) = (u32x4){cvtpk(v[bj][0][0], v[bj][0][1]), cvtpk(v[bj][0][2], v[bj][0][3]), cvtpk(v[bj][1][0], v[bj][1][1]), cvtpk(v[bj][1][2], v[bj][1][3])}; }
    }
};
struct EpiResid { static constexpr bool PERM = false; const Args* a; int layer; const float* pscale; const float* srcbase;
    __device__ __forceinline__ void operator()(const AccT& acc, const pg8::Unit& u, int wr, int wc, int fr, int fq) const {
        const int r0 = u.pm * 256;
        const float* src = srcbase ? srcbase + (size_t)r0 * D : resid_row(*a, layer, r0); const float* gate = mod_row(*a, layer, r0) + 2 * D; float* out = (float*)(a->ws + WS_X) + (size_t)r0 * D;
        const int col0 = u.pn * 256 + wc * 32 + 4 * fq;
#pragma unroll
        for (int bj = 0; bj < 2; ++bj)
#pragma unroll
            for (int n = 0; n < 2; ++n) { const int cc = col0 + bj * 128 + n * 16; f32x4 g = *(const f32x4*)(gate + cc); if (pscale) g = g * *(const f32x4*)(pscale + cc);
#pragma unroll
                for (int ai = 0; ai < 2; ++ai)
#pragma unroll
                    for (int m = 0; m < 4; ++m) { const size_t off = (size_t)(ai * 128 + wr * 64 + m * 16 + fr) * D + cc;
                        *(f32x4*)(out + off) = *(const f32x4*)(src + off) + g * acc[ai][bj][m][n]; } }
    }
};
struct EpiGateUp { static constexpr bool PERM = true; bf16* act;
    __device__ __forceinline__ void operator()(const AccT& acc, const pg8::Unit& u, int wr, int wc, int fr, int fq) const {
        const __amdgpu_buffer_rsrc_t rs = __builtin_amdgcn_make_buffer_rsrc((void*)act, 0, 43008 * 512 * 2, 0x00020000);
#pragma unroll
        for (int ai = 0; ai < 2; ++ai)
#pragma unroll
            for (int m = 0; m < 4; ++m) { const int off = (int)((((size_t)u.pm * 256 + ai * 128 + wr * 64 + m * 16 + fr) * 512 + u.pn * 128 + wc * 32 + 8 * fq) * 2);
                const f32x4 g0 = acc[ai][0][m][0], g1 = acc[ai][0][m][1], u0 = acc[ai][1][m][0], u1 = acc[ai][1][m][1];
                const u32x4 ov = (u32x4){cvtpk(silu_f(g0[0]) * u0[0], silu_f(g0[1]) * u0[1]), cvtpk(silu_f(g0[2]) * u0[2], silu_f(g0[3]) * u0[3]),
                                     cvtpk(silu_f(g1[0]) * u1[0], silu_f(g1[1]) * u1[1]), cvtpk(silu_f(g1[2]) * u1[2], silu_f(g1[3]) * u1[3])};
#if MOE_FP8
                { const float sa = (float)(1 << MOE_ASH); const u32x2 o8 = (u32x2){pk_fp8x4(silu_f(g0[0]) * u0[0] * sa, silu_f(g0[1]) * u0[1] * sa, silu_f(g0[2]) * u0[2] * sa, silu_f(g0[3]) * u0[3] * sa),
                                                                                    pk_fp8x4(silu_f(g1[0]) * u1[0] * sa, silu_f(g1[1]) * u1[1] * sa, silu_f(g1[2]) * u1[2] * sa, silu_f(g1[3]) * u1[3] * sa)};
                  (void)ov; __builtin_amdgcn_raw_buffer_store_b64(o8, rs, off >> 1, 0, 16  ); } }
#else
                __builtin_amdgcn_raw_buffer_store_b128(ov, rs, off, 0, 16  ); }
#endif
    }
};
struct EpiDown { static constexpr bool PERM = true; const int* list; const float* w2; bf16* y2;
    __device__ __forceinline__ void operator()(const AccT& acc, const pg8::Unit& u, int wr, int wc, int fr, int fq) const {
#pragma unroll
        for (int ai = 0; ai < 2; ++ai)
#pragma unroll
            for (int m = 0; m < 4; ++m) { const int lr = ai * 128 + wr * 64 + m * 16 + fr;
                if (lr < u.x1) { const int dest = list[u.x0 + lr]; const float w = w2[dest]; bf16* p = y2 + (size_t)dest * D + u.pn * 256 + wc * 32 + 8 * fq;
#pragma unroll
                    for (int bj = 0; bj < 2; ++bj) { const f32x4 v0 = acc[ai][bj][m][0] * w, v1 = acc[ai][bj][m][1] * w;
                        *(u32x4*)(p + bj * 128) = (u32x4){cvtpk(v0[0], v0[1]), cvtpk(v0[2], v0[3]), cvtpk(v1[0], v1[1]), cvtpk(v1[2], v1[3])}; } } }
    }
};

constexpr int TAB_OFF = 135168;

__device__ __forceinline__ void ph_rope(const Args& a, const Ctx& c, int layer) {
    const int j = layer == 0 ? 0 : 1; const bool ctxq = layer == 0;
    const float* qg = a.in[I_QG] + j * 64; const float* kg = a.in[I_KG] + j * 64;
    const f32x2* tab = (const f32x2*)(a.ws + WS_ROPE);
    bf16* Qb = (bf16*)(a.ws + WS_Q); bf16* Kb = (bf16*)(a.ws + WS_K);
    const int nitems = TT * 20;
    for (int it = blockIdx.x * NTHREADS + c.tid; it < nitems; it += c.G * NTHREADS) {
        const int r = it / 20, hs = it % 20;
        if (hs < 16 && r >= TL && !ctxq) continue;
        bf16* p; const float* g; float post;
        if (hs < 16) { p = Qb + (size_t)r * 1024 + hs * 64; g = qg; post = 0.125f * 1.4426950408889634f; } else { p = Kb + kv_row(r) * 256 + (hs - 16) * 64; g = kg; post = 1.0f; }
        float x[64]; float ss = 0.f;
#pragma unroll
        for (int i = 0; i < 8; ++i) { const u32x4 w = ((const u32x4*)p)[i];
            x[8 * i + 0] = bflo(w.x); x[8 * i + 1] = bfhi(w.x); x[8 * i + 2] = bflo(w.y); x[8 * i + 3] = bfhi(w.y);
            x[8 * i + 4] = bflo(w.z); x[8 * i + 5] = bfhi(w.z); x[8 * i + 6] = bflo(w.w); x[8 * i + 7] = bfhi(w.w); }
#pragma unroll
        for (int i = 0; i < 64; ++i) ss += x[i] * x[i];
        const float rstd = rsqrtf(ss * (1.0f / 64.0f) + EPS);
#pragma unroll
        for (int i = 0; i < 64; ++i) x[i] = x[i] * rstd * g[i];
        if (r < TL) { const int t = r % SEQ, rp = t >> 6, cp = t & 63;
#pragma unroll
            for (int i = 0; i < 32; ++i) { const f32x2 cs = tab[(i < 16 ? rp : cp) * 16 + (i & 15)]; const float x0 = x[2 * i], x1 = x[2 * i + 1];
                x[2 * i] = x0 * cs.x - x1 * cs.y; x[2 * i + 1] = x0 * cs.y + x1 * cs.x; } }
#pragma unroll
        for (int i = 0; i < 8; ++i) ((u32x4*)p)[i] = (u32x4){cvtpk(x[8 * i] * post, x[8 * i + 1] * post), cvtpk(x[8 * i + 2] * post, x[8 * i + 3] * post),
                                                            cvtpk(x[8 * i + 4] * post, x[8 * i + 5] * post), cvtpk(x[8 * i + 6] * post, x[8 * i + 7] * post)};
    }
}

__device__ __forceinline__ void ph_att(const Args& a, const Ctx& c, int layer, char* lds_generic) {
    const int nun = 1024 + (layer == 0 ? 64 : 0);
    const attn_body::bf16* Qb = (const attn_body::bf16*)(a.ws + WS_Q); const attn_body::bf16* Kb = (const attn_body::bf16*)(a.ws + WS_K); const attn_body::bf16* Vb = (const attn_body::bf16*)(a.ws + WS_V);
    for (int U = c.vcu; U < nun; U += c.G) {
        long qrow0, kv0; int h, NT;
        if (U < 1024) { const int bh = U >> 4, qb = U & 15, b = bh >> 4; h = bh & 15; qrow0 = (long)b * SEQ + qb * 256; kv0 = (long)b * KVROWS; NT = KVROWS / 64; }
        else { const int q = U - 1024, b = q >> 4; h = q & 15; qrow0 = (long)TL + b * CTXL; kv0 = (long)b * KVROWS; NT = CTXL / 64; }
        attn_body::attn_unit<8>(qrow0, h, kv0, NT, Qb, Kb, Vb, (attn_body::bf16*)(a.ws + WS_HB), lds_generic);
    }
}

__device__ __forceinline__ void ph_m1(const Args& a, const Ctx& c, int layer) {
    const int Tm = layer == 3 ? TL : TT, ntiles = Tm / 32;
    const float* g = a.in[I_NFFN] + layer * D;
    constexpr int RP = 2064;
    LAS unsigned char* hiT = c.lds; LAS unsigned char* loT = c.lds + 32 * RP;
    LAS float* part = (LAS float*)c.lds;
    LAS float* logit = (LAS float*)(c.lds + 65536);
    LAS int* lcnt = (LAS int*)(c.lds + 133120); LAS int* lbase = lcnt + 32;
    const bf16* wr = (const bf16*)(a.ws + WS_WR) + (size_t)layer * 2 * 65536;
    unsigned* gcnt = (unsigned*)(a.ws + WS_CTL) + CW_CNT + layer * 32;
    int* list = (int*)(a.ws + WS_LIST); float* w2 = (float*)(a.ws + WS_W2);
    const int r32 = c.lane & 31, hi = c.lane >> 5;
    SECT_DECL
    for (int tile = blockIdx.x; tile < ntiles; tile += c.G) {
        const int r0 = tile * 32;
        if (c.tid < 32) lcnt[c.tid] = 0;
        { f32x4 vv[4][4], gs[4], sh[4];
#pragma unroll
          for (int i = 0; i < 4; ++i) { const f32x4* xr = (const f32x4*)((const float*)(a.ws + WS_X) + (size_t)(r0 + 4 * c.wave + i) * D) + c.lane;
#pragma unroll
              for (int j = 0; j < 4; ++j) vv[i][j] = xr[64 * j]; }
          { const float* m = mod_row(a, layer, r0);
#pragma unroll
            for (int j = 0; j < 4; ++j) { gs[j] = ((const f32x4*)g)[c.lane + 64 * j] * (((const f32x4*)(m + 4 * D))[c.lane + 64 * j] + 1.0f); sh[j] = ((const f32x4*)(m + 3 * D))[c.lane + 64 * j]; } }
#pragma unroll
          for (int i = 0; i < 4; ++i) { const int lr = 4 * c.wave + i, r = r0 + lr;
            f32x4 h[4];
            const float rstd = row_rstd(vv[i]);
#pragma unroll
            for (int j = 0; j < 4; ++j) h[j] = (vv[i][j] * rstd) * gs[j] + sh[j];
#if MOE_FP8
            unsigned* to8 = (unsigned*)((unsigned char*)(a.ws + WS_TK) + (size_t)r * D) + c.lane;
#else
            u32x2* to = (u32x2*)((bf16*)(a.ws + WS_TK) + (size_t)r * D) + c.lane;
#endif
#pragma unroll
            for (int j = 0; j < 4; ++j) { const unsigned h0 = cvtpk(h[j].x, h[j].y), h1 = cvtpk(h[j].z, h[j].w);
                const unsigned l0 = cvtpk(h[j].x - bflo(h0), h[j].y - bfhi(h0)), l1 = cvtpk(h[j].z - bflo(h1), h[j].w - bfhi(h1));
#if MOE_FP8
                to8[64 * j] = pk_fp8x4(h[j].x, h[j].y, h[j].z, h[j].w);
#else
                to[64 * j] = (u32x2){h0, h1};
#endif
                *(LAS u32x2*)(hiT + lr * RP + (4 * c.lane + 256 * j) * 2) = (u32x2){h0, h1};
                *(LAS u32x2*)(loT + lr * RP + (4 * c.lane + 256 * j) * 2) = (u32x2){l0, l1}; } } }
        __syncthreads();
        SECT(1);
        f32x16 acc0 = {}, acc1 = {};
#pragma unroll
        for (int kk = 0; kk < 8; ++kk) { const int k0 = 128 * c.wave + 16 * kk + 8 * hi;
            const bf16x8 ahi = *(const LAS bf16x8*)(hiT + r32 * RP + k0 * 2), alo = *(const LAS bf16x8*)(loT + r32 * RP + k0 * 2);
            const bf16x8 b0h = *(const bf16x8*)(wr + r32 * 1024 + k0), b1h = *(const bf16x8*)(wr + (32 + r32) * 1024 + k0);
            const bf16x8 b0l = *(const bf16x8*)(wr + 65536 + r32 * 1024 + k0), b1l = *(const bf16x8*)(wr + 65536 + (32 + r32) * 1024 + k0);
            acc0 = __builtin_amdgcn_mfma_f32_32x32x16_bf16(ahi, b0h, acc0, 0, 0, 0); acc1 = __builtin_amdgcn_mfma_f32_32x32x16_bf16(ahi, b1h, acc1, 0, 0, 0);
            acc0 = __builtin_amdgcn_mfma_f32_32x32x16_bf16(alo, b0h, acc0, 0, 0, 0); acc1 = __builtin_amdgcn_mfma_f32_32x32x16_bf16(alo, b1h, acc1, 0, 0, 0);
            acc0 = __builtin_amdgcn_mfma_f32_32x32x16_bf16(ahi, b0l, acc0, 0, 0, 0); acc1 = __builtin_amdgcn_mfma_f32_32x32x16_bf16(ahi, b1l, acc1, 0, 0, 0); }
        __syncthreads();
        SECT(2);
#pragma unroll
        for (int reg = 0; reg < 16; ++reg) { part[((c.wave * 2 + 0) * 16 + reg) * 64 + c.lane] = acc0[reg]; part[((c.wave * 2 + 1) * 16 + reg) * 64 + c.lane] = acc1[reg]; }
        __syncthreads();
#pragma unroll
        for (int q = 0; q < 4; ++q) { const int idx = c.tid + 512 * q, nt = idx >> 10, reg = (idx >> 6) & 15, ln = idx & 63; float s = 0.f;
#pragma unroll
            for (int w = 0; w < 8; ++w) s += part[((w * 2 + nt) * 16 + reg) * 64 + ln];
            logit[((reg & 3) + 8 * (reg >> 2) + 4 * (ln >> 5)) * 64 + nt * 32 + (ln & 31)] = s; }
        __syncthreads();
        SECT(3);
        int e0 = 0, e1 = 0, p0 = 0, p1 = 0; float w0 = 0.f, w1 = 0.f;
        if (c.tid < 32) { const LAS float* lg = logit + c.tid * 64;
            int grp = 0; float gm = lg[0];
#pragma unroll
            for (int q = 1; q < 4; ++q) if (lg[q] > gm) { gm = lg[q]; grp = q; }
            float den = 0.f;
#pragma unroll
            for (int q = 0; q < 4; ++q) den += expf(lg[q] - gm);
            const float gate = 1.0f / den;
            const LAS float* le = lg + 4 + grp * 8;
            int i0 = 0; float v0 = le[0];
#pragma unroll
            for (int q = 1; q < 8; ++q) if (le[q] > v0) { v0 = le[q]; i0 = q; }
            int i1 = -1; float v1 = -3.0e38f;
#pragma unroll
            for (int q = 0; q < 8; ++q) if (q != i0 && le[q] > v1) { v1 = le[q]; i1 = q; }
            const float ex = expf(v1 - v0); w0 = gate / (1.0f + ex); w1 = gate * ex / (1.0f + ex);
            e0 = grp * 8 + i0; e1 = grp * 8 + i1;
            p0 = __hip_atomic_fetch_add(lcnt + e0, 1, __ATOMIC_RELAXED, __HIP_MEMORY_SCOPE_WORKGROUP);
            p1 = __hip_atomic_fetch_add(lcnt + e1, 1, __ATOMIC_RELAXED, __HIP_MEMORY_SCOPE_WORKGROUP); }
        __syncthreads();
        if (c.tid < 32) { const int n = lcnt[c.tid]; lbase[c.tid] = n ? (int)__hip_atomic_fetch_add(gcnt + c.tid, (unsigned)n, __ATOMIC_RELAXED, __HIP_MEMORY_SCOPE_AGENT) : 0; }
        __syncthreads();
        if (c.tid < 32) { const int r = r0 + c.tid;
            list[e0 * MOE_CAP + lbase[e0] + p0] = 2 * r; w2[2 * r] = w0;
            list[e1 * MOE_CAP + lbase[e1] + p1] = 2 * r + 1; w2[2 * r + 1] = w1; }
        __syncthreads();
        SECT(4);
    }
    if (layer == 1) SECT_END(48);
}
__device__ __forceinline__ void moe_tables(const Args& a, const Ctx& c, int layer, LAS int* tab) {
    unsigned* gcnt = (unsigned*)(a.ws + WS_CTL) + CW_CNT + layer * 32;
    if (c.tid < 32) tab[40 + c.tid] = (int)__hip_atomic_load(gcnt + c.tid, __ATOMIC_RELAXED, __HIP_MEMORY_SCOPE_AGENT);
    __syncthreads();
    if (c.tid == 0) { int s = 0; for (int e = 0; e < 32; ++e) { tab[e] = s; s += (tab[40 + e] + 255) >> 8; } tab[32] = s; }
    __syncthreads();
}

__device__ __forceinline__ void ph_rpool(const Args& a, const Ctx& c, int layer) {
    LAS unsigned char* hs = c.lds;
    const float* g = a.in[I_NMIX] + layer * D;
    for (int tile = blockIdx.x; tile < TT / 32; tile += c.G) {
        const int r0 = tile * 32;
        const int s0 = r0 < TL ? (r0 / SEQ) * SEQ : TL + ((r0 - TL) / CTXL) * CTXL, s1 = s0 + (r0 < TL ? SEQ : CTXL);
        for (int lr = c.wave; lr < 47; lr += NWAVES) { const int gr = r0 - 8 + lr; if (gr < s0 || gr >= s1) continue;
            f32x4 v[4], h[4]; load_row_combined(a, layer, gr, c.lane, v);
            if (lr >= 8 && lr < 40) { f32x4* xo = (f32x4*)((float*)(a.ws + WS_Z) + (size_t)gr * D) + c.lane;
#pragma unroll
                for (int j = 0; j < 4; ++j) xo[64 * j] = v[j]; }
            const float rstd = row_rstd(v); const float* m = mod_row(a, layer, gr);
            norm_mod(v, rstd, g, m, m + D, c.lane, h);
#pragma unroll
            for (int j = 0; j < 4; ++j) *(LAS u32x2*)(hs + lr * 2048 + (4 * c.lane + 256 * j) * 2) = (u32x2){cvtpk(h[j].x, h[j].y), cvtpk(h[j].z, h[j].w)}; }
        __syncthreads();
        { const int half = 1 << (c.tid >> 7);
          const LAS unsigned* col = (const LAS unsigned*)hs + c.tid;
          float sx = 0.f, sy = 0.f;
          { const int lo = (r0 - half) > s0 ? (r0 - half) : s0, hi = (r0 + half) < s1 ? (r0 + half) : s1;
            for (int gr = lo; gr < hi; ++gr) { const unsigned u = col[(gr - r0 + 8) * 512]; sx += bflo(u); sy += bfhi(u); } }
          unsigned* ho = (unsigned*)((bf16*)(a.ws + WS_HB) + (size_t)r0 * D) + c.tid;
          for (int t = 0; t < 32; ++t) { const int gr = r0 + t; const int lo = (gr - half) > s0 ? (gr - half) : s0, hi = (gr + half) < s1 ? (gr + half) : s1;
              const float inv = __builtin_amdgcn_rcpf((float)(hi - lo)); const unsigned u = col[(t + 8) * 512];
              ho[t * 512] = cvtpk(sx * inv - bflo(u), sy * inv - bfhi(u));
              if (t < 31) { if (gr + half < s1) { const unsigned w = col[(t + 8 + half) * 512]; sx += bflo(w); sy += bfhi(w); }
                            if (gr - half >= s0) { const unsigned w = col[(t + 8 - half) * 512]; sx -= bflo(w); sy -= bfhi(w); } } } }
        __syncthreads();
    }
}

struct EpiInproj { static constexpr bool PERM = true; bf16* Z; bf16* XBC; float* DT; const float* dtb;
    __device__ __forceinline__ void operator()(const AccT& acc, const pg8::Unit& u, int wr, int wc, int fr, int fq) const {
        const size_t r0 = (size_t)u.pm * 256;
        if (u.pn < 20) { bf16* base; int pitch; if (u.pn < 8) { base = Z + u.pn * 256; pitch = 2048; } else { base = XBC + (u.pn - 8) * 256; pitch = 3072; }
#pragma unroll
            for (int ai = 0; ai < 2; ++ai)
#pragma unroll
                for (int m = 0; m < 4; ++m) { bf16* rowp = base + (r0 + ai * 128 + wr * 64 + m * 16 + fr) * pitch + wc * 32 + 8 * fq;
#pragma unroll
                    for (int bj = 0; bj < 2; ++bj) { const f32x4 v0 = acc[ai][bj][m][0], v1 = acc[ai][bj][m][1];
                        *(u32x4*)(rowp + bj * 128) = (u32x4){cvtpk(v0[0], v0[1]), cvtpk(v0[2], v0[3]), cvtpk(v1[0], v1[1]), cvtpk(v1[2], v1[3])}; } }
        } else if (wc < 2) { const int col = wc * 32 + 8 * fq; const f32x4 b0 = *(const f32x4*)(dtb + col), b1 = *(const f32x4*)(dtb + col + 4);
#pragma unroll
            for (int ai = 0; ai < 2; ++ai)
#pragma unroll
                for (int m = 0; m < 4; ++m) { float* p = DT + (r0 + ai * 128 + wr * 64 + m * 16 + fr) * 64 + col; f32x4 v0 = acc[ai][0][m][0] + b0, v1 = acc[ai][0][m][1] + b1;
#pragma unroll
                    for (int e = 0; e < 4; ++e) { v0[e] = fmaxf(v0[e], 0.f) + log1pf(__expf(-fabsf(v0[e]))); v1[e] = fmaxf(v1[e], 0.f) + log1pf(__expf(-fabsf(v1[e]))); }
                    *(f32x4*)p = v0; *(f32x4*)(p + 4) = v1; } }
    }
};

__device__ __forceinline__ void ph_conv(const Args& a, const Ctx& c) {
    LAS unsigned char* tin = c.lds; LAS unsigned char* toT = c.lds + 17408; LAS unsigned char* toN = c.lds + 34816;
    const bf16* xbc = (const bf16*)(a.ws + WS_XBC);
    u32x4 pin[3];
#define CONV_PREFETCH(tk) do { const int ci_ = (tk) / 48, chb_ = (tk) % 48, r0_ = ci_ * 128, ch0_ = chb_ * 64; \
        const bool first_ = ci_ < 128 ? (ci_ % 32 == 0) : (((ci_ - 128) & 1) == 0), last_ = ci_ < 128 ? (ci_ % 32 == 31) : (((ci_ - 128) & 1) == 1); \
        _Pragma("unroll") for (int q = 0; q < 3; ++q) { const int p = c.tid + 512 * q, lr = p >> 3, pc = p & 7; const bool valid = p < 131 * 8 && !((lr < 2 && first_) || (lr == 130 && last_)); \
            pin[q] = (u32x4){0u, 0u, 0u, 0u}; if (valid) pin[q] = *(const u32x4*)(xbc + (size_t)(r0_ - 2 + lr) * 3072 + ch0_ + pc * 8); } } while (0)
    if ((int)blockIdx.x < NCH * 48) CONV_PREFETCH((int)blockIdx.x);
    for (int task = blockIdx.x; task < NCH * 48; task += c.G) {
        const int ci = task / 48, chb = task % 48, r0 = ci * 128, ch0 = chb * 64;
#pragma unroll
        for (int q = 0; q < 3; ++q) { const int p = c.tid + 512 * q; if (p < 131 * 8) *(LAS u32x4*)(tin + (p >> 3) * 128 + (p & 7) * 16) = pin[q]; }
        __syncthreads();
        if (task + c.G < NCH * 48) CONV_PREFETCH(task + c.G);
        { const int ch = c.tid & 63, tq = c.tid >> 6; const float* cw = a.in[I_CONVW] + ch0 + ch;
          const float w0 = cw[0], w1 = cw[3072], w2 = cw[2 * 3072], w3 = cw[3 * 3072], bias = a.in[I_CONVB][ch0 + ch];
          float xin[19];
#pragma unroll
          for (int i = 0; i < 19; ++i) xin[i] = bf2f(*(const LAS bf16*)(tin + (16 * tq + i) * 128 + ch * 2));
          float o[16];
#pragma unroll
          for (int i = 0; i < 16; ++i) o[i] = silu_f(bias + w0 * xin[i] + w1 * xin[i + 1] + w2 * xin[i + 2] + w3 * xin[i + 3]);
          if (chb < 40) { *(LAS u32x4*)(toT + ch * 272 + tq * 32) = (u32x4){cvtpk(o[0], o[1]), cvtpk(o[2], o[3]), cvtpk(o[4], o[5]), cvtpk(o[6], o[7])};
                          *(LAS u32x4*)(toT + ch * 272 + tq * 32 + 16) = (u32x4){cvtpk(o[8], o[9]), cvtpk(o[10], o[11]), cvtpk(o[12], o[13]), cvtpk(o[14], o[15])}; }
          if (chb >= 32) {
#pragma unroll
              for (int i = 0; i < 16; ++i) *(LAS bf16*)(toN + (16 * tq + i) * 144 + ch * 2) = (bf16)(cvtpk(o[i], 0.f) & 0xffffu); } }
        __syncthreads();
        if (chb < 40) { bf16* dst = chb < 32 ? (bf16*)(a.ws + WS_XT) + ((size_t)ci * 2048 + ch0) * 128 : (bf16*)(a.ws + WS_BT) + ((size_t)ci * 512 + (ch0 - 2048)) * 128;
#pragma unroll
            for (int q = 0; q < 2; ++q) { const int p = c.tid + 512 * q, chl = p >> 4, pc = p & 15; *(u32x4*)(dst + chl * 128 + pc * 8) = *(const LAS u32x4*)(toT + chl * 272 + pc * 16); } }
        if (chb >= 32) { bf16* dst = chb < 40 ? (bf16*)(a.ws + WS_BN) + (size_t)r0 * 512 + (ch0 - 2048) : (bf16*)(a.ws + WS_CN) + (size_t)r0 * 512 + (ch0 - 2560);
#pragma unroll
            for (int q = 0; q < 2; ++q) { const int p = c.tid + 512 * q, t = p >> 3, pc = p & 7; *(u32x4*)(dst + (size_t)t * 512 + pc * 8) = *(const LAS u32x4*)(toN + t * 144 + pc * 16); } }
        __syncthreads();
    }
#undef CONV_PREFETCH
    const int gw = c.vcu * NWAVES + c.wave, NGW = c.G * NWAVES;
    const float* dt = (const float*)(a.ws + WS_DT);
    for (int item = gw; item < NCH * 32; item += NGW) { const int ci = item >> 5, h = item & 31, r0 = ci * 128 + 2 * c.lane;
        const float af = -expf(a.in[I_ALOG][h]), ab = -expf(a.in[I_ALOG][32 + h]);
        const float dtf0 = dt[(size_t)r0 * 64 + h], dtf1 = dt[(size_t)(r0 + 1) * 64 + h], dtb0 = dt[(size_t)r0 * 64 + 32 + h], dtb1 = dt[(size_t)(r0 + 1) * 64 + 32 + h];
        const float laf0 = dtf0 * af, laf1 = dtf1 * af, lab0 = dtb0 * ab, lab1 = dtb1 * ab;
        float inf_ = laf0 + laf1, inb = lab0 + lab1; const float pf = inf_, pbk = inb;
#pragma unroll
        for (int o = 1; o < 64; o <<= 1) { const float t1 = __shfl_up(inf_, o), t2 = __shfl_up(inb, o); if (c.lane >= o) { inf_ += t1; inb += t2; } }
        const float totf = __shfl(inf_, 63), totb = __shfl(inb, 63);
        const float exf = inf_ - pf, exb = inb - pbk;
        const float cf0 = exf + laf0, cf1 = inf_, pb0 = exb, pb1 = exb + lab0;
        f32x4* sca = (f32x4*)(a.ws + WS_SCA) + (size_t)r0 * 32 + h; f32x4* scb = (f32x4*)(a.ws + WS_SCB) + (size_t)r0 * 32 + h;
        { const float L2E = 1.4426950408889634f;
          sca[0] = (f32x4){cf0 * L2E, pb0 * L2E, cf0 * L2E - __log2f(dtf0), pb0 * L2E + __log2f(dtb0)}; sca[32] = (f32x4){cf1 * L2E, pb1 * L2E, cf1 * L2E - __log2f(dtf1), pb1 * L2E + __log2f(dtb1)}; }
        scb[0] = (f32x4){__expf(cf0), __expf(totb - pb0), dtf0 * __expf(totf - cf0), dtb0 * __expf(pb0)};
        scb[32] = (f32x4){__expf(cf1), __expf(totb - pb1), dtf1 * __expf(totf - cf1), dtb1 * __expf(pb1)};
        if (c.lane == 0) ((f32x2*)(a.ws + WS_DEC))[ci * 32 + h] = (f32x2){__expf(totf), __expf(totb)}; }
}

__device__ __forceinline__ void ph_scan(const Args& a, const Ctx& c) {
    constexpr int P = 272, BUF = 53248;
    LAS unsigned char* stg = c.lds + 2 * BUF + c.wave * 2048;
    const int r32 = c.lane & 31, hi = c.lane >> 5, pt = c.wave >> 2, nt = c.wave & 3;
    for (int task = c.vcu; task < 256; task += c.G) { const int b = task >> 6, dir = (task >> 5) & 1, h = task & 31, g = h >> 3;
        f32x16 acc = {};
        u32x4 xrA[2], brA[4], xrB[2], brB[4]; f32x4 wregA = {}, wregB = {}; f32x2 decA = {}, decB = {};
#define SCAN_CI(k) (dir == 0 ? ((k) < 2 ? 128 + 2 * b + (k) : 32 * b + ((k) - 2)) : ((k) < 2 ? 128 + 2 * b + 1 - (k) : 32 * b + 31 - ((k) - 2)))
#define SCAN_LOAD(k, xr, br, wreg, dcr) do { const int ci_ = SCAN_CI(k); const bf16* xs_ = (const bf16*)(a.ws + WS_XT) + ((size_t)ci_ * 2048 + 64 * h) * 128; const bf16* bs_ = (const bf16*)(a.ws + WS_BT) + ((size_t)ci_ * 512 + 128 * g) * 128; \
        _Pragma("unroll") for (int q = 0; q < 2; ++q) xr[q] = ((const u32x4*)xs_)[c.tid + 512 * q]; _Pragma("unroll") for (int q = 0; q < 4; ++q) br[q] = ((const u32x4*)bs_)[c.tid + 512 * q]; \
        wreg = ((const f32x4*)(a.ws + WS_SCB))[((size_t)ci_ * 128 + (c.tid & 127)) * 32 + h]; dcr = ((const f32x2*)(a.ws + WS_DEC))[ci_ * 32 + h]; } while (0)
#define SCAN_WRITE(bi, xr, br, wreg) do { LAS unsigned char* xb_ = c.lds + (bi) * BUF; LAS unsigned char* bb_ = xb_ + 17408; \
        _Pragma("unroll") for (int q = 0; q < 2; ++q) { const int p = c.tid + 512 * q; *(LAS u32x4*)(xb_ + (p >> 4) * P + (p & 15) * 16) = xr[q]; } \
        _Pragma("unroll") for (int q = 0; q < 4; ++q) { const int p = c.tid + 512 * q; *(LAS u32x4*)(bb_ + (p >> 4) * P + (p & 15) * 16) = br[q]; } \
        if (c.tid < 128) ((LAS float*)(xb_ + 52224))[c.tid] = dir == 0 ? wreg.z : wreg.w; } while (0)
#define SCAN_STEP(k, cur, dcr) do { const int ci = SCAN_CI(k); \
            { bf16* hin = (bf16*)(a.ws + WS_HIN) + (((size_t)ci * 2 + dir) * 32 + h) * 8192; \
              _Pragma("unroll") for (int r = 0; r < 16; ++r) *(LAS bf16*)(stg + ((r & 3) + 8 * (r >> 2) + 4 * hi) * 64 + r32 * 2) = (bf16)(cvtpk(acc[r], 0.f) & 0xffffu); \
              LDS_WAIT(); \
              _Pragma("unroll") for (int i = 0; i < 2; ++i) { const int row = (c.lane >> 2) + 16 * i, pc = c.lane & 3; *(u32x4*)(hin + (size_t)(32 * pt + row) * 128 + 32 * nt + pc * 8) = *(const LAS u32x4*)(stg + row * 64 + pc * 16); } } \
            const float dec = dir == 0 ? dcr.x : dcr.y; \
            _Pragma("unroll") for (int r = 0; r < 16; ++r) acc[r] *= dec; \
            { LAS unsigned char* xb = c.lds + (cur) * BUF; LAS unsigned char* bb = xb + 17408; const LAS float* wv = (const LAS float*)(xb + 52224); \
              _Pragma("unroll") for (int kk = 0; kk < 8; ++kk) { const int s8 = 16 * kk + 8 * hi; \
                  const u32x4 xa = *(const LAS u32x4*)(xb + (32 * pt + r32) * P + s8 * 2); const f32x4 wa = *(const LAS f32x4*)(wv + s8), wb = *(const LAS f32x4*)(wv + s8 + 4); \
                  const u32x4 xs = (u32x4){cvtpk(bflo(xa.x) * wa.x, bfhi(xa.x) * wa.y), cvtpk(bflo(xa.y) * wa.z, bfhi(xa.y) * wa.w), cvtpk(bflo(xa.z) * wb.x, bfhi(xa.z) * wb.y), cvtpk(bflo(xa.w) * wb.z, bfhi(xa.w) * wb.w)}; \
                  const bf16x8 bfrag = *(const LAS bf16x8*)(bb + (32 * nt + r32) * P + s8 * 2); \
                  acc = __builtin_amdgcn_mfma_f32_32x32x16_bf16(__builtin_bit_cast(bf16x8, xs), bfrag, acc, 0, 0, 0); } } } while (0)
        f32x2 dcur0, dcur1;
        SCAN_LOAD(0, xrA, brA, wregA, decA); SCAN_LOAD(1, xrB, brB, wregB, decB); SCAN_WRITE(0, xrA, brA, wregA); dcur0 = decA;
        __syncthreads();
        for (int k = 0; k < 34; k += 2) {
            if (k + 2 < 34) SCAN_LOAD(k + 2, xrA, brA, wregA, decA);
            SCAN_STEP(k, 0, dcur0);
            SCAN_WRITE(1, xrB, brB, wregB); dcur1 = decB;
            __syncthreads();
            if (k + 3 < 34) SCAN_LOAD(k + 3, xrB, brB, wregB, decB);
            SCAN_STEP(k + 1, 1, dcur1);
            if (k + 2 < 34) { SCAN_WRITE(0, xrA, brA, wregA); dcur0 = decA; }
            __syncthreads();
        }
#undef SCAN_CI
#undef SCAN_LOAD
#undef SCAN_WRITE
#undef SCAN_STEP
    }
}

__device__ __forceinline__ int crow16(int r, int hi) { return (r & 3) + 8 * (r >> 2) + 4 * hi; }
__device__ __forceinline__ void ph_yph(const Args& a, const Ctx& c) {
    constexpr int P = 272, ZP = 144;
    LAS unsigned char* Cs = c.lds; LAS unsigned char* Bs = c.lds + 34816; LAS unsigned char* xs = c.lds + 69632; LAS unsigned char* hf = c.lds + 87040; LAS unsigned char* hb = c.lds + 104448;
    LAS unsigned char* zs = c.lds + 121856; LAS unsigned char* os = c.lds + 140288; LAS f32x4* sca = (LAS f32x4*)(c.lds + 158720); LAS f32x2* scb = (LAS f32x2*)(c.lds + 160768);
    LAS float* sbv = (LAS float*)(c.lds + 161792); LAS float* scv = (LAS float*)(c.lds + 162304); LAS float* ssql = (LAS float*)(c.lds + 34816);
    const int lb = c.wave & 3, pb = c.wave >> 2;
    SECT_DECL
    for (int task = c.vcu; task < NCH * 4; task += c.G) { const int ci = task >> 2, g = task & 3, r0 = ci * 128;
        int tid_t = c.tid; asm volatile("" : "+v"(tid_t));
        f32x16 X[4]; int l0;
        u32x4 pxt[2], phf[2], phb[2], pz[2]; f32x4 ps1 = {}; f32x4 ps4 = {};
#define YPH_PREFETCH(hq) do { const int h_ = 8 * g + (hq); const u32x4* xt_ = (const u32x4*)((const bf16*)(a.ws + WS_XT) + ((size_t)ci * 2048 + 64 * h_) * 128); \
            const u32x4* hfg_ = (const u32x4*)((const bf16*)(a.ws + WS_HIN) + (((size_t)ci * 2 + 0) * 32 + h_) * 8192); const u32x4* hbg_ = (const u32x4*)((const bf16*)(a.ws + WS_HIN) + (((size_t)ci * 2 + 1) * 32 + h_) * 8192); \
            const bf16* zg_ = (const bf16*)(a.ws + WS_Z) + (size_t)r0 * 2048 + 64 * h_; \
            _Pragma("unroll") for (int q = 0; q < 2; ++q) { const int p = tidp + 512 * q; pxt[q] = xt_[p]; phf[q] = hfg_[p]; phb[q] = hbg_[p]; pz[q] = *(const u32x4*)(zg_ + (size_t)(p >> 3) * 2048 + (p & 7) * 8); } \
            ps1 = ((const f32x4*)(a.ws + WS_SCA))[((size_t)r0 + (tidp & 127)) * 32 + h_]; ps4 = ((const f32x4*)(a.ws + WS_SCB))[((size_t)r0 + (tidp & 127)) * 32 + h_]; } while (0)
        { const int tid = tid_t, lane = tid & 63, r32 = lane & 31, hi = lane >> 5; l0 = 32 * lb + r32;
          { const bf16* cn = (const bf16*)(a.ws + WS_CN) + (size_t)r0 * 512 + 128 * g; const bf16* bn = (const bf16*)(a.ws + WS_BN) + (size_t)r0 * 512 + 128 * g;
#pragma unroll
            for (int q = 0; q < 4; ++q) { const int p = tid + 512 * q, row = p >> 4, pc = p & 15;
                *(LAS u32x4*)(Cs + row * P + pc * 16) = *(const u32x4*)(cn + (size_t)row * 512 + pc * 8); *(LAS u32x4*)(Bs + row * P + pc * 16) = *(const u32x4*)(bn + (size_t)row * 512 + pc * 8); } }
          { const int tidp = tid; YPH_PREFETCH(0); }
          __syncthreads();
#pragma unroll
          for (int sb = 0; sb < 4; ++sb) { X[sb] = (f32x16){};
#pragma unroll
              for (int kk = 0; kk < 8; ++kk) { const int k8 = (16 * kk + 8 * hi) * 2;
                  X[sb] = __builtin_amdgcn_mfma_f32_32x32x16_bf16(*(const LAS bf16x8*)(Bs + (32 * sb + r32) * P + k8), *(const LAS bf16x8*)(Cs + (32 * lb + r32) * P + k8), X[sb], 0, 0, 0); } }
        }
        SECT(0);
        float ssq = 0.f;
#pragma unroll 1
        for (int hh = 0; hh < 8; ++hh) { const int h = 8 * g + hh;
            int tid = c.tid; asm volatile("" : "+v"(tid)); const int lane = tid & 63, r32 = lane & 31, hi = lane >> 5, l = 32 * lb + r32; (void)lane;
            const float dsum = a.in[I_DSK][h] + a.in[I_DSK][32 + h];
            __syncthreads();
            SECT(1);
            if (hh > 0) { bf16* gg = (bf16*)(a.ws + WS_G) + (size_t)r0 * 2048 + 64 * (h - 1);
#pragma unroll
                for (int q = 0; q < 2; ++q) { const int p = tid + 512 * q, zr = p >> 3, zc = p & 7; *(u32x4*)(gg + (size_t)zr * 2048 + zc * 8) = *(const LAS u32x4*)(os + zr * ZP + zc * 16); } }
#pragma unroll
            for (int q = 0; q < 2; ++q) { const int p = tid + 512 * q, row = p >> 4, pc = p & 15;
                *(LAS u32x4*)(xs + row * P + pc * 16) = pxt[q]; *(LAS u32x4*)(hf + row * P + pc * 16) = phf[q]; *(LAS u32x4*)(hb + row * P + pc * 16) = phb[q];
                *(LAS u32x4*)(zs + (p >> 3) * ZP + (p & 7) * 16) = pz[q]; }
            if (tid < 128) { sca[tid] = ps1; scb[tid] = (f32x2){ps4.x, ps4.y}; sbv[tid] = ps1.z; scv[tid] = ps1.w; }
            __syncthreads();
            SECT(2);
            if (hh < 7) { const int tidp = tid; YPH_PREFETCH(hh + 1); }
            SECT(3);
            const f32x4 me = sca[l]; const f32x2 ee = scb[l];
            const float dtb_l = __builtin_amdgcn_exp2f(me.w - me.y);
            f32x16 accd = {};
#pragma unroll
            for (int sb = 0; sb < 4; ++sb) { unsigned mp[8];
#pragma unroll
                for (int q = 0; q < 4; ++q) { const int s0 = 32 * sb + 8 * q + 4 * hi; float mv[4];
                    if (sb < lb) { const f32x4 bs4 = *(const LAS f32x4*)(sbv + s0);
#pragma unroll
                        for (int e = 0; e < 4; ++e) mv[e] = X[sb][4 * q + e] * __builtin_amdgcn_exp2f(me.x - bs4[e]); }
                    else if (sb > lb) { const f32x4 cs4 = *(const LAS f32x4*)(scv + s0);
#pragma unroll
                        for (int e = 0; e < 4; ++e) mv[e] = X[sb][4 * q + e] * __builtin_amdgcn_exp2f(cs4[e] - me.y); }
                    else { const f32x4 bs4 = *(const LAS f32x4*)(sbv + s0), cs4 = *(const LAS f32x4*)(scv + s0);
#pragma unroll
                        for (int e = 0; e < 4; ++e) { const int s = s0 + e; const float t = (s <= l) ? (me.x - bs4[e]) : (cs4[e] - me.y); const float xv = X[sb][4 * q + e];
                            float m = xv * __builtin_amdgcn_exp2f(t); if (s == l) m += xv * dtb_l + dsum; mv[e] = m; } }
                    mp[2 * q] = cvtpk(mv[0], mv[1]); mp[2 * q + 1] = cvtpk(mv[2], mv[3]); }
#pragma unroll
                for (int t = 0; t < 2; ++t) { const int sof = (32 * sb + 16 * t + 4 * hi) * 2;
                    const u32x2 lo = *(const LAS u32x2*)(xs + (32 * pb + r32) * P + sof), h2 = *(const LAS u32x2*)(xs + (32 * pb + r32) * P + sof + 16);
                    const u32x4 af = (u32x4){lo.x, lo.y, h2.x, h2.y}, bfm = (u32x4){mp[4 * t], mp[4 * t + 1], mp[4 * t + 2], mp[4 * t + 3]};
                    accd = __builtin_amdgcn_mfma_f32_32x32x16_bf16(__builtin_bit_cast(bf16x8, af), __builtin_bit_cast(bf16x8, bfm), accd, 0, 0, 0); }
                }
            SECT(4);
#pragma unroll
            for (int dd = 0; dd < 2; ++dd) { f32x16 acco = {}; LAS unsigned char* hx = dd == 0 ? hf : hb;
#pragma unroll
                for (int kk = 0; kk < 8; ++kk) { const int k8 = (16 * kk + 8 * hi) * 2;
                    acco = __builtin_amdgcn_mfma_f32_32x32x16_bf16(*(const LAS bf16x8*)(hx + (32 * pb + r32) * P + k8), *(const LAS bf16x8*)(Cs + (32 * lb + r32) * P + k8), acco, 0, 0, 0); }
                const float ex = dd == 0 ? ee.x : ee.y;
#pragma unroll
                for (int r = 0; r < 16; ++r) accd[r] += ex * acco[r]; }
            SECT(5);
#pragma unroll
            for (int q = 0; q < 4; ++q) { const int pcol = 32 * pb + 8 * q + 4 * hi; const u32x2 zq = *(const LAS u32x2*)(zs + l * ZP + pcol * 2);
                float gv[4];
#pragma unroll
                for (int e = 0; e < 4; ++e) { const int r = 4 * q + e; const float y = accd[r];
                    const float z = (e == 0) ? bflo(zq.x) : (e == 1) ? bfhi(zq.x) : (e == 2) ? bflo(zq.y) : bfhi(zq.y); gv[e] = y * silu_f(z); ssq += gv[e] * gv[e]; }
                *(LAS u32x2*)(os + l * ZP + pcol * 2) = (u32x2){cvtpk(gv[0], gv[1]), cvtpk(gv[2], gv[3])}; }
            SECT(6);
        }
#undef YPH_PREFETCH
        __syncthreads();
        { bf16* gg = (bf16*)(a.ws + WS_G) + (size_t)r0 * 2048 + 64 * (8 * g + 7);
#pragma unroll
          for (int q = 0; q < 2; ++q) { const int p = c.tid + 512 * q, zr = p >> 3, zc = p & 7; *(u32x4*)(gg + (size_t)zr * 2048 + zc * 8) = *(const LAS u32x4*)(os + zr * ZP + zc * 16); } }
        ssq += __shfl_xor(ssq, 32);
        if ((c.lane >> 5) == 0) ssql[pb * 128 + l0] = ssq;
        __syncthreads();
        if (c.tid < 128) ssql[256 + c.tid] = rsqrtf((ssql[c.tid] + ssql[128 + c.tid]) * (1.0f / 512.0f) + EPS);
        VM_WAIT();
        __syncthreads();
        { bf16* gt = (bf16*)(a.ws + WS_G) + (size_t)r0 * 2048 + 512 * g; const float* ng = a.in[I_SNORM] + 512 * g;
          const f32x4 g0 = *(const f32x4*)(ng + (c.tid & 63) * 8), g1 = *(const f32x4*)(ng + (c.tid & 63) * 8 + 4);
#pragma unroll 1
          for (int qb = 0; qb < 2; ++qb) { u32x4 gv8[8]; int tidq = c.tid + 4096 * qb; asm volatile("" : "+v"(tidq));
#pragma unroll
            for (int q = 0; q < 8; ++q) { const int p = tidq + 512 * q; gv8[q] = *(const u32x4*)(gt + (size_t)(p >> 6) * 2048 + (p & 63) * 8); }
#pragma unroll
            for (int q = 0; q < 8; ++q) { const int p = tidq + 512 * q, row = p >> 6, col = (p & 63) * 8; const u32x4 v = gv8[q]; const float sr = ssql[256 + row];
              *(u32x4*)(gt + (size_t)row * 2048 + col) = (u32x4){cvtpk(bflo(v.x) * sr * g0.x, bfhi(v.x) * sr * g0.y), cvtpk(bflo(v.y) * sr * g0.z, bfhi(v.y) * sr * g0.w), cvtpk(bflo(v.z) * sr * g1.x, bfhi(v.z) * sr * g1.y), cvtpk(bflo(v.w) * sr * g1.z, bfhi(v.w) * sr * g1.w)}; } } }
        __syncthreads();
        SECT(7);
    }
    SECT_END(40);
}
__device__ __forceinline__ void ph_gfix(const Args& a, const Ctx& c) {
    const float* ng = a.in[I_SNORM]; const float* rs = (const float*)(a.ws + WS_RSTD);
    const int n16 = TT * 256;
    for (int p = blockIdx.x * NTHREADS + c.tid; p < n16; p += c.G * NTHREADS) { const int r = p >> 8, col = (p & 255) * 8;
        u32x4* gp = (u32x4*)((bf16*)(a.ws + WS_G) + (size_t)r * 2048 + col); const u32x4 v = *gp; const float s = rs[r * 4 + (col >> 9)];
        const f32x4 g0 = *(const f32x4*)(ng + col), g1 = *(const f32x4*)(ng + col + 4);
        *gp = (u32x4){cvtpk(bflo(v.x) * s * g0.x, bfhi(v.x) * s * g0.y), cvtpk(bflo(v.y) * s * g0.z, bfhi(v.y) * s * g0.w), cvtpk(bflo(v.z) * s * g1.x, bfhi(v.z) * s * g1.y), cvtpk(bflo(v.w) * s * g1.z, bfhi(v.w) * s * g1.w)}; }
}

#if DEBUG_CHECKS
__device__ __forceinline__ int dbg_sample_row(int b) { const int SR[16] = {0, 1, 77, 4095, 4096, 5000, 8191, 9000, 12288, 16383, 16384, 16385, 16384 + 255, 16384 + 256, 17000, 17407}; int r = 0;
#pragma unroll
    for (int i = 0; i < 16; ++i) r = (b == i) ? SR[i] : r;
    return r; }
__device__ __forceinline__ float blk_sum(float v, LAS float* red, int tid) {
    v = wave_sum(v); __syncthreads(); if ((tid & 63) == 0) red[tid >> 6] = v; __syncthreads(); float s = 0.f;
#pragma unroll
    for (int i = 0; i < 8; ++i) s += red[i];
    __syncthreads(); return s; }
__device__ __forceinline__ float blk_max(float v, LAS float* red, int tid) {
#pragma unroll
    for (int o = 1; o < 64; o <<= 1) v = fmaxf(v, __shfl_xor(v, o));
    __syncthreads(); if ((tid & 63) == 0) red[tid >> 6] = v; __syncthreads(); float s = red[0];
#pragma unroll
    for (int i = 1; i < 8; ++i) s = fmaxf(s, red[i]);
    __syncthreads(); return s; }
__device__ __forceinline__ void dbg_report(const Args& a, int id, float err, float ssref, float n, int tid) {
    if (tid == 0) { float rel = err / (sqrtf(ssref / n) + 1e-20f); if (!(rel == rel)) rel = 1e30f; atomicMax((unsigned*)(a.ws + WS_CTL) + CW_DBG + id, __float_as_uint(rel)); } }
__device__ __forceinline__ float dbg_mod(const Args& a, int layer, int r, int j) {
    const float* cv = r < TL ? a.in[I_C] + (r / SEQ) * 1024 : a.in[I_CCTX]; float s = 0.f;
    _Pragma("nounroll") for (int k = 0; k < 1024; ++k) { const float x = cv[k]; s += (x / (1.0f + expf(-x))) * a.in[I_WADA][((size_t)layer * 1024 + k) * 6144 + j]; }
    return s + a.in[I_BADA][layer * 6144 + j]; }

__device__ __forceinline__ void chk_rmix(const Args& a, int layer, int id, LAS unsigned char* ldsb) {
    if (blockIdx.x >= 16) return; const int tid = tid_opaque(), r = dbg_sample_row(blockIdx.x);
    LAS float* red = (LAS float*)ldsb;
    const float* x = resid_row(a, layer, r); const bf16* hb = (const bf16*)(a.ws + WS_HB) + (size_t)r * D;
    float ss = 0.f; for (int cc = tid; cc < D; cc += 512) ss += x[cc] * x[cc];
    ss = blk_sum(ss, red, tid); const float rstd = rsqrtf(ss / D + EPS);
    float err = 0.f, sr = 0.f;
    for (int cc = tid; cc < D; cc += 512) { const float sh = dbg_mod(a, layer, r, cc), sc = dbg_mod(a, layer, r, D + cc);
        const float ref = x[cc] * rstd * a.in[I_NMIX][layer * D + cc] * (1.f + sc) + sh; err = fmaxf(err, fabsf(ref - bf2f(hb[cc]))); sr += ref * ref; }
    err = blk_max(err, red, tid); sr = blk_sum(sr, red, tid); dbg_report(a, id, err, sr, D, tid);
}
__device__ __forceinline__ void chk_qkv(const Args& a, int layer, int id, LAS unsigned char* ldsb) {
    if (blockIdx.x >= 16) return; const int tid = tid_opaque(), r = dbg_sample_row(blockIdx.x), j = layer ? 1 : 0;
    LAS float* red = (LAS float*)ldsb; LAS float* y = red + 16; LAS float* hrow = y + 1536;
    const bf16* hb = (const bf16*)(a.ws + WS_HB) + (size_t)r * D;
    _Pragma("nounroll") for (int k = tid; k < D; k += 512) hrow[k] = bf2f(hb[k]);
    __syncthreads();
    for (int n = tid; n < 1536; n += 512) { float s = 0.f; const float* w = a.in[I_WQKV] + (size_t)j * 1024 * 1536 + n; _Pragma("nounroll") for (int k = 0; k < 1024; ++k) s += hrow[k] * w[(size_t)k * 1536]; y[n] = s; }
    __syncthreads();
    float err = 0.f, sr = 0.f;
    for (int n = tid; n < 1536; n += 512) { float ref;
        if (n < 1280) { const int h0 = n & ~63; float ss = 0.f; _Pragma("nounroll") for (int q = 0; q < 64; ++q) ss += y[h0 + q] * y[h0 + q];
            const float rstd = rsqrtf(ss / 64.f + EPS); const float* g = (n < 1024 ? a.in[I_QG] : a.in[I_KG]) + j * 64;
            float v = y[n] * rstd * g[n & 63], vp = y[n ^ 1] * rstd * g[(n ^ 1) & 63];
            if (r < TL) { const int t = r % SEQ, i = (n & 63) >> 1, f = i & 15, pos = i < 16 ? t / 64 : t % 64; const float inv = powf(10000.f, -(float)f / 16.f), ang = (float)pos * inv, cs = cosf(ang), sn = sinf(ang);
                v = (n & 1) ? (vp * sn + v * cs) : (v * cs - vp * sn); }
            if (n < 1024) v *= 0.125f * 1.4426950408889634f;
            ref = v; } else ref = y[n];
        float got;
        if (n < 1024) { if (layer == 3 && r >= TL) continue; got = bf2f(((const bf16*)(a.ws + WS_Q))[(size_t)r * 1024 + n]); }
        else if (n < 1280) got = bf2f(((const bf16*)(a.ws + WS_K))[kv_row(r) * 256 + (n - 1024)]);
        else got = bf2f(((const bf16*)(a.ws + WS_V))[kv_row(r) * 256 + (n - 1280)]);
        err = fmaxf(err, fabsf(ref - got)); sr += ref * ref; }
    err = blk_max(err, red, tid); sr = blk_sum(sr, red, tid); dbg_report(a, id, err, sr, 1536, tid);
}
__device__ __forceinline__ void chk_att(const Args& a, int layer, int id, LAS unsigned char* ldsb) {
    if (blockIdx.x >= 16) return; const int tid = tid_opaque(), r = dbg_sample_row(blockIdx.x);
    if (layer == 3 && r >= TL) return;
    LAS float* red = (LAS float*)ldsb; LAS float* sc = red + 16; LAS float* po = sc + 4352;
    const int nk = r < TL ? KVROWS : CTXL; const long kv0 = (long)(r < TL ? r / SEQ : (r - TL) / CTXL) * KVROWS;
    const bf16* Qb = (const bf16*)(a.ws + WS_Q); const bf16* Kb = (const bf16*)(a.ws + WS_K); const bf16* Vb = (const bf16*)(a.ws + WS_V); const bf16* Ob = (const bf16*)(a.ws + WS_HB);
    float err = 0.f, sr = 0.f;
    for (int h = 0; h < 16; ++h) {
        float mx = -3e38f;
        _Pragma("nounroll") for (int jk = tid; jk < nk; jk += 512) { float s = 0.f; _Pragma("nounroll") for (int d = 0; d < 64; ++d) s += bf2f(Qb[(size_t)r * 1024 + h * 64 + d]) * bf2f(Kb[(kv0 + jk) * 256 + (h >> 2) * 64 + d]); sc[jk] = s; mx = fmaxf(mx, s); }
        mx = blk_max(mx, red, tid);
        float l = 0.f; _Pragma("nounroll") for (int jk = tid; jk < nk; jk += 512) { const float p = exp2f(sc[jk] - mx); sc[jk] = p; l += p; }
        l = blk_sum(l, red, tid);
        { const int d = tid & 63, part = tid >> 6; float o = 0.f; _Pragma("nounroll") for (int jk = part; jk < nk; jk += 8) o += sc[jk] * bf2f(Vb[(kv0 + jk) * 256 + (h >> 2) * 64 + d]); po[part * 64 + d] = o; }
        __syncthreads();
        if (tid < 64) { float o = 0.f; _Pragma("nounroll") for (int p = 0; p < 8; ++p) o += po[p * 64 + tid]; o /= l; err = fmaxf(err, fabsf(o - bf2f(Ob[(size_t)r * 1024 + h * 64 + tid]))); sr += o * o; }
        __syncthreads();
    }
    err = blk_max(err, red, tid); sr = blk_sum(sr, red, tid); dbg_report(a, id, err, sr, 1024, tid);
}
__device__ __forceinline__ void chk_oproj(const Args& a, int layer, int id, LAS unsigned char* ldsb) {
    if (blockIdx.x >= 16 || layer != 0) return; const int tid = tid_opaque(), r = dbg_sample_row(blockIdx.x), j = 0;
    LAS float* red = (LAS float*)ldsb; LAS float* orow = red + 16;
    const bf16* Ob = (const bf16*)(a.ws + WS_HB) + (size_t)r * D;
    _Pragma("nounroll") for (int k = tid; k < D; k += 512) orow[k] = bf2f(Ob[k]);
    __syncthreads();
    float err = 0.f, sr = 0.f;
    for (int n = tid; n < D; n += 512) { float s = 0.f; const float* w = a.in[I_WO] + (size_t)j * 1024 * 1024 + n; _Pragma("nounroll") for (int k = 0; k < 1024; ++k) s += orow[k] * w[(size_t)k * 1024];
        const float dl = dbg_mod(a, layer, r, 2 * D + n) * s, ref = resid_row(a, 0, r)[n] + dl; err = fmaxf(err, fabsf(ref - ((const float*)(a.ws + WS_X))[(size_t)r * D + n])); sr += dl * dl; }
    err = blk_max(err, red, tid); sr = blk_sum(sr, red, tid); dbg_report(a, id, err, sr, D, tid);
}
__device__ __forceinline__ void chk_moe(const Args& a, int layer, int id_tok, int id_y, LAS unsigned char* ldsb) {
    if (blockIdx.x >= 16) return; const int tid = tid_opaque(), r = dbg_sample_row(blockIdx.x);
    if (layer == 3 && r >= TL) return;
    LAS float* red = (LAS float*)ldsb; LAS float* tok = red + 16; LAS float* lg = tok + 1024; LAS float* tkb = lg + 64; LAS float* act = tkb + 1024; LAS float* rt = act + 1024;
    const float* x = (const float*)(a.ws + WS_X) + (size_t)r * D; const bf16* tk = (const bf16*)(a.ws + WS_TK) + (size_t)r * D;
    float ss = 0.f; for (int cc = tid; cc < D; cc += 512) ss += x[cc] * x[cc];
    ss = blk_sum(ss, red, tid); const float rstd = rsqrtf(ss / D + EPS);
    float err = 0.f, sr = 0.f;
    for (int cc = tid; cc < D; cc += 512) { const float sh = dbg_mod(a, layer, r, 3 * D + cc), sc = dbg_mod(a, layer, r, 4 * D + cc);
        const float ref = x[cc] * rstd * a.in[I_NFFN][layer * D + cc] * (1.f + sc) + sh; tok[cc] = ref;
#if MOE_FP8
        tkb[cc] = __builtin_amdgcn_cvt_f32_fp8((unsigned)((const unsigned char*)(a.ws + WS_TK))[(size_t)r * D + cc], 0);
#else
        tkb[cc] = bf2f(tk[cc]);
#endif
        err = fmaxf(err, fabsf(ref - tkb[cc])); sr += ref * ref; }
    err = blk_max(err, red, tid); sr = blk_sum(sr, red, tid);
    if (tid < 36) { float s = 0.f; _Pragma("nounroll") for (int k = 0; k < 1024; ++k) s += tok[k] * (tid < 4 ? a.in[I_WRG][((size_t)layer * 1024 + k) * 4 + tid] : a.in[I_WRE][((size_t)layer * 1024 + k) * 32 + tid - 4]); lg[tid] = s; }
    __syncthreads();
    if (tid == 0) { int grp = 0; _Pragma("nounroll") for (int q = 1; q < 4; ++q) if (lg[q] > lg[grp]) grp = q; float den = 0.f; _Pragma("nounroll") for (int q = 0; q < 4; ++q) den += expf(lg[q] - lg[grp]);
        const LAS float* le = lg + 4 + grp * 8; int i0 = 0; _Pragma("nounroll") for (int q = 1; q < 8; ++q) if (le[q] > le[i0]) i0 = q; int i1 = -1; _Pragma("nounroll") for (int q = 0; q < 8; ++q) if (q != i0 && (i1 < 0 || le[q] > le[i1])) i1 = q;
        const float ex = expf(le[i1] - le[i0]), w0 = 1.f / den / (1.f + ex), w1 = 1.f / den * ex / (1.f + ex);
        rt[0] = (float)(grp * 8 + i0); rt[1] = (float)(grp * 8 + i1); rt[2] = w0; rt[3] = w1;
        const float* w2 = (const float*)(a.ws + WS_W2); float e2 = fmaxf(fabsf(w2[2 * r] - w0), fabsf(w2[2 * r + 1] - w1)) * 30.f;
        const int* list = (const int*)(a.ws + WS_LIST); const unsigned* gc = (const unsigned*)(a.ws + WS_CTL) + CW_CNT + layer * 32;
        _Pragma("nounroll") for (int k = 0; k < 2; ++k) { const int e = (int)rt[k]; bool found = false; const int n = (int)gc[e]; _Pragma("nounroll") for (int q = 0; q < n && q < MOE_CAP; ++q) if (list[e * MOE_CAP + q] == 2 * r + k) found = true; if (!found) e2 = 1e6f; }
        rt[4] = e2; }
    __syncthreads();
    err = fmaxf(err, rt[4] * sqrtf(sr / D));
    dbg_report(a, id_tok, err, sr, D, tid);
    float err2 = 0.f, sr2 = 0.f;
    _Pragma("nounroll") for (int k = 0; k < 2; ++k) { const int e = (int)rt[k]; const float wk = rt[2 + k];
        const float* wgu = a.in[I_WGU] + ((size_t)layer * 32 + e) * 1024 * 1024; const float* wdn = a.in[I_WDN] + ((size_t)layer * 32 + e) * 512 * 1024;
        { float sg = 0.f, su = 0.f; _Pragma("nounroll") for (int q = 0; q < 1024; ++q) { sg += tkb[q] * wgu[(size_t)q * 1024 + tid]; su += tkb[q] * wgu[(size_t)q * 1024 + 512 + tid]; } act[tid] = (sg / (1.f + expf(-sg))) * su; }
        __syncthreads();
        for (int n = tid; n < D; n += 512) { float s = 0.f; _Pragma("nounroll") for (int q = 0; q < 512; ++q) s += act[q] * wdn[(size_t)q * 1024 + n]; s *= wk;
            err2 = fmaxf(err2, fabsf(s - bf2f(((const bf16*)(a.ws + WS_Y2))[(size_t)(2 * r + k) * D + n]))); sr2 += s * s; }
        __syncthreads(); }
    err2 = blk_max(err2, red, tid); sr2 = blk_sum(sr2, red, tid); dbg_report(a, id_y, err2, sr2, 2 * D, tid);
}

__global__ void __launch_bounds__(NTHREADS) dbg_kernel(Args a, int ty, int layer, int id) {
    extern __shared__ __attribute__((aligned(16))) unsigned char lds_dbg[];
    LAS unsigned char* l = (LAS unsigned char*)lds_dbg;
    if (ty == 1) chk_rmix(a, layer, id, l); else if (ty == 2) chk_qkv(a, layer, id, l); else if (ty == 3) chk_att(a, layer, id, l);
    else if (ty == 4) chk_oproj(a, layer, id, l); else if (ty == 5) chk_moe(a, layer, id, id + 1, l);
}
#endif

template <int KIND, int LAYER> __device__ __forceinline__ void run_phase(const Args& a0, Ctx& c, unsigned char* lds_gen) {
    Args a = a0; { unsigned long long wsv = (unsigned long long)a0.ws; asm volatile("" : "+s"(wsv)); a.ws = (unsigned char*)(GAS unsigned char*)wsv; }
    { unsigned lb = (unsigned)(uintptr_t)(LAS unsigned char*)lds_gen; asm volatile("" : "+s"(lb)); c.lds = (LAS unsigned char*)(uintptr_t)lb; }
    c.tid = tid_opaque(); c.lane = c.tid & 63;
    unsigned char* const ws = a.ws; constexpr int layer = LAYER;
    if constexpr (KIND == K_P0) p0_prologue(a, c);
    else if constexpr (KIND == K_RMIX) ph_rmix(a, c, layer);
    else if constexpr (KIND == K_QKV) { constexpr int j = layer ? 1 : 0;
        SchedQKV S{(const char*)(ws + WS_HB), (const char*)(ws + WS_WQKV) + (size_t)j * 1536 * 1024 * 2, layer == 0 ? 1 : 0, c.G, (int)blockIdx.x};
        EpiQKV E{(bf16*)(ws + WS_Q), (bf16*)(ws + WS_K), (bf16*)(ws + WS_V), a.in[I_QG] + j * 64, a.in[I_KG] + j * 64, (const f32x2*)(ws + WS_ROPE)};
        pg8::gemm_phase<EpiQKV, SchedQKV, false>(c.lds, 2048, 2048, S, E); }
    else if constexpr (KIND == K_ROPE) ph_rope(a, c, layer);
    else if constexpr (KIND == K_ATT) ph_att(a, c, layer, (char*)c.lds);
    else if constexpr (KIND == K_OPROJ) { constexpr int j = layer ? 1 : 0;
        SchedDense S{(const char*)(ws + WS_HB), (const char*)(ws + WS_WO) + (size_t)j * 1024 * 1024 * 2, (size_t)256 * 1024 * 2, (size_t)256 * 1024 * 2, 0, layer == 3 ? 64 : 68, 4, c.G, (int)blockIdx.x};
        EpiResid E{&a, layer, nullptr, nullptr};
        pg8::gemm_phase<EpiResid, SchedDense, false>(c.lds, 2048, 2048, S, E); }
    else if constexpr (KIND == K_M1) ph_m1(a, c, layer);
    else if constexpr (KIND == K_M2) {
        LAS int* tab = (LAS int*)(c.lds + TAB_OFF); moe_tables(a, c, layer, tab);
        unsigned* rdy = (unsigned*)(ws + WS_CTL) + CW_RDY + layer * 256;
#if MOE_FP8
        { SchedMoe S{(const char*)(ws + WS_TK), 0, (const char*)(ws + WS_WGU) + (size_t)layer * 32 * 1024 * 1024, (size_t)1024 * 1024, (size_t)256 * 1024, tab, (const int*)(ws + WS_LIST), c.G, (int)blockIdx.x, rdy, 1};
          EpiGateUp E{(bf16*)(ws + WS_ACT)};
          pg8::gemm_phase<EpiGateUp, SchedMoe, true, true>(c.lds, 1024, 1024, S, E, 127 - MOE_WSH, 127); }
        { SchedMoe S{(const char*)(ws + WS_ACT), (size_t)256 * 512, (const char*)(ws + WS_WDN) + (size_t)layer * 32 * 1024 * 512, (size_t)1024 * 512, (size_t)256 * 512, tab, (const int*)(ws + WS_LIST), c.G, (int)blockIdx.x, rdy, 2};
          EpiDown E{(const int*)(ws + WS_LIST), (const float*)(ws + WS_W2), (bf16*)(ws + WS_Y2)};
          pg8::gemm_phase<EpiDown, SchedMoe, false, true>(c.lds, 512, 512, S, E, 127 - MOE_WSH, 127 - MOE_ASH); } }
#else
        { SchedMoe S{(const char*)(ws + WS_TK), 0, (const char*)(ws + WS_WGU) + (size_t)layer * 32 * 1024 * 1024 * 2, (size_t)1024 * 1024 * 2, (size_t)256 * 1024 * 2, tab, (const int*)(ws + WS_LIST), c.G, (int)blockIdx.x, rdy, 1};
          EpiGateUp E{(bf16*)(ws + WS_ACT)};
          pg8::gemm_phase<EpiGateUp, SchedMoe, true>(c.lds, 2048, 2048, S, E); }
        { SchedMoe S{(const char*)(ws + WS_ACT), (size_t)256 * 512 * 2, (const char*)(ws + WS_WDN) + (size_t)layer * 32 * 1024 * 512 * 2, (size_t)1024 * 512 * 2, (size_t)256 * 512 * 2, tab, (const int*)(ws + WS_LIST), c.G, (int)blockIdx.x, rdy, 2};
          EpiDown E{(const int*)(ws + WS_LIST), (const float*)(ws + WS_W2), (bf16*)(ws + WS_Y2)};
          pg8::gemm_phase<EpiDown, SchedMoe, false>(c.lds, 1024, 1024, S, E); } }
#endif
    else if constexpr (KIND == K_RPOOL) ph_rpool(a, c, layer);
    else if constexpr (KIND == K_POOLG) {
        SchedDense S{(const char*)(ws + WS_HB), (const char*)(ws + WS_WPOOL), (size_t)256 * 1024 * 2, (size_t)256 * 256 * 2, (size_t)256 * 2, 68, 4, c.G, (int)blockIdx.x};
        EpiResid E{&a, layer, a.in[I_POOLS], (const float*)(ws + WS_Z)};
        pg8::gemm_phase<EpiResid, SchedDense, false>(c.lds, 512, 2048, S, E); }
    else if constexpr (KIND == K_INPROJ) {
        SchedDense S{(const char*)(ws + WS_HB), (const char*)(ws + WS_WIN), (size_t)256 * 1024 * 2, (size_t)256 * 1024 * 2, 0, 68, 21, c.G, (int)blockIdx.x};
        EpiInproj E{(bf16*)(ws + WS_Z), (bf16*)(ws + WS_XBC), (float*)(ws + WS_DT), a.in[I_DTB]};
        pg8::gemm_phase<EpiInproj, SchedDense, false>(c.lds, 2048, 2048, S, E); }
    else if constexpr (KIND == K_CONV) ph_conv(a, c);
    else if constexpr (KIND == K_SCAN) ph_scan(a, c);
    else if constexpr (KIND == K_YPH) ph_yph(a, c);
    else if constexpr (KIND == K_GFIX) ph_gfix(a, c);
    else if constexpr (KIND == K_OUTPROJ) {
        SchedDense S{(const char*)(ws + WS_G), (const char*)(ws + WS_WOUT), (size_t)256 * 2048 * 2, (size_t)256 * 2048 * 2, 0, 68, 4, c.G, (int)blockIdx.x};
        EpiResid E{&a, layer, nullptr, nullptr};
        pg8::gemm_phase<EpiResid, SchedDense, false>(c.lds, 4096, 4096, S, E); }
    else if constexpr (KIND == K_FINAL) ph_final(a, c, layer);
}
#define PROGRAM(X) \
    X(0, K_P0, 0) \
    X(1, K_RMIX, 0) X(2, K_QKV, 0) X(3, K_ATT, 0) X(4, K_OPROJ, 0) X(5, K_M1, 0) X(6, K_M2, 0) \
    X(7, K_RPOOL, 1) X(8, K_POOLG, 1) X(9, K_M1, 1) X(10, K_M2, 1) \
    X(11, K_RMIX, 2) X(12, K_INPROJ, 2) X(13, K_CONV, 2) X(14, K_SCAN, 2) X(15, K_YPH, 2) X(16, K_OUTPROJ, 2) X(17, K_M1, 2) X(18, K_M2, 2) \
    X(19, K_RMIX, 3) X(20, K_QKV, 3) X(21, K_ATT, 3) X(22, K_OPROJ, 3) X(23, K_M1, 3) X(24, K_M2, 3) \
    X(25, K_FINAL, 4)
constexpr int NPHASES = 26;
__device__ __forceinline__ unsigned long long probe_phases(const unsigned long long* ts, unsigned mask) { unsigned long long r = 0; for (int k = 0; k < 32; ++k) if (mask & (1u << k)) r += ts[k + 1] - ts[k]; return r; }
__device__ __forceinline__ unsigned long long probe_sum(const unsigned long long* s, int mask) { unsigned long long r = 0; for (int k = 0; k < 8; ++k) if (mask & (1 << k)) r += s[k]; return r; }
__global__ void __launch_bounds__(NTHREADS, 2) mega(Args a0) {
    extern __shared__ __attribute__((aligned(16))) unsigned char lds_raw[];
    Ctx c; c.lds = (LAS unsigned char*)lds_raw; c.tid = threadIdx.x; c.lane = c.tid & 63; c.wave = __builtin_amdgcn_readfirstlane(c.tid >> 6);
    c.G = gridDim.x; { const int bx = blockIdx.x; c.vcu = (c.G % 8 == 0) ? (bx % 8) * (c.G / 8) + bx / 8 : bx; }
    volatile LAS unsigned* MISC = (volatile LAS unsigned*)(c.lds + MISC_OFF);
    for (int u = c.tid; u < 128; u += NTHREADS) MISC[u] = 0u;
    __syncthreads();
    XcdBarrier bar = xcd_barrier_post((unsigned*)(a0.ws + WS_CTL) + CW_BAR + a0.bar_region * XCD_BAR_WORDS, MISC + 8);
    const int lo = a0.ph_lo, hi = a0.ph_hi;
#if PROBE
#define STAMP(idx) if (blockIdx.x == 0 && threadIdx.x == 0) __hip_atomic_store((unsigned long long*)((unsigned*)(a0.ws + WS_CTL) + CW_TS) + (idx), (unsigned long long)__builtin_amdgcn_s_memrealtime(), __ATOMIC_RELAXED, __HIP_MEMORY_SCOPE_AGENT);
#else
#define STAMP(idx)
#endif
    STAMP(0)
#if EXTRA_BARS
    for (int eb = 0; eb < EXTRA_BARS; ++eb) xcd_barrier(bar);
#endif
#define RUNPH(idx, KIND, LAYER) if (lo <= (idx) && (idx) < hi) { run_phase<KIND, LAYER>(a0, c, lds_raw); if ((idx) + 1 < hi) xcd_barrier(bar); STAMP((idx) + 1) }
    PROGRAM(RUNPH)
#undef RUNPH
#if PROBE
    if (blockIdx.x == 0 && threadIdx.x == 0 && hi == NPHASES) { const unsigned long long* ts = (const unsigned long long*)((unsigned*)(a0.ws + WS_CTL) + CW_TS);
        const unsigned long long d = (unsigned long long)PROBE_K * (PROBE_SLOT ? probe_sum(ts + PROBE_SLOT_BASE, PROBE_SLOT) : probe_phases(ts, PROBE_MASK)), t0 = __builtin_amdgcn_s_memrealtime();
        while (__builtin_amdgcn_s_memrealtime() - t0 < d) __builtin_amdgcn_s_sleep(8); }
#endif
}

extern "C" void kernel_launch(void* const* d_in, const int* in_sizes, int n_in, void* d_out, int out_size, void* d_ws, size_t ws_size, hipStream_t stream) {
    static int grid = 0;
    if (grid == 0) {
        if (n_in != N_IN || out_size != TL * D || ws_size < WS_END) { fprintf(stderr, "kernel_launch: unexpected shapes (n_in %d out %d ws %zu)\n", n_in, out_size, ws_size); grid = -1; return; }
        int dev = 0, cus = 0;
        if (hipGetDevice(&dev) != hipSuccess || hipDeviceGetAttribute(&cus, hipDeviceAttributeMultiprocessorCount, dev) != hipSuccess) { grid = -1; return; }
        if (hipFuncSetAttribute((const void*)mega, hipFuncAttributeMaxDynamicSharedMemorySize, LDS_BYTES) != hipSuccess) { fprintf(stderr, "kernel_launch: hipFuncSetAttribute failed\n"); grid = -1; return; }
        int per_cu = 0;
        if (hipOccupancyMaxActiveBlocksPerMultiprocessor(&per_cu, (const void*)mega, NTHREADS, LDS_BYTES) != hipSuccess || per_cu < 1) fprintf(stderr, "kernel_launch: occupancy query says %d\n", per_cu);
        (void)hipGetLastError();
        grid = cus;
    }
    if (grid < 0) return;
    (void)hipMemsetAsync((char*)d_ws + WS_CTL, 0, CTL_ZERO_BYTES, stream);
    Args a{};
    for (int i = 0; i < N_IN; ++i) a.in[i] = (const float*)d_in[i];
    a.out = (float*)d_out; a.ws = (unsigned char*)d_ws; a.flags = 0;
#if DEBUG_CHECKS
    struct Cut { int after; int ty, layer, nid; };
    const Cut cuts[] = DEBUG_CUTS;
    int lo = 0, region = 0, dbg_id = 1;
    for (unsigned k = 0; k < sizeof(cuts) / sizeof(cuts[0]); ++k) {
        if (cuts[k].after + 1 > lo) { a.ph_lo = lo; a.ph_hi = cuts[k].after + 1; a.bar_region = region++; hipLaunchKernelGGL(mega, dim3(grid), dim3(NTHREADS), LDS_BYTES, stream, a); lo = cuts[k].after + 1; }
        hipLaunchKernelGGL(dbg_kernel, dim3(16), dim3(NTHREADS), 65536, stream, a, cuts[k].ty, cuts[k].layer, dbg_id); dbg_id += cuts[k].nid;
    }
    a.ph_lo = lo; a.ph_hi = NPHASES; a.bar_region = region++;
    hipLaunchKernelGGL(mega, dim3(grid), dim3(NTHREADS), LDS_BYTES, stream, a);
#else
    a.ph_lo = 0; a.ph_hi = NPHASES; a.bar_region = 0;
    hipLaunchKernelGGL(mega, dim3(grid), dim3(NTHREADS), LDS_BYTES, stream, a);
#endif
}
```

```cpp
#include <hip/hip_runtime.h>
#include <cstdio>
#include <cstdint>

#define LAS __attribute__((address_space(3)))
#define GAS __attribute__((address_space(1)))
typedef unsigned short bf16;
typedef short bf16x8 __attribute__((ext_vector_type(8)));
typedef short s16x4 __attribute__((ext_vector_type(4)));
typedef float f32x2 __attribute__((ext_vector_type(2)));
typedef float f32x4 __attribute__((ext_vector_type(4)));
typedef float f32x16 __attribute__((ext_vector_type(16)));
typedef unsigned u32x2 __attribute__((ext_vector_type(2)));
typedef unsigned u32x4 __attribute__((ext_vector_type(4)));
typedef __bf16 bf16x2_t __attribute__((ext_vector_type(2)));

constexpr int D = 1024, NB = 4, SEQ = 4096, CTXL = 256, TL = NB * SEQ, TC = NB * CTXL, TT = TL + TC;
constexpr int KVROWS = SEQ + CTXL;
constexpr int NCH = TT / 128;
constexpr int MOE_CAP = TT;
constexpr float EPS = 1e-6f;
constexpr int NWAVES = 8, NTHREADS = 512;
#ifndef NLAYERS
#define NLAYERS 4
#endif
#ifndef MOE_FP8
#define MOE_FP8 1
#endif
#define MOE_WSH 5
#ifndef ATT_FP8
#define ATT_FP8 1
#endif
#define ATT_OSH 3
#define MOE_ASH 2
#define DBG_TOL 0.03f
#ifndef DEBUG_CHECKS
#define DEBUG_CHECKS 0
#endif
#ifndef PROBE
#define PROBE 0
#endif
#define PROBE_A0 0
#define PROBE_A1 1
#define PROBE_B0 4
#define PROBE_B1 5
#define PROBE_K 2
#define PROBE_MASK 0x1222224u
#define EXTRA_BARS 0
#define PROBE_SLOT_BASE 40
#define PROBE_SLOT 0
#if PROBE
#define SECT_DECL unsigned long long sect_t = __builtin_amdgcn_s_memrealtime(); unsigned long long sect_acc[8] = {0, 0, 0, 0, 0, 0, 0, 0};
#define SECT(k) do { const unsigned long long n_ = __builtin_amdgcn_s_memrealtime(); sect_acc[k] += n_ - sect_t; sect_t = n_; } while (0)
#define SECT_END(base) do { if (blockIdx.x == 0 && threadIdx.x == 0) { _Pragma("unroll") for (int k_ = 0; k_ < 8; ++k_) ((unsigned long long*)((unsigned*)(a.ws + WS_CTL) + CW_TS))[(base) + k_] = sect_acc[k_]; } } while (0)
#else
#define SECT_DECL
#define SECT(k) do {} while (0)
#define SECT_END(base) do {} while (0)
#endif
#define DEBUG_CUTS { {1, 1, 0, 1}, {2, 2, 0, 1}, {3, 3, 0, 1}, {4, 4, 0, 1}, {6, 5, 0, 2} }

enum { I_X = 0, I_C, I_CTX, I_CCTX, I_WADA, I_BADA, I_NMIX, I_NFFN, I_NFIN, I_WQKV, I_WO, I_QG, I_KG, I_POOLW, I_POOLS, I_WIN, I_CONVW, I_CONVB, I_DTB, I_ALOG, I_DSK, I_SNORM, I_WOUT, I_WRG, I_WRE, I_WGU, I_WDN, N_IN };

constexpr size_t MiB = 1u << 20;
constexpr size_t WS_CTL = 0, CTL_ZERO_BYTES = 1 * MiB;
constexpr size_t WS_MODL = 1 * MiB;
constexpr size_t WS_MODC = WS_MODL + 4 * 4 * 6144 * 4;
constexpr size_t WS_ROPE = 1 * MiB + 512 * 1024;
constexpr size_t WS_WR = 2 * MiB;
constexpr size_t WS_WQKV = 3 * MiB;
constexpr size_t WS_WO = 9 * MiB;
constexpr size_t WS_WPOOL = 13 * MiB;
constexpr size_t WS_WIN = 14 * MiB;
constexpr size_t WS_WOUT = 25 * MiB;
constexpr size_t WS_WGU = 29 * MiB;
constexpr size_t WS_WDN = 285 * MiB;
constexpr size_t WS_X = 413 * MiB;
constexpr size_t WS_HB = 481 * MiB;
constexpr size_t WS_TK = 515 * MiB;
constexpr size_t WS_Q = 549 * MiB;
constexpr size_t WS_K = 583 * MiB;
constexpr size_t WS_V = 592 * MiB;
constexpr size_t WS_Y2 = 601 * MiB;
constexpr size_t WS_ACT = 669 * MiB;
constexpr size_t WS_LIST = 711 * MiB;
constexpr size_t WS_W2 = 714 * MiB;
constexpr size_t WS_Z = 715 * MiB;
constexpr size_t WS_XBC = 783 * MiB;
constexpr size_t WS_DT = 885 * MiB;
constexpr size_t WS_XT = 890 * MiB;
constexpr size_t WS_BN = 958 * MiB;
constexpr size_t WS_BT = 975 * MiB;
constexpr size_t WS_CN = 992 * MiB;
constexpr size_t WS_SCA = 1009 * MiB;
constexpr size_t WS_SCB = 1018 * MiB;
constexpr size_t WS_DEC = 1027 * MiB;
constexpr size_t WS_HIN = 1028 * MiB;
constexpr size_t WS_G = 1164 * MiB;
constexpr size_t WS_RSTD = 1232 * MiB;
constexpr size_t WS_END = 1233 * MiB;

constexpr int CW_BAR = 4096;
constexpr int CW_CNT = 200000;
constexpr int CW_DBG = 201000;
constexpr int CW_RDY = 204000;
constexpr int CW_TS = 202000;

constexpr int LDS_BYTES = 163840;
constexpr int MISC_OFF = LDS_BYTES - 512;

__device__ __forceinline__ unsigned cvtpk(float lo, float hi) { f32x2 v = {lo, hi}; bf16x2_t b = __builtin_convertvector(v, bf16x2_t); return __builtin_bit_cast(unsigned, b); }
__device__ __forceinline__ unsigned pk_fp8x4(float a, float b, float c, float d) {
    a = __builtin_amdgcn_fmed3f(a, -448.f, 448.f); b = __builtin_amdgcn_fmed3f(b, -448.f, 448.f); c = __builtin_amdgcn_fmed3f(c, -448.f, 448.f); d = __builtin_amdgcn_fmed3f(d, -448.f, 448.f);
    unsigned w = __builtin_amdgcn_cvt_pk_fp8_f32(a, b, 0u, false); return __builtin_amdgcn_cvt_pk_fp8_f32(c, d, w, true); }
__device__ __forceinline__ float bflo(unsigned u) { return __uint_as_float(u << 16); }
__device__ __forceinline__ float bfhi(unsigned u) { return __uint_as_float(u & 0xffff0000u); }
__device__ __forceinline__ float bf2f(bf16 b) { return __uint_as_float((unsigned)b << 16); }
__device__ __forceinline__ float wave_sum(float v) {
#pragma unroll
    for (int o = 1; o < 64; o <<= 1) v += __shfl_xor(v, o);
    return v;
}
__device__ __forceinline__ float silu_f(float v) { return v * __builtin_amdgcn_rcpf(1.0f + __builtin_amdgcn_exp2f(v * -1.4426950408889634f)); }
__device__ __forceinline__ int tid_opaque() { int t = threadIdx.x; asm volatile("" : "+v"(t)); return t; }
#define LDS_WAIT() asm volatile("s_waitcnt lgkmcnt(0)" ::: "memory")
#define VM_WAIT() asm volatile("s_waitcnt vmcnt(0)" ::: "memory")

#define XB_TMO      128
#define XB_XCNT(j)  (256  + 64 * (j))
#define XB_XSUB(j)  (1280 + 64 * (j))
#define XB_XGEN(j)  (2304 + 64 * (j))
#define XB_TOP      3328
#define XB_TOPGEN   3392
#define XCD_BAR_WORDS 3456
#define XB_SPIN_CAP (1u << 20)
__device__ __forceinline__ unsigned xb_ld(unsigned* p)              { return __hip_atomic_load(p, __ATOMIC_RELAXED, __HIP_MEMORY_SCOPE_AGENT); }
__device__ __forceinline__ unsigned xb_add(unsigned* p, unsigned v) { return __hip_atomic_fetch_add(p, v, __ATOMIC_RELAXED, __HIP_MEMORY_SCOPE_AGENT); }
__device__ __forceinline__ unsigned xb_xcc_id() { return (unsigned)__builtin_amdgcn_s_getreg((3 << 11) | 20) & 0xFu; }
#define XB_SPIN(cond, bar) do { unsigned _sp = 0; while (cond) { __builtin_amdgcn_s_sleep(1); \
    if ((++_sp & 255u) == 0u) { if (xb_ld(&(bar)[XB_TMO])) break; if (_sp > XB_SPIN_CAP) { atomicAdd(&(bar)[XB_TMO], 1u); break; } } } } while (0)
struct XcdBarrier { unsigned* bar; unsigned x; volatile LAS unsigned* st; };
__device__ __forceinline__ XcdBarrier xcd_barrier_post(unsigned* bar, volatile LAS unsigned* st) {
    XcdBarrier b; b.bar = bar; b.x = xb_xcc_id(); b.st = st;
    if (threadIdx.x == 0) (void)xb_add(&bar[XB_XCNT(b.x)], 1u);
    return b;
}
__device__ __forceinline__ void xcd_barrier_complete(unsigned* bar, unsigned x, unsigned& nloc, unsigned& nx) {
    const unsigned G = gridDim.x * gridDim.y * gridDim.z;
    unsigned sum, cnt, mine, sp = 0u;
    for (;;) {
        sum = 0u; cnt = 0u; mine = 0u;
#pragma unroll
        for (unsigned j = 0; j < 16; ++j) { const unsigned c = xb_ld(&bar[XB_XCNT(j)]); sum += c; cnt += (c > 0u) ? 1u : 0u; mine = (j == x) ? c : mine; }
        if (sum == G) break;
        __builtin_amdgcn_s_sleep(1);
        if ((++sp & 255u) == 0u) { if (xb_ld(&bar[XB_TMO])) break; if (sp > XB_SPIN_CAP) { atomicAdd(&bar[XB_TMO], 1u); break; } }
    }
    nloc = mine > 0u ? mine : 1u; nx = cnt > 0u ? cnt : 1u;
}
__device__ __forceinline__ void xcd_barrier(const XcdBarrier& b) {
    asm volatile("s_waitcnt vmcnt(0)" ::: "memory");
    __syncthreads();
    if (threadIdx.x == 0) {
        unsigned* bar = b.bar;
        __builtin_amdgcn_s_waitcnt(0);
        unsigned nloc = b.st[0], nx = b.st[1];
        if (nloc == 0u) { xcd_barrier_complete(bar, b.x, nloc, nx); b.st[0] = nloc; b.st[1] = nx; }
        const unsigned old = xb_add(&bar[XB_XSUB(b.x)], 1u);
        const unsigned gen = old / nloc;
        if (old + 1u == (gen + 1u) * nloc) {
            __builtin_amdgcn_fence(__ATOMIC_RELEASE, "agent");
            asm volatile("s_waitcnt vmcnt(0)" ::: "memory");
            const unsigned og = xb_add(&bar[XB_TOP], 1u);
            const unsigned tg = og / nx;
            if (og + 1u == (tg + 1u) * nx) xb_add(&bar[XB_TOPGEN], 1u);
            else XB_SPIN(xb_ld(&bar[XB_TOPGEN]) == tg, bar);
            __builtin_amdgcn_fence(__ATOMIC_ACQUIRE, "agent");
            xb_add(&bar[XB_XGEN(b.x)], 1u);
            asm volatile("s_waitcnt vmcnt(0)" ::: "memory");
        } else {
            XB_SPIN(xb_ld(&bar[XB_XGEN(b.x)]) == gen, bar);
            __builtin_amdgcn_fence(__ATOMIC_ACQUIRE, "agent");
            asm volatile("s_waitcnt vmcnt(0)" ::: "memory");
        }
    }
    __syncthreads();
}

enum { K_P0 = 0, K_RMIX, K_QKV, K_ROPE, K_ATT, K_OPROJ, K_M1, K_M2, K_M3, K_RPOOL, K_POOLG, K_INPROJ, K_CONV, K_SCAN, K_YPH, K_GFIX, K_OUTPROJ, K_FINAL, K_DBG };
struct Args { const float* in[N_IN]; float* out; unsigned char* ws; int ph_lo, ph_hi; int flags; int bar_region; };

struct Ctx {
    LAS unsigned char* lds; int tid, lane, wave, vcu, G;
};

__device__ __forceinline__ const float* mod_row(const Args& a, int layer, int r) {
    return r < TL ? (const float*)(a.ws + WS_MODL) + (size_t)(layer * 4 + r / SEQ) * 6144 : (const float*)(a.ws + WS_MODC) + (size_t)layer * 6144;
}
__device__ __forceinline__ const float* resid_row(const Args& a, int layer, int r) {
    if (layer == 0) return r < TL ? a.in[I_X] + (size_t)r * D : a.in[I_CTX] + (size_t)(r - TL) * D;
    return (const float*)(a.ws + WS_X) + (size_t)r * D;
}

__device__ __forceinline__ void load_row_combined(const Args& a, int layer, int r, int lane, f32x4 (&v)[4]) {
    const f32x4* xr = (const f32x4*)resid_row(a, layer, r) + lane;
#pragma unroll
    for (int j = 0; j < 4; ++j) v[j] = xr[64 * j];
    if (layer > 0 && !(a.flags & 1)) {
        const f32x4* gf = (const f32x4*)(mod_row(a, layer - 1, r) + 5 * D) + lane;
        const u32x2* y0 = (const u32x2*)((const bf16*)(a.ws + WS_Y2) + (size_t)(2 * r) * D) + lane;
        const u32x2* y1 = (const u32x2*)((const bf16*)(a.ws + WS_Y2) + (size_t)(2 * r + 1) * D) + lane;
#pragma unroll
        for (int j = 0; j < 4; ++j) {
            const u32x2 p = y0[64 * j], q = y1[64 * j]; const f32x4 g = gf[64 * j];
            v[j].x += g.x * (bflo(p.x) + bflo(q.x)); v[j].y += g.y * (bfhi(p.x) + bfhi(q.x));
            v[j].z += g.z * (bflo(p.y) + bflo(q.y)); v[j].w += g.w * (bfhi(p.y) + bfhi(q.y));
        }
    }
}
__device__ __forceinline__ float row_rstd(const f32x4 (&v)[4]) {
    float s = 0.f;
#pragma unroll
    for (int j = 0; j < 4; ++j) s += (v[j].x * v[j].x + v[j].y * v[j].y) + (v[j].z * v[j].z + v[j].w * v[j].w);
    return rsqrtf(wave_sum(s) * (1.0f / D) + EPS);
}
__device__ __forceinline__ void norm_mod(const f32x4 (&v)[4], float rstd, const float* g, const float* shift, const float* scale, int lane, f32x4 (&h)[4]) {
#pragma unroll
    for (int j = 0; j < 4; ++j) {
        const f32x4 gg = ((const f32x4*)g)[lane + 64 * j], sh = ((const f32x4*)shift)[lane + 64 * j], sc = ((const f32x4*)scale)[lane + 64 * j];
        h[j] = (v[j] * rstd) * gg * (sc + 1.0f) + sh;
    }
}

__device__ __forceinline__ void tr_item(const float* W, int N, int k0, int n0, bf16* WT, size_t drow0, int dK, LAS float* scr, int lane, int hi_skip = 0) {
    const int nq = lane & 15, kr = lane >> 4;
#pragma unroll
    for (int i = 0; i < 16; ++i) { const int kk = 4 * i + kr; const f32x4 v = *(const f32x4*)(W + (size_t)(k0 + kk) * N + n0 + 4 * nq);
        LAS float* d = scr + kk * 65 + 4 * nq; d[0] = v.x; d[1] = v.y; d[2] = v.z; d[3] = v.w; }
    LDS_WAIT(); asm volatile("" ::: "memory");
    const int c = lane & 7;
#pragma unroll
    for (int j = 0; j < 8; ++j) { const int n = (lane >> 3) + 8 * j; const LAS float* s = scr + (8 * c) * 65 + n;
        u32x4 o; o.x = cvtpk(s[0 * 65], s[1 * 65]); o.y = cvtpk(s[2 * 65], s[3 * 65]); o.z = cvtpk(s[4 * 65], s[5 * 65]); o.w = cvtpk(s[6 * 65], s[7 * 65]);
        *(u32x4*)(WT + (drow0 + n + (n >= 32 ? hi_skip : 0)) * dK + k0 + 8 * c) = o; }
    LDS_WAIT(); asm volatile("" ::: "memory");
}
__device__ __forceinline__ void tr_item8(const float* W, int N, int k0, int n0, unsigned char* WT, size_t drow0, int dKb, LAS float* scr, int lane, float scale, int hi_skip = 0) {
    const int nq = lane & 15, kr = lane >> 4;
#pragma unroll
    for (int i = 0; i < 16; ++i) { const int kk = 4 * i + kr; const f32x4 v = *(const f32x4*)(W + (size_t)(k0 + kk) * N + n0 + 4 * nq);
        LAS float* d = scr + kk * 65 + 4 * nq; d[0] = v.x; d[1] = v.y; d[2] = v.z; d[3] = v.w; }
    LDS_WAIT(); asm volatile("" ::: "memory");
    const int c = lane & 3;
#pragma unroll
    for (int j = 0; j < 4; ++j) { const int n = (lane >> 2) + 16 * j; const LAS float* s = scr + (16 * c) * 65 + n;
        u32x4 o; o.x = pk_fp8x4(s[0 * 65] * scale, s[1 * 65] * scale, s[2 * 65] * scale, s[3 * 65] * scale); o.y = pk_fp8x4(s[4 * 65] * scale, s[5 * 65] * scale, s[6 * 65] * scale, s[7 * 65] * scale);
        o.z = pk_fp8x4(s[8 * 65] * scale, s[9 * 65] * scale, s[10 * 65] * scale, s[11 * 65] * scale); o.w = pk_fp8x4(s[12 * 65] * scale, s[13 * 65] * scale, s[14 * 65] * scale, s[15 * 65] * scale);
        *(u32x4*)(WT + (drow0 + n + (n >= 32 ? hi_skip : 0)) * dKb + k0 + 16 * c) = o; }
    LDS_WAIT(); asm volatile("" ::: "memory");
}
__device__ __forceinline__ void p0_prologue(const Args& a, const Ctx& c) {
    LAS float* scr = (LAS float*)(c.lds + c.wave * 16896);
    const int gw = c.vcu * NWAVES + c.wave, NGW = c.G * NWAVES;
    constexpr int I0 = 2 * 384, I1 = 2 * 256, I2 = 4 * 16, I3 = 16 * 81, I4 = 32 * 16, I5 = 128 * 256, I6 = 128 * 128, ITOT = I0 + I1 + I2 + I3 + I4 + I5 + I6;
    for (int it = gw; it < ITOT; it += NGW) {
        int r = it;
        if (r < I5) { const int m = r / 256, q = r % 256, kb = q / 16, nb = q % 16; const int n0 = nb * 64;
            const int j = n0 & 511, drow = 256 * (j >> 7) + (j & 127) + ((n0 >= 512) ? 128 : 0);
#if MOE_FP8
            tr_item8(a.in[I_WGU] + (size_t)m * 1024 * 1024, 1024, kb * 64, n0, (unsigned char*)(a.ws + WS_WGU) + (size_t)m * 1024 * 1024, drow, 1024, scr, c.lane, (float)(1 << MOE_WSH)); continue; }
#else
            tr_item(a.in[I_WGU] + (size_t)m * 1024 * 1024, 1024, kb * 64, n0, (bf16*)(a.ws + WS_WGU) + (size_t)m * 1024 * 1024, drow, 1024, scr, c.lane); continue; }
#endif
        r -= I5;
        if (r < I6) { const int m = r / 128, q = r % 128, kb = q / 16, nb = q % 16;
#if MOE_FP8
            tr_item8(a.in[I_WDN] + (size_t)m * 512 * 1024, 1024, kb * 64, nb * 64, (unsigned char*)(a.ws + WS_WDN) + (size_t)m * 1024 * 512, nb * 64, 512, scr, c.lane, (float)(1 << MOE_WSH)); continue; }
#else
            tr_item(a.in[I_WDN] + (size_t)m * 512 * 1024, 1024, kb * 64, nb * 64, (bf16*)(a.ws + WS_WDN) + (size_t)m * 1024 * 512, nb * 64, 512, scr, c.lane); continue; }
#endif
        r -= I6;
        if (r < I0) { const int m = r / 384, q = r % 384, kb = q / 24, nb = q % 24;
#if ATT_FP8
            tr_item8(a.in[I_WQKV] + (size_t)m * 1024 * 1536, 1536, kb * 64, nb * 64, (unsigned char*)(a.ws + WS_WQKV) + (size_t)m * 1536 * 1024, (nb >> 2) * 256 + (nb & 3) * 32, 1024, scr, c.lane, (float)(1 << MOE_WSH), 96); continue; }
#else
            tr_item(a.in[I_WQKV] + (size_t)m * 1024 * 1536, 1536, kb * 64, nb * 64, (bf16*)(a.ws + WS_WQKV) + (size_t)m * 1536 * 1024, (nb >> 2) * 256 + (nb & 3) * 32, 1024, scr, c.lane, 96); continue; }
#endif
        r -= I0;
        if (r < I1) { const int m = r / 256, q = r % 256, kb = q / 16, nb = q % 16;
#if ATT_FP8
            tr_item8(a.in[I_WO] + (size_t)m * 1024 * 1024, 1024, kb * 64, nb * 64, (unsigned char*)(a.ws + WS_WO) + (size_t)m * 1024 * 1024, nb * 64, 1024, scr, c.lane, (float)(1 << MOE_WSH)); continue; }
#else
            tr_item(a.in[I_WO] + (size_t)m * 1024 * 1024, 1024, kb * 64, nb * 64, (bf16*)(a.ws + WS_WO) + (size_t)m * 1024 * 1024, nb * 64, 1024, scr, c.lane); continue; }
#endif
        r -= I1;
        if (r < I2) { const int m = r / 16, q = r % 16, kb = q / 4, nb = q % 4;
            tr_item(a.in[I_POOLW] + (size_t)m * 256 * 256, 256, kb * 64, nb * 64, (bf16*)(a.ws + WS_WPOOL) + (size_t)m * 256 * 256, nb * 64, 256, scr, c.lane); continue; }
        r -= I2;
        if (r < I3) { const int kb = r / 81, nb = r % 81;
            tr_item(a.in[I_WIN], 5184, kb * 64, nb * 64, (bf16*)(a.ws + WS_WIN), nb * 64, 1024, scr, c.lane); continue; }
        r -= I3;
        { const int kb = r / 16, nb = r % 16;
            tr_item(a.in[I_WOUT], 1024, kb * 64, nb * 64, (bf16*)(a.ws + WS_WOUT), nb * 64, 2048, scr, c.lane); }
    }
    __syncthreads();
    LAS float* sv = (LAS float*)c.lds;
    LAS float* part = (LAS float*)(c.lds + 20480);
    for (int u = c.tid; u < 5 * 1024; u += NTHREADS) { const int v = u >> 10, k = u & 1023; const float x = v < 4 ? a.in[I_C][v * 1024 + k] : a.in[I_CCTX][k]; sv[u] = x / (1.0f + expf(-x)); }
    __syncthreads();
    for (int item = blockIdx.x; item < 4 * 96; item += c.G) {
        const int li = item / 96, c0 = (item % 96) * 64, cq = c.tid & 15, ks = c.tid >> 4;
        f32x4 acc[5];
#pragma unroll
        for (int v = 0; v < 5; ++v) acc[v] = (f32x4){0.f, 0.f, 0.f, 0.f};
        const float* w = a.in[I_WADA] + ((size_t)li * 1024 + ks * 32) * 6144 + c0 + 4 * cq;
#pragma unroll 4
        for (int k = 0; k < 32; ++k) { const f32x4 wv = *(const f32x4*)(w + (size_t)k * 6144);
#pragma unroll
            for (int v = 0; v < 5; ++v) acc[v] += wv * sv[v * 1024 + ks * 32 + k]; }
#pragma unroll
        for (int v = 0; v < 5; ++v) *(LAS f32x4*)(part + (ks * 16 + cq) * 20 + v * 4) = acc[v];
        __syncthreads();
        if (c.tid < 320) { const int v = c.tid >> 6, col = c.tid & 63, q = col >> 2, e = col & 3; float s = 0.f;
            for (int k2 = 0; k2 < 32; ++k2) s += part[(k2 * 16 + q) * 20 + v * 4 + e];
            s += a.in[I_BADA][li * 6144 + c0 + col];
            if (v < 4) ((float*)(a.ws + WS_MODL))[(size_t)(li * 4 + v) * 6144 + c0 + col] = s; else ((float*)(a.ws + WS_MODC))[(size_t)li * 6144 + c0 + col] = s; }
        __syncthreads();
    }
    if (blockIdx.x == (unsigned)(c.G - 1)) for (int u = c.tid; u < 1024; u += NTHREADS) { const int pos = u >> 4, f = u & 15;
        const float inv = (float)pow(10000.0, -(double)f / 16.0); const double ang = (double)((float)pos * inv);
        ((f32x2*)(a.ws + WS_ROPE))[u] = (f32x2){(float)cos(ang), (float)sin(ang)}; }
    for (int u = blockIdx.x * NTHREADS + c.tid; u < 4 * 64 * 1024; u += c.G * NTHREADS) { const int li = u >> 16, n = (u >> 10) & 63, k = u & 1023;
        float w = 0.f; if (n < 4) w = a.in[I_WRG][((size_t)li * 1024 + k) * 4 + n]; else if (n < 36) w = a.in[I_WRE][((size_t)li * 1024 + k) * 32 + (n - 4)];
        const unsigned hi = cvtpk(w, 0.f) & 0xffffu; const float rem = w - bflo(hi); const unsigned lo = cvtpk(rem, 0.f) & 0xffffu;
        bf16* wr = (bf16*)(a.ws + WS_WR) + (size_t)li * 2 * 65536; wr[n * 1024 + k] = (bf16)hi; wr[65536 + n * 1024 + k] = (bf16)lo; }
}

__device__ __forceinline__ void ph_rmix(const Args& a, const Ctx& c, int layer) {
    const int gw = c.vcu * NWAVES + c.wave, NGW = c.G * NWAVES;
    const float* g = a.in[I_NMIX] + layer * D;
    for (int r = gw; r < TT; r += NGW) {
        f32x4 v[4], h[4]; load_row_combined(a, layer, r, c.lane, v);
        if (layer > 0) { f32x4* xo = (f32x4*)((float*)(a.ws + WS_X) + (size_t)r * D) + c.lane;
#pragma unroll
            for (int j = 0; j < 4; ++j) xo[64 * j] = v[j]; }
        const float rstd = row_rstd(v); const float* m = mod_row(a, layer, r);
        norm_mod(v, rstd, g, m, m + D, c.lane, h);
        if (ATT_FP8 && layer != 2) { unsigned* ho8 = (unsigned*)((unsigned char*)(a.ws + WS_HB) + (size_t)r * D) + c.lane;
#pragma unroll
            for (int j = 0; j < 4; ++j) ho8[64 * j] = pk_fp8x4(h[j].x, h[j].y, h[j].z, h[j].w); }
        else { u32x2* ho = (u32x2*)((bf16*)(a.ws + WS_HB) + (size_t)r * D) + c.lane;
#pragma unroll
            for (int j = 0; j < 4; ++j) ho[64 * j] = (u32x2){cvtpk(h[j].x, h[j].y), cvtpk(h[j].z, h[j].w)}; }
    }
}

__device__ __forceinline__ void ph_final(const Args& a, const Ctx& c, int layer) {
    const int gw = c.vcu * NWAVES + c.wave, NGW = c.G * NWAVES;
    float dscale = 1.f, dmark = 0.f;
#if DEBUG_CHECKS
    { unsigned* dbg = (unsigned*)(a.ws + WS_CTL) + CW_DBG; int code = 0; float mag = 0.f;
      for (int id = 1; id < 32; ++id) { const float e = __uint_as_float(__hip_atomic_load(dbg + id, __ATOMIC_RELAXED, __HIP_MEMORY_SCOPE_AGENT)); if (code == 0 && e > DBG_TOL) { code = id; mag = e; } }
      dscale = 1.f + (float)code; dmark = code ? 100.f * (1.f + fminf(fmaxf(log2f(mag / DBG_TOL), 0.f), 30.f)) : 0.f; }
#endif
    for (int r = gw; r < TL; r += NGW) {
        f32x4 v[4]; load_row_combined(a, layer, r, c.lane, v);
        const float rstd = row_rstd(v) * dscale;
        f32x4* o = (f32x4*)(a.out + (size_t)r * D) + c.lane;
#pragma unroll
        for (int j = 0; j < 4; ++j) { f32x4 ov = (v[j] * rstd) * ((const f32x4*)a.in[I_NFIN])[c.lane + 64 * j]; if (j == 0 && r == 0 && c.lane == 0 && dmark > 0.f) ov.x = dmark; o[64 * j] = ov; }
    }
}


namespace pg8 {
constexpr int BM = 256, BK = 64, HALF = 128, HTB = HALF * BK * 2, STAGE_BYTES = 8 * HTB;
__host__ __device__ __forceinline__ int lds_byte(int r, int c) { const int st = (r >> 4) * 2 + (c >> 5), rr = r & 15, cc = c & 31, ob = rr * 64 + cc * 2; return st * 1024 + (ob ^ (((ob >> 9) & 1) << 5)); }
__host__ __device__ __forceinline__ void stage_rc(int b, int& R, int& C) { const int st = b / 1024, sb = b % 1024, swz = sb ^ (((sb >> 9) & 1) << 5); R = (st >> 1) * 16 + swz / 64; C = (st & 1) * 32 + (swz % 64) / 2; }
__host__ __device__ __forceinline__ int perm32(int rho) { const int n = rho >> 4, i = rho & 15; return 8 * (i >> 2) + 4 * n + (i & 3); }
struct Unit { const char* A; const char* B; int pm, pn, x0, x1; };
__device__ __forceinline__ void tile_of(int L, int nM, int nN, int& pm, int& pn) {
    const int nwg = nM * nN; int wgid = L; { const int q = nwg / 8, r = nwg % 8, xcd = wgid % 8, off = wgid / 8; wgid = (xcd < r ? xcd * (q + 1) : r * (q + 1) + (xcd - r) * q) + off; }
    const int nig = 8 * nN, gid = wgid / nig, fm = gid * 8, gsz = (nM - fm) < 8 ? (nM - fm) : 8;
    pm = fm + ((wgid % nig) % gsz); pn = (wgid % nig) / gsz;
}
typedef int v4i_t __attribute__((ext_vector_type(4))); typedef int v8i_t __attribute__((ext_vector_type(8)));
template <class Epi, class Sched, bool GATHER, bool FP8 = false>
__device__ __forceinline__ void gemm_phase(LAS unsigned char* lds, const int Kb, const int ldab, const Sched& S, const Epi& E, const int scw = 127, const int sca = 127) {
    const int tid = tid_opaque(), wid = __builtin_amdgcn_readfirstlane(tid >> 6), lane = tid & 63, wr = wid >> 2, wc = wid & 3, fr = lane & 15, fq = lane >> 4;
    const int nt = Kb / (BK * 2);
    int scw_v = scw, sca_v = sca;
    unsigned voffA[2], voffB[2]; int RA[2], CA[2];
#pragma unroll
    for (int i = 0; i < 2; ++i) { int R, C; stage_rc(tid * 16 + i * 8192, R, C); const int Rb = Epi::PERM ? ((R & ~31) + perm32(R & 31)) : R;
        RA[i] = R; CA[i] = C; voffA[i] = (unsigned)(R * ldab + C * 2); voffB[i] = (unsigned)(Rb * Kb + C * 2); }
    const size_t kstep = (size_t)(BK * 2);
    const size_t hstepA = (size_t)HALF * ldab, hstepB = (size_t)HALF * Kb;
    const unsigned ldsw = (unsigned)wid * 1024u;
    const int aoff = lds_byte(wr * 64 + fr, fq * 8), boff = lds_byte(wc * 32 + fr, fq * 8);
#define PG8_SA(b, h) (((b) * 2 + (h)) * HTB)
#define PG8_SB(b, h) ((4 + (b) * 2 + (h)) * HTB)
#define PG8_GLDS(bufoff, gptr, i_) __builtin_amdgcn_global_load_lds((const unsigned*)(gptr), (LAS unsigned*)(lds + (bufoff) + ldsw + (i_) * 8192), 16, 0, 0)
#define PG8_STAGE_B(bufoff, gbase) do { _Pragma("unroll") for (int _i = 0; _i < 2; ++_i) PG8_GLDS(bufoff, (const char*)(gbase) + voffB[_i], _i); } while (0)
#define PG8_STAGE_A(bufoff, ab, kb, h, NX) do { _Pragma("unroll") for (int _i = 0; _i < 2; ++_i) { \
        if constexpr (GATHER) { const unsigned _vo = (NX) ? voN[h][_i] : voC[h][_i]; PG8_GLDS(bufoff, (ab) + (kb) + _vo, _i); } \
        else { PG8_GLDS(bufoff, (ab) + (kb) + (size_t)(h) * hstepA + voffA[_i], _i); } } } while (0)
#define PG8_LDA(dst, b, h) do { _Pragma("unroll") for (int m = 0; m < 4; ++m) _Pragma("unroll") for (int k = 0; k < 2; ++k) dst[m][k] = *(const LAS bf16x8*)(lds + PG8_SA(b, h) + aoff + m * 2048 + k * 1024); } while (0)
#define PG8_LDB(dst, b, h) do { _Pragma("unroll") for (int n = 0; n < 2; ++n) _Pragma("unroll") for (int k = 0; k < 2; ++k) dst[n][k] = *(const LAS bf16x8*)(lds + PG8_SB(b, h) + boff + n * 2048 + k * 1024); } while (0)
#define PG8_MMA(ai, bj, At, Bt) do { __builtin_amdgcn_s_setprio(1); _Pragma("unroll") for (int m = 0; m < 4; ++m) _Pragma("unroll") for (int n = 0; n < 2; ++n) { \
        if constexpr (FP8) { const v8i_t b8 = __builtin_shufflevector(__builtin_bit_cast(v4i_t, Bt[n][0]), __builtin_bit_cast(v4i_t, Bt[n][1]), 0, 1, 2, 3, 4, 5, 6, 7), a8 = __builtin_shufflevector(__builtin_bit_cast(v4i_t, At[m][0]), __builtin_bit_cast(v4i_t, At[m][1]), 0, 1, 2, 3, 4, 5, 6, 7); \
            asm volatile("v_mfma_scale_f32_16x16x128_f8f6f4 %0, %1, %2, %0, %3, %4 op_sel_hi:[0,0,0]" : "+v"(acc[ai][bj][m][n]) : "v"(b8), "v"(a8), "v"(scw_v), "v"(sca_v)); } \
        else { _Pragma("unroll") for (int k = 0; k < 2; ++k) acc[ai][bj][m][n] = __builtin_amdgcn_mfma_f32_16x16x32_bf16(Bt[n][k], At[m][k], acc[ai][bj][m][n], 0, 0, 0); } } __builtin_amdgcn_s_setprio(0); } while (0)
#define PG8_WAIT_V(n) asm volatile("s_waitcnt vmcnt(" #n ")" ::: "memory")
#define PG8_WAIT_L(n) asm volatile("s_waitcnt lgkmcnt(" #n ")" ::: "memory")
#define PG8_BAR __builtin_amdgcn_s_barrier()
#define PG8_SCHED __builtin_amdgcn_sched_barrier(0)
    Unit cur, nxt, pend; int ui = 0; bool have_pend = false;
    if (!S.next(0, cur)) return;
    pend = cur;
    unsigned voC[2][2], voN[2][2];
    if constexpr (GATHER) {
#pragma unroll
        for (int h = 0; h < 2; ++h)
#pragma unroll
            for (int i = 0; i < 2; ++i) { voC[h][i] = (unsigned)(S.gather(cur, h * HALF + RA[i]) * ldab + CA[i] * 2); voN[h][i] = voC[h][i]; }
    } else { voC[0][0] = voN[0][0] = 0u; }
    f32x4 acc[2][2][4][2];
#pragma unroll
    for (int a = 0; a < 2; ++a)
#pragma unroll
        for (int b = 0; b < 2; ++b)
#pragma unroll
            for (int m = 0; m < 4; ++m)
#pragma unroll
                for (int n = 0; n < 2; ++n) acc[a][b][m][n] = (f32x4){0.f, 0.f, 0.f, 0.f};
    bf16x8 At[4][2], B0[2][2], B1[2][2];
    const char* cA = cur.A; const char* cB = cur.B;
    S.a_ready(cur, wid);
    PG8_STAGE_B(PG8_SB(0, 0), cB); PG8_STAGE_B(PG8_SB(0, 1), cB + hstepB); PG8_STAGE_A(PG8_SA(0, 0), cA, (size_t)0, 0, false); PG8_STAGE_A(PG8_SA(0, 1), cA, (size_t)0, 1, false);
    if (wr == 1) PG8_BAR;
    PG8_WAIT_V(2); PG8_BAR;
    PG8_STAGE_B(PG8_SB(1, 0), cB + kstep); PG8_STAGE_A(PG8_SA(1, 0), cA, kstep, 0, false); PG8_STAGE_B(PG8_SB(1, 1), cB + hstepB + kstep);
    PG8_WAIT_V(6); PG8_BAR;
    for (;;) {
        const bool has_next = S.next(ui + 1, nxt);
        if constexpr (GATHER) { if (has_next) {
#pragma unroll
            for (int h = 0; h < 2; ++h)
#pragma unroll
                for (int i = 0; i < 2; ++i) voN[h][i] = (unsigned)(S.gather(nxt, h * HALF + RA[i]) * ldab + CA[i] * 2); } }
        const char* nA = has_next ? nxt.A : cA; const char* nB = has_next ? nxt.B : cB;
        for (int t = 0; t < nt; t += 2) {
            const bool last = (t == nt - 2);
            const size_t k1 = (size_t)(t + 1) * kstep;
            const char* a2 = last ? nA : cA; const size_t k2 = last ? (size_t)0 : (size_t)(t + 2) * kstep; const size_t k3 = k2 + kstep;
            const char* b2 = last ? nB : cB + (size_t)(t + 2) * kstep; const char* b3 = b2 + kstep;
            const bool nx = GATHER ? (last && has_next) : false;
            if (last && has_next) S.a_ready(nxt, wid);
            PG8_LDB(B0, 0, 0); PG8_LDB(B1, 0, 1); PG8_SCHED; PG8_LDA(At, 0, 0); PG8_STAGE_A(PG8_SA(1, 1), cA, k1, 1, false);
            PG8_WAIT_V(8); PG8_WAIT_L(0); PG8_BAR; PG8_MMA(0, 0, At, B0); PG8_MMA(0, 1, At, B1); PG8_BAR; PG8_SCHED;
            PG8_LDA(At, 0, 1); PG8_STAGE_B(PG8_SB(0, 0), b2); PG8_STAGE_B(PG8_SB(0, 1), b2 + hstepB); PG8_STAGE_A(PG8_SA(0, 0), a2, k2, 0, nx);
            PG8_WAIT_V(8); PG8_WAIT_L(0);
            if (have_pend) { S.done(pend, lane); have_pend = false; }
            PG8_BAR; PG8_MMA(1, 0, At, B0); PG8_MMA(1, 1, At, B1); PG8_BAR; PG8_SCHED;
            PG8_LDB(B0, 1, 0); PG8_LDB(B1, 1, 1); PG8_SCHED; PG8_LDA(At, 1, 0); PG8_STAGE_A(PG8_SA(0, 1), a2, k2, 1, nx);
            PG8_WAIT_V(8); PG8_WAIT_L(0); PG8_BAR; PG8_MMA(0, 0, At, B0); PG8_MMA(0, 1, At, B1); PG8_BAR; PG8_SCHED;
            PG8_LDA(At, 1, 1); PG8_STAGE_B(PG8_SB(1, 0), b3); PG8_STAGE_B(PG8_SB(1, 1), b3 + hstepB); PG8_STAGE_A(PG8_SA(1, 0), a2, k3, 0, nx);
            PG8_WAIT_V(8); PG8_WAIT_L(0); PG8_BAR; PG8_MMA(1, 0, At, B0); PG8_MMA(1, 1, At, B1); PG8_BAR; PG8_SCHED;
        }
        if (wr == 0) PG8_BAR;
        if constexpr (FP8) asm volatile("s_nop 15\n\ts_nop 15" ::: "memory");
        E(acc, cur, wr, wc, fr, fq);
        pend = cur; have_pend = true;
        if (!has_next) break;
#pragma unroll
        for (int a = 0; a < 2; ++a)
#pragma unroll
            for (int b = 0; b < 2; ++b)
#pragma unroll
                for (int m = 0; m < 4; ++m)
#pragma unroll
                    for (int n = 0; n < 2; ++n) acc[a][b][m][n] = (f32x4){0.f, 0.f, 0.f, 0.f};
        cur = nxt; cA = nA; cB = nB; ++ui;
        if constexpr (GATHER) {
#pragma unroll
            for (int h = 0; h < 2; ++h)
#pragma unroll
                for (int i = 0; i < 2; ++i) voC[h][i] = voN[h][i]; }
        if (wr == 1) PG8_BAR;
    }
    PG8_WAIT_V(0);
    if (have_pend) S.done(pend, lane);
    PG8_BAR;
#undef PG8_SA
#undef PG8_SB
#undef PG8_GLDS
#undef PG8_STAGE_A
#undef PG8_STAGE_B
#undef PG8_LDA
#undef PG8_LDB
#undef PG8_MMA
#undef PG8_WAIT_V
#undef PG8_WAIT_L
#undef PG8_BAR
#undef PG8_SCHED
}
}
#include <hip/hip_bf16.h>
#include <cmath>
namespace attn_body {
using bf16=__hip_bfloat16;
using bf16x8=__attribute__((ext_vector_type(8)))short;
using s16x4=__attribute__((ext_vector_type(4)))short;
using f32x16=__attribute__((ext_vector_type(16)))float;
using u32x4=__attribute__((ext_vector_type(4)))unsigned;
constexpr int D=64,QP=1024,KVP=256;
constexpr int NW=8,QBLK=32,QB=QBLK*NW,KVBLK=64;
__device__ __forceinline__ int crow(int r,int hi){return (r&3)+8*(r>>2)+4*hi;}
#define SBAR() __builtin_amdgcn_sched_barrier(0)
constexpr int NSLOT=3, SLOTB=8192;
constexpr int LDS_K=0, LDS_V=NSLOT*SLOTB, LDS_WS=2*NSLOT*SLOTB, LDS_OST=LDS_WS+NW*64*4, LDS_BYTES=LDS_OST+NW*4096;
constexpr float C2=0.125f*1.4426950408889634f;
__device__ __forceinline__ void glds16s(const void*sbase,unsigned voff,unsigned lds_dst){unsigned keep;
  asm volatile("s_mov_b32 %0, m0\n\ts_mov_b32 m0, %3\n\ts_nop 4\n\tglobal_load_lds_dwordx4 %1, %2\n\ts_mov_b32 m0, %0":"=&s"(keep):"v"(voff),"s"(sbase),"s"(lds_dst):"memory");}
__device__ __forceinline__ float max3f(float a,float b,float c){float r;asm("v_max3_f32 %0, %1, %2, %3":"=v"(r):"v"(a),"v"(b),"v"(c));return r;}
__device__ __forceinline__ float max2f(float a,float b){float r;asm("v_max_f32_e32 %0, %1, %2":"=v"(r):"v"(a),"v"(b));return r;}
__device__ __forceinline__ float fadd_s(float a,float b){float r;asm("v_add_f32_e32 %0, %1, %2":"=v"(r):"v"(a),"v"(b));return r;}
__device__ __forceinline__ float fsub_s(float a,float b){float r;asm("v_sub_f32_e32 %0, %1, %2":"=v"(r):"v"(a),"v"(b));return r;}
typedef float f32x2_t __attribute__((ext_vector_type(2))); typedef __bf16 bf16x2_t __attribute__((ext_vector_type(2)));
__device__ __forceinline__ unsigned cvtpk_s(float lo,float hi){f32x2_t v={lo,hi};bf16x2_t b=__builtin_convertvector(v,bf16x2_t);return __builtin_bit_cast(unsigned,b);}
#define WAIT_BAR(N) asm volatile("s_waitcnt vmcnt(" #N ") lgkmcnt(0)\n\ts_barrier":::"memory")

__device__ __forceinline__ void qkt(f32x16&p0,f32x16&p1,const char*Kslot,const bf16x8*qr,const f32x16&negm,int r32,int hi){
  const char*kb=Kslot+hi*1024+r32*16;
  #pragma unroll
  for(int d0=0;d0<4;++d0){
    const bf16x8 b0=*reinterpret_cast<const bf16x8*>(kb+d0*2048);
    const bf16x8 b1=*reinterpret_cast<const bf16x8*>(kb+d0*2048+512);
    if(d0==0){p0=__builtin_amdgcn_mfma_f32_32x32x16_bf16(b0,qr[0],negm,0,0,0);p1=__builtin_amdgcn_mfma_f32_32x32x16_bf16(b1,qr[0],negm,0,0,0);}
    else{p0=__builtin_amdgcn_mfma_f32_32x32x16_bf16(b0,qr[d0],p0,0,0,0);p1=__builtin_amdgcn_mfma_f32_32x32x16_bf16(b1,qr[d0],p1,0,0,0);}}
}
typedef __attribute__((address_space(3))) const char* lds_cptr;
typedef short v4i16_t __attribute__((ext_vector_type(4)));
__device__ __forceinline__ void kload8(bf16x8*kf,lds_cptr kp){
  kf[0]=*(const __attribute__((address_space(3))) bf16x8*)(kp);      kf[1]=*(const __attribute__((address_space(3))) bf16x8*)(kp+512);
  kf[2]=*(const __attribute__((address_space(3))) bf16x8*)(kp+2048); kf[3]=*(const __attribute__((address_space(3))) bf16x8*)(kp+2560);
  kf[4]=*(const __attribute__((address_space(3))) bf16x8*)(kp+4096); kf[5]=*(const __attribute__((address_space(3))) bf16x8*)(kp+4608);
  kf[6]=*(const __attribute__((address_space(3))) bf16x8*)(kp+6144); kf[7]=*(const __attribute__((address_space(3))) bf16x8*)(kp+6656);
}
__device__ __forceinline__ void kload2(bf16x8*kf,lds_cptr kp,int j){ kf[2*j]=*(const __attribute__((address_space(3))) bf16x8*)(kp+j*2048); kf[2*j+1]=*(const __attribute__((address_space(3))) bf16x8*)(kp+j*2048+512); }
__device__ __forceinline__ s16x4 vtr(lds_cptr p){ return __builtin_bit_cast(s16x4,__builtin_amdgcn_ds_read_tr16_b64_v4i16((__attribute__((address_space(3))) v4i16_t*)p)); }
__device__ __forceinline__ float rowmax(const f32x16&p0,const f32x16&p1){
  float a=max3f(p0[0],p0[1],p1[0]),b=max3f(p0[2],p0[3],p1[1]);a=max3f(a,p1[2],p1[3]);
  #pragma unroll
  for(int r=4;r<16;r+=4){a=max3f(a,p0[r],p0[r+1]);b=max3f(b,p0[r+2],p0[r+3]);a=max3f(a,p1[r],p1[r+1]);b=max3f(b,p1[r+2],p1[r+3]);}
  const float m=max2f(a,b);
  auto rr=__builtin_amdgcn_permlane32_swap(__float_as_uint(m),__float_as_uint(m),false,false);
  return max2f(__uint_as_float(rr[0]),__uint_as_float(rr[1]));
}
__device__ __forceinline__ void pv(f32x16*o,int vb,bf16x8 pa0,bf16x8 pa1,bf16x8 pa2,bf16x8 pa3){
  #pragma unroll
  for(int d0=0;d0<2;++d0){s16x4 lo[4],hi[4];
    #pragma unroll
    for(int ks=0;ks<4;++ks){
      asm volatile("ds_read_b64_tr_b16 %0,%1 offset:%c2":"=&v"(lo[ks]):"v"(vb),"i"(d0*4096+ks*1024):"memory");
      asm volatile("ds_read_b64_tr_b16 %0,%1 offset:%c2":"=&v"(hi[ks]):"v"(vb),"i"(d0*4096+ks*1024+512):"memory");}
    asm volatile("s_waitcnt lgkmcnt(0)":::"memory");SBAR();
    #define PK(k) (bf16x8){lo[k][0],lo[k][1],lo[k][2],lo[k][3],hi[k][0],hi[k][1],hi[k][2],hi[k][3]}
    o[d0]=__builtin_amdgcn_mfma_f32_32x32x16_bf16(pa0,PK(0),o[d0],0,0,0);
    o[d0]=__builtin_amdgcn_mfma_f32_32x32x16_bf16(pa1,PK(1),o[d0],0,0,0);
    o[d0]=__builtin_amdgcn_mfma_f32_32x32x16_bf16(pa2,PK(2),o[d0],0,0,0);
    o[d0]=__builtin_amdgcn_mfma_f32_32x32x16_bf16(pa3,PK(3),o[d0],0,0,0);
    #undef PK
  }
}

#ifndef ATTN_STORE16
#define ATTN_STORE16(p,v) (*(u32x4*)(p)=(v))
#endif
template<int THRL> __device__ __forceinline__ void attn_unit(long qrow0,int h,long kvrow0,int NT,const bf16*Q,const bf16*__restrict__ K,const bf16*__restrict__ V,bf16*O,char*shm){
  const int tid=tid_opaque(),lane=tid&63,r32=lane&31,hi=lane>>5; const int wid=__builtin_amdgcn_readfirstlane(tid>>6);
  const bf16*Qw=Q+(qrow0+wid*QBLK)*QP+h*D;
  const bf16*Kh=K+kvrow0*KVP+(h>>2)*D,*Vh=V+kvrow0*KVP+(h>>2)*D;
  const unsigned lds0=(unsigned)(uintptr_t)shm;
  float*wsf=(float*)(shm+LDS_WS)+wid*64;
  const unsigned kvo=(unsigned)(lane*KVP+wid*8)*2u;
  const unsigned vvo=(unsigned)((16*(wid&3)+(lane>>2))*KVP+(wid>>2)*32+(lane&3)*8)*2u;
  const unsigned kdst=lds0+LDS_K+wid*1024, vdst=lds0+LDS_V+wid*1024;
  #define DMA_K(t,slot) glds16s(Kh+(long)(t)*KVBLK*KVP,kvo,(unsigned)__builtin_amdgcn_readfirstlane(kdst+(slot)))
  #define DMA_V(t,slot) glds16s(Vh+(long)(t)*KVBLK*KVP,vvo,(unsigned)__builtin_amdgcn_readfirstlane(vdst+(slot)))
  const int vb0=(int)(lds0+LDS_V)+((lane>>4)&1)*32+(lane&3)*8+(4*hi+((lane&15)>>2))*64;
  const char*Kbase=shm+LDS_K; bf16x8 kf[8];
  const lds_cptr shm3=(lds_cptr)shm; const lds_cptr kp0=shm3+LDS_K+hi*1024+r32*16; const lds_cptr vp0=shm3+LDS_V+((lane>>4)&1)*32+(lane&3)*8+(4*hi+((lane&15)>>2))*64;
  DMA_K(0,0);DMA_V(0,0);DMA_K(1,SLOTB);
  bf16x8 qr[4];
  #pragma unroll
  for(int d0=0;d0<4;++d0)qr[d0]=*reinterpret_cast<const bf16x8*>(&Qw[(long)r32*QP+d0*16+hi*8]);
  float mhat=0.f,l_reg=0.f;f32x16 o[2];o[0]=f32x16{};o[1]=f32x16{};f32x16 negm=f32x16{};asm volatile("":"+v"(negm));
  #define CMASK(P0,P1,t) do{}while(0)
  bool resc=false;
  #define START(P0,P1) do{ const float rm=rowmax(P0,P1); resc=false; \
    { const float dl=rm; mhat=fadd_s(mhat,dl); \
      _Pragma("unroll") for(int r=0;r<16;++r){P0[r]=fsub_s(P0[r],dl);P1[r]=fsub_s(P1[r],dl);} \
      _Pragma("unroll") for(int r=0;r<16;++r)negm[r]=-mhat; asm volatile("":"+v"(negm)); } \
    _Pragma("unroll") for(int r=0;r<16;++r)P0[r]=__builtin_amdgcn_exp2f(P0[r]); }while(0)
  #define RESC() do{ if(resc){ asm volatile("s_waitcnt lgkmcnt(0)":::"memory"); \
      _Pragma("unroll") for(int d_=0;d_<2;++d_) _Pragma("unroll") for(int r=0;r<16;++r)o[d_][r]*=wsf[crow(r,hi)]; } }while(0)
  f32x16 pA0,pA1,pB0,pB1;
  int sl_prev=0,sl_cur=0,sl_next=SLOTB;
  #define ROT() do{sl_prev=sl_cur;sl_cur=sl_next;sl_next=(sl_next==(NSLOT-1)*SLOTB)?0:sl_next+SLOTB;}while(0)
  DMA_K(2,2*SLOTB);
  WAIT_BAR(3);
  qkt(pA0,pA1,Kbase,qr,negm,r32,hi);asm volatile("s_nop 15\n\ts_nop 7":"+v"(pA0),"+v"(pA1));CMASK(pA0,pA1,0);
  START(pA0,pA1);
  _Pragma("unroll") for(int r=0;r<16;++r)pA1[r]=__builtin_amdgcn_exp2f(pA1[r]);
  WAIT_BAR(0);
  DMA_K(3,0);DMA_V(1,SLOTB);
  ROT();
  kload8(kf,kp0+sl_cur);
  WAIT_BAR(2);
  s16x4 vlo[8],vhi[8]; u32x4 pw0,pw1,pw2,pw3;
  #define PKW(P,B) cvtpk_s(P[B],P[B+1])
  #define PAF(k) __builtin_bit_cast(bf16x8,pw##k)
  #define VFR(i) (bf16x8){vlo[i][0],vlo[i][1],vlo[i][2],vlo[i][3],vhi[i][0],vhi[i][1],vhi[i][2],vhi[i][3]}
  #define PIN(x) asm volatile("":"+v"(x))
  #define MX3(a,b,c) __builtin_fmaxf(__builtin_fmaxf((a),(b)),(c))
  #define GAPA(MF,A0,A1,A2,A3,W0,W1,PW) do{ MF; sacc+=A0; sacc+=A1; sacc+=A2; sacc+=A3; PIN(sacc); W0; W1; PIN(PW); SBAR(); }while(0)
  #define EX(v) __builtin_amdgcn_exp2f(v)
  #define GAPB(MF,X,B) do{ MF; X[B]=EX(X[B]); X[B+1]=EX(X[B+1]); X[B+2]=EX(X[B+2]); X[B+3]=EX(X[B+3]); PIN(X); SBAR(); }while(0)
  #define VRD(i) do{ vlo[i]=vtr(vp_+(((i)>>2)*4096+((i)&3)*1024)); vhi[i]=vtr(vp_+(((i)>>2)*4096+((i)&3)*1024+512)); }while(0)
  #define KRD(G,j) do{ if(G){ kload2(kf,kp0+sl_next,j); SBAR(); } }while(0)
  #define STEP(C0,C1,P0,P1,t,GK,GV,GL) do{ SBAR(); \
    const lds_cptr vp_=vp0+sl_prev; \
    VRD(0); SBAR(); float sacc=(P0[0]+P0[1]); \
    GAPA(C0=__builtin_amdgcn_mfma_f32_32x32x16_bf16(kf[0],qr[0],negm,0,0,0), P0[2],P0[3],P0[4],P0[5],     pw0[0]=PKW(P0,0), pw0[1]=PKW(P0,2), pw0); \
    VRD(4); SBAR(); GAPA(C1=__builtin_amdgcn_mfma_f32_32x32x16_bf16(kf[1],qr[0],negm,0,0,0), P0[6],P0[7],P0[8],P0[9],     pw0[2]=PKW(P0,4), pw0[3]=PKW(P0,6), pw0); \
    VRD(1); SBAR(); GAPA(C0=__builtin_amdgcn_mfma_f32_32x32x16_bf16(kf[2],qr[1],C0,0,0,0),   P0[10],P0[11],P0[12],P0[13], pw1[0]=PKW(P0,8), pw1[1]=PKW(P0,10), pw1); \
    VRD(5); SBAR(); GAPA(C1=__builtin_amdgcn_mfma_f32_32x32x16_bf16(kf[3],qr[1],C1,0,0,0),   P0[14],P0[15],P1[0],P1[1],   pw1[2]=PKW(P0,12),pw1[3]=PKW(P0,14), pw1); \
    VRD(2); SBAR(); GAPA(C0=__builtin_amdgcn_mfma_f32_32x32x16_bf16(kf[4],qr[2],C0,0,0,0),   P1[2],P1[3],P1[4],P1[5],     pw2[0]=PKW(P1,0), pw2[1]=PKW(P1,2), pw2); \
    VRD(6); SBAR(); GAPA(C1=__builtin_amdgcn_mfma_f32_32x32x16_bf16(kf[5],qr[2],C1,0,0,0),   P1[6],P1[7],P1[8],P1[9],     pw2[2]=PKW(P1,4), pw2[3]=PKW(P1,6), pw2); \
    VRD(3); SBAR(); GAPA(C0=__builtin_amdgcn_mfma_f32_32x32x16_bf16(kf[6],qr[3],C0,0,0,0),   P1[10],P1[11],P1[12],P1[13], pw3[0]=PKW(P1,8), pw3[1]=PKW(P1,10), pw3); \
    VRD(7); SBAR(); GAPA(C1=__builtin_amdgcn_mfma_f32_32x32x16_bf16(kf[7],qr[3],C1,0,0,0),   P1[14],P1[15],0.f,0.f,       pw3[2]=PKW(P1,12),pw3[3]=PKW(P1,14), pw3); \
    l_reg+=sacc; \
    if(GK){DMA_K((t)+3,sl_cur);} if(GV){DMA_V((t)+1,sl_next);} \
    CMASK(C0,C1,t); \
    { float a=MX3(C0[0],C0[1],C1[0]),b=MX3(C0[2],C0[3],C1[1]); a=MX3(a,C1[2],C1[3]); \
      _Pragma("unroll") for(int r=4;r<16;r+=4){a=MX3(a,C0[r],C0[r+1]);b=MX3(b,C0[r+2],C0[r+3]);a=MX3(a,C1[r],C1[r+1]);b=MX3(b,C1[r+2],C1[r+3]);} \
      float rm=__builtin_fmaxf(a,b); { auto rr=__builtin_amdgcn_permlane32_swap(__float_as_uint(rm),__float_as_uint(rm),false,false); rm=__builtin_fmaxf(__uint_as_float(rr[0]),__uint_as_float(rr[1])); } \
      resc=false; \
      if(__builtin_expect(__any(rm>(float)THRL),0)){ const float dl=__builtin_fmaxf(rm,0.f); mhat+=dl; \
        _Pragma("unroll") for(int r=0;r<16;++r){C0[r]-=dl;C1[r]-=dl;} \
        _Pragma("unroll") for(int r=0;r<16;++r)negm[r]=-mhat; asm volatile("":"+v"(negm)); \
        const float f=__builtin_amdgcn_exp2f(-dl); l_reg*=f; if(hi==0)wsf[r32]=f; resc=true; } } \
    SBAR(); \
    GAPB(o[0]=__builtin_amdgcn_mfma_f32_32x32x16_bf16(PAF(0),VFR(0),o[0],0,0,0), C0,0); \
    GAPB(o[1]=__builtin_amdgcn_mfma_f32_32x32x16_bf16(PAF(0),VFR(4),o[1],0,0,0), C0,4); \
    KRD(GL,0); GAPB(o[0]=__builtin_amdgcn_mfma_f32_32x32x16_bf16(PAF(1),VFR(1),o[0],0,0,0), C0,8); \
    KRD(GL,1); GAPB(o[1]=__builtin_amdgcn_mfma_f32_32x32x16_bf16(PAF(1),VFR(5),o[1],0,0,0), C0,12); \
    KRD(GL,2); GAPB(o[0]=__builtin_amdgcn_mfma_f32_32x32x16_bf16(PAF(2),VFR(2),o[0],0,0,0), C1,0); \
    KRD(GL,3); GAPB(o[1]=__builtin_amdgcn_mfma_f32_32x32x16_bf16(PAF(2),VFR(6),o[1],0,0,0), C1,4); \
    GAPB(o[0]=__builtin_amdgcn_mfma_f32_32x32x16_bf16(PAF(3),VFR(3),o[0],0,0,0), C1,8); \
    GAPB(o[1]=__builtin_amdgcn_mfma_f32_32x32x16_bf16(PAF(3),VFR(7),o[1],0,0,0), C1,12); \
    }while(0)
  int t=1;
  for(;t+5<NT;t+=2){
    STEP(pB0,pB1,pA0,pA1,t,true,true,true);     WAIT_BAR(2); RESC(); ROT();
    STEP(pA0,pA1,pB0,pB1,t+1,true,true,true);   WAIT_BAR(2); RESC(); ROT();
  }
  #define ENDW(tt) do{ if((tt)+3<NT){WAIT_BAR(2);} else if((tt)+2<NT){WAIT_BAR(1);} else {WAIT_BAR(0);} }while(0)
  for(;t+1<NT;t+=2){
    STEP(pB0,pB1,pA0,pA1,t,(t+3<NT),(t+1<NT),(t+1<NT));       ENDW(t);   RESC(); ROT();
    STEP(pA0,pA1,pB0,pB1,t+1,(t+4<NT),(t+2<NT),(t+2<NT));     ENDW(t+1); RESC(); ROT();
  }
  STEP(pB0,pB1,pA0,pA1,NT-1,false,false,false); RESC();
  { float sacc=pB0[0]+pB0[1]; _Pragma("unroll") for(int r=2;r<16;++r)sacc+=pB0[r]; _Pragma("unroll") for(int r=0;r<16;++r)sacc+=pB1[r]; l_reg+=sacc;
    pw0=(u32x4){PKW(pB0,0),PKW(pB0,2),PKW(pB0,4),PKW(pB0,6)};pw1=(u32x4){PKW(pB0,8),PKW(pB0,10),PKW(pB0,12),PKW(pB0,14)};pw2=(u32x4){PKW(pB1,0),PKW(pB1,2),PKW(pB1,4),PKW(pB1,6)};pw3=(u32x4){PKW(pB1,8),PKW(pB1,10),PKW(pB1,12),PKW(pB1,14)};
    SBAR(); pv(o,vb0+sl_cur,PAF(0),PAF(1),PAF(2),PAF(3)); }
  #undef PKW
  #undef PAF
  #undef VFR
  #undef PIN
  #undef MX3
  #undef GAPA
  #undef GAPB
  #undef EX
  #undef VRD
  #undef KRD
  #undef STEP
  #undef ENDW
  {auto rr=__builtin_amdgcn_permlane32_swap(__float_as_uint(l_reg),__float_as_uint(l_reg),false,false);l_reg=__uint_as_float(rr[0])+__uint_as_float(rr[1]);}
  if(hi==0)wsf[32+r32]=l_reg;asm volatile("s_waitcnt lgkmcnt(0)":::"memory");
  float rli[16];
  #pragma unroll
  for(int r=0;r<16;++r)rli[r]=__builtin_amdgcn_rcpf(wsf[32+crow(r,hi)]);
#if ATT_FP8
  { unsigned char*Ow8=(unsigned char*)O+(qrow0+wid*QBLK)*QP+h*D;
    unsigned char*stg8=(unsigned char*)(shm+LDS_OST)+wid*4096;
    #pragma unroll
    for(int r=0;r<16;++r){const int orow=crow(r,hi);
      #pragma unroll
      for(int d0=0;d0<2;++d0){const float x=o[d0][r]*rli[r]*(float)(1<<ATT_OSH); stg8[orow*64+d0*32+r32]=(unsigned char)(__builtin_amdgcn_cvt_pk_fp8_f32(x,x,0u,false)&0xffu);}}
    asm volatile("s_waitcnt lgkmcnt(0)":::"memory");
    #pragma unroll
    for(int i=0;i<2;++i){const int row=i*16+(lane>>2),ch=lane&3; const u32x4 v=*(const u32x4*)(stg8+row*64+ch*16); ATTN_STORE16(Ow8+(long)row*QP+ch*16,v);} }
#else
  bf16*Ow=O+(qrow0+wid*QBLK)*QP+h*D;
  { bf16*stg=(bf16*)(shm+LDS_OST)+wid*2048;
    #pragma unroll
    for(int r=0;r<16;++r){const int orow=crow(r,hi);
      #pragma unroll
      for(int d0=0;d0<2;++d0)stg[orow*64+d0*32+r32]=__float2bfloat16(o[d0][r]*rli[r]);}
    asm volatile("s_waitcnt lgkmcnt(0)":::"memory");
    #pragma unroll
    for(int i=0;i<4;++i){const int row=i*8+(lane>>3),ch=lane&7; const u32x4 v=*(const u32x4*)(stg+row*64+ch*8); ATTN_STORE16(Ow+(long)row*QP+ch*8,v);} }
#endif
  asm volatile("s_waitcnt lgkmcnt(0)\n\ts_barrier":::"memory");
  #undef DMA_K
  #undef DMA_V
  #undef CMASK
  #undef START
  #undef RESC
  #undef ROT
}
constexpr int ATTN_LDS_BYTES=LDS_BYTES;
#undef SBAR
#undef WAIT_BAR
}

typedef f32x4 AccT[2][2][4][2];
__device__ __forceinline__ long kv_row(int r) { return r < TL ? (long)(r / SEQ) * KVROWS + CTXL + (r % SEQ) : (long)((r - TL) / CTXL) * KVROWS + ((r - TL) % CTXL); }

struct SchedDense {
    const char* A; const char* B; size_t astep, bstep, acol; int nM, nN, G, c;
    __device__ __forceinline__ bool next(int i, pg8::Unit& u) const {
        const int L = i * G + c; if (L >= nM * nN) return false;
        pg8::tile_of(L, nM, nN, u.pm, u.pn); u.A = A + (size_t)u.pm * astep + (size_t)u.pn * acol; u.B = B + (size_t)u.pn * bstep; u.x0 = 0; u.x1 = 0; return true; }
    __device__ __forceinline__ int gather(const pg8::Unit&, int) const { return 0; }
    __device__ __forceinline__ void a_ready(const pg8::Unit&, int) const {}
    __device__ __forceinline__ void done(const pg8::Unit&, int) const {}
};
struct SchedQKV {
    const char* A; const char* B; size_t tstep; int ctxq, G, c;
    __device__ __forceinline__ bool next(int i, pg8::Unit& u) const {
        const int L = i * G + c, n1 = 64 * 6, n2 = ctxq ? 24 : 8; if (L >= n1 + n2) return false;
        if (L < n1) pg8::tile_of(L, 64, 6, u.pm, u.pn);
        else if (ctxq) { pg8::tile_of(L - n1, 4, 6, u.pm, u.pn); u.pm += 64; }
        else { u.pm = 64 + ((L - n1) >> 1); u.pn = 4 + ((L - n1) & 1); }
        u.A = A + (size_t)u.pm * tstep; u.B = B + (size_t)u.pn * tstep; u.x0 = 0; u.x1 = 0; return true; }
    __device__ __forceinline__ int gather(const pg8::Unit&, int) const { return 0; }
    __device__ __forceinline__ void a_ready(const pg8::Unit&, int) const {}
    __device__ __forceinline__ void done(const pg8::Unit&, int) const {}
};
struct SchedMoe {
    const char* Abase; size_t astep; const char* Bbase; size_t bstep_e, bstep_n; const LAS int* tab; const int* list; int G, c;
    unsigned* ready; int mode;
    __device__ __forceinline__ int T(int i) const { return __builtin_amdgcn_readfirstlane(tab[i]); }
    __device__ __forceinline__ bool next(int i, pg8::Unit& u) const {
        const int ntiles = T(32), L = i * G + (mode == 2 ? G - 1 - c : c); if (L >= ntiles * 4) return false;
        int gt, pn; pg8::tile_of(L, ntiles, 4, gt, pn);
        int e = 0;
        for (int q = 1; q < 32; ++q) e += (T(q) <= gt) ? 1 : 0;
        const int ti = gt - T(e); int valid = T(40 + e) - ti * 256; valid = valid > 256 ? 256 : valid;
        u.pm = gt; u.pn = pn; u.x0 = e * MOE_CAP + ti * 256; u.x1 = valid;
        u.A = Abase + (size_t)gt * astep; u.B = Bbase + (size_t)e * bstep_e + (size_t)pn * bstep_n; return true; }
    __device__ __forceinline__ int gather(const pg8::Unit& u, int lr) const { return lr < u.x1 ? (list[u.x0 + lr] >> 1) : 0; }
    __device__ __forceinline__ void a_ready(const pg8::Unit& u, int wid) const {
        if (mode != 2) return;
        if (wid == 0) { unsigned sp = 0;
            while ((unsigned)__builtin_amdgcn_readfirstlane(__hip_atomic_load(ready + u.pm, __ATOMIC_RELAXED, __HIP_MEMORY_SCOPE_AGENT)) < 32u) { __builtin_amdgcn_s_sleep(2); if (++sp > (1u << 22)) break; }
            __builtin_amdgcn_fence(__ATOMIC_ACQUIRE, "agent"); asm volatile("s_waitcnt vmcnt(0)" ::: "memory"); }
        __builtin_amdgcn_s_barrier(); asm volatile("" ::: "memory");
    }
    __device__ __forceinline__ void done(const pg8::Unit& u, int lane) const {
        if (mode != 1) return;
        if (lane == 0) __hip_atomic_fetch_add(ready + u.pm, 1u, __ATOMIC_RELAXED, __HIP_MEMORY_SCOPE_AGENT);
    }
};

struct EpiQKV { static constexpr bool PERM = true; bf16* Q; bf16* Kb; bf16* Vb; const float* qg; const float* kg; const f32x2* tab;
    __device__ __forceinline__ void operator()(const AccT& acc, const pg8::Unit& u, int wr, int wc, int fr, int fq) const {
        bf16* base; int pitch; long row0;
        if (u.pn < 4) { base = Q + u.pn * 256; pitch = 1024; row0 = (long)u.pm * 256; }
        else { base = (u.pn == 4) ? Kb : Vb; pitch = 256; row0 = kv_row(u.pm * 256); }
        const bool isv = u.pn == 5, lat = u.pm < 64; const float* g = u.pn < 4 ? qg : kg; const float post = u.pn < 4 ? 0.125f * 1.4426950408889634f : 1.0f;
#pragma unroll
        for (int ai = 0; ai < 2; ++ai)
#pragma unroll
            for (int m = 0; m < 4; ++m) { int fq_ = fq; asm volatile("" : "+v"(fq_));
                const int fq = fq_; const int lr = ai * 128 + wr * 64 + m * 16 + fr; const unsigned roff = (unsigned)(((int)row0 + lr) * pitch + wc * 64 + 8 * fq) * 2u;
                f32x4 g0[2], g1[2];
#pragma unroll
                for (int bj = 0; bj < 2; ++bj) { g0[bj] = *(const f32x4*)(g + 32 * bj + 8 * fq); g1[bj] = *(const f32x4*)(g + 32 * bj + 8 * fq + 4); }
                f32x4 v[2][2];
#pragma unroll
                for (int bj = 0; bj < 2; ++bj) { v[bj][0] = acc[ai][bj][m][0]; v[bj][1] = acc[ai][bj][m][1]; }
                if (!isv) {
                    float ss = 0.f;
#pragma unroll
                    for (int bj = 0; bj < 2; ++bj)
#pragma unroll
                        for (int n = 0; n < 2; ++n) ss += (v[bj][n][0] * v[bj][n][0] + v[bj][n][1] * v[bj][n][1]) + (v[bj][n][2] * v[bj][n][2] + v[bj][n][3] * v[bj][n][3]);
                    ss += __shfl_xor(ss, 16); ss += __shfl_xor(ss, 32);
                    const float rstd = rsqrtf(ss * (1.0f / 64.0f) + EPS);
#pragma unroll
                    for (int bj = 0; bj < 2; ++bj) { v[bj][0] = v[bj][0] * rstd * g0[bj]; v[bj][1] = v[bj][1] * rstd * g1[bj]; }
                    if (lat) { const int t = (u.pm * 256 + lr) & (SEQ - 1);
#pragma unroll
                        for (int bj = 0; bj < 2; ++bj) { const f32x2* tb = (const f32x2*)((const char*)tab + (unsigned)(((bj == 0 ? (t >> 6) : (t & 63)) * 16 + 4 * fq) * 8));
#pragma unroll
                            for (int n = 0; n < 2; ++n)
#pragma unroll
                                for (int e = 0; e < 2; ++e) { const f32x2 cs = tb[2 * n + e]; const float x0 = v[bj][n][2 * e], x1 = v[bj][n][2 * e + 1];
                                    v[bj][n][2 * e] = x0 * cs.x - x1 * cs.y; v[bj][n][2 * e + 1] = x0 * cs.y + x1 * cs.x; } } }
#pragma unroll
                    for (int bj = 0; bj < 2; ++bj) { v[bj][0] = v[bj][0] * post; v[bj][1] = v[bj][1] * post; }
                }
#pragma unroll
                for (int bj = 0; bj < 2; ++bj)
                    *(u32x4*)((char*)base + roff + bj * 64) = (u32x4){cvtpk(v[bj][0][0], v[bj][0][1]), cvtpk(v[bj][0][2], v[bj][0][3]), cvtpk(v[bj][1][0], v[bj][1][1]), cvtpk(v[bj][1][2], v[bj][1][3])}; }
    }
};
struct EpiResid { static constexpr bool PERM = false; const Args* a; int layer; const float* pscale; const float* srcbase;
    __device__ __forceinline__ void operator()(const AccT& acc, const pg8::Unit& u, int wr, int wc, int fr, int fq) const {
        const int r0 = u.pm * 256;
        const float* src = srcbase ? srcbase + (size_t)r0 * D : resid_row(*a, layer, r0); const float* gate = mod_row(*a, layer, r0) + 2 * D; float* out = (float*)(a->ws + WS_X) + (size_t)r0 * D;
        const int col0 = u.pn * 256 + wc * 32 + 4 * fq;
#pragma unroll
        for (int bj = 0; bj < 2; ++bj)
#pragma unroll
            for (int n = 0; n < 2; ++n) { const int cc = col0 + bj * 128 + n * 16; f32x4 g = *(const f32x4*)(gate + cc); if (pscale) g = g * *(const f32x4*)(pscale + cc);
#pragma unroll
                for (int ai = 0; ai < 2; ++ai)
#pragma unroll
                    for (int m = 0; m < 4; ++m) { const size_t off = (size_t)(ai * 128 + wr * 64 + m * 16 + fr) * D + cc;
                        *(f32x4*)(out + off) = *(const f32x4*)(src + off) + g * acc[ai][bj][m][n]; } }
    }
};
struct EpiGateUp { static constexpr bool PERM = true; bf16* act;
    __device__ __forceinline__ void operator()(const AccT& acc, const pg8::Unit& u, int wr, int wc, int fr, int fq) const {
        const __amdgpu_buffer_rsrc_t rs = __builtin_amdgcn_make_buffer_rsrc((void*)act, 0, 43008 * 512 * 2, 0x00020000);
#pragma unroll
        for (int ai = 0; ai < 2; ++ai)
#pragma unroll
            for (int m = 0; m < 4; ++m) { const int off = (int)((((size_t)u.pm * 256 + ai * 128 + wr * 64 + m * 16 + fr) * 512 + u.pn * 128 + wc * 32 + 8 * fq) * 2);
                const f32x4 g0 = acc[ai][0][m][0], g1 = acc[ai][0][m][1], u0 = acc[ai][1][m][0], u1 = acc[ai][1][m][1];
                const u32x4 ov = (u32x4){cvtpk(silu_f(g0[0]) * u0[0], silu_f(g0[1]) * u0[1]), cvtpk(silu_f(g0[2]) * u0[2], silu_f(g0[3]) * u0[3]),
                                     cvtpk(silu_f(g1[0]) * u1[0], silu_f(g1[1]) * u1[1]), cvtpk(silu_f(g1[2]) * u1[2], silu_f(g1[3]) * u1[3])};
#if MOE_FP8
                { const float sa = (float)(1 << MOE_ASH); const u32x2 o8 = (u32x2){pk_fp8x4(silu_f(g0[0]) * u0[0] * sa, silu_f(g0[1]) * u0[1] * sa, silu_f(g0[2]) * u0[2] * sa, silu_f(g0[3]) * u0[3] * sa),
                                                                                    pk_fp8x4(silu_f(g1[0]) * u1[0] * sa, silu_f(g1[1]) * u1[1] * sa, silu_f(g1[2]) * u1[2] * sa, silu_f(g1[3]) * u1[3] * sa)};
                  (void)ov; __builtin_amdgcn_raw_buffer_store_b64(o8, rs, off >> 1, 0, 16  ); } }
#else
                __builtin_amdgcn_raw_buffer_store_b128(ov, rs, off, 0, 16  ); }
#endif
    }
};
struct EpiDown { static constexpr bool PERM = true; const int* list; const float* w2; bf16* y2;
    __device__ __forceinline__ void operator()(const AccT& acc, const pg8::Unit& u, int wr, int wc, int fr, int fq) const {
#pragma unroll
        for (int ai = 0; ai < 2; ++ai)
#pragma unroll
            for (int m = 0; m < 4; ++m) { const int lr = ai * 128 + wr * 64 + m * 16 + fr;
                if (lr < u.x1) { const int dest = list[u.x0 + lr]; const float w = w2[dest]; bf16* p = y2 + (size_t)dest * D + u.pn * 256 + wc * 32 + 8 * fq;
#pragma unroll
                    for (int bj = 0; bj < 2; ++bj) { const f32x4 v0 = acc[ai][bj][m][0] * w, v1 = acc[ai][bj][m][1] * w;
                        *(u32x4*)(p + bj * 128) = (u32x4){cvtpk(v0[0], v0[1]), cvtpk(v0[2], v0[3]), cvtpk(v1[0], v1[1]), cvtpk(v1[2], v1[3])}; } } }
    }
};

constexpr int TAB_OFF = 135168;

__device__ __forceinline__ void ph_rope(const Args& a, const Ctx& c, int layer) {
    const int j = layer == 0 ? 0 : 1; const bool ctxq = layer == 0;
    const float* qg = a.in[I_QG] + j * 64; const float* kg = a.in[I_KG] + j * 64;
    const f32x2* tab = (const f32x2*)(a.ws + WS_ROPE);
    bf16* Qb = (bf16*)(a.ws + WS_Q); bf16* Kb = (bf16*)(a.ws + WS_K);
    const int nitems = TT * 20;
    for (int it = blockIdx.x * NTHREADS + c.tid; it < nitems; it += c.G * NTHREADS) {
        const int r = it / 20, hs = it % 20;
        if (hs < 16 && r >= TL && !ctxq) continue;
        bf16* p; const float* g; float post;
        if (hs < 16) { p = Qb + (size_t)r * 1024 + hs * 64; g = qg; post = 0.125f * 1.4426950408889634f; } else { p = Kb + kv_row(r) * 256 + (hs - 16) * 64; g = kg; post = 1.0f; }
        float x[64]; float ss = 0.f;
#pragma unroll
        for (int i = 0; i < 8; ++i) { const u32x4 w = ((const u32x4*)p)[i];
            x[8 * i + 0] = bflo(w.x); x[8 * i + 1] = bfhi(w.x); x[8 * i + 2] = bflo(w.y); x[8 * i + 3] = bfhi(w.y);
            x[8 * i + 4] = bflo(w.z); x[8 * i + 5] = bfhi(w.z); x[8 * i + 6] = bflo(w.w); x[8 * i + 7] = bfhi(w.w); }
#pragma unroll
        for (int i = 0; i < 64; ++i) ss += x[i] * x[i];
        const float rstd = rsqrtf(ss * (1.0f / 64.0f) + EPS);
#pragma unroll
        for (int i = 0; i < 64; ++i) x[i] = x[i] * rstd * g[i];
        if (r < TL) { const int t = r % SEQ, rp = t >> 6, cp = t & 63;
#pragma unroll
            for (int i = 0; i < 32; ++i) { const f32x2 cs = tab[(i < 16 ? rp : cp) * 16 + (i & 15)]; const float x0 = x[2 * i], x1 = x[2 * i + 1];
                x[2 * i] = x0 * cs.x - x1 * cs.y; x[2 * i + 1] = x0 * cs.y + x1 * cs.x; } }
#pragma unroll
        for (int i = 0; i < 8; ++i) ((u32x4*)p)[i] = (u32x4){cvtpk(x[8 * i] * post, x[8 * i + 1] * post), cvtpk(x[8 * i + 2] * post, x[8 * i + 3] * post),
                                                            cvtpk(x[8 * i + 4] * post, x[8 * i + 5] * post), cvtpk(x[8 * i + 6] * post, x[8 * i + 7] * post)};
    }
}

__device__ __forceinline__ void ph_att(const Args& a, const Ctx& c, int layer, char* lds_generic) {
    const int nun = 1024 + (layer == 0 ? 64 : 0);
    const attn_body::bf16* Qb = (const attn_body::bf16*)(a.ws + WS_Q); const attn_body::bf16* Kb = (const attn_body::bf16*)(a.ws + WS_K); const attn_body::bf16* Vb = (const attn_body::bf16*)(a.ws + WS_V);
    for (int U = c.vcu; U < nun; U += c.G) {
        long qrow0, kv0; int h, NT;
        if (U < 1024) { const int bh = U >> 4, qb = U & 15, b = bh >> 4; h = bh & 15; qrow0 = (long)b * SEQ + qb * 256; kv0 = (long)b * KVROWS; NT = KVROWS / 64; }
        else { const int q = U - 1024, b = q >> 4; h = q & 15; qrow0 = (long)TL + b * CTXL; kv0 = (long)b * KVROWS; NT = CTXL / 64; }
        attn_body::attn_unit<8>(qrow0, h, kv0, NT, Qb, Kb, Vb, (attn_body::bf16*)(a.ws + WS_HB), lds_generic);
    }
}

__device__ __forceinline__ void ph_m1(const Args& a, const Ctx& c, int layer) {
    const int Tm = layer == 3 ? TL : TT, ntiles = Tm / 32;
    const float* g = a.in[I_NFFN] + layer * D;
    constexpr int RP = 2064;
    LAS unsigned char* hiT = c.lds; LAS unsigned char* loT = c.lds + 32 * RP;
    LAS float* part = (LAS float*)c.lds;
    LAS int* lcnt = (LAS int*)(c.lds + 133120); LAS int* lbase = lcnt + 32;
    LAS float* logit = (LAS float*)(c.lds + 134144);
    const bf16* wr = (const bf16*)(a.ws + WS_WR) + (size_t)layer * 2 * 65536;
    unsigned* gcnt = (unsigned*)(a.ws + WS_CTL) + CW_CNT + layer * 32;
    int* list = (int*)(a.ws + WS_LIST); float* w2 = (float*)(a.ws + WS_W2);
    const int r32 = c.lane & 31, hi = c.lane >> 5;
    if (c.tid < 32) lcnt[c.tid] = 0;
    f32x4 vv[4][4];
#define M1_LOADROWS(tl) do { _Pragma("unroll") for (int i = 0; i < 4; ++i) { const f32x4* xr = (const f32x4*)((const float*)(a.ws + WS_X) + (size_t)((tl) * 32 + 4 * c.wave + i) * D) + c.lane; \
        _Pragma("unroll") for (int j = 0; j < 4; ++j) vv[i][j] = xr[64 * j]; } } while (0)
    if ((int)blockIdx.x < ntiles) M1_LOADROWS((int)blockIdx.x);
    int nmine = 0;
    for (int tile = blockIdx.x; tile < ntiles; tile += c.G, ++nmine) {
        const int r0 = tile * 32;
        { f32x4 gs[4], sh[4];
          { const float* m = mod_row(a, layer, r0);
#pragma unroll
            for (int j = 0; j < 4; ++j) { gs[j] = ((const f32x4*)g)[c.lane + 64 * j] * (((const f32x4*)(m + 4 * D))[c.lane + 64 * j] + 1.0f); sh[j] = ((const f32x4*)(m + 3 * D))[c.lane + 64 * j]; } }
#pragma unroll
          for (int i = 0; i < 4; ++i) { const int lr = 4 * c.wave + i, r = r0 + lr;
            f32x4 h[4];
            const float rstd = row_rstd(vv[i]);
#pragma unroll
            for (int j = 0; j < 4; ++j) h[j] = (vv[i][j] * rstd) * gs[j] + sh[j];
#if MOE_FP8
            unsigned* to8 = (unsigned*)((unsigned char*)(a.ws + WS_TK) + (size_t)r * D) + c.lane;
#else
            u32x2* to = (u32x2*)((bf16*)(a.ws + WS_TK) + (size_t)r * D) + c.lane;
#endif
#pragma unroll
            for (int j = 0; j < 4; ++j) { const unsigned h0 = cvtpk(h[j].x, h[j].y), h1 = cvtpk(h[j].z, h[j].w);
                const unsigned l0 = cvtpk(h[j].x - bflo(h0), h[j].y - bfhi(h0)), l1 = cvtpk(h[j].z - bflo(h1), h[j].w - bfhi(h1));
#if MOE_FP8
                to8[64 * j] = pk_fp8x4(h[j].x, h[j].y, h[j].z, h[j].w);
#else
                to[64 * j] = (u32x2){h0, h1};
#endif
                *(LAS u32x2*)(hiT + lr * RP + (4 * c.lane + 256 * j) * 2) = (u32x2){h0, h1};
                *(LAS u32x2*)(loT + lr * RP + (4 * c.lane + 256 * j) * 2) = (u32x2){l0, l1}; } } }
        __syncthreads();
        f32x16 acc0 = {}, acc1 = {};
#pragma unroll
        for (int kk = 0; kk < 8; ++kk) { const int k0 = 128 * c.wave + 16 * kk + 8 * hi;
            const bf16x8 ahi = *(const LAS bf16x8*)(hiT + r32 * RP + k0 * 2), alo = *(const LAS bf16x8*)(loT + r32 * RP + k0 * 2);
            const bf16x8 b0h = *(const bf16x8*)(wr + r32 * 1024 + k0), b1h = *(const bf16x8*)(wr + (32 + r32) * 1024 + k0);
            const bf16x8 b0l = *(const bf16x8*)(wr + 65536 + r32 * 1024 + k0), b1l = *(const bf16x8*)(wr + 65536 + (32 + r32) * 1024 + k0);
            acc0 = __builtin_amdgcn_mfma_f32_32x32x16_bf16(ahi, b0h, acc0, 0, 0, 0); acc1 = __builtin_amdgcn_mfma_f32_32x32x16_bf16(ahi, b1h, acc1, 0, 0, 0);
            acc0 = __builtin_amdgcn_mfma_f32_32x32x16_bf16(alo, b0h, acc0, 0, 0, 0); acc1 = __builtin_amdgcn_mfma_f32_32x32x16_bf16(alo, b1h, acc1, 0, 0, 0);
            acc0 = __builtin_amdgcn_mfma_f32_32x32x16_bf16(ahi, b0l, acc0, 0, 0, 0); acc1 = __builtin_amdgcn_mfma_f32_32x32x16_bf16(ahi, b1l, acc1, 0, 0, 0); }
        if (tile + c.G < ntiles) M1_LOADROWS(tile + c.G);
        __syncthreads();
#pragma unroll
        for (int reg = 0; reg < 16; ++reg) { part[((c.wave * 2 + 0) * 16 + reg) * 64 + c.lane] = acc0[reg]; part[((c.wave * 2 + 1) * 16 + reg) * 64 + c.lane] = acc1[reg]; }
        __syncthreads();
        if (nmine < 3) {
#pragma unroll
            for (int q = 0; q < 4; ++q) { const int idx = c.tid + 512 * q, nt = idx >> 10, reg = (idx >> 6) & 15, ln = idx & 63; float s = 0.f;
#pragma unroll
                for (int w = 0; w < 8; ++w) s += part[((w * 2 + nt) * 16 + reg) * 64 + ln];
                logit[(nmine * 32 + (reg & 3) + 8 * (reg >> 2) + 4 * (ln >> 5)) * 64 + nt * 32 + (ln & 31)] = s; } }
        __syncthreads();
    }
#undef M1_LOADROWS
    int e0 = 0, e1 = 0, p0 = 0, p1 = 0; float w0 = 0.f, w1 = 0.f; const int myt = c.tid >> 5; const bool act_r = c.tid < 96 && myt < nmine;
    if (act_r) { const LAS float* lg = logit + c.tid * 64;
        int grp = 0; float gm = lg[0];
#pragma unroll
        for (int q = 1; q < 4; ++q) if (lg[q] > gm) { gm = lg[q]; grp = q; }
        float den = 0.f;
#pragma unroll
        for (int q = 0; q < 4; ++q) den += expf(lg[q] - gm);
        const float gate = 1.0f / den;
        const LAS float* le = lg + 4 + grp * 8;
        int i0 = 0; float v0 = le[0];
#pragma unroll
        for (int q = 1; q < 8; ++q) if (le[q] > v0) { v0 = le[q]; i0 = q; }
        int i1 = -1; float v1 = -3.0e38f;
#pragma unroll
        for (int q = 0; q < 8; ++q) if (q != i0 && le[q] > v1) { v1 = le[q]; i1 = q; }
        const float ex = expf(v1 - v0); w0 = gate / (1.0f + ex); w1 = gate * ex / (1.0f + ex);
        e0 = grp * 8 + i0; e1 = grp * 8 + i1;
        p0 = __hip_atomic_fetch_add(lcnt + e0, 1, __ATOMIC_RELAXED, __HIP_MEMORY_SCOPE_WORKGROUP);
        p1 = __hip_atomic_fetch_add(lcnt + e1, 1, __ATOMIC_RELAXED, __HIP_MEMORY_SCOPE_WORKGROUP); }
    __syncthreads();
    if (c.tid < 32) { const int n = lcnt[c.tid]; lbase[c.tid] = n ? (int)__hip_atomic_fetch_add(gcnt + c.tid, (unsigned)n, __ATOMIC_RELAXED, __HIP_MEMORY_SCOPE_AGENT) : 0; }
    __syncthreads();
    if (act_r) { const int r = ((int)blockIdx.x + myt * c.G) * 32 + (c.tid & 31);
        list[e0 * MOE_CAP + lbase[e0] + p0] = 2 * r; w2[2 * r] = w0;
        list[e1 * MOE_CAP + lbase[e1] + p1] = 2 * r + 1; w2[2 * r + 1] = w1; }
    __syncthreads();
}
__device__ __forceinline__ void moe_tables(const Args& a, const Ctx& c, int layer, LAS int* tab) {
    unsigned* gcnt = (unsigned*)(a.ws + WS_CTL) + CW_CNT + layer * 32;
    if (c.tid < 32) tab[40 + c.tid] = (int)__hip_atomic_load(gcnt + c.tid, __ATOMIC_RELAXED, __HIP_MEMORY_SCOPE_AGENT);
    __syncthreads();
    if (c.tid == 0) { int s = 0; for (int e = 0; e < 32; ++e) { tab[e] = s; s += (tab[40 + e] + 255) >> 8; } tab[32] = s; }
    __syncthreads();
}

__device__ __forceinline__ void ph_rpool(const Args& a, const Ctx& c, int layer) {
    LAS unsigned char* hs = c.lds;
    const float* g = a.in[I_NMIX] + layer * D;
    for (int tile = blockIdx.x; tile < TT / 32; tile += c.G) {
        const int r0 = tile * 32;
        const int s0 = r0 < TL ? (r0 / SEQ) * SEQ : TL + ((r0 - TL) / CTXL) * CTXL, s1 = s0 + (r0 < TL ? SEQ : CTXL);
        for (int lr = c.wave; lr < 47; lr += NWAVES) { const int gr = r0 - 8 + lr; if (gr < s0 || gr >= s1) continue;
            f32x4 v[4], h[4]; load_row_combined(a, layer, gr, c.lane, v);
            if (lr >= 8 && lr < 40) { f32x4* xo = (f32x4*)((float*)(a.ws + WS_Z) + (size_t)gr * D) + c.lane;
#pragma unroll
                for (int j = 0; j < 4; ++j) xo[64 * j] = v[j]; }
            const float rstd = row_rstd(v); const float* m = mod_row(a, layer, gr);
            norm_mod(v, rstd, g, m, m + D, c.lane, h);
#pragma unroll
            for (int j = 0; j < 4; ++j) *(LAS u32x2*)(hs + lr * 2048 + (4 * c.lane + 256 * j) * 2) = (u32x2){cvtpk(h[j].x, h[j].y), cvtpk(h[j].z, h[j].w)}; }
        __syncthreads();
        { const int half = 1 << (c.tid >> 7);
          const LAS unsigned* col = (const LAS unsigned*)hs + c.tid;
          float sx = 0.f, sy = 0.f;
          { const int lo = (r0 - half) > s0 ? (r0 - half) : s0, hi = (r0 + half) < s1 ? (r0 + half) : s1;
            for (int gr = lo; gr < hi; ++gr) { const unsigned u = col[(gr - r0 + 8) * 512]; sx += bflo(u); sy += bfhi(u); } }
          unsigned* ho = (unsigned*)((bf16*)(a.ws + WS_HB) + (size_t)r0 * D) + c.tid;
          for (int t = 0; t < 32; ++t) { const int gr = r0 + t; const int lo = (gr - half) > s0 ? (gr - half) : s0, hi = (gr + half) < s1 ? (gr + half) : s1;
              const float inv = __builtin_amdgcn_rcpf((float)(hi - lo)); const unsigned u = col[(t + 8) * 512];
              ho[t * 512] = cvtpk(sx * inv - bflo(u), sy * inv - bfhi(u));
              if (t < 31) { if (gr + half < s1) { const unsigned w = col[(t + 8 + half) * 512]; sx += bflo(w); sy += bfhi(w); }
                            if (gr - half >= s0) { const unsigned w = col[(t + 8 - half) * 512]; sx -= bflo(w); sy -= bfhi(w); } } } }
        __syncthreads();
    }
}

struct EpiInproj { static constexpr bool PERM = true; bf16* Z; bf16* XBC; float* DT; const float* dtb;
    __device__ __forceinline__ void operator()(const AccT& acc, const pg8::Unit& u, int wr, int wc, int fr, int fq) const {
        const size_t r0 = (size_t)u.pm * 256;
        if (u.pn < 20) { bf16* base; int pitch; if (u.pn < 8) { base = Z + u.pn * 256; pitch = 2048; } else { base = XBC + (u.pn - 8) * 256; pitch = 3072; }
#pragma unroll
            for (int ai = 0; ai < 2; ++ai)
#pragma unroll
                for (int m = 0; m < 4; ++m) { bf16* rowp = base + (r0 + ai * 128 + wr * 64 + m * 16 + fr) * pitch + wc * 32 + 8 * fq;
#pragma unroll
                    for (int bj = 0; bj < 2; ++bj) { const f32x4 v0 = acc[ai][bj][m][0], v1 = acc[ai][bj][m][1];
                        *(u32x4*)(rowp + bj * 128) = (u32x4){cvtpk(v0[0], v0[1]), cvtpk(v0[2], v0[3]), cvtpk(v1[0], v1[1]), cvtpk(v1[2], v1[3])}; } }
        } else if (wc < 2) { const int col = wc * 32 + 8 * fq; const f32x4 b0 = *(const f32x4*)(dtb + col), b1 = *(const f32x4*)(dtb + col + 4);
#pragma unroll
            for (int ai = 0; ai < 2; ++ai)
#pragma unroll
                for (int m = 0; m < 4; ++m) { float* p = DT + (r0 + ai * 128 + wr * 64 + m * 16 + fr) * 64 + col; f32x4 v0 = acc[ai][0][m][0] + b0, v1 = acc[ai][0][m][1] + b1;
#pragma unroll
                    for (int e = 0; e < 4; ++e) { v0[e] = fmaxf(v0[e], 0.f) + log1pf(__expf(-fabsf(v0[e]))); v1[e] = fmaxf(v1[e], 0.f) + log1pf(__expf(-fabsf(v1[e]))); }
                    *(f32x4*)p = v0; *(f32x4*)(p + 4) = v1; } }
    }
};

__device__ __forceinline__ void ph_conv(const Args& a, const Ctx& c) {
    LAS unsigned char* tin = c.lds; LAS unsigned char* toT = c.lds + 17408; LAS unsigned char* toN = c.lds + 34816;
    const bf16* xbc = (const bf16*)(a.ws + WS_XBC);
    u32x4 pin[3];
#define CONV_PREFETCH(tk) do { const int ci_ = (tk) / 48, chb_ = (tk) % 48, r0_ = ci_ * 128, ch0_ = chb_ * 64; \
        const bool first_ = ci_ < 128 ? (ci_ % 32 == 0) : (((ci_ - 128) & 1) == 0), last_ = ci_ < 128 ? (ci_ % 32 == 31) : (((ci_ - 128) & 1) == 1); \
        _Pragma("unroll") for (int q = 0; q < 3; ++q) { const int p = c.tid + 512 * q, lr = p >> 3, pc = p & 7; const bool valid = p < 131 * 8 && !((lr < 2 && first_) || (lr == 130 && last_)); \
            pin[q] = (u32x4){0u, 0u, 0u, 0u}; if (valid) pin[q] = *(const u32x4*)(xbc + (size_t)(r0_ - 2 + lr) * 3072 + ch0_ + pc * 8); } } while (0)
    if ((int)blockIdx.x < NCH * 48) CONV_PREFETCH((int)blockIdx.x);
    for (int task = blockIdx.x; task < NCH * 48; task += c.G) {
        const int ci = task / 48, chb = task % 48, r0 = ci * 128, ch0 = chb * 64;
#pragma unroll
        for (int q = 0; q < 3; ++q) { const int p = c.tid + 512 * q; if (p < 131 * 8) *(LAS u32x4*)(tin + (p >> 3) * 128 + (p & 7) * 16) = pin[q]; }
        __syncthreads();
        if (task + c.G < NCH * 48) CONV_PREFETCH(task + c.G);
        { const int ch = c.tid & 63, tq = c.tid >> 6; const float* cw = a.in[I_CONVW] + ch0 + ch;
          const float w0 = cw[0], w1 = cw[3072], w2 = cw[2 * 3072], w3 = cw[3 * 3072], bias = a.in[I_CONVB][ch0 + ch];
          float xin[19];
#pragma unroll
          for (int i = 0; i < 19; ++i) xin[i] = bf2f(*(const LAS bf16*)(tin + (16 * tq + i) * 128 + ch * 2));
          float o[16];
#pragma unroll
          for (int i = 0; i < 16; ++i) o[i] = silu_f(bias + w0 * xin[i] + w1 * xin[i + 1] + w2 * xin[i + 2] + w3 * xin[i + 3]);
          if (chb < 40) { *(LAS u32x4*)(toT + ch * 272 + tq * 32) = (u32x4){cvtpk(o[0], o[1]), cvtpk(o[2], o[3]), cvtpk(o[4], o[5]), cvtpk(o[6], o[7])};
                          *(LAS u32x4*)(toT + ch * 272 + tq * 32 + 16) = (u32x4){cvtpk(o[8], o[9]), cvtpk(o[10], o[11]), cvtpk(o[12], o[13]), cvtpk(o[14], o[15])}; }
          if (chb >= 32) {
#pragma unroll
              for (int i = 0; i < 16; ++i) *(LAS bf16*)(toN + (16 * tq + i) * 144 + ch * 2) = (bf16)(cvtpk(o[i], 0.f) & 0xffffu); } }
        __syncthreads();
        if (chb < 40) { bf16* dst = chb < 32 ? (bf16*)(a.ws + WS_XT) + ((size_t)ci * 2048 + ch0) * 128 : (bf16*)(a.ws + WS_BT) + ((size_t)ci * 512 + (ch0 - 2048)) * 128;
#pragma unroll
            for (int q = 0; q < 2; ++q) { const int p = c.tid + 512 * q, chl = p >> 4, pc = p & 15; *(u32x4*)(dst + chl * 128 + pc * 8) = *(const LAS u32x4*)(toT + chl * 272 + pc * 16); } }
        if (chb >= 32) { bf16* dst = chb < 40 ? (bf16*)(a.ws + WS_BN) + (size_t)r0 * 512 + (ch0 - 2048) : (bf16*)(a.ws + WS_CN) + (size_t)r0 * 512 + (ch0 - 2560);
#pragma unroll
            for (int q = 0; q < 2; ++q) { const int p = c.tid + 512 * q, t = p >> 3, pc = p & 7; *(u32x4*)(dst + (size_t)t * 512 + pc * 8) = *(const LAS u32x4*)(toN + t * 144 + pc * 16); } }
        __syncthreads();
    }
#undef CONV_PREFETCH
    const int gw = c.vcu * NWAVES + c.wave, NGW = c.G * NWAVES;
    const float* dt = (const float*)(a.ws + WS_DT);
    for (int item = gw; item < NCH * 32; item += NGW) { const int ci = item >> 5, h = item & 31, r0 = ci * 128 + 2 * c.lane;
        const float af = -expf(a.in[I_ALOG][h]), ab = -expf(a.in[I_ALOG][32 + h]);
        const float dtf0 = dt[(size_t)r0 * 64 + h], dtf1 = dt[(size_t)(r0 + 1) * 64 + h], dtb0 = dt[(size_t)r0 * 64 + 32 + h], dtb1 = dt[(size_t)(r0 + 1) * 64 + 32 + h];
        const float laf0 = dtf0 * af, laf1 = dtf1 * af, lab0 = dtb0 * ab, lab1 = dtb1 * ab;
        float inf_ = laf0 + laf1, inb = lab0 + lab1; const float pf = inf_, pbk = inb;
#pragma unroll
        for (int o = 1; o < 64; o <<= 1) { const float t1 = __shfl_up(inf_, o), t2 = __shfl_up(inb, o); if (c.lane >= o) { inf_ += t1; inb += t2; } }
        const float totf = __shfl(inf_, 63), totb = __shfl(inb, 63);
        const float exf = inf_ - pf, exb = inb - pbk;
        const float cf0 = exf + laf0, cf1 = inf_, pb0 = exb, pb1 = exb + lab0;
        f32x4* sca = (f32x4*)(a.ws + WS_SCA) + (size_t)r0 * 32 + h; f32x4* scb = (f32x4*)(a.ws + WS_SCB) + (size_t)r0 * 32 + h;
        { const float L2E = 1.4426950408889634f;
          sca[0] = (f32x4){cf0 * L2E, pb0 * L2E, cf0 * L2E - __log2f(dtf0), pb0 * L2E + __log2f(dtb0)}; sca[32] = (f32x4){cf1 * L2E, pb1 * L2E, cf1 * L2E - __log2f(dtf1), pb1 * L2E + __log2f(dtb1)}; }
        scb[0] = (f32x4){__expf(cf0), __expf(totb - pb0), dtf0 * __expf(totf - cf0), dtb0 * __expf(pb0)};
        scb[32] = (f32x4){__expf(cf1), __expf(totb - pb1), dtf1 * __expf(totf - cf1), dtb1 * __expf(pb1)};
        if (c.lane == 0) ((f32x2*)(a.ws + WS_DEC))[ci * 32 + h] = (f32x2){__expf(totf), __expf(totb)}; }
}

__device__ __forceinline__ void ph_scan(const Args& a, const Ctx& c) {
    constexpr int P = 272, BUF = 53248;
    LAS unsigned char* stg = c.lds + 2 * BUF + c.wave * 2048;
    const int r32 = c.lane & 31, hi = c.lane >> 5, pt = c.wave >> 2, nt = c.wave & 3;
    for (int task = c.vcu; task < 256; task += c.G) { const int b = task >> 6, dir = (task >> 5) & 1, h = task & 31, g = h >> 3;
        f32x16 acc = {};
        u32x4 xrA[2], brA[4], xrB[2], brB[4]; f32x4 wregA = {}, wregB = {}; f32x2 decA = {}, decB = {};
#define SCAN_CI(k) (dir == 0 ? ((k) < 2 ? 128 + 2 * b + (k) : 32 * b + ((k) - 2)) : ((k) < 2 ? 128 + 2 * b + 1 - (k) : 32 * b + 31 - ((k) - 2)))
#define SCAN_LOAD(k, xr, br, wreg, dcr) do { const int ci_ = SCAN_CI(k); const bf16* xs_ = (const bf16*)(a.ws + WS_XT) + ((size_t)ci_ * 2048 + 64 * h) * 128; const bf16* bs_ = (const bf16*)(a.ws + WS_BT) + ((size_t)ci_ * 512 + 128 * g) * 128; \
        _Pragma("unroll") for (int q = 0; q < 2; ++q) xr[q] = ((const u32x4*)xs_)[c.tid + 512 * q]; _Pragma("unroll") for (int q = 0; q < 4; ++q) br[q] = ((const u32x4*)bs_)[c.tid + 512 * q]; \
        wreg = ((const f32x4*)(a.ws + WS_SCB))[((size_t)ci_ * 128 + (c.tid & 127)) * 32 + h]; dcr = ((const f32x2*)(a.ws + WS_DEC))[ci_ * 32 + h]; } while (0)
#define SCAN_WRITE(bi, xr, br, wreg) do { LAS unsigned char* xb_ = c.lds + (bi) * BUF; LAS unsigned char* bb_ = xb_ + 17408; \
        _Pragma("unroll") for (int q = 0; q < 2; ++q) { const int p = c.tid + 512 * q; *(LAS u32x4*)(xb_ + (p >> 4) * P + (p & 15) * 16) = xr[q]; } \
        _Pragma("unroll") for (int q = 0; q < 4; ++q) { const int p = c.tid + 512 * q; *(LAS u32x4*)(bb_ + (p >> 4) * P + (p & 15) * 16) = br[q]; } \
        if (c.tid < 128) ((LAS float*)(xb_ + 52224))[c.tid] = dir == 0 ? wreg.z : wreg.w; } while (0)
#define SCAN_STEP(k, cur, dcr) do { const int ci = SCAN_CI(k); \
            { bf16* hin = (bf16*)(a.ws + WS_HIN) + (((size_t)ci * 2 + dir) * 32 + h) * 8192; \
              _Pragma("unroll") for (int r = 0; r < 16; ++r) *(LAS bf16*)(stg + ((r & 3) + 8 * (r >> 2) + 4 * hi) * 64 + r32 * 2) = (bf16)(cvtpk(acc[r], 0.f) & 0xffffu); \
              LDS_WAIT(); \
              _Pragma("unroll") for (int i = 0; i < 2; ++i) { const int row = (c.lane >> 2) + 16 * i, pc = c.lane & 3; *(u32x4*)(hin + (size_t)(32 * pt + row) * 128 + 32 * nt + pc * 8) = *(const LAS u32x4*)(stg + row * 64 + pc * 16); } } \
            const float dec = dir == 0 ? dcr.x : dcr.y; \
            _Pragma("unroll") for (int r = 0; r < 16; ++r) acc[r] *= dec; \
            { LAS unsigned char* xb = c.lds + (cur) * BUF; LAS unsigned char* bb = xb + 17408; const LAS float* wv = (const LAS float*)(xb + 52224); \
              _Pragma("unroll") for (int kk = 0; kk < 8; ++kk) { const int s8 = 16 * kk + 8 * hi; \
                  const u32x4 xa = *(const LAS u32x4*)(xb + (32 * pt + r32) * P + s8 * 2); const f32x4 wa = *(const LAS f32x4*)(wv + s8), wb = *(const LAS f32x4*)(wv + s8 + 4); \
                  const u32x4 xs = (u32x4){cvtpk(bflo(xa.x) * wa.x, bfhi(xa.x) * wa.y), cvtpk(bflo(xa.y) * wa.z, bfhi(xa.y) * wa.w), cvtpk(bflo(xa.z) * wb.x, bfhi(xa.z) * wb.y), cvtpk(bflo(xa.w) * wb.z, bfhi(xa.w) * wb.w)}; \
                  const bf16x8 bfrag = *(const LAS bf16x8*)(bb + (32 * nt + r32) * P + s8 * 2); \
                  acc = __builtin_amdgcn_mfma_f32_32x32x16_bf16(__builtin_bit_cast(bf16x8, xs), bfrag, acc, 0, 0, 0); } } } while (0)
        f32x2 dcur0, dcur1;
        SCAN_LOAD(0, xrA, brA, wregA, decA); SCAN_LOAD(1, xrB, brB, wregB, decB); SCAN_WRITE(0, xrA, brA, wregA); dcur0 = decA;
        __syncthreads();
        for (int k = 0; k < 34; k += 2) {
            if (k + 2 < 34) SCAN_LOAD(k + 2, xrA, brA, wregA, decA);
            SCAN_STEP(k, 0, dcur0);
            SCAN_WRITE(1, xrB, brB, wregB); dcur1 = decB;
            __syncthreads();
            if (k + 3 < 34) SCAN_LOAD(k + 3, xrB, brB, wregB, decB);
            SCAN_STEP(k + 1, 1, dcur1);
            if (k + 2 < 34) { SCAN_WRITE(0, xrA, brA, wregA); dcur0 = decA; }
            __syncthreads();
        }
#undef SCAN_CI
#undef SCAN_LOAD
#undef SCAN_WRITE
#undef SCAN_STEP
    }
}

__device__ __forceinline__ int crow16(int r, int hi) { return (r & 3) + 8 * (r >> 2) + 4 * hi; }
__device__ __forceinline__ void ph_yph(const Args& a, const Ctx& c) {
    constexpr int P = 272, ZP = 144;
    LAS unsigned char* Cs = c.lds; LAS unsigned char* Bs = c.lds + 34816; LAS unsigned char* xs = c.lds + 69632; LAS unsigned char* hf = c.lds + 87040; LAS unsigned char* hb = c.lds + 104448;
    LAS unsigned char* zs = c.lds + 121856; LAS unsigned char* os = c.lds + 140288; LAS f32x4* sca = (LAS f32x4*)(c.lds + 158720); LAS f32x2* scb = (LAS f32x2*)(c.lds + 160768);
    LAS float* sbv = (LAS float*)(c.lds + 161792); LAS float* scv = (LAS float*)(c.lds + 162304); LAS float* ssql = (LAS float*)(c.lds + 34816);
    const int lb = c.wave & 3, pb = c.wave >> 2;
    SECT_DECL
    for (int task = c.vcu; task < NCH * 4; task += c.G) { const int ci = task >> 2, g = task & 3, r0 = ci * 128;
        int tid_t = c.tid; asm volatile("" : "+v"(tid_t));
        f32x16 X[4]; int l0;
        u32x4 pxt[2], phf[2], phb[2], pz[2]; f32x4 ps1 = {}; f32x4 ps4 = {};
#define YPH_PREFETCH(hq) do { const int h_ = 8 * g + (hq); const u32x4* xt_ = (const u32x4*)((const bf16*)(a.ws + WS_XT) + ((size_t)ci * 2048 + 64 * h_) * 128); \
            const u32x4* hfg_ = (const u32x4*)((const bf16*)(a.ws + WS_HIN) + (((size_t)ci * 2 + 0) * 32 + h_) * 8192); const u32x4* hbg_ = (const u32x4*)((const bf16*)(a.ws + WS_HIN) + (((size_t)ci * 2 + 1) * 32 + h_) * 8192); \
            const bf16* zg_ = (const bf16*)(a.ws + WS_Z) + (size_t)r0 * 2048 + 64 * h_; \
            _Pragma("unroll") for (int q = 0; q < 2; ++q) { const int p = tidp + 512 * q; pxt[q] = xt_[p]; phf[q] = hfg_[p]; phb[q] = hbg_[p]; pz[q] = *(const u32x4*)(zg_ + (size_t)(p >> 3) * 2048 + (p & 7) * 8); } \
            ps1 = ((const f32x4*)(a.ws + WS_SCA))[((size_t)r0 + (tidp & 127)) * 32 + h_]; ps4 = ((const f32x4*)(a.ws + WS_SCB))[((size_t)r0 + (tidp & 127)) * 32 + h_]; } while (0)
        { const int tid = tid_t, lane = tid & 63, r32 = lane & 31, hi = lane >> 5; l0 = 32 * lb + r32;
          { const bf16* cn = (const bf16*)(a.ws + WS_CN) + (size_t)r0 * 512 + 128 * g; const bf16* bn = (const bf16*)(a.ws + WS_BN) + (size_t)r0 * 512 + 128 * g;
#pragma unroll
            for (int q = 0; q < 4; ++q) { const int p = tid + 512 * q, row = p >> 4, pc = p & 15;
                *(LAS u32x4*)(Cs + row * P + pc * 16) = *(const u32x4*)(cn + (size_t)row * 512 + pc * 8); *(LAS u32x4*)(Bs + row * P + pc * 16) = *(const u32x4*)(bn + (size_t)row * 512 + pc * 8); } }
          { const int tidp = tid; YPH_PREFETCH(0); }
          __syncthreads();
#pragma unroll
          for (int sb = 0; sb < 4; ++sb) { X[sb] = (f32x16){};
#pragma unroll
              for (int kk = 0; kk < 8; ++kk) { const int k8 = (16 * kk + 8 * hi) * 2;
                  X[sb] = __builtin_amdgcn_mfma_f32_32x32x16_bf16(*(const LAS bf16x8*)(Bs + (32 * sb + r32) * P + k8), *(const LAS bf16x8*)(Cs + (32 * lb + r32) * P + k8), X[sb], 0, 0, 0); } }
        }
        SECT(0);
        float ssq = 0.f;
#pragma unroll 1
        for (int hh = 0; hh < 8; ++hh) { const int h = 8 * g + hh;
            int tid = c.tid; asm volatile("" : "+v"(tid)); const int lane = tid & 63, r32 = lane & 31, hi = lane >> 5, l = 32 * lb + r32; (void)lane;
            const float dsum = a.in[I_DSK][h] + a.in[I_DSK][32 + h];
            __syncthreads();
            SECT(1);
            if (hh > 0) { bf16* gg = (bf16*)(a.ws + WS_G) + (size_t)r0 * 2048 + 64 * (h - 1);
#pragma unroll
                for (int q = 0; q < 2; ++q) { const int p = tid + 512 * q, zr = p >> 3, zc = p & 7; *(u32x4*)(gg + (size_t)zr * 2048 + zc * 8) = *(const LAS u32x4*)(os + zr * ZP + zc * 16); } }
#pragma unroll
            for (int q = 0; q < 2; ++q) { const int p = tid + 512 * q, row = p >> 4, pc = p & 15;
                *(LAS u32x4*)(xs + row * P + pc * 16) = pxt[q]; *(LAS u32x4*)(hf + row * P + pc * 16) = phf[q]; *(LAS u32x4*)(hb + row * P + pc * 16) = phb[q];
                *(LAS u32x4*)(zs + (p >> 3) * ZP + (p & 7) * 16) = pz[q]; }
            if (tid < 128) { sca[tid] = ps1; scb[tid] = (f32x2){ps4.x, ps4.y}; sbv[tid] = ps1.z; scv[tid] = ps1.w; }
            __syncthreads();
            SECT(2);
            if (hh < 7) { const int tidp = tid; YPH_PREFETCH(hh + 1); }
            SECT(3);
            const f32x4 me = sca[l]; const f32x2 ee = scb[l];
            const float dtb_l = __builtin_amdgcn_exp2f(me.w - me.y);
            f32x16 accd = {};
#pragma unroll
            for (int sb = 0; sb < 4; ++sb) { unsigned mp[8];
#pragma unroll
                for (int q = 0; q < 4; ++q) { const int s0 = 32 * sb + 8 * q + 4 * hi; float mv[4];
                    if (sb < lb) { const f32x4 bs4 = *(const LAS f32x4*)(sbv + s0);
#pragma unroll
                        for (int e = 0; e < 4; ++e) mv[e] = X[sb][4 * q + e] * __builtin_amdgcn_exp2f(me.x - bs4[e]); }
                    else if (sb > lb) { const f32x4 cs4 = *(const LAS f32x4*)(scv + s0);
#pragma unroll
                        for (int e = 0; e < 4; ++e) mv[e] = X[sb][4 * q + e] * __builtin_amdgcn_exp2f(cs4[e] - me.y); }
                    else { const f32x4 bs4 = *(const LAS f32x4*)(sbv + s0), cs4 = *(const LAS f32x4*)(scv + s0);
#pragma unroll
                        for (int e = 0; e < 4; ++e) { const int s = s0 + e; const float t = (s <= l) ? (me.x - bs4[e]) : (cs4[e] - me.y); const float xv = X[sb][4 * q + e];
                            float m = xv * __builtin_amdgcn_exp2f(t); if (s == l) m += xv * dtb_l + dsum; mv[e] = m; } }
                    mp[2 * q] = cvtpk(mv[0], mv[1]); mp[2 * q + 1] = cvtpk(mv[2], mv[3]); }
#pragma unroll
                for (int t = 0; t < 2; ++t) { const int sof = (32 * sb + 16 * t + 4 * hi) * 2;
                    const u32x2 lo = *(const LAS u32x2*)(xs + (32 * pb + r32) * P + sof), h2 = *(const LAS u32x2*)(xs + (32 * pb + r32) * P + sof + 16);
                    const u32x4 af = (u32x4){lo.x, lo.y, h2.x, h2.y}, bfm = (u32x4){mp[4 * t], mp[4 * t + 1], mp[4 * t + 2], mp[4 * t + 3]};
                    accd = __builtin_amdgcn_mfma_f32_32x32x16_bf16(__builtin_bit_cast(bf16x8, af), __builtin_bit_cast(bf16x8, bfm), accd, 0, 0, 0); }
                }
            SECT(4);
#pragma unroll
            for (int dd = 0; dd < 2; ++dd) { f32x16 acco = {}; LAS unsigned char* hx = dd == 0 ? hf : hb;
#pragma unroll
                for (int kk = 0; kk < 8; ++kk) { const int k8 = (16 * kk + 8 * hi) * 2;
                    acco = __builtin_amdgcn_mfma_f32_32x32x16_bf16(*(const LAS bf16x8*)(hx + (32 * pb + r32) * P + k8), *(const LAS bf16x8*)(Cs + (32 * lb + r32) * P + k8), acco, 0, 0, 0); }
                const float ex = dd == 0 ? ee.x : ee.y;
#pragma unroll
                for (int r = 0; r < 16; ++r) accd[r] += ex * acco[r]; }
            SECT(5);
#pragma unroll
            for (int q = 0; q < 4; ++q) { const int pcol = 32 * pb + 8 * q + 4 * hi; const u32x2 zq = *(const LAS u32x2*)(zs + l * ZP + pcol * 2);
                float gv[4];
#pragma unroll
                for (int e = 0; e < 4; ++e) { const int r = 4 * q + e; const float y = accd[r];
                    const float z = (e == 0) ? bflo(zq.x) : (e == 1) ? bfhi(zq.x) : (e == 2) ? bflo(zq.y) : bfhi(zq.y); gv[e] = y * silu_f(z); ssq += gv[e] * gv[e]; }
                *(LAS u32x2*)(os + l * ZP + pcol * 2) = (u32x2){cvtpk(gv[0], gv[1]), cvtpk(gv[2], gv[3])}; }
            SECT(6);
        }
#undef YPH_PREFETCH
        __syncthreads();
        { bf16* gg = (bf16*)(a.ws + WS_G) + (size_t)r0 * 2048 + 64 * (8 * g + 7);
#pragma unroll
          for (int q = 0; q < 2; ++q) { const int p = c.tid + 512 * q, zr = p >> 3, zc = p & 7; *(u32x4*)(gg + (size_t)zr * 2048 + zc * 8) = *(const LAS u32x4*)(os + zr * ZP + zc * 16); } }
        ssq += __shfl_xor(ssq, 32);
        if ((c.lane >> 5) == 0) ssql[pb * 128 + l0] = ssq;
        __syncthreads();
        if (c.tid < 128) ssql[256 + c.tid] = rsqrtf((ssql[c.tid] + ssql[128 + c.tid]) * (1.0f / 512.0f) + EPS);
        VM_WAIT();
        __syncthreads();
        { bf16* gt = (bf16*)(a.ws + WS_G) + (size_t)r0 * 2048 + 512 * g; const float* ng = a.in[I_SNORM] + 512 * g;
          const f32x4 g0 = *(const f32x4*)(ng + (c.tid & 63) * 8), g1 = *(const f32x4*)(ng + (c.tid & 63) * 8 + 4);
#pragma unroll 1
          for (int qb = 0; qb < 2; ++qb) { u32x4 gv8[8]; int tidq = c.tid + 4096 * qb; asm volatile("" : "+v"(tidq));
#pragma unroll
            for (int q = 0; q < 8; ++q) { const int p = tidq + 512 * q; gv8[q] = *(const u32x4*)(gt + (size_t)(p >> 6) * 2048 + (p & 63) * 8); }
#pragma unroll
            for (int q = 0; q < 8; ++q) { const int p = tidq + 512 * q, row = p >> 6, col = (p & 63) * 8; const u32x4 v = gv8[q]; const float sr = ssql[256 + row];
              *(u32x4*)(gt + (size_t)row * 2048 + col) = (u32x4){cvtpk(bflo(v.x) * sr * g0.x, bfhi(v.x) * sr * g0.y), cvtpk(bflo(v.y) * sr * g0.z, bfhi(v.y) * sr * g0.w), cvtpk(bflo(v.z) * sr * g1.x, bfhi(v.z) * sr * g1.y), cvtpk(bflo(v.w) * sr * g1.z, bfhi(v.w) * sr * g1.w)}; } } }
        __syncthreads();
        SECT(7);
    }
    SECT_END(40);
}
__device__ __forceinline__ void ph_gfix(const Args& a, const Ctx& c) {
    const float* ng = a.in[I_SNORM]; const float* rs = (const float*)(a.ws + WS_RSTD);
    const int n16 = TT * 256;
    for (int p = blockIdx.x * NTHREADS + c.tid; p < n16; p += c.G * NTHREADS) { const int r = p >> 8, col = (p & 255) * 8;
        u32x4* gp = (u32x4*)((bf16*)(a.ws + WS_G) + (size_t)r * 2048 + col); const u32x4 v = *gp; const float s = rs[r * 4 + (col >> 9)];
        const f32x4 g0 = *(const f32x4*)(ng + col), g1 = *(const f32x4*)(ng + col + 4);
        *gp = (u32x4){cvtpk(bflo(v.x) * s * g0.x, bfhi(v.x) * s * g0.y), cvtpk(bflo(v.y) * s * g0.z, bfhi(v.y) * s * g0.w), cvtpk(bflo(v.z) * s * g1.x, bfhi(v.z) * s * g1.y), cvtpk(bflo(v.w) * s * g1.z, bfhi(v.w) * s * g1.w)}; }
}

#if DEBUG_CHECKS
__device__ __forceinline__ float dbg_hb(const Args& a, int layer, size_t idx, float sh) {
    if (ATT_FP8 && layer != 2) return __builtin_amdgcn_cvt_f32_fp8((unsigned)((const unsigned char*)(a.ws + WS_HB))[idx], 0) * sh;
    return bf2f(((const bf16*)(a.ws + WS_HB))[idx]); }
__device__ __forceinline__ int dbg_sample_row(int b) { const int SR[16] = {0, 1, 77, 4095, 4096, 5000, 8191, 9000, 12288, 16383, 16384, 16385, 16384 + 255, 16384 + 256, 17000, 17407}; int r = 0;
#pragma unroll
    for (int i = 0; i < 16; ++i) r = (b == i) ? SR[i] : r;
    return r; }
__device__ __forceinline__ float blk_sum(float v, LAS float* red, int tid) {
    v = wave_sum(v); __syncthreads(); if ((tid & 63) == 0) red[tid >> 6] = v; __syncthreads(); float s = 0.f;
#pragma unroll
    for (int i = 0; i < 8; ++i) s += red[i];
    __syncthreads(); return s; }
__device__ __forceinline__ float blk_max(float v, LAS float* red, int tid) {
#pragma unroll
    for (int o = 1; o < 64; o <<= 1) v = fmaxf(v, __shfl_xor(v, o));
    __syncthreads(); if ((tid & 63) == 0) red[tid >> 6] = v; __syncthreads(); float s = red[0];
#pragma unroll
    for (int i = 1; i < 8; ++i) s = fmaxf(s, red[i]);
    __syncthreads(); return s; }
__device__ __forceinline__ void dbg_report(const Args& a, int id, float err, float ssref, float n, int tid) {
    if (tid == 0) { float rel = err / (sqrtf(ssref / n) + 1e-20f); if (!(rel == rel)) rel = 1e30f; atomicMax((unsigned*)(a.ws + WS_CTL) + CW_DBG + id, __float_as_uint(rel)); } }
__device__ __forceinline__ float dbg_mod(const Args& a, int layer, int r, int j) {
    const float* cv = r < TL ? a.in[I_C] + (r / SEQ) * 1024 : a.in[I_CCTX]; float s = 0.f;
    _Pragma("nounroll") for (int k = 0; k < 1024; ++k) { const float x = cv[k]; s += (x / (1.0f + expf(-x))) * a.in[I_WADA][((size_t)layer * 1024 + k) * 6144 + j]; }
    return s + a.in[I_BADA][layer * 6144 + j]; }

__device__ __forceinline__ void chk_rmix(const Args& a, int layer, int id, LAS unsigned char* ldsb) {
    if (blockIdx.x >= 16) return; const int tid = tid_opaque(), r = dbg_sample_row(blockIdx.x);
    LAS float* red = (LAS float*)ldsb;
    const float* x = resid_row(a, layer, r); const bf16* hb = (const bf16*)(a.ws + WS_HB) + (size_t)r * D;
    float ss = 0.f; for (int cc = tid; cc < D; cc += 512) ss += x[cc] * x[cc];
    ss = blk_sum(ss, red, tid); const float rstd = rsqrtf(ss / D + EPS);
    float err = 0.f, sr = 0.f;
    for (int cc = tid; cc < D; cc += 512) { const float sh = dbg_mod(a, layer, r, cc), sc = dbg_mod(a, layer, r, D + cc);
        const float ref = x[cc] * rstd * a.in[I_NMIX][layer * D + cc] * (1.f + sc) + sh; err = fmaxf(err, fabsf(ref - dbg_hb(a, layer, (size_t)r * D + cc, 1.f))); sr += ref * ref; }
    err = blk_max(err, red, tid); sr = blk_sum(sr, red, tid); dbg_report(a, id, err, sr, D, tid);
}
__device__ __forceinline__ void chk_qkv(const Args& a, int layer, int id, LAS unsigned char* ldsb) {
    if (blockIdx.x >= 16) return; const int tid = tid_opaque(), r = dbg_sample_row(blockIdx.x), j = layer ? 1 : 0;
    LAS float* red = (LAS float*)ldsb; LAS float* y = red + 16; LAS float* hrow = y + 1536;
    const bf16* hb = (const bf16*)(a.ws + WS_HB) + (size_t)r * D;
    _Pragma("nounroll") for (int k = tid; k < D; k += 512) hrow[k] = dbg_hb(a, layer, (size_t)r * D + k, 1.f);
    __syncthreads();
    for (int n = tid; n < 1536; n += 512) { float s = 0.f; const float* w = a.in[I_WQKV] + (size_t)j * 1024 * 1536 + n; _Pragma("nounroll") for (int k = 0; k < 1024; ++k) s += hrow[k] * w[(size_t)k * 1536]; y[n] = s; }
    __syncthreads();
    float err = 0.f, sr = 0.f;
    for (int n = tid; n < 1536; n += 512) { float ref;
        if (n < 1280) { const int h0 = n & ~63; float ss = 0.f; _Pragma("nounroll") for (int q = 0; q < 64; ++q) ss += y[h0 + q] * y[h0 + q];
            const float rstd = rsqrtf(ss / 64.f + EPS); const float* g = (n < 1024 ? a.in[I_QG] : a.in[I_KG]) + j * 64;
            float v = y[n] * rstd * g[n & 63], vp = y[n ^ 1] * rstd * g[(n ^ 1) & 63];
            if (r < TL) { const int t = r % SEQ, i = (n & 63) >> 1, f = i & 15, pos = i < 16 ? t / 64 : t % 64; const float inv = powf(10000.f, -(float)f / 16.f), ang = (float)pos * inv, cs = cosf(ang), sn = sinf(ang);
                v = (n & 1) ? (vp * sn + v * cs) : (v * cs - vp * sn); }
            if (n < 1024) v *= 0.125f * 1.4426950408889634f;
            ref = v; } else ref = y[n];
        float got;
        if (n < 1024) { if (layer == 3 && r >= TL) continue; got = bf2f(((const bf16*)(a.ws + WS_Q))[(size_t)r * 1024 + n]); }
        else if (n < 1280) got = bf2f(((const bf16*)(a.ws + WS_K))[kv_row(r) * 256 + (n - 1024)]);
        else got = bf2f(((const bf16*)(a.ws + WS_V))[kv_row(r) * 256 + (n - 1280)]);
        err = fmaxf(err, fabsf(ref - got)); sr += ref * ref; }
    err = blk_max(err, red, tid); sr = blk_sum(sr, red, tid); dbg_report(a, id, err, sr, 1536, tid);
}
__device__ __forceinline__ void chk_att(const Args& a, int layer, int id, LAS unsigned char* ldsb) {
    if (blockIdx.x >= 16) return; const int tid = tid_opaque(), r = dbg_sample_row(blockIdx.x);
    if (layer == 3 && r >= TL) return;
    LAS float* red = (LAS float*)ldsb; LAS float* sc = red + 16; LAS float* po = sc + 4352;
    const int nk = r < TL ? KVROWS : CTXL; const long kv0 = (long)(r < TL ? r / SEQ : (r - TL) / CTXL) * KVROWS;
    const bf16* Qb = (const bf16*)(a.ws + WS_Q); const bf16* Kb = (const bf16*)(a.ws + WS_K); const bf16* Vb = (const bf16*)(a.ws + WS_V); const bf16* Ob = (const bf16*)(a.ws + WS_HB);
    float err = 0.f, sr = 0.f;
    for (int h = 0; h < 16; ++h) {
        float mx = -3e38f;
        _Pragma("nounroll") for (int jk = tid; jk < nk; jk += 512) { float s = 0.f; _Pragma("nounroll") for (int d = 0; d < 64; ++d) s += bf2f(Qb[(size_t)r * 1024 + h * 64 + d]) * bf2f(Kb[(kv0 + jk) * 256 + (h >> 2) * 64 + d]); sc[jk] = s; mx = fmaxf(mx, s); }
        mx = blk_max(mx, red, tid);
        float l = 0.f; _Pragma("nounroll") for (int jk = tid; jk < nk; jk += 512) { const float p = exp2f(sc[jk] - mx); sc[jk] = p; l += p; }
        l = blk_sum(l, red, tid);
        { const int d = tid & 63, part = tid >> 6; float o = 0.f; _Pragma("nounroll") for (int jk = part; jk < nk; jk += 8) o += sc[jk] * bf2f(Vb[(kv0 + jk) * 256 + (h >> 2) * 64 + d]); po[part * 64 + d] = o; }
        __syncthreads();
        if (tid < 64) { float o = 0.f; _Pragma("nounroll") for (int p = 0; p < 8; ++p) o += po[p * 64 + tid]; o /= l; err = fmaxf(err, fabsf(o - dbg_hb(a, layer, (size_t)r * 1024 + h * 64 + tid, 1.f / (float)(1 << ATT_OSH)))); sr += o * o; }
        __syncthreads();
    }
    err = blk_max(err, red, tid); sr = blk_sum(sr, red, tid); dbg_report(a, id, err, sr, 1024, tid);
}
__device__ __forceinline__ void chk_oproj(const Args& a, int layer, int id, LAS unsigned char* ldsb) {
    if (blockIdx.x >= 16 || layer != 0) return; const int tid = tid_opaque(), r = dbg_sample_row(blockIdx.x), j = 0;
    LAS float* red = (LAS float*)ldsb; LAS float* orow = red + 16;
    const bf16* Ob = (const bf16*)(a.ws + WS_HB) + (size_t)r * D;
    _Pragma("nounroll") for (int k = tid; k < D; k += 512) orow[k] = dbg_hb(a, layer, (size_t)r * D + k, 1.f / (float)(1 << ATT_OSH));
    __syncthreads();
    float err = 0.f, sr = 0.f;
    for (int n = tid; n < D; n += 512) { float s = 0.f; const float* w = a.in[I_WO] + (size_t)j * 1024 * 1024 + n; _Pragma("nounroll") for (int k = 0; k < 1024; ++k) s += orow[k] * w[(size_t)k * 1024];
        const float dl = dbg_mod(a, layer, r, 2 * D + n) * s, ref = resid_row(a, 0, r)[n] + dl; err = fmaxf(err, fabsf(ref - ((const float*)(a.ws + WS_X))[(size_t)r * D + n])); sr += dl * dl; }
    err = blk_max(err, red, tid); sr = blk_sum(sr, red, tid); dbg_report(a, id, err, sr, D, tid);
}
__device__ __forceinline__ void chk_moe(const Args& a, int layer, int id_tok, int id_y, LAS unsigned char* ldsb) {
    if (blockIdx.x >= 16) return; const int tid = tid_opaque(), r = dbg_sample_row(blockIdx.x);
    if (layer == 3 && r >= TL) return;
    LAS float* red = (LAS float*)ldsb; LAS float* tok = red + 16; LAS float* lg = tok + 1024; LAS float* tkb = lg + 64; LAS float* act = tkb + 1024; LAS float* rt = act + 1024;
    const float* x = (const float*)(a.ws + WS_X) + (size_t)r * D; const bf16* tk = (const bf16*)(a.ws + WS_TK) + (size_t)r * D;
    float ss = 0.f; for (int cc = tid; cc < D; cc += 512) ss += x[cc] * x[cc];
    ss = blk_sum(ss, red, tid); const float rstd = rsqrtf(ss / D + EPS);
    float err = 0.f, sr = 0.f;
    for (int cc = tid; cc < D; cc += 512) { const float sh = dbg_mod(a, layer, r, 3 * D + cc), sc = dbg_mod(a, layer, r, 4 * D + cc);
        const float ref = x[cc] * rstd * a.in[I_NFFN][layer * D + cc] * (1.f + sc) + sh; tok[cc] = ref;
#if MOE_FP8
        tkb[cc] = __builtin_amdgcn_cvt_f32_fp8((unsigned)((const unsigned char*)(a.ws + WS_TK))[(size_t)r * D + cc], 0);
#else
        tkb[cc] = bf2f(tk[cc]);
#endif
        err = fmaxf(err, fabsf(ref - tkb[cc])); sr += ref * ref; }
    err = blk_max(err, red, tid); sr = blk_sum(sr, red, tid);
    if (tid < 36) { float s = 0.f; _Pragma("nounroll") for (int k = 0; k < 1024; ++k) s += tok[k] * (tid < 4 ? a.in[I_WRG][((size_t)layer * 1024 + k) * 4 + tid] : a.in[I_WRE][((size_t)layer * 1024 + k) * 32 + tid - 4]); lg[tid] = s; }
    __syncthreads();
    if (tid == 0) { int grp = 0; _Pragma("nounroll") for (int q = 1; q < 4; ++q) if (lg[q] > lg[grp]) grp = q; float den = 0.f; _Pragma("nounroll") for (int q = 0; q < 4; ++q) den += expf(lg[q] - lg[grp]);
        const LAS float* le = lg + 4 + grp * 8; int i0 = 0; _Pragma("nounroll") for (int q = 1; q < 8; ++q) if (le[q] > le[i0]) i0 = q; int i1 = -1; _Pragma("nounroll") for (int q = 0; q < 8; ++q) if (q != i0 && (i1 < 0 || le[q] > le[i1])) i1 = q;
        const float ex = expf(le[i1] - le[i0]), w0 = 1.f / den / (1.f + ex), w1 = 1.f / den * ex / (1.f + ex);
        rt[0] = (float)(grp * 8 + i0); rt[1] = (float)(grp * 8 + i1); rt[2] = w0; rt[3] = w1;
        const float* w2 = (const float*)(a.ws + WS_W2); float e2 = fmaxf(fabsf(w2[2 * r] - w0), fabsf(w2[2 * r + 1] - w1)) * 30.f;
        const int* list = (const int*)(a.ws + WS_LIST); const unsigned* gc = (const unsigned*)(a.ws + WS_CTL) + CW_CNT + layer * 32;
        _Pragma("nounroll") for (int k = 0; k < 2; ++k) { const int e = (int)rt[k]; bool found = false; const int n = (int)gc[e]; _Pragma("nounroll") for (int q = 0; q < n && q < MOE_CAP; ++q) if (list[e * MOE_CAP + q] == 2 * r + k) found = true; if (!found) e2 = 1e6f; }
        rt[4] = e2; }
    __syncthreads();
    err = fmaxf(err, rt[4] * sqrtf(sr / D));
    dbg_report(a, id_tok, err, sr, D, tid);
    float err2 = 0.f, sr2 = 0.f;
    _Pragma("nounroll") for (int k = 0; k < 2; ++k) { const int e = (int)rt[k]; const float wk = rt[2 + k];
        const float* wgu = a.in[I_WGU] + ((size_t)layer * 32 + e) * 1024 * 1024; const float* wdn = a.in[I_WDN] + ((size_t)layer * 32 + e) * 512 * 1024;
        { float sg = 0.f, su = 0.f; _Pragma("nounroll") for (int q = 0; q < 1024; ++q) { sg += tkb[q] * wgu[(size_t)q * 1024 + tid]; su += tkb[q] * wgu[(size_t)q * 1024 + 512 + tid]; } act[tid] = (sg / (1.f + expf(-sg))) * su; }
        __syncthreads();
        for (int n = tid; n < D; n += 512) { float s = 0.f; _Pragma("nounroll") for (int q = 0; q < 512; ++q) s += act[q] * wdn[(size_t)q * 1024 + n]; s *= wk;
            err2 = fmaxf(err2, fabsf(s - bf2f(((const bf16*)(a.ws + WS_Y2))[(size_t)(2 * r + k) * D + n]))); sr2 += s * s; }
        __syncthreads(); }
    err2 = blk_max(err2, red, tid); sr2 = blk_sum(sr2, red, tid); dbg_report(a, id_y, err2, sr2, 2 * D, tid);
}

__global__ void __launch_bounds__(NTHREADS) dbg_kernel(Args a, int ty, int layer, int id) {
    extern __shared__ __attribute__((aligned(16))) unsigned char lds_dbg[];
    LAS unsigned char* l = (LAS unsigned char*)lds_dbg;
    if (ty == 1) chk_rmix(a, layer, id, l); else if (ty == 2) chk_qkv(a, layer, id, l); else if (ty == 3) chk_att(a, layer, id, l);
    else if (ty == 4) chk_oproj(a, layer, id, l); else if (ty == 5) chk_moe(a, layer, id, id + 1, l);
}
#endif

template <int KIND, int LAYER> __device__ __forceinline__ void run_phase(const Args& a0, Ctx& c, unsigned char* lds_gen) {
    Args a = a0; { unsigned long long wsv = (unsigned long long)a0.ws; asm volatile("" : "+s"(wsv)); a.ws = (unsigned char*)(GAS unsigned char*)wsv; }
    { unsigned lb = (unsigned)(uintptr_t)(LAS unsigned char*)lds_gen; asm volatile("" : "+s"(lb)); c.lds = (LAS unsigned char*)(uintptr_t)lb; }
    c.tid = tid_opaque(); c.lane = c.tid & 63;
    unsigned char* const ws = a.ws; constexpr int layer = LAYER;
    if constexpr (KIND == K_P0) p0_prologue(a, c);
    else if constexpr (KIND == K_RMIX) ph_rmix(a, c, layer);
    else if constexpr (KIND == K_QKV) { constexpr int j = layer ? 1 : 0;
#if ATT_FP8
        SchedQKV S{(const char*)(ws + WS_HB), (const char*)(ws + WS_WQKV) + (size_t)j * 1536 * 1024, (size_t)256 * 1024, layer == 0 ? 1 : 0, c.G, (int)blockIdx.x};
        EpiQKV E{(bf16*)(ws + WS_Q), (bf16*)(ws + WS_K), (bf16*)(ws + WS_V), a.in[I_QG] + j * 64, a.in[I_KG] + j * 64, (const f32x2*)(ws + WS_ROPE)};
        pg8::gemm_phase<EpiQKV, SchedQKV, false, true>(c.lds, 1024, 1024, S, E, 127 - MOE_WSH, 127); }
#else
        SchedQKV S{(const char*)(ws + WS_HB), (const char*)(ws + WS_WQKV) + (size_t)j * 1536 * 1024 * 2, (size_t)256 * 1024 * 2, layer == 0 ? 1 : 0, c.G, (int)blockIdx.x};
        EpiQKV E{(bf16*)(ws + WS_Q), (bf16*)(ws + WS_K), (bf16*)(ws + WS_V), a.in[I_QG] + j * 64, a.in[I_KG] + j * 64, (const f32x2*)(ws + WS_ROPE)};
        pg8::gemm_phase<EpiQKV, SchedQKV, false>(c.lds, 2048, 2048, S, E); }
#endif
    else if constexpr (KIND == K_ROPE) ph_rope(a, c, layer);
    else if constexpr (KIND == K_ATT) ph_att(a, c, layer, (char*)c.lds);
    else if constexpr (KIND == K_OPROJ) { constexpr int j = layer ? 1 : 0;
#if ATT_FP8
        SchedDense S{(const char*)(ws + WS_HB), (const char*)(ws + WS_WO) + (size_t)j * 1024 * 1024, (size_t)256 * 1024, (size_t)256 * 1024, 0, layer == 3 ? 64 : 68, 4, c.G, (int)blockIdx.x};
        EpiResid E{&a, layer, nullptr, nullptr};
        pg8::gemm_phase<EpiResid, SchedDense, false, true>(c.lds, 1024, 1024, S, E, 127 - MOE_WSH, 127 - ATT_OSH); }
#else
        SchedDense S{(const char*)(ws + WS_HB), (const char*)(ws + WS_WO) + (size_t)j * 1024 * 1024 * 2, (size_t)256 * 1024 * 2, (size_t)256 * 1024 * 2, 0, layer == 3 ? 64 : 68, 4, c.G, (int)blockIdx.x};
        EpiResid E{&a, layer, nullptr, nullptr};
        pg8::gemm_phase<EpiResid, SchedDense, false>(c.lds, 2048, 2048, S, E); }
#endif
    else if constexpr (KIND == K_M1) ph_m1(a, c, layer);
    else if constexpr (KIND == K_M2) {
        LAS int* tab = (LAS int*)(c.lds + TAB_OFF); moe_tables(a, c, layer, tab);
        unsigned* rdy = (unsigned*)(ws + WS_CTL) + CW_RDY + layer * 256;
#if MOE_FP8
        { SchedMoe S{(const char*)(ws + WS_TK), 0, (const char*)(ws + WS_WGU) + (size_t)layer * 32 * 1024 * 1024, (size_t)1024 * 1024, (size_t)256 * 1024, tab, (const int*)(ws + WS_LIST), c.G, (int)blockIdx.x, rdy, 1};
          EpiGateUp E{(bf16*)(ws + WS_ACT)};
          pg8::gemm_phase<EpiGateUp, SchedMoe, true, true>(c.lds, 1024, 1024, S, E, 127 - MOE_WSH, 127); }
        { SchedMoe S{(const char*)(ws + WS_ACT), (size_t)256 * 512, (const char*)(ws + WS_WDN) + (size_t)layer * 32 * 1024 * 512, (size_t)1024 * 512, (size_t)256 * 512, tab, (const int*)(ws + WS_LIST), c.G, (int)blockIdx.x, rdy, 2};
          EpiDown E{(const int*)(ws + WS_LIST), (const float*)(ws + WS_W2), (bf16*)(ws + WS_Y2)};
          pg8::gemm_phase<EpiDown, SchedMoe, false, true>(c.lds, 512, 512, S, E, 127 - MOE_WSH, 127 - MOE_ASH); } }
#else
        { SchedMoe S{(const char*)(ws + WS_TK), 0, (const char*)(ws + WS_WGU) + (size_t)layer * 32 * 1024 * 1024 * 2, (size_t)1024 * 1024 * 2, (size_t)256 * 1024 * 2, tab, (const int*)(ws + WS_LIST), c.G, (int)blockIdx.x, rdy, 1};
          EpiGateUp E{(bf16*)(ws + WS_ACT)};
          pg8::gemm_phase<EpiGateUp, SchedMoe, true>(c.lds, 2048, 2048, S, E); }
        { SchedMoe S{(const char*)(ws + WS_ACT), (size_t)256 * 512 * 2, (const char*)(ws + WS_WDN) + (size_t)layer * 32 * 1024 * 512 * 2, (size_t)1024 * 512 * 2, (size_t)256 * 512 * 2, tab, (const int*)(ws + WS_LIST), c.G, (int)blockIdx.x, rdy, 2};
          EpiDown E{(const int*)(ws + WS_LIST), (const float*)(ws + WS_W2), (bf16*)(ws + WS_Y2)};
          pg8::gemm_phase<EpiDown, SchedMoe, false>(c.lds, 1024, 1024, S, E); } }
#endif
    else if constexpr (KIND == K_RPOOL) ph_rpool(a, c, layer);
    else if constexpr (KIND == K_POOLG) {
        SchedDense S{(const char*)(ws + WS_HB), (const char*)(ws + WS_WPOOL), (size_t)256 * 1024 * 2, (size_t)256 * 256 * 2, (size_t)256 * 2, 68, 4, c.G, (int)blockIdx.x};
        EpiResid E{&a, layer, a.in[I_POOLS], (const float*)(ws + WS_Z)};
        pg8::gemm_phase<EpiResid, SchedDense, false>(c.lds, 512, 2048, S, E); }
    else if constexpr (KIND == K_INPROJ) {
        SchedDense S{(const char*)(ws + WS_HB), (const char*)(ws + WS_WIN), (size_t)256 * 1024 * 2, (size_t)256 * 1024 * 2, 0, 68, 21, c.G, (int)blockIdx.x};
        EpiInproj E{(bf16*)(ws + WS_Z), (bf16*)(ws + WS_XBC), (float*)(ws + WS_DT), a.in[I_DTB]};
        pg8::gemm_phase<EpiInproj, SchedDense, false>(c.lds, 2048, 2048, S, E); }
    else if constexpr (KIND == K_CONV) ph_conv(a, c);
    else if constexpr (KIND == K_SCAN) ph_scan(a, c);
    else if constexpr (KIND == K_YPH) ph_yph(a, c);
    else if constexpr (KIND == K_GFIX) ph_gfix(a, c);
    else if constexpr (KIND == K_OUTPROJ) {
        SchedDense S{(const char*)(ws + WS_G), (const char*)(ws + WS_WOUT), (size_t)256 * 2048 * 2, (size_t)256 * 2048 * 2, 0, 68, 4, c.G, (int)blockIdx.x};
        EpiResid E{&a, layer, nullptr, nullptr};
        pg8::gemm_phase<EpiResid, SchedDense, false>(c.lds, 4096, 4096, S, E); }
    else if constexpr (KIND == K_FINAL) ph_final(a, c, layer);
}
#define PROGRAM(X) \
    X(0, K_P0, 0) \
    X(1, K_RMIX, 0) X(2, K_QKV, 0) X(3, K_ATT, 0) X(4, K_OPROJ, 0) X(5, K_M1, 0) X(6, K_M2, 0) \
    X(7, K_RPOOL, 1) X(8, K_POOLG, 1) X(9, K_M1, 1) X(10, K_M2, 1) \
    X(11, K_RMIX, 2) X(12, K_INPROJ, 2) X(13, K_CONV, 2) X(14, K_SCAN, 2) X(15, K_YPH, 2) X(16, K_OUTPROJ, 2) X(17, K_M1, 2) X(18, K_M2, 2) \
    X(19, K_RMIX, 3) X(20, K_QKV, 3) X(21, K_ATT, 3) X(22, K_OPROJ, 3) X(23, K_M1, 3) X(24, K_M2, 3) \
    X(25, K_FINAL, 4)
constexpr int NPHASES = 26;
__device__ __forceinline__ unsigned long long probe_phases(const unsigned long long* ts, unsigned mask) { unsigned long long r = 0; for (int k = 0; k < 32; ++k) if (mask & (1u << k)) r += ts[k + 1] - ts[k]; return r; }
__device__ __forceinline__ unsigned long long probe_sum(const unsigned long long* s, int mask) { unsigned long long r = 0; for (int k = 0; k < 8; ++k) if (mask & (1 << k)) r += s[k]; return r; }
__global__ void __launch_bounds__(NTHREADS, 2) mega(Args a0) {
    extern __shared__ __attribute__((aligned(16))) unsigned char lds_raw[];
    Ctx c; c.lds = (LAS unsigned char*)lds_raw; c.tid = threadIdx.x; c.lane = c.tid & 63; c.wave = __builtin_amdgcn_readfirstlane(c.tid >> 6);
    c.G = gridDim.x; { const int bx = blockIdx.x; c.vcu = (c.G % 8 == 0) ? (bx % 8) * (c.G / 8) + bx / 8 : bx; }
    volatile LAS unsigned* MISC = (volatile LAS unsigned*)(c.lds + MISC_OFF);
    for (int u = c.tid; u < 128; u += NTHREADS) MISC[u] = 0u;
    __syncthreads();
    XcdBarrier bar = xcd_barrier_post((unsigned*)(a0.ws + WS_CTL) + CW_BAR + a0.bar_region * XCD_BAR_WORDS, MISC + 8);
    const int lo = a0.ph_lo, hi = a0.ph_hi;
#if PROBE
#define STAMP(idx) if (blockIdx.x == 0 && threadIdx.x == 0) __hip_atomic_store((unsigned long long*)((unsigned*)(a0.ws + WS_CTL) + CW_TS) + (idx), (unsigned long long)__builtin_amdgcn_s_memrealtime(), __ATOMIC_RELAXED, __HIP_MEMORY_SCOPE_AGENT);
#else
#define STAMP(idx)
#endif
    STAMP(0)
#if EXTRA_BARS
    for (int eb = 0; eb < EXTRA_BARS; ++eb) xcd_barrier(bar);
#endif
#define RUNPH(idx, KIND, LAYER) if (lo <= (idx) && (idx) < hi) { run_phase<KIND, LAYER>(a0, c, lds_raw); if ((idx) + 1 < hi) xcd_barrier(bar); STAMP((idx) + 1) }
    PROGRAM(RUNPH)
#undef RUNPH
#if PROBE
    if (blockIdx.x == 0 && threadIdx.x == 0 && hi == NPHASES) { const unsigned long long* ts = (const unsigned long long*)((unsigned*)(a0.ws + WS_CTL) + CW_TS);
        const unsigned long long d = (unsigned long long)PROBE_K * (PROBE_SLOT ? probe_sum(ts + PROBE_SLOT_BASE, PROBE_SLOT) : probe_phases(ts, PROBE_MASK)), t0 = __builtin_amdgcn_s_memrealtime();
        while (__builtin_amdgcn_s_memrealtime() - t0 < d) __builtin_amdgcn_s_sleep(8); }
#endif
}

extern "C" void kernel_launch(void* const* d_in, const int* in_sizes, int n_in, void* d_out, int out_size, void* d_ws, size_t ws_size, hipStream_t stream) {
    static int grid = 0;
    if (grid == 0) {
        if (n_in != N_IN || out_size != TL * D || ws_size < WS_END) { fprintf(stderr, "kernel_launch: unexpected shapes (n_in %d out %d ws %zu)\n", n_in, out_size, ws_size); grid = -1; return; }
        int dev = 0, cus = 0;
        if (hipGetDevice(&dev) != hipSuccess || hipDeviceGetAttribute(&cus, hipDeviceAttributeMultiprocessorCount, dev) != hipSuccess) { grid = -1; return; }
        if (hipFuncSetAttribute((const void*)mega, hipFuncAttributeMaxDynamicSharedMemorySize, LDS_BYTES) != hipSuccess) { fprintf(stderr, "kernel_launch: hipFuncSetAttribute failed\n"); grid = -1; return; }
        int per_cu = 0;
        if (hipOccupancyMaxActiveBlocksPerMultiprocessor(&per_cu, (const void*)mega, NTHREADS, LDS_BYTES) != hipSuccess || per_cu < 1) fprintf(stderr, "kernel_launch: occupancy query says %d\n", per_cu);
        (void)hipGetLastError();
        grid = cus;
    }
    if (grid < 0) return;
    (void)hipMemsetAsync((char*)d_ws + WS_CTL, 0, CTL_ZERO_BYTES, stream);
    Args a{};
    for (int i = 0; i < N_IN; ++i) a.in[i] = (const float*)d_in[i];
    a.out = (float*)d_out; a.ws = (unsigned char*)d_ws; a.flags = 0;
#if DEBUG_CHECKS
    struct Cut { int after; int ty, layer, nid; };
    const Cut cuts[] = DEBUG_CUTS;
    int lo = 0, region = 0, dbg_id = 1;
    for (unsigned k = 0; k < sizeof(cuts) / sizeof(cuts[0]); ++k) {
        if (cuts[k].after + 1 > lo) { a.ph_lo = lo; a.ph_hi = cuts[k].after + 1; a.bar_region = region++; hipLaunchKernelGGL(mega, dim3(grid), dim3(NTHREADS), LDS_BYTES, stream, a); lo = cuts[k].after + 1; }
        hipLaunchKernelGGL(dbg_kernel, dim3(16), dim3(NTHREADS), 65536, stream, a, cuts[k].ty, cuts[k].layer, dbg_id); dbg_id += cuts[k].nid;
    }
    a.ph_lo = lo; a.ph_hi = NPHASES; a.bar_region = region++;
    hipLaunchKernelGGL(mega, dim3(grid), dim3(NTHREADS), LDS_BYTES, stream, a);
#else
    a.ph_lo = 0; a.ph_hi = NPHASES; a.bar_region = 0;
    hipLaunchKernelGGL(mega, dim3(grid), dim3(NTHREADS), LDS_BYTES, stream, a);
#endif
}
```

```cpp
#include <hip/hip_runtime.h>
#include <cstdio>
#include <cstdint>

#define LAS __attribute__((address_space(3)))
#define GAS __attribute__((address_space(1)))
typedef unsigned short bf16;
typedef short bf16x8 __attribute__((ext_vector_type(8)));
typedef short s16x4 __attribute__((ext_vector_type(4)));
typedef float f32x2 __attribute__((ext_vector_type(2)));
typedef float f32x4 __attribute__((ext_vector_type(4)));
typedef float f32x16 __attribute__((ext_vector_type(16)));
typedef unsigned u32x2 __attribute__((ext_vector_type(2)));
typedef unsigned u32x4 __attribute__((ext_vector_type(4)));
typedef __bf16 bf16x2_t __attribute__((ext_vector_type(2)));

constexpr int D = 1024, NB = 4, SEQ = 4096, CTXL = 256, TL = NB * SEQ, TC = NB * CTXL, TT = TL + TC;
constexpr int KVROWS = SEQ + CTXL;
constexpr int NCH = TT / 128;
constexpr int MOE_CAP = TT;
constexpr float EPS = 1e-6f;
constexpr int NWAVES = 8, NTHREADS = 512;
#ifndef NLAYERS
#define NLAYERS 4
#endif
#ifndef MOE_FP8
#define MOE_FP8 1
#endif
#define MOE_WSH 5
#ifndef ATT_FP8
#define ATT_FP8 1
#endif
#define ATT_OSH 3
#define MOE_ASH 2
#define DBG_TOL 0.03f
#ifndef DEBUG_CHECKS
#define DEBUG_CHECKS 0
#endif
#ifndef PROBE
#define PROBE 0
#endif
#define PROBE_A0 0
#define PROBE_A1 1
#define PROBE_B0 4
#define PROBE_B1 5
#define PROBE_K 2
#define PROBE_MASK 0x1222224u
#define EXTRA_BARS 0
#define PROBE_SLOT_BASE 40
#define PROBE_SLOT 0
#if PROBE
#define SECT_DECL unsigned long long sect_t = __builtin_amdgcn_s_memrealtime(); unsigned long long sect_acc[8] = {0, 0, 0, 0, 0, 0, 0, 0};
#define SECT(k) do { const unsigned long long n_ = __builtin_amdgcn_s_memrealtime(); sect_acc[k] += n_ - sect_t; sect_t = n_; } while (0)
#define SECT_END(base) do { if (blockIdx.x == 0 && threadIdx.x == 0) { _Pragma("unroll") for (int k_ = 0; k_ < 8; ++k_) ((unsigned long long*)((unsigned*)(a.ws + WS_CTL) + CW_TS))[(base) + k_] = sect_acc[k_]; } } while (0)
#else
#define SECT_DECL
#define SECT(k) do {} while (0)
#define SECT_END(base) do {} while (0)
#endif
#define DEBUG_CUTS { {1, 1, 0, 1}, {2, 2, 0, 1}, {3, 3, 0, 1}, {4, 4, 0, 1}, {6, 5, 0, 2} }

enum { I_X = 0, I_C, I_CTX, I_CCTX, I_WADA, I_BADA, I_NMIX, I_NFFN, I_NFIN, I_WQKV, I_WO, I_QG, I_KG, I_POOLW, I_POOLS, I_WIN, I_CONVW, I_CONVB, I_DTB, I_ALOG, I_DSK, I_SNORM, I_WOUT, I_WRG, I_WRE, I_WGU, I_WDN, N_IN };

constexpr size_t MiB = 1u << 20;
constexpr size_t WS_CTL = 0, CTL_ZERO_BYTES = 1 * MiB;
constexpr size_t WS_MODL = 1 * MiB;
constexpr size_t WS_MODC = WS_MODL + 4 * 4 * 6144 * 4;
constexpr size_t WS_ROPE = 1 * MiB + 512 * 1024;
constexpr size_t WS_WR = 2 * MiB;
constexpr size_t WS_WQKV = 3 * MiB;
constexpr size_t WS_WO = 9 * MiB;
constexpr size_t WS_WPOOL = 13 * MiB;
constexpr size_t WS_WIN = 14 * MiB;
constexpr size_t WS_WOUT = 25 * MiB;
constexpr size_t WS_WGU = 29 * MiB;
constexpr size_t WS_WDN = 285 * MiB;
constexpr size_t WS_X = 413 * MiB;
constexpr size_t WS_HB = 481 * MiB;
constexpr size_t WS_TK = 515 * MiB;
constexpr size_t WS_Q = 549 * MiB;
constexpr size_t WS_K = 583 * MiB;
constexpr size_t WS_V = 592 * MiB;
constexpr size_t WS_Y2 = 601 * MiB;
constexpr size_t WS_ACT = 669 * MiB;
constexpr size_t WS_LIST = 711 * MiB;
constexpr size_t WS_W2 = 714 * MiB;
constexpr size_t WS_Z = 715 * MiB;
constexpr size_t WS_XBC = 783 * MiB;
constexpr size_t WS_DT = 885 * MiB;
constexpr size_t WS_XT = 890 * MiB;
constexpr size_t WS_BN = 958 * MiB;
constexpr size_t WS_BT = 975 * MiB;
constexpr size_t WS_CN = 992 * MiB;
constexpr size_t WS_SCA = 1009 * MiB;
constexpr size_t WS_SCB = 1018 * MiB;
constexpr size_t WS_DEC = 1027 * MiB;
constexpr size_t WS_HIN = 1028 * MiB;
constexpr size_t WS_G = 1164 * MiB;
constexpr size_t WS_RSTD = 1232 * MiB;
constexpr size_t WS_END = 1233 * MiB;

constexpr int CW_BAR = 4096;
constexpr int CW_CNT = 200000;
constexpr int CW_DBG = 201000;
constexpr int CW_RDY = 204000;
constexpr int CW_TS = 202000;

constexpr int LDS_BYTES = 163840;
constexpr int MISC_OFF = LDS_BYTES - 512;

__device__ __forceinline__ unsigned cvtpk(float lo, float hi) { f32x2 v = {lo, hi}; bf16x2_t b = __builtin_convertvector(v, bf16x2_t); return __builtin_bit_cast(unsigned, b); }
__device__ __forceinline__ unsigned pk_fp8x4(float a, float b, float c, float d) {
    a = __builtin_amdgcn_fmed3f(a, -448.f, 448.f); b = __builtin_amdgcn_fmed3f(b, -448.f, 448.f); c = __builtin_amdgcn_fmed3f(c, -448.f, 448.f); d = __builtin_amdgcn_fmed3f(d, -448.f, 448.f);
    unsigned w = __builtin_amdgcn_cvt_pk_fp8_f32(a, b, 0u, false); return __builtin_amdgcn_cvt_pk_fp8_f32(c, d, w, true); }
__device__ __forceinline__ float bflo(unsigned u) { return __uint_as_float(u << 16); }
__device__ __forceinline__ float bfhi(unsigned u) { return __uint_as_float(u & 0xffff0000u); }
__device__ __forceinline__ float bf2f(bf16 b) { return __uint_as_float((unsigned)b << 16); }
__device__ __forceinline__ float wave_sum(float v) {
#pragma unroll
    for (int o = 1; o < 64; o <<= 1) v += __shfl_xor(v, o);
    return v;
}
__device__ __forceinline__ float silu_f(float v) { return v * __builtin_amdgcn_rcpf(1.0f + __builtin_amdgcn_exp2f(v * -1.4426950408889634f)); }
__device__ __forceinline__ int tid_opaque() { int t = threadIdx.x; asm volatile("" : "+v"(t)); return t; }
#define LDS_WAIT() asm volatile("s_waitcnt lgkmcnt(0)" ::: "memory")
#define VM_WAIT() asm volatile("s_waitcnt vmcnt(0)" ::: "memory")

#define XB_TMO      128
#define XB_XCNT(j)  (256  + 64 * (j))
#define XB_XSUB(j)  (1280 + 64 * (j))
#define XB_XGEN(j)  (2304 + 64 * (j))
#define XB_TOP      3328
#define XB_TOPGEN   3392
#define XCD_BAR_WORDS 3456
#define XB_SPIN_CAP (1u << 20)
__device__ __forceinline__ unsigned xb_ld(unsigned* p)              { return __hip_atomic_load(p, __ATOMIC_RELAXED, __HIP_MEMORY_SCOPE_AGENT); }
__device__ __forceinline__ unsigned xb_add(unsigned* p, unsigned v) { return __hip_atomic_fetch_add(p, v, __ATOMIC_RELAXED, __HIP_MEMORY_SCOPE_AGENT); }
__device__ __forceinline__ unsigned xb_xcc_id() { return (unsigned)__builtin_amdgcn_s_getreg((3 << 11) | 20) & 0xFu; }
#define XB_SPIN(cond, bar) do { unsigned _sp = 0; while (cond) { __builtin_amdgcn_s_sleep(1); \
    if ((++_sp & 255u) == 0u) { if (xb_ld(&(bar)[XB_TMO])) break; if (_sp > XB_SPIN_CAP) { atomicAdd(&(bar)[XB_TMO], 1u); break; } } } } while (0)
struct XcdBarrier { unsigned* bar; unsigned x; volatile LAS unsigned* st; };
__device__ __forceinline__ XcdBarrier xcd_barrier_post(unsigned* bar, volatile LAS unsigned* st) {
    XcdBarrier b; b.bar = bar; b.x = xb_xcc_id(); b.st = st;
    if (threadIdx.x == 0) (void)xb_add(&bar[XB_XCNT(b.x)], 1u);
    return b;
}
__device__ __forceinline__ void xcd_barrier_complete(unsigned* bar, unsigned x, unsigned& nloc, unsigned& nx) {
    const unsigned G = gridDim.x * gridDim.y * gridDim.z;
    unsigned sum, cnt, mine, sp = 0u;
    for (;;) {
        sum = 0u; cnt = 0u; mine = 0u;
#pragma unroll
        for (unsigned j = 0; j < 16; ++j) { const unsigned c = xb_ld(&bar[XB_XCNT(j)]); sum += c; cnt += (c > 0u) ? 1u : 0u; mine = (j == x) ? c : mine; }
        if (sum == G) break;
        __builtin_amdgcn_s_sleep(1);
        if ((++sp & 255u) == 0u) { if (xb_ld(&bar[XB_TMO])) break; if (sp > XB_SPIN_CAP) { atomicAdd(&bar[XB_TMO], 1u); break; } }
    }
    nloc = mine > 0u ? mine : 1u; nx = cnt > 0u ? cnt : 1u;
}
__device__ __forceinline__ void xcd_barrier(const XcdBarrier& b) {
    asm volatile("s_waitcnt vmcnt(0)" ::: "memory");
    __syncthreads();
    if (threadIdx.x == 0) {
        unsigned* bar = b.bar;
        __builtin_amdgcn_s_waitcnt(0);
        unsigned nloc = b.st[0], nx = b.st[1];
        if (nloc == 0u) { xcd_barrier_complete(bar, b.x, nloc, nx); b.st[0] = nloc; b.st[1] = nx; }
        const unsigned old = xb_add(&bar[XB_XSUB(b.x)], 1u);
        const unsigned gen = old / nloc;
        if (old + 1u == (gen + 1u) * nloc) {
            __builtin_amdgcn_fence(__ATOMIC_RELEASE, "agent");
            asm volatile("s_waitcnt vmcnt(0)" ::: "memory");
            const unsigned og = xb_add(&bar[XB_TOP], 1u);
            const unsigned tg = og / nx;
            if (og + 1u == (tg + 1u) * nx) xb_add(&bar[XB_TOPGEN], 1u);
            else XB_SPIN(xb_ld(&bar[XB_TOPGEN]) == tg, bar);
            __builtin_amdgcn_fence(__ATOMIC_ACQUIRE, "agent");
            xb_add(&bar[XB_XGEN(b.x)], 1u);
            asm volatile("s_waitcnt vmcnt(0)" ::: "memory");
        } else {
            XB_SPIN(xb_ld(&bar[XB_XGEN(b.x)]) == gen, bar);
            __builtin_amdgcn_fence(__ATOMIC_ACQUIRE, "agent");
            asm volatile("s_waitcnt vmcnt(0)" ::: "memory");
        }
    }
    __syncthreads();
}

enum { K_P0 = 0, K_RMIX, K_QKV, K_ROPE, K_ATT, K_OPROJ, K_M1, K_M2, K_M3, K_RPOOL, K_POOLG, K_INPROJ, K_CONV, K_SCAN, K_YPH, K_GFIX, K_OUTPROJ, K_FINAL, K_DBG };
struct Args { const float* in[N_IN]; float* out; unsigned char* ws; int ph_lo, ph_hi; int flags; int bar_region; };

struct Ctx {
    LAS unsigned char* lds; int tid, lane, wave, vcu, G;
};

__device__ __forceinline__ const float* mod_row(const Args& a, int layer, int r) {
    return r < TL ? (const float*)(a.ws + WS_MODL) + (size_t)(layer * 4 + r / SEQ) * 6144 : (const float*)(a.ws + WS_MODC) + (size_t)layer * 6144;
}
__device__ __forceinline__ const float* resid_row(const Args& a, int layer, int r) {
    if (layer == 0) return r < TL ? a.in[I_X] + (size_t)r * D : a.in[I_CTX] + (size_t)(r - TL) * D;
    return (const float*)(a.ws + WS_X) + (size_t)r * D;
}

__device__ __forceinline__ void load_row_combined(const Args& a, int layer, int r, int lane, f32x4 (&v)[4]) {
    const f32x4* xr = (const f32x4*)resid_row(a, layer, r) + lane;
#pragma unroll
    for (int j = 0; j < 4; ++j) v[j] = xr[64 * j];
    if (layer > 0 && !(a.flags & 1)) {
        const f32x4* gf = (const f32x4*)(mod_row(a, layer - 1, r) + 5 * D) + lane;
        const u32x2* y0 = (const u32x2*)((const bf16*)(a.ws + WS_Y2) + (size_t)(2 * r) * D) + lane;
        const u32x2* y1 = (const u32x2*)((const bf16*)(a.ws + WS_Y2) + (size_t)(2 * r + 1) * D) + lane;
#pragma unroll
        for (int j = 0; j < 4; ++j) {
            const u32x2 p = y0[64 * j], q = y1[64 * j]; const f32x4 g = gf[64 * j];
            v[j].x += g.x * (bflo(p.x) + bflo(q.x)); v[j].y += g.y * (bfhi(p.x) + bfhi(q.x));
            v[j].z += g.z * (bflo(p.y) + bflo(q.y)); v[j].w += g.w * (bfhi(p.y) + bfhi(q.y));
        }
    }
}
__device__ __forceinline__ float row_rstd(const f32x4 (&v)[4]) {
    float s = 0.f;
#pragma unroll
    for (int j = 0; j < 4; ++j) s += (v[j].x * v[j].x + v[j].y * v[j].y) + (v[j].z * v[j].z + v[j].w * v[j].w);
    return rsqrtf(wave_sum(s) * (1.0f / D) + EPS);
}
__device__ __forceinline__ void norm_mod(const f32x4 (&v)[4], float rstd, const float* g, const float* shift, const float* scale, int lane, f32x4 (&h)[4]) {
#pragma unroll
    for (int j = 0; j < 4; ++j) {
        const f32x4 gg = ((const f32x4*)g)[lane + 64 * j], sh = ((const f32x4*)shift)[lane + 64 * j], sc = ((const f32x4*)scale)[lane + 64 * j];
        h[j] = (v[j] * rstd) * gg * (sc + 1.0f) + sh;
    }
}

__device__ __forceinline__ void tr_item(const float* W, int N, int k0, int n0, bf16* WT, size_t drow0, int dK, LAS float* scr, int lane, int hi_skip = 0) {
    const int nq = lane & 15, kr = lane >> 4;
#pragma unroll
    for (int i = 0; i < 16; ++i) { const int kk = 4 * i + kr; const f32x4 v = *(const f32x4*)(W + (size_t)(k0 + kk) * N + n0 + 4 * nq);
        LAS float* d = scr + kk * 65 + 4 * nq; d[0] = v.x; d[1] = v.y; d[2] = v.z; d[3] = v.w; }
    LDS_WAIT(); asm volatile("" ::: "memory");
    const int c = lane & 7;
#pragma unroll
    for (int j = 0; j < 8; ++j) { const int n = (lane >> 3) + 8 * j; const LAS float* s = scr + (8 * c) * 65 + n;
        u32x4 o; o.x = cvtpk(s[0 * 65], s[1 * 65]); o.y = cvtpk(s[2 * 65], s[3 * 65]); o.z = cvtpk(s[4 * 65], s[5 * 65]); o.w = cvtpk(s[6 * 65], s[7 * 65]);
        *(u32x4*)(WT + (drow0 + n + (n >= 32 ? hi_skip : 0)) * dK + k0 + 8 * c) = o; }
    LDS_WAIT(); asm volatile("" ::: "memory");
}
__device__ __forceinline__ void tr_item8(const float* W, int N, int k0, int n0, unsigned char* WT, size_t drow0, int dKb, LAS float* scr, int lane, float scale, int hi_skip = 0) {
    const int nq = lane & 15, kr = lane >> 4;
#pragma unroll
    for (int i = 0; i < 16; ++i) { const int kk = 4 * i + kr; const f32x4 v = *(const f32x4*)(W + (size_t)(k0 + kk) * N + n0 + 4 * nq);
        LAS float* d = scr + kk * 65 + 4 * nq; d[0] = v.x; d[1] = v.y; d[2] = v.z; d[3] = v.w; }
    LDS_WAIT(); asm volatile("" ::: "memory");
    const int c = lane & 3;
#pragma unroll
    for (int j = 0; j < 4; ++j) { const int n = (lane >> 2) + 16 * j; const LAS float* s = scr + (16 * c) * 65 + n;
        u32x4 o; o.x = pk_fp8x4(s[0 * 65] * scale, s[1 * 65] * scale, s[2 * 65] * scale, s[3 * 65] * scale); o.y = pk_fp8x4(s[4 * 65] * scale, s[5 * 65] * scale, s[6 * 65] * scale, s[7 * 65] * scale);
        o.z = pk_fp8x4(s[8 * 65] * scale, s[9 * 65] * scale, s[10 * 65] * scale, s[11 * 65] * scale); o.w = pk_fp8x4(s[12 * 65] * scale, s[13 * 65] * scale, s[14 * 65] * scale, s[15 * 65] * scale);
        *(u32x4*)(WT + (drow0 + n + (n >= 32 ? hi_skip : 0)) * dKb + k0 + 16 * c) = o; }
    LDS_WAIT(); asm volatile("" ::: "memory");
}
struct TrD { const float* src; int N; unsigned char* dst; int dKb, drow0, hi_skip, fp8; };
__device__ __forceinline__ void tr_load(const TrD& d, f32x4 (&v)[16], int lane) {
    const int nq = lane & 15, kr = lane >> 4;
#pragma unroll
    for (int i = 0; i < 16; ++i) v[i] = *(const f32x4*)(d.src + (size_t)(4 * i + kr) * d.N + 4 * nq);
}
__device__ __forceinline__ void tr_store(const TrD& d, const f32x4 (&v)[16], LAS float* scr, int lane) {
    const int nq = lane & 15, kr = lane >> 4;
#pragma unroll
    for (int i = 0; i < 16; ++i) { LAS float* p = scr + (4 * i + kr) * 65 + 4 * nq; p[0] = v[i].x; p[1] = v[i].y; p[2] = v[i].z; p[3] = v[i].w; }
    LDS_WAIT(); asm volatile("" ::: "memory");
    if (d.fp8) { const int c = lane & 3; const float scale = (float)(1 << MOE_WSH);
#pragma unroll
        for (int j = 0; j < 4; ++j) { const int n = (lane >> 2) + 16 * j; const LAS float* s = scr + (16 * c) * 65 + n;
            u32x4 o; o.x = pk_fp8x4(s[0 * 65] * scale, s[1 * 65] * scale, s[2 * 65] * scale, s[3 * 65] * scale); o.y = pk_fp8x4(s[4 * 65] * scale, s[5 * 65] * scale, s[6 * 65] * scale, s[7 * 65] * scale);
            o.z = pk_fp8x4(s[8 * 65] * scale, s[9 * 65] * scale, s[10 * 65] * scale, s[11 * 65] * scale); o.w = pk_fp8x4(s[12 * 65] * scale, s[13 * 65] * scale, s[14 * 65] * scale, s[15 * 65] * scale);
            *(u32x4*)(d.dst + (size_t)(d.drow0 + n + (n >= 32 ? d.hi_skip : 0)) * d.dKb + 16 * c) = o; } }
    else { const int c = lane & 7;
#pragma unroll
        for (int j = 0; j < 8; ++j) { const int n = (lane >> 3) + 8 * j; const LAS float* s = scr + (8 * c) * 65 + n;
            u32x4 o; o.x = cvtpk(s[0 * 65], s[1 * 65]); o.y = cvtpk(s[2 * 65], s[3 * 65]); o.z = cvtpk(s[4 * 65], s[5 * 65]); o.w = cvtpk(s[6 * 65], s[7 * 65]);
            *(u32x4*)(d.dst + (size_t)(d.drow0 + n + (n >= 32 ? d.hi_skip : 0)) * d.dKb + 16 * c) = o; } }
    LDS_WAIT(); asm volatile("" ::: "memory");
}
constexpr int TR_I0 = 2 * 384, TR_I1 = 2 * 256, TR_I2 = 4 * 16, TR_I3 = 16 * 81, TR_I4 = 32 * 16, TR_I5 = 128 * 256, TR_I6 = 128 * 128, TR_ITOT = TR_I0 + TR_I1 + TR_I2 + TR_I3 + TR_I4 + TR_I5 + TR_I6;
__device__ __forceinline__ TrD tr_decode(const Args& a, int it) {
    TrD d; int r = it; d.hi_skip = 0;
    if (r < TR_I5) { const int m = r / 256, q = r % 256, kb = q / 16, nb = q % 16, n0 = nb * 64, j = n0 & 511;
        d.src = a.in[I_WGU] + (size_t)m * 1024 * 1024 + (size_t)kb * 64 * 1024 + n0; d.N = 1024; d.drow0 = 256 * (j >> 7) + (j & 127) + ((n0 >= 512) ? 128 : 0);
        d.fp8 = MOE_FP8; d.dKb = MOE_FP8 ? 1024 : 2048; d.dst = (unsigned char*)(a.ws + WS_WGU) + (size_t)m * 1024 * d.dKb + (size_t)kb * 64 * (MOE_FP8 ? 1 : 2); return d; }
    r -= TR_I5;
    if (r < TR_I6) { const int m = r / 128, q = r % 128, kb = q / 16, nb = q % 16;
        d.src = a.in[I_WDN] + (size_t)m * 512 * 1024 + (size_t)kb * 64 * 1024 + nb * 64; d.N = 1024; d.drow0 = nb * 64;
        d.fp8 = MOE_FP8; d.dKb = MOE_FP8 ? 512 : 1024; d.dst = (unsigned char*)(a.ws + WS_WDN) + (size_t)m * 1024 * d.dKb + (size_t)kb * 64 * (MOE_FP8 ? 1 : 2); return d; }
    r -= TR_I6;
    if (r < TR_I0) { const int m = r / 384, q = r % 384, kb = q / 24, nb = q % 24;
        d.src = a.in[I_WQKV] + (size_t)m * 1024 * 1536 + (size_t)kb * 64 * 1536 + nb * 64; d.N = 1536; d.drow0 = (nb >> 2) * 256 + (nb & 3) * 32; d.hi_skip = 96;
        d.fp8 = ATT_FP8; d.dKb = ATT_FP8 ? 1024 : 2048; d.dst = (unsigned char*)(a.ws + WS_WQKV) + (size_t)m * 1536 * d.dKb + (size_t)kb * 64 * (ATT_FP8 ? 1 : 2); return d; }
    r -= TR_I0;
    if (r < TR_I1) { const int m = r / 256, q = r % 256, kb = q / 16, nb = q % 16;
        d.src = a.in[I_WO] + (size_t)m * 1024 * 1024 + (size_t)kb * 64 * 1024 + nb * 64; d.N = 1024; d.drow0 = nb * 64;
        d.fp8 = ATT_FP8; d.dKb = ATT_FP8 ? 1024 : 2048; d.dst = (unsigned char*)(a.ws + WS_WO) + (size_t)m * 1024 * d.dKb + (size_t)kb * 64 * (ATT_FP8 ? 1 : 2); return d; }
    r -= TR_I1;
    d.fp8 = 0;
    if (r < TR_I2) { const int m = r / 16, q = r % 16, kb = q / 4, nb = q % 4;
        d.src = a.in[I_POOLW] + (size_t)m * 256 * 256 + (size_t)kb * 64 * 256 + nb * 64; d.N = 256; d.drow0 = nb * 64; d.dKb = 512; d.dst = (unsigned char*)(a.ws + WS_WPOOL) + (size_t)m * 256 * 512 + (size_t)kb * 128; return d; }
    r -= TR_I2;
    if (r < TR_I3) { const int kb = r / 81, nb = r % 81;
        d.src = a.in[I_WIN] + (size_t)kb * 64 * 5184 + nb * 64; d.N = 5184; d.drow0 = nb * 64; d.dKb = 2048; d.dst = (unsigned char*)(a.ws + WS_WIN) + (size_t)kb * 128; return d; }
    r -= TR_I3;
    { const int kb = r / 16, nb = r % 16;
        d.src = a.in[I_WOUT] + (size_t)kb * 64 * 1024 + nb * 64; d.N = 1024; d.drow0 = nb * 64; d.dKb = 4096; d.dst = (unsigned char*)(a.ws + WS_WOUT) + (size_t)kb * 128; return d; }
}
__device__ __forceinline__ void p0_prologue(const Args& a, const Ctx& c) {
    LAS float* scr = (LAS float*)(c.lds + c.wave * 16896);
    const int gw = c.vcu * NWAVES + c.wave, NGW = c.G * NWAVES;
    { f32x4 va[16], vb[16]; TrD da, db; int it = gw;
      da = tr_decode(a, it < TR_ITOT ? it : TR_ITOT - 1); tr_load(da, va, c.lane);
      while (it < TR_ITOT) {
          const int itB = it + NGW; db = tr_decode(a, itB < TR_ITOT ? itB : TR_ITOT - 1); tr_load(db, vb, c.lane);
          tr_store(da, va, scr, c.lane);
          if (itB >= TR_ITOT) break;
          const int itA = itB + NGW; da = tr_decode(a, itA < TR_ITOT ? itA : TR_ITOT - 1); tr_load(da, va, c.lane);
          tr_store(db, vb, scr, c.lane);
          it = itA; } }
    __syncthreads();
    LAS float* sv = (LAS float*)c.lds;
    LAS float* part = (LAS float*)(c.lds + 20480);
    for (int u = c.tid; u < 5 * 1024; u += NTHREADS) { const int v = u >> 10, k = u & 1023; const float x = v < 4 ? a.in[I_C][v * 1024 + k] : a.in[I_CCTX][k]; sv[u] = x / (1.0f + expf(-x)); }
    __syncthreads();
    for (int item = blockIdx.x; item < 4 * 64; item += c.G) {
        const int li = item >> 6, c0 = (item & 63) * 96, cq = c.tid % 24, ks = c.tid / 24;
        f32x4 acc[5];
#pragma unroll
        for (int v = 0; v < 5; ++v) acc[v] = (f32x4){0.f, 0.f, 0.f, 0.f};
        if (ks < 21) { const int kbeg = ks * 49, kend = (kbeg + 49) < 1024 ? (kbeg + 49) : 1024;
            const float* w = a.in[I_WADA] + ((size_t)li * 1024 + kbeg) * 6144 + c0 + 4 * cq;
#pragma unroll 7
            for (int k = kbeg; k < kend; ++k) { const f32x4 wv = *(const f32x4*)w; w += 6144;
#pragma unroll
                for (int v = 0; v < 5; ++v) acc[v] += wv * sv[v * 1024 + k]; }
#pragma unroll
            for (int v = 0; v < 5; ++v) *(LAS f32x4*)(part + (ks * 24 + cq) * 20 + v * 4) = acc[v]; }
        __syncthreads();
        if (c.tid < 480) { const int v = c.tid / 96, col = c.tid % 96, q = col >> 2, e = col & 3; float s = 0.f;
            for (int k2 = 0; k2 < 21; ++k2) s += part[(k2 * 24 + q) * 20 + v * 4 + e];
            s += a.in[I_BADA][li * 6144 + c0 + col];
            if (v < 4) ((float*)(a.ws + WS_MODL))[(size_t)(li * 4 + v) * 6144 + c0 + col] = s; else ((float*)(a.ws + WS_MODC))[(size_t)li * 6144 + c0 + col] = s; }
        __syncthreads();
    }
    if (blockIdx.x == (unsigned)(c.G - 1)) for (int u = c.tid; u < 1024; u += NTHREADS) { const int pos = u >> 4, f = u & 15;
        const float inv = (float)pow(10000.0, -(double)f / 16.0); const double ang = (double)((float)pos * inv);
        ((f32x2*)(a.ws + WS_ROPE))[u] = (f32x2){(float)cos(ang), (float)sin(ang)}; }
    for (int u = blockIdx.x * NTHREADS + c.tid; u < 4 * 64 * 1024; u += c.G * NTHREADS) { const int li = u >> 16, n = (u >> 10) & 63, k = u & 1023;
        float w = 0.f; if (n < 4) w = a.in[I_WRG][((size_t)li * 1024 + k) * 4 + n]; else if (n < 36) w = a.in[I_WRE][((size_t)li * 1024 + k) * 32 + (n - 4)];
        const unsigned hi = cvtpk(w, 0.f) & 0xffffu; const float rem = w - bflo(hi); const unsigned lo = cvtpk(rem, 0.f) & 0xffffu;
        bf16* wr = (bf16*)(a.ws + WS_WR) + (size_t)li * 2 * 65536; wr[n * 1024 + k] = (bf16)hi; wr[65536 + n * 1024 + k] = (bf16)lo; }
}

__device__ __forceinline__ void ph_rmix(const Args& a, const Ctx& c, int layer) {
    const int gw = c.vcu * NWAVES + c.wave, NGW = c.G * NWAVES;
    const float* g = a.in[I_NMIX] + layer * D;
    for (int r = gw; r < TT; r += NGW) {
        f32x4 v[4], h[4]; load_row_combined(a, layer, r, c.lane, v);
        if (layer > 0) { f32x4* xo = (f32x4*)((float*)(a.ws + WS_X) + (size_t)r * D) + c.lane;
#pragma unroll
            for (int j = 0; j < 4; ++j) xo[64 * j] = v[j]; }
        const float rstd = row_rstd(v); const float* m = mod_row(a, layer, r);
        norm_mod(v, rstd, g, m, m + D, c.lane, h);
        if (ATT_FP8 && layer != 2) { unsigned* ho8 = (unsigned*)((unsigned char*)(a.ws + WS_HB) + (size_t)r * D) + c.lane;
#pragma unroll
            for (int j = 0; j < 4; ++j) ho8[64 * j] = pk_fp8x4(h[j].x, h[j].y, h[j].z, h[j].w); }
        else { u32x2* ho = (u32x2*)((bf16*)(a.ws + WS_HB) + (size_t)r * D) + c.lane;
#pragma unroll
            for (int j = 0; j < 4; ++j) ho[64 * j] = (u32x2){cvtpk(h[j].x, h[j].y), cvtpk(h[j].z, h[j].w)}; }
    }
}

__device__ __forceinline__ void ph_final(const Args& a, const Ctx& c, int layer) {
    const int gw = c.vcu * NWAVES + c.wave, NGW = c.G * NWAVES;
    float dscale = 1.f, dmark = 0.f;
#if DEBUG_CHECKS
    { unsigned* dbg = (unsigned*)(a.ws + WS_CTL) + CW_DBG; int code = 0; float mag = 0.f;
      for (int id = 1; id < 32; ++id) { const float e = __uint_as_float(__hip_atomic_load(dbg + id, __ATOMIC_RELAXED, __HIP_MEMORY_SCOPE_AGENT)); if (code == 0 && e > DBG_TOL) { code = id; mag = e; } }
      dscale = 1.f + (float)code; dmark = code ? 100.f * (1.f + fminf(fmaxf(log2f(mag / DBG_TOL), 0.f), 30.f)) : 0.f; }
#endif
    for (int r = gw; r < TL; r += NGW) {
        f32x4 v[4]; load_row_combined(a, layer, r, c.lane, v);
        const float rstd = row_rstd(v) * dscale;
        f32x4* o = (f32x4*)(a.out + (size_t)r * D) + c.lane;
#pragma unroll
        for (int j = 0; j < 4; ++j) { f32x4 ov = (v[j] * rstd) * ((const f32x4*)a.in[I_NFIN])[c.lane + 64 * j]; if (j == 0 && r == 0 && c.lane == 0 && dmark > 0.f) ov.x = dmark; o[64 * j] = ov; }
    }
}


namespace pg8 {
constexpr int BM = 256, BK = 64, HALF = 128, HTB = HALF * BK * 2, STAGE_BYTES = 8 * HTB;
__host__ __device__ __forceinline__ int lds_byte(int r, int c) { const int st = (r >> 4) * 2 + (c >> 5), rr = r & 15, cc = c & 31, ob = rr * 64 + cc * 2; return st * 1024 + (ob ^ (((ob >> 9) & 1) << 5)); }
__host__ __device__ __forceinline__ void stage_rc(int b, int& R, int& C) { const int st = b / 1024, sb = b % 1024, swz = sb ^ (((sb >> 9) & 1) << 5); R = (st >> 1) * 16 + swz / 64; C = (st & 1) * 32 + (swz % 64) / 2; }
__host__ __device__ __forceinline__ int perm32(int rho) { const int n = rho >> 4, i = rho & 15; return 8 * (i >> 2) + 4 * n + (i & 3); }
struct Unit { const char* A; const char* B; int pm, pn, x0, x1; };
__device__ __forceinline__ void tile_of(int L, int nM, int nN, int& pm, int& pn) {
    const int nwg = nM * nN; int wgid = L; { const int q = nwg / 8, r = nwg % 8, xcd = wgid % 8, off = wgid / 8; wgid = (xcd < r ? xcd * (q + 1) : r * (q + 1) + (xcd - r) * q) + off; }
    const int nig = 8 * nN, gid = wgid / nig, fm = gid * 8, gsz = (nM - fm) < 8 ? (nM - fm) : 8;
    pm = fm + ((wgid % nig) % gsz); pn = (wgid % nig) / gsz;
}
typedef int v4i_t __attribute__((ext_vector_type(4))); typedef int v8i_t __attribute__((ext_vector_type(8)));
template <class Epi, class Sched, bool GATHER, bool FP8 = false>
__device__ __forceinline__ void gemm_phase(LAS unsigned char* lds, const int Kb, const int ldab, const Sched& S, const Epi& E, const int scw = 127, const int sca = 127) {
    const int tid = tid_opaque(), wid = __builtin_amdgcn_readfirstlane(tid >> 6), lane = tid & 63, wr = wid >> 2, wc = wid & 3, fr = lane & 15, fq = lane >> 4;
    const int nt = Kb / (BK * 2);
    int scw_v = scw, sca_v = sca;
    unsigned voffA[2], voffB[2]; int RA[2], CA[2];
#pragma unroll
    for (int i = 0; i < 2; ++i) { int R, C; stage_rc(tid * 16 + i * 8192, R, C); const int Rb = Epi::PERM ? ((R & ~31) + perm32(R & 31)) : R;
        RA[i] = R; CA[i] = C; voffA[i] = (unsigned)(R * ldab + C * 2); voffB[i] = (unsigned)(Rb * Kb + C * 2); }
    const size_t kstep = (size_t)(BK * 2);
    const size_t hstepA = (size_t)HALF * ldab, hstepB = (size_t)HALF * Kb;
    const unsigned ldsw = (unsigned)wid * 1024u;
    const int aoff = lds_byte(wr * 64 + fr, fq * 8), boff = lds_byte(wc * 32 + fr, fq * 8);
#define PG8_SA(b, h) (((b) * 2 + (h)) * HTB)
#define PG8_SB(b, h) ((4 + (b) * 2 + (h)) * HTB)
#define PG8_GLDS(bufoff, gptr, i_) __builtin_amdgcn_global_load_lds((const unsigned*)(gptr), (LAS unsigned*)(lds + (bufoff) + ldsw + (i_) * 8192), 16, 0, 0)
#define PG8_STAGE_B(bufoff, gbase) do { _Pragma("unroll") for (int _i = 0; _i < 2; ++_i) PG8_GLDS(bufoff, (const char*)(gbase) + voffB[_i], _i); } while (0)
#define PG8_STAGE_A(bufoff, ab, kb, h, NX) do { _Pragma("unroll") for (int _i = 0; _i < 2; ++_i) { \
        if constexpr (GATHER) { const unsigned _vo = (NX) ? voN[h][_i] : voC[h][_i]; PG8_GLDS(bufoff, (ab) + (kb) + _vo, _i); } \
        else { PG8_GLDS(bufoff, (ab) + (kb) + (size_t)(h) * hstepA + voffA[_i], _i); } } } while (0)
#define PG8_LDA(dst, b, h) do { _Pragma("unroll") for (int m = 0; m < 4; ++m) _Pragma("unroll") for (int k = 0; k < 2; ++k) dst[m][k] = *(const LAS bf16x8*)(lds + PG8_SA(b, h) + aoff + m * 2048 + k * 1024); } while (0)
#define PG8_LDB(dst, b, h) do { _Pragma("unroll") for (int n = 0; n < 2; ++n) _Pragma("unroll") for (int k = 0; k < 2; ++k) dst[n][k] = *(const LAS bf16x8*)(lds + PG8_SB(b, h) + boff + n * 2048 + k * 1024); } while (0)
#define PG8_MMA(ai, bj, At, Bt) do { __builtin_amdgcn_s_setprio(1); _Pragma("unroll") for (int m = 0; m < 4; ++m) _Pragma("unroll") for (int n = 0; n < 2; ++n) { \
        if constexpr (FP8) { const v8i_t b8 = __builtin_shufflevector(__builtin_bit_cast(v4i_t, Bt[n][0]), __builtin_bit_cast(v4i_t, Bt[n][1]), 0, 1, 2, 3, 4, 5, 6, 7), a8 = __builtin_shufflevector(__builtin_bit_cast(v4i_t, At[m][0]), __builtin_bit_cast(v4i_t, At[m][1]), 0, 1, 2, 3, 4, 5, 6, 7); \
            asm volatile("v_mfma_scale_f32_16x16x128_f8f6f4 %0, %1, %2, %0, %3, %4 op_sel_hi:[0,0,0]" : "+v"(acc[ai][bj][m][n]) : "v"(b8), "v"(a8), "v"(scw_v), "v"(sca_v)); } \
        else { _Pragma("unroll") for (int k = 0; k < 2; ++k) acc[ai][bj][m][n] = __builtin_amdgcn_mfma_f32_16x16x32_bf16(Bt[n][k], At[m][k], acc[ai][bj][m][n], 0, 0, 0); } } __builtin_amdgcn_s_setprio(0); } while (0)
#define PG8_WAIT_V(n) asm volatile("s_waitcnt vmcnt(" #n ")" ::: "memory")
#define PG8_WAIT_L(n) asm volatile("s_waitcnt lgkmcnt(" #n ")" ::: "memory")
#define PG8_BAR __builtin_amdgcn_s_barrier()
#define PG8_SCHED __builtin_amdgcn_sched_barrier(0)
    Unit cur, nxt, pend; int ui = 0; bool have_pend = false;
    if (!S.next(0, cur)) return;
    pend = cur;
    unsigned voC[2][2], voN[2][2];
    if constexpr (GATHER) {
#pragma unroll
        for (int h = 0; h < 2; ++h)
#pragma unroll
            for (int i = 0; i < 2; ++i) { voC[h][i] = (unsigned)(S.gather(cur, h * HALF + RA[i]) * ldab + CA[i] * 2); voN[h][i] = voC[h][i]; }
    } else { voC[0][0] = voN[0][0] = 0u; }
    f32x4 acc[2][2][4][2];
#pragma unroll
    for (int a = 0; a < 2; ++a)
#pragma unroll
        for (int b = 0; b < 2; ++b)
#pragma unroll
            for (int m = 0; m < 4; ++m)
#pragma unroll
                for (int n = 0; n < 2; ++n) acc[a][b][m][n] = (f32x4){0.f, 0.f, 0.f, 0.f};
    bf16x8 At[4][2], B0[2][2], B1[2][2];
    const char* cA = cur.A; const char* cB = cur.B;
    S.a_ready(cur, wid);
    PG8_STAGE_B(PG8_SB(0, 0), cB); PG8_STAGE_B(PG8_SB(0, 1), cB + hstepB); PG8_STAGE_A(PG8_SA(0, 0), cA, (size_t)0, 0, false); PG8_STAGE_A(PG8_SA(0, 1), cA, (size_t)0, 1, false);
    if (wr == 1) PG8_BAR;
    PG8_WAIT_V(2); PG8_BAR;
    PG8_STAGE_B(PG8_SB(1, 0), cB + kstep); PG8_STAGE_A(PG8_SA(1, 0), cA, kstep, 0, false); PG8_STAGE_B(PG8_SB(1, 1), cB + hstepB + kstep);
    PG8_WAIT_V(6); PG8_BAR;
    for (;;) {
        const bool has_next = S.next(ui + 1, nxt);
        if constexpr (GATHER) { if (has_next) {
#pragma unroll
            for (int h = 0; h < 2; ++h)
#pragma unroll
                for (int i = 0; i < 2; ++i) voN[h][i] = (unsigned)(S.gather(nxt, h * HALF + RA[i]) * ldab + CA[i] * 2); } }
        const char* nA = has_next ? nxt.A : cA; const char* nB = has_next ? nxt.B : cB;
        for (int t = 0; t < nt; t += 2) {
            const bool last = (t == nt - 2);
            const size_t k1 = (size_t)(t + 1) * kstep;
            const char* a2 = last ? nA : cA; const size_t k2 = last ? (size_t)0 : (size_t)(t + 2) * kstep; const size_t k3 = k2 + kstep;
            const char* b2 = last ? nB : cB + (size_t)(t + 2) * kstep; const char* b3 = b2 + kstep;
            const bool nx = GATHER ? (last && has_next) : false;
            if (last && has_next) S.a_ready(nxt, wid);
            PG8_LDB(B0, 0, 0); PG8_LDB(B1, 0, 1); PG8_SCHED; PG8_LDA(At, 0, 0); PG8_STAGE_A(PG8_SA(1, 1), cA, k1, 1, false);
            PG8_WAIT_V(8); PG8_WAIT_L(0); PG8_BAR; PG8_MMA(0, 0, At, B0); PG8_MMA(0, 1, At, B1); PG8_BAR; PG8_SCHED;
            PG8_LDA(At, 0, 1); PG8_STAGE_B(PG8_SB(0, 0), b2); PG8_STAGE_B(PG8_SB(0, 1), b2 + hstepB); PG8_STAGE_A(PG8_SA(0, 0), a2, k2, 0, nx);
            PG8_WAIT_V(8); PG8_WAIT_L(0);
            if (have_pend) { S.done(pend, lane); have_pend = false; }
            PG8_BAR; PG8_MMA(1, 0, At, B0); PG8_MMA(1, 1, At, B1); PG8_BAR; PG8_SCHED;
            PG8_LDB(B0, 1, 0); PG8_LDB(B1, 1, 1); PG8_SCHED; PG8_LDA(At, 1, 0); PG8_STAGE_A(PG8_SA(0, 1), a2, k2, 1, nx);
            PG8_WAIT_V(8); PG8_WAIT_L(0); PG8_BAR; PG8_MMA(0, 0, At, B0); PG8_MMA(0, 1, At, B1); PG8_BAR; PG8_SCHED;
            PG8_LDA(At, 1, 1); PG8_STAGE_B(PG8_SB(1, 0), b3); PG8_STAGE_B(PG8_SB(1, 1), b3 + hstepB); PG8_STAGE_A(PG8_SA(1, 0), a2, k3, 0, nx);
            PG8_WAIT_V(8); PG8_WAIT_L(0); PG8_BAR; PG8_MMA(1, 0, At, B0); PG8_MMA(1, 1, At, B1); PG8_BAR; PG8_SCHED;
        }
        if (wr == 0) PG8_BAR;
        if constexpr (FP8) asm volatile("s_nop 15\n\ts_nop 15" ::: "memory");
        E(acc, cur, wr, wc, fr, fq);
        pend = cur; have_pend = true;
        if (!has_next) break;
#pragma unroll
        for (int a = 0; a < 2; ++a)
#pragma unroll
            for (int b = 0; b < 2; ++b)
#pragma unroll
                for (int m = 0; m < 4; ++m)
#pragma unroll
                    for (int n = 0; n < 2; ++n) acc[a][b][m][n] = (f32x4){0.f, 0.f, 0.f, 0.f};
        cur = nxt; cA = nA; cB = nB; ++ui;
        if constexpr (GATHER) {
#pragma unroll
            for (int h = 0; h < 2; ++h)
#pragma unroll
                for (int i = 0; i < 2; ++i) voC[h][i] = voN[h][i]; }
        if (wr == 1) PG8_BAR;
    }
    PG8_WAIT_V(0);
    if (have_pend) S.done(pend, lane);
    PG8_BAR;
#undef PG8_SA
#undef PG8_SB
#undef PG8_GLDS
#undef PG8_STAGE_A
#undef PG8_STAGE_B
#undef PG8_LDA
#undef PG8_LDB
#undef PG8_MMA
#undef PG8_WAIT_V
#undef PG8_WAIT_L
#undef PG8_BAR
#undef PG8_SCHED
}
}
#include <hip/hip_bf16.h>
#include <cmath>
namespace attn_body {
using bf16=__hip_bfloat16;
using bf16x8=__attribute__((ext_vector_type(8)))short;
using s16x4=__attribute__((ext_vector_type(4)))short;
using f32x16=__attribute__((ext_vector_type(16)))float;
using u32x4=__attribute__((ext_vector_type(4)))unsigned;
constexpr int D=64,QP=1024,KVP=256;
constexpr int NW=8,QBLK=32,QB=QBLK*NW,KVBLK=64;
__device__ __forceinline__ int crow(int r,int hi){return (r&3)+8*(r>>2)+4*hi;}
#define SBAR() __builtin_amdgcn_sched_barrier(0)
constexpr int NSLOT=3, SLOTB=8192;
constexpr int LDS_K=0, LDS_V=NSLOT*SLOTB, LDS_WS=2*NSLOT*SLOTB, LDS_OST=LDS_WS+NW*64*4, LDS_BYTES=LDS_OST+NW*4096;
constexpr float C2=0.125f*1.4426950408889634f;
__device__ __forceinline__ void glds16s(const void*sbase,unsigned voff,unsigned lds_dst){unsigned keep;
  asm volatile("s_mov_b32 %0, m0\n\ts_mov_b32 m0, %3\n\ts_nop 4\n\tglobal_load_lds_dwordx4 %1, %2\n\ts_mov_b32 m0, %0":"=&s"(keep):"v"(voff),"s"(sbase),"s"(lds_dst):"memory");}
__device__ __forceinline__ float max3f(float a,float b,float c){float r;asm("v_max3_f32 %0, %1, %2, %3":"=v"(r):"v"(a),"v"(b),"v"(c));return r;}
__device__ __forceinline__ float max2f(float a,float b){float r;asm("v_max_f32_e32 %0, %1, %2":"=v"(r):"v"(a),"v"(b));return r;}
__device__ __forceinline__ float fadd_s(float a,float b){float r;asm("v_add_f32_e32 %0, %1, %2":"=v"(r):"v"(a),"v"(b));return r;}
__device__ __forceinline__ float fsub_s(float a,float b){float r;asm("v_sub_f32_e32 %0, %1, %2":"=v"(r):"v"(a),"v"(b));return r;}
typedef float f32x2_t __attribute__((ext_vector_type(2))); typedef __bf16 bf16x2_t __attribute__((ext_vector_type(2)));
__device__ __forceinline__ unsigned cvtpk_s(float lo,float hi){f32x2_t v={lo,hi};bf16x2_t b=__builtin_convertvector(v,bf16x2_t);return __builtin_bit_cast(unsigned,b);}
#define WAIT_BAR(N) asm volatile("s_waitcnt vmcnt(" #N ") lgkmcnt(0)\n\ts_barrier":::"memory")

__device__ __forceinline__ void qkt(f32x16&p0,f32x16&p1,const char*Kslot,const bf16x8*qr,const f32x16&negm,int r32,int hi){
  const char*kb=Kslot+hi*1024+r32*16;
  #pragma unroll
  for(int d0=0;d0<4;++d0){
    const bf16x8 b0=*reinterpret_cast<const bf16x8*>(kb+d0*2048);
    const bf16x8 b1=*reinterpret_cast<const bf16x8*>(kb+d0*2048+512);
    if(d0==0){p0=__builtin_amdgcn_mfma_f32_32x32x16_bf16(b0,qr[0],negm,0,0,0);p1=__builtin_amdgcn_mfma_f32_32x32x16_bf16(b1,qr[0],negm,0,0,0);}
    else{p0=__builtin_amdgcn_mfma_f32_32x32x16_bf16(b0,qr[d0],p0,0,0,0);p1=__builtin_amdgcn_mfma_f32_32x32x16_bf16(b1,qr[d0],p1,0,0,0);}}
}
typedef __attribute__((address_space(3))) const char* lds_cptr;
typedef short v4i16_t __attribute__((ext_vector_type(4)));
__device__ __forceinline__ void kload8(bf16x8*kf,lds_cptr kp){
  kf[0]=*(const __attribute__((address_space(3))) bf16x8*)(kp);      kf[1]=*(const __attribute__((address_space(3))) bf16x8*)(kp+512);
  kf[2]=*(const __attribute__((address_space(3))) bf16x8*)(kp+2048); kf[3]=*(const __attribute__((address_space(3))) bf16x8*)(kp+2560);
  kf[4]=*(const __attribute__((address_space(3))) bf16x8*)(kp+4096); kf[5]=*(const __attribute__((address_space(3))) bf16x8*)(kp+4608);
  kf[6]=*(const __attribute__((address_space(3))) bf16x8*)(kp+6144); kf[7]=*(const __attribute__((address_space(3))) bf16x8*)(kp+6656);
}
__device__ __forceinline__ void kload2(bf16x8*kf,lds_cptr kp,int j){ kf[2*j]=*(const __attribute__((address_space(3))) bf16x8*)(kp+j*2048); kf[2*j+1]=*(const __attribute__((address_space(3))) bf16x8*)(kp+j*2048+512); }
__device__ __forceinline__ s16x4 vtr(lds_cptr p){ return __builtin_bit_cast(s16x4,__builtin_amdgcn_ds_read_tr16_b64_v4i16((__attribute__((address_space(3))) v4i16_t*)p)); }
__device__ __forceinline__ float rowmax(const f32x16&p0,const f32x16&p1){
  float a=max3f(p0[0],p0[1],p1[0]),b=max3f(p0[2],p0[3],p1[1]);a=max3f(a,p1[2],p1[3]);
  #pragma unroll
  for(int r=4;r<16;r+=4){a=max3f(a,p0[r],p0[r+1]);b=max3f(b,p0[r+2],p0[r+3]);a=max3f(a,p1[r],p1[r+1]);b=max3f(b,p1[r+2],p1[r+3]);}
  const float m=max2f(a,b);
  auto rr=__builtin_amdgcn_permlane32_swap(__float_as_uint(m),__float_as_uint(m),false,false);
  return max2f(__uint_as_float(rr[0]),__uint_as_float(rr[1]));
}
__device__ __forceinline__ void pv(f32x16*o,int vb,bf16x8 pa0,bf16x8 pa1,bf16x8 pa2,bf16x8 pa3){
  #pragma unroll
  for(int d0=0;d0<2;++d0){s16x4 lo[4],hi[4];
    #pragma unroll
    for(int ks=0;ks<4;++ks){
      asm volatile("ds_read_b64_tr_b16 %0,%1 offset:%c2":"=&v"(lo[ks]):"v"(vb),"i"(d0*4096+ks*1024):"memory");
      asm volatile("ds_read_b64_tr_b16 %0,%1 offset:%c2":"=&v"(hi[ks]):"v"(vb),"i"(d0*4096+ks*1024+512):"memory");}
    asm volatile("s_waitcnt lgkmcnt(0)":::"memory");SBAR();
    #define PK(k) (bf16x8){lo[k][0],lo[k][1],lo[k][2],lo[k][3],hi[k][0],hi[k][1],hi[k][2],hi[k][3]}
    o[d0]=__builtin_amdgcn_mfma_f32_32x32x16_bf16(pa0,PK(0),o[d0],0,0,0);
    o[d0]=__builtin_amdgcn_mfma_f32_32x32x16_bf16(pa1,PK(1),o[d0],0,0,0);
    o[d0]=__builtin_amdgcn_mfma_f32_32x32x16_bf16(pa2,PK(2),o[d0],0,0,0);
    o[d0]=__builtin_amdgcn_mfma_f32_32x32x16_bf16(pa3,PK(3),o[d0],0,0,0);
    #undef PK
  }
}

#ifndef ATTN_STORE16
#define ATTN_STORE16(p,v) (*(u32x4*)(p)=(v))
#endif
template<int THRL> __device__ __forceinline__ void attn_unit(long qrow0,int h,long kvrow0,int NT,const bf16*Q,const bf16*__restrict__ K,const bf16*__restrict__ V,bf16*O,char*shm){
  const int tid=tid_opaque(),lane=tid&63,r32=lane&31,hi=lane>>5; const int wid=__builtin_amdgcn_readfirstlane(tid>>6);
  const bf16*Qw=Q+(qrow0+wid*QBLK)*QP+h*D;
  const bf16*Kh=K+kvrow0*KVP+(h>>2)*D,*Vh=V+kvrow0*KVP+(h>>2)*D;
  const unsigned lds0=(unsigned)(uintptr_t)shm;
  float*wsf=(float*)(shm+LDS_WS)+wid*64;
  const unsigned kvo=(unsigned)(lane*KVP+wid*8)*2u;
  const unsigned vvo=(unsigned)((16*(wid&3)+(lane>>2))*KVP+(wid>>2)*32+(lane&3)*8)*2u;
  const unsigned kdst=lds0+LDS_K+wid*1024, vdst=lds0+LDS_V+wid*1024;
  #define DMA_K(t,slot) glds16s(Kh+(long)(t)*KVBLK*KVP,kvo,(unsigned)__builtin_amdgcn_readfirstlane(kdst+(slot)))
  #define DMA_V(t,slot) glds16s(Vh+(long)(t)*KVBLK*KVP,vvo,(unsigned)__builtin_amdgcn_readfirstlane(vdst+(slot)))
  const int vb0=(int)(lds0+LDS_V)+((lane>>4)&1)*32+(lane&3)*8+(4*hi+((lane&15)>>2))*64;
  const char*Kbase=shm+LDS_K; bf16x8 kf[8];
  const lds_cptr shm3=(lds_cptr)shm; const lds_cptr kp0=shm3+LDS_K+hi*1024+r32*16; const lds_cptr vp0=shm3+LDS_V+((lane>>4)&1)*32+(lane&3)*8+(4*hi+((lane&15)>>2))*64;
  DMA_K(0,0);DMA_V(0,0);DMA_K(1,SLOTB);
  bf16x8 qr[4];
  #pragma unroll
  for(int d0=0;d0<4;++d0)qr[d0]=*reinterpret_cast<const bf16x8*>(&Qw[(long)r32*QP+d0*16+hi*8]);
  float mhat=0.f,l_reg=0.f;f32x16 o[2];o[0]=f32x16{};o[1]=f32x16{};f32x16 negm=f32x16{};asm volatile("":"+v"(negm));
  #define CMASK(P0,P1,t) do{}while(0)
  bool resc=false;
  #define START(P0,P1) do{ const float rm=rowmax(P0,P1); resc=false; \
    { const float dl=rm; mhat=fadd_s(mhat,dl); \
      _Pragma("unroll") for(int r=0;r<16;++r){P0[r]=fsub_s(P0[r],dl);P1[r]=fsub_s(P1[r],dl);} \
      _Pragma("unroll") for(int r=0;r<16;++r)negm[r]=-mhat; asm volatile("":"+v"(negm)); } \
    _Pragma("unroll") for(int r=0;r<16;++r)P0[r]=__builtin_amdgcn_exp2f(P0[r]); }while(0)
  #define RESC() do{ if(resc){ asm volatile("s_waitcnt lgkmcnt(0)":::"memory"); \
      _Pragma("unroll") for(int d_=0;d_<2;++d_) _Pragma("unroll") for(int r=0;r<16;++r)o[d_][r]*=wsf[crow(r,hi)]; } }while(0)
  f32x16 pA0,pA1,pB0,pB1;
  int sl_prev=0,sl_cur=0,sl_next=SLOTB;
  #define ROT() do{sl_prev=sl_cur;sl_cur=sl_next;sl_next=(sl_next==(NSLOT-1)*SLOTB)?0:sl_next+SLOTB;}while(0)
  DMA_K(2,2*SLOTB);
  WAIT_BAR(3);
  qkt(pA0,pA1,Kbase,qr,negm,r32,hi);asm volatile("s_nop 15\n\ts_nop 7":"+v"(pA0),"+v"(pA1));CMASK(pA0,pA1,0);
  START(pA0,pA1);
  _Pragma("unroll") for(int r=0;r<16;++r)pA1[r]=__builtin_amdgcn_exp2f(pA1[r]);
  WAIT_BAR(0);
  DMA_K(3,0);DMA_V(1,SLOTB);
  ROT();
  kload8(kf,kp0+sl_cur);
  WAIT_BAR(2);
  s16x4 vlo[8],vhi[8]; u32x4 pw0,pw1,pw2,pw3;
  #define PKW(P,B) cvtpk_s(P[B],P[B+1])
  #define PAF(k) __builtin_bit_cast(bf16x8,pw##k)
  #define VFR(i) (bf16x8){vlo[i][0],vlo[i][1],vlo[i][2],vlo[i][3],vhi[i][0],vhi[i][1],vhi[i][2],vhi[i][3]}
  #define PIN(x) asm volatile("":"+v"(x))
  #define MX3(a,b,c) __builtin_fmaxf(__builtin_fmaxf((a),(b)),(c))
  #define GAPA(MF,A0,A1,A2,A3,W0,W1,PW) do{ MF; sacc+=A0; sacc+=A1; sacc+=A2; sacc+=A3; PIN(sacc); W0; W1; PIN(PW); SBAR(); }while(0)
  #define EX(v) __builtin_amdgcn_exp2f(v)
  #define GAPB(MF,X,B) do{ MF; X[B]=EX(X[B]); X[B+1]=EX(X[B+1]); X[B+2]=EX(X[B+2]); X[B+3]=EX(X[B+3]); PIN(X); SBAR(); }while(0)
  #define VRD(i) do{ vlo[i]=vtr(vp_+(((i)>>2)*4096+((i)&3)*1024)); vhi[i]=vtr(vp_+(((i)>>2)*4096+((i)&3)*1024+512)); }while(0)
  #define KRD(G,j) do{ if(G){ kload2(kf,kp0+sl_next,j); SBAR(); } }while(0)
  #define STEP(C0,C1,P0,P1,t,GK,GV,GL) do{ SBAR(); \
    const lds_cptr vp_=vp0+sl_prev; \
    VRD(0); SBAR(); float sacc=(P0[0]+P0[1]); \
    GAPA(C0=__builtin_amdgcn_mfma_f32_32x32x16_bf16(kf[0],qr[0],negm,0,0,0), P0[2],P0[3],P0[4],P0[5],     pw0[0]=PKW(P0,0), pw0[1]=PKW(P0,2), pw0); \
    VRD(4); SBAR(); GAPA(C1=__builtin_amdgcn_mfma_f32_32x32x16_bf16(kf[1],qr[0],negm,0,0,0), P0[6],P0[7],P0[8],P0[9],     pw0[2]=PKW(P0,4), pw0[3]=PKW(P0,6), pw0); \
    VRD(1); SBAR(); GAPA(C0=__builtin_amdgcn_mfma_f32_32x32x16_bf16(kf[2],qr[1],C0,0,0,0),   P0[10],P0[11],P0[12],P0[13], pw1[0]=PKW(P0,8), pw1[1]=PKW(P0,10), pw1); \
    VRD(5); SBAR(); GAPA(C1=__builtin_amdgcn_mfma_f32_32x32x16_bf16(kf[3],qr[1],C1,0,0,0),   P0[14],P0[15],P1[0],P1[1],   pw1[2]=PKW(P0,12),pw1[3]=PKW(P0,14), pw1); \
    VRD(2); SBAR(); GAPA(C0=__builtin_amdgcn_mfma_f32_32x32x16_bf16(kf[4],qr[2],C0,0,0,0),   P1[2],P1[3],P1[4],P1[5],     pw2[0]=PKW(P1,0), pw2[1]=PKW(P1,2), pw2); \
    VRD(6); SBAR(); GAPA(C1=__builtin_amdgcn_mfma_f32_32x32x16_bf16(kf[5],qr[2],C1,0,0,0),   P1[6],P1[7],P1[8],P1[9],     pw2[2]=PKW(P1,4), pw2[3]=PKW(P1,6), pw2); \
    VRD(3); SBAR(); GAPA(C0=__builtin_amdgcn_mfma_f32_32x32x16_bf16(kf[6],qr[3],C0,0,0,0),   P1[10],P1[11],P1[12],P1[13], pw3[0]=PKW(P1,8), pw3[1]=PKW(P1,10), pw3); \
    VRD(7); SBAR(); GAPA(C1=__builtin_amdgcn_mfma_f32_32x32x16_bf16(kf[7],qr[3],C1,0,0,0),   P1[14],P1[15],0.f,0.f,       pw3[2]=PKW(P1,12),pw3[3]=PKW(P1,14), pw3); \
    l_reg+=sacc; \
    if(GK){DMA_K((t)+3,sl_cur);} if(GV){DMA_V((t)+1,sl_next);} \
    CMASK(C0,C1,t); \
    { float a=MX3(C0[0],C0[1],C1[0]),b=MX3(C0[2],C0[3],C1[1]); a=MX3(a,C1[2],C1[3]); \
      _Pragma("unroll") for(int r=4;r<16;r+=4){a=MX3(a,C0[r],C0[r+1]);b=MX3(b,C0[r+2],C0[r+3]);a=MX3(a,C1[r],C1[r+1]);b=MX3(b,C1[r+2],C1[r+3]);} \
      float rm=__builtin_fmaxf(a,b); { auto rr=__builtin_amdgcn_permlane32_swap(__float_as_uint(rm),__float_as_uint(rm),false,false); rm=__builtin_fmaxf(__uint_as_float(rr[0]),__uint_as_float(rr[1])); } \
      resc=false; \
      if(__builtin_expect(__any(rm>(float)THRL),0)){ const float dl=__builtin_fmaxf(rm,0.f); mhat+=dl; \
        _Pragma("unroll") for(int r=0;r<16;++r){C0[r]-=dl;C1[r]-=dl;} \
        _Pragma("unroll") for(int r=0;r<16;++r)negm[r]=-mhat; asm volatile("":"+v"(negm)); \
        const float f=__builtin_amdgcn_exp2f(-dl); l_reg*=f; if(hi==0)wsf[r32]=f; resc=true; } } \
    SBAR(); \
    GAPB(o[0]=__builtin_amdgcn_mfma_f32_32x32x16_bf16(PAF(0),VFR(0),o[0],0,0,0), C0,0); \
    GAPB(o[1]=__builtin_amdgcn_mfma_f32_32x32x16_bf16(PAF(0),VFR(4),o[1],0,0,0), C0,4); \
    KRD(GL,0); GAPB(o[0]=__builtin_amdgcn_mfma_f32_32x32x16_bf16(PAF(1),VFR(1),o[0],0,0,0), C0,8); \
    KRD(GL,1); GAPB(o[1]=__builtin_amdgcn_mfma_f32_32x32x16_bf16(PAF(1),VFR(5),o[1],0,0,0), C0,12); \
    KRD(GL,2); GAPB(o[0]=__builtin_amdgcn_mfma_f32_32x32x16_bf16(PAF(2),VFR(2),o[0],0,0,0), C1,0); \
    KRD(GL,3); GAPB(o[1]=__builtin_amdgcn_mfma_f32_32x32x16_bf16(PAF(2),VFR(6),o[1],0,0,0), C1,4); \
    GAPB(o[0]=__builtin_amdgcn_mfma_f32_32x32x16_bf16(PAF(3),VFR(3),o[0],0,0,0), C1,8); \
    GAPB(o[1]=__builtin_amdgcn_mfma_f32_32x32x16_bf16(PAF(3),VFR(7),o[1],0,0,0), C1,12); \
    }while(0)
  int t=1;
  for(;t+5<NT;t+=2){
    STEP(pB0,pB1,pA0,pA1,t,true,true,true);     WAIT_BAR(2); RESC(); ROT();
    STEP(pA0,pA1,pB0,pB1,t+1,true,true,true);   WAIT_BAR(2); RESC(); ROT();
  }
  #define ENDW(tt) do{ if((tt)+3<NT){WAIT_BAR(2);} else if((tt)+2<NT){WAIT_BAR(1);} else {WAIT_BAR(0);} }while(0)
  for(;t+1<NT;t+=2){
    STEP(pB0,pB1,pA0,pA1,t,(t+3<NT),(t+1<NT),(t+1<NT));       ENDW(t);   RESC(); ROT();
    STEP(pA0,pA1,pB0,pB1,t+1,(t+4<NT),(t+2<NT),(t+2<NT));     ENDW(t+1); RESC(); ROT();
  }
  STEP(pB0,pB1,pA0,pA1,NT-1,false,false,false); RESC();
  { float sacc=pB0[0]+pB0[1]; _Pragma("unroll") for(int r=2;r<16;++r)sacc+=pB0[r]; _Pragma("unroll") for(int r=0;r<16;++r)sacc+=pB1[r]; l_reg+=sacc;
    pw0=(u32x4){PKW(pB0,0),PKW(pB0,2),PKW(pB0,4),PKW(pB0,6)};pw1=(u32x4){PKW(pB0,8),PKW(pB0,10),PKW(pB0,12),PKW(pB0,14)};pw2=(u32x4){PKW(pB1,0),PKW(pB1,2),PKW(pB1,4),PKW(pB1,6)};pw3=(u32x4){PKW(pB1,8),PKW(pB1,10),PKW(pB1,12),PKW(pB1,14)};
    SBAR(); pv(o,vb0+sl_cur,PAF(0),PAF(1),PAF(2),PAF(3)); }
  #undef PKW
  #undef PAF
  #undef VFR
  #undef PIN
  #undef MX3
  #undef GAPA
  #undef GAPB
  #undef EX
  #undef VRD
  #undef KRD
  #undef STEP
  #undef ENDW
  {auto rr=__builtin_amdgcn_permlane32_swap(__float_as_uint(l_reg),__float_as_uint(l_reg),false,false);l_reg=__uint_as_float(rr[0])+__uint_as_float(rr[1]);}
  if(hi==0)wsf[32+r32]=l_reg;asm volatile("s_waitcnt lgkmcnt(0)":::"memory");
  float rli[16];
  #pragma unroll
  for(int r=0;r<16;++r)rli[r]=__builtin_amdgcn_rcpf(wsf[32+crow(r,hi)]);
#if ATT_FP8
  { unsigned char*Ow8=(unsigned char*)O+(qrow0+wid*QBLK)*QP+h*D;
    unsigned char*stg8=(unsigned char*)(shm+LDS_OST)+wid*4096;
    #pragma unroll
    for(int r=0;r<16;++r){const int orow=crow(r,hi);
      #pragma unroll
      for(int d0=0;d0<2;++d0){const float x=o[d0][r]*rli[r]*(float)(1<<ATT_OSH); stg8[orow*64+d0*32+r32]=(unsigned char)(__builtin_amdgcn_cvt_pk_fp8_f32(x,x,0u,false)&0xffu);}}
    asm volatile("s_waitcnt lgkmcnt(0)":::"memory");
    #pragma unroll
    for(int i=0;i<2;++i){const int row=i*16+(lane>>2),ch=lane&3; const u32x4 v=*(const u32x4*)(stg8+row*64+ch*16); ATTN_STORE16(Ow8+(long)row*QP+ch*16,v);} }
#else
  bf16*Ow=O+(qrow0+wid*QBLK)*QP+h*D;
  { bf16*stg=(bf16*)(shm+LDS_OST)+wid*2048;
    #pragma unroll
    for(int r=0;r<16;++r){const int orow=crow(r,hi);
      #pragma unroll
      for(int d0=0;d0<2;++d0)stg[orow*64+d0*32+r32]=__float2bfloat16(o[d0][r]*rli[r]);}
    asm volatile("s_waitcnt lgkmcnt(0)":::"memory");
    #pragma unroll
    for(int i=0;i<4;++i){const int row=i*8+(lane>>3),ch=lane&7; const u32x4 v=*(const u32x4*)(stg+row*64+ch*8); ATTN_STORE16(Ow+(long)row*QP+ch*8,v);} }
#endif
  asm volatile("s_waitcnt lgkmcnt(0)\n\ts_barrier":::"memory");
  #undef DMA_K
  #undef DMA_V
  #undef CMASK
  #undef START
  #undef RESC
  #undef ROT
}
constexpr int ATTN_LDS_BYTES=LDS_BYTES;
#undef SBAR
#undef WAIT_BAR
}

typedef f32x4 AccT[2][2][4][2];
__device__ __forceinline__ long kv_row(int r) { return r < TL ? (long)(r / SEQ) * KVROWS + CTXL + (r % SEQ) : (long)((r - TL) / CTXL) * KVROWS + ((r - TL) % CTXL); }

struct SchedDense {
    const char* A; const char* B; size_t astep, bstep, acol; int nM, nN, G, c;
    __device__ __forceinline__ bool next(int i, pg8::Unit& u) const {
        const int L = i * G + c; if (L >= nM * nN) return false;
        pg8::tile_of(L, nM, nN, u.pm, u.pn); u.A = A + (size_t)u.pm * astep + (size_t)u.pn * acol; u.B = B + (size_t)u.pn * bstep; u.x0 = 0; u.x1 = 0; return true; }
    __device__ __forceinline__ int gather(const pg8::Unit&, int) const { return 0; }
    __device__ __forceinline__ void a_ready(const pg8::Unit&, int) const {}
    __device__ __forceinline__ void done(const pg8::Unit&, int) const {}
};
struct SchedQKV {
    const char* A; const char* B; size_t tstep; int ctxq, G, c;
    __device__ __forceinline__ bool next(int i, pg8::Unit& u) const {
        const int L = i * G + c, n1 = 64 * 6, n2 = ctxq ? 24 : 8; if (L >= n1 + n2) return false;
        if (L < n1) pg8::tile_of(L, 64, 6, u.pm, u.pn);
        else if (ctxq) { pg8::tile_of(L - n1, 4, 6, u.pm, u.pn); u.pm += 64; }
        else { u.pm = 64 + ((L - n1) >> 1); u.pn = 4 + ((L - n1) & 1); }
        u.A = A + (size_t)u.pm * tstep; u.B = B + (size_t)u.pn * tstep; u.x0 = 0; u.x1 = 0; return true; }
    __device__ __forceinline__ int gather(const pg8::Unit&, int) const { return 0; }
    __device__ __forceinline__ void a_ready(const pg8::Unit&, int) const {}
    __device__ __forceinline__ void done(const pg8::Unit&, int) const {}
};
struct SchedMoe {
    const char* Abase; size_t astep; const char* Bbase; size_t bstep_e, bstep_n; const LAS int* tab; const int* list; int G, c;
    unsigned* ready; int mode;
    __device__ __forceinline__ int T(int i) const { return __builtin_amdgcn_readfirstlane(tab[i]); }
    __device__ __forceinline__ bool next(int i, pg8::Unit& u) const {
        const int ntiles = T(32), L = i * G + (mode == 2 ? G - 1 - c : c); if (L >= ntiles * 4) return false;
        int gt, pn; pg8::tile_of(L, ntiles, 4, gt, pn);
        int e = 0;
        for (int q = 1; q < 32; ++q) e += (T(q) <= gt) ? 1 : 0;
        const int ti = gt - T(e); int valid = T(40 + e) - ti * 256; valid = valid > 256 ? 256 : valid;
        u.pm = gt; u.pn = pn; u.x0 = e * MOE_CAP + ti * 256; u.x1 = valid;
        u.A = Abase + (size_t)gt * astep; u.B = Bbase + (size_t)e * bstep_e + (size_t)pn * bstep_n; return true; }
    __device__ __forceinline__ int gather(const pg8::Unit& u, int lr) const { return lr < u.x1 ? (list[u.x0 + lr] >> 1) : 0; }
    __device__ __forceinline__ void a_ready(const pg8::Unit& u, int wid) const {
        if (mode != 2) return;
        if (wid == 0) { unsigned sp = 0;
            while ((unsigned)__builtin_amdgcn_readfirstlane(__hip_atomic_load(ready + u.pm, __ATOMIC_RELAXED, __HIP_MEMORY_SCOPE_AGENT)) < 32u) { __builtin_amdgcn_s_sleep(2); if (++sp > (1u << 22)) break; }
            __builtin_amdgcn_fence(__ATOMIC_ACQUIRE, "agent"); asm volatile("s_waitcnt vmcnt(0)" ::: "memory"); }
        __builtin_amdgcn_s_barrier(); asm volatile("" ::: "memory");
    }
    __device__ __forceinline__ void done(const pg8::Unit& u, int lane) const {
        if (mode != 1) return;
        if (lane == 0) __hip_atomic_fetch_add(ready + u.pm, 1u, __ATOMIC_RELAXED, __HIP_MEMORY_SCOPE_AGENT);
    }
};

struct EpiQKV { static constexpr bool PERM = true; bf16* Q; bf16* Kb; bf16* Vb; const float* qg; const float* kg; const f32x2* tab;
    __device__ __forceinline__ void operator()(const AccT& acc, const pg8::Unit& u, int wr, int wc, int fr, int fq) const {
        bf16* base; int pitch; long row0;
        if (u.pn < 4) { base = Q + u.pn * 256; pitch = 1024; row0 = (long)u.pm * 256; }
        else { base = (u.pn == 4) ? Kb : Vb; pitch = 256; row0 = kv_row(u.pm * 256); }
        const bool isv = u.pn == 5, lat = u.pm < 64; const float* g = u.pn < 4 ? qg : kg; const float post = u.pn < 4 ? 0.125f * 1.4426950408889634f : 1.0f;
#pragma unroll
        for (int ai = 0; ai < 2; ++ai)
#pragma unroll
            for (int m = 0; m < 4; ++m) { int fq_ = fq; asm volatile("" : "+v"(fq_));
                const int fq = fq_; const int lr = ai * 128 + wr * 64 + m * 16 + fr; const unsigned roff = (unsigned)(((int)row0 + lr) * pitch + wc * 64 + 8 * fq) * 2u;
                f32x4 g0[2], g1[2];
#pragma unroll
                for (int bj = 0; bj < 2; ++bj) { g0[bj] = *(const f32x4*)(g + 32 * bj + 8 * fq); g1[bj] = *(const f32x4*)(g + 32 * bj + 8 * fq + 4); }
                f32x4 v[2][2];
#pragma unroll
                for (int bj = 0; bj < 2; ++bj) { v[bj][0] = acc[ai][bj][m][0]; v[bj][1] = acc[ai][bj][m][1]; }
                if (!isv) {
                    float ss = 0.f;
#pragma unroll
                    for (int bj = 0; bj < 2; ++bj)
#pragma unroll
                        for (int n = 0; n < 2; ++n) ss += (v[bj][n][0] * v[bj][n][0] + v[bj][n][1] * v[bj][n][1]) + (v[bj][n][2] * v[bj][n][2] + v[bj][n][3] * v[bj][n][3]);
                    ss += __shfl_xor(ss, 16); ss += __shfl_xor(ss, 32);
                    const float rstd = rsqrtf(ss * (1.0f / 64.0f) + EPS);
#pragma unroll
                    for (int bj = 0; bj < 2; ++bj) { v[bj][0] = v[bj][0] * rstd * g0[bj]; v[bj][1] = v[bj][1] * rstd * g1[bj]; }
                    if (lat) { const int t = (u.pm * 256 + lr) & (SEQ - 1);
#pragma unroll
                        for (int bj = 0; bj < 2; ++bj) { const f32x2* tb = (const f32x2*)((const char*)tab + (unsigned)(((bj == 0 ? (t >> 6) : (t & 63)) * 16 + 4 * fq) * 8));
#pragma unroll
                            for (int n = 0; n < 2; ++n)
#pragma unroll
                                for (int e = 0; e < 2; ++e) { const f32x2 cs = tb[2 * n + e]; const float x0 = v[bj][n][2 * e], x1 = v[bj][n][2 * e + 1];
                                    v[bj][n][2 * e] = x0 * cs.x - x1 * cs.y; v[bj][n][2 * e + 1] = x0 * cs.y + x1 * cs.x; } } }
#pragma unroll
                    for (int bj = 0; bj < 2; ++bj) { v[bj][0] = v[bj][0] * post; v[bj][1] = v[bj][1] * post; }
                }
#pragma unroll
                for (int bj = 0; bj < 2; ++bj)
                    *(u32x4*)((char*)base + roff + bj * 64) = (u32x4){cvtpk(v[bj][0][0], v[bj][0][1]), cvtpk(v[bj][0][2], v[bj][0][3]), cvtpk(v[bj][1][0], v[bj][1][1]), cvtpk(v[bj][1][2], v[bj][1][3])}; }
    }
};
struct EpiResid { static constexpr bool PERM = false; const Args* a; int layer; const float* pscale; const float* srcbase;
    __device__ __forceinline__ void operator()(const AccT& acc, const pg8::Unit& u, int wr, int wc, int fr, int fq) const {
        const int r0 = u.pm * 256;
        const float* src = srcbase ? srcbase + (size_t)r0 * D : resid_row(*a, layer, r0); const float* gate = mod_row(*a, layer, r0) + 2 * D; float* out = (float*)(a->ws + WS_X) + (size_t)r0 * D;
        const int col0 = u.pn * 256 + wc * 32 + 4 * fq;
#pragma unroll
        for (int bj = 0; bj < 2; ++bj)
#pragma unroll
            for (int n = 0; n < 2; ++n) { const int cc = col0 + bj * 128 + n * 16; f32x4 g = *(const f32x4*)(gate + cc); if (pscale) g = g * *(const f32x4*)(pscale + cc);
#pragma unroll
                for (int ai = 0; ai < 2; ++ai)
#pragma unroll
                    for (int m = 0; m < 4; ++m) { const size_t off = (size_t)(ai * 128 + wr * 64 + m * 16 + fr) * D + cc;
                        *(f32x4*)(out + off) = *(const f32x4*)(src + off) + g * acc[ai][bj][m][n]; } }
    }
};
struct EpiGateUp { static constexpr bool PERM = true; bf16* act;
    __device__ __forceinline__ void operator()(const AccT& acc, const pg8::Unit& u, int wr, int wc, int fr, int fq) const {
        const __amdgpu_buffer_rsrc_t rs = __builtin_amdgcn_make_buffer_rsrc((void*)act, 0, 43008 * 512 * 2, 0x00020000);
#pragma unroll
        for (int ai = 0; ai < 2; ++ai)
#pragma unroll
            for (int m = 0; m < 4; ++m) { const int off = (int)((((size_t)u.pm * 256 + ai * 128 + wr * 64 + m * 16 + fr) * 512 + u.pn * 128 + wc * 32 + 8 * fq) * 2);
                const f32x4 g0 = acc[ai][0][m][0], g1 = acc[ai][0][m][1], u0 = acc[ai][1][m][0], u1 = acc[ai][1][m][1];
                const u32x4 ov = (u32x4){cvtpk(silu_f(g0[0]) * u0[0], silu_f(g0[1]) * u0[1]), cvtpk(silu_f(g0[2]) * u0[2], silu_f(g0[3]) * u0[3]),
                                     cvtpk(silu_f(g1[0]) * u1[0], silu_f(g1[1]) * u1[1]), cvtpk(silu_f(g1[2]) * u1[2], silu_f(g1[3]) * u1[3])};
#if MOE_FP8
                { const float sa = (float)(1 << MOE_ASH); const u32x2 o8 = (u32x2){pk_fp8x4(silu_f(g0[0]) * u0[0] * sa, silu_f(g0[1]) * u0[1] * sa, silu_f(g0[2]) * u0[2] * sa, silu_f(g0[3]) * u0[3] * sa),
                                                                                    pk_fp8x4(silu_f(g1[0]) * u1[0] * sa, silu_f(g1[1]) * u1[1] * sa, silu_f(g1[2]) * u1[2] * sa, silu_f(g1[3]) * u1[3] * sa)};
                  (void)ov; __builtin_amdgcn_raw_buffer_store_b64(o8, rs, off >> 1, 0, 16  ); } }
#else
                __builtin_amdgcn_raw_buffer_store_b128(ov, rs, off, 0, 16  ); }
#endif
    }
};
struct EpiDown { static constexpr bool PERM = true; const int* list; const float* w2; bf16* y2;
    __device__ __forceinline__ void operator()(const AccT& acc, const pg8::Unit& u, int wr, int wc, int fr, int fq) const {
#pragma unroll
        for (int ai = 0; ai < 2; ++ai)
#pragma unroll
            for (int m = 0; m < 4; ++m) { const int lr = ai * 128 + wr * 64 + m * 16 + fr;
                if (lr < u.x1) { const int dest = list[u.x0 + lr]; const float w = w2[dest]; bf16* p = y2 + (size_t)dest * D + u.pn * 256 + wc * 32 + 8 * fq;
#pragma unroll
                    for (int bj = 0; bj < 2; ++bj) { const f32x4 v0 = acc[ai][bj][m][0] * w, v1 = acc[ai][bj][m][1] * w;
                        *(u32x4*)(p + bj * 128) = (u32x4){cvtpk(v0[0], v0[1]), cvtpk(v0[2], v0[3]), cvtpk(v1[0], v1[1]), cvtpk(v1[2], v1[3])}; } } }
    }
};

constexpr int TAB_OFF = 135168;

__device__ __forceinline__ void ph_rope(const Args& a, const Ctx& c, int layer) {
    const int j = layer == 0 ? 0 : 1; const bool ctxq = layer == 0;
    const float* qg = a.in[I_QG] + j * 64; const float* kg = a.in[I_KG] + j * 64;
    const f32x2* tab = (const f32x2*)(a.ws + WS_ROPE);
    bf16* Qb = (bf16*)(a.ws + WS_Q); bf16* Kb = (bf16*)(a.ws + WS_K);
    const int nitems = TT * 20;
    for (int it = blockIdx.x * NTHREADS + c.tid; it < nitems; it += c.G * NTHREADS) {
        const int r = it / 20, hs = it % 20;
        if (hs < 16 && r >= TL && !ctxq) continue;
        bf16* p; const float* g; float post;
        if (hs < 16) { p = Qb + (size_t)r * 1024 + hs * 64; g = qg; post = 0.125f * 1.4426950408889634f; } else { p = Kb + kv_row(r) * 256 + (hs - 16) * 64; g = kg; post = 1.0f; }
        float x[64]; float ss = 0.f;
#pragma unroll
        for (int i = 0; i < 8; ++i) { const u32x4 w = ((const u32x4*)p)[i];
            x[8 * i + 0] = bflo(w.x); x[8 * i + 1] = bfhi(w.x); x[8 * i + 2] = bflo(w.y); x[8 * i + 3] = bfhi(w.y);
            x[8 * i + 4] = bflo(w.z); x[8 * i + 5] = bfhi(w.z); x[8 * i + 6] = bflo(w.w); x[8 * i + 7] = bfhi(w.w); }
#pragma unroll
        for (int i = 0; i < 64; ++i) ss += x[i] * x[i];
        const float rstd = rsqrtf(ss * (1.0f / 64.0f) + EPS);
#pragma unroll
        for (int i = 0; i < 64; ++i) x[i] = x[i] * rstd * g[i];
        if (r < TL) { const int t = r % SEQ, rp = t >> 6, cp = t & 63;
#pragma unroll
            for (int i = 0; i < 32; ++i) { const f32x2 cs = tab[(i < 16 ? rp : cp) * 16 + (i & 15)]; const float x0 = x[2 * i], x1 = x[2 * i + 1];
                x[2 * i] = x0 * cs.x - x1 * cs.y; x[2 * i + 1] = x0 * cs.y + x1 * cs.x; } }
#pragma unroll
        for (int i = 0; i < 8; ++i) ((u32x4*)p)[i] = (u32x4){cvtpk(x[8 * i] * post, x[8 * i + 1] * post), cvtpk(x[8 * i + 2] * post, x[8 * i + 3] * post),
                                                            cvtpk(x[8 * i + 4] * post, x[8 * i + 5] * post), cvtpk(x[8 * i + 6] * post, x[8 * i + 7] * post)};
    }
}

__device__ __forceinline__ void ph_att(const Args& a, const Ctx& c, int layer, char* lds_generic) {
    const int nun = 1024 + (layer == 0 ? 64 : 0);
    const attn_body::bf16* Qb = (const attn_body::bf16*)(a.ws + WS_Q); const attn_body::bf16* Kb = (const attn_body::bf16*)(a.ws + WS_K); const attn_body::bf16* Vb = (const attn_body::bf16*)(a.ws + WS_V);
    for (int U = c.vcu; U < nun; U += c.G) {
        long qrow0, kv0; int h, NT;
        if (U < 1024) { const int bh = U >> 4, qb = U & 15, b = bh >> 4; h = bh & 15; qrow0 = (long)b * SEQ + qb * 256; kv0 = (long)b * KVROWS; NT = KVROWS / 64; }
        else { const int q = U - 1024, b = q >> 4; h = q & 15; qrow0 = (long)TL + b * CTXL; kv0 = (long)b * KVROWS; NT = CTXL / 64; }
        attn_body::attn_unit<8>(qrow0, h, kv0, NT, Qb, Kb, Vb, (attn_body::bf16*)(a.ws + WS_HB), lds_generic);
    }
}

__device__ __forceinline__ void ph_m1(const Args& a, const Ctx& c, int layer) {
    const int Tm = layer == 3 ? TL : TT, ntiles = Tm / 32;
    const float* g = a.in[I_NFFN] + layer * D;
    constexpr int RP = 2064;
    LAS unsigned char* hiT = c.lds; LAS unsigned char* loT = c.lds + 32 * RP;
    LAS float* part = (LAS float*)c.lds;
    LAS int* lcnt = (LAS int*)(c.lds + 133120); LAS int* lbase = lcnt + 32;
    LAS float* logit = (LAS float*)(c.lds + 134144);
    const bf16* wr = (const bf16*)(a.ws + WS_WR) + (size_t)layer * 2 * 65536;
    unsigned* gcnt = (unsigned*)(a.ws + WS_CTL) + CW_CNT + layer * 32;
    int* list = (int*)(a.ws + WS_LIST); float* w2 = (float*)(a.ws + WS_W2);
    const int r32 = c.lane & 31, hi = c.lane >> 5;
    if (c.tid < 32) lcnt[c.tid] = 0;
    f32x4 vv[4][4];
#define M1_LOADROWS(tl) do { _Pragma("unroll") for (int i = 0; i < 4; ++i) { const f32x4* xr = (const f32x4*)((const float*)(a.ws + WS_X) + (size_t)((tl) * 32 + 4 * c.wave + i) * D) + c.lane; \
        _Pragma("unroll") for (int j = 0; j < 4; ++j) vv[i][j] = xr[64 * j]; } } while (0)
    if ((int)blockIdx.x < ntiles) M1_LOADROWS((int)blockIdx.x);
    int nmine = 0;
    for (int tile = blockIdx.x; tile < ntiles; tile += c.G, ++nmine) {
        const int r0 = tile * 32;
        { f32x4 gs[4], sh[4];
          { const float* m = mod_row(a, layer, r0);
#pragma unroll
            for (int j = 0; j < 4; ++j) { gs[j] = ((const f32x4*)g)[c.lane + 64 * j] * (((const f32x4*)(m + 4 * D))[c.lane + 64 * j] + 1.0f); sh[j] = ((const f32x4*)(m + 3 * D))[c.lane + 64 * j]; } }
#pragma unroll
          for (int i = 0; i < 4; ++i) { const int lr = 4 * c.wave + i, r = r0 + lr;
            f32x4 h[4];
            const float rstd = row_rstd(vv[i]);
#pragma unroll
            for (int j = 0; j < 4; ++j) h[j] = (vv[i][j] * rstd) * gs[j] + sh[j];
#if MOE_FP8
            unsigned* to8 = (unsigned*)((unsigned char*)(a.ws + WS_TK) + (size_t)r * D) + c.lane;
#else
            u32x2* to = (u32x2*)((bf16*)(a.ws + WS_TK) + (size_t)r * D) + c.lane;
#endif
#pragma unroll
            for (int j = 0; j < 4; ++j) { const unsigned h0 = cvtpk(h[j].x, h[j].y), h1 = cvtpk(h[j].z, h[j].w);
                const unsigned l0 = cvtpk(h[j].x - bflo(h0), h[j].y - bfhi(h0)), l1 = cvtpk(h[j].z - bflo(h1), h[j].w - bfhi(h1));
#if MOE_FP8
                to8[64 * j] = pk_fp8x4(h[j].x, h[j].y, h[j].z, h[j].w);
#else
                to[64 * j] = (u32x2){h0, h1};
#endif
                *(LAS u32x2*)(hiT + lr * RP + (4 * c.lane + 256 * j) * 2) = (u32x2){h0, h1};
                *(LAS u32x2*)(loT + lr * RP + (4 * c.lane + 256 * j) * 2) = (u32x2){l0, l1}; } } }
        __syncthreads();
        f32x16 acc0 = {}, acc1 = {};
#pragma unroll
        for (int kk = 0; kk < 8; ++kk) { const int k0 = 128 * c.wave + 16 * kk + 8 * hi;
            const bf16x8 ahi = *(const LAS bf16x8*)(hiT + r32 * RP + k0 * 2), alo = *(const LAS bf16x8*)(loT + r32 * RP + k0 * 2);
            const bf16x8 b0h = *(const bf16x8*)(wr + r32 * 1024 + k0), b1h = *(const bf16x8*)(wr + (32 + r32) * 1024 + k0);
            const bf16x8 b0l = *(const bf16x8*)(wr + 65536 + r32 * 1024 + k0), b1l = *(const bf16x8*)(wr + 65536 + (32 + r32) * 1024 + k0);
            acc0 = __builtin_amdgcn_mfma_f32_32x32x16_bf16(ahi, b0h, acc0, 0, 0, 0); acc1 = __builtin_amdgcn_mfma_f32_32x32x16_bf16(ahi, b1h, acc1, 0, 0, 0);
            acc0 = __builtin_amdgcn_mfma_f32_32x32x16_bf16(alo, b0h, acc0, 0, 0, 0); acc1 = __builtin_amdgcn_mfma_f32_32x32x16_bf16(alo, b1h, acc1, 0, 0, 0);
            acc0 = __builtin_amdgcn_mfma_f32_32x32x16_bf16(ahi, b0l, acc0, 0, 0, 0); acc1 = __builtin_amdgcn_mfma_f32_32x32x16_bf16(ahi, b1l, acc1, 0, 0, 0); }
        if (tile + c.G < ntiles) M1_LOADROWS(tile + c.G);
        __syncthreads();
#pragma unroll
        for (int reg = 0; reg < 16; ++reg) { part[((c.wave * 2 + 0) * 16 + reg) * 64 + c.lane] = acc0[reg]; part[((c.wave * 2 + 1) * 16 + reg) * 64 + c.lane] = acc1[reg]; }
        __syncthreads();
        if (nmine < 3) {
#pragma unroll
            for (int q = 0; q < 4; ++q) { const int idx = c.tid + 512 * q, nt = idx >> 10, reg = (idx >> 6) & 15, ln = idx & 63; float s = 0.f;
#pragma unroll
                for (int w = 0; w < 8; ++w) s += part[((w * 2 + nt) * 16 + reg) * 64 + ln];
                logit[(nmine * 32 + (reg & 3) + 8 * (reg >> 2) + 4 * (ln >> 5)) * 64 + nt * 32 + (ln & 31)] = s; } }
        __syncthreads();
    }
#undef M1_LOADROWS
    int e0 = 0, e1 = 0, p0 = 0, p1 = 0; float w0 = 0.f, w1 = 0.f; const int myt = c.tid >> 5; const bool act_r = c.tid < 96 && myt < nmine;
    if (act_r) { const LAS float* lg = logit + c.tid * 64;
        int grp = 0; float gm = lg[0];
#pragma unroll
        for (int q = 1; q < 4; ++q) if (lg[q] > gm) { gm = lg[q]; grp = q; }
        float den = 0.f;
#pragma unroll
        for (int q = 0; q < 4; ++q) den += expf(lg[q] - gm);
        const float gate = 1.0f / den;
        const LAS float* le = lg + 4 + grp * 8;
        int i0 = 0; float v0 = le[0];
#pragma unroll
        for (int q = 1; q < 8; ++q) if (le[q] > v0) { v0 = le[q]; i0 = q; }
        int i1 = -1; float v1 = -3.0e38f;
#pragma unroll
        for (int q = 0; q < 8; ++q) if (q != i0 && le[q] > v1) { v1 = le[q]; i1 = q; }
        const float ex = expf(v1 - v0); w0 = gate / (1.0f + ex); w1 = gate * ex / (1.0f + ex);
        e0 = grp * 8 + i0; e1 = grp * 8 + i1;
        p0 = __hip_atomic_fetch_add(lcnt + e0, 1, __ATOMIC_RELAXED, __HIP_MEMORY_SCOPE_WORKGROUP);
        p1 = __hip_atomic_fetch_add(lcnt + e1, 1, __ATOMIC_RELAXED, __HIP_MEMORY_SCOPE_WORKGROUP); }
    __syncthreads();
    if (c.tid < 32) { const int n = lcnt[c.tid]; lbase[c.tid] = n ? (int)__hip_atomic_fetch_add(gcnt + c.tid, (unsigned)n, __ATOMIC_RELAXED, __HIP_MEMORY_SCOPE_AGENT) : 0; }
    __syncthreads();
    if (act_r) { const int r = ((int)blockIdx.x + myt * c.G) * 32 + (c.tid & 31);
        list[e0 * MOE_CAP + lbase[e0] + p0] = 2 * r; w2[2 * r] = w0;
        list[e1 * MOE_CAP + lbase[e1] + p1] = 2 * r + 1; w2[2 * r + 1] = w1; }
    __syncthreads();
}
__device__ __forceinline__ void moe_tables(const Args& a, const Ctx& c, int layer, LAS int* tab) {
    unsigned* gcnt = (unsigned*)(a.ws + WS_CTL) + CW_CNT + layer * 32;
    if (c.tid < 32) tab[40 + c.tid] = (int)__hip_atomic_load(gcnt + c.tid, __ATOMIC_RELAXED, __HIP_MEMORY_SCOPE_AGENT);
    __syncthreads();
    if (c.tid == 0) { int s = 0; for (int e = 0; e < 32; ++e) { tab[e] = s; s += (tab[40 + e] + 255) >> 8; } tab[32] = s; }
    __syncthreads();
}

__device__ __forceinline__ void ph_rpool(const Args& a, const Ctx& c, int layer) {
    LAS unsigned char* hs = c.lds;
    const float* g = a.in[I_NMIX] + layer * D;
    for (int tile = blockIdx.x; tile < TT / 32; tile += c.G) {
        const int r0 = tile * 32;
        const int s0 = r0 < TL ? (r0 / SEQ) * SEQ : TL + ((r0 - TL) / CTXL) * CTXL, s1 = s0 + (r0 < TL ? SEQ : CTXL);
        for (int lr = c.wave; lr < 47; lr += NWAVES) { const int gr = r0 - 8 + lr; if (gr < s0 || gr >= s1) continue;
            f32x4 v[4], h[4]; load_row_combined(a, layer, gr, c.lane, v);
            if (lr >= 8 && lr < 40) { f32x4* xo = (f32x4*)((float*)(a.ws + WS_Z) + (size_t)gr * D) + c.lane;
#pragma unroll
                for (int j = 0; j < 4; ++j) xo[64 * j] = v[j]; }
            const float rstd = row_rstd(v); const float* m = mod_row(a, layer, gr);
            norm_mod(v, rstd, g, m, m + D, c.lane, h);
#pragma unroll
            for (int j = 0; j < 4; ++j) *(LAS u32x2*)(hs + lr * 2048 + (4 * c.lane + 256 * j) * 2) = (u32x2){cvtpk(h[j].x, h[j].y), cvtpk(h[j].z, h[j].w)}; }
        __syncthreads();
        { const int half = 1 << (c.tid >> 7);
          const LAS unsigned* col = (const LAS unsigned*)hs + c.tid;
          float sx = 0.f, sy = 0.f;
          { const int lo = (r0 - half) > s0 ? (r0 - half) : s0, hi = (r0 + half) < s1 ? (r0 + half) : s1;
            for (int gr = lo; gr < hi; ++gr) { const unsigned u = col[(gr - r0 + 8) * 512]; sx += bflo(u); sy += bfhi(u); } }
          unsigned* ho = (unsigned*)((bf16*)(a.ws + WS_HB) + (size_t)r0 * D) + c.tid;
          for (int t = 0; t < 32; ++t) { const int gr = r0 + t; const int lo = (gr - half) > s0 ? (gr - half) : s0, hi = (gr + half) < s1 ? (gr + half) : s1;
              const float inv = __builtin_amdgcn_rcpf((float)(hi - lo)); const unsigned u = col[(t + 8) * 512];
              ho[t * 512] = cvtpk(sx * inv - bflo(u), sy * inv - bfhi(u));
              if (t < 31) { if (gr + half < s1) { const unsigned w = col[(t + 8 + half) * 512]; sx += bflo(w); sy += bfhi(w); }
                            if (gr - half >= s0) { const unsigned w = col[(t + 8 - half) * 512]; sx -= bflo(w); sy -= bfhi(w); } } } }
        __syncthreads();
    }
}

struct EpiInproj { static constexpr bool PERM = true; bf16* Z; bf16* XBC; float* DT; const float* dtb;
    __device__ __forceinline__ void operator()(const AccT& acc, const pg8::Unit& u, int wr, int wc, int fr, int fq) const {
        const size_t r0 = (size_t)u.pm * 256;
        if (u.pn < 20) { bf16* base; int pitch; if (u.pn < 8) { base = Z + u.pn * 256; pitch = 2048; } else { base = XBC + (u.pn - 8) * 256; pitch = 3072; }
#pragma unroll
            for (int ai = 0; ai < 2; ++ai)
#pragma unroll
                for (int m = 0; m < 4; ++m) { bf16* rowp = base + (r0 + ai * 128 + wr * 64 + m * 16 + fr) * pitch + wc * 32 + 8 * fq;
#pragma unroll
                    for (int bj = 0; bj < 2; ++bj) { const f32x4 v0 = acc[ai][bj][m][0], v1 = acc[ai][bj][m][1];
                        *(u32x4*)(rowp + bj * 128) = (u32x4){cvtpk(v0[0], v0[1]), cvtpk(v0[2], v0[3]), cvtpk(v1[0], v1[1]), cvtpk(v1[2], v1[3])}; } }
        } else if (wc < 2) { const int col = wc * 32 + 8 * fq; const f32x4 b0 = *(const f32x4*)(dtb + col), b1 = *(const f32x4*)(dtb + col + 4);
#pragma unroll
            for (int ai = 0; ai < 2; ++ai)
#pragma unroll
                for (int m = 0; m < 4; ++m) { float* p = DT + (r0 + ai * 128 + wr * 64 + m * 16 + fr) * 64 + col; f32x4 v0 = acc[ai][0][m][0] + b0, v1 = acc[ai][0][m][1] + b1;
#pragma unroll
                    for (int e = 0; e < 4; ++e) { v0[e] = fmaxf(v0[e], 0.f) + log1pf(__expf(-fabsf(v0[e]))); v1[e] = fmaxf(v1[e], 0.f) + log1pf(__expf(-fabsf(v1[e]))); }
                    *(f32x4*)p = v0; *(f32x4*)(p + 4) = v1; } }
    }
};

__device__ __forceinline__ void ph_conv(const Args& a, const Ctx& c) {
    LAS unsigned char* tin = c.lds; LAS unsigned char* toT = c.lds + 17408; LAS unsigned char* toN = c.lds + 34816;
    const bf16* xbc = (const bf16*)(a.ws + WS_XBC);
    u32x4 pin[3];
#define CONV_PREFETCH(tk) do { const int ci_ = (tk) / 48, chb_ = (tk) % 48, r0_ = ci_ * 128, ch0_ = chb_ * 64; \
        const bool first_ = ci_ < 128 ? (ci_ % 32 == 0) : (((ci_ - 128) & 1) == 0), last_ = ci_ < 128 ? (ci_ % 32 == 31) : (((ci_ - 128) & 1) == 1); \
        _Pragma("unroll") for (int q = 0; q < 3; ++q) { const int p = c.tid + 512 * q, lr = p >> 3, pc = p & 7; const bool valid = p < 131 * 8 && !((lr < 2 && first_) || (lr == 130 && last_)); \
            pin[q] = (u32x4){0u, 0u, 0u, 0u}; if (valid) pin[q] = *(const u32x4*)(xbc + (size_t)(r0_ - 2 + lr) * 3072 + ch0_ + pc * 8); } } while (0)
    if ((int)blockIdx.x < NCH * 48) CONV_PREFETCH((int)blockIdx.x);
    for (int task = blockIdx.x; task < NCH * 48; task += c.G) {
        const int ci = task / 48, chb = task % 48, r0 = ci * 128, ch0 = chb * 64;
#pragma unroll
        for (int q = 0; q < 3; ++q) { const int p = c.tid + 512 * q; if (p < 131 * 8) *(LAS u32x4*)(tin + (p >> 3) * 128 + (p & 7) * 16) = pin[q]; }
        __syncthreads();
        if (task + c.G < NCH * 48) CONV_PREFETCH(task + c.G);
        { const int ch = c.tid & 63, tq = c.tid >> 6; const float* cw = a.in[I_CONVW] + ch0 + ch;
          const float w0 = cw[0], w1 = cw[3072], w2 = cw[2 * 3072], w3 = cw[3 * 3072], bias = a.in[I_CONVB][ch0 + ch];
          float xin[19];
#pragma unroll
          for (int i = 0; i < 19; ++i) xin[i] = bf2f(*(const LAS bf16*)(tin + (16 * tq + i) * 128 + ch * 2));
          float o[16];
#pragma unroll
          for (int i = 0; i < 16; ++i) o[i] = silu_f(bias + w0 * xin[i] + w1 * xin[i + 1] + w2 * xin[i + 2] + w3 * xin[i + 3]);
          if (chb < 40) { *(LAS u32x4*)(toT + ch * 272 + tq * 32) = (u32x4){cvtpk(o[0], o[1]), cvtpk(o[2], o[3]), cvtpk(o[4], o[5]), cvtpk(o[6], o[7])};
                          *(LAS u32x4*)(toT + ch * 272 + tq * 32 + 16) = (u32x4){cvtpk(o[8], o[9]), cvtpk(o[10], o[11]), cvtpk(o[12], o[13]), cvtpk(o[14], o[15])}; }
          if (chb >= 32) {
#pragma unroll
              for (int i = 0; i < 16; ++i) *(LAS bf16*)(toN + (16 * tq + i) * 144 + ch * 2) = (bf16)(cvtpk(o[i], 0.f) & 0xffffu); } }
        __syncthreads();
        if (chb < 40) { bf16* dst = chb < 32 ? (bf16*)(a.ws + WS_XT) + ((size_t)ci * 2048 + ch0) * 128 : (bf16*)(a.ws + WS_BT) + ((size_t)ci * 512 + (ch0 - 2048)) * 128;
#pragma unroll
            for (int q = 0; q < 2; ++q) { const int p = c.tid + 512 * q, chl = p >> 4, pc = p & 15; *(u32x4*)(dst + chl * 128 + pc * 8) = *(const LAS u32x4*)(toT + chl * 272 + pc * 16); } }
        if (chb >= 32) { bf16* dst = chb < 40 ? (bf16*)(a.ws + WS_BN) + (size_t)r0 * 512 + (ch0 - 2048) : (bf16*)(a.ws + WS_CN) + (size_t)r0 * 512 + (ch0 - 2560);
#pragma unroll
            for (int q = 0; q < 2; ++q) { const int p = c.tid + 512 * q, t = p >> 3, pc = p & 7; *(u32x4*)(dst + (size_t)t * 512 + pc * 8) = *(const LAS u32x4*)(toN + t * 144 + pc * 16); } }
        __syncthreads();
    }
#undef CONV_PREFETCH
    const int gw = c.vcu * NWAVES + c.wave, NGW = c.G * NWAVES;
    const float* dt = (const float*)(a.ws + WS_DT);
    for (int item = gw; item < NCH * 32; item += NGW) { const int ci = item >> 5, h = item & 31, r0 = ci * 128 + 2 * c.lane;
        const float af = -expf(a.in[I_ALOG][h]), ab = -expf(a.in[I_ALOG][32 + h]);
        const float dtf0 = dt[(size_t)r0 * 64 + h], dtf1 = dt[(size_t)(r0 + 1) * 64 + h], dtb0 = dt[(size_t)r0 * 64 + 32 + h], dtb1 = dt[(size_t)(r0 + 1) * 64 + 32 + h];
        const float laf0 = dtf0 * af, laf1 = dtf1 * af, lab0 = dtb0 * ab, lab1 = dtb1 * ab;
        float inf_ = laf0 + laf1, inb = lab0 + lab1; const float pf = inf_, pbk = inb;
#pragma unroll
        for (int o = 1; o < 64; o <<= 1) { const float t1 = __shfl_up(inf_, o), t2 = __shfl_up(inb, o); if (c.lane >= o) { inf_ += t1; inb += t2; } }
        const float totf = __shfl(inf_, 63), totb = __shfl(inb, 63);
        const float exf = inf_ - pf, exb = inb - pbk;
        const float cf0 = exf + laf0, cf1 = inf_, pb0 = exb, pb1 = exb + lab0;
        f32x4* sca = (f32x4*)(a.ws + WS_SCA) + (size_t)r0 * 32 + h; f32x4* scb = (f32x4*)(a.ws + WS_SCB) + (size_t)r0 * 32 + h;
        { const float L2E = 1.4426950408889634f;
          sca[0] = (f32x4){cf0 * L2E, pb0 * L2E, cf0 * L2E - __log2f(dtf0), pb0 * L2E + __log2f(dtb0)}; sca[32] = (f32x4){cf1 * L2E, pb1 * L2E, cf1 * L2E - __log2f(dtf1), pb1 * L2E + __log2f(dtb1)}; }
        scb[0] = (f32x4){__expf(cf0), __expf(totb - pb0), dtf0 * __expf(totf - cf0), dtb0 * __expf(pb0)};
        scb[32] = (f32x4){__expf(cf1), __expf(totb - pb1), dtf1 * __expf(totf - cf1), dtb1 * __expf(pb1)};
        if (c.lane == 0) ((f32x2*)(a.ws + WS_DEC))[ci * 32 + h] = (f32x2){__expf(totf), __expf(totb)}; }
}

__device__ __forceinline__ void ph_scan(const Args& a, const Ctx& c) {
    constexpr int P = 272, BUF = 53248;
    LAS unsigned char* stg = c.lds + 2 * BUF + c.wave * 2048;
    const int r32 = c.lane & 31, hi = c.lane >> 5, pt = c.wave >> 2, nt = c.wave & 3;
    for (int task = c.vcu; task < 256; task += c.G) { const int b = task >> 6, dir = (task >> 5) & 1, h = task & 31, g = h >> 3;
        f32x16 acc = {};
        u32x4 xrA[2], brA[4], xrB[2], brB[4]; f32x4 wregA = {}, wregB = {}; f32x2 decA = {}, decB = {};
#define SCAN_CI(k) (dir == 0 ? ((k) < 2 ? 128 + 2 * b + (k) : 32 * b + ((k) - 2)) : ((k) < 2 ? 128 + 2 * b + 1 - (k) : 32 * b + 31 - ((k) - 2)))
#define SCAN_LOAD(k, xr, br, wreg, dcr) do { const int ci_ = SCAN_CI(k); const bf16* xs_ = (const bf16*)(a.ws + WS_XT) + ((size_t)ci_ * 2048 + 64 * h) * 128; const bf16* bs_ = (const bf16*)(a.ws + WS_BT) + ((size_t)ci_ * 512 + 128 * g) * 128; \
        _Pragma("unroll") for (int q = 0; q < 2; ++q) xr[q] = ((const u32x4*)xs_)[c.tid + 512 * q]; _Pragma("unroll") for (int q = 0; q < 4; ++q) br[q] = ((const u32x4*)bs_)[c.tid + 512 * q]; \
        wreg = ((const f32x4*)(a.ws + WS_SCB))[((size_t)ci_ * 128 + (c.tid & 127)) * 32 + h]; dcr = ((const f32x2*)(a.ws + WS_DEC))[ci_ * 32 + h]; } while (0)
#define SCAN_WRITE(bi, xr, br, wreg) do { LAS unsigned char* xb_ = c.lds + (bi) * BUF; LAS unsigned char* bb_ = xb_ + 17408; \
        _Pragma("unroll") for (int q = 0; q < 2; ++q) { const int p = c.tid + 512 * q; *(LAS u32x4*)(xb_ + (p >> 4) * P + (p & 15) * 16) = xr[q]; } \
        _Pragma("unroll") for (int q = 0; q < 4; ++q) { const int p = c.tid + 512 * q; *(LAS u32x4*)(bb_ + (p >> 4) * P + (p & 15) * 16) = br[q]; } \
        if (c.tid < 128) ((LAS float*)(xb_ + 52224))[c.tid] = dir == 0 ? wreg.z : wreg.w; } while (0)
#define SCAN_STEP(k, cur, dcr) do { const int ci = SCAN_CI(k); \
            { bf16* hin = (bf16*)(a.ws + WS_HIN) + (((size_t)ci * 2 + dir) * 32 + h) * 8192; \
              _Pragma("unroll") for (int r = 0; r < 16; ++r) *(LAS bf16*)(stg + ((r & 3) + 8 * (r >> 2) + 4 * hi) * 64 + r32 * 2) = (bf16)(cvtpk(acc[r], 0.f) & 0xffffu); \
              LDS_WAIT(); \
              _Pragma("unroll") for (int i = 0; i < 2; ++i) { const int row = (c.lane >> 2) + 16 * i, pc = c.lane & 3; *(u32x4*)(hin + (size_t)(32 * pt + row) * 128 + 32 * nt + pc * 8) = *(const LAS u32x4*)(stg + row * 64 + pc * 16); } } \
            const float dec = dir == 0 ? dcr.x : dcr.y; \
            _Pragma("unroll") for (int r = 0; r < 16; ++r) acc[r] *= dec; \
            { LAS unsigned char* xb = c.lds + (cur) * BUF; LAS unsigned char* bb = xb + 17408; const LAS float* wv = (const LAS float*)(xb + 52224); \
              _Pragma("unroll") for (int kk = 0; kk < 8; ++kk) { const int s8 = 16 * kk + 8 * hi; \
                  const u32x4 xa = *(const LAS u32x4*)(xb + (32 * pt + r32) * P + s8 * 2); const f32x4 wa = *(const LAS f32x4*)(wv + s8), wb = *(const LAS f32x4*)(wv + s8 + 4); \
                  const u32x4 xs = (u32x4){cvtpk(bflo(xa.x) * wa.x, bfhi(xa.x) * wa.y), cvtpk(bflo(xa.y) * wa.z, bfhi(xa.y) * wa.w), cvtpk(bflo(xa.z) * wb.x, bfhi(xa.z) * wb.y), cvtpk(bflo(xa.w) * wb.z, bfhi(xa.w) * wb.w)}; \
                  const bf16x8 bfrag = *(const LAS bf16x8*)(bb + (32 * nt + r32) * P + s8 * 2); \
                  acc = __builtin_amdgcn_mfma_f32_32x32x16_bf16(__builtin_bit_cast(bf16x8, xs), bfrag, acc, 0, 0, 0); } } } while (0)
        f32x2 dcur0, dcur1;
        SCAN_LOAD(0, xrA, brA, wregA, decA); SCAN_LOAD(1, xrB, brB, wregB, decB); SCAN_WRITE(0, xrA, brA, wregA); dcur0 = decA;
        __syncthreads();
        for (int k = 0; k < 34; k += 2) {
            if (k + 2 < 34) SCAN_LOAD(k + 2, xrA, brA, wregA, decA);
            SCAN_STEP(k, 0, dcur0);
            SCAN_WRITE(1, xrB, brB, wregB); dcur1 = decB;
            __syncthreads();
            if (k + 3 < 34) SCAN_LOAD(k + 3, xrB, brB, wregB, decB);
            SCAN_STEP(k + 1, 1, dcur1);
            if (k + 2 < 34) { SCAN_WRITE(0, xrA, brA, wregA); dcur0 = decA; }
            __syncthreads();
        }
#undef SCAN_CI
#undef SCAN_LOAD
#undef SCAN_WRITE
#undef SCAN_STEP
    }
}

__device__ __forceinline__ int crow16(int r, int hi) { return (r & 3) + 8 * (r >> 2) + 4 * hi; }
__device__ __forceinline__ void ph_yph(const Args& a, const Ctx& c) {
    constexpr int P = 272, ZP = 144;
    LAS unsigned char* Cs = c.lds; LAS unsigned char* Bs = c.lds + 34816; LAS unsigned char* xs = c.lds + 69632; LAS unsigned char* hf = c.lds + 87040; LAS unsigned char* hb = c.lds + 104448;
    LAS unsigned char* zs = c.lds + 121856; LAS unsigned char* os = c.lds + 140288; LAS f32x4* sca = (LAS f32x4*)(c.lds + 158720); LAS f32x2* scb = (LAS f32x2*)(c.lds + 160768);
    LAS float* sbv = (LAS float*)(c.lds + 161792); LAS float* scv = (LAS float*)(c.lds + 162304); LAS float* ssql = (LAS float*)(c.lds + 34816);
    const int lb = c.wave & 3, pb = c.wave >> 2;
    SECT_DECL
    for (int task = c.vcu; task < NCH * 4; task += c.G) { const int ci = task >> 2, g = task & 3, r0 = ci * 128;
        int tid_t = c.tid; asm volatile("" : "+v"(tid_t));
        f32x16 X[4]; int l0;
        u32x4 pxt[2], phf[2], phb[2], pz[2]; f32x4 ps1 = {}; f32x4 ps4 = {};
#define YPH_PREFETCH(hq) do { const int h_ = 8 * g + (hq); const u32x4* xt_ = (const u32x4*)((const bf16*)(a.ws + WS_XT) + ((size_t)ci * 2048 + 64 * h_) * 128); \
            const u32x4* hfg_ = (const u32x4*)((const bf16*)(a.ws + WS_HIN) + (((size_t)ci * 2 + 0) * 32 + h_) * 8192); const u32x4* hbg_ = (const u32x4*)((const bf16*)(a.ws + WS_HIN) + (((size_t)ci * 2 + 1) * 32 + h_) * 8192); \
            const bf16* zg_ = (const bf16*)(a.ws + WS_Z) + (size_t)r0 * 2048 + 64 * h_; \
            _Pragma("unroll") for (int q = 0; q < 2; ++q) { const int p = tidp + 512 * q; pxt[q] = xt_[p]; phf[q] = hfg_[p]; phb[q] = hbg_[p]; pz[q] = *(const u32x4*)(zg_ + (size_t)(p >> 3) * 2048 + (p & 7) * 8); } \
            ps1 = ((const f32x4*)(a.ws + WS_SCA))[((size_t)r0 + (tidp & 127)) * 32 + h_]; ps4 = ((const f32x4*)(a.ws + WS_SCB))[((size_t)r0 + (tidp & 127)) * 32 + h_]; } while (0)
        { const int tid = tid_t, lane = tid & 63, r32 = lane & 31, hi = lane >> 5; l0 = 32 * lb + r32;
          { const bf16* cn = (const bf16*)(a.ws + WS_CN) + (size_t)r0 * 512 + 128 * g; const bf16* bn = (const bf16*)(a.ws + WS_BN) + (size_t)r0 * 512 + 128 * g;
#pragma unroll
            for (int q = 0; q < 4; ++q) { const int p = tid + 512 * q, row = p >> 4, pc = p & 15;
                *(LAS u32x4*)(Cs + row * P + pc * 16) = *(const u32x4*)(cn + (size_t)row * 512 + pc * 8); *(LAS u32x4*)(Bs + row * P + pc * 16) = *(const u32x4*)(bn + (size_t)row * 512 + pc * 8); } }
          { const int tidp = tid; YPH_PREFETCH(0); }
          __syncthreads();
#pragma unroll
          for (int sb = 0; sb < 4; ++sb) { X[sb] = (f32x16){};
#pragma unroll
              for (int kk = 0; kk < 8; ++kk) { const int k8 = (16 * kk + 8 * hi) * 2;
                  X[sb] = __builtin_amdgcn_mfma_f32_32x32x16_bf16(*(const LAS bf16x8*)(Bs + (32 * sb + r32) * P + k8), *(const LAS bf16x8*)(Cs + (32 * lb + r32) * P + k8), X[sb], 0, 0, 0); } }
        }
        SECT(0);
        float ssq = 0.f;
#pragma unroll 1
        for (int hh = 0; hh < 8; ++hh) { const int h = 8 * g + hh;
            int tid = c.tid; asm volatile("" : "+v"(tid)); const int lane = tid & 63, r32 = lane & 31, hi = lane >> 5, l = 32 * lb + r32; (void)lane;
            const float dsum = a.in[I_DSK][h] + a.in[I_DSK][32 + h];
            __syncthreads();
            SECT(1);
            if (hh > 0) { bf16* gg = (bf16*)(a.ws + WS_G) + (size_t)r0 * 2048 + 64 * (h - 1);
#pragma unroll
                for (int q = 0; q < 2; ++q) { const int p = tid + 512 * q, zr = p >> 3, zc = p & 7; *(u32x4*)(gg + (size_t)zr * 2048 + zc * 8) = *(const LAS u32x4*)(os + zr * ZP + zc * 16); } }
#pragma unroll
            for (int q = 0; q < 2; ++q) { const int p = tid + 512 * q, row = p >> 4, pc = p & 15;
                *(LAS u32x4*)(xs + row * P + pc * 16) = pxt[q]; *(LAS u32x4*)(hf + row * P + pc * 16) = phf[q]; *(LAS u32x4*)(hb + row * P + pc * 16) = phb[q];
                *(LAS u32x4*)(zs + (p >> 3) * ZP + (p & 7) * 16) = pz[q]; }
            if (tid < 128) { sca[tid] = ps1; scb[tid] = (f32x2){ps4.x, ps4.y}; sbv[tid] = ps1.z; scv[tid] = ps1.w; }
            __syncthreads();
            SECT(2);
            if (hh < 7) { const int tidp = tid; YPH_PREFETCH(hh + 1); }
            SECT(3);
            const f32x4 me = sca[l]; const f32x2 ee = scb[l];
            const float dtb_l = __builtin_amdgcn_exp2f(me.w - me.y);
            f32x16 accd = {};
#pragma unroll
            for (int sb = 0; sb < 4; ++sb) { unsigned mp[8];
#pragma unroll
                for (int q = 0; q < 4; ++q) { const int s0 = 32 * sb + 8 * q + 4 * hi; float mv[4];
                    if (sb < lb) { const f32x4 bs4 = *(const LAS f32x4*)(sbv + s0);
#pragma unroll
                        for (int e = 0; e < 4; ++e) mv[e] = X[sb][4 * q + e] * __builtin_amdgcn_exp2f(me.x - bs4[e]); }
                    else if (sb > lb) { const f32x4 cs4 = *(const LAS f32x4*)(scv + s0);
#pragma unroll
                        for (int e = 0; e < 4; ++e) mv[e] = X[sb][4 * q + e] * __builtin_amdgcn_exp2f(cs4[e] - me.y); }
                    else { const f32x4 bs4 = *(const LAS f32x4*)(sbv + s0), cs4 = *(const LAS f32x4*)(scv + s0);
#pragma unroll
                        for (int e = 0; e < 4; ++e) { const int s = s0 + e; const float t = (s <= l) ? (me.x - bs4[e]) : (cs4[e] - me.y); const float xv = X[sb][4 * q + e];
                            float m = xv * __builtin_amdgcn_exp2f(t); if (s == l) m += xv * dtb_l + dsum; mv[e] = m; } }
                    mp[2 * q] = cvtpk(mv[0], mv[1]); mp[2 * q + 1] = cvtpk(mv[2], mv[3]); }
#pragma unroll
                for (int t = 0; t < 2; ++t) { const int sof = (32 * sb + 16 * t + 4 * hi) * 2;
                    const u32x2 lo = *(const LAS u32x2*)(xs + (32 * pb + r32) * P + sof), h2 = *(const LAS u32x2*)(xs + (32 * pb + r32) * P + sof + 16);
                    const u32x4 af = (u32x4){lo.x, lo.y, h2.x, h2.y}, bfm = (u32x4){mp[4 * t], mp[4 * t + 1], mp[4 * t + 2], mp[4 * t + 3]};
                    accd = __builtin_amdgcn_mfma_f32_32x32x16_bf16(__builtin_bit_cast(bf16x8, af), __builtin_bit_cast(bf16x8, bfm), accd, 0, 0, 0); }
                }
            SECT(4);
#pragma unroll
            for (int dd = 0; dd < 2; ++dd) { f32x16 acco = {}; LAS unsigned char* hx = dd == 0 ? hf : hb;
#pragma unroll
                for (int kk = 0; kk < 8; ++kk) { const int k8 = (16 * kk + 8 * hi) * 2;
                    acco = __builtin_amdgcn_mfma_f32_32x32x16_bf16(*(const LAS bf16x8*)(hx + (32 * pb + r32) * P + k8), *(const LAS bf16x8*)(Cs + (32 * lb + r32) * P + k8), acco, 0, 0, 0); }
                const float ex = dd == 0 ? ee.x : ee.y;
#pragma unroll
                for (int r = 0; r < 16; ++r) accd[r] += ex * acco[r]; }
            SECT(5);
#pragma unroll
            for (int q = 0; q < 4; ++q) { const int pcol = 32 * pb + 8 * q + 4 * hi; const u32x2 zq = *(const LAS u32x2*)(zs + l * ZP + pcol * 2);
                float gv[4];
#pragma unroll
                for (int e = 0; e < 4; ++e) { const int r = 4 * q + e; const float y = accd[r];
                    const float z = (e == 0) ? bflo(zq.x) : (e == 1) ? bfhi(zq.x) : (e == 2) ? bflo(zq.y) : bfhi(zq.y); gv[e] = y * silu_f(z); ssq += gv[e] * gv[e]; }
                *(LAS u32x2*)(os + l * ZP + pcol * 2) = (u32x2){cvtpk(gv[0], gv[1]), cvtpk(gv[2], gv[3])}; }
            SECT(6);
        }
#undef YPH_PREFETCH
        __syncthreads();
        { bf16* gg = (bf16*)(a.ws + WS_G) + (size_t)r0 * 2048 + 64 * (8 * g + 7);
#pragma unroll
          for (int q = 0; q < 2; ++q) { const int p = c.tid + 512 * q, zr = p >> 3, zc = p & 7; *(u32x4*)(gg + (size_t)zr * 2048 + zc * 8) = *(const LAS u32x4*)(os + zr * ZP + zc * 16); } }
        ssq += __shfl_xor(ssq, 32);
        if ((c.lane >> 5) == 0) ssql[pb * 128 + l0] = ssq;
        __syncthreads();
        if (c.tid < 128) ssql[256 + c.tid] = rsqrtf((ssql[c.tid] + ssql[128 + c.tid]) * (1.0f / 512.0f) + EPS);
        VM_WAIT();
        __syncthreads();
        { bf16* gt = (bf16*)(a.ws + WS_G) + (size_t)r0 * 2048 + 512 * g; const float* ng = a.in[I_SNORM] + 512 * g;
          const f32x4 g0 = *(const f32x4*)(ng + (c.tid & 63) * 8), g1 = *(const f32x4*)(ng + (c.tid & 63) * 8 + 4);
#pragma unroll 1
          for (int qb = 0; qb < 2; ++qb) { u32x4 gv8[8]; int tidq = c.tid + 4096 * qb; asm volatile("" : "+v"(tidq));
#pragma unroll
            for (int q = 0; q < 8; ++q) { const int p = tidq + 512 * q; gv8[q] = *(const u32x4*)(gt + (size_t)(p >> 6) * 2048 + (p & 63) * 8); }
#pragma unroll
            for (int q = 0; q < 8; ++q) { const int p = tidq + 512 * q, row = p >> 6, col = (p & 63) * 8; const u32x4 v = gv8[q]; const float sr = ssql[256 + row];
              *(u32x4*)(gt + (size_t)row * 2048 + col) = (u32x4){cvtpk(bflo(v.x) * sr * g0.x, bfhi(v.x) * sr * g0.y), cvtpk(bflo(v.y) * sr * g0.z, bfhi(v.y) * sr * g0.w), cvtpk(bflo(v.z) * sr * g1.x, bfhi(v.z) * sr * g1.y), cvtpk(bflo(v.w) * sr * g1.z, bfhi(v.w) * sr * g1.w)}; } } }
        __syncthreads();
        SECT(7);
    }
    SECT_END(40);
}
__device__ __forceinline__ void ph_gfix(const Args& a, const Ctx& c) {
    const float* ng = a.in[I_SNORM]; const float* rs = (const float*)(a.ws + WS_RSTD);
    const int n16 = TT * 256;
    for (int p = blockIdx.x * NTHREADS + c.tid; p < n16; p += c.G * NTHREADS) { const int r = p >> 8, col = (p & 255) * 8;
        u32x4* gp = (u32x4*)((bf16*)(a.ws + WS_G) + (size_t)r * 2048 + col); const u32x4 v = *gp; const float s = rs[r * 4 + (col >> 9)];
        const f32x4 g0 = *(const f32x4*)(ng + col), g1 = *(const f32x4*)(ng + col + 4);
        *gp = (u32x4){cvtpk(bflo(v.x) * s * g0.x, bfhi(v.x) * s * g0.y), cvtpk(bflo(v.y) * s * g0.z, bfhi(v.y) * s * g0.w), cvtpk(bflo(v.z) * s * g1.x, bfhi(v.z) * s * g1.y), cvtpk(bflo(v.w) * s * g1.z, bfhi(v.w) * s * g1.w)}; }
}

#if DEBUG_CHECKS
__device__ __forceinline__ float dbg_hb(const Args& a, int layer, size_t idx, float sh) {
    if (ATT_FP8 && layer != 2) return __builtin_amdgcn_cvt_f32_fp8((unsigned)((const unsigned char*)(a.ws + WS_HB))[idx], 0) * sh;
    return bf2f(((const bf16*)(a.ws + WS_HB))[idx]); }
__device__ __forceinline__ int dbg_sample_row(int b) { const int SR[16] = {0, 1, 77, 4095, 4096, 5000, 8191, 9000, 12288, 16383, 16384, 16385, 16384 + 255, 16384 + 256, 17000, 17407}; int r = 0;
#pragma unroll
    for (int i = 0; i < 16; ++i) r = (b == i) ? SR[i] : r;
    return r; }
__device__ __forceinline__ float blk_sum(float v, LAS float* red, int tid) {
    v = wave_sum(v); __syncthreads(); if ((tid & 63) == 0) red[tid >> 6] = v; __syncthreads(); float s = 0.f;
#pragma unroll
    for (int i = 0; i < 8; ++i) s += red[i];
    __syncthreads(); return s; }
__device__ __forceinline__ float blk_max(float v, LAS float* red, int tid) {
#pragma unroll
    for (int o = 1; o < 64; o <<= 1) v = fmaxf(v, __shfl_xor(v, o));
    __syncthreads(); if ((tid & 63) == 0) red[tid >> 6] = v; __syncthreads(); float s = red[0];
#pragma unroll
    for (int i = 1; i < 8; ++i) s = fmaxf(s, red[i]);
    __syncthreads(); return s; }
__device__ __forceinline__ void dbg_report(const Args& a, int id, float err, float ssref, float n, int tid) {
    if (tid == 0) { float rel = err / (sqrtf(ssref / n) + 1e-20f); if (!(rel == rel)) rel = 1e30f; atomicMax((unsigned*)(a.ws + WS_CTL) + CW_DBG + id, __float_as_uint(rel)); } }
__device__ __forceinline__ float dbg_mod(const Args& a, int layer, int r, int j) {
    const float* cv = r < TL ? a.in[I_C] + (r / SEQ) * 1024 : a.in[I_CCTX]; float s = 0.f;
    _Pragma("nounroll") for (int k = 0; k < 1024; ++k) { const float x = cv[k]; s += (x / (1.0f + expf(-x))) * a.in[I_WADA][((size_t)layer * 1024 + k) * 6144 + j]; }
    return s + a.in[I_BADA][layer * 6144 + j]; }

__device__ __forceinline__ void chk_rmix(const Args& a, int layer, int id, LAS unsigned char* ldsb) {
    if (blockIdx.x >= 16) return; const int tid = tid_opaque(), r = dbg_sample_row(blockIdx.x);
    LAS float* red = (LAS float*)ldsb;
    const float* x = resid_row(a, layer, r); const bf16* hb = (const bf16*)(a.ws + WS_HB) + (size_t)r * D;
    float ss = 0.f; for (int cc = tid; cc < D; cc += 512) ss += x[cc] * x[cc];
    ss = blk_sum(ss, red, tid); const float rstd = rsqrtf(ss / D + EPS);
    float err = 0.f, sr = 0.f;
    for (int cc = tid; cc < D; cc += 512) { const float sh = dbg_mod(a, layer, r, cc), sc = dbg_mod(a, layer, r, D + cc);
        const float ref = x[cc] * rstd * a.in[I_NMIX][layer * D + cc] * (1.f + sc) + sh; err = fmaxf(err, fabsf(ref - dbg_hb(a, layer, (size_t)r * D + cc, 1.f))); sr += ref * ref; }
    err = blk_max(err, red, tid); sr = blk_sum(sr, red, tid); dbg_report(a, id, err, sr, D, tid);
}
__device__ __forceinline__ void chk_qkv(const Args& a, int layer, int id, LAS unsigned char* ldsb) {
    if (blockIdx.x >= 16) return; const int tid = tid_opaque(), r = dbg_sample_row(blockIdx.x), j = layer ? 1 : 0;
    LAS float* red = (LAS float*)ldsb; LAS float* y = red + 16; LAS float* hrow = y + 1536;
    const bf16* hb = (const bf16*)(a.ws + WS_HB) + (size_t)r * D;
    _Pragma("nounroll") for (int k = tid; k < D; k += 512) hrow[k] = dbg_hb(a, layer, (size_t)r * D + k, 1.f);
    __syncthreads();
    for (int n = tid; n < 1536; n += 512) { float s = 0.f; const float* w = a.in[I_WQKV] + (size_t)j * 1024 * 1536 + n; _Pragma("nounroll") for (int k = 0; k < 1024; ++k) s += hrow[k] * w[(size_t)k * 1536]; y[n] = s; }
    __syncthreads();
    float err = 0.f, sr = 0.f;
    for (int n = tid; n < 1536; n += 512) { float ref;
        if (n < 1280) { const int h0 = n & ~63; float ss = 0.f; _Pragma("nounroll") for (int q = 0; q < 64; ++q) ss += y[h0 + q] * y[h0 + q];
            const float rstd = rsqrtf(ss / 64.f + EPS); const float* g = (n < 1024 ? a.in[I_QG] : a.in[I_KG]) + j * 64;
            float v = y[n] * rstd * g[n & 63], vp = y[n ^ 1] * rstd * g[(n ^ 1) & 63];
            if (r < TL) { const int t = r % SEQ, i = (n & 63) >> 1, f = i & 15, pos = i < 16 ? t / 64 : t % 64; const float inv = powf(10000.f, -(float)f / 16.f), ang = (float)pos * inv, cs = cosf(ang), sn = sinf(ang);
                v = (n & 1) ? (vp * sn + v * cs) : (v * cs - vp * sn); }
            if (n < 1024) v *= 0.125f * 1.4426950408889634f;
            ref = v; } else ref = y[n];
        float got;
        if (n < 1024) { if (layer == 3 && r >= TL) continue; got = bf2f(((const bf16*)(a.ws + WS_Q))[(size_t)r * 1024 + n]); }
        else if (n < 1280) got = bf2f(((const bf16*)(a.ws + WS_K))[kv_row(r) * 256 + (n - 1024)]);
        else got = bf2f(((const bf16*)(a.ws + WS_V))[kv_row(r) * 256 + (n - 1280)]);
        err = fmaxf(err, fabsf(ref - got)); sr += ref * ref; }
    err = blk_max(err, red, tid); sr = blk_sum(sr, red, tid); dbg_report(a, id, err, sr, 1536, tid);
}
__device__ __forceinline__ void chk_att(const Args& a, int layer, int id, LAS unsigned char* ldsb) {
    if (blockIdx.x >= 16) return; const int tid = tid_opaque(), r = dbg_sample_row(blockIdx.x);
    if (layer == 3 && r >= TL) return;
    LAS float* red = (LAS float*)ldsb; LAS float* sc = red + 16; LAS float* po = sc + 4352;
    const int nk = r < TL ? KVROWS : CTXL; const long kv0 = (long)(r < TL ? r / SEQ : (r - TL) / CTXL) * KVROWS;
    const bf16* Qb = (const bf16*)(a.ws + WS_Q); const bf16* Kb = (const bf16*)(a.ws + WS_K); const bf16* Vb = (const bf16*)(a.ws + WS_V); const bf16* Ob = (const bf16*)(a.ws + WS_HB);
    float err = 0.f, sr = 0.f;
    for (int h = 0; h < 16; ++h) {
        float mx = -3e38f;
        _Pragma("nounroll") for (int jk = tid; jk < nk; jk += 512) { float s = 0.f; _Pragma("nounroll") for (int d = 0; d < 64; ++d) s += bf2f(Qb[(size_t)r * 1024 + h * 64 + d]) * bf2f(Kb[(kv0 + jk) * 256 + (h >> 2) * 64 + d]); sc[jk] = s; mx = fmaxf(mx, s); }
        mx = blk_max(mx, red, tid);
        float l = 0.f; _Pragma("nounroll") for (int jk = tid; jk < nk; jk += 512) { const float p = exp2f(sc[jk] - mx); sc[jk] = p; l += p; }
        l = blk_sum(l, red, tid);
        { const int d = tid & 63, part = tid >> 6; float o = 0.f; _Pragma("nounroll") for (int jk = part; jk < nk; jk += 8) o += sc[jk] * bf2f(Vb[(kv0 + jk) * 256 + (h >> 2) * 64 + d]); po[part * 64 + d] = o; }
        __syncthreads();
        if (tid < 64) { float o = 0.f; _Pragma("nounroll") for (int p = 0; p < 8; ++p) o += po[p * 64 + tid]; o /= l; err = fmaxf(err, fabsf(o - dbg_hb(a, layer, (size_t)r * 1024 + h * 64 + tid, 1.f / (float)(1 << ATT_OSH)))); sr += o * o; }
        __syncthreads();
    }
    err = blk_max(err, red, tid); sr = blk_sum(sr, red, tid); dbg_report(a, id, err, sr, 1024, tid);
}
__device__ __forceinline__ void chk_oproj(const Args& a, int layer, int id, LAS unsigned char* ldsb) {
    if (blockIdx.x >= 16 || layer != 0) return; const int tid = tid_opaque(), r = dbg_sample_row(blockIdx.x), j = 0;
    LAS float* red = (LAS float*)ldsb; LAS float* orow = red + 16;
    const bf16* Ob = (const bf16*)(a.ws + WS_HB) + (size_t)r * D;
    _Pragma("nounroll") for (int k = tid; k < D; k += 512) orow[k] = dbg_hb(a, layer, (size_t)r * D + k, 1.f / (float)(1 << ATT_OSH));
    __syncthreads();
    float err = 0.f, sr = 0.f;
    for (int n = tid; n < D; n += 512) { float s = 0.f; const float* w = a.in[I_WO] + (size_t)j * 1024 * 1024 + n; _Pragma("nounroll") for (int k = 0; k < 1024; ++k) s += orow[k] * w[(size_t)k * 1024];
        const float dl = dbg_mod(a, layer, r, 2 * D + n) * s, ref = resid_row(a, 0, r)[n] + dl; err = fmaxf(err, fabsf(ref - ((const float*)(a.ws + WS_X))[(size_t)r * D + n])); sr += dl * dl; }
    err = blk_max(err, red, tid); sr = blk_sum(sr, red, tid); dbg_report(a, id, err, sr, D, tid);
}
__device__ __forceinline__ void chk_moe(const Args& a, int layer, int id_tok, int id_y, LAS unsigned char* ldsb) {
    if (blockIdx.x >= 16) return; const int tid = tid_opaque(), r = dbg_sample_row(blockIdx.x);
    if (layer == 3 && r >= TL) return;
    LAS float* red = (LAS float*)ldsb; LAS float* tok = red + 16; LAS float* lg = tok + 1024; LAS float* tkb = lg + 64; LAS float* act = tkb + 1024; LAS float* rt = act + 1024;
    const float* x = (const float*)(a.ws + WS_X) + (size_t)r * D; const bf16* tk = (const bf16*)(a.ws + WS_TK) + (size_t)r * D;
    float ss = 0.f; for (int cc = tid; cc < D; cc += 512) ss += x[cc] * x[cc];
    ss = blk_sum(ss, red, tid); const float rstd = rsqrtf(ss / D + EPS);
    float err = 0.f, sr = 0.f;
    for (int cc = tid; cc < D; cc += 512) { const float sh = dbg_mod(a, layer, r, 3 * D + cc), sc = dbg_mod(a, layer, r, 4 * D + cc);
        const float ref = x[cc] * rstd * a.in[I_NFFN][layer * D + cc] * (1.f + sc) + sh; tok[cc] = ref;
#if MOE_FP8
        tkb[cc] = __builtin_amdgcn_cvt_f32_fp8((unsigned)((const unsigned char*)(a.ws + WS_TK))[(size_t)r * D + cc], 0);
#else
        tkb[cc] = bf2f(tk[cc]);
#endif
        err = fmaxf(err, fabsf(ref - tkb[cc])); sr += ref * ref; }
    err = blk_max(err, red, tid); sr = blk_sum(sr, red, tid);
    if (tid < 36) { float s = 0.f; _Pragma("nounroll") for (int k = 0; k < 1024; ++k) s += tok[k] * (tid < 4 ? a.in[I_WRG][((size_t)layer * 1024 + k) * 4 + tid] : a.in[I_WRE][((size_t)layer * 1024 + k) * 32 + tid - 4]); lg[tid] = s; }
    __syncthreads();
    if (tid == 0) { int grp = 0; _Pragma("nounroll") for (int q = 1; q < 4; ++q) if (lg[q] > lg[grp]) grp = q; float den = 0.f; _Pragma("nounroll") for (int q = 0; q < 4; ++q) den += expf(lg[q] - lg[grp]);
        const LAS float* le = lg + 4 + grp * 8; int i0 = 0; _Pragma("nounroll") for (int q = 1; q < 8; ++q) if (le[q] > le[i0]) i0 = q; int i1 = -1; _Pragma("nounroll") for (int q = 0; q < 8; ++q) if (q != i0 && (i1 < 0 || le[q] > le[i1])) i1 = q;
        const float ex = expf(le[i1] - le[i0]), w0 = 1.f / den / (1.f + ex), w1 = 1.f / den * ex / (1.f + ex);
        rt[0] = (float)(grp * 8 + i0); rt[1] = (float)(grp * 8 + i1); rt[2] = w0; rt[3] = w1;
        const float* w2 = (const float*)(a.ws + WS_W2); float e2 = fmaxf(fabsf(w2[2 * r] - w0), fabsf(w2[2 * r + 1] - w1)) * 30.f;
        const int* list = (const int*)(a.ws + WS_LIST); const unsigned* gc = (const unsigned*)(a.ws + WS_CTL) + CW_CNT + layer * 32;
        _Pragma("nounroll") for (int k = 0; k < 2; ++k) { const int e = (int)rt[k]; bool found = false; const int n = (int)gc[e]; _Pragma("nounroll") for (int q = 0; q < n && q < MOE_CAP; ++q) if (list[e * MOE_CAP + q] == 2 * r + k) found = true; if (!found) e2 = 1e6f; }
        rt[4] = e2; }
    __syncthreads();
    err = fmaxf(err, rt[4] * sqrtf(sr / D));
    dbg_report(a, id_tok, err, sr, D, tid);
    float err2 = 0.f, sr2 = 0.f;
    _Pragma("nounroll") for (int k = 0; k < 2; ++k) { const int e = (int)rt[k]; const float wk = rt[2 + k];
        const float* wgu = a.in[I_WGU] + ((size_t)layer * 32 + e) * 1024 * 1024; const float* wdn = a.in[I_WDN] + ((size_t)layer * 32 + e) * 512 * 1024;
        { float sg = 0.f, su = 0.f; _Pragma("nounroll") for (int q = 0; q < 1024; ++q) { sg += tkb[q] * wgu[(size_t)q * 1024 + tid]; su += tkb[q] * wgu[(size_t)q * 1024 + 512 + tid]; } act[tid] = (sg / (1.f + expf(-sg))) * su; }
        __syncthreads();
        for (int n = tid; n < D; n += 512) { float s = 0.f; _Pragma("nounroll") for (int q = 0; q < 512; ++q) s += act[q] * wdn[(size_t)q * 1024 + n]; s *= wk;
            err2 = fmaxf(err2, fabsf(s - bf2f(((const bf16*)(a.ws + WS_Y2))[(size_t)(2 * r + k) * D + n]))); sr2 += s * s; }
        __syncthreads(); }
    err2 = blk_max(err2, red, tid); sr2 = blk_sum(sr2, red, tid); dbg_report(a, id_y, err2, sr2, 2 * D, tid);
}

__global__ void __launch_bounds__(NTHREADS) dbg_kernel(Args a, int ty, int layer, int id) {
    extern __shared__ __attribute__((aligned(16))) unsigned char lds_dbg[];
    LAS unsigned char* l = (LAS unsigned char*)lds_dbg;
    if (ty == 1) chk_rmix(a, layer, id, l); else if (ty == 2) chk_qkv(a, layer, id, l); else if (ty == 3) chk_att(a, layer, id, l);
    else if (ty == 4) chk_oproj(a, layer, id, l); else if (ty == 5) chk_moe(a, layer, id, id + 1, l);
}
#endif

template <int KIND, int LAYER> __device__ __forceinline__ void run_phase(const Args& a0, Ctx& c, unsigned char* lds_gen) {
    Args a = a0; { unsigned long long wsv = (unsigned long long)a0.ws; asm volatile("" : "+s"(wsv)); a.ws = (unsigned char*)(GAS unsigned char*)wsv; }
    { unsigned lb = (unsigned)(uintptr_t)(LAS unsigned char*)lds_gen; asm volatile("" : "+s"(lb)); c.lds = (LAS unsigned char*)(uintptr_t)lb; }
    c.tid = tid_opaque(); c.lane = c.tid & 63;
    unsigned char* const ws = a.ws; constexpr int layer = LAYER;
    if constexpr (KIND == K_P0) p0_prologue(a, c);
    else if constexpr (KIND == K_RMIX) ph_rmix(a, c, layer);
    else if constexpr (KIND == K_QKV) { constexpr int j = layer ? 1 : 0;
#if ATT_FP8
        SchedQKV S{(const char*)(ws + WS_HB), (const char*)(ws + WS_WQKV) + (size_t)j * 1536 * 1024, (size_t)256 * 1024, layer == 0 ? 1 : 0, c.G, (int)blockIdx.x};
        EpiQKV E{(bf16*)(ws + WS_Q), (bf16*)(ws + WS_K), (bf16*)(ws + WS_V), a.in[I_QG] + j * 64, a.in[I_KG] + j * 64, (const f32x2*)(ws + WS_ROPE)};
        pg8::gemm_phase<EpiQKV, SchedQKV, false, true>(c.lds, 1024, 1024, S, E, 127 - MOE_WSH, 127); }
#else
        SchedQKV S{(const char*)(ws + WS_HB), (const char*)(ws + WS_WQKV) + (size_t)j * 1536 * 1024 * 2, (size_t)256 * 1024 * 2, layer == 0 ? 1 : 0, c.G, (int)blockIdx.x};
        EpiQKV E{(bf16*)(ws + WS_Q), (bf16*)(ws + WS_K), (bf16*)(ws + WS_V), a.in[I_QG] + j * 64, a.in[I_KG] + j * 64, (const f32x2*)(ws + WS_ROPE)};
        pg8::gemm_phase<EpiQKV, SchedQKV, false>(c.lds, 2048, 2048, S, E); }
#endif
    else if constexpr (KIND == K_ROPE) ph_rope(a, c, layer);
    else if constexpr (KIND == K_ATT) ph_att(a, c, layer, (char*)c.lds);
    else if constexpr (KIND == K_OPROJ) { constexpr int j = layer ? 1 : 0;
#if ATT_FP8
        SchedDense S{(const char*)(ws + WS_HB), (const char*)(ws + WS_WO) + (size_t)j * 1024 * 1024, (size_t)256 * 1024, (size_t)256 * 1024, 0, layer == 3 ? 64 : 68, 4, c.G, (int)blockIdx.x};
        EpiResid E{&a, layer, nullptr, nullptr};
        pg8::gemm_phase<EpiResid, SchedDense, false, true>(c.lds, 1024, 1024, S, E, 127 - MOE_WSH, 127 - ATT_OSH); }
#else
        SchedDense S{(const char*)(ws + WS_HB), (const char*)(ws + WS_WO) + (size_t)j * 1024 * 1024 * 2, (size_t)256 * 1024 * 2, (size_t)256 * 1024 * 2, 0, layer == 3 ? 64 : 68, 4, c.G, (int)blockIdx.x};
        EpiResid E{&a, layer, nullptr, nullptr};
        pg8::gemm_phase<EpiResid, SchedDense, false>(c.lds, 2048, 2048, S, E); }
#endif
    else if constexpr (KIND == K_M1) ph_m1(a, c, layer);
    else if constexpr (KIND == K_M2) {
        LAS int* tab = (LAS int*)(c.lds + TAB_OFF); moe_tables(a, c, layer, tab);
        unsigned* rdy = (unsigned*)(ws + WS_CTL) + CW_RDY + layer * 256;
#if MOE_FP8
        { SchedMoe S{(const char*)(ws + WS_TK), 0, (const char*)(ws + WS_WGU) + (size_t)layer * 32 * 1024 * 1024, (size_t)1024 * 1024, (size_t)256 * 1024, tab, (const int*)(ws + WS_LIST), c.G, (int)blockIdx.x, rdy, 1};
          EpiGateUp E{(bf16*)(ws + WS_ACT)};
          pg8::gemm_phase<EpiGateUp, SchedMoe, true, true>(c.lds, 1024, 1024, S, E, 127 - MOE_WSH, 127); }
        { SchedMoe S{(const char*)(ws + WS_ACT), (size_t)256 * 512, (const char*)(ws + WS_WDN) + (size_t)layer * 32 * 1024 * 512, (size_t)1024 * 512, (size_t)256 * 512, tab, (const int*)(ws + WS_LIST), c.G, (int)blockIdx.x, rdy, 2};
          EpiDown E{(const int*)(ws + WS_LIST), (const float*)(ws + WS_W2), (bf16*)(ws + WS_Y2)};
          pg8::gemm_phase<EpiDown, SchedMoe, false, true>(c.lds, 512, 512, S, E, 127 - MOE_WSH, 127 - MOE_ASH); } }
#else
        { SchedMoe S{(const char*)(ws + WS_TK), 0, (const char*)(ws + WS_WGU) + (size_t)layer * 32 * 1024 * 1024 * 2, (size_t)1024 * 1024 * 2, (size_t)256 * 1024 * 2, tab, (const int*)(ws + WS_LIST), c.G, (int)blockIdx.x, rdy, 1};
          EpiGateUp E{(bf16*)(ws + WS_ACT)};
          pg8::gemm_phase<EpiGateUp, SchedMoe, true>(c.lds, 2048, 2048, S, E); }
        { SchedMoe S{(const char*)(ws + WS_ACT), (size_t)256 * 512 * 2, (const char*)(ws + WS_WDN) + (size_t)layer * 32 * 1024 * 512 * 2, (size_t)1024 * 512 * 2, (size_t)256 * 512 * 2, tab, (const int*)(ws + WS_LIST), c.G, (int)blockIdx.x, rdy, 2};
          EpiDown E{(const int*)(ws + WS_LIST), (const float*)(ws + WS_W2), (bf16*)(ws + WS_Y2)};
          pg8::gemm_phase<EpiDown, SchedMoe, false>(c.lds, 1024, 1024, S, E); } }
#endif
    else if constexpr (KIND == K_RPOOL) ph_rpool(a, c, layer);
    else if constexpr (KIND == K_POOLG) {
        SchedDense S{(const char*)(ws + WS_HB), (const char*)(ws + WS_WPOOL), (size_t)256 * 1024 * 2, (size_t)256 * 256 * 2, (size_t)256 * 2, 68, 4, c.G, (int)blockIdx.x};
        EpiResid E{&a, layer, a.in[I_POOLS], (const float*)(ws + WS_Z)};
        pg8::gemm_phase<EpiResid, SchedDense, false>(c.lds, 512, 2048, S, E); }
    else if constexpr (KIND == K_INPROJ) {
        SchedDense S{(const char*)(ws + WS_HB), (const char*)(ws + WS_WIN), (size_t)256 * 1024 * 2, (size_t)256 * 1024 * 2, 0, 68, 21, c.G, (int)blockIdx.x};
        EpiInproj E{(bf16*)(ws + WS_Z), (bf16*)(ws + WS_XBC), (float*)(ws + WS_DT), a.in[I_DTB]};
        pg8::gemm_phase<EpiInproj, SchedDense, false>(c.lds, 2048, 2048, S, E); }
    else if constexpr (KIND == K_CONV) ph_conv(a, c);
    else if constexpr (KIND == K_SCAN) ph_scan(a, c);
    else if constexpr (KIND == K_YPH) ph_yph(a, c);
    else if constexpr (KIND == K_GFIX) ph_gfix(a, c);
    else if constexpr (KIND == K_OUTPROJ) {
        SchedDense S{(const char*)(ws + WS_G), (const char*)(ws + WS_WOUT), (size_t)256 * 2048 * 2, (size_t)256 * 2048 * 2, 0, 68, 4, c.G, (int)blockIdx.x};
        EpiResid E{&a, layer, nullptr, nullptr};
        pg8::gemm_phase<EpiResid, SchedDense, false>(c.lds, 4096, 4096, S, E); }
    else if constexpr (KIND == K_FINAL) ph_final(a, c, layer);
}
#define PROGRAM(X) \
    X(0, K_P0, 0) \
    X(1, K_RMIX, 0) X(2, K_QKV, 0) X(3, K_ATT, 0) X(4, K_OPROJ, 0) X(5, K_M1, 0) X(6, K_M2, 0) \
    X(7, K_RPOOL, 1) X(8, K_POOLG, 1) X(9, K_M1, 1) X(10, K_M2, 1) \
    X(11, K_RMIX, 2) X(12, K_INPROJ, 2) X(13, K_CONV, 2) X(14, K_SCAN, 2) X(15, K_YPH, 2) X(16, K_OUTPROJ, 2) X(17, K_M1, 2) X(18, K_M2, 2) \
    X(19, K_RMIX, 3) X(20, K_QKV, 3) X(21, K_ATT, 3) X(22, K_OPROJ, 3) X(23, K_M1, 3) X(24, K_M2, 3) \
    X(25, K_FINAL, 4)
constexpr int NPHASES = 26;
__device__ __forceinline__ unsigned long long probe_phases(const unsigned long long* ts, unsigned mask) { unsigned long long r = 0; for (int k = 0; k < 32; ++k) if (mask & (1u << k)) r += ts[k + 1] - ts[k]; return r; }
__device__ __forceinline__ unsigned long long probe_sum(const unsigned long long* s, int mask) { unsigned long long r = 0; for (int k = 0; k < 8; ++k) if (mask & (1 << k)) r += s[k]; return r; }
__global__ void __launch_bounds__(NTHREADS, 2) mega(Args a0) {
    extern __shared__ __attribute__((aligned(16))) unsigned char lds_raw[];
    Ctx c; c.lds = (LAS unsigned char*)lds_raw; c.tid = threadIdx.x; c.lane = c.tid & 63; c.wave = __builtin_amdgcn_readfirstlane(c.tid >> 6);
    c.G = gridDim.x; { const int bx = blockIdx.x; c.vcu = (c.G % 8 == 0) ? (bx % 8) * (c.G / 8) + bx / 8 : bx; }
    volatile LAS unsigned* MISC = (volatile LAS unsigned*)(c.lds + MISC_OFF);
    for (int u = c.tid; u < 128; u += NTHREADS) MISC[u] = 0u;
    __syncthreads();
    XcdBarrier bar = xcd_barrier_post((unsigned*)(a0.ws + WS_CTL) + CW_BAR + a0.bar_region * XCD_BAR_WORDS, MISC + 8);
    const int lo = a0.ph_lo, hi = a0.ph_hi;
#if PROBE
#define STAMP(idx) if (blockIdx.x == 0 && threadIdx.x == 0) __hip_atomic_store((unsigned long long*)((unsigned*)(a0.ws + WS_CTL) + CW_TS) + (idx), (unsigned long long)__builtin_amdgcn_s_memrealtime(), __ATOMIC_RELAXED, __HIP_MEMORY_SCOPE_AGENT);
#else
#define STAMP(idx)
#endif
    STAMP(0)
#if EXTRA_BARS
    for (int eb = 0; eb < EXTRA_BARS; ++eb) xcd_barrier(bar);
#endif
#define RUNPH(idx, KIND, LAYER) if (lo <= (idx) && (idx) < hi) { run_phase<KIND, LAYER>(a0, c, lds_raw); if ((idx) + 1 < hi) xcd_barrier(bar); STAMP((idx) + 1) }
    PROGRAM(RUNPH)
#undef RUNPH
#if PROBE
    if (blockIdx.x == 0 && threadIdx.x == 0 && hi == NPHASES) { const unsigned long long* ts = (const unsigned long long*)((unsigned*)(a0.ws + WS_CTL) + CW_TS);
        const unsigned long long d = (unsigned long long)PROBE_K * (PROBE_SLOT ? probe_sum(ts + PROBE_SLOT_BASE, PROBE_SLOT) : probe_phases(ts, PROBE_MASK)), t0 = __builtin_amdgcn_s_memrealtime();
        while (__builtin_amdgcn_s_memrealtime() - t0 < d) __builtin_amdgcn_s_sleep(8); }
#endif
}

extern "C" void kernel_launch(void* const* d_in, const int* in_sizes, int n_in, void* d_out, int out_size, void* d_ws, size_t ws_size, hipStream_t stream) {
    static int grid = 0;
    if (grid == 0) {
        if (n_in != N_IN || out_size != TL * D || ws_size < WS_END) { fprintf(stderr, "kernel_launch: unexpected shapes (n_in %d out %d ws %zu)\n", n_in, out_size, ws_size); grid = -1; return; }
        int dev = 0, cus = 0;
        if (hipGetDevice(&dev) != hipSuccess || hipDeviceGetAttribute(&cus, hipDeviceAttributeMultiprocessorCount, dev) != hipSuccess) { grid = -1; return; }
        if (hipFuncSetAttribute((const void*)mega, hipFuncAttributeMaxDynamicSharedMemorySize, LDS_BYTES) != hipSuccess) { fprintf(stderr, "kernel_launch: hipFuncSetAttribute failed\n"); grid = -1; return; }
        int per_cu = 0;
        if (hipOccupancyMaxActiveBlocksPerMultiprocessor(&per_cu, (const void*)mega, NTHREADS, LDS_BYTES) != hipSuccess || per_cu < 1) fprintf(stderr, "kernel_launch: occupancy query says %d\n", per_cu);
        (void)hipGetLastError();
        grid = cus;
    }
    if (grid < 0) return;
    (void)hipMemsetAsync((char*)d_ws + WS_CTL, 0, CTL_ZERO_BYTES, stream);
    Args a{};
    for (int i = 0; i < N_IN; ++i) a.in[i] = (const float*)d_in[i];
    a.out = (float*)d_out; a.ws = (unsigned char*)d_ws; a.flags = 0;
#if DEBUG_CHECKS
    struct Cut { int after; int ty, layer, nid; };
    const Cut cuts[] = DEBUG_CUTS;
    int lo = 0, region = 0, dbg_id = 1;
    for (unsigned k = 0; k < sizeof(cuts) / sizeof(cuts[0]); ++k) {
        if (cuts[k].after + 1 > lo) { a.ph_lo = lo; a.ph_hi = cuts[k].after + 1; a.bar_region = region++; hipLaunchKernelGGL(mega, dim3(grid), dim3(NTHREADS), LDS_BYTES, stream, a); lo = cuts[k].after + 1; }
        hipLaunchKernelGGL(dbg_kernel, dim3(16), dim3(NTHREADS), 65536, stream, a, cuts[k].ty, cuts[k].layer, dbg_id); dbg_id += cuts[k].nid;
    }
    a.ph_lo = lo; a.ph_hi = NPHASES; a.bar_region = region++;
    hipLaunchKernelGGL(mega, dim3(grid), dim3(NTHREADS), LDS_BYTES, stream, a);
#else
    a.ph_lo = 0; a.ph_hi = NPHASES; a.bar_region = 0;
    hipLaunchKernelGGL(mega, dim3(grid), dim3(NTHREADS), LDS_BYTES, stream, a);
#endif
}
```

```cpp
#include <hip/hip_runtime.h>
#include <cstdio>
#include <cstdint>

#define LAS __attribute__((address_space(3)))
#define GAS __attribute__((address_space(1)))
typedef unsigned short bf16;
typedef short bf16x8 __attribute__((ext_vector_type(8)));
typedef short s16x4 __attribute__((ext_vector_type(4)));
typedef float f32x2 __attribute__((ext_vector_type(2)));
typedef float f32x4 __attribute__((ext_vector_type(4)));
typedef float f32x16 __attribute__((ext_vector_type(16)));
typedef unsigned u32x2 __attribute__((ext_vector_type(2)));
typedef unsigned u32x4 __attribute__((ext_vector_type(4)));
typedef __bf16 bf16x2_t __attribute__((ext_vector_type(2)));

constexpr int D = 1024, NB = 4, SEQ = 4096, CTXL = 256, TL = NB * SEQ, TC = NB * CTXL, TT = TL + TC;
constexpr int KVROWS = SEQ + CTXL;
constexpr int NCH = TT / 128;
constexpr int MOE_CAP = TT;
constexpr float EPS = 1e-6f;
constexpr int NWAVES = 8, NTHREADS = 512;
#ifndef NLAYERS
#define NLAYERS 4
#endif
#ifndef MOE_FP8
#define MOE_FP8 1
#endif
#define MOE_WSH 5
#ifndef ATT_FP8
#define ATT_FP8 1
#endif
#define ATT_OSH 3
#define MOE_ASH 2
#define DBG_TOL 0.03f
#ifndef DEBUG_CHECKS
#define DEBUG_CHECKS 0
#endif
#ifndef PROBE
#define PROBE 0
#endif
#define PROBE_A0 0
#define PROBE_A1 1
#define PROBE_B0 4
#define PROBE_B1 5
#define PROBE_K 2
#define PROBE_MASK 0x1222224u
#define EXTRA_BARS 0
#define PROBE_SLOT_BASE 40
#define PROBE_SLOT 0
#if PROBE
#define SECT_DECL unsigned long long sect_t = __builtin_amdgcn_s_memrealtime(); unsigned long long sect_acc[8] = {0, 0, 0, 0, 0, 0, 0, 0};
#define SECT(k) do { const unsigned long long n_ = __builtin_amdgcn_s_memrealtime(); sect_acc[k] += n_ - sect_t; sect_t = n_; } while (0)
#define SECT_END(base) do { if (blockIdx.x == 0 && threadIdx.x == 0) { _Pragma("unroll") for (int k_ = 0; k_ < 8; ++k_) ((unsigned long long*)((unsigned*)(a.ws + WS_CTL) + CW_TS))[(base) + k_] = sect_acc[k_]; } } while (0)
#else
#define SECT_DECL
#define SECT(k) do {} while (0)
#define SECT_END(base) do {} while (0)
#endif
#define DEBUG_CUTS { {1, 1, 0, 1}, {2, 2, 0, 1}, {3, 3, 0, 1}, {4, 4, 0, 1}, {6, 5, 0, 2} }

enum { I_X = 0, I_C, I_CTX, I_CCTX, I_WADA, I_BADA, I_NMIX, I_NFFN, I_NFIN, I_WQKV, I_WO, I_QG, I_KG, I_POOLW, I_POOLS, I_WIN, I_CONVW, I_CONVB, I_DTB, I_ALOG, I_DSK, I_SNORM, I_WOUT, I_WRG, I_WRE, I_WGU, I_WDN, N_IN };

constexpr size_t MiB = 1u << 20;
constexpr size_t WS_CTL = 0, CTL_ZERO_BYTES = 1 * MiB;
constexpr size_t WS_MODL = 1 * MiB;
constexpr size_t WS_MODC = WS_MODL + 4 * 4 * 6144 * 4;
constexpr size_t WS_ROPE = 1 * MiB + 512 * 1024;
constexpr size_t WS_WR = 2 * MiB;
constexpr size_t WS_WQKV = 3 * MiB;
constexpr size_t WS_WO = 9 * MiB;
constexpr size_t WS_WPOOL = 13 * MiB;
constexpr size_t WS_WIN = 14 * MiB;
constexpr size_t WS_WOUT = 25 * MiB;
constexpr size_t WS_WGU = 29 * MiB;
constexpr size_t WS_WDN = 285 * MiB;
constexpr size_t WS_X = 413 * MiB;
constexpr size_t WS_HB = 481 * MiB;
constexpr size_t WS_TK = 515 * MiB;
constexpr size_t WS_Q = 549 * MiB;
constexpr size_t WS_K = 583 * MiB;
constexpr size_t WS_V = 592 * MiB;
constexpr size_t WS_Y2 = 601 * MiB;
constexpr size_t WS_ACT = 669 * MiB;
constexpr size_t WS_LIST = 711 * MiB;
constexpr size_t WS_W2 = 714 * MiB;
constexpr size_t WS_Z = 715 * MiB;
constexpr size_t WS_XBC = 783 * MiB;
constexpr size_t WS_DT = 885 * MiB;
constexpr size_t WS_XT = 890 * MiB;
constexpr size_t WS_BN = 958 * MiB;
constexpr size_t WS_BT = 975 * MiB;
constexpr size_t WS_CN = 992 * MiB;
constexpr size_t WS_SCA = 1009 * MiB;
constexpr size_t WS_SCB = 1018 * MiB;
constexpr size_t WS_DEC = 1027 * MiB;
constexpr size_t WS_HIN = 1028 * MiB;
constexpr size_t WS_G = 1164 * MiB;
constexpr size_t WS_RSTD = 1232 * MiB;
constexpr size_t WS_END = 1233 * MiB;

constexpr int CW_BAR = 4096;
constexpr int CW_CNT = 200000;
constexpr int CW_DBG = 201000;
constexpr int CW_RDY = 204000;
constexpr int CW_RDX = 206000;
constexpr int CW_TS = 202000;

constexpr int LDS_BYTES = 163840;
constexpr int MISC_OFF = LDS_BYTES - 512;

__device__ __forceinline__ unsigned cvtpk(float lo, float hi) { f32x2 v = {lo, hi}; bf16x2_t b = __builtin_convertvector(v, bf16x2_t); return __builtin_bit_cast(unsigned, b); }
__device__ __forceinline__ unsigned pk_fp8x4(float a, float b, float c, float d) {
    a = __builtin_amdgcn_fmed3f(a, -448.f, 448.f); b = __builtin_amdgcn_fmed3f(b, -448.f, 448.f); c = __builtin_amdgcn_fmed3f(c, -448.f, 448.f); d = __builtin_amdgcn_fmed3f(d, -448.f, 448.f);
    unsigned w = __builtin_amdgcn_cvt_pk_fp8_f32(a, b, 0u, false); return __builtin_amdgcn_cvt_pk_fp8_f32(c, d, w, true); }
__device__ __forceinline__ float bflo(unsigned u) { return __uint_as_float(u << 16); }
__device__ __forceinline__ float bfhi(unsigned u) { return __uint_as_float(u & 0xffff0000u); }
__device__ __forceinline__ float bf2f(bf16 b) { return __uint_as_float((unsigned)b << 16); }
__device__ __forceinline__ float wave_sum(float v) {
#pragma unroll
    for (int o = 1; o < 64; o <<= 1) v += __shfl_xor(v, o);
    return v;
}
__device__ __forceinline__ float silu_f(float v) { return v * __builtin_amdgcn_rcpf(1.0f + __builtin_amdgcn_exp2f(v * -1.4426950408889634f)); }
__device__ __forceinline__ int tid_opaque() { int t = threadIdx.x; asm volatile("" : "+v"(t)); return t; }
#define LDS_WAIT() asm volatile("s_waitcnt lgkmcnt(0)" ::: "memory")
#define VM_WAIT() asm volatile("s_waitcnt vmcnt(0)" ::: "memory")

#define XB_TMO      128
#define XB_XCNT(j)  (256  + 64 * (j))
#define XB_XSUB(j)  (1280 + 64 * (j))
#define XB_XGEN(j)  (2304 + 64 * (j))
#define XB_TOP      3328
#define XB_TOPGEN   3392
#define XCD_BAR_WORDS 3456
#define XB_SPIN_CAP (1u << 20)
__device__ __forceinline__ unsigned xb_ld(unsigned* p)              { return __hip_atomic_load(p, __ATOMIC_RELAXED, __HIP_MEMORY_SCOPE_AGENT); }
__device__ __forceinline__ unsigned xb_add(unsigned* p, unsigned v) { return __hip_atomic_fetch_add(p, v, __ATOMIC_RELAXED, __HIP_MEMORY_SCOPE_AGENT); }
__device__ __forceinline__ unsigned xb_xcc_id() { return (unsigned)__builtin_amdgcn_s_getreg((3 << 11) | 20) & 0xFu; }
#define XB_SPIN(cond, bar) do { unsigned _sp = 0; while (cond) { __builtin_amdgcn_s_sleep(1); \
    if ((++_sp & 255u) == 0u) { if (xb_ld(&(bar)[XB_TMO])) break; if (_sp > XB_SPIN_CAP) { atomicAdd(&(bar)[XB_TMO], 1u); break; } } } } while (0)
struct XcdBarrier { unsigned* bar; unsigned x; volatile LAS unsigned* st; };
__device__ __forceinline__ XcdBarrier xcd_barrier_post(unsigned* bar, volatile LAS unsigned* st) {
    XcdBarrier b; b.bar = bar; b.x = xb_xcc_id(); b.st = st;
    if (threadIdx.x == 0) (void)xb_add(&bar[XB_XCNT(b.x)], 1u);
    return b;
}
__device__ __forceinline__ void xcd_barrier_complete(unsigned* bar, unsigned x, unsigned& nloc, unsigned& nx) {
    const unsigned G = gridDim.x * gridDim.y * gridDim.z;
    unsigned sum, cnt, mine, sp = 0u;
    for (;;) {
        sum = 0u; cnt = 0u; mine = 0u;
#pragma unroll
        for (unsigned j = 0; j < 16; ++j) { const unsigned c = xb_ld(&bar[XB_XCNT(j)]); sum += c; cnt += (c > 0u) ? 1u : 0u; mine = (j == x) ? c : mine; }
        if (sum == G) break;
        __builtin_amdgcn_s_sleep(1);
        if ((++sp & 255u) == 0u) { if (xb_ld(&bar[XB_TMO])) break; if (sp > XB_SPIN_CAP) { atomicAdd(&bar[XB_TMO], 1u); break; } }
    }
    nloc = mine > 0u ? mine : 1u; nx = cnt > 0u ? cnt : 1u;
}
__device__ __forceinline__ void xcd_barrier(const XcdBarrier& b) {
    asm volatile("s_waitcnt vmcnt(0)" ::: "memory");
    __syncthreads();
    if (threadIdx.x == 0) {
        unsigned* bar = b.bar;
        __builtin_amdgcn_s_waitcnt(0);
        unsigned nloc = b.st[0], nx = b.st[1];
        if (nloc == 0u) { xcd_barrier_complete(bar, b.x, nloc, nx); b.st[0] = nloc; b.st[1] = nx; }
        const unsigned old = xb_add(&bar[XB_XSUB(b.x)], 1u);
        const unsigned gen = old / nloc;
        if (old + 1u == (gen + 1u) * nloc) {
            __builtin_amdgcn_fence(__ATOMIC_RELEASE, "agent");
            asm volatile("s_waitcnt vmcnt(0)" ::: "memory");
            const unsigned og = xb_add(&bar[XB_TOP], 1u);
            const unsigned tg = og / nx;
            if (og + 1u == (tg + 1u) * nx) xb_add(&bar[XB_TOPGEN], 1u);
            else XB_SPIN(xb_ld(&bar[XB_TOPGEN]) == tg, bar);
            __builtin_amdgcn_fence(__ATOMIC_ACQUIRE, "agent");
            xb_add(&bar[XB_XGEN(b.x)], 1u);
            asm volatile("s_waitcnt vmcnt(0)" ::: "memory");
        } else {
            XB_SPIN(xb_ld(&bar[XB_XGEN(b.x)]) == gen, bar);
            __builtin_amdgcn_fence(__ATOMIC_ACQUIRE, "agent");
            asm volatile("s_waitcnt vmcnt(0)" ::: "memory");
        }
    }
    __syncthreads();
}

enum { K_P0 = 0, K_RMIX, K_QKV, K_ROPE, K_ATT, K_OPROJ, K_M1, K_M2, K_M3, K_RPOOL, K_POOLG, K_INPROJ, K_CONV, K_SCAN, K_YPH, K_GFIX, K_OUTPROJ, K_FINAL, K_DBG };
struct Args { const float* in[N_IN]; float* out; unsigned char* ws; int ph_lo, ph_hi; int flags; int bar_region; };

struct Ctx {
    LAS unsigned char* lds; int tid, lane, wave, vcu, G;
};

__device__ __forceinline__ const float* mod_row(const Args& a, int layer, int r) {
    return r < TL ? (const float*)(a.ws + WS_MODL) + (size_t)(layer * 4 + r / SEQ) * 6144 : (const float*)(a.ws + WS_MODC) + (size_t)layer * 6144;
}
__device__ __forceinline__ const float* resid_row(const Args& a, int layer, int r) {
    if (layer == 0) return r < TL ? a.in[I_X] + (size_t)r * D : a.in[I_CTX] + (size_t)(r - TL) * D;
    return (const float*)(a.ws + WS_X) + (size_t)r * D;
}

__device__ __forceinline__ void load_row_combined(const Args& a, int layer, int r, int lane, f32x4 (&v)[4]) {
    const f32x4* xr = (const f32x4*)resid_row(a, layer, r) + lane;
#pragma unroll
    for (int j = 0; j < 4; ++j) v[j] = xr[64 * j];
    if (layer > 0 && !(a.flags & 1)) {
        const f32x4* gf = (const f32x4*)(mod_row(a, layer - 1, r) + 5 * D) + lane;
        const u32x2* y0 = (const u32x2*)((const bf16*)(a.ws + WS_Y2) + (size_t)(2 * r) * D) + lane;
        const u32x2* y1 = (const u32x2*)((const bf16*)(a.ws + WS_Y2) + (size_t)(2 * r + 1) * D) + lane;
#pragma unroll
        for (int j = 0; j < 4; ++j) {
            const u32x2 p = y0[64 * j], q = y1[64 * j]; const f32x4 g = gf[64 * j];
            v[j].x += g.x * (bflo(p.x) + bflo(q.x)); v[j].y += g.y * (bfhi(p.x) + bfhi(q.x));
            v[j].z += g.z * (bflo(p.y) + bflo(q.y)); v[j].w += g.w * (bfhi(p.y) + bfhi(q.y));
        }
    }
}
__device__ __forceinline__ float row_rstd(const f32x4 (&v)[4]) {
    float s = 0.f;
#pragma unroll
    for (int j = 0; j < 4; ++j) s += (v[j].x * v[j].x + v[j].y * v[j].y) + (v[j].z * v[j].z + v[j].w * v[j].w);
    return rsqrtf(wave_sum(s) * (1.0f / D) + EPS);
}
__device__ __forceinline__ void norm_mod(const f32x4 (&v)[4], float rstd, const float* g, const float* shift, const float* scale, int lane, f32x4 (&h)[4]) {
#pragma unroll
    for (int j = 0; j < 4; ++j) {
        const f32x4 gg = ((const f32x4*)g)[lane + 64 * j], sh = ((const f32x4*)shift)[lane + 64 * j], sc = ((const f32x4*)scale)[lane + 64 * j];
        h[j] = (v[j] * rstd) * gg * (sc + 1.0f) + sh;
    }
}

__device__ __forceinline__ void tr_item(const float* W, int N, int k0, int n0, bf16* WT, size_t drow0, int dK, LAS float* scr, int lane, int hi_skip = 0) {
    const int nq = lane & 15, kr = lane >> 4;
#pragma unroll
    for (int i = 0; i < 16; ++i) { const int kk = 4 * i + kr; const f32x4 v = *(const f32x4*)(W + (size_t)(k0 + kk) * N + n0 + 4 * nq);
        LAS float* d = scr + kk * 65 + 4 * nq; d[0] = v.x; d[1] = v.y; d[2] = v.z; d[3] = v.w; }
    LDS_WAIT(); asm volatile("" ::: "memory");
    const int c = lane & 7;
#pragma unroll
    for (int j = 0; j < 8; ++j) { const int n = (lane >> 3) + 8 * j; const LAS float* s = scr + (8 * c) * 65 + n;
        u32x4 o; o.x = cvtpk(s[0 * 65], s[1 * 65]); o.y = cvtpk(s[2 * 65], s[3 * 65]); o.z = cvtpk(s[4 * 65], s[5 * 65]); o.w = cvtpk(s[6 * 65], s[7 * 65]);
        *(u32x4*)(WT + (drow0 + n + (n >= 32 ? hi_skip : 0)) * dK + k0 + 8 * c) = o; }
    LDS_WAIT(); asm volatile("" ::: "memory");
}
__device__ __forceinline__ void tr_item8(const float* W, int N, int k0, int n0, unsigned char* WT, size_t drow0, int dKb, LAS float* scr, int lane, float scale, int hi_skip = 0) {
    const int nq = lane & 15, kr = lane >> 4;
#pragma unroll
    for (int i = 0; i < 16; ++i) { const int kk = 4 * i + kr; const f32x4 v = *(const f32x4*)(W + (size_t)(k0 + kk) * N + n0 + 4 * nq);
        LAS float* d = scr + kk * 65 + 4 * nq; d[0] = v.x; d[1] = v.y; d[2] = v.z; d[3] = v.w; }
    LDS_WAIT(); asm volatile("" ::: "memory");
    const int c = lane & 3;
#pragma unroll
    for (int j = 0; j < 4; ++j) { const int n = (lane >> 2) + 16 * j; const LAS float* s = scr + (16 * c) * 65 + n;
        u32x4 o; o.x = pk_fp8x4(s[0 * 65] * scale, s[1 * 65] * scale, s[2 * 65] * scale, s[3 * 65] * scale); o.y = pk_fp8x4(s[4 * 65] * scale, s[5 * 65] * scale, s[6 * 65] * scale, s[7 * 65] * scale);
        o.z = pk_fp8x4(s[8 * 65] * scale, s[9 * 65] * scale, s[10 * 65] * scale, s[11 * 65] * scale); o.w = pk_fp8x4(s[12 * 65] * scale, s[13 * 65] * scale, s[14 * 65] * scale, s[15 * 65] * scale);
        *(u32x4*)(WT + (drow0 + n + (n >= 32 ? hi_skip : 0)) * dKb + k0 + 16 * c) = o; }
    LDS_WAIT(); asm volatile("" ::: "memory");
}
struct TrD { const float* src; int N; unsigned char* dst; int dKb, drow0, hi_skip, fp8; };
__device__ __forceinline__ void tr_load(const TrD& d, f32x4 (&v)[16], int lane) {
    const int nq = lane & 15, kr = lane >> 4;
#pragma unroll
    for (int i = 0; i < 16; ++i) v[i] = *(const f32x4*)(d.src + (size_t)(4 * i + kr) * d.N + 4 * nq);
}
__device__ __forceinline__ void tr_store(const TrD& d, const f32x4 (&v)[16], LAS float* scr, int lane) {
    const int nq = lane & 15, kr = lane >> 4;
#pragma unroll
    for (int i = 0; i < 16; ++i) { LAS float* p = scr + (4 * i + kr) * 65 + 4 * nq; p[0] = v[i].x; p[1] = v[i].y; p[2] = v[i].z; p[3] = v[i].w; }
    LDS_WAIT(); asm volatile("" ::: "memory");
    if (d.fp8) { const int c = lane & 3; const float scale = (float)(1 << MOE_WSH);
#pragma unroll
        for (int j = 0; j < 4; ++j) { const int n = (lane >> 2) + 16 * j; const LAS float* s = scr + (16 * c) * 65 + n;
            u32x4 o; o.x = pk_fp8x4(s[0 * 65] * scale, s[1 * 65] * scale, s[2 * 65] * scale, s[3 * 65] * scale); o.y = pk_fp8x4(s[4 * 65] * scale, s[5 * 65] * scale, s[6 * 65] * scale, s[7 * 65] * scale);
            o.z = pk_fp8x4(s[8 * 65] * scale, s[9 * 65] * scale, s[10 * 65] * scale, s[11 * 65] * scale); o.w = pk_fp8x4(s[12 * 65] * scale, s[13 * 65] * scale, s[14 * 65] * scale, s[15 * 65] * scale);
            *(u32x4*)(d.dst + (size_t)(d.drow0 + n + (n >= 32 ? d.hi_skip : 0)) * d.dKb + 16 * c) = o; } }
    else { const int c = lane & 7;
#pragma unroll
        for (int j = 0; j < 8; ++j) { const int n = (lane >> 3) + 8 * j; const LAS float* s = scr + (8 * c) * 65 + n;
            u32x4 o; o.x = cvtpk(s[0 * 65], s[1 * 65]); o.y = cvtpk(s[2 * 65], s[3 * 65]); o.z = cvtpk(s[4 * 65], s[5 * 65]); o.w = cvtpk(s[6 * 65], s[7 * 65]);
            *(u32x4*)(d.dst + (size_t)(d.drow0 + n + (n >= 32 ? d.hi_skip : 0)) * d.dKb + 16 * c) = o; } }
    LDS_WAIT(); asm volatile("" ::: "memory");
}
constexpr int TR_I0 = 2 * 384, TR_I1 = 2 * 256, TR_I2 = 4 * 16, TR_I3 = 16 * 81, TR_I4 = 32 * 16, TR_I5 = 128 * 256, TR_I6 = 128 * 128, TR_ITOT = TR_I0 + TR_I1 + TR_I2 + TR_I3 + TR_I4 + TR_I5 + TR_I6;
__device__ __forceinline__ TrD tr_decode(const Args& a, int it) {
    TrD d; int r = it; d.hi_skip = 0;
    if (r < TR_I5) { const int m = r / 256, q = r % 256, kb = q / 16, nb = q % 16, n0 = nb * 64, j = n0 & 511;
        d.src = a.in[I_WGU] + (size_t)m * 1024 * 1024 + (size_t)kb * 64 * 1024 + n0; d.N = 1024; d.drow0 = 256 * (j >> 7) + (j & 127) + ((n0 >= 512) ? 128 : 0);
        d.fp8 = MOE_FP8; d.dKb = MOE_FP8 ? 1024 : 2048; d.dst = (unsigned char*)(a.ws + WS_WGU) + (size_t)m * 1024 * d.dKb + (size_t)kb * 64 * (MOE_FP8 ? 1 : 2); return d; }
    r -= TR_I5;
    if (r < TR_I6) { const int m = r / 128, q = r % 128, kb = q / 16, nb = q % 16;
        d.src = a.in[I_WDN] + (size_t)m * 512 * 1024 + (size_t)kb * 64 * 1024 + nb * 64; d.N = 1024; d.drow0 = nb * 64;
        d.fp8 = MOE_FP8; d.dKb = MOE_FP8 ? 512 : 1024; d.dst = (unsigned char*)(a.ws + WS_WDN) + (size_t)m * 1024 * d.dKb + (size_t)kb * 64 * (MOE_FP8 ? 1 : 2); return d; }
    r -= TR_I6;
    if (r < TR_I0) { const int m = r / 384, q = r % 384, kb = q / 24, nb = q % 24;
        d.src = a.in[I_WQKV] + (size_t)m * 1024 * 1536 + (size_t)kb * 64 * 1536 + nb * 64; d.N = 1536; d.drow0 = (nb >> 2) * 256 + (nb & 3) * 32; d.hi_skip = 96;
        d.fp8 = ATT_FP8; d.dKb = ATT_FP8 ? 1024 : 2048; d.dst = (unsigned char*)(a.ws + WS_WQKV) + (size_t)m * 1536 * d.dKb + (size_t)kb * 64 * (ATT_FP8 ? 1 : 2); return d; }
    r -= TR_I0;
    if (r < TR_I1) { const int m = r / 256, q = r % 256, kb = q / 16, nb = q % 16;
        d.src = a.in[I_WO] + (size_t)m * 1024 * 1024 + (size_t)kb * 64 * 1024 + nb * 64; d.N = 1024; d.drow0 = nb * 64;
        d.fp8 = ATT_FP8; d.dKb = ATT_FP8 ? 1024 : 2048; d.dst = (unsigned char*)(a.ws + WS_WO) + (size_t)m * 1024 * d.dKb + (size_t)kb * 64 * (ATT_FP8 ? 1 : 2); return d; }
    r -= TR_I1;
    d.fp8 = 0;
    if (r < TR_I2) { const int m = r / 16, q = r % 16, kb = q / 4, nb = q % 4;
        d.src = a.in[I_POOLW] + (size_t)m * 256 * 256 + (size_t)kb * 64 * 256 + nb * 64; d.N = 256; d.drow0 = nb * 64; d.dKb = 512; d.dst = (unsigned char*)(a.ws + WS_WPOOL) + (size_t)m * 256 * 512 + (size_t)kb * 128; return d; }
    r -= TR_I2;
    if (r < TR_I3) { const int kb = r / 81, nb = r % 81;
        d.src = a.in[I_WIN] + (size_t)kb * 64 * 5184 + nb * 64; d.N = 5184; d.drow0 = nb * 64; d.dKb = 2048; d.dst = (unsigned char*)(a.ws + WS_WIN) + (size_t)kb * 128; return d; }
    r -= TR_I3;
    { const int kb = r / 16, nb = r % 16;
        d.src = a.in[I_WOUT] + (size_t)kb * 64 * 1024 + nb * 64; d.N = 1024; d.drow0 = nb * 64; d.dKb = 4096; d.dst = (unsigned char*)(a.ws + WS_WOUT) + (size_t)kb * 128; return d; }
}
__device__ __forceinline__ void p0_prologue(const Args& a, const Ctx& c) {
    LAS float* scr = (LAS float*)(c.lds + c.wave * 16896);
    const int gw = c.vcu * NWAVES + c.wave, NGW = c.G * NWAVES;
    { f32x4 va[16], vb[16]; TrD da, db; int it = gw;
      da = tr_decode(a, it < TR_ITOT ? it : TR_ITOT - 1); tr_load(da, va, c.lane);
      while (it < TR_ITOT) {
          const int itB = it + NGW; db = tr_decode(a, itB < TR_ITOT ? itB : TR_ITOT - 1); tr_load(db, vb, c.lane);
          tr_store(da, va, scr, c.lane);
          if (itB >= TR_ITOT) break;
          const int itA = itB + NGW; da = tr_decode(a, itA < TR_ITOT ? itA : TR_ITOT - 1); tr_load(da, va, c.lane);
          tr_store(db, vb, scr, c.lane);
          it = itA; } }
    __syncthreads();
    LAS float* sv = (LAS float*)c.lds;
    LAS float* part = (LAS float*)(c.lds + 20480);
    for (int u = c.tid; u < 5 * 1024; u += NTHREADS) { const int v = u >> 10, k = u & 1023; const float x = v < 4 ? a.in[I_C][v * 1024 + k] : a.in[I_CCTX][k]; sv[u] = x / (1.0f + expf(-x)); }
    __syncthreads();
    for (int item = blockIdx.x; item < 4 * 64; item += c.G) {
        const int li = item >> 6, c0 = (item & 63) * 96, cq = c.tid % 24, ks = c.tid / 24;
        f32x4 acc[5];
#pragma unroll
        for (int v = 0; v < 5; ++v) acc[v] = (f32x4){0.f, 0.f, 0.f, 0.f};
        if (ks < 21) { const int kbeg = ks * 49, kend = (kbeg + 49) < 1024 ? (kbeg + 49) : 1024;
            const float* w = a.in[I_WADA] + ((size_t)li * 1024 + kbeg) * 6144 + c0 + 4 * cq;
#pragma unroll 7
            for (int k = kbeg; k < kend; ++k) { const f32x4 wv = *(const f32x4*)w; w += 6144;
#pragma unroll
                for (int v = 0; v < 5; ++v) acc[v] += wv * sv[v * 1024 + k]; }
#pragma unroll
            for (int v = 0; v < 5; ++v) *(LAS f32x4*)(part + (ks * 24 + cq) * 20 + v * 4) = acc[v]; }
        __syncthreads();
        if (c.tid < 480) { const int v = c.tid / 96, col = c.tid % 96, q = col >> 2, e = col & 3; float s = 0.f;
            for (int k2 = 0; k2 < 21; ++k2) s += part[(k2 * 24 + q) * 20 + v * 4 + e];
            s += a.in[I_BADA][li * 6144 + c0 + col];
            if (v < 4) ((float*)(a.ws + WS_MODL))[(size_t)(li * 4 + v) * 6144 + c0 + col] = s; else ((float*)(a.ws + WS_MODC))[(size_t)li * 6144 + c0 + col] = s; }
        __syncthreads();
    }
    if (blockIdx.x == (unsigned)(c.G - 1)) for (int u = c.tid; u < 1024; u += NTHREADS) { const int pos = u >> 4, f = u & 15;
        const float inv = (float)pow(10000.0, -(double)f / 16.0); const double ang = (double)((float)pos * inv);
        ((f32x2*)(a.ws + WS_ROPE))[u] = (f32x2){(float)cos(ang), (float)sin(ang)}; }
    for (int u = blockIdx.x * NTHREADS + c.tid; u < 4 * 64 * 1024; u += c.G * NTHREADS) { const int li = u >> 16, n = (u >> 10) & 63, k = u & 1023;
        float w = 0.f; if (n < 4) w = a.in[I_WRG][((size_t)li * 1024 + k) * 4 + n]; else if (n < 36) w = a.in[I_WRE][((size_t)li * 1024 + k) * 32 + (n - 4)];
        const unsigned hi = cvtpk(w, 0.f) & 0xffffu; const float rem = w - bflo(hi); const unsigned lo = cvtpk(rem, 0.f) & 0xffffu;
        bf16* wr = (bf16*)(a.ws + WS_WR) + (size_t)li * 2 * 65536; wr[n * 1024 + k] = (bf16)hi; wr[65536 + n * 1024 + k] = (bf16)lo; }
}

__device__ __forceinline__ void ph_rmix(const Args& a, const Ctx& c, int layer) {
    const int gw = c.vcu * NWAVES + c.wave, NGW = c.G * NWAVES;
    const float* g = a.in[I_NMIX] + layer * D;
    for (int r = gw; r < TT; r += NGW) {
        f32x4 v[4], h[4]; load_row_combined(a, layer, r, c.lane, v);
        if (layer > 0) { f32x4* xo = (f32x4*)((float*)(a.ws + WS_X) + (size_t)r * D) + c.lane;
#pragma unroll
            for (int j = 0; j < 4; ++j) xo[64 * j] = v[j]; }
        const float rstd = row_rstd(v); const float* m = mod_row(a, layer, r);
        norm_mod(v, rstd, g, m, m + D, c.lane, h);
        if (ATT_FP8 && layer != 2) { unsigned* ho8 = (unsigned*)((unsigned char*)(a.ws + WS_HB) + (size_t)r * D) + c.lane;
#pragma unroll
            for (int j = 0; j < 4; ++j) ho8[64 * j] = pk_fp8x4(h[j].x, h[j].y, h[j].z, h[j].w); }
        else { u32x2* ho = (u32x2*)((bf16*)(a.ws + WS_HB) + (size_t)r * D) + c.lane;
#pragma unroll
            for (int j = 0; j < 4; ++j) ho[64 * j] = (u32x2){cvtpk(h[j].x, h[j].y), cvtpk(h[j].z, h[j].w)}; }
    }
}

__device__ __forceinline__ void ph_final(const Args& a, const Ctx& c, int layer) {
    const int gw = c.vcu * NWAVES + c.wave, NGW = c.G * NWAVES;
    float dscale = 1.f, dmark = 0.f;
#if DEBUG_CHECKS
    { unsigned* dbg = (unsigned*)(a.ws + WS_CTL) + CW_DBG; int code = 0; float mag = 0.f;
      for (int id = 1; id < 32; ++id) { const float e = __uint_as_float(__hip_atomic_load(dbg + id, __ATOMIC_RELAXED, __HIP_MEMORY_SCOPE_AGENT)); if (code == 0 && e > DBG_TOL) { code = id; mag = e; } }
      dscale = 1.f + (float)code; dmark = code ? 100.f * (1.f + fminf(fmaxf(log2f(mag / DBG_TOL), 0.f), 30.f)) : 0.f; }
#endif
    for (int r = gw; r < TL; r += NGW) {
        f32x4 v[4]; load_row_combined(a, layer, r, c.lane, v);
        const float rstd = row_rstd(v) * dscale;
        f32x4* o = (f32x4*)(a.out + (size_t)r * D) + c.lane;
#pragma unroll
        for (int j = 0; j < 4; ++j) { f32x4 ov = (v[j] * rstd) * ((const f32x4*)a.in[I_NFIN])[c.lane + 64 * j]; if (j == 0 && r == 0 && c.lane == 0 && dmark > 0.f) ov.x = dmark; o[64 * j] = ov; }
    }
}


namespace pg8 {
constexpr int BM = 256, BK = 64, HALF = 128, HTB = HALF * BK * 2, STAGE_BYTES = 8 * HTB;
__host__ __device__ __forceinline__ int lds_byte(int r, int c) { const int st = (r >> 4) * 2 + (c >> 5), rr = r & 15, cc = c & 31, ob = rr * 64 + cc * 2; return st * 1024 + (ob ^ (((ob >> 9) & 1) << 5)); }
__host__ __device__ __forceinline__ void stage_rc(int b, int& R, int& C) { const int st = b / 1024, sb = b % 1024, swz = sb ^ (((sb >> 9) & 1) << 5); R = (st >> 1) * 16 + swz / 64; C = (st & 1) * 32 + (swz % 64) / 2; }
__host__ __device__ __forceinline__ int perm32(int rho) { const int n = rho >> 4, i = rho & 15; return 8 * (i >> 2) + 4 * n + (i & 3); }
struct Unit { const char* A; const char* B; int pm, pn, x0, x1; };
__device__ __forceinline__ void tile_of(int L, int nM, int nN, int& pm, int& pn) {
    const int nwg = nM * nN; int wgid = L; { const int q = nwg / 8, r = nwg % 8, xcd = wgid % 8, off = wgid / 8; wgid = (xcd < r ? xcd * (q + 1) : r * (q + 1) + (xcd - r) * q) + off; }
    const int nig = 8 * nN, gid = wgid / nig, fm = gid * 8, gsz = (nM - fm) < 8 ? (nM - fm) : 8;
    pm = fm + ((wgid % nig) % gsz); pn = (wgid % nig) / gsz;
}
typedef int v4i_t __attribute__((ext_vector_type(4))); typedef int v8i_t __attribute__((ext_vector_type(8)));
template <class Epi, class Sched, bool GATHER, bool FP8 = false>
__device__ __forceinline__ void gemm_phase(LAS unsigned char* lds, const int Kb, const int ldab, const Sched& S, const Epi& E, const int scw = 127, const int sca = 127) {
    const int tid = tid_opaque(), wid = __builtin_amdgcn_readfirstlane(tid >> 6), lane = tid & 63, wr = wid >> 2, wc = wid & 3, fr = lane & 15, fq = lane >> 4;
    const int nt = Kb / (BK * 2);
    int scw_v = scw, sca_v = sca;
    unsigned voffA[2], voffB[2]; int RA[2], CA[2];
#pragma unroll
    for (int i = 0; i < 2; ++i) { int R, C; stage_rc(tid * 16 + i * 8192, R, C); const int Rb = Epi::PERM ? ((R & ~31) + perm32(R & 31)) : R;
        RA[i] = R; CA[i] = C; voffA[i] = (unsigned)(R * ldab + C * 2); voffB[i] = (unsigned)(Rb * Kb + C * 2); }
    const size_t kstep = (size_t)(BK * 2);
    const size_t hstepA = (size_t)HALF * ldab, hstepB = (size_t)HALF * Kb;
    const unsigned ldsw = (unsigned)wid * 1024u;
    const int aoff = lds_byte(wr * 64 + fr, fq * 8), boff = lds_byte(wc * 32 + fr, fq * 8);
#define PG8_SA(b, h) (((b) * 2 + (h)) * HTB)
#define PG8_SB(b, h) ((4 + (b) * 2 + (h)) * HTB)
#define PG8_GLDS(bufoff, gptr, i_) __builtin_amdgcn_global_load_lds((const unsigned*)(gptr), (LAS unsigned*)(lds + (bufoff) + ldsw + (i_) * 8192), 16, 0, 0)
#define PG8_STAGE_B(bufoff, gbase) do { _Pragma("unroll") for (int _i = 0; _i < 2; ++_i) PG8_GLDS(bufoff, (const char*)(gbase) + voffB[_i], _i); } while (0)
#define PG8_STAGE_A(bufoff, ab, kb, h, NX) do { _Pragma("unroll") for (int _i = 0; _i < 2; ++_i) { \
        if constexpr (GATHER) { const unsigned _vo = (NX) ? voN[h][_i] : voC[h][_i]; PG8_GLDS(bufoff, (ab) + (kb) + _vo, _i); } \
        else { PG8_GLDS(bufoff, (ab) + (kb) + (size_t)(h) * hstepA + voffA[_i], _i); } } } while (0)
#define PG8_LDA(dst, b, h) do { _Pragma("unroll") for (int m = 0; m < 4; ++m) _Pragma("unroll") for (int k = 0; k < 2; ++k) dst[m][k] = *(const LAS bf16x8*)(lds + PG8_SA(b, h) + aoff + m * 2048 + k * 1024); } while (0)
#define PG8_LDB(dst, b, h) do { _Pragma("unroll") for (int n = 0; n < 2; ++n) _Pragma("unroll") for (int k = 0; k < 2; ++k) dst[n][k] = *(const LAS bf16x8*)(lds + PG8_SB(b, h) + boff + n * 2048 + k * 1024); } while (0)
#define PG8_MMA(ai, bj, At, Bt) do { __builtin_amdgcn_s_setprio(1); _Pragma("unroll") for (int m = 0; m < 4; ++m) _Pragma("unroll") for (int n = 0; n < 2; ++n) { \
        if constexpr (FP8) { const v8i_t b8 = __builtin_shufflevector(__builtin_bit_cast(v4i_t, Bt[n][0]), __builtin_bit_cast(v4i_t, Bt[n][1]), 0, 1, 2, 3, 4, 5, 6, 7), a8 = __builtin_shufflevector(__builtin_bit_cast(v4i_t, At[m][0]), __builtin_bit_cast(v4i_t, At[m][1]), 0, 1, 2, 3, 4, 5, 6, 7); \
            asm volatile("v_mfma_scale_f32_16x16x128_f8f6f4 %0, %1, %2, %0, %3, %4 op_sel_hi:[0,0,0]" : "+v"(acc[ai][bj][m][n]) : "v"(b8), "v"(a8), "v"(scw_v), "v"(sca_v)); } \
        else { _Pragma("unroll") for (int k = 0; k < 2; ++k) acc[ai][bj][m][n] = __builtin_amdgcn_mfma_f32_16x16x32_bf16(Bt[n][k], At[m][k], acc[ai][bj][m][n], 0, 0, 0); } } __builtin_amdgcn_s_setprio(0); } while (0)
#define PG8_WAIT_V(n) asm volatile("s_waitcnt vmcnt(" #n ")" ::: "memory")
#define PG8_WAIT_L(n) asm volatile("s_waitcnt lgkmcnt(" #n ")" ::: "memory")
#define PG8_BAR __builtin_amdgcn_s_barrier()
#define PG8_SCHED __builtin_amdgcn_sched_barrier(0)
    Unit cur, nxt, pend; int ui = 0; bool have_pend = false;
    if (!S.next(0, cur)) return;
    pend = cur;
    unsigned voC[2][2], voN[2][2];
    if constexpr (GATHER) {
#pragma unroll
        for (int h = 0; h < 2; ++h)
#pragma unroll
            for (int i = 0; i < 2; ++i) { voC[h][i] = (unsigned)(S.gather(cur, h * HALF + RA[i]) * ldab + CA[i] * 2); voN[h][i] = voC[h][i]; }
    } else { voC[0][0] = voN[0][0] = 0u; }
    f32x4 acc[2][2][4][2];
#pragma unroll
    for (int a = 0; a < 2; ++a)
#pragma unroll
        for (int b = 0; b < 2; ++b)
#pragma unroll
            for (int m = 0; m < 4; ++m)
#pragma unroll
                for (int n = 0; n < 2; ++n) acc[a][b][m][n] = (f32x4){0.f, 0.f, 0.f, 0.f};
    bf16x8 At[4][2], B0[2][2], B1[2][2];
    const char* cA = cur.A; const char* cB = cur.B;
    S.a_ready(cur, wid);
    PG8_STAGE_B(PG8_SB(0, 0), cB); PG8_STAGE_B(PG8_SB(0, 1), cB + hstepB); PG8_STAGE_A(PG8_SA(0, 0), cA, (size_t)0, 0, false); PG8_STAGE_A(PG8_SA(0, 1), cA, (size_t)0, 1, false);
    if (wr == 1) PG8_BAR;
    PG8_WAIT_V(2); PG8_BAR;
    PG8_STAGE_B(PG8_SB(1, 0), cB + kstep); PG8_STAGE_A(PG8_SA(1, 0), cA, kstep, 0, false); PG8_STAGE_B(PG8_SB(1, 1), cB + hstepB + kstep);
    PG8_WAIT_V(6); PG8_BAR;
    for (;;) {
        const bool has_next = S.next(ui + 1, nxt);
        if constexpr (GATHER) { if (has_next) {
#pragma unroll
            for (int h = 0; h < 2; ++h)
#pragma unroll
                for (int i = 0; i < 2; ++i) voN[h][i] = (unsigned)(S.gather(nxt, h * HALF + RA[i]) * ldab + CA[i] * 2); } }
        const char* nA = has_next ? nxt.A : cA; const char* nB = has_next ? nxt.B : cB;
        for (int t = 0; t < nt; t += 2) {
            const bool last = (t == nt - 2);
            const size_t k1 = (size_t)(t + 1) * kstep;
            const char* a2 = last ? nA : cA; const size_t k2 = last ? (size_t)0 : (size_t)(t + 2) * kstep; const size_t k3 = k2 + kstep;
            const char* b2 = last ? nB : cB + (size_t)(t + 2) * kstep; const char* b3 = b2 + kstep;
            const bool nx = GATHER ? (last && has_next) : false;
            if (last && has_next) S.a_ready(nxt, wid);
            PG8_LDB(B0, 0, 0); PG8_LDB(B1, 0, 1); PG8_SCHED; PG8_LDA(At, 0, 0); PG8_STAGE_A(PG8_SA(1, 1), cA, k1, 1, false);
            PG8_WAIT_V(8); PG8_WAIT_L(0); PG8_BAR; PG8_MMA(0, 0, At, B0); PG8_MMA(0, 1, At, B1); PG8_BAR; PG8_SCHED;
            PG8_LDA(At, 0, 1); PG8_STAGE_B(PG8_SB(0, 0), b2); PG8_STAGE_B(PG8_SB(0, 1), b2 + hstepB); PG8_STAGE_A(PG8_SA(0, 0), a2, k2, 0, nx);
            PG8_WAIT_V(8); PG8_WAIT_L(0);
            if constexpr (!Sched::IMM_DONE) { if (have_pend) { S.done(pend, lane); have_pend = false; } }
            PG8_BAR; PG8_MMA(1, 0, At, B0); PG8_MMA(1, 1, At, B1); PG8_BAR; PG8_SCHED;
            PG8_LDB(B0, 1, 0); PG8_LDB(B1, 1, 1); PG8_SCHED; PG8_LDA(At, 1, 0); PG8_STAGE_A(PG8_SA(0, 1), a2, k2, 1, nx);
            PG8_WAIT_V(8); PG8_WAIT_L(0); PG8_BAR; PG8_MMA(0, 0, At, B0); PG8_MMA(0, 1, At, B1); PG8_BAR; PG8_SCHED;
            PG8_LDA(At, 1, 1); PG8_STAGE_B(PG8_SB(1, 0), b3); PG8_STAGE_B(PG8_SB(1, 1), b3 + hstepB); PG8_STAGE_A(PG8_SA(1, 0), a2, k3, 0, nx);
            PG8_WAIT_V(8); PG8_WAIT_L(0); PG8_BAR; PG8_MMA(1, 0, At, B0); PG8_MMA(1, 1, At, B1); PG8_BAR; PG8_SCHED;
        }
        if (wr == 0) PG8_BAR;
        if constexpr (FP8) asm volatile("s_nop 15\n\ts_nop 15" ::: "memory");
        E(acc, cur, wr, wc, fr, fq);
        if constexpr (Sched::IMM_DONE) { PG8_WAIT_V(0); S.done(cur, lane); }
        else { pend = cur; have_pend = true; }
        if (!has_next) break;
#pragma unroll
        for (int a = 0; a < 2; ++a)
#pragma unroll
            for (int b = 0; b < 2; ++b)
#pragma unroll
                for (int m = 0; m < 4; ++m)
#pragma unroll
                    for (int n = 0; n < 2; ++n) acc[a][b][m][n] = (f32x4){0.f, 0.f, 0.f, 0.f};
        cur = nxt; cA = nA; cB = nB; ++ui;
        if constexpr (GATHER) {
#pragma unroll
            for (int h = 0; h < 2; ++h)
#pragma unroll
                for (int i = 0; i < 2; ++i) voC[h][i] = voN[h][i]; }
        if (wr == 1) PG8_BAR;
    }
    PG8_WAIT_V(0);
    if constexpr (!Sched::IMM_DONE) { if (have_pend) S.done(pend, lane); }
    PG8_BAR;
#undef PG8_SA
#undef PG8_SB
#undef PG8_GLDS
#undef PG8_STAGE_A
#undef PG8_STAGE_B
#undef PG8_LDA
#undef PG8_LDB
#undef PG8_MMA
#undef PG8_WAIT_V
#undef PG8_WAIT_L
#undef PG8_BAR
#undef PG8_SCHED
}
}
#include <hip/hip_bf16.h>
#include <cmath>
namespace attn_body {
using bf16=__hip_bfloat16;
using bf16x8=__attribute__((ext_vector_type(8)))short;
using s16x4=__attribute__((ext_vector_type(4)))short;
using f32x16=__attribute__((ext_vector_type(16)))float;
using u32x4=__attribute__((ext_vector_type(4)))unsigned;
constexpr int D=64,QP=1024,KVP=256;
constexpr int NW=8,QBLK=32,QB=QBLK*NW,KVBLK=64;
__device__ __forceinline__ int crow(int r,int hi){return (r&3)+8*(r>>2)+4*hi;}
#define SBAR() __builtin_amdgcn_sched_barrier(0)
constexpr int NSLOT=3, SLOTB=8192;
constexpr int LDS_K=0, LDS_V=NSLOT*SLOTB, LDS_WS=2*NSLOT*SLOTB, LDS_OST=LDS_WS+NW*64*4, LDS_BYTES=LDS_OST+NW*4096;
constexpr float C2=0.125f*1.4426950408889634f;
__device__ __forceinline__ void glds16s(const void*sbase,unsigned voff,unsigned lds_dst){unsigned keep;
  asm volatile("s_mov_b32 %0, m0\n\ts_mov_b32 m0, %3\n\ts_nop 4\n\tglobal_load_lds_dwordx4 %1, %2\n\ts_mov_b32 m0, %0":"=&s"(keep):"v"(voff),"s"(sbase),"s"(lds_dst):"memory");}
__device__ __forceinline__ float max3f(float a,float b,float c){float r;asm("v_max3_f32 %0, %1, %2, %3":"=v"(r):"v"(a),"v"(b),"v"(c));return r;}
__device__ __forceinline__ float max2f(float a,float b){float r;asm("v_max_f32_e32 %0, %1, %2":"=v"(r):"v"(a),"v"(b));return r;}
__device__ __forceinline__ float fadd_s(float a,float b){float r;asm("v_add_f32_e32 %0, %1, %2":"=v"(r):"v"(a),"v"(b));return r;}
__device__ __forceinline__ float fsub_s(float a,float b){float r;asm("v_sub_f32_e32 %0, %1, %2":"=v"(r):"v"(a),"v"(b));return r;}
typedef float f32x2_t __attribute__((ext_vector_type(2))); typedef __bf16 bf16x2_t __attribute__((ext_vector_type(2)));
__device__ __forceinline__ unsigned cvtpk_s(float lo,float hi){f32x2_t v={lo,hi};bf16x2_t b=__builtin_convertvector(v,bf16x2_t);return __builtin_bit_cast(unsigned,b);}
#define WAIT_BAR(N) asm volatile("s_waitcnt vmcnt(" #N ") lgkmcnt(0)\n\ts_barrier":::"memory")

__device__ __forceinline__ void qkt(f32x16&p0,f32x16&p1,const char*Kslot,const bf16x8*qr,const f32x16&negm,int r32,int hi){
  const char*kb=Kslot+hi*1024+r32*16;
  #pragma unroll
  for(int d0=0;d0<4;++d0){
    const bf16x8 b0=*reinterpret_cast<const bf16x8*>(kb+d0*2048);
    const bf16x8 b1=*reinterpret_cast<const bf16x8*>(kb+d0*2048+512);
    if(d0==0){p0=__builtin_amdgcn_mfma_f32_32x32x16_bf16(b0,qr[0],negm,0,0,0);p1=__builtin_amdgcn_mfma_f32_32x32x16_bf16(b1,qr[0],negm,0,0,0);}
    else{p0=__builtin_amdgcn_mfma_f32_32x32x16_bf16(b0,qr[d0],p0,0,0,0);p1=__builtin_amdgcn_mfma_f32_32x32x16_bf16(b1,qr[d0],p1,0,0,0);}}
}
typedef __attribute__((address_space(3))) const char* lds_cptr;
typedef short v4i16_t __attribute__((ext_vector_type(4)));
__device__ __forceinline__ void kload8(bf16x8*kf,lds_cptr kp){
  kf[0]=*(const __attribute__((address_space(3))) bf16x8*)(kp);      kf[1]=*(const __attribute__((address_space(3))) bf16x8*)(kp+512);
  kf[2]=*(const __attribute__((address_space(3))) bf16x8*)(kp+2048); kf[3]=*(const __attribute__((address_space(3))) bf16x8*)(kp+2560);
  kf[4]=*(const __attribute__((address_space(3))) bf16x8*)(kp+4096); kf[5]=*(const __attribute__((address_space(3))) bf16x8*)(kp+4608);
  kf[6]=*(const __attribute__((address_space(3))) bf16x8*)(kp+6144); kf[7]=*(const __attribute__((address_space(3))) bf16x8*)(kp+6656);
}
__device__ __forceinline__ void kload2(bf16x8*kf,lds_cptr kp,int j){ kf[2*j]=*(const __attribute__((address_space(3))) bf16x8*)(kp+j*2048); kf[2*j+1]=*(const __attribute__((address_space(3))) bf16x8*)(kp+j*2048+512); }
__device__ __forceinline__ s16x4 vtr(lds_cptr p){ return __builtin_bit_cast(s16x4,__builtin_amdgcn_ds_read_tr16_b64_v4i16((__attribute__((address_space(3))) v4i16_t*)p)); }
__device__ __forceinline__ float rowmax(const f32x16&p0,const f32x16&p1){
  float a=max3f(p0[0],p0[1],p1[0]),b=max3f(p0[2],p0[3],p1[1]);a=max3f(a,p1[2],p1[3]);
  #pragma unroll
  for(int r=4;r<16;r+=4){a=max3f(a,p0[r],p0[r+1]);b=max3f(b,p0[r+2],p0[r+3]);a=max3f(a,p1[r],p1[r+1]);b=max3f(b,p1[r+2],p1[r+3]);}
  const float m=max2f(a,b);
  auto rr=__builtin_amdgcn_permlane32_swap(__float_as_uint(m),__float_as_uint(m),false,false);
  return max2f(__uint_as_float(rr[0]),__uint_as_float(rr[1]));
}
__device__ __forceinline__ void pv(f32x16*o,int vb,bf16x8 pa0,bf16x8 pa1,bf16x8 pa2,bf16x8 pa3){
  #pragma unroll
  for(int d0=0;d0<2;++d0){s16x4 lo[4],hi[4];
    #pragma unroll
    for(int ks=0;ks<4;++ks){
      asm volatile("ds_read_b64_tr_b16 %0,%1 offset:%c2":"=&v"(lo[ks]):"v"(vb),"i"(d0*4096+ks*1024):"memory");
      asm volatile("ds_read_b64_tr_b16 %0,%1 offset:%c2":"=&v"(hi[ks]):"v"(vb),"i"(d0*4096+ks*1024+512):"memory");}
    asm volatile("s_waitcnt lgkmcnt(0)":::"memory");SBAR();
    #define PK(k) (bf16x8){lo[k][0],lo[k][1],lo[k][2],lo[k][3],hi[k][0],hi[k][1],hi[k][2],hi[k][3]}
    o[d0]=__builtin_amdgcn_mfma_f32_32x32x16_bf16(pa0,PK(0),o[d0],0,0,0);
    o[d0]=__builtin_amdgcn_mfma_f32_32x32x16_bf16(pa1,PK(1),o[d0],0,0,0);
    o[d0]=__builtin_amdgcn_mfma_f32_32x32x16_bf16(pa2,PK(2),o[d0],0,0,0);
    o[d0]=__builtin_amdgcn_mfma_f32_32x32x16_bf16(pa3,PK(3),o[d0],0,0,0);
    #undef PK
  }
}

#ifndef ATTN_STORE16
#define ATTN_STORE16(p,v) (*(u32x4*)(p)=(v))
#endif
template<int THRL> __device__ __forceinline__ void attn_unit(long qrow0,int h,long kvrow0,int NT,const bf16*Q,const bf16*__restrict__ K,const bf16*__restrict__ V,bf16*O,char*shm){
  const int tid=tid_opaque(),lane=tid&63,r32=lane&31,hi=lane>>5; const int wid=__builtin_amdgcn_readfirstlane(tid>>6);
  const bf16*Qw=Q+(qrow0+wid*QBLK)*QP+h*D;
  const bf16*Kh=K+kvrow0*KVP+(h>>2)*D,*Vh=V+kvrow0*KVP+(h>>2)*D;
  const unsigned lds0=(unsigned)(uintptr_t)shm;
  float*wsf=(float*)(shm+LDS_WS)+wid*64;
  const unsigned kvo=(unsigned)(lane*KVP+wid*8)*2u;
  const unsigned vvo=(unsigned)((16*(wid&3)+(lane>>2))*KVP+(wid>>2)*32+(lane&3)*8)*2u;
  const unsigned kdst=lds0+LDS_K+wid*1024, vdst=lds0+LDS_V+wid*1024;
  #define DMA_K(t,slot) glds16s(Kh+(long)(t)*KVBLK*KVP,kvo,(unsigned)__builtin_amdgcn_readfirstlane(kdst+(slot)))
  #define DMA_V(t,slot) glds16s(Vh+(long)(t)*KVBLK*KVP,vvo,(unsigned)__builtin_amdgcn_readfirstlane(vdst+(slot)))
  const int vb0=(int)(lds0+LDS_V)+((lane>>4)&1)*32+(lane&3)*8+(4*hi+((lane&15)>>2))*64;
  const char*Kbase=shm+LDS_K; bf16x8 kf[8];
  const lds_cptr shm3=(lds_cptr)shm; const lds_cptr kp0=shm3+LDS_K+hi*1024+r32*16; const lds_cptr vp0=shm3+LDS_V+((lane>>4)&1)*32+(lane&3)*8+(4*hi+((lane&15)>>2))*64;
  DMA_K(0,0);DMA_V(0,0);DMA_K(1,SLOTB);
  bf16x8 qr[4];
  #pragma unroll
  for(int d0=0;d0<4;++d0)qr[d0]=*reinterpret_cast<const bf16x8*>(&Qw[(long)r32*QP+d0*16+hi*8]);
  float mhat=0.f,l_reg=0.f;f32x16 o[2];o[0]=f32x16{};o[1]=f32x16{};f32x16 negm=f32x16{};asm volatile("":"+v"(negm));
  #define CMASK(P0,P1,t) do{}while(0)
  bool resc=false;
  #define START(P0,P1) do{ const float rm=rowmax(P0,P1); resc=false; \
    { const float dl=rm; mhat=fadd_s(mhat,dl); \
      _Pragma("unroll") for(int r=0;r<16;++r){P0[r]=fsub_s(P0[r],dl);P1[r]=fsub_s(P1[r],dl);} \
      _Pragma("unroll") for(int r=0;r<16;++r)negm[r]=-mhat; asm volatile("":"+v"(negm)); } \
    _Pragma("unroll") for(int r=0;r<16;++r)P0[r]=__builtin_amdgcn_exp2f(P0[r]); }while(0)
  #define RESC() do{ if(resc){ asm volatile("s_waitcnt lgkmcnt(0)":::"memory"); \
      _Pragma("unroll") for(int d_=0;d_<2;++d_) _Pragma("unroll") for(int r=0;r<16;++r)o[d_][r]*=wsf[crow(r,hi)]; } }while(0)
  f32x16 pA0,pA1,pB0,pB1;
  int sl_prev=0,sl_cur=0,sl_next=SLOTB;
  #define ROT() do{sl_prev=sl_cur;sl_cur=sl_next;sl_next=(sl_next==(NSLOT-1)*SLOTB)?0:sl_next+SLOTB;}while(0)
  DMA_K(2,2*SLOTB);
  WAIT_BAR(3);
  qkt(pA0,pA1,Kbase,qr,negm,r32,hi);asm volatile("s_nop 15\n\ts_nop 7":"+v"(pA0),"+v"(pA1));CMASK(pA0,pA1,0);
  START(pA0,pA1);
  _Pragma("unroll") for(int r=0;r<16;++r)pA1[r]=__builtin_amdgcn_exp2f(pA1[r]);
  WAIT_BAR(0);
  DMA_K(3,0);DMA_V(1,SLOTB);
  ROT();
  kload8(kf,kp0+sl_cur);
  WAIT_BAR(2);
  s16x4 vlo[8],vhi[8]; u32x4 pw0,pw1,pw2,pw3;
  #define PKW(P,B) cvtpk_s(P[B],P[B+1])
  #define PAF(k) __builtin_bit_cast(bf16x8,pw##k)
  #define VFR(i) (bf16x8){vlo[i][0],vlo[i][1],vlo[i][2],vlo[i][3],vhi[i][0],vhi[i][1],vhi[i][2],vhi[i][3]}
  #define PIN(x) asm volatile("":"+v"(x))
  #define MX3(a,b,c) __builtin_fmaxf(__builtin_fmaxf((a),(b)),(c))
  #define GAPA(MF,A0,A1,A2,A3,W0,W1,PW) do{ MF; sacc+=A0; sacc+=A1; sacc+=A2; sacc+=A3; PIN(sacc); W0; W1; PIN(PW); SBAR(); }while(0)
  #define EX(v) __builtin_amdgcn_exp2f(v)
  #define GAPB(MF,X,B) do{ MF; X[B]=EX(X[B]); X[B+1]=EX(X[B+1]); X[B+2]=EX(X[B+2]); X[B+3]=EX(X[B+3]); PIN(X); SBAR(); }while(0)
  #define VRD(i) do{ vlo[i]=vtr(vp_+(((i)>>2)*4096+((i)&3)*1024)); vhi[i]=vtr(vp_+(((i)>>2)*4096+((i)&3)*1024+512)); }while(0)
  #define KRD(G,j) do{ if(G){ kload2(kf,kp0+sl_next,j); SBAR(); } }while(0)
  #define STEP(C0,C1,P0,P1,t,GK,GV,GL) do{ SBAR(); \
    const lds_cptr vp_=vp0+sl_prev; \
    VRD(0); SBAR(); float sacc=(P0[0]+P0[1]); \
    GAPA(C0=__builtin_amdgcn_mfma_f32_32x32x16_bf16(kf[0],qr[0],negm,0,0,0), P0[2],P0[3],P0[4],P0[5],     pw0[0]=PKW(P0,0), pw0[1]=PKW(P0,2), pw0); \
    VRD(4); SBAR(); GAPA(C1=__builtin_amdgcn_mfma_f32_32x32x16_bf16(kf[1],qr[0],negm,0,0,0), P0[6],P0[7],P0[8],P0[9],     pw0[2]=PKW(P0,4), pw0[3]=PKW(P0,6), pw0); \
    VRD(1); SBAR(); GAPA(C0=__builtin_amdgcn_mfma_f32_32x32x16_bf16(kf[2],qr[1],C0,0,0,0),   P0[10],P0[11],P0[12],P0[13], pw1[0]=PKW(P0,8), pw1[1]=PKW(P0,10), pw1); \
    VRD(5); SBAR(); GAPA(C1=__builtin_amdgcn_mfma_f32_32x32x16_bf16(kf[3],qr[1],C1,0,0,0),   P0[14],P0[15],P1[0],P1[1],   pw1[2]=PKW(P0,12),pw1[3]=PKW(P0,14), pw1); \
    VRD(2); SBAR(); GAPA(C0=__builtin_amdgcn_mfma_f32_32x32x16_bf16(kf[4],qr[2],C0,0,0,0),   P1[2],P1[3],P1[4],P1[5],     pw2[0]=PKW(P1,0), pw2[1]=PKW(P1,2), pw2); \
    VRD(6); SBAR(); GAPA(C1=__builtin_amdgcn_mfma_f32_32x32x16_bf16(kf[5],qr[2],C1,0,0,0),   P1[6],P1[7],P1[8],P1[9],     pw2[2]=PKW(P1,4), pw2[3]=PKW(P1,6), pw2); \
    VRD(3); SBAR(); GAPA(C0=__builtin_amdgcn_mfma_f32_32x32x16_bf16(kf[6],qr[3],C0,0,0,0),   P1[10],P1[11],P1[12],P1[13], pw3[0]=PKW(P1,8), pw3[1]=PKW(P1,10), pw3); \
    VRD(7); SBAR(); GAPA(C1=__builtin_amdgcn_mfma_f32_32x32x16_bf16(kf[7],qr[3],C1,0,0,0),   P1[14],P1[15],0.f,0.f,       pw3[2]=PKW(P1,12),pw3[3]=PKW(P1,14), pw3); \
    l_reg+=sacc; \
    if(GK){DMA_K((t)+3,sl_cur);} if(GV){DMA_V((t)+1,sl_next);} \
    CMASK(C0,C1,t); \
    { float a=MX3(C0[0],C0[1],C1[0]),b=MX3(C0[2],C0[3],C1[1]); a=MX3(a,C1[2],C1[3]); \
      _Pragma("unroll") for(int r=4;r<16;r+=4){a=MX3(a,C0[r],C0[r+1]);b=MX3(b,C0[r+2],C0[r+3]);a=MX3(a,C1[r],C1[r+1]);b=MX3(b,C1[r+2],C1[r+3]);} \
      float rm=__builtin_fmaxf(a,b); { auto rr=__builtin_amdgcn_permlane32_swap(__float_as_uint(rm),__float_as_uint(rm),false,false); rm=__builtin_fmaxf(__uint_as_float(rr[0]),__uint_as_float(rr[1])); } \
      resc=false; \
      if(__builtin_expect(__any(rm>(float)THRL),0)){ const float dl=__builtin_fmaxf(rm,0.f); mhat+=dl; \
        _Pragma("unroll") for(int r=0;r<16;++r){C0[r]-=dl;C1[r]-=dl;} \
        _Pragma("unroll") for(int r=0;r<16;++r)negm[r]=-mhat; asm volatile("":"+v"(negm)); \
        const float f=__builtin_amdgcn_exp2f(-dl); l_reg*=f; if(hi==0)wsf[r32]=f; resc=true; } } \
    SBAR(); \
    GAPB(o[0]=__builtin_amdgcn_mfma_f32_32x32x16_bf16(PAF(0),VFR(0),o[0],0,0,0), C0,0); \
    GAPB(o[1]=__builtin_amdgcn_mfma_f32_32x32x16_bf16(PAF(0),VFR(4),o[1],0,0,0), C0,4); \
    KRD(GL,0); GAPB(o[0]=__builtin_amdgcn_mfma_f32_32x32x16_bf16(PAF(1),VFR(1),o[0],0,0,0), C0,8); \
    KRD(GL,1); GAPB(o[1]=__builtin_amdgcn_mfma_f32_32x32x16_bf16(PAF(1),VFR(5),o[1],0,0,0), C0,12); \
    KRD(GL,2); GAPB(o[0]=__builtin_amdgcn_mfma_f32_32x32x16_bf16(PAF(2),VFR(2),o[0],0,0,0), C1,0); \
    KRD(GL,3); GAPB(o[1]=__builtin_amdgcn_mfma_f32_32x32x16_bf16(PAF(2),VFR(6),o[1],0,0,0), C1,4); \
    GAPB(o[0]=__builtin_amdgcn_mfma_f32_32x32x16_bf16(PAF(3),VFR(3),o[0],0,0,0), C1,8); \
    GAPB(o[1]=__builtin_amdgcn_mfma_f32_32x32x16_bf16(PAF(3),VFR(7),o[1],0,0,0), C1,12); \
    }while(0)
  int t=1;
  for(;t+5<NT;t+=2){
    STEP(pB0,pB1,pA0,pA1,t,true,true,true);     WAIT_BAR(2); RESC(); ROT();
    STEP(pA0,pA1,pB0,pB1,t+1,true,true,true);   WAIT_BAR(2); RESC(); ROT();
  }
  #define ENDW(tt) do{ if((tt)+3<NT){WAIT_BAR(2);} else if((tt)+2<NT){WAIT_BAR(1);} else {WAIT_BAR(0);} }while(0)
  for(;t+1<NT;t+=2){
    STEP(pB0,pB1,pA0,pA1,t,(t+3<NT),(t+1<NT),(t+1<NT));       ENDW(t);   RESC(); ROT();
    STEP(pA0,pA1,pB0,pB1,t+1,(t+4<NT),(t+2<NT),(t+2<NT));     ENDW(t+1); RESC(); ROT();
  }
  STEP(pB0,pB1,pA0,pA1,NT-1,false,false,false); RESC();
  { float sacc=pB0[0]+pB0[1]; _Pragma("unroll") for(int r=2;r<16;++r)sacc+=pB0[r]; _Pragma("unroll") for(int r=0;r<16;++r)sacc+=pB1[r]; l_reg+=sacc;
    pw0=(u32x4){PKW(pB0,0),PKW(pB0,2),PKW(pB0,4),PKW(pB0,6)};pw1=(u32x4){PKW(pB0,8),PKW(pB0,10),PKW(pB0,12),PKW(pB0,14)};pw2=(u32x4){PKW(pB1,0),PKW(pB1,2),PKW(pB1,4),PKW(pB1,6)};pw3=(u32x4){PKW(pB1,8),PKW(pB1,10),PKW(pB1,12),PKW(pB1,14)};
    SBAR(); pv(o,vb0+sl_cur,PAF(0),PAF(1),PAF(2),PAF(3)); }
  #undef PKW
  #undef PAF
  #undef VFR
  #undef PIN
  #undef MX3
  #undef GAPA
  #undef GAPB
  #undef EX
  #undef VRD
  #undef KRD
  #undef STEP
  #undef ENDW
  {auto rr=__builtin_amdgcn_permlane32_swap(__float_as_uint(l_reg),__float_as_uint(l_reg),false,false);l_reg=__uint_as_float(rr[0])+__uint_as_float(rr[1]);}
  if(hi==0)wsf[32+r32]=l_reg;asm volatile("s_waitcnt lgkmcnt(0)":::"memory");
  float rli[16];
  #pragma unroll
  for(int r=0;r<16;++r)rli[r]=__builtin_amdgcn_rcpf(wsf[32+crow(r,hi)]);
#if ATT_FP8
  { unsigned char*Ow8=(unsigned char*)O+(qrow0+wid*QBLK)*QP+h*D;
    unsigned char*stg8=(unsigned char*)(shm+LDS_OST)+wid*4096;
    #pragma unroll
    for(int r=0;r<16;++r){const int orow=crow(r,hi);
      #pragma unroll
      for(int d0=0;d0<2;++d0){const float x=o[d0][r]*rli[r]*(float)(1<<ATT_OSH); stg8[orow*64+d0*32+r32]=(unsigned char)(__builtin_amdgcn_cvt_pk_fp8_f32(x,x,0u,false)&0xffu);}}
    asm volatile("s_waitcnt lgkmcnt(0)":::"memory");
    #pragma unroll
    for(int i=0;i<2;++i){const int row=i*16+(lane>>2),ch=lane&3; const u32x4 v=*(const u32x4*)(stg8+row*64+ch*16); ATTN_STORE16(Ow8+(long)row*QP+ch*16,v);} }
#else
  bf16*Ow=O+(qrow0+wid*QBLK)*QP+h*D;
  { bf16*stg=(bf16*)(shm+LDS_OST)+wid*2048;
    #pragma unroll
    for(int r=0;r<16;++r){const int orow=crow(r,hi);
      #pragma unroll
      for(int d0=0;d0<2;++d0)stg[orow*64+d0*32+r32]=__float2bfloat16(o[d0][r]*rli[r]);}
    asm volatile("s_waitcnt lgkmcnt(0)":::"memory");
    #pragma unroll
    for(int i=0;i<4;++i){const int row=i*8+(lane>>3),ch=lane&7; const u32x4 v=*(const u32x4*)(stg+row*64+ch*8); ATTN_STORE16(Ow+(long)row*QP+ch*8,v);} }
#endif
  asm volatile("s_waitcnt lgkmcnt(0)\n\ts_barrier":::"memory");
  #undef DMA_K
  #undef DMA_V
  #undef CMASK
  #undef START
  #undef RESC
  #undef ROT
}
constexpr int ATTN_LDS_BYTES=LDS_BYTES;
#undef SBAR
#undef WAIT_BAR
}

typedef f32x4 AccT[2][2][4][2];
__device__ __forceinline__ long kv_row(int r) { return r < TL ? (long)(r / SEQ) * KVROWS + CTXL + (r % SEQ) : (long)((r - TL) / CTXL) * KVROWS + ((r - TL) % CTXL); }

struct SchedDense {
    static constexpr bool IMM_DONE = false;
    const char* A; const char* B; size_t astep, bstep, acol; int nM, nN, G, c;
    __device__ __forceinline__ bool next(int i, pg8::Unit& u) const {
        const int L = i * G + c; if (L >= nM * nN) return false;
        pg8::tile_of(L, nM, nN, u.pm, u.pn); u.A = A + (size_t)u.pm * astep + (size_t)u.pn * acol; u.B = B + (size_t)u.pn * bstep; u.x0 = 0; u.x1 = 0; return true; }
    __device__ __forceinline__ int gather(const pg8::Unit&, int) const { return 0; }
    __device__ __forceinline__ void a_ready(const pg8::Unit&, int) const {}
    __device__ __forceinline__ void done(const pg8::Unit&, int) const {}
};
struct SchedDenseR {
    static constexpr bool IMM_DONE = true;
    const char* A; const char* B; size_t astep, bstep, acol; int nM, nN, nF, G, c; unsigned* ready;
    __device__ __forceinline__ bool next(int i, pg8::Unit& u) const {
        const int L = i * G + c, n1 = nF * nN; if (L >= nM * nN) return false;
        if (L < n1) pg8::tile_of(L, nF, nN, u.pm, u.pn); else { u.pm = nF + (L - n1) / nN; u.pn = (L - n1) % nN; }
        u.A = A + (size_t)u.pm * astep + (size_t)u.pn * acol; u.B = B + (size_t)u.pn * bstep; u.x0 = 0; u.x1 = 0; return true; }
    __device__ __forceinline__ int gather(const pg8::Unit&, int) const { return 0; }
    __device__ __forceinline__ void a_ready(const pg8::Unit&, int) const {}
    __device__ __forceinline__ void done(const pg8::Unit& u, int lane) const { if (lane == 0) __hip_atomic_fetch_add(ready + u.pm, 1u, __ATOMIC_RELAXED, __HIP_MEMORY_SCOPE_AGENT); }
};
struct SchedQKV {
    static constexpr bool IMM_DONE = false;
    const char* A; const char* B; size_t tstep; int ctxq, G, c;
    __device__ __forceinline__ bool next(int i, pg8::Unit& u) const {
        const int L = i * G + c, n1 = 64 * 6, n2 = ctxq ? 24 : 8; if (L >= n1 + n2) return false;
        if (L < n1) pg8::tile_of(L, 64, 6, u.pm, u.pn);
        else if (ctxq) { pg8::tile_of(L - n1, 4, 6, u.pm, u.pn); u.pm += 64; }
        else { u.pm = 64 + ((L - n1) >> 1); u.pn = 4 + ((L - n1) & 1); }
        u.A = A + (size_t)u.pm * tstep; u.B = B + (size_t)u.pn * tstep; u.x0 = 0; u.x1 = 0; return true; }
    __device__ __forceinline__ int gather(const pg8::Unit&, int) const { return 0; }
    __device__ __forceinline__ void a_ready(const pg8::Unit&, int) const {}
    __device__ __forceinline__ void done(const pg8::Unit&, int) const {}
};
struct SchedMoe {
    static constexpr bool IMM_DONE = false;
    const char* Abase; size_t astep; const char* Bbase; size_t bstep_e, bstep_n; const LAS int* tab; const int* list; int G, c;
    unsigned* ready; int mode;
    __device__ __forceinline__ int T(int i) const { return __builtin_amdgcn_readfirstlane(tab[i]); }
    __device__ __forceinline__ bool next(int i, pg8::Unit& u) const {
        const int ntiles = T(32), L = i * G + (mode == 2 ? G - 1 - c : c); if (L >= ntiles * 4) return false;
        int gt, pn; pg8::tile_of(L, ntiles, 4, gt, pn);
        int e = 0;
        for (int q = 1; q < 32; ++q) e += (T(q) <= gt) ? 1 : 0;
        const int ti = gt - T(e); int valid = T(40 + e) - ti * 256; valid = valid > 256 ? 256 : valid;
        u.pm = gt; u.pn = pn; u.x0 = e * MOE_CAP + ti * 256; u.x1 = valid;
        u.A = Abase + (size_t)gt * astep; u.B = Bbase + (size_t)e * bstep_e + (size_t)pn * bstep_n; return true; }
    __device__ __forceinline__ int gather(const pg8::Unit& u, int lr) const { return lr < u.x1 ? (list[u.x0 + lr] >> 1) : 0; }
    __device__ __forceinline__ void a_ready(const pg8::Unit& u, int wid) const {
        if (mode != 2) return;
        if (wid == 0) { unsigned sp = 0;
            while ((unsigned)__builtin_amdgcn_readfirstlane(__hip_atomic_load(ready + u.pm, __ATOMIC_RELAXED, __HIP_MEMORY_SCOPE_AGENT)) < 32u) { __builtin_amdgcn_s_sleep(2); if (++sp > (1u << 22)) break; }
            __builtin_amdgcn_fence(__ATOMIC_ACQUIRE, "agent"); asm volatile("s_waitcnt vmcnt(0)" ::: "memory"); }
        __builtin_amdgcn_s_barrier(); asm volatile("" ::: "memory");
    }
    __device__ __forceinline__ void done(const pg8::Unit& u, int lane) const {
        if (mode != 1) return;
        if (lane == 0) __hip_atomic_fetch_add(ready + u.pm, 1u, __ATOMIC_RELAXED, __HIP_MEMORY_SCOPE_AGENT);
    }
};

struct EpiQKV { static constexpr bool PERM = true; bf16* Q; bf16* Kb; bf16* Vb; const float* qg; const float* kg; const f32x2* tab;
    __device__ __forceinline__ void operator()(const AccT& acc, const pg8::Unit& u, int wr, int wc, int fr, int fq) const {
        bf16* base; int pitch; long row0;
        if (u.pn < 4) { base = Q + u.pn * 256; pitch = 1024; row0 = (long)u.pm * 256; }
        else { base = (u.pn == 4) ? Kb : Vb; pitch = 256; row0 = kv_row(u.pm * 256); }
        const bool isv = u.pn == 5, lat = u.pm < 64; const float* g = u.pn < 4 ? qg : kg; const float post = u.pn < 4 ? 0.125f * 1.4426950408889634f : 1.0f;
#pragma unroll
        for (int ai = 0; ai < 2; ++ai)
#pragma unroll
            for (int m = 0; m < 4; ++m) { int fq_ = fq; asm volatile("" : "+v"(fq_));
                const int fq = fq_; const int lr = ai * 128 + wr * 64 + m * 16 + fr; const unsigned roff = (unsigned)(((int)row0 + lr) * pitch + wc * 64 + 8 * fq) * 2u;
                f32x4 g0[2], g1[2];
#pragma unroll
                for (int bj = 0; bj < 2; ++bj) { g0[bj] = *(const f32x4*)(g + 32 * bj + 8 * fq); g1[bj] = *(const f32x4*)(g + 32 * bj + 8 * fq + 4); }
                f32x4 v[2][2];
#pragma unroll
                for (int bj = 0; bj < 2; ++bj) { v[bj][0] = acc[ai][bj][m][0]; v[bj][1] = acc[ai][bj][m][1]; }
                if (!isv) {
                    float ss = 0.f;
#pragma unroll
                    for (int bj = 0; bj < 2; ++bj)
#pragma unroll
                        for (int n = 0; n < 2; ++n) ss += (v[bj][n][0] * v[bj][n][0] + v[bj][n][1] * v[bj][n][1]) + (v[bj][n][2] * v[bj][n][2] + v[bj][n][3] * v[bj][n][3]);
                    ss += __shfl_xor(ss, 16); ss += __shfl_xor(ss, 32);
                    const float rstd = rsqrtf(ss * (1.0f / 64.0f) + EPS);
#pragma unroll
                    for (int bj = 0; bj < 2; ++bj) { v[bj][0] = v[bj][0] * rstd * g0[bj]; v[bj][1] = v[bj][1] * rstd * g1[bj]; }
                    if (lat) { const int t = (u.pm * 256 + lr) & (SEQ - 1);
#pragma unroll
                        for (int bj = 0; bj < 2; ++bj) { const f32x2* tb = (const f32x2*)((const char*)tab + (unsigned)(((bj == 0 ? (t >> 6) : (t & 63)) * 16 + 4 * fq) * 8));
#pragma unroll
                            for (int n = 0; n < 2; ++n)
#pragma unroll
                                for (int e = 0; e < 2; ++e) { const f32x2 cs = tb[2 * n + e]; const float x0 = v[bj][n][2 * e], x1 = v[bj][n][2 * e + 1];
                                    v[bj][n][2 * e] = x0 * cs.x - x1 * cs.y; v[bj][n][2 * e + 1] = x0 * cs.y + x1 * cs.x; } } }
#pragma unroll
                    for (int bj = 0; bj < 2; ++bj) { v[bj][0] = v[bj][0] * post; v[bj][1] = v[bj][1] * post; }
                }
#pragma unroll
                for (int bj = 0; bj < 2; ++bj)
                    *(u32x4*)((char*)base + roff + bj * 64) = (u32x4){cvtpk(v[bj][0][0], v[bj][0][1]), cvtpk(v[bj][0][2], v[bj][0][3]), cvtpk(v[bj][1][0], v[bj][1][1]), cvtpk(v[bj][1][2], v[bj][1][3])}; }
    }
};
struct EpiResid { static constexpr bool PERM = false; const Args* a; int layer; const float* pscale; const float* srcbase;
    __device__ __forceinline__ void operator()(const AccT& acc, const pg8::Unit& u, int wr, int wc, int, int) const {
        int ln = (int)__builtin_amdgcn_mbcnt_hi(~0u, __builtin_amdgcn_mbcnt_lo(~0u, 0u)); asm volatile("" : "+v"(ln)); const int fr = ln & 15, fq = ln >> 4;
        const int r0 = u.pm * 256;
        const float* src = srcbase ? srcbase + (size_t)r0 * D : resid_row(*a, layer, r0); const float* gate = mod_row(*a, layer, r0) + 2 * D;
        const __amdgpu_buffer_rsrc_t rs = __builtin_amdgcn_make_buffer_rsrc((void*)(a->ws + WS_X), 0, TT * D * 4, 0x00020000);
        const int col0 = u.pn * 256 + wc * 32 + 4 * fq;
#pragma unroll
        for (int bj = 0; bj < 2; ++bj)
#pragma unroll
            for (int n = 0; n < 2; ++n) { const int cc = col0 + bj * 128 + n * 16; f32x4 g = *(const f32x4*)(gate + cc); if (pscale) g = g * *(const f32x4*)(pscale + cc);
#pragma unroll
                for (int ai = 0; ai < 2; ++ai)
#pragma unroll
                    for (int m = 0; m < 4; ++m) { const int off = (ai * 128 + wr * 64 + m * 16 + fr) * D + cc;
                        const f32x4 o = *(const f32x4*)(src + off) + g * acc[ai][bj][m][n];
                        __builtin_amdgcn_raw_buffer_store_b128(__builtin_bit_cast(u32x4, o), rs, (r0 * D + off) * 4, 0, 16  ); }
                asm volatile("" ::: "memory"); }
    }
};
struct EpiGateUp { static constexpr bool PERM = true; bf16* act;
    __device__ __forceinline__ void operator()(const AccT& acc, const pg8::Unit& u, int wr, int wc, int fr, int fq) const {
        const __amdgpu_buffer_rsrc_t rs = __builtin_amdgcn_make_buffer_rsrc((void*)act, 0, 43008 * 512 * 2, 0x00020000);
#pragma unroll
        for (int ai = 0; ai < 2; ++ai)
#pragma unroll
            for (int m = 0; m < 4; ++m) { const int off = (int)((((size_t)u.pm * 256 + ai * 128 + wr * 64 + m * 16 + fr) * 512 + u.pn * 128 + wc * 32 + 8 * fq) * 2);
                const f32x4 g0 = acc[ai][0][m][0], g1 = acc[ai][0][m][1], u0 = acc[ai][1][m][0], u1 = acc[ai][1][m][1];
                const u32x4 ov = (u32x4){cvtpk(silu_f(g0[0]) * u0[0], silu_f(g0[1]) * u0[1]), cvtpk(silu_f(g0[2]) * u0[2], silu_f(g0[3]) * u0[3]),
                                     cvtpk(silu_f(g1[0]) * u1[0], silu_f(g1[1]) * u1[1]), cvtpk(silu_f(g1[2]) * u1[2], silu_f(g1[3]) * u1[3])};
#if MOE_FP8
                { const float sa = (float)(1 << MOE_ASH); const u32x2 o8 = (u32x2){pk_fp8x4(silu_f(g0[0]) * u0[0] * sa, silu_f(g0[1]) * u0[1] * sa, silu_f(g0[2]) * u0[2] * sa, silu_f(g0[3]) * u0[3] * sa),
                                                                                    pk_fp8x4(silu_f(g1[0]) * u1[0] * sa, silu_f(g1[1]) * u1[1] * sa, silu_f(g1[2]) * u1[2] * sa, silu_f(g1[3]) * u1[3] * sa)};
                  (void)ov; __builtin_amdgcn_raw_buffer_store_b64(o8, rs, off >> 1, 0, 16  ); } }
#else
                __builtin_amdgcn_raw_buffer_store_b128(ov, rs, off, 0, 16  ); }
#endif
    }
};
struct EpiDown { static constexpr bool PERM = true; const int* list; const float* w2; bf16* y2;
    __device__ __forceinline__ void operator()(const AccT& acc, const pg8::Unit& u, int wr, int wc, int fr, int fq) const {
#pragma unroll
        for (int ai = 0; ai < 2; ++ai)
#pragma unroll
            for (int m = 0; m < 4; ++m) { const int lr = ai * 128 + wr * 64 + m * 16 + fr;
                if (lr < u.x1) { const int dest = list[u.x0 + lr]; const float w = w2[dest]; bf16* p = y2 + (size_t)dest * D + u.pn * 256 + wc * 32 + 8 * fq;
#pragma unroll
                    for (int bj = 0; bj < 2; ++bj) { const f32x4 v0 = acc[ai][bj][m][0] * w, v1 = acc[ai][bj][m][1] * w;
                        *(u32x4*)(p + bj * 128) = (u32x4){cvtpk(v0[0], v0[1]), cvtpk(v0[2], v0[3]), cvtpk(v1[0], v1[1]), cvtpk(v1[2], v1[3])}; } } }
    }
};

constexpr int TAB_OFF = 135168;

__device__ __forceinline__ void ph_rope(const Args& a, const Ctx& c, int layer) {
    const int j = layer == 0 ? 0 : 1; const bool ctxq = layer == 0;
    const float* qg = a.in[I_QG] + j * 64; const float* kg = a.in[I_KG] + j * 64;
    const f32x2* tab = (const f32x2*)(a.ws + WS_ROPE);
    bf16* Qb = (bf16*)(a.ws + WS_Q); bf16* Kb = (bf16*)(a.ws + WS_K);
    const int nitems = TT * 20;
    for (int it = blockIdx.x * NTHREADS + c.tid; it < nitems; it += c.G * NTHREADS) {
        const int r = it / 20, hs = it % 20;
        if (hs < 16 && r >= TL && !ctxq) continue;
        bf16* p; const float* g; float post;
        if (hs < 16) { p = Qb + (size_t)r * 1024 + hs * 64; g = qg; post = 0.125f * 1.4426950408889634f; } else { p = Kb + kv_row(r) * 256 + (hs - 16) * 64; g = kg; post = 1.0f; }
        float x[64]; float ss = 0.f;
#pragma unroll
        for (int i = 0; i < 8; ++i) { const u32x4 w = ((const u32x4*)p)[i];
            x[8 * i + 0] = bflo(w.x); x[8 * i + 1] = bfhi(w.x); x[8 * i + 2] = bflo(w.y); x[8 * i + 3] = bfhi(w.y);
            x[8 * i + 4] = bflo(w.z); x[8 * i + 5] = bfhi(w.z); x[8 * i + 6] = bflo(w.w); x[8 * i + 7] = bfhi(w.w); }
#pragma unroll
        for (int i = 0; i < 64; ++i) ss += x[i] * x[i];
        const float rstd = rsqrtf(ss * (1.0f / 64.0f) + EPS);
#pragma unroll
        for (int i = 0; i < 64; ++i) x[i] = x[i] * rstd * g[i];
        if (r < TL) { const int t = r % SEQ, rp = t >> 6, cp = t & 63;
#pragma unroll
            for (int i = 0; i < 32; ++i) { const f32x2 cs = tab[(i < 16 ? rp : cp) * 16 + (i & 15)]; const float x0 = x[2 * i], x1 = x[2 * i + 1];
                x[2 * i] = x0 * cs.x - x1 * cs.y; x[2 * i + 1] = x0 * cs.y + x1 * cs.x; } }
#pragma unroll
        for (int i = 0; i < 8; ++i) ((u32x4*)p)[i] = (u32x4){cvtpk(x[8 * i] * post, x[8 * i + 1] * post), cvtpk(x[8 * i + 2] * post, x[8 * i + 3] * post),
                                                            cvtpk(x[8 * i + 4] * post, x[8 * i + 5] * post), cvtpk(x[8 * i + 6] * post, x[8 * i + 7] * post)};
    }
}

__device__ __forceinline__ void ph_att(const Args& a, const Ctx& c, int layer, char* lds_generic) {
    const int nun = 1024 + (layer == 0 ? 64 : 0);
    const attn_body::bf16* Qb = (const attn_body::bf16*)(a.ws + WS_Q); const attn_body::bf16* Kb = (const attn_body::bf16*)(a.ws + WS_K); const attn_body::bf16* Vb = (const attn_body::bf16*)(a.ws + WS_V);
    for (int U = c.vcu; U < nun; U += c.G) {
        long qrow0, kv0; int h, NT;
        if (U < 1024) { const int bh = U >> 4, qb = U & 15, b = bh >> 4; h = bh & 15; qrow0 = (long)b * SEQ + qb * 256; kv0 = (long)b * KVROWS; NT = KVROWS / 64; }
        else { const int q = U - 1024, b = q >> 4; h = q & 15; qrow0 = (long)TL + b * CTXL; kv0 = (long)b * KVROWS; NT = CTXL / 64; }
        attn_body::attn_unit<8>(qrow0, h, kv0, NT, Qb, Kb, Vb, (attn_body::bf16*)(a.ws + WS_HB), lds_generic);
    }
}

__device__ __forceinline__ void ph_m1(const Args& a, const Ctx& c, int layer, const unsigned* rdy, int nN) {
    const int Tm = layer == 3 ? TL : TT, ntiles = Tm / 32;
    int tl0, tl1, tl2;
    { int bid = (int)blockIdx.x; asm volatile("" : "+s"(bid));
      if (c.G == 256 && ntiles == 544) { if (bid < 16) { tl0 = 512 + bid; tl1 = -1; tl2 = -1; } else { const int j = bid - 16; tl0 = j; tl1 = j + 240; tl2 = j < 32 ? j + 480 : (j < 48 ? 528 + (j - 32) : -1); } }
      else { tl0 = bid < ntiles ? bid : -1; tl1 = bid + c.G < ntiles ? bid + c.G : -1; tl2 = bid + 2 * c.G < ntiles ? bid + 2 * c.G : -1; } }
    const unsigned need = 8u * (unsigned)nN;
#define M1_WAIT(tl) do { if (c.wave == 0) { unsigned sp_ = 0; \
        while ((unsigned)__builtin_amdgcn_readfirstlane(__hip_atomic_load(rdy + ((tl) >> 3), __ATOMIC_RELAXED, __HIP_MEMORY_SCOPE_AGENT)) < need) { __builtin_amdgcn_s_sleep(2); if (++sp_ > (1u << 22)) break; } \
        __builtin_amdgcn_fence(__ATOMIC_ACQUIRE, "agent"); asm volatile("s_waitcnt vmcnt(0)" ::: "memory"); } \
        __syncthreads(); } while (0)
    const float* g = a.in[I_NFFN] + layer * D;
    constexpr int RP = 2064;
    LAS unsigned char* hiT = c.lds; LAS unsigned char* loT = c.lds + 32 * RP;
    LAS float* part = (LAS float*)c.lds;
    LAS int* lcnt = (LAS int*)(c.lds + 133120); LAS int* lbase = lcnt + 32;
    LAS float* logit = (LAS float*)(c.lds + 134144);
    const bf16* wr = (const bf16*)(a.ws + WS_WR) + (size_t)layer * 2 * 65536;
    unsigned* gcnt = (unsigned*)(a.ws + WS_CTL) + CW_CNT + layer * 32;
    int* list = (int*)(a.ws + WS_LIST); float* w2 = (float*)(a.ws + WS_W2);
    const int r32 = c.lane & 31, hi = c.lane >> 5;
    if (c.tid < 32) lcnt[c.tid] = 0;
    f32x4 vv[4][4];
#define M1_LOADROWS(tl) do { _Pragma("unroll") for (int i = 0; i < 4; ++i) { const f32x4* xr = (const f32x4*)((const float*)(a.ws + WS_X) + (size_t)((tl) * 32 + 4 * c.wave + i) * D) + c.lane; \
        _Pragma("unroll") for (int j = 0; j < 4; ++j) vv[i][j] = xr[64 * j]; } } while (0)
    if (tl0 >= 0) { M1_WAIT(tl0); M1_LOADROWS(tl0); }
    int nmine = 0;
    for (; nmine < 3; ++nmine) { const int tile = nmine == 0 ? tl0 : nmine == 1 ? tl1 : tl2, tnext = nmine == 0 ? tl1 : nmine == 1 ? tl2 : -1;
        if (tile < 0) break;
        const int r0 = tile * 32;
        { f32x4 gs[4], sh[4];
          { const float* m = mod_row(a, layer, r0);
#pragma unroll
            for (int j = 0; j < 4; ++j) { gs[j] = ((const f32x4*)g)[c.lane + 64 * j] * (((const f32x4*)(m + 4 * D))[c.lane + 64 * j] + 1.0f); sh[j] = ((const f32x4*)(m + 3 * D))[c.lane + 64 * j]; } }
#pragma unroll
          for (int i = 0; i < 4; ++i) { const int lr = 4 * c.wave + i, r = r0 + lr;
            f32x4 h[4];
            const float rstd = row_rstd(vv[i]);
#pragma unroll
            for (int j = 0; j < 4; ++j) h[j] = (vv[i][j] * rstd) * gs[j] + sh[j];
#if MOE_FP8
            unsigned* to8 = (unsigned*)((unsigned char*)(a.ws + WS_TK) + (size_t)r * D) + c.lane;
#else
            u32x2* to = (u32x2*)((bf16*)(a.ws + WS_TK) + (size_t)r * D) + c.lane;
#endif
#pragma unroll
            for (int j = 0; j < 4; ++j) { const unsigned h0 = cvtpk(h[j].x, h[j].y), h1 = cvtpk(h[j].z, h[j].w);
                const unsigned l0 = cvtpk(h[j].x - bflo(h0), h[j].y - bfhi(h0)), l1 = cvtpk(h[j].z - bflo(h1), h[j].w - bfhi(h1));
#if MOE_FP8
                to8[64 * j] = pk_fp8x4(h[j].x, h[j].y, h[j].z, h[j].w);
#else
                to[64 * j] = (u32x2){h0, h1};
#endif
                *(LAS u32x2*)(hiT + lr * RP + (4 * c.lane + 256 * j) * 2) = (u32x2){h0, h1};
                *(LAS u32x2*)(loT + lr * RP + (4 * c.lane + 256 * j) * 2) = (u32x2){l0, l1}; } } }
        __syncthreads();
        f32x16 acc0 = {}, acc1 = {};
#pragma unroll
        for (int kk = 0; kk < 8; ++kk) { const int k0 = 128 * c.wave + 16 * kk + 8 * hi;
            const bf16x8 ahi = *(const LAS bf16x8*)(hiT + r32 * RP + k0 * 2), alo = *(const LAS bf16x8*)(loT + r32 * RP + k0 * 2);
            const bf16x8 b0h = *(const bf16x8*)(wr + r32 * 1024 + k0), b1h = *(const bf16x8*)(wr + (32 + r32) * 1024 + k0);
            const bf16x8 b0l = *(const bf16x8*)(wr + 65536 + r32 * 1024 + k0), b1l = *(const bf16x8*)(wr + 65536 + (32 + r32) * 1024 + k0);
            acc0 = __builtin_amdgcn_mfma_f32_32x32x16_bf16(ahi, b0h, acc0, 0, 0, 0); acc1 = __builtin_amdgcn_mfma_f32_32x32x16_bf16(ahi, b1h, acc1, 0, 0, 0);
            acc0 = __builtin_amdgcn_mfma_f32_32x32x16_bf16(alo, b0h, acc0, 0, 0, 0); acc1 = __builtin_amdgcn_mfma_f32_32x32x16_bf16(alo, b1h, acc1, 0, 0, 0);
            acc0 = __builtin_amdgcn_mfma_f32_32x32x16_bf16(ahi, b0l, acc0, 0, 0, 0); acc1 = __builtin_amdgcn_mfma_f32_32x32x16_bf16(ahi, b1l, acc1, 0, 0, 0); }
        if (tnext >= 0) { M1_WAIT(tnext); M1_LOADROWS(tnext); }
        else __syncthreads();
#pragma unroll
        for (int reg = 0; reg < 16; ++reg) { part[((c.wave * 2 + 0) * 16 + reg) * 64 + c.lane] = acc0[reg]; part[((c.wave * 2 + 1) * 16 + reg) * 64 + c.lane] = acc1[reg]; }
        __syncthreads();
        if (nmine < 3) {
#pragma unroll
            for (int q = 0; q < 4; ++q) { const int idx = c.tid + 512 * q, nt = idx >> 10, reg = (idx >> 6) & 15, ln = idx & 63; float s = 0.f;
#pragma unroll
                for (int w = 0; w < 8; ++w) s += part[((w * 2 + nt) * 16 + reg) * 64 + ln];
                logit[(nmine * 32 + (reg & 3) + 8 * (reg >> 2) + 4 * (ln >> 5)) * 64 + nt * 32 + (ln & 31)] = s; } }
        __syncthreads();
    }
#undef M1_LOADROWS
#undef M1_WAIT
    int e0 = 0, e1 = 0, p0 = 0, p1 = 0; float w0 = 0.f, w1 = 0.f; const int myt = c.tid >> 5; const bool act_r = c.tid < 96 && myt < nmine;
    if (act_r) { const LAS float* lg = logit + c.tid * 64;
        int grp = 0; float gm = lg[0];
#pragma unroll
        for (int q = 1; q < 4; ++q) if (lg[q] > gm) { gm = lg[q]; grp = q; }
        float den = 0.f;
#pragma unroll
        for (int q = 0; q < 4; ++q) den += expf(lg[q] - gm);
        const float gate = 1.0f / den;
        const LAS float* le = lg + 4 + grp * 8;
        int i0 = 0; float v0 = le[0];
#pragma unroll
        for (int q = 1; q < 8; ++q) if (le[q] > v0) { v0 = le[q]; i0 = q; }
        int i1 = -1; float v1 = -3.0e38f;
#pragma unroll
        for (int q = 0; q < 8; ++q) if (q != i0 && le[q] > v1) { v1 = le[q]; i1 = q; }
        const float ex = expf(v1 - v0); w0 = gate / (1.0f + ex); w1 = gate * ex / (1.0f + ex);
        e0 = grp * 8 + i0; e1 = grp * 8 + i1;
        p0 = __hip_atomic_fetch_add(lcnt + e0, 1, __ATOMIC_RELAXED, __HIP_MEMORY_SCOPE_WORKGROUP);
        p1 = __hip_atomic_fetch_add(lcnt + e1, 1, __ATOMIC_RELAXED, __HIP_MEMORY_SCOPE_WORKGROUP); }
    __syncthreads();
    if (c.tid < 32) { const int n = lcnt[c.tid]; lbase[c.tid] = n ? (int)__hip_atomic_fetch_add(gcnt + c.tid, (unsigned)n, __ATOMIC_RELAXED, __HIP_MEMORY_SCOPE_AGENT) : 0; }
    __syncthreads();
    if (act_r) { const int r = (myt == 0 ? tl0 : myt == 1 ? tl1 : tl2) * 32 + (c.tid & 31);
        list[e0 * MOE_CAP + lbase[e0] + p0] = 2 * r; w2[2 * r] = w0;
        list[e1 * MOE_CAP + lbase[e1] + p1] = 2 * r + 1; w2[2 * r + 1] = w1; }
    __syncthreads();
}
__device__ __forceinline__ void moe_tables(const Args& a, const Ctx& c, int layer, LAS int* tab) {
    unsigned* gcnt = (unsigned*)(a.ws + WS_CTL) + CW_CNT + layer * 32;
    if (c.tid < 32) tab[40 + c.tid] = (int)__hip_atomic_load(gcnt + c.tid, __ATOMIC_RELAXED, __HIP_MEMORY_SCOPE_AGENT);
    __syncthreads();
    if (c.tid == 0) { int s = 0; for (int e = 0; e < 32; ++e) { tab[e] = s; s += (tab[40 + e] + 255) >> 8; } tab[32] = s; }
    __syncthreads();
}

__device__ __forceinline__ void ph_rpool(const Args& a, const Ctx& c, int layer) {
    LAS unsigned char* hs = c.lds;
    const float* g = a.in[I_NMIX] + layer * D;
    for (int tile = blockIdx.x; tile < TT / 32; tile += c.G) {
        const int r0 = tile * 32;
        const int s0 = r0 < TL ? (r0 / SEQ) * SEQ : TL + ((r0 - TL) / CTXL) * CTXL, s1 = s0 + (r0 < TL ? SEQ : CTXL);
        for (int lr = c.wave; lr < 47; lr += NWAVES) { const int gr = r0 - 8 + lr; if (gr < s0 || gr >= s1) continue;
            f32x4 v[4], h[4]; load_row_combined(a, layer, gr, c.lane, v);
            if (lr >= 8 && lr < 40) { f32x4* xo = (f32x4*)((float*)(a.ws + WS_Z) + (size_t)gr * D) + c.lane;
#pragma unroll
                for (int j = 0; j < 4; ++j) xo[64 * j] = v[j]; }
            const float rstd = row_rstd(v); const float* m = mod_row(a, layer, gr);
            norm_mod(v, rstd, g, m, m + D, c.lane, h);
#pragma unroll
            for (int j = 0; j < 4; ++j) *(LAS u32x2*)(hs + lr * 2048 + (4 * c.lane + 256 * j) * 2) = (u32x2){cvtpk(h[j].x, h[j].y), cvtpk(h[j].z, h[j].w)}; }
        __syncthreads();
        { const int half = 1 << (c.tid >> 7);
          const LAS unsigned* col = (const LAS unsigned*)hs + c.tid;
          float sx = 0.f, sy = 0.f;
          { const int lo = (r0 - half) > s0 ? (r0 - half) : s0, hi = (r0 + half) < s1 ? (r0 + half) : s1;
            for (int gr = lo; gr < hi; ++gr) { const unsigned u = col[(gr - r0 + 8) * 512]; sx += bflo(u); sy += bfhi(u); } }
          unsigned* ho = (unsigned*)((bf16*)(a.ws + WS_HB) + (size_t)r0 * D) + c.tid;
          for (int t = 0; t < 32; ++t) { const int gr = r0 + t; const int lo = (gr - half) > s0 ? (gr - half) : s0, hi = (gr + half) < s1 ? (gr + half) : s1;
              const float inv = __builtin_amdgcn_rcpf((float)(hi - lo)); const unsigned u = col[(t + 8) * 512];
              ho[t * 512] = cvtpk(sx * inv - bflo(u), sy * inv - bfhi(u));
              if (t < 31) { if (gr + half < s1) { const unsigned w = col[(t + 8 + half) * 512]; sx += bflo(w); sy += bfhi(w); }
                            if (gr - half >= s0) { const unsigned w = col[(t + 8 - half) * 512]; sx -= bflo(w); sy -= bfhi(w); } } } }
        __syncthreads();
    }
}

struct EpiInproj { static constexpr bool PERM = true; bf16* Z; bf16* XBC; float* DT; const float* dtb;
    __device__ __forceinline__ void operator()(const AccT& acc, const pg8::Unit& u, int wr, int wc, int fr, int fq) const {
        const size_t r0 = (size_t)u.pm * 256;
        if (u.pn < 20) { bf16* base; int pitch; if (u.pn < 8) { base = Z + u.pn * 256; pitch = 2048; } else { base = XBC + (u.pn - 8) * 256; pitch = 3072; }
#pragma unroll
            for (int ai = 0; ai < 2; ++ai)
#pragma unroll
                for (int m = 0; m < 4; ++m) { bf16* rowp = base + (r0 + ai * 128 + wr * 64 + m * 16 + fr) * pitch + wc * 32 + 8 * fq;
#pragma unroll
                    for (int bj = 0; bj < 2; ++bj) { const f32x4 v0 = acc[ai][bj][m][0], v1 = acc[ai][bj][m][1];
                        *(u32x4*)(rowp + bj * 128) = (u32x4){cvtpk(v0[0], v0[1]), cvtpk(v0[2], v0[3]), cvtpk(v1[0], v1[1]), cvtpk(v1[2], v1[3])}; } }
        } else if (wc < 2) { const int col = wc * 32 + 8 * fq; const f32x4 b0 = *(const f32x4*)(dtb + col), b1 = *(const f32x4*)(dtb + col + 4);
#pragma unroll
            for (int ai = 0; ai < 2; ++ai)
#pragma unroll
                for (int m = 0; m < 4; ++m) { float* p = DT + (r0 + ai * 128 + wr * 64 + m * 16 + fr) * 64 + col; f32x4 v0 = acc[ai][0][m][0] + b0, v1 = acc[ai][0][m][1] + b1;
#pragma unroll
                    for (int e = 0; e < 4; ++e) { v0[e] = fmaxf(v0[e], 0.f) + log1pf(__expf(-fabsf(v0[e]))); v1[e] = fmaxf(v1[e], 0.f) + log1pf(__expf(-fabsf(v1[e]))); }
                    *(f32x4*)p = v0; *(f32x4*)(p + 4) = v1; } }
    }
};

__device__ __forceinline__ void ph_conv(const Args& a, const Ctx& c) {
    LAS unsigned char* tin = c.lds; LAS unsigned char* toT = c.lds + 17408; LAS unsigned char* toN = c.lds + 34816;
    const bf16* xbc = (const bf16*)(a.ws + WS_XBC);
    u32x4 pin[3];
#define CONV_PREFETCH(tk) do { const int ci_ = (tk) / 48, chb_ = (tk) % 48, r0_ = ci_ * 128, ch0_ = chb_ * 64; \
        const bool first_ = ci_ < 128 ? (ci_ % 32 == 0) : (((ci_ - 128) & 1) == 0), last_ = ci_ < 128 ? (ci_ % 32 == 31) : (((ci_ - 128) & 1) == 1); \
        _Pragma("unroll") for (int q = 0; q < 3; ++q) { const int p = c.tid + 512 * q, lr = p >> 3, pc = p & 7; const bool valid = p < 131 * 8 && !((lr < 2 && first_) || (lr == 130 && last_)); \
            pin[q] = (u32x4){0u, 0u, 0u, 0u}; if (valid) pin[q] = *(const u32x4*)(xbc + (size_t)(r0_ - 2 + lr) * 3072 + ch0_ + pc * 8); } } while (0)
    if ((int)blockIdx.x < NCH * 48) CONV_PREFETCH((int)blockIdx.x);
    for (int task = blockIdx.x; task < NCH * 48; task += c.G) {
        const int ci = task / 48, chb = task % 48, r0 = ci * 128, ch0 = chb * 64;
#pragma unroll
        for (int q = 0; q < 3; ++q) { const int p = c.tid + 512 * q; if (p < 131 * 8) *(LAS u32x4*)(tin + (p >> 3) * 128 + (p & 7) * 16) = pin[q]; }
        __syncthreads();
        if (task + c.G < NCH * 48) CONV_PREFETCH(task + c.G);
        { const int ch = c.tid & 63, tq = c.tid >> 6; const float* cw = a.in[I_CONVW] + ch0 + ch;
          const float w0 = cw[0], w1 = cw[3072], w2 = cw[2 * 3072], w3 = cw[3 * 3072], bias = a.in[I_CONVB][ch0 + ch];
          float xin[19];
#pragma unroll
          for (int i = 0; i < 19; ++i) xin[i] = bf2f(*(const LAS bf16*)(tin + (16 * tq + i) * 128 + ch * 2));
          float o[16];
#pragma unroll
          for (int i = 0; i < 16; ++i) o[i] = silu_f(bias + w0 * xin[i] + w1 * xin[i + 1] + w2 * xin[i + 2] + w3 * xin[i + 3]);
          if (chb < 40) { *(LAS u32x4*)(toT + ch * 272 + tq * 32) = (u32x4){cvtpk(o[0], o[1]), cvtpk(o[2], o[3]), cvtpk(o[4], o[5]), cvtpk(o[6], o[7])};
                          *(LAS u32x4*)(toT + ch * 272 + tq * 32 + 16) = (u32x4){cvtpk(o[8], o[9]), cvtpk(o[10], o[11]), cvtpk(o[12], o[13]), cvtpk(o[14], o[15])}; }
          if (chb >= 32) {
#pragma unroll
              for (int i = 0; i < 16; ++i) *(LAS bf16*)(toN + (16 * tq + i) * 144 + ch * 2) = (bf16)(cvtpk(o[i], 0.f) & 0xffffu); } }
        __syncthreads();
        if (chb < 40) { bf16* dst = chb < 32 ? (bf16*)(a.ws + WS_XT) + ((size_t)ci * 2048 + ch0) * 128 : (bf16*)(a.ws + WS_BT) + ((size_t)ci * 512 + (ch0 - 2048)) * 128;
#pragma unroll
            for (int q = 0; q < 2; ++q) { const int p = c.tid + 512 * q, chl = p >> 4, pc = p & 15; *(u32x4*)(dst + chl * 128 + pc * 8) = *(const LAS u32x4*)(toT + chl * 272 + pc * 16); } }
        if (chb >= 32) { bf16* dst = chb < 40 ? (bf16*)(a.ws + WS_BN) + (size_t)r0 * 512 + (ch0 - 2048) : (bf16*)(a.ws + WS_CN) + (size_t)r0 * 512 + (ch0 - 2560);
#pragma unroll
            for (int q = 0; q < 2; ++q) { const int p = c.tid + 512 * q, t = p >> 3, pc = p & 7; *(u32x4*)(dst + (size_t)t * 512 + pc * 8) = *(const LAS u32x4*)(toN + t * 144 + pc * 16); } }
        __syncthreads();
    }
#undef CONV_PREFETCH
    const int gw = c.vcu * NWAVES + c.wave, NGW = c.G * NWAVES;
    const float* dt = (const float*)(a.ws + WS_DT);
    for (int item = gw; item < NCH * 32; item += NGW) { const int ci = item >> 5, h = item & 31, r0 = ci * 128 + 2 * c.lane;
        const float af = -expf(a.in[I_ALOG][h]), ab = -expf(a.in[I_ALOG][32 + h]);
        const float dtf0 = dt[(size_t)r0 * 64 + h], dtf1 = dt[(size_t)(r0 + 1) * 64 + h], dtb0 = dt[(size_t)r0 * 64 + 32 + h], dtb1 = dt[(size_t)(r0 + 1) * 64 + 32 + h];
        const float laf0 = dtf0 * af, laf1 = dtf1 * af, lab0 = dtb0 * ab, lab1 = dtb1 * ab;
        float inf_ = laf0 + laf1, inb = lab0 + lab1; const float pf = inf_, pbk = inb;
#pragma unroll
        for (int o = 1; o < 64; o <<= 1) { const float t1 = __shfl_up(inf_, o), t2 = __shfl_up(inb, o); if (c.lane >= o) { inf_ += t1; inb += t2; } }
        const float totf = __shfl(inf_, 63), totb = __shfl(inb, 63);
        const float exf = inf_ - pf, exb = inb - pbk;
        const float cf0 = exf + laf0, cf1 = inf_, pb0 = exb, pb1 = exb + lab0;
        f32x4* sca = (f32x4*)(a.ws + WS_SCA) + (size_t)r0 * 32 + h; f32x4* scb = (f32x4*)(a.ws + WS_SCB) + (size_t)r0 * 32 + h;
        { const float L2E = 1.4426950408889634f;
          sca[0] = (f32x4){cf0 * L2E, pb0 * L2E, cf0 * L2E - __log2f(dtf0), pb0 * L2E + __log2f(dtb0)}; sca[32] = (f32x4){cf1 * L2E, pb1 * L2E, cf1 * L2E - __log2f(dtf1), pb1 * L2E + __log2f(dtb1)}; }
        scb[0] = (f32x4){__expf(cf0), __expf(totb - pb0), dtf0 * __expf(totf - cf0), dtb0 * __expf(pb0)};
        scb[32] = (f32x4){__expf(cf1), __expf(totb - pb1), dtf1 * __expf(totf - cf1), dtb1 * __expf(pb1)};
        if (c.lane == 0) ((f32x2*)(a.ws + WS_DEC))[ci * 32 + h] = (f32x2){__expf(totf), __expf(totb)}; }
}

__device__ __forceinline__ void ph_scan(const Args& a, const Ctx& c) {
    constexpr int P = 272, BUF = 53248;
    LAS unsigned char* stg = c.lds + 2 * BUF + c.wave * 2048;
    const int r32 = c.lane & 31, hi = c.lane >> 5, pt = c.wave >> 2, nt = c.wave & 3;
    for (int task = c.vcu; task < 256; task += c.G) { const int b = task >> 6, dir = (task >> 5) & 1, h = task & 31, g = h >> 3;
        f32x16 acc = {};
        u32x4 xrA[2], brA[4], xrB[2], brB[4]; f32x4 wregA = {}, wregB = {}; f32x2 decA = {}, decB = {};
#define SCAN_CI(k) (dir == 0 ? ((k) < 2 ? 128 + 2 * b + (k) : 32 * b + ((k) - 2)) : ((k) < 2 ? 128 + 2 * b + 1 - (k) : 32 * b + 31 - ((k) - 2)))
#define SCAN_LOAD(k, xr, br, wreg, dcr) do { const int ci_ = SCAN_CI(k); const bf16* xs_ = (const bf16*)(a.ws + WS_XT) + ((size_t)ci_ * 2048 + 64 * h) * 128; const bf16* bs_ = (const bf16*)(a.ws + WS_BT) + ((size_t)ci_ * 512 + 128 * g) * 128; \
        _Pragma("unroll") for (int q = 0; q < 2; ++q) xr[q] = ((const u32x4*)xs_)[c.tid + 512 * q]; _Pragma("unroll") for (int q = 0; q < 4; ++q) br[q] = ((const u32x4*)bs_)[c.tid + 512 * q]; \
        wreg = ((const f32x4*)(a.ws + WS_SCB))[((size_t)ci_ * 128 + (c.tid & 127)) * 32 + h]; dcr = ((const f32x2*)(a.ws + WS_DEC))[ci_ * 32 + h]; } while (0)
#define SCAN_WRITE(bi, xr, br, wreg) do { LAS unsigned char* xb_ = c.lds + (bi) * BUF; LAS unsigned char* bb_ = xb_ + 17408; \
        _Pragma("unroll") for (int q = 0; q < 2; ++q) { const int p = c.tid + 512 * q; *(LAS u32x4*)(xb_ + (p >> 4) * P + (p & 15) * 16) = xr[q]; } \
        _Pragma("unroll") for (int q = 0; q < 4; ++q) { const int p = c.tid + 512 * q; *(LAS u32x4*)(bb_ + (p >> 4) * P + (p & 15) * 16) = br[q]; } \
        if (c.tid < 128) ((LAS float*)(xb_ + 52224))[c.tid] = dir == 0 ? wreg.z : wreg.w; } while (0)
#define SCAN_STEP(k, cur, dcr) do { const int ci = SCAN_CI(k); \
            { bf16* hin = (bf16*)(a.ws + WS_HIN) + (((size_t)ci * 2 + dir) * 32 + h) * 8192; \
              _Pragma("unroll") for (int r = 0; r < 16; ++r) *(LAS bf16*)(stg + ((r & 3) + 8 * (r >> 2) + 4 * hi) * 64 + r32 * 2) = (bf16)(cvtpk(acc[r], 0.f) & 0xffffu); \
              LDS_WAIT(); \
              _Pragma("unroll") for (int i = 0; i < 2; ++i) { const int row = (c.lane >> 2) + 16 * i, pc = c.lane & 3; *(u32x4*)(hin + (size_t)(32 * pt + row) * 128 + 32 * nt + pc * 8) = *(const LAS u32x4*)(stg + row * 64 + pc * 16); } } \
            const float dec = dir == 0 ? dcr.x : dcr.y; \
            _Pragma("unroll") for (int r = 0; r < 16; ++r) acc[r] *= dec; \
            { LAS unsigned char* xb = c.lds + (cur) * BUF; LAS unsigned char* bb = xb + 17408; const LAS float* wv = (const LAS float*)(xb + 52224); \
              _Pragma("unroll") for (int kk = 0; kk < 8; ++kk) { const int s8 = 16 * kk + 8 * hi; \
                  const u32x4 xa = *(const LAS u32x4*)(xb + (32 * pt + r32) * P + s8 * 2); const f32x4 wa = *(const LAS f32x4*)(wv + s8), wb = *(const LAS f32x4*)(wv + s8 + 4); \
                  const u32x4 xs = (u32x4){cvtpk(bflo(xa.x) * wa.x, bfhi(xa.x) * wa.y), cvtpk(bflo(xa.y) * wa.z, bfhi(xa.y) * wa.w), cvtpk(bflo(xa.z) * wb.x, bfhi(xa.z) * wb.y), cvtpk(bflo(xa.w) * wb.z, bfhi(xa.w) * wb.w)}; \
                  const bf16x8 bfrag = *(const LAS bf16x8*)(bb + (32 * nt + r32) * P + s8 * 2); \
                  acc = __builtin_amdgcn_mfma_f32_32x32x16_bf16(__builtin_bit_cast(bf16x8, xs), bfrag, acc, 0, 0, 0); } } } while (0)
        f32x2 dcur0, dcur1;
        SCAN_LOAD(0, xrA, brA, wregA, decA); SCAN_LOAD(1, xrB, brB, wregB, decB); SCAN_WRITE(0, xrA, brA, wregA); dcur0 = decA;
        __syncthreads();
        for (int k = 0; k < 34; k += 2) {
            if (k + 2 < 34) SCAN_LOAD(k + 2, xrA, brA, wregA, decA);
            SCAN_STEP(k, 0, dcur0);
            SCAN_WRITE(1, xrB, brB, wregB); dcur1 = decB;
            __syncthreads();
            if (k + 3 < 34) SCAN_LOAD(k + 3, xrB, brB, wregB, decB);
            SCAN_STEP(k + 1, 1, dcur1);
            if (k + 2 < 34) { SCAN_WRITE(0, xrA, brA, wregA); dcur0 = decA; }
            __syncthreads();
        }
#undef SCAN_CI
#undef SCAN_LOAD
#undef SCAN_WRITE
#undef SCAN_STEP
    }
}

__device__ __forceinline__ int crow16(int r, int hi) { return (r & 3) + 8 * (r >> 2) + 4 * hi; }
__device__ __forceinline__ void ph_yph(const Args& a, const Ctx& c) {
    constexpr int P = 272, ZP = 144;
    LAS unsigned char* Cs = c.lds; LAS unsigned char* Bs = c.lds + 34816; LAS unsigned char* xs = c.lds + 69632; LAS unsigned char* hf = c.lds + 87040; LAS unsigned char* hb = c.lds + 104448;
    LAS unsigned char* zs = c.lds + 121856; LAS unsigned char* os = c.lds + 140288; LAS f32x4* sca = (LAS f32x4*)(c.lds + 158720); LAS f32x2* scb = (LAS f32x2*)(c.lds + 160768);
    LAS float* sbv = (LAS float*)(c.lds + 161792); LAS float* scv = (LAS float*)(c.lds + 162304); LAS float* ssql = (LAS float*)(c.lds + 34816);
    const int lb = c.wave & 3, pb = c.wave >> 2;
    SECT_DECL
    for (int task = c.vcu; task < NCH * 4; task += c.G) { const int ci = task >> 2, g = task & 3, r0 = ci * 128;
        int tid_t = c.tid; asm volatile("" : "+v"(tid_t));
        f32x16 X[4]; int l0;
        u32x4 pxt[2], phf[2], phb[2], pz[2]; f32x4 ps1 = {}; f32x4 ps4 = {};
#define YPH_PREFETCH(hq) do { const int h_ = 8 * g + (hq); const u32x4* xt_ = (const u32x4*)((const bf16*)(a.ws + WS_XT) + ((size_t)ci * 2048 + 64 * h_) * 128); \
            const u32x4* hfg_ = (const u32x4*)((const bf16*)(a.ws + WS_HIN) + (((size_t)ci * 2 + 0) * 32 + h_) * 8192); const u32x4* hbg_ = (const u32x4*)((const bf16*)(a.ws + WS_HIN) + (((size_t)ci * 2 + 1) * 32 + h_) * 8192); \
            const bf16* zg_ = (const bf16*)(a.ws + WS_Z) + (size_t)r0 * 2048 + 64 * h_; \
            _Pragma("unroll") for (int q = 0; q < 2; ++q) { const int p = tidp + 512 * q; pxt[q] = xt_[p]; phf[q] = hfg_[p]; phb[q] = hbg_[p]; pz[q] = *(const u32x4*)(zg_ + (size_t)(p >> 3) * 2048 + (p & 7) * 8); } \
            ps1 = ((const f32x4*)(a.ws + WS_SCA))[((size_t)r0 + (tidp & 127)) * 32 + h_]; ps4 = ((const f32x4*)(a.ws + WS_SCB))[((size_t)r0 + (tidp & 127)) * 32 + h_]; } while (0)
        { const int tid = tid_t, lane = tid & 63, r32 = lane & 31, hi = lane >> 5; l0 = 32 * lb + r32;
          { const bf16* cn = (const bf16*)(a.ws + WS_CN) + (size_t)r0 * 512 + 128 * g; const bf16* bn = (const bf16*)(a.ws + WS_BN) + (size_t)r0 * 512 + 128 * g;
#pragma unroll
            for (int q = 0; q < 4; ++q) { const int p = tid + 512 * q, row = p >> 4, pc = p & 15;
                *(LAS u32x4*)(Cs + row * P + pc * 16) = *(const u32x4*)(cn + (size_t)row * 512 + pc * 8); *(LAS u32x4*)(Bs + row * P + pc * 16) = *(const u32x4*)(bn + (size_t)row * 512 + pc * 8); } }
          { const int tidp = tid; YPH_PREFETCH(0); }
          __syncthreads();
#pragma unroll
          for (int sb = 0; sb < 4; ++sb) { X[sb] = (f32x16){};
#pragma unroll
              for (int kk = 0; kk < 8; ++kk) { const int k8 = (16 * kk + 8 * hi) * 2;
                  X[sb] = __builtin_amdgcn_mfma_f32_32x32x16_bf16(*(const LAS bf16x8*)(Bs + (32 * sb + r32) * P + k8), *(const LAS bf16x8*)(Cs + (32 * lb + r32) * P + k8), X[sb], 0, 0, 0); } }
        }
        SECT(0);
        float ssq = 0.f;
#pragma unroll 1
        for (int hh = 0; hh < 8; ++hh) { const int h = 8 * g + hh;
            int tid = c.tid; asm volatile("" : "+v"(tid)); const int lane = tid & 63, r32 = lane & 31, hi = lane >> 5, l = 32 * lb + r32; (void)lane;
            const float dsum = a.in[I_DSK][h] + a.in[I_DSK][32 + h];
            __syncthreads();
            SECT(1);
            if (hh > 0) { bf16* gg = (bf16*)(a.ws + WS_G) + (size_t)r0 * 2048 + 64 * (h - 1);
#pragma unroll
                for (int q = 0; q < 2; ++q) { const int p = tid + 512 * q, zr = p >> 3, zc = p & 7; *(u32x4*)(gg + (size_t)zr * 2048 + zc * 8) = *(const LAS u32x4*)(os + zr * ZP + zc * 16); } }
#pragma unroll
            for (int q = 0; q < 2; ++q) { const int p = tid + 512 * q, row = p >> 4, pc = p & 15;
                *(LAS u32x4*)(xs + row * P + pc * 16) = pxt[q]; *(LAS u32x4*)(hf + row * P + pc * 16) = phf[q]; *(LAS u32x4*)(hb + row * P + pc * 16) = phb[q];
                *(LAS u32x4*)(zs + (p >> 3) * ZP + (p & 7) * 16) = pz[q]; }
            if (tid < 128) { sca[tid] = ps1; scb[tid] = (f32x2){ps4.x, ps4.y}; sbv[tid] = ps1.z; scv[tid] = ps1.w; }
            __syncthreads();
            SECT(2);
            if (hh < 7) { const int tidp = tid; YPH_PREFETCH(hh + 1); }
            SECT(3);
            const f32x4 me = sca[l]; const f32x2 ee = scb[l];
            const float dtb_l = __builtin_amdgcn_exp2f(me.w - me.y);
            f32x16 accd = {};
#pragma unroll
            for (int sb = 0; sb < 4; ++sb) { unsigned mp[8];
#pragma unroll
                for (int q = 0; q < 4; ++q) { const int s0 = 32 * sb + 8 * q + 4 * hi; float mv[4];
                    if (sb < lb) { const f32x4 bs4 = *(const LAS f32x4*)(sbv + s0);
#pragma unroll
                        for (int e = 0; e < 4; ++e) mv[e] = X[sb][4 * q + e] * __builtin_amdgcn_exp2f(me.x - bs4[e]); }
                    else if (sb > lb) { const f32x4 cs4 = *(const LAS f32x4*)(scv + s0);
#pragma unroll
                        for (int e = 0; e < 4; ++e) mv[e] = X[sb][4 * q + e] * __builtin_amdgcn_exp2f(cs4[e] - me.y); }
                    else { const f32x4 bs4 = *(const LAS f32x4*)(sbv + s0), cs4 = *(const LAS f32x4*)(scv + s0);
#pragma unroll
                        for (int e = 0; e < 4; ++e) { const int s = s0 + e; const float t = (s <= l) ? (me.x - bs4[e]) : (cs4[e] - me.y); const float xv = X[sb][4 * q + e];
                            float m = xv * __builtin_amdgcn_exp2f(t); if (s == l) m += xv * dtb_l + dsum; mv[e] = m; } }
                    mp[2 * q] = cvtpk(mv[0], mv[1]); mp[2 * q + 1] = cvtpk(mv[2], mv[3]); }
#pragma unroll
                for (int t = 0; t < 2; ++t) { const int sof = (32 * sb + 16 * t + 4 * hi) * 2;
                    const u32x2 lo = *(const LAS u32x2*)(xs + (32 * pb + r32) * P + sof), h2 = *(const LAS u32x2*)(xs + (32 * pb + r32) * P + sof + 16);
                    const u32x4 af = (u32x4){lo.x, lo.y, h2.x, h2.y}, bfm = (u32x4){mp[4 * t], mp[4 * t + 1], mp[4 * t + 2], mp[4 * t + 3]};
                    accd = __builtin_amdgcn_mfma_f32_32x32x16_bf16(__builtin_bit_cast(bf16x8, af), __builtin_bit_cast(bf16x8, bfm), accd, 0, 0, 0); }
                }
            SECT(4);
#pragma unroll
            for (int dd = 0; dd < 2; ++dd) { f32x16 acco = {}; LAS unsigned char* hx = dd == 0 ? hf : hb;
#pragma unroll
                for (int kk = 0; kk < 8; ++kk) { const int k8 = (16 * kk + 8 * hi) * 2;
                    acco = __builtin_amdgcn_mfma_f32_32x32x16_bf16(*(const LAS bf16x8*)(hx + (32 * pb + r32) * P + k8), *(const LAS bf16x8*)(Cs + (32 * lb + r32) * P + k8), acco, 0, 0, 0); }
                const float ex = dd == 0 ? ee.x : ee.y;
#pragma unroll
                for (int r = 0; r < 16; ++r) accd[r] += ex * acco[r]; }
            SECT(5);
#pragma unroll
            for (int q = 0; q < 4; ++q) { const int pcol = 32 * pb + 8 * q + 4 * hi; const u32x2 zq = *(const LAS u32x2*)(zs + l * ZP + pcol * 2);
                float gv[4];
#pragma unroll
                for (int e = 0; e < 4; ++e) { const int r = 4 * q + e; const float y = accd[r];
                    const float z = (e == 0) ? bflo(zq.x) : (e == 1) ? bfhi(zq.x) : (e == 2) ? bflo(zq.y) : bfhi(zq.y); gv[e] = y * silu_f(z); ssq += gv[e] * gv[e]; }
                *(LAS u32x2*)(os + l * ZP + pcol * 2) = (u32x2){cvtpk(gv[0], gv[1]), cvtpk(gv[2], gv[3])}; }
            SECT(6);
        }
#undef YPH_PREFETCH
        __syncthreads();
        { bf16* gg = (bf16*)(a.ws + WS_G) + (size_t)r0 * 2048 + 64 * (8 * g + 7);
#pragma unroll
          for (int q = 0; q < 2; ++q) { const int p = c.tid + 512 * q, zr = p >> 3, zc = p & 7; *(u32x4*)(gg + (size_t)zr * 2048 + zc * 8) = *(const LAS u32x4*)(os + zr * ZP + zc * 16); } }
        ssq += __shfl_xor(ssq, 32);
        if ((c.lane >> 5) == 0) ssql[pb * 128 + l0] = ssq;
        __syncthreads();
        if (c.tid < 128) ssql[256 + c.tid] = rsqrtf((ssql[c.tid] + ssql[128 + c.tid]) * (1.0f / 512.0f) + EPS);
        VM_WAIT();
        __syncthreads();
        { bf16* gt = (bf16*)(a.ws + WS_G) + (size_t)r0 * 2048 + 512 * g; const float* ng = a.in[I_SNORM] + 512 * g;
          const f32x4 g0 = *(const f32x4*)(ng + (c.tid & 63) * 8), g1 = *(const f32x4*)(ng + (c.tid & 63) * 8 + 4);
#pragma unroll 1
          for (int qb = 0; qb < 2; ++qb) { u32x4 gv8[8]; int tidq = c.tid + 4096 * qb; asm volatile("" : "+v"(tidq));
#pragma unroll
            for (int q = 0; q < 8; ++q) { const int p = tidq + 512 * q; gv8[q] = *(const u32x4*)(gt + (size_t)(p >> 6) * 2048 + (p & 63) * 8); }
#pragma unroll
            for (int q = 0; q < 8; ++q) { const int p = tidq + 512 * q, row = p >> 6, col = (p & 63) * 8; const u32x4 v = gv8[q]; const float sr = ssql[256 + row];
              *(u32x4*)(gt + (size_t)row * 2048 + col) = (u32x4){cvtpk(bflo(v.x) * sr * g0.x, bfhi(v.x) * sr * g0.y), cvtpk(bflo(v.y) * sr * g0.z, bfhi(v.y) * sr * g0.w), cvtpk(bflo(v.z) * sr * g1.x, bfhi(v.z) * sr * g1.y), cvtpk(bflo(v.w) * sr * g1.z, bfhi(v.w) * sr * g1.w)}; } } }
        __syncthreads();
        SECT(7);
    }
    SECT_END(40);
}
__device__ __forceinline__ void ph_gfix(const Args& a, const Ctx& c) {
    const float* ng = a.in[I_SNORM]; const float* rs = (const float*)(a.ws + WS_RSTD);
    const int n16 = TT * 256;
    for (int p = blockIdx.x * NTHREADS + c.tid; p < n16; p += c.G * NTHREADS) { const int r = p >> 8, col = (p & 255) * 8;
        u32x4* gp = (u32x4*)((bf16*)(a.ws + WS_G) + (size_t)r * 2048 + col); const u32x4 v = *gp; const float s = rs[r * 4 + (col >> 9)];
        const f32x4 g0 = *(const f32x4*)(ng + col), g1 = *(const f32x4*)(ng + col + 4);
        *gp = (u32x4){cvtpk(bflo(v.x) * s * g0.x, bfhi(v.x) * s * g0.y), cvtpk(bflo(v.y) * s * g0.z, bfhi(v.y) * s * g0.w), cvtpk(bflo(v.z) * s * g1.x, bfhi(v.z) * s * g1.y), cvtpk(bflo(v.w) * s * g1.z, bfhi(v.w) * s * g1.w)}; }
}

#if DEBUG_CHECKS
__device__ __forceinline__ float dbg_hb(const Args& a, int layer, size_t idx, float sh) {
    if (ATT_FP8 && layer != 2) return __builtin_amdgcn_cvt_f32_fp8((unsigned)((const unsigned char*)(a.ws + WS_HB))[idx], 0) * sh;
    return bf2f(((const bf16*)(a.ws + WS_HB))[idx]); }
__device__ __forceinline__ int dbg_sample_row(int b) { const int SR[16] = {0, 1, 77, 4095, 4096, 5000, 8191, 9000, 12288, 16383, 16384, 16385, 16384 + 255, 16384 + 256, 17000, 17407}; int r = 0;
#pragma unroll
    for (int i = 0; i < 16; ++i) r = (b == i) ? SR[i] : r;
    return r; }
__device__ __forceinline__ float blk_sum(float v, LAS float* red, int tid) {
    v = wave_sum(v); __syncthreads(); if ((tid & 63) == 0) red[tid >> 6] = v; __syncthreads(); float s = 0.f;
#pragma unroll
    for (int i = 0; i < 8; ++i) s += red[i];
    __syncthreads(); return s; }
__device__ __forceinline__ float blk_max(float v, LAS float* red, int tid) {
#pragma unroll
    for (int o = 1; o < 64; o <<= 1) v = fmaxf(v, __shfl_xor(v, o));
    __syncthreads(); if ((tid & 63) == 0) red[tid >> 6] = v; __syncthreads(); float s = red[0];
#pragma unroll
    for (int i = 1; i < 8; ++i) s = fmaxf(s, red[i]);
    __syncthreads(); return s; }
__device__ __forceinline__ void dbg_report(const Args& a, int id, float err, float ssref, float n, int tid) {
    if (tid == 0) { float rel = err / (sqrtf(ssref / n) + 1e-20f); if (!(rel == rel)) rel = 1e30f; atomicMax((unsigned*)(a.ws + WS_CTL) + CW_DBG + id, __float_as_uint(rel)); } }
__device__ __forceinline__ float dbg_mod(const Args& a, int layer, int r, int j) {
    const float* cv = r < TL ? a.in[I_C] + (r / SEQ) * 1024 : a.in[I_CCTX]; float s = 0.f;
    _Pragma("nounroll") for (int k = 0; k < 1024; ++k) { const float x = cv[k]; s += (x / (1.0f + expf(-x))) * a.in[I_WADA][((size_t)layer * 1024 + k) * 6144 + j]; }
    return s + a.in[I_BADA][layer * 6144 + j]; }

__device__ __forceinline__ void chk_rmix(const Args& a, int layer, int id, LAS unsigned char* ldsb) {
    if (blockIdx.x >= 16) return; const int tid = tid_opaque(), r = dbg_sample_row(blockIdx.x);
    LAS float* red = (LAS float*)ldsb;
    const float* x = resid_row(a, layer, r); const bf16* hb = (const bf16*)(a.ws + WS_HB) + (size_t)r * D;
    float ss = 0.f; for (int cc = tid; cc < D; cc += 512) ss += x[cc] * x[cc];
    ss = blk_sum(ss, red, tid); const float rstd = rsqrtf(ss / D + EPS);
    float err = 0.f, sr = 0.f;
    for (int cc = tid; cc < D; cc += 512) { const float sh = dbg_mod(a, layer, r, cc), sc = dbg_mod(a, layer, r, D + cc);
        const float ref = x[cc] * rstd * a.in[I_NMIX][layer * D + cc] * (1.f + sc) + sh; err = fmaxf(err, fabsf(ref - dbg_hb(a, layer, (size_t)r * D + cc, 1.f))); sr += ref * ref; }
    err = blk_max(err, red, tid); sr = blk_sum(sr, red, tid); dbg_report(a, id, err, sr, D, tid);
}
__device__ __forceinline__ void chk_qkv(const Args& a, int layer, int id, LAS unsigned char* ldsb) {
    if (blockIdx.x >= 16) return; const int tid = tid_opaque(), r = dbg_sample_row(blockIdx.x), j = layer ? 1 : 0;
    LAS float* red = (LAS float*)ldsb; LAS float* y = red + 16; LAS float* hrow = y + 1536;
    const bf16* hb = (const bf16*)(a.ws + WS_HB) + (size_t)r * D;
    _Pragma("nounroll") for (int k = tid; k < D; k += 512) hrow[k] = dbg_hb(a, layer, (size_t)r * D + k, 1.f);
    __syncthreads();
    for (int n = tid; n < 1536; n += 512) { float s = 0.f; const float* w = a.in[I_WQKV] + (size_t)j * 1024 * 1536 + n; _Pragma("nounroll") for (int k = 0; k < 1024; ++k) s += hrow[k] * w[(size_t)k * 1536]; y[n] = s; }
    __syncthreads();
    float err = 0.f, sr = 0.f;
    for (int n = tid; n < 1536; n += 512) { float ref;
        if (n < 1280) { const int h0 = n & ~63; float ss = 0.f; _Pragma("nounroll") for (int q = 0; q < 64; ++q) ss += y[h0 + q] * y[h0 + q];
            const float rstd = rsqrtf(ss / 64.f + EPS); const float* g = (n < 1024 ? a.in[I_QG] : a.in[I_KG]) + j * 64;
            float v = y[n] * rstd * g[n & 63], vp = y[n ^ 1] * rstd * g[(n ^ 1) & 63];
            if (r < TL) { const int t = r % SEQ, i = (n & 63) >> 1, f = i & 15, pos = i < 16 ? t / 64 : t % 64; const float inv = powf(10000.f, -(float)f / 16.f), ang = (float)pos * inv, cs = cosf(ang), sn = sinf(ang);
                v = (n & 1) ? (vp * sn + v * cs) : (v * cs - vp * sn); }
            if (n < 1024) v *= 0.125f * 1.4426950408889634f;
            ref = v; } else ref = y[n];
        float got;
        if (n < 1024) { if (layer == 3 && r >= TL) continue; got = bf2f(((const bf16*)(a.ws + WS_Q))[(size_t)r * 1024 + n]); }
        else if (n < 1280) got = bf2f(((const bf16*)(a.ws + WS_K))[kv_row(r) * 256 + (n - 1024)]);
        else got = bf2f(((const bf16*)(a.ws + WS_V))[kv_row(r) * 256 + (n - 1280)]);
        err = fmaxf(err, fabsf(ref - got)); sr += ref * ref; }
    err = blk_max(err, red, tid); sr = blk_sum(sr, red, tid); dbg_report(a, id, err, sr, 1536, tid);
}
__device__ __forceinline__ void chk_att(const Args& a, int layer, int id, LAS unsigned char* ldsb) {
    if (blockIdx.x >= 16) return; const int tid = tid_opaque(), r = dbg_sample_row(blockIdx.x);
    if (layer == 3 && r >= TL) return;
    LAS float* red = (LAS float*)ldsb; LAS float* sc = red + 16; LAS float* po = sc + 4352;
    const int nk = r < TL ? KVROWS : CTXL; const long kv0 = (long)(r < TL ? r / SEQ : (r - TL) / CTXL) * KVROWS;
    const bf16* Qb = (const bf16*)(a.ws + WS_Q); const bf16* Kb = (const bf16*)(a.ws + WS_K); const bf16* Vb = (const bf16*)(a.ws + WS_V); const bf16* Ob = (const bf16*)(a.ws + WS_HB);
    float err = 0.f, sr = 0.f;
    for (int h = 0; h < 16; ++h) {
        float mx = -3e38f;
        _Pragma("nounroll") for (int jk = tid; jk < nk; jk += 512) { float s = 0.f; _Pragma("nounroll") for (int d = 0; d < 64; ++d) s += bf2f(Qb[(size_t)r * 1024 + h * 64 + d]) * bf2f(Kb[(kv0 + jk) * 256 + (h >> 2) * 64 + d]); sc[jk] = s; mx = fmaxf(mx, s); }
        mx = blk_max(mx, red, tid);
        float l = 0.f; _Pragma("nounroll") for (int jk = tid; jk < nk; jk += 512) { const float p = exp2f(sc[jk] - mx); sc[jk] = p; l += p; }
        l = blk_sum(l, red, tid);
        { const int d = tid & 63, part = tid >> 6; float o = 0.f; _Pragma("nounroll") for (int jk = part; jk < nk; jk += 8) o += sc[jk] * bf2f(Vb[(kv0 + jk) * 256 + (h >> 2) * 64 + d]); po[part * 64 + d] = o; }
        __syncthreads();
        if (tid < 64) { float o = 0.f; _Pragma("nounroll") for (int p = 0; p < 8; ++p) o += po[p * 64 + tid]; o /= l; err = fmaxf(err, fabsf(o - dbg_hb(a, layer, (size_t)r * 1024 + h * 64 + tid, 1.f / (float)(1 << ATT_OSH)))); sr += o * o; }
        __syncthreads();
    }
    err = blk_max(err, red, tid); sr = blk_sum(sr, red, tid); dbg_report(a, id, err, sr, 1024, tid);
}
__device__ __forceinline__ void chk_oproj(const Args& a, int layer, int id, LAS unsigned char* ldsb) {
    if (blockIdx.x >= 16 || layer != 0) return; const int tid = tid_opaque(), r = dbg_sample_row(blockIdx.x), j = 0;
    LAS float* red = (LAS float*)ldsb; LAS float* orow = red + 16;
    const bf16* Ob = (const bf16*)(a.ws + WS_HB) + (size_t)r * D;
    _Pragma("nounroll") for (int k = tid; k < D; k += 512) orow[k] = dbg_hb(a, layer, (size_t)r * D + k, 1.f / (float)(1 << ATT_OSH));
    __syncthreads();
    float err = 0.f, sr = 0.f;
    for (int n = tid; n < D; n += 512) { float s = 0.f; const float* w = a.in[I_WO] + (size_t)j * 1024 * 1024 + n; _Pragma("nounroll") for (int k = 0; k < 1024; ++k) s += orow[k] * w[(size_t)k * 1024];
        const float dl = dbg_mod(a, layer, r, 2 * D + n) * s, ref = resid_row(a, 0, r)[n] + dl; err = fmaxf(err, fabsf(ref - ((const float*)(a.ws + WS_X))[(size_t)r * D + n])); sr += dl * dl; }
    err = blk_max(err, red, tid); sr = blk_sum(sr, red, tid); dbg_report(a, id, err, sr, D, tid);
}
__device__ __forceinline__ void chk_moe(const Args& a, int layer, int id_tok, int id_y, LAS unsigned char* ldsb) {
    if (blockIdx.x >= 16) return; const int tid = tid_opaque(), r = dbg_sample_row(blockIdx.x);
    if (layer == 3 && r >= TL) return;
    LAS float* red = (LAS float*)ldsb; LAS float* tok = red + 16; LAS float* lg = tok + 1024; LAS float* tkb = lg + 64; LAS float* act = tkb + 1024; LAS float* rt = act + 1024;
    const float* x = (const float*)(a.ws + WS_X) + (size_t)r * D; const bf16* tk = (const bf16*)(a.ws + WS_TK) + (size_t)r * D;
    float ss = 0.f; for (int cc = tid; cc < D; cc += 512) ss += x[cc] * x[cc];
    ss = blk_sum(ss, red, tid); const float rstd = rsqrtf(ss / D + EPS);
    float err = 0.f, sr = 0.f;
    for (int cc = tid; cc < D; cc += 512) { const float sh = dbg_mod(a, layer, r, 3 * D + cc), sc = dbg_mod(a, layer, r, 4 * D + cc);
        const float ref = x[cc] * rstd * a.in[I_NFFN][layer * D + cc] * (1.f + sc) + sh; tok[cc] = ref;
#if MOE_FP8
        tkb[cc] = __builtin_amdgcn_cvt_f32_fp8((unsigned)((const unsigned char*)(a.ws + WS_TK))[(size_t)r * D + cc], 0);
#else
        tkb[cc] = bf2f(tk[cc]);
#endif
        err = fmaxf(err, fabsf(ref - tkb[cc])); sr += ref * ref; }
    err = blk_max(err, red, tid); sr = blk_sum(sr, red, tid);
    if (tid < 36) { float s = 0.f; _Pragma("nounroll") for (int k = 0; k < 1024; ++k) s += tok[k] * (tid < 4 ? a.in[I_WRG][((size_t)layer * 1024 + k) * 4 + tid] : a.in[I_WRE][((size_t)layer * 1024 + k) * 32 + tid - 4]); lg[tid] = s; }
    __syncthreads();
    if (tid == 0) { int grp = 0; _Pragma("nounroll") for (int q = 1; q < 4; ++q) if (lg[q] > lg[grp]) grp = q; float den = 0.f; _Pragma("nounroll") for (int q = 0; q < 4; ++q) den += expf(lg[q] - lg[grp]);
        const LAS float* le = lg + 4 + grp * 8; int i0 = 0; _Pragma("nounroll") for (int q = 1; q < 8; ++q) if (le[q] > le[i0]) i0 = q; int i1 = -1; _Pragma("nounroll") for (int q = 0; q < 8; ++q) if (q != i0 && (i1 < 0 || le[q] > le[i1])) i1 = q;
        const float ex = expf(le[i1] - le[i0]), w0 = 1.f / den / (1.f + ex), w1 = 1.f / den * ex / (1.f + ex);
        rt[0] = (float)(grp * 8 + i0); rt[1] = (float)(grp * 8 + i1); rt[2] = w0; rt[3] = w1;
        const float* w2 = (const float*)(a.ws + WS_W2); float e2 = fmaxf(fabsf(w2[2 * r] - w0), fabsf(w2[2 * r + 1] - w1)) * 30.f;
        const int* list = (const int*)(a.ws + WS_LIST); const unsigned* gc = (const unsigned*)(a.ws + WS_CTL) + CW_CNT + layer * 32;
        _Pragma("nounroll") for (int k = 0; k < 2; ++k) { const int e = (int)rt[k]; bool found = false; const int n = (int)gc[e]; _Pragma("nounroll") for (int q = 0; q < n && q < MOE_CAP; ++q) if (list[e * MOE_CAP + q] == 2 * r + k) found = true; if (!found) e2 = 1e6f; }
        rt[4] = e2; }
    __syncthreads();
    err = fmaxf(err, rt[4] * sqrtf(sr / D));
    dbg_report(a, id_tok, err, sr, D, tid);
    float err2 = 0.f, sr2 = 0.f;
    _Pragma("nounroll") for (int k = 0; k < 2; ++k) { const int e = (int)rt[k]; const float wk = rt[2 + k];
        const float* wgu = a.in[I_WGU] + ((size_t)layer * 32 + e) * 1024 * 1024; const float* wdn = a.in[I_WDN] + ((size_t)layer * 32 + e) * 512 * 1024;
        { float sg = 0.f, su = 0.f; _Pragma("nounroll") for (int q = 0; q < 1024; ++q) { sg += tkb[q] * wgu[(size_t)q * 1024 + tid]; su += tkb[q] * wgu[(size_t)q * 1024 + 512 + tid]; } act[tid] = (sg / (1.f + expf(-sg))) * su; }
        __syncthreads();
        for (int n = tid; n < D; n += 512) { float s = 0.f; _Pragma("nounroll") for (int q = 0; q < 512; ++q) s += act[q] * wdn[(size_t)q * 1024 + n]; s *= wk;
            err2 = fmaxf(err2, fabsf(s - bf2f(((const bf16*)(a.ws + WS_Y2))[(size_t)(2 * r + k) * D + n]))); sr2 += s * s; }
        __syncthreads(); }
    err2 = blk_max(err2, red, tid); sr2 = blk_sum(sr2, red, tid); dbg_report(a, id_y, err2, sr2, 2 * D, tid);
}

__global__ void __launch_bounds__(NTHREADS) dbg_kernel(Args a, int ty, int layer, int id) {
    extern __shared__ __attribute__((aligned(16))) unsigned char lds_dbg[];
    LAS unsigned char* l = (LAS unsigned char*)lds_dbg;
    if (ty == 1) chk_rmix(a, layer, id, l); else if (ty == 2) chk_qkv(a, layer, id, l); else if (ty == 3) chk_att(a, layer, id, l);
    else if (ty == 4) chk_oproj(a, layer, id, l); else if (ty == 5) chk_moe(a, layer, id, id + 1, l);
}
#endif

template <int KIND, int LAYER> __device__ __forceinline__ void run_phase(const Args& a0, Ctx& c, unsigned char* lds_gen) {
    Args a = a0; { unsigned long long wsv = (unsigned long long)a0.ws; asm volatile("" : "+s"(wsv)); a.ws = (unsigned char*)(GAS unsigned char*)wsv; }
    { unsigned lb = (unsigned)(uintptr_t)(LAS unsigned char*)lds_gen; asm volatile("" : "+s"(lb)); c.lds = (LAS unsigned char*)(uintptr_t)lb; }
    c.tid = tid_opaque(); c.lane = c.tid & 63;
    unsigned char* const ws = a.ws; constexpr int layer = LAYER;
#define RELAUNDER() do { { unsigned long long wsv_ = (unsigned long long)a0.ws; asm volatile("" : "+s"(wsv_)); a.ws = (unsigned char*)(GAS unsigned char*)wsv_; } \
        { unsigned lb_ = (unsigned)(uintptr_t)(LAS unsigned char*)lds_gen; asm volatile("" : "+s"(lb_)); c.lds = (LAS unsigned char*)(uintptr_t)lb_; } c.tid = tid_opaque(); c.lane = c.tid & 63; } while (0)
    if constexpr (KIND == K_P0) p0_prologue(a, c);
    else if constexpr (KIND == K_RMIX) ph_rmix(a, c, layer);
    else if constexpr (KIND == K_QKV) { constexpr int j = layer ? 1 : 0;
#if ATT_FP8
        SchedQKV S{(const char*)(ws + WS_HB), (const char*)(ws + WS_WQKV) + (size_t)j * 1536 * 1024, (size_t)256 * 1024, layer == 0 ? 1 : 0, c.G, (int)blockIdx.x};
        EpiQKV E{(bf16*)(ws + WS_Q), (bf16*)(ws + WS_K), (bf16*)(ws + WS_V), a.in[I_QG] + j * 64, a.in[I_KG] + j * 64, (const f32x2*)(ws + WS_ROPE)};
        pg8::gemm_phase<EpiQKV, SchedQKV, false, true>(c.lds, 1024, 1024, S, E, 127 - MOE_WSH, 127); }
#else
        SchedQKV S{(const char*)(ws + WS_HB), (const char*)(ws + WS_WQKV) + (size_t)j * 1536 * 1024 * 2, (size_t)256 * 1024 * 2, layer == 0 ? 1 : 0, c.G, (int)blockIdx.x};
        EpiQKV E{(bf16*)(ws + WS_Q), (bf16*)(ws + WS_K), (bf16*)(ws + WS_V), a.in[I_QG] + j * 64, a.in[I_KG] + j * 64, (const f32x2*)(ws + WS_ROPE)};
        pg8::gemm_phase<EpiQKV, SchedQKV, false>(c.lds, 2048, 2048, S, E); }
#endif
    else if constexpr (KIND == K_ROPE) ph_rope(a, c, layer);
    else if constexpr (KIND == K_ATT) ph_att(a, c, layer, (char*)c.lds);
    else if constexpr (KIND == K_OPROJ) { constexpr int j = layer ? 1 : 0;
#if ATT_FP8
        unsigned* rdx = (unsigned*)(ws + WS_CTL) + CW_RDX + layer * 128;
        SchedDenseR S{(const char*)(ws + WS_HB), (const char*)(ws + WS_WO) + (size_t)j * 1024 * 1024, (size_t)256 * 1024, (size_t)256 * 1024, 0, layer == 3 ? 64 : 68, 4, 64, c.G, (int)blockIdx.x, rdx};
        EpiResid E{&a, layer, nullptr, nullptr};
        pg8::gemm_phase<EpiResid, SchedDenseR, false, true>(c.lds, 1024, 1024, S, E, 127 - MOE_WSH, 127 - ATT_OSH);
        RELAUNDER(); ph_m1(a, c, layer, (unsigned*)(a.ws + WS_CTL) + CW_RDX + layer * 128, 4); }
#else
        unsigned* rdx = (unsigned*)(ws + WS_CTL) + CW_RDX + layer * 128;
        SchedDenseR S{(const char*)(ws + WS_HB), (const char*)(ws + WS_WO) + (size_t)j * 1024 * 1024 * 2, (size_t)256 * 1024 * 2, (size_t)256 * 1024 * 2, 0, layer == 3 ? 64 : 68, 4, 64, c.G, (int)blockIdx.x, rdx};
        EpiResid E{&a, layer, nullptr, nullptr};
        pg8::gemm_phase<EpiResid, SchedDenseR, false>(c.lds, 2048, 2048, S, E);
        RELAUNDER(); ph_m1(a, c, layer, (unsigned*)(a.ws + WS_CTL) + CW_RDX + layer * 128, 4); }
#endif
    else if constexpr (KIND == K_M2) {
        LAS int* tab = (LAS int*)(c.lds + TAB_OFF); moe_tables(a, c, layer, tab);
        unsigned* rdy = (unsigned*)(ws + WS_CTL) + CW_RDY + layer * 256;
#if MOE_FP8
        { SchedMoe S{(const char*)(ws + WS_TK), 0, (const char*)(ws + WS_WGU) + (size_t)layer * 32 * 1024 * 1024, (size_t)1024 * 1024, (size_t)256 * 1024, tab, (const int*)(ws + WS_LIST), c.G, (int)blockIdx.x, rdy, 1};
          EpiGateUp E{(bf16*)(ws + WS_ACT)};
          pg8::gemm_phase<EpiGateUp, SchedMoe, true, true>(c.lds, 1024, 1024, S, E, 127 - MOE_WSH, 127); }
        { SchedMoe S{(const char*)(ws + WS_ACT), (size_t)256 * 512, (const char*)(ws + WS_WDN) + (size_t)layer * 32 * 1024 * 512, (size_t)1024 * 512, (size_t)256 * 512, tab, (const int*)(ws + WS_LIST), c.G, (int)blockIdx.x, rdy, 2};
          EpiDown E{(const int*)(ws + WS_LIST), (const float*)(ws + WS_W2), (bf16*)(ws + WS_Y2)};
          pg8::gemm_phase<EpiDown, SchedMoe, false, true>(c.lds, 512, 512, S, E, 127 - MOE_WSH, 127 - MOE_ASH); } }
#else
        { SchedMoe S{(const char*)(ws + WS_TK), 0, (const char*)(ws + WS_WGU) + (size_t)layer * 32 * 1024 * 1024 * 2, (size_t)1024 * 1024 * 2, (size_t)256 * 1024 * 2, tab, (const int*)(ws + WS_LIST), c.G, (int)blockIdx.x, rdy, 1};
          EpiGateUp E{(bf16*)(ws + WS_ACT)};
          pg8::gemm_phase<EpiGateUp, SchedMoe, true>(c.lds, 2048, 2048, S, E); }
        { SchedMoe S{(const char*)(ws + WS_ACT), (size_t)256 * 512 * 2, (const char*)(ws + WS_WDN) + (size_t)layer * 32 * 1024 * 512 * 2, (size_t)1024 * 512 * 2, (size_t)256 * 512 * 2, tab, (const int*)(ws + WS_LIST), c.G, (int)blockIdx.x, rdy, 2};
          EpiDown E{(const int*)(ws + WS_LIST), (const float*)(ws + WS_W2), (bf16*)(ws + WS_Y2)};
          pg8::gemm_phase<EpiDown, SchedMoe, false>(c.lds, 1024, 1024, S, E); } }
#endif
    else if constexpr (KIND == K_RPOOL) ph_rpool(a, c, layer);
    else if constexpr (KIND == K_POOLG) {
        unsigned* rdx = (unsigned*)(ws + WS_CTL) + CW_RDX + layer * 128;
        SchedDenseR S{(const char*)(ws + WS_HB), (const char*)(ws + WS_WPOOL), (size_t)256 * 1024 * 2, (size_t)256 * 256 * 2, (size_t)256 * 2, 68, 4, 64, c.G, (int)blockIdx.x, rdx};
        EpiResid E{&a, layer, a.in[I_POOLS], (const float*)(ws + WS_Z)};
        pg8::gemm_phase<EpiResid, SchedDenseR, false>(c.lds, 512, 2048, S, E);
        RELAUNDER(); ph_m1(a, c, layer, (unsigned*)(a.ws + WS_CTL) + CW_RDX + layer * 128, 4); }
    else if constexpr (KIND == K_INPROJ) {
        SchedDense S{(const char*)(ws + WS_HB), (const char*)(ws + WS_WIN), (size_t)256 * 1024 * 2, (size_t)256 * 1024 * 2, 0, 68, 21, c.G, (int)blockIdx.x};
        EpiInproj E{(bf16*)(ws + WS_Z), (bf16*)(ws + WS_XBC), (float*)(ws + WS_DT), a.in[I_DTB]};
        pg8::gemm_phase<EpiInproj, SchedDense, false>(c.lds, 2048, 2048, S, E); }
    else if constexpr (KIND == K_CONV) ph_conv(a, c);
    else if constexpr (KIND == K_SCAN) ph_scan(a, c);
    else if constexpr (KIND == K_YPH) ph_yph(a, c);
    else if constexpr (KIND == K_GFIX) ph_gfix(a, c);
    else if constexpr (KIND == K_OUTPROJ) {
        unsigned* rdx = (unsigned*)(ws + WS_CTL) + CW_RDX + layer * 128;
        SchedDenseR S{(const char*)(ws + WS_G), (const char*)(ws + WS_WOUT), (size_t)256 * 2048 * 2, (size_t)256 * 2048 * 2, 0, 68, 4, 64, c.G, (int)blockIdx.x, rdx};
        EpiResid E{&a, layer, nullptr, nullptr};
        pg8::gemm_phase<EpiResid, SchedDenseR, false>(c.lds, 4096, 4096, S, E);
        RELAUNDER(); ph_m1(a, c, layer, (unsigned*)(a.ws + WS_CTL) + CW_RDX + layer * 128, 4); }
    else if constexpr (KIND == K_FINAL) ph_final(a, c, layer);
#undef RELAUNDER
}
#define PROGRAM(X) \
    X(0, K_P0, 0) \
    X(1, K_RMIX, 0) X(2, K_QKV, 0) X(3, K_ATT, 0) X(4, K_OPROJ, 0) X(5, K_M2, 0) \
    X(6, K_RPOOL, 1) X(7, K_POOLG, 1) X(8, K_M2, 1) \
    X(9, K_RMIX, 2) X(10, K_INPROJ, 2) X(11, K_CONV, 2) X(12, K_SCAN, 2) X(13, K_YPH, 2) X(14, K_OUTPROJ, 2) X(15, K_M2, 2) \
    X(16, K_RMIX, 3) X(17, K_QKV, 3) X(18, K_ATT, 3) X(19, K_OPROJ, 3) X(20, K_M2, 3) \
    X(21, K_FINAL, 4)
constexpr int NPHASES = 22;
__device__ __forceinline__ unsigned long long probe_phases(const unsigned long long* ts, unsigned mask) { unsigned long long r = 0; for (int k = 0; k < 32; ++k) if (mask & (1u << k)) r += ts[k + 1] - ts[k]; return r; }
__device__ __forceinline__ unsigned long long probe_sum(const unsigned long long* s, int mask) { unsigned long long r = 0; for (int k = 0; k < 8; ++k) if (mask & (1 << k)) r += s[k]; return r; }
__global__ void __launch_bounds__(NTHREADS, 2) mega(Args a0) {
    extern __shared__ __attribute__((aligned(16))) unsigned char lds_raw[];
    Ctx c; c.lds = (LAS unsigned char*)lds_raw; c.tid = threadIdx.x; c.lane = c.tid & 63; c.wave = __builtin_amdgcn_readfirstlane(c.tid >> 6);
    c.G = gridDim.x; { const int bx = blockIdx.x; c.vcu = (c.G % 8 == 0) ? (bx % 8) * (c.G / 8) + bx / 8 : bx; }
    volatile LAS unsigned* MISC = (volatile LAS unsigned*)(c.lds + MISC_OFF);
    for (int u = c.tid; u < 128; u += NTHREADS) MISC[u] = 0u;
    __syncthreads();
    XcdBarrier bar = xcd_barrier_post((unsigned*)(a0.ws + WS_CTL) + CW_BAR + a0.bar_region * XCD_BAR_WORDS, MISC + 8);
    const int lo = a0.ph_lo, hi = a0.ph_hi;
#if PROBE
#define STAMP(idx) if (blockIdx.x == 0 && threadIdx.x == 0) __hip_atomic_store((unsigned long long*)((unsigned*)(a0.ws + WS_CTL) + CW_TS) + (idx), (unsigned long long)__builtin_amdgcn_s_memrealtime(), __ATOMIC_RELAXED, __HIP_MEMORY_SCOPE_AGENT);
#else
#define STAMP(idx)
#endif
    STAMP(0)
#if EXTRA_BARS
    for (int eb = 0; eb < EXTRA_BARS; ++eb) xcd_barrier(bar);
#endif
#define RUNPH(idx, KIND, LAYER) if (lo <= (idx) && (idx) < hi) { run_phase<KIND, LAYER>(a0, c, lds_raw); if ((idx) + 1 < hi) xcd_barrier(bar); STAMP((idx) + 1) }
    PROGRAM(RUNPH)
#undef RUNPH
#if PROBE
    if (blockIdx.x == 0 && threadIdx.x == 0 && hi == NPHASES) { const unsigned long long* ts = (const unsigned long long*)((unsigned*)(a0.ws + WS_CTL) + CW_TS);
        const unsigned long long d = (unsigned long long)PROBE_K * (PROBE_SLOT ? probe_sum(ts + PROBE_SLOT_BASE, PROBE_SLOT) : probe_phases(ts, PROBE_MASK)), t0 = __builtin_amdgcn_s_memrealtime();
        while (__builtin_amdgcn_s_memrealtime() - t0 < d) __builtin_amdgcn_s_sleep(8); }
#endif
}

extern "C" void kernel_launch(void* const* d_in, const int* in_sizes, int n_in, void* d_out, int out_size, void* d_ws, size_t ws_size, hipStream_t stream) {
    static int grid = 0;
    if (grid == 0) {
        if (n_in != N_IN || out_size != TL * D || ws_size < WS_END) { fprintf(stderr, "kernel_launch: unexpected shapes (n_in %d out %d ws %zu)\n", n_in, out_size, ws_size); grid = -1; return; }
        int dev = 0, cus = 0;
        if (hipGetDevice(&dev) != hipSuccess || hipDeviceGetAttribute(&cus, hipDeviceAttributeMultiprocessorCount, dev) != hipSuccess) { grid = -1; return; }
        if (hipFuncSetAttribute((const void*)mega, hipFuncAttributeMaxDynamicSharedMemorySize, LDS_BYTES) != hipSuccess) { fprintf(stderr, "kernel_launch: hipFuncSetAttribute failed\n"); grid = -1; return; }
        int per_cu = 0;
        if (hipOccupancyMaxActiveBlocksPerMultiprocessor(&per_cu, (const void*)mega, NTHREADS, LDS_BYTES) != hipSuccess || per_cu < 1) fprintf(stderr, "kernel_launch: occupancy query says %d\n", per_cu);
        (void)hipGetLastError();
        grid = cus;
    }
    if (grid < 0) return;
    (void)hipMemsetAsync((char*)d_ws + WS_CTL, 0, CTL_ZERO_BYTES, stream);
    Args a{};
    for (int i = 0; i < N_IN; ++i) a.in[i] = (const float*)d_in[i];
    a.out = (float*)d_out; a.ws = (unsigned char*)d_ws; a.flags = 0;
#if DEBUG_CHECKS
    struct Cut { int after; int ty, layer, nid; };
    const Cut cuts[] = DEBUG_CUTS;
    int lo = 0, region = 0, dbg_id = 1;
    for (unsigned k = 0; k < sizeof(cuts) / sizeof(cuts[0]); ++k) {
        if (cuts[k].after + 1 > lo) { a.ph_lo = lo; a.ph_hi = cuts[k].after + 1; a.bar_region = region++; hipLaunchKernelGGL(mega, dim3(grid), dim3(NTHREADS), LDS_BYTES, stream, a); lo = cuts[k].after + 1; }
        hipLaunchKernelGGL(dbg_kernel, dim3(16), dim3(NTHREADS), 65536, stream, a, cuts[k].ty, cuts[k].layer, dbg_id); dbg_id += cuts[k].nid;
    }
    a.ph_lo = lo; a.ph_hi = NPHASES; a.bar_region = region++;
    hipLaunchKernelGGL(mega, dim3(grid), dim3(NTHREADS), LDS_BYTES, stream, a);
#else
    a.ph_lo = 0; a.ph_hi = NPHASES; a.bar_region = 0;
    hipLaunchKernelGGL(mega, dim3(grid), dim3(NTHREADS), LDS_BYTES, stream, a);
#endif
}
```

```cpp
#include <hip/hip_runtime.h>
#include <cstdio>
#include <cstdint>

#define LAS __attribute__((address_space(3)))
#define GAS __attribute__((address_space(1)))
typedef unsigned short bf16;
typedef short bf16x8 __attribute__((ext_vector_type(8)));
typedef short s16x4 __attribute__((ext_vector_type(4)));
typedef float f32x2 __attribute__((ext_vector_type(2)));
typedef float f32x4 __attribute__((ext_vector_type(4)));
typedef float f32x16 __attribute__((ext_vector_type(16)));
typedef unsigned u32x2 __attribute__((ext_vector_type(2)));
typedef unsigned u32x4 __attribute__((ext_vector_type(4)));
typedef __bf16 bf16x2_t __attribute__((ext_vector_type(2)));

constexpr int D = 1024, NB = 4, SEQ = 4096, CTXL = 256, TL = NB * SEQ, TC = NB * CTXL, TT = TL + TC;
constexpr int KVROWS = SEQ + CTXL;
constexpr int NCH = TT / 128;
constexpr int MOE_CAP = TT;
constexpr float EPS = 1e-6f;
constexpr int NWAVES = 8, NTHREADS = 512;
#ifndef NLAYERS
#define NLAYERS 4
#endif
#ifndef MOE_FP8
#define MOE_FP8 1
#endif
#define MOE_WSH 5
#ifndef ATT_FP8
#define ATT_FP8 1
#endif
#define ATT_OSH 3
#define MOE_ASH 2
#define DBG_TOL 0.03f
#ifndef DEBUG_CHECKS
#define DEBUG_CHECKS 0
#endif
#ifndef PROBE
#define PROBE 0
#endif
#define PROBE_A0 0
#define PROBE_A1 1
#define PROBE_B0 4
#define PROBE_B1 5
#define PROBE_K 2
#define PROBE_MASK 0x1222224u
#define EXTRA_BARS 0
#define PROBE_SLOT_BASE 40
#define PROBE_SLOT 0
#if PROBE
#define SECT_DECL unsigned long long sect_t = __builtin_amdgcn_s_memrealtime(); unsigned long long sect_acc[8] = {0, 0, 0, 0, 0, 0, 0, 0};
#define SECT(k) do { const unsigned long long n_ = __builtin_amdgcn_s_memrealtime(); sect_acc[k] += n_ - sect_t; sect_t = n_; } while (0)
#define SECT_END(base) do { if (blockIdx.x == 0 && threadIdx.x == 0) { _Pragma("unroll") for (int k_ = 0; k_ < 8; ++k_) ((unsigned long long*)((unsigned*)(a.ws + WS_CTL) + CW_TS))[(base) + k_] = sect_acc[k_]; } } while (0)
#else
#define SECT_DECL
#define SECT(k) do {} while (0)
#define SECT_END(base) do {} while (0)
#endif
#define DEBUG_CUTS { {1, 1, 0, 1}, {2, 2, 0, 1}, {3, 3, 0, 1}, {4, 4, 0, 1}, {6, 5, 0, 2} }

enum { I_X = 0, I_C, I_CTX, I_CCTX, I_WADA, I_BADA, I_NMIX, I_NFFN, I_NFIN, I_WQKV, I_WO, I_QG, I_KG, I_POOLW, I_POOLS, I_WIN, I_CONVW, I_CONVB, I_DTB, I_ALOG, I_DSK, I_SNORM, I_WOUT, I_WRG, I_WRE, I_WGU, I_WDN, N_IN };

constexpr size_t MiB = 1u << 20;
constexpr size_t WS_CTL = 0, CTL_ZERO_BYTES = 1 * MiB;
constexpr size_t WS_MODL = 1 * MiB;
constexpr size_t WS_MODC = WS_MODL + 4 * 4 * 6144 * 4;
constexpr size_t WS_ROPE = 1 * MiB + 512 * 1024;
constexpr size_t WS_WR = 2 * MiB;
constexpr size_t WS_WQKV = 3 * MiB;
constexpr size_t WS_WO = 9 * MiB;
constexpr size_t WS_WPOOL = 13 * MiB;
constexpr size_t WS_WIN = 14 * MiB;
constexpr size_t WS_WOUT = 25 * MiB;
constexpr size_t WS_WGU = 29 * MiB;
constexpr size_t WS_WDN = 285 * MiB;
constexpr size_t WS_X = 413 * MiB;
constexpr size_t WS_HB = 481 * MiB;
constexpr size_t WS_TK = 515 * MiB;
constexpr size_t WS_Q = 549 * MiB;
constexpr size_t WS_K = 583 * MiB;
constexpr size_t WS_V = 592 * MiB;
constexpr size_t WS_Y2 = 601 * MiB;
constexpr size_t WS_ACT = 669 * MiB;
constexpr size_t WS_LIST = 711 * MiB;
constexpr size_t WS_W2 = 714 * MiB;
constexpr size_t WS_Z = 715 * MiB;
constexpr size_t WS_XBC = 783 * MiB;
constexpr size_t WS_DT = 885 * MiB;
constexpr size_t WS_XT = 890 * MiB;
constexpr size_t WS_BN = 958 * MiB;
constexpr size_t WS_BT = 975 * MiB;
constexpr size_t WS_CN = 992 * MiB;
constexpr size_t WS_SCA = 1009 * MiB;
constexpr size_t WS_SCB = 1018 * MiB;
constexpr size_t WS_DEC = 1027 * MiB;
constexpr size_t WS_HIN = 1028 * MiB;
constexpr size_t WS_G = 1164 * MiB;
constexpr size_t WS_RSTD = 1232 * MiB;
constexpr size_t WS_END = 1233 * MiB;

constexpr int CW_BAR = 4096;
constexpr int CW_CNT = 200000;
constexpr int CW_DBG = 201000;
constexpr int CW_RDY = 204000;
constexpr int CW_RDG = 207000;
constexpr int CW_RDX = 206000;
constexpr int CW_TS = 202000;

constexpr int LDS_BYTES = 163840;
constexpr int MISC_OFF = LDS_BYTES - 512;

__device__ __forceinline__ unsigned cvtpk(float lo, float hi) { f32x2 v = {lo, hi}; bf16x2_t b = __builtin_convertvector(v, bf16x2_t); return __builtin_bit_cast(unsigned, b); }
__device__ __forceinline__ unsigned pk_fp8x4(float a, float b, float c, float d) {
    a = __builtin_amdgcn_fmed3f(a, -448.f, 448.f); b = __builtin_amdgcn_fmed3f(b, -448.f, 448.f); c = __builtin_amdgcn_fmed3f(c, -448.f, 448.f); d = __builtin_amdgcn_fmed3f(d, -448.f, 448.f);
    unsigned w = __builtin_amdgcn_cvt_pk_fp8_f32(a, b, 0u, false); return __builtin_amdgcn_cvt_pk_fp8_f32(c, d, w, true); }
__device__ __forceinline__ float bflo(unsigned u) { return __uint_as_float(u << 16); }
__device__ __forceinline__ float bfhi(unsigned u) { return __uint_as_float(u & 0xffff0000u); }
__device__ __forceinline__ float bf2f(bf16 b) { return __uint_as_float((unsigned)b << 16); }
__device__ __forceinline__ float wave_sum(float v) {
#pragma unroll
    for (int o = 1; o < 64; o <<= 1) v += __shfl_xor(v, o);
    return v;
}
__device__ __forceinline__ float silu_f(float v) { return v * __builtin_amdgcn_rcpf(1.0f + __builtin_amdgcn_exp2f(v * -1.4426950408889634f)); }
__device__ __forceinline__ int tid_opaque() { int t = threadIdx.x; asm volatile("" : "+v"(t)); return t; }
#define LDS_WAIT() asm volatile("s_waitcnt lgkmcnt(0)" ::: "memory")
#define VM_WAIT() asm volatile("s_waitcnt vmcnt(0)" ::: "memory")

#define XB_TMO      128
#define XB_XCNT(j)  (256  + 64 * (j))
#define XB_XSUB(j)  (1280 + 64 * (j))
#define XB_XGEN(j)  (2304 + 64 * (j))
#define XB_TOP      3328
#define XB_TOPGEN   3392
#define XCD_BAR_WORDS 3456
#define XB_SPIN_CAP (1u << 20)
__device__ __forceinline__ unsigned xb_ld(unsigned* p)              { return __hip_atomic_load(p, __ATOMIC_RELAXED, __HIP_MEMORY_SCOPE_AGENT); }
__device__ __forceinline__ unsigned xb_add(unsigned* p, unsigned v) { return __hip_atomic_fetch_add(p, v, __ATOMIC_RELAXED, __HIP_MEMORY_SCOPE_AGENT); }
__device__ __forceinline__ unsigned xb_xcc_id() { return (unsigned)__builtin_amdgcn_s_getreg((3 << 11) | 20) & 0xFu; }
#define XB_SPIN(cond, bar) do { unsigned _sp = 0; while (cond) { __builtin_amdgcn_s_sleep(1); \
    if ((++_sp & 255u) == 0u) { if (xb_ld(&(bar)[XB_TMO])) break; if (_sp > XB_SPIN_CAP) { atomicAdd(&(bar)[XB_TMO], 1u); break; } } } } while (0)
struct XcdBarrier { unsigned* bar; unsigned x; volatile LAS unsigned* st; };
__device__ __forceinline__ XcdBarrier xcd_barrier_post(unsigned* bar, volatile LAS unsigned* st) {
    XcdBarrier b; b.bar = bar; b.x = xb_xcc_id(); b.st = st;
    if (threadIdx.x == 0) (void)xb_add(&bar[XB_XCNT(b.x)], 1u);
    return b;
}
__device__ __forceinline__ void xcd_barrier_complete(unsigned* bar, unsigned x, unsigned& nloc, unsigned& nx) {
    const unsigned G = gridDim.x * gridDim.y * gridDim.z;
    unsigned sum, cnt, mine, sp = 0u;
    for (;;) {
        sum = 0u; cnt = 0u; mine = 0u;
#pragma unroll
        for (unsigned j = 0; j < 16; ++j) { const unsigned c = xb_ld(&bar[XB_XCNT(j)]); sum += c; cnt += (c > 0u) ? 1u : 0u; mine = (j == x) ? c : mine; }
        if (sum == G) break;
        __builtin_amdgcn_s_sleep(1);
        if ((++sp & 255u) == 0u) { if (xb_ld(&bar[XB_TMO])) break; if (sp > XB_SPIN_CAP) { atomicAdd(&bar[XB_TMO], 1u); break; } }
    }
    nloc = mine > 0u ? mine : 1u; nx = cnt > 0u ? cnt : 1u;
}
__device__ __forceinline__ void xcd_barrier(const XcdBarrier& b) {
    asm volatile("s_waitcnt vmcnt(0)" ::: "memory");
    __syncthreads();
    if (threadIdx.x == 0) {
        unsigned* bar = b.bar;
        __builtin_amdgcn_s_waitcnt(0);
        unsigned nloc = b.st[0], nx = b.st[1];
        if (nloc == 0u) { xcd_barrier_complete(bar, b.x, nloc, nx); b.st[0] = nloc; b.st[1] = nx; }
        const unsigned old = xb_add(&bar[XB_XSUB(b.x)], 1u);
        const unsigned gen = old / nloc;
        if (old + 1u == (gen + 1u) * nloc) {
            __builtin_amdgcn_fence(__ATOMIC_RELEASE, "agent");
            asm volatile("s_waitcnt vmcnt(0)" ::: "memory");
            const unsigned og = xb_add(&bar[XB_TOP], 1u);
            const unsigned tg = og / nx;
            if (og + 1u == (tg + 1u) * nx) xb_add(&bar[XB_TOPGEN], 1u);
            else XB_SPIN(xb_ld(&bar[XB_TOPGEN]) == tg, bar);
            __builtin_amdgcn_fence(__ATOMIC_ACQUIRE, "agent");
            xb_add(&bar[XB_XGEN(b.x)], 1u);
            asm volatile("s_waitcnt vmcnt(0)" ::: "memory");
        } else {
            XB_SPIN(xb_ld(&bar[XB_XGEN(b.x)]) == gen, bar);
            __builtin_amdgcn_fence(__ATOMIC_ACQUIRE, "agent");
            asm volatile("s_waitcnt vmcnt(0)" ::: "memory");
        }
    }
    __syncthreads();
}

enum { K_P0 = 0, K_RMIX, K_QKV, K_ROPE, K_ATT, K_OPROJ, K_M1, K_M2, K_M3, K_RPOOL, K_POOLG, K_INPROJ, K_CONV, K_SCAN, K_YPH, K_GFIX, K_OUTPROJ, K_FINAL, K_DBG };
struct Args { const float* in[N_IN]; float* out; unsigned char* ws; int ph_lo, ph_hi; int flags; int bar_region; };

struct Ctx {
    LAS unsigned char* lds; int tid, lane, wave, vcu, G;
};

__device__ __forceinline__ const float* mod_row(const Args& a, int layer, int r) {
    return r < TL ? (const float*)(a.ws + WS_MODL) + (size_t)(layer * 4 + r / SEQ) * 6144 : (const float*)(a.ws + WS_MODC) + (size_t)layer * 6144;
}
__device__ __forceinline__ const float* resid_row(const Args& a, int layer, int r) {
    if (layer == 0) return r < TL ? a.in[I_X] + (size_t)r * D : a.in[I_CTX] + (size_t)(r - TL) * D;
    return (const float*)(a.ws + WS_X) + (size_t)r * D;
}

__device__ __forceinline__ void load_row_combined(const Args& a, int layer, int r, int lane, f32x4 (&v)[4]) {
    const f32x4* xr = (const f32x4*)resid_row(a, layer, r) + lane;
#pragma unroll
    for (int j = 0; j < 4; ++j) v[j] = xr[64 * j];
    if (layer > 0 && !(a.flags & 1)) {
        const f32x4* gf = (const f32x4*)(mod_row(a, layer - 1, r) + 5 * D) + lane;
        const u32x2* y0 = (const u32x2*)((const bf16*)(a.ws + WS_Y2) + (size_t)(2 * r) * D) + lane;
        const u32x2* y1 = (const u32x2*)((const bf16*)(a.ws + WS_Y2) + (size_t)(2 * r + 1) * D) + lane;
#pragma unroll
        for (int j = 0; j < 4; ++j) {
            const u32x2 p = y0[64 * j], q = y1[64 * j]; const f32x4 g = gf[64 * j];
            v[j].x += g.x * (bflo(p.x) + bflo(q.x)); v[j].y += g.y * (bfhi(p.x) + bfhi(q.x));
            v[j].z += g.z * (bflo(p.y) + bflo(q.y)); v[j].w += g.w * (bfhi(p.y) + bfhi(q.y));
        }
    }
}
__device__ __forceinline__ float row_rstd(const f32x4 (&v)[4]) {
    float s = 0.f;
#pragma unroll
    for (int j = 0; j < 4; ++j) s += (v[j].x * v[j].x + v[j].y * v[j].y) + (v[j].z * v[j].z + v[j].w * v[j].w);
    return rsqrtf(wave_sum(s) * (1.0f / D) + EPS);
}
__device__ __forceinline__ void norm_mod(const f32x4 (&v)[4], float rstd, const float* g, const float* shift, const float* scale, int lane, f32x4 (&h)[4]) {
#pragma unroll
    for (int j = 0; j < 4; ++j) {
        const f32x4 gg = ((const f32x4*)g)[lane + 64 * j], sh = ((const f32x4*)shift)[lane + 64 * j], sc = ((const f32x4*)scale)[lane + 64 * j];
        h[j] = (v[j] * rstd) * gg * (sc + 1.0f) + sh;
    }
}

__device__ __forceinline__ void tr_item(const float* W, int N, int k0, int n0, bf16* WT, size_t drow0, int dK, LAS float* scr, int lane, int hi_skip = 0) {
    const int nq = lane & 15, kr = lane >> 4;
#pragma unroll
    for (int i = 0; i < 16; ++i) { const int kk = 4 * i + kr; const f32x4 v = *(const f32x4*)(W + (size_t)(k0 + kk) * N + n0 + 4 * nq);
        LAS float* d = scr + kk * 65 + 4 * nq; d[0] = v.x; d[1] = v.y; d[2] = v.z; d[3] = v.w; }
    LDS_WAIT(); asm volatile("" ::: "memory");
    const int c = lane & 7;
#pragma unroll
    for (int j = 0; j < 8; ++j) { const int n = (lane >> 3) + 8 * j; const LAS float* s = scr + (8 * c) * 65 + n;
        u32x4 o; o.x = cvtpk(s[0 * 65], s[1 * 65]); o.y = cvtpk(s[2 * 65], s[3 * 65]); o.z = cvtpk(s[4 * 65], s[5 * 65]); o.w = cvtpk(s[6 * 65], s[7 * 65]);
        *(u32x4*)(WT + (drow0 + n + (n >= 32 ? hi_skip : 0)) * dK + k0 + 8 * c) = o; }
    LDS_WAIT(); asm volatile("" ::: "memory");
}
__device__ __forceinline__ void tr_item8(const float* W, int N, int k0, int n0, unsigned char* WT, size_t drow0, int dKb, LAS float* scr, int lane, float scale, int hi_skip = 0) {
    const int nq = lane & 15, kr = lane >> 4;
#pragma unroll
    for (int i = 0; i < 16; ++i) { const int kk = 4 * i + kr; const f32x4 v = *(const f32x4*)(W + (size_t)(k0 + kk) * N + n0 + 4 * nq);
        LAS float* d = scr + kk * 65 + 4 * nq; d[0] = v.x; d[1] = v.y; d[2] = v.z; d[3] = v.w; }
    LDS_WAIT(); asm volatile("" ::: "memory");
    const int c = lane & 3;
#pragma unroll
    for (int j = 0; j < 4; ++j) { const int n = (lane >> 2) + 16 * j; const LAS float* s = scr + (16 * c) * 65 + n;
        u32x4 o; o.x = pk_fp8x4(s[0 * 65] * scale, s[1 * 65] * scale, s[2 * 65] * scale, s[3 * 65] * scale); o.y = pk_fp8x4(s[4 * 65] * scale, s[5 * 65] * scale, s[6 * 65] * scale, s[7 * 65] * scale);
        o.z = pk_fp8x4(s[8 * 65] * scale, s[9 * 65] * scale, s[10 * 65] * scale, s[11 * 65] * scale); o.w = pk_fp8x4(s[12 * 65] * scale, s[13 * 65] * scale, s[14 * 65] * scale, s[15 * 65] * scale);
        *(u32x4*)(WT + (drow0 + n + (n >= 32 ? hi_skip : 0)) * dKb + k0 + 16 * c) = o; }
    LDS_WAIT(); asm volatile("" ::: "memory");
}
struct TrD { const float* src; int N; unsigned char* dst; int dKb, drow0, hi_skip, fp8; };
__device__ __forceinline__ void tr_load(const TrD& d, f32x4 (&v)[16], int lane) {
    const int nq = lane & 15, kr = lane >> 4;
#pragma unroll
    for (int i = 0; i < 16; ++i) v[i] = *(const f32x4*)(d.src + (size_t)(4 * i + kr) * d.N + 4 * nq);
}
__device__ __forceinline__ void tr_store(const TrD& d, const f32x4 (&v)[16], LAS float* scr, int lane) {
    const int nq = lane & 15, kr = lane >> 4;
#pragma unroll
    for (int i = 0; i < 16; ++i) { LAS float* p = scr + (4 * i + kr) * 65 + 4 * nq; p[0] = v[i].x; p[1] = v[i].y; p[2] = v[i].z; p[3] = v[i].w; }
    LDS_WAIT(); asm volatile("" ::: "memory");
    if (d.fp8) { const int c = lane & 3; const float scale = (float)(1 << MOE_WSH);
#pragma unroll
        for (int j = 0; j < 4; ++j) { const int n = (lane >> 2) + 16 * j; const LAS float* s = scr + (16 * c) * 65 + n;
            u32x4 o; o.x = pk_fp8x4(s[0 * 65] * scale, s[1 * 65] * scale, s[2 * 65] * scale, s[3 * 65] * scale); o.y = pk_fp8x4(s[4 * 65] * scale, s[5 * 65] * scale, s[6 * 65] * scale, s[7 * 65] * scale);
            o.z = pk_fp8x4(s[8 * 65] * scale, s[9 * 65] * scale, s[10 * 65] * scale, s[11 * 65] * scale); o.w = pk_fp8x4(s[12 * 65] * scale, s[13 * 65] * scale, s[14 * 65] * scale, s[15 * 65] * scale);
            *(u32x4*)(d.dst + (size_t)(d.drow0 + n + (n >= 32 ? d.hi_skip : 0)) * d.dKb + 16 * c) = o; } }
    else { const int c = lane & 7;
#pragma unroll
        for (int j = 0; j < 8; ++j) { const int n = (lane >> 3) + 8 * j; const LAS float* s = scr + (8 * c) * 65 + n;
            u32x4 o; o.x = cvtpk(s[0 * 65], s[1 * 65]); o.y = cvtpk(s[2 * 65], s[3 * 65]); o.z = cvtpk(s[4 * 65], s[5 * 65]); o.w = cvtpk(s[6 * 65], s[7 * 65]);
            *(u32x4*)(d.dst + (size_t)(d.drow0 + n + (n >= 32 ? d.hi_skip : 0)) * d.dKb + 16 * c) = o; } }
    LDS_WAIT(); asm volatile("" ::: "memory");
}
constexpr int TR_I0 = 2 * 384, TR_I1 = 2 * 256, TR_I2 = 4 * 16, TR_I3 = 16 * 81, TR_I4 = 32 * 16, TR_I5 = 128 * 256, TR_I6 = 128 * 128, TR_ITOT = TR_I0 + TR_I1 + TR_I2 + TR_I3 + TR_I4 + TR_I5 + TR_I6;
__device__ __forceinline__ TrD tr_decode(const Args& a, int it) {
    TrD d; int r = it; d.hi_skip = 0;
    if (r < TR_I5) { const int m = r / 256, q = r % 256, kb = q / 16, nb = q % 16, n0 = nb * 64, j = n0 & 511;
        d.src = a.in[I_WGU] + (size_t)m * 1024 * 1024 + (size_t)kb * 64 * 1024 + n0; d.N = 1024; d.drow0 = 256 * (j >> 7) + (j & 127) + ((n0 >= 512) ? 128 : 0);
        d.fp8 = MOE_FP8; d.dKb = MOE_FP8 ? 1024 : 2048; d.dst = (unsigned char*)(a.ws + WS_WGU) + (size_t)m * 1024 * d.dKb + (size_t)kb * 64 * (MOE_FP8 ? 1 : 2); return d; }
    r -= TR_I5;
    if (r < TR_I6) { const int m = r / 128, q = r % 128, kb = q / 16, nb = q % 16;
        d.src = a.in[I_WDN] + (size_t)m * 512 * 1024 + (size_t)kb * 64 * 1024 + nb * 64; d.N = 1024; d.drow0 = nb * 64;
        d.fp8 = MOE_FP8; d.dKb = MOE_FP8 ? 512 : 1024; d.dst = (unsigned char*)(a.ws + WS_WDN) + (size_t)m * 1024 * d.dKb + (size_t)kb * 64 * (MOE_FP8 ? 1 : 2); return d; }
    r -= TR_I6;
    if (r < TR_I0) { const int m = r / 384, q = r % 384, kb = q / 24, nb = q % 24;
        d.src = a.in[I_WQKV] + (size_t)m * 1024 * 1536 + (size_t)kb * 64 * 1536 + nb * 64; d.N = 1536; d.drow0 = (nb >> 2) * 256 + (nb & 3) * 32; d.hi_skip = 96;
        d.fp8 = ATT_FP8; d.dKb = ATT_FP8 ? 1024 : 2048; d.dst = (unsigned char*)(a.ws + WS_WQKV) + (size_t)m * 1536 * d.dKb + (size_t)kb * 64 * (ATT_FP8 ? 1 : 2); return d; }
    r -= TR_I0;
    if (r < TR_I1) { const int m = r / 256, q = r % 256, kb = q / 16, nb = q % 16;
        d.src = a.in[I_WO] + (size_t)m * 1024 * 1024 + (size_t)kb * 64 * 1024 + nb * 64; d.N = 1024; d.drow0 = nb * 64;
        d.fp8 = ATT_FP8; d.dKb = ATT_FP8 ? 1024 : 2048; d.dst = (unsigned char*)(a.ws + WS_WO) + (size_t)m * 1024 * d.dKb + (size_t)kb * 64 * (ATT_FP8 ? 1 : 2); return d; }
    r -= TR_I1;
    d.fp8 = 0;
    if (r < TR_I2) { const int m = r / 16, q = r % 16, kb = q / 4, nb = q % 4;
        d.src = a.in[I_POOLW] + (size_t)m * 256 * 256 + (size_t)kb * 64 * 256 + nb * 64; d.N = 256; d.drow0 = nb * 64; d.dKb = 512; d.dst = (unsigned char*)(a.ws + WS_WPOOL) + (size_t)m * 256 * 512 + (size_t)kb * 128; return d; }
    r -= TR_I2;
    if (r < TR_I3) { const int kb = r / 81, nb = r % 81;
        d.src = a.in[I_WIN] + (size_t)kb * 64 * 5184 + nb * 64; d.N = 5184; d.drow0 = nb * 64; d.dKb = 2048; d.dst = (unsigned char*)(a.ws + WS_WIN) + (size_t)kb * 128; return d; }
    r -= TR_I3;
    { const int kb = r / 16, nb = r % 16;
        d.src = a.in[I_WOUT] + (size_t)kb * 64 * 1024 + nb * 64; d.N = 1024; d.drow0 = nb * 64; d.dKb = 4096; d.dst = (unsigned char*)(a.ws + WS_WOUT) + (size_t)kb * 128; return d; }
}
__device__ __forceinline__ void p0_prologue(const Args& a, const Ctx& c) {
    LAS float* scr = (LAS float*)(c.lds + c.wave * 16896);
    const int gw = c.vcu * NWAVES + c.wave, NGW = c.G * NWAVES;
    { f32x4 va[16], vb[16]; TrD da, db; int it = gw;
      da = tr_decode(a, it < TR_ITOT ? it : TR_ITOT - 1); tr_load(da, va, c.lane);
      while (it < TR_ITOT) {
          const int itB = it + NGW; db = tr_decode(a, itB < TR_ITOT ? itB : TR_ITOT - 1); tr_load(db, vb, c.lane);
          tr_store(da, va, scr, c.lane);
          if (itB >= TR_ITOT) break;
          const int itA = itB + NGW; da = tr_decode(a, itA < TR_ITOT ? itA : TR_ITOT - 1); tr_load(da, va, c.lane);
          tr_store(db, vb, scr, c.lane);
          it = itA; } }
    __syncthreads();
    LAS float* sv = (LAS float*)c.lds;
    LAS float* part = (LAS float*)(c.lds + 20480);
    for (int u = c.tid; u < 5 * 1024; u += NTHREADS) { const int v = u >> 10, k = u & 1023; const float x = v < 4 ? a.in[I_C][v * 1024 + k] : a.in[I_CCTX][k]; sv[u] = x / (1.0f + expf(-x)); }
    __syncthreads();
    for (int item = blockIdx.x; item < 4 * 64; item += c.G) {
        const int li = item >> 6, c0 = (item & 63) * 96, cq = c.tid % 24, ks = c.tid / 24;
        f32x4 acc[5];
#pragma unroll
        for (int v = 0; v < 5; ++v) acc[v] = (f32x4){0.f, 0.f, 0.f, 0.f};
        if (ks < 21) { const int kbeg = ks * 49, kend = (kbeg + 49) < 1024 ? (kbeg + 49) : 1024;
            const float* w = a.in[I_WADA] + ((size_t)li * 1024 + kbeg) * 6144 + c0 + 4 * cq;
#pragma unroll 7
            for (int k = kbeg; k < kend; ++k) { const f32x4 wv = *(const f32x4*)w; w += 6144;
#pragma unroll
                for (int v = 0; v < 5; ++v) acc[v] += wv * sv[v * 1024 + k]; }
#pragma unroll
            for (int v = 0; v < 5; ++v) *(LAS f32x4*)(part + (ks * 24 + cq) * 20 + v * 4) = acc[v]; }
        __syncthreads();
        if (c.tid < 480) { const int v = c.tid / 96, col = c.tid % 96, q = col >> 2, e = col & 3; float s = 0.f;
            for (int k2 = 0; k2 < 21; ++k2) s += part[(k2 * 24 + q) * 20 + v * 4 + e];
            s += a.in[I_BADA][li * 6144 + c0 + col];
            if (v < 4) ((float*)(a.ws + WS_MODL))[(size_t)(li * 4 + v) * 6144 + c0 + col] = s; else ((float*)(a.ws + WS_MODC))[(size_t)li * 6144 + c0 + col] = s; }
        __syncthreads();
    }
    if (blockIdx.x == (unsigned)(c.G - 1)) for (int u = c.tid; u < 1024; u += NTHREADS) { const int pos = u >> 4, f = u & 15;
        const float inv = (float)pow(10000.0, -(double)f / 16.0); const double ang = (double)((float)pos * inv);
        ((f32x2*)(a.ws + WS_ROPE))[u] = (f32x2){(float)cos(ang), (float)sin(ang)}; }
    for (int u = blockIdx.x * NTHREADS + c.tid; u < 4 * 64 * 1024; u += c.G * NTHREADS) { const int li = u >> 16, n = (u >> 10) & 63, k = u & 1023;
        float w = 0.f; if (n < 4) w = a.in[I_WRG][((size_t)li * 1024 + k) * 4 + n]; else if (n < 36) w = a.in[I_WRE][((size_t)li * 1024 + k) * 32 + (n - 4)];
        const unsigned hi = cvtpk(w, 0.f) & 0xffffu; const float rem = w - bflo(hi); const unsigned lo = cvtpk(rem, 0.f) & 0xffffu;
        bf16* wr = (bf16*)(a.ws + WS_WR) + (size_t)li * 2 * 65536; wr[n * 1024 + k] = (bf16)hi; wr[65536 + n * 1024 + k] = (bf16)lo; }
}

__device__ __forceinline__ void ph_rmix(const Args& a, const Ctx& c, int layer) {
    const int gw = c.vcu * NWAVES + c.wave, NGW = c.G * NWAVES;
    const float* g = a.in[I_NMIX] + layer * D;
    for (int r = gw; r < TT; r += NGW) {
        f32x4 v[4], h[4]; load_row_combined(a, layer, r, c.lane, v);
        if (layer > 0) { f32x4* xo = (f32x4*)((float*)(a.ws + WS_X) + (size_t)r * D) + c.lane;
#pragma unroll
            for (int j = 0; j < 4; ++j) xo[64 * j] = v[j]; }
        const float rstd = row_rstd(v); const float* m = mod_row(a, layer, r);
        norm_mod(v, rstd, g, m, m + D, c.lane, h);
        if (ATT_FP8 && layer != 2) { unsigned* ho8 = (unsigned*)((unsigned char*)(a.ws + WS_HB) + (size_t)r * D) + c.lane;
#pragma unroll
            for (int j = 0; j < 4; ++j) ho8[64 * j] = pk_fp8x4(h[j].x, h[j].y, h[j].z, h[j].w); }
        else { u32x2* ho = (u32x2*)((bf16*)(a.ws + WS_HB) + (size_t)r * D) + c.lane;
#pragma unroll
            for (int j = 0; j < 4; ++j) ho[64 * j] = (u32x2){cvtpk(h[j].x, h[j].y), cvtpk(h[j].z, h[j].w)}; }
    }
}

__device__ __forceinline__ void ph_final(const Args& a, const Ctx& c, int layer) {
    const int gw = c.vcu * NWAVES + c.wave, NGW = c.G * NWAVES;
    float dscale = 1.f, dmark = 0.f;
#if DEBUG_CHECKS
    { unsigned* dbg = (unsigned*)(a.ws + WS_CTL) + CW_DBG; int code = 0; float mag = 0.f;
      for (int id = 1; id < 32; ++id) { const float e = __uint_as_float(__hip_atomic_load(dbg + id, __ATOMIC_RELAXED, __HIP_MEMORY_SCOPE_AGENT)); if (code == 0 && e > DBG_TOL) { code = id; mag = e; } }
      dscale = 1.f + (float)code; dmark = code ? 100.f * (1.f + fminf(fmaxf(log2f(mag / DBG_TOL), 0.f), 30.f)) : 0.f; }
#endif
    for (int r = gw; r < TL; r += NGW) {
        f32x4 v[4]; load_row_combined(a, layer, r, c.lane, v);
        const float rstd = row_rstd(v) * dscale;
        f32x4* o = (f32x4*)(a.out + (size_t)r * D) + c.lane;
#pragma unroll
        for (int j = 0; j < 4; ++j) { f32x4 ov = (v[j] * rstd) * ((const f32x4*)a.in[I_NFIN])[c.lane + 64 * j]; if (j == 0 && r == 0 && c.lane == 0 && dmark > 0.f) ov.x = dmark; o[64 * j] = ov; }
    }
}


namespace pg8 {
constexpr int BM = 256, BK = 64, HALF = 128, HTB = HALF * BK * 2, STAGE_BYTES = 8 * HTB;
__host__ __device__ __forceinline__ int lds_byte(int r, int c) { const int st = (r >> 4) * 2 + (c >> 5), rr = r & 15, cc = c & 31, ob = rr * 64 + cc * 2; return st * 1024 + (ob ^ (((ob >> 9) & 1) << 5)); }
__host__ __device__ __forceinline__ void stage_rc(int b, int& R, int& C) { const int st = b / 1024, sb = b % 1024, swz = sb ^ (((sb >> 9) & 1) << 5); R = (st >> 1) * 16 + swz / 64; C = (st & 1) * 32 + (swz % 64) / 2; }
__host__ __device__ __forceinline__ int perm32(int rho) { const int n = rho >> 4, i = rho & 15; return 8 * (i >> 2) + 4 * n + (i & 3); }
struct Unit { const char* A; const char* B; int pm, pn, x0, x1; };
__device__ __forceinline__ void tile_of(int L, int nM, int nN, int& pm, int& pn) {
    const int nwg = nM * nN; int wgid = L; { const int q = nwg / 8, r = nwg % 8, xcd = wgid % 8, off = wgid / 8; wgid = (xcd < r ? xcd * (q + 1) : r * (q + 1) + (xcd - r) * q) + off; }
    const int nig = 8 * nN, gid = wgid / nig, fm = gid * 8, gsz = (nM - fm) < 8 ? (nM - fm) : 8;
    pm = fm + ((wgid % nig) % gsz); pn = (wgid % nig) / gsz;
}
typedef int v4i_t __attribute__((ext_vector_type(4))); typedef int v8i_t __attribute__((ext_vector_type(8)));
template <class Epi, class Sched, bool GATHER, bool FP8 = false>
__device__ __forceinline__ void gemm_phase(LAS unsigned char* lds, const int Kb, const int ldab, const Sched& S, const Epi& E, const int scw = 127, const int sca = 127) {
    const int tid = tid_opaque(), wid = __builtin_amdgcn_readfirstlane(tid >> 6), lane = tid & 63, wr = wid >> 2, wc = wid & 3, fr = lane & 15, fq = lane >> 4;
    const int nt = Kb / (BK * 2);
    int scw_v = scw, sca_v = sca;
    unsigned voffA[2], voffB[2]; int RA[2], CA[2];
#pragma unroll
    for (int i = 0; i < 2; ++i) { int R, C; stage_rc(tid * 16 + i * 8192, R, C); const int Rb = Epi::PERM ? ((R & ~31) + perm32(R & 31)) : R;
        RA[i] = R; CA[i] = C; voffA[i] = (unsigned)(R * ldab + C * 2); voffB[i] = (unsigned)(Rb * Kb + C * 2); }
    const size_t kstep = (size_t)(BK * 2);
    const size_t hstepA = (size_t)HALF * ldab, hstepB = (size_t)HALF * Kb;
    const unsigned ldsw = (unsigned)wid * 1024u;
    const int aoff = lds_byte(wr * 64 + fr, fq * 8), boff = lds_byte(wc * 32 + fr, fq * 8);
#define PG8_SA(b, h) (((b) * 2 + (h)) * HTB)
#define PG8_SB(b, h) ((4 + (b) * 2 + (h)) * HTB)
#define PG8_GLDS(bufoff, gptr, i_) __builtin_amdgcn_global_load_lds((const unsigned*)(gptr), (LAS unsigned*)(lds + (bufoff) + ldsw + (i_) * 8192), 16, 0, 0)
#define PG8_STAGE_B(bufoff, gbase) do { _Pragma("unroll") for (int _i = 0; _i < 2; ++_i) PG8_GLDS(bufoff, (const char*)(gbase) + voffB[_i], _i); } while (0)
#define PG8_STAGE_A(bufoff, ab, kb, h, NX) do { _Pragma("unroll") for (int _i = 0; _i < 2; ++_i) { \
        if constexpr (GATHER) { const unsigned _vo = (NX) ? voN[h][_i] : voC[h][_i]; PG8_GLDS(bufoff, (ab) + (kb) + _vo, _i); } \
        else { PG8_GLDS(bufoff, (ab) + (kb) + (size_t)(h) * hstepA + voffA[_i], _i); } } } while (0)
#define PG8_LDA(dst, b, h) do { _Pragma("unroll") for (int m = 0; m < 4; ++m) _Pragma("unroll") for (int k = 0; k < 2; ++k) dst[m][k] = *(const LAS bf16x8*)(lds + PG8_SA(b, h) + aoff + m * 2048 + k * 1024); } while (0)
#define PG8_LDB(dst, b, h) do { _Pragma("unroll") for (int n = 0; n < 2; ++n) _Pragma("unroll") for (int k = 0; k < 2; ++k) dst[n][k] = *(const LAS bf16x8*)(lds + PG8_SB(b, h) + boff + n * 2048 + k * 1024); } while (0)
#define PG8_MMA(ai, bj, At, Bt) do { __builtin_amdgcn_s_setprio(1); _Pragma("unroll") for (int m = 0; m < 4; ++m) _Pragma("unroll") for (int n = 0; n < 2; ++n) { \
        if constexpr (FP8) { const v8i_t b8 = __builtin_shufflevector(__builtin_bit_cast(v4i_t, Bt[n][0]), __builtin_bit_cast(v4i_t, Bt[n][1]), 0, 1, 2, 3, 4, 5, 6, 7), a8 = __builtin_shufflevector(__builtin_bit_cast(v4i_t, At[m][0]), __builtin_bit_cast(v4i_t, At[m][1]), 0, 1, 2, 3, 4, 5, 6, 7); \
            asm volatile("v_mfma_scale_f32_16x16x128_f8f6f4 %0, %1, %2, %0, %3, %4 op_sel_hi:[0,0,0]" : "+v"(acc[ai][bj][m][n]) : "v"(b8), "v"(a8), "v"(scw_v), "v"(sca_v)); } \
        else { _Pragma("unroll") for (int k = 0; k < 2; ++k) acc[ai][bj][m][n] = __builtin_amdgcn_mfma_f32_16x16x32_bf16(Bt[n][k], At[m][k], acc[ai][bj][m][n], 0, 0, 0); } } __builtin_amdgcn_s_setprio(0); } while (0)
#define PG8_WAIT_V(n) asm volatile("s_waitcnt vmcnt(" #n ")" ::: "memory")
#define PG8_WAIT_L(n) asm volatile("s_waitcnt lgkmcnt(" #n ")" ::: "memory")
#define PG8_BAR __builtin_amdgcn_s_barrier()
#define PG8_SCHED __builtin_amdgcn_sched_barrier(0)
    Unit cur, nxt, pend; int ui = 0; bool have_pend = false;
    if (!S.next(0, cur)) return;
    pend = cur;
    unsigned voC[2][2], voN[2][2];
    if constexpr (GATHER) {
#pragma unroll
        for (int h = 0; h < 2; ++h)
#pragma unroll
            for (int i = 0; i < 2; ++i) { voC[h][i] = (unsigned)(S.gather(cur, h * HALF + RA[i]) * ldab + CA[i] * 2); voN[h][i] = voC[h][i]; }
    } else { voC[0][0] = voN[0][0] = 0u; }
    f32x4 acc[2][2][4][2];
#pragma unroll
    for (int a = 0; a < 2; ++a)
#pragma unroll
        for (int b = 0; b < 2; ++b)
#pragma unroll
            for (int m = 0; m < 4; ++m)
#pragma unroll
                for (int n = 0; n < 2; ++n) acc[a][b][m][n] = (f32x4){0.f, 0.f, 0.f, 0.f};
    bf16x8 At[4][2], B0[2][2], B1[2][2];
    const char* cA = cur.A; const char* cB = cur.B;
    S.a_ready(cur, wid);
    PG8_STAGE_B(PG8_SB(0, 0), cB); PG8_STAGE_B(PG8_SB(0, 1), cB + hstepB); PG8_STAGE_A(PG8_SA(0, 0), cA, (size_t)0, 0, false); PG8_STAGE_A(PG8_SA(0, 1), cA, (size_t)0, 1, false);
    if (wr == 1) PG8_BAR;
    PG8_WAIT_V(2); PG8_BAR;
    PG8_STAGE_B(PG8_SB(1, 0), cB + kstep); PG8_STAGE_A(PG8_SA(1, 0), cA, kstep, 0, false); PG8_STAGE_B(PG8_SB(1, 1), cB + hstepB + kstep);
    PG8_WAIT_V(6); PG8_BAR;
    for (;;) {
        const bool has_next = S.next(ui + 1, nxt);
        if constexpr (GATHER) { if (has_next) {
#pragma unroll
            for (int h = 0; h < 2; ++h)
#pragma unroll
                for (int i = 0; i < 2; ++i) voN[h][i] = (unsigned)(S.gather(nxt, h * HALF + RA[i]) * ldab + CA[i] * 2); } }
        const char* nA = has_next ? nxt.A : cA; const char* nB = has_next ? nxt.B : cB;
        for (int t = 0; t < nt; t += 2) {
            const bool last = (t == nt - 2);
            const size_t k1 = (size_t)(t + 1) * kstep;
            const char* a2 = last ? nA : cA; const size_t k2 = last ? (size_t)0 : (size_t)(t + 2) * kstep; const size_t k3 = k2 + kstep;
            const char* b2 = last ? nB : cB + (size_t)(t + 2) * kstep; const char* b3 = b2 + kstep;
            const bool nx = GATHER ? (last && has_next) : false;
            if (last && has_next) S.a_ready(nxt, wid);
            PG8_LDB(B0, 0, 0); PG8_LDB(B1, 0, 1); PG8_SCHED; PG8_LDA(At, 0, 0); PG8_STAGE_A(PG8_SA(1, 1), cA, k1, 1, false);
            PG8_WAIT_V(8); PG8_WAIT_L(0); PG8_BAR; PG8_MMA(0, 0, At, B0); PG8_MMA(0, 1, At, B1); PG8_BAR; PG8_SCHED;
            PG8_LDA(At, 0, 1); PG8_STAGE_B(PG8_SB(0, 0), b2); PG8_STAGE_B(PG8_SB(0, 1), b2 + hstepB); PG8_STAGE_A(PG8_SA(0, 0), a2, k2, 0, nx);
            PG8_WAIT_V(8); PG8_WAIT_L(0);
            if constexpr (!Sched::IMM_DONE) { if (have_pend) { S.done(pend, lane); have_pend = false; } }
            PG8_BAR; PG8_MMA(1, 0, At, B0); PG8_MMA(1, 1, At, B1); PG8_BAR; PG8_SCHED;
            PG8_LDB(B0, 1, 0); PG8_LDB(B1, 1, 1); PG8_SCHED; PG8_LDA(At, 1, 0); PG8_STAGE_A(PG8_SA(0, 1), a2, k2, 1, nx);
            PG8_WAIT_V(8); PG8_WAIT_L(0); PG8_BAR; PG8_MMA(0, 0, At, B0); PG8_MMA(0, 1, At, B1); PG8_BAR; PG8_SCHED;
            PG8_LDA(At, 1, 1); PG8_STAGE_B(PG8_SB(1, 0), b3); PG8_STAGE_B(PG8_SB(1, 1), b3 + hstepB); PG8_STAGE_A(PG8_SA(1, 0), a2, k3, 0, nx);
            PG8_WAIT_V(8); PG8_WAIT_L(0); PG8_BAR; PG8_MMA(1, 0, At, B0); PG8_MMA(1, 1, At, B1); PG8_BAR; PG8_SCHED;
        }
        if (wr == 0) PG8_BAR;
        if constexpr (FP8) asm volatile("s_nop 15\n\ts_nop 15" ::: "memory");
        E(acc, cur, wr, wc, fr, fq);
        if constexpr (Sched::IMM_DONE) { PG8_WAIT_V(0); S.done(cur, lane); }
        else { pend = cur; have_pend = true; }
        if (!has_next) break;
#pragma unroll
        for (int a = 0; a < 2; ++a)
#pragma unroll
            for (int b = 0; b < 2; ++b)
#pragma unroll
                for (int m = 0; m < 4; ++m)
#pragma unroll
                    for (int n = 0; n < 2; ++n) acc[a][b][m][n] = (f32x4){0.f, 0.f, 0.f, 0.f};
        cur = nxt; cA = nA; cB = nB; ++ui;
        if constexpr (GATHER) {
#pragma unroll
            for (int h = 0; h < 2; ++h)
#pragma unroll
                for (int i = 0; i < 2; ++i) voC[h][i] = voN[h][i]; }
        if (wr == 1) PG8_BAR;
    }
    PG8_WAIT_V(0);
    if constexpr (!Sched::IMM_DONE) { if (have_pend) S.done(pend, lane); }
    PG8_BAR;
#undef PG8_SA
#undef PG8_SB
#undef PG8_GLDS
#undef PG8_STAGE_A
#undef PG8_STAGE_B
#undef PG8_LDA
#undef PG8_LDB
#undef PG8_MMA
#undef PG8_WAIT_V
#undef PG8_WAIT_L
#undef PG8_BAR
#undef PG8_SCHED
}
}
#include <hip/hip_bf16.h>
#include <cmath>
namespace attn_body {
using bf16=__hip_bfloat16;
using bf16x8=__attribute__((ext_vector_type(8)))short;
using s16x4=__attribute__((ext_vector_type(4)))short;
using f32x16=__attribute__((ext_vector_type(16)))float;
using u32x4=__attribute__((ext_vector_type(4)))unsigned;
constexpr int D=64,QP=1024,KVP=256;
constexpr int NW=8,QBLK=32,QB=QBLK*NW,KVBLK=64;
__device__ __forceinline__ int crow(int r,int hi){return (r&3)+8*(r>>2)+4*hi;}
#define SBAR() __builtin_amdgcn_sched_barrier(0)
constexpr int NSLOT=3, SLOTB=8192;
constexpr int LDS_K=0, LDS_V=NSLOT*SLOTB, LDS_WS=2*NSLOT*SLOTB, LDS_OST=LDS_WS+NW*64*4, LDS_BYTES=LDS_OST+NW*4096;
constexpr float C2=0.125f*1.4426950408889634f;
__device__ __forceinline__ void glds16s(const void*sbase,unsigned voff,unsigned lds_dst){unsigned keep;
  asm volatile("s_mov_b32 %0, m0\n\ts_mov_b32 m0, %3\n\ts_nop 4\n\tglobal_load_lds_dwordx4 %1, %2\n\ts_mov_b32 m0, %0":"=&s"(keep):"v"(voff),"s"(sbase),"s"(lds_dst):"memory");}
__device__ __forceinline__ float max3f(float a,float b,float c){float r;asm("v_max3_f32 %0, %1, %2, %3":"=v"(r):"v"(a),"v"(b),"v"(c));return r;}
__device__ __forceinline__ float max2f(float a,float b){float r;asm("v_max_f32_e32 %0, %1, %2":"=v"(r):"v"(a),"v"(b));return r;}
__device__ __forceinline__ float fadd_s(float a,float b){float r;asm("v_add_f32_e32 %0, %1, %2":"=v"(r):"v"(a),"v"(b));return r;}
__device__ __forceinline__ float fsub_s(float a,float b){float r;asm("v_sub_f32_e32 %0, %1, %2":"=v"(r):"v"(a),"v"(b));return r;}
typedef float f32x2_t __attribute__((ext_vector_type(2))); typedef __bf16 bf16x2_t __attribute__((ext_vector_type(2)));
__device__ __forceinline__ unsigned cvtpk_s(float lo,float hi){f32x2_t v={lo,hi};bf16x2_t b=__builtin_convertvector(v,bf16x2_t);return __builtin_bit_cast(unsigned,b);}
#define WAIT_BAR(N) asm volatile("s_waitcnt vmcnt(" #N ") lgkmcnt(0)\n\ts_barrier":::"memory")

__device__ __forceinline__ void qkt(f32x16&p0,f32x16&p1,const char*Kslot,const bf16x8*qr,const f32x16&negm,int r32,int hi){
  const char*kb=Kslot+hi*1024+r32*16;
  #pragma unroll
  for(int d0=0;d0<4;++d0){
    const bf16x8 b0=*reinterpret_cast<const bf16x8*>(kb+d0*2048);
    const bf16x8 b1=*reinterpret_cast<const bf16x8*>(kb+d0*2048+512);
    if(d0==0){p0=__builtin_amdgcn_mfma_f32_32x32x16_bf16(b0,qr[0],negm,0,0,0);p1=__builtin_amdgcn_mfma_f32_32x32x16_bf16(b1,qr[0],negm,0,0,0);}
    else{p0=__builtin_amdgcn_mfma_f32_32x32x16_bf16(b0,qr[d0],p0,0,0,0);p1=__builtin_amdgcn_mfma_f32_32x32x16_bf16(b1,qr[d0],p1,0,0,0);}}
}
typedef __attribute__((address_space(3))) const char* lds_cptr;
typedef short v4i16_t __attribute__((ext_vector_type(4)));
__device__ __forceinline__ void kload8(bf16x8*kf,lds_cptr kp){
  kf[0]=*(const __attribute__((address_space(3))) bf16x8*)(kp);      kf[1]=*(const __attribute__((address_space(3))) bf16x8*)(kp+512);
  kf[2]=*(const __attribute__((address_space(3))) bf16x8*)(kp+2048); kf[3]=*(const __attribute__((address_space(3))) bf16x8*)(kp+2560);
  kf[4]=*(const __attribute__((address_space(3))) bf16x8*)(kp+4096); kf[5]=*(const __attribute__((address_space(3))) bf16x8*)(kp+4608);
  kf[6]=*(const __attribute__((address_space(3))) bf16x8*)(kp+6144); kf[7]=*(const __attribute__((address_space(3))) bf16x8*)(kp+6656);
}
__device__ __forceinline__ void kload2(bf16x8*kf,lds_cptr kp,int j){ kf[2*j]=*(const __attribute__((address_space(3))) bf16x8*)(kp+j*2048); kf[2*j+1]=*(const __attribute__((address_space(3))) bf16x8*)(kp+j*2048+512); }
__device__ __forceinline__ s16x4 vtr(lds_cptr p){ return __builtin_bit_cast(s16x4,__builtin_amdgcn_ds_read_tr16_b64_v4i16((__attribute__((address_space(3))) v4i16_t*)p)); }
__device__ __forceinline__ float rowmax(const f32x16&p0,const f32x16&p1){
  float a=max3f(p0[0],p0[1],p1[0]),b=max3f(p0[2],p0[3],p1[1]);a=max3f(a,p1[2],p1[3]);
  #pragma unroll
  for(int r=4;r<16;r+=4){a=max3f(a,p0[r],p0[r+1]);b=max3f(b,p0[r+2],p0[r+3]);a=max3f(a,p1[r],p1[r+1]);b=max3f(b,p1[r+2],p1[r+3]);}
  const float m=max2f(a,b);
  auto rr=__builtin_amdgcn_permlane32_swap(__float_as_uint(m),__float_as_uint(m),false,false);
  return max2f(__uint_as_float(rr[0]),__uint_as_float(rr[1]));
}
__device__ __forceinline__ void pv(f32x16*o,int vb,bf16x8 pa0,bf16x8 pa1,bf16x8 pa2,bf16x8 pa3){
  #pragma unroll
  for(int d0=0;d0<2;++d0){s16x4 lo[4],hi[4];
    #pragma unroll
    for(int ks=0;ks<4;++ks){
      asm volatile("ds_read_b64_tr_b16 %0,%1 offset:%c2":"=&v"(lo[ks]):"v"(vb),"i"(d0*4096+ks*1024):"memory");
      asm volatile("ds_read_b64_tr_b16 %0,%1 offset:%c2":"=&v"(hi[ks]):"v"(vb),"i"(d0*4096+ks*1024+512):"memory");}
    asm volatile("s_waitcnt lgkmcnt(0)":::"memory");SBAR();
    #define PK(k) (bf16x8){lo[k][0],lo[k][1],lo[k][2],lo[k][3],hi[k][0],hi[k][1],hi[k][2],hi[k][3]}
    o[d0]=__builtin_amdgcn_mfma_f32_32x32x16_bf16(pa0,PK(0),o[d0],0,0,0);
    o[d0]=__builtin_amdgcn_mfma_f32_32x32x16_bf16(pa1,PK(1),o[d0],0,0,0);
    o[d0]=__builtin_amdgcn_mfma_f32_32x32x16_bf16(pa2,PK(2),o[d0],0,0,0);
    o[d0]=__builtin_amdgcn_mfma_f32_32x32x16_bf16(pa3,PK(3),o[d0],0,0,0);
    #undef PK
  }
}

#ifndef ATTN_STORE16
#define ATTN_STORE16(p,v) (*(u32x4*)(p)=(v))
#endif
template<int THRL> __device__ __forceinline__ void attn_unit(long qrow0,int h,long kvrow0,int NT,const bf16*Q,const bf16*__restrict__ K,const bf16*__restrict__ V,bf16*O,char*shm){
  const int tid=tid_opaque(),lane=tid&63,r32=lane&31,hi=lane>>5; const int wid=__builtin_amdgcn_readfirstlane(tid>>6);
  const bf16*Qw=Q+(qrow0+wid*QBLK)*QP+h*D;
  const bf16*Kh=K+kvrow0*KVP+(h>>2)*D,*Vh=V+kvrow0*KVP+(h>>2)*D;
  const unsigned lds0=(unsigned)(uintptr_t)shm;
  float*wsf=(float*)(shm+LDS_WS)+wid*64;
  const unsigned kvo=(unsigned)(lane*KVP+wid*8)*2u;
  const unsigned vvo=(unsigned)((16*(wid&3)+(lane>>2))*KVP+(wid>>2)*32+(lane&3)*8)*2u;
  const unsigned kdst=lds0+LDS_K+wid*1024, vdst=lds0+LDS_V+wid*1024;
  #define DMA_K(t,slot) glds16s(Kh+(long)(t)*KVBLK*KVP,kvo,(unsigned)__builtin_amdgcn_readfirstlane(kdst+(slot)))
  #define DMA_V(t,slot) glds16s(Vh+(long)(t)*KVBLK*KVP,vvo,(unsigned)__builtin_amdgcn_readfirstlane(vdst+(slot)))
  const int vb0=(int)(lds0+LDS_V)+((lane>>4)&1)*32+(lane&3)*8+(4*hi+((lane&15)>>2))*64;
  const char*Kbase=shm+LDS_K; bf16x8 kf[8];
  const lds_cptr shm3=(lds_cptr)shm; const lds_cptr kp0=shm3+LDS_K+hi*1024+r32*16; const lds_cptr vp0=shm3+LDS_V+((lane>>4)&1)*32+(lane&3)*8+(4*hi+((lane&15)>>2))*64;
  DMA_K(0,0);DMA_V(0,0);DMA_K(1,SLOTB);
  bf16x8 qr[4];
  #pragma unroll
  for(int d0=0;d0<4;++d0)qr[d0]=*reinterpret_cast<const bf16x8*>(&Qw[(long)r32*QP+d0*16+hi*8]);
  float mhat=0.f,l_reg=0.f;f32x16 o[2];o[0]=f32x16{};o[1]=f32x16{};f32x16 negm=f32x16{};asm volatile("":"+v"(negm));
  #define CMASK(P0,P1,t) do{}while(0)
  bool resc=false;
  #define START(P0,P1) do{ const float rm=rowmax(P0,P1); resc=false; \
    { const float dl=rm; mhat=fadd_s(mhat,dl); \
      _Pragma("unroll") for(int r=0;r<16;++r){P0[r]=fsub_s(P0[r],dl);P1[r]=fsub_s(P1[r],dl);} \
      _Pragma("unroll") for(int r=0;r<16;++r)negm[r]=-mhat; asm volatile("":"+v"(negm)); } \
    _Pragma("unroll") for(int r=0;r<16;++r)P0[r]=__builtin_amdgcn_exp2f(P0[r]); }while(0)
  #define RESC() do{ if(resc){ asm volatile("s_waitcnt lgkmcnt(0)":::"memory"); \
      _Pragma("unroll") for(int d_=0;d_<2;++d_) _Pragma("unroll") for(int r=0;r<16;++r)o[d_][r]*=wsf[crow(r,hi)]; } }while(0)
  f32x16 pA0,pA1,pB0,pB1;
  int sl_prev=0,sl_cur=0,sl_next=SLOTB;
  #define ROT() do{sl_prev=sl_cur;sl_cur=sl_next;sl_next=(sl_next==(NSLOT-1)*SLOTB)?0:sl_next+SLOTB;}while(0)
  DMA_K(2,2*SLOTB);
  WAIT_BAR(3);
  qkt(pA0,pA1,Kbase,qr,negm,r32,hi);asm volatile("s_nop 15\n\ts_nop 7":"+v"(pA0),"+v"(pA1));CMASK(pA0,pA1,0);
  START(pA0,pA1);
  _Pragma("unroll") for(int r=0;r<16;++r)pA1[r]=__builtin_amdgcn_exp2f(pA1[r]);
  WAIT_BAR(0);
  DMA_K(3,0);DMA_V(1,SLOTB);
  ROT();
  kload8(kf,kp0+sl_cur);
  WAIT_BAR(2);
  s16x4 vlo[8],vhi[8]; u32x4 pw0,pw1,pw2,pw3;
  #define PKW(P,B) cvtpk_s(P[B],P[B+1])
  #define PAF(k) __builtin_bit_cast(bf16x8,pw##k)
  #define VFR(i) (bf16x8){vlo[i][0],vlo[i][1],vlo[i][2],vlo[i][3],vhi[i][0],vhi[i][1],vhi[i][2],vhi[i][3]}
  #define PIN(x) asm volatile("":"+v"(x))
  #define MX3(a,b,c) __builtin_fmaxf(__builtin_fmaxf((a),(b)),(c))
  #define GAPA(MF,A0,A1,A2,A3,W0,W1,PW) do{ MF; sacc+=A0; sacc+=A1; sacc+=A2; sacc+=A3; PIN(sacc); W0; W1; PIN(PW); SBAR(); }while(0)
  #define EX(v) __builtin_amdgcn_exp2f(v)
  #define GAPB(MF,X,B) do{ MF; X[B]=EX(X[B]); X[B+1]=EX(X[B+1]); X[B+2]=EX(X[B+2]); X[B+3]=EX(X[B+3]); PIN(X); SBAR(); }while(0)
  #define VRD(i) do{ vlo[i]=vtr(vp_+(((i)>>2)*4096+((i)&3)*1024)); vhi[i]=vtr(vp_+(((i)>>2)*4096+((i)&3)*1024+512)); }while(0)
  #define KRD(G,j) do{ if(G){ kload2(kf,kp0+sl_next,j); SBAR(); } }while(0)
  #define STEP(C0,C1,P0,P1,t,GK,GV,GL) do{ SBAR(); \
    const lds_cptr vp_=vp0+sl_prev; \
    VRD(0); SBAR(); float sacc=(P0[0]+P0[1]); \
    GAPA(C0=__builtin_amdgcn_mfma_f32_32x32x16_bf16(kf[0],qr[0],negm,0,0,0), P0[2],P0[3],P0[4],P0[5],     pw0[0]=PKW(P0,0), pw0[1]=PKW(P0,2), pw0); \
    VRD(4); SBAR(); GAPA(C1=__builtin_amdgcn_mfma_f32_32x32x16_bf16(kf[1],qr[0],negm,0,0,0), P0[6],P0[7],P0[8],P0[9],     pw0[2]=PKW(P0,4), pw0[3]=PKW(P0,6), pw0); \
    VRD(1); SBAR(); GAPA(C0=__builtin_amdgcn_mfma_f32_32x32x16_bf16(kf[2],qr[1],C0,0,0,0),   P0[10],P0[11],P0[12],P0[13], pw1[0]=PKW(P0,8), pw1[1]=PKW(P0,10), pw1); \
    VRD(5); SBAR(); GAPA(C1=__builtin_amdgcn_mfma_f32_32x32x16_bf16(kf[3],qr[1],C1,0,0,0),   P0[14],P0[15],P1[0],P1[1],   pw1[2]=PKW(P0,12),pw1[3]=PKW(P0,14), pw1); \
    VRD(2); SBAR(); GAPA(C0=__builtin_amdgcn_mfma_f32_32x32x16_bf16(kf[4],qr[2],C0,0,0,0),   P1[2],P1[3],P1[4],P1[5],     pw2[0]=PKW(P1,0), pw2[1]=PKW(P1,2), pw2); \
    VRD(6); SBAR(); GAPA(C1=__builtin_amdgcn_mfma_f32_32x32x16_bf16(kf[5],qr[2],C1,0,0,0),   P1[6],P1[7],P1[8],P1[9],     pw2[2]=PKW(P1,4), pw2[3]=PKW(P1,6), pw2); \
    VRD(3); SBAR(); GAPA(C0=__builtin_amdgcn_mfma_f32_32x32x16_bf16(kf[6],qr[3],C0,0,0,0),   P1[10],P1[11],P1[12],P1[13], pw3[0]=PKW(P1,8), pw3[1]=PKW(P1,10), pw3); \
    VRD(7); SBAR(); GAPA(C1=__builtin_amdgcn_mfma_f32_32x32x16_bf16(kf[7],qr[3],C1,0,0,0),   P1[14],P1[15],0.f,0.f,       pw3[2]=PKW(P1,12),pw3[3]=PKW(P1,14), pw3); \
    l_reg+=sacc; \
    if(GK){DMA_K((t)+3,sl_cur);} if(GV){DMA_V((t)+1,sl_next);} \
    CMASK(C0,C1,t); \
    { float a=MX3(C0[0],C0[1],C1[0]),b=MX3(C0[2],C0[3],C1[1]); a=MX3(a,C1[2],C1[3]); \
      _Pragma("unroll") for(int r=4;r<16;r+=4){a=MX3(a,C0[r],C0[r+1]);b=MX3(b,C0[r+2],C0[r+3]);a=MX3(a,C1[r],C1[r+1]);b=MX3(b,C1[r+2],C1[r+3]);} \
      float rm=__builtin_fmaxf(a,b); { auto rr=__builtin_amdgcn_permlane32_swap(__float_as_uint(rm),__float_as_uint(rm),false,false); rm=__builtin_fmaxf(__uint_as_float(rr[0]),__uint_as_float(rr[1])); } \
      resc=false; \
      if(__builtin_expect(__any(rm>(float)THRL),0)){ const float dl=__builtin_fmaxf(rm,0.f); mhat+=dl; \
        _Pragma("unroll") for(int r=0;r<16;++r){C0[r]-=dl;C1[r]-=dl;} \
        _Pragma("unroll") for(int r=0;r<16;++r)negm[r]=-mhat; asm volatile("":"+v"(negm)); \
        const float f=__builtin_amdgcn_exp2f(-dl); l_reg*=f; if(hi==0)wsf[r32]=f; resc=true; } } \
    SBAR(); \
    GAPB(o[0]=__builtin_amdgcn_mfma_f32_32x32x16_bf16(PAF(0),VFR(0),o[0],0,0,0), C0,0); \
    GAPB(o[1]=__builtin_amdgcn_mfma_f32_32x32x16_bf16(PAF(0),VFR(4),o[1],0,0,0), C0,4); \
    KRD(GL,0); GAPB(o[0]=__builtin_amdgcn_mfma_f32_32x32x16_bf16(PAF(1),VFR(1),o[0],0,0,0), C0,8); \
    KRD(GL,1); GAPB(o[1]=__builtin_amdgcn_mfma_f32_32x32x16_bf16(PAF(1),VFR(5),o[1],0,0,0), C0,12); \
    KRD(GL,2); GAPB(o[0]=__builtin_amdgcn_mfma_f32_32x32x16_bf16(PAF(2),VFR(2),o[0],0,0,0), C1,0); \
    KRD(GL,3); GAPB(o[1]=__builtin_amdgcn_mfma_f32_32x32x16_bf16(PAF(2),VFR(6),o[1],0,0,0), C1,4); \
    GAPB(o[0]=__builtin_amdgcn_mfma_f32_32x32x16_bf16(PAF(3),VFR(3),o[0],0,0,0), C1,8); \
    GAPB(o[1]=__builtin_amdgcn_mfma_f32_32x32x16_bf16(PAF(3),VFR(7),o[1],0,0,0), C1,12); \
    }while(0)
  int t=1;
  for(;t+5<NT;t+=2){
    STEP(pB0,pB1,pA0,pA1,t,true,true,true);     WAIT_BAR(2); RESC(); ROT();
    STEP(pA0,pA1,pB0,pB1,t+1,true,true,true);   WAIT_BAR(2); RESC(); ROT();
  }
  #define ENDW(tt) do{ if((tt)+3<NT){WAIT_BAR(2);} else if((tt)+2<NT){WAIT_BAR(1);} else {WAIT_BAR(0);} }while(0)
  for(;t+1<NT;t+=2){
    STEP(pB0,pB1,pA0,pA1,t,(t+3<NT),(t+1<NT),(t+1<NT));       ENDW(t);   RESC(); ROT();
    STEP(pA0,pA1,pB0,pB1,t+1,(t+4<NT),(t+2<NT),(t+2<NT));     ENDW(t+1); RESC(); ROT();
  }
  STEP(pB0,pB1,pA0,pA1,NT-1,false,false,false); RESC();
  { float sacc=pB0[0]+pB0[1]; _Pragma("unroll") for(int r=2;r<16;++r)sacc+=pB0[r]; _Pragma("unroll") for(int r=0;r<16;++r)sacc+=pB1[r]; l_reg+=sacc;
    pw0=(u32x4){PKW(pB0,0),PKW(pB0,2),PKW(pB0,4),PKW(pB0,6)};pw1=(u32x4){PKW(pB0,8),PKW(pB0,10),PKW(pB0,12),PKW(pB0,14)};pw2=(u32x4){PKW(pB1,0),PKW(pB1,2),PKW(pB1,4),PKW(pB1,6)};pw3=(u32x4){PKW(pB1,8),PKW(pB1,10),PKW(pB1,12),PKW(pB1,14)};
    SBAR(); pv(o,vb0+sl_cur,PAF(0),PAF(1),PAF(2),PAF(3)); }
  #undef PKW
  #undef PAF
  #undef VFR
  #undef PIN
  #undef MX3
  #undef GAPA
  #undef GAPB
  #undef EX
  #undef VRD
  #undef KRD
  #undef STEP
  #undef ENDW
  {auto rr=__builtin_amdgcn_permlane32_swap(__float_as_uint(l_reg),__float_as_uint(l_reg),false,false);l_reg=__uint_as_float(rr[0])+__uint_as_float(rr[1]);}
  if(hi==0)wsf[32+r32]=l_reg;asm volatile("s_waitcnt lgkmcnt(0)":::"memory");
  float rli[16];
  #pragma unroll
  for(int r=0;r<16;++r)rli[r]=__builtin_amdgcn_rcpf(wsf[32+crow(r,hi)]);
#if ATT_FP8
  { unsigned char*Ow8=(unsigned char*)O+(qrow0+wid*QBLK)*QP+h*D;
    unsigned char*stg8=(unsigned char*)(shm+LDS_OST)+wid*4096;
    #pragma unroll
    for(int r=0;r<16;++r){const int orow=crow(r,hi);
      #pragma unroll
      for(int d0=0;d0<2;++d0){const float x=o[d0][r]*rli[r]*(float)(1<<ATT_OSH); stg8[orow*64+d0*32+r32]=(unsigned char)(__builtin_amdgcn_cvt_pk_fp8_f32(x,x,0u,false)&0xffu);}}
    asm volatile("s_waitcnt lgkmcnt(0)":::"memory");
    #pragma unroll
    for(int i=0;i<2;++i){const int row=i*16+(lane>>2),ch=lane&3; const u32x4 v=*(const u32x4*)(stg8+row*64+ch*16); ATTN_STORE16(Ow8+(long)row*QP+ch*16,v);} }
#else
  bf16*Ow=O+(qrow0+wid*QBLK)*QP+h*D;
  { bf16*stg=(bf16*)(shm+LDS_OST)+wid*2048;
    #pragma unroll
    for(int r=0;r<16;++r){const int orow=crow(r,hi);
      #pragma unroll
      for(int d0=0;d0<2;++d0)stg[orow*64+d0*32+r32]=__float2bfloat16(o[d0][r]*rli[r]);}
    asm volatile("s_waitcnt lgkmcnt(0)":::"memory");
    #pragma unroll
    for(int i=0;i<4;++i){const int row=i*8+(lane>>3),ch=lane&7; const u32x4 v=*(const u32x4*)(stg+row*64+ch*8); ATTN_STORE16(Ow+(long)row*QP+ch*8,v);} }
#endif
  asm volatile("s_waitcnt lgkmcnt(0)\n\ts_barrier":::"memory");
  #undef DMA_K
  #undef DMA_V
  #undef CMASK
  #undef START
  #undef RESC
  #undef ROT
}
constexpr int ATTN_LDS_BYTES=LDS_BYTES;
#undef SBAR
#undef WAIT_BAR
}

typedef f32x4 AccT[2][2][4][2];
__device__ __forceinline__ long kv_row(int r) { return r < TL ? (long)(r / SEQ) * KVROWS + CTXL + (r % SEQ) : (long)((r - TL) / CTXL) * KVROWS + ((r - TL) % CTXL); }

struct SchedDense {
    static constexpr bool IMM_DONE = false;
    const char* A; const char* B; size_t astep, bstep, acol; int nM, nN, G, c;
    __device__ __forceinline__ bool next(int i, pg8::Unit& u) const {
        const int L = i * G + c; if (L >= nM * nN) return false;
        pg8::tile_of(L, nM, nN, u.pm, u.pn); u.A = A + (size_t)u.pm * astep + (size_t)u.pn * acol; u.B = B + (size_t)u.pn * bstep; u.x0 = 0; u.x1 = 0; return true; }
    __device__ __forceinline__ int gather(const pg8::Unit&, int) const { return 0; }
    __device__ __forceinline__ void a_ready(const pg8::Unit&, int) const {}
    __device__ __forceinline__ void done(const pg8::Unit&, int) const {}
};
struct SchedDenseR {
    static constexpr bool IMM_DONE = true;
    const char* A; const char* B; size_t astep, bstep, acol; int nM, nN, nF, G, c; unsigned* ready;
    __device__ __forceinline__ bool next(int i, pg8::Unit& u) const {
        const int L = i * G + c, n1 = nF * nN; if (L >= nM * nN) return false;
        if (L < n1) pg8::tile_of(L, nF, nN, u.pm, u.pn); else { u.pm = nF + (L - n1) / nN; u.pn = (L - n1) % nN; }
        u.A = A + (size_t)u.pm * astep + (size_t)u.pn * acol; u.B = B + (size_t)u.pn * bstep; u.x0 = 0; u.x1 = 0; return true; }
    __device__ __forceinline__ int gather(const pg8::Unit&, int) const { return 0; }
    __device__ __forceinline__ void a_ready(const pg8::Unit&, int) const {}
    __device__ __forceinline__ void done(const pg8::Unit& u, int lane) const { if (lane == 0) __hip_atomic_fetch_add(ready + u.pm, 1u, __ATOMIC_RELAXED, __HIP_MEMORY_SCOPE_AGENT); }
};
struct SchedOutproj {
    static constexpr bool IMM_DONE = true;
    const char* A; const char* B; size_t astep, bstep; int G, c; const unsigned* rdg; unsigned* ready;
    __device__ __forceinline__ bool next(int i, pg8::Unit& u) const {
        int n;
        if (G == 256) { if (c >= 32) { if (i == 0) n = c - 32; else if (i == 1 && c < 64) n = 224 + (c - 32); else return false; } else { if (i == 0 && c < 16) n = 256 + c; else return false; } }
        else { n = i * G + c; if (n >= 272) return false; }
        u.pm = n >> 2; u.pn = n & 3; u.A = A + (size_t)u.pm * astep; u.B = B + (size_t)u.pn * bstep; u.x0 = 0; u.x1 = 0; return true; }
    __device__ __forceinline__ int gather(const pg8::Unit&, int) const { return 0; }
    __device__ __forceinline__ void a_ready(const pg8::Unit& u, int wid) const {
        if (wid == 0) { unsigned sp = 0;
            while ((unsigned)__builtin_amdgcn_readfirstlane(__hip_atomic_load(rdg + u.pm, __ATOMIC_RELAXED, __HIP_MEMORY_SCOPE_AGENT)) < 8u) { __builtin_amdgcn_s_sleep(2); if (++sp > (1u << 22)) break; }
            __builtin_amdgcn_fence(__ATOMIC_ACQUIRE, "agent"); asm volatile("s_waitcnt vmcnt(0)" ::: "memory"); }
        __builtin_amdgcn_s_barrier(); asm volatile("" ::: "memory");
    }
    __device__ __forceinline__ void done(const pg8::Unit& u, int lane) const { if (lane == 0) __hip_atomic_fetch_add(ready + u.pm, 1u, __ATOMIC_RELAXED, __HIP_MEMORY_SCOPE_AGENT); }
};
struct SchedQKV {
    static constexpr bool IMM_DONE = false;
    const char* A; const char* B; size_t tstep; int ctxq, G, c;
    __device__ __forceinline__ bool next(int i, pg8::Unit& u) const {
        const int L = i * G + c, n1 = 64 * 6, n2 = ctxq ? 24 : 8; if (L >= n1 + n2) return false;
        if (L < n1) pg8::tile_of(L, 64, 6, u.pm, u.pn);
        else if (ctxq) { pg8::tile_of(L - n1, 4, 6, u.pm, u.pn); u.pm += 64; }
        else { u.pm = 64 + ((L - n1) >> 1); u.pn = 4 + ((L - n1) & 1); }
        u.A = A + (size_t)u.pm * tstep; u.B = B + (size_t)u.pn * tstep; u.x0 = 0; u.x1 = 0; return true; }
    __device__ __forceinline__ int gather(const pg8::Unit&, int) const { return 0; }
    __device__ __forceinline__ void a_ready(const pg8::Unit&, int) const {}
    __device__ __forceinline__ void done(const pg8::Unit&, int) const {}
};
struct SchedMoe {
    static constexpr bool IMM_DONE = false;
    const char* Abase; size_t astep; const char* Bbase; size_t bstep_e, bstep_n; const LAS int* tab; const int* list; int G, c;
    unsigned* ready; int mode;
    __device__ __forceinline__ int T(int i) const { return __builtin_amdgcn_readfirstlane(tab[i]); }
    __device__ __forceinline__ bool next(int i, pg8::Unit& u) const {
        const int ntiles = T(32), L = i * G + (mode == 2 ? G - 1 - c : c); if (L >= ntiles * 4) return false;
        int gt, pn; pg8::tile_of(L, ntiles, 4, gt, pn);
        int e = 0;
        for (int q = 1; q < 32; ++q) e += (T(q) <= gt) ? 1 : 0;
        const int ti = gt - T(e); int valid = T(40 + e) - ti * 256; valid = valid > 256 ? 256 : valid;
        u.pm = gt; u.pn = pn; u.x0 = e * MOE_CAP + ti * 256; u.x1 = valid;
        u.A = Abase + (size_t)gt * astep; u.B = Bbase + (size_t)e * bstep_e + (size_t)pn * bstep_n; return true; }
    __device__ __forceinline__ int gather(const pg8::Unit& u, int lr) const { return lr < u.x1 ? (list[u.x0 + lr] >> 1) : 0; }
    __device__ __forceinline__ void a_ready(const pg8::Unit& u, int wid) const {
        if (mode != 2) return;
        if (wid == 0) { unsigned sp = 0;
            while ((unsigned)__builtin_amdgcn_readfirstlane(__hip_atomic_load(ready + u.pm, __ATOMIC_RELAXED, __HIP_MEMORY_SCOPE_AGENT)) < 32u) { __builtin_amdgcn_s_sleep(2); if (++sp > (1u << 22)) break; }
            __builtin_amdgcn_fence(__ATOMIC_ACQUIRE, "agent"); asm volatile("s_waitcnt vmcnt(0)" ::: "memory"); }
        __builtin_amdgcn_s_barrier(); asm volatile("" ::: "memory");
    }
    __device__ __forceinline__ void done(const pg8::Unit& u, int lane) const {
        if (mode != 1) return;
        if (lane == 0) __hip_atomic_fetch_add(ready + u.pm, 1u, __ATOMIC_RELAXED, __HIP_MEMORY_SCOPE_AGENT);
    }
};

struct EpiQKV { static constexpr bool PERM = true; bf16* Q; bf16* Kb; bf16* Vb; const float* qg; const float* kg; const f32x2* tab;
    __device__ __forceinline__ void operator()(const AccT& acc, const pg8::Unit& u, int wr, int wc, int fr, int fq) const {
        bf16* base; int pitch; long row0;
        if (u.pn < 4) { base = Q + u.pn * 256; pitch = 1024; row0 = (long)u.pm * 256; }
        else { base = (u.pn == 4) ? Kb : Vb; pitch = 256; row0 = kv_row(u.pm * 256); }
        const bool isv = u.pn == 5, lat = u.pm < 64; const float* g = u.pn < 4 ? qg : kg; const float post = u.pn < 4 ? 0.125f * 1.4426950408889634f : 1.0f;
#pragma unroll
        for (int ai = 0; ai < 2; ++ai)
#pragma unroll
            for (int m = 0; m < 4; ++m) { int fq_ = fq; asm volatile("" : "+v"(fq_));
                const int fq = fq_; const int lr = ai * 128 + wr * 64 + m * 16 + fr; const unsigned roff = (unsigned)(((int)row0 + lr) * pitch + wc * 64 + 8 * fq) * 2u;
                f32x4 g0[2], g1[2];
#pragma unroll
                for (int bj = 0; bj < 2; ++bj) { g0[bj] = *(const f32x4*)(g + 32 * bj + 8 * fq); g1[bj] = *(const f32x4*)(g + 32 * bj + 8 * fq + 4); }
                f32x4 v[2][2];
#pragma unroll
                for (int bj = 0; bj < 2; ++bj) { v[bj][0] = acc[ai][bj][m][0]; v[bj][1] = acc[ai][bj][m][1]; }
                if (!isv) {
                    float ss = 0.f;
#pragma unroll
                    for (int bj = 0; bj < 2; ++bj)
#pragma unroll
                        for (int n = 0; n < 2; ++n) ss += (v[bj][n][0] * v[bj][n][0] + v[bj][n][1] * v[bj][n][1]) + (v[bj][n][2] * v[bj][n][2] + v[bj][n][3] * v[bj][n][3]);
                    ss += __shfl_xor(ss, 16); ss += __shfl_xor(ss, 32);
                    const float rstd = rsqrtf(ss * (1.0f / 64.0f) + EPS);
#pragma unroll
                    for (int bj = 0; bj < 2; ++bj) { v[bj][0] = v[bj][0] * rstd * g0[bj]; v[bj][1] = v[bj][1] * rstd * g1[bj]; }
                    if (lat) { const int t = (u.pm * 256 + lr) & (SEQ - 1);
#pragma unroll
                        for (int bj = 0; bj < 2; ++bj) { const f32x2* tb = (const f32x2*)((const char*)tab + (unsigned)(((bj == 0 ? (t >> 6) : (t & 63)) * 16 + 4 * fq) * 8));
#pragma unroll
                            for (int n = 0; n < 2; ++n)
#pragma unroll
                                for (int e = 0; e < 2; ++e) { const f32x2 cs = tb[2 * n + e]; const float x0 = v[bj][n][2 * e], x1 = v[bj][n][2 * e + 1];
                                    v[bj][n][2 * e] = x0 * cs.x - x1 * cs.y; v[bj][n][2 * e + 1] = x0 * cs.y + x1 * cs.x; } } }
#pragma unroll
                    for (int bj = 0; bj < 2; ++bj) { v[bj][0] = v[bj][0] * post; v[bj][1] = v[bj][1] * post; }
                }
#pragma unroll
                for (int bj = 0; bj < 2; ++bj)
                    *(u32x4*)((char*)base + roff + bj * 64) = (u32x4){cvtpk(v[bj][0][0], v[bj][0][1]), cvtpk(v[bj][0][2], v[bj][0][3]), cvtpk(v[bj][1][0], v[bj][1][1]), cvtpk(v[bj][1][2], v[bj][1][3])}; }
    }
};
struct EpiResid { static constexpr bool PERM = false; const Args* a; int layer; const float* pscale; const float* srcbase;
    __device__ __forceinline__ void operator()(const AccT& acc, const pg8::Unit& u, int wr, int wc, int, int) const {
        int ln = (int)__builtin_amdgcn_mbcnt_hi(~0u, __builtin_amdgcn_mbcnt_lo(~0u, 0u)); asm volatile("" : "+v"(ln)); const int fr = ln & 15, fq = ln >> 4;
        const int r0 = u.pm * 256;
        const float* src = srcbase ? srcbase + (size_t)r0 * D : resid_row(*a, layer, r0); const float* gate = mod_row(*a, layer, r0) + 2 * D;
        const __amdgpu_buffer_rsrc_t rs = __builtin_amdgcn_make_buffer_rsrc((void*)(a->ws + WS_X), 0, TT * D * 4, 0x00020000);
        const int col0 = u.pn * 256 + wc * 32 + 4 * fq;
#pragma unroll
        for (int bj = 0; bj < 2; ++bj)
#pragma unroll
            for (int n = 0; n < 2; ++n) { const int cc = col0 + bj * 128 + n * 16; f32x4 g = *(const f32x4*)(gate + cc); if (pscale) g = g * *(const f32x4*)(pscale + cc);
#pragma unroll
                for (int ai = 0; ai < 2; ++ai)
#pragma unroll
                    for (int m = 0; m < 4; ++m) { const int off = (ai * 128 + wr * 64 + m * 16 + fr) * D + cc;
                        const f32x4 o = *(const f32x4*)(src + off) + g * acc[ai][bj][m][n];
                        __builtin_amdgcn_raw_buffer_store_b128(__builtin_bit_cast(u32x4, o), rs, (r0 * D + off) * 4, 0, 16  ); }
                asm volatile("" ::: "memory"); }
    }
};
struct EpiGateUp { static constexpr bool PERM = true; bf16* act;
    __device__ __forceinline__ void operator()(const AccT& acc, const pg8::Unit& u, int wr, int wc, int fr, int fq) const {
        const __amdgpu_buffer_rsrc_t rs = __builtin_amdgcn_make_buffer_rsrc((void*)act, 0, 43008 * 512 * 2, 0x00020000);
#pragma unroll
        for (int ai = 0; ai < 2; ++ai)
#pragma unroll
            for (int m = 0; m < 4; ++m) { const int off = (int)((((size_t)u.pm * 256 + ai * 128 + wr * 64 + m * 16 + fr) * 512 + u.pn * 128 + wc * 32 + 8 * fq) * 2);
                const f32x4 g0 = acc[ai][0][m][0], g1 = acc[ai][0][m][1], u0 = acc[ai][1][m][0], u1 = acc[ai][1][m][1];
                const u32x4 ov = (u32x4){cvtpk(silu_f(g0[0]) * u0[0], silu_f(g0[1]) * u0[1]), cvtpk(silu_f(g0[2]) * u0[2], silu_f(g0[3]) * u0[3]),
                                     cvtpk(silu_f(g1[0]) * u1[0], silu_f(g1[1]) * u1[1]), cvtpk(silu_f(g1[2]) * u1[2], silu_f(g1[3]) * u1[3])};
#if MOE_FP8
                { const float sa = (float)(1 << MOE_ASH); const u32x2 o8 = (u32x2){pk_fp8x4(silu_f(g0[0]) * u0[0] * sa, silu_f(g0[1]) * u0[1] * sa, silu_f(g0[2]) * u0[2] * sa, silu_f(g0[3]) * u0[3] * sa),
                                                                                    pk_fp8x4(silu_f(g1[0]) * u1[0] * sa, silu_f(g1[1]) * u1[1] * sa, silu_f(g1[2]) * u1[2] * sa, silu_f(g1[3]) * u1[3] * sa)};
                  (void)ov; __builtin_amdgcn_raw_buffer_store_b64(o8, rs, off >> 1, 0, 16  ); } }
#else
                __builtin_amdgcn_raw_buffer_store_b128(ov, rs, off, 0, 16  ); }
#endif
    }
};
struct EpiDown { static constexpr bool PERM = true; const int* list; const float* w2; bf16* y2;
    __device__ __forceinline__ void operator()(const AccT& acc, const pg8::Unit& u, int wr, int wc, int fr, int fq) const {
#pragma unroll
        for (int ai = 0; ai < 2; ++ai)
#pragma unroll
            for (int m = 0; m < 4; ++m) { const int lr = ai * 128 + wr * 64 + m * 16 + fr;
                if (lr < u.x1) { const int dest = list[u.x0 + lr]; const float w = w2[dest]; bf16* p = y2 + (size_t)dest * D + u.pn * 256 + wc * 32 + 8 * fq;
#pragma unroll
                    for (int bj = 0; bj < 2; ++bj) { const f32x4 v0 = acc[ai][bj][m][0] * w, v1 = acc[ai][bj][m][1] * w;
                        *(u32x4*)(p + bj * 128) = (u32x4){cvtpk(v0[0], v0[1]), cvtpk(v0[2], v0[3]), cvtpk(v1[0], v1[1]), cvtpk(v1[2], v1[3])}; } } }
    }
};

constexpr int TAB_OFF = 135168;

__device__ __forceinline__ void ph_rope(const Args& a, const Ctx& c, int layer) {
    const int j = layer == 0 ? 0 : 1; const bool ctxq = layer == 0;
    const float* qg = a.in[I_QG] + j * 64; const float* kg = a.in[I_KG] + j * 64;
    const f32x2* tab = (const f32x2*)(a.ws + WS_ROPE);
    bf16* Qb = (bf16*)(a.ws + WS_Q); bf16* Kb = (bf16*)(a.ws + WS_K);
    const int nitems = TT * 20;
    for (int it = blockIdx.x * NTHREADS + c.tid; it < nitems; it += c.G * NTHREADS) {
        const int r = it / 20, hs = it % 20;
        if (hs < 16 && r >= TL && !ctxq) continue;
        bf16* p; const float* g; float post;
        if (hs < 16) { p = Qb + (size_t)r * 1024 + hs * 64; g = qg; post = 0.125f * 1.4426950408889634f; } else { p = Kb + kv_row(r) * 256 + (hs - 16) * 64; g = kg; post = 1.0f; }
        float x[64]; float ss = 0.f;
#pragma unroll
        for (int i = 0; i < 8; ++i) { const u32x4 w = ((const u32x4*)p)[i];
            x[8 * i + 0] = bflo(w.x); x[8 * i + 1] = bfhi(w.x); x[8 * i + 2] = bflo(w.y); x[8 * i + 3] = bfhi(w.y);
            x[8 * i + 4] = bflo(w.z); x[8 * i + 5] = bfhi(w.z); x[8 * i + 6] = bflo(w.w); x[8 * i + 7] = bfhi(w.w); }
#pragma unroll
        for (int i = 0; i < 64; ++i) ss += x[i] * x[i];
        const float rstd = rsqrtf(ss * (1.0f / 64.0f) + EPS);
#pragma unroll
        for (int i = 0; i < 64; ++i) x[i] = x[i] * rstd * g[i];
        if (r < TL) { const int t = r % SEQ, rp = t >> 6, cp = t & 63;
#pragma unroll
            for (int i = 0; i < 32; ++i) { const f32x2 cs = tab[(i < 16 ? rp : cp) * 16 + (i & 15)]; const float x0 = x[2 * i], x1 = x[2 * i + 1];
                x[2 * i] = x0 * cs.x - x1 * cs.y; x[2 * i + 1] = x0 * cs.y + x1 * cs.x; } }
#pragma unroll
        for (int i = 0; i < 8; ++i) ((u32x4*)p)[i] = (u32x4){cvtpk(x[8 * i] * post, x[8 * i + 1] * post), cvtpk(x[8 * i + 2] * post, x[8 * i + 3] * post),
                                                            cvtpk(x[8 * i + 4] * post, x[8 * i + 5] * post), cvtpk(x[8 * i + 6] * post, x[8 * i + 7] * post)};
    }
}

__device__ __forceinline__ void ph_att(const Args& a, const Ctx& c, int layer, char* lds_generic) {
    const int nun = 1024 + (layer == 0 ? 64 : 0);
    const attn_body::bf16* Qb = (const attn_body::bf16*)(a.ws + WS_Q); const attn_body::bf16* Kb = (const attn_body::bf16*)(a.ws + WS_K); const attn_body::bf16* Vb = (const attn_body::bf16*)(a.ws + WS_V);
    for (int U = c.vcu; U < nun; U += c.G) {
        long qrow0, kv0; int h, NT;
        if (U < 1024) { const int bh = U >> 4, qb = U & 15, b = bh >> 4; h = bh & 15; qrow0 = (long)b * SEQ + qb * 256; kv0 = (long)b * KVROWS; NT = KVROWS / 64; }
        else { const int q = U - 1024, b = q >> 4; h = q & 15; qrow0 = (long)TL + b * CTXL; kv0 = (long)b * KVROWS; NT = CTXL / 64; }
        attn_body::attn_unit<8>(qrow0, h, kv0, NT, Qb, Kb, Vb, (attn_body::bf16*)(a.ws + WS_HB), lds_generic);
    }
}

__device__ __forceinline__ void ph_m1(const Args& a, const Ctx& c, int layer, const unsigned* rdy, int nN, int amode) {
    const int Tm = layer == 3 ? TL : TT, ntiles = Tm / 32;
    int tl0, tl1, tl2;
    { int bid = (int)blockIdx.x; asm volatile("" : "+s"(bid));
      if (amode == 1 && c.G == 256 && ntiles == 544) {
          int k = c.vcu - 64; asm volatile("" : "+s"(k));
          if (k < 0) { tl0 = -1; tl1 = -1; tl2 = -1; } else { tl0 = k; tl1 = k + 192; tl2 = k < 64 ? k + 384 : (k < 160 ? 448 + (k - 64) : -1); } }
      else if (c.G == 256 && ntiles == 544) { if (bid < 16) { tl0 = 512 + bid; tl1 = -1; tl2 = -1; } else { const int j = bid - 16; tl0 = j; tl1 = j + 240; tl2 = j < 32 ? j + 480 : (j < 48 ? 528 + (j - 32) : -1); } }
      else { tl0 = bid < ntiles ? bid : -1; tl1 = bid + c.G < ntiles ? bid + c.G : -1; tl2 = bid + 2 * c.G < ntiles ? bid + 2 * c.G : -1; } }
    const unsigned need = 8u * (unsigned)nN;
#define M1_WAIT(tl) do { if (c.wave == 0) { unsigned sp_ = 0; \
        while ((unsigned)__builtin_amdgcn_readfirstlane(__hip_atomic_load(rdy + ((tl) >> 3), __ATOMIC_RELAXED, __HIP_MEMORY_SCOPE_AGENT)) < need) { __builtin_amdgcn_s_sleep(2); if (++sp_ > (1u << 22)) break; } \
        __builtin_amdgcn_fence(__ATOMIC_ACQUIRE, "agent"); asm volatile("s_waitcnt vmcnt(0)" ::: "memory"); } \
        __syncthreads(); } while (0)
    const float* g = a.in[I_NFFN] + layer * D;
    constexpr int RP = 2064;
    LAS unsigned char* hiT = c.lds; LAS unsigned char* loT = c.lds + 32 * RP;
    LAS float* part = (LAS float*)c.lds;
    LAS int* lcnt = (LAS int*)(c.lds + 133120); LAS int* lbase = lcnt + 32;
    LAS float* logit = (LAS float*)(c.lds + 134144);
    const bf16* wr = (const bf16*)(a.ws + WS_WR) + (size_t)layer * 2 * 65536;
    unsigned* gcnt = (unsigned*)(a.ws + WS_CTL) + CW_CNT + layer * 32;
    int* list = (int*)(a.ws + WS_LIST); float* w2 = (float*)(a.ws + WS_W2);
    const int r32 = c.lane & 31, hi = c.lane >> 5;
    if (c.tid < 32) lcnt[c.tid] = 0;
    f32x4 vv[4][4];
#define M1_LOADROWS(tl) do { _Pragma("unroll") for (int i = 0; i < 4; ++i) { const f32x4* xr = (const f32x4*)((const float*)(a.ws + WS_X) + (size_t)((tl) * 32 + 4 * c.wave + i) * D) + c.lane; \
        _Pragma("unroll") for (int j = 0; j < 4; ++j) vv[i][j] = xr[64 * j]; } } while (0)
    if (tl0 >= 0) { M1_WAIT(tl0); M1_LOADROWS(tl0); }
    int nmine = 0;
    for (; nmine < 3; ++nmine) { const int tile = nmine == 0 ? tl0 : nmine == 1 ? tl1 : tl2, tnext = nmine == 0 ? tl1 : nmine == 1 ? tl2 : -1;
        if (tile < 0) break;
        const int r0 = tile * 32;
        { f32x4 gs[4], sh[4];
          { const float* m = mod_row(a, layer, r0);
#pragma unroll
            for (int j = 0; j < 4; ++j) { gs[j] = ((const f32x4*)g)[c.lane + 64 * j] * (((const f32x4*)(m + 4 * D))[c.lane + 64 * j] + 1.0f); sh[j] = ((const f32x4*)(m + 3 * D))[c.lane + 64 * j]; } }
#pragma unroll
          for (int i = 0; i < 4; ++i) { const int lr = 4 * c.wave + i, r = r0 + lr;
            f32x4 h[4];
            const float rstd = row_rstd(vv[i]);
#pragma unroll
            for (int j = 0; j < 4; ++j) h[j] = (vv[i][j] * rstd) * gs[j] + sh[j];
#if MOE_FP8
            unsigned* to8 = (unsigned*)((unsigned char*)(a.ws + WS_TK) + (size_t)r * D) + c.lane;
#else
            u32x2* to = (u32x2*)((bf16*)(a.ws + WS_TK) + (size_t)r * D) + c.lane;
#endif
#pragma unroll
            for (int j = 0; j < 4; ++j) { const unsigned h0 = cvtpk(h[j].x, h[j].y), h1 = cvtpk(h[j].z, h[j].w);
                const unsigned l0 = cvtpk(h[j].x - bflo(h0), h[j].y - bfhi(h0)), l1 = cvtpk(h[j].z - bflo(h1), h[j].w - bfhi(h1));
#if MOE_FP8
                to8[64 * j] = pk_fp8x4(h[j].x, h[j].y, h[j].z, h[j].w);
#else
                to[64 * j] = (u32x2){h0, h1};
#endif
                *(LAS u32x2*)(hiT + lr * RP + (4 * c.lane + 256 * j) * 2) = (u32x2){h0, h1};
                *(LAS u32x2*)(loT + lr * RP + (4 * c.lane + 256 * j) * 2) = (u32x2){l0, l1}; } } }
        __syncthreads();
        f32x16 acc0 = {}, acc1 = {};
#pragma unroll
        for (int kk = 0; kk < 8; ++kk) { const int k0 = 128 * c.wave + 16 * kk + 8 * hi;
            const bf16x8 ahi = *(const LAS bf16x8*)(hiT + r32 * RP + k0 * 2), alo = *(const LAS bf16x8*)(loT + r32 * RP + k0 * 2);
            const bf16x8 b0h = *(const bf16x8*)(wr + r32 * 1024 + k0), b1h = *(const bf16x8*)(wr + (32 + r32) * 1024 + k0);
            const bf16x8 b0l = *(const bf16x8*)(wr + 65536 + r32 * 1024 + k0), b1l = *(const bf16x8*)(wr + 65536 + (32 + r32) * 1024 + k0);
            acc0 = __builtin_amdgcn_mfma_f32_32x32x16_bf16(ahi, b0h, acc0, 0, 0, 0); acc1 = __builtin_amdgcn_mfma_f32_32x32x16_bf16(ahi, b1h, acc1, 0, 0, 0);
            acc0 = __builtin_amdgcn_mfma_f32_32x32x16_bf16(alo, b0h, acc0, 0, 0, 0); acc1 = __builtin_amdgcn_mfma_f32_32x32x16_bf16(alo, b1h, acc1, 0, 0, 0);
            acc0 = __builtin_amdgcn_mfma_f32_32x32x16_bf16(ahi, b0l, acc0, 0, 0, 0); acc1 = __builtin_amdgcn_mfma_f32_32x32x16_bf16(ahi, b1l, acc1, 0, 0, 0); }
        if (tnext >= 0) { M1_WAIT(tnext); M1_LOADROWS(tnext); }
        else __syncthreads();
#pragma unroll
        for (int reg = 0; reg < 16; ++reg) { part[((c.wave * 2 + 0) * 16 + reg) * 64 + c.lane] = acc0[reg]; part[((c.wave * 2 + 1) * 16 + reg) * 64 + c.lane] = acc1[reg]; }
        __syncthreads();
        if (nmine < 3) {
#pragma unroll
            for (int q = 0; q < 4; ++q) { const int idx = c.tid + 512 * q, nt = idx >> 10, reg = (idx >> 6) & 15, ln = idx & 63; float s = 0.f;
#pragma unroll
                for (int w = 0; w < 8; ++w) s += part[((w * 2 + nt) * 16 + reg) * 64 + ln];
                logit[(nmine * 32 + (reg & 3) + 8 * (reg >> 2) + 4 * (ln >> 5)) * 64 + nt * 32 + (ln & 31)] = s; } }
        __syncthreads();
    }
#undef M1_LOADROWS
#undef M1_WAIT
    int e0 = 0, e1 = 0, p0 = 0, p1 = 0; float w0 = 0.f, w1 = 0.f; const int myt = c.tid >> 5; const bool act_r = c.tid < 96 && myt < nmine;
    if (act_r) { const LAS float* lg = logit + c.tid * 64;
        int grp = 0; float gm = lg[0];
#pragma unroll
        for (int q = 1; q < 4; ++q) if (lg[q] > gm) { gm = lg[q]; grp = q; }
        float den = 0.f;
#pragma unroll
        for (int q = 0; q < 4; ++q) den += expf(lg[q] - gm);
        const float gate = 1.0f / den;
        const LAS float* le = lg + 4 + grp * 8;
        int i0 = 0; float v0 = le[0];
#pragma unroll
        for (int q = 1; q < 8; ++q) if (le[q] > v0) { v0 = le[q]; i0 = q; }
        int i1 = -1; float v1 = -3.0e38f;
#pragma unroll
        for (int q = 0; q < 8; ++q) if (q != i0 && le[q] > v1) { v1 = le[q]; i1 = q; }
        const float ex = expf(v1 - v0); w0 = gate / (1.0f + ex); w1 = gate * ex / (1.0f + ex);
        e0 = grp * 8 + i0; e1 = grp * 8 + i1;
        p0 = __hip_atomic_fetch_add(lcnt + e0, 1, __ATOMIC_RELAXED, __HIP_MEMORY_SCOPE_WORKGROUP);
        p1 = __hip_atomic_fetch_add(lcnt + e1, 1, __ATOMIC_RELAXED, __HIP_MEMORY_SCOPE_WORKGROUP); }
    __syncthreads();
    if (c.tid < 32) { const int n = lcnt[c.tid]; lbase[c.tid] = n ? (int)__hip_atomic_fetch_add(gcnt + c.tid, (unsigned)n, __ATOMIC_RELAXED, __HIP_MEMORY_SCOPE_AGENT) : 0; }
    __syncthreads();
    if (act_r) { const int r = (myt == 0 ? tl0 : myt == 1 ? tl1 : tl2) * 32 + (c.tid & 31);
        list[e0 * MOE_CAP + lbase[e0] + p0] = 2 * r; w2[2 * r] = w0;
        list[e1 * MOE_CAP + lbase[e1] + p1] = 2 * r + 1; w2[2 * r + 1] = w1; }
    __syncthreads();
}
__device__ __forceinline__ void moe_tables(const Args& a, const Ctx& c, int layer, LAS int* tab) {
    unsigned* gcnt = (unsigned*)(a.ws + WS_CTL) + CW_CNT + layer * 32;
    if (c.tid < 32) tab[40 + c.tid] = (int)__hip_atomic_load(gcnt + c.tid, __ATOMIC_RELAXED, __HIP_MEMORY_SCOPE_AGENT);
    __syncthreads();
    if (c.tid == 0) { int s = 0; for (int e = 0; e < 32; ++e) { tab[e] = s; s += (tab[40 + e] + 255) >> 8; } tab[32] = s; }
    __syncthreads();
}

__device__ __forceinline__ void ph_rpool(const Args& a, const Ctx& c, int layer) {
    LAS unsigned char* hs = c.lds;
    const float* g = a.in[I_NMIX] + layer * D;
    for (int tile = blockIdx.x; tile < TT / 32; tile += c.G) {
        const int r0 = tile * 32;
        const int s0 = r0 < TL ? (r0 / SEQ) * SEQ : TL + ((r0 - TL) / CTXL) * CTXL, s1 = s0 + (r0 < TL ? SEQ : CTXL);
        for (int lr = c.wave; lr < 47; lr += NWAVES) { const int gr = r0 - 8 + lr; if (gr < s0 || gr >= s1) continue;
            f32x4 v[4], h[4]; load_row_combined(a, layer, gr, c.lane, v);
            if (lr >= 8 && lr < 40) { f32x4* xo = (f32x4*)((float*)(a.ws + WS_Z) + (size_t)gr * D) + c.lane;
#pragma unroll
                for (int j = 0; j < 4; ++j) xo[64 * j] = v[j]; }
            const float rstd = row_rstd(v); const float* m = mod_row(a, layer, gr);
            norm_mod(v, rstd, g, m, m + D, c.lane, h);
#pragma unroll
            for (int j = 0; j < 4; ++j) *(LAS u32x2*)(hs + lr * 2048 + (4 * c.lane + 256 * j) * 2) = (u32x2){cvtpk(h[j].x, h[j].y), cvtpk(h[j].z, h[j].w)}; }
        __syncthreads();
        { const int half = 1 << (c.tid >> 7);
          const LAS unsigned* col = (const LAS unsigned*)hs + c.tid;
          float sx = 0.f, sy = 0.f;
          { const int lo = (r0 - half) > s0 ? (r0 - half) : s0, hi = (r0 + half) < s1 ? (r0 + half) : s1;
            for (int gr = lo; gr < hi; ++gr) { const unsigned u = col[(gr - r0 + 8) * 512]; sx += bflo(u); sy += bfhi(u); } }
          unsigned* ho = (unsigned*)((bf16*)(a.ws + WS_HB) + (size_t)r0 * D) + c.tid;
          for (int t = 0; t < 32; ++t) { const int gr = r0 + t; const int lo = (gr - half) > s0 ? (gr - half) : s0, hi = (gr + half) < s1 ? (gr + half) : s1;
              const float inv = __builtin_amdgcn_rcpf((float)(hi - lo)); const unsigned u = col[(t + 8) * 512];
              ho[t * 512] = cvtpk(sx * inv - bflo(u), sy * inv - bfhi(u));
              if (t < 31) { if (gr + half < s1) { const unsigned w = col[(t + 8 + half) * 512]; sx += bflo(w); sy += bfhi(w); }
                            if (gr - half >= s0) { const unsigned w = col[(t + 8 - half) * 512]; sx -= bflo(w); sy -= bfhi(w); } } } }
        __syncthreads();
    }
}

struct EpiInproj { static constexpr bool PERM = true; bf16* Z; bf16* XBC; float* DT; const float* dtb;
    __device__ __forceinline__ void operator()(const AccT& acc, const pg8::Unit& u, int wr, int wc, int fr, int fq) const {
        const size_t r0 = (size_t)u.pm * 256;
        if (u.pn < 20) { bf16* base; int pitch; if (u.pn < 8) { base = Z + u.pn * 256; pitch = 2048; } else { base = XBC + (u.pn - 8) * 256; pitch = 3072; }
#pragma unroll
            for (int ai = 0; ai < 2; ++ai)
#pragma unroll
                for (int m = 0; m < 4; ++m) { bf16* rowp = base + (r0 + ai * 128 + wr * 64 + m * 16 + fr) * pitch + wc * 32 + 8 * fq;
#pragma unroll
                    for (int bj = 0; bj < 2; ++bj) { const f32x4 v0 = acc[ai][bj][m][0], v1 = acc[ai][bj][m][1];
                        *(u32x4*)(rowp + bj * 128) = (u32x4){cvtpk(v0[0], v0[1]), cvtpk(v0[2], v0[3]), cvtpk(v1[0], v1[1]), cvtpk(v1[2], v1[3])}; } }
        } else if (wc < 2) { const int col = wc * 32 + 8 * fq; const f32x4 b0 = *(const f32x4*)(dtb + col), b1 = *(const f32x4*)(dtb + col + 4);
#pragma unroll
            for (int ai = 0; ai < 2; ++ai)
#pragma unroll
                for (int m = 0; m < 4; ++m) { float* p = DT + (r0 + ai * 128 + wr * 64 + m * 16 + fr) * 64 + col; f32x4 v0 = acc[ai][0][m][0] + b0, v1 = acc[ai][0][m][1] + b1;
#pragma unroll
                    for (int e = 0; e < 4; ++e) { v0[e] = fmaxf(v0[e], 0.f) + log1pf(__expf(-fabsf(v0[e]))); v1[e] = fmaxf(v1[e], 0.f) + log1pf(__expf(-fabsf(v1[e]))); }
                    *(f32x4*)p = v0; *(f32x4*)(p + 4) = v1; } }
    }
};

__device__ __forceinline__ void ph_conv(const Args& a, const Ctx& c) {
    LAS unsigned char* tin = c.lds; LAS unsigned char* toT = c.lds + 17408; LAS unsigned char* toN = c.lds + 34816;
    const bf16* xbc = (const bf16*)(a.ws + WS_XBC);
    u32x4 pin[3];
#define CONV_PREFETCH(tk) do { const int ci_ = (tk) / 48, chb_ = (tk) % 48, r0_ = ci_ * 128, ch0_ = chb_ * 64; \
        const bool first_ = ci_ < 128 ? (ci_ % 32 == 0) : (((ci_ - 128) & 1) == 0), last_ = ci_ < 128 ? (ci_ % 32 == 31) : (((ci_ - 128) & 1) == 1); \
        _Pragma("unroll") for (int q = 0; q < 3; ++q) { const int p = c.tid + 512 * q, lr = p >> 3, pc = p & 7; const bool valid = p < 131 * 8 && !((lr < 2 && first_) || (lr == 130 && last_)); \
            pin[q] = (u32x4){0u, 0u, 0u, 0u}; if (valid) pin[q] = *(const u32x4*)(xbc + (size_t)(r0_ - 2 + lr) * 3072 + ch0_ + pc * 8); } } while (0)
    if ((int)blockIdx.x < NCH * 48) CONV_PREFETCH((int)blockIdx.x);
    for (int task = blockIdx.x; task < NCH * 48; task += c.G) {
        const int ci = task / 48, chb = task % 48, r0 = ci * 128, ch0 = chb * 64;
#pragma unroll
        for (int q = 0; q < 3; ++q) { const int p = c.tid + 512 * q; if (p < 131 * 8) *(LAS u32x4*)(tin + (p >> 3) * 128 + (p & 7) * 16) = pin[q]; }
        __syncthreads();
        if (task + c.G < NCH * 48) CONV_PREFETCH(task + c.G);
        { const int ch = c.tid & 63, tq = c.tid >> 6; const float* cw = a.in[I_CONVW] + ch0 + ch;
          const float w0 = cw[0], w1 = cw[3072], w2 = cw[2 * 3072], w3 = cw[3 * 3072], bias = a.in[I_CONVB][ch0 + ch];
          float xin[19];
#pragma unroll
          for (int i = 0; i < 19; ++i) xin[i] = bf2f(*(const LAS bf16*)(tin + (16 * tq + i) * 128 + ch * 2));
          float o[16];
#pragma unroll
          for (int i = 0; i < 16; ++i) o[i] = silu_f(bias + w0 * xin[i] + w1 * xin[i + 1] + w2 * xin[i + 2] + w3 * xin[i + 3]);
          if (chb < 40) { *(LAS u32x4*)(toT + ch * 272 + tq * 32) = (u32x4){cvtpk(o[0], o[1]), cvtpk(o[2], o[3]), cvtpk(o[4], o[5]), cvtpk(o[6], o[7])};
                          *(LAS u32x4*)(toT + ch * 272 + tq * 32 + 16) = (u32x4){cvtpk(o[8], o[9]), cvtpk(o[10], o[11]), cvtpk(o[12], o[13]), cvtpk(o[14], o[15])}; }
          if (chb >= 32) {
#pragma unroll
              for (int i = 0; i < 16; ++i) *(LAS bf16*)(toN + (16 * tq + i) * 144 + ch * 2) = (bf16)(cvtpk(o[i], 0.f) & 0xffffu); } }
        __syncthreads();
        if (chb < 40) { bf16* dst = chb < 32 ? (bf16*)(a.ws + WS_XT) + ((size_t)ci * 2048 + ch0) * 128 : (bf16*)(a.ws + WS_BT) + ((size_t)ci * 512 + (ch0 - 2048)) * 128;
#pragma unroll
            for (int q = 0; q < 2; ++q) { const int p = c.tid + 512 * q, chl = p >> 4, pc = p & 15; *(u32x4*)(dst + chl * 128 + pc * 8) = *(const LAS u32x4*)(toT + chl * 272 + pc * 16); } }
        if (chb >= 32) { bf16* dst = chb < 40 ? (bf16*)(a.ws + WS_BN) + (size_t)r0 * 512 + (ch0 - 2048) : (bf16*)(a.ws + WS_CN) + (size_t)r0 * 512 + (ch0 - 2560);
#pragma unroll
            for (int q = 0; q < 2; ++q) { const int p = c.tid + 512 * q, t = p >> 3, pc = p & 7; *(u32x4*)(dst + (size_t)t * 512 + pc * 8) = *(const LAS u32x4*)(toN + t * 144 + pc * 16); } }
        __syncthreads();
    }
#undef CONV_PREFETCH
    const int gw = c.vcu * NWAVES + c.wave, NGW = c.G * NWAVES;
    const float* dt = (const float*)(a.ws + WS_DT);
    for (int item = gw; item < NCH * 32; item += NGW) { const int ci = item >> 5, h = item & 31, r0 = ci * 128 + 2 * c.lane;
        const float af = -expf(a.in[I_ALOG][h]), ab = -expf(a.in[I_ALOG][32 + h]);
        const float dtf0 = dt[(size_t)r0 * 64 + h], dtf1 = dt[(size_t)(r0 + 1) * 64 + h], dtb0 = dt[(size_t)r0 * 64 + 32 + h], dtb1 = dt[(size_t)(r0 + 1) * 64 + 32 + h];
        const float laf0 = dtf0 * af, laf1 = dtf1 * af, lab0 = dtb0 * ab, lab1 = dtb1 * ab;
        float inf_ = laf0 + laf1, inb = lab0 + lab1; const float pf = inf_, pbk = inb;
#pragma unroll
        for (int o = 1; o < 64; o <<= 1) { const float t1 = __shfl_up(inf_, o), t2 = __shfl_up(inb, o); if (c.lane >= o) { inf_ += t1; inb += t2; } }
        const float totf = __shfl(inf_, 63), totb = __shfl(inb, 63);
        const float exf = inf_ - pf, exb = inb - pbk;
        const float cf0 = exf + laf0, cf1 = inf_, pb0 = exb, pb1 = exb + lab0;
        f32x4* sca = (f32x4*)(a.ws + WS_SCA) + (size_t)r0 * 32 + h; f32x4* scb = (f32x4*)(a.ws + WS_SCB) + (size_t)r0 * 32 + h;
        { const float L2E = 1.4426950408889634f;
          sca[0] = (f32x4){cf0 * L2E, pb0 * L2E, cf0 * L2E - __log2f(dtf0), pb0 * L2E + __log2f(dtb0)}; sca[32] = (f32x4){cf1 * L2E, pb1 * L2E, cf1 * L2E - __log2f(dtf1), pb1 * L2E + __log2f(dtb1)}; }
        scb[0] = (f32x4){__expf(cf0), __expf(totb - pb0), dtf0 * __expf(totf - cf0), dtb0 * __expf(pb0)};
        scb[32] = (f32x4){__expf(cf1), __expf(totb - pb1), dtf1 * __expf(totf - cf1), dtb1 * __expf(pb1)};
        if (c.lane == 0) ((f32x2*)(a.ws + WS_DEC))[ci * 32 + h] = (f32x2){__expf(totf), __expf(totb)}; }
}

__device__ __forceinline__ void ph_scan(const Args& a, const Ctx& c) {
    constexpr int P = 272, BUF = 53248;
    LAS unsigned char* stg = c.lds + 2 * BUF + c.wave * 2048;
    const int r32 = c.lane & 31, hi = c.lane >> 5, pt = c.wave >> 2, nt = c.wave & 3;
    for (int task = c.vcu; task < 256; task += c.G) { const int b = task >> 6, dir = (task >> 5) & 1, h = task & 31, g = h >> 3;
        f32x16 acc = {};
        u32x4 xrA[2], brA[4], xrB[2], brB[4]; f32x4 wregA = {}, wregB = {}; f32x2 decA = {}, decB = {};
#define SCAN_CI(k) (dir == 0 ? ((k) < 2 ? 128 + 2 * b + (k) : 32 * b + ((k) - 2)) : ((k) < 2 ? 128 + 2 * b + 1 - (k) : 32 * b + 31 - ((k) - 2)))
#define SCAN_LOAD(k, xr, br, wreg, dcr) do { const int ci_ = SCAN_CI(k); const bf16* xs_ = (const bf16*)(a.ws + WS_XT) + ((size_t)ci_ * 2048 + 64 * h) * 128; const bf16* bs_ = (const bf16*)(a.ws + WS_BT) + ((size_t)ci_ * 512 + 128 * g) * 128; \
        _Pragma("unroll") for (int q = 0; q < 2; ++q) xr[q] = ((const u32x4*)xs_)[c.tid + 512 * q]; _Pragma("unroll") for (int q = 0; q < 4; ++q) br[q] = ((const u32x4*)bs_)[c.tid + 512 * q]; \
        wreg = ((const f32x4*)(a.ws + WS_SCB))[((size_t)ci_ * 128 + (c.tid & 127)) * 32 + h]; dcr = ((const f32x2*)(a.ws + WS_DEC))[ci_ * 32 + h]; } while (0)
#define SCAN_WRITE(bi, xr, br, wreg) do { LAS unsigned char* xb_ = c.lds + (bi) * BUF; LAS unsigned char* bb_ = xb_ + 17408; \
        _Pragma("unroll") for (int q = 0; q < 2; ++q) { const int p = c.tid + 512 * q; *(LAS u32x4*)(xb_ + (p >> 4) * P + (p & 15) * 16) = xr[q]; } \
        _Pragma("unroll") for (int q = 0; q < 4; ++q) { const int p = c.tid + 512 * q; *(LAS u32x4*)(bb_ + (p >> 4) * P + (p & 15) * 16) = br[q]; } \
        if (c.tid < 128) ((LAS float*)(xb_ + 52224))[c.tid] = dir == 0 ? wreg.z : wreg.w; } while (0)
#define SCAN_STEP(k, cur, dcr) do { const int ci = SCAN_CI(k); \
            { bf16* hin = (bf16*)(a.ws + WS_HIN) + (((size_t)ci * 2 + dir) * 32 + h) * 8192; \
              _Pragma("unroll") for (int r = 0; r < 16; ++r) *(LAS bf16*)(stg + ((r & 3) + 8 * (r >> 2) + 4 * hi) * 64 + r32 * 2) = (bf16)(cvtpk(acc[r], 0.f) & 0xffffu); \
              LDS_WAIT(); \
              _Pragma("unroll") for (int i = 0; i < 2; ++i) { const int row = (c.lane >> 2) + 16 * i, pc = c.lane & 3; *(u32x4*)(hin + (size_t)(32 * pt + row) * 128 + 32 * nt + pc * 8) = *(const LAS u32x4*)(stg + row * 64 + pc * 16); } } \
            const float dec = dir == 0 ? dcr.x : dcr.y; \
            _Pragma("unroll") for (int r = 0; r < 16; ++r) acc[r] *= dec; \
            { LAS unsigned char* xb = c.lds + (cur) * BUF; LAS unsigned char* bb = xb + 17408; const LAS float* wv = (const LAS float*)(xb + 52224); \
              _Pragma("unroll") for (int kk = 0; kk < 8; ++kk) { const int s8 = 16 * kk + 8 * hi; \
                  const u32x4 xa = *(const LAS u32x4*)(xb + (32 * pt + r32) * P + s8 * 2); const f32x4 wa = *(const LAS f32x4*)(wv + s8), wb = *(const LAS f32x4*)(wv + s8 + 4); \
                  const u32x4 xs = (u32x4){cvtpk(bflo(xa.x) * wa.x, bfhi(xa.x) * wa.y), cvtpk(bflo(xa.y) * wa.z, bfhi(xa.y) * wa.w), cvtpk(bflo(xa.z) * wb.x, bfhi(xa.z) * wb.y), cvtpk(bflo(xa.w) * wb.z, bfhi(xa.w) * wb.w)}; \
                  const bf16x8 bfrag = *(const LAS bf16x8*)(bb + (32 * nt + r32) * P + s8 * 2); \
                  acc = __builtin_amdgcn_mfma_f32_32x32x16_bf16(__builtin_bit_cast(bf16x8, xs), bfrag, acc, 0, 0, 0); } } } while (0)
        f32x2 dcur0, dcur1;
        SCAN_LOAD(0, xrA, brA, wregA, decA); SCAN_LOAD(1, xrB, brB, wregB, decB); SCAN_WRITE(0, xrA, brA, wregA); dcur0 = decA;
        __syncthreads();
        for (int k = 0; k < 34; k += 2) {
            if (k + 2 < 34) SCAN_LOAD(k + 2, xrA, brA, wregA, decA);
            SCAN_STEP(k, 0, dcur0);
            SCAN_WRITE(1, xrB, brB, wregB); dcur1 = decB;
            __syncthreads();
            if (k + 3 < 34) SCAN_LOAD(k + 3, xrB, brB, wregB, decB);
            SCAN_STEP(k + 1, 1, dcur1);
            if (k + 2 < 34) { SCAN_WRITE(0, xrA, brA, wregA); dcur0 = decA; }
            __syncthreads();
        }
#undef SCAN_CI
#undef SCAN_LOAD
#undef SCAN_WRITE
#undef SCAN_STEP
    }
}

__device__ __forceinline__ int crow16(int r, int hi) { return (r & 3) + 8 * (r >> 2) + 4 * hi; }
__device__ __forceinline__ void ph_yph(const Args& a, const Ctx& c, unsigned* rdg) {
    constexpr int P = 272, ZP = 144;
    LAS unsigned char* Cs = c.lds; LAS unsigned char* Bs = c.lds + 34816; LAS unsigned char* xs = c.lds + 69632; LAS unsigned char* hf = c.lds + 87040; LAS unsigned char* hb = c.lds + 104448;
    LAS unsigned char* zs = c.lds + 121856; LAS unsigned char* os = c.lds + 140288; LAS f32x4* sca = (LAS f32x4*)(c.lds + 158720); LAS f32x2* scb = (LAS f32x2*)(c.lds + 160768);
    LAS float* sbv = (LAS float*)(c.lds + 161792); LAS float* scv = (LAS float*)(c.lds + 162304); LAS float* ssql = (LAS float*)(c.lds + 34816);
    const int lb = c.wave & 3, pb = c.wave >> 2;
    SECT_DECL
    for (int task = c.vcu; task < NCH * 4; task += c.G) { const int ci = task >> 2, g = task & 3, r0 = ci * 128;
        int tid_t = c.tid; asm volatile("" : "+v"(tid_t));
        f32x16 X[4]; int l0;
        u32x4 pxt[2], phf[2], phb[2], pz[2]; f32x4 ps1 = {}; f32x4 ps4 = {};
#define YPH_PREFETCH(hq) do { const int h_ = 8 * g + (hq); const u32x4* xt_ = (const u32x4*)((const bf16*)(a.ws + WS_XT) + ((size_t)ci * 2048 + 64 * h_) * 128); \
            const u32x4* hfg_ = (const u32x4*)((const bf16*)(a.ws + WS_HIN) + (((size_t)ci * 2 + 0) * 32 + h_) * 8192); const u32x4* hbg_ = (const u32x4*)((const bf16*)(a.ws + WS_HIN) + (((size_t)ci * 2 + 1) * 32 + h_) * 8192); \
            const bf16* zg_ = (const bf16*)(a.ws + WS_Z) + (size_t)r0 * 2048 + 64 * h_; \
            _Pragma("unroll") for (int q = 0; q < 2; ++q) { const int p = tidp + 512 * q; pxt[q] = xt_[p]; phf[q] = hfg_[p]; phb[q] = hbg_[p]; pz[q] = *(const u32x4*)(zg_ + (size_t)(p >> 3) * 2048 + (p & 7) * 8); } \
            ps1 = ((const f32x4*)(a.ws + WS_SCA))[((size_t)r0 + (tidp & 127)) * 32 + h_]; ps4 = ((const f32x4*)(a.ws + WS_SCB))[((size_t)r0 + (tidp & 127)) * 32 + h_]; } while (0)
        { const int tid = tid_t, lane = tid & 63, r32 = lane & 31, hi = lane >> 5; l0 = 32 * lb + r32;
          { const bf16* cn = (const bf16*)(a.ws + WS_CN) + (size_t)r0 * 512 + 128 * g; const bf16* bn = (const bf16*)(a.ws + WS_BN) + (size_t)r0 * 512 + 128 * g;
#pragma unroll
            for (int q = 0; q < 4; ++q) { const int p = tid + 512 * q, row = p >> 4, pc = p & 15;
                *(LAS u32x4*)(Cs + row * P + pc * 16) = *(const u32x4*)(cn + (size_t)row * 512 + pc * 8); *(LAS u32x4*)(Bs + row * P + pc * 16) = *(const u32x4*)(bn + (size_t)row * 512 + pc * 8); } }
          { const int tidp = tid; YPH_PREFETCH(0); }
          __syncthreads();
#pragma unroll
          for (int sb = 0; sb < 4; ++sb) { X[sb] = (f32x16){};
#pragma unroll
              for (int kk = 0; kk < 8; ++kk) { const int k8 = (16 * kk + 8 * hi) * 2;
                  X[sb] = __builtin_amdgcn_mfma_f32_32x32x16_bf16(*(const LAS bf16x8*)(Bs + (32 * sb + r32) * P + k8), *(const LAS bf16x8*)(Cs + (32 * lb + r32) * P + k8), X[sb], 0, 0, 0); } }
        }
        SECT(0);
        float ssq = 0.f;
#pragma unroll 1
        for (int hh = 0; hh < 8; ++hh) { const int h = 8 * g + hh;
            int tid = c.tid; asm volatile("" : "+v"(tid)); const int lane = tid & 63, r32 = lane & 31, hi = lane >> 5, l = 32 * lb + r32; (void)lane;
            const float dsum = a.in[I_DSK][h] + a.in[I_DSK][32 + h];
            __syncthreads();
            SECT(1);
            if (hh > 0) { bf16* gg = (bf16*)(a.ws + WS_G) + (size_t)r0 * 2048 + 64 * (h - 1);
#pragma unroll
                for (int q = 0; q < 2; ++q) { const int p = tid + 512 * q, zr = p >> 3, zc = p & 7; *(u32x4*)(gg + (size_t)zr * 2048 + zc * 8) = *(const LAS u32x4*)(os + zr * ZP + zc * 16); } }
#pragma unroll
            for (int q = 0; q < 2; ++q) { const int p = tid + 512 * q, row = p >> 4, pc = p & 15;
                *(LAS u32x4*)(xs + row * P + pc * 16) = pxt[q]; *(LAS u32x4*)(hf + row * P + pc * 16) = phf[q]; *(LAS u32x4*)(hb + row * P + pc * 16) = phb[q];
                *(LAS u32x4*)(zs + (p >> 3) * ZP + (p & 7) * 16) = pz[q]; }
            if (tid < 128) { sca[tid] = ps1; scb[tid] = (f32x2){ps4.x, ps4.y}; sbv[tid] = ps1.z; scv[tid] = ps1.w; }
            __syncthreads();
            SECT(2);
            if (hh < 7) { const int tidp = tid; YPH_PREFETCH(hh + 1); }
            SECT(3);
            const f32x4 me = sca[l]; const f32x2 ee = scb[l];
            const float dtb_l = __builtin_amdgcn_exp2f(me.w - me.y);
            f32x16 accd = {};
#pragma unroll
            for (int sb = 0; sb < 4; ++sb) { unsigned mp[8];
#pragma unroll
                for (int q = 0; q < 4; ++q) { const int s0 = 32 * sb + 8 * q + 4 * hi; float mv[4];
                    if (sb < lb) { const f32x4 bs4 = *(const LAS f32x4*)(sbv + s0);
#pragma unroll
                        for (int e = 0; e < 4; ++e) mv[e] = X[sb][4 * q + e] * __builtin_amdgcn_exp2f(me.x - bs4[e]); }
                    else if (sb > lb) { const f32x4 cs4 = *(const LAS f32x4*)(scv + s0);
#pragma unroll
                        for (int e = 0; e < 4; ++e) mv[e] = X[sb][4 * q + e] * __builtin_amdgcn_exp2f(cs4[e] - me.y); }
                    else { const f32x4 bs4 = *(const LAS f32x4*)(sbv + s0), cs4 = *(const LAS f32x4*)(scv + s0);
#pragma unroll
                        for (int e = 0; e < 4; ++e) { const int s = s0 + e; const float t = (s <= l) ? (me.x - bs4[e]) : (cs4[e] - me.y); const float xv = X[sb][4 * q + e];
                            float m = xv * __builtin_amdgcn_exp2f(t); if (s == l) m += xv * dtb_l + dsum; mv[e] = m; } }
                    mp[2 * q] = cvtpk(mv[0], mv[1]); mp[2 * q + 1] = cvtpk(mv[2], mv[3]); }
#pragma unroll
                for (int t = 0; t < 2; ++t) { const int sof = (32 * sb + 16 * t + 4 * hi) * 2;
                    const u32x2 lo = *(const LAS u32x2*)(xs + (32 * pb + r32) * P + sof), h2 = *(const LAS u32x2*)(xs + (32 * pb + r32) * P + sof + 16);
                    const u32x4 af = (u32x4){lo.x, lo.y, h2.x, h2.y}, bfm = (u32x4){mp[4 * t], mp[4 * t + 1], mp[4 * t + 2], mp[4 * t + 3]};
                    accd = __builtin_amdgcn_mfma_f32_32x32x16_bf16(__builtin_bit_cast(bf16x8, af), __builtin_bit_cast(bf16x8, bfm), accd, 0, 0, 0); }
                }
            SECT(4);
#pragma unroll
            for (int dd = 0; dd < 2; ++dd) { f32x16 acco = {}; LAS unsigned char* hx = dd == 0 ? hf : hb;
#pragma unroll
                for (int kk = 0; kk < 8; ++kk) { const int k8 = (16 * kk + 8 * hi) * 2;
                    acco = __builtin_amdgcn_mfma_f32_32x32x16_bf16(*(const LAS bf16x8*)(hx + (32 * pb + r32) * P + k8), *(const LAS bf16x8*)(Cs + (32 * lb + r32) * P + k8), acco, 0, 0, 0); }
                const float ex = dd == 0 ? ee.x : ee.y;
#pragma unroll
                for (int r = 0; r < 16; ++r) accd[r] += ex * acco[r]; }
            SECT(5);
#pragma unroll
            for (int q = 0; q < 4; ++q) { const int pcol = 32 * pb + 8 * q + 4 * hi; const u32x2 zq = *(const LAS u32x2*)(zs + l * ZP + pcol * 2);
                float gv[4];
#pragma unroll
                for (int e = 0; e < 4; ++e) { const int r = 4 * q + e; const float y = accd[r];
                    const float z = (e == 0) ? bflo(zq.x) : (e == 1) ? bfhi(zq.x) : (e == 2) ? bflo(zq.y) : bfhi(zq.y); gv[e] = y * silu_f(z); ssq += gv[e] * gv[e]; }
                *(LAS u32x2*)(os + l * ZP + pcol * 2) = (u32x2){cvtpk(gv[0], gv[1]), cvtpk(gv[2], gv[3])}; }
            SECT(6);
        }
#undef YPH_PREFETCH
        __syncthreads();
        { bf16* gg = (bf16*)(a.ws + WS_G) + (size_t)r0 * 2048 + 64 * (8 * g + 7);
#pragma unroll
          for (int q = 0; q < 2; ++q) { const int p = c.tid + 512 * q, zr = p >> 3, zc = p & 7; *(u32x4*)(gg + (size_t)zr * 2048 + zc * 8) = *(const LAS u32x4*)(os + zr * ZP + zc * 16); } }
        ssq += __shfl_xor(ssq, 32);
        if ((c.lane >> 5) == 0) ssql[pb * 128 + l0] = ssq;
        __syncthreads();
        if (c.tid < 128) ssql[256 + c.tid] = rsqrtf((ssql[c.tid] + ssql[128 + c.tid]) * (1.0f / 512.0f) + EPS);
        VM_WAIT();
        __syncthreads();
        { bf16* gt = (bf16*)(a.ws + WS_G) + (size_t)r0 * 2048 + 512 * g; const float* ng = a.in[I_SNORM] + 512 * g;
          const __amdgpu_buffer_rsrc_t grs = __builtin_amdgcn_make_buffer_rsrc((void*)(a.ws + WS_G), 0, TT * 2048 * 2, 0x00020000);
          const f32x4 g0 = *(const f32x4*)(ng + (c.tid & 63) * 8), g1 = *(const f32x4*)(ng + (c.tid & 63) * 8 + 4);
#pragma unroll 1
          for (int qb = 0; qb < 2; ++qb) { u32x4 gv8[8]; int tidq = c.tid + 4096 * qb; asm volatile("" : "+v"(tidq));
#pragma unroll
            for (int q = 0; q < 8; ++q) { const int p = tidq + 512 * q; gv8[q] = *(const u32x4*)(gt + (size_t)(p >> 6) * 2048 + (p & 63) * 8); }
#pragma unroll
            for (int q = 0; q < 8; ++q) { const int p = tidq + 512 * q, row = p >> 6, col = (p & 63) * 8; const u32x4 v = gv8[q]; const float sr = ssql[256 + row];
              __builtin_amdgcn_raw_buffer_store_b128((u32x4){cvtpk(bflo(v.x) * sr * g0.x, bfhi(v.x) * sr * g0.y), cvtpk(bflo(v.y) * sr * g0.z, bfhi(v.y) * sr * g0.w), cvtpk(bflo(v.z) * sr * g1.x, bfhi(v.z) * sr * g1.y), cvtpk(bflo(v.w) * sr * g1.z, bfhi(v.w) * sr * g1.w)},
                  grs, ((r0 + row) * 2048 + 512 * g + col) * 2, 0, 16  ); } } }
        VM_WAIT();
        __syncthreads();
        if (c.tid == 0) __hip_atomic_fetch_add(rdg + (ci >> 1), 1u, __ATOMIC_RELAXED, __HIP_MEMORY_SCOPE_AGENT);
        SECT(7);
    }
    SECT_END(40);
}
__device__ __forceinline__ void ph_gfix(const Args& a, const Ctx& c) {
    const float* ng = a.in[I_SNORM]; const float* rs = (const float*)(a.ws + WS_RSTD);
    const int n16 = TT * 256;
    for (int p = blockIdx.x * NTHREADS + c.tid; p < n16; p += c.G * NTHREADS) { const int r = p >> 8, col = (p & 255) * 8;
        u32x4* gp = (u32x4*)((bf16*)(a.ws + WS_G) + (size_t)r * 2048 + col); const u32x4 v = *gp; const float s = rs[r * 4 + (col >> 9)];
        const f32x4 g0 = *(const f32x4*)(ng + col), g1 = *(const f32x4*)(ng + col + 4);
        *gp = (u32x4){cvtpk(bflo(v.x) * s * g0.x, bfhi(v.x) * s * g0.y), cvtpk(bflo(v.y) * s * g0.z, bfhi(v.y) * s * g0.w), cvtpk(bflo(v.z) * s * g1.x, bfhi(v.z) * s * g1.y), cvtpk(bflo(v.w) * s * g1.z, bfhi(v.w) * s * g1.w)}; }
}

#if DEBUG_CHECKS
__device__ __forceinline__ float dbg_hb(const Args& a, int layer, size_t idx, float sh) {
    if (ATT_FP8 && layer != 2) return __builtin_amdgcn_cvt_f32_fp8((unsigned)((const unsigned char*)(a.ws + WS_HB))[idx], 0) * sh;
    return bf2f(((const bf16*)(a.ws + WS_HB))[idx]); }
__device__ __forceinline__ int dbg_sample_row(int b) { const int SR[16] = {0, 1, 77, 4095, 4096, 5000, 8191, 9000, 12288, 16383, 16384, 16385, 16384 + 255, 16384 + 256, 17000, 17407}; int r = 0;
#pragma unroll
    for (int i = 0; i < 16; ++i) r = (b == i) ? SR[i] : r;
    return r; }
__device__ __forceinline__ float blk_sum(float v, LAS float* red, int tid) {
    v = wave_sum(v); __syncthreads(); if ((tid & 63) == 0) red[tid >> 6] = v; __syncthreads(); float s = 0.f;
#pragma unroll
    for (int i = 0; i < 8; ++i) s += red[i];
    __syncthreads(); return s; }
__device__ __forceinline__ float blk_max(float v, LAS float* red, int tid) {
#pragma unroll
    for (int o = 1; o < 64; o <<= 1) v = fmaxf(v, __shfl_xor(v, o));
    __syncthreads(); if ((tid & 63) == 0) red[tid >> 6] = v; __syncthreads(); float s = red[0];
#pragma unroll
    for (int i = 1; i < 8; ++i) s = fmaxf(s, red[i]);
    __syncthreads(); return s; }
__device__ __forceinline__ void dbg_report(const Args& a, int id, float err, float ssref, float n, int tid) {
    if (tid == 0) { float rel = err / (sqrtf(ssref / n) + 1e-20f); if (!(rel == rel)) rel = 1e30f; atomicMax((unsigned*)(a.ws + WS_CTL) + CW_DBG + id, __float_as_uint(rel)); } }
__device__ __forceinline__ float dbg_mod(const Args& a, int layer, int r, int j) {
    const float* cv = r < TL ? a.in[I_C] + (r / SEQ) * 1024 : a.in[I_CCTX]; float s = 0.f;
    _Pragma("nounroll") for (int k = 0; k < 1024; ++k) { const float x = cv[k]; s += (x / (1.0f + expf(-x))) * a.in[I_WADA][((size_t)layer * 1024 + k) * 6144 + j]; }
    return s + a.in[I_BADA][layer * 6144 + j]; }

__device__ __forceinline__ void chk_rmix(const Args& a, int layer, int id, LAS unsigned char* ldsb) {
    if (blockIdx.x >= 16) return; const int tid = tid_opaque(), r = dbg_sample_row(blockIdx.x);
    LAS float* red = (LAS float*)ldsb;
    const float* x = resid_row(a, layer, r); const bf16* hb = (const bf16*)(a.ws + WS_HB) + (size_t)r * D;
    float ss = 0.f; for (int cc = tid; cc < D; cc += 512) ss += x[cc] * x[cc];
    ss = blk_sum(ss, red, tid); const float rstd = rsqrtf(ss / D + EPS);
    float err = 0.f, sr = 0.f;
    for (int cc = tid; cc < D; cc += 512) { const float sh = dbg_mod(a, layer, r, cc), sc = dbg_mod(a, layer, r, D + cc);
        const float ref = x[cc] * rstd * a.in[I_NMIX][layer * D + cc] * (1.f + sc) + sh; err = fmaxf(err, fabsf(ref - dbg_hb(a, layer, (size_t)r * D + cc, 1.f))); sr += ref * ref; }
    err = blk_max(err, red, tid); sr = blk_sum(sr, red, tid); dbg_report(a, id, err, sr, D, tid);
}
__device__ __forceinline__ void chk_qkv(const Args& a, int layer, int id, LAS unsigned char* ldsb) {
    if (blockIdx.x >= 16) return; const int tid = tid_opaque(), r = dbg_sample_row(blockIdx.x), j = layer ? 1 : 0;
    LAS float* red = (LAS float*)ldsb; LAS float* y = red + 16; LAS float* hrow = y + 1536;
    const bf16* hb = (const bf16*)(a.ws + WS_HB) + (size_t)r * D;
    _Pragma("nounroll") for (int k = tid; k < D; k += 512) hrow[k] = dbg_hb(a, layer, (size_t)r * D + k, 1.f);
    __syncthreads();
    for (int n = tid; n < 1536; n += 512) { float s = 0.f; const float* w = a.in[I_WQKV] + (size_t)j * 1024 * 1536 + n; _Pragma("nounroll") for (int k = 0; k < 1024; ++k) s += hrow[k] * w[(size_t)k * 1536]; y[n] = s; }
    __syncthreads();
    float err = 0.f, sr = 0.f;
    for (int n = tid; n < 1536; n += 512) { float ref;
        if (n < 1280) { const int h0 = n & ~63; float ss = 0.f; _Pragma("nounroll") for (int q = 0; q < 64; ++q) ss += y[h0 + q] * y[h0 + q];
            const float rstd = rsqrtf(ss / 64.f + EPS); const float* g = (n < 1024 ? a.in[I_QG] : a.in[I_KG]) + j * 64;
            float v = y[n] * rstd * g[n & 63], vp = y[n ^ 1] * rstd * g[(n ^ 1) & 63];
            if (r < TL) { const int t = r % SEQ, i = (n & 63) >> 1, f = i & 15, pos = i < 16 ? t / 64 : t % 64; const float inv = powf(10000.f, -(float)f / 16.f), ang = (float)pos * inv, cs = cosf(ang), sn = sinf(ang);
                v = (n & 1) ? (vp * sn + v * cs) : (v * cs - vp * sn); }
            if (n < 1024) v *= 0.125f * 1.4426950408889634f;
            ref = v; } else ref = y[n];
        float got;
        if (n < 1024) { if (layer == 3 && r >= TL) continue; got = bf2f(((const bf16*)(a.ws + WS_Q))[(size_t)r * 1024 + n]); }
        else if (n < 1280) got = bf2f(((const bf16*)(a.ws + WS_K))[kv_row(r) * 256 + (n - 1024)]);
        else got = bf2f(((const bf16*)(a.ws + WS_V))[kv_row(r) * 256 + (n - 1280)]);
        err = fmaxf(err, fabsf(ref - got)); sr += ref * ref; }
    err = blk_max(err, red, tid); sr = blk_sum(sr, red, tid); dbg_report(a, id, err, sr, 1536, tid);
}
__device__ __forceinline__ void chk_att(const Args& a, int layer, int id, LAS unsigned char* ldsb) {
    if (blockIdx.x >= 16) return; const int tid = tid_opaque(), r = dbg_sample_row(blockIdx.x);
    if (layer == 3 && r >= TL) return;
    LAS float* red = (LAS float*)ldsb; LAS float* sc = red + 16; LAS float* po = sc + 4352;
    const int nk = r < TL ? KVROWS : CTXL; const long kv0 = (long)(r < TL ? r / SEQ : (r - TL) / CTXL) * KVROWS;
    const bf16* Qb = (const bf16*)(a.ws + WS_Q); const bf16* Kb = (const bf16*)(a.ws + WS_K); const bf16* Vb = (const bf16*)(a.ws + WS_V); const bf16* Ob = (const bf16*)(a.ws + WS_HB);
    float err = 0.f, sr = 0.f;
    for (int h = 0; h < 16; ++h) {
        float mx = -3e38f;
        _Pragma("nounroll") for (int jk = tid; jk < nk; jk += 512) { float s = 0.f; _Pragma("nounroll") for (int d = 0; d < 64; ++d) s += bf2f(Qb[(size_t)r * 1024 + h * 64 + d]) * bf2f(Kb[(kv0 + jk) * 256 + (h >> 2) * 64 + d]); sc[jk] = s; mx = fmaxf(mx, s); }
        mx = blk_max(mx, red, tid);
        float l = 0.f; _Pragma("nounroll") for (int jk = tid; jk < nk; jk += 512) { const float p = exp2f(sc[jk] - mx); sc[jk] = p; l += p; }
        l = blk_sum(l, red, tid);
        { const int d = tid & 63, part = tid >> 6; float o = 0.f; _Pragma("nounroll") for (int jk = part; jk < nk; jk += 8) o += sc[jk] * bf2f(Vb[(kv0 + jk) * 256 + (h >> 2) * 64 + d]); po[part * 64 + d] = o; }
        __syncthreads();
        if (tid < 64) { float o = 0.f; _Pragma("nounroll") for (int p = 0; p < 8; ++p) o += po[p * 64 + tid]; o /= l; err = fmaxf(err, fabsf(o - dbg_hb(a, layer, (size_t)r * 1024 + h * 64 + tid, 1.f / (float)(1 << ATT_OSH)))); sr += o * o; }
        __syncthreads();
    }
    err = blk_max(err, red, tid); sr = blk_sum(sr, red, tid); dbg_report(a, id, err, sr, 1024, tid);
}
__device__ __forceinline__ void chk_oproj(const Args& a, int layer, int id, LAS unsigned char* ldsb) {
    if (blockIdx.x >= 16 || layer != 0) return; const int tid = tid_opaque(), r = dbg_sample_row(blockIdx.x), j = 0;
    LAS float* red = (LAS float*)ldsb; LAS float* orow = red + 16;
    const bf16* Ob = (const bf16*)(a.ws + WS_HB) + (size_t)r * D;
    _Pragma("nounroll") for (int k = tid; k < D; k += 512) orow[k] = dbg_hb(a, layer, (size_t)r * D + k, 1.f / (float)(1 << ATT_OSH));
    __syncthreads();
    float err = 0.f, sr = 0.f;
    for (int n = tid; n < D; n += 512) { float s = 0.f; const float* w = a.in[I_WO] + (size_t)j * 1024 * 1024 + n; _Pragma("nounroll") for (int k = 0; k < 1024; ++k) s += orow[k] * w[(size_t)k * 1024];
        const float dl = dbg_mod(a, layer, r, 2 * D + n) * s, ref = resid_row(a, 0, r)[n] + dl; err = fmaxf(err, fabsf(ref - ((const float*)(a.ws + WS_X))[(size_t)r * D + n])); sr += dl * dl; }
    err = blk_max(err, red, tid); sr = blk_sum(sr, red, tid); dbg_report(a, id, err, sr, D, tid);
}
__device__ __forceinline__ void chk_moe(const Args& a, int layer, int id_tok, int id_y, LAS unsigned char* ldsb) {
    if (blockIdx.x >= 16) return; const int tid = tid_opaque(), r = dbg_sample_row(blockIdx.x);
    if (layer == 3 && r >= TL) return;
    LAS float* red = (LAS float*)ldsb; LAS float* tok = red + 16; LAS float* lg = tok + 1024; LAS float* tkb = lg + 64; LAS float* act = tkb + 1024; LAS float* rt = act + 1024;
    const float* x = (const float*)(a.ws + WS_X) + (size_t)r * D; const bf16* tk = (const bf16*)(a.ws + WS_TK) + (size_t)r * D;
    float ss = 0.f; for (int cc = tid; cc < D; cc += 512) ss += x[cc] * x[cc];
    ss = blk_sum(ss, red, tid); const float rstd = rsqrtf(ss / D + EPS);
    float err = 0.f, sr = 0.f;
    for (int cc = tid; cc < D; cc += 512) { const float sh = dbg_mod(a, layer, r, 3 * D + cc), sc = dbg_mod(a, layer, r, 4 * D + cc);
        const float ref = x[cc] * rstd * a.in[I_NFFN][layer * D + cc] * (1.f + sc) + sh; tok[cc] = ref;
#if MOE_FP8
        tkb[cc] = __builtin_amdgcn_cvt_f32_fp8((unsigned)((const unsigned char*)(a.ws + WS_TK))[(size_t)r * D + cc], 0);
#else
        tkb[cc] = bf2f(tk[cc]);
#endif
        err = fmaxf(err, fabsf(ref - tkb[cc])); sr += ref * ref; }
    err = blk_max(err, red, tid); sr = blk_sum(sr, red, tid);
    if (tid < 36) { float s = 0.f; _Pragma("nounroll") for (int k = 0; k < 1024; ++k) s += tok[k] * (tid < 4 ? a.in[I_WRG][((size_t)layer * 1024 + k) * 4 + tid] : a.in[I_WRE][((size_t)layer * 1024 + k) * 32 + tid - 4]); lg[tid] = s; }
    __syncthreads();
    if (tid == 0) { int grp = 0; _Pragma("nounroll") for (int q = 1; q < 4; ++q) if (lg[q] > lg[grp]) grp = q; float den = 0.f; _Pragma("nounroll") for (int q = 0; q < 4; ++q) den += expf(lg[q] - lg[grp]);
        const LAS float* le = lg + 4 + grp * 8; int i0 = 0; _Pragma("nounroll") for (int q = 1; q < 8; ++q) if (le[q] > le[i0]) i0 = q; int i1 = -1; _Pragma("nounroll") for (int q = 0; q < 8; ++q) if (q != i0 && (i1 < 0 || le[q] > le[i1])) i1 = q;
        const float ex = expf(le[i1] - le[i0]), w0 = 1.f / den / (1.f + ex), w1 = 1.f / den * ex / (1.f + ex);
        rt[0] = (float)(grp * 8 + i0); rt[1] = (float)(grp * 8 + i1); rt[2] = w0; rt[3] = w1;
        const float* w2 = (const float*)(a.ws + WS_W2); float e2 = fmaxf(fabsf(w2[2 * r] - w0), fabsf(w2[2 * r + 1] - w1)) * 30.f;
        const int* list = (const int*)(a.ws + WS_LIST); const unsigned* gc = (const unsigned*)(a.ws + WS_CTL) + CW_CNT + layer * 32;
        _Pragma("nounroll") for (int k = 0; k < 2; ++k) { const int e = (int)rt[k]; bool found = false; const int n = (int)gc[e]; _Pragma("nounroll") for (int q = 0; q < n && q < MOE_CAP; ++q) if (list[e * MOE_CAP + q] == 2 * r + k) found = true; if (!found) e2 = 1e6f; }
        rt[4] = e2; }
    __syncthreads();
    err = fmaxf(err, rt[4] * sqrtf(sr / D));
    dbg_report(a, id_tok, err, sr, D, tid);
    float err2 = 0.f, sr2 = 0.f;
    _Pragma("nounroll") for (int k = 0; k < 2; ++k) { const int e = (int)rt[k]; const float wk = rt[2 + k];
        const float* wgu = a.in[I_WGU] + ((size_t)layer * 32 + e) * 1024 * 1024; const float* wdn = a.in[I_WDN] + ((size_t)layer * 32 + e) * 512 * 1024;
        { float sg = 0.f, su = 0.f; _Pragma("nounroll") for (int q = 0; q < 1024; ++q) { sg += tkb[q] * wgu[(size_t)q * 1024 + tid]; su += tkb[q] * wgu[(size_t)q * 1024 + 512 + tid]; } act[tid] = (sg / (1.f + expf(-sg))) * su; }
        __syncthreads();
        for (int n = tid; n < D; n += 512) { float s = 0.f; _Pragma("nounroll") for (int q = 0; q < 512; ++q) s += act[q] * wdn[(size_t)q * 1024 + n]; s *= wk;
            err2 = fmaxf(err2, fabsf(s - bf2f(((const bf16*)(a.ws + WS_Y2))[(size_t)(2 * r + k) * D + n]))); sr2 += s * s; }
        __syncthreads(); }
    err2 = blk_max(err2, red, tid); sr2 = blk_sum(sr2, red, tid); dbg_report(a, id_y, err2, sr2, 2 * D, tid);
}

__global__ void __launch_bounds__(NTHREADS) dbg_kernel(Args a, int ty, int layer, int id) {
    extern __shared__ __attribute__((aligned(16))) unsigned char lds_dbg[];
    LAS unsigned char* l = (LAS unsigned char*)lds_dbg;
    if (ty == 1) chk_rmix(a, layer, id, l); else if (ty == 2) chk_qkv(a, layer, id, l); else if (ty == 3) chk_att(a, layer, id, l);
    else if (ty == 4) chk_oproj(a, layer, id, l); else if (ty == 5) chk_moe(a, layer, id, id + 1, l);
}
#endif

template <int KIND, int LAYER> __device__ __forceinline__ void run_phase(const Args& a0, Ctx& c, unsigned char* lds_gen) {
    Args a = a0; { unsigned long long wsv = (unsigned long long)a0.ws; asm volatile("" : "+s"(wsv)); a.ws = (unsigned char*)(GAS unsigned char*)wsv; }
    { unsigned lb = (unsigned)(uintptr_t)(LAS unsigned char*)lds_gen; asm volatile("" : "+s"(lb)); c.lds = (LAS unsigned char*)(uintptr_t)lb; }
    c.tid = tid_opaque(); c.lane = c.tid & 63;
    unsigned char* const ws = a.ws; constexpr int layer = LAYER;
#define RELAUNDER() do { { unsigned long long wsv_ = (unsigned long long)a0.ws; asm volatile("" : "+s"(wsv_)); a.ws = (unsigned char*)(GAS unsigned char*)wsv_; } \
        { unsigned lb_ = (unsigned)(uintptr_t)(LAS unsigned char*)lds_gen; asm volatile("" : "+s"(lb_)); c.lds = (LAS unsigned char*)(uintptr_t)lb_; } c.tid = tid_opaque(); c.lane = c.tid & 63; } while (0)
    if constexpr (KIND == K_P0) p0_prologue(a, c);
    else if constexpr (KIND == K_RMIX) ph_rmix(a, c, layer);
    else if constexpr (KIND == K_QKV) { constexpr int j = layer ? 1 : 0;
#if ATT_FP8
        SchedQKV S{(const char*)(ws + WS_HB), (const char*)(ws + WS_WQKV) + (size_t)j * 1536 * 1024, (size_t)256 * 1024, layer == 0 ? 1 : 0, c.G, (int)blockIdx.x};
        EpiQKV E{(bf16*)(ws + WS_Q), (bf16*)(ws + WS_K), (bf16*)(ws + WS_V), a.in[I_QG] + j * 64, a.in[I_KG] + j * 64, (const f32x2*)(ws + WS_ROPE)};
        pg8::gemm_phase<EpiQKV, SchedQKV, false, true>(c.lds, 1024, 1024, S, E, 127 - MOE_WSH, 127); }
#else
        SchedQKV S{(const char*)(ws + WS_HB), (const char*)(ws + WS_WQKV) + (size_t)j * 1536 * 1024 * 2, (size_t)256 * 1024 * 2, layer == 0 ? 1 : 0, c.G, (int)blockIdx.x};
        EpiQKV E{(bf16*)(ws + WS_Q), (bf16*)(ws + WS_K), (bf16*)(ws + WS_V), a.in[I_QG] + j * 64, a.in[I_KG] + j * 64, (const f32x2*)(ws + WS_ROPE)};
        pg8::gemm_phase<EpiQKV, SchedQKV, false>(c.lds, 2048, 2048, S, E); }
#endif
    else if constexpr (KIND == K_ROPE) ph_rope(a, c, layer);
    else if constexpr (KIND == K_ATT) ph_att(a, c, layer, (char*)c.lds);
    else if constexpr (KIND == K_OPROJ) { constexpr int j = layer ? 1 : 0;
#if ATT_FP8
        unsigned* rdx = (unsigned*)(ws + WS_CTL) + CW_RDX + layer * 128;
        SchedDenseR S{(const char*)(ws + WS_HB), (const char*)(ws + WS_WO) + (size_t)j * 1024 * 1024, (size_t)256 * 1024, (size_t)256 * 1024, 0, layer == 3 ? 64 : 68, 4, 64, c.G, (int)blockIdx.x, rdx};
        EpiResid E{&a, layer, nullptr, nullptr};
        pg8::gemm_phase<EpiResid, SchedDenseR, false, true>(c.lds, 1024, 1024, S, E, 127 - MOE_WSH, 127 - ATT_OSH);
        RELAUNDER(); ph_m1(a, c, layer, (unsigned*)(a.ws + WS_CTL) + CW_RDX + layer * 128, 4, 0); }
#else
        unsigned* rdx = (unsigned*)(ws + WS_CTL) + CW_RDX + layer * 128;
        SchedDenseR S{(const char*)(ws + WS_HB), (const char*)(ws + WS_WO) + (size_t)j * 1024 * 1024 * 2, (size_t)256 * 1024 * 2, (size_t)256 * 1024 * 2, 0, layer == 3 ? 64 : 68, 4, 64, c.G, (int)blockIdx.x, rdx};
        EpiResid E{&a, layer, nullptr, nullptr};
        pg8::gemm_phase<EpiResid, SchedDenseR, false>(c.lds, 2048, 2048, S, E);
        RELAUNDER(); ph_m1(a, c, layer, (unsigned*)(a.ws + WS_CTL) + CW_RDX + layer * 128, 4, 0); }
#endif
    else if constexpr (KIND == K_M2) {
        LAS int* tab = (LAS int*)(c.lds + TAB_OFF); moe_tables(a, c, layer, tab);
        unsigned* rdy = (unsigned*)(ws + WS_CTL) + CW_RDY + layer * 256;
#if MOE_FP8
        { SchedMoe S{(const char*)(ws + WS_TK), 0, (const char*)(ws + WS_WGU) + (size_t)layer * 32 * 1024 * 1024, (size_t)1024 * 1024, (size_t)256 * 1024, tab, (const int*)(ws + WS_LIST), c.G, (int)blockIdx.x, rdy, 1};
          EpiGateUp E{(bf16*)(ws + WS_ACT)};
          pg8::gemm_phase<EpiGateUp, SchedMoe, true, true>(c.lds, 1024, 1024, S, E, 127 - MOE_WSH, 127); }
        { SchedMoe S{(const char*)(ws + WS_ACT), (size_t)256 * 512, (const char*)(ws + WS_WDN) + (size_t)layer * 32 * 1024 * 512, (size_t)1024 * 512, (size_t)256 * 512, tab, (const int*)(ws + WS_LIST), c.G, (int)blockIdx.x, rdy, 2};
          EpiDown E{(const int*)(ws + WS_LIST), (const float*)(ws + WS_W2), (bf16*)(ws + WS_Y2)};
          pg8::gemm_phase<EpiDown, SchedMoe, false, true>(c.lds, 512, 512, S, E, 127 - MOE_WSH, 127 - MOE_ASH); } }
#else
        { SchedMoe S{(const char*)(ws + WS_TK), 0, (const char*)(ws + WS_WGU) + (size_t)layer * 32 * 1024 * 1024 * 2, (size_t)1024 * 1024 * 2, (size_t)256 * 1024 * 2, tab, (const int*)(ws + WS_LIST), c.G, (int)blockIdx.x, rdy, 1};
          EpiGateUp E{(bf16*)(ws + WS_ACT)};
          pg8::gemm_phase<EpiGateUp, SchedMoe, true>(c.lds, 2048, 2048, S, E); }
        { SchedMoe S{(const char*)(ws + WS_ACT), (size_t)256 * 512 * 2, (const char*)(ws + WS_WDN) + (size_t)layer * 32 * 1024 * 512 * 2, (size_t)1024 * 512 * 2, (size_t)256 * 512 * 2, tab, (const int*)(ws + WS_LIST), c.G, (int)blockIdx.x, rdy, 2};
          EpiDown E{(const int*)(ws + WS_LIST), (const float*)(ws + WS_W2), (bf16*)(ws + WS_Y2)};
          pg8::gemm_phase<EpiDown, SchedMoe, false>(c.lds, 1024, 1024, S, E); } }
#endif
    else if constexpr (KIND == K_RPOOL) ph_rpool(a, c, layer);
    else if constexpr (KIND == K_POOLG) {
        unsigned* rdx = (unsigned*)(ws + WS_CTL) + CW_RDX + layer * 128;
        SchedDenseR S{(const char*)(ws + WS_HB), (const char*)(ws + WS_WPOOL), (size_t)256 * 1024 * 2, (size_t)256 * 256 * 2, (size_t)256 * 2, 68, 4, 64, c.G, (int)blockIdx.x, rdx};
        EpiResid E{&a, layer, a.in[I_POOLS], (const float*)(ws + WS_Z)};
        pg8::gemm_phase<EpiResid, SchedDenseR, false>(c.lds, 512, 2048, S, E);
        RELAUNDER(); ph_m1(a, c, layer, (unsigned*)(a.ws + WS_CTL) + CW_RDX + layer * 128, 4, 0); }
    else if constexpr (KIND == K_INPROJ) {
        SchedDense S{(const char*)(ws + WS_HB), (const char*)(ws + WS_WIN), (size_t)256 * 1024 * 2, (size_t)256 * 1024 * 2, 0, 68, 21, c.G, (int)blockIdx.x};
        EpiInproj E{(bf16*)(ws + WS_Z), (bf16*)(ws + WS_XBC), (float*)(ws + WS_DT), a.in[I_DTB]};
        pg8::gemm_phase<EpiInproj, SchedDense, false>(c.lds, 2048, 2048, S, E); }
    else if constexpr (KIND == K_CONV) ph_conv(a, c);
    else if constexpr (KIND == K_SCAN) ph_scan(a, c);
    else if constexpr (KIND == K_YPH) {
        ph_yph(a, c, (unsigned*)(ws + WS_CTL) + CW_RDG);
        RELAUNDER();
        { unsigned* rdx = (unsigned*)(a.ws + WS_CTL) + CW_RDX + layer * 128;
          SchedOutproj S{(const char*)(a.ws + WS_G), (const char*)(a.ws + WS_WOUT), (size_t)256 * 2048 * 2, (size_t)256 * 2048 * 2, c.G, c.vcu, (const unsigned*)(a.ws + WS_CTL) + CW_RDG, rdx};
          EpiResid E{&a, layer, nullptr, nullptr};
          pg8::gemm_phase<EpiResid, SchedOutproj, false>(c.lds, 4096, 4096, S, E); }
        RELAUNDER(); ph_m1(a, c, layer, (unsigned*)(a.ws + WS_CTL) + CW_RDX + layer * 128, 4, 1); }
    else if constexpr (KIND == K_GFIX) ph_gfix(a, c);
    else if constexpr (KIND == K_FINAL) ph_final(a, c, layer);
#undef RELAUNDER
}
#define PROGRAM(X) \
    X(0, K_P0, 0) \
    X(1, K_RMIX, 0) X(2, K_QKV, 0) X(3, K_ATT, 0) X(4, K_OPROJ, 0) X(5, K_M2, 0) \
    X(6, K_RPOOL, 1) X(7, K_POOLG, 1) X(8, K_M2, 1) \
    X(9, K_RMIX, 2) X(10, K_INPROJ, 2) X(11, K_CONV, 2) X(12, K_SCAN, 2) X(13, K_YPH, 2) X(14, K_M2, 2) \
    X(15, K_RMIX, 3) X(16, K_QKV, 3) X(17, K_ATT, 3) X(18, K_OPROJ, 3) X(19, K_M2, 3) \
    X(20, K_FINAL, 4)
constexpr int NPHASES = 21;
__device__ __forceinline__ unsigned long long probe_phases(const unsigned long long* ts, unsigned mask) { unsigned long long r = 0; for (int k = 0; k < 32; ++k) if (mask & (1u << k)) r += ts[k + 1] - ts[k]; return r; }
__device__ __forceinline__ unsigned long long probe_sum(const unsigned long long* s, int mask) { unsigned long long r = 0; for (int k = 0; k < 8; ++k) if (mask & (1 << k)) r += s[k]; return r; }
__global__ void __launch_bounds__(NTHREADS, 2) mega(Args a0) {
    extern __shared__ __attribute__((aligned(16))) unsigned char lds_raw[];
    Ctx c; c.lds = (LAS unsigned char*)lds_raw; c.tid = threadIdx.x; c.lane = c.tid & 63; c.wave = __builtin_amdgcn_readfirstlane(c.tid >> 6);
    c.G = gridDim.x; { const int bx = blockIdx.x; c.vcu = (c.G % 8 == 0) ? (bx % 8) * (c.G / 8) + bx / 8 : bx; }
    volatile LAS unsigned* MISC = (volatile LAS unsigned*)(c.lds + MISC_OFF);
    for (int u = c.tid; u < 128; u += NTHREADS) MISC[u] = 0u;
    __syncthreads();
    XcdBarrier bar = xcd_barrier_post((unsigned*)(a0.ws + WS_CTL) + CW_BAR + a0.bar_region * XCD_BAR_WORDS, MISC + 8);
    const int lo = a0.ph_lo, hi = a0.ph_hi;
#if PROBE
#define STAMP(idx) if (blockIdx.x == 0 && threadIdx.x == 0) __hip_atomic_store((unsigned long long*)((unsigned*)(a0.ws + WS_CTL) + CW_TS) + (idx), (unsigned long long)__builtin_amdgcn_s_memrealtime(), __ATOMIC_RELAXED, __HIP_MEMORY_SCOPE_AGENT);
#else
#define STAMP(idx)
#endif
    STAMP(0)
#if EXTRA_BARS
    for (int eb = 0; eb < EXTRA_BARS; ++eb) xcd_barrier(bar);
#endif
#define RUNPH(idx, KIND, LAYER) if (lo <= (idx) && (idx) < hi) { run_phase<KIND, LAYER>(a0, c, lds_raw); if ((idx) + 1 < hi) xcd_barrier(bar); STAMP((idx) + 1) }
    PROGRAM(RUNPH)
#undef RUNPH
#if PROBE
    if (blockIdx.x == 0 && threadIdx.x == 0 && hi == NPHASES) { const unsigned long long* ts = (const unsigned long long*)((unsigned*)(a0.ws + WS_CTL) + CW_TS);
        const unsigned long long d = (unsigned long long)PROBE_K * (PROBE_SLOT ? probe_sum(ts + PROBE_SLOT_BASE, PROBE_SLOT) : probe_phases(ts, PROBE_MASK)), t0 = __builtin_amdgcn_s_memrealtime();
        while (__builtin_amdgcn_s_memrealtime() - t0 < d) __builtin_amdgcn_s_sleep(8); }
#endif
}

extern "C" void kernel_launch(void* const* d_in, const int* in_sizes, int n_in, void* d_out, int out_size, void* d_ws, size_t ws_size, hipStream_t stream) {
    static int grid = 0;
    if (grid == 0) {
        if (n_in != N_IN || out_size != TL * D || ws_size < WS_END) { fprintf(stderr, "kernel_launch: unexpected shapes (n_in %d out %d ws %zu)\n", n_in, out_size, ws_size); grid = -1; return; }
        int dev = 0, cus = 0;
        if (hipGetDevice(&dev) != hipSuccess || hipDeviceGetAttribute(&cus, hipDeviceAttributeMultiprocessorCount, dev) != hipSuccess) { grid = -1; return; }
        if (hipFuncSetAttribute((const void*)mega, hipFuncAttributeMaxDynamicSharedMemorySize, LDS_BYTES) != hipSuccess) { fprintf(stderr, "kernel_launch: hipFuncSetAttribute failed\n"); grid = -1; return; }
        int per_cu = 0;
        if (hipOccupancyMaxActiveBlocksPerMultiprocessor(&per_cu, (const void*)mega, NTHREADS, LDS_BYTES) != hipSuccess || per_cu < 1) fprintf(stderr, "kernel_launch: occupancy query says %d\n", per_cu);
        (void)hipGetLastError();
        grid = cus;
    }
    if (grid < 0) return;
    (void)hipMemsetAsync((char*)d_ws + WS_CTL, 0, CTL_ZERO_BYTES, stream);
    Args a{};
    for (int i = 0; i < N_IN; ++i) a.in[i] = (const float*)d_in[i];
    a.out = (float*)d_out; a.ws = (unsigned char*)d_ws; a.flags = 0;
#if DEBUG_CHECKS
    struct Cut { int after; int ty, layer, nid; };
    const Cut cuts[] = DEBUG_CUTS;
    int lo = 0, region = 0, dbg_id = 1;
    for (unsigned k = 0; k < sizeof(cuts) / sizeof(cuts[0]); ++k) {
        if (cuts[k].after + 1 > lo) { a.ph_lo = lo; a.ph_hi = cuts[k].after + 1; a.bar_region = region++; hipLaunchKernelGGL(mega, dim3(grid), dim3(NTHREADS), LDS_BYTES, stream, a); lo = cuts[k].after + 1; }
        hipLaunchKernelGGL(dbg_kernel, dim3(16), dim3(NTHREADS), 65536, stream, a, cuts[k].ty, cuts[k].layer, dbg_id); dbg_id += cuts[k].nid;
    }
    a.ph_lo = lo; a.ph_hi = NPHASES; a.bar_region = region++;
    hipLaunchKernelGGL(mega, dim3(grid), dim3(NTHREADS), LDS_BYTES, stream, a);
#else
    a.ph_lo = 0; a.ph_hi = NPHASES; a.bar_region = 0;
    hipLaunchKernelGGL(mega, dim3(grid), dim3(NTHREADS), LDS_BYTES, stream, a);
#endif
}
```

```cpp
#include <hip/hip_runtime.h>
#include <cstdio>
#include <cstdint>

#define LAS __attribute__((address_space(3)))
#define GAS __attribute__((address_space(1)))
typedef unsigned short bf16;
typedef short bf16x8 __attribute__((ext_vector_type(8)));
typedef short s16x4 __attribute__((ext_vector_type(4)));
typedef float f32x2 __attribute__((ext_vector_type(2)));
typedef float f32x4 __attribute__((ext_vector_type(4)));
typedef float f32x16 __attribute__((ext_vector_type(16)));
typedef unsigned u32x2 __attribute__((ext_vector_type(2)));
typedef unsigned u32x4 __attribute__((ext_vector_type(4)));
typedef __bf16 bf16x2_t __attribute__((ext_vector_type(2)));

constexpr int D = 1024, NB = 4, SEQ = 4096, CTXL = 256, TL = NB * SEQ, TC = NB * CTXL, TT = TL + TC;
constexpr int KVROWS = SEQ + CTXL;
constexpr int NCH = TT / 128;
constexpr int MOE_CAP = TT;
constexpr float EPS = 1e-6f;
constexpr int NWAVES = 8, NTHREADS = 512;
#ifndef NLAYERS
#define NLAYERS 4
#endif
#ifndef MOE_FP8
#define MOE_FP8 1
#endif
#define MOE_WSH 5
#ifndef ATT_FP8
#define ATT_FP8 1
#endif
#define ATT_OSH 3
#define MOE_ASH 2
#define DBG_TOL 0.03f
#ifndef DEBUG_CHECKS
#define DEBUG_CHECKS 0
#endif
#ifndef PROBE
#define PROBE 0
#endif
#define PROBE_A0 0
#define PROBE_A1 1
#define PROBE_B0 4
#define PROBE_B1 5
#define PROBE_K 2
#define PROBE_MASK 0x1222224u
#define EXTRA_BARS 0
#define PROBE_SLOT_BASE 40
#define PROBE_SLOT 0
#if PROBE
#define SECT_DECL unsigned long long sect_t = __builtin_amdgcn_s_memrealtime(); unsigned long long sect_acc[8] = {0, 0, 0, 0, 0, 0, 0, 0};
#define SECT(k) do { const unsigned long long n_ = __builtin_amdgcn_s_memrealtime(); sect_acc[k] += n_ - sect_t; sect_t = n_; } while (0)
#define SECT_END(base) do { if (blockIdx.x == 0 && threadIdx.x == 0) { _Pragma("unroll") for (int k_ = 0; k_ < 8; ++k_) ((unsigned long long*)((unsigned*)(a.ws + WS_CTL) + CW_TS))[(base) + k_] = sect_acc[k_]; } } while (0)
#else
#define SECT_DECL
#define SECT(k) do {} while (0)
#define SECT_END(base) do {} while (0)
#endif
#define DEBUG_CUTS { {1, 1, 0, 1}, {2, 2, 0, 1}, {3, 3, 0, 1}, {4, 4, 0, 1}, {6, 5, 0, 2} }

enum { I_X = 0, I_C, I_CTX, I_CCTX, I_WADA, I_BADA, I_NMIX, I_NFFN, I_NFIN, I_WQKV, I_WO, I_QG, I_KG, I_POOLW, I_POOLS, I_WIN, I_CONVW, I_CONVB, I_DTB, I_ALOG, I_DSK, I_SNORM, I_WOUT, I_WRG, I_WRE, I_WGU, I_WDN, N_IN };

constexpr size_t MiB = 1u << 20;
constexpr size_t WS_CTL = 0, CTL_ZERO_BYTES = 1 * MiB;
constexpr size_t WS_MODL = 1 * MiB;
constexpr size_t WS_MODC = WS_MODL + 4 * 4 * 6144 * 4;
constexpr size_t WS_ROPE = 1 * MiB + 512 * 1024;
constexpr size_t WS_WR = 2 * MiB;
constexpr size_t WS_WQKV = 3 * MiB;
constexpr size_t WS_WO = 9 * MiB;
constexpr size_t WS_WPOOL = 13 * MiB;
constexpr size_t WS_WIN = 14 * MiB;
constexpr size_t WS_WOUT = 25 * MiB;
constexpr size_t WS_WGU = 29 * MiB;
constexpr size_t WS_WDN = 285 * MiB;
constexpr size_t WS_X = 413 * MiB;
constexpr size_t WS_HB = 481 * MiB;
constexpr size_t WS_TK = 515 * MiB;
constexpr size_t WS_Q = 549 * MiB;
constexpr size_t WS_K = 583 * MiB;
constexpr size_t WS_V = 592 * MiB;
constexpr size_t WS_Y2 = 601 * MiB;
constexpr size_t WS_ACT = 669 * MiB;
constexpr size_t WS_LIST = 711 * MiB;
constexpr size_t WS_W2 = 714 * MiB;
constexpr size_t WS_Z = 715 * MiB;
constexpr size_t WS_XBC = 783 * MiB;
constexpr size_t WS_DT = 885 * MiB;
constexpr size_t WS_XT = 890 * MiB;
constexpr size_t WS_BN = 958 * MiB;
constexpr size_t WS_BT = 975 * MiB;
constexpr size_t WS_CN = 992 * MiB;
constexpr size_t WS_SCA = 1009 * MiB;
constexpr size_t WS_SCB = 1018 * MiB;
constexpr size_t WS_DEC = 1027 * MiB;
constexpr size_t WS_HIN = 1028 * MiB;
constexpr size_t WS_G = 1164 * MiB;
constexpr size_t WS_RSTD = 1232 * MiB;
constexpr size_t WS_END = 1233 * MiB;

constexpr int CW_BAR = 4096;
constexpr int CW_CNT = 200000;
constexpr int CW_DBG = 201000;
constexpr int CW_RDY = 204000;
constexpr int CW_RDG = 207000;
constexpr int CW_RDX = 206000;
constexpr int CW_TS = 202000;

constexpr int LDS_BYTES = 163840;
constexpr int MISC_OFF = LDS_BYTES - 512;

__device__ __forceinline__ unsigned cvtpk(float lo, float hi) { f32x2 v = {lo, hi}; bf16x2_t b = __builtin_convertvector(v, bf16x2_t); return __builtin_bit_cast(unsigned, b); }
__device__ __forceinline__ unsigned pk_fp8x4(float a, float b, float c, float d) {
    a = __builtin_amdgcn_fmed3f(a, -448.f, 448.f); b = __builtin_amdgcn_fmed3f(b, -448.f, 448.f); c = __builtin_amdgcn_fmed3f(c, -448.f, 448.f); d = __builtin_amdgcn_fmed3f(d, -448.f, 448.f);
    unsigned w = __builtin_amdgcn_cvt_pk_fp8_f32(a, b, 0u, false); return __builtin_amdgcn_cvt_pk_fp8_f32(c, d, w, true); }
__device__ __forceinline__ float bflo(unsigned u) { return __uint_as_float(u << 16); }
__device__ __forceinline__ float bfhi(unsigned u) { return __uint_as_float(u & 0xffff0000u); }
__device__ __forceinline__ float bf2f(bf16 b) { return __uint_as_float((unsigned)b << 16); }
__device__ __forceinline__ float wave_sum(float v) {
#pragma unroll
    for (int o = 1; o < 64; o <<= 1) v += __shfl_xor(v, o);
    return v;
}
__device__ __forceinline__ float silu_f(float v) { return v * __builtin_amdgcn_rcpf(1.0f + __builtin_amdgcn_exp2f(v * -1.4426950408889634f)); }
__device__ __forceinline__ int tid_opaque() { int t = threadIdx.x; asm volatile("" : "+v"(t)); return t; }
#define LDS_WAIT() asm volatile("s_waitcnt lgkmcnt(0)" ::: "memory")
#define VM_WAIT() asm volatile("s_waitcnt vmcnt(0)" ::: "memory")

#define XB_TMO      128
#define XB_XCNT(j)  (256  + 64 * (j))
#define XB_XSUB(j)  (1280 + 64 * (j))
#define XB_XGEN(j)  (2304 + 64 * (j))
#define XB_TOP      3328
#define XB_TOPGEN   3392
#define XCD_BAR_WORDS 3456
#define XB_SPIN_CAP (1u << 20)
__device__ __forceinline__ unsigned xb_ld(unsigned* p)              { return __hip_atomic_load(p, __ATOMIC_RELAXED, __HIP_MEMORY_SCOPE_AGENT); }
__device__ __forceinline__ unsigned xb_add(unsigned* p, unsigned v) { return __hip_atomic_fetch_add(p, v, __ATOMIC_RELAXED, __HIP_MEMORY_SCOPE_AGENT); }
__device__ __forceinline__ unsigned xb_xcc_id() { return (unsigned)__builtin_amdgcn_s_getreg((3 << 11) | 20) & 0xFu; }
#define XB_SPIN(cond, bar) do { unsigned _sp = 0; while (cond) { __builtin_amdgcn_s_sleep(1); \
    if ((++_sp & 255u) == 0u) { if (xb_ld(&(bar)[XB_TMO])) break; if (_sp > XB_SPIN_CAP) { atomicAdd(&(bar)[XB_TMO], 1u); break; } } } } while (0)
struct XcdBarrier { unsigned* bar; unsigned x; volatile LAS unsigned* st; };
__device__ __forceinline__ XcdBarrier xcd_barrier_post(unsigned* bar, volatile LAS unsigned* st) {
    XcdBarrier b; b.bar = bar; b.x = xb_xcc_id(); b.st = st;
    if (threadIdx.x == 0) (void)xb_add(&bar[XB_XCNT(b.x)], 1u);
    return b;
}
__device__ __forceinline__ void xcd_barrier_complete(unsigned* bar, unsigned x, unsigned& nloc, unsigned& nx) {
    const unsigned G = gridDim.x * gridDim.y * gridDim.z;
    unsigned sum, cnt, mine, sp = 0u;
    for (;;) {
        sum = 0u; cnt = 0u; mine = 0u;
#pragma unroll
        for (unsigned j = 0; j < 16; ++j) { const unsigned c = xb_ld(&bar[XB_XCNT(j)]); sum += c; cnt += (c > 0u) ? 1u : 0u; mine = (j == x) ? c : mine; }
        if (sum == G) break;
        __builtin_amdgcn_s_sleep(1);
        if ((++sp & 255u) == 0u) { if (xb_ld(&bar[XB_TMO])) break; if (sp > XB_SPIN_CAP) { atomicAdd(&bar[XB_TMO], 1u); break; } }
    }
    nloc = mine > 0u ? mine : 1u; nx = cnt > 0u ? cnt : 1u;
}
__device__ __forceinline__ void xcd_barrier(const XcdBarrier& b) {
    asm volatile("s_waitcnt vmcnt(0)" ::: "memory");
    __syncthreads();
    if (threadIdx.x == 0) {
        unsigned* bar = b.bar;
        __builtin_amdgcn_s_waitcnt(0);
        unsigned nloc = b.st[0], nx = b.st[1];
        if (nloc == 0u) { xcd_barrier_complete(bar, b.x, nloc, nx); b.st[0] = nloc; b.st[1] = nx; }
        const unsigned old = xb_add(&bar[XB_XSUB(b.x)], 1u);
        const unsigned gen = old / nloc;
        if (old + 1u == (gen + 1u) * nloc) {
            __builtin_amdgcn_fence(__ATOMIC_RELEASE, "agent");
            asm volatile("s_waitcnt vmcnt(0)" ::: "memory");
            const unsigned og = xb_add(&bar[XB_TOP], 1u);
            const unsigned tg = og / nx;
            if (og + 1u == (tg + 1u) * nx) xb_add(&bar[XB_TOPGEN], 1u);
            else XB_SPIN(xb_ld(&bar[XB_TOPGEN]) == tg, bar);
            __builtin_amdgcn_fence(__ATOMIC_ACQUIRE, "agent");
            xb_add(&bar[XB_XGEN(b.x)], 1u);
            asm volatile("s_waitcnt vmcnt(0)" ::: "memory");
        } else {
            XB_SPIN(xb_ld(&bar[XB_XGEN(b.x)]) == gen, bar);
            __builtin_amdgcn_fence(__ATOMIC_ACQUIRE, "agent");
            asm volatile("s_waitcnt vmcnt(0)" ::: "memory");
        }
    }
    __syncthreads();
}

enum { K_P0 = 0, K_RMIX, K_QKV, K_ROPE, K_ATT, K_OPROJ, K_M1, K_M2, K_M3, K_RPOOL, K_POOLG, K_INPROJ, K_CONV, K_SCAN, K_YPH, K_GFIX, K_OUTPROJ, K_FINAL, K_DBG };
struct Args { const float* in[N_IN]; float* out; unsigned char* ws; int ph_lo, ph_hi; int flags; int bar_region; };

struct Ctx {
    LAS unsigned char* lds; int tid, lane, wave, vcu, G;
};

__device__ __forceinline__ const float* mod_row(const Args& a, int layer, int r) {
    return r < TL ? (const float*)(a.ws + WS_MODL) + (size_t)(layer * 4 + r / SEQ) * 6144 : (const float*)(a.ws + WS_MODC) + (size_t)layer * 6144;
}
__device__ __forceinline__ const float* resid_row(const Args& a, int layer, int r) {
    if (layer == 0) return r < TL ? a.in[I_X] + (size_t)r * D : a.in[I_CTX] + (size_t)(r - TL) * D;
    return (const float*)(a.ws + WS_X) + (size_t)r * D;
}

__device__ __forceinline__ void load_row_combined(const Args& a, int layer, int r, int lane, f32x4 (&v)[4]) {
    if (layer == 0) { const f32x4* xr = (const f32x4*)resid_row(a, 0, r) + lane;
#pragma unroll
        for (int j = 0; j < 4; ++j) v[j] = xr[64 * j]; }
    else { const u32x2* xr = (const u32x2*)((const bf16*)(a.ws + WS_X) + (size_t)r * D) + lane;
#pragma unroll
        for (int j = 0; j < 4; ++j) { const u32x2 p = xr[64 * j]; v[j] = (f32x4){bflo(p.x), bfhi(p.x), bflo(p.y), bfhi(p.y)}; } }
    if (layer > 0 && !(a.flags & 1)) {
        const f32x4* gf = (const f32x4*)(mod_row(a, layer - 1, r) + 5 * D) + lane;
        const u32x2* y0 = (const u32x2*)((const bf16*)(a.ws + WS_Y2) + (size_t)(2 * r) * D) + lane;
        const u32x2* y1 = (const u32x2*)((const bf16*)(a.ws + WS_Y2) + (size_t)(2 * r + 1) * D) + lane;
#pragma unroll
        for (int j = 0; j < 4; ++j) {
            const u32x2 p = y0[64 * j], q = y1[64 * j]; const f32x4 g = gf[64 * j];
            v[j].x += g.x * (bflo(p.x) + bflo(q.x)); v[j].y += g.y * (bfhi(p.x) + bfhi(q.x));
            v[j].z += g.z * (bflo(p.y) + bflo(q.y)); v[j].w += g.w * (bfhi(p.y) + bfhi(q.y));
        }
    }
}
__device__ __forceinline__ float row_rstd(const f32x4 (&v)[4]) {
    float s = 0.f;
#pragma unroll
    for (int j = 0; j < 4; ++j) s += (v[j].x * v[j].x + v[j].y * v[j].y) + (v[j].z * v[j].z + v[j].w * v[j].w);
    return rsqrtf(wave_sum(s) * (1.0f / D) + EPS);
}
__device__ __forceinline__ void norm_mod(const f32x4 (&v)[4], float rstd, const float* g, const float* shift, const float* scale, int lane, f32x4 (&h)[4]) {
#pragma unroll
    for (int j = 0; j < 4; ++j) {
        const f32x4 gg = ((const f32x4*)g)[lane + 64 * j], sh = ((const f32x4*)shift)[lane + 64 * j], sc = ((const f32x4*)scale)[lane + 64 * j];
        h[j] = (v[j] * rstd) * gg * (sc + 1.0f) + sh;
    }
}

__device__ __forceinline__ void tr_item(const float* W, int N, int k0, int n0, bf16* WT, size_t drow0, int dK, LAS float* scr, int lane, int hi_skip = 0) {
    const int nq = lane & 15, kr = lane >> 4;
#pragma unroll
    for (int i = 0; i < 16; ++i) { const int kk = 4 * i + kr; const f32x4 v = *(const f32x4*)(W + (size_t)(k0 + kk) * N + n0 + 4 * nq);
        LAS float* d = scr + kk * 65 + 4 * nq; d[0] = v.x; d[1] = v.y; d[2] = v.z; d[3] = v.w; }
    LDS_WAIT(); asm volatile("" ::: "memory");
    const int c = lane & 7;
#pragma unroll
    for (int j = 0; j < 8; ++j) { const int n = (lane >> 3) + 8 * j; const LAS float* s = scr + (8 * c) * 65 + n;
        u32x4 o; o.x = cvtpk(s[0 * 65], s[1 * 65]); o.y = cvtpk(s[2 * 65], s[3 * 65]); o.z = cvtpk(s[4 * 65], s[5 * 65]); o.w = cvtpk(s[6 * 65], s[7 * 65]);
        *(u32x4*)(WT + (drow0 + n + (n >= 32 ? hi_skip : 0)) * dK + k0 + 8 * c) = o; }
    LDS_WAIT(); asm volatile("" ::: "memory");
}
__device__ __forceinline__ void tr_item8(const float* W, int N, int k0, int n0, unsigned char* WT, size_t drow0, int dKb, LAS float* scr, int lane, float scale, int hi_skip = 0) {
    const int nq = lane & 15, kr = lane >> 4;
#pragma unroll
    for (int i = 0; i < 16; ++i) { const int kk = 4 * i + kr; const f32x4 v = *(const f32x4*)(W + (size_t)(k0 + kk) * N + n0 + 4 * nq);
        LAS float* d = scr + kk * 65 + 4 * nq; d[0] = v.x; d[1] = v.y; d[2] = v.z; d[3] = v.w; }
    LDS_WAIT(); asm volatile("" ::: "memory");
    const int c = lane & 3;
#pragma unroll
    for (int j = 0; j < 4; ++j) { const int n = (lane >> 2) + 16 * j; const LAS float* s = scr + (16 * c) * 65 + n;
        u32x4 o; o.x = pk_fp8x4(s[0 * 65] * scale, s[1 * 65] * scale, s[2 * 65] * scale, s[3 * 65] * scale); o.y = pk_fp8x4(s[4 * 65] * scale, s[5 * 65] * scale, s[6 * 65] * scale, s[7 * 65] * scale);
        o.z = pk_fp8x4(s[8 * 65] * scale, s[9 * 65] * scale, s[10 * 65] * scale, s[11 * 65] * scale); o.w = pk_fp8x4(s[12 * 65] * scale, s[13 * 65] * scale, s[14 * 65] * scale, s[15 * 65] * scale);
        *(u32x4*)(WT + (drow0 + n + (n >= 32 ? hi_skip : 0)) * dKb + k0 + 16 * c) = o; }
    LDS_WAIT(); asm volatile("" ::: "memory");
}
struct TrD { const float* src; int N; unsigned char* dst; int dKb, drow0, hi_skip, fp8; };
__device__ __forceinline__ void tr_load(const TrD& d, f32x4 (&v)[16], int lane) {
    const int nq = lane & 15, kr = lane >> 4;
#pragma unroll
    for (int i = 0; i < 16; ++i) v[i] = *(const f32x4*)(d.src + (size_t)(4 * i + kr) * d.N + 4 * nq);
}
__device__ __forceinline__ void tr_store(const TrD& d, const f32x4 (&v)[16], LAS float* scr, int lane) {
    const int nq = lane & 15, kr = lane >> 4;
#pragma unroll
    for (int i = 0; i < 16; ++i) { LAS float* p = scr + (4 * i + kr) * 65 + 4 * nq; p[0] = v[i].x; p[1] = v[i].y; p[2] = v[i].z; p[3] = v[i].w; }
    LDS_WAIT(); asm volatile("" ::: "memory");
    if (d.fp8) { const int c = lane & 3; const float scale = (float)(1 << MOE_WSH);
#pragma unroll
        for (int j = 0; j < 4; ++j) { const int n = (lane >> 2) + 16 * j; const LAS float* s = scr + (16 * c) * 65 + n;
            u32x4 o; o.x = pk_fp8x4(s[0 * 65] * scale, s[1 * 65] * scale, s[2 * 65] * scale, s[3 * 65] * scale); o.y = pk_fp8x4(s[4 * 65] * scale, s[5 * 65] * scale, s[6 * 65] * scale, s[7 * 65] * scale);
            o.z = pk_fp8x4(s[8 * 65] * scale, s[9 * 65] * scale, s[10 * 65] * scale, s[11 * 65] * scale); o.w = pk_fp8x4(s[12 * 65] * scale, s[13 * 65] * scale, s[14 * 65] * scale, s[15 * 65] * scale);
            *(u32x4*)(d.dst + (size_t)(d.drow0 + n + (n >= 32 ? d.hi_skip : 0)) * d.dKb + 16 * c) = o; } }
    else { const int c = lane & 7;
#pragma unroll
        for (int j = 0; j < 8; ++j) { const int n = (lane >> 3) + 8 * j; const LAS float* s = scr + (8 * c) * 65 + n;
            u32x4 o; o.x = cvtpk(s[0 * 65], s[1 * 65]); o.y = cvtpk(s[2 * 65], s[3 * 65]); o.z = cvtpk(s[4 * 65], s[5 * 65]); o.w = cvtpk(s[6 * 65], s[7 * 65]);
            *(u32x4*)(d.dst + (size_t)(d.drow0 + n + (n >= 32 ? d.hi_skip : 0)) * d.dKb + 16 * c) = o; } }
    LDS_WAIT(); asm volatile("" ::: "memory");
}
constexpr int TR_I0 = 2 * 384, TR_I1 = 2 * 256, TR_I2 = 4 * 16, TR_I3 = 16 * 81, TR_I4 = 32 * 16, TR_I5 = 128 * 256, TR_I6 = 128 * 128, TR_ITOT = TR_I0 + TR_I1 + TR_I2 + TR_I3 + TR_I4 + TR_I5 + TR_I6;
__device__ __forceinline__ TrD tr_decode(const Args& a, int it) {
    TrD d; int r = it; d.hi_skip = 0;
    if (r < TR_I5) { const int m = r / 256, q = r % 256, kb = q / 16, nb = q % 16, n0 = nb * 64, j = n0 & 511;
        d.src = a.in[I_WGU] + (size_t)m * 1024 * 1024 + (size_t)kb * 64 * 1024 + n0; d.N = 1024; d.drow0 = 256 * (j >> 7) + (j & 127) + ((n0 >= 512) ? 128 : 0);
        d.fp8 = MOE_FP8; d.dKb = MOE_FP8 ? 1024 : 2048; d.dst = (unsigned char*)(a.ws + WS_WGU) + (size_t)m * 1024 * d.dKb + (size_t)kb * 64 * (MOE_FP8 ? 1 : 2); return d; }
    r -= TR_I5;
    if (r < TR_I6) { const int m = r / 128, q = r % 128, kb = q / 16, nb = q % 16;
        d.src = a.in[I_WDN] + (size_t)m * 512 * 1024 + (size_t)kb * 64 * 1024 + nb * 64; d.N = 1024; d.drow0 = nb * 64;
        d.fp8 = MOE_FP8; d.dKb = MOE_FP8 ? 512 : 1024; d.dst = (unsigned char*)(a.ws + WS_WDN) + (size_t)m * 1024 * d.dKb + (size_t)kb * 64 * (MOE_FP8 ? 1 : 2); return d; }
    r -= TR_I6;
    if (r < TR_I0) { const int m = r / 384, q = r % 384, kb = q / 24, nb = q % 24;
        d.src = a.in[I_WQKV] + (size_t)m * 1024 * 1536 + (size_t)kb * 64 * 1536 + nb * 64; d.N = 1536; d.drow0 = (nb >> 2) * 256 + (nb & 3) * 32; d.hi_skip = 96;
        d.fp8 = ATT_FP8; d.dKb = ATT_FP8 ? 1024 : 2048; d.dst = (unsigned char*)(a.ws + WS_WQKV) + (size_t)m * 1536 * d.dKb + (size_t)kb * 64 * (ATT_FP8 ? 1 : 2); return d; }
    r -= TR_I0;
    if (r < TR_I1) { const int m = r / 256, q = r % 256, kb = q / 16, nb = q % 16;
        d.src = a.in[I_WO] + (size_t)m * 1024 * 1024 + (size_t)kb * 64 * 1024 + nb * 64; d.N = 1024; d.drow0 = nb * 64;
        d.fp8 = ATT_FP8; d.dKb = ATT_FP8 ? 1024 : 2048; d.dst = (unsigned char*)(a.ws + WS_WO) + (size_t)m * 1024 * d.dKb + (size_t)kb * 64 * (ATT_FP8 ? 1 : 2); return d; }
    r -= TR_I1;
    d.fp8 = 0;
    if (r < TR_I2) { const int m = r / 16, q = r % 16, kb = q / 4, nb = q % 4;
        d.src = a.in[I_POOLW] + (size_t)m * 256 * 256 + (size_t)kb * 64 * 256 + nb * 64; d.N = 256; d.drow0 = nb * 64; d.dKb = 512; d.dst = (unsigned char*)(a.ws + WS_WPOOL) + (size_t)m * 256 * 512 + (size_t)kb * 128; return d; }
    r -= TR_I2;
    if (r < TR_I3) { const int kb = r / 81, nb = r % 81;
        d.src = a.in[I_WIN] + (size_t)kb * 64 * 5184 + nb * 64; d.N = 5184; d.drow0 = nb * 64; d.dKb = 2048; d.dst = (unsigned char*)(a.ws + WS_WIN) + (size_t)kb * 128; return d; }
    r -= TR_I3;
    { const int kb = r / 16, nb = r % 16;
        d.src = a.in[I_WOUT] + (size_t)kb * 64 * 1024 + nb * 64; d.N = 1024; d.drow0 = nb * 64; d.dKb = 4096; d.dst = (unsigned char*)(a.ws + WS_WOUT) + (size_t)kb * 128; return d; }
}
__device__ __forceinline__ void p0_prologue(const Args& a, const Ctx& c) {
    LAS float* scr = (LAS float*)(c.lds + c.wave * 16896);
    const int gw = c.vcu * NWAVES + c.wave, NGW = c.G * NWAVES;
    { f32x4 va[16], vb[16]; TrD da, db; int it = gw;
      da = tr_decode(a, it < TR_ITOT ? it : TR_ITOT - 1); tr_load(da, va, c.lane);
      while (it < TR_ITOT) {
          const int itB = it + NGW; db = tr_decode(a, itB < TR_ITOT ? itB : TR_ITOT - 1); tr_load(db, vb, c.lane);
          tr_store(da, va, scr, c.lane);
          if (itB >= TR_ITOT) break;
          const int itA = itB + NGW; da = tr_decode(a, itA < TR_ITOT ? itA : TR_ITOT - 1); tr_load(da, va, c.lane);
          tr_store(db, vb, scr, c.lane);
          it = itA; } }
    __syncthreads();
    LAS float* sv = (LAS float*)c.lds;
    LAS float* part = (LAS float*)(c.lds + 20480);
    for (int u = c.tid; u < 5 * 1024; u += NTHREADS) { const int v = u >> 10, k = u & 1023; const float x = v < 4 ? a.in[I_C][v * 1024 + k] : a.in[I_CCTX][k]; sv[u] = x / (1.0f + expf(-x)); }
    __syncthreads();
    for (int item = blockIdx.x; item < 4 * 64; item += c.G) {
        const int li = item >> 6, c0 = (item & 63) * 96, cq = c.tid % 24, ks = c.tid / 24;
        f32x4 acc[5];
#pragma unroll
        for (int v = 0; v < 5; ++v) acc[v] = (f32x4){0.f, 0.f, 0.f, 0.f};
        if (ks < 21) { const int kbeg = ks * 49, kend = (kbeg + 49) < 1024 ? (kbeg + 49) : 1024;
            const float* w = a.in[I_WADA] + ((size_t)li * 1024 + kbeg) * 6144 + c0 + 4 * cq;
#pragma unroll 7
            for (int k = kbeg; k < kend; ++k) { const f32x4 wv = *(const f32x4*)w; w += 6144;
#pragma unroll
                for (int v = 0; v < 5; ++v) acc[v] += wv * sv[v * 1024 + k]; }
#pragma unroll
            for (int v = 0; v < 5; ++v) *(LAS f32x4*)(part + (ks * 24 + cq) * 20 + v * 4) = acc[v]; }
        __syncthreads();
        if (c.tid < 480) { const int v = c.tid / 96, col = c.tid % 96, q = col >> 2, e = col & 3; float s = 0.f;
            for (int k2 = 0; k2 < 21; ++k2) s += part[(k2 * 24 + q) * 20 + v * 4 + e];
            s += a.in[I_BADA][li * 6144 + c0 + col];
            if (v < 4) ((float*)(a.ws + WS_MODL))[(size_t)(li * 4 + v) * 6144 + c0 + col] = s; else ((float*)(a.ws + WS_MODC))[(size_t)li * 6144 + c0 + col] = s; }
        __syncthreads();
    }
    if (blockIdx.x == (unsigned)(c.G - 1)) for (int u = c.tid; u < 1024; u += NTHREADS) { const int pos = u >> 4, f = u & 15;
        const float inv = (float)pow(10000.0, -(double)f / 16.0); const double ang = (double)((float)pos * inv);
        ((f32x2*)(a.ws + WS_ROPE))[u] = (f32x2){(float)cos(ang), (float)sin(ang)}; }
    for (int u = blockIdx.x * NTHREADS + c.tid; u < 4 * 64 * 1024; u += c.G * NTHREADS) { const int li = u >> 16, n = (u >> 10) & 63, k = u & 1023;
        float w = 0.f; if (n < 4) w = a.in[I_WRG][((size_t)li * 1024 + k) * 4 + n]; else if (n < 36) w = a.in[I_WRE][((size_t)li * 1024 + k) * 32 + (n - 4)];
        const unsigned hi = cvtpk(w, 0.f) & 0xffffu; const float rem = w - bflo(hi); const unsigned lo = cvtpk(rem, 0.f) & 0xffffu;
        bf16* wr = (bf16*)(a.ws + WS_WR) + (size_t)li * 2 * 65536; wr[n * 1024 + k] = (bf16)hi; wr[65536 + n * 1024 + k] = (bf16)lo; }
}

__device__ __forceinline__ void ph_rmix(const Args& a, const Ctx& c, int layer) {
    const int gw = c.vcu * NWAVES + c.wave, NGW = c.G * NWAVES;
    const float* g = a.in[I_NMIX] + layer * D;
    for (int r = gw; r < TT; r += NGW) {
        f32x4 v[4], h[4]; load_row_combined(a, layer, r, c.lane, v);
        if (layer > 0) { u32x2* xo = (u32x2*)((bf16*)(a.ws + WS_X) + (size_t)r * D) + c.lane;
#pragma unroll
            for (int j = 0; j < 4; ++j) xo[64 * j] = (u32x2){cvtpk(v[j].x, v[j].y), cvtpk(v[j].z, v[j].w)}; }
        const float rstd = row_rstd(v); const float* m = mod_row(a, layer, r);
        norm_mod(v, rstd, g, m, m + D, c.lane, h);
        if (ATT_FP8 && layer != 2) { unsigned* ho8 = (unsigned*)((unsigned char*)(a.ws + WS_HB) + (size_t)r * D) + c.lane;
#pragma unroll
            for (int j = 0; j < 4; ++j) ho8[64 * j] = pk_fp8x4(h[j].x, h[j].y, h[j].z, h[j].w); }
        else { u32x2* ho = (u32x2*)((bf16*)(a.ws + WS_HB) + (size_t)r * D) + c.lane;
#pragma unroll
            for (int j = 0; j < 4; ++j) ho[64 * j] = (u32x2){cvtpk(h[j].x, h[j].y), cvtpk(h[j].z, h[j].w)}; }
    }
}

__device__ __forceinline__ void ph_final(const Args& a, const Ctx& c, int layer) {
    const int gw = c.vcu * NWAVES + c.wave, NGW = c.G * NWAVES;
    float dscale = 1.f, dmark = 0.f;
#if DEBUG_CHECKS
    { unsigned* dbg = (unsigned*)(a.ws + WS_CTL) + CW_DBG; int code = 0; float mag = 0.f;
      for (int id = 1; id < 32; ++id) { const float e = __uint_as_float(__hip_atomic_load(dbg + id, __ATOMIC_RELAXED, __HIP_MEMORY_SCOPE_AGENT)); if (code == 0 && e > DBG_TOL) { code = id; mag = e; } }
      dscale = 1.f + (float)code; dmark = code ? 100.f * (1.f + fminf(fmaxf(log2f(mag / DBG_TOL), 0.f), 30.f)) : 0.f; }
#endif
    for (int r = gw; r < TL; r += NGW) {
        f32x4 v[4]; load_row_combined(a, layer, r, c.lane, v);
        const float rstd = row_rstd(v) * dscale;
        f32x4* o = (f32x4*)(a.out + (size_t)r * D) + c.lane;
#pragma unroll
        for (int j = 0; j < 4; ++j) { f32x4 ov = (v[j] * rstd) * ((const f32x4*)a.in[I_NFIN])[c.lane + 64 * j]; if (j == 0 && r == 0 && c.lane == 0 && dmark > 0.f) ov.x = dmark; o[64 * j] = ov; }
    }
}


namespace pg8 {
constexpr int BM = 256, BK = 64, HALF = 128, HTB = HALF * BK * 2, STAGE_BYTES = 8 * HTB;
__host__ __device__ __forceinline__ int lds_byte(int r, int c) { const int st = (r >> 4) * 2 + (c >> 5), rr = r & 15, cc = c & 31, ob = rr * 64 + cc * 2; return st * 1024 + (ob ^ (((ob >> 9) & 1) << 5)); }
__host__ __device__ __forceinline__ void stage_rc(int b, int& R, int& C) { const int st = b / 1024, sb = b % 1024, swz = sb ^ (((sb >> 9) & 1) << 5); R = (st >> 1) * 16 + swz / 64; C = (st & 1) * 32 + (swz % 64) / 2; }
__host__ __device__ __forceinline__ int perm32(int rho) { const int n = rho >> 4, i = rho & 15; return 8 * (i >> 2) + 4 * n + (i & 3); }
struct Unit { const char* A; const char* B; int pm, pn, x0, x1; };
__device__ __forceinline__ void tile_of(int L, int nM, int nN, int& pm, int& pn) {
    const int nwg = nM * nN; int wgid = L; { const int q = nwg / 8, r = nwg % 8, xcd = wgid % 8, off = wgid / 8; wgid = (xcd < r ? xcd * (q + 1) : r * (q + 1) + (xcd - r) * q) + off; }
    const int nig = 8 * nN, gid = wgid / nig, fm = gid * 8, gsz = (nM - fm) < 8 ? (nM - fm) : 8;
    pm = fm + ((wgid % nig) % gsz); pn = (wgid % nig) / gsz;
}
typedef int v4i_t __attribute__((ext_vector_type(4))); typedef int v8i_t __attribute__((ext_vector_type(8)));
template <class Epi, class Sched, bool GATHER, bool FP8 = false>
__device__ __forceinline__ void gemm_phase(LAS unsigned char* lds, const int Kb, const int ldab, const Sched& S, const Epi& E, const int scw = 127, const int sca = 127) {
    const int tid = tid_opaque(), wid = __builtin_amdgcn_readfirstlane(tid >> 6), lane = tid & 63, wr = wid >> 2, wc = wid & 3, fr = lane & 15, fq = lane >> 4;
    const int nt = Kb / (BK * 2);
    int scw_v = scw, sca_v = sca;
    unsigned voffA[2], voffB[2]; int RA[2], CA[2];
#pragma unroll
    for (int i = 0; i < 2; ++i) { int R, C; stage_rc(tid * 16 + i * 8192, R, C); const int Rb = Epi::PERM ? ((R & ~31) + perm32(R & 31)) : R;
        RA[i] = R; CA[i] = C; voffA[i] = (unsigned)(R * ldab + C * 2); voffB[i] = (unsigned)(Rb * Kb + C * 2); }
    const size_t kstep = (size_t)(BK * 2);
    const size_t hstepA = (size_t)HALF * ldab, hstepB = (size_t)HALF * Kb;
    const unsigned ldsw = (unsigned)wid * 1024u;
    const int aoff = lds_byte(wr * 64 + fr, fq * 8), boff = lds_byte(wc * 32 + fr, fq * 8);
#define PG8_SA(b, h) (((b) * 2 + (h)) * HTB)
#define PG8_SB(b, h) ((4 + (b) * 2 + (h)) * HTB)
#define PG8_GLDS(bufoff, gptr, i_) __builtin_amdgcn_global_load_lds((const unsigned*)(gptr), (LAS unsigned*)(lds + (bufoff) + ldsw + (i_) * 8192), 16, 0, 0)
#define PG8_STAGE_B(bufoff, gbase) do { _Pragma("unroll") for (int _i = 0; _i < 2; ++_i) PG8_GLDS(bufoff, (const char*)(gbase) + voffB[_i], _i); } while (0)
#define PG8_STAGE_A(bufoff, ab, kb, h, NX) do { _Pragma("unroll") for (int _i = 0; _i < 2; ++_i) { \
        if constexpr (GATHER) { const unsigned _vo = (NX) ? voN[h][_i] : voC[h][_i]; PG8_GLDS(bufoff, (ab) + (kb) + _vo, _i); } \
        else { PG8_GLDS(bufoff, (ab) + (kb) + (size_t)(h) * hstepA + voffA[_i], _i); } } } while (0)
#define PG8_LDA(dst, b, h) do { _Pragma("unroll") for (int m = 0; m < 4; ++m) _Pragma("unroll") for (int k = 0; k < 2; ++k) dst[m][k] = *(const LAS bf16x8*)(lds + PG8_SA(b, h) + aoff + m * 2048 + k * 1024); } while (0)
#define PG8_LDB(dst, b, h) do { _Pragma("unroll") for (int n = 0; n < 2; ++n) _Pragma("unroll") for (int k = 0; k < 2; ++k) dst[n][k] = *(const LAS bf16x8*)(lds + PG8_SB(b, h) + boff + n * 2048 + k * 1024); } while (0)
#define PG8_MMA(ai, bj, At, Bt) do { __builtin_amdgcn_s_setprio(1); _Pragma("unroll") for (int m = 0; m < 4; ++m) _Pragma("unroll") for (int n = 0; n < 2; ++n) { \
        if constexpr (FP8) { const v8i_t b8 = __builtin_shufflevector(__builtin_bit_cast(v4i_t, Bt[n][0]), __builtin_bit_cast(v4i_t, Bt[n][1]), 0, 1, 2, 3, 4, 5, 6, 7), a8 = __builtin_shufflevector(__builtin_bit_cast(v4i_t, At[m][0]), __builtin_bit_cast(v4i_t, At[m][1]), 0, 1, 2, 3, 4, 5, 6, 7); \
            asm volatile("v_mfma_scale_f32_16x16x128_f8f6f4 %0, %1, %2, %0, %3, %4 op_sel_hi:[0,0,0]" : "+v"(acc[ai][bj][m][n]) : "v"(b8), "v"(a8), "v"(scw_v), "v"(sca_v)); } \
        else { _Pragma("unroll") for (int k = 0; k < 2; ++k) acc[ai][bj][m][n] = __builtin_amdgcn_mfma_f32_16x16x32_bf16(Bt[n][k], At[m][k], acc[ai][bj][m][n], 0, 0, 0); } } __builtin_amdgcn_s_setprio(0); } while (0)
#define PG8_WAIT_V(n) asm volatile("s_waitcnt vmcnt(" #n ")" ::: "memory")
#define PG8_WAIT_L(n) asm volatile("s_waitcnt lgkmcnt(" #n ")" ::: "memory")
#define PG8_BAR __builtin_amdgcn_s_barrier()
#define PG8_SCHED __builtin_amdgcn_sched_barrier(0)
    Unit cur, nxt, pend; int ui = 0; bool have_pend = false;
    if (!S.next(0, cur)) return;
    pend = cur;
    unsigned voC[2][2], voN[2][2];
    if constexpr (GATHER) {
#pragma unroll
        for (int h = 0; h < 2; ++h)
#pragma unroll
            for (int i = 0; i < 2; ++i) { voC[h][i] = (unsigned)(S.gather(cur, h * HALF + RA[i]) * ldab + CA[i] * 2); voN[h][i] = voC[h][i]; }
    } else { voC[0][0] = voN[0][0] = 0u; }
    f32x4 acc[2][2][4][2];
#pragma unroll
    for (int a = 0; a < 2; ++a)
#pragma unroll
        for (int b = 0; b < 2; ++b)
#pragma unroll
            for (int m = 0; m < 4; ++m)
#pragma unroll
                for (int n = 0; n < 2; ++n) acc[a][b][m][n] = (f32x4){0.f, 0.f, 0.f, 0.f};
    bf16x8 At[4][2], B0[2][2], B1[2][2];
    const char* cA = cur.A; const char* cB = cur.B;
    S.a_ready(cur, wid);
    PG8_STAGE_B(PG8_SB(0, 0), cB); PG8_STAGE_B(PG8_SB(0, 1), cB + hstepB); PG8_STAGE_A(PG8_SA(0, 0), cA, (size_t)0, 0, false); PG8_STAGE_A(PG8_SA(0, 1), cA, (size_t)0, 1, false);
    if (wr == 1) PG8_BAR;
    PG8_WAIT_V(2); PG8_BAR;
    PG8_STAGE_B(PG8_SB(1, 0), cB + kstep); PG8_STAGE_A(PG8_SA(1, 0), cA, kstep, 0, false); PG8_STAGE_B(PG8_SB(1, 1), cB + hstepB + kstep);
    PG8_WAIT_V(6); PG8_BAR;
    for (;;) {
        const bool has_next = S.next(ui + 1, nxt);
        if constexpr (GATHER) { if (has_next) {
#pragma unroll
            for (int h = 0; h < 2; ++h)
#pragma unroll
                for (int i = 0; i < 2; ++i) voN[h][i] = (unsigned)(S.gather(nxt, h * HALF + RA[i]) * ldab + CA[i] * 2); } }
        const char* nA = has_next ? nxt.A : cA; const char* nB = has_next ? nxt.B : cB;
        for (int t = 0; t < nt; t += 2) {
            const bool last = (t == nt - 2);
            const size_t k1 = (size_t)(t + 1) * kstep;
            const char* a2 = last ? nA : cA; const size_t k2 = last ? (size_t)0 : (size_t)(t + 2) * kstep; const size_t k3 = k2 + kstep;
            const char* b2 = last ? nB : cB + (size_t)(t + 2) * kstep; const char* b3 = b2 + kstep;
            const bool nx = GATHER ? (last && has_next) : false;
            if (last && has_next) S.a_ready(nxt, wid);
            PG8_LDB(B0, 0, 0); PG8_LDB(B1, 0, 1); PG8_SCHED; PG8_LDA(At, 0, 0); PG8_STAGE_A(PG8_SA(1, 1), cA, k1, 1, false);
            PG8_WAIT_V(8); PG8_WAIT_L(0); PG8_BAR; PG8_MMA(0, 0, At, B0); PG8_MMA(0, 1, At, B1); PG8_BAR; PG8_SCHED;
            PG8_LDA(At, 0, 1); PG8_STAGE_B(PG8_SB(0, 0), b2); PG8_STAGE_B(PG8_SB(0, 1), b2 + hstepB); PG8_STAGE_A(PG8_SA(0, 0), a2, k2, 0, nx);
            PG8_WAIT_V(8); PG8_WAIT_L(0);
            if constexpr (!Sched::IMM_DONE) { if (have_pend) { S.done(pend, lane); have_pend = false; } }
            PG8_BAR; PG8_MMA(1, 0, At, B0); PG8_MMA(1, 1, At, B1); PG8_BAR; PG8_SCHED;
            PG8_LDB(B0, 1, 0); PG8_LDB(B1, 1, 1); PG8_SCHED; PG8_LDA(At, 1, 0); PG8_STAGE_A(PG8_SA(0, 1), a2, k2, 1, nx);
            PG8_WAIT_V(8); PG8_WAIT_L(0); PG8_BAR; PG8_MMA(0, 0, At, B0); PG8_MMA(0, 1, At, B1); PG8_BAR; PG8_SCHED;
            PG8_LDA(At, 1, 1); PG8_STAGE_B(PG8_SB(1, 0), b3); PG8_STAGE_B(PG8_SB(1, 1), b3 + hstepB); PG8_STAGE_A(PG8_SA(1, 0), a2, k3, 0, nx);
            PG8_WAIT_V(8); PG8_WAIT_L(0); PG8_BAR; PG8_MMA(1, 0, At, B0); PG8_MMA(1, 1, At, B1); PG8_BAR; PG8_SCHED;
        }
        if (wr == 0) PG8_BAR;
        if constexpr (FP8) asm volatile("s_nop 15\n\ts_nop 15" ::: "memory");
        E(acc, cur, wr, wc, fr, fq);
        if constexpr (Sched::IMM_DONE) { PG8_WAIT_V(0); S.done(cur, lane); }
        else { pend = cur; have_pend = true; }
        if (!has_next) break;
#pragma unroll
        for (int a = 0; a < 2; ++a)
#pragma unroll
            for (int b = 0; b < 2; ++b)
#pragma unroll
                for (int m = 0; m < 4; ++m)
#pragma unroll
                    for (int n = 0; n < 2; ++n) acc[a][b][m][n] = (f32x4){0.f, 0.f, 0.f, 0.f};
        cur = nxt; cA = nA; cB = nB; ++ui;
        if constexpr (GATHER) {
#pragma unroll
            for (int h = 0; h < 2; ++h)
#pragma unroll
                for (int i = 0; i < 2; ++i) voC[h][i] = voN[h][i]; }
        if (wr == 1) PG8_BAR;
    }
    PG8_WAIT_V(0);
    if constexpr (!Sched::IMM_DONE) { if (have_pend) S.done(pend, lane); }
    PG8_BAR;
#undef PG8_SA
#undef PG8_SB
#undef PG8_GLDS
#undef PG8_STAGE_A
#undef PG8_STAGE_B
#undef PG8_LDA
#undef PG8_LDB
#undef PG8_MMA
#undef PG8_WAIT_V
#undef PG8_WAIT_L
#undef PG8_BAR
#undef PG8_SCHED
}
}
#include <hip/hip_bf16.h>
#include <cmath>
namespace attn_body {
using bf16=__hip_bfloat16;
using bf16x8=__attribute__((ext_vector_type(8)))short;
using s16x4=__attribute__((ext_vector_type(4)))short;
using f32x16=__attribute__((ext_vector_type(16)))float;
using u32x4=__attribute__((ext_vector_type(4)))unsigned;
constexpr int D=64,QP=1024,KVP=256;
constexpr int NW=8,QBLK=32,QB=QBLK*NW,KVBLK=64;
__device__ __forceinline__ int crow(int r,int hi){return (r&3)+8*(r>>2)+4*hi;}
#define SBAR() __builtin_amdgcn_sched_barrier(0)
constexpr int NSLOT=3, SLOTB=8192;
constexpr int LDS_K=0, LDS_V=NSLOT*SLOTB, LDS_WS=2*NSLOT*SLOTB, LDS_OST=LDS_WS+NW*64*4, LDS_BYTES=LDS_OST+NW*4096;
constexpr float C2=0.125f*1.4426950408889634f;
__device__ __forceinline__ void glds16s(const void*sbase,unsigned voff,unsigned lds_dst){unsigned keep;
  asm volatile("s_mov_b32 %0, m0\n\ts_mov_b32 m0, %3\n\ts_nop 4\n\tglobal_load_lds_dwordx4 %1, %2\n\ts_mov_b32 m0, %0":"=&s"(keep):"v"(voff),"s"(sbase),"s"(lds_dst):"memory");}
__device__ __forceinline__ float max3f(float a,float b,float c){float r;asm("v_max3_f32 %0, %1, %2, %3":"=v"(r):"v"(a),"v"(b),"v"(c));return r;}
__device__ __forceinline__ float max2f(float a,float b){float r;asm("v_max_f32_e32 %0, %1, %2":"=v"(r):"v"(a),"v"(b));return r;}
__device__ __forceinline__ float fadd_s(float a,float b){float r;asm("v_add_f32_e32 %0, %1, %2":"=v"(r):"v"(a),"v"(b));return r;}
__device__ __forceinline__ float fsub_s(float a,float b){float r;asm("v_sub_f32_e32 %0, %1, %2":"=v"(r):"v"(a),"v"(b));return r;}
typedef float f32x2_t __attribute__((ext_vector_type(2))); typedef __bf16 bf16x2_t __attribute__((ext_vector_type(2)));
__device__ __forceinline__ unsigned cvtpk_s(float lo,float hi){f32x2_t v={lo,hi};bf16x2_t b=__builtin_convertvector(v,bf16x2_t);return __builtin_bit_cast(unsigned,b);}
#define WAIT_BAR(N) asm volatile("s_waitcnt vmcnt(" #N ") lgkmcnt(0)\n\ts_barrier":::"memory")

__device__ __forceinline__ void qkt(f32x16&p0,f32x16&p1,const char*Kslot,const bf16x8*qr,const f32x16&negm,int r32,int hi){
  const char*kb=Kslot+hi*1024+r32*16;
  #pragma unroll
  for(int d0=0;d0<4;++d0){
    const bf16x8 b0=*reinterpret_cast<const bf16x8*>(kb+d0*2048);
    const bf16x8 b1=*reinterpret_cast<const bf16x8*>(kb+d0*2048+512);
    if(d0==0){p0=__builtin_amdgcn_mfma_f32_32x32x16_bf16(b0,qr[0],negm,0,0,0);p1=__builtin_amdgcn_mfma_f32_32x32x16_bf16(b1,qr[0],negm,0,0,0);}
    else{p0=__builtin_amdgcn_mfma_f32_32x32x16_bf16(b0,qr[d0],p0,0,0,0);p1=__builtin_amdgcn_mfma_f32_32x32x16_bf16(b1,qr[d0],p1,0,0,0);}}
}
typedef __attribute__((address_space(3))) const char* lds_cptr;
typedef short v4i16_t __attribute__((ext_vector_type(4)));
__device__ __forceinline__ void kload8(bf16x8*kf,lds_cptr kp){
  kf[0]=*(const __attribute__((address_space(3))) bf16x8*)(kp);      kf[1]=*(const __attribute__((address_space(3))) bf16x8*)(kp+512);
  kf[2]=*(const __attribute__((address_space(3))) bf16x8*)(kp+2048); kf[3]=*(const __attribute__((address_space(3))) bf16x8*)(kp+2560);
  kf[4]=*(const __attribute__((address_space(3))) bf16x8*)(kp+4096); kf[5]=*(const __attribute__((address_space(3))) bf16x8*)(kp+4608);
  kf[6]=*(const __attribute__((address_space(3))) bf16x8*)(kp+6144); kf[7]=*(const __attribute__((address_space(3))) bf16x8*)(kp+6656);
}
__device__ __forceinline__ void kload2(bf16x8*kf,lds_cptr kp,int j){ kf[2*j]=*(const __attribute__((address_space(3))) bf16x8*)(kp+j*2048); kf[2*j+1]=*(const __attribute__((address_space(3))) bf16x8*)(kp+j*2048+512); }
__device__ __forceinline__ s16x4 vtr(lds_cptr p){ return __builtin_bit_cast(s16x4,__builtin_amdgcn_ds_read_tr16_b64_v4i16((__attribute__((address_space(3))) v4i16_t*)p)); }
__device__ __forceinline__ float rowmax(const f32x16&p0,const f32x16&p1){
  float a=max3f(p0[0],p0[1],p1[0]),b=max3f(p0[2],p0[3],p1[1]);a=max3f(a,p1[2],p1[3]);
  #pragma unroll
  for(int r=4;r<16;r+=4){a=max3f(a,p0[r],p0[r+1]);b=max3f(b,p0[r+2],p0[r+3]);a=max3f(a,p1[r],p1[r+1]);b=max3f(b,p1[r+2],p1[r+3]);}
  const float m=max2f(a,b);
  auto rr=__builtin_amdgcn_permlane32_swap(__float_as_uint(m),__float_as_uint(m),false,false);
  return max2f(__uint_as_float(rr[0]),__uint_as_float(rr[1]));
}
__device__ __forceinline__ void pv(f32x16*o,int vb,bf16x8 pa0,bf16x8 pa1,bf16x8 pa2,bf16x8 pa3){
  #pragma unroll
  for(int d0=0;d0<2;++d0){s16x4 lo[4],hi[4];
    #pragma unroll
    for(int ks=0;ks<4;++ks){
      asm volatile("ds_read_b64_tr_b16 %0,%1 offset:%c2":"=&v"(lo[ks]):"v"(vb),"i"(d0*4096+ks*1024):"memory");
      asm volatile("ds_read_b64_tr_b16 %0,%1 offset:%c2":"=&v"(hi[ks]):"v"(vb),"i"(d0*4096+ks*1024+512):"memory");}
    asm volatile("s_waitcnt lgkmcnt(0)":::"memory");SBAR();
    #define PK(k) (bf16x8){lo[k][0],lo[k][1],lo[k][2],lo[k][3],hi[k][0],hi[k][1],hi[k][2],hi[k][3]}
    o[d0]=__builtin_amdgcn_mfma_f32_32x32x16_bf16(pa0,PK(0),o[d0],0,0,0);
    o[d0]=__builtin_amdgcn_mfma_f32_32x32x16_bf16(pa1,PK(1),o[d0],0,0,0);
    o[d0]=__builtin_amdgcn_mfma_f32_32x32x16_bf16(pa2,PK(2),o[d0],0,0,0);
    o[d0]=__builtin_amdgcn_mfma_f32_32x32x16_bf16(pa3,PK(3),o[d0],0,0,0);
    #undef PK
  }
}

#ifndef ATTN_STORE16
#define ATTN_STORE16(p,v) (*(u32x4*)(p)=(v))
#endif
template<int THRL> __device__ __forceinline__ void attn_unit(long qrow0,int h,long kvrow0,int NT,const bf16*Q,const bf16*__restrict__ K,const bf16*__restrict__ V,bf16*O,char*shm){
  const int tid=tid_opaque(),lane=tid&63,r32=lane&31,hi=lane>>5; const int wid=__builtin_amdgcn_readfirstlane(tid>>6);
  const bf16*Qw=Q+(qrow0+wid*QBLK)*QP+h*D;
  const bf16*Kh=K+kvrow0*KVP+(h>>2)*D,*Vh=V+kvrow0*KVP+(h>>2)*D;
  const unsigned lds0=(unsigned)(uintptr_t)shm;
  float*wsf=(float*)(shm+LDS_WS)+wid*64;
  const unsigned kvo=(unsigned)(lane*KVP+wid*8)*2u;
  const unsigned vvo=(unsigned)((16*(wid&3)+(lane>>2))*KVP+(wid>>2)*32+(lane&3)*8)*2u;
  const unsigned kdst=lds0+LDS_K+wid*1024, vdst=lds0+LDS_V+wid*1024;
  #define DMA_K(t,slot) glds16s(Kh+(long)(t)*KVBLK*KVP,kvo,(unsigned)__builtin_amdgcn_readfirstlane(kdst+(slot)))
  #define DMA_V(t,slot) glds16s(Vh+(long)(t)*KVBLK*KVP,vvo,(unsigned)__builtin_amdgcn_readfirstlane(vdst+(slot)))
  const int vb0=(int)(lds0+LDS_V)+((lane>>4)&1)*32+(lane&3)*8+(4*hi+((lane&15)>>2))*64;
  const char*Kbase=shm+LDS_K; bf16x8 kf[8];
  const lds_cptr shm3=(lds_cptr)shm; const lds_cptr kp0=shm3+LDS_K+hi*1024+r32*16; const lds_cptr vp0=shm3+LDS_V+((lane>>4)&1)*32+(lane&3)*8+(4*hi+((lane&15)>>2))*64;
  DMA_K(0,0);DMA_V(0,0);DMA_K(1,SLOTB);
  bf16x8 qr[4];
  #pragma unroll
  for(int d0=0;d0<4;++d0)qr[d0]=*reinterpret_cast<const bf16x8*>(&Qw[(long)r32*QP+d0*16+hi*8]);
  float mhat=0.f,l_reg=0.f;f32x16 o[2];o[0]=f32x16{};o[1]=f32x16{};f32x16 negm=f32x16{};asm volatile("":"+v"(negm));
  #define CMASK(P0,P1,t) do{}while(0)
  bool resc=false;
  #define START(P0,P1) do{ const float rm=rowmax(P0,P1); resc=false; \
    { const float dl=rm; mhat=fadd_s(mhat,dl); \
      _Pragma("unroll") for(int r=0;r<16;++r){P0[r]=fsub_s(P0[r],dl);P1[r]=fsub_s(P1[r],dl);} \
      _Pragma("unroll") for(int r=0;r<16;++r)negm[r]=-mhat; asm volatile("":"+v"(negm)); } \
    _Pragma("unroll") for(int r=0;r<16;++r)P0[r]=__builtin_amdgcn_exp2f(P0[r]); }while(0)
  #define RESC() do{ if(resc){ asm volatile("s_waitcnt lgkmcnt(0)":::"memory"); \
      _Pragma("unroll") for(int d_=0;d_<2;++d_) _Pragma("unroll") for(int r=0;r<16;++r)o[d_][r]*=wsf[crow(r,hi)]; } }while(0)
  f32x16 pA0,pA1,pB0,pB1;
  int sl_prev=0,sl_cur=0,sl_next=SLOTB;
  #define ROT() do{sl_prev=sl_cur;sl_cur=sl_next;sl_next=(sl_next==(NSLOT-1)*SLOTB)?0:sl_next+SLOTB;}while(0)
  DMA_K(2,2*SLOTB);
  WAIT_BAR(3);
  qkt(pA0,pA1,Kbase,qr,negm,r32,hi);asm volatile("s_nop 15\n\ts_nop 7":"+v"(pA0),"+v"(pA1));CMASK(pA0,pA1,0);
  START(pA0,pA1);
  _Pragma("unroll") for(int r=0;r<16;++r)pA1[r]=__builtin_amdgcn_exp2f(pA1[r]);
  WAIT_BAR(0);
  DMA_K(3,0);DMA_V(1,SLOTB);
  ROT();
  kload8(kf,kp0+sl_cur);
  WAIT_BAR(2);
  s16x4 vlo[8],vhi[8]; u32x4 pw0,pw1,pw2,pw3;
  #define PKW(P,B) cvtpk_s(P[B],P[B+1])
  #define PAF(k) __builtin_bit_cast(bf16x8,pw##k)
  #define VFR(i) (bf16x8){vlo[i][0],vlo[i][1],vlo[i][2],vlo[i][3],vhi[i][0],vhi[i][1],vhi[i][2],vhi[i][3]}
  #define PIN(x) asm volatile("":"+v"(x))
  #define MX3(a,b,c) __builtin_fmaxf(__builtin_fmaxf((a),(b)),(c))
  #define GAPA(MF,A0,A1,A2,A3,W0,W1,PW) do{ MF; sacc+=A0; sacc+=A1; sacc+=A2; sacc+=A3; PIN(sacc); W0; W1; PIN(PW); SBAR(); }while(0)
  #define EX(v) __builtin_amdgcn_exp2f(v)
  #define GAPB(MF,X,B) do{ MF; X[B]=EX(X[B]); X[B+1]=EX(X[B+1]); X[B+2]=EX(X[B+2]); X[B+3]=EX(X[B+3]); PIN(X); SBAR(); }while(0)
  #define VRD(i) do{ vlo[i]=vtr(vp_+(((i)>>2)*4096+((i)&3)*1024)); vhi[i]=vtr(vp_+(((i)>>2)*4096+((i)&3)*1024+512)); }while(0)
  #define KRD(G,j) do{ if(G){ kload2(kf,kp0+sl_next,j); SBAR(); } }while(0)
  #define STEP(C0,C1,P0,P1,t,GK,GV,GL) do{ SBAR(); \
    const lds_cptr vp_=vp0+sl_prev; \
    VRD(0); SBAR(); float sacc=(P0[0]+P0[1]); \
    GAPA(C0=__builtin_amdgcn_mfma_f32_32x32x16_bf16(kf[0],qr[0],negm,0,0,0), P0[2],P0[3],P0[4],P0[5],     pw0[0]=PKW(P0,0), pw0[1]=PKW(P0,2), pw0); \
    VRD(4); SBAR(); GAPA(C1=__builtin_amdgcn_mfma_f32_32x32x16_bf16(kf[1],qr[0],negm,0,0,0), P0[6],P0[7],P0[8],P0[9],     pw0[2]=PKW(P0,4), pw0[3]=PKW(P0,6), pw0); \
    VRD(1); SBAR(); GAPA(C0=__builtin_amdgcn_mfma_f32_32x32x16_bf16(kf[2],qr[1],C0,0,0,0),   P0[10],P0[11],P0[12],P0[13], pw1[0]=PKW(P0,8), pw1[1]=PKW(P0,10), pw1); \
    VRD(5); SBAR(); GAPA(C1=__builtin_amdgcn_mfma_f32_32x32x16_bf16(kf[3],qr[1],C1,0,0,0),   P0[14],P0[15],P1[0],P1[1],   pw1[2]=PKW(P0,12),pw1[3]=PKW(P0,14), pw1); \
    VRD(2); SBAR(); GAPA(C0=__builtin_amdgcn_mfma_f32_32x32x16_bf16(kf[4],qr[2],C0,0,0,0),   P1[2],P1[3],P1[4],P1[5],     pw2[0]=PKW(P1,0), pw2[1]=PKW(P1,2), pw2); \
    VRD(6); SBAR(); GAPA(C1=__builtin_amdgcn_mfma_f32_32x32x16_bf16(kf[5],qr[2],C1,0,0,0),   P1[6],P1[7],P1[8],P1[9],     pw2[2]=PKW(P1,4), pw2[3]=PKW(P1,6), pw2); \
    VRD(3); SBAR(); GAPA(C0=__builtin_amdgcn_mfma_f32_32x32x16_bf16(kf[6],qr[3],C0,0,0,0),   P1[10],P1[11],P1[12],P1[13], pw3[0]=PKW(P1,8), pw3[1]=PKW(P1,10), pw3); \
    VRD(7); SBAR(); GAPA(C1=__builtin_amdgcn_mfma_f32_32x32x16_bf16(kf[7],qr[3],C1,0,0,0),   P1[14],P1[15],0.f,0.f,       pw3[2]=PKW(P1,12),pw3[3]=PKW(P1,14), pw3); \
    l_reg+=sacc; \
    if(GK){DMA_K((t)+3,sl_cur);} if(GV){DMA_V((t)+1,sl_next);} \
    CMASK(C0,C1,t); \
    { float a=MX3(C0[0],C0[1],C1[0]),b=MX3(C0[2],C0[3],C1[1]); a=MX3(a,C1[2],C1[3]); \
      _Pragma("unroll") for(int r=4;r<16;r+=4){a=MX3(a,C0[r],C0[r+1]);b=MX3(b,C0[r+2],C0[r+3]);a=MX3(a,C1[r],C1[r+1]);b=MX3(b,C1[r+2],C1[r+3]);} \
      float rm=__builtin_fmaxf(a,b); { auto rr=__builtin_amdgcn_permlane32_swap(__float_as_uint(rm),__float_as_uint(rm),false,false); rm=__builtin_fmaxf(__uint_as_float(rr[0]),__uint_as_float(rr[1])); } \
      resc=false; \
      if(__builtin_expect(__any(rm>(float)THRL),0)){ const float dl=__builtin_fmaxf(rm,0.f); mhat+=dl; \
        _Pragma("unroll") for(int r=0;r<16;++r){C0[r]-=dl;C1[r]-=dl;} \
        _Pragma("unroll") for(int r=0;r<16;++r)negm[r]=-mhat; asm volatile("":"+v"(negm)); \
        const float f=__builtin_amdgcn_exp2f(-dl); l_reg*=f; if(hi==0)wsf[r32]=f; resc=true; } } \
    SBAR(); \
    GAPB(o[0]=__builtin_amdgcn_mfma_f32_32x32x16_bf16(PAF(0),VFR(0),o[0],0,0,0), C0,0); \
    GAPB(o[1]=__builtin_amdgcn_mfma_f32_32x32x16_bf16(PAF(0),VFR(4),o[1],0,0,0), C0,4); \
    KRD(GL,0); GAPB(o[0]=__builtin_amdgcn_mfma_f32_32x32x16_bf16(PAF(1),VFR(1),o[0],0,0,0), C0,8); \
    KRD(GL,1); GAPB(o[1]=__builtin_amdgcn_mfma_f32_32x32x16_bf16(PAF(1),VFR(5),o[1],0,0,0), C0,12); \
    KRD(GL,2); GAPB(o[0]=__builtin_amdgcn_mfma_f32_32x32x16_bf16(PAF(2),VFR(2),o[0],0,0,0), C1,0); \
    KRD(GL,3); GAPB(o[1]=__builtin_amdgcn_mfma_f32_32x32x16_bf16(PAF(2),VFR(6),o[1],0,0,0), C1,4); \
    GAPB(o[0]=__builtin_amdgcn_mfma_f32_32x32x16_bf16(PAF(3),VFR(3),o[0],0,0,0), C1,8); \
    GAPB(o[1]=__builtin_amdgcn_mfma_f32_32x32x16_bf16(PAF(3),VFR(7),o[1],0,0,0), C1,12); \
    }while(0)
  int t=1;
  for(;t+5<NT;t+=2){
    STEP(pB0,pB1,pA0,pA1,t,true,true,true);     WAIT_BAR(2); RESC(); ROT();
    STEP(pA0,pA1,pB0,pB1,t+1,true,true,true);   WAIT_BAR(2); RESC(); ROT();
  }
  #define ENDW(tt) do{ if((tt)+3<NT){WAIT_BAR(2);} else if((tt)+2<NT){WAIT_BAR(1);} else {WAIT_BAR(0);} }while(0)
  for(;t+1<NT;t+=2){
    STEP(pB0,pB1,pA0,pA1,t,(t+3<NT),(t+1<NT),(t+1<NT));       ENDW(t);   RESC(); ROT();
    STEP(pA0,pA1,pB0,pB1,t+1,(t+4<NT),(t+2<NT),(t+2<NT));     ENDW(t+1); RESC(); ROT();
  }
  STEP(pB0,pB1,pA0,pA1,NT-1,false,false,false); RESC();
  { float sacc=pB0[0]+pB0[1]; _Pragma("unroll") for(int r=2;r<16;++r)sacc+=pB0[r]; _Pragma("unroll") for(int r=0;r<16;++r)sacc+=pB1[r]; l_reg+=sacc;
    pw0=(u32x4){PKW(pB0,0),PKW(pB0,2),PKW(pB0,4),PKW(pB0,6)};pw1=(u32x4){PKW(pB0,8),PKW(pB0,10),PKW(pB0,12),PKW(pB0,14)};pw2=(u32x4){PKW(pB1,0),PKW(pB1,2),PKW(pB1,4),PKW(pB1,6)};pw3=(u32x4){PKW(pB1,8),PKW(pB1,10),PKW(pB1,12),PKW(pB1,14)};
    SBAR(); pv(o,vb0+sl_cur,PAF(0),PAF(1),PAF(2),PAF(3)); }
  #undef PKW
  #undef PAF
  #undef VFR
  #undef PIN
  #undef MX3
  #undef GAPA
  #undef GAPB
  #undef EX
  #undef VRD
  #undef KRD
  #undef STEP
  #undef ENDW
  {auto rr=__builtin_amdgcn_permlane32_swap(__float_as_uint(l_reg),__float_as_uint(l_reg),false,false);l_reg=__uint_as_float(rr[0])+__uint_as_float(rr[1]);}
  if(hi==0)wsf[32+r32]=l_reg;asm volatile("s_waitcnt lgkmcnt(0)":::"memory");
  float rli[16];
  #pragma unroll
  for(int r=0;r<16;++r)rli[r]=__builtin_amdgcn_rcpf(wsf[32+crow(r,hi)]);
#if ATT_FP8
  { unsigned char*Ow8=(unsigned char*)O+(qrow0+wid*QBLK)*QP+h*D;
    unsigned char*stg8=(unsigned char*)(shm+LDS_OST)+wid*4096;
    #pragma unroll
    for(int r=0;r<16;++r){const int orow=crow(r,hi);
      #pragma unroll
      for(int d0=0;d0<2;++d0){const float x=o[d0][r]*rli[r]*(float)(1<<ATT_OSH); stg8[orow*64+d0*32+r32]=(unsigned char)(__builtin_amdgcn_cvt_pk_fp8_f32(x,x,0u,false)&0xffu);}}
    asm volatile("s_waitcnt lgkmcnt(0)":::"memory");
    #pragma unroll
    for(int i=0;i<2;++i){const int row=i*16+(lane>>2),ch=lane&3; const u32x4 v=*(const u32x4*)(stg8+row*64+ch*16); ATTN_STORE16(Ow8+(long)row*QP+ch*16,v);} }
#else
  bf16*Ow=O+(qrow0+wid*QBLK)*QP+h*D;
  { bf16*stg=(bf16*)(shm+LDS_OST)+wid*2048;
    #pragma unroll
    for(int r=0;r<16;++r){const int orow=crow(r,hi);
      #pragma unroll
      for(int d0=0;d0<2;++d0)stg[orow*64+d0*32+r32]=__float2bfloat16(o[d0][r]*rli[r]);}
    asm volatile("s_waitcnt lgkmcnt(0)":::"memory");
    #pragma unroll
    for(int i=0;i<4;++i){const int row=i*8+(lane>>3),ch=lane&7; const u32x4 v=*(const u32x4*)(stg+row*64+ch*8); ATTN_STORE16(Ow+(long)row*QP+ch*8,v);} }
#endif
  asm volatile("s_waitcnt lgkmcnt(0)\n\ts_barrier":::"memory");
  #undef DMA_K
  #undef DMA_V
  #undef CMASK
  #undef START
  #undef RESC
  #undef ROT
}
constexpr int ATTN_LDS_BYTES=LDS_BYTES;
#undef SBAR
#undef WAIT_BAR
}

typedef f32x4 AccT[2][2][4][2];
__device__ __forceinline__ long kv_row(int r) { return r < TL ? (long)(r / SEQ) * KVROWS + CTXL + (r % SEQ) : (long)((r - TL) / CTXL) * KVROWS + ((r - TL) % CTXL); }

struct SchedDense {
    static constexpr bool IMM_DONE = false;
    const char* A; const char* B; size_t astep, bstep, acol; int nM, nN, G, c;
    __device__ __forceinline__ bool next(int i, pg8::Unit& u) const {
        const int L = i * G + c; if (L >= nM * nN) return false;
        pg8::tile_of(L, nM, nN, u.pm, u.pn); u.A = A + (size_t)u.pm * astep + (size_t)u.pn * acol; u.B = B + (size_t)u.pn * bstep; u.x0 = 0; u.x1 = 0; return true; }
    __device__ __forceinline__ int gather(const pg8::Unit&, int) const { return 0; }
    __device__ __forceinline__ void a_ready(const pg8::Unit&, int) const {}
    __device__ __forceinline__ void done(const pg8::Unit&, int) const {}
};
struct SchedDenseR {
    static constexpr bool IMM_DONE = true;
    const char* A; const char* B; size_t astep, bstep, acol; int nM, nN, nF, G, c; unsigned* ready;
    __device__ __forceinline__ bool next(int i, pg8::Unit& u) const {
        const int L = i * G + c, n1 = nF * nN; if (L >= nM * nN) return false;
        if (L < n1) pg8::tile_of(L, nF, nN, u.pm, u.pn); else { u.pm = nF + (L - n1) / nN; u.pn = (L - n1) % nN; }
        u.A = A + (size_t)u.pm * astep + (size_t)u.pn * acol; u.B = B + (size_t)u.pn * bstep; u.x0 = 0; u.x1 = 0; return true; }
    __device__ __forceinline__ int gather(const pg8::Unit&, int) const { return 0; }
    __device__ __forceinline__ void a_ready(const pg8::Unit&, int) const {}
    __device__ __forceinline__ void done(const pg8::Unit& u, int lane) const { if (lane == 0) __hip_atomic_fetch_add(ready + u.pm, 1u, __ATOMIC_RELAXED, __HIP_MEMORY_SCOPE_AGENT); }
};
struct SchedOutproj {
    static constexpr bool IMM_DONE = true;
    const char* A; const char* B; size_t astep, bstep; int G, c; const unsigned* rdg; unsigned* ready;
    __device__ __forceinline__ bool next(int i, pg8::Unit& u) const {
        int n;
        if (G == 256) { if (c >= 32) { if (i == 0) n = c - 32; else if (i == 1 && c < 64) n = 224 + (c - 32); else return false; } else { if (i == 0 && c < 16) n = 256 + c; else return false; } }
        else { n = i * G + c; if (n >= 272) return false; }
        u.pm = n >> 2; u.pn = n & 3; u.A = A + (size_t)u.pm * astep; u.B = B + (size_t)u.pn * bstep; u.x0 = 0; u.x1 = 0; return true; }
    __device__ __forceinline__ int gather(const pg8::Unit&, int) const { return 0; }
    __device__ __forceinline__ void a_ready(const pg8::Unit& u, int wid) const {
        if (wid == 0) { unsigned sp = 0;
            while ((unsigned)__builtin_amdgcn_readfirstlane(__hip_atomic_load(rdg + u.pm, __ATOMIC_RELAXED, __HIP_MEMORY_SCOPE_AGENT)) < 8u) { __builtin_amdgcn_s_sleep(2); if (++sp > (1u << 22)) break; }
            __builtin_amdgcn_fence(__ATOMIC_ACQUIRE, "agent"); asm volatile("s_waitcnt vmcnt(0)" ::: "memory"); }
        __builtin_amdgcn_s_barrier(); asm volatile("" ::: "memory");
    }
    __device__ __forceinline__ void done(const pg8::Unit& u, int lane) const { if (lane == 0) __hip_atomic_fetch_add(ready + u.pm, 1u, __ATOMIC_RELAXED, __HIP_MEMORY_SCOPE_AGENT); }
};
struct SchedQKV {
    static constexpr bool IMM_DONE = false;
    const char* A; const char* B; size_t tstep; int ctxq, G, c;
    __device__ __forceinline__ bool next(int i, pg8::Unit& u) const {
        const int L = i * G + c, n1 = 64 * 6, n2 = ctxq ? 24 : 8; if (L >= n1 + n2) return false;
        if (L < n1) pg8::tile_of(L, 64, 6, u.pm, u.pn);
        else if (ctxq) { pg8::tile_of(L - n1, 4, 6, u.pm, u.pn); u.pm += 64; }
        else { u.pm = 64 + ((L - n1) >> 1); u.pn = 4 + ((L - n1) & 1); }
        u.A = A + (size_t)u.pm * tstep; u.B = B + (size_t)u.pn * tstep; u.x0 = 0; u.x1 = 0; return true; }
    __device__ __forceinline__ int gather(const pg8::Unit&, int) const { return 0; }
    __device__ __forceinline__ void a_ready(const pg8::Unit&, int) const {}
    __device__ __forceinline__ void done(const pg8::Unit&, int) const {}
};
struct SchedMoe {
    static constexpr bool IMM_DONE = false;
    const char* Abase; size_t astep; const char* Bbase; size_t bstep_e, bstep_n; const LAS int* tab; const int* list; int G, c;
    unsigned* ready; int mode;
    __device__ __forceinline__ int T(int i) const { return __builtin_amdgcn_readfirstlane(tab[i]); }
    __device__ __forceinline__ bool next(int i, pg8::Unit& u) const {
        const int ntiles = T(32), L = i * G + (mode == 2 ? G - 1 - c : c); if (L >= ntiles * 4) return false;
        int gt, pn; pg8::tile_of(L, ntiles, 4, gt, pn);
        int e = 0;
        for (int q = 1; q < 32; ++q) e += (T(q) <= gt) ? 1 : 0;
        const int ti = gt - T(e); int valid = T(40 + e) - ti * 256; valid = valid > 256 ? 256 : valid;
        u.pm = gt; u.pn = pn; u.x0 = e * MOE_CAP + ti * 256; u.x1 = valid;
        u.A = Abase + (size_t)gt * astep; u.B = Bbase + (size_t)e * bstep_e + (size_t)pn * bstep_n; return true; }
    __device__ __forceinline__ int gather(const pg8::Unit& u, int lr) const { return lr < u.x1 ? (list[u.x0 + lr] >> 1) : 0; }
    __device__ __forceinline__ void a_ready(const pg8::Unit& u, int wid) const {
        if (mode != 2) return;
        if (wid == 0) { unsigned sp = 0;
            while ((unsigned)__builtin_amdgcn_readfirstlane(__hip_atomic_load(ready + u.pm, __ATOMIC_RELAXED, __HIP_MEMORY_SCOPE_AGENT)) < 32u) { __builtin_amdgcn_s_sleep(2); if (++sp > (1u << 22)) break; }
            __builtin_amdgcn_fence(__ATOMIC_ACQUIRE, "agent"); asm volatile("s_waitcnt vmcnt(0)" ::: "memory"); }
        __builtin_amdgcn_s_barrier(); asm volatile("" ::: "memory");
    }
    __device__ __forceinline__ void done(const pg8::Unit& u, int lane) const {
        if (mode != 1) return;
        if (lane == 0) __hip_atomic_fetch_add(ready + u.pm, 1u, __ATOMIC_RELAXED, __HIP_MEMORY_SCOPE_AGENT);
    }
};

struct EpiQKV { static constexpr bool PERM = true; bf16* Q; bf16* Kb; bf16* Vb; const float* qg; const float* kg; const f32x2* tab;
    __device__ __forceinline__ void operator()(const AccT& acc, const pg8::Unit& u, int wr, int wc, int fr, int fq) const {
        bf16* base; int pitch; long row0;
        if (u.pn < 4) { base = Q + u.pn * 256; pitch = 1024; row0 = (long)u.pm * 256; }
        else { base = (u.pn == 4) ? Kb : Vb; pitch = 256; row0 = kv_row(u.pm * 256); }
        const bool isv = u.pn == 5, lat = u.pm < 64; const float* g = u.pn < 4 ? qg : kg; const float post = u.pn < 4 ? 0.125f * 1.4426950408889634f : 1.0f;
#pragma unroll
        for (int ai = 0; ai < 2; ++ai)
#pragma unroll
            for (int m = 0; m < 4; ++m) { int fq_ = fq; asm volatile("" : "+v"(fq_));
                const int fq = fq_; const int lr = ai * 128 + wr * 64 + m * 16 + fr; const unsigned roff = (unsigned)(((int)row0 + lr) * pitch + wc * 64 + 8 * fq) * 2u;
                f32x4 g0[2], g1[2];
#pragma unroll
                for (int bj = 0; bj < 2; ++bj) { g0[bj] = *(const f32x4*)(g + 32 * bj + 8 * fq); g1[bj] = *(const f32x4*)(g + 32 * bj + 8 * fq + 4); }
                f32x4 v[2][2];
#pragma unroll
                for (int bj = 0; bj < 2; ++bj) { v[bj][0] = acc[ai][bj][m][0]; v[bj][1] = acc[ai][bj][m][1]; }
                if (!isv) {
                    float ss = 0.f;
#pragma unroll
                    for (int bj = 0; bj < 2; ++bj)
#pragma unroll
                        for (int n = 0; n < 2; ++n) ss += (v[bj][n][0] * v[bj][n][0] + v[bj][n][1] * v[bj][n][1]) + (v[bj][n][2] * v[bj][n][2] + v[bj][n][3] * v[bj][n][3]);
                    ss += __shfl_xor(ss, 16); ss += __shfl_xor(ss, 32);
                    const float rstd = rsqrtf(ss * (1.0f / 64.0f) + EPS);
#pragma unroll
                    for (int bj = 0; bj < 2; ++bj) { v[bj][0] = v[bj][0] * rstd * g0[bj]; v[bj][1] = v[bj][1] * rstd * g1[bj]; }
                    if (lat) { const int t = (u.pm * 256 + lr) & (SEQ - 1);
#pragma unroll
                        for (int bj = 0; bj < 2; ++bj) { const f32x2* tb = (const f32x2*)((const char*)tab + (unsigned)(((bj == 0 ? (t >> 6) : (t & 63)) * 16 + 4 * fq) * 8));
#pragma unroll
                            for (int n = 0; n < 2; ++n)
#pragma unroll
                                for (int e = 0; e < 2; ++e) { const f32x2 cs = tb[2 * n + e]; const float x0 = v[bj][n][2 * e], x1 = v[bj][n][2 * e + 1];
                                    v[bj][n][2 * e] = x0 * cs.x - x1 * cs.y; v[bj][n][2 * e + 1] = x0 * cs.y + x1 * cs.x; } } }
#pragma unroll
                    for (int bj = 0; bj < 2; ++bj) { v[bj][0] = v[bj][0] * post; v[bj][1] = v[bj][1] * post; }
                }
#pragma unroll
                for (int bj = 0; bj < 2; ++bj)
                    *(u32x4*)((char*)base + roff + bj * 64) = (u32x4){cvtpk(v[bj][0][0], v[bj][0][1]), cvtpk(v[bj][0][2], v[bj][0][3]), cvtpk(v[bj][1][0], v[bj][1][1]), cvtpk(v[bj][1][2], v[bj][1][3])}; }
    }
};
template <bool PERM_> struct EpiResidT { static constexpr bool PERM = PERM_; const Args* a; int layer; const float* pscale; const bf16* srcbase;
    __device__ __forceinline__ void operator()(const AccT& acc, const pg8::Unit& u, int wr, int wc, int, int) const {
        int ln; asm volatile("v_mbcnt_lo_u32_b32 %0, -1, 0\n\tv_mbcnt_hi_u32_b32 %0, -1, %0" : "=v"(ln)); const int fr = ln & 15, fq = ln >> 4;
        const int r0 = u.pm * 256;
        const float* gate = mod_row(*a, layer, r0) + 2 * D;
        const bool f32src = (layer == 0) && !srcbase; const float* src32 = resid_row(*a, 0, r0); const bf16* src16 = (srcbase ? srcbase : (const bf16*)(a->ws + WS_X)) + (size_t)r0 * D;
        const __amdgpu_buffer_rsrc_t rs = __builtin_amdgcn_make_buffer_rsrc((void*)(a->ws + WS_X), 0, TT * D * 2, 0x00020000);
        if constexpr (PERM_) {
#pragma unroll
        for (int bj = 0; bj < 2; ++bj) { const int cc = u.pn * 256 + bj * 128 + wc * 32 + 8 * fq;
            f32x4 g0 = *(const f32x4*)(gate + cc), g1 = *(const f32x4*)(gate + cc + 4); if (pscale) { g0 = g0 * *(const f32x4*)(pscale + cc); g1 = g1 * *(const f32x4*)(pscale + cc + 4); }
#pragma unroll
            for (int ai = 0; ai < 2; ++ai)
#pragma unroll
                for (int m = 0; m < 4; ++m) { const int off = (ai * 128 + wr * 64 + m * 16 + fr) * D + cc;
                    f32x4 s0, s1;
                    if (f32src) { s0 = *(const f32x4*)(src32 + off); s1 = *(const f32x4*)(src32 + off + 4); }
                    else { const u32x4 p = *(const u32x4*)(src16 + off); s0 = (f32x4){bflo(p.x), bfhi(p.x), bflo(p.y), bfhi(p.y)}; s1 = (f32x4){bflo(p.z), bfhi(p.z), bflo(p.w), bfhi(p.w)}; }
                    const f32x4 o0 = s0 + g0 * acc[ai][bj][m][0], o1 = s1 + g1 * acc[ai][bj][m][1];
                    __builtin_amdgcn_raw_buffer_store_b128((u32x4){cvtpk(o0.x, o0.y), cvtpk(o0.z, o0.w), cvtpk(o1.x, o1.y), cvtpk(o1.z, o1.w)}, rs, (r0 * D + off) * 2, 0, 16  ); }
            asm volatile("" ::: "memory"); }
        } else {
#pragma unroll
        for (int bj = 0; bj < 2; ++bj)
#pragma unroll
            for (int n = 0; n < 2; ++n) { const int cc = u.pn * 256 + bj * 128 + wc * 32 + n * 16 + 4 * fq; f32x4 g = *(const f32x4*)(gate + cc); if (pscale) g = g * *(const f32x4*)(pscale + cc);
#pragma unroll
                for (int ai = 0; ai < 2; ++ai)
#pragma unroll
                    for (int m = 0; m < 4; ++m) { const int off = (ai * 128 + wr * 64 + m * 16 + fr) * D + cc;
                        f32x4 s0;
                        if (f32src) s0 = *(const f32x4*)(src32 + off);
                        else { const u32x2 p = *(const u32x2*)(src16 + off); s0 = (f32x4){bflo(p.x), bfhi(p.x), bflo(p.y), bfhi(p.y)}; }
                        const f32x4 o0 = s0 + g * acc[ai][bj][m][n];
                        __builtin_amdgcn_raw_buffer_store_b64((u32x2){cvtpk(o0.x, o0.y), cvtpk(o0.z, o0.w)}, rs, (r0 * D + off) * 2, 0, 16  ); }
                asm volatile("" ::: "memory"); }
        }
    }
};
typedef EpiResidT<true> EpiResid; typedef EpiResidT<false> EpiResidN;
struct EpiGateUp { static constexpr bool PERM = true; bf16* act;
    __device__ __forceinline__ void operator()(const AccT& acc, const pg8::Unit& u, int wr, int wc, int fr, int fq) const {
        const __amdgpu_buffer_rsrc_t rs = __builtin_amdgcn_make_buffer_rsrc((void*)act, 0, 43008 * 512 * 2, 0x00020000);
#pragma unroll
        for (int ai = 0; ai < 2; ++ai)
#pragma unroll
            for (int m = 0; m < 4; ++m) { const int off = (int)((((size_t)u.pm * 256 + ai * 128 + wr * 64 + m * 16 + fr) * 512 + u.pn * 128 + wc * 32 + 8 * fq) * 2);
                const f32x4 g0 = acc[ai][0][m][0], g1 = acc[ai][0][m][1], u0 = acc[ai][1][m][0], u1 = acc[ai][1][m][1];
                const u32x4 ov = (u32x4){cvtpk(silu_f(g0[0]) * u0[0], silu_f(g0[1]) * u0[1]), cvtpk(silu_f(g0[2]) * u0[2], silu_f(g0[3]) * u0[3]),
                                     cvtpk(silu_f(g1[0]) * u1[0], silu_f(g1[1]) * u1[1]), cvtpk(silu_f(g1[2]) * u1[2], silu_f(g1[3]) * u1[3])};
#if MOE_FP8
                { const float sa = (float)(1 << MOE_ASH); const u32x2 o8 = (u32x2){pk_fp8x4(silu_f(g0[0]) * u0[0] * sa, silu_f(g0[1]) * u0[1] * sa, silu_f(g0[2]) * u0[2] * sa, silu_f(g0[3]) * u0[3] * sa),
                                                                                    pk_fp8x4(silu_f(g1[0]) * u1[0] * sa, silu_f(g1[1]) * u1[1] * sa, silu_f(g1[2]) * u1[2] * sa, silu_f(g1[3]) * u1[3] * sa)};
                  (void)ov; __builtin_amdgcn_raw_buffer_store_b64(o8, rs, off >> 1, 0, 16  ); } }
#else
                __builtin_amdgcn_raw_buffer_store_b128(ov, rs, off, 0, 16  ); }
#endif
    }
};
struct EpiDown { static constexpr bool PERM = true; const int* list; const float* w2; bf16* y2;
    __device__ __forceinline__ void operator()(const AccT& acc, const pg8::Unit& u, int wr, int wc, int fr, int fq) const {
#pragma unroll
        for (int ai = 0; ai < 2; ++ai)
#pragma unroll
            for (int m = 0; m < 4; ++m) { const int lr = ai * 128 + wr * 64 + m * 16 + fr;
                if (lr < u.x1) { const int dest = list[u.x0 + lr]; const float w = w2[dest]; bf16* p = y2 + (size_t)dest * D + u.pn * 256 + wc * 32 + 8 * fq;
#pragma unroll
                    for (int bj = 0; bj < 2; ++bj) { const f32x4 v0 = acc[ai][bj][m][0] * w, v1 = acc[ai][bj][m][1] * w;
                        *(u32x4*)(p + bj * 128) = (u32x4){cvtpk(v0[0], v0[1]), cvtpk(v0[2], v0[3]), cvtpk(v1[0], v1[1]), cvtpk(v1[2], v1[3])}; } } }
    }
};

constexpr int TAB_OFF = 135168;

__device__ __forceinline__ void ph_rope(const Args& a, const Ctx& c, int layer) {
    const int j = layer == 0 ? 0 : 1; const bool ctxq = layer == 0;
    const float* qg = a.in[I_QG] + j * 64; const float* kg = a.in[I_KG] + j * 64;
    const f32x2* tab = (const f32x2*)(a.ws + WS_ROPE);
    bf16* Qb = (bf16*)(a.ws + WS_Q); bf16* Kb = (bf16*)(a.ws + WS_K);
    const int nitems = TT * 20;
    for (int it = blockIdx.x * NTHREADS + c.tid; it < nitems; it += c.G * NTHREADS) {
        const int r = it / 20, hs = it % 20;
        if (hs < 16 && r >= TL && !ctxq) continue;
        bf16* p; const float* g; float post;
        if (hs < 16) { p = Qb + (size_t)r * 1024 + hs * 64; g = qg; post = 0.125f * 1.4426950408889634f; } else { p = Kb + kv_row(r) * 256 + (hs - 16) * 64; g = kg; post = 1.0f; }
        float x[64]; float ss = 0.f;
#pragma unroll
        for (int i = 0; i < 8; ++i) { const u32x4 w = ((const u32x4*)p)[i];
            x[8 * i + 0] = bflo(w.x); x[8 * i + 1] = bfhi(w.x); x[8 * i + 2] = bflo(w.y); x[8 * i + 3] = bfhi(w.y);
            x[8 * i + 4] = bflo(w.z); x[8 * i + 5] = bfhi(w.z); x[8 * i + 6] = bflo(w.w); x[8 * i + 7] = bfhi(w.w); }
#pragma unroll
        for (int i = 0; i < 64; ++i) ss += x[i] * x[i];
        const float rstd = rsqrtf(ss * (1.0f / 64.0f) + EPS);
#pragma unroll
        for (int i = 0; i < 64; ++i) x[i] = x[i] * rstd * g[i];
        if (r < TL) { const int t = r % SEQ, rp = t >> 6, cp = t & 63;
#pragma unroll
            for (int i = 0; i < 32; ++i) { const f32x2 cs = tab[(i < 16 ? rp : cp) * 16 + (i & 15)]; const float x0 = x[2 * i], x1 = x[2 * i + 1];
                x[2 * i] = x0 * cs.x - x1 * cs.y; x[2 * i + 1] = x0 * cs.y + x1 * cs.x; } }
#pragma unroll
        for (int i = 0; i < 8; ++i) ((u32x4*)p)[i] = (u32x4){cvtpk(x[8 * i] * post, x[8 * i + 1] * post), cvtpk(x[8 * i + 2] * post, x[8 * i + 3] * post),
                                                            cvtpk(x[8 * i + 4] * post, x[8 * i + 5] * post), cvtpk(x[8 * i + 6] * post, x[8 * i + 7] * post)};
    }
}

__device__ __forceinline__ void ph_att(const Args& a, const Ctx& c, int layer, char* lds_generic) {
    const int nun = 1024 + (layer == 0 ? 64 : 0);
    const attn_body::bf16* Qb = (const attn_body::bf16*)(a.ws + WS_Q); const attn_body::bf16* Kb = (const attn_body::bf16*)(a.ws + WS_K); const attn_body::bf16* Vb = (const attn_body::bf16*)(a.ws + WS_V);
    for (int U = c.vcu; U < nun; U += c.G) {
        long qrow0, kv0; int h, NT;
        if (U < 1024) { const int bh = U >> 4, qb = U & 15, b = bh >> 4; h = bh & 15; qrow0 = (long)b * SEQ + qb * 256; kv0 = (long)b * KVROWS; NT = KVROWS / 64; }
        else { const int q = U - 1024, b = q >> 4; h = q & 15; qrow0 = (long)TL + b * CTXL; kv0 = (long)b * KVROWS; NT = CTXL / 64; }
        attn_body::attn_unit<8>(qrow0, h, kv0, NT, Qb, Kb, Vb, (attn_body::bf16*)(a.ws + WS_HB), lds_generic);
    }
}

__device__ __forceinline__ void ph_m1(const Args& a, const Ctx& c, int layer, const unsigned* rdy, int nN, int amode) {
    const int Tm = layer == 3 ? TL : TT, ntiles = Tm / 32;
    int tl0, tl1, tl2;
    { int bid = (int)blockIdx.x; asm volatile("" : "+s"(bid));
      if (amode == 1 && c.G == 256 && ntiles == 544) {
          int k = c.vcu - 64; asm volatile("" : "+s"(k));
          if (k < 0) { tl0 = -1; tl1 = -1; tl2 = -1; } else { tl0 = k; tl1 = k + 192; tl2 = k < 64 ? k + 384 : (k < 160 ? 448 + (k - 64) : -1); } }
      else if (c.G == 256 && ntiles == 544) { if (bid < 16) { tl0 = 512 + bid; tl1 = -1; tl2 = -1; } else { const int j = bid - 16; tl0 = j; tl1 = j + 240; tl2 = j < 32 ? j + 480 : (j < 48 ? 528 + (j - 32) : -1); } }
      else { tl0 = bid < ntiles ? bid : -1; tl1 = bid + c.G < ntiles ? bid + c.G : -1; tl2 = bid + 2 * c.G < ntiles ? bid + 2 * c.G : -1; } }
    const unsigned need = 8u * (unsigned)nN;
#define M1_WAIT(tl) do { if (c.wave == 0) { unsigned sp_ = 0; \
        while ((unsigned)__builtin_amdgcn_readfirstlane(__hip_atomic_load(rdy + ((tl) >> 3), __ATOMIC_RELAXED, __HIP_MEMORY_SCOPE_AGENT)) < need) { __builtin_amdgcn_s_sleep(2); if (++sp_ > (1u << 22)) break; } \
        __builtin_amdgcn_fence(__ATOMIC_ACQUIRE, "agent"); asm volatile("s_waitcnt vmcnt(0)" ::: "memory"); } \
        __syncthreads(); } while (0)
    const float* g = a.in[I_NFFN] + layer * D;
    constexpr int RP = 2064;
    LAS unsigned char* hiT = c.lds; LAS unsigned char* loT = c.lds + 32 * RP;
    LAS float* part = (LAS float*)c.lds;
    LAS int* lcnt = (LAS int*)(c.lds + 133120); LAS int* lbase = lcnt + 32;
    LAS float* logit = (LAS float*)(c.lds + 134144);
    const bf16* wr = (const bf16*)(a.ws + WS_WR) + (size_t)layer * 2 * 65536;
    unsigned* gcnt = (unsigned*)(a.ws + WS_CTL) + CW_CNT + layer * 32;
    int* list = (int*)(a.ws + WS_LIST); float* w2 = (float*)(a.ws + WS_W2);
    const int r32 = c.lane & 31, hi = c.lane >> 5;
    if (c.tid < 32) lcnt[c.tid] = 0;
    u32x2 vr[4][4];
#define M1_LOADROWS(tl) do { _Pragma("unroll") for (int i = 0; i < 4; ++i) { const u32x2* xr = (const u32x2*)((const bf16*)(a.ws + WS_X) + (size_t)((tl) * 32 + 4 * c.wave + i) * D) + c.lane; \
        _Pragma("unroll") for (int j = 0; j < 4; ++j) vr[i][j] = xr[64 * j]; } } while (0)
    if (tl0 >= 0) { M1_WAIT(tl0); M1_LOADROWS(tl0); }
    int nmine = 0;
    for (; nmine < 3; ++nmine) { const int tile = nmine == 0 ? tl0 : nmine == 1 ? tl1 : tl2, tnext = nmine == 0 ? tl1 : nmine == 1 ? tl2 : -1;
        if (tile < 0) break;
        const int r0 = tile * 32;
        { f32x4 gs[4], sh[4];
          { const float* m = mod_row(a, layer, r0);
#pragma unroll
            for (int j = 0; j < 4; ++j) { gs[j] = ((const f32x4*)g)[c.lane + 64 * j] * (((const f32x4*)(m + 4 * D))[c.lane + 64 * j] + 1.0f); sh[j] = ((const f32x4*)(m + 3 * D))[c.lane + 64 * j]; } }
#pragma unroll
          for (int i = 0; i < 4; ++i) { const int lr = 4 * c.wave + i, r = r0 + lr;
            f32x4 h[4], vv[4];
#pragma unroll
            for (int j = 0; j < 4; ++j) { const u32x2 p = vr[i][j]; vv[j] = (f32x4){bflo(p.x), bfhi(p.x), bflo(p.y), bfhi(p.y)}; }
            const float rstd = row_rstd(vv);
#pragma unroll
            for (int j = 0; j < 4; ++j) h[j] = (vv[j] * rstd) * gs[j] + sh[j];
#if MOE_FP8
            unsigned* to8 = (unsigned*)((unsigned char*)(a.ws + WS_TK) + (size_t)r * D) + c.lane;
#else
            u32x2* to = (u32x2*)((bf16*)(a.ws + WS_TK) + (size_t)r * D) + c.lane;
#endif
#pragma unroll
            for (int j = 0; j < 4; ++j) { const unsigned h0 = cvtpk(h[j].x, h[j].y), h1 = cvtpk(h[j].z, h[j].w);
                const unsigned l0 = cvtpk(h[j].x - bflo(h0), h[j].y - bfhi(h0)), l1 = cvtpk(h[j].z - bflo(h1), h[j].w - bfhi(h1));
#if MOE_FP8
                to8[64 * j] = pk_fp8x4(h[j].x, h[j].y, h[j].z, h[j].w);
#else
                to[64 * j] = (u32x2){h0, h1};
#endif
                *(LAS u32x2*)(hiT + lr * RP + (4 * c.lane + 256 * j) * 2) = (u32x2){h0, h1};
                *(LAS u32x2*)(loT + lr * RP + (4 * c.lane + 256 * j) * 2) = (u32x2){l0, l1}; } } }
        __syncthreads();
        f32x16 acc0 = {}, acc1 = {};
#pragma unroll
        for (int kk = 0; kk < 8; ++kk) { const int k0 = 128 * c.wave + 16 * kk + 8 * hi;
            const bf16x8 ahi = *(const LAS bf16x8*)(hiT + r32 * RP + k0 * 2), alo = *(const LAS bf16x8*)(loT + r32 * RP + k0 * 2);
            const bf16x8 b0h = *(const bf16x8*)(wr + r32 * 1024 + k0), b1h = *(const bf16x8*)(wr + (32 + r32) * 1024 + k0);
            const bf16x8 b0l = *(const bf16x8*)(wr + 65536 + r32 * 1024 + k0), b1l = *(const bf16x8*)(wr + 65536 + (32 + r32) * 1024 + k0);
            acc0 = __builtin_amdgcn_mfma_f32_32x32x16_bf16(ahi, b0h, acc0, 0, 0, 0); acc1 = __builtin_amdgcn_mfma_f32_32x32x16_bf16(ahi, b1h, acc1, 0, 0, 0);
            acc0 = __builtin_amdgcn_mfma_f32_32x32x16_bf16(alo, b0h, acc0, 0, 0, 0); acc1 = __builtin_amdgcn_mfma_f32_32x32x16_bf16(alo, b1h, acc1, 0, 0, 0);
            acc0 = __builtin_amdgcn_mfma_f32_32x32x16_bf16(ahi, b0l, acc0, 0, 0, 0); acc1 = __builtin_amdgcn_mfma_f32_32x32x16_bf16(ahi, b1l, acc1, 0, 0, 0); }
        if (tnext >= 0) { M1_WAIT(tnext); M1_LOADROWS(tnext); }
        else __syncthreads();
#pragma unroll
        for (int reg = 0; reg < 16; ++reg) { part[((c.wave * 2 + 0) * 16 + reg) * 64 + c.lane] = acc0[reg]; part[((c.wave * 2 + 1) * 16 + reg) * 64 + c.lane] = acc1[reg]; }
        __syncthreads();
        if (nmine < 3) {
#pragma unroll
            for (int q = 0; q < 4; ++q) { const int idx = c.tid + 512 * q, nt = idx >> 10, reg = (idx >> 6) & 15, ln = idx & 63; float s = 0.f;
#pragma unroll
                for (int w = 0; w < 8; ++w) s += part[((w * 2 + nt) * 16 + reg) * 64 + ln];
                logit[(nmine * 32 + (reg & 3) + 8 * (reg >> 2) + 4 * (ln >> 5)) * 64 + nt * 32 + (ln & 31)] = s; } }
        __syncthreads();
    }
#undef M1_LOADROWS
#undef M1_WAIT
    int e0 = 0, e1 = 0, p0 = 0, p1 = 0; float w0 = 0.f, w1 = 0.f; const int myt = c.tid >> 5; const bool act_r = c.tid < 96 && myt < nmine;
    if (act_r) { const LAS float* lg = logit + c.tid * 64;
        int grp = 0; float gm = lg[0];
#pragma unroll
        for (int q = 1; q < 4; ++q) if (lg[q] > gm) { gm = lg[q]; grp = q; }
        float den = 0.f;
#pragma unroll
        for (int q = 0; q < 4; ++q) den += expf(lg[q] - gm);
        const float gate = 1.0f / den;
        const LAS float* le = lg + 4 + grp * 8;
        int i0 = 0; float v0 = le[0];
#pragma unroll
        for (int q = 1; q < 8; ++q) if (le[q] > v0) { v0 = le[q]; i0 = q; }
        int i1 = -1; float v1 = -3.0e38f;
#pragma unroll
        for (int q = 0; q < 8; ++q) if (q != i0 && le[q] > v1) { v1 = le[q]; i1 = q; }
        const float ex = expf(v1 - v0); w0 = gate / (1.0f + ex); w1 = gate * ex / (1.0f + ex);
        e0 = grp * 8 + i0; e1 = grp * 8 + i1;
        p0 = __hip_atomic_fetch_add(lcnt + e0, 1, __ATOMIC_RELAXED, __HIP_MEMORY_SCOPE_WORKGROUP);
        p1 = __hip_atomic_fetch_add(lcnt + e1, 1, __ATOMIC_RELAXED, __HIP_MEMORY_SCOPE_WORKGROUP); }
    __syncthreads();
    if (c.tid < 32) { const int n = lcnt[c.tid]; lbase[c.tid] = n ? (int)__hip_atomic_fetch_add(gcnt + c.tid, (unsigned)n, __ATOMIC_RELAXED, __HIP_MEMORY_SCOPE_AGENT) : 0; }
    __syncthreads();
    if (act_r) { const int r = (myt == 0 ? tl0 : myt == 1 ? tl1 : tl2) * 32 + (c.tid & 31);
        list[e0 * MOE_CAP + lbase[e0] + p0] = 2 * r; w2[2 * r] = w0;
        list[e1 * MOE_CAP + lbase[e1] + p1] = 2 * r + 1; w2[2 * r + 1] = w1; }
    __syncthreads();
}
__device__ __forceinline__ void moe_tables(const Args& a, const Ctx& c, int layer, LAS int* tab) {
    unsigned* gcnt = (unsigned*)(a.ws + WS_CTL) + CW_CNT + layer * 32;
    if (c.tid < 32) tab[40 + c.tid] = (int)__hip_atomic_load(gcnt + c.tid, __ATOMIC_RELAXED, __HIP_MEMORY_SCOPE_AGENT);
    __syncthreads();
    if (c.tid == 0) { int s = 0; for (int e = 0; e < 32; ++e) { tab[e] = s; s += (tab[40 + e] + 255) >> 8; } tab[32] = s; }
    __syncthreads();
}

__device__ __forceinline__ void ph_rpool(const Args& a, const Ctx& c, int layer) {
    LAS unsigned char* hs = c.lds;
    const float* g = a.in[I_NMIX] + layer * D;
    for (int tile = blockIdx.x; tile < TT / 32; tile += c.G) {
        const int r0 = tile * 32;
        const int s0 = r0 < TL ? (r0 / SEQ) * SEQ : TL + ((r0 - TL) / CTXL) * CTXL, s1 = s0 + (r0 < TL ? SEQ : CTXL);
        for (int lr = c.wave; lr < 47; lr += NWAVES) { const int gr = r0 - 8 + lr; if (gr < s0 || gr >= s1) continue;
            f32x4 v[4], h[4]; load_row_combined(a, layer, gr, c.lane, v);
            if (lr >= 8 && lr < 40) { u32x2* xo = (u32x2*)((bf16*)(a.ws + WS_Z) + (size_t)gr * D) + c.lane;
#pragma unroll
                for (int j = 0; j < 4; ++j) xo[64 * j] = (u32x2){cvtpk(v[j].x, v[j].y), cvtpk(v[j].z, v[j].w)}; }
            const float rstd = row_rstd(v); const float* m = mod_row(a, layer, gr);
            norm_mod(v, rstd, g, m, m + D, c.lane, h);
#pragma unroll
            for (int j = 0; j < 4; ++j) *(LAS u32x2*)(hs + lr * 2048 + (4 * c.lane + 256 * j) * 2) = (u32x2){cvtpk(h[j].x, h[j].y), cvtpk(h[j].z, h[j].w)}; }
        __syncthreads();
        { const int half = 1 << (c.tid >> 7);
          const LAS unsigned* col = (const LAS unsigned*)hs + c.tid;
          float sx = 0.f, sy = 0.f;
          { const int lo = (r0 - half) > s0 ? (r0 - half) : s0, hi = (r0 + half) < s1 ? (r0 + half) : s1;
            for (int gr = lo; gr < hi; ++gr) { const unsigned u = col[(gr - r0 + 8) * 512]; sx += bflo(u); sy += bfhi(u); } }
          unsigned* ho = (unsigned*)((bf16*)(a.ws + WS_HB) + (size_t)r0 * D) + c.tid;
          for (int t = 0; t < 32; ++t) { const int gr = r0 + t; const int lo = (gr - half) > s0 ? (gr - half) : s0, hi = (gr + half) < s1 ? (gr + half) : s1;
              const float inv = __builtin_amdgcn_rcpf((float)(hi - lo)); const unsigned u = col[(t + 8) * 512];
              ho[t * 512] = cvtpk(sx * inv - bflo(u), sy * inv - bfhi(u));
              if (t < 31) { if (gr + half < s1) { const unsigned w = col[(t + 8 + half) * 512]; sx += bflo(w); sy += bfhi(w); }
                            if (gr - half >= s0) { const unsigned w = col[(t + 8 - half) * 512]; sx -= bflo(w); sy -= bfhi(w); } } } }
        __syncthreads();
    }
}

struct EpiInproj { static constexpr bool PERM = true; bf16* Z; bf16* XBC; float* DT; const float* dtb;
    __device__ __forceinline__ void operator()(const AccT& acc, const pg8::Unit& u, int wr, int wc, int fr, int fq) const {
        const size_t r0 = (size_t)u.pm * 256;
        if (u.pn < 20) { bf16* base; int pitch; if (u.pn < 8) { base = Z + u.pn * 256; pitch = 2048; } else { base = XBC + (u.pn - 8) * 256; pitch = 3072; }
#pragma unroll
            for (int ai = 0; ai < 2; ++ai)
#pragma unroll
                for (int m = 0; m < 4; ++m) { bf16* rowp = base + (r0 + ai * 128 + wr * 64 + m * 16 + fr) * pitch + wc * 32 + 8 * fq;
#pragma unroll
                    for (int bj = 0; bj < 2; ++bj) { const f32x4 v0 = acc[ai][bj][m][0], v1 = acc[ai][bj][m][1];
                        *(u32x4*)(rowp + bj * 128) = (u32x4){cvtpk(v0[0], v0[1]), cvtpk(v0[2], v0[3]), cvtpk(v1[0], v1[1]), cvtpk(v1[2], v1[3])}; } }
        } else if (wc < 2) { const int col = wc * 32 + 8 * fq; const f32x4 b0 = *(const f32x4*)(dtb + col), b1 = *(const f32x4*)(dtb + col + 4);
#pragma unroll
            for (int ai = 0; ai < 2; ++ai)
#pragma unroll
                for (int m = 0; m < 4; ++m) { float* p = DT + (r0 + ai * 128 + wr * 64 + m * 16 + fr) * 64 + col; f32x4 v0 = acc[ai][0][m][0] + b0, v1 = acc[ai][0][m][1] + b1;
#pragma unroll
                    for (int e = 0; e < 4; ++e) { v0[e] = fmaxf(v0[e], 0.f) + log1pf(__expf(-fabsf(v0[e]))); v1[e] = fmaxf(v1[e], 0.f) + log1pf(__expf(-fabsf(v1[e]))); }
                    *(f32x4*)p = v0; *(f32x4*)(p + 4) = v1; } }
    }
};

__device__ __forceinline__ void ph_conv(const Args& a, const Ctx& c) {
    LAS unsigned char* tin = c.lds; LAS unsigned char* toT = c.lds + 17408; LAS unsigned char* toN = c.lds + 34816;
    const bf16* xbc = (const bf16*)(a.ws + WS_XBC);
    u32x4 pin[3];
#define CONV_PREFETCH(tk) do { const int ci_ = (tk) / 48, chb_ = (tk) % 48, r0_ = ci_ * 128, ch0_ = chb_ * 64; \
        const bool first_ = ci_ < 128 ? (ci_ % 32 == 0) : (((ci_ - 128) & 1) == 0), last_ = ci_ < 128 ? (ci_ % 32 == 31) : (((ci_ - 128) & 1) == 1); \
        _Pragma("unroll") for (int q = 0; q < 3; ++q) { const int p = c.tid + 512 * q, lr = p >> 3, pc = p & 7; const bool valid = p < 131 * 8 && !((lr < 2 && first_) || (lr == 130 && last_)); \
            pin[q] = (u32x4){0u, 0u, 0u, 0u}; if (valid) pin[q] = *(const u32x4*)(xbc + (size_t)(r0_ - 2 + lr) * 3072 + ch0_ + pc * 8); } } while (0)
    if ((int)blockIdx.x < NCH * 48) CONV_PREFETCH((int)blockIdx.x);
    for (int task = blockIdx.x; task < NCH * 48; task += c.G) {
        const int ci = task / 48, chb = task % 48, r0 = ci * 128, ch0 = chb * 64;
#pragma unroll
        for (int q = 0; q < 3; ++q) { const int p = c.tid + 512 * q; if (p < 131 * 8) *(LAS u32x4*)(tin + (p >> 3) * 128 + (p & 7) * 16) = pin[q]; }
        __syncthreads();
        if (task + c.G < NCH * 48) CONV_PREFETCH(task + c.G);
        { const int ch = c.tid & 63, tq = c.tid >> 6; const float* cw = a.in[I_CONVW] + ch0 + ch;
          const float w0 = cw[0], w1 = cw[3072], w2 = cw[2 * 3072], w3 = cw[3 * 3072], bias = a.in[I_CONVB][ch0 + ch];
          float xin[19];
#pragma unroll
          for (int i = 0; i < 19; ++i) xin[i] = bf2f(*(const LAS bf16*)(tin + (16 * tq + i) * 128 + ch * 2));
          float o[16];
#pragma unroll
          for (int i = 0; i < 16; ++i) o[i] = silu_f(bias + w0 * xin[i] + w1 * xin[i + 1] + w2 * xin[i + 2] + w3 * xin[i + 3]);
          if (chb < 40) { *(LAS u32x4*)(toT + ch * 272 + tq * 32) = (u32x4){cvtpk(o[0], o[1]), cvtpk(o[2], o[3]), cvtpk(o[4], o[5]), cvtpk(o[6], o[7])};
                          *(LAS u32x4*)(toT + ch * 272 + tq * 32 + 16) = (u32x4){cvtpk(o[8], o[9]), cvtpk(o[10], o[11]), cvtpk(o[12], o[13]), cvtpk(o[14], o[15])}; }
          if (chb >= 32) {
#pragma unroll
              for (int i = 0; i < 16; ++i) *(LAS bf16*)(toN + (16 * tq + i) * 144 + ch * 2) = (bf16)(cvtpk(o[i], 0.f) & 0xffffu); } }
        __syncthreads();
        if (chb < 40) { bf16* dst = chb < 32 ? (bf16*)(a.ws + WS_XT) + ((size_t)ci * 2048 + ch0) * 128 : (bf16*)(a.ws + WS_BT) + ((size_t)ci * 512 + (ch0 - 2048)) * 128;
#pragma unroll
            for (int q = 0; q < 2; ++q) { const int p = c.tid + 512 * q, chl = p >> 4, pc = p & 15; *(u32x4*)(dst + chl * 128 + pc * 8) = *(const LAS u32x4*)(toT + chl * 272 + pc * 16); } }
        if (chb >= 32) { bf16* dst = chb < 40 ? (bf16*)(a.ws + WS_BN) + (size_t)r0 * 512 + (ch0 - 2048) : (bf16*)(a.ws + WS_CN) + (size_t)r0 * 512 + (ch0 - 2560);
#pragma unroll
            for (int q = 0; q < 2; ++q) { const int p = c.tid + 512 * q, t = p >> 3, pc = p & 7; *(u32x4*)(dst + (size_t)t * 512 + pc * 8) = *(const LAS u32x4*)(toN + t * 144 + pc * 16); } }
        __syncthreads();
    }
#undef CONV_PREFETCH
    const int gw = c.vcu * NWAVES + c.wave, NGW = c.G * NWAVES;
    const float* dt = (const float*)(a.ws + WS_DT);
    for (int item = gw; item < NCH * 32; item += NGW) { const int ci = item >> 5, h = item & 31, r0 = ci * 128 + 2 * c.lane;
        const float af = -expf(a.in[I_ALOG][h]), ab = -expf(a.in[I_ALOG][32 + h]);
        const float dtf0 = dt[(size_t)r0 * 64 + h], dtf1 = dt[(size_t)(r0 + 1) * 64 + h], dtb0 = dt[(size_t)r0 * 64 + 32 + h], dtb1 = dt[(size_t)(r0 + 1) * 64 + 32 + h];
        const float laf0 = dtf0 * af, laf1 = dtf1 * af, lab0 = dtb0 * ab, lab1 = dtb1 * ab;
        float inf_ = laf0 + laf1, inb = lab0 + lab1; const float pf = inf_, pbk = inb;
#pragma unroll
        for (int o = 1; o < 64; o <<= 1) { const float t1 = __shfl_up(inf_, o), t2 = __shfl_up(inb, o); if (c.lane >= o) { inf_ += t1; inb += t2; } }
        const float totf = __shfl(inf_, 63), totb = __shfl(inb, 63);
        const float exf = inf_ - pf, exb = inb - pbk;
        const float cf0 = exf + laf0, cf1 = inf_, pb0 = exb, pb1 = exb + lab0;
        f32x4* sca = (f32x4*)(a.ws + WS_SCA) + (size_t)r0 * 32 + h; f32x4* scb = (f32x4*)(a.ws + WS_SCB) + (size_t)r0 * 32 + h;
        { const float L2E = 1.4426950408889634f;
          sca[0] = (f32x4){cf0 * L2E, pb0 * L2E, cf0 * L2E - __log2f(dtf0), pb0 * L2E + __log2f(dtb0)}; sca[32] = (f32x4){cf1 * L2E, pb1 * L2E, cf1 * L2E - __log2f(dtf1), pb1 * L2E + __log2f(dtb1)}; }
        scb[0] = (f32x4){__expf(cf0), __expf(totb - pb0), dtf0 * __expf(totf - cf0), dtb0 * __expf(pb0)};
        scb[32] = (f32x4){__expf(cf1), __expf(totb - pb1), dtf1 * __expf(totf - cf1), dtb1 * __expf(pb1)};
        if (c.lane == 0) ((f32x2*)(a.ws + WS_DEC))[ci * 32 + h] = (f32x2){__expf(totf), __expf(totb)}; }
}

__device__ __forceinline__ void ph_scan(const Args& a, const Ctx& c) {
    constexpr int P = 272, BUF = 53248;
    LAS unsigned char* stg = c.lds + 2 * BUF + c.wave * 2048;
    const int r32 = c.lane & 31, hi = c.lane >> 5, pt = c.wave >> 2, nt = c.wave & 3;
    for (int task = c.vcu; task < 256; task += c.G) { const int b = task >> 6, dir = (task >> 5) & 1, h = task & 31, g = h >> 3;
        f32x16 acc = {};
        u32x4 xrA[2], brA[4], xrB[2], brB[4]; f32x4 wregA = {}, wregB = {}; f32x2 decA = {}, decB = {};
#define SCAN_CI(k) (dir == 0 ? ((k) < 2 ? 128 + 2 * b + (k) : 32 * b + ((k) - 2)) : ((k) < 2 ? 128 + 2 * b + 1 - (k) : 32 * b + 31 - ((k) - 2)))
#define SCAN_LOAD(k, xr, br, wreg, dcr) do { const int ci_ = SCAN_CI(k); const bf16* xs_ = (const bf16*)(a.ws + WS_XT) + ((size_t)ci_ * 2048 + 64 * h) * 128; const bf16* bs_ = (const bf16*)(a.ws + WS_BT) + ((size_t)ci_ * 512 + 128 * g) * 128; \
        _Pragma("unroll") for (int q = 0; q < 2; ++q) xr[q] = ((const u32x4*)xs_)[c.tid + 512 * q]; _Pragma("unroll") for (int q = 0; q < 4; ++q) br[q] = ((const u32x4*)bs_)[c.tid + 512 * q]; \
        wreg = ((const f32x4*)(a.ws + WS_SCB))[((size_t)ci_ * 128 + (c.tid & 127)) * 32 + h]; dcr = ((const f32x2*)(a.ws + WS_DEC))[ci_ * 32 + h]; } while (0)
#define SCAN_WRITE(bi, xr, br, wreg) do { LAS unsigned char* xb_ = c.lds + (bi) * BUF; LAS unsigned char* bb_ = xb_ + 17408; \
        _Pragma("unroll") for (int q = 0; q < 2; ++q) { const int p = c.tid + 512 * q; *(LAS u32x4*)(xb_ + (p >> 4) * P + (p & 15) * 16) = xr[q]; } \
        _Pragma("unroll") for (int q = 0; q < 4; ++q) { const int p = c.tid + 512 * q; *(LAS u32x4*)(bb_ + (p >> 4) * P + (p & 15) * 16) = br[q]; } \
        if (c.tid < 128) ((LAS float*)(xb_ + 52224))[c.tid] = dir == 0 ? wreg.z : wreg.w; } while (0)
#define SCAN_STEP(k, cur, dcr) do { const int ci = SCAN_CI(k); \
            { bf16* hin = (bf16*)(a.ws + WS_HIN) + (((size_t)ci * 2 + dir) * 32 + h) * 8192; \
              _Pragma("unroll") for (int r = 0; r < 16; ++r) *(LAS bf16*)(stg + ((r & 3) + 8 * (r >> 2) + 4 * hi) * 64 + r32 * 2) = (bf16)(cvtpk(acc[r], 0.f) & 0xffffu); \
              LDS_WAIT(); \
              _Pragma("unroll") for (int i = 0; i < 2; ++i) { const int row = (c.lane >> 2) + 16 * i, pc = c.lane & 3; *(u32x4*)(hin + (size_t)(32 * pt + row) * 128 + 32 * nt + pc * 8) = *(const LAS u32x4*)(stg + row * 64 + pc * 16); } } \
            const float dec = dir == 0 ? dcr.x : dcr.y; \
            _Pragma("unroll") for (int r = 0; r < 16; ++r) acc[r] *= dec; \
            { LAS unsigned char* xb = c.lds + (cur) * BUF; LAS unsigned char* bb = xb + 17408; const LAS float* wv = (const LAS float*)(xb + 52224); \
              _Pragma("unroll") for (int kk = 0; kk < 8; ++kk) { const int s8 = 16 * kk + 8 * hi; \
                  const u32x4 xa = *(const LAS u32x4*)(xb + (32 * pt + r32) * P + s8 * 2); const f32x4 wa = *(const LAS f32x4*)(wv + s8), wb = *(const LAS f32x4*)(wv + s8 + 4); \
                  const u32x4 xs = (u32x4){cvtpk(bflo(xa.x) * wa.x, bfhi(xa.x) * wa.y), cvtpk(bflo(xa.y) * wa.z, bfhi(xa.y) * wa.w), cvtpk(bflo(xa.z) * wb.x, bfhi(xa.z) * wb.y), cvtpk(bflo(xa.w) * wb.z, bfhi(xa.w) * wb.w)}; \
                  const bf16x8 bfrag = *(const LAS bf16x8*)(bb + (32 * nt + r32) * P + s8 * 2); \
                  acc = __builtin_amdgcn_mfma_f32_32x32x16_bf16(__builtin_bit_cast(bf16x8, xs), bfrag, acc, 0, 0, 0); } } } while (0)
        f32x2 dcur0, dcur1;
        SCAN_LOAD(0, xrA, brA, wregA, decA); SCAN_LOAD(1, xrB, brB, wregB, decB); SCAN_WRITE(0, xrA, brA, wregA); dcur0 = decA;
        __syncthreads();
        for (int k = 0; k < 34; k += 2) {
            if (k + 2 < 34) SCAN_LOAD(k + 2, xrA, brA, wregA, decA);
            SCAN_STEP(k, 0, dcur0);
            SCAN_WRITE(1, xrB, brB, wregB); dcur1 = decB;
            __syncthreads();
            if (k + 3 < 34) SCAN_LOAD(k + 3, xrB, brB, wregB, decB);
            SCAN_STEP(k + 1, 1, dcur1);
            if (k + 2 < 34) { SCAN_WRITE(0, xrA, brA, wregA); dcur0 = decA; }
            __syncthreads();
        }
#undef SCAN_CI
#undef SCAN_LOAD
#undef SCAN_WRITE
#undef SCAN_STEP
    }
}

__device__ __forceinline__ int crow16(int r, int hi) { return (r & 3) + 8 * (r >> 2) + 4 * hi; }
__device__ __forceinline__ void ph_yph(const Args& a, const Ctx& c, unsigned* rdg) {
    constexpr int P = 272, ZP = 144;
    LAS unsigned char* Cs = c.lds; LAS unsigned char* Bs = c.lds + 34816; LAS unsigned char* xs = c.lds + 69632; LAS unsigned char* hf = c.lds + 87040; LAS unsigned char* hb = c.lds + 104448;
    LAS unsigned char* zs = c.lds + 121856; LAS unsigned char* os = c.lds + 140288; LAS f32x4* sca = (LAS f32x4*)(c.lds + 158720); LAS f32x2* scb = (LAS f32x2*)(c.lds + 160768);
    LAS float* sbv = (LAS float*)(c.lds + 161792); LAS float* scv = (LAS float*)(c.lds + 162304); LAS float* ssql = (LAS float*)(c.lds + 34816);
    const int lb = c.wave & 3, pb = c.wave >> 2;
    SECT_DECL
    for (int task = c.vcu; task < NCH * 4; task += c.G) { const int ci = task >> 2, g = task & 3, r0 = ci * 128;
        int tid_t = c.tid; asm volatile("" : "+v"(tid_t));
        f32x16 X[4]; int l0;
        u32x4 pxt[2], phf[2], phb[2], pz[2]; f32x4 ps1 = {}; f32x4 ps4 = {};
#define YPH_PREFETCH(hq) do { const int h_ = 8 * g + (hq); const u32x4* xt_ = (const u32x4*)((const bf16*)(a.ws + WS_XT) + ((size_t)ci * 2048 + 64 * h_) * 128); \
            const u32x4* hfg_ = (const u32x4*)((const bf16*)(a.ws + WS_HIN) + (((size_t)ci * 2 + 0) * 32 + h_) * 8192); const u32x4* hbg_ = (const u32x4*)((const bf16*)(a.ws + WS_HIN) + (((size_t)ci * 2 + 1) * 32 + h_) * 8192); \
            const bf16* zg_ = (const bf16*)(a.ws + WS_Z) + (size_t)r0 * 2048 + 64 * h_; \
            _Pragma("unroll") for (int q = 0; q < 2; ++q) { const int p = tidp + 512 * q; pxt[q] = xt_[p]; phf[q] = hfg_[p]; phb[q] = hbg_[p]; pz[q] = *(const u32x4*)(zg_ + (size_t)(p >> 3) * 2048 + (p & 7) * 8); } \
            ps1 = ((const f32x4*)(a.ws + WS_SCA))[((size_t)r0 + (tidp & 127)) * 32 + h_]; ps4 = ((const f32x4*)(a.ws + WS_SCB))[((size_t)r0 + (tidp & 127)) * 32 + h_]; } while (0)
        { const int tid = tid_t, lane = tid & 63, r32 = lane & 31, hi = lane >> 5; l0 = 32 * lb + r32;
          { const bf16* cn = (const bf16*)(a.ws + WS_CN) + (size_t)r0 * 512 + 128 * g; const bf16* bn = (const bf16*)(a.ws + WS_BN) + (size_t)r0 * 512 + 128 * g;
#pragma unroll
            for (int q = 0; q < 4; ++q) { const int p = tid + 512 * q, row = p >> 4, pc = p & 15;
                *(LAS u32x4*)(Cs + row * P + pc * 16) = *(const u32x4*)(cn + (size_t)row * 512 + pc * 8); *(LAS u32x4*)(Bs + row * P + pc * 16) = *(const u32x4*)(bn + (size_t)row * 512 + pc * 8); } }
          { const int tidp = tid; YPH_PREFETCH(0); }
          __syncthreads();
#pragma unroll
          for (int sb = 0; sb < 4; ++sb) { X[sb] = (f32x16){};
#pragma unroll
              for (int kk = 0; kk < 8; ++kk) { const int k8 = (16 * kk + 8 * hi) * 2;
                  X[sb] = __builtin_amdgcn_mfma_f32_32x32x16_bf16(*(const LAS bf16x8*)(Bs + (32 * sb + r32) * P + k8), *(const LAS bf16x8*)(Cs + (32 * lb + r32) * P + k8), X[sb], 0, 0, 0); } }
        }
        SECT(0);
        float ssq = 0.f;
#pragma unroll 1
        for (int hh = 0; hh < 8; ++hh) { const int h = 8 * g + hh;
            int tid = c.tid; asm volatile("" : "+v"(tid)); const int lane = tid & 63, r32 = lane & 31, hi = lane >> 5, l = 32 * lb + r32; (void)lane;
            const float dsum = a.in[I_DSK][h] + a.in[I_DSK][32 + h];
            __syncthreads();
            SECT(1);
            if (hh > 0) { bf16* gg = (bf16*)(a.ws + WS_G) + (size_t)r0 * 2048 + 64 * (h - 1);
#pragma unroll
                for (int q = 0; q < 2; ++q) { const int p = tid + 512 * q, zr = p >> 3, zc = p & 7; *(u32x4*)(gg + (size_t)zr * 2048 + zc * 8) = *(const LAS u32x4*)(os + zr * ZP + zc * 16); } }
#pragma unroll
            for (int q = 0; q < 2; ++q) { const int p = tid + 512 * q, row = p >> 4, pc = p & 15;
                *(LAS u32x4*)(xs + row * P + pc * 16) = pxt[q]; *(LAS u32x4*)(hf + row * P + pc * 16) = phf[q]; *(LAS u32x4*)(hb + row * P + pc * 16) = phb[q];
                *(LAS u32x4*)(zs + (p >> 3) * ZP + (p & 7) * 16) = pz[q]; }
            if (tid < 128) { sca[tid] = ps1; scb[tid] = (f32x2){ps4.x, ps4.y}; sbv[tid] = ps1.z; scv[tid] = ps1.w; }
            __syncthreads();
            SECT(2);
            if (hh < 7) { const int tidp = tid; YPH_PREFETCH(hh + 1); }
            SECT(3);
            const f32x4 me = sca[l]; const f32x2 ee = scb[l];
            const float dtb_l = __builtin_amdgcn_exp2f(me.w - me.y);
            f32x16 accd = {};
#pragma unroll
            for (int sb = 0; sb < 4; ++sb) { unsigned mp[8];
#pragma unroll
                for (int q = 0; q < 4; ++q) { const int s0 = 32 * sb + 8 * q + 4 * hi; float mv[4];
                    if (sb < lb) { const f32x4 bs4 = *(const LAS f32x4*)(sbv + s0);
#pragma unroll
                        for (int e = 0; e < 4; ++e) mv[e] = X[sb][4 * q + e] * __builtin_amdgcn_exp2f(me.x - bs4[e]); }
                    else if (sb > lb) { const f32x4 cs4 = *(const LAS f32x4*)(scv + s0);
#pragma unroll
                        for (int e = 0; e < 4; ++e) mv[e] = X[sb][4 * q + e] * __builtin_amdgcn_exp2f(cs4[e] - me.y); }
                    else { const f32x4 bs4 = *(const LAS f32x4*)(sbv + s0), cs4 = *(const LAS f32x4*)(scv + s0);
#pragma unroll
                        for (int e = 0; e < 4; ++e) { const int s = s0 + e; const float t = (s <= l) ? (me.x - bs4[e]) : (cs4[e] - me.y); const float xv = X[sb][4 * q + e];
                            float m = xv * __builtin_amdgcn_exp2f(t); if (s == l) m += xv * dtb_l + dsum; mv[e] = m; } }
                    mp[2 * q] = cvtpk(mv[0], mv[1]); mp[2 * q + 1] = cvtpk(mv[2], mv[3]); }
#pragma unroll
                for (int t = 0; t < 2; ++t) { const int sof = (32 * sb + 16 * t + 4 * hi) * 2;
                    const u32x2 lo = *(const LAS u32x2*)(xs + (32 * pb + r32) * P + sof), h2 = *(const LAS u32x2*)(xs + (32 * pb + r32) * P + sof + 16);
                    const u32x4 af = (u32x4){lo.x, lo.y, h2.x, h2.y}, bfm = (u32x4){mp[4 * t], mp[4 * t + 1], mp[4 * t + 2], mp[4 * t + 3]};
                    accd = __builtin_amdgcn_mfma_f32_32x32x16_bf16(__builtin_bit_cast(bf16x8, af), __builtin_bit_cast(bf16x8, bfm), accd, 0, 0, 0); }
                }
            SECT(4);
#pragma unroll
            for (int dd = 0; dd < 2; ++dd) { f32x16 acco = {}; LAS unsigned char* hx = dd == 0 ? hf : hb;
#pragma unroll
                for (int kk = 0; kk < 8; ++kk) { const int k8 = (16 * kk + 8 * hi) * 2;
                    acco = __builtin_amdgcn_mfma_f32_32x32x16_bf16(*(const LAS bf16x8*)(hx + (32 * pb + r32) * P + k8), *(const LAS bf16x8*)(Cs + (32 * lb + r32) * P + k8), acco, 0, 0, 0); }
                const float ex = dd == 0 ? ee.x : ee.y;
#pragma unroll
                for (int r = 0; r < 16; ++r) accd[r] += ex * acco[r]; }
            SECT(5);
#pragma unroll
            for (int q = 0; q < 4; ++q) { const int pcol = 32 * pb + 8 * q + 4 * hi; const u32x2 zq = *(const LAS u32x2*)(zs + l * ZP + pcol * 2);
                float gv[4];
#pragma unroll
                for (int e = 0; e < 4; ++e) { const int r = 4 * q + e; const float y = accd[r];
                    const float z = (e == 0) ? bflo(zq.x) : (e == 1) ? bfhi(zq.x) : (e == 2) ? bflo(zq.y) : bfhi(zq.y); gv[e] = y * silu_f(z); ssq += gv[e] * gv[e]; }
                *(LAS u32x2*)(os + l * ZP + pcol * 2) = (u32x2){cvtpk(gv[0], gv[1]), cvtpk(gv[2], gv[3])}; }
            SECT(6);
        }
#undef YPH_PREFETCH
        __syncthreads();
        { bf16* gg = (bf16*)(a.ws + WS_G) + (size_t)r0 * 2048 + 64 * (8 * g + 7);
#pragma unroll
          for (int q = 0; q < 2; ++q) { const int p = c.tid + 512 * q, zr = p >> 3, zc = p & 7; *(u32x4*)(gg + (size_t)zr * 2048 + zc * 8) = *(const LAS u32x4*)(os + zr * ZP + zc * 16); } }
        ssq += __shfl_xor(ssq, 32);
        if ((c.lane >> 5) == 0) ssql[pb * 128 + l0] = ssq;
        __syncthreads();
        if (c.tid < 128) ssql[256 + c.tid] = rsqrtf((ssql[c.tid] + ssql[128 + c.tid]) * (1.0f / 512.0f) + EPS);
        VM_WAIT();
        __syncthreads();
        { bf16* gt = (bf16*)(a.ws + WS_G) + (size_t)r0 * 2048 + 512 * g; const float* ng = a.in[I_SNORM] + 512 * g;
          const __amdgpu_buffer_rsrc_t grs = __builtin_amdgcn_make_buffer_rsrc((void*)(a.ws + WS_G), 0, TT * 2048 * 2, 0x00020000);
          const f32x4 g0 = *(const f32x4*)(ng + (c.tid & 63) * 8), g1 = *(const f32x4*)(ng + (c.tid & 63) * 8 + 4);
#pragma unroll 1
          for (int qb = 0; qb < 2; ++qb) { u32x4 gv8[8]; int tidq = c.tid + 4096 * qb; asm volatile("" : "+v"(tidq));
#pragma unroll
            for (int q = 0; q < 8; ++q) { const int p = tidq + 512 * q; gv8[q] = *(const u32x4*)(gt + (size_t)(p >> 6) * 2048 + (p & 63) * 8); }
#pragma unroll
            for (int q = 0; q < 8; ++q) { const int p = tidq + 512 * q, row = p >> 6, col = (p & 63) * 8; const u32x4 v = gv8[q]; const float sr = ssql[256 + row];
              __builtin_amdgcn_raw_buffer_store_b128((u32x4){cvtpk(bflo(v.x) * sr * g0.x, bfhi(v.x) * sr * g0.y), cvtpk(bflo(v.y) * sr * g0.z, bfhi(v.y) * sr * g0.w), cvtpk(bflo(v.z) * sr * g1.x, bfhi(v.z) * sr * g1.y), cvtpk(bflo(v.w) * sr * g1.z, bfhi(v.w) * sr * g1.w)},
                  grs, ((r0 + row) * 2048 + 512 * g + col) * 2, 0, 16  ); } } }
        VM_WAIT();
        __syncthreads();
        if (c.tid == 0) __hip_atomic_fetch_add(rdg + (ci >> 1), 1u, __ATOMIC_RELAXED, __HIP_MEMORY_SCOPE_AGENT);
        SECT(7);
    }
    SECT_END(40);
}
__device__ __forceinline__ void ph_gfix(const Args& a, const Ctx& c) {
    const float* ng = a.in[I_SNORM]; const float* rs = (const float*)(a.ws + WS_RSTD);
    const int n16 = TT * 256;
    for (int p = blockIdx.x * NTHREADS + c.tid; p < n16; p += c.G * NTHREADS) { const int r = p >> 8, col = (p & 255) * 8;
        u32x4* gp = (u32x4*)((bf16*)(a.ws + WS_G) + (size_t)r * 2048 + col); const u32x4 v = *gp; const float s = rs[r * 4 + (col >> 9)];
        const f32x4 g0 = *(const f32x4*)(ng + col), g1 = *(const f32x4*)(ng + col + 4);
        *gp = (u32x4){cvtpk(bflo(v.x) * s * g0.x, bfhi(v.x) * s * g0.y), cvtpk(bflo(v.y) * s * g0.z, bfhi(v.y) * s * g0.w), cvtpk(bflo(v.z) * s * g1.x, bfhi(v.z) * s * g1.y), cvtpk(bflo(v.w) * s * g1.z, bfhi(v.w) * s * g1.w)}; }
}

#if DEBUG_CHECKS
__device__ __forceinline__ float dbg_hb(const Args& a, int layer, size_t idx, float sh) {
    if (ATT_FP8 && layer != 2) return __builtin_amdgcn_cvt_f32_fp8((unsigned)((const unsigned char*)(a.ws + WS_HB))[idx], 0) * sh;
    return bf2f(((const bf16*)(a.ws + WS_HB))[idx]); }
__device__ __forceinline__ int dbg_sample_row(int b) { const int SR[16] = {0, 1, 77, 4095, 4096, 5000, 8191, 9000, 12288, 16383, 16384, 16385, 16384 + 255, 16384 + 256, 17000, 17407}; int r = 0;
#pragma unroll
    for (int i = 0; i < 16; ++i) r = (b == i) ? SR[i] : r;
    return r; }
__device__ __forceinline__ float blk_sum(float v, LAS float* red, int tid) {
    v = wave_sum(v); __syncthreads(); if ((tid & 63) == 0) red[tid >> 6] = v; __syncthreads(); float s = 0.f;
#pragma unroll
    for (int i = 0; i < 8; ++i) s += red[i];
    __syncthreads(); return s; }
__device__ __forceinline__ float blk_max(float v, LAS float* red, int tid) {
#pragma unroll
    for (int o = 1; o < 64; o <<= 1) v = fmaxf(v, __shfl_xor(v, o));
    __syncthreads(); if ((tid & 63) == 0) red[tid >> 6] = v; __syncthreads(); float s = red[0];
#pragma unroll
    for (int i = 1; i < 8; ++i) s = fmaxf(s, red[i]);
    __syncthreads(); return s; }
__device__ __forceinline__ void dbg_report(const Args& a, int id, float err, float ssref, float n, int tid) {
    if (tid == 0) { float rel = err / (sqrtf(ssref / n) + 1e-20f); if (!(rel == rel)) rel = 1e30f; atomicMax((unsigned*)(a.ws + WS_CTL) + CW_DBG + id, __float_as_uint(rel)); } }
__device__ __forceinline__ float dbg_mod(const Args& a, int layer, int r, int j) {
    const float* cv = r < TL ? a.in[I_C] + (r / SEQ) * 1024 : a.in[I_CCTX]; float s = 0.f;
    _Pragma("nounroll") for (int k = 0; k < 1024; ++k) { const float x = cv[k]; s += (x / (1.0f + expf(-x))) * a.in[I_WADA][((size_t)layer * 1024 + k) * 6144 + j]; }
    return s + a.in[I_BADA][layer * 6144 + j]; }

__device__ __forceinline__ void chk_rmix(const Args& a, int layer, int id, LAS unsigned char* ldsb) {
    if (blockIdx.x >= 16) return; const int tid = tid_opaque(), r = dbg_sample_row(blockIdx.x);
    LAS float* red = (LAS float*)ldsb;
    const float* x = resid_row(a, layer, r); const bf16* hb = (const bf16*)(a.ws + WS_HB) + (size_t)r * D;
    float ss = 0.f; for (int cc = tid; cc < D; cc += 512) ss += x[cc] * x[cc];
    ss = blk_sum(ss, red, tid); const float rstd = rsqrtf(ss / D + EPS);
    float err = 0.f, sr = 0.f;
    for (int cc = tid; cc < D; cc += 512) { const float sh = dbg_mod(a, layer, r, cc), sc = dbg_mod(a, layer, r, D + cc);
        const float ref = x[cc] * rstd * a.in[I_NMIX][layer * D + cc] * (1.f + sc) + sh; err = fmaxf(err, fabsf(ref - dbg_hb(a, layer, (size_t)r * D + cc, 1.f))); sr += ref * ref; }
    err = blk_max(err, red, tid); sr = blk_sum(sr, red, tid); dbg_report(a, id, err, sr, D, tid);
}
__device__ __forceinline__ void chk_qkv(const Args& a, int layer, int id, LAS unsigned char* ldsb) {
    if (blockIdx.x >= 16) return; const int tid = tid_opaque(), r = dbg_sample_row(blockIdx.x), j = layer ? 1 : 0;
    LAS float* red = (LAS float*)ldsb; LAS float* y = red + 16; LAS float* hrow = y + 1536;
    const bf16* hb = (const bf16*)(a.ws + WS_HB) + (size_t)r * D;
    _Pragma("nounroll") for (int k = tid; k < D; k += 512) hrow[k] = dbg_hb(a, layer, (size_t)r * D + k, 1.f);
    __syncthreads();
    for (int n = tid; n < 1536; n += 512) { float s = 0.f; const float* w = a.in[I_WQKV] + (size_t)j * 1024 * 1536 + n; _Pragma("nounroll") for (int k = 0; k < 1024; ++k) s += hrow[k] * w[(size_t)k * 1536]; y[n] = s; }
    __syncthreads();
    float err = 0.f, sr = 0.f;
    for (int n = tid; n < 1536; n += 512) { float ref;
        if (n < 1280) { const int h0 = n & ~63; float ss = 0.f; _Pragma("nounroll") for (int q = 0; q < 64; ++q) ss += y[h0 + q] * y[h0 + q];
            const float rstd = rsqrtf(ss / 64.f + EPS); const float* g = (n < 1024 ? a.in[I_QG] : a.in[I_KG]) + j * 64;
            float v = y[n] * rstd * g[n & 63], vp = y[n ^ 1] * rstd * g[(n ^ 1) & 63];
            if (r < TL) { const int t = r % SEQ, i = (n & 63) >> 1, f = i & 15, pos = i < 16 ? t / 64 : t % 64; const float inv = powf(10000.f, -(float)f / 16.f), ang = (float)pos * inv, cs = cosf(ang), sn = sinf(ang);
                v = (n & 1) ? (vp * sn + v * cs) : (v * cs - vp * sn); }
            if (n < 1024) v *= 0.125f * 1.4426950408889634f;
            ref = v; } else ref = y[n];
        float got;
        if (n < 1024) { if (layer == 3 && r >= TL) continue; got = bf2f(((const bf16*)(a.ws + WS_Q))[(size_t)r * 1024 + n]); }
        else if (n < 1280) got = bf2f(((const bf16*)(a.ws + WS_K))[kv_row(r) * 256 + (n - 1024)]);
        else got = bf2f(((const bf16*)(a.ws + WS_V))[kv_row(r) * 256 + (n - 1280)]);
        err = fmaxf(err, fabsf(ref - got)); sr += ref * ref; }
    err = blk_max(err, red, tid); sr = blk_sum(sr, red, tid); dbg_report(a, id, err, sr, 1536, tid);
}
__device__ __forceinline__ void chk_att(const Args& a, int layer, int id, LAS unsigned char* ldsb) {
    if (blockIdx.x >= 16) return; const int tid = tid_opaque(), r = dbg_sample_row(blockIdx.x);
    if (layer == 3 && r >= TL) return;
    LAS float* red = (LAS float*)ldsb; LAS float* sc = red + 16; LAS float* po = sc + 4352;
    const int nk = r < TL ? KVROWS : CTXL; const long kv0 = (long)(r < TL ? r / SEQ : (r - TL) / CTXL) * KVROWS;
    const bf16* Qb = (const bf16*)(a.ws + WS_Q); const bf16* Kb = (const bf16*)(a.ws + WS_K); const bf16* Vb = (const bf16*)(a.ws + WS_V); const bf16* Ob = (const bf16*)(a.ws + WS_HB);
    float err = 0.f, sr = 0.f;
    for (int h = 0; h < 16; ++h) {
        float mx = -3e38f;
        _Pragma("nounroll") for (int jk = tid; jk < nk; jk += 512) { float s = 0.f; _Pragma("nounroll") for (int d = 0; d < 64; ++d) s += bf2f(Qb[(size_t)r * 1024 + h * 64 + d]) * bf2f(Kb[(kv0 + jk) * 256 + (h >> 2) * 64 + d]); sc[jk] = s; mx = fmaxf(mx, s); }
        mx = blk_max(mx, red, tid);
        float l = 0.f; _Pragma("nounroll") for (int jk = tid; jk < nk; jk += 512) { const float p = exp2f(sc[jk] - mx); sc[jk] = p; l += p; }
        l = blk_sum(l, red, tid);
        { const int d = tid & 63, part = tid >> 6; float o = 0.f; _Pragma("nounroll") for (int jk = part; jk < nk; jk += 8) o += sc[jk] * bf2f(Vb[(kv0 + jk) * 256 + (h >> 2) * 64 + d]); po[part * 64 + d] = o; }
        __syncthreads();
        if (tid < 64) { float o = 0.f; _Pragma("nounroll") for (int p = 0; p < 8; ++p) o += po[p * 64 + tid]; o /= l; err = fmaxf(err, fabsf(o - dbg_hb(a, layer, (size_t)r * 1024 + h * 64 + tid, 1.f / (float)(1 << ATT_OSH)))); sr += o * o; }
        __syncthreads();
    }
    err = blk_max(err, red, tid); sr = blk_sum(sr, red, tid); dbg_report(a, id, err, sr, 1024, tid);
}
__device__ __forceinline__ void chk_oproj(const Args& a, int layer, int id, LAS unsigned char* ldsb) {
    if (blockIdx.x >= 16 || layer != 0) return; const int tid = tid_opaque(), r = dbg_sample_row(blockIdx.x), j = 0;
    LAS float* red = (LAS float*)ldsb; LAS float* orow = red + 16;
    const bf16* Ob = (const bf16*)(a.ws + WS_HB) + (size_t)r * D;
    _Pragma("nounroll") for (int k = tid; k < D; k += 512) orow[k] = dbg_hb(a, layer, (size_t)r * D + k, 1.f / (float)(1 << ATT_OSH));
    __syncthreads();
    float err = 0.f, sr = 0.f;
    for (int n = tid; n < D; n += 512) { float s = 0.f; const float* w = a.in[I_WO] + (size_t)j * 1024 * 1024 + n; _Pragma("nounroll") for (int k = 0; k < 1024; ++k) s += orow[k] * w[(size_t)k * 1024];
        const float dl = dbg_mod(a, layer, r, 2 * D + n) * s, ref = resid_row(a, 0, r)[n] + dl; err = fmaxf(err, fabsf(ref - ((const float*)(a.ws + WS_X))[(size_t)r * D + n])); sr += dl * dl; }
    err = blk_max(err, red, tid); sr = blk_sum(sr, red, tid); dbg_report(a, id, err, sr, D, tid);
}
__device__ __forceinline__ void chk_moe(const Args& a, int layer, int id_tok, int id_y, LAS unsigned char* ldsb) {
    if (blockIdx.x >= 16) return; const int tid = tid_opaque(), r = dbg_sample_row(blockIdx.x);
    if (layer == 3 && r >= TL) return;
    LAS float* red = (LAS float*)ldsb; LAS float* tok = red + 16; LAS float* lg = tok + 1024; LAS float* tkb = lg + 64; LAS float* act = tkb + 1024; LAS float* rt = act + 1024;
    const float* x = (const float*)(a.ws + WS_X) + (size_t)r * D; const bf16* tk = (const bf16*)(a.ws + WS_TK) + (size_t)r * D;
    float ss = 0.f; for (int cc = tid; cc < D; cc += 512) ss += x[cc] * x[cc];
    ss = blk_sum(ss, red, tid); const float rstd = rsqrtf(ss / D + EPS);
    float err = 0.f, sr = 0.f;
    for (int cc = tid; cc < D; cc += 512) { const float sh = dbg_mod(a, layer, r, 3 * D + cc), sc = dbg_mod(a, layer, r, 4 * D + cc);
        const float ref = x[cc] * rstd * a.in[I_NFFN][layer * D + cc] * (1.f + sc) + sh; tok[cc] = ref;
#if MOE_FP8
        tkb[cc] = __builtin_amdgcn_cvt_f32_fp8((unsigned)((const unsigned char*)(a.ws + WS_TK))[(size_t)r * D + cc], 0);
#else
        tkb[cc] = bf2f(tk[cc]);
#endif
        err = fmaxf(err, fabsf(ref - tkb[cc])); sr += ref * ref; }
    err = blk_max(err, red, tid); sr = blk_sum(sr, red, tid);
    if (tid < 36) { float s = 0.f; _Pragma("nounroll") for (int k = 0; k < 1024; ++k) s += tok[k] * (tid < 4 ? a.in[I_WRG][((size_t)layer * 1024 + k) * 4 + tid] : a.in[I_WRE][((size_t)layer * 1024 + k) * 32 + tid - 4]); lg[tid] = s; }
    __syncthreads();
    if (tid == 0) { int grp = 0; _Pragma("nounroll") for (int q = 1; q < 4; ++q) if (lg[q] > lg[grp]) grp = q; float den = 0.f; _Pragma("nounroll") for (int q = 0; q < 4; ++q) den += expf(lg[q] - lg[grp]);
        const LAS float* le = lg + 4 + grp * 8; int i0 = 0; _Pragma("nounroll") for (int q = 1; q < 8; ++q) if (le[q] > le[i0]) i0 = q; int i1 = -1; _Pragma("nounroll") for (int q = 0; q < 8; ++q) if (q != i0 && (i1 < 0 || le[q] > le[i1])) i1 = q;
        const float ex = expf(le[i1] - le[i0]), w0 = 1.f / den / (1.f + ex), w1 = 1.f / den * ex / (1.f + ex);
        rt[0] = (float)(grp * 8 + i0); rt[1] = (float)(grp * 8 + i1); rt[2] = w0; rt[3] = w1;
        const float* w2 = (const float*)(a.ws + WS_W2); float e2 = fmaxf(fabsf(w2[2 * r] - w0), fabsf(w2[2 * r + 1] - w1)) * 30.f;
        const int* list = (const int*)(a.ws + WS_LIST); const unsigned* gc = (const unsigned*)(a.ws + WS_CTL) + CW_CNT + layer * 32;
        _Pragma("nounroll") for (int k = 0; k < 2; ++k) { const int e = (int)rt[k]; bool found = false; const int n = (int)gc[e]; _Pragma("nounroll") for (int q = 0; q < n && q < MOE_CAP; ++q) if (list[e * MOE_CAP + q] == 2 * r + k) found = true; if (!found) e2 = 1e6f; }
        rt[4] = e2; }
    __syncthreads();
    err = fmaxf(err, rt[4] * sqrtf(sr / D));
    dbg_report(a, id_tok, err, sr, D, tid);
    float err2 = 0.f, sr2 = 0.f;
    _Pragma("nounroll") for (int k = 0; k < 2; ++k) { const int e = (int)rt[k]; const float wk = rt[2 + k];
        const float* wgu = a.in[I_WGU] + ((size_t)layer * 32 + e) * 1024 * 1024; const float* wdn = a.in[I_WDN] + ((size_t)layer * 32 + e) * 512 * 1024;
        { float sg = 0.f, su = 0.f; _Pragma("nounroll") for (int q = 0; q < 1024; ++q) { sg += tkb[q] * wgu[(size_t)q * 1024 + tid]; su += tkb[q] * wgu[(size_t)q * 1024 + 512 + tid]; } act[tid] = (sg / (1.f + expf(-sg))) * su; }
        __syncthreads();
        for (int n = tid; n < D; n += 512) { float s = 0.f; _Pragma("nounroll") for (int q = 0; q < 512; ++q) s += act[q] * wdn[(size_t)q * 1024 + n]; s *= wk;
            err2 = fmaxf(err2, fabsf(s - bf2f(((const bf16*)(a.ws + WS_Y2))[(size_t)(2 * r + k) * D + n]))); sr2 += s * s; }
        __syncthreads(); }
    err2 = blk_max(err2, red, tid); sr2 = blk_sum(sr2, red, tid); dbg_report(a, id_y, err2, sr2, 2 * D, tid);
}

__global__ void __launch_bounds__(NTHREADS) dbg_kernel(Args a, int ty, int layer, int id) {
    extern __shared__ __attribute__((aligned(16))) unsigned char lds_dbg[];
    LAS unsigned char* l = (LAS unsigned char*)lds_dbg;
    if (ty == 1) chk_rmix(a, layer, id, l); else if (ty == 2) chk_qkv(a, layer, id, l); else if (ty == 3) chk_att(a, layer, id, l);
    else if (ty == 4) chk_oproj(a, layer, id, l); else if (ty == 5) chk_moe(a, layer, id, id + 1, l);
}
#endif

template <int KIND, int LAYER> __device__ __forceinline__ void run_phase(const Args& a0, Ctx& c, unsigned char* lds_gen) {
    Args a = a0; { unsigned long long wsv = (unsigned long long)a0.ws; asm volatile("" : "+s"(wsv)); a.ws = (unsigned char*)(GAS unsigned char*)wsv; }
    { unsigned lb = (unsigned)(uintptr_t)(LAS unsigned char*)lds_gen; asm volatile("" : "+s"(lb)); c.lds = (LAS unsigned char*)(uintptr_t)lb; }
    c.tid = tid_opaque(); c.lane = c.tid & 63;
    unsigned char* const ws = a.ws; constexpr int layer = LAYER;
#define RELAUNDER() do { { unsigned long long wsv_ = (unsigned long long)a0.ws; asm volatile("" : "+s"(wsv_)); a.ws = (unsigned char*)(GAS unsigned char*)wsv_; } \
        { unsigned lb_ = (unsigned)(uintptr_t)(LAS unsigned char*)lds_gen; asm volatile("" : "+s"(lb_)); c.lds = (LAS unsigned char*)(uintptr_t)lb_; } c.tid = tid_opaque(); c.lane = c.tid & 63; } while (0)
    if constexpr (KIND == K_P0) p0_prologue(a, c);
    else if constexpr (KIND == K_RMIX) ph_rmix(a, c, layer);
    else if constexpr (KIND == K_QKV) { constexpr int j = layer ? 1 : 0;
#if ATT_FP8
        SchedQKV S{(const char*)(ws + WS_HB), (const char*)(ws + WS_WQKV) + (size_t)j * 1536 * 1024, (size_t)256 * 1024, layer == 0 ? 1 : 0, c.G, (int)blockIdx.x};
        EpiQKV E{(bf16*)(ws + WS_Q), (bf16*)(ws + WS_K), (bf16*)(ws + WS_V), a.in[I_QG] + j * 64, a.in[I_KG] + j * 64, (const f32x2*)(ws + WS_ROPE)};
        pg8::gemm_phase<EpiQKV, SchedQKV, false, true>(c.lds, 1024, 1024, S, E, 127 - MOE_WSH, 127); }
#else
        SchedQKV S{(const char*)(ws + WS_HB), (const char*)(ws + WS_WQKV) + (size_t)j * 1536 * 1024 * 2, (size_t)256 * 1024 * 2, layer == 0 ? 1 : 0, c.G, (int)blockIdx.x};
        EpiQKV E{(bf16*)(ws + WS_Q), (bf16*)(ws + WS_K), (bf16*)(ws + WS_V), a.in[I_QG] + j * 64, a.in[I_KG] + j * 64, (const f32x2*)(ws + WS_ROPE)};
        pg8::gemm_phase<EpiQKV, SchedQKV, false>(c.lds, 2048, 2048, S, E); }
#endif
    else if constexpr (KIND == K_ROPE) ph_rope(a, c, layer);
    else if constexpr (KIND == K_ATT) ph_att(a, c, layer, (char*)c.lds);
    else if constexpr (KIND == K_OPROJ) { constexpr int j = layer ? 1 : 0;
#if ATT_FP8
        unsigned* rdx = (unsigned*)(ws + WS_CTL) + CW_RDX + layer * 128;
        SchedDenseR S{(const char*)(ws + WS_HB), (const char*)(ws + WS_WO) + (size_t)j * 1024 * 1024, (size_t)256 * 1024, (size_t)256 * 1024, 0, layer == 3 ? 64 : 68, 4, 64, c.G, (int)blockIdx.x, rdx};
        EpiResid E{&a, layer, nullptr, nullptr};
        pg8::gemm_phase<EpiResid, SchedDenseR, false, true>(c.lds, 1024, 1024, S, E, 127 - MOE_WSH, 127 - ATT_OSH);
        RELAUNDER(); ph_m1(a, c, layer, (unsigned*)(a.ws + WS_CTL) + CW_RDX + layer * 128, 4, 0); }
#else
        unsigned* rdx = (unsigned*)(ws + WS_CTL) + CW_RDX + layer * 128;
        SchedDenseR S{(const char*)(ws + WS_HB), (const char*)(ws + WS_WO) + (size_t)j * 1024 * 1024 * 2, (size_t)256 * 1024 * 2, (size_t)256 * 1024 * 2, 0, layer == 3 ? 64 : 68, 4, 64, c.G, (int)blockIdx.x, rdx};
        EpiResid E{&a, layer, nullptr, nullptr};
        pg8::gemm_phase<EpiResid, SchedDenseR, false>(c.lds, 2048, 2048, S, E);
        RELAUNDER(); ph_m1(a, c, layer, (unsigned*)(a.ws + WS_CTL) + CW_RDX + layer * 128, 4, 0); }
#endif
    else if constexpr (KIND == K_M2) {
        LAS int* tab = (LAS int*)(c.lds + TAB_OFF); moe_tables(a, c, layer, tab);
        unsigned* rdy = (unsigned*)(ws + WS_CTL) + CW_RDY + layer * 256;
#if MOE_FP8
        { SchedMoe S{(const char*)(ws + WS_TK), 0, (const char*)(ws + WS_WGU) + (size_t)layer * 32 * 1024 * 1024, (size_t)1024 * 1024, (size_t)256 * 1024, tab, (const int*)(ws + WS_LIST), c.G, (int)blockIdx.x, rdy, 1};
          EpiGateUp E{(bf16*)(ws + WS_ACT)};
          pg8::gemm_phase<EpiGateUp, SchedMoe, true, true>(c.lds, 1024, 1024, S, E, 127 - MOE_WSH, 127); }
        { SchedMoe S{(const char*)(ws + WS_ACT), (size_t)256 * 512, (const char*)(ws + WS_WDN) + (size_t)layer * 32 * 1024 * 512, (size_t)1024 * 512, (size_t)256 * 512, tab, (const int*)(ws + WS_LIST), c.G, (int)blockIdx.x, rdy, 2};
          EpiDown E{(const int*)(ws + WS_LIST), (const float*)(ws + WS_W2), (bf16*)(ws + WS_Y2)};
          pg8::gemm_phase<EpiDown, SchedMoe, false, true>(c.lds, 512, 512, S, E, 127 - MOE_WSH, 127 - MOE_ASH); } }
#else
        { SchedMoe S{(const char*)(ws + WS_TK), 0, (const char*)(ws + WS_WGU) + (size_t)layer * 32 * 1024 * 1024 * 2, (size_t)1024 * 1024 * 2, (size_t)256 * 1024 * 2, tab, (const int*)(ws + WS_LIST), c.G, (int)blockIdx.x, rdy, 1};
          EpiGateUp E{(bf16*)(ws + WS_ACT)};
          pg8::gemm_phase<EpiGateUp, SchedMoe, true>(c.lds, 2048, 2048, S, E); }
        { SchedMoe S{(const char*)(ws + WS_ACT), (size_t)256 * 512 * 2, (const char*)(ws + WS_WDN) + (size_t)layer * 32 * 1024 * 512 * 2, (size_t)1024 * 512 * 2, (size_t)256 * 512 * 2, tab, (const int*)(ws + WS_LIST), c.G, (int)blockIdx.x, rdy, 2};
          EpiDown E{(const int*)(ws + WS_LIST), (const float*)(ws + WS_W2), (bf16*)(ws + WS_Y2)};
          pg8::gemm_phase<EpiDown, SchedMoe, false>(c.lds, 1024, 1024, S, E); } }
#endif
    else if constexpr (KIND == K_RPOOL) ph_rpool(a, c, layer);
    else if constexpr (KIND == K_POOLG) {
        unsigned* rdx = (unsigned*)(ws + WS_CTL) + CW_RDX + layer * 128;
        SchedDenseR S{(const char*)(ws + WS_HB), (const char*)(ws + WS_WPOOL), (size_t)256 * 1024 * 2, (size_t)256 * 256 * 2, (size_t)256 * 2, 68, 4, 64, c.G, (int)blockIdx.x, rdx};
        EpiResidN E{&a, layer, a.in[I_POOLS], (const bf16*)(ws + WS_Z)};
        pg8::gemm_phase<EpiResidN, SchedDenseR, false>(c.lds, 512, 2048, S, E);
        RELAUNDER(); ph_m1(a, c, layer, (unsigned*)(a.ws + WS_CTL) + CW_RDX + layer * 128, 4, 0); }
    else if constexpr (KIND == K_INPROJ) {
        SchedDense S{(const char*)(ws + WS_HB), (const char*)(ws + WS_WIN), (size_t)256 * 1024 * 2, (size_t)256 * 1024 * 2, 0, 68, 21, c.G, (int)blockIdx.x};
        EpiInproj E{(bf16*)(ws + WS_Z), (bf16*)(ws + WS_XBC), (float*)(ws + WS_DT), a.in[I_DTB]};
        pg8::gemm_phase<EpiInproj, SchedDense, false>(c.lds, 2048, 2048, S, E); }
    else if constexpr (KIND == K_CONV) ph_conv(a, c);
    else if constexpr (KIND == K_SCAN) ph_scan(a, c);
    else if constexpr (KIND == K_YPH) {
        ph_yph(a, c, (unsigned*)(ws + WS_CTL) + CW_RDG);
        RELAUNDER();
        { unsigned* rdx = (unsigned*)(a.ws + WS_CTL) + CW_RDX + layer * 128;
          SchedOutproj S{(const char*)(a.ws + WS_G), (const char*)(a.ws + WS_WOUT), (size_t)256 * 2048 * 2, (size_t)256 * 2048 * 2, c.G, c.vcu, (const unsigned*)(a.ws + WS_CTL) + CW_RDG, rdx};
          EpiResid E{&a, layer, nullptr, nullptr};
          pg8::gemm_phase<EpiResid, SchedOutproj, false>(c.lds, 4096, 4096, S, E); }
        RELAUNDER(); ph_m1(a, c, layer, (unsigned*)(a.ws + WS_CTL) + CW_RDX + layer * 128, 4, 1); }
    else if constexpr (KIND == K_GFIX) ph_gfix(a, c);
    else if constexpr (KIND == K_FINAL) ph_final(a, c, layer);
#undef RELAUNDER
}
#define PROGRAM(X) \
    X(0, K_P0, 0) \
    X(1, K_RMIX, 0) X(2, K_QKV, 0) X(3, K_ATT, 0) X(4, K_OPROJ, 0) X(5, K_M2, 0) \
    X(6, K_RPOOL, 1) X(7, K_POOLG, 1) X(8, K_M2, 1) \
    X(9, K_RMIX, 2) X(10, K_INPROJ, 2) X(11, K_CONV, 2) X(12, K_SCAN, 2) X(13, K_YPH, 2) X(14, K_M2, 2) \
    X(15, K_RMIX, 3) X(16, K_QKV, 3) X(17, K_ATT, 3) X(18, K_OPROJ, 3) X(19, K_M2, 3) \
    X(20, K_FINAL, 4)
constexpr int NPHASES = 21;
__device__ __forceinline__ unsigned long long probe_phases(const unsigned long long* ts, unsigned mask) { unsigned long long r = 0; for (int k = 0; k < 32; ++k) if (mask & (1u << k)) r += ts[k + 1] - ts[k]; return r; }
__device__ __forceinline__ unsigned long long probe_sum(const unsigned long long* s, int mask) { unsigned long long r = 0; for (int k = 0; k < 8; ++k) if (mask & (1 << k)) r += s[k]; return r; }
__global__ void __launch_bounds__(NTHREADS, 2) mega(Args a0) {
    extern __shared__ __attribute__((aligned(16))) unsigned char lds_raw[];
    Ctx c; c.lds = (LAS unsigned char*)lds_raw; c.tid = threadIdx.x; c.lane = c.tid & 63; c.wave = __builtin_amdgcn_readfirstlane(c.tid >> 6);
    c.G = gridDim.x; { const int bx = blockIdx.x; c.vcu = (c.G % 8 == 0) ? (bx % 8) * (c.G / 8) + bx / 8 : bx; }
    volatile LAS unsigned* MISC = (volatile LAS unsigned*)(c.lds + MISC_OFF);
    for (int u = c.tid; u < 128; u += NTHREADS) MISC[u] = 0u;
    __syncthreads();
    XcdBarrier bar = xcd_barrier_post((unsigned*)(a0.ws + WS_CTL) + CW_BAR + a0.bar_region * XCD_BAR_WORDS, MISC + 8);
    const int lo = a0.ph_lo, hi = a0.ph_hi;
#if PROBE
#define STAMP(idx) if (blockIdx.x == 0 && threadIdx.x == 0) __hip_atomic_store((unsigned long long*)((unsigned*)(a0.ws + WS_CTL) + CW_TS) + (idx), (unsigned long long)__builtin_amdgcn_s_memrealtime(), __ATOMIC_RELAXED, __HIP_MEMORY_SCOPE_AGENT);
#else
#define STAMP(idx)
#endif
    STAMP(0)
#if EXTRA_BARS
    for (int eb = 0; eb < EXTRA_BARS; ++eb) xcd_barrier(bar);
#endif
#define RUNPH(idx, KIND, LAYER) if (lo <= (idx) && (idx) < hi) { run_phase<KIND, LAYER>(a0, c, lds_raw); if ((idx) + 1 < hi) xcd_barrier(bar); STAMP((idx) + 1) }
    PROGRAM(RUNPH)
#undef RUNPH
#if PROBE
    if (blockIdx.x == 0 && threadIdx.x == 0 && hi == NPHASES) { const unsigned long long* ts = (const unsigned long long*)((unsigned*)(a0.ws + WS_CTL) + CW_TS);
        const unsigned long long d = (unsigned long long)PROBE_K * (PROBE_SLOT ? probe_sum(ts + PROBE_SLOT_BASE, PROBE_SLOT) : probe_phases(ts, PROBE_MASK)), t0 = __builtin_amdgcn_s_memrealtime();
        while (__builtin_amdgcn_s_memrealtime() - t0 < d) __builtin_amdgcn_s_sleep(8); }
#endif
}

extern "C" void kernel_launch(void* const* d_in, const int* in_sizes, int n_in, void* d_out, int out_size, void* d_ws, size_t ws_size, hipStream_t stream) {
    static int grid = 0;
    if (grid == 0) {
        if (n_in != N_IN || out_size != TL * D || ws_size < WS_END) { fprintf(stderr, "kernel_launch: unexpected shapes (n_in %d out %d ws %zu)\n", n_in, out_size, ws_size); grid = -1; return; }
        int dev = 0, cus = 0;
        if (hipGetDevice(&dev) != hipSuccess || hipDeviceGetAttribute(&cus, hipDeviceAttributeMultiprocessorCount, dev) != hipSuccess) { grid = -1; return; }
        if (hipFuncSetAttribute((const void*)mega, hipFuncAttributeMaxDynamicSharedMemorySize, LDS_BYTES) != hipSuccess) { fprintf(stderr, "kernel_launch: hipFuncSetAttribute failed\n"); grid = -1; return; }
        int per_cu = 0;
        if (hipOccupancyMaxActiveBlocksPerMultiprocessor(&per_cu, (const void*)mega, NTHREADS, LDS_BYTES) != hipSuccess || per_cu < 1) fprintf(stderr, "kernel_launch: occupancy query says %d\n", per_cu);
        (void)hipGetLastError();
        grid = cus;
    }
    if (grid < 0) return;
    (void)hipMemsetAsync((char*)d_ws + WS_CTL, 0, CTL_ZERO_BYTES, stream);
    Args a{};
    for (int i = 0; i < N_IN; ++i) a.in[i] = (const float*)d_in[i];
    a.out = (float*)d_out; a.ws = (unsigned char*)d_ws; a.flags = 0;
#if DEBUG_CHECKS
    struct Cut { int after; int ty, layer, nid; };
    const Cut cuts[] = DEBUG_CUTS;
    int lo = 0, region = 0, dbg_id = 1;
    for (unsigned k = 0; k < sizeof(cuts) / sizeof(cuts[0]); ++k) {
        if (cuts[k].after + 1 > lo) { a.ph_lo = lo; a.ph_hi = cuts[k].after + 1; a.bar_region = region++; hipLaunchKernelGGL(mega, dim3(grid), dim3(NTHREADS), LDS_BYTES, stream, a); lo = cuts[k].after + 1; }
        hipLaunchKernelGGL(dbg_kernel, dim3(16), dim3(NTHREADS), 65536, stream, a, cuts[k].ty, cuts[k].layer, dbg_id); dbg_id += cuts[k].nid;
    }
    a.ph_lo = lo; a.ph_hi = NPHASES; a.bar_region = region++;
    hipLaunchKernelGGL(mega, dim3(grid), dim3(NTHREADS), LDS_BYTES, stream, a);
#else
    a.ph_lo = 0; a.ph_hi = NPHASES; a.bar_region = 0;
    hipLaunchKernelGGL(mega, dim3(grid), dim3(NTHREADS), LDS_BYTES, stream, a);
#endif
}
```

```cpp
#include <hip/hip_runtime.h>
#include <cstdio>
#include <cstdint>

#define LAS __attribute__((address_space(3)))
#define GAS __attribute__((address_space(1)))
typedef unsigned short bf16;
typedef short bf16x8 __attribute__((ext_vector_type(8)));
typedef short s16x4 __attribute__((ext_vector_type(4)));
typedef float f32x2 __attribute__((ext_vector_type(2)));
typedef float f32x4 __attribute__((ext_vector_type(4)));
typedef float f32x16 __attribute__((ext_vector_type(16)));
typedef unsigned u32x2 __attribute__((ext_vector_type(2)));
typedef unsigned u32x4 __attribute__((ext_vector_type(4)));
typedef __bf16 bf16x2_t __attribute__((ext_vector_type(2)));

constexpr int D = 1024, NB = 4, SEQ = 4096, CTXL = 256, TL = NB * SEQ, TC = NB * CTXL, TT = TL + TC;
constexpr int KVROWS = SEQ + CTXL;
constexpr int NCH = TT / 128;
constexpr int MOE_CAP = TT;
constexpr float EPS = 1e-6f;
constexpr int NWAVES = 8, NTHREADS = 512;
#ifndef NLAYERS
#define NLAYERS 4
#endif
#ifndef MOE_FP8
#define MOE_FP8 1
#endif
#define MOE_WSH 5
#ifndef ATT_FP8
#define ATT_FP8 1
#endif
#define ATT_OSH 3
#define MOE_ASH 2
#define DBG_TOL 0.03f
#ifndef DEBUG_CHECKS
#define DEBUG_CHECKS 0
#endif
#ifndef PROBE
#define PROBE 0
#endif
#define PROBE_A0 0
#define PROBE_A1 1
#define PROBE_B0 4
#define PROBE_B1 5
#define PROBE_K 2
#define PROBE_MASK 0x1222224u
#define EXTRA_BARS 0
#define PROBE_SLOT_BASE 40
#define PROBE_SLOT 0
#if PROBE
#define SECT_DECL unsigned long long sect_t = __builtin_amdgcn_s_memrealtime(); unsigned long long sect_acc[8] = {0, 0, 0, 0, 0, 0, 0, 0};
#define SECT(k) do { const unsigned long long n_ = __builtin_amdgcn_s_memrealtime(); sect_acc[k] += n_ - sect_t; sect_t = n_; } while (0)
#ifndef PROBE_BLOCK
#define PROBE_BLOCK 0
#endif
#define SECT_END(base) do { if (blockIdx.x == PROBE_BLOCK && threadIdx.x == 0) { _Pragma("unroll") for (int k_ = 0; k_ < 8; ++k_) ((unsigned long long*)((unsigned*)(a.ws + WS_CTL) + CW_TS))[(base) + k_] = sect_acc[k_]; } } while (0)
#else
#define SECT_DECL
#define SECT(k) do {} while (0)
#define SECT_END(base) do {} while (0)
#endif
#define DEBUG_CUTS { {1, 1, 0, 1}, {2, 2, 0, 1}, {3, 3, 0, 1}, {4, 4, 0, 1}, {6, 5, 0, 2} }

enum { I_X = 0, I_C, I_CTX, I_CCTX, I_WADA, I_BADA, I_NMIX, I_NFFN, I_NFIN, I_WQKV, I_WO, I_QG, I_KG, I_POOLW, I_POOLS, I_WIN, I_CONVW, I_CONVB, I_DTB, I_ALOG, I_DSK, I_SNORM, I_WOUT, I_WRG, I_WRE, I_WGU, I_WDN, N_IN };

constexpr size_t MiB = 1u << 20;
constexpr size_t WS_CTL = 0, CTL_ZERO_BYTES = 1 * MiB;
constexpr size_t WS_MODL = 1 * MiB;
constexpr size_t WS_MODC = WS_MODL + 4 * 4 * 6144 * 4;
constexpr size_t WS_ROPE = 1 * MiB + 512 * 1024;
constexpr size_t WS_WR = 2 * MiB;
constexpr size_t WS_WQKV = 3 * MiB;
constexpr size_t WS_WO = 9 * MiB;
constexpr size_t WS_WPOOL = 13 * MiB;
constexpr size_t WS_WIN = 14 * MiB;
constexpr size_t WS_WOUT = 25 * MiB;
constexpr size_t WS_WGU = 29 * MiB;
constexpr size_t WS_WDN = 285 * MiB;
constexpr size_t WS_X = 413 * MiB;
constexpr size_t WS_HB = 481 * MiB;
constexpr size_t WS_TK = 515 * MiB;
constexpr size_t WS_Q = 549 * MiB;
constexpr size_t WS_K = 583 * MiB;
constexpr size_t WS_V = 592 * MiB;
constexpr size_t WS_Y2 = 601 * MiB;
constexpr size_t WS_ACT = 669 * MiB;
constexpr size_t WS_LIST = 711 * MiB;
constexpr size_t WS_W2 = 714 * MiB;
constexpr size_t WS_Z = 715 * MiB;
constexpr size_t WS_XBC = 783 * MiB;
constexpr size_t WS_DT = 885 * MiB;
constexpr size_t WS_XT = 890 * MiB;
constexpr size_t WS_BN = 958 * MiB;
constexpr size_t WS_BT = 975 * MiB;
constexpr size_t WS_CN = 992 * MiB;
constexpr size_t WS_SCA = 1009 * MiB;
constexpr size_t WS_SCB = 1018 * MiB;
constexpr size_t WS_DEC = 1027 * MiB;
constexpr size_t WS_HIN = 1028 * MiB;
constexpr size_t WS_G = 1164 * MiB;
constexpr size_t WS_RSTD = 1232 * MiB;
constexpr size_t WS_END = 1233 * MiB;

constexpr int CW_BAR = 4096;
constexpr int CW_CNT = 200000;
constexpr int CW_DBG = 201000;
constexpr int CW_RDY = 204000;
constexpr int CW_RDG = 207000;
constexpr int CW_RDX = 206000;
constexpr int CW_TS = 202000;

constexpr int LDS_BYTES = 163840;
constexpr int MISC_OFF = LDS_BYTES - 512;

__device__ __forceinline__ unsigned cvtpk(float lo, float hi) { f32x2 v = {lo, hi}; bf16x2_t b = __builtin_convertvector(v, bf16x2_t); return __builtin_bit_cast(unsigned, b); }
__device__ __forceinline__ unsigned pk_fp8x4(float a, float b, float c, float d) {
    a = __builtin_amdgcn_fmed3f(a, -448.f, 448.f); b = __builtin_amdgcn_fmed3f(b, -448.f, 448.f); c = __builtin_amdgcn_fmed3f(c, -448.f, 448.f); d = __builtin_amdgcn_fmed3f(d, -448.f, 448.f);
    unsigned w = __builtin_amdgcn_cvt_pk_fp8_f32(a, b, 0u, false); return __builtin_amdgcn_cvt_pk_fp8_f32(c, d, w, true); }
__device__ __forceinline__ float bflo(unsigned u) { return __uint_as_float(u << 16); }
__device__ __forceinline__ float bfhi(unsigned u) { return __uint_as_float(u & 0xffff0000u); }
__device__ __forceinline__ float bf2f(bf16 b) { return __uint_as_float((unsigned)b << 16); }
__device__ __forceinline__ float wave_sum(float v) {
#pragma unroll
    for (int o = 1; o < 64; o <<= 1) v += __shfl_xor(v, o);
    return v;
}
__device__ __forceinline__ float silu_f(float v) { return v * __builtin_amdgcn_rcpf(1.0f + __builtin_amdgcn_exp2f(v * -1.4426950408889634f)); }
__device__ __forceinline__ int tid_opaque() { int t = threadIdx.x; asm volatile("" : "+v"(t)); return t; }
#define LDS_WAIT() asm volatile("s_waitcnt lgkmcnt(0)" ::: "memory")
#define VM_WAIT() asm volatile("s_waitcnt vmcnt(0)" ::: "memory")

#define XB_TMO      128
#define XB_XCNT(j)  (256  + 64 * (j))
#define XB_XSUB(j)  (1280 + 64 * (j))
#define XB_XGEN(j)  (2304 + 64 * (j))
#define XB_TOP      3328
#define XB_TOPGEN   3392
#define XCD_BAR_WORDS 3456
#define XB_SPIN_CAP (1u << 20)
#ifndef XB_FLATPOLL
#define XB_FLATPOLL 0
#endif
__device__ __forceinline__ unsigned xb_ld(unsigned* p)              { return __hip_atomic_load(p, __ATOMIC_RELAXED, __HIP_MEMORY_SCOPE_AGENT); }
__device__ __forceinline__ unsigned xb_add(unsigned* p, unsigned v) { return __hip_atomic_fetch_add(p, v, __ATOMIC_RELAXED, __HIP_MEMORY_SCOPE_AGENT); }
__device__ __forceinline__ unsigned xb_xcc_id() { return (unsigned)__builtin_amdgcn_s_getreg((3 << 11) | 20) & 0xFu; }
#define XB_SPIN(cond, bar) do { unsigned _sp = 0; while (cond) { __builtin_amdgcn_s_sleep(1); \
    if ((++_sp & 255u) == 0u) { if (xb_ld(&(bar)[XB_TMO])) break; if (_sp > XB_SPIN_CAP) { atomicAdd(&(bar)[XB_TMO], 1u); break; } } } } while (0)
struct XcdBarrier { unsigned* bar; unsigned x; volatile LAS unsigned* st; };
__device__ __forceinline__ XcdBarrier xcd_barrier_post(unsigned* bar, volatile LAS unsigned* st) {
    XcdBarrier b; b.bar = bar; b.x = xb_xcc_id(); b.st = st;
    if (threadIdx.x == 0) (void)xb_add(&bar[XB_XCNT(b.x)], 1u);
    return b;
}
__device__ __forceinline__ void xcd_barrier_complete(unsigned* bar, unsigned x, unsigned& nloc, unsigned& nx) {
    const unsigned G = gridDim.x * gridDim.y * gridDim.z;
    unsigned sum, cnt, mine, sp = 0u;
    for (;;) {
        sum = 0u; cnt = 0u; mine = 0u;
#pragma unroll
        for (unsigned j = 0; j < 16; ++j) { const unsigned c = xb_ld(&bar[XB_XCNT(j)]); sum += c; cnt += (c > 0u) ? 1u : 0u; mine = (j == x) ? c : mine; }
        if (sum == G) break;
        __builtin_amdgcn_s_sleep(1);
        if ((++sp & 255u) == 0u) { if (xb_ld(&bar[XB_TMO])) break; if (sp > XB_SPIN_CAP) { atomicAdd(&bar[XB_TMO], 1u); break; } }
    }
    nloc = mine > 0u ? mine : 1u; nx = cnt > 0u ? cnt : 1u;
}
__device__ __forceinline__ void xcd_barrier(const XcdBarrier& b) {
    asm volatile("s_waitcnt vmcnt(0)" ::: "memory");
    __syncthreads();
    if (threadIdx.x == 0) {
        unsigned* bar = b.bar;
        __builtin_amdgcn_s_waitcnt(0);
        unsigned nloc = b.st[0], nx = b.st[1];
        if (nloc == 0u) { xcd_barrier_complete(bar, b.x, nloc, nx); b.st[0] = nloc; b.st[1] = nx; }
#if XB_FLATPOLL
        const unsigned seq = b.st[2]; b.st[2] = seq + 1u;
#endif
        const unsigned old = xb_add(&bar[XB_XSUB(b.x)], 1u);
        const unsigned gen = old / nloc;
        if (old + 1u == (gen + 1u) * nloc) {
            __builtin_amdgcn_fence(__ATOMIC_RELEASE, "agent");
            asm volatile("s_waitcnt vmcnt(0)" ::: "memory");
            const unsigned og = xb_add(&bar[XB_TOP], 1u);
            const unsigned tg = og / nx;
            if (og + 1u == (tg + 1u) * nx) xb_add(&bar[XB_TOPGEN], 1u);
            else XB_SPIN(xb_ld(&bar[XB_TOPGEN]) == tg, bar);
            __builtin_amdgcn_fence(__ATOMIC_ACQUIRE, "agent");
#if !XB_FLATPOLL
            xb_add(&bar[XB_XGEN(b.x)], 1u);
#endif
            asm volatile("s_waitcnt vmcnt(0)" ::: "memory");
        } else {
#if XB_FLATPOLL
            XB_SPIN(xb_ld(&bar[XB_TOPGEN]) == seq, bar);
#else
            XB_SPIN(xb_ld(&bar[XB_XGEN(b.x)]) == gen, bar);
#endif
            __builtin_amdgcn_fence(__ATOMIC_ACQUIRE, "agent");
            asm volatile("s_waitcnt vmcnt(0)" ::: "memory");
        }
    }
    __syncthreads();
}

enum { K_P0 = 0, K_RMIX, K_QKV, K_ROPE, K_ATT, K_OPROJ, K_M1, K_M2, K_M3, K_RPOOL, K_POOLG, K_INPROJ, K_CONV, K_SCAN, K_YPH, K_GFIX, K_OUTPROJ, K_FINAL, K_DBG };
struct Args { const float* in[N_IN]; float* out; unsigned char* ws; int ph_lo, ph_hi; int flags; int bar_region; };

struct Ctx {
    LAS unsigned char* lds; int tid, lane, wave, vcu, G;
};

__device__ __forceinline__ const float* mod_row(const Args& a, int layer, int r) {
    return r < TL ? (const float*)(a.ws + WS_MODL) + (size_t)(layer * 4 + r / SEQ) * 6144 : (const float*)(a.ws + WS_MODC) + (size_t)layer * 6144;
}
__device__ __forceinline__ const float* resid_row(const Args& a, int layer, int r) {
    if (layer == 0) return r < TL ? a.in[I_X] + (size_t)r * D : a.in[I_CTX] + (size_t)(r - TL) * D;
    return (const float*)(a.ws + WS_X) + (size_t)r * D;
}

__device__ __forceinline__ void load_row_combined(const Args& a, int layer, int r, int lane, f32x4 (&v)[4]) {
    if (layer == 0) { const f32x4* xr = (const f32x4*)resid_row(a, 0, r) + lane;
#pragma unroll
        for (int j = 0; j < 4; ++j) v[j] = xr[64 * j]; }
    else { const u32x2* xr = (const u32x2*)((const bf16*)(a.ws + WS_X) + (size_t)r * D) + lane;
#pragma unroll
        for (int j = 0; j < 4; ++j) { const u32x2 p = xr[64 * j]; v[j] = (f32x4){bflo(p.x), bfhi(p.x), bflo(p.y), bfhi(p.y)}; } }
    if (layer > 0 && !(a.flags & 1)) {
        const f32x4* gf = (const f32x4*)(mod_row(a, layer - 1, r) + 5 * D) + lane;
        const u32x2* y0 = (const u32x2*)((const bf16*)(a.ws + WS_Y2) + (size_t)(2 * r) * D) + lane;
        const u32x2* y1 = (const u32x2*)((const bf16*)(a.ws + WS_Y2) + (size_t)(2 * r + 1) * D) + lane;
#pragma unroll
        for (int j = 0; j < 4; ++j) {
            const u32x2 p = y0[64 * j], q = y1[64 * j]; const f32x4 g = gf[64 * j];
            v[j].x += g.x * (bflo(p.x) + bflo(q.x)); v[j].y += g.y * (bfhi(p.x) + bfhi(q.x));
            v[j].z += g.z * (bflo(p.y) + bflo(q.y)); v[j].w += g.w * (bfhi(p.y) + bfhi(q.y));
        }
    }
}
__device__ __forceinline__ float row_rstd(const f32x4 (&v)[4]) {
    float s = 0.f;
#pragma unroll
    for (int j = 0; j < 4; ++j) s += (v[j].x * v[j].x + v[j].y * v[j].y) + (v[j].z * v[j].z + v[j].w * v[j].w);
    return rsqrtf(wave_sum(s) * (1.0f / D) + EPS);
}
__device__ __forceinline__ void norm_mod(const f32x4 (&v)[4], float rstd, const float* g, const float* shift, const float* scale, int lane, f32x4 (&h)[4]) {
#pragma unroll
    for (int j = 0; j < 4; ++j) {
        const f32x4 gg = ((const f32x4*)g)[lane + 64 * j], sh = ((const f32x4*)shift)[lane + 64 * j], sc = ((const f32x4*)scale)[lane + 64 * j];
        h[j] = (v[j] * rstd) * gg * (sc + 1.0f) + sh;
    }
}

__device__ __forceinline__ void tr_item(const float* W, int N, int k0, int n0, bf16* WT, size_t drow0, int dK, LAS float* scr, int lane, int hi_skip = 0) {
    const int nq = lane & 15, kr = lane >> 4;
#pragma unroll
    for (int i = 0; i < 16; ++i) { const int kk = 4 * i + kr; const f32x4 v = *(const f32x4*)(W + (size_t)(k0 + kk) * N + n0 + 4 * nq);
        LAS float* d = scr + kk * 65 + 4 * nq; d[0] = v.x; d[1] = v.y; d[2] = v.z; d[3] = v.w; }
    LDS_WAIT(); asm volatile("" ::: "memory");
    const int c = lane & 7;
#pragma unroll
    for (int j = 0; j < 8; ++j) { const int n = (lane >> 3) + 8 * j; const LAS float* s = scr + (8 * c) * 65 + n;
        u32x4 o; o.x = cvtpk(s[0 * 65], s[1 * 65]); o.y = cvtpk(s[2 * 65], s[3 * 65]); o.z = cvtpk(s[4 * 65], s[5 * 65]); o.w = cvtpk(s[6 * 65], s[7 * 65]);
        *(u32x4*)(WT + (drow0 + n + (n >= 32 ? hi_skip : 0)) * dK + k0 + 8 * c) = o; }
    LDS_WAIT(); asm volatile("" ::: "memory");
}
__device__ __forceinline__ void tr_item8(const float* W, int N, int k0, int n0, unsigned char* WT, size_t drow0, int dKb, LAS float* scr, int lane, float scale, int hi_skip = 0) {
    const int nq = lane & 15, kr = lane >> 4;
#pragma unroll
    for (int i = 0; i < 16; ++i) { const int kk = 4 * i + kr; const f32x4 v = *(const f32x4*)(W + (size_t)(k0 + kk) * N + n0 + 4 * nq);
        LAS float* d = scr + kk * 65 + 4 * nq; d[0] = v.x; d[1] = v.y; d[2] = v.z; d[3] = v.w; }
    LDS_WAIT(); asm volatile("" ::: "memory");
    const int c = lane & 3;
#pragma unroll
    for (int j = 0; j < 4; ++j) { const int n = (lane >> 2) + 16 * j; const LAS float* s = scr + (16 * c) * 65 + n;
        u32x4 o; o.x = pk_fp8x4(s[0 * 65] * scale, s[1 * 65] * scale, s[2 * 65] * scale, s[3 * 65] * scale); o.y = pk_fp8x4(s[4 * 65] * scale, s[5 * 65] * scale, s[6 * 65] * scale, s[7 * 65] * scale);
        o.z = pk_fp8x4(s[8 * 65] * scale, s[9 * 65] * scale, s[10 * 65] * scale, s[11 * 65] * scale); o.w = pk_fp8x4(s[12 * 65] * scale, s[13 * 65] * scale, s[14 * 65] * scale, s[15 * 65] * scale);
        *(u32x4*)(WT + (drow0 + n + (n >= 32 ? hi_skip : 0)) * dKb + k0 + 16 * c) = o; }
    LDS_WAIT(); asm volatile("" ::: "memory");
}
struct TrD { const float* src; int N; unsigned char* dst; int dKb, drow0, hi_skip, fp8; };
__device__ __forceinline__ void tr_load(const TrD& d, f32x4 (&v)[16], int lane) {
    const int nq = lane & 15, kr = lane >> 4;
#pragma unroll
    for (int i = 0; i < 16; ++i) v[i] = *(const f32x4*)(d.src + (size_t)(4 * i + kr) * d.N + 4 * nq);
}
__device__ __forceinline__ void tr_store(const TrD& d, const f32x4 (&v)[16], LAS float* scr, int lane) {
    const int nq = lane & 15, kr = lane >> 4;
#pragma unroll
    for (int i = 0; i < 16; ++i) { LAS float* p = scr + (4 * i + kr) * 65 + 4 * nq; p[0] = v[i].x; p[1] = v[i].y; p[2] = v[i].z; p[3] = v[i].w; }
    LDS_WAIT(); asm volatile("" ::: "memory");
    if (d.fp8) { const int c = lane & 3; const float scale = (float)(1 << MOE_WSH);
#pragma unroll
        for (int j = 0; j < 4; ++j) { const int n = (lane >> 2) + 16 * j; const LAS float* s = scr + (16 * c) * 65 + n;
            u32x4 o; o.x = pk_fp8x4(s[0 * 65] * scale, s[1 * 65] * scale, s[2 * 65] * scale, s[3 * 65] * scale); o.y = pk_fp8x4(s[4 * 65] * scale, s[5 * 65] * scale, s[6 * 65] * scale, s[7 * 65] * scale);
            o.z = pk_fp8x4(s[8 * 65] * scale, s[9 * 65] * scale, s[10 * 65] * scale, s[11 * 65] * scale); o.w = pk_fp8x4(s[12 * 65] * scale, s[13 * 65] * scale, s[14 * 65] * scale, s[15 * 65] * scale);
            *(u32x4*)(d.dst + (size_t)(d.drow0 + n + (n >= 32 ? d.hi_skip : 0)) * d.dKb + 16 * c) = o; } }
    else { const int c = lane & 7;
#pragma unroll
        for (int j = 0; j < 8; ++j) { const int n = (lane >> 3) + 8 * j; const LAS float* s = scr + (8 * c) * 65 + n;
            u32x4 o; o.x = cvtpk(s[0 * 65], s[1 * 65]); o.y = cvtpk(s[2 * 65], s[3 * 65]); o.z = cvtpk(s[4 * 65], s[5 * 65]); o.w = cvtpk(s[6 * 65], s[7 * 65]);
            *(u32x4*)(d.dst + (size_t)(d.drow0 + n + (n >= 32 ? d.hi_skip : 0)) * d.dKb + 16 * c) = o; } }
    LDS_WAIT(); asm volatile("" ::: "memory");
}
constexpr int TR_I0 = 2 * 384, TR_I1 = 2 * 256, TR_I2 = 4 * 16, TR_I3 = 16 * 81, TR_I4 = 32 * 16, TR_I5 = 128 * 256, TR_I6 = 128 * 128, TR_ITOT = TR_I0 + TR_I1 + TR_I2 + TR_I3 + TR_I4 + TR_I5 + TR_I6;
__device__ __forceinline__ TrD tr_decode(const Args& a, int it) {
    TrD d; int r = it; d.hi_skip = 0;
    if (r < TR_I5) { const int m = r / 256, q = r % 256, kb = q / 16, nb = q % 16, n0 = nb * 64, j = n0 & 511;
        d.src = a.in[I_WGU] + (size_t)m * 1024 * 1024 + (size_t)kb * 64 * 1024 + n0; d.N = 1024; d.drow0 = 256 * (j >> 7) + (j & 127) + ((n0 >= 512) ? 128 : 0);
        d.fp8 = MOE_FP8; d.dKb = MOE_FP8 ? 1024 : 2048; d.dst = (unsigned char*)(a.ws + WS_WGU) + (size_t)m * 1024 * d.dKb + (size_t)kb * 64 * (MOE_FP8 ? 1 : 2); return d; }
    r -= TR_I5;
    if (r < TR_I6) { const int m = r / 128, q = r % 128, kb = q / 16, nb = q % 16;
        d.src = a.in[I_WDN] + (size_t)m * 512 * 1024 + (size_t)kb * 64 * 1024 + nb * 64; d.N = 1024; d.drow0 = nb * 64;
        d.fp8 = MOE_FP8; d.dKb = MOE_FP8 ? 512 : 1024; d.dst = (unsigned char*)(a.ws + WS_WDN) + (size_t)m * 1024 * d.dKb + (size_t)kb * 64 * (MOE_FP8 ? 1 : 2); return d; }
    r -= TR_I6;
    if (r < TR_I0) { const int m = r / 384, q = r % 384, kb = q / 24, nb = q % 24;
        d.src = a.in[I_WQKV] + (size_t)m * 1024 * 1536 + (size_t)kb * 64 * 1536 + nb * 64; d.N = 1536; d.drow0 = (nb >> 2) * 256 + (nb & 3) * 32; d.hi_skip = 96;
        d.fp8 = ATT_FP8; d.dKb = ATT_FP8 ? 1024 : 2048; d.dst = (unsigned char*)(a.ws + WS_WQKV) + (size_t)m * 1536 * d.dKb + (size_t)kb * 64 * (ATT_FP8 ? 1 : 2); return d; }
    r -= TR_I0;
    if (r < TR_I1) { const int m = r / 256, q = r % 256, kb = q / 16, nb = q % 16;
        d.src = a.in[I_WO] + (size_t)m * 1024 * 1024 + (size_t)kb * 64 * 1024 + nb * 64; d.N = 1024; d.drow0 = nb * 64;
        d.fp8 = ATT_FP8; d.dKb = ATT_FP8 ? 1024 : 2048; d.dst = (unsigned char*)(a.ws + WS_WO) + (size_t)m * 1024 * d.dKb + (size_t)kb * 64 * (ATT_FP8 ? 1 : 2); return d; }
    r -= TR_I1;
    d.fp8 = 0;
    if (r < TR_I2) { const int m = r / 16, q = r % 16, kb = q / 4, nb = q % 4;
        d.src = a.in[I_POOLW] + (size_t)m * 256 * 256 + (size_t)kb * 64 * 256 + nb * 64; d.N = 256; d.drow0 = nb * 64; d.dKb = 512; d.dst = (unsigned char*)(a.ws + WS_WPOOL) + (size_t)m * 256 * 512 + (size_t)kb * 128; return d; }
    r -= TR_I2;
    if (r < TR_I3) { const int kb = r / 81, nb = r % 81;
        d.src = a.in[I_WIN] + (size_t)kb * 64 * 5184 + nb * 64; d.N = 5184; d.drow0 = nb * 64; d.dKb = 2048; d.dst = (unsigned char*)(a.ws + WS_WIN) + (size_t)kb * 128; return d; }
    r -= TR_I3;
    { const int kb = r / 16, nb = r % 16;
        d.src = a.in[I_WOUT] + (size_t)kb * 64 * 1024 + nb * 64; d.N = 1024; d.drow0 = nb * 64; d.dKb = 4096; d.dst = (unsigned char*)(a.ws + WS_WOUT) + (size_t)kb * 128; return d; }
}
__device__ __forceinline__ void p0_prologue(const Args& a, const Ctx& c) {
    LAS float* scr = (LAS float*)(c.lds + c.wave * 16896);
    const int gw = c.vcu * NWAVES + c.wave, NGW = c.G * NWAVES;
    { f32x4 va[16], vb[16]; TrD da, db; int it = gw;
      da = tr_decode(a, it < TR_ITOT ? it : TR_ITOT - 1); tr_load(da, va, c.lane);
      while (it < TR_ITOT) {
          const int itB = it + NGW; db = tr_decode(a, itB < TR_ITOT ? itB : TR_ITOT - 1); tr_load(db, vb, c.lane);
          tr_store(da, va, scr, c.lane);
          if (itB >= TR_ITOT) break;
          const int itA = itB + NGW; da = tr_decode(a, itA < TR_ITOT ? itA : TR_ITOT - 1); tr_load(da, va, c.lane);
          tr_store(db, vb, scr, c.lane);
          it = itA; } }
    __syncthreads();
    LAS float* sv = (LAS float*)c.lds;
    LAS float* part = (LAS float*)(c.lds + 20480);
    for (int u = c.tid; u < 5 * 1024; u += NTHREADS) { const int v = u >> 10, k = u & 1023; const float x = v < 4 ? a.in[I_C][v * 1024 + k] : a.in[I_CCTX][k]; sv[u] = x / (1.0f + expf(-x)); }
    __syncthreads();
    for (int item = blockIdx.x; item < 4 * 64; item += c.G) {
        const int li = item >> 6, c0 = (item & 63) * 96, cq = c.tid % 24, ks = c.tid / 24;
        f32x4 acc[5];
#pragma unroll
        for (int v = 0; v < 5; ++v) acc[v] = (f32x4){0.f, 0.f, 0.f, 0.f};
        if (ks < 21) { const int kbeg = ks * 49, kend = (kbeg + 49) < 1024 ? (kbeg + 49) : 1024;
            const float* w = a.in[I_WADA] + ((size_t)li * 1024 + kbeg) * 6144 + c0 + 4 * cq;
#pragma unroll 7
            for (int k = kbeg; k < kend; ++k) { const f32x4 wv = *(const f32x4*)w; w += 6144;
#pragma unroll
                for (int v = 0; v < 5; ++v) acc[v] += wv * sv[v * 1024 + k]; }
#pragma unroll
            for (int v = 0; v < 5; ++v) *(LAS f32x4*)(part + (ks * 24 + cq) * 20 + v * 4) = acc[v]; }
        __syncthreads();
        if (c.tid < 480) { const int v = c.tid / 96, col = c.tid % 96, q = col >> 2, e = col & 3; float s = 0.f;
            for (int k2 = 0; k2 < 21; ++k2) s += part[(k2 * 24 + q) * 20 + v * 4 + e];
            s += a.in[I_BADA][li * 6144 + c0 + col];
            if (v < 4) ((float*)(a.ws + WS_MODL))[(size_t)(li * 4 + v) * 6144 + c0 + col] = s; else ((float*)(a.ws + WS_MODC))[(size_t)li * 6144 + c0 + col] = s; }
        __syncthreads();
    }
    if (blockIdx.x == (unsigned)(c.G - 1)) for (int u = c.tid; u < 1024; u += NTHREADS) { const int pos = u >> 4, f = u & 15;
        const float inv = (float)pow(10000.0, -(double)f / 16.0); const double ang = (double)((float)pos * inv);
        ((f32x2*)(a.ws + WS_ROPE))[u] = (f32x2){(float)cos(ang), (float)sin(ang)}; }
    for (int u = blockIdx.x * NTHREADS + c.tid; u < 4 * 64 * 1024; u += c.G * NTHREADS) { const int li = u >> 16, n = (u >> 10) & 63, k = u & 1023;
        float w = 0.f; if (n < 4) w = a.in[I_WRG][((size_t)li * 1024 + k) * 4 + n]; else if (n < 36) w = a.in[I_WRE][((size_t)li * 1024 + k) * 32 + (n - 4)];
        const unsigned hi = cvtpk(w, 0.f) & 0xffffu; const float rem = w - bflo(hi); const unsigned lo = cvtpk(rem, 0.f) & 0xffffu;
        bf16* wr = (bf16*)(a.ws + WS_WR) + (size_t)li * 2 * 65536; wr[n * 1024 + k] = (bf16)hi; wr[65536 + n * 1024 + k] = (bf16)lo; }
}

__device__ __forceinline__ void ph_rmix(const Args& a, const Ctx& c, int layer) {
    const int gw = c.vcu * NWAVES + c.wave, NGW = c.G * NWAVES;
    const float* g = a.in[I_NMIX] + layer * D;
    for (int r = gw; r < TT; r += NGW) {
        f32x4 v[4], h[4]; load_row_combined(a, layer, r, c.lane, v);
        if (layer > 0) { u32x2* xo = (u32x2*)((bf16*)(a.ws + WS_X) + (size_t)r * D) + c.lane;
#pragma unroll
            for (int j = 0; j < 4; ++j) xo[64 * j] = (u32x2){cvtpk(v[j].x, v[j].y), cvtpk(v[j].z, v[j].w)}; }
        const float rstd = row_rstd(v); const float* m = mod_row(a, layer, r);
        norm_mod(v, rstd, g, m, m + D, c.lane, h);
        if (ATT_FP8 && layer != 2) { unsigned* ho8 = (unsigned*)((unsigned char*)(a.ws + WS_HB) + (size_t)r * D) + c.lane;
#pragma unroll
            for (int j = 0; j < 4; ++j) ho8[64 * j] = pk_fp8x4(h[j].x, h[j].y, h[j].z, h[j].w); }
        else { u32x2* ho = (u32x2*)((bf16*)(a.ws + WS_HB) + (size_t)r * D) + c.lane;
#pragma unroll
            for (int j = 0; j < 4; ++j) ho[64 * j] = (u32x2){cvtpk(h[j].x, h[j].y), cvtpk(h[j].z, h[j].w)}; }
    }
}

__device__ __forceinline__ void ph_final(const Args& a, const Ctx& c, int layer) {
    const int gw = c.vcu * NWAVES + c.wave, NGW = c.G * NWAVES;
    float dscale = 1.f, dmark = 0.f;
#if DEBUG_CHECKS
    { unsigned* dbg = (unsigned*)(a.ws + WS_CTL) + CW_DBG; int code = 0; float mag = 0.f;
      for (int id = 1; id < 32; ++id) { const float e = __uint_as_float(__hip_atomic_load(dbg + id, __ATOMIC_RELAXED, __HIP_MEMORY_SCOPE_AGENT)); if (code == 0 && e > DBG_TOL) { code = id; mag = e; } }
      dscale = 1.f + (float)code; dmark = code ? 100.f * (1.f + fminf(fmaxf(log2f(mag / DBG_TOL), 0.f), 30.f)) : 0.f; }
#endif
    for (int r = gw; r < TL; r += NGW) {
        f32x4 v[4]; load_row_combined(a, layer, r, c.lane, v);
        const float rstd = row_rstd(v) * dscale;
        f32x4* o = (f32x4*)(a.out + (size_t)r * D) + c.lane;
#pragma unroll
        for (int j = 0; j < 4; ++j) { f32x4 ov = (v[j] * rstd) * ((const f32x4*)a.in[I_NFIN])[c.lane + 64 * j]; if (j == 0 && r == 0 && c.lane == 0 && dmark > 0.f) ov.x = dmark; o[64 * j] = ov; }
    }
}


namespace pg8 {
constexpr int BM = 256, BK = 64, HALF = 128, HTB = HALF * BK * 2, STAGE_BYTES = 8 * HTB;
__host__ __device__ __forceinline__ int lds_byte(int r, int c) { const int st = (r >> 4) * 2 + (c >> 5), rr = r & 15, cc = c & 31, ob = rr * 64 + cc * 2; return st * 1024 + (ob ^ (((ob >> 9) & 1) << 5)); }
__host__ __device__ __forceinline__ void stage_rc(int b, int& R, int& C) { const int st = b / 1024, sb = b % 1024, swz = sb ^ (((sb >> 9) & 1) << 5); R = (st >> 1) * 16 + swz / 64; C = (st & 1) * 32 + (swz % 64) / 2; }
__host__ __device__ __forceinline__ int perm32(int rho) { const int n = rho >> 4, i = rho & 15; return 8 * (i >> 2) + 4 * n + (i & 3); }
struct Unit { const char* A; const char* B; int pm, pn, x0, x1; };
__device__ __forceinline__ void tile_of(int L, int nM, int nN, int& pm, int& pn) {
    const int nwg = nM * nN; int wgid = L; { const int q = nwg / 8, r = nwg % 8, xcd = wgid % 8, off = wgid / 8; wgid = (xcd < r ? xcd * (q + 1) : r * (q + 1) + (xcd - r) * q) + off; }
    const int nig = 8 * nN, gid = wgid / nig, fm = gid * 8, gsz = (nM - fm) < 8 ? (nM - fm) : 8;
    pm = fm + ((wgid % nig) % gsz); pn = (wgid % nig) / gsz;
}
typedef int v4i_t __attribute__((ext_vector_type(4))); typedef int v8i_t __attribute__((ext_vector_type(8)));
template <class Epi, class Sched, bool GATHER, bool FP8 = false>
__device__ __forceinline__ void gemm_phase(LAS unsigned char* lds, const int Kb, const int ldab, const Sched& S, const Epi& E, const int scw = 127, const int sca = 127) {
    const int tid = tid_opaque(), wid = __builtin_amdgcn_readfirstlane(tid >> 6), lane = tid & 63, wr = wid >> 2, wc = wid & 3, fr = lane & 15, fq = lane >> 4;
    const int nt = Kb / (BK * 2);
    int scw_v = scw, sca_v = sca;
    unsigned voffA[2], voffB[2]; int RA[2], CA[2];
#pragma unroll
    for (int i = 0; i < 2; ++i) { int R, C; stage_rc(tid * 16 + i * 8192, R, C); const int Rb = Epi::PERM ? ((R & ~31) + perm32(R & 31)) : R;
        RA[i] = R; CA[i] = C; voffA[i] = (unsigned)(R * ldab + C * 2); voffB[i] = (unsigned)(Rb * Kb + C * 2); }
    const size_t kstep = (size_t)(BK * 2);
    const size_t hstepA = (size_t)HALF * ldab, hstepB = (size_t)HALF * Kb;
    const unsigned ldsw = (unsigned)wid * 1024u;
    const int aoff = lds_byte(wr * 64 + fr, fq * 8), boff = lds_byte(wc * 32 + fr, fq * 8);
#define PG8_SA(b, h) (((b) * 2 + (h)) * HTB)
#define PG8_SB(b, h) ((4 + (b) * 2 + (h)) * HTB)
#define PG8_GLDS(bufoff, gptr, i_) __builtin_amdgcn_global_load_lds((const unsigned*)(gptr), (LAS unsigned*)(lds + (bufoff) + ldsw + (i_) * 8192), 16, 0, 0)
#define PG8_STAGE_B(bufoff, gbase) do { _Pragma("unroll") for (int _i = 0; _i < 2; ++_i) PG8_GLDS(bufoff, (const char*)(gbase) + voffB[_i], _i); } while (0)
#define PG8_STAGE_A(bufoff, ab, kb, h, NX) do { _Pragma("unroll") for (int _i = 0; _i < 2; ++_i) { \
        if constexpr (GATHER) { const unsigned _vo = (NX) ? voN[h][_i] : voC[h][_i]; PG8_GLDS(bufoff, (ab) + (kb) + _vo, _i); } \
        else { PG8_GLDS(bufoff, (ab) + (kb) + (size_t)(h) * hstepA + voffA[_i], _i); } } } while (0)
#define PG8_LDA(dst, b, h) do { _Pragma("unroll") for (int m = 0; m < 4; ++m) _Pragma("unroll") for (int k = 0; k < 2; ++k) dst[m][k] = *(const LAS bf16x8*)(lds + PG8_SA(b, h) + aoff + m * 2048 + k * 1024); } while (0)
#define PG8_LDB(dst, b, h) do { _Pragma("unroll") for (int n = 0; n < 2; ++n) _Pragma("unroll") for (int k = 0; k < 2; ++k) dst[n][k] = *(const LAS bf16x8*)(lds + PG8_SB(b, h) + boff + n * 2048 + k * 1024); } while (0)
#define PG8_MMA(ai, bj, At, Bt) do { __builtin_amdgcn_s_setprio(1); _Pragma("unroll") for (int m = 0; m < 4; ++m) _Pragma("unroll") for (int n = 0; n < 2; ++n) { \
        if constexpr (FP8) { const v8i_t b8 = __builtin_shufflevector(__builtin_bit_cast(v4i_t, Bt[n][0]), __builtin_bit_cast(v4i_t, Bt[n][1]), 0, 1, 2, 3, 4, 5, 6, 7), a8 = __builtin_shufflevector(__builtin_bit_cast(v4i_t, At[m][0]), __builtin_bit_cast(v4i_t, At[m][1]), 0, 1, 2, 3, 4, 5, 6, 7); \
            asm volatile("v_mfma_scale_f32_16x16x128_f8f6f4 %0, %1, %2, %0, %3, %4 op_sel_hi:[0,0,0]" : "+v"(acc[ai][bj][m][n]) : "v"(b8), "v"(a8), "v"(scw_v), "v"(sca_v)); } \
        else { _Pragma("unroll") for (int k = 0; k < 2; ++k) acc[ai][bj][m][n] = __builtin_amdgcn_mfma_f32_16x16x32_bf16(Bt[n][k], At[m][k], acc[ai][bj][m][n], 0, 0, 0); } } __builtin_amdgcn_s_setprio(0); } while (0)
#define PG8_WAIT_V(n) asm volatile("s_waitcnt vmcnt(" #n ")" ::: "memory")
#define PG8_WAIT_L(n) asm volatile("s_waitcnt lgkmcnt(" #n ")" ::: "memory")
#define PG8_BAR __builtin_amdgcn_s_barrier()
#define PG8_SCHED __builtin_amdgcn_sched_barrier(0)
    Unit cur, nxt, pend; int ui = 0; bool have_pend = false;
    if (!S.next(0, cur)) return;
    pend = cur;
    unsigned voC[2][2], voN[2][2];
    if constexpr (GATHER) {
#pragma unroll
        for (int h = 0; h < 2; ++h)
#pragma unroll
            for (int i = 0; i < 2; ++i) { voC[h][i] = (unsigned)(S.gather(cur, h * HALF + RA[i]) * ldab + CA[i] * 2); voN[h][i] = voC[h][i]; }
    } else { voC[0][0] = voN[0][0] = 0u; }
    f32x4 acc[2][2][4][2];
#pragma unroll
    for (int a = 0; a < 2; ++a)
#pragma unroll
        for (int b = 0; b < 2; ++b)
#pragma unroll
            for (int m = 0; m < 4; ++m)
#pragma unroll
                for (int n = 0; n < 2; ++n) acc[a][b][m][n] = (f32x4){0.f, 0.f, 0.f, 0.f};
    bf16x8 At[4][2], B0[2][2], B1[2][2];
    const char* cA = cur.A; const char* cB = cur.B;
    S.a_ready(cur, wid);
    PG8_STAGE_B(PG8_SB(0, 0), cB); PG8_STAGE_B(PG8_SB(0, 1), cB + hstepB); PG8_STAGE_A(PG8_SA(0, 0), cA, (size_t)0, 0, false); PG8_STAGE_A(PG8_SA(0, 1), cA, (size_t)0, 1, false);
    if (wr == 1) PG8_BAR;
    PG8_WAIT_V(2); PG8_BAR;
    PG8_STAGE_B(PG8_SB(1, 0), cB + kstep); PG8_STAGE_A(PG8_SA(1, 0), cA, kstep, 0, false); PG8_STAGE_B(PG8_SB(1, 1), cB + hstepB + kstep);
    PG8_WAIT_V(6); PG8_BAR;
    for (;;) {
        const bool has_next = S.next(ui + 1, nxt);
        if constexpr (GATHER) { if (has_next) {
#pragma unroll
            for (int h = 0; h < 2; ++h)
#pragma unroll
                for (int i = 0; i < 2; ++i) voN[h][i] = (unsigned)(S.gather(nxt, h * HALF + RA[i]) * ldab + CA[i] * 2); } }
        const char* nA = has_next ? nxt.A : cA; const char* nB = has_next ? nxt.B : cB;
        for (int t = 0; t < nt; t += 2) {
            const bool last = (t == nt - 2);
            const size_t k1 = (size_t)(t + 1) * kstep;
            const char* a2 = last ? nA : cA; const size_t k2 = last ? (size_t)0 : (size_t)(t + 2) * kstep; const size_t k3 = k2 + kstep;
            const char* b2 = last ? nB : cB + (size_t)(t + 2) * kstep; const char* b3 = b2 + kstep;
            const bool nx = GATHER ? (last && has_next) : false;
            if (last && has_next) S.a_ready(nxt, wid);
            PG8_LDB(B0, 0, 0); PG8_LDB(B1, 0, 1); PG8_SCHED; PG8_LDA(At, 0, 0); PG8_STAGE_A(PG8_SA(1, 1), cA, k1, 1, false);
            PG8_WAIT_V(8); PG8_WAIT_L(0); PG8_BAR; PG8_MMA(0, 0, At, B0); PG8_MMA(0, 1, At, B1); PG8_BAR; PG8_SCHED;
            PG8_LDA(At, 0, 1); PG8_STAGE_B(PG8_SB(0, 0), b2); PG8_STAGE_B(PG8_SB(0, 1), b2 + hstepB); PG8_STAGE_A(PG8_SA(0, 0), a2, k2, 0, nx);
            PG8_WAIT_V(8); PG8_WAIT_L(0);
            if constexpr (!Sched::IMM_DONE) { if (have_pend) { S.done(pend, lane); have_pend = false; } }
            PG8_BAR; PG8_MMA(1, 0, At, B0); PG8_MMA(1, 1, At, B1); PG8_BAR; PG8_SCHED;
            PG8_LDB(B0, 1, 0); PG8_LDB(B1, 1, 1); PG8_SCHED; PG8_LDA(At, 1, 0); PG8_STAGE_A(PG8_SA(0, 1), a2, k2, 1, nx);
            PG8_WAIT_V(8); PG8_WAIT_L(0); PG8_BAR; PG8_MMA(0, 0, At, B0); PG8_MMA(0, 1, At, B1); PG8_BAR; PG8_SCHED;
            PG8_LDA(At, 1, 1); PG8_STAGE_B(PG8_SB(1, 0), b3); PG8_STAGE_B(PG8_SB(1, 1), b3 + hstepB); PG8_STAGE_A(PG8_SA(1, 0), a2, k3, 0, nx);
            PG8_WAIT_V(8); PG8_WAIT_L(0); PG8_BAR; PG8_MMA(1, 0, At, B0); PG8_MMA(1, 1, At, B1); PG8_BAR; PG8_SCHED;
        }
        if (wr == 0) PG8_BAR;
        if constexpr (FP8) asm volatile("s_nop 15\n\ts_nop 15" ::: "memory");
        E(acc, cur, wr, wc, fr, fq);
        if constexpr (Sched::IMM_DONE) { PG8_WAIT_V(0); S.done(cur, lane); }
        else { pend = cur; have_pend = true; }
        if (!has_next) break;
#pragma unroll
        for (int a = 0; a < 2; ++a)
#pragma unroll
            for (int b = 0; b < 2; ++b)
#pragma unroll
                for (int m = 0; m < 4; ++m)
#pragma unroll
                    for (int n = 0; n < 2; ++n) acc[a][b][m][n] = (f32x4){0.f, 0.f, 0.f, 0.f};
        cur = nxt; cA = nA; cB = nB; ++ui;
        if constexpr (GATHER) {
#pragma unroll
            for (int h = 0; h < 2; ++h)
#pragma unroll
                for (int i = 0; i < 2; ++i) voC[h][i] = voN[h][i]; }
        if (wr == 1) PG8_BAR;
    }
    PG8_WAIT_V(0);
    if constexpr (!Sched::IMM_DONE) { if (have_pend) S.done(pend, lane); }
    PG8_BAR;
#undef PG8_SA
#undef PG8_SB
#undef PG8_GLDS
#undef PG8_STAGE_A
#undef PG8_STAGE_B
#undef PG8_LDA
#undef PG8_LDB
#undef PG8_MMA
#undef PG8_WAIT_V
#undef PG8_WAIT_L
#undef PG8_BAR
#undef PG8_SCHED
}
}
#include <hip/hip_bf16.h>
#include <cmath>
namespace attn_body {
using bf16=__hip_bfloat16;
using bf16x8=__attribute__((ext_vector_type(8)))short;
using s16x4=__attribute__((ext_vector_type(4)))short;
using f32x16=__attribute__((ext_vector_type(16)))float;
using u32x4=__attribute__((ext_vector_type(4)))unsigned;
constexpr int D=64,QP=1024,KVP=256;
constexpr int NW=8,QBLK=32,QB=QBLK*NW,KVBLK=64;
__device__ __forceinline__ int crow(int r,int hi){return (r&3)+8*(r>>2)+4*hi;}
#define SBAR() __builtin_amdgcn_sched_barrier(0)
constexpr int NSLOT=3, SLOTB=8192;
constexpr int LDS_K=0, LDS_V=NSLOT*SLOTB, LDS_WS=2*NSLOT*SLOTB, LDS_OST=LDS_WS+NW*64*4, LDS_BYTES=LDS_OST+NW*4096;
constexpr float C2=0.125f*1.4426950408889634f;
__device__ __forceinline__ void glds16s(const void*sbase,unsigned voff,unsigned lds_dst){unsigned keep;
  asm volatile("s_mov_b32 %0, m0\n\ts_mov_b32 m0, %3\n\ts_nop 4\n\tglobal_load_lds_dwordx4 %1, %2\n\ts_mov_b32 m0, %0":"=&s"(keep):"v"(voff),"s"(sbase),"s"(lds_dst):"memory");}
__device__ __forceinline__ float max3f(float a,float b,float c){float r;asm("v_max3_f32 %0, %1, %2, %3":"=v"(r):"v"(a),"v"(b),"v"(c));return r;}
__device__ __forceinline__ float max2f(float a,float b){float r;asm("v_max_f32_e32 %0, %1, %2":"=v"(r):"v"(a),"v"(b));return r;}
__device__ __forceinline__ float fadd_s(float a,float b){float r;asm("v_add_f32_e32 %0, %1, %2":"=v"(r):"v"(a),"v"(b));return r;}
__device__ __forceinline__ float fsub_s(float a,float b){float r;asm("v_sub_f32_e32 %0, %1, %2":"=v"(r):"v"(a),"v"(b));return r;}
typedef float f32x2_t __attribute__((ext_vector_type(2))); typedef __bf16 bf16x2_t __attribute__((ext_vector_type(2)));
__device__ __forceinline__ unsigned cvtpk_s(float lo,float hi){f32x2_t v={lo,hi};bf16x2_t b=__builtin_convertvector(v,bf16x2_t);return __builtin_bit_cast(unsigned,b);}
#define WAIT_BAR(N) asm volatile("s_waitcnt vmcnt(" #N ") lgkmcnt(0)\n\ts_barrier":::"memory")

__device__ __forceinline__ void qkt(f32x16&p0,f32x16&p1,const char*Kslot,const bf16x8*qr,const f32x16&negm,int r32,int hi){
  const char*kb=Kslot+hi*1024+r32*16;
  #pragma unroll
  for(int d0=0;d0<4;++d0){
    const bf16x8 b0=*reinterpret_cast<const bf16x8*>(kb+d0*2048);
    const bf16x8 b1=*reinterpret_cast<const bf16x8*>(kb+d0*2048+512);
    if(d0==0){p0=__builtin_amdgcn_mfma_f32_32x32x16_bf16(b0,qr[0],negm,0,0,0);p1=__builtin_amdgcn_mfma_f32_32x32x16_bf16(b1,qr[0],negm,0,0,0);}
    else{p0=__builtin_amdgcn_mfma_f32_32x32x16_bf16(b0,qr[d0],p0,0,0,0);p1=__builtin_amdgcn_mfma_f32_32x32x16_bf16(b1,qr[d0],p1,0,0,0);}}
}
typedef __attribute__((address_space(3))) const char* lds_cptr;
typedef short v4i16_t __attribute__((ext_vector_type(4)));
__device__ __forceinline__ void kload8(bf16x8*kf,lds_cptr kp){
  kf[0]=*(const __attribute__((address_space(3))) bf16x8*)(kp);      kf[1]=*(const __attribute__((address_space(3))) bf16x8*)(kp+512);
  kf[2]=*(const __attribute__((address_space(3))) bf16x8*)(kp+2048); kf[3]=*(const __attribute__((address_space(3))) bf16x8*)(kp+2560);
  kf[4]=*(const __attribute__((address_space(3))) bf16x8*)(kp+4096); kf[5]=*(const __attribute__((address_space(3))) bf16x8*)(kp+4608);
  kf[6]=*(const __attribute__((address_space(3))) bf16x8*)(kp+6144); kf[7]=*(const __attribute__((address_space(3))) bf16x8*)(kp+6656);
}
__device__ __forceinline__ void kload2(bf16x8*kf,lds_cptr kp,int j){ kf[2*j]=*(const __attribute__((address_space(3))) bf16x8*)(kp+j*2048); kf[2*j+1]=*(const __attribute__((address_space(3))) bf16x8*)(kp+j*2048+512); }
__device__ __forceinline__ s16x4 vtr(lds_cptr p){ return __builtin_bit_cast(s16x4,__builtin_amdgcn_ds_read_tr16_b64_v4i16((__attribute__((address_space(3))) v4i16_t*)p)); }
__device__ __forceinline__ float rowmax(const f32x16&p0,const f32x16&p1){
  float a=max3f(p0[0],p0[1],p1[0]),b=max3f(p0[2],p0[3],p1[1]);a=max3f(a,p1[2],p1[3]);
  #pragma unroll
  for(int r=4;r<16;r+=4){a=max3f(a,p0[r],p0[r+1]);b=max3f(b,p0[r+2],p0[r+3]);a=max3f(a,p1[r],p1[r+1]);b=max3f(b,p1[r+2],p1[r+3]);}
  const float m=max2f(a,b);
  auto rr=__builtin_amdgcn_permlane32_swap(__float_as_uint(m),__float_as_uint(m),false,false);
  return max2f(__uint_as_float(rr[0]),__uint_as_float(rr[1]));
}
__device__ __forceinline__ void pv(f32x16*o,int vb,bf16x8 pa0,bf16x8 pa1,bf16x8 pa2,bf16x8 pa3){
  #pragma unroll
  for(int d0=0;d0<2;++d0){s16x4 lo[4],hi[4];
    #pragma unroll
    for(int ks=0;ks<4;++ks){
      asm volatile("ds_read_b64_tr_b16 %0,%1 offset:%c2":"=&v"(lo[ks]):"v"(vb),"i"(d0*4096+ks*1024):"memory");
      asm volatile("ds_read_b64_tr_b16 %0,%1 offset:%c2":"=&v"(hi[ks]):"v"(vb),"i"(d0*4096+ks*1024+512):"memory");}
    asm volatile("s_waitcnt lgkmcnt(0)":::"memory");SBAR();
    #define PK(k) (bf16x8){lo[k][0],lo[k][1],lo[k][2],lo[k][3],hi[k][0],hi[k][1],hi[k][2],hi[k][3]}
    o[d0]=__builtin_amdgcn_mfma_f32_32x32x16_bf16(pa0,PK(0),o[d0],0,0,0);
    o[d0]=__builtin_amdgcn_mfma_f32_32x32x16_bf16(pa1,PK(1),o[d0],0,0,0);
    o[d0]=__builtin_amdgcn_mfma_f32_32x32x16_bf16(pa2,PK(2),o[d0],0,0,0);
    o[d0]=__builtin_amdgcn_mfma_f32_32x32x16_bf16(pa3,PK(3),o[d0],0,0,0);
    #undef PK
  }
}

#ifndef ATTN_STORE16
#define ATTN_STORE16(p,v) (*(u32x4*)(p)=(v))
#endif
template<int THRL> __device__ __forceinline__ void attn_unit(long qrow0,int h,long kvrow0,int NT,const bf16*Q,const bf16*__restrict__ K,const bf16*__restrict__ V,bf16*O,char*shm){
  const int tid=tid_opaque(),lane=tid&63,r32=lane&31,hi=lane>>5; const int wid=__builtin_amdgcn_readfirstlane(tid>>6);
  const bf16*Qw=Q+(qrow0+wid*QBLK)*QP+h*D;
  const bf16*Kh=K+kvrow0*KVP+(h>>2)*D,*Vh=V+kvrow0*KVP+(h>>2)*D;
  const unsigned lds0=(unsigned)(uintptr_t)shm;
  float*wsf=(float*)(shm+LDS_WS)+wid*64;
  const unsigned kvo=(unsigned)(lane*KVP+wid*8)*2u;
  const unsigned vvo=(unsigned)((16*(wid&3)+(lane>>2))*KVP+(wid>>2)*32+(lane&3)*8)*2u;
  const unsigned kdst=lds0+LDS_K+wid*1024, vdst=lds0+LDS_V+wid*1024;
  #define DMA_K(t,slot) glds16s(Kh+(long)(t)*KVBLK*KVP,kvo,(unsigned)__builtin_amdgcn_readfirstlane(kdst+(slot)))
  #define DMA_V(t,slot) glds16s(Vh+(long)(t)*KVBLK*KVP,vvo,(unsigned)__builtin_amdgcn_readfirstlane(vdst+(slot)))
  const int vb0=(int)(lds0+LDS_V)+((lane>>4)&1)*32+(lane&3)*8+(4*hi+((lane&15)>>2))*64;
  const char*Kbase=shm+LDS_K; bf16x8 kf[8];
  const lds_cptr shm3=(lds_cptr)shm; const lds_cptr kp0=shm3+LDS_K+hi*1024+r32*16; const lds_cptr vp0=shm3+LDS_V+((lane>>4)&1)*32+(lane&3)*8+(4*hi+((lane&15)>>2))*64;
  DMA_K(0,0);DMA_V(0,0);DMA_K(1,SLOTB);
  bf16x8 qr[4];
  #pragma unroll
  for(int d0=0;d0<4;++d0)qr[d0]=*reinterpret_cast<const bf16x8*>(&Qw[(long)r32*QP+d0*16+hi*8]);
  float mhat=0.f,l_reg=0.f;f32x16 o[2];o[0]=f32x16{};o[1]=f32x16{};f32x16 negm=f32x16{};asm volatile("":"+v"(negm));
  #define CMASK(P0,P1,t) do{}while(0)
  bool resc=false;
  #define START(P0,P1) do{ const float rm=rowmax(P0,P1); resc=false; \
    { const float dl=rm; mhat=fadd_s(mhat,dl); \
      _Pragma("unroll") for(int r=0;r<16;++r){P0[r]=fsub_s(P0[r],dl);P1[r]=fsub_s(P1[r],dl);} \
      _Pragma("unroll") for(int r=0;r<16;++r)negm[r]=-mhat; asm volatile("":"+v"(negm)); } \
    _Pragma("unroll") for(int r=0;r<16;++r)P0[r]=__builtin_amdgcn_exp2f(P0[r]); }while(0)
  #define RESC() do{ if(resc){ asm volatile("s_waitcnt lgkmcnt(0)":::"memory"); \
      _Pragma("unroll") for(int d_=0;d_<2;++d_) _Pragma("unroll") for(int r=0;r<16;++r)o[d_][r]*=wsf[crow(r,hi)]; } }while(0)
  f32x16 pA0,pA1,pB0,pB1;
  int sl_prev=0,sl_cur=0,sl_next=SLOTB;
  #define ROT() do{sl_prev=sl_cur;sl_cur=sl_next;sl_next=(sl_next==(NSLOT-1)*SLOTB)?0:sl_next+SLOTB;}while(0)
  DMA_K(2,2*SLOTB);
  WAIT_BAR(3);
  qkt(pA0,pA1,Kbase,qr,negm,r32,hi);asm volatile("s_nop 15\n\ts_nop 7":"+v"(pA0),"+v"(pA1));CMASK(pA0,pA1,0);
  START(pA0,pA1);
  _Pragma("unroll") for(int r=0;r<16;++r)pA1[r]=__builtin_amdgcn_exp2f(pA1[r]);
  WAIT_BAR(0);
  DMA_K(3,0);DMA_V(1,SLOTB);
  ROT();
  kload8(kf,kp0+sl_cur);
  WAIT_BAR(2);
  s16x4 vlo[8],vhi[8]; u32x4 pw0,pw1,pw2,pw3;
  #define PKW(P,B) cvtpk_s(P[B],P[B+1])
  #define PAF(k) __builtin_bit_cast(bf16x8,pw##k)
  #define VFR(i) (bf16x8){vlo[i][0],vlo[i][1],vlo[i][2],vlo[i][3],vhi[i][0],vhi[i][1],vhi[i][2],vhi[i][3]}
  #define PIN(x) asm volatile("":"+v"(x))
  #define MX3(a,b,c) __builtin_fmaxf(__builtin_fmaxf((a),(b)),(c))
  #define GAPA(MF,A0,A1,A2,A3,W0,W1,PW) do{ MF; sacc+=A0; sacc+=A1; sacc+=A2; sacc+=A3; PIN(sacc); W0; W1; PIN(PW); SBAR(); }while(0)
  #define EX(v) __builtin_amdgcn_exp2f(v)
  #define GAPB(MF,X,B) do{ MF; X[B]=EX(X[B]); X[B+1]=EX(X[B+1]); X[B+2]=EX(X[B+2]); X[B+3]=EX(X[B+3]); PIN(X); SBAR(); }while(0)
  #define VRD(i) do{ vlo[i]=vtr(vp_+(((i)>>2)*4096+((i)&3)*1024)); vhi[i]=vtr(vp_+(((i)>>2)*4096+((i)&3)*1024+512)); }while(0)
  #define KRD(G,j) do{ if(G){ kload2(kf,kp0+sl_next,j); SBAR(); } }while(0)
  #define STEP(C0,C1,P0,P1,t,GK,GV,GL) do{ SBAR(); \
    const lds_cptr vp_=vp0+sl_prev; \
    VRD(0); SBAR(); float sacc=(P0[0]+P0[1]); \
    GAPA(C0=__builtin_amdgcn_mfma_f32_32x32x16_bf16(kf[0],qr[0],negm,0,0,0), P0[2],P0[3],P0[4],P0[5],     pw0[0]=PKW(P0,0), pw0[1]=PKW(P0,2), pw0); \
    VRD(4); SBAR(); GAPA(C1=__builtin_amdgcn_mfma_f32_32x32x16_bf16(kf[1],qr[0],negm,0,0,0), P0[6],P0[7],P0[8],P0[9],     pw0[2]=PKW(P0,4), pw0[3]=PKW(P0,6), pw0); \
    VRD(1); SBAR(); GAPA(C0=__builtin_amdgcn_mfma_f32_32x32x16_bf16(kf[2],qr[1],C0,0,0,0),   P0[10],P0[11],P0[12],P0[13], pw1[0]=PKW(P0,8), pw1[1]=PKW(P0,10), pw1); \
    VRD(5); SBAR(); GAPA(C1=__builtin_amdgcn_mfma_f32_32x32x16_bf16(kf[3],qr[1],C1,0,0,0),   P0[14],P0[15],P1[0],P1[1],   pw1[2]=PKW(P0,12),pw1[3]=PKW(P0,14), pw1); \
    VRD(2); SBAR(); GAPA(C0=__builtin_amdgcn_mfma_f32_32x32x16_bf16(kf[4],qr[2],C0,0,0,0),   P1[2],P1[3],P1[4],P1[5],     pw2[0]=PKW(P1,0), pw2[1]=PKW(P1,2), pw2); \
    VRD(6); SBAR(); GAPA(C1=__builtin_amdgcn_mfma_f32_32x32x16_bf16(kf[5],qr[2],C1,0,0,0),   P1[6],P1[7],P1[8],P1[9],     pw2[2]=PKW(P1,4), pw2[3]=PKW(P1,6), pw2); \
    VRD(3); SBAR(); GAPA(C0=__builtin_amdgcn_mfma_f32_32x32x16_bf16(kf[6],qr[3],C0,0,0,0),   P1[10],P1[11],P1[12],P1[13], pw3[0]=PKW(P1,8), pw3[1]=PKW(P1,10), pw3); \
    VRD(7); SBAR(); GAPA(C1=__builtin_amdgcn_mfma_f32_32x32x16_bf16(kf[7],qr[3],C1,0,0,0),   P1[14],P1[15],0.f,0.f,       pw3[2]=PKW(P1,12),pw3[3]=PKW(P1,14), pw3); \
    l_reg+=sacc; \
    if(GK){DMA_K((t)+3,sl_cur);} if(GV){DMA_V((t)+1,sl_next);} \
    CMASK(C0,C1,t); \
    { float a=MX3(C0[0],C0[1],C1[0]),b=MX3(C0[2],C0[3],C1[1]); a=MX3(a,C1[2],C1[3]); \
      _Pragma("unroll") for(int r=4;r<16;r+=4){a=MX3(a,C0[r],C0[r+1]);b=MX3(b,C0[r+2],C0[r+3]);a=MX3(a,C1[r],C1[r+1]);b=MX3(b,C1[r+2],C1[r+3]);} \
      float rm=__builtin_fmaxf(a,b); { auto rr=__builtin_amdgcn_permlane32_swap(__float_as_uint(rm),__float_as_uint(rm),false,false); rm=__builtin_fmaxf(__uint_as_float(rr[0]),__uint_as_float(rr[1])); } \
      resc=false; \
      if(__builtin_expect(__any(rm>(float)THRL),0)){ const float dl=__builtin_fmaxf(rm,0.f); mhat+=dl; \
        _Pragma("unroll") for(int r=0;r<16;++r){C0[r]-=dl;C1[r]-=dl;} \
        _Pragma("unroll") for(int r=0;r<16;++r)negm[r]=-mhat; asm volatile("":"+v"(negm)); \
        const float f=__builtin_amdgcn_exp2f(-dl); l_reg*=f; if(hi==0)wsf[r32]=f; resc=true; } } \
    SBAR(); \
    GAPB(o[0]=__builtin_amdgcn_mfma_f32_32x32x16_bf16(PAF(0),VFR(0),o[0],0,0,0), C0,0); \
    GAPB(o[1]=__builtin_amdgcn_mfma_f32_32x32x16_bf16(PAF(0),VFR(4),o[1],0,0,0), C0,4); \
    KRD(GL,0); GAPB(o[0]=__builtin_amdgcn_mfma_f32_32x32x16_bf16(PAF(1),VFR(1),o[0],0,0,0), C0,8); \
    KRD(GL,1); GAPB(o[1]=__builtin_amdgcn_mfma_f32_32x32x16_bf16(PAF(1),VFR(5),o[1],0,0,0), C0,12); \
    KRD(GL,2); GAPB(o[0]=__builtin_amdgcn_mfma_f32_32x32x16_bf16(PAF(2),VFR(2),o[0],0,0,0), C1,0); \
    KRD(GL,3); GAPB(o[1]=__builtin_amdgcn_mfma_f32_32x32x16_bf16(PAF(2),VFR(6),o[1],0,0,0), C1,4); \
    GAPB(o[0]=__builtin_amdgcn_mfma_f32_32x32x16_bf16(PAF(3),VFR(3),o[0],0,0,0), C1,8); \
    GAPB(o[1]=__builtin_amdgcn_mfma_f32_32x32x16_bf16(PAF(3),VFR(7),o[1],0,0,0), C1,12); \
    }while(0)
  int t=1;
  for(;t+5<NT;t+=2){
    STEP(pB0,pB1,pA0,pA1,t,true,true,true);     WAIT_BAR(2); RESC(); ROT();
    STEP(pA0,pA1,pB0,pB1,t+1,true,true,true);   WAIT_BAR(2); RESC(); ROT();
  }
  #define ENDW(tt) do{ if((tt)+3<NT){WAIT_BAR(2);} else if((tt)+2<NT){WAIT_BAR(1);} else {WAIT_BAR(0);} }while(0)
  for(;t+1<NT;t+=2){
    STEP(pB0,pB1,pA0,pA1,t,(t+3<NT),(t+1<NT),(t+1<NT));       ENDW(t);   RESC(); ROT();
    STEP(pA0,pA1,pB0,pB1,t+1,(t+4<NT),(t+2<NT),(t+2<NT));     ENDW(t+1); RESC(); ROT();
  }
  STEP(pB0,pB1,pA0,pA1,NT-1,false,false,false); RESC();
  { float sacc=pB0[0]+pB0[1]; _Pragma("unroll") for(int r=2;r<16;++r)sacc+=pB0[r]; _Pragma("unroll") for(int r=0;r<16;++r)sacc+=pB1[r]; l_reg+=sacc;
    pw0=(u32x4){PKW(pB0,0),PKW(pB0,2),PKW(pB0,4),PKW(pB0,6)};pw1=(u32x4){PKW(pB0,8),PKW(pB0,10),PKW(pB0,12),PKW(pB0,14)};pw2=(u32x4){PKW(pB1,0),PKW(pB1,2),PKW(pB1,4),PKW(pB1,6)};pw3=(u32x4){PKW(pB1,8),PKW(pB1,10),PKW(pB1,12),PKW(pB1,14)};
    SBAR(); pv(o,vb0+sl_cur,PAF(0),PAF(1),PAF(2),PAF(3)); }
  #undef PKW
  #undef PAF
  #undef VFR
  #undef PIN
  #undef MX3
  #undef GAPA
  #undef GAPB
  #undef EX
  #undef VRD
  #undef KRD
  #undef STEP
  #undef ENDW
  {auto rr=__builtin_amdgcn_permlane32_swap(__float_as_uint(l_reg),__float_as_uint(l_reg),false,false);l_reg=__uint_as_float(rr[0])+__uint_as_float(rr[1]);}
  if(hi==0)wsf[32+r32]=l_reg;asm volatile("s_waitcnt lgkmcnt(0)":::"memory");
  float rli[16];
  #pragma unroll
  for(int r=0;r<16;++r)rli[r]=__builtin_amdgcn_rcpf(wsf[32+crow(r,hi)]);
#if ATT_FP8
  { unsigned char*Ow8=(unsigned char*)O+(qrow0+wid*QBLK)*QP+h*D;
    unsigned char*stg8=(unsigned char*)(shm+LDS_OST)+wid*4096;
    #pragma unroll
    for(int r=0;r<16;++r){const int orow=crow(r,hi);
      #pragma unroll
      for(int d0=0;d0<2;++d0){const float x=o[d0][r]*rli[r]*(float)(1<<ATT_OSH); stg8[orow*64+d0*32+r32]=(unsigned char)(__builtin_amdgcn_cvt_pk_fp8_f32(x,x,0u,false)&0xffu);}}
    asm volatile("s_waitcnt lgkmcnt(0)":::"memory");
    #pragma unroll
    for(int i=0;i<2;++i){const int row=i*16+(lane>>2),ch=lane&3; const u32x4 v=*(const u32x4*)(stg8+row*64+ch*16); ATTN_STORE16(Ow8+(long)row*QP+ch*16,v);} }
#else
  bf16*Ow=O+(qrow0+wid*QBLK)*QP+h*D;
  { bf16*stg=(bf16*)(shm+LDS_OST)+wid*2048;
    #pragma unroll
    for(int r=0;r<16;++r){const int orow=crow(r,hi);
      #pragma unroll
      for(int d0=0;d0<2;++d0)stg[orow*64+d0*32+r32]=__float2bfloat16(o[d0][r]*rli[r]);}
    asm volatile("s_waitcnt lgkmcnt(0)":::"memory");
    #pragma unroll
    for(int i=0;i<4;++i){const int row=i*8+(lane>>3),ch=lane&7; const u32x4 v=*(const u32x4*)(stg+row*64+ch*8); ATTN_STORE16(Ow+(long)row*QP+ch*8,v);} }
#endif
  asm volatile("s_waitcnt lgkmcnt(0)\n\ts_barrier":::"memory");
  #undef DMA_K
  #undef DMA_V
  #undef CMASK
  #undef START
  #undef RESC
  #undef ROT
}
constexpr int ATTN_LDS_BYTES=LDS_BYTES;
#undef SBAR
#undef WAIT_BAR
}

typedef f32x4 AccT[2][2][4][2];
__device__ __forceinline__ long kv_row(int r) { return r < TL ? (long)(r / SEQ) * KVROWS + CTXL + (r % SEQ) : (long)((r - TL) / CTXL) * KVROWS + ((r - TL) % CTXL); }

struct SchedDense {
    static constexpr bool IMM_DONE = false;
    const char* A; const char* B; size_t astep, bstep, acol; int nM, nN, G, c;
    __device__ __forceinline__ bool next(int i, pg8::Unit& u) const {
        const int L = i * G + c; if (L >= nM * nN) return false;
        pg8::tile_of(L, nM, nN, u.pm, u.pn); u.A = A + (size_t)u.pm * astep + (size_t)u.pn * acol; u.B = B + (size_t)u.pn * bstep; u.x0 = 0; u.x1 = 0; return true; }
    __device__ __forceinline__ int gather(const pg8::Unit&, int) const { return 0; }
    __device__ __forceinline__ void a_ready(const pg8::Unit&, int) const {}
    __device__ __forceinline__ void done(const pg8::Unit&, int) const {}
};
struct SchedDenseR {
    static constexpr bool IMM_DONE = true;
    const char* A; const char* B; size_t astep, bstep, acol; int nM, nN, nF, G, c; unsigned* ready;
    __device__ __forceinline__ bool next(int i, pg8::Unit& u) const {
        const int L = i * G + c, n1 = nF * nN; if (L >= nM * nN) return false;
        if (L < n1) pg8::tile_of(L, nF, nN, u.pm, u.pn); else { u.pm = nF + (L - n1) / nN; u.pn = (L - n1) % nN; }
        u.A = A + (size_t)u.pm * astep + (size_t)u.pn * acol; u.B = B + (size_t)u.pn * bstep; u.x0 = 0; u.x1 = 0; return true; }
    __device__ __forceinline__ int gather(const pg8::Unit&, int) const { return 0; }
    __device__ __forceinline__ void a_ready(const pg8::Unit&, int) const {}
    __device__ __forceinline__ void done(const pg8::Unit& u, int lane) const { if (lane == 0) __hip_atomic_fetch_add(ready + u.pm, 1u, __ATOMIC_RELAXED, __HIP_MEMORY_SCOPE_AGENT); }
};
struct SchedOutproj {
    static constexpr bool IMM_DONE = true;
    const char* A; const char* B; size_t astep, bstep; int G, c; const unsigned* rdg; unsigned* ready;
    __device__ __forceinline__ bool next(int i, pg8::Unit& u) const {
        int n;
        if (G == 256) { if (c >= 32) { if (i == 0) n = c - 32; else if (i == 1 && c < 64) n = 224 + (c - 32); else return false; } else { if (i == 0 && c < 16) n = 256 + c; else return false; } }
        else { n = i * G + c; if (n >= 272) return false; }
        u.pm = n >> 2; u.pn = n & 3; u.A = A + (size_t)u.pm * astep; u.B = B + (size_t)u.pn * bstep; u.x0 = 0; u.x1 = 0; return true; }
    __device__ __forceinline__ int gather(const pg8::Unit&, int) const { return 0; }
    __device__ __forceinline__ void a_ready(const pg8::Unit& u, int wid) const {
        if (wid == 0) { unsigned sp = 0;
            while ((unsigned)__builtin_amdgcn_readfirstlane(__hip_atomic_load(rdg + u.pm, __ATOMIC_RELAXED, __HIP_MEMORY_SCOPE_AGENT)) < 8u) { __builtin_amdgcn_s_sleep(2); if (++sp > (1u << 22)) break; }
            __builtin_amdgcn_fence(__ATOMIC_ACQUIRE, "agent"); asm volatile("s_waitcnt vmcnt(0)" ::: "memory"); }
        __builtin_amdgcn_s_barrier(); asm volatile("" ::: "memory");
    }
    __device__ __forceinline__ void done(const pg8::Unit& u, int lane) const { if (lane == 0) __hip_atomic_fetch_add(ready + u.pm, 1u, __ATOMIC_RELAXED, __HIP_MEMORY_SCOPE_AGENT); }
};
struct SchedQKV {
    static constexpr bool IMM_DONE = false;
    const char* A; const char* B; size_t tstep; int ctxq, G, c;
    __device__ __forceinline__ bool next(int i, pg8::Unit& u) const {
        const int L = i * G + c, n1 = 64 * 6, n2 = ctxq ? 24 : 8; if (L >= n1 + n2) return false;
        if (L < n1) pg8::tile_of(L, 64, 6, u.pm, u.pn);
        else if (ctxq) { pg8::tile_of(L - n1, 4, 6, u.pm, u.pn); u.pm += 64; }
        else { u.pm = 64 + ((L - n1) >> 1); u.pn = 4 + ((L - n1) & 1); }
        u.A = A + (size_t)u.pm * tstep; u.B = B + (size_t)u.pn * tstep; u.x0 = 0; u.x1 = 0; return true; }
    __device__ __forceinline__ int gather(const pg8::Unit&, int) const { return 0; }
    __device__ __forceinline__ void a_ready(const pg8::Unit&, int) const {}
    __device__ __forceinline__ void done(const pg8::Unit&, int) const {}
};
struct SchedMoe {
    static constexpr bool IMM_DONE = false;
    const char* Abase; size_t astep; const char* Bbase; size_t bstep_e, bstep_n; const LAS int* tab; const int* list; int G, c;
    unsigned* ready; int mode;
    __device__ __forceinline__ int T(int i) const { return __builtin_amdgcn_readfirstlane(tab[i]); }
    __device__ __forceinline__ bool next(int i, pg8::Unit& u) const {
        const int ntiles = T(32); int gt, pn;
        if (G == 256) {
            const int x = c & 7, j = c >> 3, g = (mode == 2 ? 7 - x : x) + 8 * i, fm = 8 * g; if (fm >= ntiles) return false;
            const int gsz = (ntiles - fm) < 8 ? (ntiles - fm) : 8; if (j >= 4 * gsz) return false;
            gt = fm + j % gsz; pn = j / gsz; }
        else { const int L = i * G + (mode == 2 ? G - 1 - c : c); if (L >= ntiles * 4) return false; pg8::tile_of(L, ntiles, 4, gt, pn); }
        int e = 0;
        for (int q = 1; q < 32; ++q) e += (T(q) <= gt) ? 1 : 0;
        const int ti = gt - T(e); int valid = T(40 + e) - ti * 256; valid = valid > 256 ? 256 : valid;
        u.pm = gt; u.pn = pn; u.x0 = e * MOE_CAP + ti * 256; u.x1 = valid;
        u.A = Abase + (size_t)gt * astep; u.B = Bbase + (size_t)e * bstep_e + (size_t)pn * bstep_n; return true; }
    __device__ __forceinline__ int gather(const pg8::Unit& u, int lr) const { return lr < u.x1 ? (list[u.x0 + lr] >> 1) : 0; }
    __device__ __forceinline__ void a_ready(const pg8::Unit& u, int wid) const {
        if (mode != 2) return;
        if (wid == 0) { unsigned sp = 0;
            while ((unsigned)__builtin_amdgcn_readfirstlane(__hip_atomic_load(ready + u.pm, __ATOMIC_RELAXED, __HIP_MEMORY_SCOPE_AGENT)) < 32u) { __builtin_amdgcn_s_sleep(2); if (++sp > (1u << 22)) break; }
            __builtin_amdgcn_fence(__ATOMIC_ACQUIRE, "agent"); asm volatile("s_waitcnt vmcnt(0)" ::: "memory"); }
        __builtin_amdgcn_s_barrier(); asm volatile("" ::: "memory");
    }
    __device__ __forceinline__ void done(const pg8::Unit& u, int lane) const {
        if (mode != 1) return;
        if (lane == 0) __hip_atomic_fetch_add(ready + u.pm, 1u, __ATOMIC_RELAXED, __HIP_MEMORY_SCOPE_AGENT);
    }
};

struct EpiQKV { static constexpr bool PERM = true; bf16* Q; bf16* Kb; bf16* Vb; const float* qg; const float* kg; const f32x2* tab;
    __device__ __forceinline__ void operator()(const AccT& acc, const pg8::Unit& u, int wr, int wc, int fr, int fq) const {
        bf16* base; int pitch; long row0;
        if (u.pn < 4) { base = Q + u.pn * 256; pitch = 1024; row0 = (long)u.pm * 256; }
        else { base = (u.pn == 4) ? Kb : Vb; pitch = 256; row0 = kv_row(u.pm * 256); }
        const bool isv = u.pn == 5, lat = u.pm < 64; const float* g = u.pn < 4 ? qg : kg; const float post = u.pn < 4 ? 0.125f * 1.4426950408889634f : 1.0f;
#pragma unroll
        for (int ai = 0; ai < 2; ++ai)
#pragma unroll
            for (int m = 0; m < 4; ++m) { int fq_ = fq; asm volatile("" : "+v"(fq_));
                const int fq = fq_; const int lr = ai * 128 + wr * 64 + m * 16 + fr; const unsigned roff = (unsigned)(((int)row0 + lr) * pitch + wc * 64 + 8 * fq) * 2u;
                f32x4 g0[2], g1[2];
#pragma unroll
                for (int bj = 0; bj < 2; ++bj) { g0[bj] = *(const f32x4*)(g + 32 * bj + 8 * fq); g1[bj] = *(const f32x4*)(g + 32 * bj + 8 * fq + 4); }
                f32x4 v[2][2];
#pragma unroll
                for (int bj = 0; bj < 2; ++bj) { v[bj][0] = acc[ai][bj][m][0]; v[bj][1] = acc[ai][bj][m][1]; }
                if (!isv) {
                    float ss = 0.f;
#pragma unroll
                    for (int bj = 0; bj < 2; ++bj)
#pragma unroll
                        for (int n = 0; n < 2; ++n) ss += (v[bj][n][0] * v[bj][n][0] + v[bj][n][1] * v[bj][n][1]) + (v[bj][n][2] * v[bj][n][2] + v[bj][n][3] * v[bj][n][3]);
                    ss += __shfl_xor(ss, 16); ss += __shfl_xor(ss, 32);
                    const float rstd = rsqrtf(ss * (1.0f / 64.0f) + EPS);
#pragma unroll
                    for (int bj = 0; bj < 2; ++bj) { v[bj][0] = v[bj][0] * rstd * g0[bj]; v[bj][1] = v[bj][1] * rstd * g1[bj]; }
                    if (lat) { const int t = (u.pm * 256 + lr) & (SEQ - 1);
#pragma unroll
                        for (int bj = 0; bj < 2; ++bj) { const f32x2* tb = (const f32x2*)((const char*)tab + (unsigned)(((bj == 0 ? (t >> 6) : (t & 63)) * 16 + 4 * fq) * 8));
#pragma unroll
                            for (int n = 0; n < 2; ++n)
#pragma unroll
                                for (int e = 0; e < 2; ++e) { const f32x2 cs = tb[2 * n + e]; const float x0 = v[bj][n][2 * e], x1 = v[bj][n][2 * e + 1];
                                    v[bj][n][2 * e] = x0 * cs.x - x1 * cs.y; v[bj][n][2 * e + 1] = x0 * cs.y + x1 * cs.x; } } }
#pragma unroll
                    for (int bj = 0; bj < 2; ++bj) { v[bj][0] = v[bj][0] * post; v[bj][1] = v[bj][1] * post; }
                }
#pragma unroll
                for (int bj = 0; bj < 2; ++bj)
                    *(u32x4*)((char*)base + roff + bj * 64) = (u32x4){cvtpk(v[bj][0][0], v[bj][0][1]), cvtpk(v[bj][0][2], v[bj][0][3]), cvtpk(v[bj][1][0], v[bj][1][1]), cvtpk(v[bj][1][2], v[bj][1][3])}; }
    }
};
template <bool PERM_> struct EpiResidT { static constexpr bool PERM = PERM_; const Args* a; int layer; const float* pscale; const bf16* srcbase;
    __device__ __forceinline__ void operator()(const AccT& acc, const pg8::Unit& u, int wr, int wc, int, int) const {
        int ln; asm volatile("v_mbcnt_lo_u32_b32 %0, -1, 0\n\tv_mbcnt_hi_u32_b32 %0, -1, %0" : "=v"(ln)); const int fr = ln & 15, fq = ln >> 4;
        const int r0 = u.pm * 256;
        const float* gate = mod_row(*a, layer, r0) + 2 * D;
        const bool f32src = (layer == 0) && !srcbase; const float* src32 = resid_row(*a, 0, r0); const bf16* src16 = (srcbase ? srcbase : (const bf16*)(a->ws + WS_X)) + (size_t)r0 * D;
        const __amdgpu_buffer_rsrc_t rs = __builtin_amdgcn_make_buffer_rsrc((void*)(a->ws + WS_X), 0, TT * D * 2, 0x00020000);
        if constexpr (PERM_) {
#pragma unroll
        for (int bj = 0; bj < 2; ++bj) { const int cc = u.pn * 256 + bj * 128 + wc * 32 + 8 * fq;
            f32x4 g0 = *(const f32x4*)(gate + cc), g1 = *(const f32x4*)(gate + cc + 4); if (pscale) { g0 = g0 * *(const f32x4*)(pscale + cc); g1 = g1 * *(const f32x4*)(pscale + cc + 4); }
#pragma unroll
            for (int ai = 0; ai < 2; ++ai)
#pragma unroll
                for (int m = 0; m < 4; ++m) { const int off = (ai * 128 + wr * 64 + m * 16 + fr) * D + cc;
                    f32x4 s0, s1;
                    if (f32src) { s0 = *(const f32x4*)(src32 + off); s1 = *(const f32x4*)(src32 + off + 4); }
                    else { const u32x4 p = *(const u32x4*)(src16 + off); s0 = (f32x4){bflo(p.x), bfhi(p.x), bflo(p.y), bfhi(p.y)}; s1 = (f32x4){bflo(p.z), bfhi(p.z), bflo(p.w), bfhi(p.w)}; }
                    const f32x4 o0 = s0 + g0 * acc[ai][bj][m][0], o1 = s1 + g1 * acc[ai][bj][m][1];
                    __builtin_amdgcn_raw_buffer_store_b128((u32x4){cvtpk(o0.x, o0.y), cvtpk(o0.z, o0.w), cvtpk(o1.x, o1.y), cvtpk(o1.z, o1.w)}, rs, (r0 * D + off) * 2, 0, 16  ); }
            asm volatile("" ::: "memory"); }
        } else {
#pragma unroll
        for (int bj = 0; bj < 2; ++bj)
#pragma unroll
            for (int n = 0; n < 2; ++n) { const int cc = u.pn * 256 + bj * 128 + wc * 32 + n * 16 + 4 * fq; f32x4 g = *(const f32x4*)(gate + cc); if (pscale) g = g * *(const f32x4*)(pscale + cc);
#pragma unroll
                for (int ai = 0; ai < 2; ++ai)
#pragma unroll
                    for (int m = 0; m < 4; ++m) { const int off = (ai * 128 + wr * 64 + m * 16 + fr) * D + cc;
                        f32x4 s0;
                        if (f32src) s0 = *(const f32x4*)(src32 + off);
                        else { const u32x2 p = *(const u32x2*)(src16 + off); s0 = (f32x4){bflo(p.x), bfhi(p.x), bflo(p.y), bfhi(p.y)}; }
                        const f32x4 o0 = s0 + g * acc[ai][bj][m][n];
                        __builtin_amdgcn_raw_buffer_store_b64((u32x2){cvtpk(o0.x, o0.y), cvtpk(o0.z, o0.w)}, rs, (r0 * D + off) * 2, 0, 16  ); }
                asm volatile("" ::: "memory"); }
        }
    }
};
typedef EpiResidT<true> EpiResid; typedef EpiResidT<false> EpiResidN;
struct EpiGateUp { static constexpr bool PERM = true; bf16* act;
    __device__ __forceinline__ void operator()(const AccT& acc, const pg8::Unit& u, int wr, int wc, int fr, int fq) const {
        const __amdgpu_buffer_rsrc_t rs = __builtin_amdgcn_make_buffer_rsrc((void*)act, 0, 43008 * 512 * 2, 0x00020000);
#pragma unroll
        for (int ai = 0; ai < 2; ++ai)
#pragma unroll
            for (int m = 0; m < 4; ++m) { const int off = (int)((((size_t)u.pm * 256 + ai * 128 + wr * 64 + m * 16 + fr) * 512 + u.pn * 128 + wc * 32 + 8 * fq) * 2);
                const f32x4 g0 = acc[ai][0][m][0], g1 = acc[ai][0][m][1], u0 = acc[ai][1][m][0], u1 = acc[ai][1][m][1];
                const u32x4 ov = (u32x4){cvtpk(silu_f(g0[0]) * u0[0], silu_f(g0[1]) * u0[1]), cvtpk(silu_f(g0[2]) * u0[2], silu_f(g0[3]) * u0[3]),
                                     cvtpk(silu_f(g1[0]) * u1[0], silu_f(g1[1]) * u1[1]), cvtpk(silu_f(g1[2]) * u1[2], silu_f(g1[3]) * u1[3])};
#if MOE_FP8
                { const float sa = (float)(1 << MOE_ASH); const u32x2 o8 = (u32x2){pk_fp8x4(silu_f(g0[0]) * u0[0] * sa, silu_f(g0[1]) * u0[1] * sa, silu_f(g0[2]) * u0[2] * sa, silu_f(g0[3]) * u0[3] * sa),
                                                                                    pk_fp8x4(silu_f(g1[0]) * u1[0] * sa, silu_f(g1[1]) * u1[1] * sa, silu_f(g1[2]) * u1[2] * sa, silu_f(g1[3]) * u1[3] * sa)};
                  (void)ov; __builtin_amdgcn_raw_buffer_store_b64(o8, rs, off >> 1, 0, 16  ); } }
#else
                __builtin_amdgcn_raw_buffer_store_b128(ov, rs, off, 0, 16  ); }
#endif
    }
};
struct EpiDown { static constexpr bool PERM = true; const int* list; const float* w2; bf16* y2;
    __device__ __forceinline__ void operator()(const AccT& acc, const pg8::Unit& u, int wr, int wc, int fr, int fq) const {
#pragma unroll
        for (int ai = 0; ai < 2; ++ai)
#pragma unroll
            for (int m = 0; m < 4; ++m) { const int lr = ai * 128 + wr * 64 + m * 16 + fr;
                if (lr < u.x1) { const int dest = list[u.x0 + lr]; const float w = w2[dest]; bf16* p = y2 + (size_t)dest * D + u.pn * 256 + wc * 32 + 8 * fq;
#pragma unroll
                    for (int bj = 0; bj < 2; ++bj) { const f32x4 v0 = acc[ai][bj][m][0] * w, v1 = acc[ai][bj][m][1] * w;
                        *(u32x4*)(p + bj * 128) = (u32x4){cvtpk(v0[0], v0[1]), cvtpk(v0[2], v0[3]), cvtpk(v1[0], v1[1]), cvtpk(v1[2], v1[3])}; } } }
    }
};

constexpr int TAB_OFF = 135168;

__device__ __forceinline__ void ph_rope(const Args& a, const Ctx& c, int layer) {
    const int j = layer == 0 ? 0 : 1; const bool ctxq = layer == 0;
    const float* qg = a.in[I_QG] + j * 64; const float* kg = a.in[I_KG] + j * 64;
    const f32x2* tab = (const f32x2*)(a.ws + WS_ROPE);
    bf16* Qb = (bf16*)(a.ws + WS_Q); bf16* Kb = (bf16*)(a.ws + WS_K);
    const int nitems = TT * 20;
    for (int it = blockIdx.x * NTHREADS + c.tid; it < nitems; it += c.G * NTHREADS) {
        const int r = it / 20, hs = it % 20;
        if (hs < 16 && r >= TL && !ctxq) continue;
        bf16* p; const float* g; float post;
        if (hs < 16) { p = Qb + (size_t)r * 1024 + hs * 64; g = qg; post = 0.125f * 1.4426950408889634f; } else { p = Kb + kv_row(r) * 256 + (hs - 16) * 64; g = kg; post = 1.0f; }
        float x[64]; float ss = 0.f;
#pragma unroll
        for (int i = 0; i < 8; ++i) { const u32x4 w = ((const u32x4*)p)[i];
            x[8 * i + 0] = bflo(w.x); x[8 * i + 1] = bfhi(w.x); x[8 * i + 2] = bflo(w.y); x[8 * i + 3] = bfhi(w.y);
            x[8 * i + 4] = bflo(w.z); x[8 * i + 5] = bfhi(w.z); x[8 * i + 6] = bflo(w.w); x[8 * i + 7] = bfhi(w.w); }
#pragma unroll
        for (int i = 0; i < 64; ++i) ss += x[i] * x[i];
        const float rstd = rsqrtf(ss * (1.0f / 64.0f) + EPS);
#pragma unroll
        for (int i = 0; i < 64; ++i) x[i] = x[i] * rstd * g[i];
        if (r < TL) { const int t = r % SEQ, rp = t >> 6, cp = t & 63;
#pragma unroll
            for (int i = 0; i < 32; ++i) { const f32x2 cs = tab[(i < 16 ? rp : cp) * 16 + (i & 15)]; const float x0 = x[2 * i], x1 = x[2 * i + 1];
                x[2 * i] = x0 * cs.x - x1 * cs.y; x[2 * i + 1] = x0 * cs.y + x1 * cs.x; } }
#pragma unroll
        for (int i = 0; i < 8; ++i) ((u32x4*)p)[i] = (u32x4){cvtpk(x[8 * i] * post, x[8 * i + 1] * post), cvtpk(x[8 * i + 2] * post, x[8 * i + 3] * post),
                                                            cvtpk(x[8 * i + 4] * post, x[8 * i + 5] * post), cvtpk(x[8 * i + 6] * post, x[8 * i + 7] * post)};
    }
}

__device__ __forceinline__ void ph_att(const Args& a, const Ctx& c, int layer, char* lds_generic) {
    const int nun = 1024 + (layer == 0 ? 64 : 0);
    const attn_body::bf16* Qb = (const attn_body::bf16*)(a.ws + WS_Q); const attn_body::bf16* Kb = (const attn_body::bf16*)(a.ws + WS_K); const attn_body::bf16* Vb = (const attn_body::bf16*)(a.ws + WS_V);
    for (int U = c.vcu; U < nun; U += c.G) {
        long qrow0, kv0; int h, NT;
        if (U < 1024) { const int bh = U >> 4, qb = U & 15, b = bh >> 4; h = bh & 15; qrow0 = (long)b * SEQ + qb * 256; kv0 = (long)b * KVROWS; NT = KVROWS / 64; }
        else { const int q = U - 1024, b = q >> 4; h = q & 15; qrow0 = (long)TL + b * CTXL; kv0 = (long)b * KVROWS; NT = CTXL / 64; }
        attn_body::attn_unit<8>(qrow0, h, kv0, NT, Qb, Kb, Vb, (attn_body::bf16*)(a.ws + WS_HB), lds_generic);
    }
}

__device__ __forceinline__ void ph_m1(const Args& a, const Ctx& c, int layer, const unsigned* rdy, int nN, int amode) {
    const int Tm = layer == 3 ? TL : TT, ntiles = Tm / 32;
    int tl0, tl1, tl2;
    { int bid = (int)blockIdx.x; asm volatile("" : "+s"(bid));
      if (amode == 1 && c.G == 256 && ntiles == 544) {
          int k = c.vcu - 64; asm volatile("" : "+s"(k));
          if (k < 0) { tl0 = -1; tl1 = -1; tl2 = -1; } else { tl0 = k; tl1 = k + 192; tl2 = k < 64 ? k + 384 : (k < 160 ? 448 + (k - 64) : -1); } }
      else if (c.G == 256 && ntiles == 544) { if (bid < 16) { tl0 = 512 + bid; tl1 = -1; tl2 = -1; } else { const int j = bid - 16; tl0 = j; tl1 = j + 240; tl2 = j < 32 ? j + 480 : (j < 48 ? 528 + (j - 32) : -1); } }
      else { tl0 = bid < ntiles ? bid : -1; tl1 = bid + c.G < ntiles ? bid + c.G : -1; tl2 = bid + 2 * c.G < ntiles ? bid + 2 * c.G : -1; } }
    const unsigned need = 8u * (unsigned)nN;
#define M1_WAIT(tl) do { if (c.wave == 0) { unsigned sp_ = 0; \
        while ((unsigned)__builtin_amdgcn_readfirstlane(__hip_atomic_load(rdy + ((tl) >> 3), __ATOMIC_RELAXED, __HIP_MEMORY_SCOPE_AGENT)) < need) { __builtin_amdgcn_s_sleep(2); if (++sp_ > (1u << 22)) break; } \
        __builtin_amdgcn_fence(__ATOMIC_ACQUIRE, "agent"); asm volatile("s_waitcnt vmcnt(0)" ::: "memory"); } \
        __syncthreads(); } while (0)
    const float* g = a.in[I_NFFN] + layer * D;
    constexpr int RP = 2064;
    LAS unsigned char* hiT = c.lds; LAS unsigned char* loT = c.lds + 32 * RP;
    LAS float* part = (LAS float*)c.lds;
    LAS int* lcnt = (LAS int*)(c.lds + 133120); LAS int* lbase = lcnt + 32;
    LAS float* logit = (LAS float*)(c.lds + 134144);
    const bf16* wr = (const bf16*)(a.ws + WS_WR) + (size_t)layer * 2 * 65536;
    unsigned* gcnt = (unsigned*)(a.ws + WS_CTL) + CW_CNT + layer * 32;
    int* list = (int*)(a.ws + WS_LIST); float* w2 = (float*)(a.ws + WS_W2);
    const int r32 = c.lane & 31, hi = c.lane >> 5;
    if (c.tid < 32) lcnt[c.tid] = 0;
    u32x2 vr[4][4];
#define M1_LOADROWS(tl) do { _Pragma("unroll") for (int i = 0; i < 4; ++i) { const u32x2* xr = (const u32x2*)((const bf16*)(a.ws + WS_X) + (size_t)((tl) * 32 + 4 * c.wave + i) * D) + c.lane; \
        _Pragma("unroll") for (int j = 0; j < 4; ++j) vr[i][j] = xr[64 * j]; } } while (0)
    if (tl0 >= 0) { M1_WAIT(tl0); M1_LOADROWS(tl0); }
    int nmine = 0;
    for (; nmine < 3; ++nmine) { const int tile = nmine == 0 ? tl0 : nmine == 1 ? tl1 : tl2, tnext = nmine == 0 ? tl1 : nmine == 1 ? tl2 : -1;
        if (tile < 0) break;
        const int r0 = tile * 32;
        { f32x4 gs[4], sh[4];
          { const float* m = mod_row(a, layer, r0);
#pragma unroll
            for (int j = 0; j < 4; ++j) { gs[j] = ((const f32x4*)g)[c.lane + 64 * j] * (((const f32x4*)(m + 4 * D))[c.lane + 64 * j] + 1.0f); sh[j] = ((const f32x4*)(m + 3 * D))[c.lane + 64 * j]; } }
#pragma unroll
          for (int i = 0; i < 4; ++i) { const int lr = 4 * c.wave + i, r = r0 + lr;
            f32x4 h[4], vv[4];
#pragma unroll
            for (int j = 0; j < 4; ++j) { const u32x2 p = vr[i][j]; vv[j] = (f32x4){bflo(p.x), bfhi(p.x), bflo(p.y), bfhi(p.y)}; }
            const float rstd = row_rstd(vv);
#pragma unroll
            for (int j = 0; j < 4; ++j) h[j] = (vv[j] * rstd) * gs[j] + sh[j];
#if MOE_FP8
            unsigned* to8 = (unsigned*)((unsigned char*)(a.ws + WS_TK) + (size_t)r * D) + c.lane;
#else
            u32x2* to = (u32x2*)((bf16*)(a.ws + WS_TK) + (size_t)r * D) + c.lane;
#endif
#pragma unroll
            for (int j = 0; j < 4; ++j) { const unsigned h0 = cvtpk(h[j].x, h[j].y), h1 = cvtpk(h[j].z, h[j].w);
                const unsigned l0 = cvtpk(h[j].x - bflo(h0), h[j].y - bfhi(h0)), l1 = cvtpk(h[j].z - bflo(h1), h[j].w - bfhi(h1));
#if MOE_FP8
                to8[64 * j] = pk_fp8x4(h[j].x, h[j].y, h[j].z, h[j].w);
#else
                to[64 * j] = (u32x2){h0, h1};
#endif
                *(LAS u32x2*)(hiT + lr * RP + (4 * c.lane + 256 * j) * 2) = (u32x2){h0, h1};
                *(LAS u32x2*)(loT + lr * RP + (4 * c.lane + 256 * j) * 2) = (u32x2){l0, l1}; } } }
        __syncthreads();
        f32x16 acc0 = {}, acc1 = {};
#pragma unroll
        for (int kk = 0; kk < 8; ++kk) { const int k0 = 128 * c.wave + 16 * kk + 8 * hi;
            const bf16x8 ahi = *(const LAS bf16x8*)(hiT + r32 * RP + k0 * 2), alo = *(const LAS bf16x8*)(loT + r32 * RP + k0 * 2);
            const bf16x8 b0h = *(const bf16x8*)(wr + r32 * 1024 + k0), b1h = *(const bf16x8*)(wr + (32 + r32) * 1024 + k0);
            const bf16x8 b0l = *(const bf16x8*)(wr + 65536 + r32 * 1024 + k0), b1l = *(const bf16x8*)(wr + 65536 + (32 + r32) * 1024 + k0);
            acc0 = __builtin_amdgcn_mfma_f32_32x32x16_bf16(ahi, b0h, acc0, 0, 0, 0); acc1 = __builtin_amdgcn_mfma_f32_32x32x16_bf16(ahi, b1h, acc1, 0, 0, 0);
            acc0 = __builtin_amdgcn_mfma_f32_32x32x16_bf16(alo, b0h, acc0, 0, 0, 0); acc1 = __builtin_amdgcn_mfma_f32_32x32x16_bf16(alo, b1h, acc1, 0, 0, 0);
            acc0 = __builtin_amdgcn_mfma_f32_32x32x16_bf16(ahi, b0l, acc0, 0, 0, 0); acc1 = __builtin_amdgcn_mfma_f32_32x32x16_bf16(ahi, b1l, acc1, 0, 0, 0); }
        if (tnext >= 0) { M1_WAIT(tnext); M1_LOADROWS(tnext); }
        else __syncthreads();
#pragma unroll
        for (int reg = 0; reg < 16; ++reg) { part[((c.wave * 2 + 0) * 16 + reg) * 64 + c.lane] = acc0[reg]; part[((c.wave * 2 + 1) * 16 + reg) * 64 + c.lane] = acc1[reg]; }
        __syncthreads();
        if (nmine < 3) {
#pragma unroll
            for (int q = 0; q < 4; ++q) { const int idx = c.tid + 512 * q, nt = idx >> 10, reg = (idx >> 6) & 15, ln = idx & 63; float s = 0.f;
#pragma unroll
                for (int w = 0; w < 8; ++w) s += part[((w * 2 + nt) * 16 + reg) * 64 + ln];
                logit[(nmine * 32 + (reg & 3) + 8 * (reg >> 2) + 4 * (ln >> 5)) * 64 + nt * 32 + (ln & 31)] = s; } }
        __syncthreads();
    }
#undef M1_LOADROWS
#undef M1_WAIT
    int e0 = 0, e1 = 0, p0 = 0, p1 = 0; float w0 = 0.f, w1 = 0.f; const int myt = c.tid >> 5; const bool act_r = c.tid < 96 && myt < nmine;
    if (act_r) { const LAS float* lg = logit + c.tid * 64;
        int grp = 0; float gm = lg[0];
#pragma unroll
        for (int q = 1; q < 4; ++q) if (lg[q] > gm) { gm = lg[q]; grp = q; }
        float den = 0.f;
#pragma unroll
        for (int q = 0; q < 4; ++q) den += expf(lg[q] - gm);
        const float gate = 1.0f / den;
        const LAS float* le = lg + 4 + grp * 8;
        int i0 = 0; float v0 = le[0];
#pragma unroll
        for (int q = 1; q < 8; ++q) if (le[q] > v0) { v0 = le[q]; i0 = q; }
        int i1 = -1; float v1 = -3.0e38f;
#pragma unroll
        for (int q = 0; q < 8; ++q) if (q != i0 && le[q] > v1) { v1 = le[q]; i1 = q; }
        const float ex = expf(v1 - v0); w0 = gate / (1.0f + ex); w1 = gate * ex / (1.0f + ex);
        e0 = grp * 8 + i0; e1 = grp * 8 + i1;
        p0 = __hip_atomic_fetch_add(lcnt + e0, 1, __ATOMIC_RELAXED, __HIP_MEMORY_SCOPE_WORKGROUP);
        p1 = __hip_atomic_fetch_add(lcnt + e1, 1, __ATOMIC_RELAXED, __HIP_MEMORY_SCOPE_WORKGROUP); }
    __syncthreads();
    if (c.tid < 32) { const int n = lcnt[c.tid]; lbase[c.tid] = n ? (int)__hip_atomic_fetch_add(gcnt + c.tid, (unsigned)n, __ATOMIC_RELAXED, __HIP_MEMORY_SCOPE_AGENT) : 0; }
    __syncthreads();
    if (act_r) { const int r = (myt == 0 ? tl0 : myt == 1 ? tl1 : tl2) * 32 + (c.tid & 31);
        list[e0 * MOE_CAP + lbase[e0] + p0] = 2 * r; w2[2 * r] = w0;
        list[e1 * MOE_CAP + lbase[e1] + p1] = 2 * r + 1; w2[2 * r + 1] = w1; }
    __syncthreads();
}
__device__ __forceinline__ void moe_tables(const Args& a, const Ctx& c, int layer, LAS int* tab) {
    unsigned* gcnt = (unsigned*)(a.ws + WS_CTL) + CW_CNT + layer * 32;
    if (c.tid < 32) tab[40 + c.tid] = (int)__hip_atomic_load(gcnt + c.tid, __ATOMIC_RELAXED, __HIP_MEMORY_SCOPE_AGENT);
    __syncthreads();
    if (c.tid == 0) { int s = 0; for (int e = 0; e < 32; ++e) { tab[e] = s; s += (tab[40 + e] + 255) >> 8; } tab[32] = s; }
    __syncthreads();
}

__device__ __forceinline__ void ph_rpool(const Args& a, const Ctx& c, int layer) {
    LAS unsigned char* hs = c.lds;
    const float* g = a.in[I_NMIX] + layer * D;
    for (int tile = blockIdx.x; tile < TT / 32; tile += c.G) {
        const int r0 = tile * 32;
        const int s0 = r0 < TL ? (r0 / SEQ) * SEQ : TL + ((r0 - TL) / CTXL) * CTXL, s1 = s0 + (r0 < TL ? SEQ : CTXL);
        for (int lr = c.wave; lr < 47; lr += NWAVES) { const int gr = r0 - 8 + lr; if (gr < s0 || gr >= s1) continue;
            f32x4 v[4], h[4]; load_row_combined(a, layer, gr, c.lane, v);
            if (lr >= 8 && lr < 40) { u32x2* xo = (u32x2*)((bf16*)(a.ws + WS_Z) + (size_t)gr * D) + c.lane;
#pragma unroll
                for (int j = 0; j < 4; ++j) xo[64 * j] = (u32x2){cvtpk(v[j].x, v[j].y), cvtpk(v[j].z, v[j].w)}; }
            const float rstd = row_rstd(v); const float* m = mod_row(a, layer, gr);
            norm_mod(v, rstd, g, m, m + D, c.lane, h);
#pragma unroll
            for (int j = 0; j < 4; ++j) *(LAS u32x2*)(hs + lr * 2048 + (4 * c.lane + 256 * j) * 2) = (u32x2){cvtpk(h[j].x, h[j].y), cvtpk(h[j].z, h[j].w)}; }
        __syncthreads();
        { const int half = 1 << (c.tid >> 7);
          const LAS unsigned* col = (const LAS unsigned*)hs + c.tid;
          float sx = 0.f, sy = 0.f;
          { const int lo = (r0 - half) > s0 ? (r0 - half) : s0, hi = (r0 + half) < s1 ? (r0 + half) : s1;
            for (int gr = lo; gr < hi; ++gr) { const unsigned u = col[(gr - r0 + 8) * 512]; sx += bflo(u); sy += bfhi(u); } }
          unsigned* ho = (unsigned*)((bf16*)(a.ws + WS_HB) + (size_t)r0 * D) + c.tid;
          for (int t = 0; t < 32; ++t) { const int gr = r0 + t; const int lo = (gr - half) > s0 ? (gr - half) : s0, hi = (gr + half) < s1 ? (gr + half) : s1;
              const float inv = __builtin_amdgcn_rcpf((float)(hi - lo)); const unsigned u = col[(t + 8) * 512];
              ho[t * 512] = cvtpk(sx * inv - bflo(u), sy * inv - bfhi(u));
              if (t < 31) { if (gr + half < s1) { const unsigned w = col[(t + 8 + half) * 512]; sx += bflo(w); sy += bfhi(w); }
                            if (gr - half >= s0) { const unsigned w = col[(t + 8 - half) * 512]; sx -= bflo(w); sy -= bfhi(w); } } } }
        __syncthreads();
    }
}

struct EpiInproj { static constexpr bool PERM = true; bf16* Z; bf16* XBC; float* DT; const float* dtb;
    __device__ __forceinline__ void operator()(const AccT& acc, const pg8::Unit& u, int wr, int wc, int fr, int fq) const {
        const size_t r0 = (size_t)u.pm * 256;
        if (u.pn < 20) { bf16* base; int pitch; if (u.pn < 8) { base = Z + u.pn * 256; pitch = 2048; } else { base = XBC + (u.pn - 8) * 256; pitch = 3072; }
#pragma unroll
            for (int ai = 0; ai < 2; ++ai)
#pragma unroll
                for (int m = 0; m < 4; ++m) { bf16* rowp = base + (r0 + ai * 128 + wr * 64 + m * 16 + fr) * pitch + wc * 32 + 8 * fq;
#pragma unroll
                    for (int bj = 0; bj < 2; ++bj) { const f32x4 v0 = acc[ai][bj][m][0], v1 = acc[ai][bj][m][1];
                        *(u32x4*)(rowp + bj * 128) = (u32x4){cvtpk(v0[0], v0[1]), cvtpk(v0[2], v0[3]), cvtpk(v1[0], v1[1]), cvtpk(v1[2], v1[3])}; } }
        } else if (wc < 2) { const int col = wc * 32 + 8 * fq; const f32x4 b0 = *(const f32x4*)(dtb + col), b1 = *(const f32x4*)(dtb + col + 4);
#pragma unroll
            for (int ai = 0; ai < 2; ++ai)
#pragma unroll
                for (int m = 0; m < 4; ++m) { float* p = DT + (r0 + ai * 128 + wr * 64 + m * 16 + fr) * 64 + col; f32x4 v0 = acc[ai][0][m][0] + b0, v1 = acc[ai][0][m][1] + b1;
#pragma unroll
                    for (int e = 0; e < 4; ++e) { v0[e] = fmaxf(v0[e], 0.f) + log1pf(__expf(-fabsf(v0[e]))); v1[e] = fmaxf(v1[e], 0.f) + log1pf(__expf(-fabsf(v1[e]))); }
                    *(f32x4*)p = v0; *(f32x4*)(p + 4) = v1; } }
    }
};

__device__ __forceinline__ void ph_conv(const Args& a, const Ctx& c) {
    LAS unsigned char* tin = c.lds; LAS unsigned char* toT = c.lds + 17408; LAS unsigned char* toN = c.lds + 34816;
    const bf16* xbc = (const bf16*)(a.ws + WS_XBC);
    u32x4 pin[3];
#define CONV_PREFETCH(tk) do { const int ci_ = (tk) / 48, chb_ = (tk) % 48, r0_ = ci_ * 128, ch0_ = chb_ * 64; \
        const bool first_ = ci_ < 128 ? (ci_ % 32 == 0) : (((ci_ - 128) & 1) == 0), last_ = ci_ < 128 ? (ci_ % 32 == 31) : (((ci_ - 128) & 1) == 1); \
        _Pragma("unroll") for (int q = 0; q < 3; ++q) { const int p = c.tid + 512 * q, lr = p >> 3, pc = p & 7; const bool valid = p < 131 * 8 && !((lr < 2 && first_) || (lr == 130 && last_)); \
            pin[q] = (u32x4){0u, 0u, 0u, 0u}; if (valid) pin[q] = *(const u32x4*)(xbc + (size_t)(r0_ - 2 + lr) * 3072 + ch0_ + pc * 8); } } while (0)
    if ((int)blockIdx.x < NCH * 48) CONV_PREFETCH((int)blockIdx.x);
    for (int task = blockIdx.x; task < NCH * 48; task += c.G) {
        const int ci = task / 48, chb = task % 48, r0 = ci * 128, ch0 = chb * 64;
#pragma unroll
        for (int q = 0; q < 3; ++q) { const int p = c.tid + 512 * q; if (p < 131 * 8) *(LAS u32x4*)(tin + (p >> 3) * 128 + (p & 7) * 16) = pin[q]; }
        __syncthreads();
        if (task + c.G < NCH * 48) CONV_PREFETCH(task + c.G);
        { const int ch = c.tid & 63, tq = c.tid >> 6; const float* cw = a.in[I_CONVW] + ch0 + ch;
          const float w0 = cw[0], w1 = cw[3072], w2 = cw[2 * 3072], w3 = cw[3 * 3072], bias = a.in[I_CONVB][ch0 + ch];
          float xin[19];
#pragma unroll
          for (int i = 0; i < 19; ++i) xin[i] = bf2f(*(const LAS bf16*)(tin + (16 * tq + i) * 128 + ch * 2));
          float o[16];
#pragma unroll
          for (int i = 0; i < 16; ++i) o[i] = silu_f(bias + w0 * xin[i] + w1 * xin[i + 1] + w2 * xin[i + 2] + w3 * xin[i + 3]);
          if (chb < 40) { *(LAS u32x4*)(toT + ch * 272 + tq * 32) = (u32x4){cvtpk(o[0], o[1]), cvtpk(o[2], o[3]), cvtpk(o[4], o[5]), cvtpk(o[6], o[7])};
                          *(LAS u32x4*)(toT + ch * 272 + tq * 32 + 16) = (u32x4){cvtpk(o[8], o[9]), cvtpk(o[10], o[11]), cvtpk(o[12], o[13]), cvtpk(o[14], o[15])}; }
          if (chb >= 32) {
#pragma unroll
              for (int i = 0; i < 16; ++i) *(LAS bf16*)(toN + (16 * tq + i) * 144 + ch * 2) = (bf16)(cvtpk(o[i], 0.f) & 0xffffu); } }
        __syncthreads();
        if (chb < 40) { bf16* dst = chb < 32 ? (bf16*)(a.ws + WS_XT) + ((size_t)ci * 2048 + ch0) * 128 : (bf16*)(a.ws + WS_BT) + ((size_t)ci * 512 + (ch0 - 2048)) * 128;
#pragma unroll
            for (int q = 0; q < 2; ++q) { const int p = c.tid + 512 * q, chl = p >> 4, pc = p & 15; *(u32x4*)(dst + chl * 128 + pc * 8) = *(const LAS u32x4*)(toT + chl * 272 + pc * 16); } }
        if (chb >= 32) { bf16* dst = chb < 40 ? (bf16*)(a.ws + WS_BN) + (size_t)r0 * 512 + (ch0 - 2048) : (bf16*)(a.ws + WS_CN) + (size_t)r0 * 512 + (ch0 - 2560);
#pragma unroll
            for (int q = 0; q < 2; ++q) { const int p = c.tid + 512 * q, t = p >> 3, pc = p & 7; *(u32x4*)(dst + (size_t)t * 512 + pc * 8) = *(const LAS u32x4*)(toN + t * 144 + pc * 16); } }
        __syncthreads();
    }
#undef CONV_PREFETCH
    const int gw = c.vcu * NWAVES + c.wave, NGW = c.G * NWAVES;
    const float* dt = (const float*)(a.ws + WS_DT);
    for (int item = gw; item < NCH * 32; item += NGW) { const int ci = item >> 5, h = item & 31, r0 = ci * 128 + 2 * c.lane;
        const float af = -expf(a.in[I_ALOG][h]), ab = -expf(a.in[I_ALOG][32 + h]);
        const float dtf0 = dt[(size_t)r0 * 64 + h], dtf1 = dt[(size_t)(r0 + 1) * 64 + h], dtb0 = dt[(size_t)r0 * 64 + 32 + h], dtb1 = dt[(size_t)(r0 + 1) * 64 + 32 + h];
        const float laf0 = dtf0 * af, laf1 = dtf1 * af, lab0 = dtb0 * ab, lab1 = dtb1 * ab;
        float inf_ = laf0 + laf1, inb = lab0 + lab1; const float pf = inf_, pbk = inb;
#pragma unroll
        for (int o = 1; o < 64; o <<= 1) { const float t1 = __shfl_up(inf_, o), t2 = __shfl_up(inb, o); if (c.lane >= o) { inf_ += t1; inb += t2; } }
        const float totf = __shfl(inf_, 63), totb = __shfl(inb, 63);
        const float exf = inf_ - pf, exb = inb - pbk;
        const float cf0 = exf + laf0, cf1 = inf_, pb0 = exb, pb1 = exb + lab0;
        f32x4* sca = (f32x4*)(a.ws + WS_SCA) + (size_t)r0 * 32 + h; f32x4* scb = (f32x4*)(a.ws + WS_SCB) + (size_t)r0 * 32 + h;
        { const float L2E = 1.4426950408889634f;
          sca[0] = (f32x4){cf0 * L2E, pb0 * L2E, cf0 * L2E - __log2f(dtf0), pb0 * L2E + __log2f(dtb0)}; sca[32] = (f32x4){cf1 * L2E, pb1 * L2E, cf1 * L2E - __log2f(dtf1), pb1 * L2E + __log2f(dtb1)}; }
        scb[0] = (f32x4){__expf(cf0), __expf(totb - pb0), dtf0 * __expf(totf - cf0), dtb0 * __expf(pb0)};
        scb[32] = (f32x4){__expf(cf1), __expf(totb - pb1), dtf1 * __expf(totf - cf1), dtb1 * __expf(pb1)};
        if (c.lane == 0) ((f32x2*)(a.ws + WS_DEC))[ci * 32 + h] = (f32x2){__expf(totf), __expf(totb)}; }
}

__device__ __forceinline__ void ph_scan(const Args& a, const Ctx& c) {
    constexpr int P = 272, BUF = 53248;
    LAS unsigned char* stg = c.lds + 2 * BUF + c.wave * 2048;
    const int r32 = c.lane & 31, hi = c.lane >> 5, pt = c.wave >> 2, nt = c.wave & 3;
    for (int task = c.vcu; task < 256; task += c.G) { const int b = task >> 6, dir = (task >> 5) & 1, h = task & 31, g = h >> 3;
        f32x16 acc = {};
        u32x4 xrA[2], brA[4], xrB[2], brB[4]; f32x4 wregA = {}, wregB = {}; f32x2 decA = {}, decB = {};
#define SCAN_CI(k) (dir == 0 ? ((k) < 2 ? 128 + 2 * b + (k) : 32 * b + ((k) - 2)) : ((k) < 2 ? 128 + 2 * b + 1 - (k) : 32 * b + 31 - ((k) - 2)))
#define SCAN_LOAD(k, xr, br, wreg, dcr) do { const int ci_ = SCAN_CI(k); const bf16* xs_ = (const bf16*)(a.ws + WS_XT) + ((size_t)ci_ * 2048 + 64 * h) * 128; const bf16* bs_ = (const bf16*)(a.ws + WS_BT) + ((size_t)ci_ * 512 + 128 * g) * 128; \
        _Pragma("unroll") for (int q = 0; q < 2; ++q) xr[q] = ((const u32x4*)xs_)[c.tid + 512 * q]; _Pragma("unroll") for (int q = 0; q < 4; ++q) br[q] = ((const u32x4*)bs_)[c.tid + 512 * q]; \
        wreg = ((const f32x4*)(a.ws + WS_SCB))[((size_t)ci_ * 128 + (c.tid & 127)) * 32 + h]; dcr = ((const f32x2*)(a.ws + WS_DEC))[ci_ * 32 + h]; } while (0)
#define SCAN_WRITE(bi, xr, br, wreg) do { LAS unsigned char* xb_ = c.lds + (bi) * BUF; LAS unsigned char* bb_ = xb_ + 17408; \
        _Pragma("unroll") for (int q = 0; q < 2; ++q) { const int p = c.tid + 512 * q; *(LAS u32x4*)(xb_ + (p >> 4) * P + (p & 15) * 16) = xr[q]; } \
        _Pragma("unroll") for (int q = 0; q < 4; ++q) { const int p = c.tid + 512 * q; *(LAS u32x4*)(bb_ + (p >> 4) * P + (p & 15) * 16) = br[q]; } \
        if (c.tid < 128) ((LAS float*)(xb_ + 52224))[c.tid] = dir == 0 ? wreg.z : wreg.w; } while (0)
#define SCAN_STEP(k, cur, dcr) do { const int ci = SCAN_CI(k); \
            { bf16* hin = (bf16*)(a.ws + WS_HIN) + (((size_t)ci * 2 + dir) * 32 + h) * 8192; \
              _Pragma("unroll") for (int r = 0; r < 16; ++r) *(LAS bf16*)(stg + ((r & 3) + 8 * (r >> 2) + 4 * hi) * 64 + r32 * 2) = (bf16)(cvtpk(acc[r], 0.f) & 0xffffu); \
              LDS_WAIT(); \
              _Pragma("unroll") for (int i = 0; i < 2; ++i) { const int row = (c.lane >> 2) + 16 * i, pc = c.lane & 3; *(u32x4*)(hin + (size_t)(32 * pt + row) * 128 + 32 * nt + pc * 8) = *(const LAS u32x4*)(stg + row * 64 + pc * 16); } } \
            const float dec = dir == 0 ? dcr.x : dcr.y; \
            _Pragma("unroll") for (int r = 0; r < 16; ++r) acc[r] *= dec; \
            { LAS unsigned char* xb = c.lds + (cur) * BUF; LAS unsigned char* bb = xb + 17408; const LAS float* wv = (const LAS float*)(xb + 52224); \
              _Pragma("unroll") for (int kk = 0; kk < 8; ++kk) { const int s8 = 16 * kk + 8 * hi; \
                  const u32x4 xa = *(const LAS u32x4*)(xb + (32 * pt + r32) * P + s8 * 2); const f32x4 wa = *(const LAS f32x4*)(wv + s8), wb = *(const LAS f32x4*)(wv + s8 + 4); \
                  const u32x4 xs = (u32x4){cvtpk(bflo(xa.x) * wa.x, bfhi(xa.x) * wa.y), cvtpk(bflo(xa.y) * wa.z, bfhi(xa.y) * wa.w), cvtpk(bflo(xa.z) * wb.x, bfhi(xa.z) * wb.y), cvtpk(bflo(xa.w) * wb.z, bfhi(xa.w) * wb.w)}; \
                  const bf16x8 bfrag = *(const LAS bf16x8*)(bb + (32 * nt + r32) * P + s8 * 2); \
                  acc = __builtin_amdgcn_mfma_f32_32x32x16_bf16(__builtin_bit_cast(bf16x8, xs), bfrag, acc, 0, 0, 0); } } } while (0)
        f32x2 dcur0, dcur1;
        SCAN_LOAD(0, xrA, brA, wregA, decA); SCAN_LOAD(1, xrB, brB, wregB, decB); SCAN_WRITE(0, xrA, brA, wregA); dcur0 = decA;
        __syncthreads();
        for (int k = 0; k < 34; k += 2) {
            if (k + 2 < 34) SCAN_LOAD(k + 2, xrA, brA, wregA, decA);
            SCAN_STEP(k, 0, dcur0);
            SCAN_WRITE(1, xrB, brB, wregB); dcur1 = decB;
            __syncthreads();
            if (k + 3 < 34) SCAN_LOAD(k + 3, xrB, brB, wregB, decB);
            SCAN_STEP(k + 1, 1, dcur1);
            if (k + 2 < 34) { SCAN_WRITE(0, xrA, brA, wregA); dcur0 = decA; }
            __syncthreads();
        }
#undef SCAN_CI
#undef SCAN_LOAD
#undef SCAN_WRITE
#undef SCAN_STEP
    }
}

__device__ __forceinline__ int crow16(int r, int hi) { return (r & 3) + 8 * (r >> 2) + 4 * hi; }
__device__ __forceinline__ void ph_yph(const Args& a, const Ctx& c, unsigned* rdg) {
    constexpr int P = 272, ZP = 144;
    LAS unsigned char* Cs = c.lds; LAS unsigned char* Bs = c.lds + 34816; LAS unsigned char* xs = c.lds + 69632; LAS unsigned char* hf = c.lds + 87040; LAS unsigned char* hb = c.lds + 104448;
    LAS unsigned char* zs = c.lds + 121856; LAS unsigned char* os = c.lds + 140288; LAS f32x4* sca = (LAS f32x4*)(c.lds + 158720); LAS f32x2* scb = (LAS f32x2*)(c.lds + 160768);
    LAS float* sbv = (LAS float*)(c.lds + 161792); LAS float* scv = (LAS float*)(c.lds + 162304); LAS float* ssql = (LAS float*)(c.lds + 34816);
    const int lb = c.wave & 3, pb = c.wave >> 2;
    SECT_DECL
    for (int task = c.vcu; task < NCH * 4; task += c.G) { const int ci = task >> 2, g = task & 3, r0 = ci * 128;
        int tid_t = c.tid; asm volatile("" : "+v"(tid_t));
        f32x16 X[4]; int l0;
        u32x4 pxt[2], phf[2], phb[2], pz[2]; f32x4 ps1 = {}; f32x4 ps4 = {};
#define YPH_PREFETCH(hq) do { const int h_ = 8 * g + (hq); const u32x4* xt_ = (const u32x4*)((const bf16*)(a.ws + WS_XT) + ((size_t)ci * 2048 + 64 * h_) * 128); \
            const u32x4* hfg_ = (const u32x4*)((const bf16*)(a.ws + WS_HIN) + (((size_t)ci * 2 + 0) * 32 + h_) * 8192); const u32x4* hbg_ = (const u32x4*)((const bf16*)(a.ws + WS_HIN) + (((size_t)ci * 2 + 1) * 32 + h_) * 8192); \
            const bf16* zg_ = (const bf16*)(a.ws + WS_Z) + (size_t)r0 * 2048 + 64 * h_; \
            _Pragma("unroll") for (int q = 0; q < 2; ++q) { const int p = tidp + 512 * q; pxt[q] = xt_[p]; phf[q] = hfg_[p]; phb[q] = hbg_[p]; pz[q] = *(const u32x4*)(zg_ + (size_t)(p >> 3) * 2048 + (p & 7) * 8); } \
            ps1 = ((const f32x4*)(a.ws + WS_SCA))[((size_t)r0 + (tidp & 127)) * 32 + h_]; ps4 = ((const f32x4*)(a.ws + WS_SCB))[((size_t)r0 + (tidp & 127)) * 32 + h_]; } while (0)
        { const int tid = tid_t, lane = tid & 63, r32 = lane & 31, hi = lane >> 5; l0 = 32 * lb + r32;
          { const bf16* cn = (const bf16*)(a.ws + WS_CN) + (size_t)r0 * 512 + 128 * g; const bf16* bn = (const bf16*)(a.ws + WS_BN) + (size_t)r0 * 512 + 128 * g;
#pragma unroll
            for (int q = 0; q < 4; ++q) { const int p = tid + 512 * q, row = p >> 4, pc = p & 15;
                *(LAS u32x4*)(Cs + row * P + pc * 16) = *(const u32x4*)(cn + (size_t)row * 512 + pc * 8); *(LAS u32x4*)(Bs + row * P + pc * 16) = *(const u32x4*)(bn + (size_t)row * 512 + pc * 8); } }
          { const int tidp = tid; YPH_PREFETCH(0); }
          __syncthreads();
#pragma unroll
          for (int sb = 0; sb < 4; ++sb) { X[sb] = (f32x16){};
#pragma unroll
              for (int kk = 0; kk < 8; ++kk) { const int k8 = (16 * kk + 8 * hi) * 2;
                  X[sb] = __builtin_amdgcn_mfma_f32_32x32x16_bf16(*(const LAS bf16x8*)(Bs + (32 * sb + r32) * P + k8), *(const LAS bf16x8*)(Cs + (32 * lb + r32) * P + k8), X[sb], 0, 0, 0); } }
        }
        SECT(0);
        float ssq = 0.f;
#pragma unroll 1
        for (int hh = 0; hh < 8; ++hh) { const int h = 8 * g + hh;
            int tid = c.tid; asm volatile("" : "+v"(tid)); const int lane = tid & 63, r32 = lane & 31, hi = lane >> 5, l = 32 * lb + r32; (void)lane;
            const float dsum = a.in[I_DSK][h] + a.in[I_DSK][32 + h];
            __syncthreads();
            SECT(1);
            if (hh > 0) { bf16* gg = (bf16*)(a.ws + WS_G) + (size_t)r0 * 2048 + 64 * (h - 1);
#pragma unroll
                for (int q = 0; q < 2; ++q) { const int p = tid + 512 * q, zr = p >> 3, zc = p & 7; *(u32x4*)(gg + (size_t)zr * 2048 + zc * 8) = *(const LAS u32x4*)(os + zr * ZP + zc * 16); } }
#pragma unroll
            for (int q = 0; q < 2; ++q) { const int p = tid + 512 * q, row = p >> 4, pc = p & 15;
                *(LAS u32x4*)(xs + row * P + pc * 16) = pxt[q]; *(LAS u32x4*)(hf + row * P + pc * 16) = phf[q]; *(LAS u32x4*)(hb + row * P + pc * 16) = phb[q];
                *(LAS u32x4*)(zs + (p >> 3) * ZP + (p & 7) * 16) = pz[q]; }
            if (tid < 128) { sca[tid] = ps1; scb[tid] = (f32x2){ps4.x, ps4.y}; sbv[tid] = ps1.z; scv[tid] = ps1.w; }
            __syncthreads();
            SECT(2);
            if (hh < 7) { const int tidp = tid; YPH_PREFETCH(hh + 1); }
            SECT(3);
            const f32x4 me = sca[l]; const f32x2 ee = scb[l];
            const float dtb_l = __builtin_amdgcn_exp2f(me.w - me.y);
            f32x16 accd = {};
#pragma unroll
            for (int sb = 0; sb < 4; ++sb) { unsigned mp[8];
#pragma unroll
                for (int q = 0; q < 4; ++q) { const int s0 = 32 * sb + 8 * q + 4 * hi; float mv[4];
                    if (sb < lb) { const f32x4 bs4 = *(const LAS f32x4*)(sbv + s0);
#pragma unroll
                        for (int e = 0; e < 4; ++e) mv[e] = X[sb][4 * q + e] * __builtin_amdgcn_exp2f(me.x - bs4[e]); }
                    else if (sb > lb) { const f32x4 cs4 = *(const LAS f32x4*)(scv + s0);
#pragma unroll
                        for (int e = 0; e < 4; ++e) mv[e] = X[sb][4 * q + e] * __builtin_amdgcn_exp2f(cs4[e] - me.y); }
                    else { const f32x4 bs4 = *(const LAS f32x4*)(sbv + s0), cs4 = *(const LAS f32x4*)(scv + s0);
#pragma unroll
                        for (int e = 0; e < 4; ++e) { const int s = s0 + e; const float t = (s <= l) ? (me.x - bs4[e]) : (cs4[e] - me.y); const float xv = X[sb][4 * q + e];
                            float m = xv * __builtin_amdgcn_exp2f(t); if (s == l) m += xv * dtb_l + dsum; mv[e] = m; } }
                    mp[2 * q] = cvtpk(mv[0], mv[1]); mp[2 * q + 1] = cvtpk(mv[2], mv[3]); }
#pragma unroll
                for (int t = 0; t < 2; ++t) { const int sof = (32 * sb + 16 * t + 4 * hi) * 2;
                    const u32x2 lo = *(const LAS u32x2*)(xs + (32 * pb + r32) * P + sof), h2 = *(const LAS u32x2*)(xs + (32 * pb + r32) * P + sof + 16);
                    const u32x4 af = (u32x4){lo.x, lo.y, h2.x, h2.y}, bfm = (u32x4){mp[4 * t], mp[4 * t + 1], mp[4 * t + 2], mp[4 * t + 3]};
                    accd = __builtin_amdgcn_mfma_f32_32x32x16_bf16(__builtin_bit_cast(bf16x8, af), __builtin_bit_cast(bf16x8, bfm), accd, 0, 0, 0); }
                }
            SECT(4);
#pragma unroll
            for (int dd = 0; dd < 2; ++dd) { f32x16 acco = {}; LAS unsigned char* hx = dd == 0 ? hf : hb;
#pragma unroll
                for (int kk = 0; kk < 8; ++kk) { const int k8 = (16 * kk + 8 * hi) * 2;
                    acco = __builtin_amdgcn_mfma_f32_32x32x16_bf16(*(const LAS bf16x8*)(hx + (32 * pb + r32) * P + k8), *(const LAS bf16x8*)(Cs + (32 * lb + r32) * P + k8), acco, 0, 0, 0); }
                const float ex = dd == 0 ? ee.x : ee.y;
#pragma unroll
                for (int r = 0; r < 16; ++r) accd[r] += ex * acco[r]; }
            SECT(5);
#pragma unroll
            for (int q = 0; q < 4; ++q) { const int pcol = 32 * pb + 8 * q + 4 * hi; const u32x2 zq = *(const LAS u32x2*)(zs + l * ZP + pcol * 2);
                float gv[4];
#pragma unroll
                for (int e = 0; e < 4; ++e) { const int r = 4 * q + e; const float y = accd[r];
                    const float z = (e == 0) ? bflo(zq.x) : (e == 1) ? bfhi(zq.x) : (e == 2) ? bflo(zq.y) : bfhi(zq.y); gv[e] = y * silu_f(z); ssq += gv[e] * gv[e]; }
                *(LAS u32x2*)(os + l * ZP + pcol * 2) = (u32x2){cvtpk(gv[0], gv[1]), cvtpk(gv[2], gv[3])}; }
            SECT(6);
        }
#undef YPH_PREFETCH
        __syncthreads();
        { bf16* gg = (bf16*)(a.ws + WS_G) + (size_t)r0 * 2048 + 64 * (8 * g + 7);
#pragma unroll
          for (int q = 0; q < 2; ++q) { const int p = c.tid + 512 * q, zr = p >> 3, zc = p & 7; *(u32x4*)(gg + (size_t)zr * 2048 + zc * 8) = *(const LAS u32x4*)(os + zr * ZP + zc * 16); } }
        ssq += __shfl_xor(ssq, 32);
        if ((c.lane >> 5) == 0) ssql[pb * 128 + l0] = ssq;
        __syncthreads();
        if (c.tid < 128) ssql[256 + c.tid] = rsqrtf((ssql[c.tid] + ssql[128 + c.tid]) * (1.0f / 512.0f) + EPS);
        VM_WAIT();
        __syncthreads();
        { bf16* gt = (bf16*)(a.ws + WS_G) + (size_t)r0 * 2048 + 512 * g; const float* ng = a.in[I_SNORM] + 512 * g;
          const __amdgpu_buffer_rsrc_t grs = __builtin_amdgcn_make_buffer_rsrc((void*)(a.ws + WS_G), 0, TT * 2048 * 2, 0x00020000);
          const f32x4 g0 = *(const f32x4*)(ng + (c.tid & 63) * 8), g1 = *(const f32x4*)(ng + (c.tid & 63) * 8 + 4);
#pragma unroll 1
          for (int qb = 0; qb < 2; ++qb) { u32x4 gv8[8]; int tidq = c.tid + 4096 * qb; asm volatile("" : "+v"(tidq));
#pragma unroll
            for (int q = 0; q < 8; ++q) { const int p = tidq + 512 * q; gv8[q] = *(const u32x4*)(gt + (size_t)(p >> 6) * 2048 + (p & 63) * 8); }
#pragma unroll
            for (int q = 0; q < 8; ++q) { const int p = tidq + 512 * q, row = p >> 6, col = (p & 63) * 8; const u32x4 v = gv8[q]; const float sr = ssql[256 + row];
              __builtin_amdgcn_raw_buffer_store_b128((u32x4){cvtpk(bflo(v.x) * sr * g0.x, bfhi(v.x) * sr * g0.y), cvtpk(bflo(v.y) * sr * g0.z, bfhi(v.y) * sr * g0.w), cvtpk(bflo(v.z) * sr * g1.x, bfhi(v.z) * sr * g1.y), cvtpk(bflo(v.w) * sr * g1.z, bfhi(v.w) * sr * g1.w)},
                  grs, ((r0 + row) * 2048 + 512 * g + col) * 2, 0, 16  ); } } }
        VM_WAIT();
        __syncthreads();
        if (c.tid == 0) __hip_atomic_fetch_add(rdg + (ci >> 1), 1u, __ATOMIC_RELAXED, __HIP_MEMORY_SCOPE_AGENT);
        SECT(7);
    }
    SECT_END(40);
}
__device__ __forceinline__ void ph_gfix(const Args& a, const Ctx& c) {
    const float* ng = a.in[I_SNORM]; const float* rs = (const float*)(a.ws + WS_RSTD);
    const int n16 = TT * 256;
    for (int p = blockIdx.x * NTHREADS + c.tid; p < n16; p += c.G * NTHREADS) { const int r = p >> 8, col = (p & 255) * 8;
        u32x4* gp = (u32x4*)((bf16*)(a.ws + WS_G) + (size_t)r * 2048 + col); const u32x4 v = *gp; const float s = rs[r * 4 + (col >> 9)];
        const f32x4 g0 = *(const f32x4*)(ng + col), g1 = *(const f32x4*)(ng + col + 4);
        *gp = (u32x4){cvtpk(bflo(v.x) * s * g0.x, bfhi(v.x) * s * g0.y), cvtpk(bflo(v.y) * s * g0.z, bfhi(v.y) * s * g0.w), cvtpk(bflo(v.z) * s * g1.x, bfhi(v.z) * s * g1.y), cvtpk(bflo(v.w) * s * g1.z, bfhi(v.w) * s * g1.w)}; }
}

#if DEBUG_CHECKS
__device__ __forceinline__ float dbg_hb(const Args& a, int layer, size_t idx, float sh) {
    if (ATT_FP8 && layer != 2) return __builtin_amdgcn_cvt_f32_fp8((unsigned)((const unsigned char*)(a.ws + WS_HB))[idx], 0) * sh;
    return bf2f(((const bf16*)(a.ws + WS_HB))[idx]); }
__device__ __forceinline__ int dbg_sample_row(int b) { const int SR[16] = {0, 1, 77, 4095, 4096, 5000, 8191, 9000, 12288, 16383, 16384, 16385, 16384 + 255, 16384 + 256, 17000, 17407}; int r = 0;
#pragma unroll
    for (int i = 0; i < 16; ++i) r = (b == i) ? SR[i] : r;
    return r; }
__device__ __forceinline__ float blk_sum(float v, LAS float* red, int tid) {
    v = wave_sum(v); __syncthreads(); if ((tid & 63) == 0) red[tid >> 6] = v; __syncthreads(); float s = 0.f;
#pragma unroll
    for (int i = 0; i < 8; ++i) s += red[i];
    __syncthreads(); return s; }
__device__ __forceinline__ float blk_max(float v, LAS float* red, int tid) {
#pragma unroll
    for (int o = 1; o < 64; o <<= 1) v = fmaxf(v, __shfl_xor(v, o));
    __syncthreads(); if ((tid & 63) == 0) red[tid >> 6] = v; __syncthreads(); float s = red[0];
#pragma unroll
    for (int i = 1; i < 8; ++i) s = fmaxf(s, red[i]);
    __syncthreads(); return s; }
__device__ __forceinline__ void dbg_report(const Args& a, int id, float err, float ssref, float n, int tid) {
    if (tid == 0) { float rel = err / (sqrtf(ssref / n) + 1e-20f); if (!(rel == rel)) rel = 1e30f; atomicMax((unsigned*)(a.ws + WS_CTL) + CW_DBG + id, __float_as_uint(rel)); } }
__device__ __forceinline__ float dbg_mod(const Args& a, int layer, int r, int j) {
    const float* cv = r < TL ? a.in[I_C] + (r / SEQ) * 1024 : a.in[I_CCTX]; float s = 0.f;
    _Pragma("nounroll") for (int k = 0; k < 1024; ++k) { const float x = cv[k]; s += (x / (1.0f + expf(-x))) * a.in[I_WADA][((size_t)layer * 1024 + k) * 6144 + j]; }
    return s + a.in[I_BADA][layer * 6144 + j]; }

__device__ __forceinline__ void chk_rmix(const Args& a, int layer, int id, LAS unsigned char* ldsb) {
    if (blockIdx.x >= 16) return; const int tid = tid_opaque(), r = dbg_sample_row(blockIdx.x);
    LAS float* red = (LAS float*)ldsb;
    const float* x = resid_row(a, layer, r); const bf16* hb = (const bf16*)(a.ws + WS_HB) + (size_t)r * D;
    float ss = 0.f; for (int cc = tid; cc < D; cc += 512) ss += x[cc] * x[cc];
    ss = blk_sum(ss, red, tid); const float rstd = rsqrtf(ss / D + EPS);
    float err = 0.f, sr = 0.f;
    for (int cc = tid; cc < D; cc += 512) { const float sh = dbg_mod(a, layer, r, cc), sc = dbg_mod(a, layer, r, D + cc);
        const float ref = x[cc] * rstd * a.in[I_NMIX][layer * D + cc] * (1.f + sc) + sh; err = fmaxf(err, fabsf(ref - dbg_hb(a, layer, (size_t)r * D + cc, 1.f))); sr += ref * ref; }
    err = blk_max(err, red, tid); sr = blk_sum(sr, red, tid); dbg_report(a, id, err, sr, D, tid);
}
__device__ __forceinline__ void chk_qkv(const Args& a, int layer, int id, LAS unsigned char* ldsb) {
    if (blockIdx.x >= 16) return; const int tid = tid_opaque(), r = dbg_sample_row(blockIdx.x), j = layer ? 1 : 0;
    LAS float* red = (LAS float*)ldsb; LAS float* y = red + 16; LAS float* hrow = y + 1536;
    const bf16* hb = (const bf16*)(a.ws + WS_HB) + (size_t)r * D;
    _Pragma("nounroll") for (int k = tid; k < D; k += 512) hrow[k] = dbg_hb(a, layer, (size_t)r * D + k, 1.f);
    __syncthreads();
    for (int n = tid; n < 1536; n += 512) { float s = 0.f; const float* w = a.in[I_WQKV] + (size_t)j * 1024 * 1536 + n; _Pragma("nounroll") for (int k = 0; k < 1024; ++k) s += hrow[k] * w[(size_t)k * 1536]; y[n] = s; }
    __syncthreads();
    float err = 0.f, sr = 0.f;
    for (int n = tid; n < 1536; n += 512) { float ref;
        if (n < 1280) { const int h0 = n & ~63; float ss = 0.f; _Pragma("nounroll") for (int q = 0; q < 64; ++q) ss += y[h0 + q] * y[h0 + q];
            const float rstd = rsqrtf(ss / 64.f + EPS); const float* g = (n < 1024 ? a.in[I_QG] : a.in[I_KG]) + j * 64;
            float v = y[n] * rstd * g[n & 63], vp = y[n ^ 1] * rstd * g[(n ^ 1) & 63];
            if (r < TL) { const int t = r % SEQ, i = (n & 63) >> 1, f = i & 15, pos = i < 16 ? t / 64 : t % 64; const float inv = powf(10000.f, -(float)f / 16.f), ang = (float)pos * inv, cs = cosf(ang), sn = sinf(ang);
                v = (n & 1) ? (vp * sn + v * cs) : (v * cs - vp * sn); }
            if (n < 1024) v *= 0.125f * 1.4426950408889634f;
            ref = v; } else ref = y[n];
        float got;
        if (n < 1024) { if (layer == 3 && r >= TL) continue; got = bf2f(((const bf16*)(a.ws + WS_Q))[(size_t)r * 1024 + n]); }
        else if (n < 1280) got = bf2f(((const bf16*)(a.ws + WS_K))[kv_row(r) * 256 + (n - 1024)]);
        else got = bf2f(((const bf16*)(a.ws + WS_V))[kv_row(r) * 256 + (n - 1280)]);
        err = fmaxf(err, fabsf(ref - got)); sr += ref * ref; }
    err = blk_max(err, red, tid); sr = blk_sum(sr, red, tid); dbg_report(a, id, err, sr, 1536, tid);
}
__device__ __forceinline__ void chk_att(const Args& a, int layer, int id, LAS unsigned char* ldsb) {
    if (blockIdx.x >= 16) return; const int tid = tid_opaque(), r = dbg_sample_row(blockIdx.x);
    if (layer == 3 && r >= TL) return;
    LAS float* red = (LAS float*)ldsb; LAS float* sc = red + 16; LAS float* po = sc + 4352;
    const int nk = r < TL ? KVROWS : CTXL; const long kv0 = (long)(r < TL ? r / SEQ : (r - TL) / CTXL) * KVROWS;
    const bf16* Qb = (const bf16*)(a.ws + WS_Q); const bf16* Kb = (const bf16*)(a.ws + WS_K); const bf16* Vb = (const bf16*)(a.ws + WS_V); const bf16* Ob = (const bf16*)(a.ws + WS_HB);
    float err = 0.f, sr = 0.f;
    for (int h = 0; h < 16; ++h) {
        float mx = -3e38f;
        _Pragma("nounroll") for (int jk = tid; jk < nk; jk += 512) { float s = 0.f; _Pragma("nounroll") for (int d = 0; d < 64; ++d) s += bf2f(Qb[(size_t)r * 1024 + h * 64 + d]) * bf2f(Kb[(kv0 + jk) * 256 + (h >> 2) * 64 + d]); sc[jk] = s; mx = fmaxf(mx, s); }
        mx = blk_max(mx, red, tid);
        float l = 0.f; _Pragma("nounroll") for (int jk = tid; jk < nk; jk += 512) { const float p = exp2f(sc[jk] - mx); sc[jk] = p; l += p; }
        l = blk_sum(l, red, tid);
        { const int d = tid & 63, part = tid >> 6; float o = 0.f; _Pragma("nounroll") for (int jk = part; jk < nk; jk += 8) o += sc[jk] * bf2f(Vb[(kv0 + jk) * 256 + (h >> 2) * 64 + d]); po[part * 64 + d] = o; }
        __syncthreads();
        if (tid < 64) { float o = 0.f; _Pragma("nounroll") for (int p = 0; p < 8; ++p) o += po[p * 64 + tid]; o /= l; err = fmaxf(err, fabsf(o - dbg_hb(a, layer, (size_t)r * 1024 + h * 64 + tid, 1.f / (float)(1 << ATT_OSH)))); sr += o * o; }
        __syncthreads();
    }
    err = blk_max(err, red, tid); sr = blk_sum(sr, red, tid); dbg_report(a, id, err, sr, 1024, tid);
}
__device__ __forceinline__ void chk_oproj(const Args& a, int layer, int id, LAS unsigned char* ldsb) {
    if (blockIdx.x >= 16 || layer != 0) return; const int tid = tid_opaque(), r = dbg_sample_row(blockIdx.x), j = 0;
    LAS float* red = (LAS float*)ldsb; LAS float* orow = red + 16;
    const bf16* Ob = (const bf16*)(a.ws + WS_HB) + (size_t)r * D;
    _Pragma("nounroll") for (int k = tid; k < D; k += 512) orow[k] = dbg_hb(a, layer, (size_t)r * D + k, 1.f / (float)(1 << ATT_OSH));
    __syncthreads();
    float err = 0.f, sr = 0.f;
    for (int n = tid; n < D; n += 512) { float s = 0.f; const float* w = a.in[I_WO] + (size_t)j * 1024 * 1024 + n; _Pragma("nounroll") for (int k = 0; k < 1024; ++k) s += orow[k] * w[(size_t)k * 1024];
        const float dl = dbg_mod(a, layer, r, 2 * D + n) * s, ref = resid_row(a, 0, r)[n] + dl; err = fmaxf(err, fabsf(ref - ((const float*)(a.ws + WS_X))[(size_t)r * D + n])); sr += dl * dl; }
    err = blk_max(err, red, tid); sr = blk_sum(sr, red, tid); dbg_report(a, id, err, sr, D, tid);
}
__device__ __forceinline__ void chk_moe(const Args& a, int layer, int id_tok, int id_y, LAS unsigned char* ldsb) {
    if (blockIdx.x >= 16) return; const int tid = tid_opaque(), r = dbg_sample_row(blockIdx.x);
    if (layer == 3 && r >= TL) return;
    LAS float* red = (LAS float*)ldsb; LAS float* tok = red + 16; LAS float* lg = tok + 1024; LAS float* tkb = lg + 64; LAS float* act = tkb + 1024; LAS float* rt = act + 1024;
    const float* x = (const float*)(a.ws + WS_X) + (size_t)r * D; const bf16* tk = (const bf16*)(a.ws + WS_TK) + (size_t)r * D;
    float ss = 0.f; for (int cc = tid; cc < D; cc += 512) ss += x[cc] * x[cc];
    ss = blk_sum(ss, red, tid); const float rstd = rsqrtf(ss / D + EPS);
    float err = 0.f, sr = 0.f;
    for (int cc = tid; cc < D; cc += 512) { const float sh = dbg_mod(a, layer, r, 3 * D + cc), sc = dbg_mod(a, layer, r, 4 * D + cc);
        const float ref = x[cc] * rstd * a.in[I_NFFN][layer * D + cc] * (1.f + sc) + sh; tok[cc] = ref;
#if MOE_FP8
        tkb[cc] = __builtin_amdgcn_cvt_f32_fp8((unsigned)((const unsigned char*)(a.ws + WS_TK))[(size_t)r * D + cc], 0);
#else
        tkb[cc] = bf2f(tk[cc]);
#endif
        err = fmaxf(err, fabsf(ref - tkb[cc])); sr += ref * ref; }
    err = blk_max(err, red, tid); sr = blk_sum(sr, red, tid);
    if (tid < 36) { float s = 0.f; _Pragma("nounroll") for (int k = 0; k < 1024; ++k) s += tok[k] * (tid < 4 ? a.in[I_WRG][((size_t)layer * 1024 + k) * 4 + tid] : a.in[I_WRE][((size_t)layer * 1024 + k) * 32 + tid - 4]); lg[tid] = s; }
    __syncthreads();
    if (tid == 0) { int grp = 0; _Pragma("nounroll") for (int q = 1; q < 4; ++q) if (lg[q] > lg[grp]) grp = q; float den = 0.f; _Pragma("nounroll") for (int q = 0; q < 4; ++q) den += expf(lg[q] - lg[grp]);
        const LAS float* le = lg + 4 + grp * 8; int i0 = 0; _Pragma("nounroll") for (int q = 1; q < 8; ++q) if (le[q] > le[i0]) i0 = q; int i1 = -1; _Pragma("nounroll") for (int q = 0; q < 8; ++q) if (q != i0 && (i1 < 0 || le[q] > le[i1])) i1 = q;
        const float ex = expf(le[i1] - le[i0]), w0 = 1.f / den / (1.f + ex), w1 = 1.f / den * ex / (1.f + ex);
        rt[0] = (float)(grp * 8 + i0); rt[1] = (float)(grp * 8 + i1); rt[2] = w0; rt[3] = w1;
        const float* w2 = (const float*)(a.ws + WS_W2); float e2 = fmaxf(fabsf(w2[2 * r] - w0), fabsf(w2[2 * r + 1] - w1)) * 30.f;
        const int* list = (const int*)(a.ws + WS_LIST); const unsigned* gc = (const unsigned*)(a.ws + WS_CTL) + CW_CNT + layer * 32;
        _Pragma("nounroll") for (int k = 0; k < 2; ++k) { const int e = (int)rt[k]; bool found = false; const int n = (int)gc[e]; _Pragma("nounroll") for (int q = 0; q < n && q < MOE_CAP; ++q) if (list[e * MOE_CAP + q] == 2 * r + k) found = true; if (!found) e2 = 1e6f; }
        rt[4] = e2; }
    __syncthreads();
    err = fmaxf(err, rt[4] * sqrtf(sr / D));
    dbg_report(a, id_tok, err, sr, D, tid);
    float err2 = 0.f, sr2 = 0.f;
    _Pragma("nounroll") for (int k = 0; k < 2; ++k) { const int e = (int)rt[k]; const float wk = rt[2 + k];
        const float* wgu = a.in[I_WGU] + ((size_t)layer * 32 + e) * 1024 * 1024; const float* wdn = a.in[I_WDN] + ((size_t)layer * 32 + e) * 512 * 1024;
        { float sg = 0.f, su = 0.f; _Pragma("nounroll") for (int q = 0; q < 1024; ++q) { sg += tkb[q] * wgu[(size_t)q * 1024 + tid]; su += tkb[q] * wgu[(size_t)q * 1024 + 512 + tid]; } act[tid] = (sg / (1.f + expf(-sg))) * su; }
        __syncthreads();
        for (int n = tid; n < D; n += 512) { float s = 0.f; _Pragma("nounroll") for (int q = 0; q < 512; ++q) s += act[q] * wdn[(size_t)q * 1024 + n]; s *= wk;
            err2 = fmaxf(err2, fabsf(s - bf2f(((const bf16*)(a.ws + WS_Y2))[(size_t)(2 * r + k) * D + n]))); sr2 += s * s; }
        __syncthreads(); }
    err2 = blk_max(err2, red, tid); sr2 = blk_sum(sr2, red, tid); dbg_report(a, id_y, err2, sr2, 2 * D, tid);
}

__global__ void __launch_bounds__(NTHREADS) dbg_kernel(Args a, int ty, int layer, int id) {
    extern __shared__ __attribute__((aligned(16))) unsigned char lds_dbg[];
    LAS unsigned char* l = (LAS unsigned char*)lds_dbg;
    if (ty == 1) chk_rmix(a, layer, id, l); else if (ty == 2) chk_qkv(a, layer, id, l); else if (ty == 3) chk_att(a, layer, id, l);
    else if (ty == 4) chk_oproj(a, layer, id, l); else if (ty == 5) chk_moe(a, layer, id, id + 1, l);
}
#endif

template <int KIND, int LAYER> __device__ __forceinline__ void run_phase(const Args& a0, Ctx& c, unsigned char* lds_gen) {
    Args a = a0; { unsigned long long wsv = (unsigned long long)a0.ws; asm volatile("" : "+s"(wsv)); a.ws = (unsigned char*)(GAS unsigned char*)wsv; }
    { unsigned lb = (unsigned)(uintptr_t)(LAS unsigned char*)lds_gen; asm volatile("" : "+s"(lb)); c.lds = (LAS unsigned char*)(uintptr_t)lb; }
    c.tid = tid_opaque(); c.lane = c.tid & 63;
    unsigned char* const ws = a.ws; constexpr int layer = LAYER;
#define RELAUNDER() do { { unsigned long long wsv_ = (unsigned long long)a0.ws; asm volatile("" : "+s"(wsv_)); a.ws = (unsigned char*)(GAS unsigned char*)wsv_; } \
        { unsigned lb_ = (unsigned)(uintptr_t)(LAS unsigned char*)lds_gen; asm volatile("" : "+s"(lb_)); c.lds = (LAS unsigned char*)(uintptr_t)lb_; } c.tid = tid_opaque(); c.lane = c.tid & 63; } while (0)
    if constexpr (KIND == K_P0) p0_prologue(a, c);
    else if constexpr (KIND == K_RMIX) ph_rmix(a, c, layer);
    else if constexpr (KIND == K_QKV) { constexpr int j = layer ? 1 : 0;
#if ATT_FP8
        SchedQKV S{(const char*)(ws + WS_HB), (const char*)(ws + WS_WQKV) + (size_t)j * 1536 * 1024, (size_t)256 * 1024, layer == 0 ? 1 : 0, c.G, (int)blockIdx.x};
        EpiQKV E{(bf16*)(ws + WS_Q), (bf16*)(ws + WS_K), (bf16*)(ws + WS_V), a.in[I_QG] + j * 64, a.in[I_KG] + j * 64, (const f32x2*)(ws + WS_ROPE)};
        pg8::gemm_phase<EpiQKV, SchedQKV, false, true>(c.lds, 1024, 1024, S, E, 127 - MOE_WSH, 127); }
#else
        SchedQKV S{(const char*)(ws + WS_HB), (const char*)(ws + WS_WQKV) + (size_t)j * 1536 * 1024 * 2, (size_t)256 * 1024 * 2, layer == 0 ? 1 : 0, c.G, (int)blockIdx.x};
        EpiQKV E{(bf16*)(ws + WS_Q), (bf16*)(ws + WS_K), (bf16*)(ws + WS_V), a.in[I_QG] + j * 64, a.in[I_KG] + j * 64, (const f32x2*)(ws + WS_ROPE)};
        pg8::gemm_phase<EpiQKV, SchedQKV, false>(c.lds, 2048, 2048, S, E); }
#endif
    else if constexpr (KIND == K_ROPE) ph_rope(a, c, layer);
    else if constexpr (KIND == K_ATT) ph_att(a, c, layer, (char*)c.lds);
    else if constexpr (KIND == K_OPROJ) { constexpr int j = layer ? 1 : 0;
#if ATT_FP8
        unsigned* rdx = (unsigned*)(ws + WS_CTL) + CW_RDX + layer * 128;
        SchedDenseR S{(const char*)(ws + WS_HB), (const char*)(ws + WS_WO) + (size_t)j * 1024 * 1024, (size_t)256 * 1024, (size_t)256 * 1024, 0, layer == 3 ? 64 : 68, 4, 64, c.G, (int)blockIdx.x, rdx};
        EpiResid E{&a, layer, nullptr, nullptr};
        pg8::gemm_phase<EpiResid, SchedDenseR, false, true>(c.lds, 1024, 1024, S, E, 127 - MOE_WSH, 127 - ATT_OSH);
        RELAUNDER(); ph_m1(a, c, layer, (unsigned*)(a.ws + WS_CTL) + CW_RDX + layer * 128, 4, 0); }
#else
        unsigned* rdx = (unsigned*)(ws + WS_CTL) + CW_RDX + layer * 128;
        SchedDenseR S{(const char*)(ws + WS_HB), (const char*)(ws + WS_WO) + (size_t)j * 1024 * 1024 * 2, (size_t)256 * 1024 * 2, (size_t)256 * 1024 * 2, 0, layer == 3 ? 64 : 68, 4, 64, c.G, (int)blockIdx.x, rdx};
        EpiResid E{&a, layer, nullptr, nullptr};
        pg8::gemm_phase<EpiResid, SchedDenseR, false>(c.lds, 2048, 2048, S, E);
        RELAUNDER(); ph_m1(a, c, layer, (unsigned*)(a.ws + WS_CTL) + CW_RDX + layer * 128, 4, 0); }
#endif
    else if constexpr (KIND == K_M2) {
        LAS int* tab = (LAS int*)(c.lds + TAB_OFF); moe_tables(a, c, layer, tab);
        unsigned* rdy = (unsigned*)(ws + WS_CTL) + CW_RDY + layer * 256;
#if MOE_FP8
        { SchedMoe S{(const char*)(ws + WS_TK), 0, (const char*)(ws + WS_WGU) + (size_t)layer * 32 * 1024 * 1024, (size_t)1024 * 1024, (size_t)256 * 1024, tab, (const int*)(ws + WS_LIST), c.G, (int)blockIdx.x, rdy, 1};
          EpiGateUp E{(bf16*)(ws + WS_ACT)};
          pg8::gemm_phase<EpiGateUp, SchedMoe, true, true>(c.lds, 1024, 1024, S, E, 127 - MOE_WSH, 127); }
        { SchedMoe S{(const char*)(ws + WS_ACT), (size_t)256 * 512, (const char*)(ws + WS_WDN) + (size_t)layer * 32 * 1024 * 512, (size_t)1024 * 512, (size_t)256 * 512, tab, (const int*)(ws + WS_LIST), c.G, (int)blockIdx.x, rdy, 2};
          EpiDown E{(const int*)(ws + WS_LIST), (const float*)(ws + WS_W2), (bf16*)(ws + WS_Y2)};
          pg8::gemm_phase<EpiDown, SchedMoe, false, true>(c.lds, 512, 512, S, E, 127 - MOE_WSH, 127 - MOE_ASH); } }
#else
        { SchedMoe S{(const char*)(ws + WS_TK), 0, (const char*)(ws + WS_WGU) + (size_t)layer * 32 * 1024 * 1024 * 2, (size_t)1024 * 1024 * 2, (size_t)256 * 1024 * 2, tab, (const int*)(ws + WS_LIST), c.G, (int)blockIdx.x, rdy, 1};
          EpiGateUp E{(bf16*)(ws + WS_ACT)};
          pg8::gemm_phase<EpiGateUp, SchedMoe, true>(c.lds, 2048, 2048, S, E); }
        { SchedMoe S{(const char*)(ws + WS_ACT), (size_t)256 * 512 * 2, (const char*)(ws + WS_WDN) + (size_t)layer * 32 * 1024 * 512 * 2, (size_t)1024 * 512 * 2, (size_t)256 * 512 * 2, tab, (const int*)(ws + WS_LIST), c.G, (int)blockIdx.x, rdy, 2};
          EpiDown E{(const int*)(ws + WS_LIST), (const float*)(ws + WS_W2), (bf16*)(ws + WS_Y2)};
          pg8::gemm_phase<EpiDown, SchedMoe, false>(c.lds, 1024, 1024, S, E); } }
#endif
    else if constexpr (KIND == K_RPOOL) ph_rpool(a, c, layer);
    else if constexpr (KIND == K_POOLG) {
        unsigned* rdx = (unsigned*)(ws + WS_CTL) + CW_RDX + layer * 128;
        SchedDenseR S{(const char*)(ws + WS_HB), (const char*)(ws + WS_WPOOL), (size_t)256 * 1024 * 2, (size_t)256 * 256 * 2, (size_t)256 * 2, 68, 4, 64, c.G, (int)blockIdx.x, rdx};
        EpiResidN E{&a, layer, a.in[I_POOLS], (const bf16*)(ws + WS_Z)};
        pg8::gemm_phase<EpiResidN, SchedDenseR, false>(c.lds, 512, 2048, S, E);
        RELAUNDER(); ph_m1(a, c, layer, (unsigned*)(a.ws + WS_CTL) + CW_RDX + layer * 128, 4, 0); }
    else if constexpr (KIND == K_INPROJ) {
        SchedDense S{(const char*)(ws + WS_HB), (const char*)(ws + WS_WIN), (size_t)256 * 1024 * 2, (size_t)256 * 1024 * 2, 0, 68, 21, c.G, (int)blockIdx.x};
        EpiInproj E{(bf16*)(ws + WS_Z), (bf16*)(ws + WS_XBC), (float*)(ws + WS_DT), a.in[I_DTB]};
        pg8::gemm_phase<EpiInproj, SchedDense, false>(c.lds, 2048, 2048, S, E); }
    else if constexpr (KIND == K_CONV) ph_conv(a, c);
    else if constexpr (KIND == K_SCAN) ph_scan(a, c);
    else if constexpr (KIND == K_YPH) {
        ph_yph(a, c, (unsigned*)(ws + WS_CTL) + CW_RDG);
        RELAUNDER();
        { unsigned* rdx = (unsigned*)(a.ws + WS_CTL) + CW_RDX + layer * 128;
          SchedOutproj S{(const char*)(a.ws + WS_G), (const char*)(a.ws + WS_WOUT), (size_t)256 * 2048 * 2, (size_t)256 * 2048 * 2, c.G, c.vcu, (const unsigned*)(a.ws + WS_CTL) + CW_RDG, rdx};
          EpiResid E{&a, layer, nullptr, nullptr};
          pg8::gemm_phase<EpiResid, SchedOutproj, false>(c.lds, 4096, 4096, S, E); }
        RELAUNDER(); ph_m1(a, c, layer, (unsigned*)(a.ws + WS_CTL) + CW_RDX + layer * 128, 4, 1); }
    else if constexpr (KIND == K_GFIX) ph_gfix(a, c);
    else if constexpr (KIND == K_FINAL) ph_final(a, c, layer);
#undef RELAUNDER
}
#define PROGRAM(X) \
    X(0, K_P0, 0) \
    X(1, K_RMIX, 0) X(2, K_QKV, 0) X(3, K_ATT, 0) X(4, K_OPROJ, 0) X(5, K_M2, 0) \
    X(6, K_RPOOL, 1) X(7, K_POOLG, 1) X(8, K_M2, 1) \
    X(9, K_RMIX, 2) X(10, K_INPROJ, 2) X(11, K_CONV, 2) X(12, K_SCAN, 2) X(13, K_YPH, 2) X(14, K_M2, 2) \
    X(15, K_RMIX, 3) X(16, K_QKV, 3) X(17, K_ATT, 3) X(18, K_OPROJ, 3) X(19, K_M2, 3) \
    X(20, K_FINAL, 4)
constexpr int NPHASES = 21;
__device__ __forceinline__ unsigned long long probe_phases(const unsigned long long* ts, unsigned mask) { unsigned long long r = 0; for (int k = 0; k < 32; ++k) if (mask & (1u << k)) r += ts[k + 1] - ts[k]; return r; }
__device__ __forceinline__ unsigned long long probe_sum(const unsigned long long* s, int mask) { unsigned long long r = 0; for (int k = 0; k < 8; ++k) if (mask & (1 << k)) r += s[k]; return r; }
__global__ void __launch_bounds__(NTHREADS, 2) mega(Args a0) {
    extern __shared__ __attribute__((aligned(16))) unsigned char lds_raw[];
    Ctx c; c.lds = (LAS unsigned char*)lds_raw; c.tid = threadIdx.x; c.lane = c.tid & 63; c.wave = __builtin_amdgcn_readfirstlane(c.tid >> 6);
    c.G = gridDim.x; { const int bx = blockIdx.x; c.vcu = (c.G % 8 == 0) ? (bx % 8) * (c.G / 8) + bx / 8 : bx; }
    volatile LAS unsigned* MISC = (volatile LAS unsigned*)(c.lds + MISC_OFF);
    for (int u = c.tid; u < 128; u += NTHREADS) MISC[u] = 0u;
    __syncthreads();
    XcdBarrier bar = xcd_barrier_post((unsigned*)(a0.ws + WS_CTL) + CW_BAR + a0.bar_region * XCD_BAR_WORDS, MISC + 8);
    const int lo = a0.ph_lo, hi = a0.ph_hi;
#if PROBE
#define STAMP(idx) if (blockIdx.x == 0 && threadIdx.x == 0) __hip_atomic_store((unsigned long long*)((unsigned*)(a0.ws + WS_CTL) + CW_TS) + (idx), (unsigned long long)__builtin_amdgcn_s_memrealtime(), __ATOMIC_RELAXED, __HIP_MEMORY_SCOPE_AGENT);
#else
#define STAMP(idx)
#endif
    STAMP(0)
#if EXTRA_BARS
    for (int eb = 0; eb < EXTRA_BARS; ++eb) xcd_barrier(bar);
#endif
#define RUNPH(idx, KIND, LAYER) if (lo <= (idx) && (idx) < hi) { run_phase<KIND, LAYER>(a0, c, lds_raw); if ((idx) + 1 < hi) xcd_barrier(bar); STAMP((idx) + 1) }
    PROGRAM(RUNPH)
#undef RUNPH
#if PROBE
    if (blockIdx.x == 0 && threadIdx.x == 0 && hi == NPHASES) { const unsigned long long* ts = (const unsigned long long*)((unsigned*)(a0.ws + WS_CTL) + CW_TS);
        const unsigned long long d = (unsigned long long)PROBE_K * (PROBE_SLOT ? probe_sum(ts + PROBE_SLOT_BASE, PROBE_SLOT) : probe_phases(ts, PROBE_MASK)), t0 = __builtin_amdgcn_s_memrealtime();
        while (__builtin_amdgcn_s_memrealtime() - t0 < d) __builtin_amdgcn_s_sleep(8); }
#endif
}

extern "C" void kernel_launch(void* const* d_in, const int* in_sizes, int n_in, void* d_out, int out_size, void* d_ws, size_t ws_size, hipStream_t stream) {
    static int grid = 0;
    if (grid == 0) {
        if (n_in != N_IN || out_size != TL * D || ws_size < WS_END) { fprintf(stderr, "kernel_launch: unexpected shapes (n_in %d out %d ws %zu)\n", n_in, out_size, ws_size); grid = -1; return; }
        int dev = 0, cus = 0;
        if (hipGetDevice(&dev) != hipSuccess || hipDeviceGetAttribute(&cus, hipDeviceAttributeMultiprocessorCount, dev) != hipSuccess) { grid = -1; return; }
        if (hipFuncSetAttribute((const void*)mega, hipFuncAttributeMaxDynamicSharedMemorySize, LDS_BYTES) != hipSuccess) { fprintf(stderr, "kernel_launch: hipFuncSetAttribute failed\n"); grid = -1; return; }
        int per_cu = 0;
        if (hipOccupancyMaxActiveBlocksPerMultiprocessor(&per_cu, (const void*)mega, NTHREADS, LDS_BYTES) != hipSuccess || per_cu < 1) fprintf(stderr, "kernel_launch: occupancy query says %d\n", per_cu);
        (void)hipGetLastError();
        grid = cus;
    }
    if (grid < 0) return;
    (void)hipMemsetAsync((char*)d_ws + WS_CTL, 0, CTL_ZERO_BYTES, stream);
    Args a{};
    for (int i = 0; i < N_IN; ++i) a.in[i] = (const float*)d_in[i];
    a.out = (float*)d_out; a.ws = (unsigned char*)d_ws; a.flags = 0;
#if DEBUG_CHECKS
    struct Cut { int after; int ty, layer, nid; };
    const Cut cuts[] = DEBUG_CUTS;
    int lo = 0, region = 0, dbg_id = 1;
    for (unsigned k = 0; k < sizeof(cuts) / sizeof(cuts[0]); ++k) {
        if (cuts[k].after + 1 > lo) { a.ph_lo = lo; a.ph_hi = cuts[k].after + 1; a.bar_region = region++; hipLaunchKernelGGL(mega, dim3(grid), dim3(NTHREADS), LDS_BYTES, stream, a); lo = cuts[k].after + 1; }
        hipLaunchKernelGGL(dbg_kernel, dim3(16), dim3(NTHREADS), 65536, stream, a, cuts[k].ty, cuts[k].layer, dbg_id); dbg_id += cuts[k].nid;
    }
    a.ph_lo = lo; a.ph_hi = NPHASES; a.bar_region = region++;
    hipLaunchKernelGGL(mega, dim3(grid), dim3(NTHREADS), LDS_BYTES, stream, a);
#else
    a.ph_lo = 0; a.ph_hi = NPHASES; a.bar_region = 0;
    hipLaunchKernelGGL(mega, dim3(grid), dim3(NTHREADS), LDS_BYTES, stream, a);
#endif
}
```

```cpp
#include <hip/hip_runtime.h>
#include <cstdio>
#include <cstdint>

#define LAS __attribute__((address_space(3)))
#define GAS __attribute__((address_space(1)))
typedef unsigned short bf16;
typedef short bf16x8 __attribute__((ext_vector_type(8)));
typedef short s16x4 __attribute__((ext_vector_type(4)));
typedef float f32x2 __attribute__((ext_vector_type(2)));
typedef float f32x4 __attribute__((ext_vector_type(4)));
typedef float f32x16 __attribute__((ext_vector_type(16)));
typedef unsigned u32x2 __attribute__((ext_vector_type(2)));
typedef unsigned u32x4 __attribute__((ext_vector_type(4)));
typedef __bf16 bf16x2_t __attribute__((ext_vector_type(2)));

constexpr int D = 1024, NB = 4, SEQ = 4096, CTXL = 256, TL = NB * SEQ, TC = NB * CTXL, TT = TL + TC;
constexpr int KVROWS = SEQ + CTXL;
constexpr int NCH = TT / 128;
constexpr int MOE_CAP = TT;
constexpr float EPS = 1e-6f;
constexpr int NWAVES = 8, NTHREADS = 512;
#ifndef NLAYERS
#define NLAYERS 4
#endif
#ifndef MOE_FP8
#define MOE_FP8 1
#endif
#define MOE_WSH 5
#ifndef ATT_FP8
#define ATT_FP8 1
#endif
#define ATT_OSH 3
#define MOE_ASH 2
#define DBG_TOL 0.03f
#ifndef DEBUG_CHECKS
#define DEBUG_CHECKS 0
#endif
#ifndef PROBE
#define PROBE 0
#endif
#define PROBE_A0 0
#define PROBE_A1 1
#define PROBE_B0 4
#define PROBE_B1 5
#define PROBE_K 2
#define PROBE_MASK 0x1222224u
#define EXTRA_BARS 0
#define PROBE_SLOT_BASE 40
#define PROBE_SLOT 0
#if PROBE
#define SECT_DECL unsigned long long sect_t = __builtin_amdgcn_s_memrealtime(); unsigned long long sect_acc[8] = {0, 0, 0, 0, 0, 0, 0, 0};
#define SECT(k) do { const unsigned long long n_ = __builtin_amdgcn_s_memrealtime(); sect_acc[k] += n_ - sect_t; sect_t = n_; } while (0)
#ifndef PROBE_BLOCK
#define PROBE_BLOCK 0
#endif
#define SECT_END(base) do { if (blockIdx.x == PROBE_BLOCK && threadIdx.x == 0) { _Pragma("unroll") for (int k_ = 0; k_ < 8; ++k_) ((unsigned long long*)((unsigned*)(a.ws + WS_CTL) + CW_TS))[(base) + k_] = sect_acc[k_]; } } while (0)
#else
#define SECT_DECL
#define SECT(k) do {} while (0)
#define SECT_END(base) do {} while (0)
#endif
#define DEBUG_CUTS { {1, 1, 0, 1}, {2, 2, 0, 1}, {3, 3, 0, 1}, {4, 4, 0, 1}, {6, 5, 0, 2} }

enum { I_X = 0, I_C, I_CTX, I_CCTX, I_WADA, I_BADA, I_NMIX, I_NFFN, I_NFIN, I_WQKV, I_WO, I_QG, I_KG, I_POOLW, I_POOLS, I_WIN, I_CONVW, I_CONVB, I_DTB, I_ALOG, I_DSK, I_SNORM, I_WOUT, I_WRG, I_WRE, I_WGU, I_WDN, N_IN };

constexpr size_t MiB = 1u << 20;
constexpr size_t WS_CTL = 0, CTL_ZERO_BYTES = 1 * MiB;
constexpr size_t WS_MODL = 1 * MiB;
constexpr size_t WS_MODC = WS_MODL + 4 * 4 * 6144 * 4;
constexpr size_t WS_ROPE = 1 * MiB + 512 * 1024;
constexpr size_t WS_WR = 2 * MiB;
constexpr size_t WS_WQKV = 3 * MiB;
constexpr size_t WS_WO = 9 * MiB;
constexpr size_t WS_WPOOL = 13 * MiB;
constexpr size_t WS_WIN = 14 * MiB;
constexpr size_t WS_WOUT = 25 * MiB;
constexpr size_t WS_WGU = 29 * MiB;
constexpr size_t WS_WDN = 285 * MiB;
constexpr size_t WS_X = 413 * MiB;
constexpr size_t WS_HB = 481 * MiB;
constexpr size_t WS_TK = 515 * MiB;
constexpr size_t WS_Q = 549 * MiB;
constexpr size_t WS_K = 583 * MiB;
constexpr size_t WS_V = 592 * MiB;
constexpr size_t WS_Y2 = 601 * MiB;
constexpr size_t WS_ACT = 669 * MiB;
constexpr size_t WS_LIST = 711 * MiB;
constexpr size_t WS_W2 = 714 * MiB;
constexpr size_t WS_Z = 715 * MiB;
constexpr size_t WS_XBC = 783 * MiB;
constexpr size_t WS_DT = 885 * MiB;
constexpr size_t WS_XT = 890 * MiB;
constexpr size_t WS_BN = 958 * MiB;
constexpr size_t WS_BT = 975 * MiB;
constexpr size_t WS_CN = 992 * MiB;
constexpr size_t WS_SCA = 1009 * MiB;
constexpr size_t WS_SCB = 1018 * MiB;
constexpr size_t WS_DEC = 1027 * MiB;
constexpr size_t WS_HIN = 1028 * MiB;
constexpr size_t WS_G = 1164 * MiB;
constexpr size_t WS_RSTD = 1232 * MiB;
constexpr size_t WS_END = 1233 * MiB;

constexpr int CW_BAR = 4096;
constexpr int CW_CNT = 200000;
constexpr int CW_DBG = 201000;
constexpr int CW_RDY = 204000;
constexpr int CW_RDG = 207000;
constexpr int CW_RDX = 206000;
constexpr int CW_TS = 202000;

constexpr int LDS_BYTES = 163840;
constexpr int MISC_OFF = LDS_BYTES - 512;

__device__ __forceinline__ unsigned cvtpk(float lo, float hi) { f32x2 v = {lo, hi}; bf16x2_t b = __builtin_convertvector(v, bf16x2_t); return __builtin_bit_cast(unsigned, b); }
__device__ __forceinline__ unsigned pk_fp8x4(float a, float b, float c, float d) {
    a = __builtin_amdgcn_fmed3f(a, -448.f, 448.f); b = __builtin_amdgcn_fmed3f(b, -448.f, 448.f); c = __builtin_amdgcn_fmed3f(c, -448.f, 448.f); d = __builtin_amdgcn_fmed3f(d, -448.f, 448.f);
    unsigned w = __builtin_amdgcn_cvt_pk_fp8_f32(a, b, 0u, false); return __builtin_amdgcn_cvt_pk_fp8_f32(c, d, w, true); }
__device__ __forceinline__ float bflo(unsigned u) { return __uint_as_float(u << 16); }
__device__ __forceinline__ float bfhi(unsigned u) { return __uint_as_float(u & 0xffff0000u); }
__device__ __forceinline__ float bf2f(bf16 b) { return __uint_as_float((unsigned)b << 16); }
__device__ __forceinline__ float wave_sum(float v) {
#pragma unroll
    for (int o = 1; o < 64; o <<= 1) v += __shfl_xor(v, o);
    return v;
}
__device__ __forceinline__ float silu_f(float v) { return v * __builtin_amdgcn_rcpf(1.0f + __builtin_amdgcn_exp2f(v * -1.4426950408889634f)); }
__device__ __forceinline__ int tid_opaque() { int t = threadIdx.x; asm volatile("" : "+v"(t)); return t; }
#define LDS_WAIT() asm volatile("s_waitcnt lgkmcnt(0)" ::: "memory")
#define VM_WAIT() asm volatile("s_waitcnt vmcnt(0)" ::: "memory")

#define XB_TMO      128
#define XB_XCNT(j)  (256  + 64 * (j))
#define XB_XSUB(j)  (1280 + 64 * (j))
#define XB_XGEN(j)  (2304 + 64 * (j))
#define XB_TOP      3328
#define XB_TOPGEN   3392
#define XCD_BAR_WORDS 3456
#define XB_SPIN_CAP (1u << 20)
#ifndef XB_FLATPOLL
#define XB_FLATPOLL 0
#endif
__device__ __forceinline__ unsigned xb_ld(unsigned* p)              { return __hip_atomic_load(p, __ATOMIC_RELAXED, __HIP_MEMORY_SCOPE_AGENT); }
__device__ __forceinline__ unsigned xb_add(unsigned* p, unsigned v) { return __hip_atomic_fetch_add(p, v, __ATOMIC_RELAXED, __HIP_MEMORY_SCOPE_AGENT); }
__device__ __forceinline__ unsigned xb_xcc_id() { return (unsigned)__builtin_amdgcn_s_getreg((3 << 11) | 20) & 0xFu; }
#define XB_SPIN(cond, bar) do { unsigned _sp = 0; while (cond) { __builtin_amdgcn_s_sleep(1); \
    if ((++_sp & 255u) == 0u) { if (xb_ld(&(bar)[XB_TMO])) break; if (_sp > XB_SPIN_CAP) { atomicAdd(&(bar)[XB_TMO], 1u); break; } } } } while (0)
struct XcdBarrier { unsigned* bar; unsigned x; volatile LAS unsigned* st; };
__device__ __forceinline__ XcdBarrier xcd_barrier_post(unsigned* bar, volatile LAS unsigned* st) {
    XcdBarrier b; b.bar = bar; b.x = xb_xcc_id(); b.st = st;
    if (threadIdx.x == 0) (void)xb_add(&bar[XB_XCNT(b.x)], 1u);
    return b;
}
__device__ __forceinline__ void xcd_barrier_complete(unsigned* bar, unsigned x, unsigned& nloc, unsigned& nx) {
    const unsigned G = gridDim.x * gridDim.y * gridDim.z;
    unsigned sum, cnt, mine, sp = 0u;
    for (;;) {
        sum = 0u; cnt = 0u; mine = 0u;
#pragma unroll
        for (unsigned j = 0; j < 16; ++j) { const unsigned c = xb_ld(&bar[XB_XCNT(j)]); sum += c; cnt += (c > 0u) ? 1u : 0u; mine = (j == x) ? c : mine; }
        if (sum == G) break;
        __builtin_amdgcn_s_sleep(1);
        if ((++sp & 255u) == 0u) { if (xb_ld(&bar[XB_TMO])) break; if (sp > XB_SPIN_CAP) { atomicAdd(&bar[XB_TMO], 1u); break; } }
    }
    nloc = mine > 0u ? mine : 1u; nx = cnt > 0u ? cnt : 1u;
}
__device__ __forceinline__ void xcd_barrier(const XcdBarrier& b) {
    asm volatile("s_waitcnt vmcnt(0)" ::: "memory");
    __syncthreads();
    if (threadIdx.x == 0) {
        unsigned* bar = b.bar;
        __builtin_amdgcn_s_waitcnt(0);
        unsigned nloc = b.st[0], nx = b.st[1];
        if (nloc == 0u) { xcd_barrier_complete(bar, b.x, nloc, nx); b.st[0] = nloc; b.st[1] = nx; }
#if XB_FLATPOLL
        const unsigned seq = b.st[2]; b.st[2] = seq + 1u;
#endif
        const unsigned old = xb_add(&bar[XB_XSUB(b.x)], 1u);
        const unsigned gen = old / nloc;
        if (old + 1u == (gen + 1u) * nloc) {
            __builtin_amdgcn_fence(__ATOMIC_RELEASE, "agent");
            asm volatile("s_waitcnt vmcnt(0)" ::: "memory");
            const unsigned og = xb_add(&bar[XB_TOP], 1u);
            const unsigned tg = og / nx;
            if (og + 1u == (tg + 1u) * nx) xb_add(&bar[XB_TOPGEN], 1u);
            else XB_SPIN(xb_ld(&bar[XB_TOPGEN]) == tg, bar);
            __builtin_amdgcn_fence(__ATOMIC_ACQUIRE, "agent");
#if !XB_FLATPOLL
            xb_add(&bar[XB_XGEN(b.x)], 1u);
#endif
            asm volatile("s_waitcnt vmcnt(0)" ::: "memory");
        } else {
#if XB_FLATPOLL
            XB_SPIN(xb_ld(&bar[XB_TOPGEN]) == seq, bar);
#else
            XB_SPIN(xb_ld(&bar[XB_XGEN(b.x)]) == gen, bar);
#endif
            __builtin_amdgcn_fence(__ATOMIC_ACQUIRE, "agent");
            asm volatile("s_waitcnt vmcnt(0)" ::: "memory");
        }
    }
    __syncthreads();
}

enum { K_P0 = 0, K_RMIX, K_QKV, K_ROPE, K_ATT, K_OPROJ, K_M1, K_M2, K_M3, K_RPOOL, K_POOLG, K_INPROJ, K_CONV, K_SCAN, K_YPH, K_GFIX, K_OUTPROJ, K_FINAL, K_DBG };
struct Args { const float* in[N_IN]; float* out; unsigned char* ws; int ph_lo, ph_hi; int flags; int bar_region; };

struct Ctx {
    LAS unsigned char* lds; int tid, lane, wave, vcu, G;
};

__device__ __forceinline__ const float* mod_row(const Args& a, int layer, int r) {
    return r < TL ? (const float*)(a.ws + WS_MODL) + (size_t)(layer * 4 + r / SEQ) * 6144 : (const float*)(a.ws + WS_MODC) + (size_t)layer * 6144;
}
__device__ __forceinline__ const float* resid_row(const Args& a, int layer, int r) {
    if (layer == 0) return r < TL ? a.in[I_X] + (size_t)r * D : a.in[I_CTX] + (size_t)(r - TL) * D;
    return (const float*)(a.ws + WS_X) + (size_t)r * D;
}

__device__ __forceinline__ void load_row_combined(const Args& a, int layer, int r, int lane, f32x4 (&v)[4]) {
    if (layer == 0) { const f32x4* xr = (const f32x4*)resid_row(a, 0, r) + lane;
#pragma unroll
        for (int j = 0; j < 4; ++j) v[j] = xr[64 * j]; }
    else { const u32x2* xr = (const u32x2*)((const bf16*)(a.ws + WS_X) + (size_t)r * D) + lane;
#pragma unroll
        for (int j = 0; j < 4; ++j) { const u32x2 p = xr[64 * j]; v[j] = (f32x4){bflo(p.x), bfhi(p.x), bflo(p.y), bfhi(p.y)}; } }
    if (layer > 0 && !(a.flags & 1)) {
        const f32x4* gf = (const f32x4*)(mod_row(a, layer - 1, r) + 5 * D) + lane;
        const u32x2* y0 = (const u32x2*)((const bf16*)(a.ws + WS_Y2) + (size_t)(2 * r) * D) + lane;
        const u32x2* y1 = (const u32x2*)((const bf16*)(a.ws + WS_Y2) + (size_t)(2 * r + 1) * D) + lane;
#pragma unroll
        for (int j = 0; j < 4; ++j) {
            const u32x2 p = y0[64 * j], q = y1[64 * j]; const f32x4 g = gf[64 * j];
            v[j].x += g.x * (bflo(p.x) + bflo(q.x)); v[j].y += g.y * (bfhi(p.x) + bfhi(q.x));
            v[j].z += g.z * (bflo(p.y) + bflo(q.y)); v[j].w += g.w * (bfhi(p.y) + bfhi(q.y));
        }
    }
}
__device__ __forceinline__ float row_rstd(const f32x4 (&v)[4]) {
    float s = 0.f;
#pragma unroll
    for (int j = 0; j < 4; ++j) s += (v[j].x * v[j].x + v[j].y * v[j].y) + (v[j].z * v[j].z + v[j].w * v[j].w);
    return rsqrtf(wave_sum(s) * (1.0f / D) + EPS);
}
__device__ __forceinline__ void norm_mod(const f32x4 (&v)[4], float rstd, const float* g, const float* shift, const float* scale, int lane, f32x4 (&h)[4]) {
#pragma unroll
    for (int j = 0; j < 4; ++j) {
        const f32x4 gg = ((const f32x4*)g)[lane + 64 * j], sh = ((const f32x4*)shift)[lane + 64 * j], sc = ((const f32x4*)scale)[lane + 64 * j];
        h[j] = (v[j] * rstd) * gg * (sc + 1.0f) + sh;
    }
}

__device__ __forceinline__ void tr_item(const float* W, int N, int k0, int n0, bf16* WT, size_t drow0, int dK, LAS float* scr, int lane, int hi_skip = 0) {
    const int nq = lane & 15, kr = lane >> 4;
#pragma unroll
    for (int i = 0; i < 16; ++i) { const int kk = 4 * i + kr; const f32x4 v = *(const f32x4*)(W + (size_t)(k0 + kk) * N + n0 + 4 * nq);
        LAS float* d = scr + kk * 65 + 4 * nq; d[0] = v.x; d[1] = v.y; d[2] = v.z; d[3] = v.w; }
    LDS_WAIT(); asm volatile("" ::: "memory");
    const int c = lane & 7;
#pragma unroll
    for (int j = 0; j < 8; ++j) { const int n = (lane >> 3) + 8 * j; const LAS float* s = scr + (8 * c) * 65 + n;
        u32x4 o; o.x = cvtpk(s[0 * 65], s[1 * 65]); o.y = cvtpk(s[2 * 65], s[3 * 65]); o.z = cvtpk(s[4 * 65], s[5 * 65]); o.w = cvtpk(s[6 * 65], s[7 * 65]);
        *(u32x4*)(WT + (drow0 + n + (n >= 32 ? hi_skip : 0)) * dK + k0 + 8 * c) = o; }
    LDS_WAIT(); asm volatile("" ::: "memory");
}
__device__ __forceinline__ void tr_item8(const float* W, int N, int k0, int n0, unsigned char* WT, size_t drow0, int dKb, LAS float* scr, int lane, float scale, int hi_skip = 0) {
    const int nq = lane & 15, kr = lane >> 4;
#pragma unroll
    for (int i = 0; i < 16; ++i) { const int kk = 4 * i + kr; const f32x4 v = *(const f32x4*)(W + (size_t)(k0 + kk) * N + n0 + 4 * nq);
        LAS float* d = scr + kk * 65 + 4 * nq; d[0] = v.x; d[1] = v.y; d[2] = v.z; d[3] = v.w; }
    LDS_WAIT(); asm volatile("" ::: "memory");
    const int c = lane & 3;
#pragma unroll
    for (int j = 0; j < 4; ++j) { const int n = (lane >> 2) + 16 * j; const LAS float* s = scr + (16 * c) * 65 + n;
        u32x4 o; o.x = pk_fp8x4(s[0 * 65] * scale, s[1 * 65] * scale, s[2 * 65] * scale, s[3 * 65] * scale); o.y = pk_fp8x4(s[4 * 65] * scale, s[5 * 65] * scale, s[6 * 65] * scale, s[7 * 65] * scale);
        o.z = pk_fp8x4(s[8 * 65] * scale, s[9 * 65] * scale, s[10 * 65] * scale, s[11 * 65] * scale); o.w = pk_fp8x4(s[12 * 65] * scale, s[13 * 65] * scale, s[14 * 65] * scale, s[15 * 65] * scale);
        *(u32x4*)(WT + (drow0 + n + (n >= 32 ? hi_skip : 0)) * dKb + k0 + 16 * c) = o; }
    LDS_WAIT(); asm volatile("" ::: "memory");
}
struct TrD { const float* src; int N; unsigned char* dst; int dKb, drow0, hi_skip, fp8; };
__device__ __forceinline__ void tr_load(const TrD& d, f32x4 (&v)[16], int lane) {
    const int nq = lane & 15, kr = lane >> 4;
#pragma unroll
    for (int i = 0; i < 16; ++i) v[i] = *(const f32x4*)(d.src + (size_t)(4 * i + kr) * d.N + 4 * nq);
}
__device__ __forceinline__ void tr_store(const TrD& d, const f32x4 (&v)[16], LAS float* scr, int lane) {
    const int nq = lane & 15, kr = lane >> 4;
#pragma unroll
    for (int i = 0; i < 16; ++i) { LAS float* p = scr + (4 * i + kr) * 65 + 4 * nq; p[0] = v[i].x; p[1] = v[i].y; p[2] = v[i].z; p[3] = v[i].w; }
    LDS_WAIT(); asm volatile("" ::: "memory");
    if (d.fp8) { const int c = lane & 3; const float scale = (float)(1 << MOE_WSH);
#pragma unroll
        for (int j = 0; j < 4; ++j) { const int n = (lane >> 2) + 16 * j; const LAS float* s = scr + (16 * c) * 65 + n;
            u32x4 o; o.x = pk_fp8x4(s[0 * 65] * scale, s[1 * 65] * scale, s[2 * 65] * scale, s[3 * 65] * scale); o.y = pk_fp8x4(s[4 * 65] * scale, s[5 * 65] * scale, s[6 * 65] * scale, s[7 * 65] * scale);
            o.z = pk_fp8x4(s[8 * 65] * scale, s[9 * 65] * scale, s[10 * 65] * scale, s[11 * 65] * scale); o.w = pk_fp8x4(s[12 * 65] * scale, s[13 * 65] * scale, s[14 * 65] * scale, s[15 * 65] * scale);
            *(u32x4*)(d.dst + (size_t)(d.drow0 + n + (n >= 32 ? d.hi_skip : 0)) * d.dKb + 16 * c) = o; } }
    else { const int c = lane & 7;
#pragma unroll
        for (int j = 0; j < 8; ++j) { const int n = (lane >> 3) + 8 * j; const LAS float* s = scr + (8 * c) * 65 + n;
            u32x4 o; o.x = cvtpk(s[0 * 65], s[1 * 65]); o.y = cvtpk(s[2 * 65], s[3 * 65]); o.z = cvtpk(s[4 * 65], s[5 * 65]); o.w = cvtpk(s[6 * 65], s[7 * 65]);
            *(u32x4*)(d.dst + (size_t)(d.drow0 + n + (n >= 32 ? d.hi_skip : 0)) * d.dKb + 16 * c) = o; } }
    LDS_WAIT(); asm volatile("" ::: "memory");
}
constexpr int TR_I0 = 2 * 384, TR_I1 = 2 * 256, TR_I2 = 4 * 16, TR_I3 = 16 * 81, TR_I4 = 32 * 16, TR_I5 = 128 * 256, TR_I6 = 128 * 128, TR_ITOT = TR_I0 + TR_I1 + TR_I2 + TR_I3 + TR_I4 + TR_I5 + TR_I6;
__device__ __forceinline__ TrD tr_decode(const Args& a, int it) {
    TrD d; int r = it; d.hi_skip = 0;
    if (r < TR_I5) { const int m = r / 256, q = r % 256, kb = q / 16, nb = q % 16, n0 = nb * 64, j = n0 & 511;
        d.src = a.in[I_WGU] + (size_t)m * 1024 * 1024 + (size_t)kb * 64 * 1024 + n0; d.N = 1024; d.drow0 = 256 * (j >> 7) + (j & 127) + ((n0 >= 512) ? 128 : 0);
        d.fp8 = MOE_FP8; d.dKb = MOE_FP8 ? 1024 : 2048; d.dst = (unsigned char*)(a.ws + WS_WGU) + (size_t)m * 1024 * d.dKb + (size_t)kb * 64 * (MOE_FP8 ? 1 : 2); return d; }
    r -= TR_I5;
    if (r < TR_I6) { const int m = r / 128, q = r % 128, kb = q / 16, nb = q % 16;
        d.src = a.in[I_WDN] + (size_t)m * 512 * 1024 + (size_t)kb * 64 * 1024 + nb * 64; d.N = 1024; d.drow0 = nb * 64;
        d.fp8 = MOE_FP8; d.dKb = MOE_FP8 ? 512 : 1024; d.dst = (unsigned char*)(a.ws + WS_WDN) + (size_t)m * 1024 * d.dKb + (size_t)kb * 64 * (MOE_FP8 ? 1 : 2); return d; }
    r -= TR_I6;
    if (r < TR_I0) { const int m = r / 384, q = r % 384, kb = q / 24, nb = q % 24;
        d.src = a.in[I_WQKV] + (size_t)m * 1024 * 1536 + (size_t)kb * 64 * 1536 + nb * 64; d.N = 1536; d.drow0 = (nb >> 2) * 256 + (nb & 3) * 32; d.hi_skip = 96;
        d.fp8 = ATT_FP8; d.dKb = ATT_FP8 ? 1024 : 2048; d.dst = (unsigned char*)(a.ws + WS_WQKV) + (size_t)m * 1536 * d.dKb + (size_t)kb * 64 * (ATT_FP8 ? 1 : 2); return d; }
    r -= TR_I0;
    if (r < TR_I1) { const int m = r / 256, q = r % 256, kb = q / 16, nb = q % 16;
        d.src = a.in[I_WO] + (size_t)m * 1024 * 1024 + (size_t)kb * 64 * 1024 + nb * 64; d.N = 1024; d.drow0 = nb * 64;
        d.fp8 = ATT_FP8; d.dKb = ATT_FP8 ? 1024 : 2048; d.dst = (unsigned char*)(a.ws + WS_WO) + (size_t)m * 1024 * d.dKb + (size_t)kb * 64 * (ATT_FP8 ? 1 : 2); return d; }
    r -= TR_I1;
    d.fp8 = 0;
    if (r < TR_I2) { const int m = r / 16, q = r % 16, kb = q / 4, nb = q % 4;
        d.src = a.in[I_POOLW] + (size_t)m * 256 * 256 + (size_t)kb * 64 * 256 + nb * 64; d.N = 256; d.drow0 = nb * 64; d.dKb = 512; d.dst = (unsigned char*)(a.ws + WS_WPOOL) + (size_t)m * 256 * 512 + (size_t)kb * 128; return d; }
    r -= TR_I2;
    if (r < TR_I3) { const int kb = r / 81, nb = r % 81;
        d.src = a.in[I_WIN] + (size_t)kb * 64 * 5184 + nb * 64; d.N = 5184; d.drow0 = nb * 64; d.dKb = 2048; d.dst = (unsigned char*)(a.ws + WS_WIN) + (size_t)kb * 128; return d; }
    r -= TR_I3;
    { const int kb = r / 16, nb = r % 16;
        d.src = a.in[I_WOUT] + (size_t)kb * 64 * 1024 + nb * 64; d.N = 1024; d.drow0 = nb * 64; d.dKb = 4096; d.dst = (unsigned char*)(a.ws + WS_WOUT) + (size_t)kb * 128; return d; }
}
__device__ __forceinline__ void p0_prologue(const Args& a, const Ctx& c) {
    LAS float* scr = (LAS float*)(c.lds + c.wave * 16896);
    const int gw = c.vcu * NWAVES + c.wave, NGW = c.G * NWAVES;
    { f32x4 va[16], vb[16]; TrD da, db; int it = gw;
      da = tr_decode(a, it < TR_ITOT ? it : TR_ITOT - 1); tr_load(da, va, c.lane);
      while (it < TR_ITOT) {
          const int itB = it + NGW; db = tr_decode(a, itB < TR_ITOT ? itB : TR_ITOT - 1); tr_load(db, vb, c.lane);
          tr_store(da, va, scr, c.lane);
          if (itB >= TR_ITOT) break;
          const int itA = itB + NGW; da = tr_decode(a, itA < TR_ITOT ? itA : TR_ITOT - 1); tr_load(da, va, c.lane);
          tr_store(db, vb, scr, c.lane);
          it = itA; } }
    __syncthreads();
    LAS float* sv = (LAS float*)c.lds;
    LAS float* part = (LAS float*)(c.lds + 20480);
    for (int u = c.tid; u < 5 * 1024; u += NTHREADS) { const int v = u >> 10, k = u & 1023; const float x = v < 4 ? a.in[I_C][v * 1024 + k] : a.in[I_CCTX][k]; sv[u] = x / (1.0f + expf(-x)); }
    __syncthreads();
    for (int item = blockIdx.x; item < 4 * 64; item += c.G) {
        const int li = item >> 6, c0 = (item & 63) * 96, cq = c.tid % 24, ks = c.tid / 24;
        f32x4 acc[5];
#pragma unroll
        for (int v = 0; v < 5; ++v) acc[v] = (f32x4){0.f, 0.f, 0.f, 0.f};
        if (ks < 21) { const int kbeg = ks * 49, kend = (kbeg + 49) < 1024 ? (kbeg + 49) : 1024;
            const float* w = a.in[I_WADA] + ((size_t)li * 1024 + kbeg) * 6144 + c0 + 4 * cq;
#pragma unroll 7
            for (int k = kbeg; k < kend; ++k) { const f32x4 wv = *(const f32x4*)w; w += 6144;
#pragma unroll
                for (int v = 0; v < 5; ++v) acc[v] += wv * sv[v * 1024 + k]; }
#pragma unroll
            for (int v = 0; v < 5; ++v) *(LAS f32x4*)(part + (ks * 24 + cq) * 20 + v * 4) = acc[v]; }
        __syncthreads();
        if (c.tid < 480) { const int v = c.tid / 96, col = c.tid % 96, q = col >> 2, e = col & 3; float s = 0.f;
            for (int k2 = 0; k2 < 21; ++k2) s += part[(k2 * 24 + q) * 20 + v * 4 + e];
            s += a.in[I_BADA][li * 6144 + c0 + col];
            if (v < 4) ((float*)(a.ws + WS_MODL))[(size_t)(li * 4 + v) * 6144 + c0 + col] = s; else ((float*)(a.ws + WS_MODC))[(size_t)li * 6144 + c0 + col] = s; }
        __syncthreads();
    }
    if (blockIdx.x == (unsigned)(c.G - 1)) for (int u = c.tid; u < 1024; u += NTHREADS) { const int pos = u >> 4, f = u & 15;
        const float inv = (float)pow(10000.0, -(double)f / 16.0); const double ang = (double)((float)pos * inv);
        ((f32x2*)(a.ws + WS_ROPE))[u] = (f32x2){(float)cos(ang), (float)sin(ang)}; }
    for (int u = blockIdx.x * NTHREADS + c.tid; u < 4 * 64 * 1024; u += c.G * NTHREADS) { const int li = u >> 16, n = (u >> 10) & 63, k = u & 1023;
        float w = 0.f; if (n < 4) w = a.in[I_WRG][((size_t)li * 1024 + k) * 4 + n]; else if (n < 36) w = a.in[I_WRE][((size_t)li * 1024 + k) * 32 + (n - 4)];
        const unsigned hi = cvtpk(w, 0.f) & 0xffffu; const float rem = w - bflo(hi); const unsigned lo = cvtpk(rem, 0.f) & 0xffffu;
        bf16* wr = (bf16*)(a.ws + WS_WR) + (size_t)li * 2 * 65536; wr[n * 1024 + k] = (bf16)hi; wr[65536 + n * 1024 + k] = (bf16)lo; }
}

__device__ __forceinline__ void ph_rmix(const Args& a, const Ctx& c, int layer) {
    const int gw = c.vcu * NWAVES + c.wave, NGW = c.G * NWAVES;
    const float* g = a.in[I_NMIX] + layer * D;
    for (int r = gw; r < TT; r += NGW) {
        f32x4 v[4], h[4]; load_row_combined(a, layer, r, c.lane, v);
        if (layer > 0) { u32x2* xo = (u32x2*)((bf16*)(a.ws + WS_X) + (size_t)r * D) + c.lane;
#pragma unroll
            for (int j = 0; j < 4; ++j) xo[64 * j] = (u32x2){cvtpk(v[j].x, v[j].y), cvtpk(v[j].z, v[j].w)}; }
        const float rstd = row_rstd(v); const float* m = mod_row(a, layer, r);
        norm_mod(v, rstd, g, m, m + D, c.lane, h);
        if (ATT_FP8 && layer != 2) { unsigned* ho8 = (unsigned*)((unsigned char*)(a.ws + WS_HB) + (size_t)r * D) + c.lane;
#pragma unroll
            for (int j = 0; j < 4; ++j) ho8[64 * j] = pk_fp8x4(h[j].x, h[j].y, h[j].z, h[j].w); }
        else { u32x2* ho = (u32x2*)((bf16*)(a.ws + WS_HB) + (size_t)r * D) + c.lane;
#pragma unroll
            for (int j = 0; j < 4; ++j) ho[64 * j] = (u32x2){cvtpk(h[j].x, h[j].y), cvtpk(h[j].z, h[j].w)}; }
    }
}

__device__ __forceinline__ void ph_final(const Args& a, const Ctx& c, int layer) {
    const int gw = c.vcu * NWAVES + c.wave, NGW = c.G * NWAVES;
    float dscale = 1.f, dmark = 0.f;
#if DEBUG_CHECKS
    { unsigned* dbg = (unsigned*)(a.ws + WS_CTL) + CW_DBG; int code = 0; float mag = 0.f;
      for (int id = 1; id < 32; ++id) { const float e = __uint_as_float(__hip_atomic_load(dbg + id, __ATOMIC_RELAXED, __HIP_MEMORY_SCOPE_AGENT)); if (code == 0 && e > DBG_TOL) { code = id; mag = e; } }
      dscale = 1.f + (float)code; dmark = code ? 100.f * (1.f + fminf(fmaxf(log2f(mag / DBG_TOL), 0.f), 30.f)) : 0.f; }
#endif
    for (int r = gw; r < TL; r += NGW) {
        f32x4 v[4]; load_row_combined(a, layer, r, c.lane, v);
        const float rstd = row_rstd(v) * dscale;
        f32x4* o = (f32x4*)(a.out + (size_t)r * D) + c.lane;
#pragma unroll
        for (int j = 0; j < 4; ++j) { f32x4 ov = (v[j] * rstd) * ((const f32x4*)a.in[I_NFIN])[c.lane + 64 * j]; if (j == 0 && r == 0 && c.lane == 0 && dmark > 0.f) ov.x = dmark; o[64 * j] = ov; }
    }
}


namespace pg8 {
constexpr int BM = 256, BK = 64, HALF = 128, HTB = HALF * BK * 2, STAGE_BYTES = 8 * HTB;
__host__ __device__ __forceinline__ int lds_byte(int r, int c) { const int st = (r >> 4) * 2 + (c >> 5), rr = r & 15, cc = c & 31, ob = rr * 64 + cc * 2; return st * 1024 + (ob ^ (((ob >> 9) & 1) << 5)); }
__host__ __device__ __forceinline__ void stage_rc(int b, int& R, int& C) { const int st = b / 1024, sb = b % 1024, swz = sb ^ (((sb >> 9) & 1) << 5); R = (st >> 1) * 16 + swz / 64; C = (st & 1) * 32 + (swz % 64) / 2; }
__host__ __device__ __forceinline__ int perm32(int rho) { const int n = rho >> 4, i = rho & 15; return 8 * (i >> 2) + 4 * n + (i & 3); }
struct Unit { const char* A; const char* B; int pm, pn, x0, x1; };
__device__ __forceinline__ void tile_of(int L, int nM, int nN, int& pm, int& pn) {
    const int nwg = nM * nN; int wgid = L; { const int q = nwg / 8, r = nwg % 8, xcd = wgid % 8, off = wgid / 8; wgid = (xcd < r ? xcd * (q + 1) : r * (q + 1) + (xcd - r) * q) + off; }
    const int nig = 8 * nN, gid = wgid / nig, fm = gid * 8, gsz = (nM - fm) < 8 ? (nM - fm) : 8;
    pm = fm + ((wgid % nig) % gsz); pn = (wgid % nig) / gsz;
}
typedef int v4i_t __attribute__((ext_vector_type(4))); typedef int v8i_t __attribute__((ext_vector_type(8)));
template <class Epi, class Sched, bool GATHER, bool FP8 = false>
__device__ __forceinline__ void gemm_phase(LAS unsigned char* lds, const int Kb, const int ldab, const Sched& S, const Epi& E, const int scw = 127, const int sca = 127) {
    const int tid = tid_opaque(), wid = __builtin_amdgcn_readfirstlane(tid >> 6), lane = tid & 63, wr = wid >> 2, wc = wid & 3, fr = lane & 15, fq = lane >> 4;
    const int nt = Kb / (BK * 2);
    int scw_v = scw, sca_v = sca;
    unsigned voffA[2], voffB[2]; int RA[2], CA[2];
#pragma unroll
    for (int i = 0; i < 2; ++i) { int R, C; stage_rc(tid * 16 + i * 8192, R, C); const int Rb = Epi::PERM ? ((R & ~31) + perm32(R & 31)) : R;
        RA[i] = R; CA[i] = C; voffA[i] = (unsigned)(R * ldab + C * 2); voffB[i] = (unsigned)(Rb * Kb + C * 2); }
    const size_t kstep = (size_t)(BK * 2);
    const size_t hstepA = (size_t)HALF * ldab, hstepB = (size_t)HALF * Kb;
    const unsigned ldsw = (unsigned)wid * 1024u;
    const int aoff = lds_byte(wr * 64 + fr, fq * 8), boff = lds_byte(wc * 32 + fr, fq * 8);
#define PG8_SA(b, h) (((b) * 2 + (h)) * HTB)
#define PG8_SB(b, h) ((4 + (b) * 2 + (h)) * HTB)
#define PG8_GLDS(bufoff, gptr, i_) __builtin_amdgcn_global_load_lds((const unsigned*)(gptr), (LAS unsigned*)(lds + (bufoff) + ldsw + (i_) * 8192), 16, 0, 0)
#define PG8_STAGE_B(bufoff, gbase) do { _Pragma("unroll") for (int _i = 0; _i < 2; ++_i) PG8_GLDS(bufoff, (const char*)(gbase) + voffB[_i], _i); } while (0)
#define PG8_STAGE_A(bufoff, ab, kb, h, NX) do { _Pragma("unroll") for (int _i = 0; _i < 2; ++_i) { \
        if constexpr (GATHER) { const unsigned _vo = (NX) ? voN[h][_i] : voC[h][_i]; PG8_GLDS(bufoff, (ab) + (kb) + _vo, _i); } \
        else { PG8_GLDS(bufoff, (ab) + (kb) + (size_t)(h) * hstepA + voffA[_i], _i); } } } while (0)
#define PG8_LDA(dst, b, h) do { _Pragma("unroll") for (int m = 0; m < 4; ++m) _Pragma("unroll") for (int k = 0; k < 2; ++k) dst[m][k] = *(const LAS bf16x8*)(lds + PG8_SA(b, h) + aoff + m * 2048 + k * 1024); } while (0)
#define PG8_LDB(dst, b, h) do { _Pragma("unroll") for (int n = 0; n < 2; ++n) _Pragma("unroll") for (int k = 0; k < 2; ++k) dst[n][k] = *(const LAS bf16x8*)(lds + PG8_SB(b, h) + boff + n * 2048 + k * 1024); } while (0)
#define PG8_MMA(ai, bj, At, Bt) do { __builtin_amdgcn_s_setprio(1); _Pragma("unroll") for (int m = 0; m < 4; ++m) _Pragma("unroll") for (int n = 0; n < 2; ++n) { \
        if constexpr (FP8) { const v8i_t b8 = __builtin_shufflevector(__builtin_bit_cast(v4i_t, Bt[n][0]), __builtin_bit_cast(v4i_t, Bt[n][1]), 0, 1, 2, 3, 4, 5, 6, 7), a8 = __builtin_shufflevector(__builtin_bit_cast(v4i_t, At[m][0]), __builtin_bit_cast(v4i_t, At[m][1]), 0, 1, 2, 3, 4, 5, 6, 7); \
            asm volatile("v_mfma_scale_f32_16x16x128_f8f6f4 %0, %1, %2, %0, %3, %4 op_sel_hi:[0,0,0]" : "+v"(acc[ai][bj][m][n]) : "v"(b8), "v"(a8), "v"(scw_v), "v"(sca_v)); } \
        else { _Pragma("unroll") for (int k = 0; k < 2; ++k) acc[ai][bj][m][n] = __builtin_amdgcn_mfma_f32_16x16x32_bf16(Bt[n][k], At[m][k], acc[ai][bj][m][n], 0, 0, 0); } } __builtin_amdgcn_s_setprio(0); } while (0)
#define PG8_WAIT_V(n) asm volatile("s_waitcnt vmcnt(" #n ")" ::: "memory")
#define PG8_WAIT_L(n) asm volatile("s_waitcnt lgkmcnt(" #n ")" ::: "memory")
#define PG8_BAR __builtin_amdgcn_s_barrier()
#define PG8_SCHED __builtin_amdgcn_sched_barrier(0)
    Unit cur, nxt, pend; int ui = 0; bool have_pend = false;
    if (!S.next(0, cur)) return;
    pend = cur;
    unsigned voC[2][2], voN[2][2];
    if constexpr (GATHER) {
#pragma unroll
        for (int h = 0; h < 2; ++h)
#pragma unroll
            for (int i = 0; i < 2; ++i) { voC[h][i] = (unsigned)(S.gather(cur, h * HALF + RA[i]) * ldab + CA[i] * 2); voN[h][i] = voC[h][i]; }
    } else { voC[0][0] = voN[0][0] = 0u; }
    f32x4 acc[2][2][4][2];
#pragma unroll
    for (int a = 0; a < 2; ++a)
#pragma unroll
        for (int b = 0; b < 2; ++b)
#pragma unroll
            for (int m = 0; m < 4; ++m)
#pragma unroll
                for (int n = 0; n < 2; ++n) acc[a][b][m][n] = (f32x4){0.f, 0.f, 0.f, 0.f};
    bf16x8 At[4][2], B0[2][2], B1[2][2];
    const char* cA = cur.A; const char* cB = cur.B;
    S.a_ready(cur, wid);
    PG8_STAGE_B(PG8_SB(0, 0), cB); PG8_STAGE_B(PG8_SB(0, 1), cB + hstepB); PG8_STAGE_A(PG8_SA(0, 0), cA, (size_t)0, 0, false); PG8_STAGE_A(PG8_SA(0, 1), cA, (size_t)0, 1, false);
    if (wr == 1) PG8_BAR;
    PG8_WAIT_V(2); PG8_BAR;
    PG8_STAGE_B(PG8_SB(1, 0), cB + kstep); PG8_STAGE_A(PG8_SA(1, 0), cA, kstep, 0, false); PG8_STAGE_B(PG8_SB(1, 1), cB + hstepB + kstep);
    PG8_WAIT_V(6); PG8_BAR;
    for (;;) {
        const bool has_next = S.next(ui + 1, nxt);
        if constexpr (GATHER) { if (has_next) {
#pragma unroll
            for (int h = 0; h < 2; ++h)
#pragma unroll
                for (int i = 0; i < 2; ++i) voN[h][i] = (unsigned)(S.gather(nxt, h * HALF + RA[i]) * ldab + CA[i] * 2); } }
        const char* nA = has_next ? nxt.A : cA; const char* nB = has_next ? nxt.B : cB;
        for (int t = 0; t < nt; t += 2) {
            const bool last = (t == nt - 2);
            const size_t k1 = (size_t)(t + 1) * kstep;
            const char* a2 = last ? nA : cA; const size_t k2 = last ? (size_t)0 : (size_t)(t + 2) * kstep; const size_t k3 = k2 + kstep;
            const char* b2 = last ? nB : cB + (size_t)(t + 2) * kstep; const char* b3 = b2 + kstep;
            const bool nx = GATHER ? (last && has_next) : false;
            if (last && has_next) S.a_ready(nxt, wid);
            PG8_LDB(B0, 0, 0); PG8_LDB(B1, 0, 1); PG8_SCHED; PG8_LDA(At, 0, 0); PG8_STAGE_A(PG8_SA(1, 1), cA, k1, 1, false);
            PG8_WAIT_V(8); PG8_WAIT_L(0); PG8_BAR; PG8_MMA(0, 0, At, B0); PG8_MMA(0, 1, At, B1); PG8_BAR; PG8_SCHED;
            PG8_LDA(At, 0, 1); PG8_STAGE_B(PG8_SB(0, 0), b2); PG8_STAGE_B(PG8_SB(0, 1), b2 + hstepB); PG8_STAGE_A(PG8_SA(0, 0), a2, k2, 0, nx);
            PG8_WAIT_V(8); PG8_WAIT_L(0);
            if constexpr (!Sched::IMM_DONE) { if (have_pend) { S.done(pend, lane); have_pend = false; } }
            PG8_BAR; PG8_MMA(1, 0, At, B0); PG8_MMA(1, 1, At, B1); PG8_BAR; PG8_SCHED;
            PG8_LDB(B0, 1, 0); PG8_LDB(B1, 1, 1); PG8_SCHED; PG8_LDA(At, 1, 0); PG8_STAGE_A(PG8_SA(0, 1), a2, k2, 1, nx);
            PG8_WAIT_V(8); PG8_WAIT_L(0); PG8_BAR; PG8_MMA(0, 0, At, B0); PG8_MMA(0, 1, At, B1); PG8_BAR; PG8_SCHED;
            PG8_LDA(At, 1, 1); PG8_STAGE_B(PG8_SB(1, 0), b3); PG8_STAGE_B(PG8_SB(1, 1), b3 + hstepB); PG8_STAGE_A(PG8_SA(1, 0), a2, k3, 0, nx);
            PG8_WAIT_V(8); PG8_WAIT_L(0); PG8_BAR; PG8_MMA(1, 0, At, B0); PG8_MMA(1, 1, At, B1); PG8_BAR; PG8_SCHED;
        }
        if (wr == 0) PG8_BAR;
        if constexpr (FP8) asm volatile("s_nop 15\n\ts_nop 15" ::: "memory");
        E(acc, cur, wr, wc, fr, fq);
        if constexpr (Sched::IMM_DONE) { PG8_WAIT_V(0); S.done(cur, lane); }
        else { pend = cur; have_pend = true; }
        if (!has_next) break;
#pragma unroll
        for (int a = 0; a < 2; ++a)
#pragma unroll
            for (int b = 0; b < 2; ++b)
#pragma unroll
                for (int m = 0; m < 4; ++m)
#pragma unroll
                    for (int n = 0; n < 2; ++n) acc[a][b][m][n] = (f32x4){0.f, 0.f, 0.f, 0.f};
        cur = nxt; cA = nA; cB = nB; ++ui;
        if constexpr (GATHER) {
#pragma unroll
            for (int h = 0; h < 2; ++h)
#pragma unroll
                for (int i = 0; i < 2; ++i) voC[h][i] = voN[h][i]; }
        if (wr == 1) PG8_BAR;
    }
    PG8_WAIT_V(0);
    if constexpr (!Sched::IMM_DONE) { if (have_pend) S.done(pend, lane); }
    PG8_BAR;
#undef PG8_SA
#undef PG8_SB
#undef PG8_GLDS
#undef PG8_STAGE_A
#undef PG8_STAGE_B
#undef PG8_LDA
#undef PG8_LDB
#undef PG8_MMA
#undef PG8_WAIT_V
#undef PG8_WAIT_L
#undef PG8_BAR
#undef PG8_SCHED
}
}
#include <hip/hip_bf16.h>
#include <cmath>
namespace attn_body {
using bf16=__hip_bfloat16;
using bf16x8=__attribute__((ext_vector_type(8)))short;
using s16x4=__attribute__((ext_vector_type(4)))short;
using f32x16=__attribute__((ext_vector_type(16)))float;
using u32x4=__attribute__((ext_vector_type(4)))unsigned;
constexpr int D=64,QP=1024,KVP=256;
constexpr int NW=8,QBLK=32,QB=QBLK*NW,KVBLK=64;
__device__ __forceinline__ int crow(int r,int hi){return (r&3)+8*(r>>2)+4*hi;}
#define SBAR() __builtin_amdgcn_sched_barrier(0)
constexpr int NSLOT=3, SLOTB=8192;
constexpr int LDS_K=0, LDS_V=NSLOT*SLOTB, LDS_WS=2*NSLOT*SLOTB, LDS_OST=LDS_WS+NW*64*4, LDS_BYTES=LDS_OST+NW*4096;
constexpr float C2=0.125f*1.4426950408889634f;
__device__ __forceinline__ void glds16s(const void*sbase,unsigned voff,unsigned lds_dst){unsigned keep;
  asm volatile("s_mov_b32 %0, m0\n\ts_mov_b32 m0, %3\n\ts_nop 4\n\tglobal_load_lds_dwordx4 %1, %2\n\ts_mov_b32 m0, %0":"=&s"(keep):"v"(voff),"s"(sbase),"s"(lds_dst):"memory");}
__device__ __forceinline__ float max3f(float a,float b,float c){float r;asm("v_max3_f32 %0, %1, %2, %3":"=v"(r):"v"(a),"v"(b),"v"(c));return r;}
__device__ __forceinline__ float max2f(float a,float b){float r;asm("v_max_f32_e32 %0, %1, %2":"=v"(r):"v"(a),"v"(b));return r;}
__device__ __forceinline__ float fadd_s(float a,float b){float r;asm("v_add_f32_e32 %0, %1, %2":"=v"(r):"v"(a),"v"(b));return r;}
__device__ __forceinline__ float fsub_s(float a,float b){float r;asm("v_sub_f32_e32 %0, %1, %2":"=v"(r):"v"(a),"v"(b));return r;}
typedef float f32x2_t __attribute__((ext_vector_type(2))); typedef __bf16 bf16x2_t __attribute__((ext_vector_type(2)));
__device__ __forceinline__ unsigned cvtpk_s(float lo,float hi){f32x2_t v={lo,hi};bf16x2_t b=__builtin_convertvector(v,bf16x2_t);return __builtin_bit_cast(unsigned,b);}
#define WAIT_BAR(N) asm volatile("s_waitcnt vmcnt(" #N ") lgkmcnt(0)\n\ts_barrier":::"memory")

__device__ __forceinline__ void qkt(f32x16&p0,f32x16&p1,const char*Kslot,const bf16x8*qr,const f32x16&negm,int r32,int hi){
  const char*kb=Kslot+hi*1024+r32*16;
  #pragma unroll
  for(int d0=0;d0<4;++d0){
    const bf16x8 b0=*reinterpret_cast<const bf16x8*>(kb+d0*2048);
    const bf16x8 b1=*reinterpret_cast<const bf16x8*>(kb+d0*2048+512);
    if(d0==0){p0=__builtin_amdgcn_mfma_f32_32x32x16_bf16(b0,qr[0],negm,0,0,0);p1=__builtin_amdgcn_mfma_f32_32x32x16_bf16(b1,qr[0],negm,0,0,0);}
    else{p0=__builtin_amdgcn_mfma_f32_32x32x16_bf16(b0,qr[d0],p0,0,0,0);p1=__builtin_amdgcn_mfma_f32_32x32x16_bf16(b1,qr[d0],p1,0,0,0);}}
}
typedef __attribute__((address_space(3))) const char* lds_cptr;
typedef short v4i16_t __attribute__((ext_vector_type(4)));
__device__ __forceinline__ void kload8(bf16x8*kf,lds_cptr kp){
  kf[0]=*(const __attribute__((address_space(3))) bf16x8*)(kp);      kf[1]=*(const __attribute__((address_space(3))) bf16x8*)(kp+512);
  kf[2]=*(const __attribute__((address_space(3))) bf16x8*)(kp+2048); kf[3]=*(const __attribute__((address_space(3))) bf16x8*)(kp+2560);
  kf[4]=*(const __attribute__((address_space(3))) bf16x8*)(kp+4096); kf[5]=*(const __attribute__((address_space(3))) bf16x8*)(kp+4608);
  kf[6]=*(const __attribute__((address_space(3))) bf16x8*)(kp+6144); kf[7]=*(const __attribute__((address_space(3))) bf16x8*)(kp+6656);
}
__device__ __forceinline__ void kload2(bf16x8*kf,lds_cptr kp,int j){ kf[2*j]=*(const __attribute__((address_space(3))) bf16x8*)(kp+j*2048); kf[2*j+1]=*(const __attribute__((address_space(3))) bf16x8*)(kp+j*2048+512); }
__device__ __forceinline__ s16x4 vtr(lds_cptr p){ return __builtin_bit_cast(s16x4,__builtin_amdgcn_ds_read_tr16_b64_v4i16((__attribute__((address_space(3))) v4i16_t*)p)); }
__device__ __forceinline__ float rowmax(const f32x16&p0,const f32x16&p1){
  float a=max3f(p0[0],p0[1],p1[0]),b=max3f(p0[2],p0[3],p1[1]);a=max3f(a,p1[2],p1[3]);
  #pragma unroll
  for(int r=4;r<16;r+=4){a=max3f(a,p0[r],p0[r+1]);b=max3f(b,p0[r+2],p0[r+3]);a=max3f(a,p1[r],p1[r+1]);b=max3f(b,p1[r+2],p1[r+3]);}
  const float m=max2f(a,b);
  auto rr=__builtin_amdgcn_permlane32_swap(__float_as_uint(m),__float_as_uint(m),false,false);
  return max2f(__uint_as_float(rr[0]),__uint_as_float(rr[1]));
}
__device__ __forceinline__ void pv(f32x16*o,int vb,bf16x8 pa0,bf16x8 pa1,bf16x8 pa2,bf16x8 pa3){
  #pragma unroll
  for(int d0=0;d0<2;++d0){s16x4 lo[4],hi[4];
    #pragma unroll
    for(int ks=0;ks<4;++ks){
      asm volatile("ds_read_b64_tr_b16 %0,%1 offset:%c2":"=&v"(lo[ks]):"v"(vb),"i"(d0*4096+ks*1024):"memory");
      asm volatile("ds_read_b64_tr_b16 %0,%1 offset:%c2":"=&v"(hi[ks]):"v"(vb),"i"(d0*4096+ks*1024+512):"memory");}
    asm volatile("s_waitcnt lgkmcnt(0)":::"memory");SBAR();
    #define PK(k) (bf16x8){lo[k][0],lo[k][1],lo[k][2],lo[k][3],hi[k][0],hi[k][1],hi[k][2],hi[k][3]}
    o[d0]=__builtin_amdgcn_mfma_f32_32x32x16_bf16(pa0,PK(0),o[d0],0,0,0);
    o[d0]=__builtin_amdgcn_mfma_f32_32x32x16_bf16(pa1,PK(1),o[d0],0,0,0);
    o[d0]=__builtin_amdgcn_mfma_f32_32x32x16_bf16(pa2,PK(2),o[d0],0,0,0);
    o[d0]=__builtin_amdgcn_mfma_f32_32x32x16_bf16(pa3,PK(3),o[d0],0,0,0);
    #undef PK
  }
}

#ifndef ATTN_STORE16
#define ATTN_STORE16(p,v) (*(u32x4*)(p)=(v))
#endif
template<int THRL> __device__ __forceinline__ void attn_unit(long qrow0,int h,long kvrow0,int NT,const bf16*Q,const bf16*__restrict__ K,const bf16*__restrict__ V,bf16*O,char*shm){
  const int tid=tid_opaque(),lane=tid&63,r32=lane&31,hi=lane>>5; const int wid=__builtin_amdgcn_readfirstlane(tid>>6);
  const bf16*Qw=Q+(qrow0+wid*QBLK)*QP+h*D;
  const bf16*Kh=K+kvrow0*KVP+(h>>2)*D,*Vh=V+kvrow0*KVP+(h>>2)*D;
  const unsigned lds0=(unsigned)(uintptr_t)shm;
  float*wsf=(float*)(shm+LDS_WS)+wid*64;
  const unsigned kvo=(unsigned)(lane*KVP+wid*8)*2u;
  const unsigned vvo=(unsigned)((16*(wid&3)+(lane>>2))*KVP+(wid>>2)*32+(lane&3)*8)*2u;
  const unsigned kdst=lds0+LDS_K+wid*1024, vdst=lds0+LDS_V+wid*1024;
  #define DMA_K(t,slot) glds16s(Kh+(long)(t)*KVBLK*KVP,kvo,(unsigned)__builtin_amdgcn_readfirstlane(kdst+(slot)))
  #define DMA_V(t,slot) glds16s(Vh+(long)(t)*KVBLK*KVP,vvo,(unsigned)__builtin_amdgcn_readfirstlane(vdst+(slot)))
  const int vb0=(int)(lds0+LDS_V)+((lane>>4)&1)*32+(lane&3)*8+(4*hi+((lane&15)>>2))*64;
  const char*Kbase=shm+LDS_K; bf16x8 kf[8];
  const lds_cptr shm3=(lds_cptr)shm; const lds_cptr kp0=shm3+LDS_K+hi*1024+r32*16; const lds_cptr vp0=shm3+LDS_V+((lane>>4)&1)*32+(lane&3)*8+(4*hi+((lane&15)>>2))*64;
  DMA_K(0,0);DMA_V(0,0);DMA_K(1,SLOTB);
  bf16x8 qr[4];
  #pragma unroll
  for(int d0=0;d0<4;++d0)qr[d0]=*reinterpret_cast<const bf16x8*>(&Qw[(long)r32*QP+d0*16+hi*8]);
  float mhat=0.f,l_reg=0.f;f32x16 o[2];o[0]=f32x16{};o[1]=f32x16{};f32x16 negm=f32x16{};asm volatile("":"+v"(negm));
  #define CMASK(P0,P1,t) do{}while(0)
  bool resc=false;
  #define START(P0,P1) do{ const float rm=rowmax(P0,P1); resc=false; \
    { const float dl=rm; mhat=fadd_s(mhat,dl); \
      _Pragma("unroll") for(int r=0;r<16;++r){P0[r]=fsub_s(P0[r],dl);P1[r]=fsub_s(P1[r],dl);} \
      _Pragma("unroll") for(int r=0;r<16;++r)negm[r]=-mhat; asm volatile("":"+v"(negm)); } \
    _Pragma("unroll") for(int r=0;r<16;++r)P0[r]=__builtin_amdgcn_exp2f(P0[r]); }while(0)
  #define RESC() do{ if(resc){ asm volatile("s_waitcnt lgkmcnt(0)":::"memory"); \
      _Pragma("unroll") for(int d_=0;d_<2;++d_) _Pragma("unroll") for(int r=0;r<16;++r)o[d_][r]*=wsf[crow(r,hi)]; } }while(0)
  f32x16 pA0,pA1,pB0,pB1;
  int sl_prev=0,sl_cur=0,sl_next=SLOTB;
  #define ROT() do{sl_prev=sl_cur;sl_cur=sl_next;sl_next=(sl_next==(NSLOT-1)*SLOTB)?0:sl_next+SLOTB;}while(0)
  DMA_K(2,2*SLOTB);
  WAIT_BAR(3);
  qkt(pA0,pA1,Kbase,qr,negm,r32,hi);asm volatile("s_nop 15\n\ts_nop 7":"+v"(pA0),"+v"(pA1));CMASK(pA0,pA1,0);
  START(pA0,pA1);
  _Pragma("unroll") for(int r=0;r<16;++r)pA1[r]=__builtin_amdgcn_exp2f(pA1[r]);
  WAIT_BAR(0);
  DMA_K(3,0);DMA_V(1,SLOTB);
  ROT();
  kload8(kf,kp0+sl_cur);
  WAIT_BAR(2);
  s16x4 vlo[8],vhi[8]; u32x4 pw0,pw1,pw2,pw3;
  #define PKW(P,B) cvtpk_s(P[B],P[B+1])
  #define PAF(k) __builtin_bit_cast(bf16x8,pw##k)
  #define VFR(i) (bf16x8){vlo[i][0],vlo[i][1],vlo[i][2],vlo[i][3],vhi[i][0],vhi[i][1],vhi[i][2],vhi[i][3]}
  #define PIN(x) asm volatile("":"+v"(x))
  #define MX3(a,b,c) __builtin_fmaxf(__builtin_fmaxf((a),(b)),(c))
  #define GAPA(MF,A0,A1,A2,A3,W0,W1,PW) do{ MF; sacc+=A0; sacc+=A1; sacc+=A2; sacc+=A3; PIN(sacc); W0; W1; PIN(PW); SBAR(); }while(0)
  #define EX(v) __builtin_amdgcn_exp2f(v)
  #define GAPB(MF,X,B) do{ MF; X[B]=EX(X[B]); X[B+1]=EX(X[B+1]); X[B+2]=EX(X[B+2]); X[B+3]=EX(X[B+3]); PIN(X); SBAR(); }while(0)
  #define VRD(i) do{ vlo[i]=vtr(vp_+(((i)>>2)*4096+((i)&3)*1024)); vhi[i]=vtr(vp_+(((i)>>2)*4096+((i)&3)*1024+512)); }while(0)
  #define KRD(G,j) do{ if(G){ kload2(kf,kp0+sl_next,j); SBAR(); } }while(0)
  #define STEP(C0,C1,P0,P1,t,GK,GV,GL) do{ SBAR(); \
    const lds_cptr vp_=vp0+sl_prev; \
    VRD(0); SBAR(); float sacc=(P0[0]+P0[1]); \
    GAPA(C0=__builtin_amdgcn_mfma_f32_32x32x16_bf16(kf[0],qr[0],negm,0,0,0), P0[2],P0[3],P0[4],P0[5],     pw0[0]=PKW(P0,0), pw0[1]=PKW(P0,2), pw0); \
    VRD(4); SBAR(); GAPA(C1=__builtin_amdgcn_mfma_f32_32x32x16_bf16(kf[1],qr[0],negm,0,0,0), P0[6],P0[7],P0[8],P0[9],     pw0[2]=PKW(P0,4), pw0[3]=PKW(P0,6), pw0); \
    VRD(1); SBAR(); GAPA(C0=__builtin_amdgcn_mfma_f32_32x32x16_bf16(kf[2],qr[1],C0,0,0,0),   P0[10],P0[11],P0[12],P0[13], pw1[0]=PKW(P0,8), pw1[1]=PKW(P0,10), pw1); \
    VRD(5); SBAR(); GAPA(C1=__builtin_amdgcn_mfma_f32_32x32x16_bf16(kf[3],qr[1],C1,0,0,0),   P0[14],P0[15],P1[0],P1[1],   pw1[2]=PKW(P0,12),pw1[3]=PKW(P0,14), pw1); \
    VRD(2); SBAR(); GAPA(C0=__builtin_amdgcn_mfma_f32_32x32x16_bf16(kf[4],qr[2],C0,0,0,0),   P1[2],P1[3],P1[4],P1[5],     pw2[0]=PKW(P1,0), pw2[1]=PKW(P1,2), pw2); \
    VRD(6); SBAR(); GAPA(C1=__builtin_amdgcn_mfma_f32_32x32x16_bf16(kf[5],qr[2],C1,0,0,0),   P1[6],P1[7],P1[8],P1[9],     pw2[2]=PKW(P1,4), pw2[3]=PKW(P1,6), pw2); \
    VRD(3); SBAR(); GAPA(C0=__builtin_amdgcn_mfma_f32_32x32x16_bf16(kf[6],qr[3],C0,0,0,0),   P1[10],P1[11],P1[12],P1[13], pw3[0]=PKW(P1,8), pw3[1]=PKW(P1,10), pw3); \
    VRD(7); SBAR(); GAPA(C1=__builtin_amdgcn_mfma_f32_32x32x16_bf16(kf[7],qr[3],C1,0,0,0),   P1[14],P1[15],0.f,0.f,       pw3[2]=PKW(P1,12),pw3[3]=PKW(P1,14), pw3); \
    l_reg+=sacc; \
    if(GK){DMA_K((t)+3,sl_cur);} if(GV){DMA_V((t)+1,sl_next);} \
    CMASK(C0,C1,t); \
    { float a=MX3(C0[0],C0[1],C1[0]),b=MX3(C0[2],C0[3],C1[1]); a=MX3(a,C1[2],C1[3]); \
      _Pragma("unroll") for(int r=4;r<16;r+=4){a=MX3(a,C0[r],C0[r+1]);b=MX3(b,C0[r+2],C0[r+3]);a=MX3(a,C1[r],C1[r+1]);b=MX3(b,C1[r+2],C1[r+3]);} \
      float rm=__builtin_fmaxf(a,b); { auto rr=__builtin_amdgcn_permlane32_swap(__float_as_uint(rm),__float_as_uint(rm),false,false); rm=__builtin_fmaxf(__uint_as_float(rr[0]),__uint_as_float(rr[1])); } \
      resc=false; \
      if(__builtin_expect(__any(rm>(float)THRL),0)){ const float dl=__builtin_fmaxf(rm,0.f); mhat+=dl; \
        _Pragma("unroll") for(int r=0;r<16;++r){C0[r]-=dl;C1[r]-=dl;} \
        _Pragma("unroll") for(int r=0;r<16;++r)negm[r]=-mhat; asm volatile("":"+v"(negm)); \
        const float f=__builtin_amdgcn_exp2f(-dl); l_reg*=f; if(hi==0)wsf[r32]=f; resc=true; } } \
    SBAR(); \
    GAPB(o[0]=__builtin_amdgcn_mfma_f32_32x32x16_bf16(PAF(0),VFR(0),o[0],0,0,0), C0,0); \
    GAPB(o[1]=__builtin_amdgcn_mfma_f32_32x32x16_bf16(PAF(0),VFR(4),o[1],0,0,0), C0,4); \
    KRD(GL,0); GAPB(o[0]=__builtin_amdgcn_mfma_f32_32x32x16_bf16(PAF(1),VFR(1),o[0],0,0,0), C0,8); \
    KRD(GL,1); GAPB(o[1]=__builtin_amdgcn_mfma_f32_32x32x16_bf16(PAF(1),VFR(5),o[1],0,0,0), C0,12); \
    KRD(GL,2); GAPB(o[0]=__builtin_amdgcn_mfma_f32_32x32x16_bf16(PAF(2),VFR(2),o[0],0,0,0), C1,0); \
    KRD(GL,3); GAPB(o[1]=__builtin_amdgcn_mfma_f32_32x32x16_bf16(PAF(2),VFR(6),o[1],0,0,0), C1,4); \
    GAPB(o[0]=__builtin_amdgcn_mfma_f32_32x32x16_bf16(PAF(3),VFR(3),o[0],0,0,0), C1,8); \
    GAPB(o[1]=__builtin_amdgcn_mfma_f32_32x32x16_bf16(PAF(3),VFR(7),o[1],0,0,0), C1,12); \
    }while(0)
  int t=1;
  for(;t+5<NT;t+=2){
    STEP(pB0,pB1,pA0,pA1,t,true,true,true);     WAIT_BAR(2); RESC(); ROT();
    STEP(pA0,pA1,pB0,pB1,t+1,true,true,true);   WAIT_BAR(2); RESC(); ROT();
  }
  #define ENDW(tt) do{ if((tt)+3<NT){WAIT_BAR(2);} else if((tt)+2<NT){WAIT_BAR(1);} else {WAIT_BAR(0);} }while(0)
  for(;t+1<NT;t+=2){
    STEP(pB0,pB1,pA0,pA1,t,(t+3<NT),(t+1<NT),(t+1<NT));       ENDW(t);   RESC(); ROT();
    STEP(pA0,pA1,pB0,pB1,t+1,(t+4<NT),(t+2<NT),(t+2<NT));     ENDW(t+1); RESC(); ROT();
  }
  STEP(pB0,pB1,pA0,pA1,NT-1,false,false,false); RESC();
  { float sacc=pB0[0]+pB0[1]; _Pragma("unroll") for(int r=2;r<16;++r)sacc+=pB0[r]; _Pragma("unroll") for(int r=0;r<16;++r)sacc+=pB1[r]; l_reg+=sacc;
    pw0=(u32x4){PKW(pB0,0),PKW(pB0,2),PKW(pB0,4),PKW(pB0,6)};pw1=(u32x4){PKW(pB0,8),PKW(pB0,10),PKW(pB0,12),PKW(pB0,14)};pw2=(u32x4){PKW(pB1,0),PKW(pB1,2),PKW(pB1,4),PKW(pB1,6)};pw3=(u32x4){PKW(pB1,8),PKW(pB1,10),PKW(pB1,12),PKW(pB1,14)};
    SBAR(); pv(o,vb0+sl_cur,PAF(0),PAF(1),PAF(2),PAF(3)); }
  #undef PKW
  #undef PAF
  #undef VFR
  #undef PIN
  #undef MX3
  #undef GAPA
  #undef GAPB
  #undef EX
  #undef VRD
  #undef KRD
  #undef STEP
  #undef ENDW
  {auto rr=__builtin_amdgcn_permlane32_swap(__float_as_uint(l_reg),__float_as_uint(l_reg),false,false);l_reg=__uint_as_float(rr[0])+__uint_as_float(rr[1]);}
  if(hi==0)wsf[32+r32]=l_reg;asm volatile("s_waitcnt lgkmcnt(0)":::"memory");
  float rli[16];
  #pragma unroll
  for(int r=0;r<16;++r)rli[r]=__builtin_amdgcn_rcpf(wsf[32+crow(r,hi)]);
#if ATT_FP8
  { unsigned char*Ow8=(unsigned char*)O+(qrow0+wid*QBLK)*QP+h*D;
    unsigned char*stg8=(unsigned char*)(shm+LDS_OST)+wid*4096;
    #pragma unroll
    for(int r=0;r<16;++r){const int orow=crow(r,hi);
      #pragma unroll
      for(int d0=0;d0<2;++d0){const float x=o[d0][r]*rli[r]*(float)(1<<ATT_OSH); stg8[orow*64+d0*32+r32]=(unsigned char)(__builtin_amdgcn_cvt_pk_fp8_f32(x,x,0u,false)&0xffu);}}
    asm volatile("s_waitcnt lgkmcnt(0)":::"memory");
    #pragma unroll
    for(int i=0;i<2;++i){const int row=i*16+(lane>>2),ch=lane&3; const u32x4 v=*(const u32x4*)(stg8+row*64+ch*16); ATTN_STORE16(Ow8+(long)row*QP+ch*16,v);} }
#else
  bf16*Ow=O+(qrow0+wid*QBLK)*QP+h*D;
  { bf16*stg=(bf16*)(shm+LDS_OST)+wid*2048;
    #pragma unroll
    for(int r=0;r<16;++r){const int orow=crow(r,hi);
      #pragma unroll
      for(int d0=0;d0<2;++d0)stg[orow*64+d0*32+r32]=__float2bfloat16(o[d0][r]*rli[r]);}
    asm volatile("s_waitcnt lgkmcnt(0)":::"memory");
    #pragma unroll
    for(int i=0;i<4;++i){const int row=i*8+(lane>>3),ch=lane&7; const u32x4 v=*(const u32x4*)(stg+row*64+ch*8); ATTN_STORE16(Ow+(long)row*QP+ch*8,v);} }
#endif
  asm volatile("s_waitcnt lgkmcnt(0)\n\ts_barrier":::"memory");
  #undef DMA_K
  #undef DMA_V
  #undef CMASK
  #undef START
  #undef RESC
  #undef ROT
}
constexpr int ATTN_LDS_BYTES=LDS_BYTES;
#undef SBAR
#undef WAIT_BAR
}

typedef f32x4 AccT[2][2][4][2];
__device__ __forceinline__ long kv_row(int r) { return r < TL ? (long)(r / SEQ) * KVROWS + CTXL + (r % SEQ) : (long)((r - TL) / CTXL) * KVROWS + ((r - TL) % CTXL); }

struct SchedDense {
    static constexpr bool IMM_DONE = false;
    const char* A; const char* B; size_t astep, bstep, acol; int nM, nN, G, c;
    __device__ __forceinline__ bool next(int i, pg8::Unit& u) const {
        const int L = i * G + c; if (L >= nM * nN) return false;
        pg8::tile_of(L, nM, nN, u.pm, u.pn); u.A = A + (size_t)u.pm * astep + (size_t)u.pn * acol; u.B = B + (size_t)u.pn * bstep; u.x0 = 0; u.x1 = 0; return true; }
    __device__ __forceinline__ int gather(const pg8::Unit&, int) const { return 0; }
    __device__ __forceinline__ void a_ready(const pg8::Unit&, int) const {}
    __device__ __forceinline__ void done(const pg8::Unit&, int) const {}
};
struct SchedDenseR {
    static constexpr bool IMM_DONE = true;
    const char* A; const char* B; size_t astep, bstep, acol; int nM, nN, nF, G, c; unsigned* ready;
    __device__ __forceinline__ bool next(int i, pg8::Unit& u) const {
        const int L = i * G + c, n1 = nF * nN; if (L >= nM * nN) return false;
        if (L < n1) pg8::tile_of(L, nF, nN, u.pm, u.pn); else { u.pm = nF + (L - n1) / nN; u.pn = (L - n1) % nN; }
        u.A = A + (size_t)u.pm * astep + (size_t)u.pn * acol; u.B = B + (size_t)u.pn * bstep; u.x0 = 0; u.x1 = 0; return true; }
    __device__ __forceinline__ int gather(const pg8::Unit&, int) const { return 0; }
    __device__ __forceinline__ void a_ready(const pg8::Unit&, int) const {}
    __device__ __forceinline__ void done(const pg8::Unit& u, int lane) const { if (lane == 0) __hip_atomic_fetch_add(ready + u.pm, 1u, __ATOMIC_RELAXED, __HIP_MEMORY_SCOPE_AGENT); }
};
struct SchedOutproj {
    static constexpr bool IMM_DONE = true;
    const char* A; const char* B; size_t astep, bstep; int G, c; const unsigned* rdg; unsigned* ready;
    __device__ __forceinline__ bool next(int i, pg8::Unit& u) const {
        int n;
        if (G == 256) { if (c >= 32) { if (i == 0) n = c - 32; else if (i == 1 && c < 64) n = 224 + (c - 32); else return false; } else { if (i == 0 && c < 16) n = 256 + c; else return false; } }
        else { n = i * G + c; if (n >= 272) return false; }
        u.pm = n >> 2; u.pn = n & 3; u.A = A + (size_t)u.pm * astep; u.B = B + (size_t)u.pn * bstep; u.x0 = 0; u.x1 = 0; return true; }
    __device__ __forceinline__ int gather(const pg8::Unit&, int) const { return 0; }
    __device__ __forceinline__ void a_ready(const pg8::Unit& u, int wid) const {
        if (wid == 0) { unsigned sp = 0;
            while ((unsigned)__builtin_amdgcn_readfirstlane(__hip_atomic_load(rdg + u.pm, __ATOMIC_RELAXED, __HIP_MEMORY_SCOPE_AGENT)) < 8u) { __builtin_amdgcn_s_sleep(2); if (++sp > (1u << 22)) break; }
            __builtin_amdgcn_fence(__ATOMIC_ACQUIRE, "agent"); asm volatile("s_waitcnt vmcnt(0)" ::: "memory"); }
        __builtin_amdgcn_s_barrier(); asm volatile("" ::: "memory");
    }
    __device__ __forceinline__ void done(const pg8::Unit& u, int lane) const { if (lane == 0) __hip_atomic_fetch_add(ready + u.pm, 1u, __ATOMIC_RELAXED, __HIP_MEMORY_SCOPE_AGENT); }
};
struct SchedQKV {
    static constexpr bool IMM_DONE = false;
    const char* A; const char* B; size_t tstep; int ctxq, G, c;
    __device__ __forceinline__ bool next(int i, pg8::Unit& u) const {
        const int L = i * G + c, n1 = 64 * 6, n2 = ctxq ? 24 : 8; if (L >= n1 + n2) return false;
        if (L < n1) pg8::tile_of(L, 64, 6, u.pm, u.pn);
        else if (ctxq) { pg8::tile_of(L - n1, 4, 6, u.pm, u.pn); u.pm += 64; }
        else { u.pm = 64 + ((L - n1) >> 1); u.pn = 4 + ((L - n1) & 1); }
        u.A = A + (size_t)u.pm * tstep; u.B = B + (size_t)u.pn * tstep; u.x0 = 0; u.x1 = 0; return true; }
    __device__ __forceinline__ int gather(const pg8::Unit&, int) const { return 0; }
    __device__ __forceinline__ void a_ready(const pg8::Unit&, int) const {}
    __device__ __forceinline__ void done(const pg8::Unit&, int) const {}
};
struct SchedMoe {
    static constexpr bool IMM_DONE = false;
    const char* Abase; size_t astep; const char* Bbase; size_t bstep_e, bstep_n; const LAS int* tab; const int* list; int G, c;
    unsigned* ready; int mode;
    __device__ __forceinline__ int T(int i) const { return __builtin_amdgcn_readfirstlane(tab[i]); }
    __device__ __forceinline__ bool next(int i, pg8::Unit& u) const {
        const int ntiles = T(32); int gt, pn;
        if (G == 256) {
            const int x = c & 7, j = c >> 3, g = (mode == 2 ? 7 - x : x) + 8 * i, fm = 8 * g; if (fm >= ntiles) return false;
            const int gsz = (ntiles - fm) < 8 ? (ntiles - fm) : 8; if (j >= 4 * gsz) return false;
            gt = fm + j % gsz; pn = j / gsz; }
        else { const int L = i * G + (mode == 2 ? G - 1 - c : c); if (L >= ntiles * 4) return false; pg8::tile_of(L, ntiles, 4, gt, pn); }
        int e = 0;
        for (int q = 1; q < 32; ++q) e += (T(q) <= gt) ? 1 : 0;
        const int ti = gt - T(e); int valid = T(40 + e) - ti * 256; valid = valid > 256 ? 256 : valid;
        u.pm = gt; u.pn = pn; u.x0 = e * MOE_CAP + ti * 256; u.x1 = valid;
        u.A = Abase + (size_t)gt * astep; u.B = Bbase + (size_t)e * bstep_e + (size_t)pn * bstep_n; return true; }
    __device__ __forceinline__ int gather(const pg8::Unit& u, int lr) const { return lr < u.x1 ? (list[u.x0 + lr] >> 1) : 0; }
    __device__ __forceinline__ void a_ready(const pg8::Unit& u, int wid) const {
        if (mode != 2) return;
        if (wid == 0) { unsigned sp = 0;
            while ((unsigned)__builtin_amdgcn_readfirstlane(__hip_atomic_load(ready + u.pm, __ATOMIC_RELAXED, __HIP_MEMORY_SCOPE_AGENT)) < 32u) { __builtin_amdgcn_s_sleep(2); if (++sp > (1u << 22)) break; }
            __builtin_amdgcn_fence(__ATOMIC_ACQUIRE, "agent"); asm volatile("s_waitcnt vmcnt(0)" ::: "memory"); }
        __builtin_amdgcn_s_barrier(); asm volatile("" ::: "memory");
    }
    __device__ __forceinline__ void done(const pg8::Unit& u, int lane) const {
        if (mode != 1) return;
        if (lane == 0) __hip_atomic_fetch_add(ready + u.pm, 1u, __ATOMIC_RELAXED, __HIP_MEMORY_SCOPE_AGENT);
    }
};

struct EpiQKV { static constexpr bool PERM = true; bf16* Q; bf16* Kb; bf16* Vb; const float* qg; const float* kg; const f32x2* tab;
    __device__ __forceinline__ void operator()(const AccT& acc, const pg8::Unit& u, int wr, int wc, int fr, int fq) const {
        bf16* base; int pitch; long row0;
        if (u.pn < 4) { base = Q + u.pn * 256; pitch = 1024; row0 = (long)u.pm * 256; }
        else { base = (u.pn == 4) ? Kb : Vb; pitch = 256; row0 = kv_row(u.pm * 256); }
        const bool isv = u.pn == 5, lat = u.pm < 64; const float* g = u.pn < 4 ? qg : kg; const float post = u.pn < 4 ? 0.125f * 1.4426950408889634f : 1.0f;
#pragma unroll
        for (int ai = 0; ai < 2; ++ai)
#pragma unroll
            for (int m = 0; m < 4; ++m) { int fq_ = fq; asm volatile("" : "+v"(fq_));
                const int fq = fq_; const int lr = ai * 128 + wr * 64 + m * 16 + fr; const unsigned roff = (unsigned)(((int)row0 + lr) * pitch + wc * 64 + 8 * fq) * 2u;
                f32x4 g0[2], g1[2];
#pragma unroll
                for (int bj = 0; bj < 2; ++bj) { g0[bj] = *(const f32x4*)(g + 32 * bj + 8 * fq); g1[bj] = *(const f32x4*)(g + 32 * bj + 8 * fq + 4); }
                f32x4 v[2][2];
#pragma unroll
                for (int bj = 0; bj < 2; ++bj) { v[bj][0] = acc[ai][bj][m][0]; v[bj][1] = acc[ai][bj][m][1]; }
                if (!isv) {
                    float ss = 0.f;
#pragma unroll
                    for (int bj = 0; bj < 2; ++bj)
#pragma unroll
                        for (int n = 0; n < 2; ++n) ss += (v[bj][n][0] * v[bj][n][0] + v[bj][n][1] * v[bj][n][1]) + (v[bj][n][2] * v[bj][n][2] + v[bj][n][3] * v[bj][n][3]);
                    ss += __shfl_xor(ss, 16); ss += __shfl_xor(ss, 32);
                    const float rstd = rsqrtf(ss * (1.0f / 64.0f) + EPS);
#pragma unroll
                    for (int bj = 0; bj < 2; ++bj) { v[bj][0] = v[bj][0] * rstd * g0[bj]; v[bj][1] = v[bj][1] * rstd * g1[bj]; }
                    if (lat) { const int t = (u.pm * 256 + lr) & (SEQ - 1);
#pragma unroll
                        for (int bj = 0; bj < 2; ++bj) { const f32x2* tb = (const f32x2*)((const char*)tab + (unsigned)(((bj == 0 ? (t >> 6) : (t & 63)) * 16 + 4 * fq) * 8));
#pragma unroll
                            for (int n = 0; n < 2; ++n)
#pragma unroll
                                for (int e = 0; e < 2; ++e) { const f32x2 cs = tb[2 * n + e]; const float x0 = v[bj][n][2 * e], x1 = v[bj][n][2 * e + 1];
                                    v[bj][n][2 * e] = x0 * cs.x - x1 * cs.y; v[bj][n][2 * e + 1] = x0 * cs.y + x1 * cs.x; } } }
#pragma unroll
                    for (int bj = 0; bj < 2; ++bj) { v[bj][0] = v[bj][0] * post; v[bj][1] = v[bj][1] * post; }
                }
#pragma unroll
                for (int bj = 0; bj < 2; ++bj)
                    *(u32x4*)((char*)base + roff + bj * 64) = (u32x4){cvtpk(v[bj][0][0], v[bj][0][1]), cvtpk(v[bj][0][2], v[bj][0][3]), cvtpk(v[bj][1][0], v[bj][1][1]), cvtpk(v[bj][1][2], v[bj][1][3])}; }
    }
};
template <bool PERM_> struct EpiResidT { static constexpr bool PERM = PERM_; const Args* a; int layer; const float* pscale; const bf16* srcbase;
    __device__ __forceinline__ void operator()(const AccT& acc, const pg8::Unit& u, int wr, int wc, int, int) const {
        int ln; asm volatile("v_mbcnt_lo_u32_b32 %0, -1, 0\n\tv_mbcnt_hi_u32_b32 %0, -1, %0" : "=v"(ln)); const int fr = ln & 15, fq = ln >> 4;
        const int r0 = u.pm * 256;
        const float* gate = mod_row(*a, layer, r0) + 2 * D;
        const bool f32src = (layer == 0) && !srcbase; const float* src32 = resid_row(*a, 0, r0); const bf16* src16 = (srcbase ? srcbase : (const bf16*)(a->ws + WS_X)) + (size_t)r0 * D;
        const __amdgpu_buffer_rsrc_t rs = __builtin_amdgcn_make_buffer_rsrc((void*)(a->ws + WS_X), 0, TT * D * 2, 0x00020000);
        if constexpr (PERM_) {
#pragma unroll
        for (int bj = 0; bj < 2; ++bj) { const int cc = u.pn * 256 + bj * 128 + wc * 32 + 8 * fq;
            f32x4 g0 = *(const f32x4*)(gate + cc), g1 = *(const f32x4*)(gate + cc + 4); if (pscale) { g0 = g0 * *(const f32x4*)(pscale + cc); g1 = g1 * *(const f32x4*)(pscale + cc + 4); }
#pragma unroll
            for (int ai = 0; ai < 2; ++ai)
#pragma unroll
                for (int m = 0; m < 4; ++m) { const int off = (ai * 128 + wr * 64 + m * 16 + fr) * D + cc;
                    f32x4 s0, s1;
                    if (f32src) { s0 = *(const f32x4*)(src32 + off); s1 = *(const f32x4*)(src32 + off + 4); }
                    else { const u32x4 p = *(const u32x4*)(src16 + off); s0 = (f32x4){bflo(p.x), bfhi(p.x), bflo(p.y), bfhi(p.y)}; s1 = (f32x4){bflo(p.z), bfhi(p.z), bflo(p.w), bfhi(p.w)}; }
                    const f32x4 o0 = s0 + g0 * acc[ai][bj][m][0], o1 = s1 + g1 * acc[ai][bj][m][1];
                    __builtin_amdgcn_raw_buffer_store_b128((u32x4){cvtpk(o0.x, o0.y), cvtpk(o0.z, o0.w), cvtpk(o1.x, o1.y), cvtpk(o1.z, o1.w)}, rs, (r0 * D + off) * 2, 0, 16  ); }
            asm volatile("" ::: "memory"); }
        } else {
#pragma unroll
        for (int bj = 0; bj < 2; ++bj)
#pragma unroll
            for (int n = 0; n < 2; ++n) { const int cc = u.pn * 256 + bj * 128 + wc * 32 + n * 16 + 4 * fq; f32x4 g = *(const f32x4*)(gate + cc); if (pscale) g = g * *(const f32x4*)(pscale + cc);
#pragma unroll
                for (int ai = 0; ai < 2; ++ai)
#pragma unroll
                    for (int m = 0; m < 4; ++m) { const int off = (ai * 128 + wr * 64 + m * 16 + fr) * D + cc;
                        f32x4 s0;
                        if (f32src) s0 = *(const f32x4*)(src32 + off);
                        else { const u32x2 p = *(const u32x2*)(src16 + off); s0 = (f32x4){bflo(p.x), bfhi(p.x), bflo(p.y), bfhi(p.y)}; }
                        const f32x4 o0 = s0 + g * acc[ai][bj][m][n];
                        __builtin_amdgcn_raw_buffer_store_b64((u32x2){cvtpk(o0.x, o0.y), cvtpk(o0.z, o0.w)}, rs, (r0 * D + off) * 2, 0, 16  ); }
                asm volatile("" ::: "memory"); }
        }
    }
};
typedef EpiResidT<true> EpiResid; typedef EpiResidT<false> EpiResidN;
struct EpiGateUp { static constexpr bool PERM = true; bf16* act;
    __device__ __forceinline__ void operator()(const AccT& acc, const pg8::Unit& u, int wr, int wc, int fr, int fq) const {
        const __amdgpu_buffer_rsrc_t rs = __builtin_amdgcn_make_buffer_rsrc((void*)act, 0, 43008 * 512 * 2, 0x00020000);
#pragma unroll
        for (int ai = 0; ai < 2; ++ai)
#pragma unroll
            for (int m = 0; m < 4; ++m) { const int off = (int)((((size_t)u.pm * 256 + ai * 128 + wr * 64 + m * 16 + fr) * 512 + u.pn * 128 + wc * 32 + 8 * fq) * 2);
                const f32x4 g0 = acc[ai][0][m][0], g1 = acc[ai][0][m][1], u0 = acc[ai][1][m][0], u1 = acc[ai][1][m][1];
                const u32x4 ov = (u32x4){cvtpk(silu_f(g0[0]) * u0[0], silu_f(g0[1]) * u0[1]), cvtpk(silu_f(g0[2]) * u0[2], silu_f(g0[3]) * u0[3]),
                                     cvtpk(silu_f(g1[0]) * u1[0], silu_f(g1[1]) * u1[1]), cvtpk(silu_f(g1[2]) * u1[2], silu_f(g1[3]) * u1[3])};
#if MOE_FP8
                { const float sa = (float)(1 << MOE_ASH); const u32x2 o8 = (u32x2){pk_fp8x4(silu_f(g0[0]) * u0[0] * sa, silu_f(g0[1]) * u0[1] * sa, silu_f(g0[2]) * u0[2] * sa, silu_f(g0[3]) * u0[3] * sa),
                                                                                    pk_fp8x4(silu_f(g1[0]) * u1[0] * sa, silu_f(g1[1]) * u1[1] * sa, silu_f(g1[2]) * u1[2] * sa, silu_f(g1[3]) * u1[3] * sa)};
                  (void)ov; __builtin_amdgcn_raw_buffer_store_b64(o8, rs, off >> 1, 0, 16  ); } }
#else
                __builtin_amdgcn_raw_buffer_store_b128(ov, rs, off, 0, 16  ); }
#endif
    }
};
struct EpiDown { static constexpr bool PERM = true; const int* list; const float* w2; bf16* y2;
    __device__ __forceinline__ void operator()(const AccT& acc, const pg8::Unit& u, int wr, int wc, int fr, int fq) const {
#pragma unroll
        for (int ai = 0; ai < 2; ++ai)
#pragma unroll
            for (int m = 0; m < 4; ++m) { const int lr = ai * 128 + wr * 64 + m * 16 + fr;
                if (lr < u.x1) { const int dest = list[u.x0 + lr]; const float w = w2[dest]; bf16* p = y2 + (size_t)dest * D + u.pn * 256 + wc * 32 + 8 * fq;
#pragma unroll
                    for (int bj = 0; bj < 2; ++bj) { const f32x4 v0 = acc[ai][bj][m][0] * w, v1 = acc[ai][bj][m][1] * w;
                        *(u32x4*)(p + bj * 128) = (u32x4){cvtpk(v0[0], v0[1]), cvtpk(v0[2], v0[3]), cvtpk(v1[0], v1[1]), cvtpk(v1[2], v1[3])}; } } }
    }
};

constexpr int TAB_OFF = 135168;

__device__ __forceinline__ void ph_rope(const Args& a, const Ctx& c, int layer) {
    const int j = layer == 0 ? 0 : 1; const bool ctxq = layer == 0;
    const float* qg = a.in[I_QG] + j * 64; const float* kg = a.in[I_KG] + j * 64;
    const f32x2* tab = (const f32x2*)(a.ws + WS_ROPE);
    bf16* Qb = (bf16*)(a.ws + WS_Q); bf16* Kb = (bf16*)(a.ws + WS_K);
    const int nitems = TT * 20;
    for (int it = blockIdx.x * NTHREADS + c.tid; it < nitems; it += c.G * NTHREADS) {
        const int r = it / 20, hs = it % 20;
        if (hs < 16 && r >= TL && !ctxq) continue;
        bf16* p; const float* g; float post;
        if (hs < 16) { p = Qb + (size_t)r * 1024 + hs * 64; g = qg; post = 0.125f * 1.4426950408889634f; } else { p = Kb + kv_row(r) * 256 + (hs - 16) * 64; g = kg; post = 1.0f; }
        float x[64]; float ss = 0.f;
#pragma unroll
        for (int i = 0; i < 8; ++i) { const u32x4 w = ((const u32x4*)p)[i];
            x[8 * i + 0] = bflo(w.x); x[8 * i + 1] = bfhi(w.x); x[8 * i + 2] = bflo(w.y); x[8 * i + 3] = bfhi(w.y);
            x[8 * i + 4] = bflo(w.z); x[8 * i + 5] = bfhi(w.z); x[8 * i + 6] = bflo(w.w); x[8 * i + 7] = bfhi(w.w); }
#pragma unroll
        for (int i = 0; i < 64; ++i) ss += x[i] * x[i];
        const float rstd = rsqrtf(ss * (1.0f / 64.0f) + EPS);
#pragma unroll
        for (int i = 0; i < 64; ++i) x[i] = x[i] * rstd * g[i];
        if (r < TL) { const int t = r % SEQ, rp = t >> 6, cp = t & 63;
#pragma unroll
            for (int i = 0; i < 32; ++i) { const f32x2 cs = tab[(i < 16 ? rp : cp) * 16 + (i & 15)]; const float x0 = x[2 * i], x1 = x[2 * i + 1];
                x[2 * i] = x0 * cs.x - x1 * cs.y; x[2 * i + 1] = x0 * cs.y + x1 * cs.x; } }
#pragma unroll
        for (int i = 0; i < 8; ++i) ((u32x4*)p)[i] = (u32x4){cvtpk(x[8 * i] * post, x[8 * i + 1] * post), cvtpk(x[8 * i + 2] * post, x[8 * i + 3] * post),
                                                            cvtpk(x[8 * i + 4] * post, x[8 * i + 5] * post), cvtpk(x[8 * i + 6] * post, x[8 * i + 7] * post)};
    }
}

__device__ __forceinline__ void ph_att(const Args& a, const Ctx& c, int layer, char* lds_generic) {
    const int nun = 1024 + (layer == 0 ? 64 : 0);
    const attn_body::bf16* Qb = (const attn_body::bf16*)(a.ws + WS_Q); const attn_body::bf16* Kb = (const attn_body::bf16*)(a.ws + WS_K); const attn_body::bf16* Vb = (const attn_body::bf16*)(a.ws + WS_V);
    for (int U = c.vcu; U < nun; U += c.G) {
        long qrow0, kv0; int h, NT;
        if (U < 1024) { const int bh = U >> 4, qb = U & 15, b = bh >> 4; h = bh & 15; qrow0 = (long)b * SEQ + qb * 256; kv0 = (long)b * KVROWS; NT = KVROWS / 64; }
        else { const int q = U - 1024, b = q >> 4; h = q & 15; qrow0 = (long)TL + b * CTXL; kv0 = (long)b * KVROWS; NT = CTXL / 64; }
        attn_body::attn_unit<8>(qrow0, h, kv0, NT, Qb, Kb, Vb, (attn_body::bf16*)(a.ws + WS_HB), lds_generic);
    }
}

__device__ __forceinline__ void ph_m1(const Args& a, const Ctx& c, int layer, const unsigned* rdy, int nN, int amode) {
    const int Tm = layer == 3 ? TL : TT, ntiles = Tm / 32;
    int tl0, tl1, tl2;
    { int bid = (int)blockIdx.x; asm volatile("" : "+s"(bid));
      if (amode == 1 && c.G == 256 && ntiles == 544) {
          int k = c.vcu - 64; asm volatile("" : "+s"(k));
          if (k < 0) { tl0 = -1; tl1 = -1; tl2 = -1; } else { tl0 = k; tl1 = k + 192; tl2 = k < 64 ? k + 384 : (k < 160 ? 448 + (k - 64) : -1); } }
      else if (c.G == 256 && ntiles == 544) { if (bid < 16) { tl0 = 512 + bid; tl1 = -1; tl2 = -1; } else { const int j = bid - 16; tl0 = j; tl1 = j + 240; tl2 = j < 32 ? j + 480 : (j < 48 ? 528 + (j - 32) : -1); } }
      else { tl0 = bid < ntiles ? bid : -1; tl1 = bid + c.G < ntiles ? bid + c.G : -1; tl2 = bid + 2 * c.G < ntiles ? bid + 2 * c.G : -1; } }
    const unsigned need = 8u * (unsigned)nN;
#define M1_WAIT(tl) do { if (c.wave == 0) { unsigned sp_ = 0; \
        while ((unsigned)__builtin_amdgcn_readfirstlane(__hip_atomic_load(rdy + ((tl) >> 3), __ATOMIC_RELAXED, __HIP_MEMORY_SCOPE_AGENT)) < need) { __builtin_amdgcn_s_sleep(2); if (++sp_ > (1u << 22)) break; } \
        __builtin_amdgcn_fence(__ATOMIC_ACQUIRE, "agent"); asm volatile("s_waitcnt vmcnt(0)" ::: "memory"); } \
        __syncthreads(); } while (0)
    const float* g = a.in[I_NFFN] + layer * D;
    constexpr int RP = 2064;
    LAS unsigned char* hiT = c.lds; LAS unsigned char* loT = c.lds + 32 * RP;
    LAS float* part = (LAS float*)c.lds;
    LAS int* lcnt = (LAS int*)(c.lds + 133120); LAS int* lbase = lcnt + 32;
    LAS float* logit = (LAS float*)(c.lds + 134144);
    const bf16* wr = (const bf16*)(a.ws + WS_WR) + (size_t)layer * 2 * 65536;
    unsigned* gcnt = (unsigned*)(a.ws + WS_CTL) + CW_CNT + layer * 32;
    int* list = (int*)(a.ws + WS_LIST); float* w2 = (float*)(a.ws + WS_W2);
    const int r32 = c.lane & 31, hi = c.lane >> 5;
    if (c.tid < 32) lcnt[c.tid] = 0;
    u32x2 vr[4][4];
#define M1_LOADROWS(tl) do { _Pragma("unroll") for (int i = 0; i < 4; ++i) { const u32x2* xr = (const u32x2*)((const bf16*)(a.ws + WS_X) + (size_t)((tl) * 32 + 4 * c.wave + i) * D) + c.lane; \
        _Pragma("unroll") for (int j = 0; j < 4; ++j) vr[i][j] = xr[64 * j]; } } while (0)
    if (tl0 >= 0) { M1_WAIT(tl0); M1_LOADROWS(tl0); }
    int nmine = 0;
    for (; nmine < 3; ++nmine) { const int tile = nmine == 0 ? tl0 : nmine == 1 ? tl1 : tl2, tnext = nmine == 0 ? tl1 : nmine == 1 ? tl2 : -1;
        if (tile < 0) break;
        const int r0 = tile * 32;
        { f32x4 gs[4], sh[4];
          { const float* m = mod_row(a, layer, r0);
#pragma unroll
            for (int j = 0; j < 4; ++j) { gs[j] = ((const f32x4*)g)[c.lane + 64 * j] * (((const f32x4*)(m + 4 * D))[c.lane + 64 * j] + 1.0f); sh[j] = ((const f32x4*)(m + 3 * D))[c.lane + 64 * j]; } }
#pragma unroll
          for (int i = 0; i < 4; ++i) { const int lr = 4 * c.wave + i, r = r0 + lr;
            f32x4 h[4], vv[4];
#pragma unroll
            for (int j = 0; j < 4; ++j) { const u32x2 p = vr[i][j]; vv[j] = (f32x4){bflo(p.x), bfhi(p.x), bflo(p.y), bfhi(p.y)}; }
            const float rstd = row_rstd(vv);
#pragma unroll
            for (int j = 0; j < 4; ++j) h[j] = (vv[j] * rstd) * gs[j] + sh[j];
#if MOE_FP8
            unsigned* to8 = (unsigned*)((unsigned char*)(a.ws + WS_TK) + (size_t)r * D) + c.lane;
#else
            u32x2* to = (u32x2*)((bf16*)(a.ws + WS_TK) + (size_t)r * D) + c.lane;
#endif
#pragma unroll
            for (int j = 0; j < 4; ++j) { const unsigned h0 = cvtpk(h[j].x, h[j].y), h1 = cvtpk(h[j].z, h[j].w);
                const unsigned l0 = cvtpk(h[j].x - bflo(h0), h[j].y - bfhi(h0)), l1 = cvtpk(h[j].z - bflo(h1), h[j].w - bfhi(h1));
#if MOE_FP8
                to8[64 * j] = pk_fp8x4(h[j].x, h[j].y, h[j].z, h[j].w);
#else
                to[64 * j] = (u32x2){h0, h1};
#endif
                *(LAS u32x2*)(hiT + lr * RP + (4 * c.lane + 256 * j) * 2) = (u32x2){h0, h1};
                *(LAS u32x2*)(loT + lr * RP + (4 * c.lane + 256 * j) * 2) = (u32x2){l0, l1}; } } }
        __syncthreads();
        f32x16 acc0 = {}, acc1 = {};
#pragma unroll
        for (int kk = 0; kk < 8; ++kk) { const int k0 = 128 * c.wave + 16 * kk + 8 * hi;
            const bf16x8 ahi = *(const LAS bf16x8*)(hiT + r32 * RP + k0 * 2), alo = *(const LAS bf16x8*)(loT + r32 * RP + k0 * 2);
            const bf16x8 b0h = *(const bf16x8*)(wr + r32 * 1024 + k0), b1h = *(const bf16x8*)(wr + (32 + r32) * 1024 + k0);
            const bf16x8 b0l = *(const bf16x8*)(wr + 65536 + r32 * 1024 + k0), b1l = *(const bf16x8*)(wr + 65536 + (32 + r32) * 1024 + k0);
            acc0 = __builtin_amdgcn_mfma_f32_32x32x16_bf16(ahi, b0h, acc0, 0, 0, 0); acc1 = __builtin_amdgcn_mfma_f32_32x32x16_bf16(ahi, b1h, acc1, 0, 0, 0);
            acc0 = __builtin_amdgcn_mfma_f32_32x32x16_bf16(alo, b0h, acc0, 0, 0, 0); acc1 = __builtin_amdgcn_mfma_f32_32x32x16_bf16(alo, b1h, acc1, 0, 0, 0);
            acc0 = __builtin_amdgcn_mfma_f32_32x32x16_bf16(ahi, b0l, acc0, 0, 0, 0); acc1 = __builtin_amdgcn_mfma_f32_32x32x16_bf16(ahi, b1l, acc1, 0, 0, 0); }
        if (tnext >= 0) { M1_WAIT(tnext); M1_LOADROWS(tnext); }
        else __syncthreads();
#pragma unroll
        for (int reg = 0; reg < 16; ++reg) { part[((c.wave * 2 + 0) * 16 + reg) * 64 + c.lane] = acc0[reg]; part[((c.wave * 2 + 1) * 16 + reg) * 64 + c.lane] = acc1[reg]; }
        __syncthreads();
        if (nmine < 3) {
#pragma unroll
            for (int q = 0; q < 4; ++q) { const int idx = c.tid + 512 * q, nt = idx >> 10, reg = (idx >> 6) & 15, ln = idx & 63; float s = 0.f;
#pragma unroll
                for (int w = 0; w < 8; ++w) s += part[((w * 2 + nt) * 16 + reg) * 64 + ln];
                logit[(nmine * 32 + (reg & 3) + 8 * (reg >> 2) + 4 * (ln >> 5)) * 64 + nt * 32 + (ln & 31)] = s; } }
        __syncthreads();
    }
#undef M1_LOADROWS
#undef M1_WAIT
    int e0 = 0, e1 = 0, p0 = 0, p1 = 0; float w0 = 0.f, w1 = 0.f; const int myt = c.tid >> 5; const bool act_r = c.tid < 96 && myt < nmine;
    if (act_r) { const LAS float* lg = logit + c.tid * 64;
        int grp = 0; float gm = lg[0];
#pragma unroll
        for (int q = 1; q < 4; ++q) if (lg[q] > gm) { gm = lg[q]; grp = q; }
        float den = 0.f;
#pragma unroll
        for (int q = 0; q < 4; ++q) den += expf(lg[q] - gm);
        const float gate = 1.0f / den;
        const LAS float* le = lg + 4 + grp * 8;
        int i0 = 0; float v0 = le[0];
#pragma unroll
        for (int q = 1; q < 8; ++q) if (le[q] > v0) { v0 = le[q]; i0 = q; }
        int i1 = -1; float v1 = -3.0e38f;
#pragma unroll
        for (int q = 0; q < 8; ++q) if (q != i0 && le[q] > v1) { v1 = le[q]; i1 = q; }
        const float ex = expf(v1 - v0); w0 = gate / (1.0f + ex); w1 = gate * ex / (1.0f + ex);
        e0 = grp * 8 + i0; e1 = grp * 8 + i1;
        p0 = __hip_atomic_fetch_add(lcnt + e0, 1, __ATOMIC_RELAXED, __HIP_MEMORY_SCOPE_WORKGROUP);
        p1 = __hip_atomic_fetch_add(lcnt + e1, 1, __ATOMIC_RELAXED, __HIP_MEMORY_SCOPE_WORKGROUP); }
    __syncthreads();
    if (c.tid < 32) { const int n = lcnt[c.tid]; lbase[c.tid] = n ? (int)__hip_atomic_fetch_add(gcnt + c.tid, (unsigned)n, __ATOMIC_RELAXED, __HIP_MEMORY_SCOPE_AGENT) : 0; }
    __syncthreads();
    if (act_r) { const int r = (myt == 0 ? tl0 : myt == 1 ? tl1 : tl2) * 32 + (c.tid & 31);
        list[e0 * MOE_CAP + lbase[e0] + p0] = 2 * r; w2[2 * r] = w0;
        list[e1 * MOE_CAP + lbase[e1] + p1] = 2 * r + 1; w2[2 * r + 1] = w1; }
    __syncthreads();
}
__device__ __forceinline__ void moe_tables(const Args& a, const Ctx& c, int layer, LAS int* tab) {
    unsigned* gcnt = (unsigned*)(a.ws + WS_CTL) + CW_CNT + layer * 32;
    if (c.tid < 32) tab[40 + c.tid] = (int)__hip_atomic_load(gcnt + c.tid, __ATOMIC_RELAXED, __HIP_MEMORY_SCOPE_AGENT);
    __syncthreads();
    if (c.tid == 0) { int s = 0; for (int e = 0; e < 32; ++e) { tab[e] = s; s += (tab[40 + e] + 255) >> 8; } tab[32] = s; }
    __syncthreads();
}

__device__ __forceinline__ void ph_rpool(const Args& a, const Ctx& c, int layer) {
    LAS unsigned char* hs = c.lds;
    const float* g = a.in[I_NMIX] + layer * D;
    for (int tile = blockIdx.x; tile < TT / 32; tile += c.G) {
        const int r0 = tile * 32;
        const int s0 = r0 < TL ? (r0 / SEQ) * SEQ : TL + ((r0 - TL) / CTXL) * CTXL, s1 = s0 + (r0 < TL ? SEQ : CTXL);
        for (int lr = c.wave; lr < 47; lr += NWAVES) { const int gr = r0 - 8 + lr; if (gr < s0 || gr >= s1) continue;
            f32x4 v[4], h[4]; load_row_combined(a, layer, gr, c.lane, v);
            if (lr >= 8 && lr < 40) { u32x2* xo = (u32x2*)((bf16*)(a.ws + WS_Z) + (size_t)gr * D) + c.lane;
#pragma unroll
                for (int j = 0; j < 4; ++j) xo[64 * j] = (u32x2){cvtpk(v[j].x, v[j].y), cvtpk(v[j].z, v[j].w)}; }
            const float rstd = row_rstd(v); const float* m = mod_row(a, layer, gr);
            norm_mod(v, rstd, g, m, m + D, c.lane, h);
#pragma unroll
            for (int j = 0; j < 4; ++j) *(LAS u32x2*)(hs + lr * 2048 + (4 * c.lane + 256 * j) * 2) = (u32x2){cvtpk(h[j].x, h[j].y), cvtpk(h[j].z, h[j].w)}; }
        __syncthreads();
        { const int half = 1 << (c.tid >> 7);
          const LAS unsigned* col = (const LAS unsigned*)hs + c.tid;
          float sx = 0.f, sy = 0.f;
          { const int lo = (r0 - half) > s0 ? (r0 - half) : s0, hi = (r0 + half) < s1 ? (r0 + half) : s1;
            for (int gr = lo; gr < hi; ++gr) { const unsigned u = col[(gr - r0 + 8) * 512]; sx += bflo(u); sy += bfhi(u); } }
          unsigned* ho = (unsigned*)((bf16*)(a.ws + WS_HB) + (size_t)r0 * D) + c.tid;
          for (int t = 0; t < 32; ++t) { const int gr = r0 + t; const int lo = (gr - half) > s0 ? (gr - half) : s0, hi = (gr + half) < s1 ? (gr + half) : s1;
              const float inv = __builtin_amdgcn_rcpf((float)(hi - lo)); const unsigned u = col[(t + 8) * 512];
              ho[t * 512] = cvtpk(sx * inv - bflo(u), sy * inv - bfhi(u));
              if (t < 31) { if (gr + half < s1) { const unsigned w = col[(t + 8 + half) * 512]; sx += bflo(w); sy += bfhi(w); }
                            if (gr - half >= s0) { const unsigned w = col[(t + 8 - half) * 512]; sx -= bflo(w); sy -= bfhi(w); } } } }
        __syncthreads();
    }
}

struct EpiInproj { static constexpr bool PERM = true; bf16* Z; bf16* XBC; float* DT; const float* dtb;
    __device__ __forceinline__ void operator()(const AccT& acc, const pg8::Unit& u, int wr, int wc, int fr, int fq) const {
        const size_t r0 = (size_t)u.pm * 256;
        if (u.pn < 20) { bf16* base; int pitch; if (u.pn < 8) { base = Z + u.pn * 256; pitch = 2048; } else { base = XBC + (u.pn - 8) * 256; pitch = 3072; }
#pragma unroll
            for (int ai = 0; ai < 2; ++ai)
#pragma unroll
                for (int m = 0; m < 4; ++m) { bf16* rowp = base + (r0 + ai * 128 + wr * 64 + m * 16 + fr) * pitch + wc * 32 + 8 * fq;
#pragma unroll
                    for (int bj = 0; bj < 2; ++bj) { const f32x4 v0 = acc[ai][bj][m][0], v1 = acc[ai][bj][m][1];
                        *(u32x4*)(rowp + bj * 128) = (u32x4){cvtpk(v0[0], v0[1]), cvtpk(v0[2], v0[3]), cvtpk(v1[0], v1[1]), cvtpk(v1[2], v1[3])}; } }
        } else if (wc < 2) { const int col = wc * 32 + 8 * fq; const f32x4 b0 = *(const f32x4*)(dtb + col), b1 = *(const f32x4*)(dtb + col + 4);
#pragma unroll
            for (int ai = 0; ai < 2; ++ai)
#pragma unroll
                for (int m = 0; m < 4; ++m) { float* p = DT + (r0 + ai * 128 + wr * 64 + m * 16 + fr) * 64 + col; f32x4 v0 = acc[ai][0][m][0] + b0, v1 = acc[ai][0][m][1] + b1;
#pragma unroll
                    for (int e = 0; e < 4; ++e) { v0[e] = fmaxf(v0[e], 0.f) + log1pf(__expf(-fabsf(v0[e]))); v1[e] = fmaxf(v1[e], 0.f) + log1pf(__expf(-fabsf(v1[e]))); }
                    *(f32x4*)p = v0; *(f32x4*)(p + 4) = v1; } }
    }
};

__device__ __forceinline__ void ph_conv(const Args& a, const Ctx& c) {
    LAS unsigned char* tin = c.lds; LAS unsigned char* toT = c.lds + 17408; LAS unsigned char* toN = c.lds + 34816;
    const bf16* xbc = (const bf16*)(a.ws + WS_XBC);
    u32x4 pin[3];
#define CONV_PREFETCH(tk) do { const int ci_ = (tk) / 48, chb_ = (tk) % 48, r0_ = ci_ * 128, ch0_ = chb_ * 64; \
        _Pragma("unroll") for (int q = 0; q < 3; ++q) { int p = c.tid + 512 * q; p = p < 131 * 8 ? p : 131 * 8 - 1; const int lr = p >> 3, pc = p & 7; int row = r0_ - 2 + lr; row = row < 0 ? 0 : (row > TT - 1 ? TT - 1 : row); \
            pin[q] = *(const u32x4*)(xbc + (size_t)row * 3072 + ch0_ + pc * 8); } } while (0)
    { const int t0 = (int)blockIdx.x < NCH * 48 ? (int)blockIdx.x : NCH * 48 - 1; CONV_PREFETCH(t0); }
    for (int task = blockIdx.x; task < NCH * 48; task += c.G) {
        const int ci = task / 48, chb = task % 48, r0 = ci * 128, ch0 = chb * 64;
        const bool first = ci < 128 ? (ci % 32 == 0) : (((ci - 128) & 1) == 0), last = ci < 128 ? (ci % 32 == 31) : (((ci - 128) & 1) == 1);
        const int ch = c.tid & 63, tq = c.tid >> 6; const float* cw = a.in[I_CONVW] + ch0 + ch;
        const float w0 = cw[0], w1 = cw[3072], w2 = cw[2 * 3072], w3 = cw[3 * 3072], bias = a.in[I_CONVB][ch0 + ch];
#pragma unroll
        for (int q = 0; q < 3; ++q) { const int p = c.tid + 512 * q, lr = p >> 3; const bool zero = (lr < 2 && first) || (lr == 130 && last);
            if (p < 131 * 8) *(LAS u32x4*)(tin + lr * 128 + (p & 7) * 16) = zero ? (u32x4){0u, 0u, 0u, 0u} : pin[q]; }
        __syncthreads();
        { const int tn = task + c.G < NCH * 48 ? task + c.G : NCH * 48 - 1; CONV_PREFETCH(tn); }
        {
          float xin[19];
#pragma unroll
          for (int i = 0; i < 19; ++i) xin[i] = bf2f(*(const LAS bf16*)(tin + (16 * tq + i) * 128 + ch * 2));
          float o[16];
#pragma unroll
          for (int i = 0; i < 16; ++i) o[i] = silu_f(bias + w0 * xin[i] + w1 * xin[i + 1] + w2 * xin[i + 2] + w3 * xin[i + 3]);
          if (chb < 40) { *(LAS u32x4*)(toT + ch * 272 + tq * 32) = (u32x4){cvtpk(o[0], o[1]), cvtpk(o[2], o[3]), cvtpk(o[4], o[5]), cvtpk(o[6], o[7])};
                          *(LAS u32x4*)(toT + ch * 272 + tq * 32 + 16) = (u32x4){cvtpk(o[8], o[9]), cvtpk(o[10], o[11]), cvtpk(o[12], o[13]), cvtpk(o[14], o[15])}; }
          if (chb >= 32) {
#pragma unroll
              for (int i = 0; i < 16; ++i) *(LAS bf16*)(toN + (16 * tq + i) * 144 + ch * 2) = (bf16)(cvtpk(o[i], 0.f) & 0xffffu); } }
        __syncthreads();
        if (chb < 40) { bf16* dst = chb < 32 ? (bf16*)(a.ws + WS_XT) + ((size_t)ci * 2048 + ch0) * 128 : (bf16*)(a.ws + WS_BT) + ((size_t)ci * 512 + (ch0 - 2048)) * 128;
#pragma unroll
            for (int q = 0; q < 2; ++q) { const int p = c.tid + 512 * q, chl = p >> 4, pc = p & 15; *(u32x4*)(dst + chl * 128 + pc * 8) = *(const LAS u32x4*)(toT + chl * 272 + pc * 16); } }
        if (chb >= 32) { bf16* dst = chb < 40 ? (bf16*)(a.ws + WS_BN) + (size_t)r0 * 512 + (ch0 - 2048) : (bf16*)(a.ws + WS_CN) + (size_t)r0 * 512 + (ch0 - 2560);
#pragma unroll
            for (int q = 0; q < 2; ++q) { const int p = c.tid + 512 * q, t = p >> 3, pc = p & 7; *(u32x4*)(dst + (size_t)t * 512 + pc * 8) = *(const LAS u32x4*)(toN + t * 144 + pc * 16); } }
        __syncthreads();
    }
#undef CONV_PREFETCH
    const int gw = c.vcu * NWAVES + c.wave, NGW = c.G * NWAVES;
    const float* dt = (const float*)(a.ws + WS_DT);
    for (int item = gw; item < NCH * 32; item += NGW) { const int ci = item >> 5, h = item & 31, r0 = ci * 128 + 2 * c.lane;
        const float af = -expf(a.in[I_ALOG][h]), ab = -expf(a.in[I_ALOG][32 + h]);
        const float dtf0 = dt[(size_t)r0 * 64 + h], dtf1 = dt[(size_t)(r0 + 1) * 64 + h], dtb0 = dt[(size_t)r0 * 64 + 32 + h], dtb1 = dt[(size_t)(r0 + 1) * 64 + 32 + h];
        const float laf0 = dtf0 * af, laf1 = dtf1 * af, lab0 = dtb0 * ab, lab1 = dtb1 * ab;
        float inf_ = laf0 + laf1, inb = lab0 + lab1; const float pf = inf_, pbk = inb;
#pragma unroll
        for (int o = 1; o < 64; o <<= 1) { const float t1 = __shfl_up(inf_, o), t2 = __shfl_up(inb, o); if (c.lane >= o) { inf_ += t1; inb += t2; } }
        const float totf = __shfl(inf_, 63), totb = __shfl(inb, 63);
        const float exf = inf_ - pf, exb = inb - pbk;
        const float cf0 = exf + laf0, cf1 = inf_, pb0 = exb, pb1 = exb + lab0;
        f32x4* sca = (f32x4*)(a.ws + WS_SCA) + (size_t)r0 * 32 + h; f32x4* scb = (f32x4*)(a.ws + WS_SCB) + (size_t)r0 * 32 + h;
        { const float L2E = 1.4426950408889634f;
          sca[0] = (f32x4){cf0 * L2E, pb0 * L2E, cf0 * L2E - __log2f(dtf0), pb0 * L2E + __log2f(dtb0)}; sca[32] = (f32x4){cf1 * L2E, pb1 * L2E, cf1 * L2E - __log2f(dtf1), pb1 * L2E + __log2f(dtb1)}; }
        scb[0] = (f32x4){__expf(cf0), __expf(totb - pb0), dtf0 * __expf(totf - cf0), dtb0 * __expf(pb0)};
        scb[32] = (f32x4){__expf(cf1), __expf(totb - pb1), dtf1 * __expf(totf - cf1), dtb1 * __expf(pb1)};
        { float* wsc = (float*)(a.ws + WS_Q) + ((size_t)(ci * 32 + h) * 2) * 128 + 2 * c.lane;
          *(f32x2*)wsc = (f32x2){dtf0 * __expf(totf - cf0), dtf1 * __expf(totf - cf1)}; *(f32x2*)(wsc + 128) = (f32x2){dtb0 * __expf(pb0), dtb1 * __expf(pb1)}; }
        if (c.lane == 0) ((f32x2*)(a.ws + WS_DEC))[ci * 32 + h] = (f32x2){__expf(totf), __expf(totb)}; }
}

__device__ __forceinline__ void ph_scan(const Args& a, const Ctx& c) {
    constexpr int P = 272, BUF = 53248;
    LAS unsigned char* stg = c.lds + 2 * BUF + c.wave * 2048;
    const int r32 = c.lane & 31, hi = c.lane >> 5, pt = c.wave >> 2, nt = c.wave & 3;
    for (int task = c.vcu; task < 256; task += c.G) { const int b = task >> 6, dir = (task >> 5) & 1, h = task & 31, g = h >> 3;
        f32x16 acc = {};
        u32x4 xrA[2], brA[4], xrB[2], brB[4]; f32x4 wA0 = {}, wA1 = {}, wB0 = {}, wB1 = {}; f32x2 decA = {}, decB = {};
#define SCAN_CI(k) (dir == 0 ? ((k) < 2 ? 128 + 2 * b + (k) : 32 * b + ((k) - 2)) : ((k) < 2 ? 128 + 2 * b + 1 - (k) : 32 * b + 31 - ((k) - 2)))
#define SCAN_LOAD(k, xr, br, w0, w1, dcr) do { const int ci_ = SCAN_CI(k); const bf16* xs_ = (const bf16*)(a.ws + WS_XT) + ((size_t)ci_ * 2048 + 64 * h) * 128; const bf16* bs_ = (const bf16*)(a.ws + WS_BT) + ((size_t)ci_ * 512 + 128 * g) * 128; \
        _Pragma("unroll") for (int q = 0; q < 2; ++q) xr[q] = ((const u32x4*)xs_)[c.tid + 512 * q]; _Pragma("unroll") for (int q = 0; q < 4; ++q) br[q] = ((const u32x4*)bs_)[c.tid + 512 * q]; \
        { const f32x4* wp_ = (const f32x4*)((const float*)(a.ws + WS_Q) + ((size_t)(ci_ * 32 + h) * 2 + dir) * 128) + 2 * (c.tid & 15); w0 = wp_[0]; w1 = wp_[1]; }        \
        dcr = ((const f32x2*)(a.ws + WS_DEC))[ci_ * 32 + h]; } while (0)
#define SCAN_WRITE(bi, xr, br, w0, w1) do { LAS unsigned char* xb_ = c.lds + (bi) * BUF; LAS unsigned char* bb_ = xb_ + 17408;        \
        _Pragma("unroll") for (int q = 0; q < 2; ++q) { const int p = c.tid + 512 * q; const u32x4 v_ = xr[q]; \
            *(LAS u32x4*)(xb_ + (p >> 4) * P + (p & 15) * 16) = (u32x4){cvtpk(bflo(v_.x) * w0.x, bfhi(v_.x) * w0.y), cvtpk(bflo(v_.y) * w0.z, bfhi(v_.y) * w0.w), cvtpk(bflo(v_.z) * w1.x, bfhi(v_.z) * w1.y), cvtpk(bflo(v_.w) * w1.z, bfhi(v_.w) * w1.w)}; } \
        _Pragma("unroll") for (int q = 0; q < 4; ++q) { const int p = c.tid + 512 * q; *(LAS u32x4*)(bb_ + (p >> 4) * P + (p & 15) * 16) = br[q]; } } while (0)
#define SCAN_STEP(k, cur, dcr) do { const int ci = SCAN_CI(k); \
            { bf16* hin = (bf16*)(a.ws + WS_HIN) + (((size_t)ci * 2 + dir) * 32 + h) * 8192; \
              _Pragma("unroll") for (int r = 0; r < 16; ++r) *(LAS bf16*)(stg + ((r & 3) + 8 * (r >> 2) + 4 * hi) * 64 + r32 * 2) = (bf16)(cvtpk(acc[r], 0.f) & 0xffffu); \
              LDS_WAIT(); \
              _Pragma("unroll") for (int i = 0; i < 2; ++i) { const int row = (c.lane >> 2) + 16 * i, pc = c.lane & 3; *(u32x4*)(hin + (size_t)(32 * pt + row) * 128 + 32 * nt + pc * 8) = *(const LAS u32x4*)(stg + row * 64 + pc * 16); } } \
            const float dec = dir == 0 ? dcr.x : dcr.y; \
            _Pragma("unroll") for (int r = 0; r < 16; ++r) acc[r] *= dec; \
            { LAS unsigned char* xb = c.lds + (cur) * BUF; LAS unsigned char* bb = xb + 17408; \
              _Pragma("unroll") for (int kk = 0; kk < 8; ++kk) { const int s8 = 16 * kk + 8 * hi; \
                  const bf16x8 xs = *(const LAS bf16x8*)(xb + (32 * pt + r32) * P + s8 * 2), bfrag = *(const LAS bf16x8*)(bb + (32 * nt + r32) * P + s8 * 2); \
                  acc = __builtin_amdgcn_mfma_f32_32x32x16_bf16(xs, bfrag, acc, 0, 0, 0); } } } while (0)
        f32x2 dcur0, dcur1;
        SCAN_LOAD(0, xrA, brA, wA0, wA1, decA); SCAN_LOAD(1, xrB, brB, wB0, wB1, decB); SCAN_WRITE(0, xrA, brA, wA0, wA1); dcur0 = decA;
        __syncthreads();
        for (int k = 0; k < 34; k += 2) {
            { const int kn = k + 2 < 34 ? k + 2 : 33; SCAN_LOAD(kn, xrA, brA, wA0, wA1, decA); }
            SCAN_STEP(k, 0, dcur0);
            SCAN_WRITE(1, xrB, brB, wB0, wB1); dcur1 = decB;
            __syncthreads();
            { const int kn = k + 3 < 34 ? k + 3 : 33; SCAN_LOAD(kn, xrB, brB, wB0, wB1, decB); }
            SCAN_STEP(k + 1, 1, dcur1);
            SCAN_WRITE(0, xrA, brA, wA0, wA1); dcur0 = decA;
            __syncthreads();
        }
#undef SCAN_CI
#undef SCAN_LOAD
#undef SCAN_WRITE
#undef SCAN_STEP
    }
}

__device__ __forceinline__ int crow16(int r, int hi) { return (r & 3) + 8 * (r >> 2) + 4 * hi; }
__device__ __forceinline__ void ph_yph(const Args& a, const Ctx& c, unsigned* rdg) {
    constexpr int P = 272, ZP = 144;
    LAS unsigned char* Cs = c.lds; LAS unsigned char* Bs = c.lds + 34816; LAS unsigned char* xs = c.lds + 69632; LAS unsigned char* hf = c.lds + 87040; LAS unsigned char* hb = c.lds + 104448;
    LAS unsigned char* zs = c.lds + 121856; LAS unsigned char* os = c.lds + 140288; LAS f32x4* sca = (LAS f32x4*)(c.lds + 158720); LAS f32x2* scb = (LAS f32x2*)(c.lds + 160768);
    LAS float* sbv = (LAS float*)(c.lds + 161792); LAS float* scv = (LAS float*)(c.lds + 162304); LAS float* ssql = (LAS float*)(c.lds + 34816);
    const int lb = c.wave & 3, pb = c.wave >> 2;
    SECT_DECL
    for (int task = c.vcu; task < NCH * 4; task += c.G) { const int ci = task >> 2, g = task & 3, r0 = ci * 128;
        int tid_t = c.tid; asm volatile("" : "+v"(tid_t));
        f32x16 X[4]; int l0;
        u32x4 pxt[2], phf[2], phb[2], pz[2]; f32x4 ps1 = {}; f32x4 ps4 = {};
#define YPH_PREFETCH(hq) do { const int h_ = 8 * g + (hq); const u32x4* xt_ = (const u32x4*)((const bf16*)(a.ws + WS_XT) + ((size_t)ci * 2048 + 64 * h_) * 128); \
            const u32x4* hfg_ = (const u32x4*)((const bf16*)(a.ws + WS_HIN) + (((size_t)ci * 2 + 0) * 32 + h_) * 8192); const u32x4* hbg_ = (const u32x4*)((const bf16*)(a.ws + WS_HIN) + (((size_t)ci * 2 + 1) * 32 + h_) * 8192); \
            const bf16* zg_ = (const bf16*)(a.ws + WS_Z) + (size_t)r0 * 2048 + 64 * h_; \
            _Pragma("unroll") for (int q = 0; q < 2; ++q) { const int p = tidp + 512 * q; pxt[q] = xt_[p]; phf[q] = hfg_[p]; phb[q] = hbg_[p]; pz[q] = *(const u32x4*)(zg_ + (size_t)(p >> 3) * 2048 + (p & 7) * 8); } \
            ps1 = ((const f32x4*)(a.ws + WS_SCA))[((size_t)r0 + (tidp & 127)) * 32 + h_]; ps4 = ((const f32x4*)(a.ws + WS_SCB))[((size_t)r0 + (tidp & 127)) * 32 + h_]; } while (0)
        { const int tid = tid_t, lane = tid & 63, r32 = lane & 31, hi = lane >> 5; l0 = 32 * lb + r32;
          { const bf16* cn = (const bf16*)(a.ws + WS_CN) + (size_t)r0 * 512 + 128 * g; const bf16* bn = (const bf16*)(a.ws + WS_BN) + (size_t)r0 * 512 + 128 * g;
#pragma unroll
            for (int q = 0; q < 4; ++q) { const int p = tid + 512 * q, row = p >> 4, pc = p & 15;
                *(LAS u32x4*)(Cs + row * P + pc * 16) = *(const u32x4*)(cn + (size_t)row * 512 + pc * 8); *(LAS u32x4*)(Bs + row * P + pc * 16) = *(const u32x4*)(bn + (size_t)row * 512 + pc * 8); } }
          { const int tidp = tid; YPH_PREFETCH(0); }
          __syncthreads();
#pragma unroll
          for (int sb = 0; sb < 4; ++sb) { X[sb] = (f32x16){};
#pragma unroll
              for (int kk = 0; kk < 8; ++kk) { const int k8 = (16 * kk + 8 * hi) * 2;
                  X[sb] = __builtin_amdgcn_mfma_f32_32x32x16_bf16(*(const LAS bf16x8*)(Bs + (32 * sb + r32) * P + k8), *(const LAS bf16x8*)(Cs + (32 * lb + r32) * P + k8), X[sb], 0, 0, 0); } }
        }
        SECT(0);
        float ssq = 0.f;
#pragma unroll 1
        for (int hh = 0; hh < 8; ++hh) { const int h = 8 * g + hh;
            int tid = c.tid; asm volatile("" : "+v"(tid)); const int lane = tid & 63, r32 = lane & 31, hi = lane >> 5, l = 32 * lb + r32; (void)lane;
            const float dsum = a.in[I_DSK][h] + a.in[I_DSK][32 + h];
            __syncthreads();
            SECT(1);
            if (hh > 0) { bf16* gg = (bf16*)(a.ws + WS_G) + (size_t)r0 * 2048 + 64 * (h - 1);
#pragma unroll
                for (int q = 0; q < 2; ++q) { const int p = tid + 512 * q, zr = p >> 3, zc = p & 7; *(u32x4*)(gg + (size_t)zr * 2048 + zc * 8) = *(const LAS u32x4*)(os + zr * ZP + zc * 16); } }
#pragma unroll
            for (int q = 0; q < 2; ++q) { const int p = tid + 512 * q, row = p >> 4, pc = p & 15;
                *(LAS u32x4*)(xs + row * P + pc * 16) = pxt[q]; *(LAS u32x4*)(hf + row * P + pc * 16) = phf[q]; *(LAS u32x4*)(hb + row * P + pc * 16) = phb[q];
                *(LAS u32x4*)(zs + (p >> 3) * ZP + (p & 7) * 16) = pz[q]; }
            if (tid < 128) { sca[tid] = ps1; scb[tid] = (f32x2){ps4.x, ps4.y}; sbv[tid] = ps1.z; scv[tid] = ps1.w; }
            __syncthreads();
            SECT(2);
            if (hh < 7) { const int tidp = tid; YPH_PREFETCH(hh + 1); }
            SECT(3);
            const f32x4 me = sca[l]; const f32x2 ee = scb[l];
            const float dtb_l = __builtin_amdgcn_exp2f(me.w - me.y);
            f32x16 accd = {};
#pragma unroll
            for (int sb = 0; sb < 4; ++sb) { unsigned mp[8];
#pragma unroll
                for (int q = 0; q < 4; ++q) { const int s0 = 32 * sb + 8 * q + 4 * hi; float mv[4];
                    if (sb < lb) { const f32x4 bs4 = *(const LAS f32x4*)(sbv + s0);
#pragma unroll
                        for (int e = 0; e < 4; ++e) mv[e] = X[sb][4 * q + e] * __builtin_amdgcn_exp2f(me.x - bs4[e]); }
                    else if (sb > lb) { const f32x4 cs4 = *(const LAS f32x4*)(scv + s0);
#pragma unroll
                        for (int e = 0; e < 4; ++e) mv[e] = X[sb][4 * q + e] * __builtin_amdgcn_exp2f(cs4[e] - me.y); }
                    else { const f32x4 bs4 = *(const LAS f32x4*)(sbv + s0), cs4 = *(const LAS f32x4*)(scv + s0);
#pragma unroll
                        for (int e = 0; e < 4; ++e) { const int s = s0 + e; const float t = (s <= l) ? (me.x - bs4[e]) : (cs4[e] - me.y); const float xv = X[sb][4 * q + e];
                            float m = xv * __builtin_amdgcn_exp2f(t); if (s == l) m += xv * dtb_l + dsum; mv[e] = m; } }
                    mp[2 * q] = cvtpk(mv[0], mv[1]); mp[2 * q + 1] = cvtpk(mv[2], mv[3]); }
#pragma unroll
                for (int t = 0; t < 2; ++t) { const int sof = (32 * sb + 16 * t + 4 * hi) * 2;
                    const u32x2 lo = *(const LAS u32x2*)(xs + (32 * pb + r32) * P + sof), h2 = *(const LAS u32x2*)(xs + (32 * pb + r32) * P + sof + 16);
                    const u32x4 af = (u32x4){lo.x, lo.y, h2.x, h2.y}, bfm = (u32x4){mp[4 * t], mp[4 * t + 1], mp[4 * t + 2], mp[4 * t + 3]};
                    accd = __builtin_amdgcn_mfma_f32_32x32x16_bf16(__builtin_bit_cast(bf16x8, af), __builtin_bit_cast(bf16x8, bfm), accd, 0, 0, 0); }
                }
            SECT(4);
#pragma unroll
            for (int dd = 0; dd < 2; ++dd) { f32x16 acco = {}; LAS unsigned char* hx = dd == 0 ? hf : hb;
#pragma unroll
                for (int kk = 0; kk < 8; ++kk) { const int k8 = (16 * kk + 8 * hi) * 2;
                    acco = __builtin_amdgcn_mfma_f32_32x32x16_bf16(*(const LAS bf16x8*)(hx + (32 * pb + r32) * P + k8), *(const LAS bf16x8*)(Cs + (32 * lb + r32) * P + k8), acco, 0, 0, 0); }
                const float ex = dd == 0 ? ee.x : ee.y;
#pragma unroll
                for (int r = 0; r < 16; ++r) accd[r] += ex * acco[r]; }
            SECT(5);
#pragma unroll
            for (int q = 0; q < 4; ++q) { const int pcol = 32 * pb + 8 * q + 4 * hi; const u32x2 zq = *(const LAS u32x2*)(zs + l * ZP + pcol * 2);
                float gv[4];
#pragma unroll
                for (int e = 0; e < 4; ++e) { const int r = 4 * q + e; const float y = accd[r];
                    const float z = (e == 0) ? bflo(zq.x) : (e == 1) ? bfhi(zq.x) : (e == 2) ? bflo(zq.y) : bfhi(zq.y); gv[e] = y * silu_f(z); ssq += gv[e] * gv[e]; }
                *(LAS u32x2*)(os + l * ZP + pcol * 2) = (u32x2){cvtpk(gv[0], gv[1]), cvtpk(gv[2], gv[3])}; }
            SECT(6);
        }
#undef YPH_PREFETCH
        __syncthreads();
        { bf16* gg = (bf16*)(a.ws + WS_G) + (size_t)r0 * 2048 + 64 * (8 * g + 7);
#pragma unroll
          for (int q = 0; q < 2; ++q) { const int p = c.tid + 512 * q, zr = p >> 3, zc = p & 7; *(u32x4*)(gg + (size_t)zr * 2048 + zc * 8) = *(const LAS u32x4*)(os + zr * ZP + zc * 16); } }
        ssq += __shfl_xor(ssq, 32);
        if ((c.lane >> 5) == 0) ssql[pb * 128 + l0] = ssq;
        __syncthreads();
        if (c.tid < 128) ssql[256 + c.tid] = rsqrtf((ssql[c.tid] + ssql[128 + c.tid]) * (1.0f / 512.0f) + EPS);
        VM_WAIT();
        __syncthreads();
        { bf16* gt = (bf16*)(a.ws + WS_G) + (size_t)r0 * 2048 + 512 * g; const float* ng = a.in[I_SNORM] + 512 * g;
          const __amdgpu_buffer_rsrc_t grs = __builtin_amdgcn_make_buffer_rsrc((void*)(a.ws + WS_G), 0, TT * 2048 * 2, 0x00020000);
          const f32x4 g0 = *(const f32x4*)(ng + (c.tid & 63) * 8), g1 = *(const f32x4*)(ng + (c.tid & 63) * 8 + 4);
#pragma unroll 1
          for (int qb = 0; qb < 2; ++qb) { u32x4 gv8[8]; int tidq = c.tid + 4096 * qb; asm volatile("" : "+v"(tidq));
#pragma unroll
            for (int q = 0; q < 8; ++q) { const int p = tidq + 512 * q; gv8[q] = *(const u32x4*)(gt + (size_t)(p >> 6) * 2048 + (p & 63) * 8); }
#pragma unroll
            for (int q = 0; q < 8; ++q) { const int p = tidq + 512 * q, row = p >> 6, col = (p & 63) * 8; const u32x4 v = gv8[q]; const float sr = ssql[256 + row];
              __builtin_amdgcn_raw_buffer_store_b128((u32x4){cvtpk(bflo(v.x) * sr * g0.x, bfhi(v.x) * sr * g0.y), cvtpk(bflo(v.y) * sr * g0.z, bfhi(v.y) * sr * g0.w), cvtpk(bflo(v.z) * sr * g1.x, bfhi(v.z) * sr * g1.y), cvtpk(bflo(v.w) * sr * g1.z, bfhi(v.w) * sr * g1.w)},
                  grs, ((r0 + row) * 2048 + 512 * g + col) * 2, 0, 16  ); } } }
        VM_WAIT();
        __syncthreads();
        if (c.tid == 0) __hip_atomic_fetch_add(rdg + (ci >> 1), 1u, __ATOMIC_RELAXED, __HIP_MEMORY_SCOPE_AGENT);
        SECT(7);
    }
    SECT_END(40);
}
__device__ __forceinline__ void ph_gfix(const Args& a, const Ctx& c) {
    const float* ng = a.in[I_SNORM]; const float* rs = (const float*)(a.ws + WS_RSTD);
    const int n16 = TT * 256;
    for (int p = blockIdx.x * NTHREADS + c.tid; p < n16; p += c.G * NTHREADS) { const int r = p >> 8, col = (p & 255) * 8;
        u32x4* gp = (u32x4*)((bf16*)(a.ws + WS_G) + (size_t)r * 2048 + col); const u32x4 v = *gp; const float s = rs[r * 4 + (col >> 9)];
        const f32x4 g0 = *(const f32x4*)(ng + col), g1 = *(const f32x4*)(ng + col + 4);
        *gp = (u32x4){cvtpk(bflo(v.x) * s * g0.x, bfhi(v.x) * s * g0.y), cvtpk(bflo(v.y) * s * g0.z, bfhi(v.y) * s * g0.w), cvtpk(bflo(v.z) * s * g1.x, bfhi(v.z) * s * g1.y), cvtpk(bflo(v.w) * s * g1.z, bfhi(v.w) * s * g1.w)}; }
}

#if DEBUG_CHECKS
__device__ __forceinline__ float dbg_hb(const Args& a, int layer, size_t idx, float sh) {
    if (ATT_FP8 && layer != 2) return __builtin_amdgcn_cvt_f32_fp8((unsigned)((const unsigned char*)(a.ws + WS_HB))[idx], 0) * sh;
    return bf2f(((const bf16*)(a.ws + WS_HB))[idx]); }
__device__ __forceinline__ int dbg_sample_row(int b) { const int SR[16] = {0, 1, 77, 4095, 4096, 5000, 8191, 9000, 12288, 16383, 16384, 16385, 16384 + 255, 16384 + 256, 17000, 17407}; int r = 0;
#pragma unroll
    for (int i = 0; i < 16; ++i) r = (b == i) ? SR[i] : r;
    return r; }
__device__ __forceinline__ float blk_sum(float v, LAS float* red, int tid) {
    v = wave_sum(v); __syncthreads(); if ((tid & 63) == 0) red[tid >> 6] = v; __syncthreads(); float s = 0.f;
#pragma unroll
    for (int i = 0; i < 8; ++i) s += red[i];
    __syncthreads(); return s; }
__device__ __forceinline__ float blk_max(float v, LAS float* red, int tid) {
#pragma unroll
    for (int o = 1; o < 64; o <<= 1) v = fmaxf(v, __shfl_xor(v, o));
    __syncthreads(); if ((tid & 63) == 0) red[tid >> 6] = v; __syncthreads(); float s = red[0];
#pragma unroll
    for (int i = 1; i < 8; ++i) s = fmaxf(s, red[i]);
    __syncthreads(); return s; }
__device__ __forceinline__ void dbg_report(const Args& a, int id, float err, float ssref, float n, int tid) {
    if (tid == 0) { float rel = err / (sqrtf(ssref / n) + 1e-20f); if (!(rel == rel)) rel = 1e30f; atomicMax((unsigned*)(a.ws + WS_CTL) + CW_DBG + id, __float_as_uint(rel)); } }
__device__ __forceinline__ float dbg_mod(const Args& a, int layer, int r, int j) {
    const float* cv = r < TL ? a.in[I_C] + (r / SEQ) * 1024 : a.in[I_CCTX]; float s = 0.f;
    _Pragma("nounroll") for (int k = 0; k < 1024; ++k) { const float x = cv[k]; s += (x / (1.0f + expf(-x))) * a.in[I_WADA][((size_t)layer * 1024 + k) * 6144 + j]; }
    return s + a.in[I_BADA][layer * 6144 + j]; }

__device__ __forceinline__ void chk_rmix(const Args& a, int layer, int id, LAS unsigned char* ldsb) {
    if (blockIdx.x >= 16) return; const int tid = tid_opaque(), r = dbg_sample_row(blockIdx.x);
    LAS float* red = (LAS float*)ldsb;
    const float* x = resid_row(a, layer, r); const bf16* hb = (const bf16*)(a.ws + WS_HB) + (size_t)r * D;
    float ss = 0.f; for (int cc = tid; cc < D; cc += 512) ss += x[cc] * x[cc];
    ss = blk_sum(ss, red, tid); const float rstd = rsqrtf(ss / D + EPS);
    float err = 0.f, sr = 0.f;
    for (int cc = tid; cc < D; cc += 512) { const float sh = dbg_mod(a, layer, r, cc), sc = dbg_mod(a, layer, r, D + cc);
        const float ref = x[cc] * rstd * a.in[I_NMIX][layer * D + cc] * (1.f + sc) + sh; err = fmaxf(err, fabsf(ref - dbg_hb(a, layer, (size_t)r * D + cc, 1.f))); sr += ref * ref; }
    err = blk_max(err, red, tid); sr = blk_sum(sr, red, tid); dbg_report(a, id, err, sr, D, tid);
}
__device__ __forceinline__ void chk_qkv(const Args& a, int layer, int id, LAS unsigned char* ldsb) {
    if (blockIdx.x >= 16) return; const int tid = tid_opaque(), r = dbg_sample_row(blockIdx.x), j = layer ? 1 : 0;
    LAS float* red = (LAS float*)ldsb; LAS float* y = red + 16; LAS float* hrow = y + 1536;
    const bf16* hb = (const bf16*)(a.ws + WS_HB) + (size_t)r * D;
    _Pragma("nounroll") for (int k = tid; k < D; k += 512) hrow[k] = dbg_hb(a, layer, (size_t)r * D + k, 1.f);
    __syncthreads();
    for (int n = tid; n < 1536; n += 512) { float s = 0.f; const float* w = a.in[I_WQKV] + (size_t)j * 1024 * 1536 + n; _Pragma("nounroll") for (int k = 0; k < 1024; ++k) s += hrow[k] * w[(size_t)k * 1536]; y[n] = s; }
    __syncthreads();
    float err = 0.f, sr = 0.f;
    for (int n = tid; n < 1536; n += 512) { float ref;
        if (n < 1280) { const int h0 = n & ~63; float ss = 0.f; _Pragma("nounroll") for (int q = 0; q < 64; ++q) ss += y[h0 + q] * y[h0 + q];
            const float rstd = rsqrtf(ss / 64.f + EPS); const float* g = (n < 1024 ? a.in[I_QG] : a.in[I_KG]) + j * 64;
            float v = y[n] * rstd * g[n & 63], vp = y[n ^ 1] * rstd * g[(n ^ 1) & 63];
            if (r < TL) { const int t = r % SEQ, i = (n & 63) >> 1, f = i & 15, pos = i < 16 ? t / 64 : t % 64; const float inv = powf(10000.f, -(float)f / 16.f), ang = (float)pos * inv, cs = cosf(ang), sn = sinf(ang);
                v = (n & 1) ? (vp * sn + v * cs) : (v * cs - vp * sn); }
            if (n < 1024) v *= 0.125f * 1.4426950408889634f;
            ref = v; } else ref = y[n];
        float got;
        if (n < 1024) { if (layer == 3 && r >= TL) continue; got = bf2f(((const bf16*)(a.ws + WS_Q))[(size_t)r * 1024 + n]); }
        else if (n < 1280) got = bf2f(((const bf16*)(a.ws + WS_K))[kv_row(r) * 256 + (n - 1024)]);
        else got = bf2f(((const bf16*)(a.ws + WS_V))[kv_row(r) * 256 + (n - 1280)]);
        err = fmaxf(err, fabsf(ref - got)); sr += ref * ref; }
    err = blk_max(err, red, tid); sr = blk_sum(sr, red, tid); dbg_report(a, id, err, sr, 1536, tid);
}
__device__ __forceinline__ void chk_att(const Args& a, int layer, int id, LAS unsigned char* ldsb) {
    if (blockIdx.x >= 16) return; const int tid = tid_opaque(), r = dbg_sample_row(blockIdx.x);
    if (layer == 3 && r >= TL) return;
    LAS float* red = (LAS float*)ldsb; LAS float* sc = red + 16; LAS float* po = sc + 4352;
    const int nk = r < TL ? KVROWS : CTXL; const long kv0 = (long)(r < TL ? r / SEQ : (r - TL) / CTXL) * KVROWS;
    const bf16* Qb = (const bf16*)(a.ws + WS_Q); const bf16* Kb = (const bf16*)(a.ws + WS_K); const bf16* Vb = (const bf16*)(a.ws + WS_V); const bf16* Ob = (const bf16*)(a.ws + WS_HB);
    float err = 0.f, sr = 0.f;
    for (int h = 0; h < 16; ++h) {
        float mx = -3e38f;
        _Pragma("nounroll") for (int jk = tid; jk < nk; jk += 512) { float s = 0.f; _Pragma("nounroll") for (int d = 0; d < 64; ++d) s += bf2f(Qb[(size_t)r * 1024 + h * 64 + d]) * bf2f(Kb[(kv0 + jk) * 256 + (h >> 2) * 64 + d]); sc[jk] = s; mx = fmaxf(mx, s); }
        mx = blk_max(mx, red, tid);
        float l = 0.f; _Pragma("nounroll") for (int jk = tid; jk < nk; jk += 512) { const float p = exp2f(sc[jk] - mx); sc[jk] = p; l += p; }
        l = blk_sum(l, red, tid);
        { const int d = tid & 63, part = tid >> 6; float o = 0.f; _Pragma("nounroll") for (int jk = part; jk < nk; jk += 8) o += sc[jk] * bf2f(Vb[(kv0 + jk) * 256 + (h >> 2) * 64 + d]); po[part * 64 + d] = o; }
        __syncthreads();
        if (tid < 64) { float o = 0.f; _Pragma("nounroll") for (int p = 0; p < 8; ++p) o += po[p * 64 + tid]; o /= l; err = fmaxf(err, fabsf(o - dbg_hb(a, layer, (size_t)r * 1024 + h * 64 + tid, 1.f / (float)(1 << ATT_OSH)))); sr += o * o; }
        __syncthreads();
    }
    err = blk_max(err, red, tid); sr = blk_sum(sr, red, tid); dbg_report(a, id, err, sr, 1024, tid);
}
__device__ __forceinline__ void chk_oproj(const Args& a, int layer, int id, LAS unsigned char* ldsb) {
    if (blockIdx.x >= 16 || layer != 0) return; const int tid = tid_opaque(), r = dbg_sample_row(blockIdx.x), j = 0;
    LAS float* red = (LAS float*)ldsb; LAS float* orow = red + 16;
    const bf16* Ob = (const bf16*)(a.ws + WS_HB) + (size_t)r * D;
    _Pragma("nounroll") for (int k = tid; k < D; k += 512) orow[k] = dbg_hb(a, layer, (size_t)r * D + k, 1.f / (float)(1 << ATT_OSH));
    __syncthreads();
    float err = 0.f, sr = 0.f;
    for (int n = tid; n < D; n += 512) { float s = 0.f; const float* w = a.in[I_WO] + (size_t)j * 1024 * 1024 + n; _Pragma("nounroll") for (int k = 0; k < 1024; ++k) s += orow[k] * w[(size_t)k * 1024];
        const float dl = dbg_mod(a, layer, r, 2 * D + n) * s, ref = resid_row(a, 0, r)[n] + dl; err = fmaxf(err, fabsf(ref - ((const float*)(a.ws + WS_X))[(size_t)r * D + n])); sr += dl * dl; }
    err = blk_max(err, red, tid); sr = blk_sum(sr, red, tid); dbg_report(a, id, err, sr, D, tid);
}
__device__ __forceinline__ void chk_moe(const Args& a, int layer, int id_tok, int id_y, LAS unsigned char* ldsb) {
    if (blockIdx.x >= 16) return; const int tid = tid_opaque(), r = dbg_sample_row(blockIdx.x);
    if (layer == 3 && r >= TL) return;
    LAS float* red = (LAS float*)ldsb; LAS float* tok = red + 16; LAS float* lg = tok + 1024; LAS float* tkb = lg + 64; LAS float* act = tkb + 1024; LAS float* rt = act + 1024;
    const float* x = (const float*)(a.ws + WS_X) + (size_t)r * D; const bf16* tk = (const bf16*)(a.ws + WS_TK) + (size_t)r * D;
    float ss = 0.f; for (int cc = tid; cc < D; cc += 512) ss += x[cc] * x[cc];
    ss = blk_sum(ss, red, tid); const float rstd = rsqrtf(ss / D + EPS);
    float err = 0.f, sr = 0.f;
    for (int cc = tid; cc < D; cc += 512) { const float sh = dbg_mod(a, layer, r, 3 * D + cc), sc = dbg_mod(a, layer, r, 4 * D + cc);
        const float ref = x[cc] * rstd * a.in[I_NFFN][layer * D + cc] * (1.f + sc) + sh; tok[cc] = ref;
#if MOE_FP8
        tkb[cc] = __builtin_amdgcn_cvt_f32_fp8((unsigned)((const unsigned char*)(a.ws + WS_TK))[(size_t)r * D + cc], 0);
#else
        tkb[cc] = bf2f(tk[cc]);
#endif
        err = fmaxf(err, fabsf(ref - tkb[cc])); sr += ref * ref; }
    err = blk_max(err, red, tid); sr = blk_sum(sr, red, tid);
    if (tid < 36) { float s = 0.f; _Pragma("nounroll") for (int k = 0; k < 1024; ++k) s += tok[k] * (tid < 4 ? a.in[I_WRG][((size_t)layer * 1024 + k) * 4 + tid] : a.in[I_WRE][((size_t)layer * 1024 + k) * 32 + tid - 4]); lg[tid] = s; }
    __syncthreads();
    if (tid == 0) { int grp = 0; _Pragma("nounroll") for (int q = 1; q < 4; ++q) if (lg[q] > lg[grp]) grp = q; float den = 0.f; _Pragma("nounroll") for (int q = 0; q < 4; ++q) den += expf(lg[q] - lg[grp]);
        const LAS float* le = lg + 4 + grp * 8; int i0 = 0; _Pragma("nounroll") for (int q = 1; q < 8; ++q) if (le[q] > le[i0]) i0 = q; int i1 = -1; _Pragma("nounroll") for (int q = 0; q < 8; ++q) if (q != i0 && (i1 < 0 || le[q] > le[i1])) i1 = q;
        const float ex = expf(le[i1] - le[i0]), w0 = 1.f / den / (1.f + ex), w1 = 1.f / den * ex / (1.f + ex);
        rt[0] = (float)(grp * 8 + i0); rt[1] = (float)(grp * 8 + i1); rt[2] = w0; rt[3] = w1;
        const float* w2 = (const float*)(a.ws + WS_W2); float e2 = fmaxf(fabsf(w2[2 * r] - w0), fabsf(w2[2 * r + 1] - w1)) * 30.f;
        const int* list = (const int*)(a.ws + WS_LIST); const unsigned* gc = (const unsigned*)(a.ws + WS_CTL) + CW_CNT + layer * 32;
        _Pragma("nounroll") for (int k = 0; k < 2; ++k) { const int e = (int)rt[k]; bool found = false; const int n = (int)gc[e]; _Pragma("nounroll") for (int q = 0; q < n && q < MOE_CAP; ++q) if (list[e * MOE_CAP + q] == 2 * r + k) found = true; if (!found) e2 = 1e6f; }
        rt[4] = e2; }
    __syncthreads();
    err = fmaxf(err, rt[4] * sqrtf(sr / D));
    dbg_report(a, id_tok, err, sr, D, tid);
    float err2 = 0.f, sr2 = 0.f;
    _Pragma("nounroll") for (int k = 0; k < 2; ++k) { const int e = (int)rt[k]; const float wk = rt[2 + k];
        const float* wgu = a.in[I_WGU] + ((size_t)layer * 32 + e) * 1024 * 1024; const float* wdn = a.in[I_WDN] + ((size_t)layer * 32 + e) * 512 * 1024;
        { float sg = 0.f, su = 0.f; _Pragma("nounroll") for (int q = 0; q < 1024; ++q) { sg += tkb[q] * wgu[(size_t)q * 1024 + tid]; su += tkb[q] * wgu[(size_t)q * 1024 + 512 + tid]; } act[tid] = (sg / (1.f + expf(-sg))) * su; }
        __syncthreads();
        for (int n = tid; n < D; n += 512) { float s = 0.f; _Pragma("nounroll") for (int q = 0; q < 512; ++q) s += act[q] * wdn[(size_t)q * 1024 + n]; s *= wk;
            err2 = fmaxf(err2, fabsf(s - bf2f(((const bf16*)(a.ws + WS_Y2))[(size_t)(2 * r + k) * D + n]))); sr2 += s * s; }
        __syncthreads(); }
    err2 = blk_max(err2, red, tid); sr2 = blk_sum(sr2, red, tid); dbg_report(a, id_y, err2, sr2, 2 * D, tid);
}

__global__ void __launch_bounds__(NTHREADS) dbg_kernel(Args a, int ty, int layer, int id) {
    extern __shared__ __attribute__((aligned(16))) unsigned char lds_dbg[];
    LAS unsigned char* l = (LAS unsigned char*)lds_dbg;
    if (ty == 1) chk_rmix(a, layer, id, l); else if (ty == 2) chk_qkv(a, layer, id, l); else if (ty == 3) chk_att(a, layer, id, l);
    else if (ty == 4) chk_oproj(a, layer, id, l); else if (ty == 5) chk_moe(a, layer, id, id + 1, l);
}
#endif

template <int KIND, int LAYER> __device__ __forceinline__ void run_phase(const Args& a0, Ctx& c, unsigned char* lds_gen) {
    Args a = a0; { unsigned long long wsv = (unsigned long long)a0.ws; asm volatile("" : "+s"(wsv)); a.ws = (unsigned char*)(GAS unsigned char*)wsv; }
    { unsigned lb = (unsigned)(uintptr_t)(LAS unsigned char*)lds_gen; asm volatile("" : "+s"(lb)); c.lds = (LAS unsigned char*)(uintptr_t)lb; }
    c.tid = tid_opaque(); c.lane = c.tid & 63;
    unsigned char* const ws = a.ws; constexpr int layer = LAYER;
#define RELAUNDER() do { { unsigned long long wsv_ = (unsigned long long)a0.ws; asm volatile("" : "+s"(wsv_)); a.ws = (unsigned char*)(GAS unsigned char*)wsv_; } \
        { unsigned lb_ = (unsigned)(uintptr_t)(LAS unsigned char*)lds_gen; asm volatile("" : "+s"(lb_)); c.lds = (LAS unsigned char*)(uintptr_t)lb_; } c.tid = tid_opaque(); c.lane = c.tid & 63; } while (0)
    if constexpr (KIND == K_P0) p0_prologue(a, c);
    else if constexpr (KIND == K_RMIX) ph_rmix(a, c, layer);
    else if constexpr (KIND == K_QKV) { constexpr int j = layer ? 1 : 0;
#if ATT_FP8
        SchedQKV S{(const char*)(ws + WS_HB), (const char*)(ws + WS_WQKV) + (size_t)j * 1536 * 1024, (size_t)256 * 1024, layer == 0 ? 1 : 0, c.G, (int)blockIdx.x};
        EpiQKV E{(bf16*)(ws + WS_Q), (bf16*)(ws + WS_K), (bf16*)(ws + WS_V), a.in[I_QG] + j * 64, a.in[I_KG] + j * 64, (const f32x2*)(ws + WS_ROPE)};
        pg8::gemm_phase<EpiQKV, SchedQKV, false, true>(c.lds, 1024, 1024, S, E, 127 - MOE_WSH, 127); }
#else
        SchedQKV S{(const char*)(ws + WS_HB), (const char*)(ws + WS_WQKV) + (size_t)j * 1536 * 1024 * 2, (size_t)256 * 1024 * 2, layer == 0 ? 1 : 0, c.G, (int)blockIdx.x};
        EpiQKV E{(bf16*)(ws + WS_Q), (bf16*)(ws + WS_K), (bf16*)(ws + WS_V), a.in[I_QG] + j * 64, a.in[I_KG] + j * 64, (const f32x2*)(ws + WS_ROPE)};
        pg8::gemm_phase<EpiQKV, SchedQKV, false>(c.lds, 2048, 2048, S, E); }
#endif
    else if constexpr (KIND == K_ROPE) ph_rope(a, c, layer);
    else if constexpr (KIND == K_ATT) ph_att(a, c, layer, (char*)c.lds);
    else if constexpr (KIND == K_OPROJ) { constexpr int j = layer ? 1 : 0;
#if ATT_FP8
        unsigned* rdx = (unsigned*)(ws + WS_CTL) + CW_RDX + layer * 128;
        SchedDenseR S{(const char*)(ws + WS_HB), (const char*)(ws + WS_WO) + (size_t)j * 1024 * 1024, (size_t)256 * 1024, (size_t)256 * 1024, 0, layer == 3 ? 64 : 68, 4, 64, c.G, (int)blockIdx.x, rdx};
        EpiResid E{&a, layer, nullptr, nullptr};
        pg8::gemm_phase<EpiResid, SchedDenseR, false, true>(c.lds, 1024, 1024, S, E, 127 - MOE_WSH, 127 - ATT_OSH);
        RELAUNDER(); ph_m1(a, c, layer, (unsigned*)(a.ws + WS_CTL) + CW_RDX + layer * 128, 4, 0); }
#else
        unsigned* rdx = (unsigned*)(ws + WS_CTL) + CW_RDX + layer * 128;
        SchedDenseR S{(const char*)(ws + WS_HB), (const char*)(ws + WS_WO) + (size_t)j * 1024 * 1024 * 2, (size_t)256 * 1024 * 2, (size_t)256 * 1024 * 2, 0, layer == 3 ? 64 : 68, 4, 64, c.G, (int)blockIdx.x, rdx};
        EpiResid E{&a, layer, nullptr, nullptr};
        pg8::gemm_phase<EpiResid, SchedDenseR, false>(c.lds, 2048, 2048, S, E);
        RELAUNDER(); ph_m1(a, c, layer, (unsigned*)(a.ws + WS_CTL) + CW_RDX + layer * 128, 4, 0); }
#endif
    else if constexpr (KIND == K_M2) {
        LAS int* tab = (LAS int*)(c.lds + TAB_OFF); moe_tables(a, c, layer, tab);
        unsigned* rdy = (unsigned*)(ws + WS_CTL) + CW_RDY + layer * 256;
#if MOE_FP8
        { SchedMoe S{(const char*)(ws + WS_TK), 0, (const char*)(ws + WS_WGU) + (size_t)layer * 32 * 1024 * 1024, (size_t)1024 * 1024, (size_t)256 * 1024, tab, (const int*)(ws + WS_LIST), c.G, (int)blockIdx.x, rdy, 1};
          EpiGateUp E{(bf16*)(ws + WS_ACT)};
          pg8::gemm_phase<EpiGateUp, SchedMoe, true, true>(c.lds, 1024, 1024, S, E, 127 - MOE_WSH, 127); }
        { SchedMoe S{(const char*)(ws + WS_ACT), (size_t)256 * 512, (const char*)(ws + WS_WDN) + (size_t)layer * 32 * 1024 * 512, (size_t)1024 * 512, (size_t)256 * 512, tab, (const int*)(ws + WS_LIST), c.G, (int)blockIdx.x, rdy, 2};
          EpiDown E{(const int*)(ws + WS_LIST), (const float*)(ws + WS_W2), (bf16*)(ws + WS_Y2)};
          pg8::gemm_phase<EpiDown, SchedMoe, false, true>(c.lds, 512, 512, S, E, 127 - MOE_WSH, 127 - MOE_ASH); } }
#else
        { SchedMoe S{(const char*)(ws + WS_TK), 0, (const char*)(ws + WS_WGU) + (size_t)layer * 32 * 1024 * 1024 * 2, (size_t)1024 * 1024 * 2, (size_t)256 * 1024 * 2, tab, (const int*)(ws + WS_LIST), c.G, (int)blockIdx.x, rdy, 1};
          EpiGateUp E{(bf16*)(ws + WS_ACT)};
          pg8::gemm_phase<EpiGateUp, SchedMoe, true>(c.lds, 2048, 2048, S, E); }
        { SchedMoe S{(const char*)(ws + WS_ACT), (size_t)256 * 512 * 2, (const char*)(ws + WS_WDN) + (size_t)layer * 32 * 1024 * 512 * 2, (size_t)1024 * 512 * 2, (size_t)256 * 512 * 2, tab, (const int*)(ws + WS_LIST), c.G, (int)blockIdx.x, rdy, 2};
          EpiDown E{(const int*)(ws + WS_LIST), (const float*)(ws + WS_W2), (bf16*)(ws + WS_Y2)};
          pg8::gemm_phase<EpiDown, SchedMoe, false>(c.lds, 1024, 1024, S, E); } }
#endif
    else if constexpr (KIND == K_RPOOL) ph_rpool(a, c, layer);
    else if constexpr (KIND == K_POOLG) {
        unsigned* rdx = (unsigned*)(ws + WS_CTL) + CW_RDX + layer * 128;
        SchedDenseR S{(const char*)(ws + WS_HB), (const char*)(ws + WS_WPOOL), (size_t)256 * 1024 * 2, (size_t)256 * 256 * 2, (size_t)256 * 2, 68, 4, 64, c.G, (int)blockIdx.x, rdx};
        EpiResidN E{&a, layer, a.in[I_POOLS], (const bf16*)(ws + WS_Z)};
        pg8::gemm_phase<EpiResidN, SchedDenseR, false>(c.lds, 512, 2048, S, E);
        RELAUNDER(); ph_m1(a, c, layer, (unsigned*)(a.ws + WS_CTL) + CW_RDX + layer * 128, 4, 0); }
    else if constexpr (KIND == K_INPROJ) {
        SchedDense S{(const char*)(ws + WS_HB), (const char*)(ws + WS_WIN), (size_t)256 * 1024 * 2, (size_t)256 * 1024 * 2, 0, 68, 21, c.G, (int)blockIdx.x};
        EpiInproj E{(bf16*)(ws + WS_Z), (bf16*)(ws + WS_XBC), (float*)(ws + WS_DT), a.in[I_DTB]};
        pg8::gemm_phase<EpiInproj, SchedDense, false>(c.lds, 2048, 2048, S, E); }
    else if constexpr (KIND == K_CONV) ph_conv(a, c);
    else if constexpr (KIND == K_SCAN) ph_scan(a, c);
    else if constexpr (KIND == K_YPH) {
        ph_yph(a, c, (unsigned*)(ws + WS_CTL) + CW_RDG);
        RELAUNDER();
        { unsigned* rdx = (unsigned*)(a.ws + WS_CTL) + CW_RDX + layer * 128;
          SchedOutproj S{(const char*)(a.ws + WS_G), (const char*)(a.ws + WS_WOUT), (size_t)256 * 2048 * 2, (size_t)256 * 2048 * 2, c.G, c.vcu, (const unsigned*)(a.ws + WS_CTL) + CW_RDG, rdx};
          EpiResid E{&a, layer, nullptr, nullptr};
          pg8::gemm_phase<EpiResid, SchedOutproj, false>(c.lds, 4096, 4096, S, E); }
        RELAUNDER(); ph_m1(a, c, layer, (unsigned*)(a.ws + WS_CTL) + CW_RDX + layer * 128, 4, 1); }
    else if constexpr (KIND == K_GFIX) ph_gfix(a, c);
    else if constexpr (KIND == K_FINAL) ph_final(a, c, layer);
#undef RELAUNDER
}
#define PROGRAM(X) \
    X(0, K_P0, 0) \
    X(1, K_RMIX, 0) X(2, K_QKV, 0) X(3, K_ATT, 0) X(4, K_OPROJ, 0) X(5, K_M2, 0) \
    X(6, K_RPOOL, 1) X(7, K_POOLG, 1) X(8, K_M2, 1) \
    X(9, K_RMIX, 2) X(10, K_INPROJ, 2) X(11, K_CONV, 2) X(12, K_SCAN, 2) X(13, K_YPH, 2) X(14, K_M2, 2) \
    X(15, K_RMIX, 3) X(16, K_QKV, 3) X(17, K_ATT, 3) X(18, K_OPROJ, 3) X(19, K_M2, 3) \
    X(20, K_FINAL, 4)
constexpr int NPHASES = 21;
__device__ __forceinline__ unsigned long long probe_phases(const unsigned long long* ts, unsigned mask) { unsigned long long r = 0; for (int k = 0; k < 32; ++k) if (mask & (1u << k)) r += ts[k + 1] - ts[k]; return r; }
__device__ __forceinline__ unsigned long long probe_sum(const unsigned long long* s, int mask) { unsigned long long r = 0; for (int k = 0; k < 8; ++k) if (mask & (1 << k)) r += s[k]; return r; }
__global__ void __launch_bounds__(NTHREADS, 2) mega(Args a0) {
    extern __shared__ __attribute__((aligned(16))) unsigned char lds_raw[];
    Ctx c; c.lds = (LAS unsigned char*)lds_raw; c.tid = threadIdx.x; c.lane = c.tid & 63; c.wave = __builtin_amdgcn_readfirstlane(c.tid >> 6);
    c.G = gridDim.x; { const int bx = blockIdx.x; c.vcu = (c.G % 8 == 0) ? (bx % 8) * (c.G / 8) + bx / 8 : bx; }
    volatile LAS unsigned* MISC = (volatile LAS unsigned*)(c.lds + MISC_OFF);
    for (int u = c.tid; u < 128; u += NTHREADS) MISC[u] = 0u;
    __syncthreads();
    XcdBarrier bar = xcd_barrier_post((unsigned*)(a0.ws + WS_CTL) + CW_BAR + a0.bar_region * XCD_BAR_WORDS, MISC + 8);
    const int lo = a0.ph_lo, hi = a0.ph_hi;
#if PROBE
#define STAMP(idx) if (blockIdx.x == 0 && threadIdx.x == 0) __hip_atomic_store((unsigned long long*)((unsigned*)(a0.ws + WS_CTL) + CW_TS) + (idx), (unsigned long long)__builtin_amdgcn_s_memrealtime(), __ATOMIC_RELAXED, __HIP_MEMORY_SCOPE_AGENT);
#else
#define STAMP(idx)
#endif
    STAMP(0)
#if EXTRA_BARS
    for (int eb = 0; eb < EXTRA_BARS; ++eb) xcd_barrier(bar);
#endif
#define RUNPH(idx, KIND, LAYER) if (lo <= (idx) && (idx) < hi) { run_phase<KIND, LAYER>(a0, c, lds_raw); if ((idx) + 1 < hi) xcd_barrier(bar); STAMP((idx) + 1) }
    PROGRAM(RUNPH)
#undef RUNPH
#if PROBE
    if (blockIdx.x == 0 && threadIdx.x == 0 && hi == NPHASES) { const unsigned long long* ts = (const unsigned long long*)((unsigned*)(a0.ws + WS_CTL) + CW_TS);
        const unsigned long long d = (unsigned long long)PROBE_K * (PROBE_SLOT ? probe_sum(ts + PROBE_SLOT_BASE, PROBE_SLOT) : probe_phases(ts, PROBE_MASK)), t0 = __builtin_amdgcn_s_memrealtime();
        while (__builtin_amdgcn_s_memrealtime() - t0 < d) __builtin_amdgcn_s_sleep(8); }
#endif
}

extern "C" void kernel_launch(void* const* d_in, const int* in_sizes, int n_in, void* d_out, int out_size, void* d_ws, size_t ws_size, hipStream_t stream) {
    static int grid = 0;
    if (grid == 0) {
        if (n_in != N_IN || out_size != TL * D || ws_size < WS_END) { fprintf(stderr, "kernel_launch: unexpected shapes (n_in %d out %d ws %zu)\n", n_in, out_size, ws_size); grid = -1; return; }
        int dev = 0, cus = 0;
        if (hipGetDevice(&dev) != hipSuccess || hipDeviceGetAttribute(&cus, hipDeviceAttributeMultiprocessorCount, dev) != hipSuccess) { grid = -1; return; }
        if (hipFuncSetAttribute((const void*)mega, hipFuncAttributeMaxDynamicSharedMemorySize, LDS_BYTES) != hipSuccess) { fprintf(stderr, "kernel_launch: hipFuncSetAttribute failed\n"); grid = -1; return; }
        int per_cu = 0;
        if (hipOccupancyMaxActiveBlocksPerMultiprocessor(&per_cu, (const void*)mega, NTHREADS, LDS_BYTES) != hipSuccess || per_cu < 1) fprintf(stderr, "kernel_launch: occupancy query says %d\n", per_cu);
        (void)hipGetLastError();
        grid = cus;
    }
    if (grid < 0) return;
    (void)hipMemsetAsync((char*)d_ws + WS_CTL, 0, CTL_ZERO_BYTES, stream);
    Args a{};
    for (int i = 0; i < N_IN; ++i) a.in[i] = (const float*)d_in[i];
    a.out = (float*)d_out; a.ws = (unsigned char*)d_ws; a.flags = 0;
#if DEBUG_CHECKS
    struct Cut { int after; int ty, layer, nid; };
    const Cut cuts[] = DEBUG_CUTS;
    int lo = 0, region = 0, dbg_id = 1;
    for (unsigned k = 0; k < sizeof(cuts) / sizeof(cuts[0]); ++k) {
        if (cuts[k].after + 1 > lo) { a.ph_lo = lo; a.ph_hi = cuts[k].after + 1; a.bar_region = region++; hipLaunchKernelGGL(mega, dim3(grid), dim3(NTHREADS), LDS_BYTES, stream, a); lo = cuts[k].after + 1; }
        hipLaunchKernelGGL(dbg_kernel, dim3(16), dim3(NTHREADS), 65536, stream, a, cuts[k].ty, cuts[k].layer, dbg_id); dbg_id += cuts[k].nid;
    }
    a.ph_lo = lo; a.ph_hi = NPHASES; a.bar_region = region++;
    hipLaunchKernelGGL(mega, dim3(grid), dim3(NTHREADS), LDS_BYTES, stream, a);
#else
    a.ph_lo = 0; a.ph_hi = NPHASES; a.bar_region = 0;
    hipLaunchKernelGGL(mega, dim3(grid), dim3(NTHREADS), LDS_BYTES, stream, a);
#endif
}
```

```cpp
#include <hip/hip_runtime.h>
#include <cstdio>
#include <cstdint>

#define LAS __attribute__((address_space(3)))
#define GAS __attribute__((address_space(1)))
typedef unsigned short bf16;
typedef short bf16x8 __attribute__((ext_vector_type(8)));
typedef short s16x4 __attribute__((ext_vector_type(4)));
typedef float f32x2 __attribute__((ext_vector_type(2)));
typedef float f32x4 __attribute__((ext_vector_type(4)));
typedef float f32x16 __attribute__((ext_vector_type(16)));
typedef unsigned u32x2 __attribute__((ext_vector_type(2)));
typedef unsigned u32x4 __attribute__((ext_vector_type(4)));
typedef __bf16 bf16x2_t __attribute__((ext_vector_type(2)));

constexpr int D = 1024, NB = 4, SEQ = 4096, CTXL = 256, TL = NB * SEQ, TC = NB * CTXL, TT = TL + TC;
constexpr int KVROWS = SEQ + CTXL;
constexpr int NCH = TT / 128;
constexpr int MOE_CAP = TT;
constexpr float EPS = 1e-6f;
constexpr int NWAVES = 8, NTHREADS = 512;
#ifndef NLAYERS
#define NLAYERS 4
#endif
#ifndef MOE_FP8
#define MOE_FP8 1
#endif
#define MOE_WSH 5
#ifndef ATT_FP8
#define ATT_FP8 1
#endif
#define ATT_OSH 3
#define MOE_ASH 2
#define DBG_TOL 0.03f
#ifndef DEBUG_CHECKS
#define DEBUG_CHECKS 0
#endif
#ifndef PROBE
#define PROBE 0
#endif
#define PROBE_A0 0
#define PROBE_A1 1
#define PROBE_B0 4
#define PROBE_B1 5
#define PROBE_K 2
#define PROBE_MASK 0x1222224u
#define EXTRA_BARS 0
#define PROBE_SLOT_BASE 40
#define PROBE_SLOT 0
#if PROBE
#define SECT_DECL unsigned long long sect_t = __builtin_amdgcn_s_memrealtime(); unsigned long long sect_acc[8] = {0, 0, 0, 0, 0, 0, 0, 0};
#define SECT(k) do { const unsigned long long n_ = __builtin_amdgcn_s_memrealtime(); sect_acc[k] += n_ - sect_t; sect_t = n_; } while (0)
#ifndef PROBE_BLOCK
#define PROBE_BLOCK 0
#endif
#define SECT_END(base) do { if (blockIdx.x == PROBE_BLOCK && threadIdx.x == 0) { _Pragma("unroll") for (int k_ = 0; k_ < 8; ++k_) ((unsigned long long*)((unsigned*)(a.ws + WS_CTL) + CW_TS))[(base) + k_] = sect_acc[k_]; } } while (0)
#else
#define SECT_DECL
#define SECT(k) do {} while (0)
#define SECT_END(base) do {} while (0)
#endif
#define DEBUG_CUTS { {1, 1, 0, 1}, {2, 2, 0, 1}, {3, 3, 0, 1}, {4, 4, 0, 1}, {6, 5, 0, 2} }

enum { I_X = 0, I_C, I_CTX, I_CCTX, I_WADA, I_BADA, I_NMIX, I_NFFN, I_NFIN, I_WQKV, I_WO, I_QG, I_KG, I_POOLW, I_POOLS, I_WIN, I_CONVW, I_CONVB, I_DTB, I_ALOG, I_DSK, I_SNORM, I_WOUT, I_WRG, I_WRE, I_WGU, I_WDN, N_IN };

constexpr size_t MiB = 1u << 20;
constexpr size_t WS_CTL = 0, CTL_ZERO_BYTES = 1 * MiB;
constexpr size_t WS_MODL = 1 * MiB;
constexpr size_t WS_MODC = WS_MODL + 4 * 4 * 6144 * 4;
constexpr size_t WS_ROPE = 1 * MiB + 512 * 1024;
constexpr size_t WS_WR = 2 * MiB;
constexpr size_t WS_WQKV = 3 * MiB;
constexpr size_t WS_WO = 9 * MiB;
constexpr size_t WS_WPOOL = 13 * MiB;
constexpr size_t WS_WIN = 14 * MiB;
constexpr size_t WS_WOUT = 25 * MiB;
constexpr size_t WS_WGU = 29 * MiB;
constexpr size_t WS_WDN = 285 * MiB;
constexpr size_t WS_X = 413 * MiB;
constexpr size_t WS_HB = 481 * MiB;
constexpr size_t WS_TK = 515 * MiB;
constexpr size_t WS_Q = 549 * MiB;
constexpr size_t WS_K = 583 * MiB;
constexpr size_t WS_V = 592 * MiB;
constexpr size_t WS_Y2 = 601 * MiB;
constexpr size_t WS_ACT = 669 * MiB;
constexpr size_t WS_LIST = 711 * MiB;
constexpr size_t WS_W2 = 714 * MiB;
constexpr size_t WS_Z = 715 * MiB;
constexpr size_t WS_XBC = 783 * MiB;
constexpr size_t WS_DT = 885 * MiB;
constexpr size_t WS_XT = 890 * MiB;
constexpr size_t WS_BN = 958 * MiB;
constexpr size_t WS_BT = 975 * MiB;
constexpr size_t WS_CN = 992 * MiB;
constexpr size_t WS_SCA = 1009 * MiB;
constexpr size_t WS_SCB = 1018 * MiB;
constexpr size_t WS_DEC = 1027 * MiB;
constexpr size_t WS_HIN = 1028 * MiB;
constexpr size_t WS_G = 1164 * MiB;
constexpr size_t WS_RSTD = 1232 * MiB;
constexpr size_t WS_END = 1233 * MiB;

constexpr int CW_BAR = 4096;
constexpr int CW_CNT = 200000;
constexpr int CW_DBG = 201000;
constexpr int CW_RDY = 204000;
constexpr int CW_RDG = 207000;
constexpr int CW_RDX = 206000;
constexpr int CW_TS = 202000;

constexpr int LDS_BYTES = 163840;
constexpr int MISC_OFF = LDS_BYTES - 512;

__device__ __forceinline__ unsigned cvtpk(float lo, float hi) { f32x2 v = {lo, hi}; bf16x2_t b = __builtin_convertvector(v, bf16x2_t); return __builtin_bit_cast(unsigned, b); }
__device__ __forceinline__ unsigned pk_fp8x4(float a, float b, float c, float d) {
    a = __builtin_amdgcn_fmed3f(a, -448.f, 448.f); b = __builtin_amdgcn_fmed3f(b, -448.f, 448.f); c = __builtin_amdgcn_fmed3f(c, -448.f, 448.f); d = __builtin_amdgcn_fmed3f(d, -448.f, 448.f);
    unsigned w = __builtin_amdgcn_cvt_pk_fp8_f32(a, b, 0u, false); return __builtin_amdgcn_cvt_pk_fp8_f32(c, d, w, true); }
__device__ __forceinline__ float bflo(unsigned u) { return __uint_as_float(u << 16); }
__device__ __forceinline__ float bfhi(unsigned u) { return __uint_as_float(u & 0xffff0000u); }
__device__ __forceinline__ float bf2f(bf16 b) { return __uint_as_float((unsigned)b << 16); }
__device__ __forceinline__ float wave_sum(float v) {
#pragma unroll
    for (int o = 1; o < 64; o <<= 1) v += __shfl_xor(v, o);
    return v;
}
__device__ __forceinline__ float silu_f(float v) { return v * __builtin_amdgcn_rcpf(1.0f + __builtin_amdgcn_exp2f(v * -1.4426950408889634f)); }
__device__ __forceinline__ int tid_opaque() { int t = threadIdx.x; asm volatile("" : "+v"(t)); return t; }
#define LDS_WAIT() asm volatile("s_waitcnt lgkmcnt(0)" ::: "memory")
#define VM_WAIT() asm volatile("s_waitcnt vmcnt(0)" ::: "memory")

#define XB_TMO      128
#define XB_XCNT(j)  (256  + 64 * (j))
#define XB_XSUB(j)  (1280 + 64 * (j))
#define XB_XGEN(j)  (2304 + 64 * (j))
#define XB_TOP      3328
#define XB_TOPGEN   3392
#define XCD_BAR_WORDS 3456
#define XB_SPIN_CAP (1u << 20)
#ifndef XB_FLATPOLL
#define XB_FLATPOLL 0
#endif
__device__ __forceinline__ unsigned xb_ld(unsigned* p)              { return __hip_atomic_load(p, __ATOMIC_RELAXED, __HIP_MEMORY_SCOPE_AGENT); }
__device__ __forceinline__ unsigned xb_add(unsigned* p, unsigned v) { return __hip_atomic_fetch_add(p, v, __ATOMIC_RELAXED, __HIP_MEMORY_SCOPE_AGENT); }
__device__ __forceinline__ unsigned xb_xcc_id() { return (unsigned)__builtin_amdgcn_s_getreg((3 << 11) | 20) & 0xFu; }
#define XB_SPIN(cond, bar) do { unsigned _sp = 0; while (cond) { __builtin_amdgcn_s_sleep(1); \
    if ((++_sp & 255u) == 0u) { if (xb_ld(&(bar)[XB_TMO])) break; if (_sp > XB_SPIN_CAP) { atomicAdd(&(bar)[XB_TMO], 1u); break; } } } } while (0)
struct XcdBarrier { unsigned* bar; unsigned x; volatile LAS unsigned* st; };
__device__ __forceinline__ XcdBarrier xcd_barrier_post(unsigned* bar, volatile LAS unsigned* st) {
    XcdBarrier b; b.bar = bar; b.x = xb_xcc_id(); b.st = st;
    if (threadIdx.x == 0) (void)xb_add(&bar[XB_XCNT(b.x)], 1u);
    return b;
}
__device__ __forceinline__ void xcd_barrier_complete(unsigned* bar, unsigned x, unsigned& nloc, unsigned& nx) {
    const unsigned G = gridDim.x * gridDim.y * gridDim.z;
    unsigned sum, cnt, mine, sp = 0u;
    for (;;) {
        sum = 0u; cnt = 0u; mine = 0u;
#pragma unroll
        for (unsigned j = 0; j < 16; ++j) { const unsigned c = xb_ld(&bar[XB_XCNT(j)]); sum += c; cnt += (c > 0u) ? 1u : 0u; mine = (j == x) ? c : mine; }
        if (sum == G) break;
        __builtin_amdgcn_s_sleep(1);
        if ((++sp & 255u) == 0u) { if (xb_ld(&bar[XB_TMO])) break; if (sp > XB_SPIN_CAP) { atomicAdd(&bar[XB_TMO], 1u); break; } }
    }
    nloc = mine > 0u ? mine : 1u; nx = cnt > 0u ? cnt : 1u;
}
__device__ __forceinline__ void xcd_barrier(const XcdBarrier& b) {
    asm volatile("s_waitcnt vmcnt(0)" ::: "memory");
    __syncthreads();
    if (threadIdx.x == 0) {
        unsigned* bar = b.bar;
        __builtin_amdgcn_s_waitcnt(0);
        unsigned nloc = b.st[0], nx = b.st[1];
        if (nloc == 0u) { xcd_barrier_complete(bar, b.x, nloc, nx); b.st[0] = nloc; b.st[1] = nx; }
#if XB_FLATPOLL
        const unsigned seq = b.st[2]; b.st[2] = seq + 1u;
#endif
        const unsigned old = xb_add(&bar[XB_XSUB(b.x)], 1u);
        const unsigned gen = old / nloc;
        if (old + 1u == (gen + 1u) * nloc) {
            __builtin_amdgcn_fence(__ATOMIC_RELEASE, "agent");
            asm volatile("s_waitcnt vmcnt(0)" ::: "memory");
            const unsigned og = xb_add(&bar[XB_TOP], 1u);
            const unsigned tg = og / nx;
            if (og + 1u == (tg + 1u) * nx) xb_add(&bar[XB_TOPGEN], 1u);
            else XB_SPIN(xb_ld(&bar[XB_TOPGEN]) == tg, bar);
            __builtin_amdgcn_fence(__ATOMIC_ACQUIRE, "agent");
#if !XB_FLATPOLL
            xb_add(&bar[XB_XGEN(b.x)], 1u);
#endif
            asm volatile("s_waitcnt vmcnt(0)" ::: "memory");
        } else {
#if XB_FLATPOLL
            XB_SPIN(xb_ld(&bar[XB_TOPGEN]) == seq, bar);
#else
            XB_SPIN(xb_ld(&bar[XB_XGEN(b.x)]) == gen, bar);
#endif
            __builtin_amdgcn_fence(__ATOMIC_ACQUIRE, "agent");
            asm volatile("s_waitcnt vmcnt(0)" ::: "memory");
        }
    }
    __syncthreads();
}

enum { K_P0 = 0, K_RMIX, K_QKV, K_ROPE, K_ATT, K_OPROJ, K_M1, K_M2, K_M3, K_RPOOL, K_POOLG, K_INPROJ, K_CONV, K_SCAN, K_YPH, K_GFIX, K_OUTPROJ, K_FINAL, K_DBG };
struct Args { const float* in[N_IN]; float* out; unsigned char* ws; int ph_lo, ph_hi; int flags; int bar_region; };

struct Ctx {
    LAS unsigned char* lds; int tid, lane, wave, vcu, G;
};

__device__ __forceinline__ const float* mod_row(const Args& a, int layer, int r) {
    return r < TL ? (const float*)(a.ws + WS_MODL) + (size_t)(layer * 4 + r / SEQ) * 6144 : (const float*)(a.ws + WS_MODC) + (size_t)layer * 6144;
}
__device__ __forceinline__ const float* resid_row(const Args& a, int layer, int r) {
    if (layer == 0) return r < TL ? a.in[I_X] + (size_t)r * D : a.in[I_CTX] + (size_t)(r - TL) * D;
    return (const float*)(a.ws + WS_X) + (size_t)r * D;
}

__device__ __forceinline__ void load_row_combined(const Args& a, int layer, int r, int lane, f32x4 (&v)[4]) {
    if (layer == 0) { const f32x4* xr = (const f32x4*)resid_row(a, 0, r) + lane;
#pragma unroll
        for (int j = 0; j < 4; ++j) v[j] = xr[64 * j]; }
    else { const u32x2* xr = (const u32x2*)((const bf16*)(a.ws + WS_X) + (size_t)r * D) + lane;
#pragma unroll
        for (int j = 0; j < 4; ++j) { const u32x2 p = xr[64 * j]; v[j] = (f32x4){bflo(p.x), bfhi(p.x), bflo(p.y), bfhi(p.y)}; } }
    if (layer > 0 && !(a.flags & 1)) {
        const f32x4* gf = (const f32x4*)(mod_row(a, layer - 1, r) + 5 * D) + lane;
        const u32x2* y0 = (const u32x2*)((const bf16*)(a.ws + WS_Y2) + (size_t)(2 * r) * D) + lane;
        const u32x2* y1 = (const u32x2*)((const bf16*)(a.ws + WS_Y2) + (size_t)(2 * r + 1) * D) + lane;
#pragma unroll
        for (int j = 0; j < 4; ++j) {
            const u32x2 p = y0[64 * j], q = y1[64 * j]; const f32x4 g = gf[64 * j];
            v[j].x += g.x * (bflo(p.x) + bflo(q.x)); v[j].y += g.y * (bfhi(p.x) + bfhi(q.x));
            v[j].z += g.z * (bflo(p.y) + bflo(q.y)); v[j].w += g.w * (bfhi(p.y) + bfhi(q.y));
        }
    }
}
__device__ __forceinline__ float row_rstd(const f32x4 (&v)[4]) {
    float s = 0.f;
#pragma unroll
    for (int j = 0; j < 4; ++j) s += (v[j].x * v[j].x + v[j].y * v[j].y) + (v[j].z * v[j].z + v[j].w * v[j].w);
    return rsqrtf(wave_sum(s) * (1.0f / D) + EPS);
}
__device__ __forceinline__ void norm_mod(const f32x4 (&v)[4], float rstd, const float* g, const float* shift, const float* scale, int lane, f32x4 (&h)[4]) {
#pragma unroll
    for (int j = 0; j < 4; ++j) {
        const f32x4 gg = ((const f32x4*)g)[lane + 64 * j], sh = ((const f32x4*)shift)[lane + 64 * j], sc = ((const f32x4*)scale)[lane + 64 * j];
        h[j] = (v[j] * rstd) * gg * (sc + 1.0f) + sh;
    }
}

__device__ __forceinline__ void tr_item(const float* W, int N, int k0, int n0, bf16* WT, size_t drow0, int dK, LAS float* scr, int lane, int hi_skip = 0) {
    const int nq = lane & 15, kr = lane >> 4;
#pragma unroll
    for (int i = 0; i < 16; ++i) { const int kk = 4 * i + kr; const f32x4 v = *(const f32x4*)(W + (size_t)(k0 + kk) * N + n0 + 4 * nq);
        LAS float* d = scr + kk * 65 + 4 * nq; d[0] = v.x; d[1] = v.y; d[2] = v.z; d[3] = v.w; }
    LDS_WAIT(); asm volatile("" ::: "memory");
    const int c = lane & 7;
#pragma unroll
    for (int j = 0; j < 8; ++j) { const int n = (lane >> 3) + 8 * j; const LAS float* s = scr + (8 * c) * 65 + n;
        u32x4 o; o.x = cvtpk(s[0 * 65], s[1 * 65]); o.y = cvtpk(s[2 * 65], s[3 * 65]); o.z = cvtpk(s[4 * 65], s[5 * 65]); o.w = cvtpk(s[6 * 65], s[7 * 65]);
        *(u32x4*)(WT + (drow0 + n + (n >= 32 ? hi_skip : 0)) * dK + k0 + 8 * c) = o; }
    LDS_WAIT(); asm volatile("" ::: "memory");
}
__device__ __forceinline__ void tr_item8(const float* W, int N, int k0, int n0, unsigned char* WT, size_t drow0, int dKb, LAS float* scr, int lane, float scale, int hi_skip = 0) {
    const int nq = lane & 15, kr = lane >> 4;
#pragma unroll
    for (int i = 0; i < 16; ++i) { const int kk = 4 * i + kr; const f32x4 v = *(const f32x4*)(W + (size_t)(k0 + kk) * N + n0 + 4 * nq);
        LAS float* d = scr + kk * 65 + 4 * nq; d[0] = v.x; d[1] = v.y; d[2] = v.z; d[3] = v.w; }
    LDS_WAIT(); asm volatile("" ::: "memory");
    const int c = lane & 3;
#pragma unroll
    for (int j = 0; j < 4; ++j) { const int n = (lane >> 2) + 16 * j; const LAS float* s = scr + (16 * c) * 65 + n;
        u32x4 o; o.x = pk_fp8x4(s[0 * 65] * scale, s[1 * 65] * scale, s[2 * 65] * scale, s[3 * 65] * scale); o.y = pk_fp8x4(s[4 * 65] * scale, s[5 * 65] * scale, s[6 * 65] * scale, s[7 * 65] * scale);
        o.z = pk_fp8x4(s[8 * 65] * scale, s[9 * 65] * scale, s[10 * 65] * scale, s[11 * 65] * scale); o.w = pk_fp8x4(s[12 * 65] * scale, s[13 * 65] * scale, s[14 * 65] * scale, s[15 * 65] * scale);
        *(u32x4*)(WT + (drow0 + n + (n >= 32 ? hi_skip : 0)) * dKb + k0 + 16 * c) = o; }
    LDS_WAIT(); asm volatile("" ::: "memory");
}
struct TrD { const float* src; int N; unsigned char* dst; int dKb, drow0, hi_skip, fp8; };
__device__ __forceinline__ void tr_load(const TrD& d, f32x4 (&v)[16], int lane) {
    const int nq = lane & 15, kr = lane >> 4;
#pragma unroll
    for (int i = 0; i < 16; ++i) v[i] = *(const f32x4*)(d.src + (size_t)(4 * i + kr) * d.N + 4 * nq);
}
__device__ __forceinline__ void tr_store(const TrD& d, const f32x4 (&v)[16], LAS float* scr, int lane) {
    const int nq = lane & 15, kr = lane >> 4;
#pragma unroll
    for (int i = 0; i < 16; ++i) { LAS float* p = scr + (4 * i + kr) * 65 + 4 * nq; p[0] = v[i].x; p[1] = v[i].y; p[2] = v[i].z; p[3] = v[i].w; }
    LDS_WAIT(); asm volatile("" ::: "memory");
    if (d.fp8) { const int c = lane & 3; const float scale = (float)(1 << MOE_WSH);
#pragma unroll
        for (int j = 0; j < 4; ++j) { const int n = (lane >> 2) + 16 * j; const LAS float* s = scr + (16 * c) * 65 + n;
            u32x4 o; o.x = pk_fp8x4(s[0 * 65] * scale, s[1 * 65] * scale, s[2 * 65] * scale, s[3 * 65] * scale); o.y = pk_fp8x4(s[4 * 65] * scale, s[5 * 65] * scale, s[6 * 65] * scale, s[7 * 65] * scale);
            o.z = pk_fp8x4(s[8 * 65] * scale, s[9 * 65] * scale, s[10 * 65] * scale, s[11 * 65] * scale); o.w = pk_fp8x4(s[12 * 65] * scale, s[13 * 65] * scale, s[14 * 65] * scale, s[15 * 65] * scale);
            *(u32x4*)(d.dst + (size_t)(d.drow0 + n + (n >= 32 ? d.hi_skip : 0)) * d.dKb + 16 * c) = o; } }
    else { const int c = lane & 7;
#pragma unroll
        for (int j = 0; j < 8; ++j) { const int n = (lane >> 3) + 8 * j; const LAS float* s = scr + (8 * c) * 65 + n;
            u32x4 o; o.x = cvtpk(s[0 * 65], s[1 * 65]); o.y = cvtpk(s[2 * 65], s[3 * 65]); o.z = cvtpk(s[4 * 65], s[5 * 65]); o.w = cvtpk(s[6 * 65], s[7 * 65]);
            *(u32x4*)(d.dst + (size_t)(d.drow0 + n + (n >= 32 ? d.hi_skip : 0)) * d.dKb + 16 * c) = o; } }
    LDS_WAIT(); asm volatile("" ::: "memory");
}
constexpr int TR_I0 = 2 * 384, TR_I1 = 2 * 256, TR_I2 = 4 * 16, TR_I3 = 16 * 81, TR_I4 = 32 * 16, TR_I5 = 128 * 256, TR_I6 = 128 * 128, TR_ITOT = TR_I0 + TR_I1 + TR_I2 + TR_I3 + TR_I4 + TR_I5 + TR_I6;
__device__ __forceinline__ TrD tr_decode(const Args& a, int it) {
    TrD d; int r = it; d.hi_skip = 0;
    if (r < TR_I5) { const int m = r / 256, q = r % 256, kb = q / 16, nb = q % 16, n0 = nb * 64, j = n0 & 511;
        d.src = a.in[I_WGU] + (size_t)m * 1024 * 1024 + (size_t)kb * 64 * 1024 + n0; d.N = 1024; d.drow0 = 256 * (j >> 7) + (j & 127) + ((n0 >= 512) ? 128 : 0);
        d.fp8 = MOE_FP8; d.dKb = MOE_FP8 ? 1024 : 2048; d.dst = (unsigned char*)(a.ws + WS_WGU) + (size_t)m * 1024 * d.dKb + (size_t)kb * 64 * (MOE_FP8 ? 1 : 2); return d; }
    r -= TR_I5;
    if (r < TR_I6) { const int m = r / 128, q = r % 128, kb = q / 16, nb = q % 16;
        d.src = a.in[I_WDN] + (size_t)m * 512 * 1024 + (size_t)kb * 64 * 1024 + nb * 64; d.N = 1024; d.drow0 = nb * 64;
        d.fp8 = MOE_FP8; d.dKb = MOE_FP8 ? 512 : 1024; d.dst = (unsigned char*)(a.ws + WS_WDN) + (size_t)m * 1024 * d.dKb + (size_t)kb * 64 * (MOE_FP8 ? 1 : 2); return d; }
    r -= TR_I6;
    if (r < TR_I0) { const int m = r / 384, q = r % 384, kb = q / 24, nb = q % 24;
        d.src = a.in[I_WQKV] + (size_t)m * 1024 * 1536 + (size_t)kb * 64 * 1536 + nb * 64; d.N = 1536; d.drow0 = (nb >> 2) * 256 + (nb & 3) * 32; d.hi_skip = 96;
        d.fp8 = ATT_FP8; d.dKb = ATT_FP8 ? 1024 : 2048; d.dst = (unsigned char*)(a.ws + WS_WQKV) + (size_t)m * 1536 * d.dKb + (size_t)kb * 64 * (ATT_FP8 ? 1 : 2); return d; }
    r -= TR_I0;
    if (r < TR_I1) { const int m = r / 256, q = r % 256, kb = q / 16, nb = q % 16;
        d.src = a.in[I_WO] + (size_t)m * 1024 * 1024 + (size_t)kb * 64 * 1024 + nb * 64; d.N = 1024; d.drow0 = nb * 64;
        d.fp8 = ATT_FP8; d.dKb = ATT_FP8 ? 1024 : 2048; d.dst = (unsigned char*)(a.ws + WS_WO) + (size_t)m * 1024 * d.dKb + (size_t)kb * 64 * (ATT_FP8 ? 1 : 2); return d; }
    r -= TR_I1;
    d.fp8 = 0;
    if (r < TR_I2) { const int m = r / 16, q = r % 16, kb = q / 4, nb = q % 4;
        d.src = a.in[I_POOLW] + (size_t)m * 256 * 256 + (size_t)kb * 64 * 256 + nb * 64; d.N = 256; d.drow0 = nb * 64; d.dKb = 512; d.dst = (unsigned char*)(a.ws + WS_WPOOL) + (size_t)m * 256 * 512 + (size_t)kb * 128; return d; }
    r -= TR_I2;
    if (r < TR_I3) { const int kb = r / 81, nb = r % 81;
        d.src = a.in[I_WIN] + (size_t)kb * 64 * 5184 + nb * 64; d.N = 5184; d.drow0 = nb * 64; d.dKb = 2048; d.dst = (unsigned char*)(a.ws + WS_WIN) + (size_t)kb * 128; return d; }
    r -= TR_I3;
    { const int kb = r / 16, nb = r % 16;
        d.src = a.in[I_WOUT] + (size_t)kb * 64 * 1024 + nb * 64; d.N = 1024; d.drow0 = nb * 64; d.dKb = 4096; d.dst = (unsigned char*)(a.ws + WS_WOUT) + (size_t)kb * 128; return d; }
}
__device__ __forceinline__ void p0_prologue(const Args& a, const Ctx& c) {
    LAS float* scr = (LAS float*)(c.lds + c.wave * 16896);
    const int gw = c.vcu * NWAVES + c.wave, NGW = c.G * NWAVES;
    { f32x4 va[16], vb[16]; TrD da, db; int it = gw;
      da = tr_decode(a, it < TR_ITOT ? it : TR_ITOT - 1); tr_load(da, va, c.lane);
      while (it < TR_ITOT) {
          const int itB = it + NGW; db = tr_decode(a, itB < TR_ITOT ? itB : TR_ITOT - 1); tr_load(db, vb, c.lane);
          tr_store(da, va, scr, c.lane);
          if (itB >= TR_ITOT) break;
          const int itA = itB + NGW; da = tr_decode(a, itA < TR_ITOT ? itA : TR_ITOT - 1); tr_load(da, va, c.lane);
          tr_store(db, vb, scr, c.lane);
          it = itA; } }
    __syncthreads();
    LAS float* sv = (LAS float*)c.lds;
    LAS float* part = (LAS float*)(c.lds + 20480);
    for (int u = c.tid; u < 5 * 1024; u += NTHREADS) { const int v = u >> 10, k = u & 1023; const float x = v < 4 ? a.in[I_C][v * 1024 + k] : a.in[I_CCTX][k]; sv[u] = x / (1.0f + expf(-x)); }
    __syncthreads();
    for (int item = blockIdx.x; item < 4 * 64; item += c.G) {
        const int li = item >> 6, c0 = (item & 63) * 96, cq = c.tid % 24, ks = c.tid / 24;
        f32x4 acc[5];
#pragma unroll
        for (int v = 0; v < 5; ++v) acc[v] = (f32x4){0.f, 0.f, 0.f, 0.f};
        if (ks < 21) { const int kbeg = ks * 49, kend = (kbeg + 49) < 1024 ? (kbeg + 49) : 1024;
            const float* w = a.in[I_WADA] + ((size_t)li * 1024 + kbeg) * 6144 + c0 + 4 * cq;
#pragma unroll 7
            for (int k = kbeg; k < kend; ++k) { const f32x4 wv = *(const f32x4*)w; w += 6144;
#pragma unroll
                for (int v = 0; v < 5; ++v) acc[v] += wv * sv[v * 1024 + k]; }
#pragma unroll
            for (int v = 0; v < 5; ++v) *(LAS f32x4*)(part + (ks * 24 + cq) * 20 + v * 4) = acc[v]; }
        __syncthreads();
        if (c.tid < 480) { const int v = c.tid / 96, col = c.tid % 96, q = col >> 2, e = col & 3; float s = 0.f;
            for (int k2 = 0; k2 < 21; ++k2) s += part[(k2 * 24 + q) * 20 + v * 4 + e];
            s += a.in[I_BADA][li * 6144 + c0 + col];
            if (v < 4) ((float*)(a.ws + WS_MODL))[(size_t)(li * 4 + v) * 6144 + c0 + col] = s; else ((float*)(a.ws + WS_MODC))[(size_t)li * 6144 + c0 + col] = s; }
        __syncthreads();
    }
    if (blockIdx.x == (unsigned)(c.G - 1)) for (int u = c.tid; u < 1024; u += NTHREADS) { const int pos = u >> 4, f = u & 15;
        const float inv = (float)pow(10000.0, -(double)f / 16.0); const double ang = (double)((float)pos * inv);
        ((f32x2*)(a.ws + WS_ROPE))[u] = (f32x2){(float)cos(ang), (float)sin(ang)}; }
    for (int u = blockIdx.x * NTHREADS + c.tid; u < 4 * 64 * 1024; u += c.G * NTHREADS) { const int li = u >> 16, n = (u >> 10) & 63, k = u & 1023;
        float w = 0.f; if (n < 4) w = a.in[I_WRG][((size_t)li * 1024 + k) * 4 + n]; else if (n < 36) w = a.in[I_WRE][((size_t)li * 1024 + k) * 32 + (n - 4)];
        const unsigned hi = cvtpk(w, 0.f) & 0xffffu; const float rem = w - bflo(hi); const unsigned lo = cvtpk(rem, 0.f) & 0xffffu;
        bf16* wr = (bf16*)(a.ws + WS_WR) + (size_t)li * 2 * 65536;
        const int fo = (((k >> 7) * 8 + ((k >> 4) & 7)) * 4 + (n >> 5)) * 512 + ((n & 31) + 32 * ((k >> 3) & 1)) * 8 + (k & 7);
        wr[fo] = (bf16)hi; wr[fo + 1024] = (bf16)lo; }
}

__device__ __forceinline__ void ph_rmix(const Args& a, const Ctx& c, int layer) {
    const int gw = c.vcu * NWAVES + c.wave, NGW = c.G * NWAVES;
    const float* g = a.in[I_NMIX] + layer * D;
    for (int r = gw; r < TT; r += NGW) {
        f32x4 v[4], h[4]; load_row_combined(a, layer, r, c.lane, v);
        if (layer > 0) { u32x2* xo = (u32x2*)((bf16*)(a.ws + WS_X) + (size_t)r * D) + c.lane;
#pragma unroll
            for (int j = 0; j < 4; ++j) xo[64 * j] = (u32x2){cvtpk(v[j].x, v[j].y), cvtpk(v[j].z, v[j].w)}; }
        const float rstd = row_rstd(v); const float* m = mod_row(a, layer, r);
        norm_mod(v, rstd, g, m, m + D, c.lane, h);
        if (ATT_FP8 && layer != 2) { unsigned* ho8 = (unsigned*)((unsigned char*)(a.ws + WS_HB) + (size_t)r * D) + c.lane;
#pragma unroll
            for (int j = 0; j < 4; ++j) ho8[64 * j] = pk_fp8x4(h[j].x, h[j].y, h[j].z, h[j].w); }
        else { u32x2* ho = (u32x2*)((bf16*)(a.ws + WS_HB) + (size_t)r * D) + c.lane;
#pragma unroll
            for (int j = 0; j < 4; ++j) ho[64 * j] = (u32x2){cvtpk(h[j].x, h[j].y), cvtpk(h[j].z, h[j].w)}; }
    }
}

__device__ __forceinline__ void ph_final(const Args& a, const Ctx& c, int layer) {
    const int gw = c.vcu * NWAVES + c.wave, NGW = c.G * NWAVES;
    float dscale = 1.f, dmark = 0.f;
#if DEBUG_CHECKS
    { unsigned* dbg = (unsigned*)(a.ws + WS_CTL) + CW_DBG; int code = 0; float mag = 0.f;
      for (int id = 1; id < 32; ++id) { const float e = __uint_as_float(__hip_atomic_load(dbg + id, __ATOMIC_RELAXED, __HIP_MEMORY_SCOPE_AGENT)); if (code == 0 && e > DBG_TOL) { code = id; mag = e; } }
      dscale = 1.f + (float)code; dmark = code ? 100.f * (1.f + fminf(fmaxf(log2f(mag / DBG_TOL), 0.f), 30.f)) : 0.f; }
#endif
    for (int r = gw; r < TL; r += NGW) {
        f32x4 v[4]; load_row_combined(a, layer, r, c.lane, v);
        const float rstd = row_rstd(v) * dscale;
        f32x4* o = (f32x4*)(a.out + (size_t)r * D) + c.lane;
#pragma unroll
        for (int j = 0; j < 4; ++j) { f32x4 ov = (v[j] * rstd) * ((const f32x4*)a.in[I_NFIN])[c.lane + 64 * j]; if (j == 0 && r == 0 && c.lane == 0 && dmark > 0.f) ov.x = dmark; o[64 * j] = ov; }
    }
}


namespace pg8 {
constexpr int BM = 256, BK = 64, HALF = 128, HTB = HALF * BK * 2, STAGE_BYTES = 8 * HTB;
__host__ __device__ __forceinline__ int lds_byte(int r, int c) { const int st = (r >> 4) * 2 + (c >> 5), rr = r & 15, cc = c & 31, ob = rr * 64 + cc * 2; return st * 1024 + (ob ^ (((ob >> 9) & 1) << 5)); }
__host__ __device__ __forceinline__ void stage_rc(int b, int& R, int& C) { const int st = b / 1024, sb = b % 1024, swz = sb ^ (((sb >> 9) & 1) << 5); R = (st >> 1) * 16 + swz / 64; C = (st & 1) * 32 + (swz % 64) / 2; }
__host__ __device__ __forceinline__ int perm32(int rho) { const int n = rho >> 4, i = rho & 15; return 8 * (i >> 2) + 4 * n + (i & 3); }
struct Unit { const char* A; const char* B; int pm, pn, x0, x1; };
__device__ __forceinline__ void tile_of(int L, int nM, int nN, int& pm, int& pn) {
    const int nwg = nM * nN; int wgid = L; { const int q = nwg / 8, r = nwg % 8, xcd = wgid % 8, off = wgid / 8; wgid = (xcd < r ? xcd * (q + 1) : r * (q + 1) + (xcd - r) * q) + off; }
    const int nig = 8 * nN, gid = wgid / nig, fm = gid * 8, gsz = (nM - fm) < 8 ? (nM - fm) : 8;
    pm = fm + ((wgid % nig) % gsz); pn = (wgid % nig) / gsz;
}
typedef int v4i_t __attribute__((ext_vector_type(4))); typedef int v8i_t __attribute__((ext_vector_type(8)));
template <class Epi, class Sched, bool GATHER, bool FP8 = false>
__device__ __forceinline__ void gemm_phase(LAS unsigned char* lds, const int Kb, const int ldab, const Sched& S, const Epi& E, const int scw = 127, const int sca = 127) {
    const int tid = tid_opaque(), wid = __builtin_amdgcn_readfirstlane(tid >> 6), lane = tid & 63, wr = wid >> 2, wc = wid & 3, fr = lane & 15, fq = lane >> 4;
    const int nt = Kb / (BK * 2);
    int scw_v = scw, sca_v = sca;
    unsigned voffA[2], voffB[2]; int RA[2], CA[2];
#pragma unroll
    for (int i = 0; i < 2; ++i) { int R, C; stage_rc(tid * 16 + i * 8192, R, C); const int Rb = Epi::PERM ? ((R & ~31) + perm32(R & 31)) : R;
        RA[i] = R; CA[i] = C; voffA[i] = (unsigned)(R * ldab + C * 2); voffB[i] = (unsigned)(Rb * Kb + C * 2); }
    const size_t kstep = (size_t)(BK * 2);
    const size_t hstepA = (size_t)HALF * ldab, hstepB = (size_t)HALF * Kb;
    const unsigned ldsw = (unsigned)wid * 1024u;
    const int aoff = lds_byte(wr * 64 + fr, fq * 8), boff = lds_byte(wc * 32 + fr, fq * 8);
#define PG8_SA(b, h) (((b) * 2 + (h)) * HTB)
#define PG8_SB(b, h) ((4 + (b) * 2 + (h)) * HTB)
#define PG8_GLDS(bufoff, gptr, i_) __builtin_amdgcn_global_load_lds((const unsigned*)(gptr), (LAS unsigned*)(lds + (bufoff) + ldsw + (i_) * 8192), 16, 0, 0)
#define PG8_STAGE_B(bufoff, gbase) do { _Pragma("unroll") for (int _i = 0; _i < 2; ++_i) PG8_GLDS(bufoff, (const char*)(gbase) + voffB[_i], _i); } while (0)
#define PG8_STAGE_A(bufoff, ab, kb, h, NX) do { _Pragma("unroll") for (int _i = 0; _i < 2; ++_i) { \
        if constexpr (GATHER) { const unsigned _vo = (NX) ? voN[h][_i] : voC[h][_i]; PG8_GLDS(bufoff, (ab) + (kb) + _vo, _i); } \
        else { PG8_GLDS(bufoff, (ab) + (kb) + (size_t)(h) * hstepA + voffA[_i], _i); } } } while (0)
#define PG8_LDA(dst, b, h) do { _Pragma("unroll") for (int m = 0; m < 4; ++m) _Pragma("unroll") for (int k = 0; k < 2; ++k) dst[m][k] = *(const LAS bf16x8*)(lds + PG8_SA(b, h) + aoff + m * 2048 + k * 1024); } while (0)
#define PG8_LDB(dst, b, h) do { _Pragma("unroll") for (int n = 0; n < 2; ++n) _Pragma("unroll") for (int k = 0; k < 2; ++k) dst[n][k] = *(const LAS bf16x8*)(lds + PG8_SB(b, h) + boff + n * 2048 + k * 1024); } while (0)
#define PG8_MMA(ai, bj, At, Bt) do { __builtin_amdgcn_s_setprio(1); _Pragma("unroll") for (int m = 0; m < 4; ++m) _Pragma("unroll") for (int n = 0; n < 2; ++n) { \
        if constexpr (FP8) { const v8i_t b8 = __builtin_shufflevector(__builtin_bit_cast(v4i_t, Bt[n][0]), __builtin_bit_cast(v4i_t, Bt[n][1]), 0, 1, 2, 3, 4, 5, 6, 7), a8 = __builtin_shufflevector(__builtin_bit_cast(v4i_t, At[m][0]), __builtin_bit_cast(v4i_t, At[m][1]), 0, 1, 2, 3, 4, 5, 6, 7); \
            asm volatile("v_mfma_scale_f32_16x16x128_f8f6f4 %0, %1, %2, %0, %3, %4 op_sel_hi:[0,0,0]" : "+v"(acc[ai][bj][m][n]) : "v"(b8), "v"(a8), "v"(scw_v), "v"(sca_v)); } \
        else { _Pragma("unroll") for (int k = 0; k < 2; ++k) acc[ai][bj][m][n] = __builtin_amdgcn_mfma_f32_16x16x32_bf16(Bt[n][k], At[m][k], acc[ai][bj][m][n], 0, 0, 0); } } __builtin_amdgcn_s_setprio(0); } while (0)
#define PG8_WAIT_V(n) asm volatile("s_waitcnt vmcnt(" #n ")" ::: "memory")
#define PG8_WAIT_L(n) asm volatile("s_waitcnt lgkmcnt(" #n ")" ::: "memory")
#define PG8_BAR __builtin_amdgcn_s_barrier()
#define PG8_SCHED __builtin_amdgcn_sched_barrier(0)
    Unit cur, nxt, pend; int ui = 0; bool have_pend = false;
    if (!S.next(0, cur)) return;
    pend = cur;
    unsigned voC[2][2], voN[2][2];
    if constexpr (GATHER) {
#pragma unroll
        for (int h = 0; h < 2; ++h)
#pragma unroll
            for (int i = 0; i < 2; ++i) { voC[h][i] = (unsigned)(S.gather(cur, h * HALF + RA[i]) * ldab + CA[i] * 2); voN[h][i] = voC[h][i]; }
    } else { voC[0][0] = voN[0][0] = 0u; }
    f32x4 acc[2][2][4][2];
#pragma unroll
    for (int a = 0; a < 2; ++a)
#pragma unroll
        for (int b = 0; b < 2; ++b)
#pragma unroll
            for (int m = 0; m < 4; ++m)
#pragma unroll
                for (int n = 0; n < 2; ++n) acc[a][b][m][n] = (f32x4){0.f, 0.f, 0.f, 0.f};
    bf16x8 At[4][2], B0[2][2], B1[2][2];
    const char* cA = cur.A; const char* cB = cur.B;
    S.a_ready(cur, wid);
    PG8_STAGE_B(PG8_SB(0, 0), cB); PG8_STAGE_B(PG8_SB(0, 1), cB + hstepB); PG8_STAGE_A(PG8_SA(0, 0), cA, (size_t)0, 0, false); PG8_STAGE_A(PG8_SA(0, 1), cA, (size_t)0, 1, false);
    if (wr == 1) PG8_BAR;
    PG8_WAIT_V(2); PG8_BAR;
    PG8_STAGE_B(PG8_SB(1, 0), cB + kstep); PG8_STAGE_A(PG8_SA(1, 0), cA, kstep, 0, false); PG8_STAGE_B(PG8_SB(1, 1), cB + hstepB + kstep);
    PG8_WAIT_V(6); PG8_BAR;
    for (;;) {
        const bool has_next = S.next(ui + 1, nxt);
        if constexpr (GATHER) { if (has_next) {
#pragma unroll
            for (int h = 0; h < 2; ++h)
#pragma unroll
                for (int i = 0; i < 2; ++i) voN[h][i] = (unsigned)(S.gather(nxt, h * HALF + RA[i]) * ldab + CA[i] * 2); } }
        const char* nA = has_next ? nxt.A : cA; const char* nB = has_next ? nxt.B : cB;
        for (int t = 0; t < nt; t += 2) {
            const bool last = (t == nt - 2);
            const size_t k1 = (size_t)(t + 1) * kstep;
            const char* a2 = last ? nA : cA; const size_t k2 = last ? (size_t)0 : (size_t)(t + 2) * kstep; const size_t k3 = k2 + kstep;
            const char* b2 = last ? nB : cB + (size_t)(t + 2) * kstep; const char* b3 = b2 + kstep;
            const bool nx = GATHER ? (last && has_next) : false;
            if (last && has_next) S.a_ready(nxt, wid);
            PG8_LDB(B0, 0, 0); PG8_LDB(B1, 0, 1); PG8_SCHED; PG8_LDA(At, 0, 0); PG8_STAGE_A(PG8_SA(1, 1), cA, k1, 1, false);
            PG8_WAIT_V(8); PG8_WAIT_L(0); PG8_BAR; PG8_MMA(0, 0, At, B0); PG8_MMA(0, 1, At, B1); PG8_BAR; PG8_SCHED;
            PG8_LDA(At, 0, 1); PG8_STAGE_B(PG8_SB(0, 0), b2); PG8_STAGE_B(PG8_SB(0, 1), b2 + hstepB); PG8_STAGE_A(PG8_SA(0, 0), a2, k2, 0, nx);
            PG8_WAIT_V(8); PG8_WAIT_L(0);
            if constexpr (!Sched::IMM_DONE) { if (have_pend) { S.done(pend, lane); have_pend = false; } }
            PG8_BAR; PG8_MMA(1, 0, At, B0); PG8_MMA(1, 1, At, B1); PG8_BAR; PG8_SCHED;
            PG8_LDB(B0, 1, 0); PG8_LDB(B1, 1, 1); PG8_SCHED; PG8_LDA(At, 1, 0); PG8_STAGE_A(PG8_SA(0, 1), a2, k2, 1, nx);
            PG8_WAIT_V(8); PG8_WAIT_L(0); PG8_BAR; PG8_MMA(0, 0, At, B0); PG8_MMA(0, 1, At, B1); PG8_BAR; PG8_SCHED;
            PG8_LDA(At, 1, 1); PG8_STAGE_B(PG8_SB(1, 0), b3); PG8_STAGE_B(PG8_SB(1, 1), b3 + hstepB); PG8_STAGE_A(PG8_SA(1, 0), a2, k3, 0, nx);
            PG8_WAIT_V(8); PG8_WAIT_L(0); PG8_BAR; PG8_MMA(1, 0, At, B0); PG8_MMA(1, 1, At, B1); PG8_BAR; PG8_SCHED;
        }
        if (wr == 0) PG8_BAR;
        if constexpr (FP8) asm volatile("s_nop 15\n\ts_nop 15" ::: "memory");
        E(acc, cur, wr, wc, fr, fq);
        if constexpr (Sched::IMM_DONE) { PG8_WAIT_V(0); S.done(cur, lane); }
        else { pend = cur; have_pend = true; }
        if (!has_next) break;
#pragma unroll
        for (int a = 0; a < 2; ++a)
#pragma unroll
            for (int b = 0; b < 2; ++b)
#pragma unroll
                for (int m = 0; m < 4; ++m)
#pragma unroll
                    for (int n = 0; n < 2; ++n) acc[a][b][m][n] = (f32x4){0.f, 0.f, 0.f, 0.f};
        cur = nxt; cA = nA; cB = nB; ++ui;
        if constexpr (GATHER) {
#pragma unroll
            for (int h = 0; h < 2; ++h)
#pragma unroll
                for (int i = 0; i < 2; ++i) voC[h][i] = voN[h][i]; }
        if (wr == 1) PG8_BAR;
    }
    PG8_WAIT_V(0);
    if constexpr (!Sched::IMM_DONE) { if (have_pend) S.done(pend, lane); }
    PG8_BAR;
#undef PG8_SA
#undef PG8_SB
#undef PG8_GLDS
#undef PG8_STAGE_A
#undef PG8_STAGE_B
#undef PG8_LDA
#undef PG8_LDB
#undef PG8_MMA
#undef PG8_WAIT_V
#undef PG8_WAIT_L
#undef PG8_BAR
#undef PG8_SCHED
}
}
#include <hip/hip_bf16.h>
#include <cmath>
namespace attn_body {
using bf16=__hip_bfloat16;
using bf16x8=__attribute__((ext_vector_type(8)))short;
using s16x4=__attribute__((ext_vector_type(4)))short;
using f32x16=__attribute__((ext_vector_type(16)))float;
using u32x4=__attribute__((ext_vector_type(4)))unsigned;
constexpr int D=64,QP=1024,KVP=256;
constexpr int NW=8,QBLK=32,QB=QBLK*NW,KVBLK=64;
__device__ __forceinline__ int crow(int r,int hi){return (r&3)+8*(r>>2)+4*hi;}
#define SBAR() __builtin_amdgcn_sched_barrier(0)
constexpr int NSLOT=3, SLOTB=8192;
constexpr int LDS_K=0, LDS_V=NSLOT*SLOTB, LDS_WS=2*NSLOT*SLOTB, LDS_OST=LDS_WS+NW*64*4, LDS_BYTES=LDS_OST+NW*4096;
constexpr float C2=0.125f*1.4426950408889634f;
__device__ __forceinline__ void glds16s(const void*sbase,unsigned voff,unsigned lds_dst){unsigned keep;
  asm volatile("s_mov_b32 %0, m0\n\ts_mov_b32 m0, %3\n\ts_nop 4\n\tglobal_load_lds_dwordx4 %1, %2\n\ts_mov_b32 m0, %0":"=&s"(keep):"v"(voff),"s"(sbase),"s"(lds_dst):"memory");}
__device__ __forceinline__ float max3f(float a,float b,float c){float r;asm("v_max3_f32 %0, %1, %2, %3":"=v"(r):"v"(a),"v"(b),"v"(c));return r;}
__device__ __forceinline__ float max2f(float a,float b){float r;asm("v_max_f32_e32 %0, %1, %2":"=v"(r):"v"(a),"v"(b));return r;}
__device__ __forceinline__ float fadd_s(float a,float b){float r;asm("v_add_f32_e32 %0, %1, %2":"=v"(r):"v"(a),"v"(b));return r;}
__device__ __forceinline__ float fsub_s(float a,float b){float r;asm("v_sub_f32_e32 %0, %1, %2":"=v"(r):"v"(a),"v"(b));return r;}
typedef float f32x2_t __attribute__((ext_vector_type(2))); typedef __bf16 bf16x2_t __attribute__((ext_vector_type(2)));
__device__ __forceinline__ unsigned cvtpk_s(float lo,float hi){f32x2_t v={lo,hi};bf16x2_t b=__builtin_convertvector(v,bf16x2_t);return __builtin_bit_cast(unsigned,b);}
#define WAIT_BAR(N) asm volatile("s_waitcnt vmcnt(" #N ") lgkmcnt(0)\n\ts_barrier":::"memory")

__device__ __forceinline__ void qkt(f32x16&p0,f32x16&p1,const char*Kslot,const bf16x8*qr,const f32x16&negm,int r32,int hi){
  const char*kb=Kslot+hi*1024+r32*16;
  #pragma unroll
  for(int d0=0;d0<4;++d0){
    const bf16x8 b0=*reinterpret_cast<const bf16x8*>(kb+d0*2048);
    const bf16x8 b1=*reinterpret_cast<const bf16x8*>(kb+d0*2048+512);
    if(d0==0){p0=__builtin_amdgcn_mfma_f32_32x32x16_bf16(b0,qr[0],negm,0,0,0);p1=__builtin_amdgcn_mfma_f32_32x32x16_bf16(b1,qr[0],negm,0,0,0);}
    else{p0=__builtin_amdgcn_mfma_f32_32x32x16_bf16(b0,qr[d0],p0,0,0,0);p1=__builtin_amdgcn_mfma_f32_32x32x16_bf16(b1,qr[d0],p1,0,0,0);}}
}
typedef __attribute__((address_space(3))) const char* lds_cptr;
typedef short v4i16_t __attribute__((ext_vector_type(4)));
__device__ __forceinline__ void kload8(bf16x8*kf,lds_cptr kp){
  kf[0]=*(const __attribute__((address_space(3))) bf16x8*)(kp);      kf[1]=*(const __attribute__((address_space(3))) bf16x8*)(kp+512);
  kf[2]=*(const __attribute__((address_space(3))) bf16x8*)(kp+2048); kf[3]=*(const __attribute__((address_space(3))) bf16x8*)(kp+2560);
  kf[4]=*(const __attribute__((address_space(3))) bf16x8*)(kp+4096); kf[5]=*(const __attribute__((address_space(3))) bf16x8*)(kp+4608);
  kf[6]=*(const __attribute__((address_space(3))) bf16x8*)(kp+6144); kf[7]=*(const __attribute__((address_space(3))) bf16x8*)(kp+6656);
}
__device__ __forceinline__ void kload2(bf16x8*kf,lds_cptr kp,int j){ kf[2*j]=*(const __attribute__((address_space(3))) bf16x8*)(kp+j*2048); kf[2*j+1]=*(const __attribute__((address_space(3))) bf16x8*)(kp+j*2048+512); }
__device__ __forceinline__ s16x4 vtr(lds_cptr p){ return __builtin_bit_cast(s16x4,__builtin_amdgcn_ds_read_tr16_b64_v4i16((__attribute__((address_space(3))) v4i16_t*)p)); }
__device__ __forceinline__ float rowmax(const f32x16&p0,const f32x16&p1){
  float a=max3f(p0[0],p0[1],p1[0]),b=max3f(p0[2],p0[3],p1[1]);a=max3f(a,p1[2],p1[3]);
  #pragma unroll
  for(int r=4;r<16;r+=4){a=max3f(a,p0[r],p0[r+1]);b=max3f(b,p0[r+2],p0[r+3]);a=max3f(a,p1[r],p1[r+1]);b=max3f(b,p1[r+2],p1[r+3]);}
  const float m=max2f(a,b);
  auto rr=__builtin_amdgcn_permlane32_swap(__float_as_uint(m),__float_as_uint(m),false,false);
  return max2f(__uint_as_float(rr[0]),__uint_as_float(rr[1]));
}
__device__ __forceinline__ void pv(f32x16*o,int vb,bf16x8 pa0,bf16x8 pa1,bf16x8 pa2,bf16x8 pa3){
  #pragma unroll
  for(int d0=0;d0<2;++d0){s16x4 lo[4],hi[4];
    #pragma unroll
    for(int ks=0;ks<4;++ks){
      asm volatile("ds_read_b64_tr_b16 %0,%1 offset:%c2":"=&v"(lo[ks]):"v"(vb),"i"(d0*4096+ks*1024):"memory");
      asm volatile("ds_read_b64_tr_b16 %0,%1 offset:%c2":"=&v"(hi[ks]):"v"(vb),"i"(d0*4096+ks*1024+512):"memory");}
    asm volatile("s_waitcnt lgkmcnt(0)":::"memory");SBAR();
    #define PK(k) (bf16x8){lo[k][0],lo[k][1],lo[k][2],lo[k][3],hi[k][0],hi[k][1],hi[k][2],hi[k][3]}
    o[d0]=__builtin_amdgcn_mfma_f32_32x32x16_bf16(pa0,PK(0),o[d0],0,0,0);
    o[d0]=__builtin_amdgcn_mfma_f32_32x32x16_bf16(pa1,PK(1),o[d0],0,0,0);
    o[d0]=__builtin_amdgcn_mfma_f32_32x32x16_bf16(pa2,PK(2),o[d0],0,0,0);
    o[d0]=__builtin_amdgcn_mfma_f32_32x32x16_bf16(pa3,PK(3),o[d0],0,0,0);
    #undef PK
  }
}

#ifndef ATTN_STORE16
#define ATTN_STORE16(p,v) (*(u32x4*)(p)=(v))
#endif
template<int THRL> __device__ __forceinline__ void attn_unit(long qrow0,int h,long kvrow0,int NT,const bf16*Q,const bf16*__restrict__ K,const bf16*__restrict__ V,bf16*O,char*shm){
  const int tid=tid_opaque(),lane=tid&63,r32=lane&31,hi=lane>>5; const int wid=__builtin_amdgcn_readfirstlane(tid>>6);
  const bf16*Qw=Q+(qrow0+wid*QBLK)*QP+h*D;
  const bf16*Kh=K+kvrow0*KVP+(h>>2)*D,*Vh=V+kvrow0*KVP+(h>>2)*D;
  const unsigned lds0=(unsigned)(uintptr_t)shm;
  float*wsf=(float*)(shm+LDS_WS)+wid*64;
  const unsigned kvo=(unsigned)(lane*KVP+wid*8)*2u;
  const unsigned vvo=(unsigned)((16*(wid&3)+(lane>>2))*KVP+(wid>>2)*32+(lane&3)*8)*2u;
  const unsigned kdst=lds0+LDS_K+wid*1024, vdst=lds0+LDS_V+wid*1024;
  #define DMA_K(t,slot) glds16s(Kh+(long)(t)*KVBLK*KVP,kvo,(unsigned)__builtin_amdgcn_readfirstlane(kdst+(slot)))
  #define DMA_V(t,slot) glds16s(Vh+(long)(t)*KVBLK*KVP,vvo,(unsigned)__builtin_amdgcn_readfirstlane(vdst+(slot)))
  const int vb0=(int)(lds0+LDS_V)+((lane>>4)&1)*32+(lane&3)*8+(4*hi+((lane&15)>>2))*64;
  const char*Kbase=shm+LDS_K; bf16x8 kf[8];
  const lds_cptr shm3=(lds_cptr)shm; const lds_cptr kp0=shm3+LDS_K+hi*1024+r32*16; const lds_cptr vp0=shm3+LDS_V+((lane>>4)&1)*32+(lane&3)*8+(4*hi+((lane&15)>>2))*64;
  DMA_K(0,0);DMA_V(0,0);DMA_K(1,SLOTB);
  bf16x8 qr[4];
  #pragma unroll
  for(int d0=0;d0<4;++d0)qr[d0]=*reinterpret_cast<const bf16x8*>(&Qw[(long)r32*QP+d0*16+hi*8]);
  float mhat=0.f,l_reg=0.f;f32x16 o[2];o[0]=f32x16{};o[1]=f32x16{};f32x16 negm=f32x16{};asm volatile("":"+v"(negm));
  #define CMASK(P0,P1,t) do{}while(0)
  bool resc=false;
  #define START(P0,P1) do{ const float rm=rowmax(P0,P1); resc=false; \
    { const float dl=rm; mhat=fadd_s(mhat,dl); \
      _Pragma("unroll") for(int r=0;r<16;++r){P0[r]=fsub_s(P0[r],dl);P1[r]=fsub_s(P1[r],dl);} \
      _Pragma("unroll") for(int r=0;r<16;++r)negm[r]=-mhat; asm volatile("":"+v"(negm)); } \
    _Pragma("unroll") for(int r=0;r<16;++r)P0[r]=__builtin_amdgcn_exp2f(P0[r]); }while(0)
  #define RESC() do{ if(resc){ asm volatile("s_waitcnt lgkmcnt(0)":::"memory"); \
      _Pragma("unroll") for(int d_=0;d_<2;++d_) _Pragma("unroll") for(int r=0;r<16;++r)o[d_][r]*=wsf[crow(r,hi)]; } }while(0)
  f32x16 pA0,pA1,pB0,pB1;
  int sl_prev=0,sl_cur=0,sl_next=SLOTB;
  #define ROT() do{sl_prev=sl_cur;sl_cur=sl_next;sl_next=(sl_next==(NSLOT-1)*SLOTB)?0:sl_next+SLOTB;}while(0)
  DMA_K(2,2*SLOTB);
  WAIT_BAR(3);
  qkt(pA0,pA1,Kbase,qr,negm,r32,hi);asm volatile("s_nop 15\n\ts_nop 7":"+v"(pA0),"+v"(pA1));CMASK(pA0,pA1,0);
  START(pA0,pA1);
  _Pragma("unroll") for(int r=0;r<16;++r)pA1[r]=__builtin_amdgcn_exp2f(pA1[r]);
  WAIT_BAR(0);
  DMA_K(3,0);DMA_V(1,SLOTB);
  ROT();
  kload8(kf,kp0+sl_cur);
  WAIT_BAR(2);
  s16x4 vlo[8],vhi[8]; u32x4 pw0,pw1,pw2,pw3;
  #define PKW(P,B) cvtpk_s(P[B],P[B+1])
  #define PAF(k) __builtin_bit_cast(bf16x8,pw##k)
  #define VFR(i) (bf16x8){vlo[i][0],vlo[i][1],vlo[i][2],vlo[i][3],vhi[i][0],vhi[i][1],vhi[i][2],vhi[i][3]}
  #define PIN(x) asm volatile("":"+v"(x))
  #define MX3(a,b,c) __builtin_fmaxf(__builtin_fmaxf((a),(b)),(c))
  #define GAPA(MF,A0,A1,A2,A3,W0,W1,PW) do{ MF; sacc+=A0; sacc+=A1; sacc+=A2; sacc+=A3; PIN(sacc); W0; W1; PIN(PW); SBAR(); }while(0)
  #define EX(v) __builtin_amdgcn_exp2f(v)
  #define GAPB(MF,X,B) do{ MF; X[B]=EX(X[B]); X[B+1]=EX(X[B+1]); X[B+2]=EX(X[B+2]); X[B+3]=EX(X[B+3]); PIN(X); SBAR(); }while(0)
  #define VRD(i) do{ vlo[i]=vtr(vp_+(((i)>>2)*4096+((i)&3)*1024)); vhi[i]=vtr(vp_+(((i)>>2)*4096+((i)&3)*1024+512)); }while(0)
  #define KRD(G,j) do{ if(G){ kload2(kf,kp0+sl_next,j); SBAR(); } }while(0)
  #define STEP(C0,C1,P0,P1,t,GK,GV,GL) do{ SBAR(); \
    const lds_cptr vp_=vp0+sl_prev; \
    VRD(0); SBAR(); float sacc=(P0[0]+P0[1]); \
    GAPA(C0=__builtin_amdgcn_mfma_f32_32x32x16_bf16(kf[0],qr[0],negm,0,0,0), P0[2],P0[3],P0[4],P0[5],     pw0[0]=PKW(P0,0), pw0[1]=PKW(P0,2), pw0); \
    VRD(4); SBAR(); GAPA(C1=__builtin_amdgcn_mfma_f32_32x32x16_bf16(kf[1],qr[0],negm,0,0,0), P0[6],P0[7],P0[8],P0[9],     pw0[2]=PKW(P0,4), pw0[3]=PKW(P0,6), pw0); \
    VRD(1); SBAR(); GAPA(C0=__builtin_amdgcn_mfma_f32_32x32x16_bf16(kf[2],qr[1],C0,0,0,0),   P0[10],P0[11],P0[12],P0[13], pw1[0]=PKW(P0,8), pw1[1]=PKW(P0,10), pw1); \
    VRD(5); SBAR(); GAPA(C1=__builtin_amdgcn_mfma_f32_32x32x16_bf16(kf[3],qr[1],C1,0,0,0),   P0[14],P0[15],P1[0],P1[1],   pw1[2]=PKW(P0,12),pw1[3]=PKW(P0,14), pw1); \
    VRD(2); SBAR(); GAPA(C0=__builtin_amdgcn_mfma_f32_32x32x16_bf16(kf[4],qr[2],C0,0,0,0),   P1[2],P1[3],P1[4],P1[5],     pw2[0]=PKW(P1,0), pw2[1]=PKW(P1,2), pw2); \
    VRD(6); SBAR(); GAPA(C1=__builtin_amdgcn_mfma_f32_32x32x16_bf16(kf[5],qr[2],C1,0,0,0),   P1[6],P1[7],P1[8],P1[9],     pw2[2]=PKW(P1,4), pw2[3]=PKW(P1,6), pw2); \
    VRD(3); SBAR(); GAPA(C0=__builtin_amdgcn_mfma_f32_32x32x16_bf16(kf[6],qr[3],C0,0,0,0),   P1[10],P1[11],P1[12],P1[13], pw3[0]=PKW(P1,8), pw3[1]=PKW(P1,10), pw3); \
    VRD(7); SBAR(); GAPA(C1=__builtin_amdgcn_mfma_f32_32x32x16_bf16(kf[7],qr[3],C1,0,0,0),   P1[14],P1[15],0.f,0.f,       pw3[2]=PKW(P1,12),pw3[3]=PKW(P1,14), pw3); \
    l_reg+=sacc; \
    if(GK){DMA_K((t)+3,sl_cur);} if(GV){DMA_V((t)+1,sl_next);} \
    CMASK(C0,C1,t); \
    { float a=MX3(C0[0],C0[1],C1[0]),b=MX3(C0[2],C0[3],C1[1]); a=MX3(a,C1[2],C1[3]); \
      _Pragma("unroll") for(int r=4;r<16;r+=4){a=MX3(a,C0[r],C0[r+1]);b=MX3(b,C0[r+2],C0[r+3]);a=MX3(a,C1[r],C1[r+1]);b=MX3(b,C1[r+2],C1[r+3]);} \
      float rm=__builtin_fmaxf(a,b); { auto rr=__builtin_amdgcn_permlane32_swap(__float_as_uint(rm),__float_as_uint(rm),false,false); rm=__builtin_fmaxf(__uint_as_float(rr[0]),__uint_as_float(rr[1])); } \
      resc=false; \
      if(__builtin_expect(__any(rm>(float)THRL),0)){ const float dl=__builtin_fmaxf(rm,0.f); mhat+=dl; \
        _Pragma("unroll") for(int r=0;r<16;++r){C0[r]-=dl;C1[r]-=dl;} \
        _Pragma("unroll") for(int r=0;r<16;++r)negm[r]=-mhat; asm volatile("":"+v"(negm)); \
        const float f=__builtin_amdgcn_exp2f(-dl); l_reg*=f; if(hi==0)wsf[r32]=f; resc=true; } } \
    SBAR(); \
    GAPB(o[0]=__builtin_amdgcn_mfma_f32_32x32x16_bf16(PAF(0),VFR(0),o[0],0,0,0), C0,0); \
    GAPB(o[1]=__builtin_amdgcn_mfma_f32_32x32x16_bf16(PAF(0),VFR(4),o[1],0,0,0), C0,4); \
    KRD(GL,0); GAPB(o[0]=__builtin_amdgcn_mfma_f32_32x32x16_bf16(PAF(1),VFR(1),o[0],0,0,0), C0,8); \
    KRD(GL,1); GAPB(o[1]=__builtin_amdgcn_mfma_f32_32x32x16_bf16(PAF(1),VFR(5),o[1],0,0,0), C0,12); \
    KRD(GL,2); GAPB(o[0]=__builtin_amdgcn_mfma_f32_32x32x16_bf16(PAF(2),VFR(2),o[0],0,0,0), C1,0); \
    KRD(GL,3); GAPB(o[1]=__builtin_amdgcn_mfma_f32_32x32x16_bf16(PAF(2),VFR(6),o[1],0,0,0), C1,4); \
    GAPB(o[0]=__builtin_amdgcn_mfma_f32_32x32x16_bf16(PAF(3),VFR(3),o[0],0,0,0), C1,8); \
    GAPB(o[1]=__builtin_amdgcn_mfma_f32_32x32x16_bf16(PAF(3),VFR(7),o[1],0,0,0), C1,12); \
    }while(0)
  int t=1;
  for(;t+5<NT;t+=2){
    STEP(pB0,pB1,pA0,pA1,t,true,true,true);     WAIT_BAR(2); RESC(); ROT();
    STEP(pA0,pA1,pB0,pB1,t+1,true,true,true);   WAIT_BAR(2); RESC(); ROT();
  }
  #define ENDW(tt) do{ if((tt)+3<NT){WAIT_BAR(2);} else if((tt)+2<NT){WAIT_BAR(1);} else {WAIT_BAR(0);} }while(0)
  for(;t+1<NT;t+=2){
    STEP(pB0,pB1,pA0,pA1,t,(t+3<NT),(t+1<NT),(t+1<NT));       ENDW(t);   RESC(); ROT();
    STEP(pA0,pA1,pB0,pB1,t+1,(t+4<NT),(t+2<NT),(t+2<NT));     ENDW(t+1); RESC(); ROT();
  }
  STEP(pB0,pB1,pA0,pA1,NT-1,false,false,false); RESC();
  { float sacc=pB0[0]+pB0[1]; _Pragma("unroll") for(int r=2;r<16;++r)sacc+=pB0[r]; _Pragma("unroll") for(int r=0;r<16;++r)sacc+=pB1[r]; l_reg+=sacc;
    pw0=(u32x4){PKW(pB0,0),PKW(pB0,2),PKW(pB0,4),PKW(pB0,6)};pw1=(u32x4){PKW(pB0,8),PKW(pB0,10),PKW(pB0,12),PKW(pB0,14)};pw2=(u32x4){PKW(pB1,0),PKW(pB1,2),PKW(pB1,4),PKW(pB1,6)};pw3=(u32x4){PKW(pB1,8),PKW(pB1,10),PKW(pB1,12),PKW(pB1,14)};
    SBAR(); pv(o,vb0+sl_cur,PAF(0),PAF(1),PAF(2),PAF(3)); }
  #undef PKW
  #undef PAF
  #undef VFR
  #undef PIN
  #undef MX3
  #undef GAPA
  #undef GAPB
  #undef EX
  #undef VRD
  #undef KRD
  #undef STEP
  #undef ENDW
  {auto rr=__builtin_amdgcn_permlane32_swap(__float_as_uint(l_reg),__float_as_uint(l_reg),false,false);l_reg=__uint_as_float(rr[0])+__uint_as_float(rr[1]);}
  if(hi==0)wsf[32+r32]=l_reg;asm volatile("s_waitcnt lgkmcnt(0)":::"memory");
  float rli[16];
  #pragma unroll
  for(int r=0;r<16;++r)rli[r]=__builtin_amdgcn_rcpf(wsf[32+crow(r,hi)]);
#if ATT_FP8
  { unsigned char*Ow8=(unsigned char*)O+(qrow0+wid*QBLK)*QP+h*D;
    unsigned char*stg8=(unsigned char*)(shm+LDS_OST)+wid*4096;
    #pragma unroll
    for(int r=0;r<16;++r){const int orow=crow(r,hi);
      #pragma unroll
      for(int d0=0;d0<2;++d0){const float x=o[d0][r]*rli[r]*(float)(1<<ATT_OSH); stg8[orow*64+d0*32+r32]=(unsigned char)(__builtin_amdgcn_cvt_pk_fp8_f32(x,x,0u,false)&0xffu);}}
    asm volatile("s_waitcnt lgkmcnt(0)":::"memory");
    #pragma unroll
    for(int i=0;i<2;++i){const int row=i*16+(lane>>2),ch=lane&3; const u32x4 v=*(const u32x4*)(stg8+row*64+ch*16); ATTN_STORE16(Ow8+(long)row*QP+ch*16,v);} }
#else
  bf16*Ow=O+(qrow0+wid*QBLK)*QP+h*D;
  { bf16*stg=(bf16*)(shm+LDS_OST)+wid*2048;
    #pragma unroll
    for(int r=0;r<16;++r){const int orow=crow(r,hi);
      #pragma unroll
      for(int d0=0;d0<2;++d0)stg[orow*64+d0*32+r32]=__float2bfloat16(o[d0][r]*rli[r]);}
    asm volatile("s_waitcnt lgkmcnt(0)":::"memory");
    #pragma unroll
    for(int i=0;i<4;++i){const int row=i*8+(lane>>3),ch=lane&7; const u32x4 v=*(const u32x4*)(stg+row*64+ch*8); ATTN_STORE16(Ow+(long)row*QP+ch*8,v);} }
#endif
  asm volatile("s_waitcnt lgkmcnt(0)\n\ts_barrier":::"memory");
  #undef DMA_K
  #undef DMA_V
  #undef CMASK
  #undef START
  #undef RESC
  #undef ROT
}
constexpr int ATTN_LDS_BYTES=LDS_BYTES;
#undef SBAR
#undef WAIT_BAR
}

typedef f32x4 AccT[2][2][4][2];
__device__ __forceinline__ long kv_row(int r) { return r < TL ? (long)(r / SEQ) * KVROWS + CTXL + (r % SEQ) : (long)((r - TL) / CTXL) * KVROWS + ((r - TL) % CTXL); }

struct SchedDense {
    static constexpr bool IMM_DONE = false;
    const char* A; const char* B; size_t astep, bstep, acol; int nM, nN, G, c;
    __device__ __forceinline__ bool next(int i, pg8::Unit& u) const {
        const int L = i * G + c; if (L >= nM * nN) return false;
        pg8::tile_of(L, nM, nN, u.pm, u.pn); u.A = A + (size_t)u.pm * astep + (size_t)u.pn * acol; u.B = B + (size_t)u.pn * bstep; u.x0 = 0; u.x1 = 0; return true; }
    __device__ __forceinline__ int gather(const pg8::Unit&, int) const { return 0; }
    __device__ __forceinline__ void a_ready(const pg8::Unit&, int) const {}
    __device__ __forceinline__ void done(const pg8::Unit&, int) const {}
};
struct SchedDenseR {
    static constexpr bool IMM_DONE = true;
    const char* A; const char* B; size_t astep, bstep, acol; int nM, nN, nF, G, c; unsigned* ready;
    __device__ __forceinline__ bool next(int i, pg8::Unit& u) const {
        const int L = i * G + c, n1 = nF * nN; if (L >= nM * nN) return false;
        if (L < n1) pg8::tile_of(L, nF, nN, u.pm, u.pn); else { u.pm = nF + (L - n1) / nN; u.pn = (L - n1) % nN; }
        u.A = A + (size_t)u.pm * astep + (size_t)u.pn * acol; u.B = B + (size_t)u.pn * bstep; u.x0 = 0; u.x1 = 0; return true; }
    __device__ __forceinline__ int gather(const pg8::Unit&, int) const { return 0; }
    __device__ __forceinline__ void a_ready(const pg8::Unit&, int) const {}
    __device__ __forceinline__ void done(const pg8::Unit& u, int lane) const { if (lane == 0) __hip_atomic_fetch_add(ready + u.pm, 1u, __ATOMIC_RELAXED, __HIP_MEMORY_SCOPE_AGENT); }
};
struct SchedOutproj {
    static constexpr bool IMM_DONE = true;
    const char* A; const char* B; size_t astep, bstep; int G, c; const unsigned* rdg; unsigned* ready;
    __device__ __forceinline__ bool next(int i, pg8::Unit& u) const {
        int n;
        if (G == 256) { if (c >= 32) { if (i == 0) n = c - 32; else if (i == 1 && c < 64) n = 224 + (c - 32); else return false; } else { if (i == 0 && c < 16) n = 256 + c; else return false; } }
        else { n = i * G + c; if (n >= 272) return false; }
        u.pm = n >> 2; u.pn = n & 3; u.A = A + (size_t)u.pm * astep; u.B = B + (size_t)u.pn * bstep; u.x0 = 0; u.x1 = 0; return true; }
    __device__ __forceinline__ int gather(const pg8::Unit&, int) const { return 0; }
    __device__ __forceinline__ void a_ready(const pg8::Unit& u, int wid) const {
        if (wid == 0) { unsigned sp = 0;
            while ((unsigned)__builtin_amdgcn_readfirstlane(__hip_atomic_load(rdg + u.pm, __ATOMIC_RELAXED, __HIP_MEMORY_SCOPE_AGENT)) < 8u) { __builtin_amdgcn_s_sleep(2); if (++sp > (1u << 22)) break; }
            __builtin_amdgcn_fence(__ATOMIC_ACQUIRE, "agent"); asm volatile("s_waitcnt vmcnt(0)" ::: "memory"); }
        __builtin_amdgcn_s_barrier(); asm volatile("" ::: "memory");
    }
    __device__ __forceinline__ void done(const pg8::Unit& u, int lane) const { if (lane == 0) __hip_atomic_fetch_add(ready + u.pm, 1u, __ATOMIC_RELAXED, __HIP_MEMORY_SCOPE_AGENT); }
};
struct SchedQKV {
    static constexpr bool IMM_DONE = false;
    const char* A; const char* B; size_t tstep; int ctxq, G, c;
    __device__ __forceinline__ bool next(int i, pg8::Unit& u) const {
        const int L = i * G + c, n1 = 64 * 6, n2 = ctxq ? 24 : 8; if (L >= n1 + n2) return false;
        if (L < n1) pg8::tile_of(L, 64, 6, u.pm, u.pn);
        else if (ctxq) { pg8::tile_of(L - n1, 4, 6, u.pm, u.pn); u.pm += 64; }
        else { u.pm = 64 + ((L - n1) >> 1); u.pn = 4 + ((L - n1) & 1); }
        u.A = A + (size_t)u.pm * tstep; u.B = B + (size_t)u.pn * tstep; u.x0 = 0; u.x1 = 0; return true; }
    __device__ __forceinline__ int gather(const pg8::Unit&, int) const { return 0; }
    __device__ __forceinline__ void a_ready(const pg8::Unit&, int) const {}
    __device__ __forceinline__ void done(const pg8::Unit&, int) const {}
};
struct SchedMoe {
    static constexpr bool IMM_DONE = false;
    const char* Abase; size_t astep; const char* Bbase; size_t bstep_e, bstep_n; const LAS int* tab; const int* list; int G, c;
    unsigned* ready; int mode;
    __device__ __forceinline__ int T(int i) const { return __builtin_amdgcn_readfirstlane(tab[i]); }
    __device__ __forceinline__ bool next(int i, pg8::Unit& u) const {
        const int ntiles = T(32); int gt, pn;
        if (G == 256) {
            const int x = c & 7, j = c >> 3, g = (mode == 2 ? 7 - x : x) + 8 * i, fm = 8 * g; if (fm >= ntiles) return false;
            const int gsz = (ntiles - fm) < 8 ? (ntiles - fm) : 8; if (j >= 4 * gsz) return false;
            gt = fm + j % gsz; pn = j / gsz; }
        else { const int L = i * G + (mode == 2 ? G - 1 - c : c); if (L >= ntiles * 4) return false; pg8::tile_of(L, ntiles, 4, gt, pn); }
        int e = 0;
        for (int q = 1; q < 32; ++q) e += (T(q) <= gt) ? 1 : 0;
        const int ti = gt - T(e); int valid = T(40 + e) - ti * 256; valid = valid > 256 ? 256 : valid;
        u.pm = gt; u.pn = pn; u.x0 = e * MOE_CAP + ti * 256; u.x1 = valid;
        u.A = Abase + (size_t)gt * astep; u.B = Bbase + (size_t)e * bstep_e + (size_t)pn * bstep_n; return true; }
    __device__ __forceinline__ int gather(const pg8::Unit& u, int lr) const { return lr < u.x1 ? (list[u.x0 + lr] >> 1) : 0; }
    __device__ __forceinline__ void a_ready(const pg8::Unit& u, int wid) const {
        if (mode != 2) return;
        if (wid == 0) { unsigned sp = 0;
            while ((unsigned)__builtin_amdgcn_readfirstlane(__hip_atomic_load(ready + u.pm, __ATOMIC_RELAXED, __HIP_MEMORY_SCOPE_AGENT)) < 32u) { __builtin_amdgcn_s_sleep(2); if (++sp > (1u << 22)) break; }
            __builtin_amdgcn_fence(__ATOMIC_ACQUIRE, "agent"); asm volatile("s_waitcnt vmcnt(0)" ::: "memory"); }
        __builtin_amdgcn_s_barrier(); asm volatile("" ::: "memory");
    }
    __device__ __forceinline__ void done(const pg8::Unit& u, int lane) const {
        if (mode != 1) return;
        if (lane == 0) __hip_atomic_fetch_add(ready + u.pm, 1u, __ATOMIC_RELAXED, __HIP_MEMORY_SCOPE_AGENT);
    }
};

struct EpiQKV { static constexpr bool PERM = true; bf16* Q; bf16* Kb; bf16* Vb; const float* qg; const float* kg; const f32x2* tab;
    __device__ __forceinline__ void operator()(const AccT& acc, const pg8::Unit& u, int wr, int wc, int fr, int fq) const {
        bf16* base; int pitch; long row0;
        if (u.pn < 4) { base = Q + u.pn * 256; pitch = 1024; row0 = (long)u.pm * 256; }
        else { base = (u.pn == 4) ? Kb : Vb; pitch = 256; row0 = kv_row(u.pm * 256); }
        const bool isv = u.pn == 5, lat = u.pm < 64; const float* g = u.pn < 4 ? qg : kg; const float post = u.pn < 4 ? 0.125f * 1.4426950408889634f : 1.0f;
#pragma unroll
        for (int ai = 0; ai < 2; ++ai)
#pragma unroll
            for (int m = 0; m < 4; ++m) { int fq_ = fq; asm volatile("" : "+v"(fq_));
                const int fq = fq_; const int lr = ai * 128 + wr * 64 + m * 16 + fr; const unsigned roff = (unsigned)(((int)row0 + lr) * pitch + wc * 64 + 8 * fq) * 2u;
                f32x4 g0[2], g1[2];
#pragma unroll
                for (int bj = 0; bj < 2; ++bj) { g0[bj] = *(const f32x4*)(g + 32 * bj + 8 * fq); g1[bj] = *(const f32x4*)(g + 32 * bj + 8 * fq + 4); }
                f32x4 v[2][2];
#pragma unroll
                for (int bj = 0; bj < 2; ++bj) { v[bj][0] = acc[ai][bj][m][0]; v[bj][1] = acc[ai][bj][m][1]; }
                if (!isv) {
                    float ss = 0.f;
#pragma unroll
                    for (int bj = 0; bj < 2; ++bj)
#pragma unroll
                        for (int n = 0; n < 2; ++n) ss += (v[bj][n][0] * v[bj][n][0] + v[bj][n][1] * v[bj][n][1]) + (v[bj][n][2] * v[bj][n][2] + v[bj][n][3] * v[bj][n][3]);
                    ss += __shfl_xor(ss, 16); ss += __shfl_xor(ss, 32);
                    const float rstd = rsqrtf(ss * (1.0f / 64.0f) + EPS);
#pragma unroll
                    for (int bj = 0; bj < 2; ++bj) { v[bj][0] = v[bj][0] * rstd * g0[bj]; v[bj][1] = v[bj][1] * rstd * g1[bj]; }
                    if (lat) { const int t = (u.pm * 256 + lr) & (SEQ - 1);
#pragma unroll
                        for (int bj = 0; bj < 2; ++bj) { const f32x2* tb = (const f32x2*)((const char*)tab + (unsigned)(((bj == 0 ? (t >> 6) : (t & 63)) * 16 + 4 * fq) * 8));
#pragma unroll
                            for (int n = 0; n < 2; ++n)
#pragma unroll
                                for (int e = 0; e < 2; ++e) { const f32x2 cs = tb[2 * n + e]; const float x0 = v[bj][n][2 * e], x1 = v[bj][n][2 * e + 1];
                                    v[bj][n][2 * e] = x0 * cs.x - x1 * cs.y; v[bj][n][2 * e + 1] = x0 * cs.y + x1 * cs.x; } } }
#pragma unroll
                    for (int bj = 0; bj < 2; ++bj) { v[bj][0] = v[bj][0] * post; v[bj][1] = v[bj][1] * post; }
                }
#pragma unroll
                for (int bj = 0; bj < 2; ++bj)
                    *(u32x4*)((char*)base + roff + bj * 64) = (u32x4){cvtpk(v[bj][0][0], v[bj][0][1]), cvtpk(v[bj][0][2], v[bj][0][3]), cvtpk(v[bj][1][0], v[bj][1][1]), cvtpk(v[bj][1][2], v[bj][1][3])}; }
    }
};
template <bool PERM_> struct EpiResidT { static constexpr bool PERM = PERM_; const Args* a; int layer; const float* pscale; const bf16* srcbase;
    __device__ __forceinline__ void operator()(const AccT& acc, const pg8::Unit& u, int wr, int wc, int, int) const {
        int ln; asm volatile("v_mbcnt_lo_u32_b32 %0, -1, 0\n\tv_mbcnt_hi_u32_b32 %0, -1, %0" : "=v"(ln)); const int fr = ln & 15, fq = ln >> 4;
        const int r0 = u.pm * 256;
        const float* gate = mod_row(*a, layer, r0) + 2 * D;
        const bool f32src = (layer == 0) && !srcbase; const float* src32 = resid_row(*a, 0, r0); const bf16* src16 = (srcbase ? srcbase : (const bf16*)(a->ws + WS_X)) + (size_t)r0 * D;
        const __amdgpu_buffer_rsrc_t rs = __builtin_amdgcn_make_buffer_rsrc((void*)(a->ws + WS_X), 0, TT * D * 2, 0x00020000);
        if constexpr (PERM_) {
#pragma unroll
        for (int bj = 0; bj < 2; ++bj) { const int cc = u.pn * 256 + bj * 128 + wc * 32 + 8 * fq;
            f32x4 g0 = *(const f32x4*)(gate + cc), g1 = *(const f32x4*)(gate + cc + 4); if (pscale) { g0 = g0 * *(const f32x4*)(pscale + cc); g1 = g1 * *(const f32x4*)(pscale + cc + 4); }
#pragma unroll
            for (int ai = 0; ai < 2; ++ai)
#pragma unroll
                for (int m = 0; m < 4; ++m) { const int off = (ai * 128 + wr * 64 + m * 16 + fr) * D + cc;
                    f32x4 s0, s1;
                    if (f32src) { s0 = *(const f32x4*)(src32 + off); s1 = *(const f32x4*)(src32 + off + 4); }
                    else { const u32x4 p = *(const u32x4*)(src16 + off); s0 = (f32x4){bflo(p.x), bfhi(p.x), bflo(p.y), bfhi(p.y)}; s1 = (f32x4){bflo(p.z), bfhi(p.z), bflo(p.w), bfhi(p.w)}; }
                    const f32x4 o0 = s0 + g0 * acc[ai][bj][m][0], o1 = s1 + g1 * acc[ai][bj][m][1];
                    __builtin_amdgcn_raw_buffer_store_b128((u32x4){cvtpk(o0.x, o0.y), cvtpk(o0.z, o0.w), cvtpk(o1.x, o1.y), cvtpk(o1.z, o1.w)}, rs, (r0 * D + off) * 2, 0, 16  ); }
            asm volatile("" ::: "memory"); }
        } else {
#pragma unroll
        for (int bj = 0; bj < 2; ++bj)
#pragma unroll
            for (int n = 0; n < 2; ++n) { const int cc = u.pn * 256 + bj * 128 + wc * 32 + n * 16 + 4 * fq; f32x4 g = *(const f32x4*)(gate + cc); if (pscale) g = g * *(const f32x4*)(pscale + cc);
#pragma unroll
                for (int ai = 0; ai < 2; ++ai)
#pragma unroll
                    for (int m = 0; m < 4; ++m) { const int off = (ai * 128 + wr * 64 + m * 16 + fr) * D + cc;
                        f32x4 s0;
                        if (f32src) s0 = *(const f32x4*)(src32 + off);
                        else { const u32x2 p = *(const u32x2*)(src16 + off); s0 = (f32x4){bflo(p.x), bfhi(p.x), bflo(p.y), bfhi(p.y)}; }
                        const f32x4 o0 = s0 + g * acc[ai][bj][m][n];
                        __builtin_amdgcn_raw_buffer_store_b64((u32x2){cvtpk(o0.x, o0.y), cvtpk(o0.z, o0.w)}, rs, (r0 * D + off) * 2, 0, 16  ); }
                asm volatile("" ::: "memory"); }
        }
    }
};
typedef EpiResidT<true> EpiResid; typedef EpiResidT<false> EpiResidN;
struct EpiGateUp { static constexpr bool PERM = true; bf16* act;
    __device__ __forceinline__ void operator()(const AccT& acc, const pg8::Unit& u, int wr, int wc, int fr, int fq) const {
        const __amdgpu_buffer_rsrc_t rs = __builtin_amdgcn_make_buffer_rsrc((void*)act, 0, 43008 * 512 * 2, 0x00020000);
#pragma unroll
        for (int ai = 0; ai < 2; ++ai)
#pragma unroll
            for (int m = 0; m < 4; ++m) { const int off = (int)((((size_t)u.pm * 256 + ai * 128 + wr * 64 + m * 16 + fr) * 512 + u.pn * 128 + wc * 32 + 8 * fq) * 2);
                const f32x4 g0 = acc[ai][0][m][0], g1 = acc[ai][0][m][1], u0 = acc[ai][1][m][0], u1 = acc[ai][1][m][1];
                const u32x4 ov = (u32x4){cvtpk(silu_f(g0[0]) * u0[0], silu_f(g0[1]) * u0[1]), cvtpk(silu_f(g0[2]) * u0[2], silu_f(g0[3]) * u0[3]),
                                     cvtpk(silu_f(g1[0]) * u1[0], silu_f(g1[1]) * u1[1]), cvtpk(silu_f(g1[2]) * u1[2], silu_f(g1[3]) * u1[3])};
#if MOE_FP8
                { const float sa = (float)(1 << MOE_ASH); const u32x2 o8 = (u32x2){pk_fp8x4(silu_f(g0[0]) * u0[0] * sa, silu_f(g0[1]) * u0[1] * sa, silu_f(g0[2]) * u0[2] * sa, silu_f(g0[3]) * u0[3] * sa),
                                                                                    pk_fp8x4(silu_f(g1[0]) * u1[0] * sa, silu_f(g1[1]) * u1[1] * sa, silu_f(g1[2]) * u1[2] * sa, silu_f(g1[3]) * u1[3] * sa)};
                  (void)ov; __builtin_amdgcn_raw_buffer_store_b64(o8, rs, off >> 1, 0, 16  ); } }
#else
                __builtin_amdgcn_raw_buffer_store_b128(ov, rs, off, 0, 16  ); }
#endif
    }
};
struct EpiDown { static constexpr bool PERM = true; const int* list; const float* w2; bf16* y2;
    __device__ __forceinline__ void operator()(const AccT& acc, const pg8::Unit& u, int wr, int wc, int fr, int fq) const {
#pragma unroll
        for (int ai = 0; ai < 2; ++ai)
#pragma unroll
            for (int m = 0; m < 4; ++m) { const int lr = ai * 128 + wr * 64 + m * 16 + fr;
                if (lr < u.x1) { const int dest = list[u.x0 + lr]; const float w = w2[dest]; bf16* p = y2 + (size_t)dest * D + u.pn * 256 + wc * 32 + 8 * fq;
#pragma unroll
                    for (int bj = 0; bj < 2; ++bj) { const f32x4 v0 = acc[ai][bj][m][0] * w, v1 = acc[ai][bj][m][1] * w;
                        *(u32x4*)(p + bj * 128) = (u32x4){cvtpk(v0[0], v0[1]), cvtpk(v0[2], v0[3]), cvtpk(v1[0], v1[1]), cvtpk(v1[2], v1[3])}; } } }
    }
};

constexpr int TAB_OFF = 135168;

__device__ __forceinline__ void ph_rope(const Args& a, const Ctx& c, int layer) {
    const int j = layer == 0 ? 0 : 1; const bool ctxq = layer == 0;
    const float* qg = a.in[I_QG] + j * 64; const float* kg = a.in[I_KG] + j * 64;
    const f32x2* tab = (const f32x2*)(a.ws + WS_ROPE);
    bf16* Qb = (bf16*)(a.ws + WS_Q); bf16* Kb = (bf16*)(a.ws + WS_K);
    const int nitems = TT * 20;
    for (int it = blockIdx.x * NTHREADS + c.tid; it < nitems; it += c.G * NTHREADS) {
        const int r = it / 20, hs = it % 20;
        if (hs < 16 && r >= TL && !ctxq) continue;
        bf16* p; const float* g; float post;
        if (hs < 16) { p = Qb + (size_t)r * 1024 + hs * 64; g = qg; post = 0.125f * 1.4426950408889634f; } else { p = Kb + kv_row(r) * 256 + (hs - 16) * 64; g = kg; post = 1.0f; }
        float x[64]; float ss = 0.f;
#pragma unroll
        for (int i = 0; i < 8; ++i) { const u32x4 w = ((const u32x4*)p)[i];
            x[8 * i + 0] = bflo(w.x); x[8 * i + 1] = bfhi(w.x); x[8 * i + 2] = bflo(w.y); x[8 * i + 3] = bfhi(w.y);
            x[8 * i + 4] = bflo(w.z); x[8 * i + 5] = bfhi(w.z); x[8 * i + 6] = bflo(w.w); x[8 * i + 7] = bfhi(w.w); }
#pragma unroll
        for (int i = 0; i < 64; ++i) ss += x[i] * x[i];
        const float rstd = rsqrtf(ss * (1.0f / 64.0f) + EPS);
#pragma unroll
        for (int i = 0; i < 64; ++i) x[i] = x[i] * rstd * g[i];
        if (r < TL) { const int t = r % SEQ, rp = t >> 6, cp = t & 63;
#pragma unroll
            for (int i = 0; i < 32; ++i) { const f32x2 cs = tab[(i < 16 ? rp : cp) * 16 + (i & 15)]; const float x0 = x[2 * i], x1 = x[2 * i + 1];
                x[2 * i] = x0 * cs.x - x1 * cs.y; x[2 * i + 1] = x0 * cs.y + x1 * cs.x; } }
#pragma unroll
        for (int i = 0; i < 8; ++i) ((u32x4*)p)[i] = (u32x4){cvtpk(x[8 * i] * post, x[8 * i + 1] * post), cvtpk(x[8 * i + 2] * post, x[8 * i + 3] * post),
                                                            cvtpk(x[8 * i + 4] * post, x[8 * i + 5] * post), cvtpk(x[8 * i + 6] * post, x[8 * i + 7] * post)};
    }
}

__device__ __forceinline__ void ph_att(const Args& a, const Ctx& c, int layer, char* lds_generic) {
    const int nun = 1024 + (layer == 0 ? 64 : 0);
    const attn_body::bf16* Qb = (const attn_body::bf16*)(a.ws + WS_Q); const attn_body::bf16* Kb = (const attn_body::bf16*)(a.ws + WS_K); const attn_body::bf16* Vb = (const attn_body::bf16*)(a.ws + WS_V);
    for (int U = c.vcu; U < nun; U += c.G) {
        long qrow0, kv0; int h, NT;
        if (U < 1024) { const int bh = U >> 4, qb = U & 15, b = bh >> 4; h = bh & 15; qrow0 = (long)b * SEQ + qb * 256; kv0 = (long)b * KVROWS; NT = KVROWS / 64; }
        else { const int q = U - 1024, b = q >> 4; h = q & 15; qrow0 = (long)TL + b * CTXL; kv0 = (long)b * KVROWS; NT = CTXL / 64; }
        attn_body::attn_unit<8>(qrow0, h, kv0, NT, Qb, Kb, Vb, (attn_body::bf16*)(a.ws + WS_HB), lds_generic);
    }
}

__device__ __forceinline__ void ph_m1(const Args& a, const Ctx& c, int layer, const unsigned* rdy, int nN, int amode) {
    const int Tm = layer == 3 ? TL : TT, ntiles = Tm / 32;
    int tl0, tl1, tl2;
    { int bid = (int)blockIdx.x; asm volatile("" : "+s"(bid));
      if (amode == 1 && c.G == 256 && ntiles == 544) {
          int k = c.vcu - 64; asm volatile("" : "+s"(k));
          if (k < 0) { tl0 = -1; tl1 = -1; tl2 = -1; } else { tl0 = k; tl1 = k + 192; tl2 = k < 64 ? k + 384 : (k < 160 ? 448 + (k - 64) : -1); } }
      else if (c.G == 256 && ntiles == 544) { if (bid < 16) { tl0 = 512 + bid; tl1 = -1; tl2 = -1; } else { const int j = bid - 16; tl0 = j; tl1 = j + 240; tl2 = j < 32 ? j + 480 : (j < 48 ? 528 + (j - 32) : -1); } }
      else { tl0 = bid < ntiles ? bid : -1; tl1 = bid + c.G < ntiles ? bid + c.G : -1; tl2 = bid + 2 * c.G < ntiles ? bid + 2 * c.G : -1; } }
    const unsigned need = 8u * (unsigned)nN;
#define M1_WAIT(tl) do { if (c.wave == 0) { unsigned sp_ = 0; \
        while ((unsigned)__builtin_amdgcn_readfirstlane(__hip_atomic_load(rdy + ((tl) >> 3), __ATOMIC_RELAXED, __HIP_MEMORY_SCOPE_AGENT)) < need) { __builtin_amdgcn_s_sleep(2); if (++sp_ > (1u << 22)) break; } \
        __builtin_amdgcn_fence(__ATOMIC_ACQUIRE, "agent"); asm volatile("s_waitcnt vmcnt(0)" ::: "memory"); } \
        __syncthreads(); } while (0)
    const float* g = a.in[I_NFFN] + layer * D;
    constexpr int RP = 2064;
    LAS unsigned char* hiT = c.lds; LAS unsigned char* loT = c.lds + 32 * RP;
    LAS float* part = (LAS float*)c.lds;
    LAS int* lcnt = (LAS int*)(c.lds + 133120); LAS int* lbase = lcnt + 32;
    LAS float* logit = (LAS float*)(c.lds + 134144);
    const bf16* wr = (const bf16*)(a.ws + WS_WR) + (size_t)layer * 2 * 65536;
    unsigned* gcnt = (unsigned*)(a.ws + WS_CTL) + CW_CNT + layer * 32;
    int* list = (int*)(a.ws + WS_LIST); float* w2 = (float*)(a.ws + WS_W2);
    const int r32 = c.lane & 31, hi = c.lane >> 5;
    if (c.tid < 32) lcnt[c.tid] = 0;
    u32x2 vr[4][4];
#define M1_LOADROWS(tl) do { _Pragma("unroll") for (int i = 0; i < 4; ++i) { const u32x2* xr = (const u32x2*)((const bf16*)(a.ws + WS_X) + (size_t)((tl) * 32 + 4 * c.wave + i) * D) + c.lane; \
        _Pragma("unroll") for (int j = 0; j < 4; ++j) vr[i][j] = xr[64 * j]; } } while (0)
    if (tl0 >= 0) { M1_WAIT(tl0); M1_LOADROWS(tl0); }
    int nmine = 0;
    for (; nmine < 3; ++nmine) { const int tile = nmine == 0 ? tl0 : nmine == 1 ? tl1 : tl2, tnext = nmine == 0 ? tl1 : nmine == 1 ? tl2 : -1;
        if (tile < 0) break;
        const int r0 = tile * 32;
        { f32x4 gs[4], sh[4];
          { const float* m = mod_row(a, layer, r0);
#pragma unroll
            for (int j = 0; j < 4; ++j) { gs[j] = ((const f32x4*)g)[c.lane + 64 * j] * (((const f32x4*)(m + 4 * D))[c.lane + 64 * j] + 1.0f); sh[j] = ((const f32x4*)(m + 3 * D))[c.lane + 64 * j]; } }
#pragma unroll
          for (int i = 0; i < 4; ++i) { const int lr = 4 * c.wave + i, r = r0 + lr;
            f32x4 h[4], vv[4];
#pragma unroll
            for (int j = 0; j < 4; ++j) { const u32x2 p = vr[i][j]; vv[j] = (f32x4){bflo(p.x), bfhi(p.x), bflo(p.y), bfhi(p.y)}; }
            const float rstd = row_rstd(vv);
#pragma unroll
            for (int j = 0; j < 4; ++j) h[j] = (vv[j] * rstd) * gs[j] + sh[j];
#if MOE_FP8
            unsigned* to8 = (unsigned*)((unsigned char*)(a.ws + WS_TK) + (size_t)r * D) + c.lane;
#else
            u32x2* to = (u32x2*)((bf16*)(a.ws + WS_TK) + (size_t)r * D) + c.lane;
#endif
#pragma unroll
            for (int j = 0; j < 4; ++j) { const unsigned h0 = cvtpk(h[j].x, h[j].y), h1 = cvtpk(h[j].z, h[j].w);
                const unsigned l0 = cvtpk(h[j].x - bflo(h0), h[j].y - bfhi(h0)), l1 = cvtpk(h[j].z - bflo(h1), h[j].w - bfhi(h1));
#if MOE_FP8
                to8[64 * j] = pk_fp8x4(h[j].x, h[j].y, h[j].z, h[j].w);
#else
                to[64 * j] = (u32x2){h0, h1};
#endif
                *(LAS u32x2*)(hiT + lr * RP + (4 * c.lane + 256 * j) * 2) = (u32x2){h0, h1};
                *(LAS u32x2*)(loT + lr * RP + (4 * c.lane + 256 * j) * 2) = (u32x2){l0, l1}; } } }
        __syncthreads();
        f32x16 acc0 = {}, acc1 = {};
#pragma unroll
        for (int kk = 0; kk < 8; ++kk) { const int k0 = 128 * c.wave + 16 * kk + 8 * hi;
            const bf16x8 ahi = *(const LAS bf16x8*)(hiT + r32 * RP + k0 * 2), alo = *(const LAS bf16x8*)(loT + r32 * RP + k0 * 2);
            const bf16* wf = wr + (c.wave * 8 + kk) * 2048 + c.lane * 8;
            const bf16x8 b0h = *(const bf16x8*)wf, b1h = *(const bf16x8*)(wf + 512), b0l = *(const bf16x8*)(wf + 1024), b1l = *(const bf16x8*)(wf + 1536);
            acc0 = __builtin_amdgcn_mfma_f32_32x32x16_bf16(ahi, b0h, acc0, 0, 0, 0); acc1 = __builtin_amdgcn_mfma_f32_32x32x16_bf16(ahi, b1h, acc1, 0, 0, 0);
            acc0 = __builtin_amdgcn_mfma_f32_32x32x16_bf16(alo, b0h, acc0, 0, 0, 0); acc1 = __builtin_amdgcn_mfma_f32_32x32x16_bf16(alo, b1h, acc1, 0, 0, 0);
            acc0 = __builtin_amdgcn_mfma_f32_32x32x16_bf16(ahi, b0l, acc0, 0, 0, 0); acc1 = __builtin_amdgcn_mfma_f32_32x32x16_bf16(ahi, b1l, acc1, 0, 0, 0); }
        if (tnext >= 0) { M1_WAIT(tnext); M1_LOADROWS(tnext); }
        else __syncthreads();
#pragma unroll
        for (int reg = 0; reg < 16; ++reg) { part[((c.wave * 2 + 0) * 16 + reg) * 64 + c.lane] = acc0[reg]; part[((c.wave * 2 + 1) * 16 + reg) * 64 + c.lane] = acc1[reg]; }
        __syncthreads();
        if (nmine < 3) {
#pragma unroll
            for (int q = 0; q < 4; ++q) { const int idx = c.tid + 512 * q, nt = idx >> 10, reg = (idx >> 6) & 15, ln = idx & 63; float s = 0.f;
#pragma unroll
                for (int w = 0; w < 8; ++w) s += part[((w * 2 + nt) * 16 + reg) * 64 + ln];
                logit[(nmine * 32 + (reg & 3) + 8 * (reg >> 2) + 4 * (ln >> 5)) * 64 + nt * 32 + (ln & 31)] = s; } }
        __syncthreads();
    }
#undef M1_LOADROWS
#undef M1_WAIT
    int e0 = 0, e1 = 0, p0 = 0, p1 = 0; float w0 = 0.f, w1 = 0.f; const int myt = c.tid >> 5; const bool act_r = c.tid < 96 && myt < nmine;
    if (act_r) { const LAS float* lg = logit + c.tid * 64;
        int grp = 0; float gm = lg[0];
#pragma unroll
        for (int q = 1; q < 4; ++q) if (lg[q] > gm) { gm = lg[q]; grp = q; }
        float den = 0.f;
#pragma unroll
        for (int q = 0; q < 4; ++q) den += expf(lg[q] - gm);
        const float gate = 1.0f / den;
        const LAS float* le = lg + 4 + grp * 8;
        int i0 = 0; float v0 = le[0];
#pragma unroll
        for (int q = 1; q < 8; ++q) if (le[q] > v0) { v0 = le[q]; i0 = q; }
        int i1 = -1; float v1 = -3.0e38f;
#pragma unroll
        for (int q = 0; q < 8; ++q) if (q != i0 && le[q] > v1) { v1 = le[q]; i1 = q; }
        const float ex = expf(v1 - v0); w0 = gate / (1.0f + ex); w1 = gate * ex / (1.0f + ex);
        e0 = grp * 8 + i0; e1 = grp * 8 + i1;
        p0 = __hip_atomic_fetch_add(lcnt + e0, 1, __ATOMIC_RELAXED, __HIP_MEMORY_SCOPE_WORKGROUP);
        p1 = __hip_atomic_fetch_add(lcnt + e1, 1, __ATOMIC_RELAXED, __HIP_MEMORY_SCOPE_WORKGROUP); }
    __syncthreads();
    if (c.tid < 32) { const int n = lcnt[c.tid]; lbase[c.tid] = n ? (int)__hip_atomic_fetch_add(gcnt + c.tid, (unsigned)n, __ATOMIC_RELAXED, __HIP_MEMORY_SCOPE_AGENT) : 0; }
    __syncthreads();
    if (act_r) { const int r = (myt == 0 ? tl0 : myt == 1 ? tl1 : tl2) * 32 + (c.tid & 31);
        list[e0 * MOE_CAP + lbase[e0] + p0] = 2 * r; w2[2 * r] = w0;
        list[e1 * MOE_CAP + lbase[e1] + p1] = 2 * r + 1; w2[2 * r + 1] = w1; }
    __syncthreads();
}
__device__ __forceinline__ void moe_tables(const Args& a, const Ctx& c, int layer, LAS int* tab) {
    unsigned* gcnt = (unsigned*)(a.ws + WS_CTL) + CW_CNT + layer * 32;
    if (c.tid < 32) tab[40 + c.tid] = (int)__hip_atomic_load(gcnt + c.tid, __ATOMIC_RELAXED, __HIP_MEMORY_SCOPE_AGENT);
    __syncthreads();
    if (c.tid == 0) { int s = 0; for (int e = 0; e < 32; ++e) { tab[e] = s; s += (tab[40 + e] + 255) >> 8; } tab[32] = s; }
    __syncthreads();
}

__device__ __forceinline__ void ph_rpool(const Args& a, const Ctx& c, int layer) {
    constexpr int TR = 34, HR = TR + 15;
    LAS unsigned char* hs = c.lds;
    const float* g = a.in[I_NMIX] + layer * D;
    for (int tile = blockIdx.x; tile < TT / TR; tile += c.G) {
        const int r0 = tile * TR;
        for (int lr0 = c.wave; lr0 < HR; lr0 += 2 * NWAVES) {
            const int lrA = lr0, lrB = lr0 + NWAVES; const int grA = r0 - 8 + lrA, grB = r0 - 8 + lrB;
            const bool okA = grA >= 0 && grA < TT, okB = lrB < HR && grB >= 0 && grB < TT;
            const int cA = grA < 0 ? 0 : (grA > TT - 1 ? TT - 1 : grA), cB = grB < 0 ? 0 : (grB > TT - 1 ? TT - 1 : grB);
            f32x4 vA[4], vB[4], h[4]; load_row_combined(a, layer, cA, c.lane, vA); load_row_combined(a, layer, cB, c.lane, vB);
            if (okA) {
                if (lrA >= 8 && lrA < 8 + TR) { u32x2* xo = (u32x2*)((bf16*)(a.ws + WS_Z) + (size_t)grA * D) + c.lane;
#pragma unroll
                    for (int j = 0; j < 4; ++j) xo[64 * j] = (u32x2){cvtpk(vA[j].x, vA[j].y), cvtpk(vA[j].z, vA[j].w)}; }
                const float rstd = row_rstd(vA); const float* m = mod_row(a, layer, grA);
                norm_mod(vA, rstd, g, m, m + D, c.lane, h);
#pragma unroll
                for (int j = 0; j < 4; ++j) *(LAS u32x2*)(hs + lrA * 2048 + (4 * c.lane + 256 * j) * 2) = (u32x2){cvtpk(h[j].x, h[j].y), cvtpk(h[j].z, h[j].w)}; }
            if (okB) {
                if (lrB >= 8 && lrB < 8 + TR) { u32x2* xo = (u32x2*)((bf16*)(a.ws + WS_Z) + (size_t)grB * D) + c.lane;
#pragma unroll
                    for (int j = 0; j < 4; ++j) xo[64 * j] = (u32x2){cvtpk(vB[j].x, vB[j].y), cvtpk(vB[j].z, vB[j].w)}; }
                const float rstd = row_rstd(vB); const float* m = mod_row(a, layer, grB);
                norm_mod(vB, rstd, g, m, m + D, c.lane, h);
#pragma unroll
                for (int j = 0; j < 4; ++j) *(LAS u32x2*)(hs + lrB * 2048 + (4 * c.lane + 256 * j) * 2) = (u32x2){cvtpk(h[j].x, h[j].y), cvtpk(h[j].z, h[j].w)}; } }
        __syncthreads();
        { const int half = 1 << (c.tid >> 7);
          const LAS unsigned* col = (const LAS unsigned*)hs + c.tid;
          float sx = 0.f, sy = 0.f;
          unsigned* ho = (unsigned*)((bf16*)(a.ws + WS_HB) + (size_t)r0 * D) + c.tid;
          for (int t = 0; t < TR; ++t) { const int gr = r0 + t;
              const int s0 = gr < TL ? (gr / SEQ) * SEQ : TL + ((gr - TL) / CTXL) * CTXL, s1 = s0 + (gr < TL ? SEQ : CTXL);
              const int lo = (gr - half) > s0 ? (gr - half) : s0, hi = (gr + half) < s1 ? (gr + half) : s1;
              if (t == 0 || gr == s0) { sx = 0.f; sy = 0.f;
                  for (int w = lo; w < hi; ++w) { const unsigned u = col[(w - r0 + 8) * 512]; sx += bflo(u); sy += bfhi(u); } }
              else { if (gr + half - 1 < s1) { const unsigned w = col[(t + 8 + half - 1) * 512]; sx += bflo(w); sy += bfhi(w); }
                     if (gr - 1 - half >= s0) { const unsigned w = col[(t + 8 - 1 - half) * 512]; sx -= bflo(w); sy -= bfhi(w); } }
              const float inv = __builtin_amdgcn_rcpf((float)(hi - lo)); const unsigned u = col[(t + 8) * 512];
              ho[t * 512] = cvtpk(sx * inv - bflo(u), sy * inv - bfhi(u)); } }
        __syncthreads();
    }
}

struct EpiInproj { static constexpr bool PERM = true; bf16* Z; bf16* XBC; float* DT; const float* dtb;
    __device__ __forceinline__ void operator()(const AccT& acc, const pg8::Unit& u, int wr, int wc, int fr, int fq) const {
        const size_t r0 = (size_t)u.pm * 256;
        if (u.pn < 20) { bf16* base; int pitch; if (u.pn < 8) { base = Z + u.pn * 256; pitch = 2048; } else { base = XBC + (u.pn - 8) * 256; pitch = 3072; }
#pragma unroll
            for (int ai = 0; ai < 2; ++ai)
#pragma unroll
                for (int m = 0; m < 4; ++m) { bf16* rowp = base + (r0 + ai * 128 + wr * 64 + m * 16 + fr) * pitch + wc * 32 + 8 * fq;
#pragma unroll
                    for (int bj = 0; bj < 2; ++bj) { const f32x4 v0 = acc[ai][bj][m][0], v1 = acc[ai][bj][m][1];
                        *(u32x4*)(rowp + bj * 128) = (u32x4){cvtpk(v0[0], v0[1]), cvtpk(v0[2], v0[3]), cvtpk(v1[0], v1[1]), cvtpk(v1[2], v1[3])}; } }
        } else if (wc < 2) { const int col = wc * 32 + 8 * fq; const f32x4 b0 = *(const f32x4*)(dtb + col), b1 = *(const f32x4*)(dtb + col + 4);
#pragma unroll
            for (int ai = 0; ai < 2; ++ai)
#pragma unroll
                for (int m = 0; m < 4; ++m) { float* p = DT + (r0 + ai * 128 + wr * 64 + m * 16 + fr) * 64 + col; f32x4 v0 = acc[ai][0][m][0] + b0, v1 = acc[ai][0][m][1] + b1;
#pragma unroll
                    for (int e = 0; e < 4; ++e) { v0[e] = fmaxf(v0[e], 0.f) + log1pf(__expf(-fabsf(v0[e]))); v1[e] = fmaxf(v1[e], 0.f) + log1pf(__expf(-fabsf(v1[e]))); }
                    *(f32x4*)p = v0; *(f32x4*)(p + 4) = v1; } }
    }
};

__device__ __forceinline__ void ph_conv(const Args& a, const Ctx& c) {
    LAS unsigned char* tin = c.lds; LAS unsigned char* toT = c.lds + 17408; LAS unsigned char* toN = c.lds + 34816;
    const bf16* xbc = (const bf16*)(a.ws + WS_XBC);
    u32x4 pin[3];
#define CONV_PREFETCH(tk) do { const int ci_ = (tk) / 48, chb_ = (tk) % 48, r0_ = ci_ * 128, ch0_ = chb_ * 64; \
        _Pragma("unroll") for (int q = 0; q < 3; ++q) { int p = c.tid + 512 * q; p = p < 131 * 8 ? p : 131 * 8 - 1; const int lr = p >> 3, pc = p & 7; int row = r0_ - 2 + lr; row = row < 0 ? 0 : (row > TT - 1 ? TT - 1 : row); \
            pin[q] = *(const u32x4*)(xbc + (size_t)row * 3072 + ch0_ + pc * 8); } } while (0)
    { const int t0 = (int)blockIdx.x < NCH * 48 ? (int)blockIdx.x : NCH * 48 - 1; CONV_PREFETCH(t0); }
    for (int task = blockIdx.x; task < NCH * 48; task += c.G) {
        const int ci = task / 48, chb = task % 48, r0 = ci * 128, ch0 = chb * 64;
        const bool first = ci < 128 ? (ci % 32 == 0) : (((ci - 128) & 1) == 0), last = ci < 128 ? (ci % 32 == 31) : (((ci - 128) & 1) == 1);
        const int ch = c.tid & 63, tq = c.tid >> 6; const float* cw = a.in[I_CONVW] + ch0 + ch;
        const float w0 = cw[0], w1 = cw[3072], w2 = cw[2 * 3072], w3 = cw[3 * 3072], bias = a.in[I_CONVB][ch0 + ch];
#pragma unroll
        for (int q = 0; q < 3; ++q) { const int p = c.tid + 512 * q, lr = p >> 3; const bool zero = (lr < 2 && first) || (lr == 130 && last);
            if (p < 131 * 8) *(LAS u32x4*)(tin + lr * 128 + (p & 7) * 16) = zero ? (u32x4){0u, 0u, 0u, 0u} : pin[q]; }
        __syncthreads();
        { const int tn = task + c.G < NCH * 48 ? task + c.G : NCH * 48 - 1; CONV_PREFETCH(tn); }
        {
          float xin[19];
#pragma unroll
          for (int i = 0; i < 19; ++i) xin[i] = bf2f(*(const LAS bf16*)(tin + (16 * tq + i) * 128 + ch * 2));
          float o[16];
#pragma unroll
          for (int i = 0; i < 16; ++i) o[i] = silu_f(bias + w0 * xin[i] + w1 * xin[i + 1] + w2 * xin[i + 2] + w3 * xin[i + 3]);
          if (chb < 40) { *(LAS u32x4*)(toT + ch * 272 + tq * 32) = (u32x4){cvtpk(o[0], o[1]), cvtpk(o[2], o[3]), cvtpk(o[4], o[5]), cvtpk(o[6], o[7])};
                          *(LAS u32x4*)(toT + ch * 272 + tq * 32 + 16) = (u32x4){cvtpk(o[8], o[9]), cvtpk(o[10], o[11]), cvtpk(o[12], o[13]), cvtpk(o[14], o[15])}; }
          if (chb >= 32) {
#pragma unroll
              for (int i = 0; i < 16; ++i) *(LAS bf16*)(toN + (16 * tq + i) * 144 + ch * 2) = (bf16)(cvtpk(o[i], 0.f) & 0xffffu); } }
        __syncthreads();
        if (chb < 40) { bf16* dst = chb < 32 ? (bf16*)(a.ws + WS_XT) + ((size_t)ci * 2048 + ch0) * 128 : (bf16*)(a.ws + WS_BT) + ((size_t)ci * 512 + (ch0 - 2048)) * 128;
#pragma unroll
            for (int q = 0; q < 2; ++q) { const int p = c.tid + 512 * q, chl = p >> 4, pc = p & 15; *(u32x4*)(dst + chl * 128 + pc * 8) = *(const LAS u32x4*)(toT + chl * 272 + pc * 16); } }
        if (chb >= 32) { bf16* dst = chb < 40 ? (bf16*)(a.ws + WS_BN) + (size_t)r0 * 512 + (ch0 - 2048) : (bf16*)(a.ws + WS_CN) + (size_t)r0 * 512 + (ch0 - 2560);
#pragma unroll
            for (int q = 0; q < 2; ++q) { const int p = c.tid + 512 * q, t = p >> 3, pc = p & 7; *(u32x4*)(dst + (size_t)t * 512 + pc * 8) = *(const LAS u32x4*)(toN + t * 144 + pc * 16); } }
        __syncthreads();
    }
#undef CONV_PREFETCH
    const int gw = c.vcu * NWAVES + c.wave, NGW = c.G * NWAVES;
    const float* dt = (const float*)(a.ws + WS_DT);
    for (int item = gw; item < NCH * 32; item += NGW) { const int ci = item >> 5, h = item & 31, r0 = ci * 128 + 2 * c.lane;
        const float af = -expf(a.in[I_ALOG][h]), ab = -expf(a.in[I_ALOG][32 + h]);
        const float dtf0 = dt[(size_t)r0 * 64 + h], dtf1 = dt[(size_t)(r0 + 1) * 64 + h], dtb0 = dt[(size_t)r0 * 64 + 32 + h], dtb1 = dt[(size_t)(r0 + 1) * 64 + 32 + h];
        const float laf0 = dtf0 * af, laf1 = dtf1 * af, lab0 = dtb0 * ab, lab1 = dtb1 * ab;
        float inf_ = laf0 + laf1, inb = lab0 + lab1; const float pf = inf_, pbk = inb;
#pragma unroll
        for (int o = 1; o < 64; o <<= 1) { const float t1 = __shfl_up(inf_, o), t2 = __shfl_up(inb, o); if (c.lane >= o) { inf_ += t1; inb += t2; } }
        const float totf = __shfl(inf_, 63), totb = __shfl(inb, 63);
        const float exf = inf_ - pf, exb = inb - pbk;
        const float cf0 = exf + laf0, cf1 = inf_, pb0 = exb, pb1 = exb + lab0;
        f32x4* sca = (f32x4*)(a.ws + WS_SCA) + (size_t)r0 * 32 + h; f32x4* scb = (f32x4*)(a.ws + WS_SCB) + (size_t)r0 * 32 + h;
        { const float L2E = 1.4426950408889634f;
          sca[0] = (f32x4){cf0 * L2E, pb0 * L2E, cf0 * L2E - __log2f(dtf0), pb0 * L2E + __log2f(dtb0)}; sca[32] = (f32x4){cf1 * L2E, pb1 * L2E, cf1 * L2E - __log2f(dtf1), pb1 * L2E + __log2f(dtb1)}; }
        scb[0] = (f32x4){__expf(cf0), __expf(totb - pb0), dtf0 * __expf(totf - cf0), dtb0 * __expf(pb0)};
        scb[32] = (f32x4){__expf(cf1), __expf(totb - pb1), dtf1 * __expf(totf - cf1), dtb1 * __expf(pb1)};
        { float* wsc = (float*)(a.ws + WS_Q) + ((size_t)(ci * 32 + h) * 2) * 128 + 2 * c.lane;
          *(f32x2*)wsc = (f32x2){dtf0 * __expf(totf - cf0), dtf1 * __expf(totf - cf1)}; *(f32x2*)(wsc + 128) = (f32x2){dtb0 * __expf(pb0), dtb1 * __expf(pb1)}; }
        if (c.lane == 0) ((f32x2*)(a.ws + WS_DEC))[ci * 32 + h] = (f32x2){__expf(totf), __expf(totb)}; }
}

__device__ __forceinline__ void ph_scan(const Args& a, const Ctx& c) {
    constexpr int P = 272, BUF = 53248;
    LAS unsigned char* stg = c.lds + 2 * BUF + c.wave * 2048;
    const int r32 = c.lane & 31, hi = c.lane >> 5, pt = c.wave >> 2, nt = c.wave & 3;
    for (int task = c.vcu; task < 256; task += c.G) { const int b = task >> 6, dir = (task >> 5) & 1, h = task & 31, g = h >> 3;
        f32x16 acc = {};
        u32x4 xrA[2], brA[4], xrB[2], brB[4]; f32x4 wA0 = {}, wA1 = {}, wB0 = {}, wB1 = {}; f32x2 decA = {}, decB = {};
#define SCAN_CI(k) (dir == 0 ? ((k) < 2 ? 128 + 2 * b + (k) : 32 * b + ((k) - 2)) : ((k) < 2 ? 128 + 2 * b + 1 - (k) : 32 * b + 31 - ((k) - 2)))
#define SCAN_LOAD(k, xr, br, w0, w1, dcr) do { const int ci_ = SCAN_CI(k); const bf16* xs_ = (const bf16*)(a.ws + WS_XT) + ((size_t)ci_ * 2048 + 64 * h) * 128; const bf16* bs_ = (const bf16*)(a.ws + WS_BT) + ((size_t)ci_ * 512 + 128 * g) * 128; \
        _Pragma("unroll") for (int q = 0; q < 2; ++q) xr[q] = ((const u32x4*)xs_)[c.tid + 512 * q]; _Pragma("unroll") for (int q = 0; q < 4; ++q) br[q] = ((const u32x4*)bs_)[c.tid + 512 * q]; \
        { const f32x4* wp_ = (const f32x4*)((const float*)(a.ws + WS_Q) + ((size_t)(ci_ * 32 + h) * 2 + dir) * 128) + 2 * (c.tid & 15); w0 = wp_[0]; w1 = wp_[1]; }        \
        dcr = ((const f32x2*)(a.ws + WS_DEC))[ci_ * 32 + h]; } while (0)
#define SCAN_WRITE(bi, xr, br, w0, w1) do { LAS unsigned char* xb_ = c.lds + (bi) * BUF; LAS unsigned char* bb_ = xb_ + 17408;        \
        _Pragma("unroll") for (int q = 0; q < 2; ++q) { const int p = c.tid + 512 * q; const u32x4 v_ = xr[q]; \
            *(LAS u32x4*)(xb_ + (p >> 4) * P + (p & 15) * 16) = (u32x4){cvtpk(bflo(v_.x) * w0.x, bfhi(v_.x) * w0.y), cvtpk(bflo(v_.y) * w0.z, bfhi(v_.y) * w0.w), cvtpk(bflo(v_.z) * w1.x, bfhi(v_.z) * w1.y), cvtpk(bflo(v_.w) * w1.z, bfhi(v_.w) * w1.w)}; } \
        _Pragma("unroll") for (int q = 0; q < 4; ++q) { const int p = c.tid + 512 * q; *(LAS u32x4*)(bb_ + (p >> 4) * P + (p & 15) * 16) = br[q]; } } while (0)
#define SCAN_STEP(k, cur, dcr) do { const int ci = SCAN_CI(k); \
            { bf16* hin = (bf16*)(a.ws + WS_HIN) + (((size_t)ci * 2 + dir) * 32 + h) * 8192; \
              _Pragma("unroll") for (int r = 0; r < 16; ++r) *(LAS bf16*)(stg + ((r & 3) + 8 * (r >> 2) + 4 * hi) * 64 + r32 * 2) = (bf16)(cvtpk(acc[r], 0.f) & 0xffffu); \
              LDS_WAIT(); \
              _Pragma("unroll") for (int i = 0; i < 2; ++i) { const int row = (c.lane >> 2) + 16 * i, pc = c.lane & 3; *(u32x4*)(hin + (size_t)(32 * pt + row) * 128 + 32 * nt + pc * 8) = *(const LAS u32x4*)(stg + row * 64 + pc * 16); } } \
            const float dec = dir == 0 ? dcr.x : dcr.y; \
            _Pragma("unroll") for (int r = 0; r < 16; ++r) acc[r] *= dec; \
            { LAS unsigned char* xb = c.lds + (cur) * BUF; LAS unsigned char* bb = xb + 17408; \
              _Pragma("unroll") for (int kk = 0; kk < 8; ++kk) { const int s8 = 16 * kk + 8 * hi; \
                  const bf16x8 xs = *(const LAS bf16x8*)(xb + (32 * pt + r32) * P + s8 * 2), bfrag = *(const LAS bf16x8*)(bb + (32 * nt + r32) * P + s8 * 2); \
                  acc = __builtin_amdgcn_mfma_f32_32x32x16_bf16(xs, bfrag, acc, 0, 0, 0); } } } while (0)
        f32x2 dcur0, dcur1;
        SCAN_LOAD(0, xrA, brA, wA0, wA1, decA); SCAN_LOAD(1, xrB, brB, wB0, wB1, decB); SCAN_WRITE(0, xrA, brA, wA0, wA1); dcur0 = decA;
        __syncthreads();
        for (int k = 0; k < 34; k += 2) {
            { const int kn = k + 2 < 34 ? k + 2 : 33; SCAN_LOAD(kn, xrA, brA, wA0, wA1, decA); }
            SCAN_STEP(k, 0, dcur0);
            SCAN_WRITE(1, xrB, brB, wB0, wB1); dcur1 = decB;
            __syncthreads();
            { const int kn = k + 3 < 34 ? k + 3 : 33; SCAN_LOAD(kn, xrB, brB, wB0, wB1, decB); }
            SCAN_STEP(k + 1, 1, dcur1);
            SCAN_WRITE(0, xrA, brA, wA0, wA1); dcur0 = decA;
            __syncthreads();
        }
#undef SCAN_CI
#undef SCAN_LOAD
#undef SCAN_WRITE
#undef SCAN_STEP
    }
}

__device__ __forceinline__ int crow16(int r, int hi) { return (r & 3) + 8 * (r >> 2) + 4 * hi; }
__device__ __forceinline__ void ph_yph(const Args& a, const Ctx& c, unsigned* rdg) {
    constexpr int P = 272, ZP = 144;
    LAS unsigned char* Cs = c.lds; LAS unsigned char* Bs = c.lds + 34816; LAS unsigned char* xs = c.lds + 69632; LAS unsigned char* hf = c.lds + 87040; LAS unsigned char* hb = c.lds + 104448;
    LAS unsigned char* zs = c.lds + 121856; LAS unsigned char* os = c.lds + 140288; LAS f32x4* sca = (LAS f32x4*)(c.lds + 158720); LAS f32x2* scb = (LAS f32x2*)(c.lds + 160768);
    LAS float* sbv = (LAS float*)(c.lds + 161792); LAS float* scv = (LAS float*)(c.lds + 162304); LAS float* ssql = (LAS float*)(c.lds + 34816);
    const int lb = c.wave & 3, pb = c.wave >> 2;
    SECT_DECL
    for (int task = c.vcu; task < NCH * 4; task += c.G) { const int ci = task >> 2, g = task & 3, r0 = ci * 128;
        int tid_t = c.tid; asm volatile("" : "+v"(tid_t));
        f32x16 X[4]; int l0;
        u32x4 pxt[2], phf[2], phb[2], pz[2]; f32x4 ps1 = {}; f32x4 ps4 = {};
#define YPH_PREFETCH(hq) do { const int h_ = 8 * g + (hq); const u32x4* xt_ = (const u32x4*)((const bf16*)(a.ws + WS_XT) + ((size_t)ci * 2048 + 64 * h_) * 128); \
            const u32x4* hfg_ = (const u32x4*)((const bf16*)(a.ws + WS_HIN) + (((size_t)ci * 2 + 0) * 32 + h_) * 8192); const u32x4* hbg_ = (const u32x4*)((const bf16*)(a.ws + WS_HIN) + (((size_t)ci * 2 + 1) * 32 + h_) * 8192); \
            const bf16* zg_ = (const bf16*)(a.ws + WS_Z) + (size_t)r0 * 2048 + 64 * h_; \
            _Pragma("unroll") for (int q = 0; q < 2; ++q) { const int p = tidp + 512 * q; pxt[q] = xt_[p]; phf[q] = hfg_[p]; phb[q] = hbg_[p]; pz[q] = *(const u32x4*)(zg_ + (size_t)(p >> 3) * 2048 + (p & 7) * 8); } \
            ps1 = ((const f32x4*)(a.ws + WS_SCA))[((size_t)r0 + (tidp & 127)) * 32 + h_]; ps4 = ((const f32x4*)(a.ws + WS_SCB))[((size_t)r0 + (tidp & 127)) * 32 + h_]; } while (0)
        { const int tid = tid_t, lane = tid & 63, r32 = lane & 31, hi = lane >> 5; l0 = 32 * lb + r32;
          { const bf16* cn = (const bf16*)(a.ws + WS_CN) + (size_t)r0 * 512 + 128 * g; const bf16* bn = (const bf16*)(a.ws + WS_BN) + (size_t)r0 * 512 + 128 * g;
#pragma unroll
            for (int q = 0; q < 4; ++q) { const int p = tid + 512 * q, row = p >> 4, pc = p & 15;
                *(LAS u32x4*)(Cs + row * P + pc * 16) = *(const u32x4*)(cn + (size_t)row * 512 + pc * 8); *(LAS u32x4*)(Bs + row * P + pc * 16) = *(const u32x4*)(bn + (size_t)row * 512 + pc * 8); } }
          { const int tidp = tid; YPH_PREFETCH(0); }
          __syncthreads();
#pragma unroll
          for (int sb = 0; sb < 4; ++sb) { X[sb] = (f32x16){};
#pragma unroll
              for (int kk = 0; kk < 8; ++kk) { const int k8 = (16 * kk + 8 * hi) * 2;
                  X[sb] = __builtin_amdgcn_mfma_f32_32x32x16_bf16(*(const LAS bf16x8*)(Bs + (32 * sb + r32) * P + k8), *(const LAS bf16x8*)(Cs + (32 * lb + r32) * P + k8), X[sb], 0, 0, 0); } }
        }
        SECT(0);
        float ssq = 0.f;
#pragma unroll 1
        for (int hh = 0; hh < 8; ++hh) { const int h = 8 * g + hh;
            int tid = c.tid; asm volatile("" : "+v"(tid)); const int lane = tid & 63, r32 = lane & 31, hi = lane >> 5, l = 32 * lb + r32; (void)lane;
            const float dsum = a.in[I_DSK][h] + a.in[I_DSK][32 + h];
            __syncthreads();
            SECT(1);
            if (hh > 0) { bf16* gg = (bf16*)(a.ws + WS_G) + (size_t)r0 * 2048 + 64 * (h - 1);
#pragma unroll
                for (int q = 0; q < 2; ++q) { const int p = tid + 512 * q, zr = p >> 3, zc = p & 7; *(u32x4*)(gg + (size_t)zr * 2048 + zc * 8) = *(const LAS u32x4*)(os + zr * ZP + zc * 16); } }
#pragma unroll
            for (int q = 0; q < 2; ++q) { const int p = tid + 512 * q, row = p >> 4, pc = p & 15;
                *(LAS u32x4*)(xs + row * P + pc * 16) = pxt[q]; *(LAS u32x4*)(hf + row * P + pc * 16) = phf[q]; *(LAS u32x4*)(hb + row * P + pc * 16) = phb[q];
                *(LAS u32x4*)(zs + (p >> 3) * ZP + (p & 7) * 16) = pz[q]; }
            if (tid < 128) { sca[tid] = ps1; scb[tid] = (f32x2){ps4.x, ps4.y}; sbv[tid] = ps1.z; scv[tid] = ps1.w; }
            __syncthreads();
            SECT(2);
            if (hh < 7) { const int tidp = tid; YPH_PREFETCH(hh + 1); }
            SECT(3);
            const f32x4 me = sca[l]; const f32x2 ee = scb[l];
            const float dtb_l = __builtin_amdgcn_exp2f(me.w - me.y);
            f32x16 accd = {};
#pragma unroll
            for (int sb = 0; sb < 4; ++sb) { unsigned mp[8];
#pragma unroll
                for (int q = 0; q < 4; ++q) { const int s0 = 32 * sb + 8 * q + 4 * hi; float mv[4];
                    if (sb < lb) { const f32x4 bs4 = *(const LAS f32x4*)(sbv + s0);
#pragma unroll
                        for (int e = 0; e < 4; ++e) mv[e] = X[sb][4 * q + e] * __builtin_amdgcn_exp2f(me.x - bs4[e]); }
                    else if (sb > lb) { const f32x4 cs4 = *(const LAS f32x4*)(scv + s0);
#pragma unroll
                        for (int e = 0; e < 4; ++e) mv[e] = X[sb][4 * q + e] * __builtin_amdgcn_exp2f(cs4[e] - me.y); }
                    else { const f32x4 bs4 = *(const LAS f32x4*)(sbv + s0), cs4 = *(const LAS f32x4*)(scv + s0);
#pragma unroll
                        for (int e = 0; e < 4; ++e) { const int s = s0 + e; const float t = (s <= l) ? (me.x - bs4[e]) : (cs4[e] - me.y); const float xv = X[sb][4 * q + e];
                            float m = xv * __builtin_amdgcn_exp2f(t); if (s == l) m += xv * dtb_l + dsum; mv[e] = m; } }
                    mp[2 * q] = cvtpk(mv[0], mv[1]); mp[2 * q + 1] = cvtpk(mv[2], mv[3]); }
#pragma unroll
                for (int t = 0; t < 2; ++t) { const int sof = (32 * sb + 16 * t + 4 * hi) * 2;
                    const u32x2 lo = *(const LAS u32x2*)(xs + (32 * pb + r32) * P + sof), h2 = *(const LAS u32x2*)(xs + (32 * pb + r32) * P + sof + 16);
                    const u32x4 af = (u32x4){lo.x, lo.y, h2.x, h2.y}, bfm = (u32x4){mp[4 * t], mp[4 * t + 1], mp[4 * t + 2], mp[4 * t + 3]};
                    accd = __builtin_amdgcn_mfma_f32_32x32x16_bf16(__builtin_bit_cast(bf16x8, af), __builtin_bit_cast(bf16x8, bfm), accd, 0, 0, 0); }
                }
            SECT(4);
#pragma unroll
            for (int dd = 0; dd < 2; ++dd) { f32x16 acco = {}; LAS unsigned char* hx = dd == 0 ? hf : hb;
#pragma unroll
                for (int kk = 0; kk < 8; ++kk) { const int k8 = (16 * kk + 8 * hi) * 2;
                    acco = __builtin_amdgcn_mfma_f32_32x32x16_bf16(*(const LAS bf16x8*)(hx + (32 * pb + r32) * P + k8), *(const LAS bf16x8*)(Cs + (32 * lb + r32) * P + k8), acco, 0, 0, 0); }
                const float ex = dd == 0 ? ee.x : ee.y;
#pragma unroll
                for (int r = 0; r < 16; ++r) accd[r] += ex * acco[r]; }
            SECT(5);
#pragma unroll
            for (int q = 0; q < 4; ++q) { const int pcol = 32 * pb + 8 * q + 4 * hi; const u32x2 zq = *(const LAS u32x2*)(zs + l * ZP + pcol * 2);
                float gv[4];
#pragma unroll
                for (int e = 0; e < 4; ++e) { const int r = 4 * q + e; const float y = accd[r];
                    const float z = (e == 0) ? bflo(zq.x) : (e == 1) ? bfhi(zq.x) : (e == 2) ? bflo(zq.y) : bfhi(zq.y); gv[e] = y * silu_f(z); ssq += gv[e] * gv[e]; }
                *(LAS u32x2*)(os + l * ZP + pcol * 2) = (u32x2){cvtpk(gv[0], gv[1]), cvtpk(gv[2], gv[3])}; }
            SECT(6);
        }
#undef YPH_PREFETCH
        __syncthreads();
        { bf16* gg = (bf16*)(a.ws + WS_G) + (size_t)r0 * 2048 + 64 * (8 * g + 7);
#pragma unroll
          for (int q = 0; q < 2; ++q) { const int p = c.tid + 512 * q, zr = p >> 3, zc = p & 7; *(u32x4*)(gg + (size_t)zr * 2048 + zc * 8) = *(const LAS u32x4*)(os + zr * ZP + zc * 16); } }
        ssq += __shfl_xor(ssq, 32);
        if ((c.lane >> 5) == 0) ssql[pb * 128 + l0] = ssq;
        __syncthreads();
        if (c.tid < 128) ssql[256 + c.tid] = rsqrtf((ssql[c.tid] + ssql[128 + c.tid]) * (1.0f / 512.0f) + EPS);
        VM_WAIT();
        __syncthreads();
        { bf16* gt = (bf16*)(a.ws + WS_G) + (size_t)r0 * 2048 + 512 * g; const float* ng = a.in[I_SNORM] + 512 * g;
          const __amdgpu_buffer_rsrc_t grs = __builtin_amdgcn_make_buffer_rsrc((void*)(a.ws + WS_G), 0, TT * 2048 * 2, 0x00020000);
          const f32x4 g0 = *(const f32x4*)(ng + (c.tid & 63) * 8), g1 = *(const f32x4*)(ng + (c.tid & 63) * 8 + 4);
#pragma unroll 1
          for (int qb = 0; qb < 2; ++qb) { u32x4 gv8[8]; int tidq = c.tid + 4096 * qb; asm volatile("" : "+v"(tidq));
#pragma unroll
            for (int q = 0; q < 8; ++q) { const int p = tidq + 512 * q; gv8[q] = *(const u32x4*)(gt + (size_t)(p >> 6) * 2048 + (p & 63) * 8); }
#pragma unroll
            for (int q = 0; q < 8; ++q) { const int p = tidq + 512 * q, row = p >> 6, col = (p & 63) * 8; const u32x4 v = gv8[q]; const float sr = ssql[256 + row];
              __builtin_amdgcn_raw_buffer_store_b128((u32x4){cvtpk(bflo(v.x) * sr * g0.x, bfhi(v.x) * sr * g0.y), cvtpk(bflo(v.y) * sr * g0.z, bfhi(v.y) * sr * g0.w), cvtpk(bflo(v.z) * sr * g1.x, bfhi(v.z) * sr * g1.y), cvtpk(bflo(v.w) * sr * g1.z, bfhi(v.w) * sr * g1.w)},
                  grs, ((r0 + row) * 2048 + 512 * g + col) * 2, 0, 16  ); } } }
        VM_WAIT();
        __syncthreads();
        if (c.tid == 0) __hip_atomic_fetch_add(rdg + (ci >> 1), 1u, __ATOMIC_RELAXED, __HIP_MEMORY_SCOPE_AGENT);
        SECT(7);
    }
    SECT_END(40);
}
__device__ __forceinline__ void ph_gfix(const Args& a, const Ctx& c) {
    const float* ng = a.in[I_SNORM]; const float* rs = (const float*)(a.ws + WS_RSTD);
    const int n16 = TT * 256;
    for (int p = blockIdx.x * NTHREADS + c.tid; p < n16; p += c.G * NTHREADS) { const int r = p >> 8, col = (p & 255) * 8;
        u32x4* gp = (u32x4*)((bf16*)(a.ws + WS_G) + (size_t)r * 2048 + col); const u32x4 v = *gp; const float s = rs[r * 4 + (col >> 9)];
        const f32x4 g0 = *(const f32x4*)(ng + col), g1 = *(const f32x4*)(ng + col + 4);
        *gp = (u32x4){cvtpk(bflo(v.x) * s * g0.x, bfhi(v.x) * s * g0.y), cvtpk(bflo(v.y) * s * g0.z, bfhi(v.y) * s * g0.w), cvtpk(bflo(v.z) * s * g1.x, bfhi(v.z) * s * g1.y), cvtpk(bflo(v.w) * s * g1.z, bfhi(v.w) * s * g1.w)}; }
}

#if DEBUG_CHECKS
__device__ __forceinline__ float dbg_hb(const Args& a, int layer, size_t idx, float sh) {
    if (ATT_FP8 && layer != 2) return __builtin_amdgcn_cvt_f32_fp8((unsigned)((const unsigned char*)(a.ws + WS_HB))[idx], 0) * sh;
    return bf2f(((const bf16*)(a.ws + WS_HB))[idx]); }
__device__ __forceinline__ int dbg_sample_row(int b) { const int SR[16] = {0, 1, 77, 4095, 4096, 5000, 8191, 9000, 12288, 16383, 16384, 16385, 16384 + 255, 16384 + 256, 17000, 17407}; int r = 0;
#pragma unroll
    for (int i = 0; i < 16; ++i) r = (b == i) ? SR[i] : r;
    return r; }
__device__ __forceinline__ float blk_sum(float v, LAS float* red, int tid) {
    v = wave_sum(v); __syncthreads(); if ((tid & 63) == 0) red[tid >> 6] = v; __syncthreads(); float s = 0.f;
#pragma unroll
    for (int i = 0; i < 8; ++i) s += red[i];
    __syncthreads(); return s; }
__device__ __forceinline__ float blk_max(float v, LAS float* red, int tid) {
#pragma unroll
    for (int o = 1; o < 64; o <<= 1) v = fmaxf(v, __shfl_xor(v, o));
    __syncthreads(); if ((tid & 63) == 0) red[tid >> 6] = v; __syncthreads(); float s = red[0];
#pragma unroll
    for (int i = 1; i < 8; ++i) s = fmaxf(s, red[i]);
    __syncthreads(); return s; }
__device__ __forceinline__ void dbg_report(const Args& a, int id, float err, float ssref, float n, int tid) {
    if (tid == 0) { float rel = err / (sqrtf(ssref / n) + 1e-20f); if (!(rel == rel)) rel = 1e30f; atomicMax((unsigned*)(a.ws + WS_CTL) + CW_DBG + id, __float_as_uint(rel)); } }
__device__ __forceinline__ float dbg_mod(const Args& a, int layer, int r, int j) {
    const float* cv = r < TL ? a.in[I_C] + (r / SEQ) * 1024 : a.in[I_CCTX]; float s = 0.f;
    _Pragma("nounroll") for (int k = 0; k < 1024; ++k) { const float x = cv[k]; s += (x / (1.0f + expf(-x))) * a.in[I_WADA][((size_t)layer * 1024 + k) * 6144 + j]; }
    return s + a.in[I_BADA][layer * 6144 + j]; }

__device__ __forceinline__ void chk_rmix(const Args& a, int layer, int id, LAS unsigned char* ldsb) {
    if (blockIdx.x >= 16) return; const int tid = tid_opaque(), r = dbg_sample_row(blockIdx.x);
    LAS float* red = (LAS float*)ldsb;
    const float* x = resid_row(a, layer, r); const bf16* hb = (const bf16*)(a.ws + WS_HB) + (size_t)r * D;
    float ss = 0.f; for (int cc = tid; cc < D; cc += 512) ss += x[cc] * x[cc];
    ss = blk_sum(ss, red, tid); const float rstd = rsqrtf(ss / D + EPS);
    float err = 0.f, sr = 0.f;
    for (int cc = tid; cc < D; cc += 512) { const float sh = dbg_mod(a, layer, r, cc), sc = dbg_mod(a, layer, r, D + cc);
        const float ref = x[cc] * rstd * a.in[I_NMIX][layer * D + cc] * (1.f + sc) + sh; err = fmaxf(err, fabsf(ref - dbg_hb(a, layer, (size_t)r * D + cc, 1.f))); sr += ref * ref; }
    err = blk_max(err, red, tid); sr = blk_sum(sr, red, tid); dbg_report(a, id, err, sr, D, tid);
}
__device__ __forceinline__ void chk_qkv(const Args& a, int layer, int id, LAS unsigned char* ldsb) {
    if (blockIdx.x >= 16) return; const int tid = tid_opaque(), r = dbg_sample_row(blockIdx.x), j = layer ? 1 : 0;
    LAS float* red = (LAS float*)ldsb; LAS float* y = red + 16; LAS float* hrow = y + 1536;
    const bf16* hb = (const bf16*)(a.ws + WS_HB) + (size_t)r * D;
    _Pragma("nounroll") for (int k = tid; k < D; k += 512) hrow[k] = dbg_hb(a, layer, (size_t)r * D + k, 1.f);
    __syncthreads();
    for (int n = tid; n < 1536; n += 512) { float s = 0.f; const float* w = a.in[I_WQKV] + (size_t)j * 1024 * 1536 + n; _Pragma("nounroll") for (int k = 0; k < 1024; ++k) s += hrow[k] * w[(size_t)k * 1536]; y[n] = s; }
    __syncthreads();
    float err = 0.f, sr = 0.f;
    for (int n = tid; n < 1536; n += 512) { float ref;
        if (n < 1280) { const int h0 = n & ~63; float ss = 0.f; _Pragma("nounroll") for (int q = 0; q < 64; ++q) ss += y[h0 + q] * y[h0 + q];
            const float rstd = rsqrtf(ss / 64.f + EPS); const float* g = (n < 1024 ? a.in[I_QG] : a.in[I_KG]) + j * 64;
            float v = y[n] * rstd * g[n & 63], vp = y[n ^ 1] * rstd * g[(n ^ 1) & 63];
            if (r < TL) { const int t = r % SEQ, i = (n & 63) >> 1, f = i & 15, pos = i < 16 ? t / 64 : t % 64; const float inv = powf(10000.f, -(float)f / 16.f), ang = (float)pos * inv, cs = cosf(ang), sn = sinf(ang);
                v = (n & 1) ? (vp * sn + v * cs) : (v * cs - vp * sn); }
            if (n < 1024) v *= 0.125f * 1.4426950408889634f;
            ref = v; } else ref = y[n];
        float got;
        if (n < 1024) { if (layer == 3 && r >= TL) continue; got = bf2f(((const bf16*)(a.ws + WS_Q))[(size_t)r * 1024 + n]); }
        else if (n < 1280) got = bf2f(((const bf16*)(a.ws + WS_K))[kv_row(r) * 256 + (n - 1024)]);
        else got = bf2f(((const bf16*)(a.ws + WS_V))[kv_row(r) * 256 + (n - 1280)]);
        err = fmaxf(err, fabsf(ref - got)); sr += ref * ref; }
    err = blk_max(err, red, tid); sr = blk_sum(sr, red, tid); dbg_report(a, id, err, sr, 1536, tid);
}
__device__ __forceinline__ void chk_att(const Args& a, int layer, int id, LAS unsigned char* ldsb) {
    if (blockIdx.x >= 16) return; const int tid = tid_opaque(), r = dbg_sample_row(blockIdx.x);
    if (layer == 3 && r >= TL) return;
    LAS float* red = (LAS float*)ldsb; LAS float* sc = red + 16; LAS float* po = sc + 4352;
    const int nk = r < TL ? KVROWS : CTXL; const long kv0 = (long)(r < TL ? r / SEQ : (r - TL) / CTXL) * KVROWS;
    const bf16* Qb = (const bf16*)(a.ws + WS_Q); const bf16* Kb = (const bf16*)(a.ws + WS_K); const bf16* Vb = (const bf16*)(a.ws + WS_V); const bf16* Ob = (const bf16*)(a.ws + WS_HB);
    float err = 0.f, sr = 0.f;
    for (int h = 0; h < 16; ++h) {
        float mx = -3e38f;
        _Pragma("nounroll") for (int jk = tid; jk < nk; jk += 512) { float s = 0.f; _Pragma("nounroll") for (int d = 0; d < 64; ++d) s += bf2f(Qb[(size_t)r * 1024 + h * 64 + d]) * bf2f(Kb[(kv0 + jk) * 256 + (h >> 2) * 64 + d]); sc[jk] = s; mx = fmaxf(mx, s); }
        mx = blk_max(mx, red, tid);
        float l = 0.f; _Pragma("nounroll") for (int jk = tid; jk < nk; jk += 512) { const float p = exp2f(sc[jk] - mx); sc[jk] = p; l += p; }
        l = blk_sum(l, red, tid);
        { const int d = tid & 63, part = tid >> 6; float o = 0.f; _Pragma("nounroll") for (int jk = part; jk < nk; jk += 8) o += sc[jk] * bf2f(Vb[(kv0 + jk) * 256 + (h >> 2) * 64 + d]); po[part * 64 + d] = o; }
        __syncthreads();
        if (tid < 64) { float o = 0.f; _Pragma("nounroll") for (int p = 0; p < 8; ++p) o += po[p * 64 + tid]; o /= l; err = fmaxf(err, fabsf(o - dbg_hb(a, layer, (size_t)r * 1024 + h * 64 + tid, 1.f / (float)(1 << ATT_OSH)))); sr += o * o; }
        __syncthreads();
    }
    err = blk_max(err, red, tid); sr = blk_sum(sr, red, tid); dbg_report(a, id, err, sr, 1024, tid);
}
__device__ __forceinline__ void chk_oproj(const Args& a, int layer, int id, LAS unsigned char* ldsb) {
    if (blockIdx.x >= 16 || layer != 0) return; const int tid = tid_opaque(), r = dbg_sample_row(blockIdx.x), j = 0;
    LAS float* red = (LAS float*)ldsb; LAS float* orow = red + 16;
    const bf16* Ob = (const bf16*)(a.ws + WS_HB) + (size_t)r * D;
    _Pragma("nounroll") for (int k = tid; k < D; k += 512) orow[k] = dbg_hb(a, layer, (size_t)r * D + k, 1.f / (float)(1 << ATT_OSH));
    __syncthreads();
    float err = 0.f, sr = 0.f;
    for (int n = tid; n < D; n += 512) { float s = 0.f; const float* w = a.in[I_WO] + (size_t)j * 1024 * 1024 + n; _Pragma("nounroll") for (int k = 0; k < 1024; ++k) s += orow[k] * w[(size_t)k * 1024];
        const float dl = dbg_mod(a, layer, r, 2 * D + n) * s, ref = resid_row(a, 0, r)[n] + dl; err = fmaxf(err, fabsf(ref - ((const float*)(a.ws + WS_X))[(size_t)r * D + n])); sr += dl * dl; }
    err = blk_max(err, red, tid); sr = blk_sum(sr, red, tid); dbg_report(a, id, err, sr, D, tid);
}
__device__ __forceinline__ void chk_moe(const Args& a, int layer, int id_tok, int id_y, LAS unsigned char* ldsb) {
    if (blockIdx.x >= 16) return; const int tid = tid_opaque(), r = dbg_sample_row(blockIdx.x);
    if (layer == 3 && r >= TL) return;
    LAS float* red = (LAS float*)ldsb; LAS float* tok = red + 16; LAS float* lg = tok + 1024; LAS float* tkb = lg + 64; LAS float* act = tkb + 1024; LAS float* rt = act + 1024;
    const float* x = (const float*)(a.ws + WS_X) + (size_t)r * D; const bf16* tk = (const bf16*)(a.ws + WS_TK) + (size_t)r * D;
    float ss = 0.f; for (int cc = tid; cc < D; cc += 512) ss += x[cc] * x[cc];
    ss = blk_sum(ss, red, tid); const float rstd = rsqrtf(ss / D + EPS);
    float err = 0.f, sr = 0.f;
    for (int cc = tid; cc < D; cc += 512) { const float sh = dbg_mod(a, layer, r, 3 * D + cc), sc = dbg_mod(a, layer, r, 4 * D + cc);
        const float ref = x[cc] * rstd * a.in[I_NFFN][layer * D + cc] * (1.f + sc) + sh; tok[cc] = ref;
#if MOE_FP8
        tkb[cc] = __builtin_amdgcn_cvt_f32_fp8((unsigned)((const unsigned char*)(a.ws + WS_TK))[(size_t)r * D + cc], 0);
#else
        tkb[cc] = bf2f(tk[cc]);
#endif
        err = fmaxf(err, fabsf(ref - tkb[cc])); sr += ref * ref; }
    err = blk_max(err, red, tid); sr = blk_sum(sr, red, tid);
    if (tid < 36) { float s = 0.f; _Pragma("nounroll") for (int k = 0; k < 1024; ++k) s += tok[k] * (tid < 4 ? a.in[I_WRG][((size_t)layer * 1024 + k) * 4 + tid] : a.in[I_WRE][((size_t)layer * 1024 + k) * 32 + tid - 4]); lg[tid] = s; }
    __syncthreads();
    if (tid == 0) { int grp = 0; _Pragma("nounroll") for (int q = 1; q < 4; ++q) if (lg[q] > lg[grp]) grp = q; float den = 0.f; _Pragma("nounroll") for (int q = 0; q < 4; ++q) den += expf(lg[q] - lg[grp]);
        const LAS float* le = lg + 4 + grp * 8; int i0 = 0; _Pragma("nounroll") for (int q = 1; q < 8; ++q) if (le[q] > le[i0]) i0 = q; int i1 = -1; _Pragma("nounroll") for (int q = 0; q < 8; ++q) if (q != i0 && (i1 < 0 || le[q] > le[i1])) i1 = q;
        const float ex = expf(le[i1] - le[i0]), w0 = 1.f / den / (1.f + ex), w1 = 1.f / den * ex / (1.f + ex);
        rt[0] = (float)(grp * 8 + i0); rt[1] = (float)(grp * 8 + i1); rt[2] = w0; rt[3] = w1;
        const float* w2 = (const float*)(a.ws + WS_W2); float e2 = fmaxf(fabsf(w2[2 * r] - w0), fabsf(w2[2 * r + 1] - w1)) * 30.f;
        const int* list = (const int*)(a.ws + WS_LIST); const unsigned* gc = (const unsigned*)(a.ws + WS_CTL) + CW_CNT + layer * 32;
        _Pragma("nounroll") for (int k = 0; k < 2; ++k) { const int e = (int)rt[k]; bool found = false; const int n = (int)gc[e]; _Pragma("nounroll") for (int q = 0; q < n && q < MOE_CAP; ++q) if (list[e * MOE_CAP + q] == 2 * r + k) found = true; if (!found) e2 = 1e6f; }
        rt[4] = e2; }
    __syncthreads();
    err = fmaxf(err, rt[4] * sqrtf(sr / D));
    dbg_report(a, id_tok, err, sr, D, tid);
    float err2 = 0.f, sr2 = 0.f;
    _Pragma("nounroll") for (int k = 0; k < 2; ++k) { const int e = (int)rt[k]; const float wk = rt[2 + k];
        const float* wgu = a.in[I_WGU] + ((size_t)layer * 32 + e) * 1024 * 1024; const float* wdn = a.in[I_WDN] + ((size_t)layer * 32 + e) * 512 * 1024;
        { float sg = 0.f, su = 0.f; _Pragma("nounroll") for (int q = 0; q < 1024; ++q) { sg += tkb[q] * wgu[(size_t)q * 1024 + tid]; su += tkb[q] * wgu[(size_t)q * 1024 + 512 + tid]; } act[tid] = (sg / (1.f + expf(-sg))) * su; }
        __syncthreads();
        for (int n = tid; n < D; n += 512) { float s = 0.f; _Pragma("nounroll") for (int q = 0; q < 512; ++q) s += act[q] * wdn[(size_t)q * 1024 + n]; s *= wk;
            err2 = fmaxf(err2, fabsf(s - bf2f(((const bf16*)(a.ws + WS_Y2))[(size_t)(2 * r + k) * D + n]))); sr2 += s * s; }
        __syncthreads(); }
    err2 = blk_max(err2, red, tid); sr2 = blk_sum(sr2, red, tid); dbg_report(a, id_y, err2, sr2, 2 * D, tid);
}

__global__ void __launch_bounds__(NTHREADS) dbg_kernel(Args a, int ty, int layer, int id) {
    extern __shared__ __attribute__((aligned(16))) unsigned char lds_dbg[];
    LAS unsigned char* l = (LAS unsigned char*)lds_dbg;
    if (ty == 1) chk_rmix(a, layer, id, l); else if (ty == 2) chk_qkv(a, layer, id, l); else if (ty == 3) chk_att(a, layer, id, l);
    else if (ty == 4) chk_oproj(a, layer, id, l); else if (ty == 5) chk_moe(a, layer, id, id + 1, l);
}
#endif

template <int KIND, int LAYER> __device__ __forceinline__ void run_phase(const Args& a0, Ctx& c, unsigned char* lds_gen) {
    Args a = a0; { unsigned long long wsv = (unsigned long long)a0.ws; asm volatile("" : "+s"(wsv)); a.ws = (unsigned char*)(GAS unsigned char*)wsv; }
    { unsigned lb = (unsigned)(uintptr_t)(LAS unsigned char*)lds_gen; asm volatile("" : "+s"(lb)); c.lds = (LAS unsigned char*)(uintptr_t)lb; }
    c.tid = tid_opaque(); c.lane = c.tid & 63;
    unsigned char* const ws = a.ws; constexpr int layer = LAYER;
#define RELAUNDER() do { { unsigned long long wsv_ = (unsigned long long)a0.ws; asm volatile("" : "+s"(wsv_)); a.ws = (unsigned char*)(GAS unsigned char*)wsv_; } \
        { unsigned lb_ = (unsigned)(uintptr_t)(LAS unsigned char*)lds_gen; asm volatile("" : "+s"(lb_)); c.lds = (LAS unsigned char*)(uintptr_t)lb_; } c.tid = tid_opaque(); c.lane = c.tid & 63; } while (0)
    if constexpr (KIND == K_P0) p0_prologue(a, c);
    else if constexpr (KIND == K_RMIX) ph_rmix(a, c, layer);
    else if constexpr (KIND == K_QKV) { constexpr int j = layer ? 1 : 0;
#if ATT_FP8
        SchedQKV S{(const char*)(ws + WS_HB), (const char*)(ws + WS_WQKV) + (size_t)j * 1536 * 1024, (size_t)256 * 1024, layer == 0 ? 1 : 0, c.G, (int)blockIdx.x};
        EpiQKV E{(bf16*)(ws + WS_Q), (bf16*)(ws + WS_K), (bf16*)(ws + WS_V), a.in[I_QG] + j * 64, a.in[I_KG] + j * 64, (const f32x2*)(ws + WS_ROPE)};
        pg8::gemm_phase<EpiQKV, SchedQKV, false, true>(c.lds, 1024, 1024, S, E, 127 - MOE_WSH, 127); }
#else
        SchedQKV S{(const char*)(ws + WS_HB), (const char*)(ws + WS_WQKV) + (size_t)j * 1536 * 1024 * 2, (size_t)256 * 1024 * 2, layer == 0 ? 1 : 0, c.G, (int)blockIdx.x};
        EpiQKV E{(bf16*)(ws + WS_Q), (bf16*)(ws + WS_K), (bf16*)(ws + WS_V), a.in[I_QG] + j * 64, a.in[I_KG] + j * 64, (const f32x2*)(ws + WS_ROPE)};
        pg8::gemm_phase<EpiQKV, SchedQKV, false>(c.lds, 2048, 2048, S, E); }
#endif
    else if constexpr (KIND == K_ROPE) ph_rope(a, c, layer);
    else if constexpr (KIND == K_ATT) ph_att(a, c, layer, (char*)c.lds);
    else if constexpr (KIND == K_OPROJ) { constexpr int j = layer ? 1 : 0;
#if ATT_FP8
        unsigned* rdx = (unsigned*)(ws + WS_CTL) + CW_RDX + layer * 128;
        SchedDenseR S{(const char*)(ws + WS_HB), (const char*)(ws + WS_WO) + (size_t)j * 1024 * 1024, (size_t)256 * 1024, (size_t)256 * 1024, 0, layer == 3 ? 64 : 68, 4, 64, c.G, (int)blockIdx.x, rdx};
        EpiResid E{&a, layer, nullptr, nullptr};
        pg8::gemm_phase<EpiResid, SchedDenseR, false, true>(c.lds, 1024, 1024, S, E, 127 - MOE_WSH, 127 - ATT_OSH);
        RELAUNDER(); ph_m1(a, c, layer, (unsigned*)(a.ws + WS_CTL) + CW_RDX + layer * 128, 4, 0); }
#else
        unsigned* rdx = (unsigned*)(ws + WS_CTL) + CW_RDX + layer * 128;
        SchedDenseR S{(const char*)(ws + WS_HB), (const char*)(ws + WS_WO) + (size_t)j * 1024 * 1024 * 2, (size_t)256 * 1024 * 2, (size_t)256 * 1024 * 2, 0, layer == 3 ? 64 : 68, 4, 64, c.G, (int)blockIdx.x, rdx};
        EpiResid E{&a, layer, nullptr, nullptr};
        pg8::gemm_phase<EpiResid, SchedDenseR, false>(c.lds, 2048, 2048, S, E);
        RELAUNDER(); ph_m1(a, c, layer, (unsigned*)(a.ws + WS_CTL) + CW_RDX + layer * 128, 4, 0); }
#endif
    else if constexpr (KIND == K_M2) {
        LAS int* tab = (LAS int*)(c.lds + TAB_OFF); moe_tables(a, c, layer, tab);
        unsigned* rdy = (unsigned*)(ws + WS_CTL) + CW_RDY + layer * 256;
#if MOE_FP8
        { SchedMoe S{(const char*)(ws + WS_TK), 0, (const char*)(ws + WS_WGU) + (size_t)layer * 32 * 1024 * 1024, (size_t)1024 * 1024, (size_t)256 * 1024, tab, (const int*)(ws + WS_LIST), c.G, (int)blockIdx.x, rdy, 1};
          EpiGateUp E{(bf16*)(ws + WS_ACT)};
          pg8::gemm_phase<EpiGateUp, SchedMoe, true, true>(c.lds, 1024, 1024, S, E, 127 - MOE_WSH, 127); }
        { SchedMoe S{(const char*)(ws + WS_ACT), (size_t)256 * 512, (const char*)(ws + WS_WDN) + (size_t)layer * 32 * 1024 * 512, (size_t)1024 * 512, (size_t)256 * 512, tab, (const int*)(ws + WS_LIST), c.G, (int)blockIdx.x, rdy, 2};
          EpiDown E{(const int*)(ws + WS_LIST), (const float*)(ws + WS_W2), (bf16*)(ws + WS_Y2)};
          pg8::gemm_phase<EpiDown, SchedMoe, false, true>(c.lds, 512, 512, S, E, 127 - MOE_WSH, 127 - MOE_ASH); } }
#else
        { SchedMoe S{(const char*)(ws + WS_TK), 0, (const char*)(ws + WS_WGU) + (size_t)layer * 32 * 1024 * 1024 * 2, (size_t)1024 * 1024 * 2, (size_t)256 * 1024 * 2, tab, (const int*)(ws + WS_LIST), c.G, (int)blockIdx.x, rdy, 1};
          EpiGateUp E{(bf16*)(ws + WS_ACT)};
          pg8::gemm_phase<EpiGateUp, SchedMoe, true>(c.lds, 2048, 2048, S, E); }
        { SchedMoe S{(const char*)(ws + WS_ACT), (size_t)256 * 512 * 2, (const char*)(ws + WS_WDN) + (size_t)layer * 32 * 1024 * 512 * 2, (size_t)1024 * 512 * 2, (size_t)256 * 512 * 2, tab, (const int*)(ws + WS_LIST), c.G, (int)blockIdx.x, rdy, 2};
          EpiDown E{(const int*)(ws + WS_LIST), (const float*)(ws + WS_W2), (bf16*)(ws + WS_Y2)};
          pg8::gemm_phase<EpiDown, SchedMoe, false>(c.lds, 1024, 1024, S, E); } }
#endif
    else if constexpr (KIND == K_RPOOL) ph_rpool(a, c, layer);
    else if constexpr (KIND == K_POOLG) {
        unsigned* rdx = (unsigned*)(ws + WS_CTL) + CW_RDX + layer * 128;
        SchedDenseR S{(const char*)(ws + WS_HB), (const char*)(ws + WS_WPOOL), (size_t)256 * 1024 * 2, (size_t)256 * 256 * 2, (size_t)256 * 2, 68, 4, 64, c.G, (int)blockIdx.x, rdx};
        EpiResidN E{&a, layer, a.in[I_POOLS], (const bf16*)(ws + WS_Z)};
        pg8::gemm_phase<EpiResidN, SchedDenseR, false>(c.lds, 512, 2048, S, E);
        RELAUNDER(); ph_m1(a, c, layer, (unsigned*)(a.ws + WS_CTL) + CW_RDX + layer * 128, 4, 0); }
    else if constexpr (KIND == K_INPROJ) {
        SchedDense S{(const char*)(ws + WS_HB), (const char*)(ws + WS_WIN), (size_t)256 * 1024 * 2, (size_t)256 * 1024 * 2, 0, 68, 21, c.G, (int)blockIdx.x};
        EpiInproj E{(bf16*)(ws + WS_Z), (bf16*)(ws + WS_XBC), (float*)(ws + WS_DT), a.in[I_DTB]};
        pg8::gemm_phase<EpiInproj, SchedDense, false>(c.lds, 2048, 2048, S, E); }
    else if constexpr (KIND == K_CONV) ph_conv(a, c);
    else if constexpr (KIND == K_SCAN) ph_scan(a, c);
    else if constexpr (KIND == K_YPH) {
        ph_yph(a, c, (unsigned*)(ws + WS_CTL) + CW_RDG);
        RELAUNDER();
        { unsigned* rdx = (unsigned*)(a.ws + WS_CTL) + CW_RDX + layer * 128;
          SchedOutproj S{(const char*)(a.ws + WS_G), (const char*)(a.ws + WS_WOUT), (size_t)256 * 2048 * 2, (size_t)256 * 2048 * 2, c.G, c.vcu, (const unsigned*)(a.ws + WS_CTL) + CW_RDG, rdx};
          EpiResid E{&a, layer, nullptr, nullptr};
          pg8::gemm_phase<EpiResid, SchedOutproj, false>(c.lds, 4096, 4096, S, E); }
        RELAUNDER(); ph_m1(a, c, layer, (unsigned*)(a.ws + WS_CTL) + CW_RDX + layer * 128, 4, 1); }
    else if constexpr (KIND == K_GFIX) ph_gfix(a, c);
    else if constexpr (KIND == K_FINAL) ph_final(a, c, layer);
#undef RELAUNDER
}
#define PROGRAM(X) \
    X(0, K_P0, 0) \
    X(1, K_RMIX, 0) X(2, K_QKV, 0) X(3, K_ATT, 0) X(4, K_OPROJ, 0) X(5, K_M2, 0) \
    X(6, K_RPOOL, 1) X(7, K_POOLG, 1) X(8, K_M2, 1) \
    X(9, K_RMIX, 2) X(10, K_INPROJ, 2) X(11, K_CONV, 2) X(12, K_SCAN, 2) X(13, K_YPH, 2) X(14, K_M2, 2) \
    X(15, K_RMIX, 3) X(16, K_QKV, 3) X(17, K_ATT, 3) X(18, K_OPROJ, 3) X(19, K_M2, 3) \
    X(20, K_FINAL, 4)
constexpr int NPHASES = 21;
__device__ __forceinline__ unsigned long long probe_phases(const unsigned long long* ts, unsigned mask) { unsigned long long r = 0; for (int k = 0; k < 32; ++k) if (mask & (1u << k)) r += ts[k + 1] - ts[k]; return r; }
__device__ __forceinline__ unsigned long long probe_sum(const unsigned long long* s, int mask) { unsigned long long r = 0; for (int k = 0; k < 8; ++k) if (mask & (1 << k)) r += s[k]; return r; }
__global__ void __launch_bounds__(NTHREADS, 2) mega(Args a0) {
    extern __shared__ __attribute__((aligned(16))) unsigned char lds_raw[];
    Ctx c; c.lds = (LAS unsigned char*)lds_raw; c.tid = threadIdx.x; c.lane = c.tid & 63; c.wave = __builtin_amdgcn_readfirstlane(c.tid >> 6);
    c.G = gridDim.x; { const int bx = blockIdx.x; c.vcu = (c.G % 8 == 0) ? (bx % 8) * (c.G / 8) + bx / 8 : bx; }
    volatile LAS unsigned* MISC = (volatile LAS unsigned*)(c.lds + MISC_OFF);
    for (int u = c.tid; u < 128; u += NTHREADS) MISC[u] = 0u;
    __syncthreads();
    XcdBarrier bar = xcd_barrier_post((unsigned*)(a0.ws + WS_CTL) + CW_BAR + a0.bar_region * XCD_BAR_WORDS, MISC + 8);
    const int lo = a0.ph_lo, hi = a0.ph_hi;
#if PROBE
#define STAMP(idx) if (blockIdx.x == 0 && threadIdx.x == 0) __hip_atomic_store((unsigned long long*)((unsigned*)(a0.ws + WS_CTL) + CW_TS) + (idx), (unsigned long long)__builtin_amdgcn_s_memrealtime(), __ATOMIC_RELAXED, __HIP_MEMORY_SCOPE_AGENT);
#else
#define STAMP(idx)
#endif
    STAMP(0)
#if EXTRA_BARS
    for (int eb = 0; eb < EXTRA_BARS; ++eb) xcd_barrier(bar);
#endif
#define RUNPH(idx, KIND, LAYER) if (lo <= (idx) && (idx) < hi) { run_phase<KIND, LAYER>(a0, c, lds_raw); if ((idx) + 1 < hi) xcd_barrier(bar); STAMP((idx) + 1) }
    PROGRAM(RUNPH)
#undef RUNPH
#if PROBE
    if (blockIdx.x == 0 && threadIdx.x == 0 && hi == NPHASES) { const unsigned long long* ts = (const unsigned long long*)((unsigned*)(a0.ws + WS_CTL) + CW_TS);
        const unsigned long long d = (unsigned long long)PROBE_K * (PROBE_SLOT ? probe_sum(ts + PROBE_SLOT_BASE, PROBE_SLOT) : probe_phases(ts, PROBE_MASK)), t0 = __builtin_amdgcn_s_memrealtime();
        while (__builtin_amdgcn_s_memrealtime() - t0 < d) __builtin_amdgcn_s_sleep(8); }
#endif
}

extern "C" void kernel_launch(void* const* d_in, const int* in_sizes, int n_in, void* d_out, int out_size, void* d_ws, size_t ws_size, hipStream_t stream) {
    static int grid = 0;
    if (grid == 0) {
        if (n_in != N_IN || out_size != TL * D || ws_size < WS_END) { fprintf(stderr, "kernel_launch: unexpected shapes (n_in %d out %d ws %zu)\n", n_in, out_size, ws_size); grid = -1; return; }
        int dev = 0, cus = 0;
        if (hipGetDevice(&dev) != hipSuccess || hipDeviceGetAttribute(&cus, hipDeviceAttributeMultiprocessorCount, dev) != hipSuccess) { grid = -1; return; }
        if (hipFuncSetAttribute((const void*)mega, hipFuncAttributeMaxDynamicSharedMemorySize, LDS_BYTES) != hipSuccess) { fprintf(stderr, "kernel_launch: hipFuncSetAttribute failed\n"); grid = -1; return; }
        int per_cu = 0;
        if (hipOccupancyMaxActiveBlocksPerMultiprocessor(&per_cu, (const void*)mega, NTHREADS, LDS_BYTES) != hipSuccess || per_cu < 1) fprintf(stderr, "kernel_launch: occupancy query says %d\n", per_cu);
        (void)hipGetLastError();
        grid = cus;
    }
    if (grid < 0) return;
    (void)hipMemsetAsync((char*)d_ws + WS_CTL, 0, CTL_ZERO_BYTES, stream);
    Args a{};
    for (int i = 0; i < N_IN; ++i) a.in[i] = (const float*)d_in[i];
    a.out = (float*)d_out; a.ws = (unsigned char*)d_ws; a.flags = 0;
#if DEBUG_CHECKS
    struct Cut { int after; int ty, layer, nid; };
    const Cut cuts[] = DEBUG_CUTS;
    int lo = 0, region = 0, dbg_id = 1;
    for (unsigned k = 0; k < sizeof(cuts) / sizeof(cuts[0]); ++k) {
        if (cuts[k].after + 1 > lo) { a.ph_lo = lo; a.ph_hi = cuts[k].after + 1; a.bar_region = region++; hipLaunchKernelGGL(mega, dim3(grid), dim3(NTHREADS), LDS_BYTES, stream, a); lo = cuts[k].after + 1; }
        hipLaunchKernelGGL(dbg_kernel, dim3(16), dim3(NTHREADS), 65536, stream, a, cuts[k].ty, cuts[k].layer, dbg_id); dbg_id += cuts[k].nid;
    }
    a.ph_lo = lo; a.ph_hi = NPHASES; a.bar_region = region++;
    hipLaunchKernelGGL(mega, dim3(grid), dim3(NTHREADS), LDS_BYTES, stream, a);
#else
    a.ph_lo = 0; a.ph_hi = NPHASES; a.bar_region = 0;
    hipLaunchKernelGGL(mega, dim3(grid), dim3(NTHREADS), LDS_BYTES, stream, a);
#endif
}
```

```cpp
#include <hip/hip_runtime.h>
#include <cstdio>
#include <cstdint>

#define LAS __attribute__((address_space(3)))
#define GAS __attribute__((address_space(1)))
typedef unsigned short bf16;
typedef short bf16x8 __attribute__((ext_vector_type(8)));
typedef short s16x4 __attribute__((ext_vector_type(4)));
typedef float f32x2 __attribute__((ext_vector_type(2)));
typedef float f32x4 __attribute__((ext_vector_type(4)));
typedef float f32x16 __attribute__((ext_vector_type(16)));
typedef unsigned u32x2 __attribute__((ext_vector_type(2)));
typedef unsigned u32x4 __attribute__((ext_vector_type(4)));
typedef __bf16 bf16x2_t __attribute__((ext_vector_type(2)));

constexpr int D = 1024, NB = 4, SEQ = 4096, CTXL = 256, TL = NB * SEQ, TC = NB * CTXL, TT = TL + TC;
constexpr int KVROWS = SEQ + CTXL;
constexpr int NCH = TT / 128;
constexpr int MOE_CAP = TT;
constexpr float EPS = 1e-6f;
constexpr int NWAVES = 8, NTHREADS = 512;
#ifndef NLAYERS
#define NLAYERS 4
#endif
#ifndef MOE_FP8
#define MOE_FP8 1
#endif
#define MOE_WSH 5
#ifndef ATT_FP8
#define ATT_FP8 1
#endif
#define ATT_OSH 3
#define MOE_ASH 2
#define DBG_TOL 0.03f
#ifndef DEBUG_CHECKS
#define DEBUG_CHECKS 0
#endif
#ifndef PROBE
#define PROBE 0
#endif
#define PROBE_A0 0
#define PROBE_A1 1
#define PROBE_B0 4
#define PROBE_B1 5
#define PROBE_K 2
#define PROBE_MASK 0x1222224u
#define EXTRA_BARS 0
#define PROBE_SLOT_BASE 40
#define PROBE_SLOT 0
#if PROBE
#define SECT_DECL unsigned long long sect_t = __builtin_amdgcn_s_memrealtime(); unsigned long long sect_acc[8] = {0, 0, 0, 0, 0, 0, 0, 0};
#define SECT(k) do { const unsigned long long n_ = __builtin_amdgcn_s_memrealtime(); sect_acc[k] += n_ - sect_t; sect_t = n_; } while (0)
#ifndef PROBE_BLOCK
#define PROBE_BLOCK 0
#endif
#define SECT_END(base) do { if (blockIdx.x == PROBE_BLOCK && threadIdx.x == 0) { _Pragma("unroll") for (int k_ = 0; k_ < 8; ++k_) ((unsigned long long*)((unsigned*)(a.ws + WS_CTL) + CW_TS))[(base) + k_] = sect_acc[k_]; } } while (0)
#else
#define SECT_DECL
#define SECT(k) do {} while (0)
#define SECT_END(base) do {} while (0)
#endif
#define DEBUG_CUTS { {1, 1, 0, 1}, {2, 2, 0, 1}, {3, 3, 0, 1}, {4, 4, 0, 1}, {6, 5, 0, 2} }

enum { I_X = 0, I_C, I_CTX, I_CCTX, I_WADA, I_BADA, I_NMIX, I_NFFN, I_NFIN, I_WQKV, I_WO, I_QG, I_KG, I_POOLW, I_POOLS, I_WIN, I_CONVW, I_CONVB, I_DTB, I_ALOG, I_DSK, I_SNORM, I_WOUT, I_WRG, I_WRE, I_WGU, I_WDN, N_IN };

constexpr size_t MiB = 1u << 20;
constexpr size_t WS_CTL = 0, CTL_ZERO_BYTES = 1 * MiB;
constexpr size_t WS_MODL = 1 * MiB;
constexpr size_t WS_MODC = WS_MODL + 4 * 4 * 6144 * 4;
constexpr size_t WS_ROPE = 1 * MiB + 512 * 1024;
constexpr size_t WS_WR = 2 * MiB;
constexpr size_t WS_WQKV = 3 * MiB;
constexpr size_t WS_WO = 9 * MiB;
constexpr size_t WS_WPOOL = 13 * MiB;
constexpr size_t WS_WIN = 14 * MiB;
constexpr size_t WS_WOUT = 25 * MiB;
constexpr size_t WS_WGU = 29 * MiB;
constexpr size_t WS_WDN = 285 * MiB;
constexpr size_t WS_X = 413 * MiB;
constexpr size_t WS_HB = 481 * MiB;
constexpr size_t WS_TK = 515 * MiB;
constexpr size_t WS_Q = 549 * MiB;
constexpr size_t WS_K = 583 * MiB;
constexpr size_t WS_V = 592 * MiB;
constexpr size_t WS_Y2 = 601 * MiB;
constexpr size_t WS_ACT = 669 * MiB;
constexpr size_t WS_LIST = 711 * MiB;
constexpr size_t WS_W2 = 714 * MiB;
constexpr size_t WS_Z = 715 * MiB;
constexpr size_t WS_XBC = 783 * MiB;
constexpr size_t WS_DT = 885 * MiB;
constexpr size_t WS_XT = 890 * MiB;
constexpr size_t WS_BN = 958 * MiB;
constexpr size_t WS_BT = 975 * MiB;
constexpr size_t WS_CN = 992 * MiB;
constexpr size_t WS_SCA = 1009 * MiB;
constexpr size_t WS_SCB = 1018 * MiB;
constexpr size_t WS_DEC = 1027 * MiB;
constexpr size_t WS_HIN = 1028 * MiB;
constexpr size_t WS_G = 1164 * MiB;
constexpr size_t WS_RSTD = 1232 * MiB;
constexpr size_t WS_END = 1233 * MiB;

constexpr int CW_BAR = 4096;
constexpr int CW_CNT = 200000;
constexpr int CW_DBG = 201000;
constexpr int CW_RDY = 204000;
constexpr int CW_RDG = 207000;
constexpr int CW_RDX = 206000;
constexpr int CW_TS = 202000;

constexpr int LDS_BYTES = 163840;
constexpr int MISC_OFF = LDS_BYTES - 512;

__device__ __forceinline__ unsigned cvtpk(float lo, float hi) { f32x2 v = {lo, hi}; bf16x2_t b = __builtin_convertvector(v, bf16x2_t); return __builtin_bit_cast(unsigned, b); }
__device__ __forceinline__ unsigned pk_fp8x4(float a, float b, float c, float d) {
    a = __builtin_amdgcn_fmed3f(a, -448.f, 448.f); b = __builtin_amdgcn_fmed3f(b, -448.f, 448.f); c = __builtin_amdgcn_fmed3f(c, -448.f, 448.f); d = __builtin_amdgcn_fmed3f(d, -448.f, 448.f);
    unsigned w = __builtin_amdgcn_cvt_pk_fp8_f32(a, b, 0u, false); return __builtin_amdgcn_cvt_pk_fp8_f32(c, d, w, true); }
__device__ __forceinline__ float bflo(unsigned u) { return __uint_as_float(u << 16); }
__device__ __forceinline__ float bfhi(unsigned u) { return __uint_as_float(u & 0xffff0000u); }
__device__ __forceinline__ float bf2f(bf16 b) { return __uint_as_float((unsigned)b << 16); }
__device__ __forceinline__ float wave_sum(float v) {
#pragma unroll
    for (int o = 1; o < 64; o <<= 1) v += __shfl_xor(v, o);
    return v;
}
__device__ __forceinline__ float silu_f(float v) { return v * __builtin_amdgcn_rcpf(1.0f + __builtin_amdgcn_exp2f(v * -1.4426950408889634f)); }
__device__ __forceinline__ int tid_opaque() { int t = threadIdx.x; asm volatile("" : "+v"(t)); return t; }
#define LDS_WAIT() asm volatile("s_waitcnt lgkmcnt(0)" ::: "memory")
#define VM_WAIT() asm volatile("s_waitcnt vmcnt(0)" ::: "memory")

#define XB_TMO      128
#define XB_XCNT(j)  (256  + 64 * (j))
#define XB_XSUB(j)  (1280 + 64 * (j))
#define XB_XGEN(j)  (2304 + 64 * (j))
#define XB_TOP      3328
#define XB_TOPGEN   3392
#define XCD_BAR_WORDS 3456
#define XB_SPIN_CAP (1u << 20)
#ifndef XB_FLATPOLL
#define XB_FLATPOLL 0
#endif
__device__ __forceinline__ unsigned xb_ld(unsigned* p)              { return __hip_atomic_load(p, __ATOMIC_RELAXED, __HIP_MEMORY_SCOPE_AGENT); }
__device__ __forceinline__ unsigned xb_add(unsigned* p, unsigned v) { return __hip_atomic_fetch_add(p, v, __ATOMIC_RELAXED, __HIP_MEMORY_SCOPE_AGENT); }
__device__ __forceinline__ unsigned xb_xcc_id() { return (unsigned)__builtin_amdgcn_s_getreg((3 << 11) | 20) & 0xFu; }
#define XB_SPIN(cond, bar) do { unsigned _sp = 0; while (cond) { __builtin_amdgcn_s_sleep(1); \
    if ((++_sp & 255u) == 0u) { if (xb_ld(&(bar)[XB_TMO])) break; if (_sp > XB_SPIN_CAP) { atomicAdd(&(bar)[XB_TMO], 1u); break; } } } } while (0)
struct XcdBarrier { unsigned* bar; unsigned x; volatile LAS unsigned* st; };
__device__ __forceinline__ XcdBarrier xcd_barrier_post(unsigned* bar, volatile LAS unsigned* st) {
    XcdBarrier b; b.bar = bar; b.x = xb_xcc_id(); b.st = st;
    if (threadIdx.x == 0) (void)xb_add(&bar[XB_XCNT(b.x)], 1u);
    return b;
}
__device__ __forceinline__ void xcd_barrier_complete(unsigned* bar, unsigned x, unsigned& nloc, unsigned& nx) {
    const unsigned G = gridDim.x * gridDim.y * gridDim.z;
    unsigned sum, cnt, mine, sp = 0u;
    for (;;) {
        sum = 0u; cnt = 0u; mine = 0u;
#pragma unroll
        for (unsigned j = 0; j < 16; ++j) { const unsigned c = xb_ld(&bar[XB_XCNT(j)]); sum += c; cnt += (c > 0u) ? 1u : 0u; mine = (j == x) ? c : mine; }
        if (sum == G) break;
        __builtin_amdgcn_s_sleep(1);
        if ((++sp & 255u) == 0u) { if (xb_ld(&bar[XB_TMO])) break; if (sp > XB_SPIN_CAP) { atomicAdd(&bar[XB_TMO], 1u); break; } }
    }
    nloc = mine > 0u ? mine : 1u; nx = cnt > 0u ? cnt : 1u;
}
__device__ __forceinline__ void xcd_barrier(const XcdBarrier& b) {
    asm volatile("s_waitcnt vmcnt(0)" ::: "memory");
    __syncthreads();
    if (threadIdx.x == 0) {
        unsigned* bar = b.bar;
        __builtin_amdgcn_s_waitcnt(0);
        unsigned nloc = b.st[0], nx = b.st[1];
        if (nloc == 0u) { xcd_barrier_complete(bar, b.x, nloc, nx); b.st[0] = nloc; b.st[1] = nx; }
#if XB_FLATPOLL
        const unsigned seq = b.st[2]; b.st[2] = seq + 1u;
#endif
        const unsigned old = xb_add(&bar[XB_XSUB(b.x)], 1u);
        const unsigned gen = old / nloc;
        if (old + 1u == (gen + 1u) * nloc) {
            __builtin_amdgcn_fence(__ATOMIC_RELEASE, "agent");
            asm volatile("s_waitcnt vmcnt(0)" ::: "memory");
            const unsigned og = xb_add(&bar[XB_TOP], 1u);
            const unsigned tg = og / nx;
            if (og + 1u == (tg + 1u) * nx) xb_add(&bar[XB_TOPGEN], 1u);
            else XB_SPIN(xb_ld(&bar[XB_TOPGEN]) == tg, bar);
            __builtin_amdgcn_fence(__ATOMIC_ACQUIRE, "agent");
#if !XB_FLATPOLL
            xb_add(&bar[XB_XGEN(b.x)], 1u);
#endif
            asm volatile("s_waitcnt vmcnt(0)" ::: "memory");
        } else {
#if XB_FLATPOLL
            XB_SPIN(xb_ld(&bar[XB_TOPGEN]) == seq, bar);
#else
            XB_SPIN(xb_ld(&bar[XB_XGEN(b.x)]) == gen, bar);
#endif
            __builtin_amdgcn_fence(__ATOMIC_ACQUIRE, "agent");
            asm volatile("s_waitcnt vmcnt(0)" ::: "memory");
        }
    }
    __syncthreads();
}

enum { K_P0 = 0, K_RMIX, K_QKV, K_ROPE, K_ATT, K_OPROJ, K_M1, K_M2, K_M3, K_RPOOL, K_POOLG, K_INPROJ, K_CONV, K_SCAN, K_YPH, K_GFIX, K_OUTPROJ, K_FINAL, K_DBG };
struct Args { const float* in[N_IN]; float* out; unsigned char* ws; int ph_lo, ph_hi; int flags; int bar_region; };

struct Ctx {
    LAS unsigned char* lds; int tid, lane, wave, vcu, G;
};

__device__ __forceinline__ const float* mod_row(const Args& a, int layer, int r) {
    return r < TL ? (const float*)(a.ws + WS_MODL) + (size_t)(layer * 4 + r / SEQ) * 6144 : (const float*)(a.ws + WS_MODC) + (size_t)layer * 6144;
}
__device__ __forceinline__ const float* resid_row(const Args& a, int layer, int r) {
    if (layer == 0) return r < TL ? a.in[I_X] + (size_t)r * D : a.in[I_CTX] + (size_t)(r - TL) * D;
    return (const float*)(a.ws + WS_X) + (size_t)r * D;
}

__device__ __forceinline__ void load_row_combined(const Args& a, int layer, int r, int lane, f32x4 (&v)[4]) {
    if (layer == 0) { const f32x4* xr = (const f32x4*)resid_row(a, 0, r) + lane;
#pragma unroll
        for (int j = 0; j < 4; ++j) v[j] = xr[64 * j]; }
    else { const u32x2* xr = (const u32x2*)((const bf16*)(a.ws + WS_X) + (size_t)r * D) + lane;
#pragma unroll
        for (int j = 0; j < 4; ++j) { const u32x2 p = xr[64 * j]; v[j] = (f32x4){bflo(p.x), bfhi(p.x), bflo(p.y), bfhi(p.y)}; } }
    if (layer > 0 && !(a.flags & 1)) {
        const f32x4* gf = (const f32x4*)(mod_row(a, layer - 1, r) + 5 * D) + lane;
        const u32x2* y0 = (const u32x2*)((const bf16*)(a.ws + WS_Y2) + (size_t)(2 * r) * D) + lane;
        const u32x2* y1 = (const u32x2*)((const bf16*)(a.ws + WS_Y2) + (size_t)(2 * r + 1) * D) + lane;
#pragma unroll
        for (int j = 0; j < 4; ++j) {
            const u32x2 p = y0[64 * j], q = y1[64 * j]; const f32x4 g = gf[64 * j];
            v[j].x += g.x * (bflo(p.x) + bflo(q.x)); v[j].y += g.y * (bfhi(p.x) + bfhi(q.x));
            v[j].z += g.z * (bflo(p.y) + bflo(q.y)); v[j].w += g.w * (bfhi(p.y) + bfhi(q.y));
        }
    }
}
__device__ __forceinline__ float row_rstd(const f32x4 (&v)[4]) {
    float s = 0.f;
#pragma unroll
    for (int j = 0; j < 4; ++j) s += (v[j].x * v[j].x + v[j].y * v[j].y) + (v[j].z * v[j].z + v[j].w * v[j].w);
    return rsqrtf(wave_sum(s) * (1.0f / D) + EPS);
}
__device__ __forceinline__ void norm_mod(const f32x4 (&v)[4], float rstd, const float* g, const float* shift, const float* scale, int lane, f32x4 (&h)[4]) {
#pragma unroll
    for (int j = 0; j < 4; ++j) {
        const f32x4 gg = ((const f32x4*)g)[lane + 64 * j], sh = ((const f32x4*)shift)[lane + 64 * j], sc = ((const f32x4*)scale)[lane + 64 * j];
        h[j] = (v[j] * rstd) * gg * (sc + 1.0f) + sh;
    }
}

__device__ __forceinline__ void tr_item(const float* W, int N, int k0, int n0, bf16* WT, size_t drow0, int dK, LAS float* scr, int lane, int hi_skip = 0) {
    const int nq = lane & 15, kr = lane >> 4;
#pragma unroll
    for (int i = 0; i < 16; ++i) { const int kk = 4 * i + kr; const f32x4 v = *(const f32x4*)(W + (size_t)(k0 + kk) * N + n0 + 4 * nq);
        LAS float* d = scr + kk * 65 + 4 * nq; d[0] = v.x; d[1] = v.y; d[2] = v.z; d[3] = v.w; }
    LDS_WAIT(); asm volatile("" ::: "memory");
    const int c = lane & 7;
#pragma unroll
    for (int j = 0; j < 8; ++j) { const int n = (lane >> 3) + 8 * j; const LAS float* s = scr + (8 * c) * 65 + n;
        u32x4 o; o.x = cvtpk(s[0 * 65], s[1 * 65]); o.y = cvtpk(s[2 * 65], s[3 * 65]); o.z = cvtpk(s[4 * 65], s[5 * 65]); o.w = cvtpk(s[6 * 65], s[7 * 65]);
        *(u32x4*)(WT + (drow0 + n + (n >= 32 ? hi_skip : 0)) * dK + k0 + 8 * c) = o; }
    LDS_WAIT(); asm volatile("" ::: "memory");
}
__device__ __forceinline__ void tr_item8(const float* W, int N, int k0, int n0, unsigned char* WT, size_t drow0, int dKb, LAS float* scr, int lane, float scale, int hi_skip = 0) {
    const int nq = lane & 15, kr = lane >> 4;
#pragma unroll
    for (int i = 0; i < 16; ++i) { const int kk = 4 * i + kr; const f32x4 v = *(const f32x4*)(W + (size_t)(k0 + kk) * N + n0 + 4 * nq);
        LAS float* d = scr + kk * 65 + 4 * nq; d[0] = v.x; d[1] = v.y; d[2] = v.z; d[3] = v.w; }
    LDS_WAIT(); asm volatile("" ::: "memory");
    const int c = lane & 3;
#pragma unroll
    for (int j = 0; j < 4; ++j) { const int n = (lane >> 2) + 16 * j; const LAS float* s = scr + (16 * c) * 65 + n;
        u32x4 o; o.x = pk_fp8x4(s[0 * 65] * scale, s[1 * 65] * scale, s[2 * 65] * scale, s[3 * 65] * scale); o.y = pk_fp8x4(s[4 * 65] * scale, s[5 * 65] * scale, s[6 * 65] * scale, s[7 * 65] * scale);
        o.z = pk_fp8x4(s[8 * 65] * scale, s[9 * 65] * scale, s[10 * 65] * scale, s[11 * 65] * scale); o.w = pk_fp8x4(s[12 * 65] * scale, s[13 * 65] * scale, s[14 * 65] * scale, s[15 * 65] * scale);
        *(u32x4*)(WT + (drow0 + n + (n >= 32 ? hi_skip : 0)) * dKb + k0 + 16 * c) = o; }
    LDS_WAIT(); asm volatile("" ::: "memory");
}
struct TrD { const float* src; int N; unsigned char* dst; int dKb, drow0, hi_skip, fp8; };
__device__ __forceinline__ void tr_load(const TrD& d, f32x4 (&v)[16], int lane) {
    const int nq = lane & 15, kr = lane >> 4;
#pragma unroll
    for (int i = 0; i < 16; ++i) v[i] = *(const f32x4*)(d.src + (size_t)(4 * i + kr) * d.N + 4 * nq);
}
__device__ __forceinline__ void tr_store(const TrD& d, const f32x4 (&v)[16], LAS float* scr, int lane) {
    const int nq = lane & 15, kr = lane >> 4;
#pragma unroll
    for (int i = 0; i < 16; ++i) { LAS float* p = scr + (4 * i + kr) * 65 + 4 * nq; p[0] = v[i].x; p[1] = v[i].y; p[2] = v[i].z; p[3] = v[i].w; }
    LDS_WAIT(); asm volatile("" ::: "memory");
    if (d.fp8) { const int c = lane & 3; const float scale = (float)(1 << MOE_WSH);
#pragma unroll
        for (int j = 0; j < 4; ++j) { const int n = (lane >> 2) + 16 * j; const LAS float* s = scr + (16 * c) * 65 + n;
            u32x4 o; o.x = pk_fp8x4(s[0 * 65] * scale, s[1 * 65] * scale, s[2 * 65] * scale, s[3 * 65] * scale); o.y = pk_fp8x4(s[4 * 65] * scale, s[5 * 65] * scale, s[6 * 65] * scale, s[7 * 65] * scale);
            o.z = pk_fp8x4(s[8 * 65] * scale, s[9 * 65] * scale, s[10 * 65] * scale, s[11 * 65] * scale); o.w = pk_fp8x4(s[12 * 65] * scale, s[13 * 65] * scale, s[14 * 65] * scale, s[15 * 65] * scale);
            *(u32x4*)(d.dst + (size_t)(d.drow0 + n + (n >= 32 ? d.hi_skip : 0)) * d.dKb + 16 * c) = o; } }
    else { const int c = lane & 7;
#pragma unroll
        for (int j = 0; j < 8; ++j) { const int n = (lane >> 3) + 8 * j; const LAS float* s = scr + (8 * c) * 65 + n;
            u32x4 o; o.x = cvtpk(s[0 * 65], s[1 * 65]); o.y = cvtpk(s[2 * 65], s[3 * 65]); o.z = cvtpk(s[4 * 65], s[5 * 65]); o.w = cvtpk(s[6 * 65], s[7 * 65]);
            *(u32x4*)(d.dst + (size_t)(d.drow0 + n + (n >= 32 ? d.hi_skip : 0)) * d.dKb + 16 * c) = o; } }
    LDS_WAIT(); asm volatile("" ::: "memory");
}
constexpr int TR_I0 = 2 * 384, TR_I1 = 2 * 256, TR_I2 = 4 * 16, TR_I3 = 16 * 81, TR_I4 = 32 * 16, TR_I5 = 128 * 256, TR_I6 = 128 * 128, TR_ITOT = TR_I0 + TR_I1 + TR_I2 + TR_I3 + TR_I4 + TR_I5 + TR_I6;
__device__ __forceinline__ TrD tr_decode(const Args& a, int it) {
    TrD d; int r = it; d.hi_skip = 0;
    if (r < TR_I5) { const int m = r / 256, q = r % 256, kb = q / 16, nb = q % 16, n0 = nb * 64, j = n0 & 511;
        d.src = a.in[I_WGU] + (size_t)m * 1024 * 1024 + (size_t)kb * 64 * 1024 + n0; d.N = 1024; d.drow0 = 256 * (j >> 7) + (j & 127) + ((n0 >= 512) ? 128 : 0);
        d.fp8 = MOE_FP8; d.dKb = MOE_FP8 ? 1024 : 2048; d.dst = (unsigned char*)(a.ws + WS_WGU) + (size_t)m * 1024 * d.dKb + (size_t)kb * 64 * (MOE_FP8 ? 1 : 2); return d; }
    r -= TR_I5;
    if (r < TR_I6) { const int m = r / 128, q = r % 128, kb = q / 16, nb = q % 16;
        d.src = a.in[I_WDN] + (size_t)m * 512 * 1024 + (size_t)kb * 64 * 1024 + nb * 64; d.N = 1024; d.drow0 = nb * 64;
        d.fp8 = MOE_FP8; d.dKb = MOE_FP8 ? 512 : 1024; d.dst = (unsigned char*)(a.ws + WS_WDN) + (size_t)m * 1024 * d.dKb + (size_t)kb * 64 * (MOE_FP8 ? 1 : 2); return d; }
    r -= TR_I6;
    if (r < TR_I0) { const int m = r / 384, q = r % 384, kb = q / 24, nb = q % 24;
        d.src = a.in[I_WQKV] + (size_t)m * 1024 * 1536 + (size_t)kb * 64 * 1536 + nb * 64; d.N = 1536; d.drow0 = (nb >> 2) * 256 + (nb & 3) * 32; d.hi_skip = 96;
        d.fp8 = ATT_FP8; d.dKb = ATT_FP8 ? 1024 : 2048; d.dst = (unsigned char*)(a.ws + WS_WQKV) + (size_t)m * 1536 * d.dKb + (size_t)kb * 64 * (ATT_FP8 ? 1 : 2); return d; }
    r -= TR_I0;
    if (r < TR_I1) { const int m = r / 256, q = r % 256, kb = q / 16, nb = q % 16;
        d.src = a.in[I_WO] + (size_t)m * 1024 * 1024 + (size_t)kb * 64 * 1024 + nb * 64; d.N = 1024; d.drow0 = nb * 64;
        d.fp8 = ATT_FP8; d.dKb = ATT_FP8 ? 1024 : 2048; d.dst = (unsigned char*)(a.ws + WS_WO) + (size_t)m * 1024 * d.dKb + (size_t)kb * 64 * (ATT_FP8 ? 1 : 2); return d; }
    r -= TR_I1;
    d.fp8 = 0;
    if (r < TR_I2) { const int m = r / 16, q = r % 16, kb = q / 4, nb = q % 4;
        d.src = a.in[I_POOLW] + (size_t)m * 256 * 256 + (size_t)kb * 64 * 256 + nb * 64; d.N = 256; d.drow0 = nb * 64; d.dKb = 512; d.dst = (unsigned char*)(a.ws + WS_WPOOL) + (size_t)m * 256 * 512 + (size_t)kb * 128; return d; }
    r -= TR_I2;
    if (r < TR_I3) { const int kb = r / 81, nb = r % 81;
        d.src = a.in[I_WIN] + (size_t)kb * 64 * 5184 + nb * 64; d.N = 5184; d.drow0 = nb * 64; d.dKb = 2048; d.dst = (unsigned char*)(a.ws + WS_WIN) + (size_t)kb * 128; return d; }
    r -= TR_I3;
    { const int kb = r / 16, nb = r % 16;
        d.src = a.in[I_WOUT] + (size_t)kb * 64 * 1024 + nb * 64; d.N = 1024; d.drow0 = nb * 64; d.dKb = 4096; d.dst = (unsigned char*)(a.ws + WS_WOUT) + (size_t)kb * 128; return d; }
}
__device__ __forceinline__ void p0_prologue(const Args& a, const Ctx& c) {
    LAS float* scr = (LAS float*)(c.lds + c.wave * 16896);
    const int gw = c.vcu * NWAVES + c.wave, NGW = c.G * NWAVES;
    { f32x4 va[16], vb[16]; TrD da, db; int it = gw;
      da = tr_decode(a, it < TR_ITOT ? it : TR_ITOT - 1); tr_load(da, va, c.lane);
      while (it < TR_ITOT) {
          const int itB = it + NGW; db = tr_decode(a, itB < TR_ITOT ? itB : TR_ITOT - 1); tr_load(db, vb, c.lane);
          tr_store(da, va, scr, c.lane);
          if (itB >= TR_ITOT) break;
          const int itA = itB + NGW; da = tr_decode(a, itA < TR_ITOT ? itA : TR_ITOT - 1); tr_load(da, va, c.lane);
          tr_store(db, vb, scr, c.lane);
          it = itA; } }
    __syncthreads();
    LAS float* sv = (LAS float*)c.lds;
    LAS float* part = (LAS float*)(c.lds + 20480);
    for (int u = c.tid; u < 5 * 1024; u += NTHREADS) { const int v = u >> 10, k = u & 1023; const float x = v < 4 ? a.in[I_C][v * 1024 + k] : a.in[I_CCTX][k]; sv[u] = x / (1.0f + expf(-x)); }
    __syncthreads();
    for (int item = blockIdx.x; item < 4 * 64; item += c.G) {
        const int li = item >> 6, c0 = (item & 63) * 96, cq = c.tid % 24, ks = c.tid / 24;
        f32x4 acc[5];
#pragma unroll
        for (int v = 0; v < 5; ++v) acc[v] = (f32x4){0.f, 0.f, 0.f, 0.f};
        if (ks < 21) { const int kbeg = ks * 49, kend = (kbeg + 49) < 1024 ? (kbeg + 49) : 1024;
            const float* w = a.in[I_WADA] + ((size_t)li * 1024 + kbeg) * 6144 + c0 + 4 * cq;
#pragma unroll 7
            for (int k = kbeg; k < kend; ++k) { const f32x4 wv = *(const f32x4*)w; w += 6144;
#pragma unroll
                for (int v = 0; v < 5; ++v) acc[v] += wv * sv[v * 1024 + k]; }
#pragma unroll
            for (int v = 0; v < 5; ++v) *(LAS f32x4*)(part + (ks * 24 + cq) * 20 + v * 4) = acc[v]; }
        __syncthreads();
        if (c.tid < 480) { const int v = c.tid / 96, col = c.tid % 96, q = col >> 2, e = col & 3; float s = 0.f;
            for (int k2 = 0; k2 < 21; ++k2) s += part[(k2 * 24 + q) * 20 + v * 4 + e];
            s += a.in[I_BADA][li * 6144 + c0 + col];
            if (v < 4) ((float*)(a.ws + WS_MODL))[(size_t)(li * 4 + v) * 6144 + c0 + col] = s; else ((float*)(a.ws + WS_MODC))[(size_t)li * 6144 + c0 + col] = s; }
        __syncthreads();
    }
    if (blockIdx.x == (unsigned)(c.G - 1)) for (int u = c.tid; u < 1024; u += NTHREADS) { const int pos = u >> 4, f = u & 15;
        const float inv = (float)pow(10000.0, -(double)f / 16.0); const double ang = (double)((float)pos * inv);
        ((f32x2*)(a.ws + WS_ROPE))[u] = (f32x2){(float)cos(ang), (float)sin(ang)}; }
    for (int u = blockIdx.x * NTHREADS + c.tid; u < 4 * 64 * 1024; u += c.G * NTHREADS) { const int li = u >> 16, n = (u >> 10) & 63, k = u & 1023;
        float w = 0.f; if (n < 4) w = a.in[I_WRG][((size_t)li * 1024 + k) * 4 + n]; else if (n < 36) w = a.in[I_WRE][((size_t)li * 1024 + k) * 32 + (n - 4)];
        const unsigned hi = cvtpk(w, 0.f) & 0xffffu; const float rem = w - bflo(hi); const unsigned lo = cvtpk(rem, 0.f) & 0xffffu;
        bf16* wr = (bf16*)(a.ws + WS_WR) + (size_t)li * 2 * 65536;
        const int fo = (((k >> 7) * 8 + ((k >> 4) & 7)) * 4 + (n >> 5)) * 512 + ((n & 31) + 32 * ((k >> 3) & 1)) * 8 + (k & 7);
        wr[fo] = (bf16)hi; wr[fo + 1024] = (bf16)lo; }
}

__device__ __forceinline__ void ph_rmix(const Args& a, const Ctx& c, int layer) {
    const int gw = c.vcu * NWAVES + c.wave, NGW = c.G * NWAVES;
    const float* g = a.in[I_NMIX] + layer * D;
    for (int r = gw; r < TT; r += NGW) {
        f32x4 v[4], h[4]; load_row_combined(a, layer, r, c.lane, v);
        if (layer > 0) { u32x2* xo = (u32x2*)((bf16*)(a.ws + WS_X) + (size_t)r * D) + c.lane;
#pragma unroll
            for (int j = 0; j < 4; ++j) xo[64 * j] = (u32x2){cvtpk(v[j].x, v[j].y), cvtpk(v[j].z, v[j].w)}; }
        const float rstd = row_rstd(v); const float* m = mod_row(a, layer, r);
        norm_mod(v, rstd, g, m, m + D, c.lane, h);
        if (ATT_FP8 && layer != 2) { unsigned* ho8 = (unsigned*)((unsigned char*)(a.ws + WS_HB) + (size_t)r * D) + c.lane;
#pragma unroll
            for (int j = 0; j < 4; ++j) ho8[64 * j] = pk_fp8x4(h[j].x, h[j].y, h[j].z, h[j].w); }
        else { u32x2* ho = (u32x2*)((bf16*)(a.ws + WS_HB) + (size_t)r * D) + c.lane;
#pragma unroll
            for (int j = 0; j < 4; ++j) ho[64 * j] = (u32x2){cvtpk(h[j].x, h[j].y), cvtpk(h[j].z, h[j].w)}; }
    }
}

__device__ __forceinline__ void ph_final(const Args& a, const Ctx& c, int layer) {
    const int gw = c.vcu * NWAVES + c.wave, NGW = c.G * NWAVES;
    float dscale = 1.f, dmark = 0.f;
#if DEBUG_CHECKS
    { unsigned* dbg = (unsigned*)(a.ws + WS_CTL) + CW_DBG; int code = 0; float mag = 0.f;
      for (int id = 1; id < 32; ++id) { const float e = __uint_as_float(__hip_atomic_load(dbg + id, __ATOMIC_RELAXED, __HIP_MEMORY_SCOPE_AGENT)); if (code == 0 && e > DBG_TOL) { code = id; mag = e; } }
      dscale = 1.f + (float)code; dmark = code ? 100.f * (1.f + fminf(fmaxf(log2f(mag / DBG_TOL), 0.f), 30.f)) : 0.f; }
#endif
    for (int r = gw; r < TL; r += NGW) {
        f32x4 v[4]; load_row_combined(a, layer, r, c.lane, v);
        const float rstd = row_rstd(v) * dscale;
        f32x4* o = (f32x4*)(a.out + (size_t)r * D) + c.lane;
#pragma unroll
        for (int j = 0; j < 4; ++j) { f32x4 ov = (v[j] * rstd) * ((const f32x4*)a.in[I_NFIN])[c.lane + 64 * j]; if (j == 0 && r == 0 && c.lane == 0 && dmark > 0.f) ov.x = dmark; o[64 * j] = ov; }
    }
}


namespace pg8 {
constexpr int BM = 256, BK = 64, HALF = 128, HTB = HALF * BK * 2, STAGE_BYTES = 8 * HTB;
__host__ __device__ __forceinline__ int lds_byte(int r, int c) { const int st = (r >> 4) * 2 + (c >> 5), rr = r & 15, cc = c & 31, ob = rr * 64 + cc * 2; return st * 1024 + (ob ^ (((ob >> 9) & 1) << 5)); }
__host__ __device__ __forceinline__ void stage_rc(int b, int& R, int& C) { const int st = b / 1024, sb = b % 1024, swz = sb ^ (((sb >> 9) & 1) << 5); R = (st >> 1) * 16 + swz / 64; C = (st & 1) * 32 + (swz % 64) / 2; }
__host__ __device__ __forceinline__ int perm32(int rho) { const int n = rho >> 4, i = rho & 15; return 8 * (i >> 2) + 4 * n + (i & 3); }
struct Unit { const char* A; const char* B; int pm, pn, x0, x1; };
__device__ __forceinline__ void tile_of(int L, int nM, int nN, int& pm, int& pn) {
    const int nwg = nM * nN; int wgid = L; { const int q = nwg / 8, r = nwg % 8, xcd = wgid % 8, off = wgid / 8; wgid = (xcd < r ? xcd * (q + 1) : r * (q + 1) + (xcd - r) * q) + off; }
    const int nig = 8 * nN, gid = wgid / nig, fm = gid * 8, gsz = (nM - fm) < 8 ? (nM - fm) : 8;
    pm = fm + ((wgid % nig) % gsz); pn = (wgid % nig) / gsz;
}
typedef int v4i_t __attribute__((ext_vector_type(4))); typedef int v8i_t __attribute__((ext_vector_type(8)));
template <class Epi, class Sched, bool GATHER, bool FP8 = false>
__device__ __forceinline__ void gemm_phase(LAS unsigned char* lds, const int Kb, const int ldab, const Sched& S, const Epi& E, const int scw = 127, const int sca = 127) {
    const int tid = tid_opaque(), wid = __builtin_amdgcn_readfirstlane(tid >> 6), lane = tid & 63, wr = wid >> 2, wc = wid & 3, fr = lane & 15, fq = lane >> 4;
    const int nt = Kb / (BK * 2);
    int scw_v = scw, sca_v = sca;
    unsigned voffA[2], voffB[2]; int RA[2], CA[2];
#pragma unroll
    for (int i = 0; i < 2; ++i) { int R, C; stage_rc(tid * 16 + i * 8192, R, C); const int Rb = Epi::PERM ? ((R & ~31) + perm32(R & 31)) : R;
        RA[i] = R; CA[i] = C; voffA[i] = (unsigned)(R * ldab + C * 2); voffB[i] = (unsigned)(Rb * Kb + C * 2); }
    const size_t kstep = (size_t)(BK * 2);
    const size_t hstepA = (size_t)HALF * ldab, hstepB = (size_t)HALF * Kb;
    const unsigned ldsw = (unsigned)wid * 1024u;
    const int aoff = lds_byte(wr * 64 + fr, fq * 8), boff = lds_byte(wc * 32 + fr, fq * 8);
#define PG8_SA(b, h) (((b) * 2 + (h)) * HTB)
#define PG8_SB(b, h) ((4 + (b) * 2 + (h)) * HTB)
#define PG8_GLDS(bufoff, gptr, i_) __builtin_amdgcn_global_load_lds((const unsigned*)(gptr), (LAS unsigned*)(lds + (bufoff) + ldsw + (i_) * 8192), 16, 0, 0)
#define PG8_STAGE_B(bufoff, gbase) do { _Pragma("unroll") for (int _i = 0; _i < 2; ++_i) PG8_GLDS(bufoff, (const char*)(gbase) + voffB[_i], _i); } while (0)
#define PG8_STAGE_A(bufoff, ab, kb, h, NX) do { _Pragma("unroll") for (int _i = 0; _i < 2; ++_i) { \
        if constexpr (GATHER) { const unsigned _vo = (NX) ? voN[h][_i] : voC[h][_i]; PG8_GLDS(bufoff, (ab) + (kb) + _vo, _i); } \
        else { PG8_GLDS(bufoff, (ab) + (kb) + (size_t)(h) * hstepA + voffA[_i], _i); } } } while (0)
#define PG8_LDA(dst, b, h) do { _Pragma("unroll") for (int m = 0; m < 4; ++m) _Pragma("unroll") for (int k = 0; k < 2; ++k) dst[m][k] = *(const LAS bf16x8*)(lds + PG8_SA(b, h) + aoff + m * 2048 + k * 1024); } while (0)
#define PG8_LDB(dst, b, h) do { _Pragma("unroll") for (int n = 0; n < 2; ++n) _Pragma("unroll") for (int k = 0; k < 2; ++k) dst[n][k] = *(const LAS bf16x8*)(lds + PG8_SB(b, h) + boff + n * 2048 + k * 1024); } while (0)
#define PG8_MMA(ai, bj, At, Bt) do { __builtin_amdgcn_s_setprio(1); _Pragma("unroll") for (int m = 0; m < 4; ++m) _Pragma("unroll") for (int n = 0; n < 2; ++n) { \
        if constexpr (FP8) { const v8i_t b8 = __builtin_shufflevector(__builtin_bit_cast(v4i_t, Bt[n][0]), __builtin_bit_cast(v4i_t, Bt[n][1]), 0, 1, 2, 3, 4, 5, 6, 7), a8 = __builtin_shufflevector(__builtin_bit_cast(v4i_t, At[m][0]), __builtin_bit_cast(v4i_t, At[m][1]), 0, 1, 2, 3, 4, 5, 6, 7); \
            asm volatile("v_mfma_scale_f32_16x16x128_f8f6f4 %0, %1, %2, %0, %3, %4 op_sel_hi:[0,0,0]" : "+v"(acc[ai][bj][m][n]) : "v"(b8), "v"(a8), "v"(scw_v), "v"(sca_v)); } \
        else { _Pragma("unroll") for (int k = 0; k < 2; ++k) acc[ai][bj][m][n] = __builtin_amdgcn_mfma_f32_16x16x32_bf16(Bt[n][k], At[m][k], acc[ai][bj][m][n], 0, 0, 0); } } __builtin_amdgcn_s_setprio(0); } while (0)
#define PG8_WAIT_V(n) asm volatile("s_waitcnt vmcnt(" #n ")" ::: "memory")
#define PG8_WAIT_L(n) asm volatile("s_waitcnt lgkmcnt(" #n ")" ::: "memory")
#define PG8_BAR __builtin_amdgcn_s_barrier()
#define PG8_SCHED __builtin_amdgcn_sched_barrier(0)
    Unit cur, nxt, pend; int ui = 0; bool have_pend = false;
    if (!S.next(0, cur)) return;
    pend = cur;
    unsigned voC[2][2], voN[2][2];
    if constexpr (GATHER) {
#pragma unroll
        for (int h = 0; h < 2; ++h)
#pragma unroll
            for (int i = 0; i < 2; ++i) { voC[h][i] = (unsigned)(S.gather(cur, h * HALF + RA[i]) * ldab + CA[i] * 2); voN[h][i] = voC[h][i]; }
    } else { voC[0][0] = voN[0][0] = 0u; }
    f32x4 acc[2][2][4][2];
#pragma unroll
    for (int a = 0; a < 2; ++a)
#pragma unroll
        for (int b = 0; b < 2; ++b)
#pragma unroll
            for (int m = 0; m < 4; ++m)
#pragma unroll
                for (int n = 0; n < 2; ++n) acc[a][b][m][n] = (f32x4){0.f, 0.f, 0.f, 0.f};
    bf16x8 At[4][2], B0[2][2], B1[2][2];
    const char* cA = cur.A; const char* cB = cur.B;
    S.a_ready(cur, wid);
    PG8_STAGE_B(PG8_SB(0, 0), cB); PG8_STAGE_B(PG8_SB(0, 1), cB + hstepB); PG8_STAGE_A(PG8_SA(0, 0), cA, (size_t)0, 0, false); PG8_STAGE_A(PG8_SA(0, 1), cA, (size_t)0, 1, false);
    if (wr == 1) PG8_BAR;
    PG8_WAIT_V(2); PG8_BAR;
    PG8_STAGE_B(PG8_SB(1, 0), cB + kstep); PG8_STAGE_A(PG8_SA(1, 0), cA, kstep, 0, false); PG8_STAGE_B(PG8_SB(1, 1), cB + hstepB + kstep);
    PG8_WAIT_V(6); PG8_BAR;
    for (;;) {
        const bool has_next = S.next(ui + 1, nxt);
        if constexpr (GATHER) { if (has_next) {
#pragma unroll
            for (int h = 0; h < 2; ++h)
#pragma unroll
                for (int i = 0; i < 2; ++i) voN[h][i] = (unsigned)(S.gather(nxt, h * HALF + RA[i]) * ldab + CA[i] * 2); } }
        const char* nA = has_next ? nxt.A : cA; const char* nB = has_next ? nxt.B : cB;
        for (int t = 0; t < nt; t += 2) {
            const bool last = (t == nt - 2);
            const size_t k1 = (size_t)(t + 1) * kstep;
            const char* a2 = last ? nA : cA; const size_t k2 = last ? (size_t)0 : (size_t)(t + 2) * kstep; const size_t k3 = k2 + kstep;
            const char* b2 = last ? nB : cB + (size_t)(t + 2) * kstep; const char* b3 = b2 + kstep;
            const bool nx = GATHER ? (last && has_next) : false;
            if (last && has_next) S.a_ready(nxt, wid);
            PG8_LDB(B0, 0, 0); PG8_LDB(B1, 0, 1); PG8_SCHED; PG8_LDA(At, 0, 0); PG8_STAGE_A(PG8_SA(1, 1), cA, k1, 1, false);
            PG8_WAIT_V(8); PG8_WAIT_L(0); PG8_BAR; PG8_MMA(0, 0, At, B0); PG8_MMA(0, 1, At, B1); PG8_BAR; PG8_SCHED;
            PG8_LDA(At, 0, 1); PG8_STAGE_B(PG8_SB(0, 0), b2); PG8_STAGE_B(PG8_SB(0, 1), b2 + hstepB); PG8_STAGE_A(PG8_SA(0, 0), a2, k2, 0, nx);
            PG8_WAIT_V(8); PG8_WAIT_L(0);
            if constexpr (!Sched::IMM_DONE) { if (have_pend) { S.done(pend, lane); have_pend = false; } }
            PG8_BAR; PG8_MMA(1, 0, At, B0); PG8_MMA(1, 1, At, B1); PG8_BAR; PG8_SCHED;
            PG8_LDB(B0, 1, 0); PG8_LDB(B1, 1, 1); PG8_SCHED; PG8_LDA(At, 1, 0); PG8_STAGE_A(PG8_SA(0, 1), a2, k2, 1, nx);
            PG8_WAIT_V(8); PG8_WAIT_L(0); PG8_BAR; PG8_MMA(0, 0, At, B0); PG8_MMA(0, 1, At, B1); PG8_BAR; PG8_SCHED;
            PG8_LDA(At, 1, 1); PG8_STAGE_B(PG8_SB(1, 0), b3); PG8_STAGE_B(PG8_SB(1, 1), b3 + hstepB); PG8_STAGE_A(PG8_SA(1, 0), a2, k3, 0, nx);
            PG8_WAIT_V(8); PG8_WAIT_L(0); PG8_BAR; PG8_MMA(1, 0, At, B0); PG8_MMA(1, 1, At, B1); PG8_BAR; PG8_SCHED;
        }
        if (wr == 0) PG8_BAR;
        if constexpr (FP8) asm volatile("s_nop 15\n\ts_nop 15" ::: "memory");
        E(acc, cur, wr, wc, fr, fq);
        if constexpr (Sched::IMM_DONE) { PG8_WAIT_V(0); S.done(cur, lane); }
        else { pend = cur; have_pend = true; }
        if (!has_next) break;
#pragma unroll
        for (int a = 0; a < 2; ++a)
#pragma unroll
            for (int b = 0; b < 2; ++b)
#pragma unroll
                for (int m = 0; m < 4; ++m)
#pragma unroll
                    for (int n = 0; n < 2; ++n) acc[a][b][m][n] = (f32x4){0.f, 0.f, 0.f, 0.f};
        cur = nxt; cA = nA; cB = nB; ++ui;
        if constexpr (GATHER) {
#pragma unroll
            for (int h = 0; h < 2; ++h)
#pragma unroll
                for (int i = 0; i < 2; ++i) voC[h][i] = voN[h][i]; }
        if (wr == 1) PG8_BAR;
    }
    PG8_WAIT_V(0);
    if constexpr (!Sched::IMM_DONE) { if (have_pend) S.done(pend, lane); }
    PG8_BAR;
#undef PG8_SA
#undef PG8_SB
#undef PG8_GLDS
#undef PG8_STAGE_A
#undef PG8_STAGE_B
#undef PG8_LDA
#undef PG8_LDB
#undef PG8_MMA
#undef PG8_WAIT_V
#undef PG8_WAIT_L
#undef PG8_BAR
#undef PG8_SCHED
}
}
#include <hip/hip_bf16.h>
#include <cmath>
namespace attn_body {
using bf16=__hip_bfloat16;
using bf16x8=__attribute__((ext_vector_type(8)))short;
using s16x4=__attribute__((ext_vector_type(4)))short;
using f32x16=__attribute__((ext_vector_type(16)))float;
using u32x4=__attribute__((ext_vector_type(4)))unsigned;
constexpr int D=64,QP=1024,KVP=256;
constexpr int NW=8,QBLK=32,QB=QBLK*NW,KVBLK=64;
__device__ __forceinline__ int crow(int r,int hi){return (r&3)+8*(r>>2)+4*hi;}
#define SBAR() __builtin_amdgcn_sched_barrier(0)
constexpr int NSLOT=3, SLOTB=8192;
constexpr int LDS_K=0, LDS_V=NSLOT*SLOTB, LDS_WS=2*NSLOT*SLOTB, LDS_OST=LDS_WS+NW*64*4, LDS_BYTES=LDS_OST+NW*4096;
constexpr float C2=0.125f*1.4426950408889634f;
__device__ __forceinline__ void glds16s(const void*sbase,unsigned voff,unsigned lds_dst){unsigned keep;
  asm volatile("s_mov_b32 %0, m0\n\ts_mov_b32 m0, %3\n\ts_nop 4\n\tglobal_load_lds_dwordx4 %1, %2\n\ts_mov_b32 m0, %0":"=&s"(keep):"v"(voff),"s"(sbase),"s"(lds_dst):"memory");}
__device__ __forceinline__ float max3f(float a,float b,float c){float r;asm("v_max3_f32 %0, %1, %2, %3":"=v"(r):"v"(a),"v"(b),"v"(c));return r;}
__device__ __forceinline__ float max2f(float a,float b){float r;asm("v_max_f32_e32 %0, %1, %2":"=v"(r):"v"(a),"v"(b));return r;}
__device__ __forceinline__ float fadd_s(float a,float b){float r;asm("v_add_f32_e32 %0, %1, %2":"=v"(r):"v"(a),"v"(b));return r;}
__device__ __forceinline__ float fsub_s(float a,float b){float r;asm("v_sub_f32_e32 %0, %1, %2":"=v"(r):"v"(a),"v"(b));return r;}
typedef float f32x2_t __attribute__((ext_vector_type(2))); typedef __bf16 bf16x2_t __attribute__((ext_vector_type(2)));
__device__ __forceinline__ unsigned cvtpk_s(float lo,float hi){f32x2_t v={lo,hi};bf16x2_t b=__builtin_convertvector(v,bf16x2_t);return __builtin_bit_cast(unsigned,b);}
#define WAIT_BAR(N) asm volatile("s_waitcnt vmcnt(" #N ") lgkmcnt(0)\n\ts_barrier":::"memory")

__device__ __forceinline__ void qkt(f32x16&p0,f32x16&p1,const char*Kslot,const bf16x8*qr,const f32x16&negm,int r32,int hi){
  const char*kb=Kslot+hi*1024+r32*16;
  #pragma unroll
  for(int d0=0;d0<4;++d0){
    const bf16x8 b0=*reinterpret_cast<const bf16x8*>(kb+d0*2048);
    const bf16x8 b1=*reinterpret_cast<const bf16x8*>(kb+d0*2048+512);
    if(d0==0){p0=__builtin_amdgcn_mfma_f32_32x32x16_bf16(b0,qr[0],negm,0,0,0);p1=__builtin_amdgcn_mfma_f32_32x32x16_bf16(b1,qr[0],negm,0,0,0);}
    else{p0=__builtin_amdgcn_mfma_f32_32x32x16_bf16(b0,qr[d0],p0,0,0,0);p1=__builtin_amdgcn_mfma_f32_32x32x16_bf16(b1,qr[d0],p1,0,0,0);}}
}
typedef __attribute__((address_space(3))) const char* lds_cptr;
typedef short v4i16_t __attribute__((ext_vector_type(4)));
__device__ __forceinline__ void kload8(bf16x8*kf,lds_cptr kp){
  kf[0]=*(const __attribute__((address_space(3))) bf16x8*)(kp);      kf[1]=*(const __attribute__((address_space(3))) bf16x8*)(kp+512);
  kf[2]=*(const __attribute__((address_space(3))) bf16x8*)(kp+2048); kf[3]=*(const __attribute__((address_space(3))) bf16x8*)(kp+2560);
  kf[4]=*(const __attribute__((address_space(3))) bf16x8*)(kp+4096); kf[5]=*(const __attribute__((address_space(3))) bf16x8*)(kp+4608);
  kf[6]=*(const __attribute__((address_space(3))) bf16x8*)(kp+6144); kf[7]=*(const __attribute__((address_space(3))) bf16x8*)(kp+6656);
}
__device__ __forceinline__ void kload2(bf16x8*kf,lds_cptr kp,int j){ kf[2*j]=*(const __attribute__((address_space(3))) bf16x8*)(kp+j*2048); kf[2*j+1]=*(const __attribute__((address_space(3))) bf16x8*)(kp+j*2048+512); }
__device__ __forceinline__ s16x4 vtr(lds_cptr p){ return __builtin_bit_cast(s16x4,__builtin_amdgcn_ds_read_tr16_b64_v4i16((__attribute__((address_space(3))) v4i16_t*)p)); }
__device__ __forceinline__ float rowmax(const f32x16&p0,const f32x16&p1){
  float a=max3f(p0[0],p0[1],p1[0]),b=max3f(p0[2],p0[3],p1[1]);a=max3f(a,p1[2],p1[3]);
  #pragma unroll
  for(int r=4;r<16;r+=4){a=max3f(a,p0[r],p0[r+1]);b=max3f(b,p0[r+2],p0[r+3]);a=max3f(a,p1[r],p1[r+1]);b=max3f(b,p1[r+2],p1[r+3]);}
  const float m=max2f(a,b);
  auto rr=__builtin_amdgcn_permlane32_swap(__float_as_uint(m),__float_as_uint(m),false,false);
  return max2f(__uint_as_float(rr[0]),__uint_as_float(rr[1]));
}
__device__ __forceinline__ void pv(f32x16*o,int vb,bf16x8 pa0,bf16x8 pa1,bf16x8 pa2,bf16x8 pa3){
  #pragma unroll
  for(int d0=0;d0<2;++d0){s16x4 lo[4],hi[4];
    #pragma unroll
    for(int ks=0;ks<4;++ks){
      asm volatile("ds_read_b64_tr_b16 %0,%1 offset:%c2":"=&v"(lo[ks]):"v"(vb),"i"(d0*4096+ks*1024):"memory");
      asm volatile("ds_read_b64_tr_b16 %0,%1 offset:%c2":"=&v"(hi[ks]):"v"(vb),"i"(d0*4096+ks*1024+512):"memory");}
    asm volatile("s_waitcnt lgkmcnt(0)":::"memory");SBAR();
    #define PK(k) (bf16x8){lo[k][0],lo[k][1],lo[k][2],lo[k][3],hi[k][0],hi[k][1],hi[k][2],hi[k][3]}
    o[d0]=__builtin_amdgcn_mfma_f32_32x32x16_bf16(pa0,PK(0),o[d0],0,0,0);
    o[d0]=__builtin_amdgcn_mfma_f32_32x32x16_bf16(pa1,PK(1),o[d0],0,0,0);
    o[d0]=__builtin_amdgcn_mfma_f32_32x32x16_bf16(pa2,PK(2),o[d0],0,0,0);
    o[d0]=__builtin_amdgcn_mfma_f32_32x32x16_bf16(pa3,PK(3),o[d0],0,0,0);
    #undef PK
  }
}

#ifndef ATTN_STORE16
#define ATTN_STORE16(p,v) (*(u32x4*)(p)=(v))
#endif
template<int THRL> __device__ __forceinline__ void attn_unit(long qrow0,int h,long kvrow0,int NT,const bf16*Q,const bf16*__restrict__ K,const bf16*__restrict__ V,bf16*O,char*shm){
  const int tid=tid_opaque(),lane=tid&63,r32=lane&31,hi=lane>>5; const int wid=__builtin_amdgcn_readfirstlane(tid>>6);
  const bf16*Qw=Q+(qrow0+wid*QBLK)*QP+h*D;
  const bf16*Kh=K+kvrow0*KVP+(h>>2)*D,*Vh=V+kvrow0*KVP+(h>>2)*D;
  const unsigned lds0=(unsigned)(uintptr_t)shm;
  float*wsf=(float*)(shm+LDS_WS)+wid*64;
  const unsigned kvo=(unsigned)(lane*KVP+wid*8)*2u;
  const unsigned vvo=(unsigned)((16*(wid&3)+(lane>>2))*KVP+(wid>>2)*32+(lane&3)*8)*2u;
  const unsigned kdst=lds0+LDS_K+wid*1024, vdst=lds0+LDS_V+wid*1024;
  #define DMA_K(t,slot) glds16s(Kh+(long)(t)*KVBLK*KVP,kvo,(unsigned)__builtin_amdgcn_readfirstlane(kdst+(slot)))
  #define DMA_V(t,slot) glds16s(Vh+(long)(t)*KVBLK*KVP,vvo,(unsigned)__builtin_amdgcn_readfirstlane(vdst+(slot)))
  const int vb0=(int)(lds0+LDS_V)+((lane>>4)&1)*32+(lane&3)*8+(4*hi+((lane&15)>>2))*64;
  const char*Kbase=shm+LDS_K; bf16x8 kf[8];
  const lds_cptr shm3=(lds_cptr)shm; const lds_cptr kp0=shm3+LDS_K+hi*1024+r32*16; const lds_cptr vp0=shm3+LDS_V+((lane>>4)&1)*32+(lane&3)*8+(4*hi+((lane&15)>>2))*64;
  DMA_K(0,0);DMA_V(0,0);DMA_K(1,SLOTB);
  bf16x8 qr[4];
  #pragma unroll
  for(int d0=0;d0<4;++d0)qr[d0]=*reinterpret_cast<const bf16x8*>(&Qw[(long)r32*QP+d0*16+hi*8]);
  float mhat=0.f,l_reg=0.f;f32x16 o[2];o[0]=f32x16{};o[1]=f32x16{};f32x16 negm=f32x16{};asm volatile("":"+v"(negm));
  #define CMASK(P0,P1,t) do{}while(0)
  bool resc=false;
  #define START(P0,P1) do{ const float rm=rowmax(P0,P1); resc=false; \
    { const float dl=rm; mhat=fadd_s(mhat,dl); \
      _Pragma("unroll") for(int r=0;r<16;++r){P0[r]=fsub_s(P0[r],dl);P1[r]=fsub_s(P1[r],dl);} \
      _Pragma("unroll") for(int r=0;r<16;++r)negm[r]=-mhat; asm volatile("":"+v"(negm)); } \
    _Pragma("unroll") for(int r=0;r<16;++r)P0[r]=__builtin_amdgcn_exp2f(P0[r]); }while(0)
  #define RESC() do{ if(resc){ asm volatile("s_waitcnt lgkmcnt(0)":::"memory"); \
      _Pragma("unroll") for(int d_=0;d_<2;++d_) _Pragma("unroll") for(int r=0;r<16;++r)o[d_][r]*=wsf[crow(r,hi)]; } }while(0)
  f32x16 pA0,pA1,pB0,pB1;
  int sl_prev=0,sl_cur=0,sl_next=SLOTB;
  #define ROT() do{sl_prev=sl_cur;sl_cur=sl_next;sl_next=(sl_next==(NSLOT-1)*SLOTB)?0:sl_next+SLOTB;}while(0)
  DMA_K(2,2*SLOTB);
  WAIT_BAR(3);
  qkt(pA0,pA1,Kbase,qr,negm,r32,hi);asm volatile("s_nop 15\n\ts_nop 7":"+v"(pA0),"+v"(pA1));CMASK(pA0,pA1,0);
  START(pA0,pA1);
  _Pragma("unroll") for(int r=0;r<16;++r)pA1[r]=__builtin_amdgcn_exp2f(pA1[r]);
  WAIT_BAR(0);
  DMA_K(3,0);DMA_V(1,SLOTB);
  ROT();
  kload8(kf,kp0+sl_cur);
  WAIT_BAR(2);
  s16x4 vlo[8],vhi[8]; u32x4 pw0,pw1,pw2,pw3;
  #define PKW(P,B) cvtpk_s(P[B],P[B+1])
  #define PAF(k) __builtin_bit_cast(bf16x8,pw##k)
  #define VFR(i) (bf16x8){vlo[i][0],vlo[i][1],vlo[i][2],vlo[i][3],vhi[i][0],vhi[i][1],vhi[i][2],vhi[i][3]}
  #define PIN(x) asm volatile("":"+v"(x))
  #define MX3(a,b,c) __builtin_fmaxf(__builtin_fmaxf((a),(b)),(c))
  #define GAPA(MF,A0,A1,A2,A3,W0,W1,PW) do{ MF; sacc+=A0; sacc+=A1; sacc+=A2; sacc+=A3; PIN(sacc); W0; W1; PIN(PW); SBAR(); }while(0)
  #define EX(v) __builtin_amdgcn_exp2f(v)
  #define GAPB(MF,X,B) do{ MF; X[B]=EX(X[B]); X[B+1]=EX(X[B+1]); X[B+2]=EX(X[B+2]); X[B+3]=EX(X[B+3]); PIN(X); SBAR(); }while(0)
  #define VRD(i) do{ vlo[i]=vtr(vp_+(((i)>>2)*4096+((i)&3)*1024)); vhi[i]=vtr(vp_+(((i)>>2)*4096+((i)&3)*1024+512)); }while(0)
  #define KRD(G,j) do{ if(G){ kload2(kf,kp0+sl_next,j); SBAR(); } }while(0)
  #define STEP(C0,C1,P0,P1,t,GK,GV,GL) do{ SBAR(); \
    const lds_cptr vp_=vp0+sl_prev; \
    VRD(0); SBAR(); float sacc=(P0[0]+P0[1]); \
    GAPA(C0=__builtin_amdgcn_mfma_f32_32x32x16_bf16(kf[0],qr[0],negm,0,0,0), P0[2],P0[3],P0[4],P0[5],     pw0[0]=PKW(P0,0), pw0[1]=PKW(P0,2), pw0); \
    VRD(4); SBAR(); GAPA(C1=__builtin_amdgcn_mfma_f32_32x32x16_bf16(kf[1],qr[0],negm,0,0,0), P0[6],P0[7],P0[8],P0[9],     pw0[2]=PKW(P0,4), pw0[3]=PKW(P0,6), pw0); \
    VRD(1); SBAR(); GAPA(C0=__builtin_amdgcn_mfma_f32_32x32x16_bf16(kf[2],qr[1],C0,0,0,0),   P0[10],P0[11],P0[12],P0[13], pw1[0]=PKW(P0,8), pw1[1]=PKW(P0,10), pw1); \
    VRD(5); SBAR(); GAPA(C1=__builtin_amdgcn_mfma_f32_32x32x16_bf16(kf[3],qr[1],C1,0,0,0),   P0[14],P0[15],P1[0],P1[1],   pw1[2]=PKW(P0,12),pw1[3]=PKW(P0,14), pw1); \
    VRD(2); SBAR(); GAPA(C0=__builtin_amdgcn_mfma_f32_32x32x16_bf16(kf[4],qr[2],C0,0,0,0),   P1[2],P1[3],P1[4],P1[5],     pw2[0]=PKW(P1,0), pw2[1]=PKW(P1,2), pw2); \
    VRD(6); SBAR(); GAPA(C1=__builtin_amdgcn_mfma_f32_32x32x16_bf16(kf[5],qr[2],C1,0,0,0),   P1[6],P1[7],P1[8],P1[9],     pw2[2]=PKW(P1,4), pw2[3]=PKW(P1,6), pw2); \
    VRD(3); SBAR(); GAPA(C0=__builtin_amdgcn_mfma_f32_32x32x16_bf16(kf[6],qr[3],C0,0,0,0),   P1[10],P1[11],P1[12],P1[13], pw3[0]=PKW(P1,8), pw3[1]=PKW(P1,10), pw3); \
    VRD(7); SBAR(); GAPA(C1=__builtin_amdgcn_mfma_f32_32x32x16_bf16(kf[7],qr[3],C1,0,0,0),   P1[14],P1[15],0.f,0.f,       pw3[2]=PKW(P1,12),pw3[3]=PKW(P1,14), pw3); \
    l_reg+=sacc; \
    if(GK){DMA_K((t)+3,sl_cur);} if(GV){DMA_V((t)+1,sl_next);} \
    CMASK(C0,C1,t); \
    { float a=MX3(C0[0],C0[1],C1[0]),b=MX3(C0[2],C0[3],C1[1]); a=MX3(a,C1[2],C1[3]); \
      _Pragma("unroll") for(int r=4;r<16;r+=4){a=MX3(a,C0[r],C0[r+1]);b=MX3(b,C0[r+2],C0[r+3]);a=MX3(a,C1[r],C1[r+1]);b=MX3(b,C1[r+2],C1[r+3]);} \
      float rm=__builtin_fmaxf(a,b); { auto rr=__builtin_amdgcn_permlane32_swap(__float_as_uint(rm),__float_as_uint(rm),false,false); rm=__builtin_fmaxf(__uint_as_float(rr[0]),__uint_as_float(rr[1])); } \
      resc=false; \
      if(__builtin_expect(__any(rm>(float)THRL),0)){ const float dl=__builtin_fmaxf(rm,0.f); mhat+=dl; \
        _Pragma("unroll") for(int r=0;r<16;++r){C0[r]-=dl;C1[r]-=dl;} \
        _Pragma("unroll") for(int r=0;r<16;++r)negm[r]=-mhat; asm volatile("":"+v"(negm)); \
        const float f=__builtin_amdgcn_exp2f(-dl); l_reg*=f; if(hi==0)wsf[r32]=f; resc=true; } } \
    SBAR(); \
    GAPB(o[0]=__builtin_amdgcn_mfma_f32_32x32x16_bf16(PAF(0),VFR(0),o[0],0,0,0), C0,0); \
    GAPB(o[1]=__builtin_amdgcn_mfma_f32_32x32x16_bf16(PAF(0),VFR(4),o[1],0,0,0), C0,4); \
    KRD(GL,0); GAPB(o[0]=__builtin_amdgcn_mfma_f32_32x32x16_bf16(PAF(1),VFR(1),o[0],0,0,0), C0,8); \
    KRD(GL,1); GAPB(o[1]=__builtin_amdgcn_mfma_f32_32x32x16_bf16(PAF(1),VFR(5),o[1],0,0,0), C0,12); \
    KRD(GL,2); GAPB(o[0]=__builtin_amdgcn_mfma_f32_32x32x16_bf16(PAF(2),VFR(2),o[0],0,0,0), C1,0); \
    KRD(GL,3); GAPB(o[1]=__builtin_amdgcn_mfma_f32_32x32x16_bf16(PAF(2),VFR(6),o[1],0,0,0), C1,4); \
    GAPB(o[0]=__builtin_amdgcn_mfma_f32_32x32x16_bf16(PAF(3),VFR(3),o[0],0,0,0), C1,8); \
    GAPB(o[1]=__builtin_amdgcn_mfma_f32_32x32x16_bf16(PAF(3),VFR(7),o[1],0,0,0), C1,12); \
    }while(0)
  int t=1;
  for(;t+5<NT;t+=2){
    STEP(pB0,pB1,pA0,pA1,t,true,true,true);     WAIT_BAR(2); RESC(); ROT();
    STEP(pA0,pA1,pB0,pB1,t+1,true,true,true);   WAIT_BAR(2); RESC(); ROT();
  }
  #define ENDW(tt) do{ if((tt)+3<NT){WAIT_BAR(2);} else if((tt)+2<NT){WAIT_BAR(1);} else {WAIT_BAR(0);} }while(0)
  for(;t+1<NT;t+=2){
    STEP(pB0,pB1,pA0,pA1,t,(t+3<NT),(t+1<NT),(t+1<NT));       ENDW(t);   RESC(); ROT();
    STEP(pA0,pA1,pB0,pB1,t+1,(t+4<NT),(t+2<NT),(t+2<NT));     ENDW(t+1); RESC(); ROT();
  }
  STEP(pB0,pB1,pA0,pA1,NT-1,false,false,false); RESC();
  { float sacc=pB0[0]+pB0[1]; _Pragma("unroll") for(int r=2;r<16;++r)sacc+=pB0[r]; _Pragma("unroll") for(int r=0;r<16;++r)sacc+=pB1[r]; l_reg+=sacc;
    pw0=(u32x4){PKW(pB0,0),PKW(pB0,2),PKW(pB0,4),PKW(pB0,6)};pw1=(u32x4){PKW(pB0,8),PKW(pB0,10),PKW(pB0,12),PKW(pB0,14)};pw2=(u32x4){PKW(pB1,0),PKW(pB1,2),PKW(pB1,4),PKW(pB1,6)};pw3=(u32x4){PKW(pB1,8),PKW(pB1,10),PKW(pB1,12),PKW(pB1,14)};
    SBAR(); pv(o,vb0+sl_cur,PAF(0),PAF(1),PAF(2),PAF(3)); }
  #undef PKW
  #undef PAF
  #undef VFR
  #undef PIN
  #undef MX3
  #undef GAPA
  #undef GAPB
  #undef EX
  #undef VRD
  #undef KRD
  #undef STEP
  #undef ENDW
  {auto rr=__builtin_amdgcn_permlane32_swap(__float_as_uint(l_reg),__float_as_uint(l_reg),false,false);l_reg=__uint_as_float(rr[0])+__uint_as_float(rr[1]);}
  if(hi==0)wsf[32+r32]=l_reg;asm volatile("s_waitcnt lgkmcnt(0)":::"memory");
  float rli[16];
  #pragma unroll
  for(int r=0;r<16;++r)rli[r]=__builtin_amdgcn_rcpf(wsf[32+crow(r,hi)]);
#if ATT_FP8
  { unsigned char*Ow8=(unsigned char*)O+(qrow0+wid*QBLK)*QP+h*D;
    unsigned char*stg8=(unsigned char*)(shm+LDS_OST)+wid*4096;
    #pragma unroll
    for(int r=0;r<16;++r){const int orow=crow(r,hi);
      #pragma unroll
      for(int d0=0;d0<2;++d0){const float x=o[d0][r]*rli[r]*(float)(1<<ATT_OSH); stg8[orow*64+d0*32+r32]=(unsigned char)(__builtin_amdgcn_cvt_pk_fp8_f32(x,x,0u,false)&0xffu);}}
    asm volatile("s_waitcnt lgkmcnt(0)":::"memory");
    #pragma unroll
    for(int i=0;i<2;++i){const int row=i*16+(lane>>2),ch=lane&3; const u32x4 v=*(const u32x4*)(stg8+row*64+ch*16); ATTN_STORE16(Ow8+(long)row*QP+ch*16,v);} }
#else
  bf16*Ow=O+(qrow0+wid*QBLK)*QP+h*D;
  { bf16*stg=(bf16*)(shm+LDS_OST)+wid*2048;
    #pragma unroll
    for(int r=0;r<16;++r){const int orow=crow(r,hi);
      #pragma unroll
      for(int d0=0;d0<2;++d0)stg[orow*64+d0*32+r32]=__float2bfloat16(o[d0][r]*rli[r]);}
    asm volatile("s_waitcnt lgkmcnt(0)":::"memory");
    #pragma unroll
    for(int i=0;i<4;++i){const int row=i*8+(lane>>3),ch=lane&7; const u32x4 v=*(const u32x4*)(stg+row*64+ch*8); ATTN_STORE16(Ow+(long)row*QP+ch*8,v);} }
#endif
  asm volatile("s_waitcnt lgkmcnt(0)\n\ts_barrier":::"memory");
  #undef DMA_K
  #undef DMA_V
  #undef CMASK
  #undef START
  #undef RESC
  #undef ROT
}
constexpr int ATTN_LDS_BYTES=LDS_BYTES;
#undef SBAR
#undef WAIT_BAR
}

typedef f32x4 AccT[2][2][4][2];
__device__ __forceinline__ long kv_row(int r) { return r < TL ? (long)(r / SEQ) * KVROWS + CTXL + (r % SEQ) : (long)((r - TL) / CTXL) * KVROWS + ((r - TL) % CTXL); }

struct SchedDense {
    static constexpr bool IMM_DONE = false;
    const char* A; const char* B; size_t astep, bstep, acol; int nM, nN, G, c;
    __device__ __forceinline__ bool next(int i, pg8::Unit& u) const {
        const int L = i * G + c; if (L >= nM * nN) return false;
        pg8::tile_of(L, nM, nN, u.pm, u.pn); u.A = A + (size_t)u.pm * astep + (size_t)u.pn * acol; u.B = B + (size_t)u.pn * bstep; u.x0 = 0; u.x1 = 0; return true; }
    __device__ __forceinline__ int gather(const pg8::Unit&, int) const { return 0; }
    __device__ __forceinline__ void a_ready(const pg8::Unit&, int) const {}
    __device__ __forceinline__ void done(const pg8::Unit&, int) const {}
};
struct SchedDenseR {
    static constexpr bool IMM_DONE = true;
    const char* A; const char* B; size_t astep, bstep, acol; int nM, nN, nF, G, c; unsigned* ready;
    __device__ __forceinline__ bool next(int i, pg8::Unit& u) const {
        const int L = i * G + c, n1 = nF * nN; if (L >= nM * nN) return false;
        if (L < n1) pg8::tile_of(L, nF, nN, u.pm, u.pn); else { u.pm = nF + (L - n1) / nN; u.pn = (L - n1) % nN; }
        u.A = A + (size_t)u.pm * astep + (size_t)u.pn * acol; u.B = B + (size_t)u.pn * bstep; u.x0 = 0; u.x1 = 0; return true; }
    __device__ __forceinline__ int gather(const pg8::Unit&, int) const { return 0; }
    __device__ __forceinline__ void a_ready(const pg8::Unit&, int) const {}
    __device__ __forceinline__ void done(const pg8::Unit& u, int lane) const { if (lane == 0) __hip_atomic_fetch_add(ready + u.pm, 1u, __ATOMIC_RELAXED, __HIP_MEMORY_SCOPE_AGENT); }
};
struct SchedOutproj {
    static constexpr bool IMM_DONE = true;
    const char* A; const char* B; size_t astep, bstep; int G, c; const unsigned* rdg; unsigned* ready;
    __device__ __forceinline__ bool next(int i, pg8::Unit& u) const {
        int n;
        if (G == 256) { if (c >= 32) { if (i == 0) n = c - 32; else if (i == 1 && c < 64) n = 224 + (c - 32); else return false; } else { if (i == 0 && c < 16) n = 256 + c; else return false; } }
        else { n = i * G + c; if (n >= 272) return false; }
        u.pm = n >> 2; u.pn = n & 3; u.A = A + (size_t)u.pm * astep; u.B = B + (size_t)u.pn * bstep; u.x0 = 0; u.x1 = 0; return true; }
    __device__ __forceinline__ int gather(const pg8::Unit&, int) const { return 0; }
    __device__ __forceinline__ void a_ready(const pg8::Unit& u, int wid) const {
        if (wid == 0) { unsigned sp = 0;
            while ((unsigned)__builtin_amdgcn_readfirstlane(__hip_atomic_load(rdg + u.pm, __ATOMIC_RELAXED, __HIP_MEMORY_SCOPE_AGENT)) < 8u) { __builtin_amdgcn_s_sleep(2); if (++sp > (1u << 22)) break; }
            __builtin_amdgcn_fence(__ATOMIC_ACQUIRE, "agent"); asm volatile("s_waitcnt vmcnt(0)" ::: "memory"); }
        __builtin_amdgcn_s_barrier(); asm volatile("" ::: "memory");
    }
    __device__ __forceinline__ void done(const pg8::Unit& u, int lane) const { if (lane == 0) __hip_atomic_fetch_add(ready + u.pm, 1u, __ATOMIC_RELAXED, __HIP_MEMORY_SCOPE_AGENT); }
};
struct SchedQKV {
    static constexpr bool IMM_DONE = false;
    const char* A; const char* B; size_t tstep; int ctxq, G, c;
    __device__ __forceinline__ bool next(int i, pg8::Unit& u) const {
        const int L = i * G + c, n1 = 64 * 6, n2 = ctxq ? 24 : 8; if (L >= n1 + n2) return false;
        if (L < n1) pg8::tile_of(L, 64, 6, u.pm, u.pn);
        else if (ctxq) { pg8::tile_of(L - n1, 4, 6, u.pm, u.pn); u.pm += 64; }
        else { u.pm = 64 + ((L - n1) >> 1); u.pn = 4 + ((L - n1) & 1); }
        u.A = A + (size_t)u.pm * tstep; u.B = B + (size_t)u.pn * tstep; u.x0 = 0; u.x1 = 0; return true; }
    __device__ __forceinline__ int gather(const pg8::Unit&, int) const { return 0; }
    __device__ __forceinline__ void a_ready(const pg8::Unit&, int) const {}
    __device__ __forceinline__ void done(const pg8::Unit&, int) const {}
};
struct SchedMoe {
    static constexpr bool IMM_DONE = false;
    const char* Abase; size_t astep; const char* Bbase; size_t bstep_e, bstep_n; const LAS int* tab; const int* list; int G, c;
    unsigned* ready; int mode;
    __device__ __forceinline__ int T(int i) const { return __builtin_amdgcn_readfirstlane(tab[i]); }
    __device__ __forceinline__ bool next(int i, pg8::Unit& u) const {
        const int ntiles = T(32); int gt, pn;
        if (G == 256) {
            const int x = c & 7, j = c >> 3, g = (mode == 2 ? 7 - x : x) + 8 * i, fm = 8 * g; if (fm >= ntiles) return false;
            const int gsz = (ntiles - fm) < 8 ? (ntiles - fm) : 8; if (j >= 4 * gsz) return false;
            gt = fm + j % gsz; pn = j / gsz; }
        else { const int L = i * G + (mode == 2 ? G - 1 - c : c); if (L >= ntiles * 4) return false; pg8::tile_of(L, ntiles, 4, gt, pn); }
        int e = 0;
        for (int q = 1; q < 32; ++q) e += (T(q) <= gt) ? 1 : 0;
        const int ti = gt - T(e); int valid = T(40 + e) - ti * 256; valid = valid > 256 ? 256 : valid;
        u.pm = gt; u.pn = pn; u.x0 = e * MOE_CAP + ti * 256; u.x1 = valid;
        u.A = Abase + (size_t)gt * astep; u.B = Bbase + (size_t)e * bstep_e + (size_t)pn * bstep_n; return true; }
    __device__ __forceinline__ int gather(const pg8::Unit& u, int lr) const { return lr < u.x1 ? (list[u.x0 + lr] >> 1) : 0; }
    __device__ __forceinline__ void a_ready(const pg8::Unit& u, int wid) const {
        if (mode != 2) return;
        if (wid == 0) { unsigned sp = 0;
            while ((unsigned)__builtin_amdgcn_readfirstlane(__hip_atomic_load(ready + u.pm, __ATOMIC_RELAXED, __HIP_MEMORY_SCOPE_AGENT)) < 32u) { __builtin_amdgcn_s_sleep(2); if (++sp > (1u << 22)) break; }
            __builtin_amdgcn_fence(__ATOMIC_ACQUIRE, "agent"); asm volatile("s_waitcnt vmcnt(0)" ::: "memory"); }
        __builtin_amdgcn_s_barrier(); asm volatile("" ::: "memory");
    }
    __device__ __forceinline__ void done(const pg8::Unit& u, int lane) const {
        if (mode != 1) return;
        if (lane == 0) __hip_atomic_fetch_add(ready + u.pm, 1u, __ATOMIC_RELAXED, __HIP_MEMORY_SCOPE_AGENT);
    }
};

struct EpiQKV { static constexpr bool PERM = true; bf16* Q; bf16* Kb; bf16* Vb; const float* qg; const float* kg; const f32x2* tab;
    __device__ __forceinline__ void operator()(const AccT& acc, const pg8::Unit& u, int wr, int wc, int fr, int fq) const {
        bf16* base; int pitch; long row0;
        if (u.pn < 4) { base = Q + u.pn * 256; pitch = 1024; row0 = (long)u.pm * 256; }
        else { base = (u.pn == 4) ? Kb : Vb; pitch = 256; row0 = kv_row(u.pm * 256); }
        const bool isv = u.pn == 5, lat = u.pm < 64; const float* g = u.pn < 4 ? qg : kg; const float post = u.pn < 4 ? 0.125f * 1.4426950408889634f : 1.0f;
#pragma unroll
        for (int ai = 0; ai < 2; ++ai)
#pragma unroll
            for (int m = 0; m < 4; ++m) { int fq_ = fq; asm volatile("" : "+v"(fq_));
                const int fq = fq_; const int lr = ai * 128 + wr * 64 + m * 16 + fr; const unsigned roff = (unsigned)(((int)row0 + lr) * pitch + wc * 64 + 8 * fq) * 2u;
                f32x4 g0[2], g1[2];
#pragma unroll
                for (int bj = 0; bj < 2; ++bj) { g0[bj] = *(const f32x4*)(g + 32 * bj + 8 * fq); g1[bj] = *(const f32x4*)(g + 32 * bj + 8 * fq + 4); }
                f32x4 v[2][2];
#pragma unroll
                for (int bj = 0; bj < 2; ++bj) { v[bj][0] = acc[ai][bj][m][0]; v[bj][1] = acc[ai][bj][m][1]; }
                if (!isv) {
                    float ss = 0.f;
#pragma unroll
                    for (int bj = 0; bj < 2; ++bj)
#pragma unroll
                        for (int n = 0; n < 2; ++n) ss += (v[bj][n][0] * v[bj][n][0] + v[bj][n][1] * v[bj][n][1]) + (v[bj][n][2] * v[bj][n][2] + v[bj][n][3] * v[bj][n][3]);
                    ss += __shfl_xor(ss, 16); ss += __shfl_xor(ss, 32);
                    const float rstd = rsqrtf(ss * (1.0f / 64.0f) + EPS);
#pragma unroll
                    for (int bj = 0; bj < 2; ++bj) { v[bj][0] = v[bj][0] * rstd * g0[bj]; v[bj][1] = v[bj][1] * rstd * g1[bj]; }
                    if (lat) { const int t = (u.pm * 256 + lr) & (SEQ - 1);
#pragma unroll
                        for (int bj = 0; bj < 2; ++bj) { const f32x2* tb = (const f32x2*)((const char*)tab + (unsigned)(((bj == 0 ? (t >> 6) : (t & 63)) * 16 + 4 * fq) * 8));
#pragma unroll
                            for (int n = 0; n < 2; ++n)
#pragma unroll
                                for (int e = 0; e < 2; ++e) { const f32x2 cs = tb[2 * n + e]; const float x0 = v[bj][n][2 * e], x1 = v[bj][n][2 * e + 1];
                                    v[bj][n][2 * e] = x0 * cs.x - x1 * cs.y; v[bj][n][2 * e + 1] = x0 * cs.y + x1 * cs.x; } } }
#pragma unroll
                    for (int bj = 0; bj < 2; ++bj) { v[bj][0] = v[bj][0] * post; v[bj][1] = v[bj][1] * post; }
                }
#pragma unroll
                for (int bj = 0; bj < 2; ++bj)
                    *(u32x4*)((char*)base + roff + bj * 64) = (u32x4){cvtpk(v[bj][0][0], v[bj][0][1]), cvtpk(v[bj][0][2], v[bj][0][3]), cvtpk(v[bj][1][0], v[bj][1][1]), cvtpk(v[bj][1][2], v[bj][1][3])}; }
    }
};
template <bool PERM_> struct EpiResidT { static constexpr bool PERM = PERM_; const Args* a; int layer; const float* pscale; const bf16* srcbase;
    __device__ __forceinline__ void operator()(const AccT& acc, const pg8::Unit& u, int wr, int wc, int, int) const {
        int ln; asm volatile("v_mbcnt_lo_u32_b32 %0, -1, 0\n\tv_mbcnt_hi_u32_b32 %0, -1, %0" : "=v"(ln)); const int fr = ln & 15, fq = ln >> 4;
        const int r0 = u.pm * 256;
        const float* gate = mod_row(*a, layer, r0) + 2 * D;
        const bool f32src = (layer == 0) && !srcbase; const float* src32 = resid_row(*a, 0, r0); const bf16* src16 = (srcbase ? srcbase : (const bf16*)(a->ws + WS_X)) + (size_t)r0 * D;
        const __amdgpu_buffer_rsrc_t rs = __builtin_amdgcn_make_buffer_rsrc((void*)(a->ws + WS_X), 0, TT * D * 2, 0x00020000);
        if constexpr (PERM_) {
#pragma unroll
        for (int bj = 0; bj < 2; ++bj) { const int cc = u.pn * 256 + bj * 128 + wc * 32 + 8 * fq;
            f32x4 g0 = *(const f32x4*)(gate + cc), g1 = *(const f32x4*)(gate + cc + 4); if (pscale) { g0 = g0 * *(const f32x4*)(pscale + cc); g1 = g1 * *(const f32x4*)(pscale + cc + 4); }
#pragma unroll
            for (int ai = 0; ai < 2; ++ai)
#pragma unroll
                for (int m = 0; m < 4; ++m) { const int off = (ai * 128 + wr * 64 + m * 16 + fr) * D + cc;
                    f32x4 s0, s1;
                    if (f32src) { s0 = *(const f32x4*)(src32 + off); s1 = *(const f32x4*)(src32 + off + 4); }
                    else { const u32x4 p = *(const u32x4*)(src16 + off); s0 = (f32x4){bflo(p.x), bfhi(p.x), bflo(p.y), bfhi(p.y)}; s1 = (f32x4){bflo(p.z), bfhi(p.z), bflo(p.w), bfhi(p.w)}; }
                    const f32x4 o0 = s0 + g0 * acc[ai][bj][m][0], o1 = s1 + g1 * acc[ai][bj][m][1];
                    __builtin_amdgcn_raw_buffer_store_b128((u32x4){cvtpk(o0.x, o0.y), cvtpk(o0.z, o0.w), cvtpk(o1.x, o1.y), cvtpk(o1.z, o1.w)}, rs, (r0 * D + off) * 2, 0, 16  ); }
            asm volatile("" ::: "memory"); }
        } else {
#pragma unroll
        for (int bj = 0; bj < 2; ++bj)
#pragma unroll
            for (int n = 0; n < 2; ++n) { const int cc = u.pn * 256 + bj * 128 + wc * 32 + n * 16 + 4 * fq; f32x4 g = *(const f32x4*)(gate + cc); if (pscale) g = g * *(const f32x4*)(pscale + cc);
#pragma unroll
                for (int ai = 0; ai < 2; ++ai)
#pragma unroll
                    for (int m = 0; m < 4; ++m) { const int off = (ai * 128 + wr * 64 + m * 16 + fr) * D + cc;
                        f32x4 s0;
                        if (f32src) s0 = *(const f32x4*)(src32 + off);
                        else { const u32x2 p = *(const u32x2*)(src16 + off); s0 = (f32x4){bflo(p.x), bfhi(p.x), bflo(p.y), bfhi(p.y)}; }
                        const f32x4 o0 = s0 + g * acc[ai][bj][m][n];
                        __builtin_amdgcn_raw_buffer_store_b64((u32x2){cvtpk(o0.x, o0.y), cvtpk(o0.z, o0.w)}, rs, (r0 * D + off) * 2, 0, 16  ); }
                asm volatile("" ::: "memory"); }
        }
    }
};
typedef EpiResidT<true> EpiResid; typedef EpiResidT<false> EpiResidN;
struct EpiGateUp { static constexpr bool PERM = true; bf16* act;
    __device__ __forceinline__ void operator()(const AccT& acc, const pg8::Unit& u, int wr, int wc, int fr, int fq) const {
        const __amdgpu_buffer_rsrc_t rs = __builtin_amdgcn_make_buffer_rsrc((void*)act, 0, 43008 * 512 * 2, 0x00020000);
#pragma unroll
        for (int ai = 0; ai < 2; ++ai)
#pragma unroll
            for (int m = 0; m < 4; ++m) { const int off = (int)((((size_t)u.pm * 256 + ai * 128 + wr * 64 + m * 16 + fr) * 512 + u.pn * 128 + wc * 32 + 8 * fq) * 2);
                const f32x4 g0 = acc[ai][0][m][0], g1 = acc[ai][0][m][1], u0 = acc[ai][1][m][0], u1 = acc[ai][1][m][1];
                const u32x4 ov = (u32x4){cvtpk(silu_f(g0[0]) * u0[0], silu_f(g0[1]) * u0[1]), cvtpk(silu_f(g0[2]) * u0[2], silu_f(g0[3]) * u0[3]),
                                     cvtpk(silu_f(g1[0]) * u1[0], silu_f(g1[1]) * u1[1]), cvtpk(silu_f(g1[2]) * u1[2], silu_f(g1[3]) * u1[3])};
#if MOE_FP8
                { const float sa = (float)(1 << MOE_ASH); const u32x2 o8 = (u32x2){pk_fp8x4(silu_f(g0[0]) * u0[0] * sa, silu_f(g0[1]) * u0[1] * sa, silu_f(g0[2]) * u0[2] * sa, silu_f(g0[3]) * u0[3] * sa),
                                                                                    pk_fp8x4(silu_f(g1[0]) * u1[0] * sa, silu_f(g1[1]) * u1[1] * sa, silu_f(g1[2]) * u1[2] * sa, silu_f(g1[3]) * u1[3] * sa)};
                  (void)ov; __builtin_amdgcn_raw_buffer_store_b64(o8, rs, off >> 1, 0, 16  ); } }
#else
                __builtin_amdgcn_raw_buffer_store_b128(ov, rs, off, 0, 16  ); }
#endif
    }
};
struct EpiDown { static constexpr bool PERM = true; const int* list; const float* w2; bf16* y2;
    __device__ __forceinline__ void operator()(const AccT& acc, const pg8::Unit& u, int wr, int wc, int fr, int fq) const {
#pragma unroll
        for (int ai = 0; ai < 2; ++ai)
#pragma unroll
            for (int m = 0; m < 4; ++m) { const int lr = ai * 128 + wr * 64 + m * 16 + fr;
                if (lr < u.x1) { const int dest = list[u.x0 + lr]; const float w = w2[dest]; bf16* p = y2 + (size_t)dest * D + u.pn * 256 + wc * 32 + 8 * fq;
#pragma unroll
                    for (int bj = 0; bj < 2; ++bj) { const f32x4 v0 = acc[ai][bj][m][0] * w, v1 = acc[ai][bj][m][1] * w;
                        *(u32x4*)(p + bj * 128) = (u32x4){cvtpk(v0[0], v0[1]), cvtpk(v0[2], v0[3]), cvtpk(v1[0], v1[1]), cvtpk(v1[2], v1[3])}; } } }
    }
};

constexpr int TAB_OFF = 135168;

__device__ __forceinline__ void ph_rope(const Args& a, const Ctx& c, int layer) {
    const int j = layer == 0 ? 0 : 1; const bool ctxq = layer == 0;
    const float* qg = a.in[I_QG] + j * 64; const float* kg = a.in[I_KG] + j * 64;
    const f32x2* tab = (const f32x2*)(a.ws + WS_ROPE);
    bf16* Qb = (bf16*)(a.ws + WS_Q); bf16* Kb = (bf16*)(a.ws + WS_K);
    const int nitems = TT * 20;
    for (int it = blockIdx.x * NTHREADS + c.tid; it < nitems; it += c.G * NTHREADS) {
        const int r = it / 20, hs = it % 20;
        if (hs < 16 && r >= TL && !ctxq) continue;
        bf16* p; const float* g; float post;
        if (hs < 16) { p = Qb + (size_t)r * 1024 + hs * 64; g = qg; post = 0.125f * 1.4426950408889634f; } else { p = Kb + kv_row(r) * 256 + (hs - 16) * 64; g = kg; post = 1.0f; }
        float x[64]; float ss = 0.f;
#pragma unroll
        for (int i = 0; i < 8; ++i) { const u32x4 w = ((const u32x4*)p)[i];
            x[8 * i + 0] = bflo(w.x); x[8 * i + 1] = bfhi(w.x); x[8 * i + 2] = bflo(w.y); x[8 * i + 3] = bfhi(w.y);
            x[8 * i + 4] = bflo(w.z); x[8 * i + 5] = bfhi(w.z); x[8 * i + 6] = bflo(w.w); x[8 * i + 7] = bfhi(w.w); }
#pragma unroll
        for (int i = 0; i < 64; ++i) ss += x[i] * x[i];
        const float rstd = rsqrtf(ss * (1.0f / 64.0f) + EPS);
#pragma unroll
        for (int i = 0; i < 64; ++i) x[i] = x[i] * rstd * g[i];
        if (r < TL) { const int t = r % SEQ, rp = t >> 6, cp = t & 63;
#pragma unroll
            for (int i = 0; i < 32; ++i) { const f32x2 cs = tab[(i < 16 ? rp : cp) * 16 + (i & 15)]; const float x0 = x[2 * i], x1 = x[2 * i + 1];
                x[2 * i] = x0 * cs.x - x1 * cs.y; x[2 * i + 1] = x0 * cs.y + x1 * cs.x; } }
#pragma unroll
        for (int i = 0; i < 8; ++i) ((u32x4*)p)[i] = (u32x4){cvtpk(x[8 * i] * post, x[8 * i + 1] * post), cvtpk(x[8 * i + 2] * post, x[8 * i + 3] * post),
                                                            cvtpk(x[8 * i + 4] * post, x[8 * i + 5] * post), cvtpk(x[8 * i + 6] * post, x[8 * i + 7] * post)};
    }
}

__device__ __forceinline__ void ph_att(const Args& a, const Ctx& c, int layer, char* lds_generic) {
    const int nun = 1024 + (layer == 0 ? 64 : 0);
    const attn_body::bf16* Qb = (const attn_body::bf16*)(a.ws + WS_Q); const attn_body::bf16* Kb = (const attn_body::bf16*)(a.ws + WS_K); const attn_body::bf16* Vb = (const attn_body::bf16*)(a.ws + WS_V);
    for (int U = c.vcu; U < nun; U += c.G) {
        long qrow0, kv0; int h, NT;
        if (U < 1024) { const int bh = U >> 4, qb = U & 15, b = bh >> 4; h = bh & 15; qrow0 = (long)b * SEQ + qb * 256; kv0 = (long)b * KVROWS; NT = KVROWS / 64; }
        else { const int q = U - 1024, b = q >> 4; h = q & 15; qrow0 = (long)TL + b * CTXL; kv0 = (long)b * KVROWS; NT = CTXL / 64; }
        attn_body::attn_unit<8>(qrow0, h, kv0, NT, Qb, Kb, Vb, (attn_body::bf16*)(a.ws + WS_HB), lds_generic);
    }
}

__device__ __forceinline__ void ph_m1(const Args& a, const Ctx& c, int layer, const unsigned* rdy, int nN, int amode) {
    const int Tm = layer == 3 ? TL : TT, ntiles = Tm / 32;
    int tl0, tl1, tl2;
    { int bid = (int)blockIdx.x; asm volatile("" : "+s"(bid));
      if (amode == 1 && c.G == 256 && ntiles == 544) {
          int k = c.vcu - 64; asm volatile("" : "+s"(k));
          if (k < 0) { tl0 = -1; tl1 = -1; tl2 = -1; } else { tl0 = k; tl1 = k + 192; tl2 = k < 64 ? k + 384 : (k < 160 ? 448 + (k - 64) : -1); } }
      else if (c.G == 256 && ntiles == 544) { if (bid < 16) { tl0 = 512 + bid; tl1 = -1; tl2 = -1; } else { const int j = bid - 16; tl0 = j; tl1 = j + 240; tl2 = j < 32 ? j + 480 : (j < 48 ? 528 + (j - 32) : -1); } }
      else { tl0 = bid < ntiles ? bid : -1; tl1 = bid + c.G < ntiles ? bid + c.G : -1; tl2 = bid + 2 * c.G < ntiles ? bid + 2 * c.G : -1; } }
    const unsigned need = 8u * (unsigned)nN;
#define M1_WAIT(tl) do { if (c.wave == 0) { unsigned sp_ = 0; \
        while ((unsigned)__builtin_amdgcn_readfirstlane(__hip_atomic_load(rdy + ((tl) >> 3), __ATOMIC_RELAXED, __HIP_MEMORY_SCOPE_AGENT)) < need) { __builtin_amdgcn_s_sleep(2); if (++sp_ > (1u << 22)) break; } \
        __builtin_amdgcn_fence(__ATOMIC_ACQUIRE, "agent"); asm volatile("s_waitcnt vmcnt(0)" ::: "memory"); } \
        __syncthreads(); } while (0)
    const float* g = a.in[I_NFFN] + layer * D;
    constexpr int RP = 2064;
    LAS unsigned char* hiT = c.lds; LAS unsigned char* loT = c.lds + 32 * RP;
    LAS float* part = (LAS float*)c.lds;
    LAS int* lcnt = (LAS int*)(c.lds + 133120); LAS int* lbase = lcnt + 32;
    LAS float* logit = (LAS float*)(c.lds + 134144);
    const bf16* wr = (const bf16*)(a.ws + WS_WR) + (size_t)layer * 2 * 65536;
    unsigned* gcnt = (unsigned*)(a.ws + WS_CTL) + CW_CNT + layer * 32;
    int* list = (int*)(a.ws + WS_LIST); float* w2 = (float*)(a.ws + WS_W2);
    const int r32 = c.lane & 31, hi = c.lane >> 5;
    if (c.tid < 32) lcnt[c.tid] = 0;
    u32x2 vr[4][4];
#define M1_LOADROWS(tl) do { _Pragma("unroll") for (int i = 0; i < 4; ++i) { const u32x2* xr = (const u32x2*)((const bf16*)(a.ws + WS_X) + (size_t)((tl) * 32 + 4 * c.wave + i) * D) + c.lane; \
        _Pragma("unroll") for (int j = 0; j < 4; ++j) vr[i][j] = xr[64 * j]; } } while (0)
    if (tl0 >= 0) { M1_WAIT(tl0); M1_LOADROWS(tl0); }
    int nmine = 0;
    for (; nmine < 3; ++nmine) { const int tile = nmine == 0 ? tl0 : nmine == 1 ? tl1 : tl2, tnext = nmine == 0 ? tl1 : nmine == 1 ? tl2 : -1;
        if (tile < 0) break;
        const int r0 = tile * 32;
        { f32x4 gs[4], sh[4];
          { const float* m = mod_row(a, layer, r0);
#pragma unroll
            for (int j = 0; j < 4; ++j) { gs[j] = ((const f32x4*)g)[c.lane + 64 * j] * (((const f32x4*)(m + 4 * D))[c.lane + 64 * j] + 1.0f); sh[j] = ((const f32x4*)(m + 3 * D))[c.lane + 64 * j]; } }
#pragma unroll
          for (int i = 0; i < 4; ++i) { const int lr = 4 * c.wave + i, r = r0 + lr;
            f32x4 h[4], vv[4];
#pragma unroll
            for (int j = 0; j < 4; ++j) { const u32x2 p = vr[i][j]; vv[j] = (f32x4){bflo(p.x), bfhi(p.x), bflo(p.y), bfhi(p.y)}; }
            const float rstd = row_rstd(vv);
#pragma unroll
            for (int j = 0; j < 4; ++j) h[j] = (vv[j] * rstd) * gs[j] + sh[j];
#if MOE_FP8
            unsigned* to8 = (unsigned*)((unsigned char*)(a.ws + WS_TK) + (size_t)r * D) + c.lane;
#else
            u32x2* to = (u32x2*)((bf16*)(a.ws + WS_TK) + (size_t)r * D) + c.lane;
#endif
#pragma unroll
            for (int j = 0; j < 4; ++j) { const unsigned h0 = cvtpk(h[j].x, h[j].y), h1 = cvtpk(h[j].z, h[j].w);
                const unsigned l0 = cvtpk(h[j].x - bflo(h0), h[j].y - bfhi(h0)), l1 = cvtpk(h[j].z - bflo(h1), h[j].w - bfhi(h1));
#if MOE_FP8
                to8[64 * j] = pk_fp8x4(h[j].x, h[j].y, h[j].z, h[j].w);
#else
                to[64 * j] = (u32x2){h0, h1};
#endif
                *(LAS u32x2*)(hiT + lr * RP + (4 * c.lane + 256 * j) * 2) = (u32x2){h0, h1};
                *(LAS u32x2*)(loT + lr * RP + (4 * c.lane + 256 * j) * 2) = (u32x2){l0, l1}; } } }
        __syncthreads();
        f32x16 acc0 = {}, acc1 = {};
#pragma unroll
        for (int kk = 0; kk < 8; ++kk) { const int k0 = 128 * c.wave + 16 * kk + 8 * hi;
            const bf16x8 ahi = *(const LAS bf16x8*)(hiT + r32 * RP + k0 * 2), alo = *(const LAS bf16x8*)(loT + r32 * RP + k0 * 2);
            const bf16* wf = wr + (c.wave * 8 + kk) * 2048 + c.lane * 8;
            const bf16x8 b0h = *(const bf16x8*)wf, b1h = *(const bf16x8*)(wf + 512), b0l = *(const bf16x8*)(wf + 1024), b1l = *(const bf16x8*)(wf + 1536);
            acc0 = __builtin_amdgcn_mfma_f32_32x32x16_bf16(ahi, b0h, acc0, 0, 0, 0); acc1 = __builtin_amdgcn_mfma_f32_32x32x16_bf16(ahi, b1h, acc1, 0, 0, 0);
            acc0 = __builtin_amdgcn_mfma_f32_32x32x16_bf16(alo, b0h, acc0, 0, 0, 0); acc1 = __builtin_amdgcn_mfma_f32_32x32x16_bf16(alo, b1h, acc1, 0, 0, 0);
            acc0 = __builtin_amdgcn_mfma_f32_32x32x16_bf16(ahi, b0l, acc0, 0, 0, 0); acc1 = __builtin_amdgcn_mfma_f32_32x32x16_bf16(ahi, b1l, acc1, 0, 0, 0); }
        if (tnext >= 0) { M1_WAIT(tnext); M1_LOADROWS(tnext); }
        else __syncthreads();
#pragma unroll
        for (int reg = 0; reg < 16; ++reg) { part[((c.wave * 2 + 0) * 16 + reg) * 64 + c.lane] = acc0[reg]; part[((c.wave * 2 + 1) * 16 + reg) * 64 + c.lane] = acc1[reg]; }
        __syncthreads();
        if (nmine < 3) {
#pragma unroll
            for (int q = 0; q < 4; ++q) { const int idx = c.tid + 512 * q, nt = idx >> 10, reg = (idx >> 6) & 15, ln = idx & 63; float s = 0.f;
#pragma unroll
                for (int w = 0; w < 8; ++w) s += part[((w * 2 + nt) * 16 + reg) * 64 + ln];
                logit[(nmine * 32 + (reg & 3) + 8 * (reg >> 2) + 4 * (ln >> 5)) * 64 + nt * 32 + (ln & 31)] = s; } }
        __syncthreads();
    }
#undef M1_LOADROWS
#undef M1_WAIT
    int e0 = 0, e1 = 0, p0 = 0, p1 = 0; float w0 = 0.f, w1 = 0.f; const int myt = c.tid >> 5; const bool act_r = c.tid < 96 && myt < nmine;
    if (act_r) { const LAS float* lg = logit + c.tid * 64;
        int grp = 0; float gm = lg[0];
#pragma unroll
        for (int q = 1; q < 4; ++q) if (lg[q] > gm) { gm = lg[q]; grp = q; }
        float den = 0.f;
#pragma unroll
        for (int q = 0; q < 4; ++q) den += expf(lg[q] - gm);
        const float gate = 1.0f / den;
        const LAS float* le = lg + 4 + grp * 8;
        int i0 = 0; float v0 = le[0];
#pragma unroll
        for (int q = 1; q < 8; ++q) if (le[q] > v0) { v0 = le[q]; i0 = q; }
        int i1 = -1; float v1 = -3.0e38f;
#pragma unroll
        for (int q = 0; q < 8; ++q) if (q != i0 && le[q] > v1) { v1 = le[q]; i1 = q; }
        const float ex = expf(v1 - v0); w0 = gate / (1.0f + ex); w1 = gate * ex / (1.0f + ex);
        e0 = grp * 8 + i0; e1 = grp * 8 + i1;
        p0 = __hip_atomic_fetch_add(lcnt + e0, 1, __ATOMIC_RELAXED, __HIP_MEMORY_SCOPE_WORKGROUP);
        p1 = __hip_atomic_fetch_add(lcnt + e1, 1, __ATOMIC_RELAXED, __HIP_MEMORY_SCOPE_WORKGROUP); }
    __syncthreads();
    if (c.tid < 32) { const int n = lcnt[c.tid]; lbase[c.tid] = n ? (int)__hip_atomic_fetch_add(gcnt + c.tid, (unsigned)n, __ATOMIC_RELAXED, __HIP_MEMORY_SCOPE_AGENT) : 0; }
    __syncthreads();
    if (act_r) { const int r = (myt == 0 ? tl0 : myt == 1 ? tl1 : tl2) * 32 + (c.tid & 31);
        list[e0 * MOE_CAP + lbase[e0] + p0] = 2 * r; w2[2 * r] = w0;
        list[e1 * MOE_CAP + lbase[e1] + p1] = 2 * r + 1; w2[2 * r + 1] = w1; }
    __syncthreads();
}
__device__ __forceinline__ void moe_tables(const Args& a, const Ctx& c, int layer, LAS int* tab) {
    unsigned* gcnt = (unsigned*)(a.ws + WS_CTL) + CW_CNT + layer * 32;
    if (c.tid < 32) tab[40 + c.tid] = (int)__hip_atomic_load(gcnt + c.tid, __ATOMIC_RELAXED, __HIP_MEMORY_SCOPE_AGENT);
    __syncthreads();
    if (c.tid == 0) { int s = 0; for (int e = 0; e < 32; ++e) { tab[e] = s; s += (tab[40 + e] + 255) >> 8; } tab[32] = s; }
    __syncthreads();
}

__device__ __forceinline__ void ph_rpool(const Args& a, const Ctx& c, int layer) {
    constexpr int TR = 34, HR = TR + 15;
    LAS unsigned char* hs = c.lds;
    const float* g = a.in[I_NMIX] + layer * D;
    for (int tile = blockIdx.x; tile < TT / TR; tile += c.G) {
        const int r0 = tile * TR;
        for (int lr0 = c.wave; lr0 < HR; lr0 += 2 * NWAVES) {
            const int lrA = lr0, lrB = lr0 + NWAVES; const int grA = r0 - 8 + lrA, grB = r0 - 8 + lrB;
            const bool okA = grA >= 0 && grA < TT, okB = lrB < HR && grB >= 0 && grB < TT;
            const int cA = grA < 0 ? 0 : (grA > TT - 1 ? TT - 1 : grA), cB = grB < 0 ? 0 : (grB > TT - 1 ? TT - 1 : grB);
            f32x4 vA[4], vB[4], h[4]; load_row_combined(a, layer, cA, c.lane, vA); load_row_combined(a, layer, cB, c.lane, vB);
            if (okA) {
                if (lrA >= 8 && lrA < 8 + TR) { u32x2* xo = (u32x2*)((bf16*)(a.ws + WS_Z) + (size_t)grA * D) + c.lane;
#pragma unroll
                    for (int j = 0; j < 4; ++j) xo[64 * j] = (u32x2){cvtpk(vA[j].x, vA[j].y), cvtpk(vA[j].z, vA[j].w)}; }
                const float rstd = row_rstd(vA); const float* m = mod_row(a, layer, grA);
                norm_mod(vA, rstd, g, m, m + D, c.lane, h);
#pragma unroll
                for (int j = 0; j < 4; ++j) *(LAS u32x2*)(hs + lrA * 2048 + (4 * c.lane + 256 * j) * 2) = (u32x2){cvtpk(h[j].x, h[j].y), cvtpk(h[j].z, h[j].w)}; }
            if (okB) {
                if (lrB >= 8 && lrB < 8 + TR) { u32x2* xo = (u32x2*)((bf16*)(a.ws + WS_Z) + (size_t)grB * D) + c.lane;
#pragma unroll
                    for (int j = 0; j < 4; ++j) xo[64 * j] = (u32x2){cvtpk(vB[j].x, vB[j].y), cvtpk(vB[j].z, vB[j].w)}; }
                const float rstd = row_rstd(vB); const float* m = mod_row(a, layer, grB);
                norm_mod(vB, rstd, g, m, m + D, c.lane, h);
#pragma unroll
                for (int j = 0; j < 4; ++j) *(LAS u32x2*)(hs + lrB * 2048 + (4 * c.lane + 256 * j) * 2) = (u32x2){cvtpk(h[j].x, h[j].y), cvtpk(h[j].z, h[j].w)}; } }
        __syncthreads();
        { const int half = 1 << (c.tid >> 7);
          const LAS unsigned* col = (const LAS unsigned*)hs + c.tid;
          float sx = 0.f, sy = 0.f;
          unsigned* ho = (unsigned*)((bf16*)(a.ws + WS_HB) + (size_t)r0 * D) + c.tid;
          for (int t = 0; t < TR; ++t) { const int gr = r0 + t;
              const int s0 = gr < TL ? (gr / SEQ) * SEQ : TL + ((gr - TL) / CTXL) * CTXL, s1 = s0 + (gr < TL ? SEQ : CTXL);
              const int lo = (gr - half) > s0 ? (gr - half) : s0, hi = (gr + half) < s1 ? (gr + half) : s1;
              if (t == 0 || gr == s0) { sx = 0.f; sy = 0.f;
                  for (int w = lo; w < hi; ++w) { const unsigned u = col[(w - r0 + 8) * 512]; sx += bflo(u); sy += bfhi(u); } }
              else { if (gr + half - 1 < s1) { const unsigned w = col[(t + 8 + half - 1) * 512]; sx += bflo(w); sy += bfhi(w); }
                     if (gr - 1 - half >= s0) { const unsigned w = col[(t + 8 - 1 - half) * 512]; sx -= bflo(w); sy -= bfhi(w); } }
              const float inv = __builtin_amdgcn_rcpf((float)(hi - lo)); const unsigned u = col[(t + 8) * 512];
              ho[t * 512] = cvtpk(sx * inv - bflo(u), sy * inv - bfhi(u)); } }
        __syncthreads();
    }
}

struct EpiInproj { static constexpr bool PERM = true; bf16* Z; bf16* XBC; float* DT; const float* dtb;
    __device__ __forceinline__ void operator()(const AccT& acc, const pg8::Unit& u, int wr, int wc, int fr, int fq) const {
        const size_t r0 = (size_t)u.pm * 256;
        if (u.pn < 20) { bf16* base; int pitch; if (u.pn < 8) { base = Z + u.pn * 256; pitch = 2048; } else { base = XBC + (u.pn - 8) * 256; pitch = 3072; }
#pragma unroll
            for (int ai = 0; ai < 2; ++ai)
#pragma unroll
                for (int m = 0; m < 4; ++m) { bf16* rowp = base + (r0 + ai * 128 + wr * 64 + m * 16 + fr) * pitch + wc * 32 + 8 * fq;
#pragma unroll
                    for (int bj = 0; bj < 2; ++bj) { const f32x4 v0 = acc[ai][bj][m][0], v1 = acc[ai][bj][m][1];
                        *(u32x4*)(rowp + bj * 128) = (u32x4){cvtpk(v0[0], v0[1]), cvtpk(v0[2], v0[3]), cvtpk(v1[0], v1[1]), cvtpk(v1[2], v1[3])}; } }
        } else if (wc < 2) { const int col = wc * 32 + 8 * fq; const f32x4 b0 = *(const f32x4*)(dtb + col), b1 = *(const f32x4*)(dtb + col + 4);
#pragma unroll
            for (int ai = 0; ai < 2; ++ai)
#pragma unroll
                for (int m = 0; m < 4; ++m) { float* p = DT + (r0 + ai * 128 + wr * 64 + m * 16 + fr) * 64 + col; f32x4 v0 = acc[ai][0][m][0] + b0, v1 = acc[ai][0][m][1] + b1;
#pragma unroll
                    for (int e = 0; e < 4; ++e) { v0[e] = fmaxf(v0[e], 0.f) + log1pf(__expf(-fabsf(v0[e]))); v1[e] = fmaxf(v1[e], 0.f) + log1pf(__expf(-fabsf(v1[e]))); }
                    *(f32x4*)p = v0; *(f32x4*)(p + 4) = v1; } }
    }
};

__device__ __forceinline__ void ph_conv(const Args& a, const Ctx& c) {
    LAS unsigned char* tin = c.lds; LAS unsigned char* toT = c.lds + 17408; LAS unsigned char* toN = c.lds + 34816;
    const bf16* xbc = (const bf16*)(a.ws + WS_XBC);
    u32x4 pin[3];
#define CONV_PREFETCH(tk) do { const int ci_ = (tk) / 48, chb_ = (tk) % 48, r0_ = ci_ * 128, ch0_ = chb_ * 64; \
        _Pragma("unroll") for (int q = 0; q < 3; ++q) { int p = c.tid + 512 * q; p = p < 131 * 8 ? p : 131 * 8 - 1; const int lr = p >> 3, pc = p & 7; int row = r0_ - 2 + lr; row = row < 0 ? 0 : (row > TT - 1 ? TT - 1 : row); \
            pin[q] = *(const u32x4*)(xbc + (size_t)row * 3072 + ch0_ + pc * 8); } } while (0)
    { const int t0 = (int)blockIdx.x < NCH * 48 ? (int)blockIdx.x : NCH * 48 - 1; CONV_PREFETCH(t0); }
    for (int task = blockIdx.x; task < NCH * 48; task += c.G) {
        const int ci = task / 48, chb = task % 48, r0 = ci * 128, ch0 = chb * 64;
        const bool first = ci < 128 ? (ci % 32 == 0) : (((ci - 128) & 1) == 0), last = ci < 128 ? (ci % 32 == 31) : (((ci - 128) & 1) == 1);
        const int ch = c.tid & 63, tq = c.tid >> 6; const float* cw = a.in[I_CONVW] + ch0 + ch;
        const float w0 = cw[0], w1 = cw[3072], w2 = cw[2 * 3072], w3 = cw[3 * 3072], bias = a.in[I_CONVB][ch0 + ch];
#pragma unroll
        for (int q = 0; q < 3; ++q) { const int p = c.tid + 512 * q, lr = p >> 3; const bool zero = (lr < 2 && first) || (lr == 130 && last);
            if (p < 131 * 8) *(LAS u32x4*)(tin + lr * 128 + (p & 7) * 16) = zero ? (u32x4){0u, 0u, 0u, 0u} : pin[q]; }
        __syncthreads();
        { const int tn = task + c.G < NCH * 48 ? task + c.G : NCH * 48 - 1; CONV_PREFETCH(tn); }
        {
          float xin[19];
#pragma unroll
          for (int i = 0; i < 19; ++i) xin[i] = bf2f(*(const LAS bf16*)(tin + (16 * tq + i) * 128 + ch * 2));
          float o[16];
#pragma unroll
          for (int i = 0; i < 16; ++i) o[i] = silu_f(bias + w0 * xin[i] + w1 * xin[i + 1] + w2 * xin[i + 2] + w3 * xin[i + 3]);
          if (chb < 40) { *(LAS u32x4*)(toT + ch * 272 + tq * 32) = (u32x4){cvtpk(o[0], o[1]), cvtpk(o[2], o[3]), cvtpk(o[4], o[5]), cvtpk(o[6], o[7])};
                          *(LAS u32x4*)(toT + ch * 272 + tq * 32 + 16) = (u32x4){cvtpk(o[8], o[9]), cvtpk(o[10], o[11]), cvtpk(o[12], o[13]), cvtpk(o[14], o[15])}; }
          if (chb >= 32) {
#pragma unroll
              for (int i = 0; i < 16; ++i) *(LAS bf16*)(toN + (16 * tq + i) * 144 + ch * 2) = (bf16)(cvtpk(o[i], 0.f) & 0xffffu); } }
        __syncthreads();
        if (chb < 40) { bf16* dst = chb < 32 ? (bf16*)(a.ws + WS_XT) + ((size_t)ci * 2048 + ch0) * 128 : (bf16*)(a.ws + WS_BT) + ((size_t)ci * 512 + (ch0 - 2048)) * 128;
#pragma unroll
            for (int q = 0; q < 2; ++q) { const int p = c.tid + 512 * q, chl = p >> 4, pc = p & 15; *(u32x4*)(dst + chl * 128 + pc * 8) = *(const LAS u32x4*)(toT + chl * 272 + pc * 16); } }
        if (chb >= 32) { bf16* dst = chb < 40 ? (bf16*)(a.ws + WS_BN) + (size_t)r0 * 512 + (ch0 - 2048) : (bf16*)(a.ws + WS_CN) + (size_t)r0 * 512 + (ch0 - 2560);
#pragma unroll
            for (int q = 0; q < 2; ++q) { const int p = c.tid + 512 * q, t = p >> 3, pc = p & 7; *(u32x4*)(dst + (size_t)t * 512 + pc * 8) = *(const LAS u32x4*)(toN + t * 144 + pc * 16); } }
        __syncthreads();
    }
#undef CONV_PREFETCH
    const int gw = c.vcu * NWAVES + c.wave, NGW = c.G * NWAVES;
    const float* dt = (const float*)(a.ws + WS_DT);
    for (int item = gw; item < NCH * 32; item += NGW) { const int ci = item >> 5, h = item & 31, r0 = ci * 128 + 2 * c.lane;
        const float af = -expf(a.in[I_ALOG][h]), ab = -expf(a.in[I_ALOG][32 + h]);
        const float dtf0 = dt[(size_t)r0 * 64 + h], dtf1 = dt[(size_t)(r0 + 1) * 64 + h], dtb0 = dt[(size_t)r0 * 64 + 32 + h], dtb1 = dt[(size_t)(r0 + 1) * 64 + 32 + h];
        const float laf0 = dtf0 * af, laf1 = dtf1 * af, lab0 = dtb0 * ab, lab1 = dtb1 * ab;
        float inf_ = laf0 + laf1, inb = lab0 + lab1; const float pf = inf_, pbk = inb;
#pragma unroll
        for (int o = 1; o < 64; o <<= 1) { const float t1 = __shfl_up(inf_, o), t2 = __shfl_up(inb, o); if (c.lane >= o) { inf_ += t1; inb += t2; } }
        const float totf = __shfl(inf_, 63), totb = __shfl(inb, 63);
        const float exf = inf_ - pf, exb = inb - pbk;
        const float cf0 = exf + laf0, cf1 = inf_, pb0 = exb, pb1 = exb + lab0;
        f32x4* sca = (f32x4*)(a.ws + WS_SCA) + (size_t)r0 * 32 + h; f32x4* scb = (f32x4*)(a.ws + WS_SCB) + (size_t)r0 * 32 + h;
        { const float L2E = 1.4426950408889634f;
          sca[0] = (f32x4){cf0 * L2E, pb0 * L2E, cf0 * L2E - __log2f(dtf0), pb0 * L2E + __log2f(dtb0)}; sca[32] = (f32x4){cf1 * L2E, pb1 * L2E, cf1 * L2E - __log2f(dtf1), pb1 * L2E + __log2f(dtb1)}; }
        scb[0] = (f32x4){__expf(cf0), __expf(totb - pb0), dtf0 * __expf(totf - cf0), dtb0 * __expf(pb0)};
        scb[32] = (f32x4){__expf(cf1), __expf(totb - pb1), dtf1 * __expf(totf - cf1), dtb1 * __expf(pb1)};
        { float* wsc = (float*)(a.ws + WS_Q) + ((size_t)(ci * 32 + h) * 2) * 128 + 2 * c.lane;
          *(f32x2*)wsc = (f32x2){dtf0 * __expf(totf - cf0), dtf1 * __expf(totf - cf1)}; *(f32x2*)(wsc + 128) = (f32x2){dtb0 * __expf(pb0), dtb1 * __expf(pb1)}; }
        if (c.lane == 0) ((f32x2*)(a.ws + WS_DEC))[ci * 32 + h] = (f32x2){__expf(totf), __expf(totb)}; }
}

__device__ __forceinline__ void ph_scan(const Args& a, const Ctx& c) {
    constexpr int P = 272, BUF = 53248;
    LAS unsigned char* stg = c.lds + 2 * BUF + c.wave * 2048;
    const int r32 = c.lane & 31, hi = c.lane >> 5, pt = c.wave >> 2, nt = c.wave & 3;
    for (int task = c.vcu; task < 256; task += c.G) { const int b = task >> 6, dir = (task >> 5) & 1, h = task & 31, g = h >> 3;
        f32x16 acc = {};
        u32x4 xrA[2], brA[4], xrB[2], brB[4]; f32x4 wA0 = {}, wA1 = {}, wB0 = {}, wB1 = {}; f32x2 decA = {}, decB = {};
#define SCAN_CI(k) (dir == 0 ? ((k) < 2 ? 128 + 2 * b + (k) : 32 * b + ((k) - 2)) : ((k) < 2 ? 128 + 2 * b + 1 - (k) : 32 * b + 31 - ((k) - 2)))
#define SCAN_LOAD(k, xr, br, w0, w1, dcr) do { const int ci_ = SCAN_CI(k); const bf16* xs_ = (const bf16*)(a.ws + WS_XT) + ((size_t)ci_ * 2048 + 64 * h) * 128; const bf16* bs_ = (const bf16*)(a.ws + WS_BT) + ((size_t)ci_ * 512 + 128 * g) * 128; \
        _Pragma("unroll") for (int q = 0; q < 2; ++q) xr[q] = ((const u32x4*)xs_)[c.tid + 512 * q]; _Pragma("unroll") for (int q = 0; q < 4; ++q) br[q] = ((const u32x4*)bs_)[c.tid + 512 * q]; \
        { const f32x4* wp_ = (const f32x4*)((const float*)(a.ws + WS_Q) + ((size_t)(ci_ * 32 + h) * 2 + dir) * 128) + 2 * (c.tid & 15); w0 = wp_[0]; w1 = wp_[1]; }        \
        dcr = ((const f32x2*)(a.ws + WS_DEC))[ci_ * 32 + h]; } while (0)
#define SCAN_WRITE(bi, xr, br, w0, w1) do { LAS unsigned char* xb_ = c.lds + (bi) * BUF; LAS unsigned char* bb_ = xb_ + 17408;        \
        _Pragma("unroll") for (int q = 0; q < 2; ++q) { const int p = c.tid + 512 * q; const u32x4 v_ = xr[q]; \
            *(LAS u32x4*)(xb_ + (p >> 4) * P + (p & 15) * 16) = (u32x4){cvtpk(bflo(v_.x) * w0.x, bfhi(v_.x) * w0.y), cvtpk(bflo(v_.y) * w0.z, bfhi(v_.y) * w0.w), cvtpk(bflo(v_.z) * w1.x, bfhi(v_.z) * w1.y), cvtpk(bflo(v_.w) * w1.z, bfhi(v_.w) * w1.w)}; } \
        _Pragma("unroll") for (int q = 0; q < 4; ++q) { const int p = c.tid + 512 * q; *(LAS u32x4*)(bb_ + (p >> 4) * P + (p & 15) * 16) = br[q]; } } while (0)
#define SCAN_STEP(k, cur, dcr) do { const int ci = SCAN_CI(k); \
            { bf16* hin = (bf16*)(a.ws + WS_HIN) + (((size_t)ci * 2 + dir) * 32 + h) * 8192; \
              _Pragma("unroll") for (int r = 0; r < 16; ++r) *(LAS bf16*)(stg + ((r & 3) + 8 * (r >> 2) + 4 * hi) * 64 + r32 * 2) = (bf16)(cvtpk(acc[r], 0.f) & 0xffffu); \
              LDS_WAIT(); \
              _Pragma("unroll") for (int i = 0; i < 2; ++i) { const int row = (c.lane >> 2) + 16 * i, pc = c.lane & 3; *(u32x4*)(hin + (size_t)(32 * pt + row) * 128 + 32 * nt + pc * 8) = *(const LAS u32x4*)(stg + row * 64 + pc * 16); } } \
            const float dec = dir == 0 ? dcr.x : dcr.y; \
            _Pragma("unroll") for (int r = 0; r < 16; ++r) acc[r] *= dec; \
            { LAS unsigned char* xb = c.lds + (cur) * BUF; LAS unsigned char* bb = xb + 17408; \
              _Pragma("unroll") for (int kk = 0; kk < 8; ++kk) { const int s8 = 16 * kk + 8 * hi; \
                  const bf16x8 xs = *(const LAS bf16x8*)(xb + (32 * pt + r32) * P + s8 * 2), bfrag = *(const LAS bf16x8*)(bb + (32 * nt + r32) * P + s8 * 2); \
                  acc = __builtin_amdgcn_mfma_f32_32x32x16_bf16(xs, bfrag, acc, 0, 0, 0); } } } while (0)
        f32x2 dcur0, dcur1;
        SCAN_LOAD(0, xrA, brA, wA0, wA1, decA); SCAN_LOAD(1, xrB, brB, wB0, wB1, decB); SCAN_WRITE(0, xrA, brA, wA0, wA1); dcur0 = decA;
        __syncthreads();
        for (int k = 0; k < 34; k += 2) {
            { const int kn = k + 2 < 34 ? k + 2 : 33; SCAN_LOAD(kn, xrA, brA, wA0, wA1, decA); }
            SCAN_STEP(k, 0, dcur0);
            SCAN_WRITE(1, xrB, brB, wB0, wB1); dcur1 = decB;
            __syncthreads();
            { const int kn = k + 3 < 34 ? k + 3 : 33; SCAN_LOAD(kn, xrB, brB, wB0, wB1, decB); }
            SCAN_STEP(k + 1, 1, dcur1);
            SCAN_WRITE(0, xrA, brA, wA0, wA1); dcur0 = decA;
            __syncthreads();
        }
#undef SCAN_CI
#undef SCAN_LOAD
#undef SCAN_WRITE
#undef SCAN_STEP
    }
}

__device__ __forceinline__ int crow16(int r, int hi) { return (r & 3) + 8 * (r >> 2) + 4 * hi; }
__device__ __forceinline__ void ph_yph(const Args& a, const Ctx& c, unsigned* rdg) {
    constexpr int P = 272, ZP = 144;
    LAS unsigned char* Cs = c.lds; LAS unsigned char* Bs = c.lds + 34816; LAS unsigned char* xs = c.lds + 69632; LAS unsigned char* hf = c.lds + 87040; LAS unsigned char* hb = c.lds + 104448;
    LAS unsigned char* zs = c.lds + 121856; LAS unsigned char* os = c.lds + 140288; LAS f32x4* sca = (LAS f32x4*)(c.lds + 158720); LAS f32x2* scb = (LAS f32x2*)(c.lds + 160768);
    LAS float* sbv = (LAS float*)(c.lds + 161792); LAS float* scv = (LAS float*)(c.lds + 162304); LAS float* ssql = (LAS float*)(c.lds + 34816);
    const int lb = c.wave & 3, pb = c.wave >> 2;
    SECT_DECL
    for (int task = c.vcu; task < NCH * 4; task += c.G) { const int ci = task >> 2, g = task & 3, r0 = ci * 128;
        int tid_t = c.tid; asm volatile("" : "+v"(tid_t));
        f32x16 X[4]; int l0;
        u32x4 pxt[2], phf[2], phb[2], pz[2]; f32x4 ps1 = {}; f32x4 ps4 = {};
#define YPH_PREFETCH(hq) do { const int h_ = 8 * g + (hq); const u32x4* xt_ = (const u32x4*)((const bf16*)(a.ws + WS_XT) + ((size_t)ci * 2048 + 64 * h_) * 128); \
            const u32x4* hfg_ = (const u32x4*)((const bf16*)(a.ws + WS_HIN) + (((size_t)ci * 2 + 0) * 32 + h_) * 8192); const u32x4* hbg_ = (const u32x4*)((const bf16*)(a.ws + WS_HIN) + (((size_t)ci * 2 + 1) * 32 + h_) * 8192); \
            const bf16* zg_ = (const bf16*)(a.ws + WS_Z) + (size_t)r0 * 2048 + 64 * h_; \
            _Pragma("unroll") for (int q = 0; q < 2; ++q) { const int p = tidp + 512 * q; pxt[q] = xt_[p]; phf[q] = hfg_[p]; phb[q] = hbg_[p]; pz[q] = *(const u32x4*)(zg_ + (size_t)(p >> 3) * 2048 + (p & 7) * 8); } \
            ps1 = ((const f32x4*)(a.ws + WS_SCA))[((size_t)r0 + (tidp & 127)) * 32 + h_]; ps4 = ((const f32x4*)(a.ws + WS_SCB))[((size_t)r0 + (tidp & 127)) * 32 + h_]; } while (0)
        { const int tid = tid_t, lane = tid & 63, r32 = lane & 31, hi = lane >> 5; l0 = 32 * lb + r32;
          { const bf16* cn = (const bf16*)(a.ws + WS_CN) + (size_t)r0 * 512 + 128 * g; const bf16* bn = (const bf16*)(a.ws + WS_BN) + (size_t)r0 * 512 + 128 * g;
#pragma unroll
            for (int q = 0; q < 4; ++q) { const int p = tid + 512 * q, row = p >> 4, pc = p & 15;
                *(LAS u32x4*)(Cs + row * P + pc * 16) = *(const u32x4*)(cn + (size_t)row * 512 + pc * 8); *(LAS u32x4*)(Bs + row * P + pc * 16) = *(const u32x4*)(bn + (size_t)row * 512 + pc * 8); } }
          { const int tidp = tid; YPH_PREFETCH(0); }
          __syncthreads();
#pragma unroll
          for (int sb = 0; sb < 4; ++sb) { X[sb] = (f32x16){};
#pragma unroll
              for (int kk = 0; kk < 8; ++kk) { const int k8 = (16 * kk + 8 * hi) * 2;
                  X[sb] = __builtin_amdgcn_mfma_f32_32x32x16_bf16(*(const LAS bf16x8*)(Bs + (32 * sb + r32) * P + k8), *(const LAS bf16x8*)(Cs + (32 * lb + r32) * P + k8), X[sb], 0, 0, 0); } }
        }
        SECT(0);
        float ssq = 0.f;
#pragma unroll 1
        for (int hh = 0; hh < 8; ++hh) { const int h = 8 * g + hh;
            int tid = c.tid; asm volatile("" : "+v"(tid)); const int lane = tid & 63, r32 = lane & 31, hi = lane >> 5, l = 32 * lb + r32; (void)lane;
            const float dsum = a.in[I_DSK][h] + a.in[I_DSK][32 + h];
            __syncthreads();
            SECT(1);
            if (hh > 0) { bf16* gg = (bf16*)(a.ws + WS_G) + (size_t)r0 * 2048 + 64 * (h - 1);
#pragma unroll
                for (int q = 0; q < 2; ++q) { const int p = tid + 512 * q, zr = p >> 3, zc = p & 7; *(u32x4*)(gg + (size_t)zr * 2048 + zc * 8) = *(const LAS u32x4*)(os + zr * ZP + zc * 16); } }
#pragma unroll
            for (int q = 0; q < 2; ++q) { const int p = tid + 512 * q, row = p >> 4, pc = p & 15;
                *(LAS u32x4*)(xs + row * P + pc * 16) = pxt[q]; *(LAS u32x4*)(hf + row * P + pc * 16) = phf[q]; *(LAS u32x4*)(hb + row * P + pc * 16) = phb[q];
                *(LAS u32x4*)(zs + (p >> 3) * ZP + (p & 7) * 16) = pz[q]; }
            if (tid < 128) { sca[tid] = ps1; scb[tid] = (f32x2){ps4.x, ps4.y}; sbv[tid] = ps1.z; scv[tid] = ps1.w; }
            __syncthreads();
            SECT(2);
            if (hh < 7) { const int tidp = tid; YPH_PREFETCH(hh + 1); }
            SECT(3);
            const f32x4 me = sca[l]; const f32x2 ee = scb[l];
            const float dtb_l = __builtin_amdgcn_exp2f(me.w - me.y);
            f32x16 accd = {};
#pragma unroll
            for (int sb = 0; sb < 4; ++sb) { unsigned mp[8];
#pragma unroll
                for (int q = 0; q < 4; ++q) { const int s0 = 32 * sb + 8 * q + 4 * hi; float mv[4];
                    if (sb < lb) { const f32x4 bs4 = *(const LAS f32x4*)(sbv + s0);
#pragma unroll
                        for (int e = 0; e < 4; ++e) mv[e] = X[sb][4 * q + e] * __builtin_amdgcn_exp2f(me.x - bs4[e]); }
                    else if (sb > lb) { const f32x4 cs4 = *(const LAS f32x4*)(scv + s0);
#pragma unroll
                        for (int e = 0; e < 4; ++e) mv[e] = X[sb][4 * q + e] * __builtin_amdgcn_exp2f(cs4[e] - me.y); }
                    else { const f32x4 bs4 = *(const LAS f32x4*)(sbv + s0), cs4 = *(const LAS f32x4*)(scv + s0);
#pragma unroll
                        for (int e = 0; e < 4; ++e) { const int s = s0 + e; const float t = (s <= l) ? (me.x - bs4[e]) : (cs4[e] - me.y); const float xv = X[sb][4 * q + e];
                            float m = xv * __builtin_amdgcn_exp2f(t); if (s == l) m += xv * dtb_l + dsum; mv[e] = m; } }
                    mp[2 * q] = cvtpk(mv[0], mv[1]); mp[2 * q + 1] = cvtpk(mv[2], mv[3]); }
#pragma unroll
                for (int t = 0; t < 2; ++t) { const int sof = (32 * sb + 16 * t + 4 * hi) * 2;
                    const u32x2 lo = *(const LAS u32x2*)(xs + (32 * pb + r32) * P + sof), h2 = *(const LAS u32x2*)(xs + (32 * pb + r32) * P + sof + 16);
                    const u32x4 af = (u32x4){lo.x, lo.y, h2.x, h2.y}, bfm = (u32x4){mp[4 * t], mp[4 * t + 1], mp[4 * t + 2], mp[4 * t + 3]};
                    accd = __builtin_amdgcn_mfma_f32_32x32x16_bf16(__builtin_bit_cast(bf16x8, af), __builtin_bit_cast(bf16x8, bfm), accd, 0, 0, 0); }
                }
            SECT(4);
#pragma unroll
            for (int dd = 0; dd < 2; ++dd) { f32x16 acco = {}; LAS unsigned char* hx = dd == 0 ? hf : hb;
#pragma unroll
                for (int kk = 0; kk < 8; ++kk) { const int k8 = (16 * kk + 8 * hi) * 2;
                    acco = __builtin_amdgcn_mfma_f32_32x32x16_bf16(*(const LAS bf16x8*)(hx + (32 * pb + r32) * P + k8), *(const LAS bf16x8*)(Cs + (32 * lb + r32) * P + k8), acco, 0, 0, 0); }
                const float ex = dd == 0 ? ee.x : ee.y;
#pragma unroll
                for (int r = 0; r < 16; ++r) accd[r] += ex * acco[r]; }
            SECT(5);
#pragma unroll
            for (int q = 0; q < 4; ++q) { const int pcol = 32 * pb + 8 * q + 4 * hi; const u32x2 zq = *(const LAS u32x2*)(zs + l * ZP + pcol * 2);
                float gv[4];
#pragma unroll
                for (int e = 0; e < 4; ++e) { const int r = 4 * q + e; const float y = accd[r];
                    const float z = (e == 0) ? bflo(zq.x) : (e == 1) ? bfhi(zq.x) : (e == 2) ? bflo(zq.y) : bfhi(zq.y); gv[e] = y * silu_f(z); ssq += gv[e] * gv[e]; }
                *(LAS u32x2*)(os + l * ZP + pcol * 2) = (u32x2){cvtpk(gv[0], gv[1]), cvtpk(gv[2], gv[3])}; }
            SECT(6);
        }
#undef YPH_PREFETCH
        __syncthreads();
        { bf16* gg = (bf16*)(a.ws + WS_G) + (size_t)r0 * 2048 + 64 * (8 * g + 7);
#pragma unroll
          for (int q = 0; q < 2; ++q) { const int p = c.tid + 512 * q, zr = p >> 3, zc = p & 7; *(u32x4*)(gg + (size_t)zr * 2048 + zc * 8) = *(const LAS u32x4*)(os + zr * ZP + zc * 16); } }
        ssq += __shfl_xor(ssq, 32);
        if ((c.lane >> 5) == 0) ssql[pb * 128 + l0] = ssq;
        __syncthreads();
        if (c.tid < 128) ssql[256 + c.tid] = rsqrtf((ssql[c.tid] + ssql[128 + c.tid]) * (1.0f / 512.0f) + EPS);
        VM_WAIT();
        __syncthreads();
        { bf16* gt = (bf16*)(a.ws + WS_G) + (size_t)r0 * 2048 + 512 * g; const float* ng = a.in[I_SNORM] + 512 * g;
          const __amdgpu_buffer_rsrc_t grs = __builtin_amdgcn_make_buffer_rsrc((void*)(a.ws + WS_G), 0, TT * 2048 * 2, 0x00020000);
          const f32x4 g0 = *(const f32x4*)(ng + (c.tid & 63) * 8), g1 = *(const f32x4*)(ng + (c.tid & 63) * 8 + 4);
#pragma unroll 1
          for (int qb = 0; qb < 2; ++qb) { u32x4 gv8[8]; int tidq = c.tid + 4096 * qb; asm volatile("" : "+v"(tidq));
#pragma unroll
            for (int q = 0; q < 8; ++q) { const int p = tidq + 512 * q; gv8[q] = *(const u32x4*)(gt + (size_t)(p >> 6) * 2048 + (p & 63) * 8); }
#pragma unroll
            for (int q = 0; q < 8; ++q) { const int p = tidq + 512 * q, row = p >> 6, col = (p & 63) * 8; const u32x4 v = gv8[q]; const float sr = ssql[256 + row];
              __builtin_amdgcn_raw_buffer_store_b128((u32x4){cvtpk(bflo(v.x) * sr * g0.x, bfhi(v.x) * sr * g0.y), cvtpk(bflo(v.y) * sr * g0.z, bfhi(v.y) * sr * g0.w), cvtpk(bflo(v.z) * sr * g1.x, bfhi(v.z) * sr * g1.y), cvtpk(bflo(v.w) * sr * g1.z, bfhi(v.w) * sr * g1.w)},
                  grs, ((r0 + row) * 2048 + 512 * g + col) * 2, 0, 16  ); } } }
        VM_WAIT();
        __syncthreads();
        if (c.tid == 0) __hip_atomic_fetch_add(rdg + (ci >> 1), 1u, __ATOMIC_RELAXED, __HIP_MEMORY_SCOPE_AGENT);
        SECT(7);
    }
    SECT_END(40);
}
__device__ __forceinline__ void ph_gfix(const Args& a, const Ctx& c) {
    const float* ng = a.in[I_SNORM]; const float* rs = (const float*)(a.ws + WS_RSTD);
    const int n16 = TT * 256;
    for (int p = blockIdx.x * NTHREADS + c.tid; p < n16; p += c.G * NTHREADS) { const int r = p >> 8, col = (p & 255) * 8;
        u32x4* gp = (u32x4*)((bf16*)(a.ws + WS_G) + (size_t)r * 2048 + col); const u32x4 v = *gp; const float s = rs[r * 4 + (col >> 9)];
        const f32x4 g0 = *(const f32x4*)(ng + col), g1 = *(const f32x4*)(ng + col + 4);
        *gp = (u32x4){cvtpk(bflo(v.x) * s * g0.x, bfhi(v.x) * s * g0.y), cvtpk(bflo(v.y) * s * g0.z, bfhi(v.y) * s * g0.w), cvtpk(bflo(v.z) * s * g1.x, bfhi(v.z) * s * g1.y), cvtpk(bflo(v.w) * s * g1.z, bfhi(v.w) * s * g1.w)}; }
}

#if DEBUG_CHECKS
__device__ __forceinline__ float dbg_hb(const Args& a, int layer, size_t idx, float sh) {
    if (ATT_FP8 && layer != 2) return __builtin_amdgcn_cvt_f32_fp8((unsigned)((const unsigned char*)(a.ws + WS_HB))[idx], 0) * sh;
    return bf2f(((const bf16*)(a.ws + WS_HB))[idx]); }
__device__ __forceinline__ int dbg_sample_row(int b) { const int SR[16] = {0, 1, 77, 4095, 4096, 5000, 8191, 9000, 12288, 16383, 16384, 16385, 16384 + 255, 16384 + 256, 17000, 17407}; int r = 0;
#pragma unroll
    for (int i = 0; i < 16; ++i) r = (b == i) ? SR[i] : r;
    return r; }
__device__ __forceinline__ float blk_sum(float v, LAS float* red, int tid) {
    v = wave_sum(v); __syncthreads(); if ((tid & 63) == 0) red[tid >> 6] = v; __syncthreads(); float s = 0.f;
#pragma unroll
    for (int i = 0; i < 8; ++i) s += red[i];
    __syncthreads(); return s; }
__device__ __forceinline__ float blk_max(float v, LAS float* red, int tid) {
#pragma unroll
    for (int o = 1; o < 64; o <<= 1) v = fmaxf(v, __shfl_xor(v, o));
    __syncthreads(); if ((tid & 63) == 0) red[tid >> 6] = v; __syncthreads(); float s = red[0];
#pragma unroll
    for (int i = 1; i < 8; ++i) s = fmaxf(s, red[i]);
    __syncthreads(); return s; }
__device__ __forceinline__ void dbg_report(const Args& a, int id, float err, float ssref, float n, int tid) {
    if (tid == 0) { float rel = err / (sqrtf(ssref / n) + 1e-20f); if (!(rel == rel)) rel = 1e30f; atomicMax((unsigned*)(a.ws + WS_CTL) + CW_DBG + id, __float_as_uint(rel)); } }
__device__ __forceinline__ float dbg_mod(const Args& a, int layer, int r, int j) {
    const float* cv = r < TL ? a.in[I_C] + (r / SEQ) * 1024 : a.in[I_CCTX]; float s = 0.f;
    _Pragma("nounroll") for (int k = 0; k < 1024; ++k) { const float x = cv[k]; s += (x / (1.0f + expf(-x))) * a.in[I_WADA][((size_t)layer * 1024 + k) * 6144 + j]; }
    return s + a.in[I_BADA][layer * 6144 + j]; }

__device__ __forceinline__ void chk_rmix(const Args& a, int layer, int id, LAS unsigned char* ldsb) {
    if (blockIdx.x >= 16) return; const int tid = tid_opaque(), r = dbg_sample_row(blockIdx.x);
    LAS float* red = (LAS float*)ldsb;
    const float* x = resid_row(a, layer, r); const bf16* hb = (const bf16*)(a.ws + WS_HB) + (size_t)r * D;
    float ss = 0.f; for (int cc = tid; cc < D; cc += 512) ss += x[cc] * x[cc];
    ss = blk_sum(ss, red, tid); const float rstd = rsqrtf(ss / D + EPS);
    float err = 0.f, sr = 0.f;
    for (int cc = tid; cc < D; cc += 512) { const float sh = dbg_mod(a, layer, r, cc), sc = dbg_mod(a, layer, r, D + cc);
        const float ref = x[cc] * rstd * a.in[I_NMIX][layer * D + cc] * (1.f + sc) + sh; err = fmaxf(err, fabsf(ref - dbg_hb(a, layer, (size_t)r * D + cc, 1.f))); sr += ref * ref; }
    err = blk_max(err, red, tid); sr = blk_sum(sr, red, tid); dbg_report(a, id, err, sr, D, tid);
}
__device__ __forceinline__ void chk_qkv(const Args& a, int layer, int id, LAS unsigned char* ldsb) {
    if (blockIdx.x >= 16) return; const int tid = tid_opaque(), r = dbg_sample_row(blockIdx.x), j = layer ? 1 : 0;
    LAS float* red = (LAS float*)ldsb; LAS float* y = red + 16; LAS float* hrow = y + 1536;
    const bf16* hb = (const bf16*)(a.ws + WS_HB) + (size_t)r * D;
    _Pragma("nounroll") for (int k = tid; k < D; k += 512) hrow[k] = dbg_hb(a, layer, (size_t)r * D + k, 1.f);
    __syncthreads();
    for (int n = tid; n < 1536; n += 512) { float s = 0.f; const float* w = a.in[I_WQKV] + (size_t)j * 1024 * 1536 + n; _Pragma("nounroll") for (int k = 0; k < 1024; ++k) s += hrow[k] * w[(size_t)k * 1536]; y[n] = s; }
    __syncthreads();
    float err = 0.f, sr = 0.f;
    for (int n = tid; n < 1536; n += 512) { float ref;
        if (n < 1280) { const int h0 = n & ~63; float ss = 0.f; _Pragma("nounroll") for (int q = 0; q < 64; ++q) ss += y[h0 + q] * y[h0 + q];
            const float rstd = rsqrtf(ss / 64.f + EPS); const float* g = (n < 1024 ? a.in[I_QG] : a.in[I_KG]) + j * 64;
            float v = y[n] * rstd * g[n & 63], vp = y[n ^ 1] * rstd * g[(n ^ 1) & 63];
            if (r < TL) { const int t = r % SEQ, i = (n & 63) >> 1, f = i & 15, pos = i < 16 ? t / 64 : t % 64; const float inv = powf(10000.f, -(float)f / 16.f), ang = (float)pos * inv, cs = cosf(ang), sn = sinf(ang);
                v = (n & 1) ? (vp * sn + v * cs) : (v * cs - vp * sn); }
            if (n < 1024) v *= 0.125f * 1.4426950408889634f;
            ref = v; } else ref = y[n];
        float got;
        if (n < 1024) { if (layer == 3 && r >= TL) continue; got = bf2f(((const bf16*)(a.ws + WS_Q))[(size_t)r * 1024 + n]); }
        else if (n < 1280) got = bf2f(((const bf16*)(a.ws + WS_K))[kv_row(r) * 256 + (n - 1024)]);
        else got = bf2f(((const bf16*)(a.ws + WS_V))[kv_row(r) * 256 + (n - 1280)]);
        err = fmaxf(err, fabsf(ref - got)); sr += ref * ref; }
    err = blk_max(err, red, tid); sr = blk_sum(sr, red, tid); dbg_report(a, id, err, sr, 1536, tid);
}
__device__ __forceinline__ void chk_att(const Args& a, int layer, int id, LAS unsigned char* ldsb) {
    if (blockIdx.x >= 16) return; const int tid = tid_opaque(), r = dbg_sample_row(blockIdx.x);
    if (layer == 3 && r >= TL) return;
    LAS float* red = (LAS float*)ldsb; LAS float* sc = red + 16; LAS float* po = sc + 4352;
    const int nk = r < TL ? KVROWS : CTXL; const long kv0 = (long)(r < TL ? r / SEQ : (r - TL) / CTXL) * KVROWS;
    const bf16* Qb = (const bf16*)(a.ws + WS_Q); const bf16* Kb = (const bf16*)(a.ws + WS_K); const bf16* Vb = (const bf16*)(a.ws + WS_V); const bf16* Ob = (const bf16*)(a.ws + WS_HB);
    float err = 0.f, sr = 0.f;
    for (int h = 0; h < 16; ++h) {
        float mx = -3e38f;
        _Pragma("nounroll") for (int jk = tid; jk < nk; jk += 512) { float s = 0.f; _Pragma("nounroll") for (int d = 0; d < 64; ++d) s += bf2f(Qb[(size_t)r * 1024 + h * 64 + d]) * bf2f(Kb[(kv0 + jk) * 256 + (h >> 2) * 64 + d]); sc[jk] = s; mx = fmaxf(mx, s); }
        mx = blk_max(mx, red, tid);
        float l = 0.f; _Pragma("nounroll") for (int jk = tid; jk < nk; jk += 512) { const float p = exp2f(sc[jk] - mx); sc[jk] = p; l += p; }
        l = blk_sum(l, red, tid);
        { const int d = tid & 63, part = tid >> 6; float o = 0.f; _Pragma("nounroll") for (int jk = part; jk < nk; jk += 8) o += sc[jk] * bf2f(Vb[(kv0 + jk) * 256 + (h >> 2) * 64 + d]); po[part * 64 + d] = o; }
        __syncthreads();
        if (tid < 64) { float o = 0.f; _Pragma("nounroll") for (int p = 0; p < 8; ++p) o += po[p * 64 + tid]; o /= l; err = fmaxf(err, fabsf(o - dbg_hb(a, layer, (size_t)r * 1024 + h * 64 + tid, 1.f / (float)(1 << ATT_OSH)))); sr += o * o; }
        __syncthreads();
    }
    err = blk_max(err, red, tid); sr = blk_sum(sr, red, tid); dbg_report(a, id, err, sr, 1024, tid);
}
__device__ __forceinline__ void chk_oproj(const Args& a, int layer, int id, LAS unsigned char* ldsb) {
    if (blockIdx.x >= 16 || layer != 0) return; const int tid = tid_opaque(), r = dbg_sample_row(blockIdx.x), j = 0;
    LAS float* red = (LAS float*)ldsb; LAS float* orow = red + 16;
    const bf16* Ob = (const bf16*)(a.ws + WS_HB) + (size_t)r * D;
    _Pragma("nounroll") for (int k = tid; k < D; k += 512) orow[k] = dbg_hb(a, layer, (size_t)r * D + k, 1.f / (float)(1 << ATT_OSH));
    __syncthreads();
    float err = 0.f, sr = 0.f;
    for (int n = tid; n < D; n += 512) { float s = 0.f; const float* w = a.in[I_WO] + (size_t)j * 1024 * 1024 + n; _Pragma("nounroll") for (int k = 0; k < 1024; ++k) s += orow[k] * w[(size_t)k * 1024];
        const float dl = dbg_mod(a, layer, r, 2 * D + n) * s, ref = resid_row(a, 0, r)[n] + dl; err = fmaxf(err, fabsf(ref - ((const float*)(a.ws + WS_X))[(size_t)r * D + n])); sr += dl * dl; }
    err = blk_max(err, red, tid); sr = blk_sum(sr, red, tid); dbg_report(a, id, err, sr, D, tid);
}
__device__ __forceinline__ void chk_moe(const Args& a, int layer, int id_tok, int id_y, LAS unsigned char* ldsb) {
    if (blockIdx.x >= 16) return; const int tid = tid_opaque(), r = dbg_sample_row(blockIdx.x);
    if (layer == 3 && r >= TL) return;
    LAS float* red = (LAS float*)ldsb; LAS float* tok = red + 16; LAS float* lg = tok + 1024; LAS float* tkb = lg + 64; LAS float* act = tkb + 1024; LAS float* rt = act + 1024;
    const float* x = (const float*)(a.ws + WS_X) + (size_t)r * D; const bf16* tk = (const bf16*)(a.ws + WS_TK) + (size_t)r * D;
    float ss = 0.f; for (int cc = tid; cc < D; cc += 512) ss += x[cc] * x[cc];
    ss = blk_sum(ss, red, tid); const float rstd = rsqrtf(ss / D + EPS);
    float err = 0.f, sr = 0.f;
    for (int cc = tid; cc < D; cc += 512) { const float sh = dbg_mod(a, layer, r, 3 * D + cc), sc = dbg_mod(a, layer, r, 4 * D + cc);
        const float ref = x[cc] * rstd * a.in[I_NFFN][layer * D + cc] * (1.f + sc) + sh; tok[cc] = ref;
#if MOE_FP8
        tkb[cc] = __builtin_amdgcn_cvt_f32_fp8((unsigned)((const unsigned char*)(a.ws + WS_TK))[(size_t)r * D + cc], 0);
#else
        tkb[cc] = bf2f(tk[cc]);
#endif
        err = fmaxf(err, fabsf(ref - tkb[cc])); sr += ref * ref; }
    err = blk_max(err, red, tid); sr = blk_sum(sr, red, tid);
    if (tid < 36) { float s = 0.f; _Pragma("nounroll") for (int k = 0; k < 1024; ++k) s += tok[k] * (tid < 4 ? a.in[I_WRG][((size_t)layer * 1024 + k) * 4 + tid] : a.in[I_WRE][((size_t)layer * 1024 + k) * 32 + tid - 4]); lg[tid] = s; }
    __syncthreads();
    if (tid == 0) { int grp = 0; _Pragma("nounroll") for (int q = 1; q < 4; ++q) if (lg[q] > lg[grp]) grp = q; float den = 0.f; _Pragma("nounroll") for (int q = 0; q < 4; ++q) den += expf(lg[q] - lg[grp]);
        const LAS float* le = lg + 4 + grp * 8; int i0 = 0; _Pragma("nounroll") for (int q = 1; q < 8; ++q) if (le[q] > le[i0]) i0 = q; int i1 = -1; _Pragma("nounroll") for (int q = 0; q < 8; ++q) if (q != i0 && (i1 < 0 || le[q] > le[i1])) i1 = q;
        const float ex = expf(le[i1] - le[i0]), w0 = 1.f / den / (1.f + ex), w1 = 1.f / den * ex / (1.f + ex);
        rt[0] = (float)(grp * 8 + i0); rt[1] = (float)(grp * 8 + i1); rt[2] = w0; rt[3] = w1;
        const float* w2 = (const float*)(a.ws + WS_W2); float e2 = fmaxf(fabsf(w2[2 * r] - w0), fabsf(w2[2 * r + 1] - w1)) * 30.f;
        const int* list = (const int*)(a.ws + WS_LIST); const unsigned* gc = (const unsigned*)(a.ws + WS_CTL) + CW_CNT + layer * 32;
        _Pragma("nounroll") for (int k = 0; k < 2; ++k) { const int e = (int)rt[k]; bool found = false; const int n = (int)gc[e]; _Pragma("nounroll") for (int q = 0; q < n && q < MOE_CAP; ++q) if (list[e * MOE_CAP + q] == 2 * r + k) found = true; if (!found) e2 = 1e6f; }
        rt[4] = e2; }
    __syncthreads();
    err = fmaxf(err, rt[4] * sqrtf(sr / D));
    dbg_report(a, id_tok, err, sr, D, tid);
    float err2 = 0.f, sr2 = 0.f;
    _Pragma("nounroll") for (int k = 0; k < 2; ++k) { const int e = (int)rt[k]; const float wk = rt[2 + k];
        const float* wgu = a.in[I_WGU] + ((size_t)layer * 32 + e) * 1024 * 1024; const float* wdn = a.in[I_WDN] + ((size_t)layer * 32 + e) * 512 * 1024;
        { float sg = 0.f, su = 0.f; _Pragma("nounroll") for (int q = 0; q < 1024; ++q) { sg += tkb[q] * wgu[(size_t)q * 1024 + tid]; su += tkb[q] * wgu[(size_t)q * 1024 + 512 + tid]; } act[tid] = (sg / (1.f + expf(-sg))) * su; }
        __syncthreads();
        for (int n = tid; n < D; n += 512) { float s = 0.f; _Pragma("nounroll") for (int q = 0; q < 512; ++q) s += act[q] * wdn[(size_t)q * 1024 + n]; s *= wk;
            err2 = fmaxf(err2, fabsf(s - bf2f(((const bf16*)(a.ws + WS_Y2))[(size_t)(2 * r + k) * D + n]))); sr2 += s * s; }
        __syncthreads(); }
    err2 = blk_max(err2, red, tid); sr2 = blk_sum(sr2, red, tid); dbg_report(a, id_y, err2, sr2, 2 * D, tid);
}

__global__ void __launch_bounds__(NTHREADS) dbg_kernel(Args a, int ty, int layer, int id) {
    extern __shared__ __attribute__((aligned(16))) unsigned char lds_dbg[];
    LAS unsigned char* l = (LAS unsigned char*)lds_dbg;
    if (ty == 1) chk_rmix(a, layer, id, l); else if (ty == 2) chk_qkv(a, layer, id, l); else if (ty == 3) chk_att(a, layer, id, l);
    else if (ty == 4) chk_oproj(a, layer, id, l); else if (ty == 5) chk_moe(a, layer, id, id + 1, l);
}
#endif

template <int KIND, int LAYER> __device__ __forceinline__ void run_phase(const Args& a0, Ctx& c, unsigned char* lds_gen) {
    Args a = a0; { unsigned long long wsv = (unsigned long long)a0.ws; asm volatile("" : "+s"(wsv)); a.ws = (unsigned char*)(GAS unsigned char*)wsv; }
    { unsigned lb = (unsigned)(uintptr_t)(LAS unsigned char*)lds_gen; asm volatile("" : "+s"(lb)); c.lds = (LAS unsigned char*)(uintptr_t)lb; }
    c.tid = tid_opaque(); c.lane = c.tid & 63;
    unsigned char* const ws = a.ws; constexpr int layer = LAYER;
#define RELAUNDER() do { { unsigned long long wsv_ = (unsigned long long)a0.ws; asm volatile("" : "+s"(wsv_)); a.ws = (unsigned char*)(GAS unsigned char*)wsv_; } \
        { unsigned lb_ = (unsigned)(uintptr_t)(LAS unsigned char*)lds_gen; asm volatile("" : "+s"(lb_)); c.lds = (LAS unsigned char*)(uintptr_t)lb_; } c.tid = tid_opaque(); c.lane = c.tid & 63; } while (0)
    if constexpr (KIND == K_P0) p0_prologue(a, c);
    else if constexpr (KIND == K_RMIX) ph_rmix(a, c, layer);
    else if constexpr (KIND == K_QKV) { constexpr int j = layer ? 1 : 0;
#if ATT_FP8
        SchedQKV S{(const char*)(ws + WS_HB), (const char*)(ws + WS_WQKV) + (size_t)j * 1536 * 1024, (size_t)256 * 1024, layer == 0 ? 1 : 0, c.G, (int)blockIdx.x};
        EpiQKV E{(bf16*)(ws + WS_Q), (bf16*)(ws + WS_K), (bf16*)(ws + WS_V), a.in[I_QG] + j * 64, a.in[I_KG] + j * 64, (const f32x2*)(ws + WS_ROPE)};
        pg8::gemm_phase<EpiQKV, SchedQKV, false, true>(c.lds, 1024, 1024, S, E, 127 - MOE_WSH, 127); }
#else
        SchedQKV S{(const char*)(ws + WS_HB), (const char*)(ws + WS_WQKV) + (size_t)j * 1536 * 1024 * 2, (size_t)256 * 1024 * 2, layer == 0 ? 1 : 0, c.G, (int)blockIdx.x};
        EpiQKV E{(bf16*)(ws + WS_Q), (bf16*)(ws + WS_K), (bf16*)(ws + WS_V), a.in[I_QG] + j * 64, a.in[I_KG] + j * 64, (const f32x2*)(ws + WS_ROPE)};
        pg8::gemm_phase<EpiQKV, SchedQKV, false>(c.lds, 2048, 2048, S, E); }
#endif
    else if constexpr (KIND == K_ROPE) ph_rope(a, c, layer);
    else if constexpr (KIND == K_ATT) ph_att(a, c, layer, (char*)c.lds);
    else if constexpr (KIND == K_OPROJ) { constexpr int j = layer ? 1 : 0;
#if ATT_FP8
        unsigned* rdx = (unsigned*)(ws + WS_CTL) + CW_RDX + layer * 128;
        SchedDenseR S{(const char*)(ws + WS_HB), (const char*)(ws + WS_WO) + (size_t)j * 1024 * 1024, (size_t)256 * 1024, (size_t)256 * 1024, 0, layer == 3 ? 64 : 68, 4, 64, c.G, (int)blockIdx.x, rdx};
        EpiResid E{&a, layer, nullptr, nullptr};
        pg8::gemm_phase<EpiResid, SchedDenseR, false, true>(c.lds, 1024, 1024, S, E, 127 - MOE_WSH, 127 - ATT_OSH);
        RELAUNDER(); ph_m1(a, c, layer, (unsigned*)(a.ws + WS_CTL) + CW_RDX + layer * 128, 4, 0); }
#else
        unsigned* rdx = (unsigned*)(ws + WS_CTL) + CW_RDX + layer * 128;
        SchedDenseR S{(const char*)(ws + WS_HB), (const char*)(ws + WS_WO) + (size_t)j * 1024 * 1024 * 2, (size_t)256 * 1024 * 2, (size_t)256 * 1024 * 2, 0, layer == 3 ? 64 : 68, 4, 64, c.G, (int)blockIdx.x, rdx};
        EpiResid E{&a, layer, nullptr, nullptr};
        pg8::gemm_phase<EpiResid, SchedDenseR, false>(c.lds, 2048, 2048, S, E);
        RELAUNDER(); ph_m1(a, c, layer, (unsigned*)(a.ws + WS_CTL) + CW_RDX + layer * 128, 4, 0); }
#endif
    else if constexpr (KIND == K_M2) {
        LAS int* tab = (LAS int*)(c.lds + TAB_OFF); moe_tables(a, c, layer, tab);
        unsigned* rdy = (unsigned*)(ws + WS_CTL) + CW_RDY + layer * 256;
#if MOE_FP8
        { SchedMoe S{(const char*)(ws + WS_TK), 0, (const char*)(ws + WS_WGU) + (size_t)layer * 32 * 1024 * 1024, (size_t)1024 * 1024, (size_t)256 * 1024, tab, (const int*)(ws + WS_LIST), c.G, (int)blockIdx.x, rdy, 1};
          EpiGateUp E{(bf16*)(ws + WS_ACT)};
          pg8::gemm_phase<EpiGateUp, SchedMoe, true, true>(c.lds, 1024, 1024, S, E, 127 - MOE_WSH, 127); }
        { SchedMoe S{(const char*)(ws + WS_ACT), (size_t)256 * 512, (const char*)(ws + WS_WDN) + (size_t)layer * 32 * 1024 * 512, (size_t)1024 * 512, (size_t)256 * 512, tab, (const int*)(ws + WS_LIST), c.G, (int)blockIdx.x, rdy, 2};
          EpiDown E{(const int*)(ws + WS_LIST), (const float*)(ws + WS_W2), (bf16*)(ws + WS_Y2)};
          pg8::gemm_phase<EpiDown, SchedMoe, false, true>(c.lds, 512, 512, S, E, 127 - MOE_WSH, 127 - MOE_ASH); } }
#else
        { SchedMoe S{(const char*)(ws + WS_TK), 0, (const char*)(ws + WS_WGU) + (size_t)layer * 32 * 1024 * 1024 * 2, (size_t)1024 * 1024 * 2, (size_t)256 * 1024 * 2, tab, (const int*)(ws + WS_LIST), c.G, (int)blockIdx.x, rdy, 1};
          EpiGateUp E{(bf16*)(ws + WS_ACT)};
          pg8::gemm_phase<EpiGateUp, SchedMoe, true>(c.lds, 2048, 2048, S, E); }
        { SchedMoe S{(const char*)(ws + WS_ACT), (size_t)256 * 512 * 2, (const char*)(ws + WS_WDN) + (size_t)layer * 32 * 1024 * 512 * 2, (size_t)1024 * 512 * 2, (size_t)256 * 512 * 2, tab, (const int*)(ws + WS_LIST), c.G, (int)blockIdx.x, rdy, 2};
          EpiDown E{(const int*)(ws + WS_LIST), (const float*)(ws + WS_W2), (bf16*)(ws + WS_Y2)};
          pg8::gemm_phase<EpiDown, SchedMoe, false>(c.lds, 1024, 1024, S, E); } }
#endif
    else if constexpr (KIND == K_RPOOL) ph_rpool(a, c, layer);
    else if constexpr (KIND == K_POOLG) {
        unsigned* rdx = (unsigned*)(ws + WS_CTL) + CW_RDX + layer * 128;
        SchedDenseR S{(const char*)(ws + WS_HB), (const char*)(ws + WS_WPOOL), (size_t)256 * 1024 * 2, (size_t)256 * 256 * 2, (size_t)256 * 2, 68, 4, 64, c.G, (int)blockIdx.x, rdx};
        EpiResidN E{&a, layer, a.in[I_POOLS], (const bf16*)(ws + WS_Z)};
        pg8::gemm_phase<EpiResidN, SchedDenseR, false>(c.lds, 512, 2048, S, E);
        RELAUNDER(); ph_m1(a, c, layer, (unsigned*)(a.ws + WS_CTL) + CW_RDX + layer * 128, 4, 0); }
    else if constexpr (KIND == K_INPROJ) {
        SchedDense S{(const char*)(ws + WS_HB), (const char*)(ws + WS_WIN), (size_t)256 * 1024 * 2, (size_t)256 * 1024 * 2, 0, 68, 21, c.G, (int)blockIdx.x};
        EpiInproj E{(bf16*)(ws + WS_Z), (bf16*)(ws + WS_XBC), (float*)(ws + WS_DT), a.in[I_DTB]};
        pg8::gemm_phase<EpiInproj, SchedDense, false>(c.lds, 2048, 2048, S, E); }
    else if constexpr (KIND == K_CONV) ph_conv(a, c);
    else if constexpr (KIND == K_SCAN) ph_scan(a, c);
    else if constexpr (KIND == K_YPH) {
        ph_yph(a, c, (unsigned*)(ws + WS_CTL) + CW_RDG);
        RELAUNDER();
        { unsigned* rdx = (unsigned*)(a.ws + WS_CTL) + CW_RDX + layer * 128;
          SchedOutproj S{(const char*)(a.ws + WS_G), (const char*)(a.ws + WS_WOUT), (size_t)256 * 2048 * 2, (size_t)256 * 2048 * 2, c.G, c.vcu, (const unsigned*)(a.ws + WS_CTL) + CW_RDG, rdx};
          EpiResid E{&a, layer, nullptr, nullptr};
          pg8::gemm_phase<EpiResid, SchedOutproj, false>(c.lds, 4096, 4096, S, E); }
        RELAUNDER(); ph_m1(a, c, layer, (unsigned*)(a.ws + WS_CTL) + CW_RDX + layer * 128, 4, 1); }
    else if constexpr (KIND == K_GFIX) ph_gfix(a, c);
    else if constexpr (KIND == K_FINAL) ph_final(a, c, layer);
#undef RELAUNDER
}
#define PROGRAM(X) \
    X(0, K_P0, 0) \
    X(1, K_RMIX, 0) X(2, K_QKV, 0) X(3, K_ATT, 0) X(4, K_OPROJ, 0) X(5, K_M2, 0) \
    X(6, K_RPOOL, 1) X(7, K_POOLG, 1) X(8, K_M2, 1) \
    X(9, K_RMIX, 2) X(10, K_INPROJ, 2) X(11, K_CONV, 2) X(12, K_SCAN, 2) X(13, K_YPH, 2) X(14, K_M2, 2) \
    X(15, K_RMIX, 3) X(16, K_QKV, 3) X(17, K_ATT, 3) X(18, K_OPROJ, 3) X(19, K_M2, 3) \
    X(20, K_FINAL, 4)
constexpr int NPHASES = 21;
__device__ __forceinline__ unsigned long long probe_phases(const unsigned long long* ts, unsigned mask) { unsigned long long r = 0; for (int k = 0; k < 32; ++k) if (mask & (1u << k)) r += ts[k + 1] - ts[k]; return r; }
__device__ __forceinline__ unsigned long long probe_sum(const unsigned long long* s, int mask) { unsigned long long r = 0; for (int k = 0; k < 8; ++k) if (mask & (1 << k)) r += s[k]; return r; }
__global__ void __launch_bounds__(NTHREADS, 2) mega(Args a0) {
    extern __shared__ __attribute__((aligned(16))) unsigned char lds_raw[];
    Ctx c; c.lds = (LAS unsigned char*)lds_raw; c.tid = threadIdx.x; c.lane = c.tid & 63; c.wave = __builtin_amdgcn_readfirstlane(c.tid >> 6);
    c.G = gridDim.x; { const int bx = blockIdx.x; c.vcu = (c.G % 8 == 0) ? (bx % 8) * (c.G / 8) + bx / 8 : bx; }
    volatile LAS unsigned* MISC = (volatile LAS unsigned*)(c.lds + MISC_OFF);
    for (int u = c.tid; u < 128; u += NTHREADS) MISC[u] = 0u;
    __syncthreads();
    XcdBarrier bar = xcd_barrier_post((unsigned*)(a0.ws + WS_CTL) + CW_BAR + a0.bar_region * XCD_BAR_WORDS, MISC + 8);
    const int lo = a0.ph_lo, hi = a0.ph_hi;
#if PROBE
#define STAMP(idx) if (blockIdx.x == 0 && threadIdx.x == 0) __hip_atomic_store((unsigned long long*)((unsigned*)(a0.ws + WS_CTL) + CW_TS) + (idx), (unsigned long long)__builtin_amdgcn_s_memrealtime(), __ATOMIC_RELAXED, __HIP_MEMORY_SCOPE_AGENT);
#else
#define STAMP(idx)
#endif
    STAMP(0)
#if EXTRA_BARS
    for (int eb = 0; eb < EXTRA_BARS; ++eb) xcd_barrier(bar);
#endif
#define RUNPH(idx, KIND, LAYER) if (lo <= (idx) && (idx) < hi) { run_phase<KIND, LAYER>(a0, c, lds_raw); if ((idx) + 1 < hi) xcd_barrier(bar); STAMP((idx) + 1) }
    PROGRAM(RUNPH)
#undef RUNPH
#if PROBE
    if (blockIdx.x == 0 && threadIdx.x == 0 && hi == NPHASES) { const unsigned long long* ts = (const unsigned long long*)((unsigned*)(a0.ws + WS_CTL) + CW_TS);
        const unsigned long long d = (unsigned long long)PROBE_K * (PROBE_SLOT ? probe_sum(ts + PROBE_SLOT_BASE, PROBE_SLOT) : probe_phases(ts, PROBE_MASK)), t0 = __builtin_amdgcn_s_memrealtime();
        while (__builtin_amdgcn_s_memrealtime() - t0 < d) __builtin_amdgcn_s_sleep(8); }
#endif
}

extern "C" void kernel_launch(void* const* d_in, const int* in_sizes, int n_in, void* d_out, int out_size, void* d_ws, size_t ws_size, hipStream_t stream) {
    static int grid = 0;
    if (grid == 0) {
        if (n_in != N_IN || out_size != TL * D || ws_size < WS_END) { fprintf(stderr, "kernel_launch: unexpected shapes (n_in %d out %d ws %zu)\n", n_in, out_size, ws_size); grid = -1; return; }
        int dev = 0, cus = 0;
        if (hipGetDevice(&dev) != hipSuccess || hipDeviceGetAttribute(&cus, hipDeviceAttributeMultiprocessorCount, dev) != hipSuccess) { grid = -1; return; }
        if (hipFuncSetAttribute((const void*)mega, hipFuncAttributeMaxDynamicSharedMemorySize, LDS_BYTES) != hipSuccess) { fprintf(stderr, "kernel_launch: hipFuncSetAttribute failed\n"); grid = -1; return; }
        int per_cu = 0;
        if (hipOccupancyMaxActiveBlocksPerMultiprocessor(&per_cu, (const void*)mega, NTHREADS, LDS_BYTES) != hipSuccess || per_cu < 1) fprintf(stderr, "kernel_launch: occupancy query says %d\n", per_cu);
        (void)hipGetLastError();
        if (cus < 192) { fprintf(stderr, "kernel_launch: %d CUs: the router keeps at most 3 row tiles of logits per workgroup (needs >= 182 workgroups)\n", cus); grid = -1; return; }
        grid = cus;
    }
    if (grid < 0) return;
    (void)hipMemsetAsync((char*)d_ws + WS_CTL, 0, CTL_ZERO_BYTES, stream);
    Args a{};
    for (int i = 0; i < N_IN; ++i) a.in[i] = (const float*)d_in[i];
    a.out = (float*)d_out; a.ws = (unsigned char*)d_ws; a.flags = 0;
#if DEBUG_CHECKS
    struct Cut { int after; int ty, layer, nid; };
    const Cut cuts[] = DEBUG_CUTS;
    int lo = 0, region = 0, dbg_id = 1;
    for (unsigned k = 0; k < sizeof(cuts) / sizeof(cuts[0]); ++k) {
        if (cuts[k].after + 1 > lo) { a.ph_lo = lo; a.ph_hi = cuts[k].after + 1; a.bar_region = region++; hipLaunchKernelGGL(mega, dim3(grid), dim3(NTHREADS), LDS_BYTES, stream, a); lo = cuts[k].after + 1; }
        hipLaunchKernelGGL(dbg_kernel, dim3(16), dim3(NTHREADS), 65536, stream, a, cuts[k].ty, cuts[k].layer, dbg_id); dbg_id += cuts[k].nid;
    }
    a.ph_lo = lo; a.ph_hi = NPHASES; a.bar_region = region++;
    hipLaunchKernelGGL(mega, dim3(grid), dim3(NTHREADS), LDS_BYTES, stream, a);
#else
    a.ph_lo = 0; a.ph_hi = NPHASES; a.bar_region = 0;
    hipLaunchKernelGGL(mega, dim3(grid), dim3(NTHREADS), LDS_BYTES, stream, a);
#endif
}
```

```cpp
#include <hip/hip_runtime.h>
#include <cstdio>
#include <cstdint>

#define LAS __attribute__((address_space(3)))
#define GAS __attribute__((address_space(1)))
typedef unsigned short bf16;
typedef short bf16x8 __attribute__((ext_vector_type(8)));
typedef short s16x4 __attribute__((ext_vector_type(4)));
typedef float f32x2 __attribute__((ext_vector_type(2)));
typedef float f32x4 __attribute__((ext_vector_type(4)));
typedef float f32x16 __attribute__((ext_vector_type(16)));
typedef unsigned u32x2 __attribute__((ext_vector_type(2)));
typedef unsigned u32x4 __attribute__((ext_vector_type(4)));
typedef __bf16 bf16x2_t __attribute__((ext_vector_type(2)));

constexpr int D = 1024, NB = 4, SEQ = 4096, CTXL = 256, TL = NB * SEQ, TC = NB * CTXL, TT = TL + TC;
constexpr int KVROWS = SEQ + CTXL;
constexpr int NCH = TT / 128;
constexpr int MOE_CAP = TT;
constexpr float EPS = 1e-6f;
constexpr int NWAVES = 8, NTHREADS = 512;
#ifndef NLAYERS
#define NLAYERS 4
#endif
#ifndef MOE_FP8
#define MOE_FP8 1
#endif
#define MOE_WSH 5
#ifndef ATT_FP8
#define ATT_FP8 1
#endif
#define ATT_OSH 3
#define MOE_ASH 2
#define DBG_TOL 0.03f
#ifndef DEBUG_CHECKS
#define DEBUG_CHECKS 0
#endif
#ifndef PROBE
#define PROBE 0
#endif
#define PROBE_A0 0
#define PROBE_A1 1
#define PROBE_B0 4
#define PROBE_B1 5
#define PROBE_K 2
#define PROBE_MASK 0x1222224u
#define EXTRA_BARS 0
#define PROBE_SLOT_BASE 40
#define PROBE_SLOT 0
#if PROBE
#define SECT_DECL unsigned long long sect_t = __builtin_amdgcn_s_memrealtime(); unsigned long long sect_acc[8] = {0, 0, 0, 0, 0, 0, 0, 0};
#define SECT(k) do { const unsigned long long n_ = __builtin_amdgcn_s_memrealtime(); sect_acc[k] += n_ - sect_t; sect_t = n_; } while (0)
#ifndef PROBE_BLOCK
#define PROBE_BLOCK 0
#endif
#define SECT_END(base) do { if (blockIdx.x == PROBE_BLOCK && threadIdx.x == 0) { _Pragma("unroll") for (int k_ = 0; k_ < 8; ++k_) ((unsigned long long*)((unsigned*)(a.ws + WS_CTL) + CW_TS))[(base) + k_] = sect_acc[k_]; } } while (0)
#else
#define SECT_DECL
#define SECT(k) do {} while (0)
#define SECT_END(base) do {} while (0)
#endif
#define DEBUG_CUTS { {1, 1, 0, 1}, {2, 2, 0, 1}, {3, 3, 0, 1}, {4, 4, 0, 1}, {6, 5, 0, 2} }

enum { I_X = 0, I_C, I_CTX, I_CCTX, I_WADA, I_BADA, I_NMIX, I_NFFN, I_NFIN, I_WQKV, I_WO, I_QG, I_KG, I_POOLW, I_POOLS, I_WIN, I_CONVW, I_CONVB, I_DTB, I_ALOG, I_DSK, I_SNORM, I_WOUT, I_WRG, I_WRE, I_WGU, I_WDN, N_IN };

constexpr size_t MiB = 1u << 20;
constexpr size_t WS_CTL = 0, CTL_ZERO_BYTES = 1 * MiB;
constexpr size_t WS_MODL = 1 * MiB;
constexpr size_t WS_MODC = WS_MODL + 4 * 4 * 6144 * 4;
constexpr size_t WS_ROPE = 1 * MiB + 512 * 1024;
constexpr size_t WS_WR = 2 * MiB;
constexpr size_t WS_WQKV = 3 * MiB;
constexpr size_t WS_WO = 9 * MiB;
constexpr size_t WS_WPOOL = 13 * MiB;
constexpr size_t WS_WIN = 14 * MiB;
constexpr size_t WS_WOUT = 25 * MiB;
constexpr size_t WS_WGU = 29 * MiB;
constexpr size_t WS_WDN = 285 * MiB;
constexpr size_t WS_X = 413 * MiB;
constexpr size_t WS_HB = 481 * MiB;
constexpr size_t WS_TK = 515 * MiB;
constexpr size_t WS_Q = 549 * MiB;
constexpr size_t WS_K = 583 * MiB;
constexpr size_t WS_V = 592 * MiB;
constexpr size_t WS_Y2 = 601 * MiB;
constexpr size_t WS_ACT = 669 * MiB;
constexpr size_t WS_LIST = 711 * MiB;
constexpr size_t WS_W2 = 714 * MiB;
constexpr size_t WS_Z = 715 * MiB;
constexpr size_t WS_XBC = 783 * MiB;
constexpr size_t WS_DT = 885 * MiB;
constexpr size_t WS_XT = 890 * MiB;
constexpr size_t WS_BN = 958 * MiB;
constexpr size_t WS_BT = 975 * MiB;
constexpr size_t WS_CN = 992 * MiB;
constexpr size_t WS_SCA = 1009 * MiB;
constexpr size_t WS_SCB = 1018 * MiB;
constexpr size_t WS_DEC = 1027 * MiB;
constexpr size_t WS_HIN = 1028 * MiB;
constexpr size_t WS_G = 1164 * MiB;
constexpr size_t WS_RSTD = 1232 * MiB;
constexpr size_t WS_END = 1233 * MiB;

constexpr int CW_BAR = 4096;
constexpr int CW_CNT = 200000;
constexpr int CW_DBG = 201000;
constexpr int CW_RDY = 204000;
constexpr int CW_RDG = 207000;
constexpr int CW_RDX = 206000;
constexpr int CW_TS = 202000;

constexpr int LDS_BYTES = 163840;
constexpr int MISC_OFF = LDS_BYTES - 512;

__device__ __forceinline__ unsigned cvtpk(float lo, float hi) { f32x2 v = {lo, hi}; bf16x2_t b = __builtin_convertvector(v, bf16x2_t); return __builtin_bit_cast(unsigned, b); }
__device__ __forceinline__ unsigned pk_fp8x4(float a, float b, float c, float d) {
    a = __builtin_amdgcn_fmed3f(a, -448.f, 448.f); b = __builtin_amdgcn_fmed3f(b, -448.f, 448.f); c = __builtin_amdgcn_fmed3f(c, -448.f, 448.f); d = __builtin_amdgcn_fmed3f(d, -448.f, 448.f);
    unsigned w = __builtin_amdgcn_cvt_pk_fp8_f32(a, b, 0u, false); return __builtin_amdgcn_cvt_pk_fp8_f32(c, d, w, true); }
__device__ __forceinline__ float bflo(unsigned u) { return __uint_as_float(u << 16); }
__device__ __forceinline__ float bfhi(unsigned u) { return __uint_as_float(u & 0xffff0000u); }
__device__ __forceinline__ float bf2f(bf16 b) { return __uint_as_float((unsigned)b << 16); }
__device__ __forceinline__ float wave_sum(float v) {
#pragma unroll
    for (int o = 1; o < 64; o <<= 1) v += __shfl_xor(v, o);
    return v;
}
__device__ __forceinline__ float silu_f(float v) { return v * __builtin_amdgcn_rcpf(1.0f + __builtin_amdgcn_exp2f(v * -1.4426950408889634f)); }
__device__ __forceinline__ int tid_opaque() { int t = threadIdx.x; asm volatile("" : "+v"(t)); return t; }
#define LDS_WAIT() asm volatile("s_waitcnt lgkmcnt(0)" ::: "memory")
#define VM_WAIT() asm volatile("s_waitcnt vmcnt(0)" ::: "memory")

#define XB_TMO      128
#define XB_XCNT(j)  (256  + 64 * (j))
#define XB_XSUB(j)  (1280 + 64 * (j))
#define XB_XGEN(j)  (2304 + 64 * (j))
#define XB_TOP      3328
#define XB_TOPGEN   3392
#define XCD_BAR_WORDS 3456
#define XB_SPIN_CAP (1u << 20)
#ifndef XB_FLATPOLL
#define XB_FLATPOLL 0
#endif
__device__ __forceinline__ unsigned xb_ld(unsigned* p)              { return __hip_atomic_load(p, __ATOMIC_RELAXED, __HIP_MEMORY_SCOPE_AGENT); }
__device__ __forceinline__ unsigned xb_add(unsigned* p, unsigned v) { return __hip_atomic_fetch_add(p, v, __ATOMIC_RELAXED, __HIP_MEMORY_SCOPE_AGENT); }
__device__ __forceinline__ unsigned xb_xcc_id() { return (unsigned)__builtin_amdgcn_s_getreg((3 << 11) | 20) & 0xFu; }
#define XB_SPIN(cond, bar) do { unsigned _sp = 0; while (cond) { __builtin_amdgcn_s_sleep(1); \
    if ((++_sp & 255u) == 0u) { if (xb_ld(&(bar)[XB_TMO])) break; if (_sp > XB_SPIN_CAP) { atomicAdd(&(bar)[XB_TMO], 1u); break; } } } } while (0)
struct XcdBarrier { unsigned* bar; unsigned x; volatile LAS unsigned* st; };
__device__ __forceinline__ XcdBarrier xcd_barrier_post(unsigned* bar, volatile LAS unsigned* st) {
    XcdBarrier b; b.bar = bar; b.x = xb_xcc_id(); b.st = st;
    if (threadIdx.x == 0) (void)xb_add(&bar[XB_XCNT(b.x)], 1u);
    return b;
}
__device__ __forceinline__ void xcd_barrier_complete(unsigned* bar, unsigned x, unsigned& nloc, unsigned& nx) {
    const unsigned G = gridDim.x * gridDim.y * gridDim.z;
    unsigned sum, cnt, mine, sp = 0u;
    for (;;) {
        sum = 0u; cnt = 0u; mine = 0u;
#pragma unroll
        for (unsigned j = 0; j < 16; ++j) { const unsigned c = xb_ld(&bar[XB_XCNT(j)]); sum += c; cnt += (c > 0u) ? 1u : 0u; mine = (j == x) ? c : mine; }
        if (sum == G) break;
        __builtin_amdgcn_s_sleep(1);
        if ((++sp & 255u) == 0u) { if (xb_ld(&bar[XB_TMO])) break; if (sp > XB_SPIN_CAP) { atomicAdd(&bar[XB_TMO], 1u); break; } }
    }
    nloc = mine > 0u ? mine : 1u; nx = cnt > 0u ? cnt : 1u;
}
__device__ __forceinline__ void xcd_barrier(const XcdBarrier& b) {
    asm volatile("s_waitcnt vmcnt(0)" ::: "memory");
    __syncthreads();
    if (threadIdx.x == 0) {
        unsigned* bar = b.bar;
        __builtin_amdgcn_s_waitcnt(0);
        unsigned nloc = b.st[0], nx = b.st[1];
        if (nloc == 0u) { xcd_barrier_complete(bar, b.x, nloc, nx); b.st[0] = nloc; b.st[1] = nx; }
#if XB_FLATPOLL
        const unsigned seq = b.st[2]; b.st[2] = seq + 1u;
#endif
        const unsigned old = xb_add(&bar[XB_XSUB(b.x)], 1u);
        const unsigned gen = old / nloc;
        if (old + 1u == (gen + 1u) * nloc) {
            __builtin_amdgcn_fence(__ATOMIC_RELEASE, "agent");
            asm volatile("s_waitcnt vmcnt(0)" ::: "memory");
            const unsigned og = xb_add(&bar[XB_TOP], 1u);
            const unsigned tg = og / nx;
            if (og + 1u == (tg + 1u) * nx) xb_add(&bar[XB_TOPGEN], 1u);
            else XB_SPIN(xb_ld(&bar[XB_TOPGEN]) == tg, bar);
            __builtin_amdgcn_fence(__ATOMIC_ACQUIRE, "agent");
#if !XB_FLATPOLL
            xb_add(&bar[XB_XGEN(b.x)], 1u);
#endif
            asm volatile("s_waitcnt vmcnt(0)" ::: "memory");
        } else {
#if XB_FLATPOLL
            XB_SPIN(xb_ld(&bar[XB_TOPGEN]) == seq, bar);
#else
            XB_SPIN(xb_ld(&bar[XB_XGEN(b.x)]) == gen, bar);
#endif
            __builtin_amdgcn_fence(__ATOMIC_ACQUIRE, "agent");
            asm volatile("s_waitcnt vmcnt(0)" ::: "memory");
        }
    }
    __syncthreads();
}

enum { K_P0 = 0, K_RMIX, K_QKV, K_ROPE, K_ATT, K_OPROJ, K_M1, K_M2, K_M3, K_RPOOL, K_POOLG, K_INPROJ, K_CONV, K_SCAN, K_YPH, K_GFIX, K_OUTPROJ, K_FINAL, K_DBG };
struct Args { const float* in[N_IN]; float* out; unsigned char* ws; int ph_lo, ph_hi; int flags; int bar_region; };

struct Ctx {
    LAS unsigned char* lds; int tid, lane, wave, vcu, G;
};

__device__ __forceinline__ const float* mod_row(const Args& a, int layer, int r) {
    return r < TL ? (const float*)(a.ws + WS_MODL) + (size_t)(layer * 4 + r / SEQ) * 6144 : (const float*)(a.ws + WS_MODC) + (size_t)layer * 6144;
}
__device__ __forceinline__ const float* resid_row(const Args& a, int layer, int r) {
    if (layer == 0) return r < TL ? a.in[I_X] + (size_t)r * D : a.in[I_CTX] + (size_t)(r - TL) * D;
    return (const float*)(a.ws + WS_X) + (size_t)r * D;
}

__device__ __forceinline__ void load_row_combined(const Args& a, int layer, int r, int lane, f32x4 (&v)[4]) {
    if (layer == 0) { const f32x4* xr = (const f32x4*)resid_row(a, 0, r) + lane;
#pragma unroll
        for (int j = 0; j < 4; ++j) v[j] = xr[64 * j]; }
    else { const u32x2* xr = (const u32x2*)((const bf16*)(a.ws + WS_X) + (size_t)r * D) + lane;
#pragma unroll
        for (int j = 0; j < 4; ++j) { const u32x2 p = xr[64 * j]; v[j] = (f32x4){bflo(p.x), bfhi(p.x), bflo(p.y), bfhi(p.y)}; } }
    if (layer > 0 && !(a.flags & 1)) {
        const f32x4* gf = (const f32x4*)(mod_row(a, layer - 1, r) + 5 * D) + lane;
        const u32x2* y0 = (const u32x2*)((const bf16*)(a.ws + WS_Y2) + (size_t)(2 * r) * D) + lane;
        const u32x2* y1 = (const u32x2*)((const bf16*)(a.ws + WS_Y2) + (size_t)(2 * r + 1) * D) + lane;
#pragma unroll
        for (int j = 0; j < 4; ++j) {
            const u32x2 p = y0[64 * j], q = y1[64 * j]; const f32x4 g = gf[64 * j];
            v[j].x += g.x * (bflo(p.x) + bflo(q.x)); v[j].y += g.y * (bfhi(p.x) + bfhi(q.x));
            v[j].z += g.z * (bflo(p.y) + bflo(q.y)); v[j].w += g.w * (bfhi(p.y) + bfhi(q.y));
        }
    }
}
__device__ __forceinline__ float row_rstd(const f32x4 (&v)[4]) {
    float s = 0.f;
#pragma unroll
    for (int j = 0; j < 4; ++j) s += (v[j].x * v[j].x + v[j].y * v[j].y) + (v[j].z * v[j].z + v[j].w * v[j].w);
    return rsqrtf(wave_sum(s) * (1.0f / D) + EPS);
}
__device__ __forceinline__ void norm_mod(const f32x4 (&v)[4], float rstd, const float* g, const float* shift, const float* scale, int lane, f32x4 (&h)[4]) {
#pragma unroll
    for (int j = 0; j < 4; ++j) {
        const f32x4 gg = ((const f32x4*)g)[lane + 64 * j], sh = ((const f32x4*)shift)[lane + 64 * j], sc = ((const f32x4*)scale)[lane + 64 * j];
        h[j] = (v[j] * rstd) * gg * (sc + 1.0f) + sh;
    }
}

__device__ __forceinline__ void tr_item(const float* W, int N, int k0, int n0, bf16* WT, size_t drow0, int dK, LAS float* scr, int lane, int hi_skip = 0) {
    const int nq = lane & 15, kr = lane >> 4;
#pragma unroll
    for (int i = 0; i < 16; ++i) { const int kk = 4 * i + kr; const f32x4 v = *(const f32x4*)(W + (size_t)(k0 + kk) * N + n0 + 4 * nq);
        LAS float* d = scr + kk * 65 + 4 * nq; d[0] = v.x; d[1] = v.y; d[2] = v.z; d[3] = v.w; }
    LDS_WAIT(); asm volatile("" ::: "memory");
    const int c = lane & 7;
#pragma unroll
    for (int j = 0; j < 8; ++j) { const int n = (lane >> 3) + 8 * j; const LAS float* s = scr + (8 * c) * 65 + n;
        u32x4 o; o.x = cvtpk(s[0 * 65], s[1 * 65]); o.y = cvtpk(s[2 * 65], s[3 * 65]); o.z = cvtpk(s[4 * 65], s[5 * 65]); o.w = cvtpk(s[6 * 65], s[7 * 65]);
        *(u32x4*)(WT + (drow0 + n + (n >= 32 ? hi_skip : 0)) * dK + k0 + 8 * c) = o; }
    LDS_WAIT(); asm volatile("" ::: "memory");
}
__device__ __forceinline__ void tr_item8(const float* W, int N, int k0, int n0, unsigned char* WT, size_t drow0, int dKb, LAS float* scr, int lane, float scale, int hi_skip = 0) {
    const int nq = lane & 15, kr = lane >> 4;
#pragma unroll
    for (int i = 0; i < 16; ++i) { const int kk = 4 * i + kr; const f32x4 v = *(const f32x4*)(W + (size_t)(k0 + kk) * N + n0 + 4 * nq);
        LAS float* d = scr + kk * 65 + 4 * nq; d[0] = v.x; d[1] = v.y; d[2] = v.z; d[3] = v.w; }
    LDS_WAIT(); asm volatile("" ::: "memory");
    const int c = lane & 3;
#pragma unroll
    for (int j = 0; j < 4; ++j) { const int n = (lane >> 2) + 16 * j; const LAS float* s = scr + (16 * c) * 65 + n;
        u32x4 o; o.x = pk_fp8x4(s[0 * 65] * scale, s[1 * 65] * scale, s[2 * 65] * scale, s[3 * 65] * scale); o.y = pk_fp8x4(s[4 * 65] * scale, s[5 * 65] * scale, s[6 * 65] * scale, s[7 * 65] * scale);
        o.z = pk_fp8x4(s[8 * 65] * scale, s[9 * 65] * scale, s[10 * 65] * scale, s[11 * 65] * scale); o.w = pk_fp8x4(s[12 * 65] * scale, s[13 * 65] * scale, s[14 * 65] * scale, s[15 * 65] * scale);
        *(u32x4*)(WT + (drow0 + n + (n >= 32 ? hi_skip : 0)) * dKb + k0 + 16 * c) = o; }
    LDS_WAIT(); asm volatile("" ::: "memory");
}
struct TrD { const float* src; int N; unsigned char* dst; int dKb, drow0, hi_skip, fp8; };
__device__ __forceinline__ void tr_load(const TrD& d, f32x4 (&v)[16], int lane) {
    const int nq = lane & 15, kr = lane >> 4;
#pragma unroll
    for (int i = 0; i < 16; ++i) v[i] = *(const f32x4*)(d.src + (size_t)(4 * i + kr) * d.N + 4 * nq);
}
__device__ __forceinline__ void tr_store(const TrD& d, const f32x4 (&v)[16], LAS float* scr, int lane) {
    const int nq = lane & 15, kr = lane >> 4;
#pragma unroll
    for (int i = 0; i < 16; ++i) { LAS float* p = scr + (4 * i + kr) * 65 + 4 * nq; p[0] = v[i].x; p[1] = v[i].y; p[2] = v[i].z; p[3] = v[i].w; }
    LDS_WAIT(); asm volatile("" ::: "memory");
    if (d.fp8) { const int c = lane & 3; const float scale = (float)(1 << MOE_WSH);
#pragma unroll
        for (int j = 0; j < 4; ++j) { const int n = (lane >> 2) + 16 * j; const LAS float* s = scr + (16 * c) * 65 + n;
            u32x4 o; o.x = pk_fp8x4(s[0 * 65] * scale, s[1 * 65] * scale, s[2 * 65] * scale, s[3 * 65] * scale); o.y = pk_fp8x4(s[4 * 65] * scale, s[5 * 65] * scale, s[6 * 65] * scale, s[7 * 65] * scale);
            o.z = pk_fp8x4(s[8 * 65] * scale, s[9 * 65] * scale, s[10 * 65] * scale, s[11 * 65] * scale); o.w = pk_fp8x4(s[12 * 65] * scale, s[13 * 65] * scale, s[14 * 65] * scale, s[15 * 65] * scale);
            *(u32x4*)(d.dst + (size_t)(d.drow0 + n + (n >= 32 ? d.hi_skip : 0)) * d.dKb + 16 * c) = o; } }
    else { const int c = lane & 7;
#pragma unroll
        for (int j = 0; j < 8; ++j) { const int n = (lane >> 3) + 8 * j; const LAS float* s = scr + (8 * c) * 65 + n;
            u32x4 o; o.x = cvtpk(s[0 * 65], s[1 * 65]); o.y = cvtpk(s[2 * 65], s[3 * 65]); o.z = cvtpk(s[4 * 65], s[5 * 65]); o.w = cvtpk(s[6 * 65], s[7 * 65]);
            *(u32x4*)(d.dst + (size_t)(d.drow0 + n + (n >= 32 ? d.hi_skip : 0)) * d.dKb + 16 * c) = o; } }
    LDS_WAIT(); asm volatile("" ::: "memory");
}
constexpr int TR_I0 = 2 * 384, TR_I1 = 2 * 256, TR_I2 = 4 * 16, TR_I3 = 16 * 81, TR_I4 = 32 * 16, TR_I5 = 128 * 256, TR_I6 = 128 * 128, TR_ITOT = TR_I0 + TR_I1 + TR_I2 + TR_I3 + TR_I4 + TR_I5 + TR_I6;
__device__ __forceinline__ TrD tr_decode(const Args& a, int it) {
    TrD d; int r = it; d.hi_skip = 0;
    if (r < TR_I5) { const int m = r / 256, q = r % 256, kb = q / 16, nb = q % 16, n0 = nb * 64, j = n0 & 511;
        d.src = a.in[I_WGU] + (size_t)m * 1024 * 1024 + (size_t)kb * 64 * 1024 + n0; d.N = 1024; d.drow0 = 256 * (j >> 7) + (j & 127) + ((n0 >= 512) ? 128 : 0);
        d.fp8 = MOE_FP8; d.dKb = MOE_FP8 ? 1024 : 2048; d.dst = (unsigned char*)(a.ws + WS_WGU) + (size_t)m * 1024 * d.dKb + (size_t)kb * 64 * (MOE_FP8 ? 1 : 2); return d; }
    r -= TR_I5;
    if (r < TR_I6) { const int m = r / 128, q = r % 128, kb = q / 16, nb = q % 16;
        d.src = a.in[I_WDN] + (size_t)m * 512 * 1024 + (size_t)kb * 64 * 1024 + nb * 64; d.N = 1024; d.drow0 = nb * 64;
        d.fp8 = MOE_FP8; d.dKb = MOE_FP8 ? 512 : 1024; d.dst = (unsigned char*)(a.ws + WS_WDN) + (size_t)m * 1024 * d.dKb + (size_t)kb * 64 * (MOE_FP8 ? 1 : 2); return d; }
    r -= TR_I6;
    if (r < TR_I0) { const int m = r / 384, q = r % 384, kb = q / 24, nb = q % 24;
        d.src = a.in[I_WQKV] + (size_t)m * 1024 * 1536 + (size_t)kb * 64 * 1536 + nb * 64; d.N = 1536; d.drow0 = (nb >> 2) * 256 + (nb & 3) * 32; d.hi_skip = 96;
        d.fp8 = ATT_FP8; d.dKb = ATT_FP8 ? 1024 : 2048; d.dst = (unsigned char*)(a.ws + WS_WQKV) + (size_t)m * 1536 * d.dKb + (size_t)kb * 64 * (ATT_FP8 ? 1 : 2); return d; }
    r -= TR_I0;
    if (r < TR_I1) { const int m = r / 256, q = r % 256, kb = q / 16, nb = q % 16;
        d.src = a.in[I_WO] + (size_t)m * 1024 * 1024 + (size_t)kb * 64 * 1024 + nb * 64; d.N = 1024; d.drow0 = nb * 64;
        d.fp8 = ATT_FP8; d.dKb = ATT_FP8 ? 1024 : 2048; d.dst = (unsigned char*)(a.ws + WS_WO) + (size_t)m * 1024 * d.dKb + (size_t)kb * 64 * (ATT_FP8 ? 1 : 2); return d; }
    r -= TR_I1;
    d.fp8 = 0;
    if (r < TR_I2) { const int m = r / 16, q = r % 16, kb = q / 4, nb = q % 4;
        d.src = a.in[I_POOLW] + (size_t)m * 256 * 256 + (size_t)kb * 64 * 256 + nb * 64; d.N = 256; d.drow0 = nb * 64; d.dKb = 512; d.dst = (unsigned char*)(a.ws + WS_WPOOL) + (size_t)m * 256 * 512 + (size_t)kb * 128; return d; }
    r -= TR_I2;
    if (r < TR_I3) { const int kb = r / 81, nb = r % 81;
        d.src = a.in[I_WIN] + (size_t)kb * 64 * 5184 + nb * 64; d.N = 5184; d.drow0 = nb * 64; d.dKb = 2048; d.dst = (unsigned char*)(a.ws + WS_WIN) + (size_t)kb * 128; return d; }
    r -= TR_I3;
    { const int kb = r / 16, nb = r % 16;
        d.src = a.in[I_WOUT] + (size_t)kb * 64 * 1024 + nb * 64; d.N = 1024; d.drow0 = nb * 64; d.dKb = 4096; d.dst = (unsigned char*)(a.ws + WS_WOUT) + (size_t)kb * 128; return d; }
}
__device__ __forceinline__ void p0_prologue(const Args& a, const Ctx& c) {
    LAS float* scr = (LAS float*)(c.lds + c.wave * 16896);
    const int gw = c.vcu * NWAVES + c.wave, NGW = c.G * NWAVES;
    { f32x4 va[16], vb[16]; TrD da, db; int it = gw;
      da = tr_decode(a, it < TR_ITOT ? it : TR_ITOT - 1); tr_load(da, va, c.lane);
      while (it < TR_ITOT) {
          const int itB = it + NGW; db = tr_decode(a, itB < TR_ITOT ? itB : TR_ITOT - 1); tr_load(db, vb, c.lane);
          tr_store(da, va, scr, c.lane);
          if (itB >= TR_ITOT) break;
          const int itA = itB + NGW; da = tr_decode(a, itA < TR_ITOT ? itA : TR_ITOT - 1); tr_load(da, va, c.lane);
          tr_store(db, vb, scr, c.lane);
          it = itA; } }
    __syncthreads();
    LAS float* sv = (LAS float*)c.lds;
    LAS float* part = (LAS float*)(c.lds + 20480);
    for (int u = c.tid; u < 5 * 1024; u += NTHREADS) { const int v = u >> 10, k = u & 1023; const float x = v < 4 ? a.in[I_C][v * 1024 + k] : a.in[I_CCTX][k]; sv[u] = x / (1.0f + expf(-x)); }
    __syncthreads();
    for (int item = blockIdx.x; item < 4 * 64; item += c.G) {
        const int li = item >> 6, c0 = (item & 63) * 96, cq = c.tid % 24, ks = c.tid / 24;
        f32x4 acc[5];
#pragma unroll
        for (int v = 0; v < 5; ++v) acc[v] = (f32x4){0.f, 0.f, 0.f, 0.f};
        if (ks < 21) { const int kbeg = ks * 49, kend = (kbeg + 49) < 1024 ? (kbeg + 49) : 1024;
            const float* w = a.in[I_WADA] + ((size_t)li * 1024 + kbeg) * 6144 + c0 + 4 * cq;
#pragma unroll 7
            for (int k = kbeg; k < kend; ++k) { const f32x4 wv = *(const f32x4*)w; w += 6144;
#pragma unroll
                for (int v = 0; v < 5; ++v) acc[v] += wv * sv[v * 1024 + k]; }
#pragma unroll
            for (int v = 0; v < 5; ++v) *(LAS f32x4*)(part + (ks * 24 + cq) * 20 + v * 4) = acc[v]; }
        __syncthreads();
        if (c.tid < 480) { const int v = c.tid / 96, col = c.tid % 96, q = col >> 2, e = col & 3; float s = 0.f;
            for (int k2 = 0; k2 < 21; ++k2) s += part[(k2 * 24 + q) * 20 + v * 4 + e];
            s += a.in[I_BADA][li * 6144 + c0 + col];
            if (v < 4) ((float*)(a.ws + WS_MODL))[(size_t)(li * 4 + v) * 6144 + c0 + col] = s; else ((float*)(a.ws + WS_MODC))[(size_t)li * 6144 + c0 + col] = s; }
        __syncthreads();
    }
    if (blockIdx.x == (unsigned)(c.G - 1)) for (int u = c.tid; u < 1024; u += NTHREADS) { const int pos = u >> 4, f = u & 15;
        const float inv = (float)pow(10000.0, -(double)f / 16.0); const double ang = (double)((float)pos * inv);
        ((f32x2*)(a.ws + WS_ROPE))[u] = (f32x2){(float)cos(ang), (float)sin(ang)}; }
    for (int u = blockIdx.x * NTHREADS + c.tid; u < 4 * 64 * 1024; u += c.G * NTHREADS) { const int li = u >> 16, n = (u >> 10) & 63, k = u & 1023;
        float w = 0.f; if (n < 4) w = a.in[I_WRG][((size_t)li * 1024 + k) * 4 + n]; else if (n < 36) w = a.in[I_WRE][((size_t)li * 1024 + k) * 32 + (n - 4)];
        const unsigned hi = cvtpk(w, 0.f) & 0xffffu; const float rem = w - bflo(hi); const unsigned lo = cvtpk(rem, 0.f) & 0xffffu;
        bf16* wr = (bf16*)(a.ws + WS_WR) + (size_t)li * 2 * 65536;
        const int fo = (((k >> 7) * 8 + ((k >> 4) & 7)) * 4 + (n >> 5)) * 512 + ((n & 31) + 32 * ((k >> 3) & 1)) * 8 + (k & 7);
        wr[fo] = (bf16)hi; wr[fo + 1024] = (bf16)lo; }
}

__device__ __forceinline__ void ph_rmix(const Args& a, const Ctx& c, int layer) {
    const int gw = c.vcu * NWAVES + c.wave, NGW = c.G * NWAVES;
    const float* g = a.in[I_NMIX] + layer * D;
    for (int r = gw; r < TT; r += NGW) {
        f32x4 v[4], h[4]; load_row_combined(a, layer, r, c.lane, v);
        if (layer > 0) { u32x2* xo = (u32x2*)((bf16*)(a.ws + WS_X) + (size_t)r * D) + c.lane;
#pragma unroll
            for (int j = 0; j < 4; ++j) xo[64 * j] = (u32x2){cvtpk(v[j].x, v[j].y), cvtpk(v[j].z, v[j].w)}; }
        const float rstd = row_rstd(v); const float* m = mod_row(a, layer, r);
        norm_mod(v, rstd, g, m, m + D, c.lane, h);
        if (ATT_FP8 && layer != 2) { unsigned* ho8 = (unsigned*)((unsigned char*)(a.ws + WS_HB) + (size_t)r * D) + c.lane;
#pragma unroll
            for (int j = 0; j < 4; ++j) ho8[64 * j] = pk_fp8x4(h[j].x, h[j].y, h[j].z, h[j].w); }
        else { u32x2* ho = (u32x2*)((bf16*)(a.ws + WS_HB) + (size_t)r * D) + c.lane;
#pragma unroll
            for (int j = 0; j < 4; ++j) ho[64 * j] = (u32x2){cvtpk(h[j].x, h[j].y), cvtpk(h[j].z, h[j].w)}; }
    }
}

__device__ __forceinline__ void ph_final(const Args& a, const Ctx& c, int layer) {
    const int gw = c.vcu * NWAVES + c.wave, NGW = c.G * NWAVES;
    float dscale = 1.f, dmark = 0.f;
#if DEBUG_CHECKS
    { unsigned* dbg = (unsigned*)(a.ws + WS_CTL) + CW_DBG; int code = 0; float mag = 0.f;
      for (int id = 1; id < 32; ++id) { const float e = __uint_as_float(__hip_atomic_load(dbg + id, __ATOMIC_RELAXED, __HIP_MEMORY_SCOPE_AGENT)); if (code == 0 && e > DBG_TOL) { code = id; mag = e; } }
      dscale = 1.f + (float)code; dmark = code ? 100.f * (1.f + fminf(fmaxf(log2f(mag / DBG_TOL), 0.f), 30.f)) : 0.f; }
#endif
    for (int r = gw; r < TL; r += NGW) {
        f32x4 v[4]; load_row_combined(a, layer, r, c.lane, v);
        const float rstd = row_rstd(v) * dscale;
        f32x4* o = (f32x4*)(a.out + (size_t)r * D) + c.lane;
#pragma unroll
        for (int j = 0; j < 4; ++j) { f32x4 ov = (v[j] * rstd) * ((const f32x4*)a.in[I_NFIN])[c.lane + 64 * j]; if (j == 0 && r == 0 && c.lane == 0 && dmark > 0.f) ov.x = dmark; o[64 * j] = ov; }
    }
}


namespace pg8 {
constexpr int BM = 256, BK = 64, HALF = 128, HTB = HALF * BK * 2, STAGE_BYTES = 8 * HTB;
__host__ __device__ __forceinline__ int lds_byte(int r, int c) { const int st = (r >> 4) * 2 + (c >> 5), rr = r & 15, cc = c & 31, ob = rr * 64 + cc * 2; return st * 1024 + (ob ^ (((ob >> 9) & 1) << 5)); }
__host__ __device__ __forceinline__ void stage_rc(int b, int& R, int& C) { const int st = b / 1024, sb = b % 1024, swz = sb ^ (((sb >> 9) & 1) << 5); R = (st >> 1) * 16 + swz / 64; C = (st & 1) * 32 + (swz % 64) / 2; }
__host__ __device__ __forceinline__ int perm32(int rho) { const int n = rho >> 4, i = rho & 15; return 8 * (i >> 2) + 4 * n + (i & 3); }
struct Unit { const char* A; const char* B; int pm, pn, x0, x1; };
__device__ __forceinline__ void tile_of(int L, int nM, int nN, int& pm, int& pn) {
    const int nwg = nM * nN; int wgid = L; { const int q = nwg / 8, r = nwg % 8, xcd = wgid % 8, off = wgid / 8; wgid = (xcd < r ? xcd * (q + 1) : r * (q + 1) + (xcd - r) * q) + off; }
    const int nig = 8 * nN, gid = wgid / nig, fm = gid * 8, gsz = (nM - fm) < 8 ? (nM - fm) : 8;
    pm = fm + ((wgid % nig) % gsz); pn = (wgid % nig) / gsz;
}
typedef int v4i_t __attribute__((ext_vector_type(4))); typedef int v8i_t __attribute__((ext_vector_type(8)));
template <class Epi, class Sched, bool GATHER, bool FP8 = false>
__device__ __forceinline__ void gemm_phase(LAS unsigned char* lds, const int Kb, const int ldab, const Sched& S, const Epi& E, const int scw = 127, const int sca = 127) {
    const int tid = tid_opaque(), wid = __builtin_amdgcn_readfirstlane(tid >> 6), lane = tid & 63, wr = wid >> 2, wc = wid & 3, fr = lane & 15, fq = lane >> 4;
    const int nt = Kb / (BK * 2);
    int scw_v = scw, sca_v = sca;
    unsigned voffA[2], voffB[2]; int RA[2], CA[2];
#pragma unroll
    for (int i = 0; i < 2; ++i) { int R, C; stage_rc(tid * 16 + i * 8192, R, C); const int Rb = Epi::PERM ? ((R & ~31) + perm32(R & 31)) : R;
        RA[i] = R; CA[i] = C; voffA[i] = (unsigned)(R * ldab + C * 2); voffB[i] = (unsigned)(Rb * Kb + C * 2); }
    const size_t kstep = (size_t)(BK * 2);
    const size_t hstepA = (size_t)HALF * ldab, hstepB = (size_t)HALF * Kb;
    const unsigned ldsw = (unsigned)wid * 1024u;
    const int aoff = lds_byte(wr * 64 + fr, fq * 8), boff = lds_byte(wc * 32 + fr, fq * 8);
#define PG8_SA(b, h) (((b) * 2 + (h)) * HTB)
#define PG8_SB(b, h) ((4 + (b) * 2 + (h)) * HTB)
#define PG8_GLDS(bufoff, gptr, i_) __builtin_amdgcn_global_load_lds((const unsigned*)(gptr), (LAS unsigned*)(lds + (bufoff) + ldsw + (i_) * 8192), 16, 0, 0)
#define PG8_STAGE_B(bufoff, gbase) do { _Pragma("unroll") for (int _i = 0; _i < 2; ++_i) PG8_GLDS(bufoff, (const char*)(gbase) + voffB[_i], _i); } while (0)
#define PG8_STAGE_A(bufoff, ab, kb, h, NX) do { _Pragma("unroll") for (int _i = 0; _i < 2; ++_i) { \
        if constexpr (GATHER) { const unsigned _vo = (NX) ? voN[h][_i] : voC[h][_i]; PG8_GLDS(bufoff, (ab) + (kb) + _vo, _i); } \
        else { PG8_GLDS(bufoff, (ab) + (kb) + (size_t)(h) * hstepA + voffA[_i], _i); } } } while (0)
#define PG8_LDA(dst, b, h) do { _Pragma("unroll") for (int m = 0; m < 4; ++m) _Pragma("unroll") for (int k = 0; k < 2; ++k) dst[m][k] = *(const LAS bf16x8*)(lds + PG8_SA(b, h) + aoff + m * 2048 + k * 1024); } while (0)
#define PG8_LDB(dst, b, h) do { _Pragma("unroll") for (int n = 0; n < 2; ++n) _Pragma("unroll") for (int k = 0; k < 2; ++k) dst[n][k] = *(const LAS bf16x8*)(lds + PG8_SB(b, h) + boff + n * 2048 + k * 1024); } while (0)
#define PG8_MMA(ai, bj, At, Bt) do { __builtin_amdgcn_s_setprio(1); _Pragma("unroll") for (int m = 0; m < 4; ++m) _Pragma("unroll") for (int n = 0; n < 2; ++n) { \
        if constexpr (FP8) { const v8i_t b8 = __builtin_shufflevector(__builtin_bit_cast(v4i_t, Bt[n][0]), __builtin_bit_cast(v4i_t, Bt[n][1]), 0, 1, 2, 3, 4, 5, 6, 7), a8 = __builtin_shufflevector(__builtin_bit_cast(v4i_t, At[m][0]), __builtin_bit_cast(v4i_t, At[m][1]), 0, 1, 2, 3, 4, 5, 6, 7); \
            asm volatile("v_mfma_scale_f32_16x16x128_f8f6f4 %0, %1, %2, %0, %3, %4 op_sel_hi:[0,0,0]" : "+v"(acc[ai][bj][m][n]) : "v"(b8), "v"(a8), "v"(scw_v), "v"(sca_v)); } \
        else { _Pragma("unroll") for (int k = 0; k < 2; ++k) acc[ai][bj][m][n] = __builtin_amdgcn_mfma_f32_16x16x32_bf16(Bt[n][k], At[m][k], acc[ai][bj][m][n], 0, 0, 0); } } __builtin_amdgcn_s_setprio(0); } while (0)
#define PG8_WAIT_V(n) asm volatile("s_waitcnt vmcnt(" #n ")" ::: "memory")
#define PG8_WAIT_L(n) asm volatile("s_waitcnt lgkmcnt(" #n ")" ::: "memory")
#define PG8_BAR __builtin_amdgcn_s_barrier()
#define PG8_SCHED __builtin_amdgcn_sched_barrier(0)
    Unit cur, nxt, pend; int ui = 0; bool have_pend = false;
    if (!S.next(0, cur)) return;
    pend = cur;
    unsigned voC[2][2], voN[2][2];
    if constexpr (GATHER) {
#pragma unroll
        for (int h = 0; h < 2; ++h)
#pragma unroll
            for (int i = 0; i < 2; ++i) { voC[h][i] = (unsigned)(S.gather(cur, h * HALF + RA[i]) * ldab + CA[i] * 2); voN[h][i] = voC[h][i]; }
    } else { voC[0][0] = voN[0][0] = 0u; }
    f32x4 acc[2][2][4][2];
#pragma unroll
    for (int a = 0; a < 2; ++a)
#pragma unroll
        for (int b = 0; b < 2; ++b)
#pragma unroll
            for (int m = 0; m < 4; ++m)
#pragma unroll
                for (int n = 0; n < 2; ++n) acc[a][b][m][n] = (f32x4){0.f, 0.f, 0.f, 0.f};
    bf16x8 At[4][2], B0[2][2], B1[2][2];
    const char* cA = cur.A; const char* cB = cur.B;
    S.a_ready(cur, wid);
    PG8_STAGE_B(PG8_SB(0, 0), cB); PG8_STAGE_B(PG8_SB(0, 1), cB + hstepB); PG8_STAGE_A(PG8_SA(0, 0), cA, (size_t)0, 0, false); PG8_STAGE_A(PG8_SA(0, 1), cA, (size_t)0, 1, false);
    if (wr == 1) PG8_BAR;
    PG8_WAIT_V(2); PG8_BAR;
    PG8_STAGE_B(PG8_SB(1, 0), cB + kstep); PG8_STAGE_A(PG8_SA(1, 0), cA, kstep, 0, false); PG8_STAGE_B(PG8_SB(1, 1), cB + hstepB + kstep);
    PG8_WAIT_V(6); PG8_BAR;
    for (;;) {
        const bool has_next = S.next(ui + 1, nxt);
        if constexpr (GATHER) { if (has_next) {
#pragma unroll
            for (int h = 0; h < 2; ++h)
#pragma unroll
                for (int i = 0; i < 2; ++i) voN[h][i] = (unsigned)(S.gather(nxt, h * HALF + RA[i]) * ldab + CA[i] * 2); } }
        const char* nA = has_next ? nxt.A : cA; const char* nB = has_next ? nxt.B : cB;
        for (int t = 0; t < nt; t += 2) {
            const bool last = (t == nt - 2);
            const size_t k1 = (size_t)(t + 1) * kstep;
            const char* a2 = last ? nA : cA; const size_t k2 = last ? (size_t)0 : (size_t)(t + 2) * kstep; const size_t k3 = k2 + kstep;
            const char* b2 = last ? nB : cB + (size_t)(t + 2) * kstep; const char* b3 = b2 + kstep;
            const bool nx = GATHER ? (last && has_next) : false;
            if (last && has_next) S.a_ready(nxt, wid);
            PG8_LDB(B0, 0, 0); PG8_LDB(B1, 0, 1); PG8_SCHED; PG8_LDA(At, 0, 0); PG8_STAGE_A(PG8_SA(1, 1), cA, k1, 1, false);
            PG8_WAIT_V(8); PG8_WAIT_L(0); PG8_BAR; PG8_MMA(0, 0, At, B0); PG8_MMA(0, 1, At, B1); PG8_BAR; PG8_SCHED;
            PG8_LDA(At, 0, 1); PG8_STAGE_B(PG8_SB(0, 0), b2); PG8_STAGE_B(PG8_SB(0, 1), b2 + hstepB); PG8_STAGE_A(PG8_SA(0, 0), a2, k2, 0, nx);
            PG8_WAIT_V(8); PG8_WAIT_L(0);
            if constexpr (!Sched::IMM_DONE) { if (have_pend) { S.done(pend, lane); have_pend = false; } }
            PG8_BAR; PG8_MMA(1, 0, At, B0); PG8_MMA(1, 1, At, B1); PG8_BAR; PG8_SCHED;
            PG8_LDB(B0, 1, 0); PG8_LDB(B1, 1, 1); PG8_SCHED; PG8_LDA(At, 1, 0); PG8_STAGE_A(PG8_SA(0, 1), a2, k2, 1, nx);
            PG8_WAIT_V(8); PG8_WAIT_L(0); PG8_BAR; PG8_MMA(0, 0, At, B0); PG8_MMA(0, 1, At, B1); PG8_BAR; PG8_SCHED;
            PG8_LDA(At, 1, 1); PG8_STAGE_B(PG8_SB(1, 0), b3); PG8_STAGE_B(PG8_SB(1, 1), b3 + hstepB); PG8_STAGE_A(PG8_SA(1, 0), a2, k3, 0, nx);
            PG8_WAIT_V(8); PG8_WAIT_L(0); PG8_BAR; PG8_MMA(1, 0, At, B0); PG8_MMA(1, 1, At, B1); PG8_BAR; PG8_SCHED;
        }
        if (wr == 0) PG8_BAR;
        if constexpr (FP8) asm volatile("s_nop 15\n\ts_nop 15" ::: "memory");
        E(acc, cur, wr, wc, fr, fq);
        if constexpr (Sched::IMM_DONE) { PG8_WAIT_V(0); S.done(cur, lane); }
        else { pend = cur; have_pend = true; }
        if (!has_next) break;
#pragma unroll
        for (int a = 0; a < 2; ++a)
#pragma unroll
            for (int b = 0; b < 2; ++b)
#pragma unroll
                for (int m = 0; m < 4; ++m)
#pragma unroll
                    for (int n = 0; n < 2; ++n) acc[a][b][m][n] = (f32x4){0.f, 0.f, 0.f, 0.f};
        cur = nxt; cA = nA; cB = nB; ++ui;
        if constexpr (GATHER) {
#pragma unroll
            for (int h = 0; h < 2; ++h)
#pragma unroll
                for (int i = 0; i < 2; ++i) voC[h][i] = voN[h][i]; }
        if (wr == 1) PG8_BAR;
    }
    PG8_WAIT_V(0);
    if constexpr (!Sched::IMM_DONE) { if (have_pend) S.done(pend, lane); }
    PG8_BAR;
#undef PG8_SA
#undef PG8_SB
#undef PG8_GLDS
#undef PG8_STAGE_A
#undef PG8_STAGE_B
#undef PG8_LDA
#undef PG8_LDB
#undef PG8_MMA
#undef PG8_WAIT_V
#undef PG8_WAIT_L
#undef PG8_BAR
#undef PG8_SCHED
}
}
#include <hip/hip_bf16.h>
#include <cmath>
namespace attn_body {
using bf16=__hip_bfloat16;
using bf16x8=__attribute__((ext_vector_type(8)))short;
using s16x4=__attribute__((ext_vector_type(4)))short;
using f32x16=__attribute__((ext_vector_type(16)))float;
using u32x4=__attribute__((ext_vector_type(4)))unsigned;
constexpr int D=64,QP=1024,KVP=256;
constexpr int NW=8,QBLK=32,QB=QBLK*NW,KVBLK=64;
__device__ __forceinline__ int crow(int r,int hi){return (r&3)+8*(r>>2)+4*hi;}
#define SBAR() __builtin_amdgcn_sched_barrier(0)
constexpr int NSLOT=3, SLOTB=8192;
constexpr int LDS_K=0, LDS_V=NSLOT*SLOTB, LDS_WS=2*NSLOT*SLOTB, LDS_OST=LDS_WS+NW*64*4, LDS_BYTES=LDS_OST+NW*4096;
constexpr float C2=0.125f*1.4426950408889634f;
__device__ __forceinline__ void glds16s(const void*sbase,unsigned voff,unsigned lds_dst){unsigned keep;
  asm volatile("s_mov_b32 %0, m0\n\ts_mov_b32 m0, %3\n\ts_nop 4\n\tglobal_load_lds_dwordx4 %1, %2\n\ts_mov_b32 m0, %0":"=&s"(keep):"v"(voff),"s"(sbase),"s"(lds_dst):"memory");}
__device__ __forceinline__ float max3f(float a,float b,float c){float r;asm("v_max3_f32 %0, %1, %2, %3":"=v"(r):"v"(a),"v"(b),"v"(c));return r;}
__device__ __forceinline__ float max2f(float a,float b){float r;asm("v_max_f32_e32 %0, %1, %2":"=v"(r):"v"(a),"v"(b));return r;}
__device__ __forceinline__ float fadd_s(float a,float b){float r;asm("v_add_f32_e32 %0, %1, %2":"=v"(r):"v"(a),"v"(b));return r;}
__device__ __forceinline__ float fsub_s(float a,float b){float r;asm("v_sub_f32_e32 %0, %1, %2":"=v"(r):"v"(a),"v"(b));return r;}
typedef float f32x2_t __attribute__((ext_vector_type(2))); typedef __bf16 bf16x2_t __attribute__((ext_vector_type(2)));
__device__ __forceinline__ unsigned cvtpk_s(float lo,float hi){f32x2_t v={lo,hi};bf16x2_t b=__builtin_convertvector(v,bf16x2_t);return __builtin_bit_cast(unsigned,b);}
#define WAIT_BAR(N) asm volatile("s_waitcnt vmcnt(" #N ") lgkmcnt(0)\n\ts_barrier":::"memory")

__device__ __forceinline__ void qkt(f32x16&p0,f32x16&p1,const char*Kslot,const bf16x8*qr,const f32x16&negm,int r32,int hi){
  const char*kb=Kslot+hi*1024+r32*16;
  #pragma unroll
  for(int d0=0;d0<4;++d0){
    const bf16x8 b0=*reinterpret_cast<const bf16x8*>(kb+d0*2048);
    const bf16x8 b1=*reinterpret_cast<const bf16x8*>(kb+d0*2048+512);
    if(d0==0){p0=__builtin_amdgcn_mfma_f32_32x32x16_bf16(b0,qr[0],negm,0,0,0);p1=__builtin_amdgcn_mfma_f32_32x32x16_bf16(b1,qr[0],negm,0,0,0);}
    else{p0=__builtin_amdgcn_mfma_f32_32x32x16_bf16(b0,qr[d0],p0,0,0,0);p1=__builtin_amdgcn_mfma_f32_32x32x16_bf16(b1,qr[d0],p1,0,0,0);}}
}
typedef __attribute__((address_space(3))) const char* lds_cptr;
typedef short v4i16_t __attribute__((ext_vector_type(4)));
__device__ __forceinline__ void kload8(bf16x8*kf,lds_cptr kp){
  kf[0]=*(const __attribute__((address_space(3))) bf16x8*)(kp);      kf[1]=*(const __attribute__((address_space(3))) bf16x8*)(kp+512);
  kf[2]=*(const __attribute__((address_space(3))) bf16x8*)(kp+2048); kf[3]=*(const __attribute__((address_space(3))) bf16x8*)(kp+2560);
  kf[4]=*(const __attribute__((address_space(3))) bf16x8*)(kp+4096); kf[5]=*(const __attribute__((address_space(3))) bf16x8*)(kp+4608);
  kf[6]=*(const __attribute__((address_space(3))) bf16x8*)(kp+6144); kf[7]=*(const __attribute__((address_space(3))) bf16x8*)(kp+6656);
}
__device__ __forceinline__ void kload2(bf16x8*kf,lds_cptr kp,int j){ kf[2*j]=*(const __attribute__((address_space(3))) bf16x8*)(kp+j*2048); kf[2*j+1]=*(const __attribute__((address_space(3))) bf16x8*)(kp+j*2048+512); }
__device__ __forceinline__ s16x4 vtr(lds_cptr p){ return __builtin_bit_cast(s16x4,__builtin_amdgcn_ds_read_tr16_b64_v4i16((__attribute__((address_space(3))) v4i16_t*)p)); }
__device__ __forceinline__ float rowmax(const f32x16&p0,const f32x16&p1){
  float a=max3f(p0[0],p0[1],p1[0]),b=max3f(p0[2],p0[3],p1[1]);a=max3f(a,p1[2],p1[3]);
  #pragma unroll
  for(int r=4;r<16;r+=4){a=max3f(a,p0[r],p0[r+1]);b=max3f(b,p0[r+2],p0[r+3]);a=max3f(a,p1[r],p1[r+1]);b=max3f(b,p1[r+2],p1[r+3]);}
  const float m=max2f(a,b);
  auto rr=__builtin_amdgcn_permlane32_swap(__float_as_uint(m),__float_as_uint(m),false,false);
  return max2f(__uint_as_float(rr[0]),__uint_as_float(rr[1]));
}
__device__ __forceinline__ void pv(f32x16*o,int vb,bf16x8 pa0,bf16x8 pa1,bf16x8 pa2,bf16x8 pa3){
  #pragma unroll
  for(int d0=0;d0<2;++d0){s16x4 lo[4],hi[4];
    #pragma unroll
    for(int ks=0;ks<4;++ks){
      asm volatile("ds_read_b64_tr_b16 %0,%1 offset:%c2":"=&v"(lo[ks]):"v"(vb),"i"(d0*4096+ks*1024):"memory");
      asm volatile("ds_read_b64_tr_b16 %0,%1 offset:%c2":"=&v"(hi[ks]):"v"(vb),"i"(d0*4096+ks*1024+512):"memory");}
    asm volatile("s_waitcnt lgkmcnt(0)":::"memory");SBAR();
    #define PK(k) (bf16x8){lo[k][0],lo[k][1],lo[k][2],lo[k][3],hi[k][0],hi[k][1],hi[k][2],hi[k][3]}
    o[d0]=__builtin_amdgcn_mfma_f32_32x32x16_bf16(pa0,PK(0),o[d0],0,0,0);
    o[d0]=__builtin_amdgcn_mfma_f32_32x32x16_bf16(pa1,PK(1),o[d0],0,0,0);
    o[d0]=__builtin_amdgcn_mfma_f32_32x32x16_bf16(pa2,PK(2),o[d0],0,0,0);
    o[d0]=__builtin_amdgcn_mfma_f32_32x32x16_bf16(pa3,PK(3),o[d0],0,0,0);
    #undef PK
  }
}

#ifndef ATTN_STORE16
#define ATTN_STORE16(p,v) (*(u32x4*)(p)=(v))
#endif
template<int THRL> __device__ __forceinline__ void attn_unit(long qrow0,int h,long kvrow0,int NT,const bf16*Q,const bf16*__restrict__ K,const bf16*__restrict__ V,bf16*O,char*shm){
  const int tid=tid_opaque(),lane=tid&63,r32=lane&31,hi=lane>>5; const int wid=__builtin_amdgcn_readfirstlane(tid>>6);
  const bf16*Qw=Q+(qrow0+wid*QBLK)*QP+h*D;
  const bf16*Kh=K+kvrow0*KVP+(h>>2)*D,*Vh=V+kvrow0*KVP+(h>>2)*D;
  const unsigned lds0=(unsigned)(uintptr_t)shm;
  float*wsf=(float*)(shm+LDS_WS)+wid*64;
  const unsigned kvo=(unsigned)(lane*KVP+wid*8)*2u;
  const unsigned vvo=(unsigned)((16*(wid&3)+(lane>>2))*KVP+(wid>>2)*32+(lane&3)*8)*2u;
  const unsigned kdst=lds0+LDS_K+wid*1024, vdst=lds0+LDS_V+wid*1024;
  #define DMA_K(t,slot) glds16s(Kh+(long)(t)*KVBLK*KVP,kvo,(unsigned)__builtin_amdgcn_readfirstlane(kdst+(slot)))
  #define DMA_V(t,slot) glds16s(Vh+(long)(t)*KVBLK*KVP,vvo,(unsigned)__builtin_amdgcn_readfirstlane(vdst+(slot)))
  const int vb0=(int)(lds0+LDS_V)+((lane>>4)&1)*32+(lane&3)*8+(4*hi+((lane&15)>>2))*64;
  const char*Kbase=shm+LDS_K; bf16x8 kf[8];
  const lds_cptr shm3=(lds_cptr)shm; const lds_cptr kp0=shm3+LDS_K+hi*1024+r32*16; const lds_cptr vp0=shm3+LDS_V+((lane>>4)&1)*32+(lane&3)*8+(4*hi+((lane&15)>>2))*64;
  DMA_K(0,0);DMA_V(0,0);DMA_K(1,SLOTB);
  bf16x8 qr[4];
  #pragma unroll
  for(int d0=0;d0<4;++d0)qr[d0]=*reinterpret_cast<const bf16x8*>(&Qw[(long)r32*QP+d0*16+hi*8]);
  float mhat=0.f,l_reg=0.f;f32x16 o[2];o[0]=f32x16{};o[1]=f32x16{};f32x16 negm=f32x16{};asm volatile("":"+v"(negm));
  #define CMASK(P0,P1,t) do{}while(0)
  bool resc=false;
  #define START(P0,P1) do{ const float rm=rowmax(P0,P1); resc=false; \
    { const float dl=rm; mhat=fadd_s(mhat,dl); \
      _Pragma("unroll") for(int r=0;r<16;++r){P0[r]=fsub_s(P0[r],dl);P1[r]=fsub_s(P1[r],dl);} \
      _Pragma("unroll") for(int r=0;r<16;++r)negm[r]=-mhat; asm volatile("":"+v"(negm)); } \
    _Pragma("unroll") for(int r=0;r<16;++r)P0[r]=__builtin_amdgcn_exp2f(P0[r]); }while(0)
  #define RESC() do{ if(resc){ asm volatile("s_waitcnt lgkmcnt(0)":::"memory"); \
      _Pragma("unroll") for(int d_=0;d_<2;++d_) _Pragma("unroll") for(int r=0;r<16;++r)o[d_][r]*=wsf[crow(r,hi)]; } }while(0)
  f32x16 pA0,pA1,pB0,pB1;
  int sl_prev=0,sl_cur=0,sl_next=SLOTB;
  #define ROT() do{sl_prev=sl_cur;sl_cur=sl_next;sl_next=(sl_next==(NSLOT-1)*SLOTB)?0:sl_next+SLOTB;}while(0)
  DMA_K(2,2*SLOTB);
  WAIT_BAR(3);
  qkt(pA0,pA1,Kbase,qr,negm,r32,hi);asm volatile("s_nop 15\n\ts_nop 7":"+v"(pA0),"+v"(pA1));CMASK(pA0,pA1,0);
  START(pA0,pA1);
  _Pragma("unroll") for(int r=0;r<16;++r)pA1[r]=__builtin_amdgcn_exp2f(pA1[r]);
  WAIT_BAR(0);
  DMA_K(3,0);DMA_V(1,SLOTB);
  ROT();
  kload8(kf,kp0+sl_cur);
  WAIT_BAR(2);
  s16x4 vlo[8],vhi[8]; u32x4 pw0,pw1,pw2,pw3;
  #define PKW(P,B) cvtpk_s(P[B],P[B+1])
  #define PAF(k) __builtin_bit_cast(bf16x8,pw##k)
  #define VFR(i) (bf16x8){vlo[i][0],vlo[i][1],vlo[i][2],vlo[i][3],vhi[i][0],vhi[i][1],vhi[i][2],vhi[i][3]}
  #define PIN(x) asm volatile("":"+v"(x))
  #define MX3(a,b,c) __builtin_fmaxf(__builtin_fmaxf((a),(b)),(c))
  #define GAPA(MF,A0,A1,A2,A3,W0,W1,PW) do{ MF; sacc+=A0; sacc+=A1; sacc+=A2; sacc+=A3; PIN(sacc); W0; W1; PIN(PW); SBAR(); }while(0)
  #define EX(v) __builtin_amdgcn_exp2f(v)
  #define GAPB(MF,X,B) do{ MF; X[B]=EX(X[B]); X[B+1]=EX(X[B+1]); X[B+2]=EX(X[B+2]); X[B+3]=EX(X[B+3]); PIN(X); SBAR(); }while(0)
  #define VRD(i) do{ vlo[i]=vtr(vp_+(((i)>>2)*4096+((i)&3)*1024)); vhi[i]=vtr(vp_+(((i)>>2)*4096+((i)&3)*1024+512)); }while(0)
  #define KRD(G,j) do{ if(G){ kload2(kf,kp0+sl_next,j); SBAR(); } }while(0)
  #define STEP(C0,C1,P0,P1,t,GK,GV,GL) do{ SBAR(); \
    const lds_cptr vp_=vp0+sl_prev; \
    VRD(0); SBAR(); float sacc=(P0[0]+P0[1]); \
    GAPA(C0=__builtin_amdgcn_mfma_f32_32x32x16_bf16(kf[0],qr[0],negm,0,0,0), P0[2],P0[3],P0[4],P0[5],     pw0[0]=PKW(P0,0), pw0[1]=PKW(P0,2), pw0); \
    VRD(4); SBAR(); GAPA(C1=__builtin_amdgcn_mfma_f32_32x32x16_bf16(kf[1],qr[0],negm,0,0,0), P0[6],P0[7],P0[8],P0[9],     pw0[2]=PKW(P0,4), pw0[3]=PKW(P0,6), pw0); \
    VRD(1); SBAR(); GAPA(C0=__builtin_amdgcn_mfma_f32_32x32x16_bf16(kf[2],qr[1],C0,0,0,0),   P0[10],P0[11],P0[12],P0[13], pw1[0]=PKW(P0,8), pw1[1]=PKW(P0,10), pw1); \
    VRD(5); SBAR(); GAPA(C1=__builtin_amdgcn_mfma_f32_32x32x16_bf16(kf[3],qr[1],C1,0,0,0),   P0[14],P0[15],P1[0],P1[1],   pw1[2]=PKW(P0,12),pw1[3]=PKW(P0,14), pw1); \
    VRD(2); SBAR(); GAPA(C0=__builtin_amdgcn_mfma_f32_32x32x16_bf16(kf[4],qr[2],C0,0,0,0),   P1[2],P1[3],P1[4],P1[5],     pw2[0]=PKW(P1,0), pw2[1]=PKW(P1,2), pw2); \
    VRD(6); SBAR(); GAPA(C1=__builtin_amdgcn_mfma_f32_32x32x16_bf16(kf[5],qr[2],C1,0,0,0),   P1[6],P1[7],P1[8],P1[9],     pw2[2]=PKW(P1,4), pw2[3]=PKW(P1,6), pw2); \
    VRD(3); SBAR(); GAPA(C0=__builtin_amdgcn_mfma_f32_32x32x16_bf16(kf[6],qr[3],C0,0,0,0),   P1[10],P1[11],P1[12],P1[13], pw3[0]=PKW(P1,8), pw3[1]=PKW(P1,10), pw3); \
    VRD(7); SBAR(); GAPA(C1=__builtin_amdgcn_mfma_f32_32x32x16_bf16(kf[7],qr[3],C1,0,0,0),   P1[14],P1[15],0.f,0.f,       pw3[2]=PKW(P1,12),pw3[3]=PKW(P1,14), pw3); \
    l_reg+=sacc; \
    if(GK){DMA_K((t)+3,sl_cur);} if(GV){DMA_V((t)+1,sl_next);} \
    CMASK(C0,C1,t); \
    { float a=MX3(C0[0],C0[1],C1[0]),b=MX3(C0[2],C0[3],C1[1]); a=MX3(a,C1[2],C1[3]); \
      _Pragma("unroll") for(int r=4;r<16;r+=4){a=MX3(a,C0[r],C0[r+1]);b=MX3(b,C0[r+2],C0[r+3]);a=MX3(a,C1[r],C1[r+1]);b=MX3(b,C1[r+2],C1[r+3]);} \
      float rm=__builtin_fmaxf(a,b); { auto rr=__builtin_amdgcn_permlane32_swap(__float_as_uint(rm),__float_as_uint(rm),false,false); rm=__builtin_fmaxf(__uint_as_float(rr[0]),__uint_as_float(rr[1])); } \
      resc=false; \
      if(__builtin_expect(__any(rm>(float)THRL),0)){ const float dl=__builtin_fmaxf(rm,0.f); mhat+=dl; \
        _Pragma("unroll") for(int r=0;r<16;++r){C0[r]-=dl;C1[r]-=dl;} \
        _Pragma("unroll") for(int r=0;r<16;++r)negm[r]=-mhat; asm volatile("":"+v"(negm)); \
        const float f=__builtin_amdgcn_exp2f(-dl); l_reg*=f; if(hi==0)wsf[r32]=f; resc=true; } } \
    SBAR(); \
    GAPB(o[0]=__builtin_amdgcn_mfma_f32_32x32x16_bf16(PAF(0),VFR(0),o[0],0,0,0), C0,0); \
    GAPB(o[1]=__builtin_amdgcn_mfma_f32_32x32x16_bf16(PAF(0),VFR(4),o[1],0,0,0), C0,4); \
    KRD(GL,0); GAPB(o[0]=__builtin_amdgcn_mfma_f32_32x32x16_bf16(PAF(1),VFR(1),o[0],0,0,0), C0,8); \
    KRD(GL,1); GAPB(o[1]=__builtin_amdgcn_mfma_f32_32x32x16_bf16(PAF(1),VFR(5),o[1],0,0,0), C0,12); \
    KRD(GL,2); GAPB(o[0]=__builtin_amdgcn_mfma_f32_32x32x16_bf16(PAF(2),VFR(2),o[0],0,0,0), C1,0); \
    KRD(GL,3); GAPB(o[1]=__builtin_amdgcn_mfma_f32_32x32x16_bf16(PAF(2),VFR(6),o[1],0,0,0), C1,4); \
    GAPB(o[0]=__builtin_amdgcn_mfma_f32_32x32x16_bf16(PAF(3),VFR(3),o[0],0,0,0), C1,8); \
    GAPB(o[1]=__builtin_amdgcn_mfma_f32_32x32x16_bf16(PAF(3),VFR(7),o[1],0,0,0), C1,12); \
    }while(0)
  int t=1;
  for(;t+5<NT;t+=2){
    STEP(pB0,pB1,pA0,pA1,t,true,true,true);     WAIT_BAR(2); RESC(); ROT();
    STEP(pA0,pA1,pB0,pB1,t+1,true,true,true);   WAIT_BAR(2); RESC(); ROT();
  }
  #define ENDW(tt) do{ if((tt)+3<NT){WAIT_BAR(2);} else if((tt)+2<NT){WAIT_BAR(1);} else {WAIT_BAR(0);} }while(0)
  for(;t+1<NT;t+=2){
    STEP(pB0,pB1,pA0,pA1,t,(t+3<NT),(t+1<NT),(t+1<NT));       ENDW(t);   RESC(); ROT();
    STEP(pA0,pA1,pB0,pB1,t+1,(t+4<NT),(t+2<NT),(t+2<NT));     ENDW(t+1); RESC(); ROT();
  }
  STEP(pB0,pB1,pA0,pA1,NT-1,false,false,false); RESC();
  { float sacc=pB0[0]+pB0[1]; _Pragma("unroll") for(int r=2;r<16;++r)sacc+=pB0[r]; _Pragma("unroll") for(int r=0;r<16;++r)sacc+=pB1[r]; l_reg+=sacc;
    pw0=(u32x4){PKW(pB0,0),PKW(pB0,2),PKW(pB0,4),PKW(pB0,6)};pw1=(u32x4){PKW(pB0,8),PKW(pB0,10),PKW(pB0,12),PKW(pB0,14)};pw2=(u32x4){PKW(pB1,0),PKW(pB1,2),PKW(pB1,4),PKW(pB1,6)};pw3=(u32x4){PKW(pB1,8),PKW(pB1,10),PKW(pB1,12),PKW(pB1,14)};
    SBAR(); pv(o,vb0+sl_cur,PAF(0),PAF(1),PAF(2),PAF(3)); }
  #undef PKW
  #undef PAF
  #undef VFR
  #undef PIN
  #undef MX3
  #undef GAPA
  #undef GAPB
  #undef EX
  #undef VRD
  #undef KRD
  #undef STEP
  #undef ENDW
  {auto rr=__builtin_amdgcn_permlane32_swap(__float_as_uint(l_reg),__float_as_uint(l_reg),false,false);l_reg=__uint_as_float(rr[0])+__uint_as_float(rr[1]);}
  if(hi==0)wsf[32+r32]=l_reg;asm volatile("s_waitcnt lgkmcnt(0)":::"memory");
  float rli[16];
  #pragma unroll
  for(int r=0;r<16;++r)rli[r]=__builtin_amdgcn_rcpf(wsf[32+crow(r,hi)]);
#if ATT_FP8
  { unsigned char*Ow8=(unsigned char*)O+(qrow0+wid*QBLK)*QP+h*D;
    unsigned char*stg8=(unsigned char*)(shm+LDS_OST)+wid*4096;
    #pragma unroll
    for(int r=0;r<16;++r){const int orow=crow(r,hi);
      #pragma unroll
      for(int d0=0;d0<2;++d0){const float x=o[d0][r]*rli[r]*(float)(1<<ATT_OSH); stg8[orow*64+d0*32+r32]=(unsigned char)(__builtin_amdgcn_cvt_pk_fp8_f32(x,x,0u,false)&0xffu);}}
    asm volatile("s_waitcnt lgkmcnt(0)":::"memory");
    #pragma unroll
    for(int i=0;i<2;++i){const int row=i*16+(lane>>2),ch=lane&3; const u32x4 v=*(const u32x4*)(stg8+row*64+ch*16); ATTN_STORE16(Ow8+(long)row*QP+ch*16,v);} }
#else
  bf16*Ow=O+(qrow0+wid*QBLK)*QP+h*D;
  { bf16*stg=(bf16*)(shm+LDS_OST)+wid*2048;
    #pragma unroll
    for(int r=0;r<16;++r){const int orow=crow(r,hi);
      #pragma unroll
      for(int d0=0;d0<2;++d0)stg[orow*64+d0*32+r32]=__float2bfloat16(o[d0][r]*rli[r]);}
    asm volatile("s_waitcnt lgkmcnt(0)":::"memory");
    #pragma unroll
    for(int i=0;i<4;++i){const int row=i*8+(lane>>3),ch=lane&7; const u32x4 v=*(const u32x4*)(stg+row*64+ch*8); ATTN_STORE16(Ow+(long)row*QP+ch*8,v);} }
#endif
  asm volatile("s_waitcnt lgkmcnt(0)\n\ts_barrier":::"memory");
  #undef DMA_K
  #undef DMA_V
  #undef CMASK
  #undef START
  #undef RESC
  #undef ROT
}
constexpr int ATTN_LDS_BYTES=LDS_BYTES;
#undef SBAR
#undef WAIT_BAR
}

typedef f32x4 AccT[2][2][4][2];
__device__ __forceinline__ long kv_row(int r) { return r < TL ? (long)(r / SEQ) * KVROWS + CTXL + (r % SEQ) : (long)((r - TL) / CTXL) * KVROWS + ((r - TL) % CTXL); }

struct SchedDense {
    static constexpr bool IMM_DONE = false;
    const char* A; const char* B; size_t astep, bstep, acol; int nM, nN, G, c;
    __device__ __forceinline__ bool next(int i, pg8::Unit& u) const {
        const int L = i * G + c; if (L >= nM * nN) return false;
        pg8::tile_of(L, nM, nN, u.pm, u.pn); u.A = A + (size_t)u.pm * astep + (size_t)u.pn * acol; u.B = B + (size_t)u.pn * bstep; u.x0 = 0; u.x1 = 0; return true; }
    __device__ __forceinline__ int gather(const pg8::Unit&, int) const { return 0; }
    __device__ __forceinline__ void a_ready(const pg8::Unit&, int) const {}
    __device__ __forceinline__ void done(const pg8::Unit&, int) const {}
};
struct SchedDenseR {
    static constexpr bool IMM_DONE = true;
    const char* A; const char* B; size_t astep, bstep, acol; int nM, nN, nF, G, c; unsigned* ready;
    __device__ __forceinline__ bool next(int i, pg8::Unit& u) const {
        const int L = i * G + c, n1 = nF * nN; if (L >= nM * nN) return false;
        if (L < n1) pg8::tile_of(L, nF, nN, u.pm, u.pn); else { u.pm = nF + (L - n1) / nN; u.pn = (L - n1) % nN; }
        u.A = A + (size_t)u.pm * astep + (size_t)u.pn * acol; u.B = B + (size_t)u.pn * bstep; u.x0 = 0; u.x1 = 0; return true; }
    __device__ __forceinline__ int gather(const pg8::Unit&, int) const { return 0; }
    __device__ __forceinline__ void a_ready(const pg8::Unit&, int) const {}
    __device__ __forceinline__ void done(const pg8::Unit& u, int lane) const { if (lane == 0) __hip_atomic_fetch_add(ready + u.pm, 1u, __ATOMIC_RELAXED, __HIP_MEMORY_SCOPE_AGENT); }
};
struct SchedOutproj {
    static constexpr bool IMM_DONE = true;
    const char* A; const char* B; size_t astep, bstep; int G, c; const unsigned* rdg; unsigned* ready;
    __device__ __forceinline__ bool next(int i, pg8::Unit& u) const {
        int n;
        if (G == 256) { if (c >= 32) { if (i == 0) n = c - 32; else if (i == 1 && c < 64) n = 224 + (c - 32); else return false; } else { if (i == 0 && c < 16) n = 256 + c; else return false; } }
        else { n = i * G + c; if (n >= 272) return false; }
        u.pm = n >> 2; u.pn = n & 3; u.A = A + (size_t)u.pm * astep; u.B = B + (size_t)u.pn * bstep; u.x0 = 0; u.x1 = 0; return true; }
    __device__ __forceinline__ int gather(const pg8::Unit&, int) const { return 0; }
    __device__ __forceinline__ void a_ready(const pg8::Unit& u, int wid) const {
        if (wid == 0) { unsigned sp = 0;
            while ((unsigned)__builtin_amdgcn_readfirstlane(__hip_atomic_load(rdg + u.pm, __ATOMIC_RELAXED, __HIP_MEMORY_SCOPE_AGENT)) < 8u) { __builtin_amdgcn_s_sleep(2); if (++sp > (1u << 22)) break; }
            __builtin_amdgcn_fence(__ATOMIC_ACQUIRE, "agent"); asm volatile("s_waitcnt vmcnt(0)" ::: "memory"); }
        __builtin_amdgcn_s_barrier(); asm volatile("" ::: "memory");
    }
    __device__ __forceinline__ void done(const pg8::Unit& u, int lane) const { if (lane == 0) __hip_atomic_fetch_add(ready + u.pm, 1u, __ATOMIC_RELAXED, __HIP_MEMORY_SCOPE_AGENT); }
};
struct SchedQKV {
    static constexpr bool IMM_DONE = false;
    const char* A; const char* B; size_t tstep; int ctxq, G, c;
    __device__ __forceinline__ bool next(int i, pg8::Unit& u) const {
        const int L = i * G + c, n1 = 64 * 6, n2 = ctxq ? 24 : 8; if (L >= n1 + n2) return false;
        if (L < n1) pg8::tile_of(L, 64, 6, u.pm, u.pn);
        else if (ctxq) { pg8::tile_of(L - n1, 4, 6, u.pm, u.pn); u.pm += 64; }
        else { u.pm = 64 + ((L - n1) >> 1); u.pn = 4 + ((L - n1) & 1); }
        u.A = A + (size_t)u.pm * tstep; u.B = B + (size_t)u.pn * tstep; u.x0 = 0; u.x1 = 0; return true; }
    __device__ __forceinline__ int gather(const pg8::Unit&, int) const { return 0; }
    __device__ __forceinline__ void a_ready(const pg8::Unit&, int) const {}
    __device__ __forceinline__ void done(const pg8::Unit&, int) const {}
};
struct SchedMoe {
    static constexpr bool IMM_DONE = false;
    const char* Abase; size_t astep; const char* Bbase; size_t bstep_e, bstep_n; const LAS int* tab; const int* list; int G, c;
    unsigned* ready; int mode;
    __device__ __forceinline__ int T(int i) const { return __builtin_amdgcn_readfirstlane(tab[i]); }
    __device__ __forceinline__ bool next(int i, pg8::Unit& u) const {
        const int ntiles = T(32); int gt, pn;
        if (G == 256) {
            const int x = c & 7, j = c >> 3, g = (mode == 2 ? 7 - x : x) + 8 * i, fm = 8 * g; if (fm >= ntiles) return false;
            const int gsz = (ntiles - fm) < 8 ? (ntiles - fm) : 8; if (j >= 4 * gsz) return false;
            gt = fm + j % gsz; pn = j / gsz; }
        else { const int L = i * G + (mode == 2 ? G - 1 - c : c); if (L >= ntiles * 4) return false; pg8::tile_of(L, ntiles, 4, gt, pn); }
        int e = 0;
        for (int q = 1; q < 32; ++q) e += (T(q) <= gt) ? 1 : 0;
        const int ti = gt - T(e); int valid = T(40 + e) - ti * 256; valid = valid > 256 ? 256 : valid;
        u.pm = gt; u.pn = pn; u.x0 = e * MOE_CAP + ti * 256; u.x1 = valid;
        u.A = Abase + (size_t)gt * astep; u.B = Bbase + (size_t)e * bstep_e + (size_t)pn * bstep_n; return true; }
    __device__ __forceinline__ int gather(const pg8::Unit& u, int lr) const { return lr < u.x1 ? (list[u.x0 + lr] >> 1) : 0; }
    __device__ __forceinline__ void a_ready(const pg8::Unit& u, int wid) const {
        if (mode != 2) return;
        if (wid == 0) { unsigned sp = 0;
            while ((unsigned)__builtin_amdgcn_readfirstlane(__hip_atomic_load(ready + u.pm, __ATOMIC_RELAXED, __HIP_MEMORY_SCOPE_AGENT)) < 32u) { __builtin_amdgcn_s_sleep(2); if (++sp > (1u << 22)) break; }
            __builtin_amdgcn_fence(__ATOMIC_ACQUIRE, "agent"); asm volatile("s_waitcnt vmcnt(0)" ::: "memory"); }
        __builtin_amdgcn_s_barrier(); asm volatile("" ::: "memory");
    }
    __device__ __forceinline__ void done(const pg8::Unit& u, int lane) const {
        if (mode != 1) return;
        if (lane == 0) __hip_atomic_fetch_add(ready + u.pm, 1u, __ATOMIC_RELAXED, __HIP_MEMORY_SCOPE_AGENT);
    }
};

struct EpiQKV { static constexpr bool PERM = true; bf16* Q; bf16* Kb; bf16* Vb; const float* qg; const float* kg; const f32x2* tab;
    __device__ __forceinline__ void operator()(const AccT& acc, const pg8::Unit& u, int wr, int wc, int fr, int fq) const {
        bf16* base; int pitch; long row0;
        if (u.pn < 4) { base = Q + u.pn * 256; pitch = 1024; row0 = (long)u.pm * 256; }
        else { base = (u.pn == 4) ? Kb : Vb; pitch = 256; row0 = kv_row(u.pm * 256); }
        const bool isv = u.pn == 5, lat = u.pm < 64; const float* g = u.pn < 4 ? qg : kg; const float post = u.pn < 4 ? 0.125f * 1.4426950408889634f : 1.0f;
#pragma unroll
        for (int ai = 0; ai < 2; ++ai)
#pragma unroll
            for (int m = 0; m < 4; ++m) { int fq_ = fq; asm volatile("" : "+v"(fq_));
                const int fq = fq_; const int lr = ai * 128 + wr * 64 + m * 16 + fr; const unsigned roff = (unsigned)(((int)row0 + lr) * pitch + wc * 64 + 8 * fq) * 2u;
                f32x4 g0[2], g1[2];
#pragma unroll
                for (int bj = 0; bj < 2; ++bj) { g0[bj] = *(const f32x4*)(g + 32 * bj + 8 * fq); g1[bj] = *(const f32x4*)(g + 32 * bj + 8 * fq + 4); }
                f32x4 v[2][2];
#pragma unroll
                for (int bj = 0; bj < 2; ++bj) { v[bj][0] = acc[ai][bj][m][0]; v[bj][1] = acc[ai][bj][m][1]; }
                if (!isv) {
                    float ss = 0.f;
#pragma unroll
                    for (int bj = 0; bj < 2; ++bj)
#pragma unroll
                        for (int n = 0; n < 2; ++n) ss += (v[bj][n][0] * v[bj][n][0] + v[bj][n][1] * v[bj][n][1]) + (v[bj][n][2] * v[bj][n][2] + v[bj][n][3] * v[bj][n][3]);
                    ss += __shfl_xor(ss, 16); ss += __shfl_xor(ss, 32);
                    const float rstd = rsqrtf(ss * (1.0f / 64.0f) + EPS);
#pragma unroll
                    for (int bj = 0; bj < 2; ++bj) { v[bj][0] = v[bj][0] * rstd * g0[bj]; v[bj][1] = v[bj][1] * rstd * g1[bj]; }
                    if (lat) { const int t = (u.pm * 256 + lr) & (SEQ - 1);
#pragma unroll
                        for (int bj = 0; bj < 2; ++bj) { const f32x2* tb = (const f32x2*)((const char*)tab + (unsigned)(((bj == 0 ? (t >> 6) : (t & 63)) * 16 + 4 * fq) * 8));
#pragma unroll
                            for (int n = 0; n < 2; ++n)
#pragma unroll
                                for (int e = 0; e < 2; ++e) { const f32x2 cs = tb[2 * n + e]; const float x0 = v[bj][n][2 * e], x1 = v[bj][n][2 * e + 1];
                                    v[bj][n][2 * e] = x0 * cs.x - x1 * cs.y; v[bj][n][2 * e + 1] = x0 * cs.y + x1 * cs.x; } } }
#pragma unroll
                    for (int bj = 0; bj < 2; ++bj) { v[bj][0] = v[bj][0] * post; v[bj][1] = v[bj][1] * post; }
                }
#pragma unroll
                for (int bj = 0; bj < 2; ++bj)
                    *(u32x4*)((char*)base + roff + bj * 64) = (u32x4){cvtpk(v[bj][0][0], v[bj][0][1]), cvtpk(v[bj][0][2], v[bj][0][3]), cvtpk(v[bj][1][0], v[bj][1][1]), cvtpk(v[bj][1][2], v[bj][1][3])}; }
    }
};
template <bool PERM_> struct EpiResidT { static constexpr bool PERM = PERM_; const Args* a; int layer; const float* pscale; const bf16* srcbase;
    __device__ __forceinline__ void operator()(const AccT& acc, const pg8::Unit& u, int wr, int wc, int, int) const {
        int ln; asm volatile("v_mbcnt_lo_u32_b32 %0, -1, 0\n\tv_mbcnt_hi_u32_b32 %0, -1, %0" : "=v"(ln)); const int fr = ln & 15, fq = ln >> 4;
        const int r0 = u.pm * 256;
        const float* gate = mod_row(*a, layer, r0) + 2 * D;
        const bool f32src = (layer == 0) && !srcbase; const float* src32 = resid_row(*a, 0, r0); const bf16* src16 = (srcbase ? srcbase : (const bf16*)(a->ws + WS_X)) + (size_t)r0 * D;
        const __amdgpu_buffer_rsrc_t rs = __builtin_amdgcn_make_buffer_rsrc((void*)(a->ws + WS_X), 0, TT * D * 2, 0x00020000);
        if constexpr (PERM_) {
#pragma unroll
        for (int bj = 0; bj < 2; ++bj) { const int cc = u.pn * 256 + bj * 128 + wc * 32 + 8 * fq;
            f32x4 g0 = *(const f32x4*)(gate + cc), g1 = *(const f32x4*)(gate + cc + 4); if (pscale) { g0 = g0 * *(const f32x4*)(pscale + cc); g1 = g1 * *(const f32x4*)(pscale + cc + 4); }
#pragma unroll
            for (int ai = 0; ai < 2; ++ai)
#pragma unroll
                for (int m = 0; m < 4; ++m) { const int off = (ai * 128 + wr * 64 + m * 16 + fr) * D + cc;
                    f32x4 s0, s1;
                    if (f32src) { s0 = *(const f32x4*)(src32 + off); s1 = *(const f32x4*)(src32 + off + 4); }
                    else { const u32x4 p = *(const u32x4*)(src16 + off); s0 = (f32x4){bflo(p.x), bfhi(p.x), bflo(p.y), bfhi(p.y)}; s1 = (f32x4){bflo(p.z), bfhi(p.z), bflo(p.w), bfhi(p.w)}; }
                    const f32x4 o0 = s0 + g0 * acc[ai][bj][m][0], o1 = s1 + g1 * acc[ai][bj][m][1];
                    __builtin_amdgcn_raw_buffer_store_b128((u32x4){cvtpk(o0.x, o0.y), cvtpk(o0.z, o0.w), cvtpk(o1.x, o1.y), cvtpk(o1.z, o1.w)}, rs, (r0 * D + off) * 2, 0, 16  ); }
            asm volatile("" ::: "memory"); }
        } else {
#pragma unroll
        for (int bj = 0; bj < 2; ++bj)
#pragma unroll
            for (int n = 0; n < 2; ++n) { const int cc = u.pn * 256 + bj * 128 + wc * 32 + n * 16 + 4 * fq; f32x4 g = *(const f32x4*)(gate + cc); if (pscale) g = g * *(const f32x4*)(pscale + cc);
#pragma unroll
                for (int ai = 0; ai < 2; ++ai)
#pragma unroll
                    for (int m = 0; m < 4; ++m) { const int off = (ai * 128 + wr * 64 + m * 16 + fr) * D + cc;
                        f32x4 s0;
                        if (f32src) s0 = *(const f32x4*)(src32 + off);
                        else { const u32x2 p = *(const u32x2*)(src16 + off); s0 = (f32x4){bflo(p.x), bfhi(p.x), bflo(p.y), bfhi(p.y)}; }
                        const f32x4 o0 = s0 + g * acc[ai][bj][m][n];
                        __builtin_amdgcn_raw_buffer_store_b64((u32x2){cvtpk(o0.x, o0.y), cvtpk(o0.z, o0.w)}, rs, (r0 * D + off) * 2, 0, 16  ); }
                asm volatile("" ::: "memory"); }
        }
    }
};
typedef EpiResidT<true> EpiResid; typedef EpiResidT<false> EpiResidN;
struct EpiGateUp { static constexpr bool PERM = true; bf16* act;
    __device__ __forceinline__ void operator()(const AccT& acc, const pg8::Unit& u, int wr, int wc, int fr, int fq) const {
        const __amdgpu_buffer_rsrc_t rs = __builtin_amdgcn_make_buffer_rsrc((void*)act, 0, 43008 * 512 * 2, 0x00020000);
#pragma unroll
        for (int ai = 0; ai < 2; ++ai)
#pragma unroll
            for (int m = 0; m < 4; ++m) { const int off = (int)((((size_t)u.pm * 256 + ai * 128 + wr * 64 + m * 16 + fr) * 512 + u.pn * 128 + wc * 32 + 8 * fq) * 2);
                const f32x4 g0 = acc[ai][0][m][0], g1 = acc[ai][0][m][1], u0 = acc[ai][1][m][0], u1 = acc[ai][1][m][1];
                const u32x4 ov = (u32x4){cvtpk(silu_f(g0[0]) * u0[0], silu_f(g0[1]) * u0[1]), cvtpk(silu_f(g0[2]) * u0[2], silu_f(g0[3]) * u0[3]),
                                     cvtpk(silu_f(g1[0]) * u1[0], silu_f(g1[1]) * u1[1]), cvtpk(silu_f(g1[2]) * u1[2], silu_f(g1[3]) * u1[3])};
#if MOE_FP8
                { const float sa = (float)(1 << MOE_ASH); const u32x2 o8 = (u32x2){pk_fp8x4(silu_f(g0[0]) * u0[0] * sa, silu_f(g0[1]) * u0[1] * sa, silu_f(g0[2]) * u0[2] * sa, silu_f(g0[3]) * u0[3] * sa),
                                                                                    pk_fp8x4(silu_f(g1[0]) * u1[0] * sa, silu_f(g1[1]) * u1[1] * sa, silu_f(g1[2]) * u1[2] * sa, silu_f(g1[3]) * u1[3] * sa)};
                  (void)ov; __builtin_amdgcn_raw_buffer_store_b64(o8, rs, off >> 1, 0, 16  ); } }
#else
                __builtin_amdgcn_raw_buffer_store_b128(ov, rs, off, 0, 16  ); }
#endif
    }
};
struct EpiDown { static constexpr bool PERM = true; const int* list; const float* w2; bf16* y2;
    __device__ __forceinline__ void operator()(const AccT& acc, const pg8::Unit& u, int wr, int wc, int fr, int fq) const {
#pragma unroll
        for (int ai = 0; ai < 2; ++ai)
#pragma unroll
            for (int m = 0; m < 4; ++m) { const int lr = ai * 128 + wr * 64 + m * 16 + fr;
                if (lr < u.x1) { const int dest = list[u.x0 + lr]; const float w = w2[dest]; bf16* p = y2 + (size_t)dest * D + u.pn * 256 + wc * 32 + 8 * fq;
#pragma unroll
                    for (int bj = 0; bj < 2; ++bj) { const f32x4 v0 = acc[ai][bj][m][0] * w, v1 = acc[ai][bj][m][1] * w;
                        *(u32x4*)(p + bj * 128) = (u32x4){cvtpk(v0[0], v0[1]), cvtpk(v0[2], v0[3]), cvtpk(v1[0], v1[1]), cvtpk(v1[2], v1[3])}; } } }
    }
};

constexpr int TAB_OFF = 135168;

__device__ __forceinline__ void ph_rope(const Args& a, const Ctx& c, int layer) {
    const int j = layer == 0 ? 0 : 1; const bool ctxq = layer == 0;
    const float* qg = a.in[I_QG] + j * 64; const float* kg = a.in[I_KG] + j * 64;
    const f32x2* tab = (const f32x2*)(a.ws + WS_ROPE);
    bf16* Qb = (bf16*)(a.ws + WS_Q); bf16* Kb = (bf16*)(a.ws + WS_K);
    const int nitems = TT * 20;
    for (int it = blockIdx.x * NTHREADS + c.tid; it < nitems; it += c.G * NTHREADS) {
        const int r = it / 20, hs = it % 20;
        if (hs < 16 && r >= TL && !ctxq) continue;
        bf16* p; const float* g; float post;
        if (hs < 16) { p = Qb + (size_t)r * 1024 + hs * 64; g = qg; post = 0.125f * 1.4426950408889634f; } else { p = Kb + kv_row(r) * 256 + (hs - 16) * 64; g = kg; post = 1.0f; }
        float x[64]; float ss = 0.f;
#pragma unroll
        for (int i = 0; i < 8; ++i) { const u32x4 w = ((const u32x4*)p)[i];
            x[8 * i + 0] = bflo(w.x); x[8 * i + 1] = bfhi(w.x); x[8 * i + 2] = bflo(w.y); x[8 * i + 3] = bfhi(w.y);
            x[8 * i + 4] = bflo(w.z); x[8 * i + 5] = bfhi(w.z); x[8 * i + 6] = bflo(w.w); x[8 * i + 7] = bfhi(w.w); }
#pragma unroll
        for (int i = 0; i < 64; ++i) ss += x[i] * x[i];
        const float rstd = rsqrtf(ss * (1.0f / 64.0f) + EPS);
#pragma unroll
        for (int i = 0; i < 64; ++i) x[i] = x[i] * rstd * g[i];
        if (r < TL) { const int t = r % SEQ, rp = t >> 6, cp = t & 63;
#pragma unroll
            for (int i = 0; i < 32; ++i) { const f32x2 cs = tab[(i < 16 ? rp : cp) * 16 + (i & 15)]; const float x0 = x[2 * i], x1 = x[2 * i + 1];
                x[2 * i] = x0 * cs.x - x1 * cs.y; x[2 * i + 1] = x0 * cs.y + x1 * cs.x; } }
#pragma unroll
        for (int i = 0; i < 8; ++i) ((u32x4*)p)[i] = (u32x4){cvtpk(x[8 * i] * post, x[8 * i + 1] * post), cvtpk(x[8 * i + 2] * post, x[8 * i + 3] * post),
                                                            cvtpk(x[8 * i + 4] * post, x[8 * i + 5] * post), cvtpk(x[8 * i + 6] * post, x[8 * i + 7] * post)};
    }
}

__device__ __forceinline__ void ph_att(const Args& a, const Ctx& c, int layer, char* lds_generic) {
    const int nun = 1024 + (layer == 0 ? 64 : 0);
    const attn_body::bf16* Qb = (const attn_body::bf16*)(a.ws + WS_Q); const attn_body::bf16* Kb = (const attn_body::bf16*)(a.ws + WS_K); const attn_body::bf16* Vb = (const attn_body::bf16*)(a.ws + WS_V);
    for (int U = c.vcu; U < nun; U += c.G) {
        long qrow0, kv0; int h, NT;
        if (U < 1024) { const int bh = U >> 4, qb = U & 15, b = bh >> 4; h = bh & 15; qrow0 = (long)b * SEQ + qb * 256; kv0 = (long)b * KVROWS; NT = KVROWS / 64; }
        else { const int q = U - 1024, b = q >> 4; h = q & 15; qrow0 = (long)TL + b * CTXL; kv0 = (long)b * KVROWS; NT = CTXL / 64; }
        attn_body::attn_unit<8>(qrow0, h, kv0, NT, Qb, Kb, Vb, (attn_body::bf16*)(a.ws + WS_HB), lds_generic);
    }
}

__device__ __forceinline__ void ph_m1(const Args& a, const Ctx& c, int layer, const unsigned* rdy, int nN, int amode) {
    const int Tm = layer == 3 ? TL : TT, ntiles = Tm / 32;
    int tl0, tl1, tl2;
    { int bid = (int)blockIdx.x; asm volatile("" : "+s"(bid));
      if (amode == 1 && c.G == 256 && ntiles == 544) {
          int k = c.vcu - 64; asm volatile("" : "+s"(k));
          if (k < 0) { tl0 = -1; tl1 = -1; tl2 = -1; } else { tl0 = k; tl1 = k + 192; tl2 = k < 64 ? k + 384 : (k < 160 ? 448 + (k - 64) : -1); } }
      else if (c.G == 256 && ntiles == 544) { if (bid < 16) { tl0 = 512 + bid; tl1 = -1; tl2 = -1; } else { const int j = bid - 16; tl0 = j; tl1 = j + 240; tl2 = j < 32 ? j + 480 : (j < 48 ? 528 + (j - 32) : -1); } }
      else { tl0 = bid < ntiles ? bid : -1; tl1 = bid + c.G < ntiles ? bid + c.G : -1; tl2 = bid + 2 * c.G < ntiles ? bid + 2 * c.G : -1; } }
    const unsigned need = 8u * (unsigned)nN;
#define M1_WAIT(tl) do { if (c.wave == 0) { unsigned sp_ = 0; \
        while ((unsigned)__builtin_amdgcn_readfirstlane(__hip_atomic_load(rdy + ((tl) >> 3), __ATOMIC_RELAXED, __HIP_MEMORY_SCOPE_AGENT)) < need) { __builtin_amdgcn_s_sleep(2); if (++sp_ > (1u << 22)) break; } \
        __builtin_amdgcn_fence(__ATOMIC_ACQUIRE, "agent"); asm volatile("s_waitcnt vmcnt(0)" ::: "memory"); } \
        __syncthreads(); } while (0)
    const float* g = a.in[I_NFFN] + layer * D;
    constexpr int RP = 2064;
    LAS unsigned char* hiT = c.lds; LAS unsigned char* loT = c.lds + 32 * RP;
    LAS float* part = (LAS float*)c.lds;
    LAS int* lcnt = (LAS int*)(c.lds + 133120); LAS int* lbase = lcnt + 32;
    LAS float* logit = (LAS float*)(c.lds + 134144);
    const bf16* wr = (const bf16*)(a.ws + WS_WR) + (size_t)layer * 2 * 65536;
    unsigned* gcnt = (unsigned*)(a.ws + WS_CTL) + CW_CNT + layer * 32;
    int* list = (int*)(a.ws + WS_LIST); float* w2 = (float*)(a.ws + WS_W2);
    const int r32 = c.lane & 31, hi = c.lane >> 5;
    if (c.tid < 32) lcnt[c.tid] = 0;
    u32x2 vr[4][4];
#define M1_LOADROWS(tl) do { _Pragma("unroll") for (int i = 0; i < 4; ++i) { const u32x2* xr = (const u32x2*)((const bf16*)(a.ws + WS_X) + (size_t)((tl) * 32 + 4 * c.wave + i) * D) + c.lane; \
        _Pragma("unroll") for (int j = 0; j < 4; ++j) vr[i][j] = xr[64 * j]; } } while (0)
    if (tl0 >= 0) { M1_WAIT(tl0); M1_LOADROWS(tl0); }
    int nmine = 0;
    for (; nmine < 3; ++nmine) { const int tile = nmine == 0 ? tl0 : nmine == 1 ? tl1 : tl2, tnext = nmine == 0 ? tl1 : nmine == 1 ? tl2 : -1;
        if (tile < 0) break;
        const int r0 = tile * 32;
        { f32x4 gs[4], sh[4];
          { const float* m = mod_row(a, layer, r0);
#pragma unroll
            for (int j = 0; j < 4; ++j) { gs[j] = ((const f32x4*)g)[c.lane + 64 * j] * (((const f32x4*)(m + 4 * D))[c.lane + 64 * j] + 1.0f); sh[j] = ((const f32x4*)(m + 3 * D))[c.lane + 64 * j]; } }
#pragma unroll
          for (int i = 0; i < 4; ++i) { const int lr = 4 * c.wave + i, r = r0 + lr;
            f32x4 h[4], vv[4];
#pragma unroll
            for (int j = 0; j < 4; ++j) { const u32x2 p = vr[i][j]; vv[j] = (f32x4){bflo(p.x), bfhi(p.x), bflo(p.y), bfhi(p.y)}; }
            const float rstd = row_rstd(vv);
#pragma unroll
            for (int j = 0; j < 4; ++j) h[j] = (vv[j] * rstd) * gs[j] + sh[j];
#if MOE_FP8
            unsigned* to8 = (unsigned*)((unsigned char*)(a.ws + WS_TK) + (size_t)r * D) + c.lane;
#else
            u32x2* to = (u32x2*)((bf16*)(a.ws + WS_TK) + (size_t)r * D) + c.lane;
#endif
#pragma unroll
            for (int j = 0; j < 4; ++j) { const unsigned h0 = cvtpk(h[j].x, h[j].y), h1 = cvtpk(h[j].z, h[j].w);
                const unsigned l0 = cvtpk(h[j].x - bflo(h0), h[j].y - bfhi(h0)), l1 = cvtpk(h[j].z - bflo(h1), h[j].w - bfhi(h1));
#if MOE_FP8
                to8[64 * j] = pk_fp8x4(h[j].x, h[j].y, h[j].z, h[j].w);
#else
                to[64 * j] = (u32x2){h0, h1};
#endif
                *(LAS u32x2*)(hiT + lr * RP + (4 * c.lane + 256 * j) * 2) = (u32x2){h0, h1};
                *(LAS u32x2*)(loT + lr * RP + (4 * c.lane + 256 * j) * 2) = (u32x2){l0, l1}; } } }
        __syncthreads();
        f32x16 acc0 = {}, acc1 = {};
#pragma unroll
        for (int kk = 0; kk < 8; ++kk) { const int k0 = 128 * c.wave + 16 * kk + 8 * hi;
            const bf16x8 ahi = *(const LAS bf16x8*)(hiT + r32 * RP + k0 * 2), alo = *(const LAS bf16x8*)(loT + r32 * RP + k0 * 2);
            const bf16* wf = wr + (c.wave * 8 + kk) * 2048 + c.lane * 8;
            const bf16x8 b0h = *(const bf16x8*)wf, b1h = *(const bf16x8*)(wf + 512), b0l = *(const bf16x8*)(wf + 1024), b1l = *(const bf16x8*)(wf + 1536);
            acc0 = __builtin_amdgcn_mfma_f32_32x32x16_bf16(ahi, b0h, acc0, 0, 0, 0); acc1 = __builtin_amdgcn_mfma_f32_32x32x16_bf16(ahi, b1h, acc1, 0, 0, 0);
            acc0 = __builtin_amdgcn_mfma_f32_32x32x16_bf16(alo, b0h, acc0, 0, 0, 0); acc1 = __builtin_amdgcn_mfma_f32_32x32x16_bf16(alo, b1h, acc1, 0, 0, 0);
            acc0 = __builtin_amdgcn_mfma_f32_32x32x16_bf16(ahi, b0l, acc0, 0, 0, 0); acc1 = __builtin_amdgcn_mfma_f32_32x32x16_bf16(ahi, b1l, acc1, 0, 0, 0); }
        if (tnext >= 0) { M1_WAIT(tnext); M1_LOADROWS(tnext); }
        else __syncthreads();
#pragma unroll
        for (int reg = 0; reg < 16; ++reg) { part[((c.wave * 2 + 0) * 16 + reg) * 64 + c.lane] = acc0[reg]; part[((c.wave * 2 + 1) * 16 + reg) * 64 + c.lane] = acc1[reg]; }
        __syncthreads();
        if (nmine < 3) {
#pragma unroll
            for (int q = 0; q < 4; ++q) { const int idx = c.tid + 512 * q, nt = idx >> 10, reg = (idx >> 6) & 15, ln = idx & 63; float s = 0.f;
#pragma unroll
                for (int w = 0; w < 8; ++w) s += part[((w * 2 + nt) * 16 + reg) * 64 + ln];
                logit[(nmine * 32 + (reg & 3) + 8 * (reg >> 2) + 4 * (ln >> 5)) * 64 + nt * 32 + (ln & 31)] = s; } }
        __syncthreads();
    }
#undef M1_LOADROWS
#undef M1_WAIT
    int e0 = 0, e1 = 0, p0 = 0, p1 = 0; float w0 = 0.f, w1 = 0.f; const int myt = c.tid >> 5; const bool act_r = c.tid < 96 && myt < nmine;
    if (act_r) { const LAS float* lg = logit + c.tid * 64;
        int grp = 0; float gm = lg[0];
#pragma unroll
        for (int q = 1; q < 4; ++q) if (lg[q] > gm) { gm = lg[q]; grp = q; }
        float den = 0.f;
#pragma unroll
        for (int q = 0; q < 4; ++q) den += expf(lg[q] - gm);
        const float gate = 1.0f / den;
        const LAS float* le = lg + 4 + grp * 8;
        int i0 = 0; float v0 = le[0];
#pragma unroll
        for (int q = 1; q < 8; ++q) if (le[q] > v0) { v0 = le[q]; i0 = q; }
        int i1 = -1; float v1 = -3.0e38f;
#pragma unroll
        for (int q = 0; q < 8; ++q) if (q != i0 && le[q] > v1) { v1 = le[q]; i1 = q; }
        const float ex = expf(v1 - v0); w0 = gate / (1.0f + ex); w1 = gate * ex / (1.0f + ex);
        e0 = grp * 8 + i0; e1 = grp * 8 + i1;
        p0 = __hip_atomic_fetch_add(lcnt + e0, 1, __ATOMIC_RELAXED, __HIP_MEMORY_SCOPE_WORKGROUP);
        p1 = __hip_atomic_fetch_add(lcnt + e1, 1, __ATOMIC_RELAXED, __HIP_MEMORY_SCOPE_WORKGROUP); }
    __syncthreads();
    if (c.tid < 32) { const int n = lcnt[c.tid]; lbase[c.tid] = n ? (int)__hip_atomic_fetch_add(gcnt + c.tid, (unsigned)n, __ATOMIC_RELAXED, __HIP_MEMORY_SCOPE_AGENT) : 0; }
    __syncthreads();
    if (act_r) { const int r = (myt == 0 ? tl0 : myt == 1 ? tl1 : tl2) * 32 + (c.tid & 31);
        list[e0 * MOE_CAP + lbase[e0] + p0] = 2 * r; w2[2 * r] = w0;
        list[e1 * MOE_CAP + lbase[e1] + p1] = 2 * r + 1; w2[2 * r + 1] = w1; }
    __syncthreads();
}
__device__ __forceinline__ void moe_tables(const Args& a, const Ctx& c, int layer, LAS int* tab) {
    unsigned* gcnt = (unsigned*)(a.ws + WS_CTL) + CW_CNT + layer * 32;
    if (c.tid < 32) tab[40 + c.tid] = (int)__hip_atomic_load(gcnt + c.tid, __ATOMIC_RELAXED, __HIP_MEMORY_SCOPE_AGENT);
    __syncthreads();
    if (c.tid == 0) { int s = 0; for (int e = 0; e < 32; ++e) { tab[e] = s; s += (tab[40 + e] + 255) >> 8; } tab[32] = s; }
    __syncthreads();
}

__device__ __forceinline__ void ph_rpool(const Args& a, const Ctx& c, int layer) {
    constexpr int TR = 34, HR = TR + 15;
    LAS unsigned char* hs = c.lds;
    const float* g = a.in[I_NMIX] + layer * D;
    for (int tile = blockIdx.x; tile < TT / TR; tile += c.G) {
        const int r0 = tile * TR;
        for (int lr0 = c.wave; lr0 < HR; lr0 += 2 * NWAVES) {
            const int lrA = lr0, lrB = lr0 + NWAVES; const int grA = r0 - 8 + lrA, grB = r0 - 8 + lrB;
            const bool okA = grA >= 0 && grA < TT, okB = lrB < HR && grB >= 0 && grB < TT;
            const int cA = grA < 0 ? 0 : (grA > TT - 1 ? TT - 1 : grA), cB = grB < 0 ? 0 : (grB > TT - 1 ? TT - 1 : grB);
            f32x4 vA[4], vB[4], h[4]; load_row_combined(a, layer, cA, c.lane, vA); load_row_combined(a, layer, cB, c.lane, vB);
            if (okA) {
                if (lrA >= 8 && lrA < 8 + TR) { u32x2* xo = (u32x2*)((bf16*)(a.ws + WS_Z) + (size_t)grA * D) + c.lane;
#pragma unroll
                    for (int j = 0; j < 4; ++j) xo[64 * j] = (u32x2){cvtpk(vA[j].x, vA[j].y), cvtpk(vA[j].z, vA[j].w)}; }
                const float rstd = row_rstd(vA); const float* m = mod_row(a, layer, grA);
                norm_mod(vA, rstd, g, m, m + D, c.lane, h);
#pragma unroll
                for (int j = 0; j < 4; ++j) *(LAS u32x2*)(hs + lrA * 2048 + (4 * c.lane + 256 * j) * 2) = (u32x2){cvtpk(h[j].x, h[j].y), cvtpk(h[j].z, h[j].w)}; }
            if (okB) {
                if (lrB >= 8 && lrB < 8 + TR) { u32x2* xo = (u32x2*)((bf16*)(a.ws + WS_Z) + (size_t)grB * D) + c.lane;
#pragma unroll
                    for (int j = 0; j < 4; ++j) xo[64 * j] = (u32x2){cvtpk(vB[j].x, vB[j].y), cvtpk(vB[j].z, vB[j].w)}; }
                const float rstd = row_rstd(vB); const float* m = mod_row(a, layer, grB);
                norm_mod(vB, rstd, g, m, m + D, c.lane, h);
#pragma unroll
                for (int j = 0; j < 4; ++j) *(LAS u32x2*)(hs + lrB * 2048 + (4 * c.lane + 256 * j) * 2) = (u32x2){cvtpk(h[j].x, h[j].y), cvtpk(h[j].z, h[j].w)}; } }
        __syncthreads();
        { const int half = 1 << (c.tid >> 7);
          const LAS unsigned* col = (const LAS unsigned*)hs + c.tid;
          float sx = 0.f, sy = 0.f;
          unsigned* ho = (unsigned*)((bf16*)(a.ws + WS_HB) + (size_t)r0 * D) + c.tid;
          for (int t = 0; t < TR; ++t) { const int gr = r0 + t;
              const int s0 = gr < TL ? (gr / SEQ) * SEQ : TL + ((gr - TL) / CTXL) * CTXL, s1 = s0 + (gr < TL ? SEQ : CTXL);
              const int lo = (gr - half) > s0 ? (gr - half) : s0, hi = (gr + half) < s1 ? (gr + half) : s1;
              if (t == 0 || gr == s0) { sx = 0.f; sy = 0.f;
                  for (int w = lo; w < hi; ++w) { const unsigned u = col[(w - r0 + 8) * 512]; sx += bflo(u); sy += bfhi(u); } }
              else { if (gr + half - 1 < s1) { const unsigned w = col[(t + 8 + half - 1) * 512]; sx += bflo(w); sy += bfhi(w); }
                     if (gr - 1 - half >= s0) { const unsigned w = col[(t + 8 - 1 - half) * 512]; sx -= bflo(w); sy -= bfhi(w); } }
              const float inv = __builtin_amdgcn_rcpf((float)(hi - lo)); const unsigned u = col[(t + 8) * 512];
              ho[t * 512] = cvtpk(sx * inv - bflo(u), sy * inv - bfhi(u)); } }
        __syncthreads();
    }
}

struct EpiInproj { static constexpr bool PERM = true; bf16* Z; bf16* XBC; float* DT; const float* dtb;
    __device__ __forceinline__ void operator()(const AccT& acc, const pg8::Unit& u, int wr, int wc, int fr, int fq) const {
        const size_t r0 = (size_t)u.pm * 256;
        if (u.pn < 20) { bf16* base; int pitch; if (u.pn < 8) { base = Z + u.pn * 256; pitch = 2048; } else { base = XBC + (u.pn - 8) * 256; pitch = 3072; }
#pragma unroll
            for (int ai = 0; ai < 2; ++ai)
#pragma unroll
                for (int m = 0; m < 4; ++m) { bf16* rowp = base + (r0 + ai * 128 + wr * 64 + m * 16 + fr) * pitch + wc * 32 + 8 * fq;
#pragma unroll
                    for (int bj = 0; bj < 2; ++bj) { const f32x4 v0 = acc[ai][bj][m][0], v1 = acc[ai][bj][m][1];
                        *(u32x4*)(rowp + bj * 128) = (u32x4){cvtpk(v0[0], v0[1]), cvtpk(v0[2], v0[3]), cvtpk(v1[0], v1[1]), cvtpk(v1[2], v1[3])}; } }
        } else if (wc < 2) { const int col = wc * 32 + 8 * fq; const f32x4 b0 = *(const f32x4*)(dtb + col), b1 = *(const f32x4*)(dtb + col + 4);
#pragma unroll
            for (int ai = 0; ai < 2; ++ai)
#pragma unroll
                for (int m = 0; m < 4; ++m) { float* p = DT + (r0 + ai * 128 + wr * 64 + m * 16 + fr) * 64 + col; f32x4 v0 = acc[ai][0][m][0] + b0, v1 = acc[ai][0][m][1] + b1;
#pragma unroll
                    for (int e = 0; e < 4; ++e) { v0[e] = fmaxf(v0[e], 0.f) + log1pf(__expf(-fabsf(v0[e]))); v1[e] = fmaxf(v1[e], 0.f) + log1pf(__expf(-fabsf(v1[e]))); }
                    *(f32x4*)p = v0; *(f32x4*)(p + 4) = v1; } }
    }
};

__device__ __forceinline__ void ph_conv(const Args& a, const Ctx& c) {
    LAS unsigned char* tin = c.lds; LAS unsigned char* toT = c.lds + 17408; LAS unsigned char* toN = c.lds + 34816;
    const bf16* xbc = (const bf16*)(a.ws + WS_XBC);
    u32x4 pin[3];
#define CONV_PREFETCH(tk) do { const int ci_ = (tk) / 48, chb_ = (tk) % 48, r0_ = ci_ * 128, ch0_ = chb_ * 64; \
        _Pragma("unroll") for (int q = 0; q < 3; ++q) { int p = c.tid + 512 * q; p = p < 131 * 8 ? p : 131 * 8 - 1; const int lr = p >> 3, pc = p & 7; int row = r0_ - 2 + lr; row = row < 0 ? 0 : (row > TT - 1 ? TT - 1 : row); \
            pin[q] = *(const u32x4*)(xbc + (size_t)row * 3072 + ch0_ + pc * 8); } } while (0)
    { const int t0 = (int)blockIdx.x < NCH * 48 ? (int)blockIdx.x : NCH * 48 - 1; CONV_PREFETCH(t0); }
    for (int task = blockIdx.x; task < NCH * 48; task += c.G) {
        const int ci = task / 48, chb = task % 48, r0 = ci * 128, ch0 = chb * 64;
        const bool first = ci < 128 ? (ci % 32 == 0) : (((ci - 128) & 1) == 0), last = ci < 128 ? (ci % 32 == 31) : (((ci - 128) & 1) == 1);
        const int ch = c.tid & 63, tq = c.tid >> 6; const float* cw = a.in[I_CONVW] + ch0 + ch;
        const float w0 = cw[0], w1 = cw[3072], w2 = cw[2 * 3072], w3 = cw[3 * 3072], bias = a.in[I_CONVB][ch0 + ch];
#pragma unroll
        for (int q = 0; q < 3; ++q) { const int p = c.tid + 512 * q, lr = p >> 3; const bool zero = (lr < 2 && first) || (lr == 130 && last);
            if (p < 131 * 8) *(LAS u32x4*)(tin + lr * 128 + (p & 7) * 16) = zero ? (u32x4){0u, 0u, 0u, 0u} : pin[q]; }
        __syncthreads();
        { const int tn = task + c.G < NCH * 48 ? task + c.G : NCH * 48 - 1; CONV_PREFETCH(tn); }
        {
          float xin[19];
#pragma unroll
          for (int i = 0; i < 19; ++i) xin[i] = bf2f(*(const LAS bf16*)(tin + (16 * tq + i) * 128 + ch * 2));
          float o[16];
#pragma unroll
          for (int i = 0; i < 16; ++i) o[i] = silu_f(bias + w0 * xin[i] + w1 * xin[i + 1] + w2 * xin[i + 2] + w3 * xin[i + 3]);
          if (chb < 40) { *(LAS u32x4*)(toT + ch * 272 + tq * 32) = (u32x4){cvtpk(o[0], o[1]), cvtpk(o[2], o[3]), cvtpk(o[4], o[5]), cvtpk(o[6], o[7])};
                          *(LAS u32x4*)(toT + ch * 272 + tq * 32 + 16) = (u32x4){cvtpk(o[8], o[9]), cvtpk(o[10], o[11]), cvtpk(o[12], o[13]), cvtpk(o[14], o[15])}; }
          if (chb >= 32) {
#pragma unroll
              for (int i = 0; i < 16; ++i) *(LAS bf16*)(toN + (16 * tq + i) * 144 + ch * 2) = (bf16)(cvtpk(o[i], 0.f) & 0xffffu); } }
        __syncthreads();
        if (chb < 40) { bf16* dst = chb < 32 ? (bf16*)(a.ws + WS_XT) + ((size_t)ci * 2048 + ch0) * 128 : (bf16*)(a.ws + WS_BT) + ((size_t)ci * 512 + (ch0 - 2048)) * 128;
#pragma unroll
            for (int q = 0; q < 2; ++q) { const int p = c.tid + 512 * q, chl = p >> 4, pc = p & 15; *(u32x4*)(dst + chl * 128 + pc * 8) = *(const LAS u32x4*)(toT + chl * 272 + pc * 16); } }
        if (chb >= 32) { bf16* dst = chb < 40 ? (bf16*)(a.ws + WS_BN) + (size_t)r0 * 512 + (ch0 - 2048) : (bf16*)(a.ws + WS_CN) + (size_t)r0 * 512 + (ch0 - 2560);
#pragma unroll
            for (int q = 0; q < 2; ++q) { const int p = c.tid + 512 * q, t = p >> 3, pc = p & 7; *(u32x4*)(dst + (size_t)t * 512 + pc * 8) = *(const LAS u32x4*)(toN + t * 144 + pc * 16); } }
        __syncthreads();
    }
#undef CONV_PREFETCH
    const int gw = c.vcu * NWAVES + c.wave, NGW = c.G * NWAVES;
    const float* dt = (const float*)(a.ws + WS_DT);
    for (int item = gw; item < NCH * 32; item += NGW) { const int ci = item >> 5, h = item & 31, r0 = ci * 128 + 2 * c.lane;
        const float af = -expf(a.in[I_ALOG][h]), ab = -expf(a.in[I_ALOG][32 + h]);
        const float dtf0 = dt[(size_t)r0 * 64 + h], dtf1 = dt[(size_t)(r0 + 1) * 64 + h], dtb0 = dt[(size_t)r0 * 64 + 32 + h], dtb1 = dt[(size_t)(r0 + 1) * 64 + 32 + h];
        const float laf0 = dtf0 * af, laf1 = dtf1 * af, lab0 = dtb0 * ab, lab1 = dtb1 * ab;
        float inf_ = laf0 + laf1, inb = lab0 + lab1; const float pf = inf_, pbk = inb;
#pragma unroll
        for (int o = 1; o < 64; o <<= 1) { const float t1 = __shfl_up(inf_, o), t2 = __shfl_up(inb, o); if (c.lane >= o) { inf_ += t1; inb += t2; } }
        const float totf = __shfl(inf_, 63), totb = __shfl(inb, 63);
        const float exf = inf_ - pf, exb = inb - pbk;
        const float cf0 = exf + laf0, cf1 = inf_, pb0 = exb, pb1 = exb + lab0;
        f32x4* sca = (f32x4*)(a.ws + WS_SCA) + ((size_t)ci * 32 + h) * 128 + 2 * c.lane; f32x4* scb = (f32x4*)(a.ws + WS_SCB) + ((size_t)ci * 32 + h) * 128 + 2 * c.lane;
        { const float L2E = 1.4426950408889634f;
          sca[0] = (f32x4){cf0 * L2E, pb0 * L2E, cf0 * L2E - __log2f(dtf0), pb0 * L2E + __log2f(dtb0)}; sca[1] = (f32x4){cf1 * L2E, pb1 * L2E, cf1 * L2E - __log2f(dtf1), pb1 * L2E + __log2f(dtb1)}; }
        scb[0] = (f32x4){__expf(cf0), __expf(totb - pb0), dtf0 * __expf(totf - cf0), dtb0 * __expf(pb0)};
        scb[1] = (f32x4){__expf(cf1), __expf(totb - pb1), dtf1 * __expf(totf - cf1), dtb1 * __expf(pb1)};
        { float* wsc = (float*)(a.ws + WS_Q) + ((size_t)(ci * 32 + h) * 2) * 128 + 2 * c.lane;
          *(f32x2*)wsc = (f32x2){dtf0 * __expf(totf - cf0), dtf1 * __expf(totf - cf1)}; *(f32x2*)(wsc + 128) = (f32x2){dtb0 * __expf(pb0), dtb1 * __expf(pb1)}; }
        if (c.lane == 0) ((f32x2*)(a.ws + WS_DEC))[ci * 32 + h] = (f32x2){__expf(totf), __expf(totb)}; }
}

__device__ __forceinline__ void ph_scan(const Args& a, const Ctx& c) {
    constexpr int P = 272, BUF = 53248;
    LAS unsigned char* stg = c.lds + 2 * BUF + c.wave * 2048;
    const int r32 = c.lane & 31, hi = c.lane >> 5, pt = c.wave >> 2, nt = c.wave & 3;
    for (int task = c.vcu; task < 256; task += c.G) { const int b = task >> 6, dir = (task >> 5) & 1, h = task & 31, g = h >> 3;
        f32x16 acc = {};
        u32x4 xrA[2], brA[4], xrB[2], brB[4]; f32x4 wA0 = {}, wA1 = {}, wB0 = {}, wB1 = {}; f32x2 decA = {}, decB = {};
#define SCAN_CI(k) (dir == 0 ? ((k) < 2 ? 128 + 2 * b + (k) : 32 * b + ((k) - 2)) : ((k) < 2 ? 128 + 2 * b + 1 - (k) : 32 * b + 31 - ((k) - 2)))
#define SCAN_LOAD(k, xr, br, w0, w1, dcr) do { const int ci_ = SCAN_CI(k); const bf16* xs_ = (const bf16*)(a.ws + WS_XT) + ((size_t)ci_ * 2048 + 64 * h) * 128; const bf16* bs_ = (const bf16*)(a.ws + WS_BT) + ((size_t)ci_ * 512 + 128 * g) * 128; \
        _Pragma("unroll") for (int q = 0; q < 2; ++q) xr[q] = ((const u32x4*)xs_)[c.tid + 512 * q]; _Pragma("unroll") for (int q = 0; q < 4; ++q) br[q] = ((const u32x4*)bs_)[c.tid + 512 * q]; \
        { const f32x4* wp_ = (const f32x4*)((const float*)(a.ws + WS_Q) + ((size_t)(ci_ * 32 + h) * 2 + dir) * 128) + 2 * (c.tid & 15); w0 = wp_[0]; w1 = wp_[1]; }        \
        dcr = ((const f32x2*)(a.ws + WS_DEC))[ci_ * 32 + h]; } while (0)
#define SCAN_WRITE(bi, xr, br, w0, w1) do { LAS unsigned char* xb_ = c.lds + (bi) * BUF; LAS unsigned char* bb_ = xb_ + 17408;        \
        _Pragma("unroll") for (int q = 0; q < 2; ++q) { const int p = c.tid + 512 * q; const u32x4 v_ = xr[q]; \
            *(LAS u32x4*)(xb_ + (p >> 4) * P + (p & 15) * 16) = (u32x4){cvtpk(bflo(v_.x) * w0.x, bfhi(v_.x) * w0.y), cvtpk(bflo(v_.y) * w0.z, bfhi(v_.y) * w0.w), cvtpk(bflo(v_.z) * w1.x, bfhi(v_.z) * w1.y), cvtpk(bflo(v_.w) * w1.z, bfhi(v_.w) * w1.w)}; } \
        _Pragma("unroll") for (int q = 0; q < 4; ++q) { const int p = c.tid + 512 * q; *(LAS u32x4*)(bb_ + (p >> 4) * P + (p & 15) * 16) = br[q]; } } while (0)
#define SCAN_STEP(k, cur, dcr) do { const int ci = SCAN_CI(k); \
            { bf16* hin = (bf16*)(a.ws + WS_HIN) + (((size_t)ci * 2 + dir) * 32 + h) * 8192; \
              _Pragma("unroll") for (int r = 0; r < 16; ++r) *(LAS bf16*)(stg + ((r & 3) + 8 * (r >> 2) + 4 * hi) * 64 + r32 * 2) = (bf16)(cvtpk(acc[r], 0.f) & 0xffffu); \
              LDS_WAIT(); \
              _Pragma("unroll") for (int i = 0; i < 2; ++i) { const int row = (c.lane >> 2) + 16 * i, pc = c.lane & 3; *(u32x4*)(hin + (size_t)(32 * pt + row) * 128 + 32 * nt + pc * 8) = *(const LAS u32x4*)(stg + row * 64 + pc * 16); } } \
            const float dec = dir == 0 ? dcr.x : dcr.y; \
            _Pragma("unroll") for (int r = 0; r < 16; ++r) acc[r] *= dec; \
            { LAS unsigned char* xb = c.lds + (cur) * BUF; LAS unsigned char* bb = xb + 17408; \
              _Pragma("unroll") for (int kk = 0; kk < 8; ++kk) { const int s8 = 16 * kk + 8 * hi; \
                  const bf16x8 xs = *(const LAS bf16x8*)(xb + (32 * pt + r32) * P + s8 * 2), bfrag = *(const LAS bf16x8*)(bb + (32 * nt + r32) * P + s8 * 2); \
                  acc = __builtin_amdgcn_mfma_f32_32x32x16_bf16(xs, bfrag, acc, 0, 0, 0); } } } while (0)
        f32x2 dcur0, dcur1;
        SCAN_LOAD(0, xrA, brA, wA0, wA1, decA); SCAN_LOAD(1, xrB, brB, wB0, wB1, decB); SCAN_WRITE(0, xrA, brA, wA0, wA1); dcur0 = decA;
        __syncthreads();
        for (int k = 0; k < 34; k += 2) {
            { const int kn = k + 2 < 34 ? k + 2 : 33; SCAN_LOAD(kn, xrA, brA, wA0, wA1, decA); }
            SCAN_STEP(k, 0, dcur0);
            SCAN_WRITE(1, xrB, brB, wB0, wB1); dcur1 = decB;
            __syncthreads();
            { const int kn = k + 3 < 34 ? k + 3 : 33; SCAN_LOAD(kn, xrB, brB, wB0, wB1, decB); }
            SCAN_STEP(k + 1, 1, dcur1);
            SCAN_WRITE(0, xrA, brA, wA0, wA1); dcur0 = decA;
            __syncthreads();
        }
#undef SCAN_CI
#undef SCAN_LOAD
#undef SCAN_WRITE
#undef SCAN_STEP
    }
}

__device__ __forceinline__ int crow16(int r, int hi) { return (r & 3) + 8 * (r >> 2) + 4 * hi; }
__device__ __forceinline__ void ph_yph(const Args& a, const Ctx& c, unsigned* rdg) {
    constexpr int P = 272, ZP = 144;
    LAS unsigned char* Cs = c.lds; LAS unsigned char* Bs = c.lds + 34816; LAS unsigned char* xs = c.lds + 69632; LAS unsigned char* hf = c.lds + 87040; LAS unsigned char* hb = c.lds + 104448;
    LAS unsigned char* zs = c.lds + 121856; LAS unsigned char* os = c.lds + 140288; LAS f32x4* sca = (LAS f32x4*)(c.lds + 158720); LAS f32x2* scb = (LAS f32x2*)(c.lds + 160768);
    LAS float* sbv = (LAS float*)(c.lds + 161792); LAS float* scv = (LAS float*)(c.lds + 162304); LAS float* ssql = (LAS float*)(c.lds + 34816);
    const int lb = c.wave & 3, pb = c.wave >> 2;
    SECT_DECL
    for (int task = c.vcu; task < NCH * 4; task += c.G) { const int ci = task >> 2, g = task & 3, r0 = ci * 128;
        int tid_t = c.tid; asm volatile("" : "+v"(tid_t));
        f32x16 X[4]; int l0;
        u32x4 pxt[2], phf[2], phb[2], pz[2]; f32x4 ps1 = {}; f32x4 ps4 = {};
#define YPH_PREFETCH(hq) do { const int h_ = 8 * g + (hq); const u32x4* xt_ = (const u32x4*)((const bf16*)(a.ws + WS_XT) + ((size_t)ci * 2048 + 64 * h_) * 128); \
            const u32x4* hfg_ = (const u32x4*)((const bf16*)(a.ws + WS_HIN) + (((size_t)ci * 2 + 0) * 32 + h_) * 8192); const u32x4* hbg_ = (const u32x4*)((const bf16*)(a.ws + WS_HIN) + (((size_t)ci * 2 + 1) * 32 + h_) * 8192); \
            const bf16* zg_ = (const bf16*)(a.ws + WS_Z) + (size_t)r0 * 2048 + 64 * h_; \
            _Pragma("unroll") for (int q = 0; q < 2; ++q) { const int p = tidp + 512 * q; pxt[q] = __builtin_nontemporal_load(xt_ + p); phf[q] = __builtin_nontemporal_load(hfg_ + p); phb[q] = __builtin_nontemporal_load(hbg_ + p); \
                pz[q] = __builtin_nontemporal_load((const u32x4*)(zg_ + (size_t)(p >> 3) * 2048 + (p & 7) * 8)); }        \
            ps1 = ((const f32x4*)(a.ws + WS_SCA))[((size_t)ci * 32 + h_) * 128 + (tidp & 127)]; ps4 = ((const f32x4*)(a.ws + WS_SCB))[((size_t)ci * 32 + h_) * 128 + (tidp & 127)]; } while (0)
        { const int tid = tid_t, lane = tid & 63, r32 = lane & 31, hi = lane >> 5; l0 = 32 * lb + r32;
          { const bf16* cn = (const bf16*)(a.ws + WS_CN) + (size_t)r0 * 512 + 128 * g; const bf16* bn = (const bf16*)(a.ws + WS_BN) + (size_t)r0 * 512 + 128 * g;
#pragma unroll
            for (int q = 0; q < 4; ++q) { const int p = tid + 512 * q, row = p >> 4, pc = p & 15;
                *(LAS u32x4*)(Cs + row * P + pc * 16) = *(const u32x4*)(cn + (size_t)row * 512 + pc * 8); *(LAS u32x4*)(Bs + row * P + pc * 16) = *(const u32x4*)(bn + (size_t)row * 512 + pc * 8); } }
          { const int tidp = tid; YPH_PREFETCH(0); }
          __syncthreads();
#pragma unroll
          for (int sb = 0; sb < 4; ++sb) { X[sb] = (f32x16){};
#pragma unroll
              for (int kk = 0; kk < 8; ++kk) { const int k8 = (16 * kk + 8 * hi) * 2;
                  X[sb] = __builtin_amdgcn_mfma_f32_32x32x16_bf16(*(const LAS bf16x8*)(Bs + (32 * sb + r32) * P + k8), *(const LAS bf16x8*)(Cs + (32 * lb + r32) * P + k8), X[sb], 0, 0, 0); } }
        }
        SECT(0);
        float ssq = 0.f;
#pragma unroll 1
        for (int hh = 0; hh < 8; ++hh) { const int h = 8 * g + hh;
            int tid = c.tid; asm volatile("" : "+v"(tid)); const int lane = tid & 63, r32 = lane & 31, hi = lane >> 5, l = 32 * lb + r32; (void)lane;
            const float dsum = a.in[I_DSK][h] + a.in[I_DSK][32 + h];
            __syncthreads();
            SECT(1);
            if (hh > 0) { bf16* gg = (bf16*)(a.ws + WS_G) + (size_t)r0 * 2048 + 64 * (h - 1);
#pragma unroll
                for (int q = 0; q < 2; ++q) { const int p = tid + 512 * q, zr = p >> 3, zc = p & 7; *(u32x4*)(gg + (size_t)zr * 2048 + zc * 8) = *(const LAS u32x4*)(os + zr * ZP + zc * 16); } }
#pragma unroll
            for (int q = 0; q < 2; ++q) { const int p = tid + 512 * q, row = p >> 4, pc = p & 15;
                *(LAS u32x4*)(xs + row * P + pc * 16) = pxt[q]; *(LAS u32x4*)(hf + row * P + pc * 16) = phf[q]; *(LAS u32x4*)(hb + row * P + pc * 16) = phb[q];
                *(LAS u32x4*)(zs + (p >> 3) * ZP + (p & 7) * 16) = pz[q]; }
            if (tid < 128) { sca[tid] = ps1; scb[tid] = (f32x2){ps4.x, ps4.y}; sbv[tid] = ps1.z; scv[tid] = ps1.w; }
            __syncthreads();
            SECT(2);
            if (hh < 7) { const int tidp = tid; YPH_PREFETCH(hh + 1); }
            SECT(3);
            const f32x4 me = sca[l]; const f32x2 ee = scb[l];
            const float dtb_l = __builtin_amdgcn_exp2f(me.w - me.y);
            f32x16 accd = {};
#pragma unroll
            for (int sb = 0; sb < 4; ++sb) { unsigned mp[8];
#pragma unroll
                for (int q = 0; q < 4; ++q) { const int s0 = 32 * sb + 8 * q + 4 * hi; float mv[4];
                    if (sb < lb) { const f32x4 bs4 = *(const LAS f32x4*)(sbv + s0);
#pragma unroll
                        for (int e = 0; e < 4; ++e) mv[e] = X[sb][4 * q + e] * __builtin_amdgcn_exp2f(me.x - bs4[e]); }
                    else if (sb > lb) { const f32x4 cs4 = *(const LAS f32x4*)(scv + s0);
#pragma unroll
                        for (int e = 0; e < 4; ++e) mv[e] = X[sb][4 * q + e] * __builtin_amdgcn_exp2f(cs4[e] - me.y); }
                    else { const f32x4 bs4 = *(const LAS f32x4*)(sbv + s0), cs4 = *(const LAS f32x4*)(scv + s0);
#pragma unroll
                        for (int e = 0; e < 4; ++e) { const int s = s0 + e; const float t = (s <= l) ? (me.x - bs4[e]) : (cs4[e] - me.y); const float xv = X[sb][4 * q + e];
                            float m = xv * __builtin_amdgcn_exp2f(t); if (s == l) m += xv * dtb_l + dsum; mv[e] = m; } }
                    mp[2 * q] = cvtpk(mv[0], mv[1]); mp[2 * q + 1] = cvtpk(mv[2], mv[3]); }
#pragma unroll
                for (int t = 0; t < 2; ++t) { const int sof = (32 * sb + 16 * t + 4 * hi) * 2;
                    const u32x2 lo = *(const LAS u32x2*)(xs + (32 * pb + r32) * P + sof), h2 = *(const LAS u32x2*)(xs + (32 * pb + r32) * P + sof + 16);
                    const u32x4 af = (u32x4){lo.x, lo.y, h2.x, h2.y}, bfm = (u32x4){mp[4 * t], mp[4 * t + 1], mp[4 * t + 2], mp[4 * t + 3]};
                    accd = __builtin_amdgcn_mfma_f32_32x32x16_bf16(__builtin_bit_cast(bf16x8, af), __builtin_bit_cast(bf16x8, bfm), accd, 0, 0, 0); }
                }
            SECT(4);
#pragma unroll
            for (int dd = 0; dd < 2; ++dd) { f32x16 acco = {}; LAS unsigned char* hx = dd == 0 ? hf : hb;
#pragma unroll
                for (int kk = 0; kk < 8; ++kk) { const int k8 = (16 * kk + 8 * hi) * 2;
                    acco = __builtin_amdgcn_mfma_f32_32x32x16_bf16(*(const LAS bf16x8*)(hx + (32 * pb + r32) * P + k8), *(const LAS bf16x8*)(Cs + (32 * lb + r32) * P + k8), acco, 0, 0, 0); }
                const float ex = dd == 0 ? ee.x : ee.y;
#pragma unroll
                for (int r = 0; r < 16; ++r) accd[r] += ex * acco[r]; }
            SECT(5);
#pragma unroll
            for (int q = 0; q < 4; ++q) { const int pcol = 32 * pb + 8 * q + 4 * hi; const u32x2 zq = *(const LAS u32x2*)(zs + l * ZP + pcol * 2);
                float gv[4];
#pragma unroll
                for (int e = 0; e < 4; ++e) { const int r = 4 * q + e; const float y = accd[r];
                    const float z = (e == 0) ? bflo(zq.x) : (e == 1) ? bfhi(zq.x) : (e == 2) ? bflo(zq.y) : bfhi(zq.y); gv[e] = y * silu_f(z); ssq += gv[e] * gv[e]; }
                *(LAS u32x2*)(os + l * ZP + pcol * 2) = (u32x2){cvtpk(gv[0], gv[1]), cvtpk(gv[2], gv[3])}; }
            SECT(6);
        }
#undef YPH_PREFETCH
        __syncthreads();
        { bf16* gg = (bf16*)(a.ws + WS_G) + (size_t)r0 * 2048 + 64 * (8 * g + 7);
#pragma unroll
          for (int q = 0; q < 2; ++q) { const int p = c.tid + 512 * q, zr = p >> 3, zc = p & 7; *(u32x4*)(gg + (size_t)zr * 2048 + zc * 8) = *(const LAS u32x4*)(os + zr * ZP + zc * 16); } }
        ssq += __shfl_xor(ssq, 32);
        if ((c.lane >> 5) == 0) ssql[pb * 128 + l0] = ssq;
        __syncthreads();
        if (c.tid < 128) ssql[256 + c.tid] = rsqrtf((ssql[c.tid] + ssql[128 + c.tid]) * (1.0f / 512.0f) + EPS);
        VM_WAIT();
        __syncthreads();
        { bf16* gt = (bf16*)(a.ws + WS_G) + (size_t)r0 * 2048 + 512 * g; const float* ng = a.in[I_SNORM] + 512 * g;
          const __amdgpu_buffer_rsrc_t grs = __builtin_amdgcn_make_buffer_rsrc((void*)(a.ws + WS_G), 0, TT * 2048 * 2, 0x00020000);
          const f32x4 g0 = *(const f32x4*)(ng + (c.tid & 63) * 8), g1 = *(const f32x4*)(ng + (c.tid & 63) * 8 + 4);
#pragma unroll 1
          for (int qb = 0; qb < 2; ++qb) { u32x4 gv8[8]; int tidq = c.tid + 4096 * qb; asm volatile("" : "+v"(tidq));
#pragma unroll
            for (int q = 0; q < 8; ++q) { const int p = tidq + 512 * q; gv8[q] = *(const u32x4*)(gt + (size_t)(p >> 6) * 2048 + (p & 63) * 8); }
#pragma unroll
            for (int q = 0; q < 8; ++q) { const int p = tidq + 512 * q, row = p >> 6, col = (p & 63) * 8; const u32x4 v = gv8[q]; const float sr = ssql[256 + row];
              __builtin_amdgcn_raw_buffer_store_b128((u32x4){cvtpk(bflo(v.x) * sr * g0.x, bfhi(v.x) * sr * g0.y), cvtpk(bflo(v.y) * sr * g0.z, bfhi(v.y) * sr * g0.w), cvtpk(bflo(v.z) * sr * g1.x, bfhi(v.z) * sr * g1.y), cvtpk(bflo(v.w) * sr * g1.z, bfhi(v.w) * sr * g1.w)},
                  grs, ((r0 + row) * 2048 + 512 * g + col) * 2, 0, 16  ); } } }
        VM_WAIT();
        __syncthreads();
        if (c.tid == 0) __hip_atomic_fetch_add(rdg + (ci >> 1), 1u, __ATOMIC_RELAXED, __HIP_MEMORY_SCOPE_AGENT);
        SECT(7);
    }
    SECT_END(40);
}
__device__ __forceinline__ void ph_gfix(const Args& a, const Ctx& c) {
    const float* ng = a.in[I_SNORM]; const float* rs = (const float*)(a.ws + WS_RSTD);
    const int n16 = TT * 256;
    for (int p = blockIdx.x * NTHREADS + c.tid; p < n16; p += c.G * NTHREADS) { const int r = p >> 8, col = (p & 255) * 8;
        u32x4* gp = (u32x4*)((bf16*)(a.ws + WS_G) + (size_t)r * 2048 + col); const u32x4 v = *gp; const float s = rs[r * 4 + (col >> 9)];
        const f32x4 g0 = *(const f32x4*)(ng + col), g1 = *(const f32x4*)(ng + col + 4);
        *gp = (u32x4){cvtpk(bflo(v.x) * s * g0.x, bfhi(v.x) * s * g0.y), cvtpk(bflo(v.y) * s * g0.z, bfhi(v.y) * s * g0.w), cvtpk(bflo(v.z) * s * g1.x, bfhi(v.z) * s * g1.y), cvtpk(bflo(v.w) * s * g1.z, bfhi(v.w) * s * g1.w)}; }
}

#if DEBUG_CHECKS
__device__ __forceinline__ float dbg_hb(const Args& a, int layer, size_t idx, float sh) {
    if (ATT_FP8 && layer != 2) return __builtin_amdgcn_cvt_f32_fp8((unsigned)((const unsigned char*)(a.ws + WS_HB))[idx], 0) * sh;
    return bf2f(((const bf16*)(a.ws + WS_HB))[idx]); }
__device__ __forceinline__ int dbg_sample_row(int b) { const int SR[16] = {0, 1, 77, 4095, 4096, 5000, 8191, 9000, 12288, 16383, 16384, 16385, 16384 + 255, 16384 + 256, 17000, 17407}; int r = 0;
#pragma unroll
    for (int i = 0; i < 16; ++i) r = (b == i) ? SR[i] : r;
    return r; }
__device__ __forceinline__ float blk_sum(float v, LAS float* red, int tid) {
    v = wave_sum(v); __syncthreads(); if ((tid & 63) == 0) red[tid >> 6] = v; __syncthreads(); float s = 0.f;
#pragma unroll
    for (int i = 0; i < 8; ++i) s += red[i];
    __syncthreads(); return s; }
__device__ __forceinline__ float blk_max(float v, LAS float* red, int tid) {
#pragma unroll
    for (int o = 1; o < 64; o <<= 1) v = fmaxf(v, __shfl_xor(v, o));
    __syncthreads(); if ((tid & 63) == 0) red[tid >> 6] = v; __syncthreads(); float s = red[0];
#pragma unroll
    for (int i = 1; i < 8; ++i) s = fmaxf(s, red[i]);
    __syncthreads(); return s; }
__device__ __forceinline__ void dbg_report(const Args& a, int id, float err, float ssref, float n, int tid) {
    if (tid == 0) { float rel = err / (sqrtf(ssref / n) + 1e-20f); if (!(rel == rel)) rel = 1e30f; atomicMax((unsigned*)(a.ws + WS_CTL) + CW_DBG + id, __float_as_uint(rel)); } }
__device__ __forceinline__ float dbg_mod(const Args& a, int layer, int r, int j) {
    const float* cv = r < TL ? a.in[I_C] + (r / SEQ) * 1024 : a.in[I_CCTX]; float s = 0.f;
    _Pragma("nounroll") for (int k = 0; k < 1024; ++k) { const float x = cv[k]; s += (x / (1.0f + expf(-x))) * a.in[I_WADA][((size_t)layer * 1024 + k) * 6144 + j]; }
    return s + a.in[I_BADA][layer * 6144 + j]; }

__device__ __forceinline__ void chk_rmix(const Args& a, int layer, int id, LAS unsigned char* ldsb) {
    if (blockIdx.x >= 16) return; const int tid = tid_opaque(), r = dbg_sample_row(blockIdx.x);
    LAS float* red = (LAS float*)ldsb;
    const float* x = resid_row(a, layer, r); const bf16* hb = (const bf16*)(a.ws + WS_HB) + (size_t)r * D;
    float ss = 0.f; for (int cc = tid; cc < D; cc += 512) ss += x[cc] * x[cc];
    ss = blk_sum(ss, red, tid); const float rstd = rsqrtf(ss / D + EPS);
    float err = 0.f, sr = 0.f;
    for (int cc = tid; cc < D; cc += 512) { const float sh = dbg_mod(a, layer, r, cc), sc = dbg_mod(a, layer, r, D + cc);
        const float ref = x[cc] * rstd * a.in[I_NMIX][layer * D + cc] * (1.f + sc) + sh; err = fmaxf(err, fabsf(ref - dbg_hb(a, layer, (size_t)r * D + cc, 1.f))); sr += ref * ref; }
    err = blk_max(err, red, tid); sr = blk_sum(sr, red, tid); dbg_report(a, id, err, sr, D, tid);
}
__device__ __forceinline__ void chk_qkv(const Args& a, int layer, int id, LAS unsigned char* ldsb) {
    if (blockIdx.x >= 16) return; const int tid = tid_opaque(), r = dbg_sample_row(blockIdx.x), j = layer ? 1 : 0;
    LAS float* red = (LAS float*)ldsb; LAS float* y = red + 16; LAS float* hrow = y + 1536;
    const bf16* hb = (const bf16*)(a.ws + WS_HB) + (size_t)r * D;
    _Pragma("nounroll") for (int k = tid; k < D; k += 512) hrow[k] = dbg_hb(a, layer, (size_t)r * D + k, 1.f);
    __syncthreads();
    for (int n = tid; n < 1536; n += 512) { float s = 0.f; const float* w = a.in[I_WQKV] + (size_t)j * 1024 * 1536 + n; _Pragma("nounroll") for (int k = 0; k < 1024; ++k) s += hrow[k] * w[(size_t)k * 1536]; y[n] = s; }
    __syncthreads();
    float err = 0.f, sr = 0.f;
    for (int n = tid; n < 1536; n += 512) { float ref;
        if (n < 1280) { const int h0 = n & ~63; float ss = 0.f; _Pragma("nounroll") for (int q = 0; q < 64; ++q) ss += y[h0 + q] * y[h0 + q];
            const float rstd = rsqrtf(ss / 64.f + EPS); const float* g = (n < 1024 ? a.in[I_QG] : a.in[I_KG]) + j * 64;
            float v = y[n] * rstd * g[n & 63], vp = y[n ^ 1] * rstd * g[(n ^ 1) & 63];
            if (r < TL) { const int t = r % SEQ, i = (n & 63) >> 1, f = i & 15, pos = i < 16 ? t / 64 : t % 64; const float inv = powf(10000.f, -(float)f / 16.f), ang = (float)pos * inv, cs = cosf(ang), sn = sinf(ang);
                v = (n & 1) ? (vp * sn + v * cs) : (v * cs - vp * sn); }
            if (n < 1024) v *= 0.125f * 1.4426950408889634f;
            ref = v; } else ref = y[n];
        float got;
        if (n < 1024) { if (layer == 3 && r >= TL) continue; got = bf2f(((const bf16*)(a.ws + WS_Q))[(size_t)r * 1024 + n]); }
        else if (n < 1280) got = bf2f(((const bf16*)(a.ws + WS_K))[kv_row(r) * 256 + (n - 1024)]);
        else got = bf2f(((const bf16*)(a.ws + WS_V))[kv_row(r) * 256 + (n - 1280)]);
        err = fmaxf(err, fabsf(ref - got)); sr += ref * ref; }
    err = blk_max(err, red, tid); sr = blk_sum(sr, red, tid); dbg_report(a, id, err, sr, 1536, tid);
}
__device__ __forceinline__ void chk_att(const Args& a, int layer, int id, LAS unsigned char* ldsb) {
    if (blockIdx.x >= 16) return; const int tid = tid_opaque(), r = dbg_sample_row(blockIdx.x);
    if (layer == 3 && r >= TL) return;
    LAS float* red = (LAS float*)ldsb; LAS float* sc = red + 16; LAS float* po = sc + 4352;
    const int nk = r < TL ? KVROWS : CTXL; const long kv0 = (long)(r < TL ? r / SEQ : (r - TL) / CTXL) * KVROWS;
    const bf16* Qb = (const bf16*)(a.ws + WS_Q); const bf16* Kb = (const bf16*)(a.ws + WS_K); const bf16* Vb = (const bf16*)(a.ws + WS_V); const bf16* Ob = (const bf16*)(a.ws + WS_HB);
    float err = 0.f, sr = 0.f;
    for (int h = 0; h < 16; ++h) {
        float mx = -3e38f;
        _Pragma("nounroll") for (int jk = tid; jk < nk; jk += 512) { float s = 0.f; _Pragma("nounroll") for (int d = 0; d < 64; ++d) s += bf2f(Qb[(size_t)r * 1024 + h * 64 + d]) * bf2f(Kb[(kv0 + jk) * 256 + (h >> 2) * 64 + d]); sc[jk] = s; mx = fmaxf(mx, s); }
        mx = blk_max(mx, red, tid);
        float l = 0.f; _Pragma("nounroll") for (int jk = tid; jk < nk; jk += 512) { const float p = exp2f(sc[jk] - mx); sc[jk] = p; l += p; }
        l = blk_sum(l, red, tid);
        { const int d = tid & 63, part = tid >> 6; float o = 0.f; _Pragma("nounroll") for (int jk = part; jk < nk; jk += 8) o += sc[jk] * bf2f(Vb[(kv0 + jk) * 256 + (h >> 2) * 64 + d]); po[part * 64 + d] = o; }
        __syncthreads();
        if (tid < 64) { float o = 0.f; _Pragma("nounroll") for (int p = 0; p < 8; ++p) o += po[p * 64 + tid]; o /= l; err = fmaxf(err, fabsf(o - dbg_hb(a, layer, (size_t)r * 1024 + h * 64 + tid, 1.f / (float)(1 << ATT_OSH)))); sr += o * o; }
        __syncthreads();
    }
    err = blk_max(err, red, tid); sr = blk_sum(sr, red, tid); dbg_report(a, id, err, sr, 1024, tid);
}
__device__ __forceinline__ void chk_oproj(const Args& a, int layer, int id, LAS unsigned char* ldsb) {
    if (blockIdx.x >= 16 || layer != 0) return; const int tid = tid_opaque(), r = dbg_sample_row(blockIdx.x), j = 0;
    LAS float* red = (LAS float*)ldsb; LAS float* orow = red + 16;
    const bf16* Ob = (const bf16*)(a.ws + WS_HB) + (size_t)r * D;
    _Pragma("nounroll") for (int k = tid; k < D; k += 512) orow[k] = dbg_hb(a, layer, (size_t)r * D + k, 1.f / (float)(1 << ATT_OSH));
    __syncthreads();
    float err = 0.f, sr = 0.f;
    for (int n = tid; n < D; n += 512) { float s = 0.f; const float* w = a.in[I_WO] + (size_t)j * 1024 * 1024 + n; _Pragma("nounroll") for (int k = 0; k < 1024; ++k) s += orow[k] * w[(size_t)k * 1024];
        const float dl = dbg_mod(a, layer, r, 2 * D + n) * s, ref = resid_row(a, 0, r)[n] + dl; err = fmaxf(err, fabsf(ref - ((const float*)(a.ws + WS_X))[(size_t)r * D + n])); sr += dl * dl; }
    err = blk_max(err, red, tid); sr = blk_sum(sr, red, tid); dbg_report(a, id, err, sr, D, tid);
}
__device__ __forceinline__ void chk_moe(const Args& a, int layer, int id_tok, int id_y, LAS unsigned char* ldsb) {
    if (blockIdx.x >= 16) return; const int tid = tid_opaque(), r = dbg_sample_row(blockIdx.x);
    if (layer == 3 && r >= TL) return;
    LAS float* red = (LAS float*)ldsb; LAS float* tok = red + 16; LAS float* lg = tok + 1024; LAS float* tkb = lg + 64; LAS float* act = tkb + 1024; LAS float* rt = act + 1024;
    const float* x = (const float*)(a.ws + WS_X) + (size_t)r * D; const bf16* tk = (const bf16*)(a.ws + WS_TK) + (size_t)r * D;
    float ss = 0.f; for (int cc = tid; cc < D; cc += 512) ss += x[cc] * x[cc];
    ss = blk_sum(ss, red, tid); const float rstd = rsqrtf(ss / D + EPS);
    float err = 0.f, sr = 0.f;
    for (int cc = tid; cc < D; cc += 512) { const float sh = dbg_mod(a, layer, r, 3 * D + cc), sc = dbg_mod(a, layer, r, 4 * D + cc);
        const float ref = x[cc] * rstd * a.in[I_NFFN][layer * D + cc] * (1.f + sc) + sh; tok[cc] = ref;
#if MOE_FP8
        tkb[cc] = __builtin_amdgcn_cvt_f32_fp8((unsigned)((const unsigned char*)(a.ws + WS_TK))[(size_t)r * D + cc], 0);
#else
        tkb[cc] = bf2f(tk[cc]);
#endif
        err = fmaxf(err, fabsf(ref - tkb[cc])); sr += ref * ref; }
    err = blk_max(err, red, tid); sr = blk_sum(sr, red, tid);
    if (tid < 36) { float s = 0.f; _Pragma("nounroll") for (int k = 0; k < 1024; ++k) s += tok[k] * (tid < 4 ? a.in[I_WRG][((size_t)layer * 1024 + k) * 4 + tid] : a.in[I_WRE][((size_t)layer * 1024 + k) * 32 + tid - 4]); lg[tid] = s; }
    __syncthreads();
    if (tid == 0) { int grp = 0; _Pragma("nounroll") for (int q = 1; q < 4; ++q) if (lg[q] > lg[grp]) grp = q; float den = 0.f; _Pragma("nounroll") for (int q = 0; q < 4; ++q) den += expf(lg[q] - lg[grp]);
        const LAS float* le = lg + 4 + grp * 8; int i0 = 0; _Pragma("nounroll") for (int q = 1; q < 8; ++q) if (le[q] > le[i0]) i0 = q; int i1 = -1; _Pragma("nounroll") for (int q = 0; q < 8; ++q) if (q != i0 && (i1 < 0 || le[q] > le[i1])) i1 = q;
        const float ex = expf(le[i1] - le[i0]), w0 = 1.f / den / (1.f + ex), w1 = 1.f / den * ex / (1.f + ex);
        rt[0] = (float)(grp * 8 + i0); rt[1] = (float)(grp * 8 + i1); rt[2] = w0; rt[3] = w1;
        const float* w2 = (const float*)(a.ws + WS_W2); float e2 = fmaxf(fabsf(w2[2 * r] - w0), fabsf(w2[2 * r + 1] - w1)) * 30.f;
        const int* list = (const int*)(a.ws + WS_LIST); const unsigned* gc = (const unsigned*)(a.ws + WS_CTL) + CW_CNT + layer * 32;
        _Pragma("nounroll") for (int k = 0; k < 2; ++k) { const int e = (int)rt[k]; bool found = false; const int n = (int)gc[e]; _Pragma("nounroll") for (int q = 0; q < n && q < MOE_CAP; ++q) if (list[e * MOE_CAP + q] == 2 * r + k) found = true; if (!found) e2 = 1e6f; }
        rt[4] = e2; }
    __syncthreads();
    err = fmaxf(err, rt[4] * sqrtf(sr / D));
    dbg_report(a, id_tok, err, sr, D, tid);
    float err2 = 0.f, sr2 = 0.f;
    _Pragma("nounroll") for (int k = 0; k < 2; ++k) { const int e = (int)rt[k]; const float wk = rt[2 + k];
        const float* wgu = a.in[I_WGU] + ((size_t)layer * 32 + e) * 1024 * 1024; const float* wdn = a.in[I_WDN] + ((size_t)layer * 32 + e) * 512 * 1024;
        { float sg = 0.f, su = 0.f; _Pragma("nounroll") for (int q = 0; q < 1024; ++q) { sg += tkb[q] * wgu[(size_t)q * 1024 + tid]; su += tkb[q] * wgu[(size_t)q * 1024 + 512 + tid]; } act[tid] = (sg / (1.f + expf(-sg))) * su; }
        __syncthreads();
        for (int n = tid; n < D; n += 512) { float s = 0.f; _Pragma("nounroll") for (int q = 0; q < 512; ++q) s += act[q] * wdn[(size_t)q * 1024 + n]; s *= wk;
            err2 = fmaxf(err2, fabsf(s - bf2f(((const bf16*)(a.ws + WS_Y2))[(size_t)(2 * r + k) * D + n]))); sr2 += s * s; }
        __syncthreads(); }
    err2 = blk_max(err2, red, tid); sr2 = blk_sum(sr2, red, tid); dbg_report(a, id_y, err2, sr2, 2 * D, tid);
}

__global__ void __launch_bounds__(NTHREADS) dbg_kernel(Args a, int ty, int layer, int id) {
    extern __shared__ __attribute__((aligned(16))) unsigned char lds_dbg[];
    LAS unsigned char* l = (LAS unsigned char*)lds_dbg;
    if (ty == 1) chk_rmix(a, layer, id, l); else if (ty == 2) chk_qkv(a, layer, id, l); else if (ty == 3) chk_att(a, layer, id, l);
    else if (ty == 4) chk_oproj(a, layer, id, l); else if (ty == 5) chk_moe(a, layer, id, id + 1, l);
}
#endif

template <int KIND, int LAYER> __device__ __forceinline__ void run_phase(const Args& a0, Ctx& c, unsigned char* lds_gen) {
    Args a = a0; { unsigned long long wsv = (unsigned long long)a0.ws; asm volatile("" : "+s"(wsv)); a.ws = (unsigned char*)(GAS unsigned char*)wsv; }
    { unsigned lb = (unsigned)(uintptr_t)(LAS unsigned char*)lds_gen; asm volatile("" : "+s"(lb)); c.lds = (LAS unsigned char*)(uintptr_t)lb; }
    c.tid = tid_opaque(); c.lane = c.tid & 63;
    unsigned char* const ws = a.ws; constexpr int layer = LAYER;
#define RELAUNDER() do { { unsigned long long wsv_ = (unsigned long long)a0.ws; asm volatile("" : "+s"(wsv_)); a.ws = (unsigned char*)(GAS unsigned char*)wsv_; } \
        { unsigned lb_ = (unsigned)(uintptr_t)(LAS unsigned char*)lds_gen; asm volatile("" : "+s"(lb_)); c.lds = (LAS unsigned char*)(uintptr_t)lb_; } c.tid = tid_opaque(); c.lane = c.tid & 63; } while (0)
    if constexpr (KIND == K_P0) p0_prologue(a, c);
    else if constexpr (KIND == K_RMIX) ph_rmix(a, c, layer);
    else if constexpr (KIND == K_QKV) { constexpr int j = layer ? 1 : 0;
#if ATT_FP8
        SchedQKV S{(const char*)(ws + WS_HB), (const char*)(ws + WS_WQKV) + (size_t)j * 1536 * 1024, (size_t)256 * 1024, layer == 0 ? 1 : 0, c.G, (int)blockIdx.x};
        EpiQKV E{(bf16*)(ws + WS_Q), (bf16*)(ws + WS_K), (bf16*)(ws + WS_V), a.in[I_QG] + j * 64, a.in[I_KG] + j * 64, (const f32x2*)(ws + WS_ROPE)};
        pg8::gemm_phase<EpiQKV, SchedQKV, false, true>(c.lds, 1024, 1024, S, E, 127 - MOE_WSH, 127); }
#else
        SchedQKV S{(const char*)(ws + WS_HB), (const char*)(ws + WS_WQKV) + (size_t)j * 1536 * 1024 * 2, (size_t)256 * 1024 * 2, layer == 0 ? 1 : 0, c.G, (int)blockIdx.x};
        EpiQKV E{(bf16*)(ws + WS_Q), (bf16*)(ws + WS_K), (bf16*)(ws + WS_V), a.in[I_QG] + j * 64, a.in[I_KG] + j * 64, (const f32x2*)(ws + WS_ROPE)};
        pg8::gemm_phase<EpiQKV, SchedQKV, false>(c.lds, 2048, 2048, S, E); }
#endif
    else if constexpr (KIND == K_ROPE) ph_rope(a, c, layer);
    else if constexpr (KIND == K_ATT) ph_att(a, c, layer, (char*)c.lds);
    else if constexpr (KIND == K_OPROJ) { constexpr int j = layer ? 1 : 0;
#if ATT_FP8
        unsigned* rdx = (unsigned*)(ws + WS_CTL) + CW_RDX + layer * 128;
        SchedDenseR S{(const char*)(ws + WS_HB), (const char*)(ws + WS_WO) + (size_t)j * 1024 * 1024, (size_t)256 * 1024, (size_t)256 * 1024, 0, layer == 3 ? 64 : 68, 4, 64, c.G, (int)blockIdx.x, rdx};
        EpiResid E{&a, layer, nullptr, nullptr};
        pg8::gemm_phase<EpiResid, SchedDenseR, false, true>(c.lds, 1024, 1024, S, E, 127 - MOE_WSH, 127 - ATT_OSH);
        RELAUNDER(); ph_m1(a, c, layer, (unsigned*)(a.ws + WS_CTL) + CW_RDX + layer * 128, 4, 0); }
#else
        unsigned* rdx = (unsigned*)(ws + WS_CTL) + CW_RDX + layer * 128;
        SchedDenseR S{(const char*)(ws + WS_HB), (const char*)(ws + WS_WO) + (size_t)j * 1024 * 1024 * 2, (size_t)256 * 1024 * 2, (size_t)256 * 1024 * 2, 0, layer == 3 ? 64 : 68, 4, 64, c.G, (int)blockIdx.x, rdx};
        EpiResid E{&a, layer, nullptr, nullptr};
        pg8::gemm_phase<EpiResid, SchedDenseR, false>(c.lds, 2048, 2048, S, E);
        RELAUNDER(); ph_m1(a, c, layer, (unsigned*)(a.ws + WS_CTL) + CW_RDX + layer * 128, 4, 0); }
#endif
    else if constexpr (KIND == K_M2) {
        LAS int* tab = (LAS int*)(c.lds + TAB_OFF); moe_tables(a, c, layer, tab);
        unsigned* rdy = (unsigned*)(ws + WS_CTL) + CW_RDY + layer * 256;
#if MOE_FP8
        { SchedMoe S{(const char*)(ws + WS_TK), 0, (const char*)(ws + WS_WGU) + (size_t)layer * 32 * 1024 * 1024, (size_t)1024 * 1024, (size_t)256 * 1024, tab, (const int*)(ws + WS_LIST), c.G, (int)blockIdx.x, rdy, 1};
          EpiGateUp E{(bf16*)(ws + WS_ACT)};
          pg8::gemm_phase<EpiGateUp, SchedMoe, true, true>(c.lds, 1024, 1024, S, E, 127 - MOE_WSH, 127); }
        { SchedMoe S{(const char*)(ws + WS_ACT), (size_t)256 * 512, (const char*)(ws + WS_WDN) + (size_t)layer * 32 * 1024 * 512, (size_t)1024 * 512, (size_t)256 * 512, tab, (const int*)(ws + WS_LIST), c.G, (int)blockIdx.x, rdy, 2};
          EpiDown E{(const int*)(ws + WS_LIST), (const float*)(ws + WS_W2), (bf16*)(ws + WS_Y2)};
          pg8::gemm_phase<EpiDown, SchedMoe, false, true>(c.lds, 512, 512, S, E, 127 - MOE_WSH, 127 - MOE_ASH); } }
#else
        { SchedMoe S{(const char*)(ws + WS_TK), 0, (const char*)(ws + WS_WGU) + (size_t)layer * 32 * 1024 * 1024 * 2, (size_t)1024 * 1024 * 2, (size_t)256 * 1024 * 2, tab, (const int*)(ws + WS_LIST), c.G, (int)blockIdx.x, rdy, 1};
          EpiGateUp E{(bf16*)(ws + WS_ACT)};
          pg8::gemm_phase<EpiGateUp, SchedMoe, true>(c.lds, 2048, 2048, S, E); }
        { SchedMoe S{(const char*)(ws + WS_ACT), (size_t)256 * 512 * 2, (const char*)(ws + WS_WDN) + (size_t)layer * 32 * 1024 * 512 * 2, (size_t)1024 * 512 * 2, (size_t)256 * 512 * 2, tab, (const int*)(ws + WS_LIST), c.G, (int)blockIdx.x, rdy, 2};
          EpiDown E{(const int*)(ws + WS_LIST), (const float*)(ws + WS_W2), (bf16*)(ws + WS_Y2)};
          pg8::gemm_phase<EpiDown, SchedMoe, false>(c.lds, 1024, 1024, S, E); } }
#endif
    else if constexpr (KIND == K_RPOOL) ph_rpool(a, c, layer);
    else if constexpr (KIND == K_POOLG) {
        unsigned* rdx = (unsigned*)(ws + WS_CTL) + CW_RDX + layer * 128;
        SchedDenseR S{(const char*)(ws + WS_HB), (const char*)(ws + WS_WPOOL), (size_t)256 * 1024 * 2, (size_t)256 * 256 * 2, (size_t)256 * 2, 68, 4, 64, c.G, (int)blockIdx.x, rdx};
        EpiResidN E{&a, layer, a.in[I_POOLS], (const bf16*)(ws + WS_Z)};
        pg8::gemm_phase<EpiResidN, SchedDenseR, false>(c.lds, 512, 2048, S, E);
        RELAUNDER(); ph_m1(a, c, layer, (unsigned*)(a.ws + WS_CTL) + CW_RDX + layer * 128, 4, 0); }
    else if constexpr (KIND == K_INPROJ) {
        SchedDense S{(const char*)(ws + WS_HB), (const char*)(ws + WS_WIN), (size_t)256 * 1024 * 2, (size_t)256 * 1024 * 2, 0, 68, 21, c.G, (int)blockIdx.x};
        EpiInproj E{(bf16*)(ws + WS_Z), (bf16*)(ws + WS_XBC), (float*)(ws + WS_DT), a.in[I_DTB]};
        pg8::gemm_phase<EpiInproj, SchedDense, false>(c.lds, 2048, 2048, S, E); }
    else if constexpr (KIND == K_CONV) ph_conv(a, c);
    else if constexpr (KIND == K_SCAN) ph_scan(a, c);
    else if constexpr (KIND == K_YPH) {
        ph_yph(a, c, (unsigned*)(ws + WS_CTL) + CW_RDG);
        RELAUNDER();
        { unsigned* rdx = (unsigned*)(a.ws + WS_CTL) + CW_RDX + layer * 128;
          SchedOutproj S{(const char*)(a.ws + WS_G), (const char*)(a.ws + WS_WOUT), (size_t)256 * 2048 * 2, (size_t)256 * 2048 * 2, c.G, c.vcu, (const unsigned*)(a.ws + WS_CTL) + CW_RDG, rdx};
          EpiResid E{&a, layer, nullptr, nullptr};
          pg8::gemm_phase<EpiResid, SchedOutproj, false>(c.lds, 4096, 4096, S, E); }
        RELAUNDER(); ph_m1(a, c, layer, (unsigned*)(a.ws + WS_CTL) + CW_RDX + layer * 128, 4, 1); }
    else if constexpr (KIND == K_GFIX) ph_gfix(a, c);
    else if constexpr (KIND == K_FINAL) ph_final(a, c, layer);
#undef RELAUNDER
}
#define PROGRAM(X) \
    X(0, K_P0, 0) \
    X(1, K_RMIX, 0) X(2, K_QKV, 0) X(3, K_ATT, 0) X(4, K_OPROJ, 0) X(5, K_M2, 0) \
    X(6, K_RPOOL, 1) X(7, K_POOLG, 1) X(8, K_M2, 1) \
    X(9, K_RMIX, 2) X(10, K_INPROJ, 2) X(11, K_CONV, 2) X(12, K_SCAN, 2) X(13, K_YPH, 2) X(14, K_M2, 2) \
    X(15, K_RMIX, 3) X(16, K_QKV, 3) X(17, K_ATT, 3) X(18, K_OPROJ, 3) X(19, K_M2, 3) \
    X(20, K_FINAL, 4)
constexpr int NPHASES = 21;
__device__ __forceinline__ unsigned long long probe_phases(const unsigned long long* ts, unsigned mask) { unsigned long long r = 0; for (int k = 0; k < 32; ++k) if (mask & (1u << k)) r += ts[k + 1] - ts[k]; return r; }
__device__ __forceinline__ unsigned long long probe_sum(const unsigned long long* s, int mask) { unsigned long long r = 0; for (int k = 0; k < 8; ++k) if (mask & (1 << k)) r += s[k]; return r; }
__global__ void __launch_bounds__(NTHREADS, 2) mega(Args a0) {
    extern __shared__ __attribute__((aligned(16))) unsigned char lds_raw[];
    Ctx c; c.lds = (LAS unsigned char*)lds_raw; c.tid = threadIdx.x; c.lane = c.tid & 63; c.wave = __builtin_amdgcn_readfirstlane(c.tid >> 6);
    c.G = gridDim.x; { const int bx = blockIdx.x; c.vcu = (c.G % 8 == 0) ? (bx % 8) * (c.G / 8) + bx / 8 : bx; }
    volatile LAS unsigned* MISC = (volatile LAS unsigned*)(c.lds + MISC_OFF);
    for (int u = c.tid; u < 128; u += NTHREADS) MISC[u] = 0u;
    __syncthreads();
    XcdBarrier bar = xcd_barrier_post((unsigned*)(a0.ws + WS_CTL) + CW_BAR + a0.bar_region * XCD_BAR_WORDS, MISC + 8);
    const int lo = a0.ph_lo, hi = a0.ph_hi;
#if PROBE
#define STAMP(idx) if (blockIdx.x == 0 && threadIdx.x == 0) __hip_atomic_store((unsigned long long*)((unsigned*)(a0.ws + WS_CTL) + CW_TS) + (idx), (unsigned long long)__builtin_amdgcn_s_memrealtime(), __ATOMIC_RELAXED, __HIP_MEMORY_SCOPE_AGENT);
#else
#define STAMP(idx)
#endif
    STAMP(0)
#if EXTRA_BARS
    for (int eb = 0; eb < EXTRA_BARS; ++eb) xcd_barrier(bar);
#endif
#define RUNPH(idx, KIND, LAYER) if (lo <= (idx) && (idx) < hi) { run_phase<KIND, LAYER>(a0, c, lds_raw); if ((idx) + 1 < hi) xcd_barrier(bar); STAMP((idx) + 1) }
    PROGRAM(RUNPH)
#undef RUNPH
#if PROBE
    if (blockIdx.x == 0 && threadIdx.x == 0 && hi == NPHASES) { const unsigned long long* ts = (const unsigned long long*)((unsigned*)(a0.ws + WS_CTL) + CW_TS);
        const unsigned long long d = (unsigned long long)PROBE_K * (PROBE_SLOT ? probe_sum(ts + PROBE_SLOT_BASE, PROBE_SLOT) : probe_phases(ts, PROBE_MASK)), t0 = __builtin_amdgcn_s_memrealtime();
        while (__builtin_amdgcn_s_memrealtime() - t0 < d) __builtin_amdgcn_s_sleep(8); }
#endif
}

extern "C" void kernel_launch(void* const* d_in, const int* in_sizes, int n_in, void* d_out, int out_size, void* d_ws, size_t ws_size, hipStream_t stream) {
    static int grid = 0;
    if (grid == 0) {
        if (n_in != N_IN || out_size != TL * D || ws_size < WS_END) { fprintf(stderr, "kernel_launch: unexpected shapes (n_in %d out %d ws %zu)\n", n_in, out_size, ws_size); grid = -1; return; }
        int dev = 0, cus = 0;
        if (hipGetDevice(&dev) != hipSuccess || hipDeviceGetAttribute(&cus, hipDeviceAttributeMultiprocessorCount, dev) != hipSuccess) { grid = -1; return; }
        if (hipFuncSetAttribute((const void*)mega, hipFuncAttributeMaxDynamicSharedMemorySize, LDS_BYTES) != hipSuccess) { fprintf(stderr, "kernel_launch: hipFuncSetAttribute failed\n"); grid = -1; return; }
        int per_cu = 0;
        if (hipOccupancyMaxActiveBlocksPerMultiprocessor(&per_cu, (const void*)mega, NTHREADS, LDS_BYTES) != hipSuccess || per_cu < 1) fprintf(stderr, "kernel_launch: occupancy query says %d\n", per_cu);
        (void)hipGetLastError();
        if (cus < 192) { fprintf(stderr, "kernel_launch: %d CUs: the router keeps at most 3 row tiles of logits per workgroup (needs >= 182 workgroups)\n", cus); grid = -1; return; }
        grid = cus;
    }
    if (grid < 0) return;
    (void)hipMemsetAsync((char*)d_ws + WS_CTL, 0, CTL_ZERO_BYTES, stream);
    Args a{};
    for (int i = 0; i < N_IN; ++i) a.in[i] = (const float*)d_in[i];
    a.out = (float*)d_out; a.ws = (unsigned char*)d_ws; a.flags = 0;
#if DEBUG_CHECKS
    struct Cut { int after; int ty, layer, nid; };
    const Cut cuts[] = DEBUG_CUTS;
    int lo = 0, region = 0, dbg_id = 1;
    for (unsigned k = 0; k < sizeof(cuts) / sizeof(cuts[0]); ++k) {
        if (cuts[k].after + 1 > lo) { a.ph_lo = lo; a.ph_hi = cuts[k].after + 1; a.bar_region = region++; hipLaunchKernelGGL(mega, dim3(grid), dim3(NTHREADS), LDS_BYTES, stream, a); lo = cuts[k].after + 1; }
        hipLaunchKernelGGL(dbg_kernel, dim3(16), dim3(NTHREADS), 65536, stream, a, cuts[k].ty, cuts[k].layer, dbg_id); dbg_id += cuts[k].nid;
    }
    a.ph_lo = lo; a.ph_hi = NPHASES; a.bar_region = region++;
    hipLaunchKernelGGL(mega, dim3(grid), dim3(NTHREADS), LDS_BYTES, stream, a);
#else
    a.ph_lo = 0; a.ph_hi = NPHASES; a.bar_region = 0;
    hipLaunchKernelGGL(mega, dim3(grid), dim3(NTHREADS), LDS_BYTES, stream, a);
#endif
}
```

```cpp
#include <hip/hip_runtime.h>
#include <cstdio>
#include <cstdint>

#define LAS __attribute__((address_space(3)))
#define GAS __attribute__((address_space(1)))
typedef unsigned short bf16;
typedef short bf16x8 __attribute__((ext_vector_type(8)));
typedef short s16x4 __attribute__((ext_vector_type(4)));
typedef float f32x2 __attribute__((ext_vector_type(2)));
typedef float f32x4 __attribute__((ext_vector_type(4)));
typedef float f32x16 __attribute__((ext_vector_type(16)));
typedef unsigned u32x2 __attribute__((ext_vector_type(2)));
typedef unsigned u32x4 __attribute__((ext_vector_type(4)));
typedef __bf16 bf16x2_t __attribute__((ext_vector_type(2)));

constexpr int D = 1024, NB = 4, SEQ = 4096, CTXL = 256, TL = NB * SEQ, TC = NB * CTXL, TT = TL + TC;
constexpr int KVROWS = SEQ + CTXL;
constexpr int NCH = TT / 128;
constexpr int MOE_CAP = TT;
constexpr float EPS = 1e-6f;
constexpr int NWAVES = 8, NTHREADS = 512;
#ifndef NLAYERS
#define NLAYERS 4
#endif
#ifndef MOE_FP8
#define MOE_FP8 1
#endif
#define MOE_WSH 5
#ifndef ATT_FP8
#define ATT_FP8 1
#endif
#define ATT_OSH 3
#define MOE_ASH 2
#define DBG_TOL 0.03f
#ifndef DEBUG_CHECKS
#define DEBUG_CHECKS 0
#endif
#ifndef PROBE
#define PROBE 0
#endif
#define PROBE_A0 0
#define PROBE_A1 1
#define PROBE_B0 4
#define PROBE_B1 5
#define PROBE_K 2
#define PROBE_MASK 0x1222224u
#define EXTRA_BARS 0
#define PROBE_SLOT_BASE 40
#define PROBE_SLOT 0
#if PROBE
#define SECT_DECL unsigned long long sect_t = __builtin_amdgcn_s_memrealtime(); unsigned long long sect_acc[8] = {0, 0, 0, 0, 0, 0, 0, 0};
#define SECT(k) do { const unsigned long long n_ = __builtin_amdgcn_s_memrealtime(); sect_acc[k] += n_ - sect_t; sect_t = n_; } while (0)
#ifndef PROBE_BLOCK
#define PROBE_BLOCK 0
#endif
#define SECT_END(base) do { if (blockIdx.x == PROBE_BLOCK && threadIdx.x == 0) { _Pragma("unroll") for (int k_ = 0; k_ < 8; ++k_) ((unsigned long long*)((unsigned*)(a.ws + WS_CTL) + CW_TS))[(base) + k_] = sect_acc[k_]; } } while (0)
#else
#define SECT_DECL
#define SECT(k) do {} while (0)
#define SECT_END(base) do {} while (0)
#endif
#define DEBUG_CUTS { {1, 1, 0, 1}, {2, 2, 0, 1}, {3, 3, 0, 1}, {4, 4, 0, 1}, {6, 5, 0, 2} }

enum { I_X = 0, I_C, I_CTX, I_CCTX, I_WADA, I_BADA, I_NMIX, I_NFFN, I_NFIN, I_WQKV, I_WO, I_QG, I_KG, I_POOLW, I_POOLS, I_WIN, I_CONVW, I_CONVB, I_DTB, I_ALOG, I_DSK, I_SNORM, I_WOUT, I_WRG, I_WRE, I_WGU, I_WDN, N_IN };

constexpr size_t MiB = 1u << 20;
constexpr size_t WS_CTL = 0, CTL_ZERO_BYTES = 1 * MiB;
constexpr size_t WS_MODL = 1 * MiB;
constexpr size_t WS_MODC = WS_MODL + 4 * 4 * 6144 * 4;
constexpr size_t WS_ROPE = 1 * MiB + 512 * 1024;
constexpr size_t WS_WR = 2 * MiB;
constexpr size_t WS_WQKV = 3 * MiB;
constexpr size_t WS_WO = 9 * MiB;
constexpr size_t WS_WPOOL = 13 * MiB;
constexpr size_t WS_WIN = 14 * MiB;
constexpr size_t WS_WOUT = 25 * MiB;
constexpr size_t WS_WGU = 29 * MiB;
constexpr size_t WS_WDN = 285 * MiB;
constexpr size_t WS_X = 413 * MiB;
constexpr size_t WS_HB = 481 * MiB;
constexpr size_t WS_TK = 515 * MiB;
constexpr size_t WS_Q = 549 * MiB;
constexpr size_t WS_K = 583 * MiB;
constexpr size_t WS_V = 592 * MiB;
constexpr size_t WS_Y2 = 601 * MiB;
constexpr size_t WS_ACT = 669 * MiB;
constexpr size_t WS_LIST = 711 * MiB;
constexpr size_t WS_W2 = 714 * MiB;
constexpr size_t WS_Z = 715 * MiB;
constexpr size_t WS_XBC = 783 * MiB;
constexpr size_t WS_DT = 885 * MiB;
constexpr size_t WS_XT = 890 * MiB;
constexpr size_t WS_BN = 958 * MiB;
constexpr size_t WS_BT = 975 * MiB;
constexpr size_t WS_CN = 992 * MiB;
constexpr size_t WS_SCA = 1009 * MiB;
constexpr size_t WS_SCB = 1018 * MiB;
constexpr size_t WS_DEC = 1027 * MiB;
constexpr size_t WS_HIN = 1028 * MiB;
constexpr size_t WS_G = 1164 * MiB;
constexpr size_t WS_RSTD = 1232 * MiB;
constexpr size_t WS_END = 1233 * MiB;

constexpr int CW_BAR = 4096;
constexpr int CW_CNT = 200000;
constexpr int CW_DBG = 201000;
constexpr int CW_RDY = 204000;
constexpr int CW_RDG = 207000;
constexpr int CW_RDX = 206000;
constexpr int CW_TS = 202000;

constexpr int LDS_BYTES = 163840;
constexpr int MISC_OFF = LDS_BYTES - 512;

__device__ __forceinline__ unsigned cvtpk(float lo, float hi) { f32x2 v = {lo, hi}; bf16x2_t b = __builtin_convertvector(v, bf16x2_t); return __builtin_bit_cast(unsigned, b); }
__device__ __forceinline__ unsigned pk_fp8x4(float a, float b, float c, float d) {
    a = __builtin_amdgcn_fmed3f(a, -448.f, 448.f); b = __builtin_amdgcn_fmed3f(b, -448.f, 448.f); c = __builtin_amdgcn_fmed3f(c, -448.f, 448.f); d = __builtin_amdgcn_fmed3f(d, -448.f, 448.f);
    unsigned w = __builtin_amdgcn_cvt_pk_fp8_f32(a, b, 0u, false); return __builtin_amdgcn_cvt_pk_fp8_f32(c, d, w, true); }
__device__ __forceinline__ float bflo(unsigned u) { return __uint_as_float(u << 16); }
__device__ __forceinline__ float bfhi(unsigned u) { return __uint_as_float(u & 0xffff0000u); }
__device__ __forceinline__ float bf2f(bf16 b) { return __uint_as_float((unsigned)b << 16); }
__device__ __forceinline__ float wave_sum(float v) {
#pragma unroll
    for (int o = 1; o < 64; o <<= 1) v += __shfl_xor(v, o);
    return v;
}
__device__ __forceinline__ float silu_f(float v) { return v * __builtin_amdgcn_rcpf(1.0f + __builtin_amdgcn_exp2f(v * -1.4426950408889634f)); }
__device__ __forceinline__ int tid_opaque() { int t = threadIdx.x; asm volatile("" : "+v"(t)); return t; }
#define LDS_WAIT() asm volatile("s_waitcnt lgkmcnt(0)" ::: "memory")
#define VM_WAIT() asm volatile("s_waitcnt vmcnt(0)" ::: "memory")

#define XB_TMO      128
#define XB_XCNT(j)  (256  + 64 * (j))
#define XB_XSUB(j)  (1280 + 64 * (j))
#define XB_XGEN(j)  (2304 + 64 * (j))
#define XB_TOP      3328
#define XB_TOPGEN   3392
#define XCD_BAR_WORDS 3456
#define XB_SPIN_CAP (1u << 20)
#ifndef XB_FLATPOLL
#define XB_FLATPOLL 0
#endif
__device__ __forceinline__ unsigned xb_ld(unsigned* p)              { return __hip_atomic_load(p, __ATOMIC_RELAXED, __HIP_MEMORY_SCOPE_AGENT); }
__device__ __forceinline__ unsigned xb_add(unsigned* p, unsigned v) { return __hip_atomic_fetch_add(p, v, __ATOMIC_RELAXED, __HIP_MEMORY_SCOPE_AGENT); }
__device__ __forceinline__ unsigned xb_xcc_id() { return (unsigned)__builtin_amdgcn_s_getreg((3 << 11) | 20) & 0xFu; }
#define XB_SPIN(cond, bar) do { unsigned _sp = 0; while (cond) { __builtin_amdgcn_s_sleep(1); \
    if ((++_sp & 255u) == 0u) { if (xb_ld(&(bar)[XB_TMO])) break; if (_sp > XB_SPIN_CAP) { atomicAdd(&(bar)[XB_TMO], 1u); break; } } } } while (0)
struct XcdBarrier { unsigned* bar; unsigned x; volatile LAS unsigned* st; };
__device__ __forceinline__ XcdBarrier xcd_barrier_post(unsigned* bar, volatile LAS unsigned* st) {
    XcdBarrier b; b.bar = bar; b.x = xb_xcc_id(); b.st = st;
    if (threadIdx.x == 0) (void)xb_add(&bar[XB_XCNT(b.x)], 1u);
    return b;
}
__device__ __forceinline__ void xcd_barrier_complete(unsigned* bar, unsigned x, unsigned& nloc, unsigned& nx) {
    const unsigned G = gridDim.x * gridDim.y * gridDim.z;
    unsigned sum, cnt, mine, sp = 0u;
    for (;;) {
        sum = 0u; cnt = 0u; mine = 0u;
#pragma unroll
        for (unsigned j = 0; j < 16; ++j) { const unsigned c = xb_ld(&bar[XB_XCNT(j)]); sum += c; cnt += (c > 0u) ? 1u : 0u; mine = (j == x) ? c : mine; }
        if (sum == G) break;
        __builtin_amdgcn_s_sleep(1);
        if ((++sp & 255u) == 0u) { if (xb_ld(&bar[XB_TMO])) break; if (sp > XB_SPIN_CAP) { atomicAdd(&bar[XB_TMO], 1u); break; } }
    }
    nloc = mine > 0u ? mine : 1u; nx = cnt > 0u ? cnt : 1u;
}
__device__ __forceinline__ void xcd_barrier(const XcdBarrier& b) {
    asm volatile("s_waitcnt vmcnt(0)" ::: "memory");
    __syncthreads();
    if (threadIdx.x == 0) {
        unsigned* bar = b.bar;
        __builtin_amdgcn_s_waitcnt(0);
        unsigned nloc = b.st[0], nx = b.st[1];
        if (nloc == 0u) { xcd_barrier_complete(bar, b.x, nloc, nx); b.st[0] = nloc; b.st[1] = nx; }
#if XB_FLATPOLL
        const unsigned seq = b.st[2]; b.st[2] = seq + 1u;
#endif
        const unsigned old = xb_add(&bar[XB_XSUB(b.x)], 1u);
        const unsigned gen = old / nloc;
        if (old + 1u == (gen + 1u) * nloc) {
            __builtin_amdgcn_fence(__ATOMIC_RELEASE, "agent");
            asm volatile("s_waitcnt vmcnt(0)" ::: "memory");
            const unsigned og = xb_add(&bar[XB_TOP], 1u);
            const unsigned tg = og / nx;
            if (og + 1u == (tg + 1u) * nx) xb_add(&bar[XB_TOPGEN], 1u);
            else XB_SPIN(xb_ld(&bar[XB_TOPGEN]) == tg, bar);
            __builtin_amdgcn_fence(__ATOMIC_ACQUIRE, "agent");
#if !XB_FLATPOLL
            xb_add(&bar[XB_XGEN(b.x)], 1u);
#endif
            asm volatile("s_waitcnt vmcnt(0)" ::: "memory");
        } else {
#if XB_FLATPOLL
            XB_SPIN(xb_ld(&bar[XB_TOPGEN]) == seq, bar);
#else
            XB_SPIN(xb_ld(&bar[XB_XGEN(b.x)]) == gen, bar);
#endif
            __builtin_amdgcn_fence(__ATOMIC_ACQUIRE, "agent");
            asm volatile("s_waitcnt vmcnt(0)" ::: "memory");
        }
    }
    __syncthreads();
}

enum { K_P0 = 0, K_RMIX, K_QKV, K_ROPE, K_ATT, K_OPROJ, K_M1, K_M2, K_M3, K_RPOOL, K_POOLG, K_INPROJ, K_CONV, K_SCAN, K_YPH, K_GFIX, K_OUTPROJ, K_FINAL, K_DBG };
struct Args { const float* in[N_IN]; float* out; unsigned char* ws; int ph_lo, ph_hi; int flags; int bar_region; };

struct Ctx {
    LAS unsigned char* lds; int tid, lane, wave, vcu, G;
};

__device__ __forceinline__ const float* mod_row(const Args& a, int layer, int r) {
    return r < TL ? (const float*)(a.ws + WS_MODL) + (size_t)(layer * 4 + r / SEQ) * 6144 : (const float*)(a.ws + WS_MODC) + (size_t)layer * 6144;
}
__device__ __forceinline__ const float* resid_row(const Args& a, int layer, int r) {
    if (layer == 0) return r < TL ? a.in[I_X] + (size_t)r * D : a.in[I_CTX] + (size_t)(r - TL) * D;
    return (const float*)(a.ws + WS_X) + (size_t)r * D;
}

__device__ __forceinline__ void load_row_combined(const Args& a, int layer, int r, int lane, f32x4 (&v)[4]) {
    if (layer == 0) { const f32x4* xr = (const f32x4*)resid_row(a, 0, r) + lane;
#pragma unroll
        for (int j = 0; j < 4; ++j) v[j] = xr[64 * j]; }
    else { const u32x2* xr = (const u32x2*)((const bf16*)(a.ws + WS_X) + (size_t)r * D) + lane;
#pragma unroll
        for (int j = 0; j < 4; ++j) { const u32x2 p = xr[64 * j]; v[j] = (f32x4){bflo(p.x), bfhi(p.x), bflo(p.y), bfhi(p.y)}; } }
    if (layer > 0 && !(a.flags & 1)) {
        const f32x4* gf = (const f32x4*)(mod_row(a, layer - 1, r) + 5 * D) + lane;
        const u32x2* y0 = (const u32x2*)((const bf16*)(a.ws + WS_Y2) + (size_t)(2 * r) * D) + lane;
        const u32x2* y1 = (const u32x2*)((const bf16*)(a.ws + WS_Y2) + (size_t)(2 * r + 1) * D) + lane;
#pragma unroll
        for (int j = 0; j < 4; ++j) {
            const u32x2 p = y0[64 * j], q = y1[64 * j]; const f32x4 g = gf[64 * j];
            v[j].x += g.x * (bflo(p.x) + bflo(q.x)); v[j].y += g.y * (bfhi(p.x) + bfhi(q.x));
            v[j].z += g.z * (bflo(p.y) + bflo(q.y)); v[j].w += g.w * (bfhi(p.y) + bfhi(q.y));
        }
    }
}
__device__ __forceinline__ float row_rstd(const f32x4 (&v)[4]) {
    float s = 0.f;
#pragma unroll
    for (int j = 0; j < 4; ++j) s += (v[j].x * v[j].x + v[j].y * v[j].y) + (v[j].z * v[j].z + v[j].w * v[j].w);
    return rsqrtf(wave_sum(s) * (1.0f / D) + EPS);
}
__device__ __forceinline__ void norm_mod(const f32x4 (&v)[4], float rstd, const float* g, const float* shift, const float* scale, int lane, f32x4 (&h)[4]) {
#pragma unroll
    for (int j = 0; j < 4; ++j) {
        const f32x4 gg = ((const f32x4*)g)[lane + 64 * j], sh = ((const f32x4*)shift)[lane + 64 * j], sc = ((const f32x4*)scale)[lane + 64 * j];
        h[j] = (v[j] * rstd) * gg * (sc + 1.0f) + sh;
    }
}

__device__ __forceinline__ void tr_item(const float* W, int N, int k0, int n0, bf16* WT, size_t drow0, int dK, LAS float* scr, int lane, int hi_skip = 0) {
    const int nq = lane & 15, kr = lane >> 4;
#pragma unroll
    for (int i = 0; i < 16; ++i) { const int kk = 4 * i + kr; const f32x4 v = *(const f32x4*)(W + (size_t)(k0 + kk) * N + n0 + 4 * nq);
        LAS float* d = scr + kk * 65 + 4 * nq; d[0] = v.x; d[1] = v.y; d[2] = v.z; d[3] = v.w; }
    LDS_WAIT(); asm volatile("" ::: "memory");
    const int c = lane & 7;
#pragma unroll
    for (int j = 0; j < 8; ++j) { const int n = (lane >> 3) + 8 * j; const LAS float* s = scr + (8 * c) * 65 + n;
        u32x4 o; o.x = cvtpk(s[0 * 65], s[1 * 65]); o.y = cvtpk(s[2 * 65], s[3 * 65]); o.z = cvtpk(s[4 * 65], s[5 * 65]); o.w = cvtpk(s[6 * 65], s[7 * 65]);
        *(u32x4*)(WT + (drow0 + n + (n >= 32 ? hi_skip : 0)) * dK + k0 + 8 * c) = o; }
    LDS_WAIT(); asm volatile("" ::: "memory");
}
__device__ __forceinline__ void tr_item8(const float* W, int N, int k0, int n0, unsigned char* WT, size_t drow0, int dKb, LAS float* scr, int lane, float scale, int hi_skip = 0) {
    const int nq = lane & 15, kr = lane >> 4;
#pragma unroll
    for (int i = 0; i < 16; ++i) { const int kk = 4 * i + kr; const f32x4 v = *(const f32x4*)(W + (size_t)(k0 + kk) * N + n0 + 4 * nq);
        LAS float* d = scr + kk * 65 + 4 * nq; d[0] = v.x; d[1] = v.y; d[2] = v.z; d[3] = v.w; }
    LDS_WAIT(); asm volatile("" ::: "memory");
    const int c = lane & 3;
#pragma unroll
    for (int j = 0; j < 4; ++j) { const int n = (lane >> 2) + 16 * j; const LAS float* s = scr + (16 * c) * 65 + n;
        u32x4 o; o.x = pk_fp8x4(s[0 * 65] * scale, s[1 * 65] * scale, s[2 * 65] * scale, s[3 * 65] * scale); o.y = pk_fp8x4(s[4 * 65] * scale, s[5 * 65] * scale, s[6 * 65] * scale, s[7 * 65] * scale);
        o.z = pk_fp8x4(s[8 * 65] * scale, s[9 * 65] * scale, s[10 * 65] * scale, s[11 * 65] * scale); o.w = pk_fp8x4(s[12 * 65] * scale, s[13 * 65] * scale, s[14 * 65] * scale, s[15 * 65] * scale);
        *(u32x4*)(WT + (drow0 + n + (n >= 32 ? hi_skip : 0)) * dKb + k0 + 16 * c) = o; }
    LDS_WAIT(); asm volatile("" ::: "memory");
}
struct TrD { const float* src; int N; unsigned char* dst; int dKb, drow0, hi_skip, fp8; };
__device__ __forceinline__ void tr_load(const TrD& d, f32x4 (&v)[16], int lane) {
    const int nq = lane & 15, kr = lane >> 4;
#pragma unroll
    for (int i = 0; i < 16; ++i) v[i] = *(const f32x4*)(d.src + (size_t)(4 * i + kr) * d.N + 4 * nq);
}
__device__ __forceinline__ void tr_store(const TrD& d, const f32x4 (&v)[16], LAS float* scr, int lane) {
    const int nq = lane & 15, kr = lane >> 4;
#pragma unroll
    for (int i = 0; i < 16; ++i) { LAS float* p = scr + (4 * i + kr) * 65 + 4 * nq; p[0] = v[i].x; p[1] = v[i].y; p[2] = v[i].z; p[3] = v[i].w; }
    LDS_WAIT(); asm volatile("" ::: "memory");
    if (d.fp8) { const int c = lane & 3; const float scale = (float)(1 << MOE_WSH);
#pragma unroll
        for (int j = 0; j < 4; ++j) { const int n = (lane >> 2) + 16 * j; const LAS float* s = scr + (16 * c) * 65 + n;
            u32x4 o; o.x = pk_fp8x4(s[0 * 65] * scale, s[1 * 65] * scale, s[2 * 65] * scale, s[3 * 65] * scale); o.y = pk_fp8x4(s[4 * 65] * scale, s[5 * 65] * scale, s[6 * 65] * scale, s[7 * 65] * scale);
            o.z = pk_fp8x4(s[8 * 65] * scale, s[9 * 65] * scale, s[10 * 65] * scale, s[11 * 65] * scale); o.w = pk_fp8x4(s[12 * 65] * scale, s[13 * 65] * scale, s[14 * 65] * scale, s[15 * 65] * scale);
            *(u32x4*)(d.dst + (size_t)(d.drow0 + n + (n >= 32 ? d.hi_skip : 0)) * d.dKb + 16 * c) = o; } }
    else { const int c = lane & 7;
#pragma unroll
        for (int j = 0; j < 8; ++j) { const int n = (lane >> 3) + 8 * j; const LAS float* s = scr + (8 * c) * 65 + n;
            u32x4 o; o.x = cvtpk(s[0 * 65], s[1 * 65]); o.y = cvtpk(s[2 * 65], s[3 * 65]); o.z = cvtpk(s[4 * 65], s[5 * 65]); o.w = cvtpk(s[6 * 65], s[7 * 65]);
            *(u32x4*)(d.dst + (size_t)(d.drow0 + n + (n >= 32 ? d.hi_skip : 0)) * d.dKb + 16 * c) = o; } }
    LDS_WAIT(); asm volatile("" ::: "memory");
}
constexpr int TR_I0 = 2 * 384, TR_I1 = 2 * 256, TR_I2 = 4 * 16, TR_I3 = 16 * 81, TR_I4 = 32 * 16, TR_I5 = 128 * 256, TR_I6 = 128 * 128, TR_ITOT = TR_I0 + TR_I1 + TR_I2 + TR_I3 + TR_I4 + TR_I5 + TR_I6;
__device__ __forceinline__ TrD tr_decode(const Args& a, int it) {
    TrD d; int r = it; d.hi_skip = 0;
    if (r < TR_I5) { const int m = r / 256, q = r % 256, kb = q / 16, nb = q % 16, n0 = nb * 64, j = n0 & 511;
        d.src = a.in[I_WGU] + (size_t)m * 1024 * 1024 + (size_t)kb * 64 * 1024 + n0; d.N = 1024; d.drow0 = 256 * (j >> 7) + (j & 127) + ((n0 >= 512) ? 128 : 0);
        d.fp8 = MOE_FP8; d.dKb = MOE_FP8 ? 1024 : 2048; d.dst = (unsigned char*)(a.ws + WS_WGU) + (size_t)m * 1024 * d.dKb + (size_t)kb * 64 * (MOE_FP8 ? 1 : 2); return d; }
    r -= TR_I5;
    if (r < TR_I6) { const int m = r / 128, q = r % 128, kb = q / 16, nb = q % 16;
        d.src = a.in[I_WDN] + (size_t)m * 512 * 1024 + (size_t)kb * 64 * 1024 + nb * 64; d.N = 1024; d.drow0 = nb * 64;
        d.fp8 = MOE_FP8; d.dKb = MOE_FP8 ? 512 : 1024; d.dst = (unsigned char*)(a.ws + WS_WDN) + (size_t)m * 1024 * d.dKb + (size_t)kb * 64 * (MOE_FP8 ? 1 : 2); return d; }
    r -= TR_I6;
    if (r < TR_I0) { const int m = r / 384, q = r % 384, kb = q / 24, nb = q % 24;
        d.src = a.in[I_WQKV] + (size_t)m * 1024 * 1536 + (size_t)kb * 64 * 1536 + nb * 64; d.N = 1536; d.drow0 = (nb >> 2) * 256 + (nb & 3) * 32; d.hi_skip = 96;
        d.fp8 = ATT_FP8; d.dKb = ATT_FP8 ? 1024 : 2048; d.dst = (unsigned char*)(a.ws + WS_WQKV) + (size_t)m * 1536 * d.dKb + (size_t)kb * 64 * (ATT_FP8 ? 1 : 2); return d; }
    r -= TR_I0;
    if (r < TR_I1) { const int m = r / 256, q = r % 256, kb = q / 16, nb = q % 16;
        d.src = a.in[I_WO] + (size_t)m * 1024 * 1024 + (size_t)kb * 64 * 1024 + nb * 64; d.N = 1024; d.drow0 = nb * 64;
        d.fp8 = ATT_FP8; d.dKb = ATT_FP8 ? 1024 : 2048; d.dst = (unsigned char*)(a.ws + WS_WO) + (size_t)m * 1024 * d.dKb + (size_t)kb * 64 * (ATT_FP8 ? 1 : 2); return d; }
    r -= TR_I1;
    d.fp8 = 0;
    if (r < TR_I2) { const int m = r / 16, q = r % 16, kb = q / 4, nb = q % 4;
        d.src = a.in[I_POOLW] + (size_t)m * 256 * 256 + (size_t)kb * 64 * 256 + nb * 64; d.N = 256; d.drow0 = nb * 64; d.dKb = 512; d.dst = (unsigned char*)(a.ws + WS_WPOOL) + (size_t)m * 256 * 512 + (size_t)kb * 128; return d; }
    r -= TR_I2;
    if (r < TR_I3) { const int kb = r / 81, nb = r % 81;
        d.src = a.in[I_WIN] + (size_t)kb * 64 * 5184 + nb * 64; d.N = 5184; d.drow0 = nb * 64; d.dKb = 2048; d.dst = (unsigned char*)(a.ws + WS_WIN) + (size_t)kb * 128; return d; }
    r -= TR_I3;
    { const int kb = r / 16, nb = r % 16;
        d.src = a.in[I_WOUT] + (size_t)kb * 64 * 1024 + nb * 64; d.N = 1024; d.drow0 = nb * 64; d.dKb = 4096; d.dst = (unsigned char*)(a.ws + WS_WOUT) + (size_t)kb * 128; return d; }
}
__device__ __forceinline__ void p0_prologue(const Args& a, const Ctx& c) {
    LAS float* scr = (LAS float*)(c.lds + c.wave * 16896);
    const int gw = c.vcu * NWAVES + c.wave, NGW = c.G * NWAVES;
    { f32x4 va[16], vb[16]; TrD da, db; int it = gw;
      da = tr_decode(a, it < TR_ITOT ? it : TR_ITOT - 1); tr_load(da, va, c.lane);
      while (it < TR_ITOT) {
          const int itB = it + NGW; db = tr_decode(a, itB < TR_ITOT ? itB : TR_ITOT - 1); tr_load(db, vb, c.lane);
          tr_store(da, va, scr, c.lane);
          if (itB >= TR_ITOT) break;
          const int itA = itB + NGW; da = tr_decode(a, itA < TR_ITOT ? itA : TR_ITOT - 1); tr_load(da, va, c.lane);
          tr_store(db, vb, scr, c.lane);
          it = itA; } }
    __syncthreads();
    LAS float* sv = (LAS float*)c.lds;
    LAS float* part = (LAS float*)(c.lds + 20480);
    for (int u = c.tid; u < 5 * 1024; u += NTHREADS) { const int v = u >> 10, k = u & 1023; const float x = v < 4 ? a.in[I_C][v * 1024 + k] : a.in[I_CCTX][k]; sv[u] = x / (1.0f + expf(-x)); }
    __syncthreads();
    for (int item = blockIdx.x; item < 4 * 64; item += c.G) {
        const int li = item >> 6, c0 = (item & 63) * 96, cq = c.tid % 24, ks = c.tid / 24;
        f32x4 acc[5];
#pragma unroll
        for (int v = 0; v < 5; ++v) acc[v] = (f32x4){0.f, 0.f, 0.f, 0.f};
        if (ks < 21) { const int kbeg = ks * 49, kend = (kbeg + 49) < 1024 ? (kbeg + 49) : 1024;
            const float* w = a.in[I_WADA] + ((size_t)li * 1024 + kbeg) * 6144 + c0 + 4 * cq;
#pragma unroll 7
            for (int k = kbeg; k < kend; ++k) { const f32x4 wv = *(const f32x4*)w; w += 6144;
#pragma unroll
                for (int v = 0; v < 5; ++v) acc[v] += wv * sv[v * 1024 + k]; }
#pragma unroll
            for (int v = 0; v < 5; ++v) *(LAS f32x4*)(part + (ks * 24 + cq) * 20 + v * 4) = acc[v]; }
        __syncthreads();
        if (c.tid < 480) { const int v = c.tid / 96, col = c.tid % 96, q = col >> 2, e = col & 3; float s = 0.f;
            for (int k2 = 0; k2 < 21; ++k2) s += part[(k2 * 24 + q) * 20 + v * 4 + e];
            s += a.in[I_BADA][li * 6144 + c0 + col];
            if (v < 4) ((float*)(a.ws + WS_MODL))[(size_t)(li * 4 + v) * 6144 + c0 + col] = s; else ((float*)(a.ws + WS_MODC))[(size_t)li * 6144 + c0 + col] = s; }
        __syncthreads();
    }
    if (blockIdx.x == (unsigned)(c.G - 1)) for (int u = c.tid; u < 1024; u += NTHREADS) { const int pos = u >> 4, f = u & 15;
        const float inv = (float)pow(10000.0, -(double)f / 16.0); const double ang = (double)((float)pos * inv);
        ((f32x2*)(a.ws + WS_ROPE))[u] = (f32x2){(float)cos(ang), (float)sin(ang)}; }
    for (int u = blockIdx.x * NTHREADS + c.tid; u < 4 * 64 * 1024; u += c.G * NTHREADS) { const int li = u >> 16, n = (u >> 10) & 63, k = u & 1023;
        float w = 0.f; if (n < 4) w = a.in[I_WRG][((size_t)li * 1024 + k) * 4 + n]; else if (n < 36) w = a.in[I_WRE][((size_t)li * 1024 + k) * 32 + (n - 4)];
        const unsigned hi = cvtpk(w, 0.f) & 0xffffu; const float rem = w - bflo(hi); const unsigned lo = cvtpk(rem, 0.f) & 0xffffu;
        bf16* wr = (bf16*)(a.ws + WS_WR) + (size_t)li * 2 * 65536;
        const int fo = (((k >> 7) * 8 + ((k >> 4) & 7)) * 4 + (n >> 5)) * 512 + ((n & 31) + 32 * ((k >> 3) & 1)) * 8 + (k & 7);
        wr[fo] = (bf16)hi; wr[fo + 1024] = (bf16)lo; }
}

__device__ __forceinline__ void ph_rmix(const Args& a, const Ctx& c, int layer) {
    const int gw = c.vcu * NWAVES + c.wave, NGW = c.G * NWAVES;
    const float* g = a.in[I_NMIX] + layer * D;
    for (int r = gw; r < TT; r += NGW) {
        f32x4 v[4], h[4]; load_row_combined(a, layer, r, c.lane, v);
        if (layer > 0) { u32x2* xo = (u32x2*)((bf16*)(a.ws + WS_X) + (size_t)r * D) + c.lane;
#pragma unroll
            for (int j = 0; j < 4; ++j) xo[64 * j] = (u32x2){cvtpk(v[j].x, v[j].y), cvtpk(v[j].z, v[j].w)}; }
        const float rstd = row_rstd(v); const float* m = mod_row(a, layer, r);
        norm_mod(v, rstd, g, m, m + D, c.lane, h);
        if (ATT_FP8 && layer != 2) { unsigned* ho8 = (unsigned*)((unsigned char*)(a.ws + WS_HB) + (size_t)r * D) + c.lane;
#pragma unroll
            for (int j = 0; j < 4; ++j) ho8[64 * j] = pk_fp8x4(h[j].x, h[j].y, h[j].z, h[j].w); }
        else { u32x2* ho = (u32x2*)((bf16*)(a.ws + WS_HB) + (size_t)r * D) + c.lane;
#pragma unroll
            for (int j = 0; j < 4; ++j) ho[64 * j] = (u32x2){cvtpk(h[j].x, h[j].y), cvtpk(h[j].z, h[j].w)}; }
    }
}

__device__ __forceinline__ void ph_final(const Args& a, const Ctx& c, int layer) {
    const int gw = c.vcu * NWAVES + c.wave, NGW = c.G * NWAVES;
    float dscale = 1.f, dmark = 0.f;
#if DEBUG_CHECKS
    { unsigned* dbg = (unsigned*)(a.ws + WS_CTL) + CW_DBG; int code = 0; float mag = 0.f;
      for (int id = 1; id < 32; ++id) { const float e = __uint_as_float(__hip_atomic_load(dbg + id, __ATOMIC_RELAXED, __HIP_MEMORY_SCOPE_AGENT)); if (code == 0 && e > DBG_TOL) { code = id; mag = e; } }
      dscale = 1.f + (float)code; dmark = code ? 100.f * (1.f + fminf(fmaxf(log2f(mag / DBG_TOL), 0.f), 30.f)) : 0.f; }
#endif
    for (int r = gw; r < TL; r += NGW) {
        f32x4 v[4]; load_row_combined(a, layer, r, c.lane, v);
        const float rstd = row_rstd(v) * dscale;
        f32x4* o = (f32x4*)(a.out + (size_t)r * D) + c.lane;
#pragma unroll
        for (int j = 0; j < 4; ++j) { f32x4 ov = (v[j] * rstd) * ((const f32x4*)a.in[I_NFIN])[c.lane + 64 * j]; if (j == 0 && r == 0 && c.lane == 0 && dmark > 0.f) ov.x = dmark; o[64 * j] = ov; }
    }
}


namespace pg8 {
constexpr int BM = 256, BK = 64, HALF = 128, HTB = HALF * BK * 2, STAGE_BYTES = 8 * HTB;
__host__ __device__ __forceinline__ int lds_byte(int r, int c) { const int st = (r >> 4) * 2 + (c >> 5), rr = r & 15, cc = c & 31, ob = rr * 64 + cc * 2; return st * 1024 + (ob ^ (((ob >> 9) & 1) << 5)); }
__host__ __device__ __forceinline__ void stage_rc(int b, int& R, int& C) { const int st = b / 1024, sb = b % 1024, swz = sb ^ (((sb >> 9) & 1) << 5); R = (st >> 1) * 16 + swz / 64; C = (st & 1) * 32 + (swz % 64) / 2; }
__host__ __device__ __forceinline__ int perm32(int rho) { const int n = rho >> 4, i = rho & 15; return 8 * (i >> 2) + 4 * n + (i & 3); }
struct Unit { const char* A; const char* B; int pm, pn, x0, x1; };
__device__ __forceinline__ void tile_of(int L, int nM, int nN, int& pm, int& pn) {
    const int nwg = nM * nN; int wgid = L; { const int q = nwg / 8, r = nwg % 8, xcd = wgid % 8, off = wgid / 8; wgid = (xcd < r ? xcd * (q + 1) : r * (q + 1) + (xcd - r) * q) + off; }
    const int nig = 8 * nN, gid = wgid / nig, fm = gid * 8, gsz = (nM - fm) < 8 ? (nM - fm) : 8;
    pm = fm + ((wgid % nig) % gsz); pn = (wgid % nig) / gsz;
}
typedef int v4i_t __attribute__((ext_vector_type(4))); typedef int v8i_t __attribute__((ext_vector_type(8)));
template <class Epi, class Sched, bool GATHER, bool FP8 = false>
__device__ __forceinline__ void gemm_phase(LAS unsigned char* lds, const int Kb, const int ldab, const Sched& S, const Epi& E, const int scw = 127, const int sca = 127) {
    const int tid = tid_opaque(), wid = __builtin_amdgcn_readfirstlane(tid >> 6), lane = tid & 63, wr = wid >> 2, wc = wid & 3, fr = lane & 15, fq = lane >> 4;
    const int nt = Kb / (BK * 2);
    int scw_v = scw, sca_v = sca;
    unsigned voffA[2], voffB[2]; int RA[2], CA[2];
#pragma unroll
    for (int i = 0; i < 2; ++i) { int R, C; stage_rc(tid * 16 + i * 8192, R, C); const int Rb = Epi::PERM ? ((R & ~31) + perm32(R & 31)) : R;
        RA[i] = R; CA[i] = C; voffA[i] = (unsigned)(R * ldab + C * 2); voffB[i] = (unsigned)(Rb * Kb + C * 2); }
    const size_t kstep = (size_t)(BK * 2);
    const size_t hstepA = (size_t)HALF * ldab, hstepB = (size_t)HALF * Kb;
    const unsigned ldsw = (unsigned)wid * 1024u;
    const int aoff = lds_byte(wr * 64 + fr, fq * 8), boff = lds_byte(wc * 32 + fr, fq * 8);
#define PG8_SA(b, h) (((b) * 2 + (h)) * HTB)
#define PG8_SB(b, h) ((4 + (b) * 2 + (h)) * HTB)
#define PG8_GLDS(bufoff, gptr, i_) __builtin_amdgcn_global_load_lds((const unsigned*)(gptr), (LAS unsigned*)(lds + (bufoff) + ldsw + (i_) * 8192), 16, 0, 0)
#define PG8_STAGE_B(bufoff, gbase) do { _Pragma("unroll") for (int _i = 0; _i < 2; ++_i) PG8_GLDS(bufoff, (const char*)(gbase) + voffB[_i], _i); } while (0)
#define PG8_STAGE_A(bufoff, ab, kb, h, NX) do { _Pragma("unroll") for (int _i = 0; _i < 2; ++_i) { \
        if constexpr (GATHER) { const unsigned _vo = (NX) ? voN[h][_i] : voC[h][_i]; PG8_GLDS(bufoff, (ab) + (kb) + _vo, _i); } \
        else { PG8_GLDS(bufoff, (ab) + (kb) + (size_t)(h) * hstepA + voffA[_i], _i); } } } while (0)
#define PG8_LDA(dst, b, h) do { _Pragma("unroll") for (int m = 0; m < 4; ++m) _Pragma("unroll") for (int k = 0; k < 2; ++k) dst[m][k] = *(const LAS bf16x8*)(lds + PG8_SA(b, h) + aoff + m * 2048 + k * 1024); } while (0)
#define PG8_LDB(dst, b, h) do { _Pragma("unroll") for (int n = 0; n < 2; ++n) _Pragma("unroll") for (int k = 0; k < 2; ++k) dst[n][k] = *(const LAS bf16x8*)(lds + PG8_SB(b, h) + boff + n * 2048 + k * 1024); } while (0)
#define PG8_MMA(ai, bj, At, Bt) do { __builtin_amdgcn_s_setprio(1); _Pragma("unroll") for (int m = 0; m < 4; ++m) _Pragma("unroll") for (int n = 0; n < 2; ++n) { \
        if constexpr (FP8) { const v8i_t b8 = __builtin_shufflevector(__builtin_bit_cast(v4i_t, Bt[n][0]), __builtin_bit_cast(v4i_t, Bt[n][1]), 0, 1, 2, 3, 4, 5, 6, 7), a8 = __builtin_shufflevector(__builtin_bit_cast(v4i_t, At[m][0]), __builtin_bit_cast(v4i_t, At[m][1]), 0, 1, 2, 3, 4, 5, 6, 7); \
            asm volatile("v_mfma_scale_f32_16x16x128_f8f6f4 %0, %1, %2, %0, %3, %4 op_sel_hi:[0,0,0]" : "+v"(acc[ai][bj][m][n]) : "v"(b8), "v"(a8), "v"(scw_v), "v"(sca_v)); } \
        else { _Pragma("unroll") for (int k = 0; k < 2; ++k) acc[ai][bj][m][n] = __builtin_amdgcn_mfma_f32_16x16x32_bf16(Bt[n][k], At[m][k], acc[ai][bj][m][n], 0, 0, 0); } } __builtin_amdgcn_s_setprio(0); } while (0)
#define PG8_WAIT_V(n) asm volatile("s_waitcnt vmcnt(" #n ")" ::: "memory")
#define PG8_WAIT_L(n) asm volatile("s_waitcnt lgkmcnt(" #n ")" ::: "memory")
#define PG8_BAR __builtin_amdgcn_s_barrier()
#define PG8_SCHED __builtin_amdgcn_sched_barrier(0)
    Unit cur, nxt, pend; int ui = 0; bool have_pend = false;
    if (!S.next(0, cur)) return;
    pend = cur;
    unsigned voC[2][2], voN[2][2];
    if constexpr (GATHER) {
#pragma unroll
        for (int h = 0; h < 2; ++h)
#pragma unroll
            for (int i = 0; i < 2; ++i) { voC[h][i] = (unsigned)(S.gather(cur, h * HALF + RA[i]) * ldab + CA[i] * 2); voN[h][i] = voC[h][i]; }
    } else { voC[0][0] = voN[0][0] = 0u; }
    f32x4 acc[2][2][4][2];
#pragma unroll
    for (int a = 0; a < 2; ++a)
#pragma unroll
        for (int b = 0; b < 2; ++b)
#pragma unroll
            for (int m = 0; m < 4; ++m)
#pragma unroll
                for (int n = 0; n < 2; ++n) acc[a][b][m][n] = (f32x4){0.f, 0.f, 0.f, 0.f};
    bf16x8 At[4][2], B0[2][2], B1[2][2];
    const char* cA = cur.A; const char* cB = cur.B;
    S.a_ready(cur, wid);
    PG8_STAGE_B(PG8_SB(0, 0), cB); PG8_STAGE_B(PG8_SB(0, 1), cB + hstepB); PG8_STAGE_A(PG8_SA(0, 0), cA, (size_t)0, 0, false); PG8_STAGE_A(PG8_SA(0, 1), cA, (size_t)0, 1, false);
    if (wr == 1) PG8_BAR;
    PG8_WAIT_V(2); PG8_BAR;
    PG8_STAGE_B(PG8_SB(1, 0), cB + kstep); PG8_STAGE_A(PG8_SA(1, 0), cA, kstep, 0, false); PG8_STAGE_B(PG8_SB(1, 1), cB + hstepB + kstep);
    PG8_WAIT_V(6); PG8_BAR;
    for (;;) {
        const bool has_next = S.next(ui + 1, nxt);
        if constexpr (GATHER) { if (has_next) {
#pragma unroll
            for (int h = 0; h < 2; ++h)
#pragma unroll
                for (int i = 0; i < 2; ++i) voN[h][i] = (unsigned)(S.gather(nxt, h * HALF + RA[i]) * ldab + CA[i] * 2); } }
        const char* nA = has_next ? nxt.A : cA; const char* nB = has_next ? nxt.B : cB;
        for (int t = 0; t < nt; t += 2) {
            const bool last = (t == nt - 2);
            if constexpr (Sched::KSCALE) { if (t != 0 && (t & 7) == 0) S.kscale(acc, cur, t >> 3, wr); }
            const size_t k1 = (size_t)(t + 1) * kstep;
            const char* a2 = last ? nA : cA; const size_t k2 = last ? (size_t)0 : (size_t)(t + 2) * kstep; const size_t k3 = k2 + kstep;
            const char* b2 = last ? nB : cB + (size_t)(t + 2) * kstep; const char* b3 = b2 + kstep;
            const bool nx = GATHER ? (last && has_next) : false;
            if (last && has_next) S.a_ready(nxt, wid);
            PG8_LDB(B0, 0, 0); PG8_LDB(B1, 0, 1); PG8_SCHED; PG8_LDA(At, 0, 0); PG8_STAGE_A(PG8_SA(1, 1), cA, k1, 1, false);
            PG8_WAIT_V(8); PG8_WAIT_L(0); PG8_BAR; PG8_MMA(0, 0, At, B0); PG8_MMA(0, 1, At, B1); PG8_BAR; PG8_SCHED;
            PG8_LDA(At, 0, 1); PG8_STAGE_B(PG8_SB(0, 0), b2); PG8_STAGE_B(PG8_SB(0, 1), b2 + hstepB); PG8_STAGE_A(PG8_SA(0, 0), a2, k2, 0, nx);
            PG8_WAIT_V(8); PG8_WAIT_L(0);
            if constexpr (!Sched::IMM_DONE) { if (have_pend) { S.done(pend, lane); have_pend = false; } }
            PG8_BAR; PG8_MMA(1, 0, At, B0); PG8_MMA(1, 1, At, B1); PG8_BAR; PG8_SCHED;
            PG8_LDB(B0, 1, 0); PG8_LDB(B1, 1, 1); PG8_SCHED; PG8_LDA(At, 1, 0); PG8_STAGE_A(PG8_SA(0, 1), a2, k2, 1, nx);
            PG8_WAIT_V(8); PG8_WAIT_L(0); PG8_BAR; PG8_MMA(0, 0, At, B0); PG8_MMA(0, 1, At, B1); PG8_BAR; PG8_SCHED;
            PG8_LDA(At, 1, 1); PG8_STAGE_B(PG8_SB(1, 0), b3); PG8_STAGE_B(PG8_SB(1, 1), b3 + hstepB); PG8_STAGE_A(PG8_SA(1, 0), a2, k3, 0, nx);
            PG8_WAIT_V(8); PG8_WAIT_L(0); PG8_BAR; PG8_MMA(1, 0, At, B0); PG8_MMA(1, 1, At, B1); PG8_BAR; PG8_SCHED;
        }
        if (wr == 0) PG8_BAR;
        if constexpr (FP8) asm volatile("s_nop 15\n\ts_nop 15" ::: "memory");
        E(acc, cur, wr, wc, fr, fq);
        if constexpr (Sched::IMM_DONE) { PG8_WAIT_V(0); S.done(cur, lane); }
        else { pend = cur; have_pend = true; }
        if (!has_next) break;
#pragma unroll
        for (int a = 0; a < 2; ++a)
#pragma unroll
            for (int b = 0; b < 2; ++b)
#pragma unroll
                for (int m = 0; m < 4; ++m)
#pragma unroll
                    for (int n = 0; n < 2; ++n) acc[a][b][m][n] = (f32x4){0.f, 0.f, 0.f, 0.f};
        cur = nxt; cA = nA; cB = nB; ++ui;
        if constexpr (GATHER) {
#pragma unroll
            for (int h = 0; h < 2; ++h)
#pragma unroll
                for (int i = 0; i < 2; ++i) voC[h][i] = voN[h][i]; }
        if (wr == 1) PG8_BAR;
    }
    PG8_WAIT_V(0);
    if constexpr (!Sched::IMM_DONE) { if (have_pend) S.done(pend, lane); }
    PG8_BAR;
#undef PG8_SA
#undef PG8_SB
#undef PG8_GLDS
#undef PG8_STAGE_A
#undef PG8_STAGE_B
#undef PG8_LDA
#undef PG8_LDB
#undef PG8_MMA
#undef PG8_WAIT_V
#undef PG8_WAIT_L
#undef PG8_BAR
#undef PG8_SCHED
}
}
#include <hip/hip_bf16.h>
#include <cmath>
namespace attn_body {
using bf16=__hip_bfloat16;
using bf16x8=__attribute__((ext_vector_type(8)))short;
using s16x4=__attribute__((ext_vector_type(4)))short;
using f32x16=__attribute__((ext_vector_type(16)))float;
using u32x4=__attribute__((ext_vector_type(4)))unsigned;
constexpr int D=64,QP=1024,KVP=256;
constexpr int NW=8,QBLK=32,QB=QBLK*NW,KVBLK=64;
__device__ __forceinline__ int crow(int r,int hi){return (r&3)+8*(r>>2)+4*hi;}
#define SBAR() __builtin_amdgcn_sched_barrier(0)
constexpr int NSLOT=3, SLOTB=8192;
constexpr int LDS_K=0, LDS_V=NSLOT*SLOTB, LDS_WS=2*NSLOT*SLOTB, LDS_OST=LDS_WS+NW*64*4, LDS_BYTES=LDS_OST+NW*4096;
constexpr float C2=0.125f*1.4426950408889634f;
__device__ __forceinline__ void glds16s(const void*sbase,unsigned voff,unsigned lds_dst){unsigned keep;
  asm volatile("s_mov_b32 %0, m0\n\ts_mov_b32 m0, %3\n\ts_nop 4\n\tglobal_load_lds_dwordx4 %1, %2\n\ts_mov_b32 m0, %0":"=&s"(keep):"v"(voff),"s"(sbase),"s"(lds_dst):"memory");}
__device__ __forceinline__ float max3f(float a,float b,float c){float r;asm("v_max3_f32 %0, %1, %2, %3":"=v"(r):"v"(a),"v"(b),"v"(c));return r;}
__device__ __forceinline__ float max2f(float a,float b){float r;asm("v_max_f32_e32 %0, %1, %2":"=v"(r):"v"(a),"v"(b));return r;}
__device__ __forceinline__ float fadd_s(float a,float b){float r;asm("v_add_f32_e32 %0, %1, %2":"=v"(r):"v"(a),"v"(b));return r;}
__device__ __forceinline__ float fsub_s(float a,float b){float r;asm("v_sub_f32_e32 %0, %1, %2":"=v"(r):"v"(a),"v"(b));return r;}
typedef float f32x2_t __attribute__((ext_vector_type(2))); typedef __bf16 bf16x2_t __attribute__((ext_vector_type(2)));
__device__ __forceinline__ unsigned cvtpk_s(float lo,float hi){f32x2_t v={lo,hi};bf16x2_t b=__builtin_convertvector(v,bf16x2_t);return __builtin_bit_cast(unsigned,b);}
#define WAIT_BAR(N) asm volatile("s_waitcnt vmcnt(" #N ") lgkmcnt(0)\n\ts_barrier":::"memory")

__device__ __forceinline__ void qkt(f32x16&p0,f32x16&p1,const char*Kslot,const bf16x8*qr,const f32x16&negm,int r32,int hi){
  const char*kb=Kslot+hi*1024+r32*16;
  #pragma unroll
  for(int d0=0;d0<4;++d0){
    const bf16x8 b0=*reinterpret_cast<const bf16x8*>(kb+d0*2048);
    const bf16x8 b1=*reinterpret_cast<const bf16x8*>(kb+d0*2048+512);
    if(d0==0){p0=__builtin_amdgcn_mfma_f32_32x32x16_bf16(b0,qr[0],negm,0,0,0);p1=__builtin_amdgcn_mfma_f32_32x32x16_bf16(b1,qr[0],negm,0,0,0);}
    else{p0=__builtin_amdgcn_mfma_f32_32x32x16_bf16(b0,qr[d0],p0,0,0,0);p1=__builtin_amdgcn_mfma_f32_32x32x16_bf16(b1,qr[d0],p1,0,0,0);}}
}
typedef __attribute__((address_space(3))) const char* lds_cptr;
typedef short v4i16_t __attribute__((ext_vector_type(4)));
__device__ __forceinline__ void kload8(bf16x8*kf,lds_cptr kp){
  kf[0]=*(const __attribute__((address_space(3))) bf16x8*)(kp);      kf[1]=*(const __attribute__((address_space(3))) bf16x8*)(kp+512);
  kf[2]=*(const __attribute__((address_space(3))) bf16x8*)(kp+2048); kf[3]=*(const __attribute__((address_space(3))) bf16x8*)(kp+2560);
  kf[4]=*(const __attribute__((address_space(3))) bf16x8*)(kp+4096); kf[5]=*(const __attribute__((address_space(3))) bf16x8*)(kp+4608);
  kf[6]=*(const __attribute__((address_space(3))) bf16x8*)(kp+6144); kf[7]=*(const __attribute__((address_space(3))) bf16x8*)(kp+6656);
}
__device__ __forceinline__ void kload2(bf16x8*kf,lds_cptr kp,int j){ kf[2*j]=*(const __attribute__((address_space(3))) bf16x8*)(kp+j*2048); kf[2*j+1]=*(const __attribute__((address_space(3))) bf16x8*)(kp+j*2048+512); }
__device__ __forceinline__ s16x4 vtr(lds_cptr p){ return __builtin_bit_cast(s16x4,__builtin_amdgcn_ds_read_tr16_b64_v4i16((__attribute__((address_space(3))) v4i16_t*)p)); }
__device__ __forceinline__ float rowmax(const f32x16&p0,const f32x16&p1){
  float a=max3f(p0[0],p0[1],p1[0]),b=max3f(p0[2],p0[3],p1[1]);a=max3f(a,p1[2],p1[3]);
  #pragma unroll
  for(int r=4;r<16;r+=4){a=max3f(a,p0[r],p0[r+1]);b=max3f(b,p0[r+2],p0[r+3]);a=max3f(a,p1[r],p1[r+1]);b=max3f(b,p1[r+2],p1[r+3]);}
  const float m=max2f(a,b);
  auto rr=__builtin_amdgcn_permlane32_swap(__float_as_uint(m),__float_as_uint(m),false,false);
  return max2f(__uint_as_float(rr[0]),__uint_as_float(rr[1]));
}
__device__ __forceinline__ void pv(f32x16*o,int vb,bf16x8 pa0,bf16x8 pa1,bf16x8 pa2,bf16x8 pa3){
  #pragma unroll
  for(int d0=0;d0<2;++d0){s16x4 lo[4],hi[4];
    #pragma unroll
    for(int ks=0;ks<4;++ks){
      asm volatile("ds_read_b64_tr_b16 %0,%1 offset:%c2":"=&v"(lo[ks]):"v"(vb),"i"(d0*4096+ks*1024):"memory");
      asm volatile("ds_read_b64_tr_b16 %0,%1 offset:%c2":"=&v"(hi[ks]):"v"(vb),"i"(d0*4096+ks*1024+512):"memory");}
    asm volatile("s_waitcnt lgkmcnt(0)":::"memory");SBAR();
    #define PK(k) (bf16x8){lo[k][0],lo[k][1],lo[k][2],lo[k][3],hi[k][0],hi[k][1],hi[k][2],hi[k][3]}
    o[d0]=__builtin_amdgcn_mfma_f32_32x32x16_bf16(pa0,PK(0),o[d0],0,0,0);
    o[d0]=__builtin_amdgcn_mfma_f32_32x32x16_bf16(pa1,PK(1),o[d0],0,0,0);
    o[d0]=__builtin_amdgcn_mfma_f32_32x32x16_bf16(pa2,PK(2),o[d0],0,0,0);
    o[d0]=__builtin_amdgcn_mfma_f32_32x32x16_bf16(pa3,PK(3),o[d0],0,0,0);
    #undef PK
  }
}

#ifndef ATTN_STORE16
#define ATTN_STORE16(p,v) (*(u32x4*)(p)=(v))
#endif
template<int THRL> __device__ __forceinline__ void attn_unit(long qrow0,int h,long kvrow0,int NT,const bf16*Q,const bf16*__restrict__ K,const bf16*__restrict__ V,bf16*O,char*shm){
  const int tid=tid_opaque(),lane=tid&63,r32=lane&31,hi=lane>>5; const int wid=__builtin_amdgcn_readfirstlane(tid>>6);
  const bf16*Qw=Q+(qrow0+wid*QBLK)*QP+h*D;
  const bf16*Kh=K+kvrow0*KVP+(h>>2)*D,*Vh=V+kvrow0*KVP+(h>>2)*D;
  const unsigned lds0=(unsigned)(uintptr_t)shm;
  float*wsf=(float*)(shm+LDS_WS)+wid*64;
  const unsigned kvo=(unsigned)(lane*KVP+wid*8)*2u;
  const unsigned vvo=(unsigned)((16*(wid&3)+(lane>>2))*KVP+(wid>>2)*32+(lane&3)*8)*2u;
  const unsigned kdst=lds0+LDS_K+wid*1024, vdst=lds0+LDS_V+wid*1024;
  #define DMA_K(t,slot) glds16s(Kh+(long)(t)*KVBLK*KVP,kvo,(unsigned)__builtin_amdgcn_readfirstlane(kdst+(slot)))
  #define DMA_V(t,slot) glds16s(Vh+(long)(t)*KVBLK*KVP,vvo,(unsigned)__builtin_amdgcn_readfirstlane(vdst+(slot)))
  const int vb0=(int)(lds0+LDS_V)+((lane>>4)&1)*32+(lane&3)*8+(4*hi+((lane&15)>>2))*64;
  const char*Kbase=shm+LDS_K; bf16x8 kf[8];
  const lds_cptr shm3=(lds_cptr)shm; const lds_cptr kp0=shm3+LDS_K+hi*1024+r32*16; const lds_cptr vp0=shm3+LDS_V+((lane>>4)&1)*32+(lane&3)*8+(4*hi+((lane&15)>>2))*64;
  DMA_K(0,0);DMA_V(0,0);DMA_K(1,SLOTB);
  bf16x8 qr[4];
  #pragma unroll
  for(int d0=0;d0<4;++d0)qr[d0]=*reinterpret_cast<const bf16x8*>(&Qw[(long)r32*QP+d0*16+hi*8]);
  float mhat=0.f,l_reg=0.f;f32x16 o[2];o[0]=f32x16{};o[1]=f32x16{};f32x16 negm=f32x16{};asm volatile("":"+v"(negm));
  #define CMASK(P0,P1,t) do{}while(0)
  bool resc=false;
  #define START(P0,P1) do{ const float rm=rowmax(P0,P1); resc=false; \
    { const float dl=rm; mhat=fadd_s(mhat,dl); \
      _Pragma("unroll") for(int r=0;r<16;++r){P0[r]=fsub_s(P0[r],dl);P1[r]=fsub_s(P1[r],dl);} \
      _Pragma("unroll") for(int r=0;r<16;++r)negm[r]=-mhat; asm volatile("":"+v"(negm)); } \
    _Pragma("unroll") for(int r=0;r<16;++r)P0[r]=__builtin_amdgcn_exp2f(P0[r]); }while(0)
  #define RESC() do{ if(resc){ asm volatile("s_waitcnt lgkmcnt(0)":::"memory"); \
      _Pragma("unroll") for(int d_=0;d_<2;++d_) _Pragma("unroll") for(int r=0;r<16;++r)o[d_][r]*=wsf[crow(r,hi)]; } }while(0)
  f32x16 pA0,pA1,pB0,pB1;
  int sl_prev=0,sl_cur=0,sl_next=SLOTB;
  #define ROT() do{sl_prev=sl_cur;sl_cur=sl_next;sl_next=(sl_next==(NSLOT-1)*SLOTB)?0:sl_next+SLOTB;}while(0)
  DMA_K(2,2*SLOTB);
  WAIT_BAR(3);
  qkt(pA0,pA1,Kbase,qr,negm,r32,hi);asm volatile("s_nop 15\n\ts_nop 7":"+v"(pA0),"+v"(pA1));CMASK(pA0,pA1,0);
  START(pA0,pA1);
  _Pragma("unroll") for(int r=0;r<16;++r)pA1[r]=__builtin_amdgcn_exp2f(pA1[r]);
  WAIT_BAR(0);
  DMA_K(3,0);DMA_V(1,SLOTB);
  ROT();
  kload8(kf,kp0+sl_cur);
  WAIT_BAR(2);
  s16x4 vlo[8],vhi[8]; u32x4 pw0,pw1,pw2,pw3;
  #define PKW(P,B) cvtpk_s(P[B],P[B+1])
  #define PAF(k) __builtin_bit_cast(bf16x8,pw##k)
  #define VFR(i) (bf16x8){vlo[i][0],vlo[i][1],vlo[i][2],vlo[i][3],vhi[i][0],vhi[i][1],vhi[i][2],vhi[i][3]}
  #define PIN(x) asm volatile("":"+v"(x))
  #define MX3(a,b,c) __builtin_fmaxf(__builtin_fmaxf((a),(b)),(c))
  #define GAPA(MF,A0,A1,A2,A3,W0,W1,PW) do{ MF; sacc+=A0; sacc+=A1; sacc+=A2; sacc+=A3; PIN(sacc); W0; W1; PIN(PW); SBAR(); }while(0)
  #define EX(v) __builtin_amdgcn_exp2f(v)
  #define GAPB(MF,X,B) do{ MF; X[B]=EX(X[B]); X[B+1]=EX(X[B+1]); X[B+2]=EX(X[B+2]); X[B+3]=EX(X[B+3]); PIN(X); SBAR(); }while(0)
  #define VRD(i) do{ vlo[i]=vtr(vp_+(((i)>>2)*4096+((i)&3)*1024)); vhi[i]=vtr(vp_+(((i)>>2)*4096+((i)&3)*1024+512)); }while(0)
  #define KRD(G,j) do{ if(G){ kload2(kf,kp0+sl_next,j); SBAR(); } }while(0)
  #define STEP(C0,C1,P0,P1,t,GK,GV,GL) do{ SBAR(); \
    const lds_cptr vp_=vp0+sl_prev; \
    VRD(0); SBAR(); float sacc=(P0[0]+P0[1]); \
    GAPA(C0=__builtin_amdgcn_mfma_f32_32x32x16_bf16(kf[0],qr[0],negm,0,0,0), P0[2],P0[3],P0[4],P0[5],     pw0[0]=PKW(P0,0), pw0[1]=PKW(P0,2), pw0); \
    VRD(4); SBAR(); GAPA(C1=__builtin_amdgcn_mfma_f32_32x32x16_bf16(kf[1],qr[0],negm,0,0,0), P0[6],P0[7],P0[8],P0[9],     pw0[2]=PKW(P0,4), pw0[3]=PKW(P0,6), pw0); \
    VRD(1); SBAR(); GAPA(C0=__builtin_amdgcn_mfma_f32_32x32x16_bf16(kf[2],qr[1],C0,0,0,0),   P0[10],P0[11],P0[12],P0[13], pw1[0]=PKW(P0,8), pw1[1]=PKW(P0,10), pw1); \
    VRD(5); SBAR(); GAPA(C1=__builtin_amdgcn_mfma_f32_32x32x16_bf16(kf[3],qr[1],C1,0,0,0),   P0[14],P0[15],P1[0],P1[1],   pw1[2]=PKW(P0,12),pw1[3]=PKW(P0,14), pw1); \
    VRD(2); SBAR(); GAPA(C0=__builtin_amdgcn_mfma_f32_32x32x16_bf16(kf[4],qr[2],C0,0,0,0),   P1[2],P1[3],P1[4],P1[5],     pw2[0]=PKW(P1,0), pw2[1]=PKW(P1,2), pw2); \
    VRD(6); SBAR(); GAPA(C1=__builtin_amdgcn_mfma_f32_32x32x16_bf16(kf[5],qr[2],C1,0,0,0),   P1[6],P1[7],P1[8],P1[9],     pw2[2]=PKW(P1,4), pw2[3]=PKW(P1,6), pw2); \
    VRD(3); SBAR(); GAPA(C0=__builtin_amdgcn_mfma_f32_32x32x16_bf16(kf[6],qr[3],C0,0,0,0),   P1[10],P1[11],P1[12],P1[13], pw3[0]=PKW(P1,8), pw3[1]=PKW(P1,10), pw3); \
    VRD(7); SBAR(); GAPA(C1=__builtin_amdgcn_mfma_f32_32x32x16_bf16(kf[7],qr[3],C1,0,0,0),   P1[14],P1[15],0.f,0.f,       pw3[2]=PKW(P1,12),pw3[3]=PKW(P1,14), pw3); \
    l_reg+=sacc; \
    if(GK){DMA_K((t)+3,sl_cur);} if(GV){DMA_V((t)+1,sl_next);} \
    CMASK(C0,C1,t); \
    { float a=MX3(C0[0],C0[1],C1[0]),b=MX3(C0[2],C0[3],C1[1]); a=MX3(a,C1[2],C1[3]); \
      _Pragma("unroll") for(int r=4;r<16;r+=4){a=MX3(a,C0[r],C0[r+1]);b=MX3(b,C0[r+2],C0[r+3]);a=MX3(a,C1[r],C1[r+1]);b=MX3(b,C1[r+2],C1[r+3]);} \
      float rm=__builtin_fmaxf(a,b); { auto rr=__builtin_amdgcn_permlane32_swap(__float_as_uint(rm),__float_as_uint(rm),false,false); rm=__builtin_fmaxf(__uint_as_float(rr[0]),__uint_as_float(rr[1])); } \
      resc=false; \
      if(__builtin_expect(__any(rm>(float)THRL),0)){ const float dl=__builtin_fmaxf(rm,0.f); mhat+=dl; \
        _Pragma("unroll") for(int r=0;r<16;++r){C0[r]-=dl;C1[r]-=dl;} \
        _Pragma("unroll") for(int r=0;r<16;++r)negm[r]=-mhat; asm volatile("":"+v"(negm)); \
        const float f=__builtin_amdgcn_exp2f(-dl); l_reg*=f; if(hi==0)wsf[r32]=f; resc=true; } } \
    SBAR(); \
    GAPB(o[0]=__builtin_amdgcn_mfma_f32_32x32x16_bf16(PAF(0),VFR(0),o[0],0,0,0), C0,0); \
    GAPB(o[1]=__builtin_amdgcn_mfma_f32_32x32x16_bf16(PAF(0),VFR(4),o[1],0,0,0), C0,4); \
    KRD(GL,0); GAPB(o[0]=__builtin_amdgcn_mfma_f32_32x32x16_bf16(PAF(1),VFR(1),o[0],0,0,0), C0,8); \
    KRD(GL,1); GAPB(o[1]=__builtin_amdgcn_mfma_f32_32x32x16_bf16(PAF(1),VFR(5),o[1],0,0,0), C0,12); \
    KRD(GL,2); GAPB(o[0]=__builtin_amdgcn_mfma_f32_32x32x16_bf16(PAF(2),VFR(2),o[0],0,0,0), C1,0); \
    KRD(GL,3); GAPB(o[1]=__builtin_amdgcn_mfma_f32_32x32x16_bf16(PAF(2),VFR(6),o[1],0,0,0), C1,4); \
    GAPB(o[0]=__builtin_amdgcn_mfma_f32_32x32x16_bf16(PAF(3),VFR(3),o[0],0,0,0), C1,8); \
    GAPB(o[1]=__builtin_amdgcn_mfma_f32_32x32x16_bf16(PAF(3),VFR(7),o[1],0,0,0), C1,12); \
    }while(0)
  int t=1;
  for(;t+5<NT;t+=2){
    STEP(pB0,pB1,pA0,pA1,t,true,true,true);     WAIT_BAR(2); RESC(); ROT();
    STEP(pA0,pA1,pB0,pB1,t+1,true,true,true);   WAIT_BAR(2); RESC(); ROT();
  }
  #define ENDW(tt) do{ if((tt)+3<NT){WAIT_BAR(2);} else if((tt)+2<NT){WAIT_BAR(1);} else {WAIT_BAR(0);} }while(0)
  for(;t+1<NT;t+=2){
    STEP(pB0,pB1,pA0,pA1,t,(t+3<NT),(t+1<NT),(t+1<NT));       ENDW(t);   RESC(); ROT();
    STEP(pA0,pA1,pB0,pB1,t+1,(t+4<NT),(t+2<NT),(t+2<NT));     ENDW(t+1); RESC(); ROT();
  }
  STEP(pB0,pB1,pA0,pA1,NT-1,false,false,false); RESC();
  { float sacc=pB0[0]+pB0[1]; _Pragma("unroll") for(int r=2;r<16;++r)sacc+=pB0[r]; _Pragma("unroll") for(int r=0;r<16;++r)sacc+=pB1[r]; l_reg+=sacc;
    pw0=(u32x4){PKW(pB0,0),PKW(pB0,2),PKW(pB0,4),PKW(pB0,6)};pw1=(u32x4){PKW(pB0,8),PKW(pB0,10),PKW(pB0,12),PKW(pB0,14)};pw2=(u32x4){PKW(pB1,0),PKW(pB1,2),PKW(pB1,4),PKW(pB1,6)};pw3=(u32x4){PKW(pB1,8),PKW(pB1,10),PKW(pB1,12),PKW(pB1,14)};
    SBAR(); pv(o,vb0+sl_cur,PAF(0),PAF(1),PAF(2),PAF(3)); }
  #undef PKW
  #undef PAF
  #undef VFR
  #undef PIN
  #undef MX3
  #undef GAPA
  #undef GAPB
  #undef EX
  #undef VRD
  #undef KRD
  #undef STEP
  #undef ENDW
  {auto rr=__builtin_amdgcn_permlane32_swap(__float_as_uint(l_reg),__float_as_uint(l_reg),false,false);l_reg=__uint_as_float(rr[0])+__uint_as_float(rr[1]);}
  if(hi==0)wsf[32+r32]=l_reg;asm volatile("s_waitcnt lgkmcnt(0)":::"memory");
  float rli[16];
  #pragma unroll
  for(int r=0;r<16;++r)rli[r]=__builtin_amdgcn_rcpf(wsf[32+crow(r,hi)]);
#if ATT_FP8
  { unsigned char*Ow8=(unsigned char*)O+(qrow0+wid*QBLK)*QP+h*D;
    unsigned char*stg8=(unsigned char*)(shm+LDS_OST)+wid*4096;
    #pragma unroll
    for(int r=0;r<16;++r){const int orow=crow(r,hi);
      #pragma unroll
      for(int d0=0;d0<2;++d0){const float x=o[d0][r]*rli[r]*(float)(1<<ATT_OSH); stg8[orow*64+d0*32+r32]=(unsigned char)(__builtin_amdgcn_cvt_pk_fp8_f32(x,x,0u,false)&0xffu);}}
    asm volatile("s_waitcnt lgkmcnt(0)":::"memory");
    #pragma unroll
    for(int i=0;i<2;++i){const int row=i*16+(lane>>2),ch=lane&3; const u32x4 v=*(const u32x4*)(stg8+row*64+ch*16); ATTN_STORE16(Ow8+(long)row*QP+ch*16,v);} }
#else
  bf16*Ow=O+(qrow0+wid*QBLK)*QP+h*D;
  { bf16*stg=(bf16*)(shm+LDS_OST)+wid*2048;
    #pragma unroll
    for(int r=0;r<16;++r){const int orow=crow(r,hi);
      #pragma unroll
      for(int d0=0;d0<2;++d0)stg[orow*64+d0*32+r32]=__float2bfloat16(o[d0][r]*rli[r]);}
    asm volatile("s_waitcnt lgkmcnt(0)":::"memory");
    #pragma unroll
    for(int i=0;i<4;++i){const int row=i*8+(lane>>3),ch=lane&7; const u32x4 v=*(const u32x4*)(stg+row*64+ch*8); ATTN_STORE16(Ow+(long)row*QP+ch*8,v);} }
#endif
  asm volatile("s_waitcnt lgkmcnt(0)\n\ts_barrier":::"memory");
  #undef DMA_K
  #undef DMA_V
  #undef CMASK
  #undef START
  #undef RESC
  #undef ROT
}
constexpr int ATTN_LDS_BYTES=LDS_BYTES;
#undef SBAR
#undef WAIT_BAR
}

typedef f32x4 AccT[2][2][4][2];
__device__ __forceinline__ long kv_row(int r) { return r < TL ? (long)(r / SEQ) * KVROWS + CTXL + (r % SEQ) : (long)((r - TL) / CTXL) * KVROWS + ((r - TL) % CTXL); }

struct SchedDense {
    static constexpr bool IMM_DONE = false; static constexpr bool KSCALE = false;
    const char* A; const char* B; size_t astep, bstep, acol; int nM, nN, G, c;
    __device__ __forceinline__ bool next(int i, pg8::Unit& u) const {
        const int L = i * G + c; if (L >= nM * nN) return false;
        pg8::tile_of(L, nM, nN, u.pm, u.pn); u.A = A + (size_t)u.pm * astep + (size_t)u.pn * acol; u.B = B + (size_t)u.pn * bstep; u.x0 = 0; u.x1 = 0; return true; }
    __device__ __forceinline__ int gather(const pg8::Unit&, int) const { return 0; }
    __device__ __forceinline__ void a_ready(const pg8::Unit&, int) const {}
    __device__ __forceinline__ void done(const pg8::Unit&, int) const {}
};
struct SchedDenseR {
    static constexpr bool IMM_DONE = true; static constexpr bool KSCALE = false;
    const char* A; const char* B; size_t astep, bstep, acol; int nM, nN, nF, G, c; unsigned* ready;
    __device__ __forceinline__ bool next(int i, pg8::Unit& u) const {
        const int L = i * G + c, n1 = nF * nN; if (L >= nM * nN) return false;
        if (L < n1) pg8::tile_of(L, nF, nN, u.pm, u.pn); else { u.pm = nF + (L - n1) / nN; u.pn = (L - n1) % nN; }
        u.A = A + (size_t)u.pm * astep + (size_t)u.pn * acol; u.B = B + (size_t)u.pn * bstep; u.x0 = 0; u.x1 = 0; return true; }
    __device__ __forceinline__ int gather(const pg8::Unit&, int) const { return 0; }
    __device__ __forceinline__ void a_ready(const pg8::Unit&, int) const {}
    __device__ __forceinline__ void done(const pg8::Unit& u, int lane) const { if (lane == 0) __hip_atomic_fetch_add(ready + u.pm, 1u, __ATOMIC_RELAXED, __HIP_MEMORY_SCOPE_AGENT); }
};
struct SchedOutproj {
    static constexpr bool IMM_DONE = true; static constexpr bool KSCALE = true;
    const char* A; const char* B; size_t astep, bstep; int G, c; const unsigned* rdg; unsigned* ready; const float* rstd;
    __device__ __forceinline__ void kscale(AccT& acc, const pg8::Unit& u, int g, int wr) const {
        int ln; asm volatile("v_mbcnt_lo_u32_b32 %0, -1, 0\n\tv_mbcnt_hi_u32_b32 %0, -1, %0" : "=v"(ln)); const int fr = ln & 15;
#pragma unroll
        for (int ai = 0; ai < 2; ++ai)
#pragma unroll
            for (int m = 0; m < 4; ++m) { const float* rp = rstd + (size_t)(u.pm * 256 + ai * 128 + wr * 64 + m * 16 + fr) * 4 + g; const float ratio = rp[-1] * __builtin_amdgcn_rcpf(rp[0]);
#pragma unroll
                for (int bj = 0; bj < 2; ++bj)
#pragma unroll
                    for (int nn = 0; nn < 2; ++nn) acc[ai][bj][m][nn] = acc[ai][bj][m][nn] * ratio; }
    }
    __device__ __forceinline__ bool next(int i, pg8::Unit& u) const {
        int n;
        if (G == 256) { if (c >= 32) { if (i == 0) n = c - 32; else if (i == 1 && c < 64) n = 224 + (c - 32); else return false; } else { if (i == 0 && c < 16) n = 256 + c; else return false; } }
        else { n = i * G + c; if (n >= 272) return false; }
        u.pm = n >> 2; u.pn = n & 3; u.A = A + (size_t)u.pm * astep; u.B = B + (size_t)u.pn * bstep; u.x0 = 0; u.x1 = 0; return true; }
    __device__ __forceinline__ int gather(const pg8::Unit&, int) const { return 0; }
    __device__ __forceinline__ void a_ready(const pg8::Unit& u, int wid) const {
        if (wid == 0) { unsigned sp = 0;
            while ((unsigned)__builtin_amdgcn_readfirstlane(__hip_atomic_load(rdg + u.pm, __ATOMIC_RELAXED, __HIP_MEMORY_SCOPE_AGENT)) < 8u) { __builtin_amdgcn_s_sleep(2); if (++sp > (1u << 22)) break; }
            __builtin_amdgcn_fence(__ATOMIC_ACQUIRE, "agent"); asm volatile("s_waitcnt vmcnt(0)" ::: "memory"); }
        __builtin_amdgcn_s_barrier(); asm volatile("" ::: "memory");
    }
    __device__ __forceinline__ void done(const pg8::Unit& u, int lane) const { if (lane == 0) __hip_atomic_fetch_add(ready + u.pm, 1u, __ATOMIC_RELAXED, __HIP_MEMORY_SCOPE_AGENT); }
};
struct SchedQKV {
    static constexpr bool IMM_DONE = false; static constexpr bool KSCALE = false;
    const char* A; const char* B; size_t tstep; int ctxq, G, c;
    __device__ __forceinline__ bool next(int i, pg8::Unit& u) const {
        const int L = i * G + c, n1 = 64 * 6, n2 = ctxq ? 24 : 8; if (L >= n1 + n2) return false;
        if (L < n1) pg8::tile_of(L, 64, 6, u.pm, u.pn);
        else if (ctxq) { pg8::tile_of(L - n1, 4, 6, u.pm, u.pn); u.pm += 64; }
        else { u.pm = 64 + ((L - n1) >> 1); u.pn = 4 + ((L - n1) & 1); }
        u.A = A + (size_t)u.pm * tstep; u.B = B + (size_t)u.pn * tstep; u.x0 = 0; u.x1 = 0; return true; }
    __device__ __forceinline__ int gather(const pg8::Unit&, int) const { return 0; }
    __device__ __forceinline__ void a_ready(const pg8::Unit&, int) const {}
    __device__ __forceinline__ void done(const pg8::Unit&, int) const {}
};
struct SchedMoe {
    static constexpr bool IMM_DONE = false; static constexpr bool KSCALE = false;
    const char* Abase; size_t astep; const char* Bbase; size_t bstep_e, bstep_n; const LAS int* tab; const int* list; int G, c;
    unsigned* ready; int mode;
    __device__ __forceinline__ int T(int i) const { return __builtin_amdgcn_readfirstlane(tab[i]); }
    __device__ __forceinline__ bool next(int i, pg8::Unit& u) const {
        const int ntiles = T(32); int gt, pn;
        if (G == 256) {
            const int x = c & 7, j = c >> 3, g = (mode == 2 ? 7 - x : x) + 8 * i, fm = 8 * g; if (fm >= ntiles) return false;
            const int gsz = (ntiles - fm) < 8 ? (ntiles - fm) : 8; if (j >= 4 * gsz) return false;
            gt = fm + j % gsz; pn = j / gsz; }
        else { const int L = i * G + (mode == 2 ? G - 1 - c : c); if (L >= ntiles * 4) return false; pg8::tile_of(L, ntiles, 4, gt, pn); }
        int e = 0;
        for (int q = 1; q < 32; ++q) e += (T(q) <= gt) ? 1 : 0;
        const int ti = gt - T(e); int valid = T(40 + e) - ti * 256; valid = valid > 256 ? 256 : valid;
        u.pm = gt; u.pn = pn; u.x0 = e * MOE_CAP + ti * 256; u.x1 = valid;
        u.A = Abase + (size_t)gt * astep; u.B = Bbase + (size_t)e * bstep_e + (size_t)pn * bstep_n; return true; }
    __device__ __forceinline__ int gather(const pg8::Unit& u, int lr) const { return lr < u.x1 ? (list[u.x0 + lr] >> 1) : 0; }
    __device__ __forceinline__ void a_ready(const pg8::Unit& u, int wid) const {
        if (mode != 2) return;
        if (wid == 0) { unsigned sp = 0;
            while ((unsigned)__builtin_amdgcn_readfirstlane(__hip_atomic_load(ready + u.pm, __ATOMIC_RELAXED, __HIP_MEMORY_SCOPE_AGENT)) < 32u) { __builtin_amdgcn_s_sleep(2); if (++sp > (1u << 22)) break; }
            __builtin_amdgcn_fence(__ATOMIC_ACQUIRE, "agent"); asm volatile("s_waitcnt vmcnt(0)" ::: "memory"); }
        __builtin_amdgcn_s_barrier(); asm volatile("" ::: "memory");
    }
    __device__ __forceinline__ void done(const pg8::Unit& u, int lane) const {
        if (mode != 1) return;
        if (lane == 0) __hip_atomic_fetch_add(ready + u.pm, 1u, __ATOMIC_RELAXED, __HIP_MEMORY_SCOPE_AGENT);
    }
};

struct EpiQKV { static constexpr bool PERM = true; bf16* Q; bf16* Kb; bf16* Vb; const float* qg; const float* kg; const f32x2* tab;
    __device__ __forceinline__ void operator()(const AccT& acc, const pg8::Unit& u, int wr, int wc, int fr, int fq) const {
        bf16* base; int pitch; long row0;
        if (u.pn < 4) { base = Q + u.pn * 256; pitch = 1024; row0 = (long)u.pm * 256; }
        else { base = (u.pn == 4) ? Kb : Vb; pitch = 256; row0 = kv_row(u.pm * 256); }
        const bool isv = u.pn == 5, lat = u.pm < 64; const float* g = u.pn < 4 ? qg : kg; const float post = u.pn < 4 ? 0.125f * 1.4426950408889634f : 1.0f;
#pragma unroll
        for (int ai = 0; ai < 2; ++ai)
#pragma unroll
            for (int m = 0; m < 4; ++m) { int fq_ = fq; asm volatile("" : "+v"(fq_));
                const int fq = fq_; const int lr = ai * 128 + wr * 64 + m * 16 + fr; const unsigned roff = (unsigned)(((int)row0 + lr) * pitch + wc * 64 + 8 * fq) * 2u;
                f32x4 g0[2], g1[2];
#pragma unroll
                for (int bj = 0; bj < 2; ++bj) { g0[bj] = *(const f32x4*)(g + 32 * bj + 8 * fq); g1[bj] = *(const f32x4*)(g + 32 * bj + 8 * fq + 4); }
                f32x4 v[2][2];
#pragma unroll
                for (int bj = 0; bj < 2; ++bj) { v[bj][0] = acc[ai][bj][m][0]; v[bj][1] = acc[ai][bj][m][1]; }
                if (!isv) {
                    float ss = 0.f;
#pragma unroll
                    for (int bj = 0; bj < 2; ++bj)
#pragma unroll
                        for (int n = 0; n < 2; ++n) ss += (v[bj][n][0] * v[bj][n][0] + v[bj][n][1] * v[bj][n][1]) + (v[bj][n][2] * v[bj][n][2] + v[bj][n][3] * v[bj][n][3]);
                    ss += __shfl_xor(ss, 16); ss += __shfl_xor(ss, 32);
                    const float rstd = rsqrtf(ss * (1.0f / 64.0f) + EPS);
#pragma unroll
                    for (int bj = 0; bj < 2; ++bj) { v[bj][0] = v[bj][0] * rstd * g0[bj]; v[bj][1] = v[bj][1] * rstd * g1[bj]; }
                    if (lat) { const int t = (u.pm * 256 + lr) & (SEQ - 1);
#pragma unroll
                        for (int bj = 0; bj < 2; ++bj) { const f32x2* tb = (const f32x2*)((const char*)tab + (unsigned)(((bj == 0 ? (t >> 6) : (t & 63)) * 16 + 4 * fq) * 8));
#pragma unroll
                            for (int n = 0; n < 2; ++n)
#pragma unroll
                                for (int e = 0; e < 2; ++e) { const f32x2 cs = tb[2 * n + e]; const float x0 = v[bj][n][2 * e], x1 = v[bj][n][2 * e + 1];
                                    v[bj][n][2 * e] = x0 * cs.x - x1 * cs.y; v[bj][n][2 * e + 1] = x0 * cs.y + x1 * cs.x; } } }
#pragma unroll
                    for (int bj = 0; bj < 2; ++bj) { v[bj][0] = v[bj][0] * post; v[bj][1] = v[bj][1] * post; }
                }
#pragma unroll
                for (int bj = 0; bj < 2; ++bj)
                    *(u32x4*)((char*)base + roff + bj * 64) = (u32x4){cvtpk(v[bj][0][0], v[bj][0][1]), cvtpk(v[bj][0][2], v[bj][0][3]), cvtpk(v[bj][1][0], v[bj][1][1]), cvtpk(v[bj][1][2], v[bj][1][3])}; }
    }
};
template <bool PERM_> struct EpiResidT { static constexpr bool PERM = PERM_; const Args* a; int layer; const float* pscale; const bf16* srcbase; const float* rowsc;
    __device__ __forceinline__ void operator()(const AccT& acc, const pg8::Unit& u, int wr, int wc, int, int) const {
        int ln; asm volatile("v_mbcnt_lo_u32_b32 %0, -1, 0\n\tv_mbcnt_hi_u32_b32 %0, -1, %0" : "=v"(ln)); const int fr = ln & 15, fq = ln >> 4;
        const int r0 = u.pm * 256;
        const float* gate = mod_row(*a, layer, r0) + 2 * D;
        const bool f32src = (layer == 0) && !srcbase; const float* src32 = resid_row(*a, 0, r0); const bf16* src16 = (srcbase ? srcbase : (const bf16*)(a->ws + WS_X)) + (size_t)r0 * D;
        const __amdgpu_buffer_rsrc_t rs = __builtin_amdgcn_make_buffer_rsrc((void*)(a->ws + WS_X), 0, TT * D * 2, 0x00020000);
        if constexpr (PERM_) {
#pragma unroll
        for (int bj = 0; bj < 2; ++bj) { const int cc = u.pn * 256 + bj * 128 + wc * 32 + 8 * fq;
            f32x4 g0 = *(const f32x4*)(gate + cc), g1 = *(const f32x4*)(gate + cc + 4); if (pscale) { g0 = g0 * *(const f32x4*)(pscale + cc); g1 = g1 * *(const f32x4*)(pscale + cc + 4); }
#pragma unroll
            for (int ai = 0; ai < 2; ++ai)
#pragma unroll
                for (int m = 0; m < 4; ++m) { const int off = (ai * 128 + wr * 64 + m * 16 + fr) * D + cc;
                    f32x4 s0, s1;
                    if (f32src) { s0 = *(const f32x4*)(src32 + off); s1 = *(const f32x4*)(src32 + off + 4); }
                    else { const u32x4 p = *(const u32x4*)(src16 + off); s0 = (f32x4){bflo(p.x), bfhi(p.x), bflo(p.y), bfhi(p.y)}; s1 = (f32x4){bflo(p.z), bfhi(p.z), bflo(p.w), bfhi(p.w)}; }
                    const float rsc = rowsc ? rowsc[(size_t)(r0 + ai * 128 + wr * 64 + m * 16 + fr) * 4 + 3] : 1.0f;
                    const f32x4 o0 = s0 + (g0 * rsc) * acc[ai][bj][m][0], o1 = s1 + (g1 * rsc) * acc[ai][bj][m][1];
                    __builtin_amdgcn_raw_buffer_store_b128((u32x4){cvtpk(o0.x, o0.y), cvtpk(o0.z, o0.w), cvtpk(o1.x, o1.y), cvtpk(o1.z, o1.w)}, rs, (r0 * D + off) * 2, 0, 16  ); }
            asm volatile("" ::: "memory"); }
        } else {
#pragma unroll
        for (int bj = 0; bj < 2; ++bj)
#pragma unroll
            for (int n = 0; n < 2; ++n) { const int cc = u.pn * 256 + bj * 128 + wc * 32 + n * 16 + 4 * fq; f32x4 g = *(const f32x4*)(gate + cc); if (pscale) g = g * *(const f32x4*)(pscale + cc);
#pragma unroll
                for (int ai = 0; ai < 2; ++ai)
#pragma unroll
                    for (int m = 0; m < 4; ++m) { const int off = (ai * 128 + wr * 64 + m * 16 + fr) * D + cc;
                        f32x4 s0;
                        if (f32src) s0 = *(const f32x4*)(src32 + off);
                        else { const u32x2 p = *(const u32x2*)(src16 + off); s0 = (f32x4){bflo(p.x), bfhi(p.x), bflo(p.y), bfhi(p.y)}; }
                        const f32x4 o0 = s0 + g * acc[ai][bj][m][n];
                        __builtin_amdgcn_raw_buffer_store_b64((u32x2){cvtpk(o0.x, o0.y), cvtpk(o0.z, o0.w)}, rs, (r0 * D + off) * 2, 0, 16  ); }
                asm volatile("" ::: "memory"); }
        }
    }
};
typedef EpiResidT<true> EpiResid; typedef EpiResidT<false> EpiResidN;
struct EpiGateUp { static constexpr bool PERM = true; bf16* act;
    __device__ __forceinline__ void operator()(const AccT& acc, const pg8::Unit& u, int wr, int wc, int fr, int fq) const {
        const __amdgpu_buffer_rsrc_t rs = __builtin_amdgcn_make_buffer_rsrc((void*)act, 0, 43008 * 512 * 2, 0x00020000);
#pragma unroll
        for (int ai = 0; ai < 2; ++ai)
#pragma unroll
            for (int m = 0; m < 4; ++m) { const int off = (int)((((size_t)u.pm * 256 + ai * 128 + wr * 64 + m * 16 + fr) * 512 + u.pn * 128 + wc * 32 + 8 * fq) * 2);
                const f32x4 g0 = acc[ai][0][m][0], g1 = acc[ai][0][m][1], u0 = acc[ai][1][m][0], u1 = acc[ai][1][m][1];
                const u32x4 ov = (u32x4){cvtpk(silu_f(g0[0]) * u0[0], silu_f(g0[1]) * u0[1]), cvtpk(silu_f(g0[2]) * u0[2], silu_f(g0[3]) * u0[3]),
                                     cvtpk(silu_f(g1[0]) * u1[0], silu_f(g1[1]) * u1[1]), cvtpk(silu_f(g1[2]) * u1[2], silu_f(g1[3]) * u1[3])};
#if MOE_FP8
                { const float sa = (float)(1 << MOE_ASH); const u32x2 o8 = (u32x2){pk_fp8x4(silu_f(g0[0]) * u0[0] * sa, silu_f(g0[1]) * u0[1] * sa, silu_f(g0[2]) * u0[2] * sa, silu_f(g0[3]) * u0[3] * sa),
                                                                                    pk_fp8x4(silu_f(g1[0]) * u1[0] * sa, silu_f(g1[1]) * u1[1] * sa, silu_f(g1[2]) * u1[2] * sa, silu_f(g1[3]) * u1[3] * sa)};
                  (void)ov; __builtin_amdgcn_raw_buffer_store_b64(o8, rs, off >> 1, 0, 16  ); } }
#else
                __builtin_amdgcn_raw_buffer_store_b128(ov, rs, off, 0, 16  ); }
#endif
    }
};
struct EpiDown { static constexpr bool PERM = true; const int* list; const float* w2; bf16* y2;
    __device__ __forceinline__ void operator()(const AccT& acc, const pg8::Unit& u, int wr, int wc, int fr, int fq) const {
#pragma unroll
        for (int ai = 0; ai < 2; ++ai)
#pragma unroll
            for (int m = 0; m < 4; ++m) { const int lr = ai * 128 + wr * 64 + m * 16 + fr;
                if (lr < u.x1) { const int dest = list[u.x0 + lr]; const float w = w2[dest]; bf16* p = y2 + (size_t)dest * D + u.pn * 256 + wc * 32 + 8 * fq;
#pragma unroll
                    for (int bj = 0; bj < 2; ++bj) { const f32x4 v0 = acc[ai][bj][m][0] * w, v1 = acc[ai][bj][m][1] * w;
                        *(u32x4*)(p + bj * 128) = (u32x4){cvtpk(v0[0], v0[1]), cvtpk(v0[2], v0[3]), cvtpk(v1[0], v1[1]), cvtpk(v1[2], v1[3])}; } } }
    }
};

constexpr int TAB_OFF = 135168;

__device__ __forceinline__ void ph_rope(const Args& a, const Ctx& c, int layer) {
    const int j = layer == 0 ? 0 : 1; const bool ctxq = layer == 0;
    const float* qg = a.in[I_QG] + j * 64; const float* kg = a.in[I_KG] + j * 64;
    const f32x2* tab = (const f32x2*)(a.ws + WS_ROPE);
    bf16* Qb = (bf16*)(a.ws + WS_Q); bf16* Kb = (bf16*)(a.ws + WS_K);
    const int nitems = TT * 20;
    for (int it = blockIdx.x * NTHREADS + c.tid; it < nitems; it += c.G * NTHREADS) {
        const int r = it / 20, hs = it % 20;
        if (hs < 16 && r >= TL && !ctxq) continue;
        bf16* p; const float* g; float post;
        if (hs < 16) { p = Qb + (size_t)r * 1024 + hs * 64; g = qg; post = 0.125f * 1.4426950408889634f; } else { p = Kb + kv_row(r) * 256 + (hs - 16) * 64; g = kg; post = 1.0f; }
        float x[64]; float ss = 0.f;
#pragma unroll
        for (int i = 0; i < 8; ++i) { const u32x4 w = ((const u32x4*)p)[i];
            x[8 * i + 0] = bflo(w.x); x[8 * i + 1] = bfhi(w.x); x[8 * i + 2] = bflo(w.y); x[8 * i + 3] = bfhi(w.y);
            x[8 * i + 4] = bflo(w.z); x[8 * i + 5] = bfhi(w.z); x[8 * i + 6] = bflo(w.w); x[8 * i + 7] = bfhi(w.w); }
#pragma unroll
        for (int i = 0; i < 64; ++i) ss += x[i] * x[i];
        const float rstd = rsqrtf(ss * (1.0f / 64.0f) + EPS);
#pragma unroll
        for (int i = 0; i < 64; ++i) x[i] = x[i] * rstd * g[i];
        if (r < TL) { const int t = r % SEQ, rp = t >> 6, cp = t & 63;
#pragma unroll
            for (int i = 0; i < 32; ++i) { const f32x2 cs = tab[(i < 16 ? rp : cp) * 16 + (i & 15)]; const float x0 = x[2 * i], x1 = x[2 * i + 1];
                x[2 * i] = x0 * cs.x - x1 * cs.y; x[2 * i + 1] = x0 * cs.y + x1 * cs.x; } }
#pragma unroll
        for (int i = 0; i < 8; ++i) ((u32x4*)p)[i] = (u32x4){cvtpk(x[8 * i] * post, x[8 * i + 1] * post), cvtpk(x[8 * i + 2] * post, x[8 * i + 3] * post),
                                                            cvtpk(x[8 * i + 4] * post, x[8 * i + 5] * post), cvtpk(x[8 * i + 6] * post, x[8 * i + 7] * post)};
    }
}

__device__ __forceinline__ void ph_att(const Args& a, const Ctx& c, int layer, char* lds_generic) {
    const int nun = 1024 + (layer == 0 ? 64 : 0);
    const attn_body::bf16* Qb = (const attn_body::bf16*)(a.ws + WS_Q); const attn_body::bf16* Kb = (const attn_body::bf16*)(a.ws + WS_K); const attn_body::bf16* Vb = (const attn_body::bf16*)(a.ws + WS_V);
    for (int U = c.vcu; U < nun; U += c.G) {
        long qrow0, kv0; int h, NT;
        if (U < 1024) { const int bh = U >> 4, qb = U & 15, b = bh >> 4; h = bh & 15; qrow0 = (long)b * SEQ + qb * 256; kv0 = (long)b * KVROWS; NT = KVROWS / 64; }
        else { const int q = U - 1024, b = q >> 4; h = q & 15; qrow0 = (long)TL + b * CTXL; kv0 = (long)b * KVROWS; NT = CTXL / 64; }
        attn_body::attn_unit<8>(qrow0, h, kv0, NT, Qb, Kb, Vb, (attn_body::bf16*)(a.ws + WS_HB), lds_generic);
    }
}

__device__ __forceinline__ void ph_m1(const Args& a, const Ctx& c, int layer, const unsigned* rdy, int nN, int amode) {
    const int Tm = layer == 3 ? TL : TT, ntiles = Tm / 32;
    int tl0, tl1, tl2;
    { int bid = (int)blockIdx.x; asm volatile("" : "+s"(bid));
      if (amode == 1 && c.G == 256 && ntiles == 544) {
          int k = c.vcu - 64; asm volatile("" : "+s"(k));
          if (k < 0) { tl0 = -1; tl1 = -1; tl2 = -1; } else { tl0 = k; tl1 = k + 192; tl2 = k < 64 ? k + 384 : (k < 160 ? 448 + (k - 64) : -1); } }
      else if (c.G == 256 && ntiles == 544) { if (bid < 16) { tl0 = 512 + bid; tl1 = -1; tl2 = -1; } else { const int j = bid - 16; tl0 = j; tl1 = j + 240; tl2 = j < 32 ? j + 480 : (j < 48 ? 528 + (j - 32) : -1); } }
      else { tl0 = bid < ntiles ? bid : -1; tl1 = bid + c.G < ntiles ? bid + c.G : -1; tl2 = bid + 2 * c.G < ntiles ? bid + 2 * c.G : -1; } }
    const unsigned need = 8u * (unsigned)nN;
#define M1_WAIT(tl) do { if (c.wave == 0) { unsigned sp_ = 0; \
        while ((unsigned)__builtin_amdgcn_readfirstlane(__hip_atomic_load(rdy + ((tl) >> 3), __ATOMIC_RELAXED, __HIP_MEMORY_SCOPE_AGENT)) < need) { __builtin_amdgcn_s_sleep(2); if (++sp_ > (1u << 22)) break; } \
        __builtin_amdgcn_fence(__ATOMIC_ACQUIRE, "agent"); asm volatile("s_waitcnt vmcnt(0)" ::: "memory"); } \
        __syncthreads(); } while (0)
    const float* g = a.in[I_NFFN] + layer * D;
    constexpr int RP = 2064;
    LAS unsigned char* hiT = c.lds; LAS unsigned char* loT = c.lds + 32 * RP;
    LAS float* part = (LAS float*)c.lds;
    LAS int* lcnt = (LAS int*)(c.lds + 133120); LAS int* lbase = lcnt + 32;
    LAS float* logit = (LAS float*)(c.lds + 134144);
    const bf16* wr = (const bf16*)(a.ws + WS_WR) + (size_t)layer * 2 * 65536;
    unsigned* gcnt = (unsigned*)(a.ws + WS_CTL) + CW_CNT + layer * 32;
    int* list = (int*)(a.ws + WS_LIST); float* w2 = (float*)(a.ws + WS_W2);
    const int r32 = c.lane & 31, hi = c.lane >> 5;
    if (c.tid < 32) lcnt[c.tid] = 0;
    u32x2 vr[4][4];
#define M1_LOADROWS(tl) do { _Pragma("unroll") for (int i = 0; i < 4; ++i) { const u32x2* xr = (const u32x2*)((const bf16*)(a.ws + WS_X) + (size_t)((tl) * 32 + 4 * c.wave + i) * D) + c.lane; \
        _Pragma("unroll") for (int j = 0; j < 4; ++j) vr[i][j] = xr[64 * j]; } } while (0)
    if (tl0 >= 0) { M1_WAIT(tl0); M1_LOADROWS(tl0); }
    int nmine = 0;
    for (; nmine < 3; ++nmine) { const int tile = nmine == 0 ? tl0 : nmine == 1 ? tl1 : tl2, tnext = nmine == 0 ? tl1 : nmine == 1 ? tl2 : -1;
        if (tile < 0) break;
        const int r0 = tile * 32;
        { f32x4 gs[4], sh[4];
          { const float* m = mod_row(a, layer, r0);
#pragma unroll
            for (int j = 0; j < 4; ++j) { gs[j] = ((const f32x4*)g)[c.lane + 64 * j] * (((const f32x4*)(m + 4 * D))[c.lane + 64 * j] + 1.0f); sh[j] = ((const f32x4*)(m + 3 * D))[c.lane + 64 * j]; } }
#pragma unroll
          for (int i = 0; i < 4; ++i) { const int lr = 4 * c.wave + i, r = r0 + lr;
            f32x4 h[4], vv[4];
#pragma unroll
            for (int j = 0; j < 4; ++j) { const u32x2 p = vr[i][j]; vv[j] = (f32x4){bflo(p.x), bfhi(p.x), bflo(p.y), bfhi(p.y)}; }
            const float rstd = row_rstd(vv);
#pragma unroll
            for (int j = 0; j < 4; ++j) h[j] = (vv[j] * rstd) * gs[j] + sh[j];
#if MOE_FP8
            unsigned* to8 = (unsigned*)((unsigned char*)(a.ws + WS_TK) + (size_t)r * D) + c.lane;
#else
            u32x2* to = (u32x2*)((bf16*)(a.ws + WS_TK) + (size_t)r * D) + c.lane;
#endif
#pragma unroll
            for (int j = 0; j < 4; ++j) { const unsigned h0 = cvtpk(h[j].x, h[j].y), h1 = cvtpk(h[j].z, h[j].w);
                const unsigned l0 = cvtpk(h[j].x - bflo(h0), h[j].y - bfhi(h0)), l1 = cvtpk(h[j].z - bflo(h1), h[j].w - bfhi(h1));
#if MOE_FP8
                to8[64 * j] = pk_fp8x4(h[j].x, h[j].y, h[j].z, h[j].w);
#else
                to[64 * j] = (u32x2){h0, h1};
#endif
                *(LAS u32x2*)(hiT + lr * RP + (4 * c.lane + 256 * j) * 2) = (u32x2){h0, h1};
                *(LAS u32x2*)(loT + lr * RP + (4 * c.lane + 256 * j) * 2) = (u32x2){l0, l1}; } } }
        __syncthreads();
        f32x16 acc0 = {}, acc1 = {};
#pragma unroll
        for (int kk = 0; kk < 8; ++kk) { const int k0 = 128 * c.wave + 16 * kk + 8 * hi;
            const bf16x8 ahi = *(const LAS bf16x8*)(hiT + r32 * RP + k0 * 2), alo = *(const LAS bf16x8*)(loT + r32 * RP + k0 * 2);
            const bf16* wf = wr + (c.wave * 8 + kk) * 2048 + c.lane * 8;
            const bf16x8 b0h = *(const bf16x8*)wf, b1h = *(const bf16x8*)(wf + 512), b0l = *(const bf16x8*)(wf + 1024), b1l = *(const bf16x8*)(wf + 1536);
            acc0 = __builtin_amdgcn_mfma_f32_32x32x16_bf16(ahi, b0h, acc0, 0, 0, 0); acc1 = __builtin_amdgcn_mfma_f32_32x32x16_bf16(ahi, b1h, acc1, 0, 0, 0);
            acc0 = __builtin_amdgcn_mfma_f32_32x32x16_bf16(alo, b0h, acc0, 0, 0, 0); acc1 = __builtin_amdgcn_mfma_f32_32x32x16_bf16(alo, b1h, acc1, 0, 0, 0);
            acc0 = __builtin_amdgcn_mfma_f32_32x32x16_bf16(ahi, b0l, acc0, 0, 0, 0); acc1 = __builtin_amdgcn_mfma_f32_32x32x16_bf16(ahi, b1l, acc1, 0, 0, 0); }
        if (tnext >= 0) { M1_WAIT(tnext); M1_LOADROWS(tnext); }
        else __syncthreads();
#pragma unroll
        for (int reg = 0; reg < 16; ++reg) { part[((c.wave * 2 + 0) * 16 + reg) * 64 + c.lane] = acc0[reg]; part[((c.wave * 2 + 1) * 16 + reg) * 64 + c.lane] = acc1[reg]; }
        __syncthreads();
        if (nmine < 3) {
#pragma unroll
            for (int q = 0; q < 4; ++q) { const int idx = c.tid + 512 * q, nt = idx >> 10, reg = (idx >> 6) & 15, ln = idx & 63; float s = 0.f;
#pragma unroll
                for (int w = 0; w < 8; ++w) s += part[((w * 2 + nt) * 16 + reg) * 64 + ln];
                logit[(nmine * 32 + (reg & 3) + 8 * (reg >> 2) + 4 * (ln >> 5)) * 64 + nt * 32 + (ln & 31)] = s; } }
        __syncthreads();
    }
#undef M1_LOADROWS
#undef M1_WAIT
    int e0 = 0, e1 = 0, p0 = 0, p1 = 0; float w0 = 0.f, w1 = 0.f; const int myt = c.tid >> 5; const bool act_r = c.tid < 96 && myt < nmine;
    if (act_r) { const LAS float* lg = logit + c.tid * 64;
        int grp = 0; float gm = lg[0];
#pragma unroll
        for (int q = 1; q < 4; ++q) if (lg[q] > gm) { gm = lg[q]; grp = q; }
        float den = 0.f;
#pragma unroll
        for (int q = 0; q < 4; ++q) den += expf(lg[q] - gm);
        const float gate = 1.0f / den;
        const LAS float* le = lg + 4 + grp * 8;
        int i0 = 0; float v0 = le[0];
#pragma unroll
        for (int q = 1; q < 8; ++q) if (le[q] > v0) { v0 = le[q]; i0 = q; }
        int i1 = -1; float v1 = -3.0e38f;
#pragma unroll
        for (int q = 0; q < 8; ++q) if (q != i0 && le[q] > v1) { v1 = le[q]; i1 = q; }
        const float ex = expf(v1 - v0); w0 = gate / (1.0f + ex); w1 = gate * ex / (1.0f + ex);
        e0 = grp * 8 + i0; e1 = grp * 8 + i1;
        p0 = __hip_atomic_fetch_add(lcnt + e0, 1, __ATOMIC_RELAXED, __HIP_MEMORY_SCOPE_WORKGROUP);
        p1 = __hip_atomic_fetch_add(lcnt + e1, 1, __ATOMIC_RELAXED, __HIP_MEMORY_SCOPE_WORKGROUP); }
    __syncthreads();
    if (c.tid < 32) { const int n = lcnt[c.tid]; lbase[c.tid] = n ? (int)__hip_atomic_fetch_add(gcnt + c.tid, (unsigned)n, __ATOMIC_RELAXED, __HIP_MEMORY_SCOPE_AGENT) : 0; }
    __syncthreads();
    if (act_r) { const int r = (myt == 0 ? tl0 : myt == 1 ? tl1 : tl2) * 32 + (c.tid & 31);
        list[e0 * MOE_CAP + lbase[e0] + p0] = 2 * r; w2[2 * r] = w0;
        list[e1 * MOE_CAP + lbase[e1] + p1] = 2 * r + 1; w2[2 * r + 1] = w1; }
    __syncthreads();
}
__device__ __forceinline__ void moe_tables(const Args& a, const Ctx& c, int layer, LAS int* tab) {
    unsigned* gcnt = (unsigned*)(a.ws + WS_CTL) + CW_CNT + layer * 32;
    if (c.tid < 32) tab[40 + c.tid] = (int)__hip_atomic_load(gcnt + c.tid, __ATOMIC_RELAXED, __HIP_MEMORY_SCOPE_AGENT);
    __syncthreads();
    if (c.tid == 0) { int s = 0; for (int e = 0; e < 32; ++e) { tab[e] = s; s += (tab[40 + e] + 255) >> 8; } tab[32] = s; }
    __syncthreads();
}

__device__ __forceinline__ void ph_rpool(const Args& a, const Ctx& c, int layer) {
    constexpr int TR = 34, HR = TR + 15;
    LAS unsigned char* hs = c.lds;
    const float* g = a.in[I_NMIX] + layer * D;
    for (int tile = blockIdx.x; tile < TT / TR; tile += c.G) {
        const int r0 = tile * TR;
        for (int lr0 = c.wave; lr0 < HR; lr0 += 2 * NWAVES) {
            const int lrA = lr0, lrB = lr0 + NWAVES; const int grA = r0 - 8 + lrA, grB = r0 - 8 + lrB;
            const bool okA = grA >= 0 && grA < TT, okB = lrB < HR && grB >= 0 && grB < TT;
            const int cA = grA < 0 ? 0 : (grA > TT - 1 ? TT - 1 : grA), cB = grB < 0 ? 0 : (grB > TT - 1 ? TT - 1 : grB);
            f32x4 vA[4], vB[4], h[4]; load_row_combined(a, layer, cA, c.lane, vA); load_row_combined(a, layer, cB, c.lane, vB);
            if (okA) {
                if (lrA >= 8 && lrA < 8 + TR) { u32x2* xo = (u32x2*)((bf16*)(a.ws + WS_Z) + (size_t)grA * D) + c.lane;
#pragma unroll
                    for (int j = 0; j < 4; ++j) xo[64 * j] = (u32x2){cvtpk(vA[j].x, vA[j].y), cvtpk(vA[j].z, vA[j].w)}; }
                const float rstd = row_rstd(vA); const float* m = mod_row(a, layer, grA);
                norm_mod(vA, rstd, g, m, m + D, c.lane, h);
#pragma unroll
                for (int j = 0; j < 4; ++j) *(LAS u32x2*)(hs + lrA * 2048 + (4 * c.lane + 256 * j) * 2) = (u32x2){cvtpk(h[j].x, h[j].y), cvtpk(h[j].z, h[j].w)}; }
            if (okB) {
                if (lrB >= 8 && lrB < 8 + TR) { u32x2* xo = (u32x2*)((bf16*)(a.ws + WS_Z) + (size_t)grB * D) + c.lane;
#pragma unroll
                    for (int j = 0; j < 4; ++j) xo[64 * j] = (u32x2){cvtpk(vB[j].x, vB[j].y), cvtpk(vB[j].z, vB[j].w)}; }
                const float rstd = row_rstd(vB); const float* m = mod_row(a, layer, grB);
                norm_mod(vB, rstd, g, m, m + D, c.lane, h);
#pragma unroll
                for (int j = 0; j < 4; ++j) *(LAS u32x2*)(hs + lrB * 2048 + (4 * c.lane + 256 * j) * 2) = (u32x2){cvtpk(h[j].x, h[j].y), cvtpk(h[j].z, h[j].w)}; } }
        __syncthreads();
        { const int half = 1 << (c.tid >> 7);
          const LAS unsigned* col = (const LAS unsigned*)hs + c.tid;
          float sx = 0.f, sy = 0.f;
          unsigned* ho = (unsigned*)((bf16*)(a.ws + WS_HB) + (size_t)r0 * D) + c.tid;
          for (int t = 0; t < TR; ++t) { const int gr = r0 + t;
              const int s0 = gr < TL ? (gr / SEQ) * SEQ : TL + ((gr - TL) / CTXL) * CTXL, s1 = s0 + (gr < TL ? SEQ : CTXL);
              const int lo = (gr - half) > s0 ? (gr - half) : s0, hi = (gr + half) < s1 ? (gr + half) : s1;
              if (t == 0 || gr == s0) { sx = 0.f; sy = 0.f;
                  for (int w = lo; w < hi; ++w) { const unsigned u = col[(w - r0 + 8) * 512]; sx += bflo(u); sy += bfhi(u); } }
              else { if (gr + half - 1 < s1) { const unsigned w = col[(t + 8 + half - 1) * 512]; sx += bflo(w); sy += bfhi(w); }
                     if (gr - 1 - half >= s0) { const unsigned w = col[(t + 8 - 1 - half) * 512]; sx -= bflo(w); sy -= bfhi(w); } }
              const float inv = __builtin_amdgcn_rcpf((float)(hi - lo)); const unsigned u = col[(t + 8) * 512];
              ho[t * 512] = cvtpk(sx * inv - bflo(u), sy * inv - bfhi(u)); } }
        __syncthreads();
    }
}

struct EpiInproj { static constexpr bool PERM = true; bf16* Z; bf16* XBC; float* DT; const float* dtb;
    __device__ __forceinline__ void operator()(const AccT& acc, const pg8::Unit& u, int wr, int wc, int fr, int fq) const {
        const size_t r0 = (size_t)u.pm * 256;
        if (u.pn < 20) { bf16* base; int pitch; if (u.pn < 8) { base = Z + u.pn * 256; pitch = 2048; } else { base = XBC + (u.pn - 8) * 256; pitch = 3072; }
#pragma unroll
            for (int ai = 0; ai < 2; ++ai)
#pragma unroll
                for (int m = 0; m < 4; ++m) { bf16* rowp = base + (r0 + ai * 128 + wr * 64 + m * 16 + fr) * pitch + wc * 32 + 8 * fq;
#pragma unroll
                    for (int bj = 0; bj < 2; ++bj) { const f32x4 v0 = acc[ai][bj][m][0], v1 = acc[ai][bj][m][1];
                        *(u32x4*)(rowp + bj * 128) = (u32x4){cvtpk(v0[0], v0[1]), cvtpk(v0[2], v0[3]), cvtpk(v1[0], v1[1]), cvtpk(v1[2], v1[3])}; } }
        } else if (wc < 2) { const int col = wc * 32 + 8 * fq; const f32x4 b0 = *(const f32x4*)(dtb + col), b1 = *(const f32x4*)(dtb + col + 4);
#pragma unroll
            for (int ai = 0; ai < 2; ++ai)
#pragma unroll
                for (int m = 0; m < 4; ++m) { float* p = DT + (r0 + ai * 128 + wr * 64 + m * 16 + fr) * 64 + col; f32x4 v0 = acc[ai][0][m][0] + b0, v1 = acc[ai][0][m][1] + b1;
#pragma unroll
                    for (int e = 0; e < 4; ++e) { v0[e] = fmaxf(v0[e], 0.f) + log1pf(__expf(-fabsf(v0[e]))); v1[e] = fmaxf(v1[e], 0.f) + log1pf(__expf(-fabsf(v1[e]))); }
                    *(f32x4*)p = v0; *(f32x4*)(p + 4) = v1; } }
    }
};

__device__ __forceinline__ void ph_conv(const Args& a, const Ctx& c) {
    LAS unsigned char* tin = c.lds; LAS unsigned char* toT = c.lds + 17408; LAS unsigned char* toN = c.lds + 34816;
    const bf16* xbc = (const bf16*)(a.ws + WS_XBC);
    u32x4 pin[3];
#define CONV_PREFETCH(tk) do { const int ci_ = (tk) / 48, chb_ = (tk) % 48, r0_ = ci_ * 128, ch0_ = chb_ * 64; \
        _Pragma("unroll") for (int q = 0; q < 3; ++q) { int p = c.tid + 512 * q; p = p < 131 * 8 ? p : 131 * 8 - 1; const int lr = p >> 3, pc = p & 7; int row = r0_ - 2 + lr; row = row < 0 ? 0 : (row > TT - 1 ? TT - 1 : row); \
            pin[q] = *(const u32x4*)(xbc + (size_t)row * 3072 + ch0_ + pc * 8); } } while (0)
    { const int t0 = (int)blockIdx.x < NCH * 48 ? (int)blockIdx.x : NCH * 48 - 1; CONV_PREFETCH(t0); }
    for (int task = blockIdx.x; task < NCH * 48; task += c.G) {
        const int ci = task / 48, chb = task % 48, r0 = ci * 128, ch0 = chb * 64;
        const bool first = ci < 128 ? (ci % 32 == 0) : (((ci - 128) & 1) == 0), last = ci < 128 ? (ci % 32 == 31) : (((ci - 128) & 1) == 1);
        const int ch = c.tid & 63, tq = c.tid >> 6; const float* cw = a.in[I_CONVW] + ch0 + ch;
        const float w0 = cw[0], w1 = cw[3072], w2 = cw[2 * 3072], w3 = cw[3 * 3072], bias = a.in[I_CONVB][ch0 + ch];
#pragma unroll
        for (int q = 0; q < 3; ++q) { const int p = c.tid + 512 * q, lr = p >> 3; const bool zero = (lr < 2 && first) || (lr == 130 && last);
            if (p < 131 * 8) *(LAS u32x4*)(tin + lr * 128 + (p & 7) * 16) = zero ? (u32x4){0u, 0u, 0u, 0u} : pin[q]; }
        __syncthreads();
        { const int tn = task + c.G < NCH * 48 ? task + c.G : NCH * 48 - 1; CONV_PREFETCH(tn); }
        {
          float xin[19];
#pragma unroll
          for (int i = 0; i < 19; ++i) xin[i] = bf2f(*(const LAS bf16*)(tin + (16 * tq + i) * 128 + ch * 2));
          float o[16];
#pragma unroll
          for (int i = 0; i < 16; ++i) o[i] = silu_f(bias + w0 * xin[i] + w1 * xin[i + 1] + w2 * xin[i + 2] + w3 * xin[i + 3]);
          if (chb < 40) { *(LAS u32x4*)(toT + ch * 272 + tq * 32) = (u32x4){cvtpk(o[0], o[1]), cvtpk(o[2], o[3]), cvtpk(o[4], o[5]), cvtpk(o[6], o[7])};
                          *(LAS u32x4*)(toT + ch * 272 + tq * 32 + 16) = (u32x4){cvtpk(o[8], o[9]), cvtpk(o[10], o[11]), cvtpk(o[12], o[13]), cvtpk(o[14], o[15])}; }
          if (chb >= 32) {
#pragma unroll
              for (int i = 0; i < 16; ++i) *(LAS bf16*)(toN + (16 * tq + i) * 144 + ch * 2) = (bf16)(cvtpk(o[i], 0.f) & 0xffffu); } }
        __syncthreads();
        if (chb < 40) { bf16* dst = chb < 32 ? (bf16*)(a.ws + WS_XT) + ((size_t)ci * 2048 + ch0) * 128 : (bf16*)(a.ws + WS_BT) + ((size_t)ci * 512 + (ch0 - 2048)) * 128;
#pragma unroll
            for (int q = 0; q < 2; ++q) { const int p = c.tid + 512 * q, chl = p >> 4, pc = p & 15; *(u32x4*)(dst + chl * 128 + pc * 8) = *(const LAS u32x4*)(toT + chl * 272 + pc * 16); } }
        if (chb >= 32) { bf16* dst = chb < 40 ? (bf16*)(a.ws + WS_BN) + (size_t)r0 * 512 + (ch0 - 2048) : (bf16*)(a.ws + WS_CN) + (size_t)r0 * 512 + (ch0 - 2560);
#pragma unroll
            for (int q = 0; q < 2; ++q) { const int p = c.tid + 512 * q, t = p >> 3, pc = p & 7; *(u32x4*)(dst + (size_t)t * 512 + pc * 8) = *(const LAS u32x4*)(toN + t * 144 + pc * 16); } }
        __syncthreads();
    }
#undef CONV_PREFETCH
    const int gw = c.vcu * NWAVES + c.wave, NGW = c.G * NWAVES;
    const float* dt = (const float*)(a.ws + WS_DT);
    for (int item = gw; item < NCH * 32; item += NGW) { const int ci = item >> 5, h = item & 31, r0 = ci * 128 + 2 * c.lane;
        const float af = -expf(a.in[I_ALOG][h]), ab = -expf(a.in[I_ALOG][32 + h]);
        const float dtf0 = dt[(size_t)r0 * 64 + h], dtf1 = dt[(size_t)(r0 + 1) * 64 + h], dtb0 = dt[(size_t)r0 * 64 + 32 + h], dtb1 = dt[(size_t)(r0 + 1) * 64 + 32 + h];
        const float laf0 = dtf0 * af, laf1 = dtf1 * af, lab0 = dtb0 * ab, lab1 = dtb1 * ab;
        float inf_ = laf0 + laf1, inb = lab0 + lab1; const float pf = inf_, pbk = inb;
#pragma unroll
        for (int o = 1; o < 64; o <<= 1) { const float t1 = __shfl_up(inf_, o), t2 = __shfl_up(inb, o); if (c.lane >= o) { inf_ += t1; inb += t2; } }
        const float totf = __shfl(inf_, 63), totb = __shfl(inb, 63);
        const float exf = inf_ - pf, exb = inb - pbk;
        const float cf0 = exf + laf0, cf1 = inf_, pb0 = exb, pb1 = exb + lab0;
        f32x4* sca = (f32x4*)(a.ws + WS_SCA) + ((size_t)ci * 32 + h) * 128 + 2 * c.lane; f32x4* scb = (f32x4*)(a.ws + WS_SCB) + ((size_t)ci * 32 + h) * 128 + 2 * c.lane;
        { const float L2E = 1.4426950408889634f;
          sca[0] = (f32x4){cf0 * L2E, pb0 * L2E, cf0 * L2E - __log2f(dtf0), pb0 * L2E + __log2f(dtb0)}; sca[1] = (f32x4){cf1 * L2E, pb1 * L2E, cf1 * L2E - __log2f(dtf1), pb1 * L2E + __log2f(dtb1)}; }
        scb[0] = (f32x4){__expf(cf0), __expf(totb - pb0), dtf0 * __expf(totf - cf0), dtb0 * __expf(pb0)};
        scb[1] = (f32x4){__expf(cf1), __expf(totb - pb1), dtf1 * __expf(totf - cf1), dtb1 * __expf(pb1)};
        { float* wsc = (float*)(a.ws + WS_Q) + ((size_t)(ci * 32 + h) * 2) * 128 + 2 * c.lane;
          *(f32x2*)wsc = (f32x2){dtf0 * __expf(totf - cf0), dtf1 * __expf(totf - cf1)}; *(f32x2*)(wsc + 128) = (f32x2){dtb0 * __expf(pb0), dtb1 * __expf(pb1)}; }
        if (c.lane == 0) ((f32x2*)(a.ws + WS_DEC))[ci * 32 + h] = (f32x2){__expf(totf), __expf(totb)}; }
}

__device__ __forceinline__ void ph_scan(const Args& a, const Ctx& c) {
    constexpr int P = 272, BUF = 53248;
    LAS unsigned char* stg = c.lds + 2 * BUF + c.wave * 2048;
    const int r32 = c.lane & 31, hi = c.lane >> 5, pt = c.wave >> 2, nt = c.wave & 3;
    for (int task = c.vcu; task < 256; task += c.G) { const int b = task >> 6, dir = (task >> 5) & 1, h = task & 31, g = h >> 3;
        f32x16 acc = {};
        u32x4 xrA[2], brA[4], xrB[2], brB[4]; f32x4 wA0 = {}, wA1 = {}, wB0 = {}, wB1 = {}; f32x2 decA = {}, decB = {};
#define SCAN_CI(k) (dir == 0 ? ((k) < 2 ? 128 + 2 * b + (k) : 32 * b + ((k) - 2)) : ((k) < 2 ? 128 + 2 * b + 1 - (k) : 32 * b + 31 - ((k) - 2)))
#define SCAN_LOAD(k, xr, br, w0, w1, dcr) do { const int ci_ = SCAN_CI(k); const bf16* xs_ = (const bf16*)(a.ws + WS_XT) + ((size_t)ci_ * 2048 + 64 * h) * 128; const bf16* bs_ = (const bf16*)(a.ws + WS_BT) + ((size_t)ci_ * 512 + 128 * g) * 128; \
        _Pragma("unroll") for (int q = 0; q < 2; ++q) xr[q] = ((const u32x4*)xs_)[c.tid + 512 * q]; _Pragma("unroll") for (int q = 0; q < 4; ++q) br[q] = ((const u32x4*)bs_)[c.tid + 512 * q]; \
        { const f32x4* wp_ = (const f32x4*)((const float*)(a.ws + WS_Q) + ((size_t)(ci_ * 32 + h) * 2 + dir) * 128) + 2 * (c.tid & 15); w0 = wp_[0]; w1 = wp_[1]; }        \
        dcr = ((const f32x2*)(a.ws + WS_DEC))[ci_ * 32 + h]; } while (0)
#define SCAN_WRITE(bi, xr, br, w0, w1) do { LAS unsigned char* xb_ = c.lds + (bi) * BUF; LAS unsigned char* bb_ = xb_ + 17408;        \
        _Pragma("unroll") for (int q = 0; q < 2; ++q) { const int p = c.tid + 512 * q; const u32x4 v_ = xr[q]; \
            *(LAS u32x4*)(xb_ + (p >> 4) * P + (p & 15) * 16) = (u32x4){cvtpk(bflo(v_.x) * w0.x, bfhi(v_.x) * w0.y), cvtpk(bflo(v_.y) * w0.z, bfhi(v_.y) * w0.w), cvtpk(bflo(v_.z) * w1.x, bfhi(v_.z) * w1.y), cvtpk(bflo(v_.w) * w1.z, bfhi(v_.w) * w1.w)}; } \
        _Pragma("unroll") for (int q = 0; q < 4; ++q) { const int p = c.tid + 512 * q; *(LAS u32x4*)(bb_ + (p >> 4) * P + (p & 15) * 16) = br[q]; } } while (0)
#define SCAN_STEP(k, cur, dcr) do { const int ci = SCAN_CI(k); \
            { bf16* hin = (bf16*)(a.ws + WS_HIN) + (((size_t)ci * 2 + dir) * 32 + h) * 8192; \
              _Pragma("unroll") for (int r = 0; r < 16; ++r) *(LAS bf16*)(stg + ((r & 3) + 8 * (r >> 2) + 4 * hi) * 64 + r32 * 2) = (bf16)(cvtpk(acc[r], 0.f) & 0xffffu); \
              LDS_WAIT(); \
              _Pragma("unroll") for (int i = 0; i < 2; ++i) { const int row = (c.lane >> 2) + 16 * i, pc = c.lane & 3; *(u32x4*)(hin + (size_t)(32 * pt + row) * 128 + 32 * nt + pc * 8) = *(const LAS u32x4*)(stg + row * 64 + pc * 16); } } \
            const float dec = dir == 0 ? dcr.x : dcr.y; \
            _Pragma("unroll") for (int r = 0; r < 16; ++r) acc[r] *= dec; \
            { LAS unsigned char* xb = c.lds + (cur) * BUF; LAS unsigned char* bb = xb + 17408; \
              _Pragma("unroll") for (int kk = 0; kk < 8; ++kk) { const int s8 = 16 * kk + 8 * hi; \
                  const bf16x8 xs = *(const LAS bf16x8*)(xb + (32 * pt + r32) * P + s8 * 2), bfrag = *(const LAS bf16x8*)(bb + (32 * nt + r32) * P + s8 * 2); \
                  acc = __builtin_amdgcn_mfma_f32_32x32x16_bf16(xs, bfrag, acc, 0, 0, 0); } } } while (0)
        f32x2 dcur0, dcur1;
        SCAN_LOAD(0, xrA, brA, wA0, wA1, decA); SCAN_LOAD(1, xrB, brB, wB0, wB1, decB); SCAN_WRITE(0, xrA, brA, wA0, wA1); dcur0 = decA;
        __syncthreads();
        for (int k = 0; k < 34; k += 2) {
            { const int kn = k + 2 < 34 ? k + 2 : 33; SCAN_LOAD(kn, xrA, brA, wA0, wA1, decA); }
            SCAN_STEP(k, 0, dcur0);
            SCAN_WRITE(1, xrB, brB, wB0, wB1); dcur1 = decB;
            __syncthreads();
            { const int kn = k + 3 < 34 ? k + 3 : 33; SCAN_LOAD(kn, xrB, brB, wB0, wB1, decB); }
            SCAN_STEP(k + 1, 1, dcur1);
            SCAN_WRITE(0, xrA, brA, wA0, wA1); dcur0 = decA;
            __syncthreads();
        }
#undef SCAN_CI
#undef SCAN_LOAD
#undef SCAN_WRITE
#undef SCAN_STEP
    }
}

__device__ __forceinline__ int crow16(int r, int hi) { return (r & 3) + 8 * (r >> 2) + 4 * hi; }
__device__ __forceinline__ void ph_yph(const Args& a, const Ctx& c, unsigned* rdg) {
    constexpr int P = 272, ZP = 144;
    LAS unsigned char* Cs = c.lds; LAS unsigned char* Bs = c.lds + 34816; LAS unsigned char* xs = c.lds + 69632; LAS unsigned char* hf = c.lds + 87040; LAS unsigned char* hb = c.lds + 104448;
    LAS unsigned char* zs = c.lds + 121856; LAS unsigned char* os = c.lds + 140288; LAS f32x4* sca = (LAS f32x4*)(c.lds + 158720); LAS f32x2* scb = (LAS f32x2*)(c.lds + 160768);
    LAS float* sbv = (LAS float*)(c.lds + 161792); LAS float* scv = (LAS float*)(c.lds + 162304); LAS float* ssql = (LAS float*)(c.lds + 34816); LAS float* ngs = (LAS float*)(c.lds + 34816 + 2048);
    const int lb = c.wave & 3, pb = c.wave >> 2;
    SECT_DECL
    for (int task = c.vcu; task < NCH * 4; task += c.G) { const int ci = task >> 2, g = task & 3, r0 = ci * 128;
        int tid_t = c.tid; asm volatile("" : "+v"(tid_t));
        f32x16 X[4]; int l0; const float ngr = a.in[I_SNORM][512 * g + c.tid];
        u32x4 pxt[2], phf[2], phb[2], pz[2]; f32x4 ps1 = {}; f32x4 ps4 = {};
#define YPH_PREFETCH(hq) do { const int h_ = 8 * g + (hq); const u32x4* xt_ = (const u32x4*)((const bf16*)(a.ws + WS_XT) + ((size_t)ci * 2048 + 64 * h_) * 128); \
            const u32x4* hfg_ = (const u32x4*)((const bf16*)(a.ws + WS_HIN) + (((size_t)ci * 2 + 0) * 32 + h_) * 8192); const u32x4* hbg_ = (const u32x4*)((const bf16*)(a.ws + WS_HIN) + (((size_t)ci * 2 + 1) * 32 + h_) * 8192); \
            const bf16* zg_ = (const bf16*)(a.ws + WS_Z) + (size_t)r0 * 2048 + 64 * h_; \
            _Pragma("unroll") for (int q = 0; q < 2; ++q) { const int p = tidp + 512 * q; pxt[q] = __builtin_nontemporal_load(xt_ + p); phf[q] = __builtin_nontemporal_load(hfg_ + p); phb[q] = __builtin_nontemporal_load(hbg_ + p); \
                pz[q] = __builtin_nontemporal_load((const u32x4*)(zg_ + (size_t)(p >> 3) * 2048 + (p & 7) * 8)); }        \
            ps1 = ((const f32x4*)(a.ws + WS_SCA))[((size_t)ci * 32 + h_) * 128 + (tidp & 127)]; ps4 = ((const f32x4*)(a.ws + WS_SCB))[((size_t)ci * 32 + h_) * 128 + (tidp & 127)]; } while (0)
        { const int tid = tid_t, lane = tid & 63, r32 = lane & 31, hi = lane >> 5; l0 = 32 * lb + r32;
          { const bf16* cn = (const bf16*)(a.ws + WS_CN) + (size_t)r0 * 512 + 128 * g; const bf16* bn = (const bf16*)(a.ws + WS_BN) + (size_t)r0 * 512 + 128 * g;
#pragma unroll
            for (int q = 0; q < 4; ++q) { const int p = tid + 512 * q, row = p >> 4, pc = p & 15;
                *(LAS u32x4*)(Cs + row * P + pc * 16) = *(const u32x4*)(cn + (size_t)row * 512 + pc * 8); *(LAS u32x4*)(Bs + row * P + pc * 16) = *(const u32x4*)(bn + (size_t)row * 512 + pc * 8); } }
          { const int tidp = tid; YPH_PREFETCH(0); }
          __syncthreads();
#pragma unroll
          for (int sb = 0; sb < 4; ++sb) { X[sb] = (f32x16){};
#pragma unroll
              for (int kk = 0; kk < 8; ++kk) { const int k8 = (16 * kk + 8 * hi) * 2;
                  X[sb] = __builtin_amdgcn_mfma_f32_32x32x16_bf16(*(const LAS bf16x8*)(Bs + (32 * sb + r32) * P + k8), *(const LAS bf16x8*)(Cs + (32 * lb + r32) * P + k8), X[sb], 0, 0, 0); } }
        }
        SECT(0);
        float ssq = 0.f;
#pragma unroll 1
        for (int hh = 0; hh < 8; ++hh) { const int h = 8 * g + hh;
            int tid = c.tid; asm volatile("" : "+v"(tid)); const int lane = tid & 63, r32 = lane & 31, hi = lane >> 5, l = 32 * lb + r32; (void)lane;
            const float dsum = a.in[I_DSK][h] + a.in[I_DSK][32 + h];
            __syncthreads();
            SECT(1);
            if (hh > 0) { const __amdgpu_buffer_rsrc_t grs = __builtin_amdgcn_make_buffer_rsrc((void*)(a.ws + WS_G), 0, TT * 2048 * 2, 0x00020000);
#pragma unroll
                for (int q = 0; q < 2; ++q) { const int p = tid + 512 * q, zr = p >> 3, zc = p & 7;
                    __builtin_amdgcn_raw_buffer_store_b128(*(const LAS u32x4*)(os + zr * ZP + zc * 16), grs, ((r0 + zr) * 2048 + 64 * (h - 1) + zc * 8) * 2, 0, 16  ); } }
#pragma unroll
            for (int q = 0; q < 2; ++q) { const int p = tid + 512 * q, row = p >> 4, pc = p & 15;
                *(LAS u32x4*)(xs + row * P + pc * 16) = pxt[q]; *(LAS u32x4*)(hf + row * P + pc * 16) = phf[q]; *(LAS u32x4*)(hb + row * P + pc * 16) = phb[q];
                *(LAS u32x4*)(zs + (p >> 3) * ZP + (p & 7) * 16) = pz[q]; }
            if (tid < 128) { sca[tid] = ps1; scb[tid] = (f32x2){ps4.x, ps4.y}; sbv[tid] = ps1.z; scv[tid] = ps1.w; }
            if (hh == 0) ngs[tid] = ngr;
            __syncthreads();
            SECT(2);
            if (hh < 7) { const int tidp = tid; YPH_PREFETCH(hh + 1); }
            SECT(3);
            const f32x4 me = sca[l]; const f32x2 ee = scb[l];
            const float dtb_l = __builtin_amdgcn_exp2f(me.w - me.y);
            f32x16 accd = {};
#pragma unroll
            for (int sb = 0; sb < 4; ++sb) { unsigned mp[8];
#pragma unroll
                for (int q = 0; q < 4; ++q) { const int s0 = 32 * sb + 8 * q + 4 * hi; float mv[4];
                    if (sb < lb) { const f32x4 bs4 = *(const LAS f32x4*)(sbv + s0);
#pragma unroll
                        for (int e = 0; e < 4; ++e) mv[e] = X[sb][4 * q + e] * __builtin_amdgcn_exp2f(me.x - bs4[e]); }
                    else if (sb > lb) { const f32x4 cs4 = *(const LAS f32x4*)(scv + s0);
#pragma unroll
                        for (int e = 0; e < 4; ++e) mv[e] = X[sb][4 * q + e] * __builtin_amdgcn_exp2f(cs4[e] - me.y); }
                    else { const f32x4 bs4 = *(const LAS f32x4*)(sbv + s0), cs4 = *(const LAS f32x4*)(scv + s0);
#pragma unroll
                        for (int e = 0; e < 4; ++e) { const int s = s0 + e; const float t = (s <= l) ? (me.x - bs4[e]) : (cs4[e] - me.y); const float xv = X[sb][4 * q + e];
                            float m = xv * __builtin_amdgcn_exp2f(t); if (s == l) m += xv * dtb_l + dsum; mv[e] = m; } }
                    mp[2 * q] = cvtpk(mv[0], mv[1]); mp[2 * q + 1] = cvtpk(mv[2], mv[3]); }
#pragma unroll
                for (int t = 0; t < 2; ++t) { const int sof = (32 * sb + 16 * t + 4 * hi) * 2;
                    const u32x2 lo = *(const LAS u32x2*)(xs + (32 * pb + r32) * P + sof), h2 = *(const LAS u32x2*)(xs + (32 * pb + r32) * P + sof + 16);
                    const u32x4 af = (u32x4){lo.x, lo.y, h2.x, h2.y}, bfm = (u32x4){mp[4 * t], mp[4 * t + 1], mp[4 * t + 2], mp[4 * t + 3]};
                    accd = __builtin_amdgcn_mfma_f32_32x32x16_bf16(__builtin_bit_cast(bf16x8, af), __builtin_bit_cast(bf16x8, bfm), accd, 0, 0, 0); }
                }
            SECT(4);
#pragma unroll
            for (int dd = 0; dd < 2; ++dd) { f32x16 acco = {}; LAS unsigned char* hx = dd == 0 ? hf : hb;
#pragma unroll
                for (int kk = 0; kk < 8; ++kk) { const int k8 = (16 * kk + 8 * hi) * 2;
                    acco = __builtin_amdgcn_mfma_f32_32x32x16_bf16(*(const LAS bf16x8*)(hx + (32 * pb + r32) * P + k8), *(const LAS bf16x8*)(Cs + (32 * lb + r32) * P + k8), acco, 0, 0, 0); }
                const float ex = dd == 0 ? ee.x : ee.y;
#pragma unroll
                for (int r = 0; r < 16; ++r) accd[r] += ex * acco[r]; }
            SECT(5);
#pragma unroll
            for (int q = 0; q < 4; ++q) { const int pcol = 32 * pb + 8 * q + 4 * hi; const u32x2 zq = *(const LAS u32x2*)(zs + l * ZP + pcol * 2);
                float gv[4];
#pragma unroll
                for (int e = 0; e < 4; ++e) { const int r = 4 * q + e; const float y = accd[r];
                    const float z = (e == 0) ? bflo(zq.x) : (e == 1) ? bfhi(zq.x) : (e == 2) ? bflo(zq.y) : bfhi(zq.y); gv[e] = y * silu_f(z); ssq += gv[e] * gv[e]; }
                const f32x4 ng4 = *(const LAS f32x4*)(ngs + 64 * hh + pcol);
                *(LAS u32x2*)(os + l * ZP + pcol * 2) = (u32x2){cvtpk(gv[0] * ng4.x, gv[1] * ng4.y), cvtpk(gv[2] * ng4.z, gv[3] * ng4.w)}; }
            SECT(6);
        }
#undef YPH_PREFETCH
        __syncthreads();
        { const __amdgpu_buffer_rsrc_t grs = __builtin_amdgcn_make_buffer_rsrc((void*)(a.ws + WS_G), 0, TT * 2048 * 2, 0x00020000);
#pragma unroll
          for (int q = 0; q < 2; ++q) { const int p = c.tid + 512 * q, zr = p >> 3, zc = p & 7;
              __builtin_amdgcn_raw_buffer_store_b128(*(const LAS u32x4*)(os + zr * ZP + zc * 16), grs, ((r0 + zr) * 2048 + 64 * (8 * g + 7) + zc * 8) * 2, 0, 16  ); } }
        ssq += __shfl_xor(ssq, 32);
        if ((c.lane >> 5) == 0) ssql[pb * 128 + l0] = ssq;
        __syncthreads();
        if (c.tid < 128) { const __amdgpu_buffer_rsrc_t rrs = __builtin_amdgcn_make_buffer_rsrc((void*)(a.ws + WS_RSTD), 0, TT * 4 * 4, 0x00020000);
            __builtin_amdgcn_raw_buffer_store_b32(__float_as_uint(rsqrtf((ssql[c.tid] + ssql[128 + c.tid]) * (1.0f / 512.0f) + EPS)), rrs, ((r0 + c.tid) * 4 + g) * 4, 0, 16  ); }
        VM_WAIT();
        __syncthreads();
        if (c.tid == 0) __hip_atomic_fetch_add(rdg + (ci >> 1), 1u, __ATOMIC_RELAXED, __HIP_MEMORY_SCOPE_AGENT);
        SECT(7);
    }
    SECT_END(40);
}
__device__ __forceinline__ void ph_gfix(const Args& a, const Ctx& c) {
    const float* ng = a.in[I_SNORM]; const float* rs = (const float*)(a.ws + WS_RSTD);
    const int n16 = TT * 256;
    for (int p = blockIdx.x * NTHREADS + c.tid; p < n16; p += c.G * NTHREADS) { const int r = p >> 8, col = (p & 255) * 8;
        u32x4* gp = (u32x4*)((bf16*)(a.ws + WS_G) + (size_t)r * 2048 + col); const u32x4 v = *gp; const float s = rs[r * 4 + (col >> 9)];
        const f32x4 g0 = *(const f32x4*)(ng + col), g1 = *(const f32x4*)(ng + col + 4);
        *gp = (u32x4){cvtpk(bflo(v.x) * s * g0.x, bfhi(v.x) * s * g0.y), cvtpk(bflo(v.y) * s * g0.z, bfhi(v.y) * s * g0.w), cvtpk(bflo(v.z) * s * g1.x, bfhi(v.z) * s * g1.y), cvtpk(bflo(v.w) * s * g1.z, bfhi(v.w) * s * g1.w)}; }
}

#if DEBUG_CHECKS
__device__ __forceinline__ float dbg_hb(const Args& a, int layer, size_t idx, float sh) {
    if (ATT_FP8 && layer != 2) return __builtin_amdgcn_cvt_f32_fp8((unsigned)((const unsigned char*)(a.ws + WS_HB))[idx], 0) * sh;
    return bf2f(((const bf16*)(a.ws + WS_HB))[idx]); }
__device__ __forceinline__ int dbg_sample_row(int b) { const int SR[16] = {0, 1, 77, 4095, 4096, 5000, 8191, 9000, 12288, 16383, 16384, 16385, 16384 + 255, 16384 + 256, 17000, 17407}; int r = 0;
#pragma unroll
    for (int i = 0; i < 16; ++i) r = (b == i) ? SR[i] : r;
    return r; }
__device__ __forceinline__ float blk_sum(float v, LAS float* red, int tid) {
    v = wave_sum(v); __syncthreads(); if ((tid & 63) == 0) red[tid >> 6] = v; __syncthreads(); float s = 0.f;
#pragma unroll
    for (int i = 0; i < 8; ++i) s += red[i];
    __syncthreads(); return s; }
__device__ __forceinline__ float blk_max(float v, LAS float* red, int tid) {
#pragma unroll
    for (int o = 1; o < 64; o <<= 1) v = fmaxf(v, __shfl_xor(v, o));
    __syncthreads(); if ((tid & 63) == 0) red[tid >> 6] = v; __syncthreads(); float s = red[0];
#pragma unroll
    for (int i = 1; i < 8; ++i) s = fmaxf(s, red[i]);
    __syncthreads(); return s; }
__device__ __forceinline__ void dbg_report(const Args& a, int id, float err, float ssref, float n, int tid) {
    if (tid == 0) { float rel = err / (sqrtf(ssref / n) + 1e-20f); if (!(rel == rel)) rel = 1e30f; atomicMax((unsigned*)(a.ws + WS_CTL) + CW_DBG + id, __float_as_uint(rel)); } }
__device__ __forceinline__ float dbg_mod(const Args& a, int layer, int r, int j) {
    const float* cv = r < TL ? a.in[I_C] + (r / SEQ) * 1024 : a.in[I_CCTX]; float s = 0.f;
    _Pragma("nounroll") for (int k = 0; k < 1024; ++k) { const float x = cv[k]; s += (x / (1.0f + expf(-x))) * a.in[I_WADA][((size_t)layer * 1024 + k) * 6144 + j]; }
    return s + a.in[I_BADA][layer * 6144 + j]; }

__device__ __forceinline__ void chk_rmix(const Args& a, int layer, int id, LAS unsigned char* ldsb) {
    if (blockIdx.x >= 16) return; const int tid = tid_opaque(), r = dbg_sample_row(blockIdx.x);
    LAS float* red = (LAS float*)ldsb;
    const float* x = resid_row(a, layer, r); const bf16* hb = (const bf16*)(a.ws + WS_HB) + (size_t)r * D;
    float ss = 0.f; for (int cc = tid; cc < D; cc += 512) ss += x[cc] * x[cc];
    ss = blk_sum(ss, red, tid); const float rstd = rsqrtf(ss / D + EPS);
    float err = 0.f, sr = 0.f;
    for (int cc = tid; cc < D; cc += 512) { const float sh = dbg_mod(a, layer, r, cc), sc = dbg_mod(a, layer, r, D + cc);
        const float ref = x[cc] * rstd * a.in[I_NMIX][layer * D + cc] * (1.f + sc) + sh; err = fmaxf(err, fabsf(ref - dbg_hb(a, layer, (size_t)r * D + cc, 1.f))); sr += ref * ref; }
    err = blk_max(err, red, tid); sr = blk_sum(sr, red, tid); dbg_report(a, id, err, sr, D, tid);
}
__device__ __forceinline__ void chk_qkv(const Args& a, int layer, int id, LAS unsigned char* ldsb) {
    if (blockIdx.x >= 16) return; const int tid = tid_opaque(), r = dbg_sample_row(blockIdx.x), j = layer ? 1 : 0;
    LAS float* red = (LAS float*)ldsb; LAS float* y = red + 16; LAS float* hrow = y + 1536;
    const bf16* hb = (const bf16*)(a.ws + WS_HB) + (size_t)r * D;
    _Pragma("nounroll") for (int k = tid; k < D; k += 512) hrow[k] = dbg_hb(a, layer, (size_t)r * D + k, 1.f);
    __syncthreads();
    for (int n = tid; n < 1536; n += 512) { float s = 0.f; const float* w = a.in[I_WQKV] + (size_t)j * 1024 * 1536 + n; _Pragma("nounroll") for (int k = 0; k < 1024; ++k) s += hrow[k] * w[(size_t)k * 1536]; y[n] = s; }
    __syncthreads();
    float err = 0.f, sr = 0.f;
    for (int n = tid; n < 1536; n += 512) { float ref;
        if (n < 1280) { const int h0 = n & ~63; float ss = 0.f; _Pragma("nounroll") for (int q = 0; q < 64; ++q) ss += y[h0 + q] * y[h0 + q];
            const float rstd = rsqrtf(ss / 64.f + EPS); const float* g = (n < 1024 ? a.in[I_QG] : a.in[I_KG]) + j * 64;
            float v = y[n] * rstd * g[n & 63], vp = y[n ^ 1] * rstd * g[(n ^ 1) & 63];
            if (r < TL) { const int t = r % SEQ, i = (n & 63) >> 1, f = i & 15, pos = i < 16 ? t / 64 : t % 64; const float inv = powf(10000.f, -(float)f / 16.f), ang = (float)pos * inv, cs = cosf(ang), sn = sinf(ang);
                v = (n & 1) ? (vp * sn + v * cs) : (v * cs - vp * sn); }
            if (n < 1024) v *= 0.125f * 1.4426950408889634f;
            ref = v; } else ref = y[n];
        float got;
        if (n < 1024) { if (layer == 3 && r >= TL) continue; got = bf2f(((const bf16*)(a.ws + WS_Q))[(size_t)r * 1024 + n]); }
        else if (n < 1280) got = bf2f(((const bf16*)(a.ws + WS_K))[kv_row(r) * 256 + (n - 1024)]);
        else got = bf2f(((const bf16*)(a.ws + WS_V))[kv_row(r) * 256 + (n - 1280)]);
        err = fmaxf(err, fabsf(ref - got)); sr += ref * ref; }
    err = blk_max(err, red, tid); sr = blk_sum(sr, red, tid); dbg_report(a, id, err, sr, 1536, tid);
}
__device__ __forceinline__ void chk_att(const Args& a, int layer, int id, LAS unsigned char* ldsb) {
    if (blockIdx.x >= 16) return; const int tid = tid_opaque(), r = dbg_sample_row(blockIdx.x);
    if (layer == 3 && r >= TL) return;
    LAS float* red = (LAS float*)ldsb; LAS float* sc = red + 16; LAS float* po = sc + 4352;
    const int nk = r < TL ? KVROWS : CTXL; const long kv0 = (long)(r < TL ? r / SEQ : (r - TL) / CTXL) * KVROWS;
    const bf16* Qb = (const bf16*)(a.ws + WS_Q); const bf16* Kb = (const bf16*)(a.ws + WS_K); const bf16* Vb = (const bf16*)(a.ws + WS_V); const bf16* Ob = (const bf16*)(a.ws + WS_HB);
    float err = 0.f, sr = 0.f;
    for (int h = 0; h < 16; ++h) {
        float mx = -3e38f;
        _Pragma("nounroll") for (int jk = tid; jk < nk; jk += 512) { float s = 0.f; _Pragma("nounroll") for (int d = 0; d < 64; ++d) s += bf2f(Qb[(size_t)r * 1024 + h * 64 + d]) * bf2f(Kb[(kv0 + jk) * 256 + (h >> 2) * 64 + d]); sc[jk] = s; mx = fmaxf(mx, s); }
        mx = blk_max(mx, red, tid);
        float l = 0.f; _Pragma("nounroll") for (int jk = tid; jk < nk; jk += 512) { const float p = exp2f(sc[jk] - mx); sc[jk] = p; l += p; }
        l = blk_sum(l, red, tid);
        { const int d = tid & 63, part = tid >> 6; float o = 0.f; _Pragma("nounroll") for (int jk = part; jk < nk; jk += 8) o += sc[jk] * bf2f(Vb[(kv0 + jk) * 256 + (h >> 2) * 64 + d]); po[part * 64 + d] = o; }
        __syncthreads();
        if (tid < 64) { float o = 0.f; _Pragma("nounroll") for (int p = 0; p < 8; ++p) o += po[p * 64 + tid]; o /= l; err = fmaxf(err, fabsf(o - dbg_hb(a, layer, (size_t)r * 1024 + h * 64 + tid, 1.f / (float)(1 << ATT_OSH)))); sr += o * o; }
        __syncthreads();
    }
    err = blk_max(err, red, tid); sr = blk_sum(sr, red, tid); dbg_report(a, id, err, sr, 1024, tid);
}
__device__ __forceinline__ void chk_oproj(const Args& a, int layer, int id, LAS unsigned char* ldsb) {
    if (blockIdx.x >= 16 || layer != 0) return; const int tid = tid_opaque(), r = dbg_sample_row(blockIdx.x), j = 0;
    LAS float* red = (LAS float*)ldsb; LAS float* orow = red + 16;
    const bf16* Ob = (const bf16*)(a.ws + WS_HB) + (size_t)r * D;
    _Pragma("nounroll") for (int k = tid; k < D; k += 512) orow[k] = dbg_hb(a, layer, (size_t)r * D + k, 1.f / (float)(1 << ATT_OSH));
    __syncthreads();
    float err = 0.f, sr = 0.f;
    for (int n = tid; n < D; n += 512) { float s = 0.f; const float* w = a.in[I_WO] + (size_t)j * 1024 * 1024 + n; _Pragma("nounroll") for (int k = 0; k < 1024; ++k) s += orow[k] * w[(size_t)k * 1024];
        const float dl = dbg_mod(a, layer, r, 2 * D + n) * s, ref = resid_row(a, 0, r)[n] + dl; err = fmaxf(err, fabsf(ref - ((const float*)(a.ws + WS_X))[(size_t)r * D + n])); sr += dl * dl; }
    err = blk_max(err, red, tid); sr = blk_sum(sr, red, tid); dbg_report(a, id, err, sr, D, tid);
}
__device__ __forceinline__ void chk_moe(const Args& a, int layer, int id_tok, int id_y, LAS unsigned char* ldsb) {
    if (blockIdx.x >= 16) return; const int tid = tid_opaque(), r = dbg_sample_row(blockIdx.x);
    if (layer == 3 && r >= TL) return;
    LAS float* red = (LAS float*)ldsb; LAS float* tok = red + 16; LAS float* lg = tok + 1024; LAS float* tkb = lg + 64; LAS float* act = tkb + 1024; LAS float* rt = act + 1024;
    const float* x = (const float*)(a.ws + WS_X) + (size_t)r * D; const bf16* tk = (const bf16*)(a.ws + WS_TK) + (size_t)r * D;
    float ss = 0.f; for (int cc = tid; cc < D; cc += 512) ss += x[cc] * x[cc];
    ss = blk_sum(ss, red, tid); const float rstd = rsqrtf(ss / D + EPS);
    float err = 0.f, sr = 0.f;
    for (int cc = tid; cc < D; cc += 512) { const float sh = dbg_mod(a, layer, r, 3 * D + cc), sc = dbg_mod(a, layer, r, 4 * D + cc);
        const float ref = x[cc] * rstd * a.in[I_NFFN][layer * D + cc] * (1.f + sc) + sh; tok[cc] = ref;
#if MOE_FP8
        tkb[cc] = __builtin_amdgcn_cvt_f32_fp8((unsigned)((const unsigned char*)(a.ws + WS_TK))[(size_t)r * D + cc], 0);
#else
        tkb[cc] = bf2f(tk[cc]);
#endif
        err = fmaxf(err, fabsf(ref - tkb[cc])); sr += ref * ref; }
    err = blk_max(err, red, tid); sr = blk_sum(sr, red, tid);
    if (tid < 36) { float s = 0.f; _Pragma("nounroll") for (int k = 0; k < 1024; ++k) s += tok[k] * (tid < 4 ? a.in[I_WRG][((size_t)layer * 1024 + k) * 4 + tid] : a.in[I_WRE][((size_t)layer * 1024 + k) * 32 + tid - 4]); lg[tid] = s; }
    __syncthreads();
    if (tid == 0) { int grp = 0; _Pragma("nounroll") for (int q = 1; q < 4; ++q) if (lg[q] > lg[grp]) grp = q; float den = 0.f; _Pragma("nounroll") for (int q = 0; q < 4; ++q) den += expf(lg[q] - lg[grp]);
        const LAS float* le = lg + 4 + grp * 8; int i0 = 0; _Pragma("nounroll") for (int q = 1; q < 8; ++q) if (le[q] > le[i0]) i0 = q; int i1 = -1; _Pragma("nounroll") for (int q = 0; q < 8; ++q) if (q != i0 && (i1 < 0 || le[q] > le[i1])) i1 = q;
        const float ex = expf(le[i1] - le[i0]), w0 = 1.f / den / (1.f + ex), w1 = 1.f / den * ex / (1.f + ex);
        rt[0] = (float)(grp * 8 + i0); rt[1] = (float)(grp * 8 + i1); rt[2] = w0; rt[3] = w1;
        const float* w2 = (const float*)(a.ws + WS_W2); float e2 = fmaxf(fabsf(w2[2 * r] - w0), fabsf(w2[2 * r + 1] - w1)) * 30.f;
        const int* list = (const int*)(a.ws + WS_LIST); const unsigned* gc = (const unsigned*)(a.ws + WS_CTL) + CW_CNT + layer * 32;
        _Pragma("nounroll") for (int k = 0; k < 2; ++k) { const int e = (int)rt[k]; bool found = false; const int n = (int)gc[e]; _Pragma("nounroll") for (int q = 0; q < n && q < MOE_CAP; ++q) if (list[e * MOE_CAP + q] == 2 * r + k) found = true; if (!found) e2 = 1e6f; }
        rt[4] = e2; }
    __syncthreads();
    err = fmaxf(err, rt[4] * sqrtf(sr / D));
    dbg_report(a, id_tok, err, sr, D, tid);
    float err2 = 0.f, sr2 = 0.f;
    _Pragma("nounroll") for (int k = 0; k < 2; ++k) { const int e = (int)rt[k]; const float wk = rt[2 + k];
        const float* wgu = a.in[I_WGU] + ((size_t)layer * 32 + e) * 1024 * 1024; const float* wdn = a.in[I_WDN] + ((size_t)layer * 32 + e) * 512 * 1024;
        { float sg = 0.f, su = 0.f; _Pragma("nounroll") for (int q = 0; q < 1024; ++q) { sg += tkb[q] * wgu[(size_t)q * 1024 + tid]; su += tkb[q] * wgu[(size_t)q * 1024 + 512 + tid]; } act[tid] = (sg / (1.f + expf(-sg))) * su; }
        __syncthreads();
        for (int n = tid; n < D; n += 512) { float s = 0.f; _Pragma("nounroll") for (int q = 0; q < 512; ++q) s += act[q] * wdn[(size_t)q * 1024 + n]; s *= wk;
            err2 = fmaxf(err2, fabsf(s - bf2f(((const bf16*)(a.ws + WS_Y2))[(size_t)(2 * r + k) * D + n]))); sr2 += s * s; }
        __syncthreads(); }
    err2 = blk_max(err2, red, tid); sr2 = blk_sum(sr2, red, tid); dbg_report(a, id_y, err2, sr2, 2 * D, tid);
}

__global__ void __launch_bounds__(NTHREADS) dbg_kernel(Args a, int ty, int layer, int id) {
    extern __shared__ __attribute__((aligned(16))) unsigned char lds_dbg[];
    LAS unsigned char* l = (LAS unsigned char*)lds_dbg;
    if (ty == 1) chk_rmix(a, layer, id, l); else if (ty == 2) chk_qkv(a, layer, id, l); else if (ty == 3) chk_att(a, layer, id, l);
    else if (ty == 4) chk_oproj(a, layer, id, l); else if (ty == 5) chk_moe(a, layer, id, id + 1, l);
}
#endif

template <int KIND, int LAYER> __device__ __forceinline__ void run_phase(const Args& a0, Ctx& c, unsigned char* lds_gen) {
    Args a = a0; { unsigned long long wsv = (unsigned long long)a0.ws; asm volatile("" : "+s"(wsv)); a.ws = (unsigned char*)(GAS unsigned char*)wsv; }
    { unsigned lb = (unsigned)(uintptr_t)(LAS unsigned char*)lds_gen; asm volatile("" : "+s"(lb)); c.lds = (LAS unsigned char*)(uintptr_t)lb; }
    c.tid = tid_opaque(); c.lane = c.tid & 63;
    unsigned char* const ws = a.ws; constexpr int layer = LAYER;
#define RELAUNDER() do { { unsigned long long wsv_ = (unsigned long long)a0.ws; asm volatile("" : "+s"(wsv_)); a.ws = (unsigned char*)(GAS unsigned char*)wsv_; } \
        { unsigned lb_ = (unsigned)(uintptr_t)(LAS unsigned char*)lds_gen; asm volatile("" : "+s"(lb_)); c.lds = (LAS unsigned char*)(uintptr_t)lb_; } c.tid = tid_opaque(); c.lane = c.tid & 63; } while (0)
    if constexpr (KIND == K_P0) p0_prologue(a, c);
    else if constexpr (KIND == K_RMIX) ph_rmix(a, c, layer);
    else if constexpr (KIND == K_QKV) { constexpr int j = layer ? 1 : 0;
#if ATT_FP8
        SchedQKV S{(const char*)(ws + WS_HB), (const char*)(ws + WS_WQKV) + (size_t)j * 1536 * 1024, (size_t)256 * 1024, layer == 0 ? 1 : 0, c.G, (int)blockIdx.x};
        EpiQKV E{(bf16*)(ws + WS_Q), (bf16*)(ws + WS_K), (bf16*)(ws + WS_V), a.in[I_QG] + j * 64, a.in[I_KG] + j * 64, (const f32x2*)(ws + WS_ROPE)};
        pg8::gemm_phase<EpiQKV, SchedQKV, false, true>(c.lds, 1024, 1024, S, E, 127 - MOE_WSH, 127); }
#else
        SchedQKV S{(const char*)(ws + WS_HB), (const char*)(ws + WS_WQKV) + (size_t)j * 1536 * 1024 * 2, (size_t)256 * 1024 * 2, layer == 0 ? 1 : 0, c.G, (int)blockIdx.x};
        EpiQKV E{(bf16*)(ws + WS_Q), (bf16*)(ws + WS_K), (bf16*)(ws + WS_V), a.in[I_QG] + j * 64, a.in[I_KG] + j * 64, (const f32x2*)(ws + WS_ROPE)};
        pg8::gemm_phase<EpiQKV, SchedQKV, false>(c.lds, 2048, 2048, S, E); }
#endif
    else if constexpr (KIND == K_ROPE) ph_rope(a, c, layer);
    else if constexpr (KIND == K_ATT) ph_att(a, c, layer, (char*)c.lds);
    else if constexpr (KIND == K_OPROJ) { constexpr int j = layer ? 1 : 0;
#if ATT_FP8
        unsigned* rdx = (unsigned*)(ws + WS_CTL) + CW_RDX + layer * 128;
        SchedDenseR S{(const char*)(ws + WS_HB), (const char*)(ws + WS_WO) + (size_t)j * 1024 * 1024, (size_t)256 * 1024, (size_t)256 * 1024, 0, layer == 3 ? 64 : 68, 4, 64, c.G, (int)blockIdx.x, rdx};
        EpiResid E{&a, layer, nullptr, nullptr, nullptr};
        pg8::gemm_phase<EpiResid, SchedDenseR, false, true>(c.lds, 1024, 1024, S, E, 127 - MOE_WSH, 127 - ATT_OSH);
        RELAUNDER(); ph_m1(a, c, layer, (unsigned*)(a.ws + WS_CTL) + CW_RDX + layer * 128, 4, 0); }
#else
        unsigned* rdx = (unsigned*)(ws + WS_CTL) + CW_RDX + layer * 128;
        SchedDenseR S{(const char*)(ws + WS_HB), (const char*)(ws + WS_WO) + (size_t)j * 1024 * 1024 * 2, (size_t)256 * 1024 * 2, (size_t)256 * 1024 * 2, 0, layer == 3 ? 64 : 68, 4, 64, c.G, (int)blockIdx.x, rdx};
        EpiResid E{&a, layer, nullptr, nullptr, nullptr};
        pg8::gemm_phase<EpiResid, SchedDenseR, false>(c.lds, 2048, 2048, S, E);
        RELAUNDER(); ph_m1(a, c, layer, (unsigned*)(a.ws + WS_CTL) + CW_RDX + layer * 128, 4, 0); }
#endif
    else if constexpr (KIND == K_M2) {
        LAS int* tab = (LAS int*)(c.lds + TAB_OFF); moe_tables(a, c, layer, tab);
        unsigned* rdy = (unsigned*)(ws + WS_CTL) + CW_RDY + layer * 256;
#if MOE_FP8
        { SchedMoe S{(const char*)(ws + WS_TK), 0, (const char*)(ws + WS_WGU) + (size_t)layer * 32 * 1024 * 1024, (size_t)1024 * 1024, (size_t)256 * 1024, tab, (const int*)(ws + WS_LIST), c.G, (int)blockIdx.x, rdy, 1};
          EpiGateUp E{(bf16*)(ws + WS_ACT)};
          pg8::gemm_phase<EpiGateUp, SchedMoe, true, true>(c.lds, 1024, 1024, S, E, 127 - MOE_WSH, 127); }
        { SchedMoe S{(const char*)(ws + WS_ACT), (size_t)256 * 512, (const char*)(ws + WS_WDN) + (size_t)layer * 32 * 1024 * 512, (size_t)1024 * 512, (size_t)256 * 512, tab, (const int*)(ws + WS_LIST), c.G, (int)blockIdx.x, rdy, 2};
          EpiDown E{(const int*)(ws + WS_LIST), (const float*)(ws + WS_W2), (bf16*)(ws + WS_Y2)};
          pg8::gemm_phase<EpiDown, SchedMoe, false, true>(c.lds, 512, 512, S, E, 127 - MOE_WSH, 127 - MOE_ASH); } }
#else
        { SchedMoe S{(const char*)(ws + WS_TK), 0, (const char*)(ws + WS_WGU) + (size_t)layer * 32 * 1024 * 1024 * 2, (size_t)1024 * 1024 * 2, (size_t)256 * 1024 * 2, tab, (const int*)(ws + WS_LIST), c.G, (int)blockIdx.x, rdy, 1};
          EpiGateUp E{(bf16*)(ws + WS_ACT)};
          pg8::gemm_phase<EpiGateUp, SchedMoe, true>(c.lds, 2048, 2048, S, E); }
        { SchedMoe S{(const char*)(ws + WS_ACT), (size_t)256 * 512 * 2, (const char*)(ws + WS_WDN) + (size_t)layer * 32 * 1024 * 512 * 2, (size_t)1024 * 512 * 2, (size_t)256 * 512 * 2, tab, (const int*)(ws + WS_LIST), c.G, (int)blockIdx.x, rdy, 2};
          EpiDown E{(const int*)(ws + WS_LIST), (const float*)(ws + WS_W2), (bf16*)(ws + WS_Y2)};
          pg8::gemm_phase<EpiDown, SchedMoe, false>(c.lds, 1024, 1024, S, E); } }
#endif
    else if constexpr (KIND == K_RPOOL) ph_rpool(a, c, layer);
    else if constexpr (KIND == K_POOLG) {
        unsigned* rdx = (unsigned*)(ws + WS_CTL) + CW_RDX + layer * 128;
        SchedDenseR S{(const char*)(ws + WS_HB), (const char*)(ws + WS_WPOOL), (size_t)256 * 1024 * 2, (size_t)256 * 256 * 2, (size_t)256 * 2, 68, 4, 64, c.G, (int)blockIdx.x, rdx};
        EpiResidN E{&a, layer, a.in[I_POOLS], (const bf16*)(ws + WS_Z), nullptr};
        pg8::gemm_phase<EpiResidN, SchedDenseR, false>(c.lds, 512, 2048, S, E);
        RELAUNDER(); ph_m1(a, c, layer, (unsigned*)(a.ws + WS_CTL) + CW_RDX + layer * 128, 4, 0); }
    else if constexpr (KIND == K_INPROJ) {
        SchedDense S{(const char*)(ws + WS_HB), (const char*)(ws + WS_WIN), (size_t)256 * 1024 * 2, (size_t)256 * 1024 * 2, 0, 68, 21, c.G, (int)blockIdx.x};
        EpiInproj E{(bf16*)(ws + WS_Z), (bf16*)(ws + WS_XBC), (float*)(ws + WS_DT), a.in[I_DTB]};
        pg8::gemm_phase<EpiInproj, SchedDense, false>(c.lds, 2048, 2048, S, E); }
    else if constexpr (KIND == K_CONV) ph_conv(a, c);
    else if constexpr (KIND == K_SCAN) ph_scan(a, c);
    else if constexpr (KIND == K_YPH) {
        ph_yph(a, c, (unsigned*)(ws + WS_CTL) + CW_RDG);
        RELAUNDER();
        { unsigned* rdx = (unsigned*)(a.ws + WS_CTL) + CW_RDX + layer * 128;
          SchedOutproj S{(const char*)(a.ws + WS_G), (const char*)(a.ws + WS_WOUT), (size_t)256 * 2048 * 2, (size_t)256 * 2048 * 2, c.G, c.vcu, (const unsigned*)(a.ws + WS_CTL) + CW_RDG, rdx, (const float*)(a.ws + WS_RSTD)};
          EpiResid E{&a, layer, nullptr, nullptr, (const float*)(a.ws + WS_RSTD)};
          pg8::gemm_phase<EpiResid, SchedOutproj, false>(c.lds, 4096, 4096, S, E); }
        RELAUNDER(); ph_m1(a, c, layer, (unsigned*)(a.ws + WS_CTL) + CW_RDX + layer * 128, 4, 1); }
    else if constexpr (KIND == K_GFIX) ph_gfix(a, c);
    else if constexpr (KIND == K_FINAL) ph_final(a, c, layer);
#undef RELAUNDER
}
#define PROGRAM(X) \
    X(0, K_P0, 0) \
    X(1, K_RMIX, 0) X(2, K_QKV, 0) X(3, K_ATT, 0) X(4, K_OPROJ, 0) X(5, K_M2, 0) \
    X(6, K_RPOOL, 1) X(7, K_POOLG, 1) X(8, K_M2, 1) \
    X(9, K_RMIX, 2) X(10, K_INPROJ, 2) X(11, K_CONV, 2) X(12, K_SCAN, 2) X(13, K_YPH, 2) X(14, K_M2, 2) \
    X(15, K_RMIX, 3) X(16, K_QKV, 3) X(17, K_ATT, 3) X(18, K_OPROJ, 3) X(19, K_M2, 3) \
    X(20, K_FINAL, 4)
constexpr int NPHASES = 21;
__device__ __forceinline__ unsigned long long probe_phases(const unsigned long long* ts, unsigned mask) { unsigned long long r = 0; for (int k = 0; k < 32; ++k) if (mask & (1u << k)) r += ts[k + 1] - ts[k]; return r; }
__device__ __forceinline__ unsigned long long probe_sum(const unsigned long long* s, int mask) { unsigned long long r = 0; for (int k = 0; k < 8; ++k) if (mask & (1 << k)) r += s[k]; return r; }
__global__ void __launch_bounds__(NTHREADS, 2) mega(Args a0) {
    extern __shared__ __attribute__((aligned(16))) unsigned char lds_raw[];
    Ctx c; c.lds = (LAS unsigned char*)lds_raw; c.tid = threadIdx.x; c.lane = c.tid & 63; c.wave = __builtin_amdgcn_readfirstlane(c.tid >> 6);
    c.G = gridDim.x; { const int bx = blockIdx.x; c.vcu = (c.G % 8 == 0) ? (bx % 8) * (c.G / 8) + bx / 8 : bx; }
    volatile LAS unsigned* MISC = (volatile LAS unsigned*)(c.lds + MISC_OFF);
    for (int u = c.tid; u < 128; u += NTHREADS) MISC[u] = 0u;
    __syncthreads();
    XcdBarrier bar = xcd_barrier_post((unsigned*)(a0.ws + WS_CTL) + CW_BAR + a0.bar_region * XCD_BAR_WORDS, MISC + 8);
    const int lo = a0.ph_lo, hi = a0.ph_hi;
#if PROBE
#define STAMP(idx) if (blockIdx.x == 0 && threadIdx.x == 0) __hip_atomic_store((unsigned long long*)((unsigned*)(a0.ws + WS_CTL) + CW_TS) + (idx), (unsigned long long)__builtin_amdgcn_s_memrealtime(), __ATOMIC_RELAXED, __HIP_MEMORY_SCOPE_AGENT);
#else
#define STAMP(idx)
#endif
    STAMP(0)
#if EXTRA_BARS
    for (int eb = 0; eb < EXTRA_BARS; ++eb) xcd_barrier(bar);
#endif
#define RUNPH(idx, KIND, LAYER) if (lo <= (idx) && (idx) < hi) { run_phase<KIND, LAYER>(a0, c, lds_raw); if ((idx) + 1 < hi) xcd_barrier(bar); STAMP((idx) + 1) }
    PROGRAM(RUNPH)
#undef RUNPH
#if PROBE
    if (blockIdx.x == 0 && threadIdx.x == 0 && hi == NPHASES) { const unsigned long long* ts = (const unsigned long long*)((unsigned*)(a0.ws + WS_CTL) + CW_TS);
        const unsigned long long d = (unsigned long long)PROBE_K * (PROBE_SLOT ? probe_sum(ts + PROBE_SLOT_BASE, PROBE_SLOT) : probe_phases(ts, PROBE_MASK)), t0 = __builtin_amdgcn_s_memrealtime();
        while (__builtin_amdgcn_s_memrealtime() - t0 < d) __builtin_amdgcn_s_sleep(8); }
#endif
}

extern "C" void kernel_launch(void* const* d_in, const int* in_sizes, int n_in, void* d_out, int out_size, void* d_ws, size_t ws_size, hipStream_t stream) {
    static int grid = 0;
    if (grid == 0) {
        if (n_in != N_IN || out_size != TL * D || ws_size < WS_END) { fprintf(stderr, "kernel_launch: unexpected shapes (n_in %d out %d ws %zu)\n", n_in, out_size, ws_size); grid = -1; return; }
        int dev = 0, cus = 0;
        if (hipGetDevice(&dev) != hipSuccess || hipDeviceGetAttribute(&cus, hipDeviceAttributeMultiprocessorCount, dev) != hipSuccess) { grid = -1; return; }
        if (hipFuncSetAttribute((const void*)mega, hipFuncAttributeMaxDynamicSharedMemorySize, LDS_BYTES) != hipSuccess) { fprintf(stderr, "kernel_launch: hipFuncSetAttribute failed\n"); grid = -1; return; }
        int per_cu = 0;
        if (hipOccupancyMaxActiveBlocksPerMultiprocessor(&per_cu, (const void*)mega, NTHREADS, LDS_BYTES) != hipSuccess || per_cu < 1) fprintf(stderr, "kernel_launch: occupancy query says %d\n", per_cu);
        (void)hipGetLastError();
        if (cus < 192) { fprintf(stderr, "kernel_launch: %d CUs: the router keeps at most 3 row tiles of logits per workgroup (needs >= 182 workgroups)\n", cus); grid = -1; return; }
        grid = cus;
    }
    if (grid < 0) return;
    (void)hipMemsetAsync((char*)d_ws + WS_CTL, 0, CTL_ZERO_BYTES, stream);
    Args a{};
    for (int i = 0; i < N_IN; ++i) a.in[i] = (const float*)d_in[i];
    a.out = (float*)d_out; a.ws = (unsigned char*)d_ws; a.flags = 0;
#if DEBUG_CHECKS
    struct Cut { int after; int ty, layer, nid; };
    const Cut cuts[] = DEBUG_CUTS;
    int lo = 0, region = 0, dbg_id = 1;
    for (unsigned k = 0; k < sizeof(cuts) / sizeof(cuts[0]); ++k) {
        if (cuts[k].after + 1 > lo) { a.ph_lo = lo; a.ph_hi = cuts[k].after + 1; a.bar_region = region++; hipLaunchKernelGGL(mega, dim3(grid), dim3(NTHREADS), LDS_BYTES, stream, a); lo = cuts[k].after + 1; }
        hipLaunchKernelGGL(dbg_kernel, dim3(16), dim3(NTHREADS), 65536, stream, a, cuts[k].ty, cuts[k].layer, dbg_id); dbg_id += cuts[k].nid;
    }
    a.ph_lo = lo; a.ph_hi = NPHASES; a.bar_region = region++;
    hipLaunchKernelGGL(mega, dim3(grid), dim3(NTHREADS), LDS_BYTES, stream, a);
#else
    a.ph_lo = 0; a.ph_hi = NPHASES; a.bar_region = 0;
    hipLaunchKernelGGL(mega, dim3(grid), dim3(NTHREADS), LDS_BYTES, stream, a);
#endif
}
```

```cpp
#include <hip/hip_runtime.h>
#include <cstdio>
#include <cstdint>

#define LAS __attribute__((address_space(3)))
#define GAS __attribute__((address_space(1)))
typedef unsigned short bf16;
typedef short bf16x8 __attribute__((ext_vector_type(8)));
typedef short s16x4 __attribute__((ext_vector_type(4)));
typedef float f32x2 __attribute__((ext_vector_type(2)));
typedef float f32x4 __attribute__((ext_vector_type(4)));
typedef float f32x16 __attribute__((ext_vector_type(16)));
typedef unsigned u32x2 __attribute__((ext_vector_type(2)));
typedef unsigned u32x4 __attribute__((ext_vector_type(4)));
typedef __bf16 bf16x2_t __attribute__((ext_vector_type(2)));

constexpr int D = 1024, NB = 4, SEQ = 4096, CTXL = 256, TL = NB * SEQ, TC = NB * CTXL, TT = TL + TC;
constexpr int KVROWS = SEQ + CTXL;
constexpr int NCH = TT / 128;
constexpr int MOE_CAP = TT;
constexpr float EPS = 1e-6f;
constexpr int NWAVES = 8, NTHREADS = 512;
#ifndef NLAYERS
#define NLAYERS 4
#endif
#ifndef MOE_FP8
#define MOE_FP8 1
#endif
#define MOE_WSH 5
#ifndef ATT_FP8
#define ATT_FP8 1
#endif
#define ATT_OSH 3
#define MOE_ASH 2
#define DBG_TOL 0.03f
#ifndef DEBUG_CHECKS
#define DEBUG_CHECKS 0
#endif
#ifndef PROBE
#define PROBE 0
#endif
#define PROBE_A0 0
#define PROBE_A1 1
#define PROBE_B0 4
#define PROBE_B1 5
#define PROBE_K 2
#define PROBE_MASK 0x1222224u
#define EXTRA_BARS 0
#define Y2_FP8 1
#define Y2_SH 3
#define SSD_FP8 1
#define PROBE_Y2MAX 0
#define PROBE_SLOT_BASE 40
#define PROBE_SLOT 0
#if PROBE
#define SECT_DECL unsigned long long sect_t = __builtin_amdgcn_s_memrealtime(); unsigned long long sect_acc[8] = {0, 0, 0, 0, 0, 0, 0, 0};
#define SECT(k) do { const unsigned long long n_ = __builtin_amdgcn_s_memrealtime(); sect_acc[k] += n_ - sect_t; sect_t = n_; } while (0)
#ifndef PROBE_BLOCK
#define PROBE_BLOCK 0
#endif
#define SECT_END(base) do { if (blockIdx.x == PROBE_BLOCK && threadIdx.x == 0) { _Pragma("unroll") for (int k_ = 0; k_ < 8; ++k_) ((unsigned long long*)((unsigned*)(a.ws + WS_CTL) + CW_TS))[(base) + k_] = sect_acc[k_]; } } while (0)
#else
#define SECT_DECL
#define SECT(k) do {} while (0)
#define SECT_END(base) do {} while (0)
#endif
#define DEBUG_CUTS { {1, 1, 0, 1}, {2, 2, 0, 1}, {3, 3, 0, 1}, {4, 4, 0, 1}, {6, 5, 0, 2} }

enum { I_X = 0, I_C, I_CTX, I_CCTX, I_WADA, I_BADA, I_NMIX, I_NFFN, I_NFIN, I_WQKV, I_WO, I_QG, I_KG, I_POOLW, I_POOLS, I_WIN, I_CONVW, I_CONVB, I_DTB, I_ALOG, I_DSK, I_SNORM, I_WOUT, I_WRG, I_WRE, I_WGU, I_WDN, N_IN };

constexpr size_t MiB = 1u << 20;
constexpr size_t WS_CTL = 0, CTL_ZERO_BYTES = 1 * MiB;
constexpr size_t WS_MODL = 1 * MiB;
constexpr size_t WS_MODC = WS_MODL + 4 * 4 * 6144 * 4;
constexpr size_t WS_ROPE = 1 * MiB + 512 * 1024;
constexpr size_t WS_WR = 2 * MiB;
constexpr size_t WS_WQKV = 3 * MiB;
constexpr size_t WS_WO = 9 * MiB;
constexpr size_t WS_WPOOL = 13 * MiB;
constexpr size_t WS_WIN = 14 * MiB;
constexpr size_t WS_WOUT = 25 * MiB;
constexpr size_t WS_WGU = 29 * MiB;
constexpr size_t WS_WDN = 285 * MiB;
constexpr size_t WS_X = 413 * MiB;
constexpr size_t WS_HB = 481 * MiB;
constexpr size_t WS_TK = 515 * MiB;
constexpr size_t WS_Q = 549 * MiB;
constexpr size_t WS_K = 583 * MiB;
constexpr size_t WS_V = 592 * MiB;
constexpr size_t WS_Y2 = 601 * MiB;
constexpr size_t WS_ACT = 669 * MiB;
constexpr size_t WS_LIST = 711 * MiB;
constexpr size_t WS_W2 = 714 * MiB;
constexpr size_t WS_Z = 715 * MiB;
constexpr size_t WS_XBC = 783 * MiB;
constexpr size_t WS_DT = 885 * MiB;
constexpr size_t WS_XT = 890 * MiB;
constexpr size_t WS_BN = 958 * MiB;
constexpr size_t WS_BT = 975 * MiB;
constexpr size_t WS_CN = 992 * MiB;
constexpr size_t WS_SCA = 1009 * MiB;
constexpr size_t WS_SCB = 1018 * MiB;
constexpr size_t WS_DEC = 1027 * MiB;
constexpr size_t WS_HIN = 1028 * MiB;
constexpr size_t WS_G = 1164 * MiB;
constexpr size_t WS_RSTD = 1232 * MiB;
constexpr size_t WS_END = 1233 * MiB;

constexpr int CW_BAR = 4096;
constexpr int CW_CNT = 200000;
constexpr int CW_DBG = 201000;
constexpr int CW_RDY = 204000;
constexpr int CW_RDG = 207000;
constexpr int CW_P0T = 208000;
constexpr int CW_RDX = 206000;
constexpr int CW_TS = 202000;

constexpr int LDS_BYTES = 163840;
constexpr int MISC_OFF = LDS_BYTES - 512;

__device__ __forceinline__ unsigned cvtpk(float lo, float hi) { f32x2 v = {lo, hi}; bf16x2_t b = __builtin_convertvector(v, bf16x2_t); return __builtin_bit_cast(unsigned, b); }
__device__ __forceinline__ unsigned pk_fp8x4(float a, float b, float c, float d) {
    a = __builtin_amdgcn_fmed3f(a, -448.f, 448.f); b = __builtin_amdgcn_fmed3f(b, -448.f, 448.f); c = __builtin_amdgcn_fmed3f(c, -448.f, 448.f); d = __builtin_amdgcn_fmed3f(d, -448.f, 448.f);
    unsigned w = __builtin_amdgcn_cvt_pk_fp8_f32(a, b, 0u, false); return __builtin_amdgcn_cvt_pk_fp8_f32(c, d, w, true); }
__device__ __forceinline__ float bflo(unsigned u) { return __uint_as_float(u << 16); }
__device__ __forceinline__ float bfhi(unsigned u) { return __uint_as_float(u & 0xffff0000u); }
__device__ __forceinline__ float bf2f(bf16 b) { return __uint_as_float((unsigned)b << 16); }
__device__ __forceinline__ float wave_sum(float v) {
#pragma unroll
    for (int o = 1; o < 64; o <<= 1) v += __shfl_xor(v, o);
    return v;
}
__device__ __forceinline__ float silu_f(float v) { return v * __builtin_amdgcn_rcpf(1.0f + __builtin_amdgcn_exp2f(v * -1.4426950408889634f)); }
__device__ __forceinline__ int tid_opaque() { int t = threadIdx.x; asm volatile("" : "+v"(t)); return t; }
#define LDS_WAIT() asm volatile("s_waitcnt lgkmcnt(0)" ::: "memory")
#define VM_WAIT() asm volatile("s_waitcnt vmcnt(0)" ::: "memory")

#define XB_TMO      128
#define XB_XCNT(j)  (256  + 64 * (j))
#define XB_XSUB(j)  (1280 + 64 * (j))
#define XB_XGEN(j)  (2304 + 64 * (j))
#define XB_TOP      3328
#define XB_TOPGEN   3392
#define XCD_BAR_WORDS 3456
#define XB_SPIN_CAP (1u << 20)
#ifndef XB_FLATPOLL
#define XB_FLATPOLL 0
#endif
__device__ __forceinline__ unsigned xb_ld(unsigned* p)              { return __hip_atomic_load(p, __ATOMIC_RELAXED, __HIP_MEMORY_SCOPE_AGENT); }
__device__ __forceinline__ unsigned xb_add(unsigned* p, unsigned v) { return __hip_atomic_fetch_add(p, v, __ATOMIC_RELAXED, __HIP_MEMORY_SCOPE_AGENT); }
__device__ __forceinline__ unsigned xb_xcc_id() { return (unsigned)__builtin_amdgcn_s_getreg((3 << 11) | 20) & 0xFu; }
#define XB_SPIN(cond, bar) do { unsigned _sp = 0; while (cond) { __builtin_amdgcn_s_sleep(1); \
    if ((++_sp & 255u) == 0u) { if (xb_ld(&(bar)[XB_TMO])) break; if (_sp > XB_SPIN_CAP) { atomicAdd(&(bar)[XB_TMO], 1u); break; } } } } while (0)
struct XcdBarrier { unsigned* bar; unsigned x; volatile LAS unsigned* st; };
__device__ __forceinline__ XcdBarrier xcd_barrier_post(unsigned* bar, volatile LAS unsigned* st) {
    XcdBarrier b; b.bar = bar; b.x = xb_xcc_id(); b.st = st;
    if (threadIdx.x == 0) (void)xb_add(&bar[XB_XCNT(b.x)], 1u);
    return b;
}
__device__ __forceinline__ void xcd_barrier_complete(unsigned* bar, unsigned x, unsigned& nloc, unsigned& nx) {
    const unsigned G = gridDim.x * gridDim.y * gridDim.z;
    unsigned sum, cnt, mine, sp = 0u;
    for (;;) {
        sum = 0u; cnt = 0u; mine = 0u;
#pragma unroll
        for (unsigned j = 0; j < 16; ++j) { const unsigned c = xb_ld(&bar[XB_XCNT(j)]); sum += c; cnt += (c > 0u) ? 1u : 0u; mine = (j == x) ? c : mine; }
        if (sum == G) break;
        __builtin_amdgcn_s_sleep(1);
        if ((++sp & 255u) == 0u) { if (xb_ld(&bar[XB_TMO])) break; if (sp > XB_SPIN_CAP) { atomicAdd(&bar[XB_TMO], 1u); break; } }
    }
    nloc = mine > 0u ? mine : 1u; nx = cnt > 0u ? cnt : 1u;
}
__device__ __forceinline__ void xcd_barrier(const XcdBarrier& b) {
    asm volatile("s_waitcnt vmcnt(0)" ::: "memory");
    __syncthreads();
    if (threadIdx.x == 0) {
        unsigned* bar = b.bar;
        __builtin_amdgcn_s_waitcnt(0);
        unsigned nloc = b.st[0], nx = b.st[1];
        if (nloc == 0u) { xcd_barrier_complete(bar, b.x, nloc, nx); b.st[0] = nloc; b.st[1] = nx; }
#if XB_FLATPOLL
        const unsigned seq = b.st[2]; b.st[2] = seq + 1u;
#endif
        const unsigned old = xb_add(&bar[XB_XSUB(b.x)], 1u);
        const unsigned gen = old / nloc;
        if (old + 1u == (gen + 1u) * nloc) {
            __builtin_amdgcn_fence(__ATOMIC_RELEASE, "agent");
            asm volatile("s_waitcnt vmcnt(0)" ::: "memory");
            const unsigned og = xb_add(&bar[XB_TOP], 1u);
            const unsigned tg = og / nx;
            if (og + 1u == (tg + 1u) * nx) xb_add(&bar[XB_TOPGEN], 1u);
            else XB_SPIN(xb_ld(&bar[XB_TOPGEN]) == tg, bar);
            __builtin_amdgcn_fence(__ATOMIC_ACQUIRE, "agent");
#if !XB_FLATPOLL
            xb_add(&bar[XB_XGEN(b.x)], 1u);
#endif
            asm volatile("s_waitcnt vmcnt(0)" ::: "memory");
        } else {
#if XB_FLATPOLL
            XB_SPIN(xb_ld(&bar[XB_TOPGEN]) == seq, bar);
#else
            XB_SPIN(xb_ld(&bar[XB_XGEN(b.x)]) == gen, bar);
#endif
            __builtin_amdgcn_fence(__ATOMIC_ACQUIRE, "agent");
            asm volatile("s_waitcnt vmcnt(0)" ::: "memory");
        }
    }
    __syncthreads();
}

enum { K_P0 = 0, K_RMIX, K_QKV, K_ROPE, K_ATT, K_OPROJ, K_M1, K_M2, K_M3, K_RPOOL, K_POOLG, K_INPROJ, K_CONV, K_SCAN, K_YPH, K_GFIX, K_OUTPROJ, K_FINAL, K_DBG };
struct Args { const float* in[N_IN]; float* out; unsigned char* ws; int ph_lo, ph_hi; int flags; int bar_region; };

struct Ctx {
    LAS unsigned char* lds; int tid, lane, wave, vcu, G;
};

__device__ __forceinline__ const float* mod_row(const Args& a, int layer, int r) {
    return r < TL ? (const float*)(a.ws + WS_MODL) + (size_t)(layer * 4 + r / SEQ) * 6144 : (const float*)(a.ws + WS_MODC) + (size_t)layer * 6144;
}
__device__ __forceinline__ const float* resid_row(const Args& a, int layer, int r) {
    if (layer == 0) return r < TL ? a.in[I_X] + (size_t)r * D : a.in[I_CTX] + (size_t)(r - TL) * D;
    return (const float*)(a.ws + WS_X) + (size_t)r * D;
}

__device__ __forceinline__ void load_row_combined(const Args& a, int layer, int r, int lane, f32x4 (&v)[4]) {
    if (layer == 0) { const f32x4* xr = (const f32x4*)resid_row(a, 0, r) + lane;
#pragma unroll
        for (int j = 0; j < 4; ++j) v[j] = xr[64 * j]; }
    else { const u32x2* xr = (const u32x2*)((const bf16*)(a.ws + WS_X) + (size_t)r * D) + lane;
#pragma unroll
        for (int j = 0; j < 4; ++j) { const u32x2 p = xr[64 * j]; v[j] = (f32x4){bflo(p.x), bfhi(p.x), bflo(p.y), bfhi(p.y)}; } }
    if (layer > 0 && !(a.flags & 1)) {
        const f32x4* gf = (const f32x4*)(mod_row(a, layer - 1, r) + 5 * D) + lane;
#if Y2_FP8
        const unsigned* y0 = (const unsigned*)((const unsigned char*)(a.ws + WS_Y2) + (size_t)(2 * r) * D) + lane;
        const unsigned* y1 = (const unsigned*)((const unsigned char*)(a.ws + WS_Y2) + (size_t)(2 * r + 1) * D) + lane;
#pragma unroll
        for (int j = 0; j < 4; ++j) {
            const unsigned p = y0[64 * j], q = y1[64 * j]; const f32x4 g = gf[64 * j] * (1.0f / (float)(1 << Y2_SH));
            v[j].x += g.x * (__builtin_amdgcn_cvt_f32_fp8(p, 0) + __builtin_amdgcn_cvt_f32_fp8(q, 0)); v[j].y += g.y * (__builtin_amdgcn_cvt_f32_fp8(p, 1) + __builtin_amdgcn_cvt_f32_fp8(q, 1));
            v[j].z += g.z * (__builtin_amdgcn_cvt_f32_fp8(p, 2) + __builtin_amdgcn_cvt_f32_fp8(q, 2)); v[j].w += g.w * (__builtin_amdgcn_cvt_f32_fp8(p, 3) + __builtin_amdgcn_cvt_f32_fp8(q, 3));
        }
#else
        const u32x2* y0 = (const u32x2*)((const bf16*)(a.ws + WS_Y2) + (size_t)(2 * r) * D) + lane;
        const u32x2* y1 = (const u32x2*)((const bf16*)(a.ws + WS_Y2) + (size_t)(2 * r + 1) * D) + lane;
#pragma unroll
        for (int j = 0; j < 4; ++j) {
            const u32x2 p = y0[64 * j], q = y1[64 * j]; const f32x4 g = gf[64 * j];
            v[j].x += g.x * (bflo(p.x) + bflo(q.x)); v[j].y += g.y * (bfhi(p.x) + bfhi(q.x));
            v[j].z += g.z * (bflo(p.y) + bflo(q.y)); v[j].w += g.w * (bfhi(p.y) + bfhi(q.y));
        }
#endif
    }
}
__device__ __forceinline__ float row_rstd(const f32x4 (&v)[4]) {
    float s = 0.f;
#pragma unroll
    for (int j = 0; j < 4; ++j) s += (v[j].x * v[j].x + v[j].y * v[j].y) + (v[j].z * v[j].z + v[j].w * v[j].w);
    return rsqrtf(wave_sum(s) * (1.0f / D) + EPS);
}
__device__ __forceinline__ void norm_mod(const f32x4 (&v)[4], float rstd, const float* g, const float* shift, const float* scale, int lane, f32x4 (&h)[4]) {
#pragma unroll
    for (int j = 0; j < 4; ++j) {
        const f32x4 gg = ((const f32x4*)g)[lane + 64 * j], sh = ((const f32x4*)shift)[lane + 64 * j], sc = ((const f32x4*)scale)[lane + 64 * j];
        h[j] = (v[j] * rstd) * gg * (sc + 1.0f) + sh;
    }
}

__device__ __forceinline__ void tr_item(const float* W, int N, int k0, int n0, bf16* WT, size_t drow0, int dK, LAS float* scr, int lane, int hi_skip = 0) {
    const int nq = lane & 15, kr = lane >> 4;
#pragma unroll
    for (int i = 0; i < 16; ++i) { const int kk = 4 * i + kr; const f32x4 v = *(const f32x4*)(W + (size_t)(k0 + kk) * N + n0 + 4 * nq);
        LAS float* d = scr + kk * 65 + 4 * nq; d[0] = v.x; d[1] = v.y; d[2] = v.z; d[3] = v.w; }
    LDS_WAIT(); asm volatile("" ::: "memory");
    const int c = lane & 7;
#pragma unroll
    for (int j = 0; j < 8; ++j) { const int n = (lane >> 3) + 8 * j; const LAS float* s = scr + (8 * c) * 65 + n;
        u32x4 o; o.x = cvtpk(s[0 * 65], s[1 * 65]); o.y = cvtpk(s[2 * 65], s[3 * 65]); o.z = cvtpk(s[4 * 65], s[5 * 65]); o.w = cvtpk(s[6 * 65], s[7 * 65]);
        *(u32x4*)(WT + (drow0 + n + (n >= 32 ? hi_skip : 0)) * dK + k0 + 8 * c) = o; }
    LDS_WAIT(); asm volatile("" ::: "memory");
}
__device__ __forceinline__ void tr_item8(const float* W, int N, int k0, int n0, unsigned char* WT, size_t drow0, int dKb, LAS float* scr, int lane, float scale, int hi_skip = 0) {
    const int nq = lane & 15, kr = lane >> 4;
#pragma unroll
    for (int i = 0; i < 16; ++i) { const int kk = 4 * i + kr; const f32x4 v = *(const f32x4*)(W + (size_t)(k0 + kk) * N + n0 + 4 * nq);
        LAS float* d = scr + kk * 65 + 4 * nq; d[0] = v.x; d[1] = v.y; d[2] = v.z; d[3] = v.w; }
    LDS_WAIT(); asm volatile("" ::: "memory");
    const int c = lane & 3;
#pragma unroll
    for (int j = 0; j < 4; ++j) { const int n = (lane >> 2) + 16 * j; const LAS float* s = scr + (16 * c) * 65 + n;
        u32x4 o; o.x = pk_fp8x4(s[0 * 65] * scale, s[1 * 65] * scale, s[2 * 65] * scale, s[3 * 65] * scale); o.y = pk_fp8x4(s[4 * 65] * scale, s[5 * 65] * scale, s[6 * 65] * scale, s[7 * 65] * scale);
        o.z = pk_fp8x4(s[8 * 65] * scale, s[9 * 65] * scale, s[10 * 65] * scale, s[11 * 65] * scale); o.w = pk_fp8x4(s[12 * 65] * scale, s[13 * 65] * scale, s[14 * 65] * scale, s[15 * 65] * scale);
        *(u32x4*)(WT + (drow0 + n + (n >= 32 ? hi_skip : 0)) * dKb + k0 + 16 * c) = o; }
    LDS_WAIT(); asm volatile("" ::: "memory");
}
struct TrD { const float* src; int N; unsigned char* dst; int dKb, drow0, hi_skip, fp8; };
__device__ __forceinline__ void tr_load(const TrD& d, f32x4 (&v)[16], int lane) {
    const int nq = lane & 15, kr = lane >> 4;
#pragma unroll
    for (int i = 0; i < 16; ++i) v[i] = *(const f32x4*)(d.src + (size_t)(4 * i + kr) * d.N + 4 * nq);
}
__device__ __forceinline__ void tr_store(const TrD& d, const f32x4 (&v)[16], LAS float* scr, int lane) {
    const int nq = lane & 15, kr = lane >> 4;
#pragma unroll
    for (int i = 0; i < 16; ++i) { LAS float* p = scr + (4 * i + kr) * 65 + 4 * nq; p[0] = v[i].x; p[1] = v[i].y; p[2] = v[i].z; p[3] = v[i].w; }
    LDS_WAIT(); asm volatile("" ::: "memory");
    if (d.fp8) { const int c = lane & 3; const float scale = (float)(1 << MOE_WSH);
#pragma unroll
        for (int j = 0; j < 4; ++j) { const int n = (lane >> 2) + 16 * j; const LAS float* s = scr + (16 * c) * 65 + n;
            u32x4 o; o.x = pk_fp8x4(s[0 * 65] * scale, s[1 * 65] * scale, s[2 * 65] * scale, s[3 * 65] * scale); o.y = pk_fp8x4(s[4 * 65] * scale, s[5 * 65] * scale, s[6 * 65] * scale, s[7 * 65] * scale);
            o.z = pk_fp8x4(s[8 * 65] * scale, s[9 * 65] * scale, s[10 * 65] * scale, s[11 * 65] * scale); o.w = pk_fp8x4(s[12 * 65] * scale, s[13 * 65] * scale, s[14 * 65] * scale, s[15 * 65] * scale);
            *(u32x4*)(d.dst + (size_t)(d.drow0 + n + (n >= 32 ? d.hi_skip : 0)) * d.dKb + 16 * c) = o; } }
    else { const int c = lane & 7;
#pragma unroll
        for (int j = 0; j < 8; ++j) { const int n = (lane >> 3) + 8 * j; const LAS float* s = scr + (8 * c) * 65 + n;
            u32x4 o; o.x = cvtpk(s[0 * 65], s[1 * 65]); o.y = cvtpk(s[2 * 65], s[3 * 65]); o.z = cvtpk(s[4 * 65], s[5 * 65]); o.w = cvtpk(s[6 * 65], s[7 * 65]);
            *(u32x4*)(d.dst + (size_t)(d.drow0 + n + (n >= 32 ? d.hi_skip : 0)) * d.dKb + 16 * c) = o; } }
    LDS_WAIT(); asm volatile("" ::: "memory");
}
constexpr int TR_I0 = 2 * 384, TR_I1 = 2 * 256, TR_I2 = 4 * 16, TR_I3 = 16 * 81, TR_I4 = 32 * 16, TR_I5 = 128 * 256, TR_I6 = 128 * 128, TR_ITOT = TR_I0 + TR_I1 + TR_I2 + TR_I3 + TR_I4 + TR_I5 + TR_I6;
__device__ __forceinline__ TrD tr_decode(const Args& a, int it) {
    TrD d; int r = it; d.hi_skip = 0;
    if (r < TR_I5) { const int m = r / 256, q = r % 256, kb = 2 * (q >> 5) + (q & 1), nb = (q >> 1) & 15, n0 = nb * 64, j = n0 & 511;
        d.src = a.in[I_WGU] + (size_t)m * 1024 * 1024 + (size_t)kb * 64 * 1024 + n0; d.N = 1024; d.drow0 = 256 * (j >> 7) + (j & 127) + ((n0 >= 512) ? 128 : 0);
        d.fp8 = MOE_FP8; d.dKb = MOE_FP8 ? 1024 : 2048; d.dst = (unsigned char*)(a.ws + WS_WGU) + (size_t)m * 1024 * d.dKb + (size_t)kb * 64 * (MOE_FP8 ? 1 : 2); return d; }
    r -= TR_I5;
    if (r < TR_I6) { const int m = r / 128, q = r % 128, kb = 2 * (q >> 5) + (q & 1), nb = (q >> 1) & 15;
        d.src = a.in[I_WDN] + (size_t)m * 512 * 1024 + (size_t)kb * 64 * 1024 + nb * 64; d.N = 1024; d.drow0 = nb * 64;
        d.fp8 = MOE_FP8; d.dKb = MOE_FP8 ? 512 : 1024; d.dst = (unsigned char*)(a.ws + WS_WDN) + (size_t)m * 1024 * d.dKb + (size_t)kb * 64 * (MOE_FP8 ? 1 : 2); return d; }
    r -= TR_I6;
    if (r < TR_I0) { const int m = r / 384, q = r % 384, kb = q / 24, nb = q % 24;
        d.src = a.in[I_WQKV] + (size_t)m * 1024 * 1536 + (size_t)kb * 64 * 1536 + nb * 64; d.N = 1536; d.drow0 = (nb >> 2) * 256 + (nb & 3) * 32; d.hi_skip = 96;
        d.fp8 = ATT_FP8; d.dKb = ATT_FP8 ? 1024 : 2048; d.dst = (unsigned char*)(a.ws + WS_WQKV) + (size_t)m * 1536 * d.dKb + (size_t)kb * 64 * (ATT_FP8 ? 1 : 2); return d; }
    r -= TR_I0;
    if (r < TR_I1) { const int m = r / 256, q = r % 256, kb = q / 16, nb = q % 16;
        d.src = a.in[I_WO] + (size_t)m * 1024 * 1024 + (size_t)kb * 64 * 1024 + nb * 64; d.N = 1024; d.drow0 = nb * 64;
        d.fp8 = ATT_FP8; d.dKb = ATT_FP8 ? 1024 : 2048; d.dst = (unsigned char*)(a.ws + WS_WO) + (size_t)m * 1024 * d.dKb + (size_t)kb * 64 * (ATT_FP8 ? 1 : 2); return d; }
    r -= TR_I1;
    d.fp8 = 0;
    if (r < TR_I2) { const int m = r / 16, q = r % 16, kb = q / 4, nb = q % 4;
        d.src = a.in[I_POOLW] + (size_t)m * 256 * 256 + (size_t)kb * 64 * 256 + nb * 64; d.N = 256; d.drow0 = nb * 64; d.dKb = 512; d.dst = (unsigned char*)(a.ws + WS_WPOOL) + (size_t)m * 256 * 512 + (size_t)kb * 128; return d; }
    r -= TR_I2;
    if (r < TR_I3) { const int kb = r / 81, nb = r % 81;
        d.src = a.in[I_WIN] + (size_t)kb * 64 * 5184 + nb * 64; d.N = 5184; d.drow0 = nb * 64; d.fp8 = SSD_FP8; d.dKb = SSD_FP8 ? 1024 : 2048; d.dst = (unsigned char*)(a.ws + WS_WIN) + (size_t)kb * 64 * (SSD_FP8 ? 1 : 2); return d; }
    r -= TR_I3;
    { const int kb = r / 16, nb = r % 16;
        d.src = a.in[I_WOUT] + (size_t)kb * 64 * 1024 + nb * 64; d.N = 1024; d.drow0 = nb * 64; d.dKb = 4096; d.dst = (unsigned char*)(a.ws + WS_WOUT) + (size_t)kb * 128; return d; }
}
__device__ __forceinline__ void p0_prologue(const Args& a, const Ctx& c) {
    LAS float* scr = (LAS float*)(c.lds + c.wave * 16896);
    const int gw = c.vcu * NWAVES + c.wave, NGW = c.G * NWAVES;
    { f32x4 va[16], vb[16]; TrD da, db;
      LAS int* tslot = (LAS int*)(c.lds + NWAVES * 16896); unsigned* tctr = (unsigned*)(a.ws + WS_CTL) + CW_P0T; unsigned pend = 0u;
      if (c.tid == 0) pend = __hip_atomic_fetch_add(tctr, 1u, __ATOMIC_RELAXED, __HIP_MEMORY_SCOPE_AGENT);
#define P0_TAKE(par, tv) do { if (c.tid == 0) { tslot[par] = (int)pend; pend = __hip_atomic_fetch_add(tctr, 1u, __ATOMIC_RELAXED, __HIP_MEMORY_SCOPE_AGENT); } __syncthreads(); tv = tslot[par]; } while (0)
      int tA, tB; P0_TAKE(0, tA);
      int idA = tA * 8 + c.wave, idB; da = tr_decode(a, idA < TR_ITOT ? idA : TR_ITOT - 1); tr_load(da, va, c.lane);
      for (;;) {
          if (tA * 8 >= TR_ITOT) break;
          P0_TAKE(1, tB); idB = tB * 8 + c.wave; db = tr_decode(a, idB < TR_ITOT ? idB : TR_ITOT - 1); tr_load(db, vb, c.lane);
          if (idA < TR_ITOT) tr_store(da, va, scr, c.lane);
          if (tB * 8 >= TR_ITOT) break;
          P0_TAKE(0, tA); idA = tA * 8 + c.wave; da = tr_decode(a, idA < TR_ITOT ? idA : TR_ITOT - 1); tr_load(da, va, c.lane);
          if (idB < TR_ITOT) tr_store(db, vb, scr, c.lane); }
#undef P0_TAKE
    }
    __syncthreads();
    LAS float* sv = (LAS float*)c.lds;
    LAS float* part = (LAS float*)(c.lds + 20480);
    for (int u = c.tid; u < 5 * 1024; u += NTHREADS) { const int v = u >> 10, k = u & 1023; const float x = v < 4 ? a.in[I_C][v * 1024 + k] : a.in[I_CCTX][k]; sv[u] = x / (1.0f + expf(-x)); }
    __syncthreads();
    for (int item = blockIdx.x; item < 4 * 64; item += c.G) {
        const int li = item >> 6, c0 = (item & 63) * 96, cq = c.tid % 24, ks = c.tid / 24;
        f32x4 acc[5];
#pragma unroll
        for (int v = 0; v < 5; ++v) acc[v] = (f32x4){0.f, 0.f, 0.f, 0.f};
        if (ks < 21) { const int kbeg = ks * 49, kend = (kbeg + 49) < 1024 ? (kbeg + 49) : 1024;
            const float* w = a.in[I_WADA] + ((size_t)li * 1024 + kbeg) * 6144 + c0 + 4 * cq;
#pragma unroll 7
            for (int k = kbeg; k < kend; ++k) { const f32x4 wv = *(const f32x4*)w; w += 6144;
#pragma unroll
                for (int v = 0; v < 5; ++v) acc[v] += wv * sv[v * 1024 + k]; }
#pragma unroll
            for (int v = 0; v < 5; ++v) *(LAS f32x4*)(part + (ks * 24 + cq) * 20 + v * 4) = acc[v]; }
        __syncthreads();
        if (c.tid < 480) { const int v = c.tid / 96, col = c.tid % 96, q = col >> 2, e = col & 3; float s = 0.f;
            for (int k2 = 0; k2 < 21; ++k2) s += part[(k2 * 24 + q) * 20 + v * 4 + e];
            s += a.in[I_BADA][li * 6144 + c0 + col];
            if (v < 4) ((float*)(a.ws + WS_MODL))[(size_t)(li * 4 + v) * 6144 + c0 + col] = s; else ((float*)(a.ws + WS_MODC))[(size_t)li * 6144 + c0 + col] = s; }
        __syncthreads();
    }
    if (blockIdx.x == (unsigned)(c.G - 1)) for (int u = c.tid; u < 1024; u += NTHREADS) { const int pos = u >> 4, f = u & 15;
        const float inv = (float)pow(10000.0, -(double)f / 16.0); const double ang = (double)((float)pos * inv);
        ((f32x2*)(a.ws + WS_ROPE))[u] = (f32x2){(float)cos(ang), (float)sin(ang)}; }
    for (int u = blockIdx.x * NTHREADS + c.tid; u < 4 * 64 * 1024; u += c.G * NTHREADS) { const int li = u >> 16, n = (u >> 10) & 63, k = u & 1023;
        float w = 0.f; if (n < 4) w = a.in[I_WRG][((size_t)li * 1024 + k) * 4 + n]; else if (n < 36) w = a.in[I_WRE][((size_t)li * 1024 + k) * 32 + (n - 4)];
        const unsigned hi = cvtpk(w, 0.f) & 0xffffu; const float rem = w - bflo(hi); const unsigned lo = cvtpk(rem, 0.f) & 0xffffu;
        bf16* wr = (bf16*)(a.ws + WS_WR) + (size_t)li * 2 * 65536;
        const int fo = (((k >> 7) * 8 + ((k >> 4) & 7)) * 4 + (n >> 5)) * 512 + ((n & 31) + 32 * ((k >> 3) & 1)) * 8 + (k & 7);
        wr[fo] = (bf16)hi; wr[fo + 1024] = (bf16)lo; }
}

__device__ __forceinline__ void ph_rmix(const Args& a, const Ctx& c, int layer) {
    const int gw = c.vcu * NWAVES + c.wave, NGW = c.G * NWAVES;
    const float* g = a.in[I_NMIX] + layer * D;
    for (int r = gw; r < TT; r += NGW) {
        f32x4 v[4], h[4]; load_row_combined(a, layer, r, c.lane, v);
        if (layer > 0) { u32x2* xo = (u32x2*)((bf16*)(a.ws + WS_X) + (size_t)r * D) + c.lane;
#pragma unroll
            for (int j = 0; j < 4; ++j) xo[64 * j] = (u32x2){cvtpk(v[j].x, v[j].y), cvtpk(v[j].z, v[j].w)}; }
        const float rstd = row_rstd(v); const float* m = mod_row(a, layer, r);
        norm_mod(v, rstd, g, m, m + D, c.lane, h);
        if ((ATT_FP8 && layer != 2) || (SSD_FP8 && layer == 2)) { unsigned* ho8 = (unsigned*)((unsigned char*)(a.ws + WS_HB) + (size_t)r * D) + c.lane;
#pragma unroll
            for (int j = 0; j < 4; ++j) ho8[64 * j] = pk_fp8x4(h[j].x, h[j].y, h[j].z, h[j].w); }
        else { u32x2* ho = (u32x2*)((bf16*)(a.ws + WS_HB) + (size_t)r * D) + c.lane;
#pragma unroll
            for (int j = 0; j < 4; ++j) ho[64 * j] = (u32x2){cvtpk(h[j].x, h[j].y), cvtpk(h[j].z, h[j].w)}; }
    }
}

__device__ __forceinline__ void ph_final(const Args& a, const Ctx& c, int layer) {
    const int gw = c.vcu * NWAVES + c.wave, NGW = c.G * NWAVES;
    float dscale = 1.f, dmark = 0.f;
#if DEBUG_CHECKS
    { unsigned* dbg = (unsigned*)(a.ws + WS_CTL) + CW_DBG; int code = 0; float mag = 0.f;
      for (int id = 1; id < 32; ++id) { const float e = __uint_as_float(__hip_atomic_load(dbg + id, __ATOMIC_RELAXED, __HIP_MEMORY_SCOPE_AGENT)); if (code == 0 && e > DBG_TOL) { code = id; mag = e; } }
      dscale = 1.f + (float)code; dmark = code ? 100.f * (1.f + fminf(fmaxf(log2f(mag / DBG_TOL), 0.f), 30.f)) : 0.f; }
#endif
    for (int r = gw; r < TL; r += NGW) {
        f32x4 v[4]; load_row_combined(a, layer, r, c.lane, v);
        const float rstd = row_rstd(v) * dscale;
        f32x4* o = (f32x4*)(a.out + (size_t)r * D) + c.lane;
#pragma unroll
        for (int j = 0; j < 4; ++j) { f32x4 ov = (v[j] * rstd) * ((const f32x4*)a.in[I_NFIN])[c.lane + 64 * j]; if (j == 0 && r == 0 && c.lane == 0 && dmark > 0.f) ov.x = dmark; o[64 * j] = ov; }
    }
}


namespace pg8 {
constexpr int BM = 256, BK = 64, HALF = 128, HTB = HALF * BK * 2, STAGE_BYTES = 8 * HTB;
__host__ __device__ __forceinline__ int lds_byte(int r, int c) { const int st = (r >> 4) * 2 + (c >> 5), rr = r & 15, cc = c & 31, ob = rr * 64 + cc * 2; return st * 1024 + (ob ^ (((ob >> 9) & 1) << 5)); }
__host__ __device__ __forceinline__ void stage_rc(int b, int& R, int& C) { const int st = b / 1024, sb = b % 1024, swz = sb ^ (((sb >> 9) & 1) << 5); R = (st >> 1) * 16 + swz / 64; C = (st & 1) * 32 + (swz % 64) / 2; }
__host__ __device__ __forceinline__ int perm32(int rho) { const int n = rho >> 4, i = rho & 15; return 8 * (i >> 2) + 4 * n + (i & 3); }
struct Unit { const char* A; const char* B; int pm, pn, x0, x1; };
__device__ __forceinline__ void tile_of(int L, int nM, int nN, int& pm, int& pn) {
    const int nwg = nM * nN; int wgid = L; { const int q = nwg / 8, r = nwg % 8, xcd = wgid % 8, off = wgid / 8; wgid = (xcd < r ? xcd * (q + 1) : r * (q + 1) + (xcd - r) * q) + off; }
    const int nig = 8 * nN, gid = wgid / nig, fm = gid * 8, gsz = (nM - fm) < 8 ? (nM - fm) : 8;
    pm = fm + ((wgid % nig) % gsz); pn = (wgid % nig) / gsz;
}
typedef int v4i_t __attribute__((ext_vector_type(4))); typedef int v8i_t __attribute__((ext_vector_type(8)));
template <class Epi, class Sched, bool GATHER, bool FP8 = false>
__device__ __forceinline__ void gemm_phase(LAS unsigned char* lds, const int Kb, const int ldab, const Sched& S, const Epi& E, const int scw = 127, const int sca = 127) {
    const int tid = tid_opaque(), wid = __builtin_amdgcn_readfirstlane(tid >> 6), lane = tid & 63, wr = wid >> 2, wc = wid & 3, fr = lane & 15, fq = lane >> 4;
    const int nt = Kb / (BK * 2);
    int scw_v = scw, sca_v = sca;
    unsigned voffA[2], voffB[2]; int RA[2], CA[2];
#pragma unroll
    for (int i = 0; i < 2; ++i) { int R, C; stage_rc(tid * 16 + i * 8192, R, C); const int Rb = Epi::PERM ? ((R & ~31) + perm32(R & 31)) : R;
        RA[i] = R; CA[i] = C; voffA[i] = (unsigned)(R * ldab + C * 2); voffB[i] = (unsigned)(Rb * Kb + C * 2); }
    const size_t kstep = (size_t)(BK * 2);
    const size_t hstepA = (size_t)HALF * ldab, hstepB = (size_t)HALF * Kb;
    const unsigned ldsw = (unsigned)wid * 1024u;
    const int aoff = lds_byte(wr * 64 + fr, fq * 8), boff = lds_byte(wc * 32 + fr, fq * 8);
#define PG8_SA(b, h) (((b) * 2 + (h)) * HTB)
#define PG8_SB(b, h) ((4 + (b) * 2 + (h)) * HTB)
#define PG8_GLDS(bufoff, gptr, i_) __builtin_amdgcn_global_load_lds((const unsigned*)(gptr), (LAS unsigned*)(lds + (bufoff) + ldsw + (i_) * 8192), 16, 0, 0)
#define PG8_STAGE_B(bufoff, gbase) do { _Pragma("unroll") for (int _i = 0; _i < 2; ++_i) PG8_GLDS(bufoff, (const char*)(gbase) + voffB[_i], _i); } while (0)
#define PG8_STAGE_A(bufoff, ab, kb, h, NX) do { _Pragma("unroll") for (int _i = 0; _i < 2; ++_i) { \
        if constexpr (GATHER) { const unsigned _vo = (NX) ? voN[h][_i] : voC[h][_i]; PG8_GLDS(bufoff, (ab) + (kb) + _vo, _i); } \
        else { PG8_GLDS(bufoff, (ab) + (kb) + (size_t)(h) * hstepA + voffA[_i], _i); } } } while (0)
#define PG8_LDA(dst, b, h) do { _Pragma("unroll") for (int m = 0; m < 4; ++m) _Pragma("unroll") for (int k = 0; k < 2; ++k) dst[m][k] = *(const LAS bf16x8*)(lds + PG8_SA(b, h) + aoff + m * 2048 + k * 1024); } while (0)
#define PG8_LDB(dst, b, h) do { _Pragma("unroll") for (int n = 0; n < 2; ++n) _Pragma("unroll") for (int k = 0; k < 2; ++k) dst[n][k] = *(const LAS bf16x8*)(lds + PG8_SB(b, h) + boff + n * 2048 + k * 1024); } while (0)
#define PG8_MMA(ai, bj, At, Bt) do { __builtin_amdgcn_s_setprio(1); _Pragma("unroll") for (int m = 0; m < 4; ++m) _Pragma("unroll") for (int n = 0; n < 2; ++n) { \
        if constexpr (FP8) { const v8i_t b8 = __builtin_shufflevector(__builtin_bit_cast(v4i_t, Bt[n][0]), __builtin_bit_cast(v4i_t, Bt[n][1]), 0, 1, 2, 3, 4, 5, 6, 7), a8 = __builtin_shufflevector(__builtin_bit_cast(v4i_t, At[m][0]), __builtin_bit_cast(v4i_t, At[m][1]), 0, 1, 2, 3, 4, 5, 6, 7); \
            asm volatile("v_mfma_scale_f32_16x16x128_f8f6f4 %0, %1, %2, %0, %3, %4 op_sel_hi:[0,0,0]" : "+v"(acc[ai][bj][m][n]) : "v"(b8), "v"(a8), "v"(scw_v), "v"(sca_v)); } \
        else { _Pragma("unroll") for (int k = 0; k < 2; ++k) acc[ai][bj][m][n] = __builtin_amdgcn_mfma_f32_16x16x32_bf16(Bt[n][k], At[m][k], acc[ai][bj][m][n], 0, 0, 0); } } __builtin_amdgcn_s_setprio(0); } while (0)
#define PG8_WAIT_V(n) asm volatile("s_waitcnt vmcnt(" #n ")" ::: "memory")
#define PG8_WAIT_L(n) asm volatile("s_waitcnt lgkmcnt(" #n ")" ::: "memory")
#define PG8_BAR __builtin_amdgcn_s_barrier()
#define PG8_SCHED __builtin_amdgcn_sched_barrier(0)
    Unit cur, nxt, pend; int ui = 0; bool have_pend = false;
    if (!S.next(0, cur)) return;
    pend = cur;
    unsigned voC[2][2], voN[2][2];
    if constexpr (GATHER) {
#pragma unroll
        for (int h = 0; h < 2; ++h)
#pragma unroll
            for (int i = 0; i < 2; ++i) { voC[h][i] = (unsigned)(S.gather(cur, h * HALF + RA[i]) * ldab + CA[i] * 2); voN[h][i] = voC[h][i]; }
    } else { voC[0][0] = voN[0][0] = 0u; }
    f32x4 acc[2][2][4][2];
#pragma unroll
    for (int a = 0; a < 2; ++a)
#pragma unroll
        for (int b = 0; b < 2; ++b)
#pragma unroll
            for (int m = 0; m < 4; ++m)
#pragma unroll
                for (int n = 0; n < 2; ++n) acc[a][b][m][n] = (f32x4){0.f, 0.f, 0.f, 0.f};
    bf16x8 At[4][2], B0[2][2], B1[2][2];
    const char* cA = cur.A; const char* cB = cur.B;
    S.a_ready(cur, wid);
    PG8_STAGE_B(PG8_SB(0, 0), cB); PG8_STAGE_B(PG8_SB(0, 1), cB + hstepB); PG8_STAGE_A(PG8_SA(0, 0), cA, (size_t)0, 0, false); PG8_STAGE_A(PG8_SA(0, 1), cA, (size_t)0, 1, false);
    if (wr == 1) PG8_BAR;
    PG8_WAIT_V(2); PG8_BAR;
    PG8_STAGE_B(PG8_SB(1, 0), cB + kstep); PG8_STAGE_A(PG8_SA(1, 0), cA, kstep, 0, false); PG8_STAGE_B(PG8_SB(1, 1), cB + hstepB + kstep);
    PG8_WAIT_V(6); PG8_BAR;
    for (;;) {
        const bool has_next = S.next(ui + 1, nxt);
        if constexpr (GATHER) { if (has_next) {
#pragma unroll
            for (int h = 0; h < 2; ++h)
#pragma unroll
                for (int i = 0; i < 2; ++i) voN[h][i] = (unsigned)(S.gather(nxt, h * HALF + RA[i]) * ldab + CA[i] * 2); } }
        const char* nA = has_next ? nxt.A : cA; const char* nB = has_next ? nxt.B : cB;
        for (int t = 0; t < nt; t += 2) {
            const bool last = (t == nt - 2);
            if constexpr (Sched::KSCALE) { if (t != 0 && (t & 7) == 0) S.kscale(acc, cur, t >> 3, wr); }
            const size_t k1 = (size_t)(t + 1) * kstep;
            const char* a2 = last ? nA : cA; const size_t k2 = last ? (size_t)0 : (size_t)(t + 2) * kstep; const size_t k3 = k2 + kstep;
            const char* b2 = last ? nB : cB + (size_t)(t + 2) * kstep; const char* b3 = b2 + kstep;
            const bool nx = GATHER ? (last && has_next) : false;
            if (last && has_next) S.a_ready(nxt, wid);
            PG8_LDB(B0, 0, 0); PG8_LDB(B1, 0, 1); PG8_SCHED; PG8_LDA(At, 0, 0); PG8_STAGE_A(PG8_SA(1, 1), cA, k1, 1, false);
            PG8_WAIT_V(8); PG8_WAIT_L(0); PG8_BAR; PG8_MMA(0, 0, At, B0); PG8_MMA(0, 1, At, B1); PG8_BAR; PG8_SCHED;
            PG8_LDA(At, 0, 1); PG8_STAGE_B(PG8_SB(0, 0), b2); PG8_STAGE_B(PG8_SB(0, 1), b2 + hstepB); PG8_STAGE_A(PG8_SA(0, 0), a2, k2, 0, nx);
            PG8_WAIT_V(8); PG8_WAIT_L(0);
            if constexpr (!Sched::IMM_DONE) { if (have_pend) { S.done(pend, lane); have_pend = false; } }
            PG8_BAR; PG8_MMA(1, 0, At, B0); PG8_MMA(1, 1, At, B1); PG8_BAR; PG8_SCHED;
            PG8_LDB(B0, 1, 0); PG8_LDB(B1, 1, 1); PG8_SCHED; PG8_LDA(At, 1, 0); PG8_STAGE_A(PG8_SA(0, 1), a2, k2, 1, nx);
            PG8_WAIT_V(8); PG8_WAIT_L(0); PG8_BAR; PG8_MMA(0, 0, At, B0); PG8_MMA(0, 1, At, B1); PG8_BAR; PG8_SCHED;
            PG8_LDA(At, 1, 1); PG8_STAGE_B(PG8_SB(1, 0), b3); PG8_STAGE_B(PG8_SB(1, 1), b3 + hstepB); PG8_STAGE_A(PG8_SA(1, 0), a2, k3, 0, nx);
            PG8_WAIT_V(8); PG8_WAIT_L(0); PG8_BAR; PG8_MMA(1, 0, At, B0); PG8_MMA(1, 1, At, B1); PG8_BAR; PG8_SCHED;
        }
        if (wr == 0) PG8_BAR;
        if constexpr (FP8) asm volatile("s_nop 15\n\ts_nop 15" ::: "memory");
        E(acc, cur, wr, wc, fr, fq);
        if constexpr (Sched::IMM_DONE) { PG8_WAIT_V(0); S.done(cur, lane); }
        else { pend = cur; have_pend = true; }
        if (!has_next) break;
#pragma unroll
        for (int a = 0; a < 2; ++a)
#pragma unroll
            for (int b = 0; b < 2; ++b)
#pragma unroll
                for (int m = 0; m < 4; ++m)
#pragma unroll
                    for (int n = 0; n < 2; ++n) acc[a][b][m][n] = (f32x4){0.f, 0.f, 0.f, 0.f};
        cur = nxt; cA = nA; cB = nB; ++ui;
        if constexpr (GATHER) {
#pragma unroll
            for (int h = 0; h < 2; ++h)
#pragma unroll
                for (int i = 0; i < 2; ++i) voC[h][i] = voN[h][i]; }
        if (wr == 1) PG8_BAR;
    }
    PG8_WAIT_V(0);
    if constexpr (!Sched::IMM_DONE) { if (have_pend) S.done(pend, lane); }
    PG8_BAR;
#undef PG8_SA
#undef PG8_SB
#undef PG8_GLDS
#undef PG8_STAGE_A
#undef PG8_STAGE_B
#undef PG8_LDA
#undef PG8_LDB
#undef PG8_MMA
#undef PG8_WAIT_V
#undef PG8_WAIT_L
#undef PG8_BAR
#undef PG8_SCHED
}
}
#include <hip/hip_bf16.h>
#include <cmath>
namespace attn_body {
using bf16=__hip_bfloat16;
using bf16x8=__attribute__((ext_vector_type(8)))short;
using s16x4=__attribute__((ext_vector_type(4)))short;
using f32x16=__attribute__((ext_vector_type(16)))float;
using u32x4=__attribute__((ext_vector_type(4)))unsigned;
constexpr int D=64,QP=1024,KVP=256;
constexpr int NW=8,QBLK=32,QB=QBLK*NW,KVBLK=64;
__device__ __forceinline__ int crow(int r,int hi){return (r&3)+8*(r>>2)+4*hi;}
#define SBAR() __builtin_amdgcn_sched_barrier(0)
constexpr int NSLOT=3, SLOTB=8192;
constexpr int LDS_K=0, LDS_V=NSLOT*SLOTB, LDS_WS=2*NSLOT*SLOTB, LDS_OST=LDS_WS+NW*64*4, LDS_BYTES=LDS_OST+NW*4096;
constexpr float C2=0.125f*1.4426950408889634f;
__device__ __forceinline__ void glds16s(const void*sbase,unsigned voff,unsigned lds_dst){unsigned keep;
  asm volatile("s_mov_b32 %0, m0\n\ts_mov_b32 m0, %3\n\ts_nop 4\n\tglobal_load_lds_dwordx4 %1, %2\n\ts_mov_b32 m0, %0":"=&s"(keep):"v"(voff),"s"(sbase),"s"(lds_dst):"memory");}
__device__ __forceinline__ float max3f(float a,float b,float c){float r;asm("v_max3_f32 %0, %1, %2, %3":"=v"(r):"v"(a),"v"(b),"v"(c));return r;}
__device__ __forceinline__ float max2f(float a,float b){float r;asm("v_max_f32_e32 %0, %1, %2":"=v"(r):"v"(a),"v"(b));return r;}
__device__ __forceinline__ float fadd_s(float a,float b){float r;asm("v_add_f32_e32 %0, %1, %2":"=v"(r):"v"(a),"v"(b));return r;}
__device__ __forceinline__ float fsub_s(float a,float b){float r;asm("v_sub_f32_e32 %0, %1, %2":"=v"(r):"v"(a),"v"(b));return r;}
typedef float f32x2_t __attribute__((ext_vector_type(2))); typedef __bf16 bf16x2_t __attribute__((ext_vector_type(2)));
__device__ __forceinline__ unsigned cvtpk_s(float lo,float hi){f32x2_t v={lo,hi};bf16x2_t b=__builtin_convertvector(v,bf16x2_t);return __builtin_bit_cast(unsigned,b);}
#define WAIT_BAR(N) asm volatile("s_waitcnt vmcnt(" #N ") lgkmcnt(0)\n\ts_barrier":::"memory")

__device__ __forceinline__ void qkt(f32x16&p0,f32x16&p1,const char*Kslot,const bf16x8*qr,const f32x16&negm,int r32,int hi){
  const char*kb=Kslot+hi*1024+r32*16;
  #pragma unroll
  for(int d0=0;d0<4;++d0){
    const bf16x8 b0=*reinterpret_cast<const bf16x8*>(kb+d0*2048);
    const bf16x8 b1=*reinterpret_cast<const bf16x8*>(kb+d0*2048+512);
    if(d0==0){p0=__builtin_amdgcn_mfma_f32_32x32x16_bf16(b0,qr[0],negm,0,0,0);p1=__builtin_amdgcn_mfma_f32_32x32x16_bf16(b1,qr[0],negm,0,0,0);}
    else{p0=__builtin_amdgcn_mfma_f32_32x32x16_bf16(b0,qr[d0],p0,0,0,0);p1=__builtin_amdgcn_mfma_f32_32x32x16_bf16(b1,qr[d0],p1,0,0,0);}}
}
typedef __attribute__((address_space(3))) const char* lds_cptr;
typedef short v4i16_t __attribute__((ext_vector_type(4)));
__device__ __forceinline__ void kload8(bf16x8*kf,lds_cptr kp){
  kf[0]=*(const __attribute__((address_space(3))) bf16x8*)(kp);      kf[1]=*(const __attribute__((address_space(3))) bf16x8*)(kp+512);
  kf[2]=*(const __attribute__((address_space(3))) bf16x8*)(kp+2048); kf[3]=*(const __attribute__((address_space(3))) bf16x8*)(kp+2560);
  kf[4]=*(const __attribute__((address_space(3))) bf16x8*)(kp+4096); kf[5]=*(const __attribute__((address_space(3))) bf16x8*)(kp+4608);
  kf[6]=*(const __attribute__((address_space(3))) bf16x8*)(kp+6144); kf[7]=*(const __attribute__((address_space(3))) bf16x8*)(kp+6656);
}
__device__ __forceinline__ void kload2(bf16x8*kf,lds_cptr kp,int j){ kf[2*j]=*(const __attribute__((address_space(3))) bf16x8*)(kp+j*2048); kf[2*j+1]=*(const __attribute__((address_space(3))) bf16x8*)(kp+j*2048+512); }
__device__ __forceinline__ s16x4 vtr(lds_cptr p){ return __builtin_bit_cast(s16x4,__builtin_amdgcn_ds_read_tr16_b64_v4i16((__attribute__((address_space(3))) v4i16_t*)p)); }
__device__ __forceinline__ float rowmax(const f32x16&p0,const f32x16&p1){
  float a=max3f(p0[0],p0[1],p1[0]),b=max3f(p0[2],p0[3],p1[1]);a=max3f(a,p1[2],p1[3]);
  #pragma unroll
  for(int r=4;r<16;r+=4){a=max3f(a,p0[r],p0[r+1]);b=max3f(b,p0[r+2],p0[r+3]);a=max3f(a,p1[r],p1[r+1]);b=max3f(b,p1[r+2],p1[r+3]);}
  const float m=max2f(a,b);
  auto rr=__builtin_amdgcn_permlane32_swap(__float_as_uint(m),__float_as_uint(m),false,false);
  return max2f(__uint_as_float(rr[0]),__uint_as_float(rr[1]));
}
__device__ __forceinline__ void pv(f32x16*o,int vb,bf16x8 pa0,bf16x8 pa1,bf16x8 pa2,bf16x8 pa3){
  #pragma unroll
  for(int d0=0;d0<2;++d0){s16x4 lo[4],hi[4];
    #pragma unroll
    for(int ks=0;ks<4;++ks){
      asm volatile("ds_read_b64_tr_b16 %0,%1 offset:%c2":"=&v"(lo[ks]):"v"(vb),"i"(d0*4096+ks*1024):"memory");
      asm volatile("ds_read_b64_tr_b16 %0,%1 offset:%c2":"=&v"(hi[ks]):"v"(vb),"i"(d0*4096+ks*1024+512):"memory");}
    asm volatile("s_waitcnt lgkmcnt(0)":::"memory");SBAR();
    #define PK(k) (bf16x8){lo[k][0],lo[k][1],lo[k][2],lo[k][3],hi[k][0],hi[k][1],hi[k][2],hi[k][3]}
    o[d0]=__builtin_amdgcn_mfma_f32_32x32x16_bf16(pa0,PK(0),o[d0],0,0,0);
    o[d0]=__builtin_amdgcn_mfma_f32_32x32x16_bf16(pa1,PK(1),o[d0],0,0,0);
    o[d0]=__builtin_amdgcn_mfma_f32_32x32x16_bf16(pa2,PK(2),o[d0],0,0,0);
    o[d0]=__builtin_amdgcn_mfma_f32_32x32x16_bf16(pa3,PK(3),o[d0],0,0,0);
    #undef PK
  }
}

#ifndef ATTN_STORE16
#define ATTN_STORE16(p,v) (*(u32x4*)(p)=(v))
#endif
template<int THRL> __device__ __forceinline__ void attn_unit(long qrow0,int h,long kvrow0,int NT,const bf16*Q,const bf16*__restrict__ K,const bf16*__restrict__ V,bf16*O,char*shm){
  const int tid=tid_opaque(),lane=tid&63,r32=lane&31,hi=lane>>5; const int wid=__builtin_amdgcn_readfirstlane(tid>>6);
  const bf16*Qw=Q+(qrow0+wid*QBLK)*QP+h*D;
  const bf16*Kh=K+kvrow0*KVP+(h>>2)*D,*Vh=V+kvrow0*KVP+(h>>2)*D;
  const unsigned lds0=(unsigned)(uintptr_t)shm;
  float*wsf=(float*)(shm+LDS_WS)+wid*64;
  const unsigned kvo=(unsigned)(lane*KVP+wid*8)*2u;
  const unsigned vvo=(unsigned)((16*(wid&3)+(lane>>2))*KVP+(wid>>2)*32+(lane&3)*8)*2u;
  const unsigned kdst=lds0+LDS_K+wid*1024, vdst=lds0+LDS_V+wid*1024;
  #define DMA_K(t,slot) glds16s(Kh+(long)(t)*KVBLK*KVP,kvo,(unsigned)__builtin_amdgcn_readfirstlane(kdst+(slot)))
  #define DMA_V(t,slot) glds16s(Vh+(long)(t)*KVBLK*KVP,vvo,(unsigned)__builtin_amdgcn_readfirstlane(vdst+(slot)))
  const int vb0=(int)(lds0+LDS_V)+((lane>>4)&1)*32+(lane&3)*8+(4*hi+((lane&15)>>2))*64;
  const char*Kbase=shm+LDS_K; bf16x8 kf[8];
  const lds_cptr shm3=(lds_cptr)shm; const lds_cptr kp0=shm3+LDS_K+hi*1024+r32*16; const lds_cptr vp0=shm3+LDS_V+((lane>>4)&1)*32+(lane&3)*8+(4*hi+((lane&15)>>2))*64;
  DMA_K(0,0);DMA_V(0,0);DMA_K(1,SLOTB);
  bf16x8 qr[4];
  #pragma unroll
  for(int d0=0;d0<4;++d0)qr[d0]=*reinterpret_cast<const bf16x8*>(&Qw[(long)r32*QP+d0*16+hi*8]);
  float mhat=0.f,l_reg=0.f;f32x16 o[2];o[0]=f32x16{};o[1]=f32x16{};f32x16 negm=f32x16{};asm volatile("":"+v"(negm));
  #define CMASK(P0,P1,t) do{}while(0)
  bool resc=false;
  #define START(P0,P1) do{ const float rm=rowmax(P0,P1); resc=false; \
    { const float dl=rm; mhat=fadd_s(mhat,dl); \
      _Pragma("unroll") for(int r=0;r<16;++r){P0[r]=fsub_s(P0[r],dl);P1[r]=fsub_s(P1[r],dl);} \
      _Pragma("unroll") for(int r=0;r<16;++r)negm[r]=-mhat; asm volatile("":"+v"(negm)); } \
    _Pragma("unroll") for(int r=0;r<16;++r)P0[r]=__builtin_amdgcn_exp2f(P0[r]); }while(0)
  #define RESC() do{ if(resc){ asm volatile("s_waitcnt lgkmcnt(0)":::"memory"); \
      _Pragma("unroll") for(int d_=0;d_<2;++d_) _Pragma("unroll") for(int r=0;r<16;++r)o[d_][r]*=wsf[crow(r,hi)]; } }while(0)
  f32x16 pA0,pA1,pB0,pB1;
  int sl_prev=0,sl_cur=0,sl_next=SLOTB;
  #define ROT() do{sl_prev=sl_cur;sl_cur=sl_next;sl_next=(sl_next==(NSLOT-1)*SLOTB)?0:sl_next+SLOTB;}while(0)
  DMA_K(2,2*SLOTB);
  WAIT_BAR(3);
  qkt(pA0,pA1,Kbase,qr,negm,r32,hi);asm volatile("s_nop 15\n\ts_nop 7":"+v"(pA0),"+v"(pA1));CMASK(pA0,pA1,0);
  START(pA0,pA1);
  _Pragma("unroll") for(int r=0;r<16;++r)pA1[r]=__builtin_amdgcn_exp2f(pA1[r]);
  WAIT_BAR(0);
  DMA_K(3,0);DMA_V(1,SLOTB);
  ROT();
  kload8(kf,kp0+sl_cur);
  WAIT_BAR(2);
  s16x4 vlo[8],vhi[8]; u32x4 pw0,pw1,pw2,pw3;
  #define PKW(P,B) cvtpk_s(P[B],P[B+1])
  #define PAF(k) __builtin_bit_cast(bf16x8,pw##k)
  #define VFR(i) (bf16x8){vlo[i][0],vlo[i][1],vlo[i][2],vlo[i][3],vhi[i][0],vhi[i][1],vhi[i][2],vhi[i][3]}
  #define PIN(x) asm volatile("":"+v"(x))
  #define MX3(a,b,c) __builtin_fmaxf(__builtin_fmaxf((a),(b)),(c))
  #define GAPA(MF,A0,A1,A2,A3,W0,W1,PW) do{ MF; sacc+=A0; sacc+=A1; sacc+=A2; sacc+=A3; PIN(sacc); W0; W1; PIN(PW); SBAR(); }while(0)
  #define EX(v) __builtin_amdgcn_exp2f(v)
  #define GAPB(MF,X,B) do{ MF; X[B]=EX(X[B]); X[B+1]=EX(X[B+1]); X[B+2]=EX(X[B+2]); X[B+3]=EX(X[B+3]); PIN(X); SBAR(); }while(0)
  #define VRD(i) do{ vlo[i]=vtr(vp_+(((i)>>2)*4096+((i)&3)*1024)); vhi[i]=vtr(vp_+(((i)>>2)*4096+((i)&3)*1024+512)); }while(0)
  #define KRD(G,j) do{ if(G){ kload2(kf,kp0+sl_next,j); SBAR(); } }while(0)
  #define STEP(C0,C1,P0,P1,t,GK,GV,GL) do{ SBAR(); \
    const lds_cptr vp_=vp0+sl_prev; \
    VRD(0); SBAR(); float sacc=(P0[0]+P0[1]); \
    GAPA(C0=__builtin_amdgcn_mfma_f32_32x32x16_bf16(kf[0],qr[0],negm,0,0,0), P0[2],P0[3],P0[4],P0[5],     pw0[0]=PKW(P0,0), pw0[1]=PKW(P0,2), pw0); \
    VRD(4); SBAR(); GAPA(C1=__builtin_amdgcn_mfma_f32_32x32x16_bf16(kf[1],qr[0],negm,0,0,0), P0[6],P0[7],P0[8],P0[9],     pw0[2]=PKW(P0,4), pw0[3]=PKW(P0,6), pw0); \
    VRD(1); SBAR(); GAPA(C0=__builtin_amdgcn_mfma_f32_32x32x16_bf16(kf[2],qr[1],C0,0,0,0),   P0[10],P0[11],P0[12],P0[13], pw1[0]=PKW(P0,8), pw1[1]=PKW(P0,10), pw1); \
    VRD(5); SBAR(); GAPA(C1=__builtin_amdgcn_mfma_f32_32x32x16_bf16(kf[3],qr[1],C1,0,0,0),   P0[14],P0[15],P1[0],P1[1],   pw1[2]=PKW(P0,12),pw1[3]=PKW(P0,14), pw1); \
    VRD(2); SBAR(); GAPA(C0=__builtin_amdgcn_mfma_f32_32x32x16_bf16(kf[4],qr[2],C0,0,0,0),   P1[2],P1[3],P1[4],P1[5],     pw2[0]=PKW(P1,0), pw2[1]=PKW(P1,2), pw2); \
    VRD(6); SBAR(); GAPA(C1=__builtin_amdgcn_mfma_f32_32x32x16_bf16(kf[5],qr[2],C1,0,0,0),   P1[6],P1[7],P1[8],P1[9],     pw2[2]=PKW(P1,4), pw2[3]=PKW(P1,6), pw2); \
    VRD(3); SBAR(); GAPA(C0=__builtin_amdgcn_mfma_f32_32x32x16_bf16(kf[6],qr[3],C0,0,0,0),   P1[10],P1[11],P1[12],P1[13], pw3[0]=PKW(P1,8), pw3[1]=PKW(P1,10), pw3); \
    VRD(7); SBAR(); GAPA(C1=__builtin_amdgcn_mfma_f32_32x32x16_bf16(kf[7],qr[3],C1,0,0,0),   P1[14],P1[15],0.f,0.f,       pw3[2]=PKW(P1,12),pw3[3]=PKW(P1,14), pw3); \
    l_reg+=sacc; \
    if(GK){DMA_K((t)+3,sl_cur);} if(GV){DMA_V((t)+1,sl_next);} \
    CMASK(C0,C1,t); \
    { float a=MX3(C0[0],C0[1],C1[0]),b=MX3(C0[2],C0[3],C1[1]); a=MX3(a,C1[2],C1[3]); \
      _Pragma("unroll") for(int r=4;r<16;r+=4){a=MX3(a,C0[r],C0[r+1]);b=MX3(b,C0[r+2],C0[r+3]);a=MX3(a,C1[r],C1[r+1]);b=MX3(b,C1[r+2],C1[r+3]);} \
      float rm=__builtin_fmaxf(a,b); { auto rr=__builtin_amdgcn_permlane32_swap(__float_as_uint(rm),__float_as_uint(rm),false,false); rm=__builtin_fmaxf(__uint_as_float(rr[0]),__uint_as_float(rr[1])); } \
      resc=false; \
      if(__builtin_expect(__any(rm>(float)THRL),0)){ const float dl=__builtin_fmaxf(rm,0.f); mhat+=dl; \
        _Pragma("unroll") for(int r=0;r<16;++r){C0[r]-=dl;C1[r]-=dl;} \
        _Pragma("unroll") for(int r=0;r<16;++r)negm[r]=-mhat; asm volatile("":"+v"(negm)); \
        const float f=__builtin_amdgcn_exp2f(-dl); l_reg*=f; if(hi==0)wsf[r32]=f; resc=true; } } \
    SBAR(); \
    GAPB(o[0]=__builtin_amdgcn_mfma_f32_32x32x16_bf16(PAF(0),VFR(0),o[0],0,0,0), C0,0); \
    GAPB(o[1]=__builtin_amdgcn_mfma_f32_32x32x16_bf16(PAF(0),VFR(4),o[1],0,0,0), C0,4); \
    KRD(GL,0); GAPB(o[0]=__builtin_amdgcn_mfma_f32_32x32x16_bf16(PAF(1),VFR(1),o[0],0,0,0), C0,8); \
    KRD(GL,1); GAPB(o[1]=__builtin_amdgcn_mfma_f32_32x32x16_bf16(PAF(1),VFR(5),o[1],0,0,0), C0,12); \
    KRD(GL,2); GAPB(o[0]=__builtin_amdgcn_mfma_f32_32x32x16_bf16(PAF(2),VFR(2),o[0],0,0,0), C1,0); \
    KRD(GL,3); GAPB(o[1]=__builtin_amdgcn_mfma_f32_32x32x16_bf16(PAF(2),VFR(6),o[1],0,0,0), C1,4); \
    GAPB(o[0]=__builtin_amdgcn_mfma_f32_32x32x16_bf16(PAF(3),VFR(3),o[0],0,0,0), C1,8); \
    GAPB(o[1]=__builtin_amdgcn_mfma_f32_32x32x16_bf16(PAF(3),VFR(7),o[1],0,0,0), C1,12); \
    }while(0)
  int t=1;
  for(;t+5<NT;t+=2){
    STEP(pB0,pB1,pA0,pA1,t,true,true,true);     WAIT_BAR(2); RESC(); ROT();
    STEP(pA0,pA1,pB0,pB1,t+1,true,true,true);   WAIT_BAR(2); RESC(); ROT();
  }
  #define ENDW(tt) do{ if((tt)+3<NT){WAIT_BAR(2);} else if((tt)+2<NT){WAIT_BAR(1);} else {WAIT_BAR(0);} }while(0)
  for(;t+1<NT;t+=2){
    STEP(pB0,pB1,pA0,pA1,t,(t+3<NT),(t+1<NT),(t+1<NT));       ENDW(t);   RESC(); ROT();
    STEP(pA0,pA1,pB0,pB1,t+1,(t+4<NT),(t+2<NT),(t+2<NT));     ENDW(t+1); RESC(); ROT();
  }
  STEP(pB0,pB1,pA0,pA1,NT-1,false,false,false); RESC();
  { float sacc=pB0[0]+pB0[1]; _Pragma("unroll") for(int r=2;r<16;++r)sacc+=pB0[r]; _Pragma("unroll") for(int r=0;r<16;++r)sacc+=pB1[r]; l_reg+=sacc;
    pw0=(u32x4){PKW(pB0,0),PKW(pB0,2),PKW(pB0,4),PKW(pB0,6)};pw1=(u32x4){PKW(pB0,8),PKW(pB0,10),PKW(pB0,12),PKW(pB0,14)};pw2=(u32x4){PKW(pB1,0),PKW(pB1,2),PKW(pB1,4),PKW(pB1,6)};pw3=(u32x4){PKW(pB1,8),PKW(pB1,10),PKW(pB1,12),PKW(pB1,14)};
    SBAR(); pv(o,vb0+sl_cur,PAF(0),PAF(1),PAF(2),PAF(3)); }
  #undef PKW
  #undef PAF
  #undef VFR
  #undef PIN
  #undef MX3
  #undef GAPA
  #undef GAPB
  #undef EX
  #undef VRD
  #undef KRD
  #undef STEP
  #undef ENDW
  {auto rr=__builtin_amdgcn_permlane32_swap(__float_as_uint(l_reg),__float_as_uint(l_reg),false,false);l_reg=__uint_as_float(rr[0])+__uint_as_float(rr[1]);}
  if(hi==0)wsf[32+r32]=l_reg;asm volatile("s_waitcnt lgkmcnt(0)":::"memory");
  float rli[16];
  #pragma unroll
  for(int r=0;r<16;++r)rli[r]=__builtin_amdgcn_rcpf(wsf[32+crow(r,hi)]);
#if ATT_FP8
  { unsigned char*Ow8=(unsigned char*)O+(qrow0+wid*QBLK)*QP+h*D;
    unsigned char*stg8=(unsigned char*)(shm+LDS_OST)+wid*4096;
    #pragma unroll
    for(int r=0;r<16;++r){const int orow=crow(r,hi);
      #pragma unroll
      for(int d0=0;d0<2;++d0){const float x=o[d0][r]*rli[r]*(float)(1<<ATT_OSH); stg8[orow*64+d0*32+r32]=(unsigned char)(__builtin_amdgcn_cvt_pk_fp8_f32(x,x,0u,false)&0xffu);}}
    asm volatile("s_waitcnt lgkmcnt(0)":::"memory");
    #pragma unroll
    for(int i=0;i<2;++i){const int row=i*16+(lane>>2),ch=lane&3; const u32x4 v=*(const u32x4*)(stg8+row*64+ch*16); ATTN_STORE16(Ow8+(long)row*QP+ch*16,v);} }
#else
  bf16*Ow=O+(qrow0+wid*QBLK)*QP+h*D;
  { bf16*stg=(bf16*)(shm+LDS_OST)+wid*2048;
    #pragma unroll
    for(int r=0;r<16;++r){const int orow=crow(r,hi);
      #pragma unroll
      for(int d0=0;d0<2;++d0)stg[orow*64+d0*32+r32]=__float2bfloat16(o[d0][r]*rli[r]);}
    asm volatile("s_waitcnt lgkmcnt(0)":::"memory");
    #pragma unroll
    for(int i=0;i<4;++i){const int row=i*8+(lane>>3),ch=lane&7; const u32x4 v=*(const u32x4*)(stg+row*64+ch*8); ATTN_STORE16(Ow+(long)row*QP+ch*8,v);} }
#endif
  asm volatile("s_waitcnt lgkmcnt(0)\n\ts_barrier":::"memory");
  #undef DMA_K
  #undef DMA_V
  #undef CMASK
  #undef START
  #undef RESC
  #undef ROT
}
constexpr int ATTN_LDS_BYTES=LDS_BYTES;
#undef SBAR
#undef WAIT_BAR
}

typedef f32x4 AccT[2][2][4][2];
__device__ __forceinline__ long kv_row(int r) { return r < TL ? (long)(r / SEQ) * KVROWS + CTXL + (r % SEQ) : (long)((r - TL) / CTXL) * KVROWS + ((r - TL) % CTXL); }

struct SchedDense {
    static constexpr bool IMM_DONE = false; static constexpr bool KSCALE = false;
    const char* A; const char* B; size_t astep, bstep, acol; int nM, nN, G, c;
    __device__ __forceinline__ bool next(int i, pg8::Unit& u) const {
        const int L = i * G + c; if (L >= nM * nN) return false;
        pg8::tile_of(L, nM, nN, u.pm, u.pn); u.A = A + (size_t)u.pm * astep + (size_t)u.pn * acol; u.B = B + (size_t)u.pn * bstep; u.x0 = 0; u.x1 = 0; return true; }
    __device__ __forceinline__ int gather(const pg8::Unit&, int) const { return 0; }
    __device__ __forceinline__ void a_ready(const pg8::Unit&, int) const {}
    __device__ __forceinline__ void done(const pg8::Unit&, int) const {}
};
struct SchedDenseR {
    static constexpr bool IMM_DONE = true; static constexpr bool KSCALE = false;
    const char* A; const char* B; size_t astep, bstep, acol; int nM, nN, nF, G, c; unsigned* ready;
    __device__ __forceinline__ bool next(int i, pg8::Unit& u) const {
        const int L = i * G + c, n1 = nF * nN; if (L >= nM * nN) return false;
        if (L < n1) pg8::tile_of(L, nF, nN, u.pm, u.pn); else { u.pm = nF + (L - n1) / nN; u.pn = (L - n1) % nN; }
        u.A = A + (size_t)u.pm * astep + (size_t)u.pn * acol; u.B = B + (size_t)u.pn * bstep; u.x0 = 0; u.x1 = 0; return true; }
    __device__ __forceinline__ int gather(const pg8::Unit&, int) const { return 0; }
    __device__ __forceinline__ void a_ready(const pg8::Unit&, int) const {}
    __device__ __forceinline__ void done(const pg8::Unit& u, int lane) const { if (lane == 0) __hip_atomic_fetch_add(ready + u.pm, 1u, __ATOMIC_RELAXED, __HIP_MEMORY_SCOPE_AGENT); }
};
struct SchedOutproj {
    static constexpr bool IMM_DONE = true; static constexpr bool KSCALE = true;
    const char* A; const char* B; size_t astep, bstep; int G, c; const unsigned* rdg; unsigned* ready; const float* rstd;
    __device__ __forceinline__ void kscale(AccT& acc, const pg8::Unit& u, int g, int wr) const {
        int ln; asm volatile("v_mbcnt_lo_u32_b32 %0, -1, 0\n\tv_mbcnt_hi_u32_b32 %0, -1, %0" : "=v"(ln)); const int fr = ln & 15;
#pragma unroll
        for (int ai = 0; ai < 2; ++ai)
#pragma unroll
            for (int m = 0; m < 4; ++m) { const float* rp = rstd + (size_t)(u.pm * 256 + ai * 128 + wr * 64 + m * 16 + fr) * 4 + g; const float ratio = rp[-1] * __builtin_amdgcn_rcpf(rp[0]);
#pragma unroll
                for (int bj = 0; bj < 2; ++bj)
#pragma unroll
                    for (int nn = 0; nn < 2; ++nn) acc[ai][bj][m][nn] = acc[ai][bj][m][nn] * ratio; }
    }
    __device__ __forceinline__ bool next(int i, pg8::Unit& u) const {
        int n;
        if (G == 256) {
            if (c < 16) { if (i < 2) n = 2 * c + i; else return false; }
            else if (i != 0) return false;
            else if (c >= 64) n = 32 + (c - 64); else n = 224 + (c - 16); }
        else { n = i * G + c; if (n >= 272) return false; }
        u.pm = n >> 2; u.pn = n & 3; u.A = A + (size_t)u.pm * astep; u.B = B + (size_t)u.pn * bstep; u.x0 = 0; u.x1 = 0; return true; }
    __device__ __forceinline__ int gather(const pg8::Unit&, int) const { return 0; }
    __device__ __forceinline__ void a_ready(const pg8::Unit& u, int wid) const {
        if (wid == 0) { unsigned sp = 0;
            while ((unsigned)__builtin_amdgcn_readfirstlane(__hip_atomic_load(rdg + u.pm, __ATOMIC_RELAXED, __HIP_MEMORY_SCOPE_AGENT)) < 8u) { __builtin_amdgcn_s_sleep(2); if (++sp > (1u << 22)) break; }
            __builtin_amdgcn_fence(__ATOMIC_ACQUIRE, "agent"); asm volatile("s_waitcnt vmcnt(0)" ::: "memory"); }
        __builtin_amdgcn_s_barrier(); asm volatile("" ::: "memory");
    }
    __device__ __forceinline__ void done(const pg8::Unit& u, int lane) const { if (lane == 0) __hip_atomic_fetch_add(ready + u.pm, 1u, __ATOMIC_RELAXED, __HIP_MEMORY_SCOPE_AGENT); }
};
struct SchedQKV {
    static constexpr bool IMM_DONE = false; static constexpr bool KSCALE = false;
    const char* A; const char* B; size_t tstep; int ctxq, G, c;
    __device__ __forceinline__ bool next(int i, pg8::Unit& u) const {
        const int L = i * G + c, n1 = 64 * 6, n2 = ctxq ? 24 : 8; if (L >= n1 + n2) return false;
        if (L < n1) pg8::tile_of(L, 64, 6, u.pm, u.pn);
        else if (ctxq) { pg8::tile_of(L - n1, 4, 6, u.pm, u.pn); u.pm += 64; }
        else { u.pm = 64 + ((L - n1) >> 1); u.pn = 4 + ((L - n1) & 1); }
        u.A = A + (size_t)u.pm * tstep; u.B = B + (size_t)u.pn * tstep; u.x0 = 0; u.x1 = 0; return true; }
    __device__ __forceinline__ int gather(const pg8::Unit&, int) const { return 0; }
    __device__ __forceinline__ void a_ready(const pg8::Unit&, int) const {}
    __device__ __forceinline__ void done(const pg8::Unit&, int) const {}
};
struct SchedMoe {
    static constexpr bool IMM_DONE = false; static constexpr bool KSCALE = false;
    const char* Abase; size_t astep; const char* Bbase; size_t bstep_e, bstep_n; const LAS int* tab; const int* list; int G, c;
    unsigned* ready; int mode;
    __device__ __forceinline__ int T(int i) const { return __builtin_amdgcn_readfirstlane(tab[i]); }
    __device__ __forceinline__ bool next(int i, pg8::Unit& u) const {
        const int ntiles = T(32); int gt, pn;
        if (G == 256) {
            const int x = c & 7, j = c >> 3, g = (mode == 2 ? 7 - x : x) + 8 * i, fm = 8 * g; if (fm >= ntiles) return false;
            const int gsz = (ntiles - fm) < 8 ? (ntiles - fm) : 8; if (j >= 4 * gsz) return false;
            gt = fm + j % gsz; pn = j / gsz; }
        else { const int L = i * G + (mode == 2 ? G - 1 - c : c); if (L >= ntiles * 4) return false; pg8::tile_of(L, ntiles, 4, gt, pn); }
        int e = 0;
        for (int q = 1; q < 32; ++q) e += (T(q) <= gt) ? 1 : 0;
        const int ti = gt - T(e); int valid = T(40 + e) - ti * 256; valid = valid > 256 ? 256 : valid;
        u.pm = gt; u.pn = pn; u.x0 = e * MOE_CAP + ti * 256; u.x1 = valid;
        u.A = Abase + (size_t)gt * astep; u.B = Bbase + (size_t)e * bstep_e + (size_t)pn * bstep_n; return true; }
    __device__ __forceinline__ int gather(const pg8::Unit& u, int lr) const { return lr < u.x1 ? (list[u.x0 + lr] >> 1) : 0; }
    __device__ __forceinline__ void a_ready(const pg8::Unit& u, int wid) const {
        if (mode != 2) return;
        if (wid == 0) { unsigned sp = 0;
            while ((unsigned)__builtin_amdgcn_readfirstlane(__hip_atomic_load(ready + u.pm, __ATOMIC_RELAXED, __HIP_MEMORY_SCOPE_AGENT)) < 32u) { __builtin_amdgcn_s_sleep(2); if (++sp > (1u << 22)) break; }
            __builtin_amdgcn_fence(__ATOMIC_ACQUIRE, "agent"); asm volatile("s_waitcnt vmcnt(0)" ::: "memory"); }
        __builtin_amdgcn_s_barrier(); asm volatile("" ::: "memory");
    }
    __device__ __forceinline__ void done(const pg8::Unit& u, int lane) const {
        if (mode != 1) return;
        if (lane == 0) __hip_atomic_fetch_add(ready + u.pm, 1u, __ATOMIC_RELAXED, __HIP_MEMORY_SCOPE_AGENT);
    }
};

struct EpiQKV { static constexpr bool PERM = true; bf16* Q; bf16* Kb; bf16* Vb; const float* qg; const float* kg; const LAS f32x2* tab;
    __device__ __forceinline__ void operator()(const AccT& acc, const pg8::Unit& u, int wr, int wc, int, int) const {
        bf16* base; int pitch; long row0;
        if (u.pn < 4) { base = Q + u.pn * 256; pitch = 1024; row0 = (long)u.pm * 256; }
        else { base = (u.pn == 4) ? Kb : Vb; pitch = 256; row0 = kv_row(u.pm * 256); }
        const bool isv = u.pn == 5, lat = u.pm < 64; const float* g = u.pn < 4 ? qg : kg; const float post = u.pn < 4 ? 0.125f * 1.4426950408889634f : 1.0f;
        int ln; asm volatile("v_mbcnt_lo_u32_b32 %0, -1, 0\n\tv_mbcnt_hi_u32_b32 %0, -1, %0" : "=v"(ln)); const int fr = ln & 15, fq = ln >> 4;
        f32x4 g0[2], g1[2];
#pragma unroll
        for (int bj = 0; bj < 2; ++bj) { g0[bj] = *(const f32x4*)(g + 32 * bj + 8 * fq); g1[bj] = *(const f32x4*)(g + 32 * bj + 8 * fq + 4); }
#pragma unroll
        for (int ai = 0; ai < 2; ++ai)
#pragma unroll
            for (int m = 0; m < 4; ++m) {
                const int lr = ai * 128 + wr * 64 + m * 16 + fr; const unsigned roff = (unsigned)(((int)row0 + lr) * pitch + wc * 64 + 8 * fq) * 2u;
                f32x4 v[2][2];
#pragma unroll
                for (int bj = 0; bj < 2; ++bj) { v[bj][0] = acc[ai][bj][m][0]; v[bj][1] = acc[ai][bj][m][1]; }
                if (!isv) {
                    float ss = 0.f;
#pragma unroll
                    for (int bj = 0; bj < 2; ++bj)
#pragma unroll
                        for (int n = 0; n < 2; ++n) ss += (v[bj][n][0] * v[bj][n][0] + v[bj][n][1] * v[bj][n][1]) + (v[bj][n][2] * v[bj][n][2] + v[bj][n][3] * v[bj][n][3]);
                    ss += __shfl_xor(ss, 16); ss += __shfl_xor(ss, 32);
                    const float rstd = rsqrtf(ss * (1.0f / 64.0f) + EPS);
#pragma unroll
                    for (int bj = 0; bj < 2; ++bj) { v[bj][0] = v[bj][0] * rstd * g0[bj]; v[bj][1] = v[bj][1] * rstd * g1[bj]; }
                    if (lat) { const int t = (u.pm * 256 + lr) & (SEQ - 1);
#pragma unroll
                        for (int bj = 0; bj < 2; ++bj) { const LAS f32x2* tb = tab + ((bj == 0 ? (t >> 6) : (t & 63)) * 17 + 4 * fq);
#pragma unroll
                            for (int n = 0; n < 2; ++n)
#pragma unroll
                                for (int e = 0; e < 2; ++e) { const f32x2 cs = tb[2 * n + e]; const float x0 = v[bj][n][2 * e], x1 = v[bj][n][2 * e + 1];
                                    v[bj][n][2 * e] = x0 * cs.x - x1 * cs.y; v[bj][n][2 * e + 1] = x0 * cs.y + x1 * cs.x; } } }
#pragma unroll
                    for (int bj = 0; bj < 2; ++bj) { v[bj][0] = v[bj][0] * post; v[bj][1] = v[bj][1] * post; }
                }
#pragma unroll
                for (int bj = 0; bj < 2; ++bj)
                    *(u32x4*)((char*)base + roff + bj * 64) = (u32x4){cvtpk(v[bj][0][0], v[bj][0][1]), cvtpk(v[bj][0][2], v[bj][0][3]), cvtpk(v[bj][1][0], v[bj][1][1]), cvtpk(v[bj][1][2], v[bj][1][3])}; }
    }
};
template <bool PERM_> struct EpiResidT { static constexpr bool PERM = PERM_; const Args* a; int layer; const float* pscale; const bf16* srcbase; const float* rowsc;
    __device__ __forceinline__ void operator()(const AccT& acc, const pg8::Unit& u, int wr, int wc, int, int) const {
        int ln; asm volatile("v_mbcnt_lo_u32_b32 %0, -1, 0\n\tv_mbcnt_hi_u32_b32 %0, -1, %0" : "=v"(ln)); const int fr = ln & 15, fq = ln >> 4;
        const int r0 = u.pm * 256;
        const float* gate = mod_row(*a, layer, r0) + 2 * D;
        const bool f32src = (layer == 0) && !srcbase; const float* src32 = resid_row(*a, 0, r0); const bf16* src16 = (srcbase ? srcbase : (const bf16*)(a->ws + WS_X)) + (size_t)r0 * D;
        const __amdgpu_buffer_rsrc_t rs = __builtin_amdgcn_make_buffer_rsrc((void*)(a->ws + WS_X), 0, TT * D * 2, 0x00020000);
        if constexpr (PERM_) {
#pragma unroll
        for (int bj = 0; bj < 2; ++bj) { const int cc = u.pn * 256 + bj * 128 + wc * 32 + 8 * fq;
            f32x4 g0 = *(const f32x4*)(gate + cc), g1 = *(const f32x4*)(gate + cc + 4); if (pscale) { g0 = g0 * *(const f32x4*)(pscale + cc); g1 = g1 * *(const f32x4*)(pscale + cc + 4); }
#pragma unroll
            for (int ai = 0; ai < 2; ++ai) { float rsc[4];
#pragma unroll
                for (int m = 0; m < 4; ++m) rsc[m] = rowsc ? rowsc[(size_t)(r0 + ai * 128 + wr * 64 + m * 16 + fr) * 4 + 3] : 1.0f;
                if (f32src) { f32x4 s0[4], s1[4];
#pragma unroll
                    for (int m = 0; m < 4; ++m) { const int off = (ai * 128 + wr * 64 + m * 16 + fr) * D + cc; s0[m] = *(const f32x4*)(src32 + off); s1[m] = *(const f32x4*)(src32 + off + 4); }
#pragma unroll
                    for (int m = 0; m < 4; ++m) { const int off = (ai * 128 + wr * 64 + m * 16 + fr) * D + cc;
                        const f32x4 o0 = s0[m] + (g0 * rsc[m]) * acc[ai][bj][m][0], o1 = s1[m] + (g1 * rsc[m]) * acc[ai][bj][m][1];
                        __builtin_amdgcn_raw_buffer_store_b128((u32x4){cvtpk(o0.x, o0.y), cvtpk(o0.z, o0.w), cvtpk(o1.x, o1.y), cvtpk(o1.z, o1.w)}, rs, (r0 * D + off) * 2, 0, 16  ); } }
                else { u32x4 pr[4];
#pragma unroll
                    for (int m = 0; m < 4; ++m) { const int off = (ai * 128 + wr * 64 + m * 16 + fr) * D + cc; pr[m] = *(const u32x4*)(src16 + off); }
#pragma unroll
                    for (int m = 0; m < 4; ++m) { const int off = (ai * 128 + wr * 64 + m * 16 + fr) * D + cc; const u32x4 p = pr[m];
                        const f32x4 s0 = (f32x4){bflo(p.x), bfhi(p.x), bflo(p.y), bfhi(p.y)}, s1 = (f32x4){bflo(p.z), bfhi(p.z), bflo(p.w), bfhi(p.w)};
                        const f32x4 o0 = s0 + (g0 * rsc[m]) * acc[ai][bj][m][0], o1 = s1 + (g1 * rsc[m]) * acc[ai][bj][m][1];
                        __builtin_amdgcn_raw_buffer_store_b128((u32x4){cvtpk(o0.x, o0.y), cvtpk(o0.z, o0.w), cvtpk(o1.x, o1.y), cvtpk(o1.z, o1.w)}, rs, (r0 * D + off) * 2, 0, 16  ); } }
                asm volatile("" ::: "memory"); } }
        } else {
#pragma unroll
        for (int bj = 0; bj < 2; ++bj)
#pragma unroll
            for (int n = 0; n < 2; ++n) { const int cc = u.pn * 256 + bj * 128 + wc * 32 + n * 16 + 4 * fq; f32x4 g = *(const f32x4*)(gate + cc); if (pscale) g = g * *(const f32x4*)(pscale + cc);
                if (f32src) { f32x4 s0[8];
#pragma unroll
                    for (int q = 0; q < 8; ++q) { const int off = ((q >> 2) * 128 + wr * 64 + (q & 3) * 16 + fr) * D + cc; s0[q] = *(const f32x4*)(src32 + off); }
#pragma unroll
                    for (int q = 0; q < 8; ++q) { const int off = ((q >> 2) * 128 + wr * 64 + (q & 3) * 16 + fr) * D + cc; const f32x4 o0 = s0[q] + g * acc[q >> 2][bj][q & 3][n];
                        __builtin_amdgcn_raw_buffer_store_b64((u32x2){cvtpk(o0.x, o0.y), cvtpk(o0.z, o0.w)}, rs, (r0 * D + off) * 2, 0, 16  ); } }
                else { u32x2 pr[8];
#pragma unroll
                    for (int q = 0; q < 8; ++q) { const int off = ((q >> 2) * 128 + wr * 64 + (q & 3) * 16 + fr) * D + cc; pr[q] = *(const u32x2*)(src16 + off); }
#pragma unroll
                    for (int q = 0; q < 8; ++q) { const int off = ((q >> 2) * 128 + wr * 64 + (q & 3) * 16 + fr) * D + cc; const u32x2 p = pr[q];
                        const f32x4 o0 = (f32x4){bflo(p.x), bfhi(p.x), bflo(p.y), bfhi(p.y)} + g * acc[q >> 2][bj][q & 3][n];
                        __builtin_amdgcn_raw_buffer_store_b64((u32x2){cvtpk(o0.x, o0.y), cvtpk(o0.z, o0.w)}, rs, (r0 * D + off) * 2, 0, 16  ); } }
                asm volatile("" ::: "memory"); }
        }
    }
};
typedef EpiResidT<true> EpiResid; typedef EpiResidT<false> EpiResidN;
struct EpiGateUp { static constexpr bool PERM = true; bf16* act;
    __device__ __forceinline__ void operator()(const AccT& acc, const pg8::Unit& u, int wr, int wc, int fr, int fq) const {
        const __amdgpu_buffer_rsrc_t rs = __builtin_amdgcn_make_buffer_rsrc((void*)act, 0, 43008 * 512 * 2, 0x00020000);
#pragma unroll
        for (int ai = 0; ai < 2; ++ai)
#pragma unroll
            for (int m = 0; m < 4; ++m) { const int off = (int)((((size_t)u.pm * 256 + ai * 128 + wr * 64 + m * 16 + fr) * 512 + u.pn * 128 + wc * 32 + 8 * fq) * 2);
                const f32x4 g0 = acc[ai][0][m][0], g1 = acc[ai][0][m][1], u0 = acc[ai][1][m][0], u1 = acc[ai][1][m][1];
                const u32x4 ov = (u32x4){cvtpk(silu_f(g0[0]) * u0[0], silu_f(g0[1]) * u0[1]), cvtpk(silu_f(g0[2]) * u0[2], silu_f(g0[3]) * u0[3]),
                                     cvtpk(silu_f(g1[0]) * u1[0], silu_f(g1[1]) * u1[1]), cvtpk(silu_f(g1[2]) * u1[2], silu_f(g1[3]) * u1[3])};
#if MOE_FP8
                { const float sa = (float)(1 << MOE_ASH); const u32x2 o8 = (u32x2){pk_fp8x4(silu_f(g0[0]) * u0[0] * sa, silu_f(g0[1]) * u0[1] * sa, silu_f(g0[2]) * u0[2] * sa, silu_f(g0[3]) * u0[3] * sa),
                                                                                    pk_fp8x4(silu_f(g1[0]) * u1[0] * sa, silu_f(g1[1]) * u1[1] * sa, silu_f(g1[2]) * u1[2] * sa, silu_f(g1[3]) * u1[3] * sa)};
                  (void)ov; __builtin_amdgcn_raw_buffer_store_b64(o8, rs, off >> 1, 0, 16  ); } }
#else
                __builtin_amdgcn_raw_buffer_store_b128(ov, rs, off, 0, 16  ); }
#endif
    }
};
struct EpiDown { static constexpr bool PERM = true; const int* list; const float* w2; bf16* y2;
    __device__ __forceinline__ void operator()(const AccT& acc, const pg8::Unit& u, int wr, int wc, int fr, int fq) const {
        int dest[8]; float wv[8];
#pragma unroll
        for (int q = 0; q < 8; ++q) { const int lr = (q >> 2) * 128 + wr * 64 + (q & 3) * 16 + fr; dest[q] = list[u.x0 + (lr < u.x1 ? lr : 0)]; }
#pragma unroll
        for (int q = 0; q < 8; ++q) wv[q] = w2[dest[q]];
#pragma unroll
        for (int ai = 0; ai < 2; ++ai)
#pragma unroll
            for (int m = 0; m < 4; ++m) { const int lr = ai * 128 + wr * 64 + m * 16 + fr;
                if (lr < u.x1) { const int dst = dest[ai * 4 + m]; const float w = wv[ai * 4 + m]; bf16* p = y2 + (size_t)dst * D + u.pn * 256 + wc * 32 + 8 * fq;
#pragma unroll
                    for (int bj = 0; bj < 2; ++bj) { const f32x4 v0 = acc[ai][bj][m][0] * w, v1 = acc[ai][bj][m][1] * w;
#if Y2_FP8
                        { const float sy = (float)(1 << Y2_SH); unsigned char* p8 = (unsigned char*)y2 + (size_t)dst * D + u.pn * 256 + wc * 32 + 8 * fq + bj * 128;
                          *(u32x2*)p8 = (u32x2){pk_fp8x4(v0[0] * sy, v0[1] * sy, v0[2] * sy, v0[3] * sy), pk_fp8x4(v1[0] * sy, v1[1] * sy, v1[2] * sy, v1[3] * sy)}; (void)p; }
#else
                        *(u32x4*)(p + bj * 128) = (u32x4){cvtpk(v0[0], v0[1]), cvtpk(v0[2], v0[3]), cvtpk(v1[0], v1[1]), cvtpk(v1[2], v1[3])};
#endif
                    } } }
    }
};

constexpr int TAB_OFF = 135168;

__device__ __forceinline__ void ph_rope(const Args& a, const Ctx& c, int layer) {
    const int j = layer == 0 ? 0 : 1; const bool ctxq = layer == 0;
    const float* qg = a.in[I_QG] + j * 64; const float* kg = a.in[I_KG] + j * 64;
    const f32x2* tab = (const f32x2*)(a.ws + WS_ROPE);
    bf16* Qb = (bf16*)(a.ws + WS_Q); bf16* Kb = (bf16*)(a.ws + WS_K);
    const int nitems = TT * 20;
    for (int it = blockIdx.x * NTHREADS + c.tid; it < nitems; it += c.G * NTHREADS) {
        const int r = it / 20, hs = it % 20;
        if (hs < 16 && r >= TL && !ctxq) continue;
        bf16* p; const float* g; float post;
        if (hs < 16) { p = Qb + (size_t)r * 1024 + hs * 64; g = qg; post = 0.125f * 1.4426950408889634f; } else { p = Kb + kv_row(r) * 256 + (hs - 16) * 64; g = kg; post = 1.0f; }
        float x[64]; float ss = 0.f;
#pragma unroll
        for (int i = 0; i < 8; ++i) { const u32x4 w = ((const u32x4*)p)[i];
            x[8 * i + 0] = bflo(w.x); x[8 * i + 1] = bfhi(w.x); x[8 * i + 2] = bflo(w.y); x[8 * i + 3] = bfhi(w.y);
            x[8 * i + 4] = bflo(w.z); x[8 * i + 5] = bfhi(w.z); x[8 * i + 6] = bflo(w.w); x[8 * i + 7] = bfhi(w.w); }
#pragma unroll
        for (int i = 0; i < 64; ++i) ss += x[i] * x[i];
        const float rstd = rsqrtf(ss * (1.0f / 64.0f) + EPS);
#pragma unroll
        for (int i = 0; i < 64; ++i) x[i] = x[i] * rstd * g[i];
        if (r < TL) { const int t = r % SEQ, rp = t >> 6, cp = t & 63;
#pragma unroll
            for (int i = 0; i < 32; ++i) { const f32x2 cs = tab[(i < 16 ? rp : cp) * 16 + (i & 15)]; const float x0 = x[2 * i], x1 = x[2 * i + 1];
                x[2 * i] = x0 * cs.x - x1 * cs.y; x[2 * i + 1] = x0 * cs.y + x1 * cs.x; } }
#pragma unroll
        for (int i = 0; i < 8; ++i) ((u32x4*)p)[i] = (u32x4){cvtpk(x[8 * i] * post, x[8 * i + 1] * post), cvtpk(x[8 * i + 2] * post, x[8 * i + 3] * post),
                                                            cvtpk(x[8 * i + 4] * post, x[8 * i + 5] * post), cvtpk(x[8 * i + 6] * post, x[8 * i + 7] * post)};
    }
}

__device__ __forceinline__ void ph_att(const Args& a, const Ctx& c, int layer, char* lds_generic) {
    const int nun = 1024 + (layer == 0 ? 64 : 0);
    const attn_body::bf16* Qb = (const attn_body::bf16*)(a.ws + WS_Q); const attn_body::bf16* Kb = (const attn_body::bf16*)(a.ws + WS_K); const attn_body::bf16* Vb = (const attn_body::bf16*)(a.ws + WS_V);
    for (int U = c.vcu; U < nun; U += c.G) {
        long qrow0, kv0; int h, NT;
        if (U < 1024) { const int bh = U >> 4, qb = U & 15, b = bh >> 4; h = bh & 15; qrow0 = (long)b * SEQ + qb * 256; kv0 = (long)b * KVROWS; NT = KVROWS / 64; }
        else { const int q = U - 1024, b = q >> 4; h = q & 15; qrow0 = (long)TL + b * CTXL; kv0 = (long)b * KVROWS; NT = CTXL / 64; }
        attn_body::attn_unit<8>(qrow0, h, kv0, NT, Qb, Kb, Vb, (attn_body::bf16*)(a.ws + WS_HB), lds_generic);
    }
}

__device__ __forceinline__ void ph_m1(const Args& a, const Ctx& c, int layer, const unsigned* rdy, int nN, int amode) {
    const int Tm = layer == 3 ? TL : TT, ntiles = Tm / 32;
    int tl0, tl1, tl2;
    { int bid = (int)blockIdx.x; asm volatile("" : "+s"(bid));
      if (amode == 1 && c.G == 256 && ntiles == 544) {
          int k = c.vcu - 64; asm volatile("" : "+s"(k));
          if (k < 0) { tl0 = -1; tl1 = -1; tl2 = -1; } else { tl0 = 64 + k; tl1 = 256 + k; tl2 = k < 64 ? k : (k < 160 ? 448 + (k - 64) : -1); } }
      else if (c.G == 256 && ntiles == 544) { if (bid < 16) { tl0 = 512 + bid; tl1 = -1; tl2 = -1; } else { const int j = bid - 16; tl0 = j; tl1 = j + 240; tl2 = j < 32 ? j + 480 : (j < 48 ? 528 + (j - 32) : -1); } }
      else { tl0 = bid < ntiles ? bid : -1; tl1 = bid + c.G < ntiles ? bid + c.G : -1; tl2 = bid + 2 * c.G < ntiles ? bid + 2 * c.G : -1; } }
    const unsigned need = 8u * (unsigned)nN;
#define M1_WAIT(tl) do { if (c.wave == 0) { unsigned sp_ = 0; \
        while ((unsigned)__builtin_amdgcn_readfirstlane(__hip_atomic_load(rdy + ((tl) >> 3), __ATOMIC_RELAXED, __HIP_MEMORY_SCOPE_AGENT)) < need) { __builtin_amdgcn_s_sleep(2); if (++sp_ > (1u << 22)) break; } \
        __builtin_amdgcn_fence(__ATOMIC_ACQUIRE, "agent"); asm volatile("s_waitcnt vmcnt(0)" ::: "memory"); } \
        __syncthreads(); } while (0)
    const float* g = a.in[I_NFFN] + layer * D;
    constexpr int RP = 2064;
    LAS unsigned char* hiT = c.lds; LAS unsigned char* loT = c.lds + 32 * RP;
    LAS float* part = (LAS float*)c.lds;
    LAS int* lcnt = (LAS int*)(c.lds + 133120); LAS int* lbase = lcnt + 32;
    LAS float* logit = (LAS float*)(c.lds + 134144);
    const bf16* wr = (const bf16*)(a.ws + WS_WR) + (size_t)layer * 2 * 65536;
    unsigned* gcnt = (unsigned*)(a.ws + WS_CTL) + CW_CNT + layer * 32;
    int* list = (int*)(a.ws + WS_LIST); float* w2 = (float*)(a.ws + WS_W2);
    const int r32 = c.lane & 31, hi = c.lane >> 5;
    if (c.tid < 32) lcnt[c.tid] = 0;
    u32x2 vr[4][4];
#define M1_LOADROWS(tl) do { _Pragma("unroll") for (int i = 0; i < 4; ++i) { const u32x2* xr = (const u32x2*)((const bf16*)(a.ws + WS_X) + (size_t)((tl) * 32 + 4 * c.wave + i) * D) + c.lane; \
        _Pragma("unroll") for (int j = 0; j < 4; ++j) vr[i][j] = xr[64 * j]; } } while (0)
    if (tl0 >= 0) { M1_WAIT(tl0); M1_LOADROWS(tl0); }
    int nmine = 0;
    for (; nmine < 3; ++nmine) { const int tile = nmine == 0 ? tl0 : nmine == 1 ? tl1 : tl2, tnext = nmine == 0 ? tl1 : nmine == 1 ? tl2 : -1;
        if (tile < 0) break;
        const int r0 = tile * 32;
        { f32x4 gs[4], sh[4];
          { const float* m = mod_row(a, layer, r0);
#pragma unroll
            for (int j = 0; j < 4; ++j) { gs[j] = ((const f32x4*)g)[c.lane + 64 * j] * (((const f32x4*)(m + 4 * D))[c.lane + 64 * j] + 1.0f); sh[j] = ((const f32x4*)(m + 3 * D))[c.lane + 64 * j]; } }
#pragma unroll
          for (int i = 0; i < 4; ++i) { const int lr = 4 * c.wave + i, r = r0 + lr;
            f32x4 h[4], vv[4];
#pragma unroll
            for (int j = 0; j < 4; ++j) { const u32x2 p = vr[i][j]; vv[j] = (f32x4){bflo(p.x), bfhi(p.x), bflo(p.y), bfhi(p.y)}; }
            const float rstd = row_rstd(vv);
#pragma unroll
            for (int j = 0; j < 4; ++j) h[j] = (vv[j] * rstd) * gs[j] + sh[j];
#if MOE_FP8
            unsigned* to8 = (unsigned*)((unsigned char*)(a.ws + WS_TK) + (size_t)r * D) + c.lane;
#else
            u32x2* to = (u32x2*)((bf16*)(a.ws + WS_TK) + (size_t)r * D) + c.lane;
#endif
#pragma unroll
            for (int j = 0; j < 4; ++j) { const unsigned h0 = cvtpk(h[j].x, h[j].y), h1 = cvtpk(h[j].z, h[j].w);
                const unsigned l0 = cvtpk(h[j].x - bflo(h0), h[j].y - bfhi(h0)), l1 = cvtpk(h[j].z - bflo(h1), h[j].w - bfhi(h1));
#if MOE_FP8
                to8[64 * j] = pk_fp8x4(h[j].x, h[j].y, h[j].z, h[j].w);
#else
                to[64 * j] = (u32x2){h0, h1};
#endif
                *(LAS u32x2*)(hiT + lr * RP + (4 * c.lane + 256 * j) * 2) = (u32x2){h0, h1};
                *(LAS u32x2*)(loT + lr * RP + (4 * c.lane + 256 * j) * 2) = (u32x2){l0, l1}; } } }
        __syncthreads();
        f32x16 acc0 = {}, acc1 = {};
#pragma unroll
        for (int kk = 0; kk < 8; ++kk) { const int k0 = 128 * c.wave + 16 * kk + 8 * hi;
            const bf16x8 ahi = *(const LAS bf16x8*)(hiT + r32 * RP + k0 * 2), alo = *(const LAS bf16x8*)(loT + r32 * RP + k0 * 2);
            const bf16* wf = wr + (c.wave * 8 + kk) * 2048 + c.lane * 8;
            const bf16x8 b0h = *(const bf16x8*)wf, b1h = *(const bf16x8*)(wf + 512), b0l = *(const bf16x8*)(wf + 1024), b1l = *(const bf16x8*)(wf + 1536);
            acc0 = __builtin_amdgcn_mfma_f32_32x32x16_bf16(ahi, b0h, acc0, 0, 0, 0); acc1 = __builtin_amdgcn_mfma_f32_32x32x16_bf16(ahi, b1h, acc1, 0, 0, 0);
            acc0 = __builtin_amdgcn_mfma_f32_32x32x16_bf16(alo, b0h, acc0, 0, 0, 0); acc1 = __builtin_amdgcn_mfma_f32_32x32x16_bf16(alo, b1h, acc1, 0, 0, 0);
            acc0 = __builtin_amdgcn_mfma_f32_32x32x16_bf16(ahi, b0l, acc0, 0, 0, 0); acc1 = __builtin_amdgcn_mfma_f32_32x32x16_bf16(ahi, b1l, acc1, 0, 0, 0); }
        if (tnext >= 0) { M1_WAIT(tnext); M1_LOADROWS(tnext); }
        else __syncthreads();
#pragma unroll
        for (int reg = 0; reg < 16; ++reg) { part[((c.wave * 2 + 0) * 16 + reg) * 64 + c.lane] = acc0[reg]; part[((c.wave * 2 + 1) * 16 + reg) * 64 + c.lane] = acc1[reg]; }
        __syncthreads();
        if (nmine < 3) {
#pragma unroll
            for (int q = 0; q < 4; ++q) { const int idx = c.tid + 512 * q, nt = idx >> 10, reg = (idx >> 6) & 15, ln = idx & 63; float s = 0.f;
#pragma unroll
                for (int w = 0; w < 8; ++w) s += part[((w * 2 + nt) * 16 + reg) * 64 + ln];
                logit[(nmine * 32 + (reg & 3) + 8 * (reg >> 2) + 4 * (ln >> 5)) * 64 + nt * 32 + (ln & 31)] = s; } }
        __syncthreads();
    }
#undef M1_LOADROWS
#undef M1_WAIT
    int e0 = 0, e1 = 0, p0 = 0, p1 = 0; float w0 = 0.f, w1 = 0.f; const int myt = c.tid >> 5; const bool act_r = c.tid < 96 && myt < nmine;
    if (act_r) { const LAS float* lg = logit + c.tid * 64;
        int grp = 0; float gm = lg[0];
#pragma unroll
        for (int q = 1; q < 4; ++q) if (lg[q] > gm) { gm = lg[q]; grp = q; }
        float den = 0.f;
#pragma unroll
        for (int q = 0; q < 4; ++q) den += expf(lg[q] - gm);
        const float gate = 1.0f / den;
        const LAS float* le = lg + 4 + grp * 8;
        int i0 = 0; float v0 = le[0];
#pragma unroll
        for (int q = 1; q < 8; ++q) if (le[q] > v0) { v0 = le[q]; i0 = q; }
        int i1 = -1; float v1 = -3.0e38f;
#pragma unroll
        for (int q = 0; q < 8; ++q) if (q != i0 && le[q] > v1) { v1 = le[q]; i1 = q; }
        const float ex = expf(v1 - v0); w0 = gate / (1.0f + ex); w1 = gate * ex / (1.0f + ex);
        e0 = grp * 8 + i0; e1 = grp * 8 + i1;
        p0 = __hip_atomic_fetch_add(lcnt + e0, 1, __ATOMIC_RELAXED, __HIP_MEMORY_SCOPE_WORKGROUP);
        p1 = __hip_atomic_fetch_add(lcnt + e1, 1, __ATOMIC_RELAXED, __HIP_MEMORY_SCOPE_WORKGROUP); }
    __syncthreads();
    if (c.tid < 32) { const int n = lcnt[c.tid]; lbase[c.tid] = n ? (int)__hip_atomic_fetch_add(gcnt + c.tid, (unsigned)n, __ATOMIC_RELAXED, __HIP_MEMORY_SCOPE_AGENT) : 0; }
    __syncthreads();
    if (act_r) { const int r = (myt == 0 ? tl0 : myt == 1 ? tl1 : tl2) * 32 + (c.tid & 31);
        list[e0 * MOE_CAP + lbase[e0] + p0] = 2 * r; w2[2 * r] = w0;
        list[e1 * MOE_CAP + lbase[e1] + p1] = 2 * r + 1; w2[2 * r + 1] = w1; }
    __syncthreads();
}
__device__ __forceinline__ void moe_tables(const Args& a, const Ctx& c, int layer, LAS int* tab) {
    unsigned* gcnt = (unsigned*)(a.ws + WS_CTL) + CW_CNT + layer * 32;
    if (c.tid < 32) tab[40 + c.tid] = (int)__hip_atomic_load(gcnt + c.tid, __ATOMIC_RELAXED, __HIP_MEMORY_SCOPE_AGENT);
    __syncthreads();
    if (c.tid == 0) { int s = 0; for (int e = 0; e < 32; ++e) { tab[e] = s; s += (tab[40 + e] + 255) >> 8; } tab[32] = s; }
    __syncthreads();
}

__device__ __forceinline__ void ph_rpool(const Args& a, const Ctx& c, int layer) {
    constexpr int TR = 34, HR = TR + 15;
    LAS unsigned char* hs = c.lds;
    const float* g = a.in[I_NMIX] + layer * D;
    for (int tile = blockIdx.x; tile < TT / TR; tile += c.G) {
        const int r0 = tile * TR;
        for (int lr0 = c.wave; lr0 < HR; lr0 += 2 * NWAVES) {
            const int lrA = lr0, lrB = lr0 + NWAVES; const int grA = r0 - 8 + lrA, grB = r0 - 8 + lrB;
            const bool okA = grA >= 0 && grA < TT, okB = lrB < HR && grB >= 0 && grB < TT;
            const int cA = grA < 0 ? 0 : (grA > TT - 1 ? TT - 1 : grA), cB = grB < 0 ? 0 : (grB > TT - 1 ? TT - 1 : grB);
            f32x4 vA[4], vB[4], h[4]; load_row_combined(a, layer, cA, c.lane, vA); load_row_combined(a, layer, cB, c.lane, vB);
            if (okA) {
                if (lrA >= 8 && lrA < 8 + TR) { u32x2* xo = (u32x2*)((bf16*)(a.ws + WS_Z) + (size_t)grA * D) + c.lane;
#pragma unroll
                    for (int j = 0; j < 4; ++j) xo[64 * j] = (u32x2){cvtpk(vA[j].x, vA[j].y), cvtpk(vA[j].z, vA[j].w)}; }
                const float rstd = row_rstd(vA); const float* m = mod_row(a, layer, grA);
                norm_mod(vA, rstd, g, m, m + D, c.lane, h);
#pragma unroll
                for (int j = 0; j < 4; ++j) *(LAS u32x2*)(hs + lrA * 2048 + (4 * c.lane + 256 * j) * 2) = (u32x2){cvtpk(h[j].x, h[j].y), cvtpk(h[j].z, h[j].w)}; }
            if (okB) {
                if (lrB >= 8 && lrB < 8 + TR) { u32x2* xo = (u32x2*)((bf16*)(a.ws + WS_Z) + (size_t)grB * D) + c.lane;
#pragma unroll
                    for (int j = 0; j < 4; ++j) xo[64 * j] = (u32x2){cvtpk(vB[j].x, vB[j].y), cvtpk(vB[j].z, vB[j].w)}; }
                const float rstd = row_rstd(vB); const float* m = mod_row(a, layer, grB);
                norm_mod(vB, rstd, g, m, m + D, c.lane, h);
#pragma unroll
                for (int j = 0; j < 4; ++j) *(LAS u32x2*)(hs + lrB * 2048 + (4 * c.lane + 256 * j) * 2) = (u32x2){cvtpk(h[j].x, h[j].y), cvtpk(h[j].z, h[j].w)}; } }
        __syncthreads();
        { const int half = 1 << (c.tid >> 7);
          const LAS unsigned* col = (const LAS unsigned*)hs + c.tid;
          float sx = 0.f, sy = 0.f;
          unsigned* ho = (unsigned*)((bf16*)(a.ws + WS_HB) + (size_t)r0 * D) + c.tid;
          for (int t = 0; t < TR; ++t) { const int gr = r0 + t;
              const int s0 = gr < TL ? (gr / SEQ) * SEQ : TL + ((gr - TL) / CTXL) * CTXL, s1 = s0 + (gr < TL ? SEQ : CTXL);
              const int lo = (gr - half) > s0 ? (gr - half) : s0, hi = (gr + half) < s1 ? (gr + half) : s1;
              if (t == 0 || gr == s0) { sx = 0.f; sy = 0.f;
                  for (int w = lo; w < hi; ++w) { const unsigned u = col[(w - r0 + 8) * 512]; sx += bflo(u); sy += bfhi(u); } }
              else { if (gr + half - 1 < s1) { const unsigned w = col[(t + 8 + half - 1) * 512]; sx += bflo(w); sy += bfhi(w); }
                     if (gr - 1 - half >= s0) { const unsigned w = col[(t + 8 - 1 - half) * 512]; sx -= bflo(w); sy -= bfhi(w); } }
              const float inv = __builtin_amdgcn_rcpf((float)(hi - lo)); const unsigned u = col[(t + 8) * 512];
              ho[t * 512] = cvtpk(sx * inv - bflo(u), sy * inv - bfhi(u)); } }
        __syncthreads();
    }
}

struct EpiInproj { static constexpr bool PERM = true; bf16* Z; bf16* XBC; float* DT; const float* dtb;
    __device__ __forceinline__ void operator()(const AccT& acc, const pg8::Unit& u, int wr, int wc, int fr, int fq) const {
        const size_t r0 = (size_t)u.pm * 256;
        if (u.pn < 20) { bf16* base; int pitch; if (u.pn < 8) { base = Z + u.pn * 256; pitch = 2048; } else { base = XBC + (u.pn - 8) * 256; pitch = 3072; }
#pragma unroll
            for (int ai = 0; ai < 2; ++ai)
#pragma unroll
                for (int m = 0; m < 4; ++m) { bf16* rowp = base + (r0 + ai * 128 + wr * 64 + m * 16 + fr) * pitch + wc * 32 + 8 * fq;
#pragma unroll
                    for (int bj = 0; bj < 2; ++bj) { const f32x4 v0 = acc[ai][bj][m][0], v1 = acc[ai][bj][m][1];
                        *(u32x4*)(rowp + bj * 128) = (u32x4){cvtpk(v0[0], v0[1]), cvtpk(v0[2], v0[3]), cvtpk(v1[0], v1[1]), cvtpk(v1[2], v1[3])}; } }
        } else if (wc < 2) { const int col = wc * 32 + 8 * fq; const f32x4 b0 = *(const f32x4*)(dtb + col), b1 = *(const f32x4*)(dtb + col + 4);
#pragma unroll
            for (int ai = 0; ai < 2; ++ai)
#pragma unroll
                for (int m = 0; m < 4; ++m) { float* p = DT + (r0 + ai * 128 + wr * 64 + m * 16 + fr) * 64 + col; f32x4 v0 = acc[ai][0][m][0] + b0, v1 = acc[ai][0][m][1] + b1;
#pragma unroll
                    for (int e = 0; e < 4; ++e) { v0[e] = fmaxf(v0[e], 0.f) + log1pf(__expf(-fabsf(v0[e]))); v1[e] = fmaxf(v1[e], 0.f) + log1pf(__expf(-fabsf(v1[e]))); }
                    *(f32x4*)p = v0; *(f32x4*)(p + 4) = v1; } }
    }
};

__device__ __forceinline__ void ph_conv(const Args& a, const Ctx& c) {
    LAS unsigned char* tin = c.lds; LAS unsigned char* toT = c.lds + 17408; LAS unsigned char* toN = c.lds + 34816;
    const bf16* xbc = (const bf16*)(a.ws + WS_XBC);
    u32x4 pin[3];
#define CONV_PREFETCH(tk) do { const int ci_ = (tk) / 48, chb_ = (tk) % 48, r0_ = ci_ * 128, ch0_ = chb_ * 64; \
        _Pragma("unroll") for (int q = 0; q < 3; ++q) { int p = c.tid + 512 * q; p = p < 131 * 8 ? p : 131 * 8 - 1; const int lr = p >> 3, pc = p & 7; int row = r0_ - 2 + lr; row = row < 0 ? 0 : (row > TT - 1 ? TT - 1 : row); \
            pin[q] = *(const u32x4*)(xbc + (size_t)row * 3072 + ch0_ + pc * 8); } } while (0)
    { const int t0 = (int)blockIdx.x < NCH * 48 ? (int)blockIdx.x : NCH * 48 - 1; CONV_PREFETCH(t0); }
    for (int task = blockIdx.x; task < NCH * 48; task += c.G) {
        const int ci = task / 48, chb = task % 48, r0 = ci * 128, ch0 = chb * 64;
        const bool first = ci < 128 ? (ci % 32 == 0) : (((ci - 128) & 1) == 0), last = ci < 128 ? (ci % 32 == 31) : (((ci - 128) & 1) == 1);
        const int ch = c.tid & 63, tq = c.tid >> 6; const float* cw = a.in[I_CONVW] + ch0 + ch;
        const float w0 = cw[0], w1 = cw[3072], w2 = cw[2 * 3072], w3 = cw[3 * 3072], bias = a.in[I_CONVB][ch0 + ch];
#pragma unroll
        for (int q = 0; q < 3; ++q) { const int p = c.tid + 512 * q, lr = p >> 3; const bool zero = (lr < 2 && first) || (lr == 130 && last);
            if (p < 131 * 8) *(LAS u32x4*)(tin + lr * 128 + (p & 7) * 16) = zero ? (u32x4){0u, 0u, 0u, 0u} : pin[q]; }
        __syncthreads();
        { const int tn = task + c.G < NCH * 48 ? task + c.G : NCH * 48 - 1; CONV_PREFETCH(tn); }
        {
          float xin[19];
#pragma unroll
          for (int i = 0; i < 19; ++i) xin[i] = bf2f(*(const LAS bf16*)(tin + (16 * tq + i) * 128 + ch * 2));
          float o[16];
#pragma unroll
          for (int i = 0; i < 16; ++i) o[i] = silu_f(bias + w0 * xin[i] + w1 * xin[i + 1] + w2 * xin[i + 2] + w3 * xin[i + 3]);
          if (chb < 40) { *(LAS u32x4*)(toT + ch * 272 + tq * 32) = (u32x4){cvtpk(o[0], o[1]), cvtpk(o[2], o[3]), cvtpk(o[4], o[5]), cvtpk(o[6], o[7])};
                          *(LAS u32x4*)(toT + ch * 272 + tq * 32 + 16) = (u32x4){cvtpk(o[8], o[9]), cvtpk(o[10], o[11]), cvtpk(o[12], o[13]), cvtpk(o[14], o[15])}; }
          if (chb >= 32) {
#pragma unroll
              for (int i = 0; i < 16; ++i) *(LAS bf16*)(toN + (16 * tq + i) * 144 + ch * 2) = (bf16)(cvtpk(o[i], 0.f) & 0xffffu); } }
        __syncthreads();
        if (chb < 40) { bf16* dst = chb < 32 ? (bf16*)(a.ws + WS_XT) + ((size_t)ci * 2048 + ch0) * 128 : (bf16*)(a.ws + WS_BT) + ((size_t)ci * 512 + (ch0 - 2048)) * 128;
#pragma unroll
            for (int q = 0; q < 2; ++q) { const int p = c.tid + 512 * q, chl = p >> 4, pc = p & 15; *(u32x4*)(dst + chl * 128 + pc * 8) = *(const LAS u32x4*)(toT + chl * 272 + pc * 16); } }
        if (chb >= 32) { bf16* dst = chb < 40 ? (bf16*)(a.ws + WS_BN) + (size_t)r0 * 512 + (ch0 - 2048) : (bf16*)(a.ws + WS_CN) + (size_t)r0 * 512 + (ch0 - 2560);
#pragma unroll
            for (int q = 0; q < 2; ++q) { const int p = c.tid + 512 * q, t = p >> 3, pc = p & 7; *(u32x4*)(dst + (size_t)t * 512 + pc * 8) = *(const LAS u32x4*)(toN + t * 144 + pc * 16); } }
        __syncthreads();
    }
#undef CONV_PREFETCH
    const int gw = c.vcu * NWAVES + c.wave, NGW = c.G * NWAVES;
    const float* dt = (const float*)(a.ws + WS_DT);
    for (int item = gw; item < NCH * 32; item += NGW) { const int ci = item >> 5, h = item & 31, r0 = ci * 128 + 2 * c.lane;
        const float af = -expf(a.in[I_ALOG][h]), ab = -expf(a.in[I_ALOG][32 + h]);
        const float dtf0 = dt[(size_t)r0 * 64 + h], dtf1 = dt[(size_t)(r0 + 1) * 64 + h], dtb0 = dt[(size_t)r0 * 64 + 32 + h], dtb1 = dt[(size_t)(r0 + 1) * 64 + 32 + h];
        const float laf0 = dtf0 * af, laf1 = dtf1 * af, lab0 = dtb0 * ab, lab1 = dtb1 * ab;
        float inf_ = laf0 + laf1, inb = lab0 + lab1; const float pf = inf_, pbk = inb;
#pragma unroll
        for (int o = 1; o < 64; o <<= 1) { const float t1 = __shfl_up(inf_, o), t2 = __shfl_up(inb, o); if (c.lane >= o) { inf_ += t1; inb += t2; } }
        const float totf = __shfl(inf_, 63), totb = __shfl(inb, 63);
        const float exf = inf_ - pf, exb = inb - pbk;
        const float cf0 = exf + laf0, cf1 = inf_, pb0 = exb, pb1 = exb + lab0;
        f32x4* sca = (f32x4*)(a.ws + WS_SCA) + ((size_t)ci * 32 + h) * 128 + 2 * c.lane; f32x4* scb = (f32x4*)(a.ws + WS_SCB) + ((size_t)ci * 32 + h) * 128 + 2 * c.lane;
        { const float L2E = 1.4426950408889634f;
          sca[0] = (f32x4){cf0 * L2E, pb0 * L2E, cf0 * L2E - __log2f(dtf0), pb0 * L2E + __log2f(dtb0)}; sca[1] = (f32x4){cf1 * L2E, pb1 * L2E, cf1 * L2E - __log2f(dtf1), pb1 * L2E + __log2f(dtb1)}; }
        scb[0] = (f32x4){__expf(cf0), __expf(totb - pb0), dtf0 * __expf(totf - cf0), dtb0 * __expf(pb0)};
        scb[1] = (f32x4){__expf(cf1), __expf(totb - pb1), dtf1 * __expf(totf - cf1), dtb1 * __expf(pb1)};
        { float* wsc = (float*)(a.ws + WS_Q) + ((size_t)(ci * 32 + h) * 2) * 128 + 2 * c.lane;
          *(f32x2*)wsc = (f32x2){dtf0 * __expf(totf - cf0), dtf1 * __expf(totf - cf1)}; *(f32x2*)(wsc + 128) = (f32x2){dtb0 * __expf(pb0), dtb1 * __expf(pb1)}; }
        if (c.lane == 0) ((f32x2*)(a.ws + WS_DEC))[ci * 32 + h] = (f32x2){__expf(totf), __expf(totb)}; }
}

__device__ __forceinline__ void ph_scan(const Args& a, const Ctx& c) {
    constexpr int P = 272, BUF = 53248;
    LAS unsigned char* stg = c.lds + 2 * BUF + c.wave * 2048;
    const int r32 = c.lane & 31, hi = c.lane >> 5, pt = c.wave >> 2, nt = c.wave & 3;
    for (int task = c.vcu; task < 256; task += c.G) { const int b = task >> 6, dir = (task >> 5) & 1, h = task & 31, g = h >> 3;
        f32x16 acc = {};
        u32x4 xrA[2], brA[4], xrB[2], brB[4]; f32x4 wA0 = {}, wA1 = {}, wB0 = {}, wB1 = {}; f32x2 decA = {}, decB = {};
#define SCAN_CI(k) (dir == 0 ? ((k) < 2 ? 128 + 2 * b + (k) : 32 * b + ((k) - 2)) : ((k) < 2 ? 128 + 2 * b + 1 - (k) : 32 * b + 31 - ((k) - 2)))
#define SCAN_LOAD(k, xr, br, w0, w1, dcr) do { const int ci_ = SCAN_CI(k); const bf16* xs_ = (const bf16*)(a.ws + WS_XT) + ((size_t)ci_ * 2048 + 64 * h) * 128; const bf16* bs_ = (const bf16*)(a.ws + WS_BT) + ((size_t)ci_ * 512 + 128 * g) * 128; \
        _Pragma("unroll") for (int q = 0; q < 2; ++q) xr[q] = ((const u32x4*)xs_)[c.tid + 512 * q]; _Pragma("unroll") for (int q = 0; q < 4; ++q) br[q] = ((const u32x4*)bs_)[c.tid + 512 * q]; \
        { const f32x4* wp_ = (const f32x4*)((const float*)(a.ws + WS_Q) + ((size_t)(ci_ * 32 + h) * 2 + dir) * 128) + 2 * (c.tid & 15); w0 = wp_[0]; w1 = wp_[1]; }        \
        dcr = ((const f32x2*)(a.ws + WS_DEC))[ci_ * 32 + h]; } while (0)
#define SCAN_WRITE(bi, xr, br, w0, w1) do { LAS unsigned char* xb_ = c.lds + (bi) * BUF; LAS unsigned char* bb_ = xb_ + 17408;        \
        _Pragma("unroll") for (int q = 0; q < 2; ++q) { const int p = c.tid + 512 * q; const u32x4 v_ = xr[q]; \
            *(LAS u32x4*)(xb_ + (p >> 4) * P + (p & 15) * 16) = (u32x4){cvtpk(bflo(v_.x) * w0.x, bfhi(v_.x) * w0.y), cvtpk(bflo(v_.y) * w0.z, bfhi(v_.y) * w0.w), cvtpk(bflo(v_.z) * w1.x, bfhi(v_.z) * w1.y), cvtpk(bflo(v_.w) * w1.z, bfhi(v_.w) * w1.w)}; } \
        _Pragma("unroll") for (int q = 0; q < 4; ++q) { const int p = c.tid + 512 * q; *(LAS u32x4*)(bb_ + (p >> 4) * P + (p & 15) * 16) = br[q]; } } while (0)
#define SCAN_STEP(k, cur, dcr) do { const int ci = SCAN_CI(k); \
            { bf16* hin = (bf16*)(a.ws + WS_HIN) + (((size_t)ci * 2 + dir) * 32 + h) * 8192; \
              _Pragma("unroll") for (int r = 0; r < 16; ++r) *(LAS bf16*)(stg + ((r & 3) + 8 * (r >> 2) + 4 * hi) * 64 + r32 * 2) = (bf16)(cvtpk(acc[r], 0.f) & 0xffffu); \
              LDS_WAIT(); \
              _Pragma("unroll") for (int i = 0; i < 2; ++i) { const int row = (c.lane >> 2) + 16 * i, pc = c.lane & 3; *(u32x4*)(hin + (size_t)(32 * pt + row) * 128 + 32 * nt + pc * 8) = *(const LAS u32x4*)(stg + row * 64 + pc * 16); } } \
            const float dec = dir == 0 ? dcr.x : dcr.y; \
            _Pragma("unroll") for (int r = 0; r < 16; ++r) acc[r] *= dec; \
            { LAS unsigned char* xb = c.lds + (cur) * BUF; LAS unsigned char* bb = xb + 17408; \
              _Pragma("unroll") for (int kk = 0; kk < 8; ++kk) { const int s8 = 16 * kk + 8 * hi; \
                  const bf16x8 xs = *(const LAS bf16x8*)(xb + (32 * pt + r32) * P + s8 * 2), bfrag = *(const LAS bf16x8*)(bb + (32 * nt + r32) * P + s8 * 2); \
                  acc = __builtin_amdgcn_mfma_f32_32x32x16_bf16(xs, bfrag, acc, 0, 0, 0); } } } while (0)
        f32x2 dcur0, dcur1;
        SCAN_LOAD(0, xrA, brA, wA0, wA1, decA); SCAN_LOAD(1, xrB, brB, wB0, wB1, decB); SCAN_WRITE(0, xrA, brA, wA0, wA1); dcur0 = decA;
        __syncthreads();
        for (int k = 0; k < 34; k += 2) {
            { const int kn = k + 2 < 34 ? k + 2 : 33; SCAN_LOAD(kn, xrA, brA, wA0, wA1, decA); }
            SCAN_STEP(k, 0, dcur0);
            SCAN_WRITE(1, xrB, brB, wB0, wB1); dcur1 = decB;
            __syncthreads();
            { const int kn = k + 3 < 34 ? k + 3 : 33; SCAN_LOAD(kn, xrB, brB, wB0, wB1, decB); }
            SCAN_STEP(k + 1, 1, dcur1);
            SCAN_WRITE(0, xrA, brA, wA0, wA1); dcur0 = decA;
            __syncthreads();
        }
#undef SCAN_CI
#undef SCAN_LOAD
#undef SCAN_WRITE
#undef SCAN_STEP
    }
}

__device__ __forceinline__ int crow16(int r, int hi) { return (r & 3) + 8 * (r >> 2) + 4 * hi; }
__device__ __forceinline__ void ph_yph(const Args& a, const Ctx& c, unsigned* rdg) {
    constexpr int P = 272, ZP = 144;
    LAS unsigned char* Cs = c.lds; LAS unsigned char* Bs = c.lds + 34816; LAS unsigned char* xs = c.lds + 69632; LAS unsigned char* hf = c.lds + 87040; LAS unsigned char* hb = c.lds + 104448;
    LAS unsigned char* zs = c.lds + 121856; LAS unsigned char* os = c.lds + 140288; LAS f32x4* sca = (LAS f32x4*)(c.lds + 158720); LAS f32x2* scb = (LAS f32x2*)(c.lds + 160768);
    LAS float* sbv = (LAS float*)(c.lds + 161792); LAS float* scv = (LAS float*)(c.lds + 162304); LAS float* ssql = (LAS float*)(c.lds + 34816); LAS float* ngs = (LAS float*)(c.lds + 34816 + 2048);
    const int lb = c.wave & 3, pb = c.wave >> 2;
    SECT_DECL
    int vq = c.vcu; asm volatile("" : "+s"(vq));
    const int ntask = (c.G == 256) ? (vq < 16 ? 1 : (vq < 64 ? 3 : 2)) : (NCH * 4 - 1 - vq) / c.G + 1;
    for (int ti = 0; ti < ntask; ++ti) {
        const int task = (c.G == 256) ? (ti == 0 ? vq : (ti == 1 ? 240 + vq : 480 + vq)) : vq + ti * c.G;
        const int ci = task >> 2, g = task & 3, r0 = ci * 128;
        int tid_t = c.tid; asm volatile("" : "+v"(tid_t));
        f32x16 X[4]; int l0; const float ngr = a.in[I_SNORM][512 * g + c.tid];
        u32x4 pxt[2], phf[2], phb[2], pz[2]; f32x4 ps1 = {}; f32x4 ps4 = {};
#define YPH_PREFETCH(hq) do { const int h_ = 8 * g + (hq); const u32x4* xt_ = (const u32x4*)((const bf16*)(a.ws + WS_XT) + ((size_t)ci * 2048 + 64 * h_) * 128); \
            const u32x4* hfg_ = (const u32x4*)((const bf16*)(a.ws + WS_HIN) + (((size_t)ci * 2 + 0) * 32 + h_) * 8192); const u32x4* hbg_ = (const u32x4*)((const bf16*)(a.ws + WS_HIN) + (((size_t)ci * 2 + 1) * 32 + h_) * 8192); \
            const bf16* zg_ = (const bf16*)(a.ws + WS_Z) + (size_t)r0 * 2048 + 64 * h_; \
            _Pragma("unroll") for (int q = 0; q < 2; ++q) { const int p = tidp + 512 * q; pxt[q] = __builtin_nontemporal_load(xt_ + p); phf[q] = __builtin_nontemporal_load(hfg_ + p); phb[q] = __builtin_nontemporal_load(hbg_ + p); \
                pz[q] = __builtin_nontemporal_load((const u32x4*)(zg_ + (size_t)(p >> 3) * 2048 + (p & 7) * 8)); }        \
            ps1 = ((const f32x4*)(a.ws + WS_SCA))[((size_t)ci * 32 + h_) * 128 + (tidp & 127)]; ps4 = ((const f32x4*)(a.ws + WS_SCB))[((size_t)ci * 32 + h_) * 128 + (tidp & 127)]; } while (0)
        { const int tid = tid_t, lane = tid & 63, r32 = lane & 31, hi = lane >> 5; l0 = 32 * lb + r32;
          { const bf16* cn = (const bf16*)(a.ws + WS_CN) + (size_t)r0 * 512 + 128 * g; const bf16* bn = (const bf16*)(a.ws + WS_BN) + (size_t)r0 * 512 + 128 * g;
#pragma unroll
            for (int q = 0; q < 4; ++q) { const int p = tid + 512 * q, row = p >> 4, pc = p & 15;
                *(LAS u32x4*)(Cs + row * P + pc * 16) = *(const u32x4*)(cn + (size_t)row * 512 + pc * 8); *(LAS u32x4*)(Bs + row * P + pc * 16) = *(const u32x4*)(bn + (size_t)row * 512 + pc * 8); } }
          { const int tidp = tid; YPH_PREFETCH(0); }
          __syncthreads();
#pragma unroll
          for (int sb = 0; sb < 4; ++sb) { X[sb] = (f32x16){};
#pragma unroll
              for (int kk = 0; kk < 8; ++kk) { const int k8 = (16 * kk + 8 * hi) * 2;
                  X[sb] = __builtin_amdgcn_mfma_f32_32x32x16_bf16(*(const LAS bf16x8*)(Bs + (32 * sb + r32) * P + k8), *(const LAS bf16x8*)(Cs + (32 * lb + r32) * P + k8), X[sb], 0, 0, 0); } }
        }
        SECT(0);
        float ssq = 0.f;
#pragma unroll 1
        for (int hh = 0; hh < 8; ++hh) { const int h = 8 * g + hh;
            int tid = c.tid; asm volatile("" : "+v"(tid)); const int lane = tid & 63, r32 = lane & 31, hi = lane >> 5, l = 32 * lb + r32; (void)lane;
            const float dsum = a.in[I_DSK][h] + a.in[I_DSK][32 + h];
            __syncthreads();
            SECT(1);
            if (hh > 0) { const __amdgpu_buffer_rsrc_t grs = __builtin_amdgcn_make_buffer_rsrc((void*)(a.ws + WS_G), 0, TT * 2048 * 2, 0x00020000);
#pragma unroll
                for (int q = 0; q < 2; ++q) { const int p = tid + 512 * q, zr = p >> 3, zc = p & 7;
                    __builtin_amdgcn_raw_buffer_store_b128(*(const LAS u32x4*)(os + zr * ZP + zc * 16), grs, ((r0 + zr) * 2048 + 64 * (h - 1) + zc * 8) * 2, 0, 16  ); } }
#pragma unroll
            for (int q = 0; q < 2; ++q) { const int p = tid + 512 * q, row = p >> 4, pc = p & 15;
                *(LAS u32x4*)(xs + row * P + pc * 16) = pxt[q]; *(LAS u32x4*)(hf + row * P + pc * 16) = phf[q]; *(LAS u32x4*)(hb + row * P + pc * 16) = phb[q];
                *(LAS u32x4*)(zs + (p >> 3) * ZP + (p & 7) * 16) = pz[q]; }
            if (tid < 128) { sca[tid] = ps1; scb[tid] = (f32x2){ps4.x, ps4.y}; sbv[tid] = ps1.z; scv[tid] = ps1.w; }
            if (hh == 0) ngs[tid] = ngr;
            __syncthreads();
            SECT(2);
            if (hh < 7) { const int tidp = tid; YPH_PREFETCH(hh + 1); }
            SECT(3);
            const f32x4 me = sca[l]; const f32x2 ee = scb[l];
            const float dtb_l = __builtin_amdgcn_exp2f(me.w - me.y);
            f32x16 accd = {};
#pragma unroll
            for (int sb = 0; sb < 4; ++sb) { unsigned mp[8];
#pragma unroll
                for (int q = 0; q < 4; ++q) { const int s0 = 32 * sb + 8 * q + 4 * hi; float mv[4];
                    if (sb < lb) { const f32x4 bs4 = *(const LAS f32x4*)(sbv + s0);
#pragma unroll
                        for (int e = 0; e < 4; ++e) mv[e] = X[sb][4 * q + e] * __builtin_amdgcn_exp2f(me.x - bs4[e]); }
                    else if (sb > lb) { const f32x4 cs4 = *(const LAS f32x4*)(scv + s0);
#pragma unroll
                        for (int e = 0; e < 4; ++e) mv[e] = X[sb][4 * q + e] * __builtin_amdgcn_exp2f(cs4[e] - me.y); }
                    else { const f32x4 bs4 = *(const LAS f32x4*)(sbv + s0), cs4 = *(const LAS f32x4*)(scv + s0);
#pragma unroll
                        for (int e = 0; e < 4; ++e) { const int s = s0 + e; const float t = (s <= l) ? (me.x - bs4[e]) : (cs4[e] - me.y); const float xv = X[sb][4 * q + e];
                            float m = xv * __builtin_amdgcn_exp2f(t); if (s == l) m += xv * dtb_l + dsum; mv[e] = m; } }
                    mp[2 * q] = cvtpk(mv[0], mv[1]); mp[2 * q + 1] = cvtpk(mv[2], mv[3]); }
#pragma unroll
                for (int t = 0; t < 2; ++t) { const int sof = (32 * sb + 16 * t + 4 * hi) * 2;
                    const u32x2 lo = *(const LAS u32x2*)(xs + (32 * pb + r32) * P + sof), h2 = *(const LAS u32x2*)(xs + (32 * pb + r32) * P + sof + 16);
                    const u32x4 af = (u32x4){lo.x, lo.y, h2.x, h2.y}, bfm = (u32x4){mp[4 * t], mp[4 * t + 1], mp[4 * t + 2], mp[4 * t + 3]};
                    accd = __builtin_amdgcn_mfma_f32_32x32x16_bf16(__builtin_bit_cast(bf16x8, af), __builtin_bit_cast(bf16x8, bfm), accd, 0, 0, 0); }
                }
            SECT(4);
#pragma unroll
            for (int dd = 0; dd < 2; ++dd) { f32x16 acco = {}; LAS unsigned char* hx = dd == 0 ? hf : hb;
#pragma unroll
                for (int kk = 0; kk < 8; ++kk) { const int k8 = (16 * kk + 8 * hi) * 2;
                    acco = __builtin_amdgcn_mfma_f32_32x32x16_bf16(*(const LAS bf16x8*)(hx + (32 * pb + r32) * P + k8), *(const LAS bf16x8*)(Cs + (32 * lb + r32) * P + k8), acco, 0, 0, 0); }
                const float ex = dd == 0 ? ee.x : ee.y;
#pragma unroll
                for (int r = 0; r < 16; ++r) accd[r] += ex * acco[r]; }
            SECT(5);
#pragma unroll
            for (int q = 0; q < 4; ++q) { const int pcol = 32 * pb + 8 * q + 4 * hi; const u32x2 zq = *(const LAS u32x2*)(zs + l * ZP + pcol * 2);
                float gv[4];
#pragma unroll
                for (int e = 0; e < 4; ++e) { const int r = 4 * q + e; const float y = accd[r];
                    const float z = (e == 0) ? bflo(zq.x) : (e == 1) ? bfhi(zq.x) : (e == 2) ? bflo(zq.y) : bfhi(zq.y); gv[e] = y * silu_f(z); ssq += gv[e] * gv[e]; }
                const f32x4 ng4 = *(const LAS f32x4*)(ngs + 64 * hh + pcol);
                *(LAS u32x2*)(os + l * ZP + pcol * 2) = (u32x2){cvtpk(gv[0] * ng4.x, gv[1] * ng4.y), cvtpk(gv[2] * ng4.z, gv[3] * ng4.w)}; }
            SECT(6);
        }
#undef YPH_PREFETCH
        __syncthreads();
        { const __amdgpu_buffer_rsrc_t grs = __builtin_amdgcn_make_buffer_rsrc((void*)(a.ws + WS_G), 0, TT * 2048 * 2, 0x00020000);
#pragma unroll
          for (int q = 0; q < 2; ++q) { const int p = c.tid + 512 * q, zr = p >> 3, zc = p & 7;
              __builtin_amdgcn_raw_buffer_store_b128(*(const LAS u32x4*)(os + zr * ZP + zc * 16), grs, ((r0 + zr) * 2048 + 64 * (8 * g + 7) + zc * 8) * 2, 0, 16  ); } }
        ssq += __shfl_xor(ssq, 32);
        if ((c.lane >> 5) == 0) ssql[pb * 128 + l0] = ssq;
        __syncthreads();
        if (c.tid < 128) { const __amdgpu_buffer_rsrc_t rrs = __builtin_amdgcn_make_buffer_rsrc((void*)(a.ws + WS_RSTD), 0, TT * 4 * 4, 0x00020000);
            __builtin_amdgcn_raw_buffer_store_b32(__float_as_uint(rsqrtf((ssql[c.tid] + ssql[128 + c.tid]) * (1.0f / 512.0f) + EPS)), rrs, ((r0 + c.tid) * 4 + g) * 4, 0, 16  ); }
        VM_WAIT();
        __syncthreads();
        if (c.tid == 0) __hip_atomic_fetch_add(rdg + (ci >> 1), 1u, __ATOMIC_RELAXED, __HIP_MEMORY_SCOPE_AGENT);
        SECT(7);
    }
    SECT_END(40);
}
__device__ __forceinline__ void ph_gfix(const Args& a, const Ctx& c) {
    const float* ng = a.in[I_SNORM]; const float* rs = (const float*)(a.ws + WS_RSTD);
    const int n16 = TT * 256;
    for (int p = blockIdx.x * NTHREADS + c.tid; p < n16; p += c.G * NTHREADS) { const int r = p >> 8, col = (p & 255) * 8;
        u32x4* gp = (u32x4*)((bf16*)(a.ws + WS_G) + (size_t)r * 2048 + col); const u32x4 v = *gp; const float s = rs[r * 4 + (col >> 9)];
        const f32x4 g0 = *(const f32x4*)(ng + col), g1 = *(const f32x4*)(ng + col + 4);
        *gp = (u32x4){cvtpk(bflo(v.x) * s * g0.x, bfhi(v.x) * s * g0.y), cvtpk(bflo(v.y) * s * g0.z, bfhi(v.y) * s * g0.w), cvtpk(bflo(v.z) * s * g1.x, bfhi(v.z) * s * g1.y), cvtpk(bflo(v.w) * s * g1.z, bfhi(v.w) * s * g1.w)}; }
}

#if DEBUG_CHECKS
__device__ __forceinline__ float dbg_hb(const Args& a, int layer, size_t idx, float sh) {
    if (ATT_FP8 && layer != 2) return __builtin_amdgcn_cvt_f32_fp8((unsigned)((const unsigned char*)(a.ws + WS_HB))[idx], 0) * sh;
    return bf2f(((const bf16*)(a.ws + WS_HB))[idx]); }
__device__ __forceinline__ int dbg_sample_row(int b) { const int SR[16] = {0, 1, 77, 4095, 4096, 5000, 8191, 9000, 12288, 16383, 16384, 16385, 16384 + 255, 16384 + 256, 17000, 17407}; int r = 0;
#pragma unroll
    for (int i = 0; i < 16; ++i) r = (b == i) ? SR[i] : r;
    return r; }
__device__ __forceinline__ float blk_sum(float v, LAS float* red, int tid) {
    v = wave_sum(v); __syncthreads(); if ((tid & 63) == 0) red[tid >> 6] = v; __syncthreads(); float s = 0.f;
#pragma unroll
    for (int i = 0; i < 8; ++i) s += red[i];
    __syncthreads(); return s; }
__device__ __forceinline__ float blk_max(float v, LAS float* red, int tid) {
#pragma unroll
    for (int o = 1; o < 64; o <<= 1) v = fmaxf(v, __shfl_xor(v, o));
    __syncthreads(); if ((tid & 63) == 0) red[tid >> 6] = v; __syncthreads(); float s = red[0];
#pragma unroll
    for (int i = 1; i < 8; ++i) s = fmaxf(s, red[i]);
    __syncthreads(); return s; }
__device__ __forceinline__ void dbg_report(const Args& a, int id, float err, float ssref, float n, int tid) {
    if (tid == 0) { float rel = err / (sqrtf(ssref / n) + 1e-20f); if (!(rel == rel)) rel = 1e30f; atomicMax((unsigned*)(a.ws + WS_CTL) + CW_DBG + id, __float_as_uint(rel)); } }
__device__ __forceinline__ float dbg_mod(const Args& a, int layer, int r, int j) {
    const float* cv = r < TL ? a.in[I_C] + (r / SEQ) * 1024 : a.in[I_CCTX]; float s = 0.f;
    _Pragma("nounroll") for (int k = 0; k < 1024; ++k) { const float x = cv[k]; s += (x / (1.0f + expf(-x))) * a.in[I_WADA][((size_t)layer * 1024 + k) * 6144 + j]; }
    return s + a.in[I_BADA][layer * 6144 + j]; }

__device__ __forceinline__ void chk_rmix(const Args& a, int layer, int id, LAS unsigned char* ldsb) {
    if (blockIdx.x >= 16) return; const int tid = tid_opaque(), r = dbg_sample_row(blockIdx.x);
    LAS float* red = (LAS float*)ldsb;
    const float* x = resid_row(a, layer, r); const bf16* hb = (const bf16*)(a.ws + WS_HB) + (size_t)r * D;
    float ss = 0.f; for (int cc = tid; cc < D; cc += 512) ss += x[cc] * x[cc];
    ss = blk_sum(ss, red, tid); const float rstd = rsqrtf(ss / D + EPS);
    float err = 0.f, sr = 0.f;
    for (int cc = tid; cc < D; cc += 512) { const float sh = dbg_mod(a, layer, r, cc), sc = dbg_mod(a, layer, r, D + cc);
        const float ref = x[cc] * rstd * a.in[I_NMIX][layer * D + cc] * (1.f + sc) + sh; err = fmaxf(err, fabsf(ref - dbg_hb(a, layer, (size_t)r * D + cc, 1.f))); sr += ref * ref; }
    err = blk_max(err, red, tid); sr = blk_sum(sr, red, tid); dbg_report(a, id, err, sr, D, tid);
}
__device__ __forceinline__ void chk_qkv(const Args& a, int layer, int id, LAS unsigned char* ldsb) {
    if (blockIdx.x >= 16) return; const int tid = tid_opaque(), r = dbg_sample_row(blockIdx.x), j = layer ? 1 : 0;
    LAS float* red = (LAS float*)ldsb; LAS float* y = red + 16; LAS float* hrow = y + 1536;
    const bf16* hb = (const bf16*)(a.ws + WS_HB) + (size_t)r * D;
    _Pragma("nounroll") for (int k = tid; k < D; k += 512) hrow[k] = dbg_hb(a, layer, (size_t)r * D + k, 1.f);
    __syncthreads();
    for (int n = tid; n < 1536; n += 512) { float s = 0.f; const float* w = a.in[I_WQKV] + (size_t)j * 1024 * 1536 + n; _Pragma("nounroll") for (int k = 0; k < 1024; ++k) s += hrow[k] * w[(size_t)k * 1536]; y[n] = s; }
    __syncthreads();
    float err = 0.f, sr = 0.f;
    for (int n = tid; n < 1536; n += 512) { float ref;
        if (n < 1280) { const int h0 = n & ~63; float ss = 0.f; _Pragma("nounroll") for (int q = 0; q < 64; ++q) ss += y[h0 + q] * y[h0 + q];
            const float rstd = rsqrtf(ss / 64.f + EPS); const float* g = (n < 1024 ? a.in[I_QG] : a.in[I_KG]) + j * 64;
            float v = y[n] * rstd * g[n & 63], vp = y[n ^ 1] * rstd * g[(n ^ 1) & 63];
            if (r < TL) { const int t = r % SEQ, i = (n & 63) >> 1, f = i & 15, pos = i < 16 ? t / 64 : t % 64; const float inv = powf(10000.f, -(float)f / 16.f), ang = (float)pos * inv, cs = cosf(ang), sn = sinf(ang);
                v = (n & 1) ? (vp * sn + v * cs) : (v * cs - vp * sn); }
            if (n < 1024) v *= 0.125f * 1.4426950408889634f;
            ref = v; } else ref = y[n];
        float got;
        if (n < 1024) { if (layer == 3 && r >= TL) continue; got = bf2f(((const bf16*)(a.ws + WS_Q))[(size_t)r * 1024 + n]); }
        else if (n < 1280) got = bf2f(((const bf16*)(a.ws + WS_K))[kv_row(r) * 256 + (n - 1024)]);
        else got = bf2f(((const bf16*)(a.ws + WS_V))[kv_row(r) * 256 + (n - 1280)]);
        err = fmaxf(err, fabsf(ref - got)); sr += ref * ref; }
    err = blk_max(err, red, tid); sr = blk_sum(sr, red, tid); dbg_report(a, id, err, sr, 1536, tid);
}
__device__ __forceinline__ void chk_att(const Args& a, int layer, int id, LAS unsigned char* ldsb) {
    if (blockIdx.x >= 16) return; const int tid = tid_opaque(), r = dbg_sample_row(blockIdx.x);
    if (layer == 3 && r >= TL) return;
    LAS float* red = (LAS float*)ldsb; LAS float* sc = red + 16; LAS float* po = sc + 4352;
    const int nk = r < TL ? KVROWS : CTXL; const long kv0 = (long)(r < TL ? r / SEQ : (r - TL) / CTXL) * KVROWS;
    const bf16* Qb = (const bf16*)(a.ws + WS_Q); const bf16* Kb = (const bf16*)(a.ws + WS_K); const bf16* Vb = (const bf16*)(a.ws + WS_V); const bf16* Ob = (const bf16*)(a.ws + WS_HB);
    float err = 0.f, sr = 0.f;
    for (int h = 0; h < 16; ++h) {
        float mx = -3e38f;
        _Pragma("nounroll") for (int jk = tid; jk < nk; jk += 512) { float s = 0.f; _Pragma("nounroll") for (int d = 0; d < 64; ++d) s += bf2f(Qb[(size_t)r * 1024 + h * 64 + d]) * bf2f(Kb[(kv0 + jk) * 256 + (h >> 2) * 64 + d]); sc[jk] = s; mx = fmaxf(mx, s); }
        mx = blk_max(mx, red, tid);
        float l = 0.f; _Pragma("nounroll") for (int jk = tid; jk < nk; jk += 512) { const float p = exp2f(sc[jk] - mx); sc[jk] = p; l += p; }
        l = blk_sum(l, red, tid);
        { const int d = tid & 63, part = tid >> 6; float o = 0.f; _Pragma("nounroll") for (int jk = part; jk < nk; jk += 8) o += sc[jk] * bf2f(Vb[(kv0 + jk) * 256 + (h >> 2) * 64 + d]); po[part * 64 + d] = o; }
        __syncthreads();
        if (tid < 64) { float o = 0.f; _Pragma("nounroll") for (int p = 0; p < 8; ++p) o += po[p * 64 + tid]; o /= l; err = fmaxf(err, fabsf(o - dbg_hb(a, layer, (size_t)r * 1024 + h * 64 + tid, 1.f / (float)(1 << ATT_OSH)))); sr += o * o; }
        __syncthreads();
    }
    err = blk_max(err, red, tid); sr = blk_sum(sr, red, tid); dbg_report(a, id, err, sr, 1024, tid);
}
__device__ __forceinline__ void chk_oproj(const Args& a, int layer, int id, LAS unsigned char* ldsb) {
    if (blockIdx.x >= 16 || layer != 0) return; const int tid = tid_opaque(), r = dbg_sample_row(blockIdx.x), j = 0;
    LAS float* red = (LAS float*)ldsb; LAS float* orow = red + 16;
    const bf16* Ob = (const bf16*)(a.ws + WS_HB) + (size_t)r * D;
    _Pragma("nounroll") for (int k = tid; k < D; k += 512) orow[k] = dbg_hb(a, layer, (size_t)r * D + k, 1.f / (float)(1 << ATT_OSH));
    __syncthreads();
    float err = 0.f, sr = 0.f;
    for (int n = tid; n < D; n += 512) { float s = 0.f; const float* w = a.in[I_WO] + (size_t)j * 1024 * 1024 + n; _Pragma("nounroll") for (int k = 0; k < 1024; ++k) s += orow[k] * w[(size_t)k * 1024];
        const float dl = dbg_mod(a, layer, r, 2 * D + n) * s, ref = resid_row(a, 0, r)[n] + dl; err = fmaxf(err, fabsf(ref - ((const float*)(a.ws + WS_X))[(size_t)r * D + n])); sr += dl * dl; }
    err = blk_max(err, red, tid); sr = blk_sum(sr, red, tid); dbg_report(a, id, err, sr, D, tid);
}
__device__ __forceinline__ void chk_moe(const Args& a, int layer, int id_tok, int id_y, LAS unsigned char* ldsb) {
    if (blockIdx.x >= 16) return; const int tid = tid_opaque(), r = dbg_sample_row(blockIdx.x);
    if (layer == 3 && r >= TL) return;
    LAS float* red = (LAS float*)ldsb; LAS float* tok = red + 16; LAS float* lg = tok + 1024; LAS float* tkb = lg + 64; LAS float* act = tkb + 1024; LAS float* rt = act + 1024;
    const float* x = (const float*)(a.ws + WS_X) + (size_t)r * D; const bf16* tk = (const bf16*)(a.ws + WS_TK) + (size_t)r * D;
    float ss = 0.f; for (int cc = tid; cc < D; cc += 512) ss += x[cc] * x[cc];
    ss = blk_sum(ss, red, tid); const float rstd = rsqrtf(ss / D + EPS);
    float err = 0.f, sr = 0.f;
    for (int cc = tid; cc < D; cc += 512) { const float sh = dbg_mod(a, layer, r, 3 * D + cc), sc = dbg_mod(a, layer, r, 4 * D + cc);
        const float ref = x[cc] * rstd * a.in[I_NFFN][layer * D + cc] * (1.f + sc) + sh; tok[cc] = ref;
#if MOE_FP8
        tkb[cc] = __builtin_amdgcn_cvt_f32_fp8((unsigned)((const unsigned char*)(a.ws + WS_TK))[(size_t)r * D + cc], 0);
#else
        tkb[cc] = bf2f(tk[cc]);
#endif
        err = fmaxf(err, fabsf(ref - tkb[cc])); sr += ref * ref; }
    err = blk_max(err, red, tid); sr = blk_sum(sr, red, tid);
    if (tid < 36) { float s = 0.f; _Pragma("nounroll") for (int k = 0; k < 1024; ++k) s += tok[k] * (tid < 4 ? a.in[I_WRG][((size_t)layer * 1024 + k) * 4 + tid] : a.in[I_WRE][((size_t)layer * 1024 + k) * 32 + tid - 4]); lg[tid] = s; }
    __syncthreads();
    if (tid == 0) { int grp = 0; _Pragma("nounroll") for (int q = 1; q < 4; ++q) if (lg[q] > lg[grp]) grp = q; float den = 0.f; _Pragma("nounroll") for (int q = 0; q < 4; ++q) den += expf(lg[q] - lg[grp]);
        const LAS float* le = lg + 4 + grp * 8; int i0 = 0; _Pragma("nounroll") for (int q = 1; q < 8; ++q) if (le[q] > le[i0]) i0 = q; int i1 = -1; _Pragma("nounroll") for (int q = 0; q < 8; ++q) if (q != i0 && (i1 < 0 || le[q] > le[i1])) i1 = q;
        const float ex = expf(le[i1] - le[i0]), w0 = 1.f / den / (1.f + ex), w1 = 1.f / den * ex / (1.f + ex);
        rt[0] = (float)(grp * 8 + i0); rt[1] = (float)(grp * 8 + i1); rt[2] = w0; rt[3] = w1;
        const float* w2 = (const float*)(a.ws + WS_W2); float e2 = fmaxf(fabsf(w2[2 * r] - w0), fabsf(w2[2 * r + 1] - w1)) * 30.f;
        const int* list = (const int*)(a.ws + WS_LIST); const unsigned* gc = (const unsigned*)(a.ws + WS_CTL) + CW_CNT + layer * 32;
        _Pragma("nounroll") for (int k = 0; k < 2; ++k) { const int e = (int)rt[k]; bool found = false; const int n = (int)gc[e]; _Pragma("nounroll") for (int q = 0; q < n && q < MOE_CAP; ++q) if (list[e * MOE_CAP + q] == 2 * r + k) found = true; if (!found) e2 = 1e6f; }
        rt[4] = e2; }
    __syncthreads();
    err = fmaxf(err, rt[4] * sqrtf(sr / D));
    dbg_report(a, id_tok, err, sr, D, tid);
    float err2 = 0.f, sr2 = 0.f;
    _Pragma("nounroll") for (int k = 0; k < 2; ++k) { const int e = (int)rt[k]; const float wk = rt[2 + k];
        const float* wgu = a.in[I_WGU] + ((size_t)layer * 32 + e) * 1024 * 1024; const float* wdn = a.in[I_WDN] + ((size_t)layer * 32 + e) * 512 * 1024;
        { float sg = 0.f, su = 0.f; _Pragma("nounroll") for (int q = 0; q < 1024; ++q) { sg += tkb[q] * wgu[(size_t)q * 1024 + tid]; su += tkb[q] * wgu[(size_t)q * 1024 + 512 + tid]; } act[tid] = (sg / (1.f + expf(-sg))) * su; }
        __syncthreads();
        for (int n = tid; n < D; n += 512) { float s = 0.f; _Pragma("nounroll") for (int q = 0; q < 512; ++q) s += act[q] * wdn[(size_t)q * 1024 + n]; s *= wk;
            err2 = fmaxf(err2, fabsf(s - bf2f(((const bf16*)(a.ws + WS_Y2))[(size_t)(2 * r + k) * D + n]))); sr2 += s * s; }
        __syncthreads(); }
    err2 = blk_max(err2, red, tid); sr2 = blk_sum(sr2, red, tid); dbg_report(a, id_y, err2, sr2, 2 * D, tid);
}

__global__ void __launch_bounds__(NTHREADS) dbg_kernel(Args a, int ty, int layer, int id) {
    extern __shared__ __attribute__((aligned(16))) unsigned char lds_dbg[];
    LAS unsigned char* l = (LAS unsigned char*)lds_dbg;
    if (ty == 1) chk_rmix(a, layer, id, l); else if (ty == 2) chk_qkv(a, layer, id, l); else if (ty == 3) chk_att(a, layer, id, l);
    else if (ty == 4) chk_oproj(a, layer, id, l); else if (ty == 5) chk_moe(a, layer, id, id + 1, l);
}
#endif

template <int KIND, int LAYER> __device__ __forceinline__ void run_phase(const Args& a0, Ctx& c, unsigned char* lds_gen) {
    Args a = a0; { unsigned long long wsv = (unsigned long long)a0.ws; asm volatile("" : "+s"(wsv)); a.ws = (unsigned char*)(GAS unsigned char*)wsv; }
    { unsigned lb = (unsigned)(uintptr_t)(LAS unsigned char*)lds_gen; asm volatile("" : "+s"(lb)); c.lds = (LAS unsigned char*)(uintptr_t)lb; }
    c.tid = tid_opaque(); c.lane = c.tid & 63;
    unsigned char* const ws = a.ws; constexpr int layer = LAYER;
#define RELAUNDER() do { { unsigned long long wsv_ = (unsigned long long)a0.ws; asm volatile("" : "+s"(wsv_)); a.ws = (unsigned char*)(GAS unsigned char*)wsv_; } \
        { unsigned lb_ = (unsigned)(uintptr_t)(LAS unsigned char*)lds_gen; asm volatile("" : "+s"(lb_)); c.lds = (LAS unsigned char*)(uintptr_t)lb_; } c.tid = tid_opaque(); c.lane = c.tid & 63; } while (0)
    if constexpr (KIND == K_P0) p0_prologue(a, c);
    else if constexpr (KIND == K_RMIX) ph_rmix(a, c, layer);
    else if constexpr (KIND == K_QKV) { constexpr int j = layer ? 1 : 0;
#if ATT_FP8
        SchedQKV S{(const char*)(ws + WS_HB), (const char*)(ws + WS_WQKV) + (size_t)j * 1536 * 1024, (size_t)256 * 1024, layer == 0 ? 1 : 0, c.G, (int)blockIdx.x};
        LAS f32x2* ltab = (LAS f32x2*)(c.lds + 136192);
        for (int q = c.tid; q < 1024; q += NTHREADS) ltab[(q >> 4) * 17 + (q & 15)] = ((const f32x2*)(ws + WS_ROPE))[q];
        __syncthreads();
        EpiQKV E{(bf16*)(ws + WS_Q), (bf16*)(ws + WS_K), (bf16*)(ws + WS_V), a.in[I_QG] + j * 64, a.in[I_KG] + j * 64, ltab};
        pg8::gemm_phase<EpiQKV, SchedQKV, false, true>(c.lds, 1024, 1024, S, E, 127 - MOE_WSH, 127); }
#else
        SchedQKV S{(const char*)(ws + WS_HB), (const char*)(ws + WS_WQKV) + (size_t)j * 1536 * 1024 * 2, (size_t)256 * 1024 * 2, layer == 0 ? 1 : 0, c.G, (int)blockIdx.x};
        EpiQKV E{(bf16*)(ws + WS_Q), (bf16*)(ws + WS_K), (bf16*)(ws + WS_V), a.in[I_QG] + j * 64, a.in[I_KG] + j * 64, (const f32x2*)(ws + WS_ROPE)};
        pg8::gemm_phase<EpiQKV, SchedQKV, false>(c.lds, 2048, 2048, S, E); }
#endif
    else if constexpr (KIND == K_ROPE) ph_rope(a, c, layer);
    else if constexpr (KIND == K_ATT) ph_att(a, c, layer, (char*)c.lds);
    else if constexpr (KIND == K_OPROJ) { constexpr int j = layer ? 1 : 0;
#if ATT_FP8
        unsigned* rdx = (unsigned*)(ws + WS_CTL) + CW_RDX + layer * 128;
        SchedDenseR S{(const char*)(ws + WS_HB), (const char*)(ws + WS_WO) + (size_t)j * 1024 * 1024, (size_t)256 * 1024, (size_t)256 * 1024, 0, layer == 3 ? 64 : 68, 4, 64, c.G, (int)blockIdx.x, rdx};
        EpiResid E{&a, layer, nullptr, nullptr, nullptr};
        pg8::gemm_phase<EpiResid, SchedDenseR, false, true>(c.lds, 1024, 1024, S, E, 127 - MOE_WSH, 127 - ATT_OSH);
        RELAUNDER(); ph_m1(a, c, layer, (unsigned*)(a.ws + WS_CTL) + CW_RDX + layer * 128, 4, 0); }
#else
        unsigned* rdx = (unsigned*)(ws + WS_CTL) + CW_RDX + layer * 128;
        SchedDenseR S{(const char*)(ws + WS_HB), (const char*)(ws + WS_WO) + (size_t)j * 1024 * 1024 * 2, (size_t)256 * 1024 * 2, (size_t)256 * 1024 * 2, 0, layer == 3 ? 64 : 68, 4, 64, c.G, (int)blockIdx.x, rdx};
        EpiResid E{&a, layer, nullptr, nullptr, nullptr};
        pg8::gemm_phase<EpiResid, SchedDenseR, false>(c.lds, 2048, 2048, S, E);
        RELAUNDER(); ph_m1(a, c, layer, (unsigned*)(a.ws + WS_CTL) + CW_RDX + layer * 128, 4, 0); }
#endif
    else if constexpr (KIND == K_M2) {
        LAS int* tab = (LAS int*)(c.lds + TAB_OFF); moe_tables(a, c, layer, tab);
        unsigned* rdy = (unsigned*)(ws + WS_CTL) + CW_RDY + layer * 256;
#if MOE_FP8
        { SchedMoe S{(const char*)(ws + WS_TK), 0, (const char*)(ws + WS_WGU) + (size_t)layer * 32 * 1024 * 1024, (size_t)1024 * 1024, (size_t)256 * 1024, tab, (const int*)(ws + WS_LIST), c.G, (int)blockIdx.x, rdy, 1};
          EpiGateUp E{(bf16*)(ws + WS_ACT)};
          pg8::gemm_phase<EpiGateUp, SchedMoe, true, true>(c.lds, 1024, 1024, S, E, 127 - MOE_WSH, 127); }
        { SchedMoe S{(const char*)(ws + WS_ACT), (size_t)256 * 512, (const char*)(ws + WS_WDN) + (size_t)layer * 32 * 1024 * 512, (size_t)1024 * 512, (size_t)256 * 512, tab, (const int*)(ws + WS_LIST), c.G, (int)blockIdx.x, rdy, 2};
          EpiDown E{(const int*)(ws + WS_LIST), (const float*)(ws + WS_W2), (bf16*)(ws + WS_Y2)};
#if PROBE_Y2MAX
          E.dbgw = (unsigned*)(ws + WS_CTL) + CW_DBG + 40;
#endif
          pg8::gemm_phase<EpiDown, SchedMoe, false, true>(c.lds, 512, 512, S, E, 127 - MOE_WSH, 127 - MOE_ASH); } }
#else
        { SchedMoe S{(const char*)(ws + WS_TK), 0, (const char*)(ws + WS_WGU) + (size_t)layer * 32 * 1024 * 1024 * 2, (size_t)1024 * 1024 * 2, (size_t)256 * 1024 * 2, tab, (const int*)(ws + WS_LIST), c.G, (int)blockIdx.x, rdy, 1};
          EpiGateUp E{(bf16*)(ws + WS_ACT)};
          pg8::gemm_phase<EpiGateUp, SchedMoe, true>(c.lds, 2048, 2048, S, E); }
        { SchedMoe S{(const char*)(ws + WS_ACT), (size_t)256 * 512 * 2, (const char*)(ws + WS_WDN) + (size_t)layer * 32 * 1024 * 512 * 2, (size_t)1024 * 512 * 2, (size_t)256 * 512 * 2, tab, (const int*)(ws + WS_LIST), c.G, (int)blockIdx.x, rdy, 2};
          EpiDown E{(const int*)(ws + WS_LIST), (const float*)(ws + WS_W2), (bf16*)(ws + WS_Y2)};
          pg8::gemm_phase<EpiDown, SchedMoe, false>(c.lds, 1024, 1024, S, E); } }
#endif
    else if constexpr (KIND == K_RPOOL) ph_rpool(a, c, layer);
    else if constexpr (KIND == K_POOLG) {
        unsigned* rdx = (unsigned*)(ws + WS_CTL) + CW_RDX + layer * 128;
        SchedDenseR S{(const char*)(ws + WS_HB), (const char*)(ws + WS_WPOOL), (size_t)256 * 1024 * 2, (size_t)256 * 256 * 2, (size_t)256 * 2, 68, 4, 64, c.G, (int)blockIdx.x, rdx};
        EpiResidN E{&a, layer, a.in[I_POOLS], (const bf16*)(ws + WS_Z), nullptr};
        pg8::gemm_phase<EpiResidN, SchedDenseR, false>(c.lds, 512, 2048, S, E);
        RELAUNDER(); ph_m1(a, c, layer, (unsigned*)(a.ws + WS_CTL) + CW_RDX + layer * 128, 4, 0); }
    else if constexpr (KIND == K_INPROJ) {
        EpiInproj E{(bf16*)(ws + WS_Z), (bf16*)(ws + WS_XBC), (float*)(ws + WS_DT), a.in[I_DTB]};
#if SSD_FP8
        SchedDense S{(const char*)(ws + WS_HB), (const char*)(ws + WS_WIN), (size_t)256 * 1024, (size_t)256 * 1024, 0, 68, 21, c.G, (int)blockIdx.x};
        pg8::gemm_phase<EpiInproj, SchedDense, false, true>(c.lds, 1024, 1024, S, E, 127 - MOE_WSH, 127); }
#else
        SchedDense S{(const char*)(ws + WS_HB), (const char*)(ws + WS_WIN), (size_t)256 * 1024 * 2, (size_t)256 * 1024 * 2, 0, 68, 21, c.G, (int)blockIdx.x};
        pg8::gemm_phase<EpiInproj, SchedDense, false>(c.lds, 2048, 2048, S, E); }
#endif
    else if constexpr (KIND == K_CONV) ph_conv(a, c);
    else if constexpr (KIND == K_SCAN) ph_scan(a, c);
    else if constexpr (KIND == K_YPH) {
        ph_yph(a, c, (unsigned*)(ws + WS_CTL) + CW_RDG);
        RELAUNDER();
        { unsigned* rdx = (unsigned*)(a.ws + WS_CTL) + CW_RDX + layer * 128;
          SchedOutproj S{(const char*)(a.ws + WS_G), (const char*)(a.ws + WS_WOUT), (size_t)256 * 2048 * 2, (size_t)256 * 2048 * 2, c.G, c.vcu, (const unsigned*)(a.ws + WS_CTL) + CW_RDG, rdx, (const float*)(a.ws + WS_RSTD)};
          EpiResid E{&a, layer, nullptr, nullptr, (const float*)(a.ws + WS_RSTD)};
          pg8::gemm_phase<EpiResid, SchedOutproj, false>(c.lds, 4096, 4096, S, E); }
        RELAUNDER(); ph_m1(a, c, layer, (unsigned*)(a.ws + WS_CTL) + CW_RDX + layer * 128, 4, 1); }
    else if constexpr (KIND == K_GFIX) ph_gfix(a, c);
    else if constexpr (KIND == K_FINAL) ph_final(a, c, layer);
#undef RELAUNDER
}
#define PROGRAM(X) \
    X(0, K_P0, 0) \
    X(1, K_RMIX, 0) X(2, K_QKV, 0) X(3, K_ATT, 0) X(4, K_OPROJ, 0) X(5, K_M2, 0) \
    X(6, K_RPOOL, 1) X(7, K_POOLG, 1) X(8, K_M2, 1) \
    X(9, K_RMIX, 2) X(10, K_INPROJ, 2) X(11, K_CONV, 2) X(12, K_SCAN, 2) X(13, K_YPH, 2) X(14, K_M2, 2) \
    X(15, K_RMIX, 3) X(16, K_QKV, 3) X(17, K_ATT, 3) X(18, K_OPROJ, 3) X(19, K_M2, 3) \
    X(20, K_FINAL, 4)
constexpr int NPHASES = 21;
__device__ __forceinline__ unsigned long long probe_phases(const unsigned long long* ts, unsigned mask) { unsigned long long r = 0; for (int k = 0; k < 32; ++k) if (mask & (1u << k)) r += ts[k + 1] - ts[k]; return r; }
__device__ __forceinline__ unsigned long long probe_sum(const unsigned long long* s, int mask) { unsigned long long r = 0; for (int k = 0; k < 8; ++k) if (mask & (1 << k)) r += s[k]; return r; }
__global__ void __launch_bounds__(NTHREADS, 2) mega(Args a0) {
    extern __shared__ __attribute__((aligned(16))) unsigned char lds_raw[];
    Ctx c; c.lds = (LAS unsigned char*)lds_raw; c.tid = threadIdx.x; c.lane = c.tid & 63; c.wave = __builtin_amdgcn_readfirstlane(c.tid >> 6);
    c.G = gridDim.x; { const int bx = blockIdx.x; c.vcu = (c.G % 8 == 0) ? (bx % 8) * (c.G / 8) + bx / 8 : bx; }
    volatile LAS unsigned* MISC = (volatile LAS unsigned*)(c.lds + MISC_OFF);
    for (int u = c.tid; u < 128; u += NTHREADS) MISC[u] = 0u;
    __syncthreads();
    XcdBarrier bar = xcd_barrier_post((unsigned*)(a0.ws + WS_CTL) + CW_BAR + a0.bar_region * XCD_BAR_WORDS, MISC + 8);
    const int lo = a0.ph_lo, hi = a0.ph_hi;
#if PROBE
#define STAMP(idx) if (blockIdx.x == 0 && threadIdx.x == 0) __hip_atomic_store((unsigned long long*)((unsigned*)(a0.ws + WS_CTL) + CW_TS) + (idx), (unsigned long long)__builtin_amdgcn_s_memrealtime(), __ATOMIC_RELAXED, __HIP_MEMORY_SCOPE_AGENT);
#else
#define STAMP(idx)
#endif
    STAMP(0)
#if EXTRA_BARS
    for (int eb = 0; eb < EXTRA_BARS; ++eb) xcd_barrier(bar);
#endif
#define RUNPH(idx, KIND, LAYER) if (lo <= (idx) && (idx) < hi) { run_phase<KIND, LAYER>(a0, c, lds_raw); if ((idx) + 1 < hi) xcd_barrier(bar); STAMP((idx) + 1) }
    PROGRAM(RUNPH)
#undef RUNPH
#if PROBE_Y2MAX
    if (blockIdx.x == 0 && threadIdx.x == 0 && hi == NPHASES) { const unsigned bits = __hip_atomic_load((unsigned*)(a0.ws + WS_CTL) + CW_DBG + 40, __ATOMIC_RELAXED, __HIP_MEMORY_SCOPE_AGENT);
        const unsigned long long d = (unsigned long long)((bits >> 20) & 0x7FFu) * 400ull, t0 = __builtin_amdgcn_s_memrealtime();
        while (__builtin_amdgcn_s_memrealtime() - t0 < d) __builtin_amdgcn_s_sleep(8); }
#endif
#if PROBE
    if (blockIdx.x == 0 && threadIdx.x == 0 && hi == NPHASES) { const unsigned long long* ts = (const unsigned long long*)((unsigned*)(a0.ws + WS_CTL) + CW_TS);
        const unsigned long long d = (unsigned long long)PROBE_K * (PROBE_SLOT ? probe_sum(ts + PROBE_SLOT_BASE, PROBE_SLOT) : probe_phases(ts, PROBE_MASK)), t0 = __builtin_amdgcn_s_memrealtime();
        while (__builtin_amdgcn_s_memrealtime() - t0 < d) __builtin_amdgcn_s_sleep(8); }
#endif
}

extern "C" void kernel_launch(void* const* d_in, const int* in_sizes, int n_in, void* d_out, int out_size, void* d_ws, size_t ws_size, hipStream_t stream) {
    static int grid = 0;
    if (grid == 0) {
        if (n_in != N_IN || out_size != TL * D || ws_size < WS_END) { fprintf(stderr, "kernel_launch: unexpected shapes (n_in %d out %d ws %zu)\n", n_in, out_size, ws_size); grid = -1; return; }
        int dev = 0, cus = 0;
        if (hipGetDevice(&dev) != hipSuccess || hipDeviceGetAttribute(&cus, hipDeviceAttributeMultiprocessorCount, dev) != hipSuccess) { grid = -1; return; }
        if (hipFuncSetAttribute((const void*)mega, hipFuncAttributeMaxDynamicSharedMemorySize, LDS_BYTES) != hipSuccess) { fprintf(stderr, "kernel_launch: hipFuncSetAttribute failed\n"); grid = -1; return; }
        int per_cu = 0;
        if (hipOccupancyMaxActiveBlocksPerMultiprocessor(&per_cu, (const void*)mega, NTHREADS, LDS_BYTES) != hipSuccess || per_cu < 1) fprintf(stderr, "kernel_launch: occupancy query says %d\n", per_cu);
        (void)hipGetLastError();
        if (cus < 192) { fprintf(stderr, "kernel_launch: %d CUs: the router keeps at most 3 row tiles of logits per workgroup (needs >= 182 workgroups)\n", cus); grid = -1; return; }
        grid = cus;
    }
    if (grid < 0) return;
    (void)hipMemsetAsync((char*)d_ws + WS_CTL, 0, CTL_ZERO_BYTES, stream);
    Args a{};
    for (int i = 0; i < N_IN; ++i) a.in[i] = (const float*)d_in[i];
    a.out = (float*)d_out; a.ws = (unsigned char*)d_ws; a.flags = 0;
#if DEBUG_CHECKS
    struct Cut { int after; int ty, layer, nid; };
    const Cut cuts[] = DEBUG_CUTS;
    int lo = 0, region = 0, dbg_id = 1;
    for (unsigned k = 0; k < sizeof(cuts) / sizeof(cuts[0]); ++k) {
        if (cuts[k].after + 1 > lo) { a.ph_lo = lo; a.ph_hi = cuts[k].after + 1; a.bar_region = region++; hipLaunchKernelGGL(mega, dim3(grid), dim3(NTHREADS), LDS_BYTES, stream, a); lo = cuts[k].after + 1; }
        hipLaunchKernelGGL(dbg_kernel, dim3(16), dim3(NTHREADS), 65536, stream, a, cuts[k].ty, cuts[k].layer, dbg_id); dbg_id += cuts[k].nid;
    }
    a.ph_lo = lo; a.ph_hi = NPHASES; a.bar_region = region++;
    hipLaunchKernelGGL(mega, dim3(grid), dim3(NTHREADS), LDS_BYTES, stream, a);
#else
    a.ph_lo = 0; a.ph_hi = NPHASES; a.bar_region = 0;
    hipLaunchKernelGGL(mega, dim3(grid), dim3(NTHREADS), LDS_BYTES, stream, a);
#endif
}
```
